# Optimizing an MI355X kernel written in HIP

```python
import math
import jax, jax.numpy as jnp
from jax import lax
import numpy as np

D_MODEL = 1024
BATCH = 16
SEQ = 4096
DEPTH = 4

GLA_HEADS = 4
GLA_DK = 128
GLA_DV = 256
GLA_RANK = 16
GLA_TAU = 16.0
GLA_CHUNK = 64
DIL_PATTERN = ((128, 1), (512, 4), (2048, 16))
DIL_HEADS = 8
DIL_HD = 64
ROPE_THETA = 10000.0
N_EXPERTS = 16
N_GROUPS = 4
EXPERTS_PER_GROUP = N_EXPERTS // N_GROUPS
TOP_K = 2
D_FF = 1024
LN_EPS = 1e-5
RMS_EPS = 1e-6
DN_ALPHA = (2 * DEPTH) ** 0.25
DN_BETA = (8 * DEPTH) ** -0.25
NEG_INF = -1e30

GLA_QK_W = GLA_HEADS * GLA_DK
GLA_V_W = GLA_HEADS * GLA_DV
N_DIL = len(DIL_PATTERN)
DIL_GROUP_W = DIL_HEADS * DIL_HD
N_BRANCH = 2
SPLITS = (GLA_QK_W, GLA_QK_W, GLA_V_W, GLA_V_W, GLA_RANK,
          N_DIL * DIL_GROUP_W, N_DIL * DIL_GROUP_W, N_DIL * DIL_GROUP_W, N_BRANCH * D_MODEL)
V_BLOCKS = (2, 7)
D_IN = sum(SPLITS)
SPLIT_POINTS = tuple(sum(SPLITS[:i + 1]) for i in range(len(SPLITS) - 1))

kernel_name = "hybrid_gla_dilated_gated_moe_deepnorm"


def layer_norm(x, g, b):
    xf = x.astype(jnp.float32)
    mu = jnp.mean(xf, axis=-1, keepdims=True)
    var = jnp.mean(jnp.square(xf - mu), axis=-1, keepdims=True)
    y = (xf - mu) * lax.rsqrt(var + LN_EPS) * g.astype(jnp.float32) + b.astype(jnp.float32)
    return y.astype(x.dtype)


def rotary(x, positions):
    e = x.shape[-1]
    half = e // 2
    inv_freq = jnp.power(jnp.float32(ROPE_THETA), -jnp.arange(0, e, 2, dtype=jnp.float32) / e)
    ang = positions.astype(jnp.float32)[..., None] * inv_freq
    cos = jnp.cos(ang)[:, :, None, :]
    sin = jnp.sin(ang)[:, :, None, :]
    xf = x.astype(jnp.float32)
    x1, x2 = xf[..., :half], xf[..., half:]
    return jnp.concatenate([x1 * cos - x2 * sin, x2 * cos + x1 * sin], axis=-1).astype(x.dtype)


def gla_chunked(q, k, v, log_a):
    B, S, H, DK = q.shape
    DV = v.shape[-1]
    C = GLA_CHUNK
    N = S // C

    def chunks(t):
        return t.astype(jnp.float32).reshape(B, N, C, H, t.shape[-1]).transpose(0, 3, 1, 2, 4)

    qc = chunks(q) * (DK ** -0.5)
    kc = chunks(k)
    vc = chunks(v)
    b = jnp.cumsum(chunks(log_a), axis=3)
    b_end = b[:, :, :, -1:, :]
    q_t = qc * jnp.exp(b)
    k_t = kc * jnp.exp(-b)
    k_s = kc * jnp.exp(b_end - b)
    causal = jnp.tril(jnp.ones((C, C), dtype=bool))
    att = jnp.where(causal, jnp.einsum('bhnid,bhnjd->bhnij', q_t, k_t), 0.0)
    o_intra = jnp.einsum('bhnij,bhnjv->bhniv', att, vc)
    decay = jnp.exp(b_end[:, :, :, 0, :])

    def step(state, inp):
        q_n, k_n, v_n, d_n = inp
        o_n = jnp.einsum('bhcd,bhdv->bhcv', q_n, state)
        state = d_n[..., None] * state + jnp.einsum('bhcd,bhcv->bhdv', k_n, v_n)
        return state, o_n

    init = jnp.zeros((B, H, DK, DV), jnp.float32)
    xs = (jnp.moveaxis(q_t, 2, 0), jnp.moveaxis(k_s, 2, 0), jnp.moveaxis(vc, 2, 0), jnp.moveaxis(decay, 2, 0))
    _, o_inter = lax.scan(step, init, xs)
    o = o_intra + jnp.moveaxis(o_inter, 0, 2)
    return o.transpose(0, 2, 3, 1, 4).reshape(B, S, H, DV)


def dilated_group(q, k, v, window, dilation):
    B, S, H, E = q.shape
    steps = window // dilation
    L = S // dilation
    nb = -(-L // steps)
    Lp = nb * steps

    def to_sub(t):
        t = t.reshape(B, L, dilation, H, E).transpose(0, 2, 3, 1, 4)
        t = jnp.pad(t, ((0, 0), (0, 0), (0, 0), (0, Lp - L), (0, 0)))
        return t.reshape(B, dilation, H, nb, steps, E)

    qb, kb, vb = to_sub(q), to_sub(k), to_sub(v)

    def with_prev(t):
        prev = jnp.concatenate([jnp.zeros_like(t[:, :, :, :1]), t[:, :, :, :-1]], axis=3)
        return jnp.concatenate([prev, t], axis=4)

    kw, vw = with_prev(kb), with_prev(vb)
    s = jnp.einsum('bdhnqe,bdhnke->bdhnqk', qb, kw).astype(jnp.float32) * (E ** -0.5)
    qi = jnp.arange(steps)[:, None]
    kj = jnp.arange(2 * steps)[None, :]
    rel = steps + qi - kj
    band = (rel >= 0) & (rel <= steps)
    blk = jnp.arange(nb)[:, None, None]
    key_exists = (blk * steps - steps + kj[None]) >= 0
    mask = band[None] & key_exists
    s = jnp.where(mask, s, NEG_INF)
    m = jnp.max(s, axis=-1, keepdims=True)
    p = jnp.exp(s - m)
    l = jnp.sum(p, axis=-1, keepdims=True)
    o = jnp.einsum('bdhnqk,bdhnke->bdhnqe', p, vw.astype(jnp.float32)) / l
    lse = (m + jnp.log(l))[..., 0]
    o = o.reshape(B, dilation, H, Lp, E)[:, :, :, :L].transpose(0, 3, 1, 2, 4).reshape(B, S, H, E)
    lse = lse.reshape(B, dilation, H, Lp)[..., :L].transpose(0, 3, 1, 2).reshape(B, S, H)
    return o, lse


def dilated_branch(q, k, v, positions):
    B, S, _ = q.shape
    q = rotary(q.reshape(B, S, N_DIL * DIL_HEADS, DIL_HD), positions)
    k = rotary(k.reshape(B, S, N_DIL * DIL_HEADS, DIL_HD), positions)
    v = v.reshape(B, S, N_DIL * DIL_HEADS, DIL_HD)
    outs, lses = [], []
    for g, (window, dilation) in enumerate(DIL_PATTERN):
        sl = slice(g * DIL_HEADS, (g + 1) * DIL_HEADS)
        o, lse = dilated_group(q[:, :, sl], k[:, :, sl], v[:, :, sl], window, dilation)
        outs.append(o)
        lses.append(lse)
    w = jax.nn.softmax(jnp.stack(lses, axis=0), axis=0)
    o = jnp.sum(w[..., None] * jnp.stack(outs, axis=0), axis=0)
    return o.reshape(B, S, DIL_GROUP_W)


def grouped_moe(x, w_router, b_router, w_gate, w_up, w_down):
    B, S, _ = x.shape
    logits = jnp.einsum('bsd,de->bse', x, w_router).astype(jnp.float32) + b_router.astype(jnp.float32)
    probs = jax.nn.softmax(logits, axis=-1)
    pg = probs.reshape(B, S, N_GROUPS, EXPERTS_PER_GROUP)
    group_score = lax.top_k(pg, TOP_K)[0].sum(-1)
    g_sel = jnp.argmax(group_score, axis=-1)
    in_group = jnp.arange(N_GROUPS) == g_sel[..., None]
    cand = jnp.where(in_group[..., None], pg, -1.0).reshape(B, S, N_EXPERTS)
    vals, idx = lax.top_k(cand, TOP_K)
    gates = vals / jnp.sum(vals, axis=-1, keepdims=True)
    combine = jnp.sum(jax.nn.one_hot(idx, N_EXPERTS, dtype=jnp.float32) * gates[..., None], axis=-2)
    y = jnp.zeros((B, S, x.shape[-1]), jnp.float32)
    for e in range(N_EXPERTS):
        h = jax.nn.silu(x @ w_gate[e]) * (x @ w_up[e])
        y = y + combine[..., e:e + 1] * (h @ w_down[e]).astype(jnp.float32)
    return y.astype(x.dtype)


def setup_inputs(seed: int = 0) -> dict:
    key = jax.random.key(seed)
    ks = jax.random.split(key, 20)
    f32 = jnp.float32

    def nrm(k, shape, scale):
        return jax.random.normal(k, shape, f32) * scale

    x = nrm(ks[0], (BATCH, SEQ, D_MODEL), 1.0)
    offset = jax.random.randint(ks[1], (BATCH, 1), 0, SEQ)
    positions = (offset + jnp.arange(SEQ)[None, :]).astype(jnp.int32)
    col_scale = jnp.concatenate([jnp.full((n,), DN_BETA if i in V_BLOCKS else 1.0, f32)
                                 for i, n in enumerate(SPLITS)])
    w_in = nrm(ks[2], (DEPTH, D_MODEL, D_IN), D_MODEL ** -0.5) * col_scale
    w_alpha_up = nrm(ks[3], (DEPTH, GLA_RANK, GLA_QK_W), GLA_RANK ** -0.5)
    b_alpha = nrm(ks[4], (DEPTH, GLA_QK_W), 0.1)
    gla_norm = 1.0 + nrm(ks[5], (DEPTH, GLA_V_W), 0.02)
    w_gla_o = nrm(ks[6], (DEPTH, GLA_V_W, D_MODEL), GLA_V_W ** -0.5)
    w_att_o = nrm(ks[7], (DEPTH, DIL_GROUP_W, D_MODEL), DIL_GROUP_W ** -0.5)
    w_out = nrm(ks[8], (DEPTH, D_MODEL, D_MODEL), D_MODEL ** -0.5 * DN_BETA)
    ln1_g = 1.0 + nrm(ks[9], (DEPTH, D_MODEL), 0.02)
    ln1_b = nrm(ks[10], (DEPTH, D_MODEL), 0.02)
    w_router = nrm(ks[11], (D_MODEL, N_EXPERTS), D_MODEL ** -0.5)
    b_router = nrm(ks[12], (N_EXPERTS,), 0.01)
    w_e_gate = nrm(ks[13], (DEPTH, N_EXPERTS, D_MODEL, D_FF), D_MODEL ** -0.5)
    w_e_up = nrm(ks[14], (DEPTH, N_EXPERTS, D_MODEL, D_FF), D_MODEL ** -0.5)
    w_e_down = nrm(ks[15], (DEPTH, N_EXPERTS, D_FF, D_MODEL), D_FF ** -0.5 * DN_BETA)
    ln2_g = 1.0 + nrm(ks[16], (DEPTH, D_MODEL), 0.02)
    ln2_b = nrm(ks[17], (DEPTH, D_MODEL), 0.02)
    return {"x": x, "positions": positions, "w_in": w_in, "w_alpha_up": w_alpha_up,
            "b_alpha": b_alpha, "gla_norm": gla_norm, "w_gla_o": w_gla_o, "w_att_o": w_att_o,
            "w_out": w_out, "ln1_g": ln1_g, "ln1_b": ln1_b, "w_router": w_router,
            "b_router": b_router, "w_e_gate": w_e_gate, "w_e_up": w_e_up, "w_e_down": w_e_down,
            "ln2_g": ln2_g, "ln2_b": ln2_b}


def reference(x, positions, w_in, w_alpha_up, b_alpha, gla_norm, w_gla_o, w_att_o, w_out,
              ln1_g, ln1_b, w_router, b_router, w_e_gate, w_e_up, w_e_down, ln2_g, ln2_b):
    B, S, _ = x.shape
    for i in range(DEPTH):
        h = x @ w_in[i]
        q_g, k_g, v_g, r_g, a_g, q_d, k_d, v_d, gate_in = jnp.split(h, SPLIT_POINTS, axis=-1)
        log_a = jax.nn.log_sigmoid((a_g @ w_alpha_up[i]).astype(jnp.float32)
                                   + b_alpha[i].astype(jnp.float32)) / GLA_TAU
        o = gla_chunked(q_g.reshape(B, S, GLA_HEADS, GLA_DK), k_g.reshape(B, S, GLA_HEADS, GLA_DK),
                        v_g.reshape(B, S, GLA_HEADS, GLA_DV), log_a.reshape(B, S, GLA_HEADS, GLA_DK))
        o = o * lax.rsqrt(jnp.mean(jnp.square(o), axis=-1, keepdims=True) + RMS_EPS)
        o = o * gla_norm[i].astype(jnp.float32).reshape(GLA_HEADS, GLA_DV)
        y_gla = (o.reshape(B, S, GLA_V_W).astype(x.dtype) * jax.nn.silu(r_g)) @ w_gla_o[i]
        y_att = dilated_branch(q_d, k_d, v_d, positions).astype(x.dtype) @ w_att_o[i]
        g_gla, g_att = jnp.split(jax.nn.sigmoid(gate_in), N_BRANCH, axis=-1)
        mix = (g_gla * y_gla + g_att * y_att) @ w_out[i]
        x = layer_norm(DN_ALPHA * x + mix, ln1_g[i], ln1_b[i])
        y_moe = grouped_moe(x, w_router, b_router, w_e_gate[i], w_e_up[i], w_e_down[i])
        x = layer_norm(DN_ALPHA * x + y_moe, ln2_g[i], ln2_b[i])
    return x
```

```cpp
#include <hip/hip_runtime.h>
#include <cstdio>
#include <cstdint>

#ifndef MK_MULTI
#define MK_MULTI 1
#endif

#define DI __device__ __forceinline__
#define GAS __attribute__((address_space(1)))
#define LAS __attribute__((address_space(3)))
typedef unsigned short bf16_t;
typedef short bf16x8 __attribute__((ext_vector_type(8)));
typedef short s16x4 __attribute__((ext_vector_type(4)));
typedef float f32x4 __attribute__((ext_vector_type(4)));
typedef float f32x2 __attribute__((ext_vector_type(2)));
typedef unsigned u32x4 __attribute__((ext_vector_type(4)));
typedef unsigned u32x2 __attribute__((ext_vector_type(2)));
#define LDS_WAIT() asm volatile("s_waitcnt lgkmcnt(0)" ::: "memory")
#define VM_WAIT() asm volatile("s_waitcnt vmcnt(0)" ::: "memory")

constexpr int D = 1024, NBATCH = 16, SEQ = 4096, T = NBATCH * SEQ, DEPTH = 4;
constexpr int TH = T / 2;
constexpr int DIN = 9744, NIN = 9984;
constexpr int NEXP = 16, DFF = 1024;
constexpr float LN_EPS = 1e-5f, RMS_EPS = 1e-6f;
constexpr float DN_ALPHA = 1.6817928305074290f;
constexpr float LOG2E = 1.4426950408889634f;
constexpr int NWAVES = 8, NTHREADS = 512;

constexpr size_t MiB = 1u << 20;
constexpr size_t WS_CTL = 0, CTL_ZERO_BYTES = 1 * MiB;
constexpr size_t WS_WIN = 1 * MiB;
constexpr size_t WS_WGO = WS_WIN + (size_t)NIN * D * 2;
constexpr size_t WS_WAO = WS_WGO + 2 * MiB;
constexpr size_t WS_WOUT = WS_WAO + 1 * MiB;
constexpr size_t WS_WGU = WS_WOUT + 2 * MiB;
constexpr size_t WS_WD = WS_WGU + 64 * MiB;
constexpr size_t WS_XB = WS_WD + 32 * MiB;
constexpr size_t WS_LIST = WS_XB + 128 * MiB;
constexpr size_t WS_GATE = WS_LIST + 4 * MiB;
constexpr size_t WS_INFO = WS_GATE + 1 * MiB;
constexpr size_t WS_HISTG = WS_INFO + 1 * MiB;
constexpr size_t WS_OG = WS_HISTG + 1 * MiB;
constexpr size_t WS_ATTG = WS_OG + 64 * MiB;
constexpr size_t WS_LSE = WS_ATTG + 96 * MiB;
constexpr size_t WS_ATT = WS_LSE + 3 * MiB;
constexpr size_t WS_MIX = WS_ATT + 32 * MiB;
constexpr size_t WS_HA = WS_MIX + 64 * MiB;
constexpr size_t WS_H = WS_HA + 2 * MiB;
constexpr size_t H_QG = 0, H_KG = H_QG + (size_t)TH * 512 * 2, H_VG = H_KG + (size_t)TH * 512 * 2, H_SR = H_VG + (size_t)TH * 1024 * 2,
                 H_QD = H_SR + (size_t)TH * 1024 * 2, H_KD = H_QD + (size_t)TH * 1536 * 2, H_VD = H_KD + (size_t)TH * 1536 * 2, H_GT = H_VD + (size_t)TH * 1536 * 2,
                 H_END = H_GT + (size_t)TH * 2048 * 2;
constexpr size_t WS_HM = WS_H;
constexpr size_t WS_YS = WS_HM + (size_t)(2 * T + 4096) * 1024 * 2;
constexpr size_t WS_END = WS_H + H_END;
static_assert(WS_YS + (size_t)2 * T * 1024 * 2 <= WS_END, "MoE overlay fits");
constexpr int CW_BAR = 4096;
constexpr int CW_CUR = 16384;

constexpr int RING_BYTES = 131072;
constexpr int TAB_OFF = RING_BYTES, MAXU = 18, TAB_BYTES = MAXU * 1024;
constexpr int MISC_OFF = TAB_OFF + TAB_BYTES;
constexpr int LDS_BYTES = MISC_OFF + 256;

DI int rfl(int v) { return __builtin_amdgcn_readfirstlane(v); }
DI int lbid() { int t = blockIdx.x; asm volatile("" : "+s"(t)); return t; }
DI int lgrid() { int t = gridDim.x; asm volatile("" : "+s"(t)); return t; }
DI int ltid() { int t = threadIdx.x; asm volatile("" : "+v"(t)); return t; }
DI float bf2f(unsigned b) { return __uint_as_float(b << 16); }
DI unsigned cvt_pk_bf16(float lo, float hi) { unsigned r; asm volatile("v_cvt_pk_bf16_f32 %0, %1, %2" : "=v"(r) : "v"(lo), "v"(hi)); return r; }
DI float bf_lo(unsigned w) { return __uint_as_float(w << 16); }
DI float bf_hi(unsigned w) { return __uint_as_float(w & 0xffff0000u); }
DI float sigmoidf_(float x) { return __builtin_amdgcn_rcpf(1.0f + __builtin_amdgcn_exp2f(-x * LOG2E)); }

#define XB_TMO      128
#define XB_XCNT(j)  (256  + 64 * (j))
#define XB_XSUB(j)  (1280 + 64 * (j))
#define XB_XGEN(j)  (2304 + 64 * (j))
#define XB_TOP      3328
#define XB_TOPGEN   3392
#define XCD_BAR_WORDS 3456
#define XB_SPIN_CAP (1u << 18)
DI unsigned xb_ld(unsigned* p)              { return __hip_atomic_load(p, __ATOMIC_RELAXED, __HIP_MEMORY_SCOPE_AGENT); }
DI unsigned xb_add(unsigned* p, unsigned v) { return __hip_atomic_fetch_add(p, v, __ATOMIC_RELAXED, __HIP_MEMORY_SCOPE_AGENT); }
DI unsigned xb_xcc_id() { return (unsigned)__builtin_amdgcn_s_getreg((3 << 11) | 20) & 0xFu; }
#define XB_SPIN(cond, bar) do { unsigned _sp = 0; while (cond) { __builtin_amdgcn_s_sleep(1); \
    if ((++_sp & 255u) == 0u) { if (xb_ld(&(bar)[XB_TMO])) break; if (_sp > XB_SPIN_CAP) { atomicAdd(&(bar)[XB_TMO], 1u); break; } } } } while (0)
struct XcdBarrier { unsigned* bar; unsigned x; volatile LAS unsigned* st; };
DI XcdBarrier xcd_barrier_post(unsigned* bar, volatile LAS unsigned* st) {
    XcdBarrier b; b.bar = bar; b.x = xb_xcc_id(); b.st = st;
    if (threadIdx.x == 0) (void)xb_add(&bar[XB_XCNT(b.x)], 1u);
    return b;
}
DI void xcd_barrier_complete(unsigned* bar, unsigned x, unsigned& nloc, unsigned& nx) {
    const unsigned G = gridDim.x * gridDim.y * gridDim.z;
    unsigned sum, cnt, mine, sp = 0u;
    for (;;) {
        sum = 0u; cnt = 0u; mine = 0u;
#pragma unroll
        for (unsigned j = 0; j < 16; ++j) { const unsigned c = xb_ld(&bar[XB_XCNT(j)]); sum += c; cnt += (c > 0u) ? 1u : 0u; mine = (j == x) ? c : mine; }
        if (sum == G) break;
        __builtin_amdgcn_s_sleep(1);
        if ((++sp & 255u) == 0u) { if (xb_ld(&bar[XB_TMO])) break; if (sp > XB_SPIN_CAP) { atomicAdd(&bar[XB_TMO], 1u); break; } }
    }
    nloc = mine > 0u ? mine : 1u; nx = cnt > 0u ? cnt : 1u;
}
DI void xcd_barrier(const XcdBarrier& b) {
    asm volatile("s_waitcnt vmcnt(0)" ::: "memory");
    __syncthreads();
    if (threadIdx.x == 0) {
        unsigned* bar = b.bar;
        __builtin_amdgcn_s_waitcnt(0);
        unsigned nloc = b.st[0], nx = b.st[1];
        if (nloc == 0u) { xcd_barrier_complete(bar, b.x, nloc, nx); b.st[0] = nloc; b.st[1] = nx; }
        const unsigned old = xb_add(&bar[XB_XSUB(b.x)], 1u);
        const unsigned gen = old / nloc;
        if (old + 1u == (gen + 1u) * nloc) {
            __builtin_amdgcn_fence(__ATOMIC_RELEASE, "agent");
            asm volatile("s_waitcnt vmcnt(0)" ::: "memory");
            const unsigned og = xb_add(&bar[XB_TOP], 1u);
            const unsigned tg = og / nx;
            if (og + 1u == (tg + 1u) * nx) xb_add(&bar[XB_TOPGEN], 1u);
            else XB_SPIN(xb_ld(&bar[XB_TOPGEN]) == tg, bar);
            __builtin_amdgcn_fence(__ATOMIC_ACQUIRE, "agent");
            xb_add(&bar[XB_XGEN(b.x)], 1u);
            asm volatile("s_waitcnt vmcnt(0)" ::: "memory");
        } else {
            XB_SPIN(xb_ld(&bar[XB_XGEN(b.x)]) == gen, bar);
            __builtin_amdgcn_fence(__ATOMIC_ACQUIRE, "agent");
            asm volatile("s_waitcnt vmcnt(0)" ::: "memory");
        }
    }
    __syncthreads();
}

struct Ctx {
    const float* x; const int* pos; const float* w_in; const float* w_alpha_up; const float* b_alpha; const float* gla_norm;
    const float* w_gla_o; const float* w_att_o; const float* w_out; const float* ln1_g; const float* ln1_b; const float* w_router; const float* b_router;
    const float* w_e_gate; const float* w_e_up; const float* w_e_down; const float* ln2_g; const float* ln2_b;
    float* out; unsigned char* ws;
    int lo, hi;
};
DI bf16_t* wsb(const Ctx& c, size_t off) { return (bf16_t*)(c.ws + off); }

namespace pg8 {
constexpr int BM = 256, BK = 64, HALF = 128, HTB = HALF * BK * 2, STAGE_BYTES = 8 * HTB, NXCD = 8, WGM = 8;
DI int lds_byte(int r, int c) { const int st = (r >> 4) * 2 + (c >> 5), rr = r & 15, cc = c & 31, ob = rr * 64 + cc * 2; return st * 1024 + (ob ^ (((ob >> 9) & 1) << 5)); }
DI void stage_rc(int b, int& R, int& C) { const int st = b / 1024, sb = b % 1024, swz = sb ^ (((sb >> 9) & 1) << 5); R = (st >> 1) * 16 + swz / 64; C = (st & 1) * 32 + (swz % 64) / 2; }
DI int perm32(int rho) { const int n = rho >> 4, i = rho & 15; return 8 * (i >> 2) + 4 * n + (i & 3); }
struct Unit { int pm, pn, e, nv, ui; };

struct StaticOrder {
    int nM, nN, nwg, G, c, K; const char* A; const char* Bt;
    DI void init(const void* A_, const void* Bt_, int M, int N, int K_, int G_, int c_) { A = (const char*)A_; Bt = (const char*)Bt_; nM = M / BM; nN = N / BM; nwg = nM * nN; G = G_; c = c_; K = K_; }
    DI bool next(int i, Unit& u) const {
        const long L = (long)i * G + c; if (L >= nwg) return false;
        int wgid = (int)L; { const int q = nwg / NXCD, r = nwg % NXCD, xcd = wgid % NXCD, off = wgid / NXCD; wgid = (xcd < r ? xcd * (q + 1) : r * (q + 1) + (xcd - r) * q) + off; }
        const int nig = WGM * nN, gid = wgid / nig, fm = gid * WGM, gsz = (nM - fm) < WGM ? (nM - fm) : WGM;
        u.pm = fm + ((wgid % nig) % gsz); u.pn = (wgid % nig) / gsz; u.e = 0; u.nv = 256; u.ui = i; return true;
    }
    DI const char* a_base(const Unit& u) const { return A + (size_t)u.pm * BM * K * 2; }
    DI const char* b_base(const Unit& u) const { return Bt + (size_t)u.pn * BM * K * 2; }
    DI void a_off(const Unit&, int tid, unsigned (&o)[2][2]) const {
#pragma unroll
        for (int i = 0; i < 2; ++i) { int R, C; stage_rc(tid * 16 + i * 8192, R, C);
#pragma unroll
            for (int h = 0; h < 2; ++h) o[h][i] = (unsigned)((h * HALF + R) * K + C) * 2u; }
    }
};
struct MoeOrder {
    int G, c, ntot, NC, K; const volatile LAS int* pre; const volatile LAS int* cnt; const char* A; const char* Bt; size_t bstride; const volatile LAS int* tab; bool gather;
    DI bool next(int i, Unit& u) const {
        const int L = i * G + c; if (L >= ntot) return false;
        const int rt = L / NC; u.pn = L - rt * NC; u.pm = rt;
        int e = 0;
#pragma unroll
        for (int j = 1; j < 16; ++j) e += (rt >= rfl(pre[j])) ? 1 : 0;
        e = rfl(e); u.e = e; const int rem = rfl(cnt[e]) - 256 * (rt - rfl(pre[e])); u.nv = rem < 256 ? rem : 256; u.ui = i; return true;
    }
    DI const char* a_base(const Unit& u) const { return gather ? A : A + (size_t)u.pm * BM * K * 2; }
    DI const char* b_base(const Unit& u) const { return Bt + (size_t)u.e * bstride + (size_t)u.pn * BM * K * 2; }
    DI void a_off(const Unit& u, int tid, unsigned (&o)[2][2]) const {
#pragma unroll
        for (int i = 0; i < 2; ++i) { int R, C; stage_rc(tid * 16 + i * 8192, R, C);
#pragma unroll
            for (int h = 0; h < 2; ++h) { const int row = gather ? tab[u.ui * 256 + h * HALF + R] : (h * HALF + R); o[h][i] = (unsigned)(row * K + C) * 2u; } }
    }
};

template <class Epi, class Sched>
DI void gemm_phase(LAS unsigned char* lds, const int K, const Sched& S, const Epi& E) {
    const int tid = ltid(), wid = rfl(tid >> 6), lane = tid & 63, wr = wid >> 2, wc = wid & 3, fr = lane & 15, fq = lane >> 4;
    const int nt = K / BK;
    unsigned voffB[2];
#pragma unroll
    for (int i = 0; i < 2; ++i) { int R, C; stage_rc(tid * 16 + i * 8192, R, C); const int Rb = Epi::PERM ? ((R & ~31) + perm32(R & 31)) : R; voffB[i] = (unsigned)(Rb * K + C) * 2u; }
    const size_t kstep = (size_t)(BK * 2);
    const size_t hstep = (size_t)HALF * K * 2;
    const unsigned ldsw = (unsigned)wid * 1024u;
    const int aoff = lds_byte(wr * 64 + fr, fq * 8), boff = lds_byte(wc * 32 + fr, fq * 8);
#define PG8_SA(b, h) (((b) * 2 + (h)) * HTB)
#define PG8_SB(b, h) ((4 + (b) * 2 + (h)) * HTB)
#define PG8_STAGE(bufoff, gbase, voff) do { _Pragma("unroll") for (int _i = 0; _i < 2; ++_i) \
        __builtin_amdgcn_global_load_lds((const unsigned*)((const char*)(gbase) + (voff)[_i]), (LAS unsigned*)(lds + (bufoff) + ldsw + _i * 8192), 16, 0, 0); } while (0)
#define PG8_LDA(dst, b, h) do { _Pragma("unroll") for (int m = 0; m < 4; ++m) _Pragma("unroll") for (int k = 0; k < 2; ++k) dst[m][k] = *(const LAS bf16x8*)(lds + PG8_SA(b, h) + aoff + m * 2048 + k * 1024); } while (0)
#define PG8_LDB(dst, b, h) do { _Pragma("unroll") for (int n = 0; n < 2; ++n) _Pragma("unroll") for (int k = 0; k < 2; ++k) dst[n][k] = *(const LAS bf16x8*)(lds + PG8_SB(b, h) + boff + n * 2048 + k * 1024); } while (0)
#define PG8_MMA(ai, bj, At, Bt) do { __builtin_amdgcn_s_setprio(1); _Pragma("unroll") for (int m = 0; m < 4; ++m) _Pragma("unroll") for (int n = 0; n < 2; ++n) _Pragma("unroll") for (int k = 0; k < 2; ++k) \
        acc[ai][bj][m][n] = __builtin_amdgcn_mfma_f32_16x16x32_bf16(Bt[n][k], At[m][k], acc[ai][bj][m][n], 0, 0, 0); __builtin_amdgcn_s_setprio(0); } while (0)
#define PG8_WAIT_V(n) asm volatile("s_waitcnt vmcnt(" #n ")" ::: "memory")
#define PG8_WAIT_L(n) asm volatile("s_waitcnt lgkmcnt(" #n ")" ::: "memory")
#define PG8_BAR __builtin_amdgcn_s_barrier()
#define PG8_SCHED __builtin_amdgcn_sched_barrier(0)
    Unit cur, nxt; int ui = 0;
    if (!S.next(0, cur)) return;
    f32x4 acc[2][2][4][2];
#pragma unroll
    for (int a = 0; a < 2; ++a)
#pragma unroll
        for (int b = 0; b < 2; ++b)
#pragma unroll
            for (int m = 0; m < 4; ++m)
#pragma unroll
                for (int n = 0; n < 2; ++n) acc[a][b][m][n] = (f32x4){0.f, 0.f, 0.f, 0.f};
    bf16x8 At[4][2], B0[2][2], B1[2][2];
    unsigned oA[2][2]; S.a_off(cur, tid, oA);
    const char* cA = S.a_base(cur); const char* cB = S.b_base(cur);
    PG8_STAGE(PG8_SB(0, 0), cB, voffB); PG8_STAGE(PG8_SB(0, 1), cB + hstep, voffB); PG8_STAGE(PG8_SA(0, 0), cA, oA[0]); PG8_STAGE(PG8_SA(0, 1), cA, oA[1]);
    if (wr == 1) PG8_BAR;
    PG8_WAIT_V(2); PG8_BAR;
    PG8_STAGE(PG8_SB(1, 0), cB + kstep, voffB); PG8_STAGE(PG8_SA(1, 0), cA + kstep, oA[0]); PG8_STAGE(PG8_SB(1, 1), cB + hstep + kstep, voffB);
    PG8_WAIT_V(6); PG8_BAR;
    for (;;) {
        const bool has_next = S.next(ui + 1, nxt);
        const char* nA = has_next ? S.a_base(nxt) : cA; const char* nB = has_next ? S.b_base(nxt) : cB;
        for (int t = 0; t < nt; t += 2) {
            const bool last = (t == nt - 2);
            const char* a1 = cA + (size_t)(t + 1) * kstep;
            const char* a2 = last ? nA : cA + (size_t)(t + 2) * kstep; const char* b2 = last ? nB : cB + (size_t)(t + 2) * kstep;
            const char* a3 = a2 + kstep; const char* b3 = b2 + kstep;
            PG8_LDB(B0, 0, 0); PG8_LDB(B1, 0, 1); PG8_SCHED; PG8_LDA(At, 0, 0); PG8_STAGE(PG8_SA(1, 1), a1, oA[1]);
            if (last && has_next) S.a_off(nxt, tid, oA);
            PG8_WAIT_V(8); PG8_WAIT_L(0); PG8_BAR; PG8_MMA(0, 0, At, B0); PG8_MMA(0, 1, At, B1); PG8_BAR; PG8_SCHED;
            PG8_LDA(At, 0, 1); PG8_STAGE(PG8_SB(0, 0), b2, voffB); PG8_STAGE(PG8_SB(0, 1), b2 + hstep, voffB); PG8_STAGE(PG8_SA(0, 0), a2, oA[0]);
            PG8_WAIT_V(8); PG8_WAIT_L(0); PG8_BAR; PG8_MMA(1, 0, At, B0); PG8_MMA(1, 1, At, B1); PG8_BAR; PG8_SCHED;
            PG8_LDB(B0, 1, 0); PG8_LDB(B1, 1, 1); PG8_SCHED; PG8_LDA(At, 1, 0); PG8_STAGE(PG8_SA(0, 1), a2, oA[1]);
            PG8_WAIT_V(8); PG8_WAIT_L(0); PG8_BAR; PG8_MMA(0, 0, At, B0); PG8_MMA(0, 1, At, B1); PG8_BAR; PG8_SCHED;
            PG8_LDA(At, 1, 1); PG8_STAGE(PG8_SB(1, 0), b3, voffB); PG8_STAGE(PG8_SB(1, 1), b3 + hstep, voffB); PG8_STAGE(PG8_SA(1, 0), a3, oA[0]);
            PG8_WAIT_V(8); PG8_WAIT_L(0); PG8_BAR; PG8_MMA(1, 0, At, B0); PG8_MMA(1, 1, At, B1); PG8_BAR; PG8_SCHED;
        }
        if (wr == 0) PG8_BAR;
        E(acc, cur, wr, wc, fr, fq);
        if (!has_next) break;
#pragma unroll
        for (int a = 0; a < 2; ++a)
#pragma unroll
            for (int b = 0; b < 2; ++b)
#pragma unroll
                for (int m = 0; m < 4; ++m)
#pragma unroll
                    for (int n = 0; n < 2; ++n) acc[a][b][m][n] = (f32x4){0.f, 0.f, 0.f, 0.f};
        cur = nxt; cA = nA; cB = nB; ++ui;
        if (wr == 1) PG8_BAR;
    }
    PG8_WAIT_V(0);
    PG8_BAR;
#undef PG8_SA
#undef PG8_SB
#undef PG8_STAGE
#undef PG8_LDA
#undef PG8_LDB
#undef PG8_MMA
#undef PG8_WAIT_V
#undef PG8_WAIT_L
#undef PG8_BAR
#undef PG8_SCHED
}
}
using pg8::Unit;

DI u32x4 pack8(const f32x4& v0, const f32x4& v1) { u32x4 w; w.x = cvt_pk_bf16(v0[0], v0[1]); w.y = cvt_pk_bf16(v0[2], v0[3]); w.z = cvt_pk_bf16(v1[0], v1[1]); w.w = cvt_pk_bf16(v1[2], v1[3]); return w; }

struct EpiIn {
    static constexpr bool PERM = true;
    bf16_t *qg, *kg, *vg, *sr, *qd, *kd, *vd, *gt; float* ha; const int* pos;
    DI void operator()(const f32x4 (&acc)[2][2][4][2], const Unit& u, int wr, int wc, int fr, int fq) const {
        const int row0 = u.pm * 256 + wr * 64 + fr; const int pn = u.pn;
        if (pn >= 12 && pn < 24) {
            bf16_t* base = pn < 18 ? qd : kd; const int tq = pn < 18 ? pn - 12 : pn - 18; const float sc = pn < 18 ? 0.125f * LOG2E : 1.0f;
            float fre[8];
#pragma unroll
            for (int i = 0; i < 8; ++i) fre[i] = __builtin_amdgcn_exp2f(-(float)(8 * fq + i) * (13.287712379549449f / 32.0f)) * 0.15915494309189535f;
#pragma unroll
            for (int ai = 0; ai < 2; ++ai)
#pragma unroll
                for (int m = 0; m < 4; ++m) {
                    const int r = row0 + ai * 128 + m * 16; const float p = (float)pos[r];
                    bf16_t* rowp = base + (size_t)r * 1536 + (4 * tq + wc) * 64 + 8 * fq;
#pragma unroll
                    for (int n = 0; n < 2; ++n) { f32x4 o1, o2;
#pragma unroll
                        for (int j = 0; j < 4; ++j) {
                            float a = p * fre[n * 4 + j]; a = a - __builtin_floorf(a);
                            const float sn = __builtin_amdgcn_sinf(a), cs = __builtin_amdgcn_cosf(a);
                            const float x1 = acc[ai][0][m][n][j], x2 = acc[ai][1][m][n][j];
                            o1[j] = (x1 * cs - x2 * sn) * sc; o2[j] = (x2 * cs + x1 * sn) * sc;
                        }
                        u32x2 w1, w2; w1.x = cvt_pk_bf16(o1[0], o1[1]); w1.y = cvt_pk_bf16(o1[2], o1[3]); w2.x = cvt_pk_bf16(o2[0], o2[1]); w2.y = cvt_pk_bf16(o2[2], o2[3]);
                        *(u32x2*)(rowp + 4 * n) = w1; *(u32x2*)(rowp + 32 + 4 * n) = w2; }
                    asm volatile("" ::: "memory");
                }
        } else if (pn == 38) {
            if (wc == 0 && fq < 2) {
#pragma unroll
                for (int ai = 0; ai < 2; ++ai)
#pragma unroll
                    for (int m = 0; m < 4; ++m) { float* p = ha + (size_t)(row0 + ai * 128 + m * 16) * 16 + 8 * fq; *(f32x4*)p = acc[ai][0][m][0]; *(f32x4*)(p + 4) = acc[ai][0][m][1]; }
            }
        } else {
            bf16_t* base; int ldc, colt, act = 0; float sc = 1.0f;
            if (pn < 2) { base = qg; ldc = 512; colt = pn * 256; sc = 0.08838834764831845f; }
            else if (pn < 4) { base = kg; ldc = 512; colt = (pn - 2) * 256; }
            else if (pn < 8) { base = vg; ldc = 1024; colt = (pn - 4) * 256; }
            else if (pn < 12) { base = sr; ldc = 1024; colt = (pn - 8) * 256; act = 1; }
            else if (pn < 30) { base = vd; ldc = 1536; colt = (pn - 24) * 256; }
            else { base = gt; ldc = 2048; colt = (pn - 30) * 256; act = 2; }
#pragma unroll
            for (int ai = 0; ai < 2; ++ai)
#pragma unroll
                for (int m = 0; m < 4; ++m) { bf16_t* rowp = base + (size_t)(row0 + ai * 128 + m * 16) * ldc + colt + wc * 32 + 8 * fq;
#pragma unroll
                    for (int bj = 0; bj < 2; ++bj) { f32x4 v0 = acc[ai][bj][m][0] * sc, v1 = acc[ai][bj][m][1] * sc;
                        if (act) {
#pragma unroll
                            for (int j = 0; j < 4; ++j) { const float s0 = sigmoidf_(v0[j]), s1 = sigmoidf_(v1[j]); v0[j] = act == 1 ? v0[j] * s0 : s0; v1[j] = act == 1 ? v1[j] * s1 : s1; } }
                        *(u32x4*)(rowp + bj * 128) = pack8(v0, v1); } }
        }
    }
};
template <bool ADD> struct EpiGate {
    static constexpr bool PERM = true;
    bf16_t* mix; const bf16_t* gt;
    DI void operator()(const f32x4 (&acc)[2][2][4][2], const Unit& u, int wr, int wc, int fr, int fq) const {
        const int row0 = u.pm * 256 + wr * 64 + fr, col0 = u.pn * 256 + wc * 32 + 8 * fq;
#pragma unroll
        for (int ai = 0; ai < 2; ++ai)
#pragma unroll
            for (int m = 0; m < 4; ++m) { const size_t r = (size_t)(row0 + ai * 128 + m * 16);
#pragma unroll
                for (int bj = 0; bj < 2; ++bj) {
                    const u32x4 g = *(const u32x4*)(gt + r * 2048 + col0 + bj * 128);
                    f32x4 v0 = acc[ai][bj][m][0], v1 = acc[ai][bj][m][1];
                    v0[0] *= bf_lo(g.x); v0[1] *= bf_hi(g.x); v0[2] *= bf_lo(g.y); v0[3] *= bf_hi(g.y); v1[0] *= bf_lo(g.z); v1[1] *= bf_hi(g.z); v1[2] *= bf_lo(g.w); v1[3] *= bf_hi(g.w);
                    bf16_t* mp = mix + r * 1024 + col0 + bj * 128;
                    if (ADD) { const u32x4 o = *(const u32x4*)mp; v0[0] += bf_lo(o.x); v0[1] += bf_hi(o.x); v0[2] += bf_lo(o.y); v0[3] += bf_hi(o.y); v1[0] += bf_lo(o.z); v1[1] += bf_hi(o.z); v1[2] += bf_lo(o.w); v1[3] += bf_hi(o.w); }
                    *(u32x4*)mp = pack8(v0, v1); } }
    }
};
struct EpiRes {
    static constexpr bool PERM = false;
    const float* xres; float* z;
    DI void operator()(const f32x4 (&acc)[2][2][4][2], const Unit& u, int wr, int wc, int fr, int fq) const {
        const int row0 = u.pm * 256 + wr * 64 + fr, col0 = u.pn * 256 + wc * 32 + 4 * fq;
#pragma unroll
        for (int ai = 0; ai < 2; ++ai)
#pragma unroll
            for (int m = 0; m < 4; ++m) { const size_t off = (size_t)(row0 + ai * 128 + m * 16) * 1024 + col0;
#pragma unroll
                for (int bj = 0; bj < 2; ++bj)
#pragma unroll
                    for (int n = 0; n < 2; ++n) { const f32x4 xr = *(const f32x4*)(xres + off + bj * 128 + n * 16); *(f32x4*)(z + off + bj * 128 + n * 16) = xr * DN_ALPHA + acc[ai][bj][m][n]; }
                asm volatile("" ::: "memory"); }
    }
};
struct EpiM1 {
    static constexpr bool PERM = true;
    bf16_t* hm;
    DI void operator()(const f32x4 (&acc)[2][2][4][2], const Unit& u, int wr, int wc, int fr, int fq) const {
        const int row0 = u.pm * 256 + wr * 64 + fr, col0 = u.pn * 128 + wc * 32 + 8 * fq;
#pragma unroll
        for (int ai = 0; ai < 2; ++ai)
#pragma unroll
            for (int m = 0; m < 4; ++m) { f32x4 v0, v1;
#pragma unroll
                for (int j = 0; j < 4; ++j) { const float g0 = acc[ai][0][m][0][j], g1 = acc[ai][0][m][1][j]; v0[j] = g0 * sigmoidf_(g0) * acc[ai][1][m][0][j]; v1[j] = g1 * sigmoidf_(g1) * acc[ai][1][m][1][j]; }
                *(u32x4*)(hm + (size_t)(row0 + ai * 128 + m * 16) * 1024 + col0) = pack8(v0, v1); }
    }
};
struct EpiM2 {
    static constexpr bool PERM = true;
    bf16_t* ys; const int* list; const volatile LAS int* pre;
    DI void operator()(const f32x4 (&acc)[2][2][4][2], const Unit& u, int wr, int wc, int fr, int fq) const {
        const int lrow0 = wr * 64 + fr, col0 = u.pn * 256 + wc * 32 + 8 * fq; const int lt = u.pm - rfl(pre[u.e]);
        const int* lp = list + (size_t)u.e * T + 256 * lt;
#pragma unroll
        for (int ai = 0; ai < 2; ++ai)
#pragma unroll
            for (int m = 0; m < 4; ++m) { const int r = lrow0 + ai * 128 + m * 16;
                if (r < u.nv) { const int slot = lp[r]; bf16_t* yp = ys + (size_t)slot * 1024 + col0;
#pragma unroll
                    for (int bj = 0; bj < 2; ++bj) *(u32x4*)(yp + bj * 128) = pack8(acc[ai][bj][m][0], acc[ai][bj][m][1]); } }
    }
};

DI void tr_item(const float* W, int N, bf16_t* WT, int K, int drow, int c0, int nvalid, int kb, LAS float* scr, int lane) {
    const int k0 = 64 * kb;
    { const int cc = lane & 31, ccl = cc < nvalid ? cc : 0; const float* wp = W + (size_t)(k0 + (lane >> 5)) * N + c0 + ccl; float v[32];
#pragma unroll
      for (int i = 0; i < 32; ++i) v[i] = wp[(size_t)(2 * i) * N];
#pragma unroll
      for (int i = 0; i < 32; ++i) scr[(2 * i + (lane >> 5)) * 33 + cc] = (cc < nvalid) ? v[i] : 0.f; }
    LDS_WAIT(); asm volatile("" ::: "memory");
    const int c = lane & 7;
#pragma unroll
    for (int j = 0; j < 4; ++j) { const int n = (lane >> 3) + 8 * j; const LAS float* s = scr + (8 * c) * 33 + n;
        u32x4 o; o.x = cvt_pk_bf16(s[0 * 33], s[1 * 33]); o.y = cvt_pk_bf16(s[2 * 33], s[3 * 33]); o.z = cvt_pk_bf16(s[4 * 33], s[5 * 33]); o.w = cvt_pk_bf16(s[6 * 33], s[7 * 33]);
        *(u32x4*)(WT + (size_t)(drow + n) * K + k0 + 8 * c) = o; }
    LDS_WAIT(); asm volatile("" ::: "memory");
}
DI void phase_w(LAS unsigned char* lds, const Ctx& c, int l, int G) {
    const int tid = ltid(), lane = tid & 63, wave = rfl(tid >> 6);
    LAS float* scr = (LAS float*)(lds + wave * 16384);
    const int gw = lbid() * NWAVES + wave, NGW = G * NWAVES;
    constexpr int I_IN = (NIN / 32) * 16, I_GO = 512, I_AO = 256, I_OUT = 512, I_EXP = 16 * 512;
    constexpr int NITEMS = I_IN + I_GO + I_AO + I_OUT + 3 * I_EXP;
    for (int it = gw; it < NITEMS; it += NGW) {
        int r = it;
        if (r < I_IN) {
            const int nbg = r >> 4, kb = r & 15, n0 = 32 * nbg, tile = n0 >> 8, p = n0 & 255; int c0, nv = 32;
            if (tile < 12) c0 = n0;
            else if (tile < 24) { const int base = tile < 18 ? 3088 : 4624, tq = tile < 18 ? tile - 12 : tile - 18; c0 = base + (4 * tq + ((p & 127) >> 5)) * 64 + (p >= 128 ? 32 : 0); }
            else if (tile < 30) c0 = 6160 + (n0 - 24 * 256);
            else if (tile < 38) c0 = 7696 + (n0 - 30 * 256);
            else { c0 = 3072; nv = (p == 0) ? 16 : 0; }
            tr_item(c.w_in + (size_t)l * D * DIN, DIN, wsb(c, WS_WIN), D, n0, c0, nv, kb, scr, lane); continue; }
        r -= I_IN;
        if (r < I_GO) { tr_item(c.w_gla_o + (size_t)l * D * D, D, wsb(c, WS_WGO), D, 32 * (r >> 4), 32 * (r >> 4), 32, r & 15, scr, lane); continue; }
        r -= I_GO;
        if (r < I_AO) { tr_item(c.w_att_o + (size_t)l * 512 * D, D, wsb(c, WS_WAO), 512, 32 * (r >> 3), 32 * (r >> 3), 32, r & 7, scr, lane); continue; }
        r -= I_AO;
        if (r < I_OUT) { tr_item(c.w_out + (size_t)l * D * D, D, wsb(c, WS_WOUT), D, 32 * (r >> 4), 32 * (r >> 4), 32, r & 15, scr, lane); continue; }
        r -= I_OUT;
        const int which = r / I_EXP; r -= which * I_EXP; const int e = r >> 9, q = r & 511, nbg = q >> 4, kb = q & 15;
        const size_t eoff = (size_t)(l * NEXP + e) * D * DFF;
        if (which == 0) tr_item(c.w_e_gate + eoff, DFF, wsb(c, WS_WGU) + (size_t)e * 2048 * 1024, D, 256 * (nbg >> 2) + 32 * (nbg & 3), 32 * nbg, 32, kb, scr, lane);
        else if (which == 1) tr_item(c.w_e_up + eoff, DFF, wsb(c, WS_WGU) + (size_t)e * 2048 * 1024, D, 256 * (nbg >> 2) + 128 + 32 * (nbg & 3), 32 * nbg, 32, kb, scr, lane);
        else tr_item(c.w_e_down + eoff, D, wsb(c, WS_WD) + (size_t)e * 1024 * 1024, DFF, 32 * nbg, 32 * nbg, 32, kb, scr, lane);
    }
    if (l == 0) {
        const size_t n8 = (size_t)T * D / 8; bf16_t* xb = wsb(c, WS_XB);
        for (size_t i = (size_t)lbid() * NTHREADS + tid; i < n8; i += (size_t)G * NTHREADS) { const f32x4 a = *(const f32x4*)(c.x + i * 8), b = *(const f32x4*)(c.x + i * 8 + 4); *(u32x4*)(xb + i * 8) = pack8(a, b); }
    }
}

DI s16x4 tr16(const LAS void* p) { return __builtin_bit_cast(s16x4, __builtin_amdgcn_ds_read_tr16_b64_v4i16((LAS s16x4*)p)); }
DI bf16x8 cat8(s16x4 lo, s16x4 hi) { return __builtin_shufflevector(lo, hi, 0, 1, 2, 3, 4, 5, 6, 7); }
#define MFMA16(a, b, c) __builtin_amdgcn_mfma_f32_16x16x32_bf16((a), (b), (c), 0, 0, 0)

constexpr int GL_QT = 0, GL_KT = 17408, GL_KS = 34816, GL_VS = 52224, GL_ATT = 86016, GL_OST = 95232, GL_DEC = 129024, GL_WUP = 129792, GL_BAL = 137984, GL_SS = 138496;
DI void gla_chain(LAS unsigned char* lds, const Ctx& c, int l, int bl, int h) {
    const int tid = ltid(), lane = tid & 63, w = rfl(tid >> 6), fr = lane & 15, fq = lane >> 4;
    const bf16_t* QG = wsb(c, WS_H + H_QG) + (size_t)bl * SEQ * 512 + h * 128;
    const bf16_t* KG = wsb(c, WS_H + H_KG) + (size_t)bl * SEQ * 512 + h * 128;
    const bf16_t* VG = wsb(c, WS_H + H_VG) + (size_t)bl * SEQ * 1024 + h * 256;
    const bf16_t* SR = wsb(c, WS_H + H_SR) + (size_t)bl * SEQ * 1024 + h * 256;
    const float* HA = (const float*)(c.ws + WS_HA) + (size_t)bl * SEQ * 16;
    bf16_t* OG = wsb(c, WS_OG) + (size_t)bl * SEQ * 1024 + h * 256;
    LAS bf16_t* QT = (LAS bf16_t*)(lds + GL_QT); LAS bf16_t* KT = (LAS bf16_t*)(lds + GL_KT); LAS bf16_t* KS = (LAS bf16_t*)(lds + GL_KS);
    LAS bf16_t* VS = (LAS bf16_t*)(lds + GL_VS); LAS bf16_t* AT = (LAS bf16_t*)(lds + GL_ATT); LAS bf16_t* OST = (LAS bf16_t*)(lds + GL_OST);
    LAS float* DEC = (LAS float*)(lds + GL_DEC); LAS float* SS = (LAS float*)(lds + GL_SS); LAS float* WUP = (LAS float*)(lds + GL_WUP); LAS float* BAL = (LAS float*)(lds + GL_BAL);
    __syncthreads();
    for (int i = tid; i < 16 * 128; i += NTHREADS) WUP[i] = c.w_alpha_up[(size_t)l * 16 * 512 + (i >> 7) * 512 + h * 128 + (i & 127)];
    if (tid < 128) BAL[tid] = c.b_alpha[l * 512 + h * 128 + tid];
    const int dv0 = 32 * w;
    const float gn0 = c.gla_norm[l * 1024 + h * 256 + dv0 + fr], gn1 = c.gla_norm[l * 1024 + h * 256 + dv0 + 16 + fr];
    f32x4 S[8][2];
#pragma unroll
    for (int a = 0; a < 8; ++a) { S[a][0] = (f32x4){0.f, 0.f, 0.f, 0.f}; S[a][1] = (f32x4){0.f, 0.f, 0.f, 0.f}; }
    __syncthreads();
    for (int n = 0; n < 64; ++n) {
        const int tok0 = n * 64;
        {
            const int row = lane; const size_t tk = (size_t)(tok0 + row);
            f32x4 a4[4];
#pragma unroll
            for (int j = 0; j < 4; ++j) a4[j] = *(const f32x4*)(HA + tk * 16 + 4 * j);
            const u32x4 q0 = *(const u32x4*)(QG + tk * 512 + 16 * w), q1 = *(const u32x4*)(QG + tk * 512 + 16 * w + 8);
            const u32x4 k0 = *(const u32x4*)(KG + tk * 512 + 16 * w), k1 = *(const u32x4*)(KG + tk * 512 + 16 * w + 8);
#pragma unroll
            for (int c2 = 0; c2 < 4; ++c2) { const int idx = tid + NTHREADS * c2, r = idx >> 5, ch = idx & 31; *(LAS u32x4*)(VS + r * 264 + ch * 8) = *(const u32x4*)(VG + (size_t)(tok0 + r) * 1024 + ch * 8); }
            float la[16];
#pragma unroll
            for (int cc = 0; cc < 16; ++cc) la[cc] = BAL[16 * w + cc];
#pragma unroll
            for (int j = 0; j < 16; ++j) { const float aj = a4[j >> 2][j & 3];
#pragma unroll
                for (int c4 = 0; c4 < 4; ++c4) { const f32x4 wv = *(const LAS f32x4*)(WUP + j * 128 + 16 * w + 4 * c4); la[4 * c4] += aj * wv[0]; la[4 * c4 + 1] += aj * wv[1]; la[4 * c4 + 2] += aj * wv[2]; la[4 * c4 + 3] += aj * wv[3]; } }
#pragma unroll
            for (int cc = 0; cc < 16; ++cc) { const float z = la[cc]; la[cc] = -(fmaxf(-z, 0.f) + __logf(1.0f + __expf(-fabsf(z)))) * (1.0f / 16.0f); }
#pragma unroll
            for (int dlt = 1; dlt < 64; dlt <<= 1)
#pragma unroll
                for (int cc = 0; cc < 16; ++cc) { const float t = __shfl_up(la[cc], dlt); if (lane >= dlt) la[cc] += t; }
            float qv[16], kv[16];
            qv[0] = bf_lo(q0.x); qv[1] = bf_hi(q0.x); qv[2] = bf_lo(q0.y); qv[3] = bf_hi(q0.y); qv[4] = bf_lo(q0.z); qv[5] = bf_hi(q0.z); qv[6] = bf_lo(q0.w); qv[7] = bf_hi(q0.w);
            qv[8] = bf_lo(q1.x); qv[9] = bf_hi(q1.x); qv[10] = bf_lo(q1.y); qv[11] = bf_hi(q1.y); qv[12] = bf_lo(q1.z); qv[13] = bf_hi(q1.z); qv[14] = bf_lo(q1.w); qv[15] = bf_hi(q1.w);
            kv[0] = bf_lo(k0.x); kv[1] = bf_hi(k0.x); kv[2] = bf_lo(k0.y); kv[3] = bf_hi(k0.y); kv[4] = bf_lo(k0.z); kv[5] = bf_hi(k0.z); kv[6] = bf_lo(k0.w); kv[7] = bf_hi(k0.w);
            kv[8] = bf_lo(k1.x); kv[9] = bf_hi(k1.x); kv[10] = bf_lo(k1.y); kv[11] = bf_hi(k1.y); kv[12] = bf_lo(k1.z); kv[13] = bf_hi(k1.z); kv[14] = bf_lo(k1.w); kv[15] = bf_hi(k1.w);
            float qt[16], kt[16], ks[16];
#pragma unroll
            for (int cc = 0; cc < 16; ++cc) { const float b = la[cc]; const float bend = __shfl(b, 63); const float eb = __expf(b); qt[cc] = qv[cc] * eb; kt[cc] = kv[cc] * __expf(-b); ks[cc] = kv[cc] * __expf(bend - b);
                if (lane == 63) DEC[16 * w + cc] = eb; }
            u32x4 p0, p1;
            p0.x = cvt_pk_bf16(qt[0], qt[1]); p0.y = cvt_pk_bf16(qt[2], qt[3]); p0.z = cvt_pk_bf16(qt[4], qt[5]); p0.w = cvt_pk_bf16(qt[6], qt[7]);
            p1.x = cvt_pk_bf16(qt[8], qt[9]); p1.y = cvt_pk_bf16(qt[10], qt[11]); p1.z = cvt_pk_bf16(qt[12], qt[13]); p1.w = cvt_pk_bf16(qt[14], qt[15]);
            *(LAS u32x4*)(QT + row * 136 + 16 * w) = p0; *(LAS u32x4*)(QT + row * 136 + 16 * w + 8) = p1;
            p0.x = cvt_pk_bf16(kt[0], kt[1]); p0.y = cvt_pk_bf16(kt[2], kt[3]); p0.z = cvt_pk_bf16(kt[4], kt[5]); p0.w = cvt_pk_bf16(kt[6], kt[7]);
            p1.x = cvt_pk_bf16(kt[8], kt[9]); p1.y = cvt_pk_bf16(kt[10], kt[11]); p1.z = cvt_pk_bf16(kt[12], kt[13]); p1.w = cvt_pk_bf16(kt[14], kt[15]);
            *(LAS u32x4*)(KT + row * 136 + 16 * w) = p0; *(LAS u32x4*)(KT + row * 136 + 16 * w + 8) = p1;
            p0.x = cvt_pk_bf16(ks[0], ks[1]); p0.y = cvt_pk_bf16(ks[2], ks[3]); p0.z = cvt_pk_bf16(ks[4], ks[5]); p0.w = cvt_pk_bf16(ks[6], ks[7]);
            p1.x = cvt_pk_bf16(ks[8], ks[9]); p1.y = cvt_pk_bf16(ks[10], ks[11]); p1.z = cvt_pk_bf16(ks[12], ks[13]); p1.w = cvt_pk_bf16(ks[14], ks[15]);
            *(LAS u32x4*)(KS + row * 136 + 16 * w) = p0; *(LAS u32x4*)(KS + row * 136 + 16 * w + 8) = p1;
        }
        __syncthreads();
#pragma unroll
        for (int rep = 0; rep < 2; ++rep) {
            const int tt = w + 8 * rep, jt = tt >> 2, it = tt & 3;
            f32x4 a = (f32x4){0.f, 0.f, 0.f, 0.f};
            if (jt <= it) {
#pragma unroll
                for (int k4 = 0; k4 < 4; ++k4) { const bf16x8 af = *(const LAS bf16x8*)(KT + (16 * jt + fr) * 136 + 32 * k4 + 8 * fq), bfr = *(const LAS bf16x8*)(QT + (16 * it + fr) * 136 + 32 * k4 + 8 * fq); a = MFMA16(af, bfr, a); }
            }
            const int i = 16 * it + fr, j0 = 16 * jt + 4 * fq;
            u32x2 o; o.x = cvt_pk_bf16(j0 <= i ? a[0] : 0.f, j0 + 1 <= i ? a[1] : 0.f); o.y = cvt_pk_bf16(j0 + 2 <= i ? a[2] : 0.f, j0 + 3 <= i ? a[3] : 0.f);
            *(LAS u32x2*)(AT + i * 72 + j0) = o;
        }
        __syncthreads();
        f32x4 o[4][2];
        {
            bf16x8 vb[2][2];
#pragma unroll
            for (int k2 = 0; k2 < 2; ++k2)
#pragma unroll
                for (int dt = 0; dt < 2; ++dt) { const LAS bf16_t* p = VS + (32 * k2 + 8 * fq + (fr >> 2)) * 264 + dv0 + 16 * dt + (fr & 3) * 4; vb[k2][dt] = cat8(tr16(p), tr16(p + 4 * 264)); }
#pragma unroll
            for (int tt = 0; tt < 4; ++tt) {
                const bf16x8 a0 = *(const LAS bf16x8*)(AT + (16 * tt + fr) * 72 + 8 * fq), a1 = *(const LAS bf16x8*)(AT + (16 * tt + fr) * 72 + 32 + 8 * fq);
#pragma unroll
                for (int dt = 0; dt < 2; ++dt) { f32x4 z = (f32x4){0.f, 0.f, 0.f, 0.f}; z = MFMA16(a0, vb[0][dt], z); o[tt][dt] = MFMA16(a1, vb[1][dt], z); }
            }
#pragma unroll
            for (int s = 0; s < 4; ++s) {
                bf16x8 sb[2];
#pragma unroll
                for (int dt = 0; dt < 2; ++dt) { u32x4 pk; pk.x = cvt_pk_bf16(S[2 * s][dt][0], S[2 * s][dt][1]); pk.y = cvt_pk_bf16(S[2 * s][dt][2], S[2 * s][dt][3]); pk.z = cvt_pk_bf16(S[2 * s + 1][dt][0], S[2 * s + 1][dt][1]); pk.w = cvt_pk_bf16(S[2 * s + 1][dt][2], S[2 * s + 1][dt][3]); sb[dt] = __builtin_bit_cast(bf16x8, pk); }
#pragma unroll
                for (int tt = 0; tt < 4; ++tt) {
                    const LAS bf16_t* qp = QT + (16 * tt + fr) * 136 + 32 * s + 4 * fq;
                    const bf16x8 af = cat8(*(const LAS s16x4*)qp, *(const LAS s16x4*)(qp + 16));
                    o[tt][0] = MFMA16(af, sb[0], o[tt][0]); o[tt][1] = MFMA16(af, sb[1], o[tt][1]);
                }
            }
#pragma unroll
            for (int k8 = 0; k8 < 8; ++k8) {
                const f32x4 dc = *(const LAS f32x4*)(DEC + 16 * k8 + 4 * fq);
                S[k8][0] *= dc; S[k8][1] *= dc;
#pragma unroll
                for (int k2 = 0; k2 < 2; ++k2) { const LAS bf16_t* p = KS + (32 * k2 + 8 * fq + (fr >> 2)) * 136 + 16 * k8 + (fr & 3) * 4; const bf16x8 af = cat8(tr16(p), tr16(p + 4 * 136));
                    S[k8][0] = MFMA16(af, vb[k2][0], S[k8][0]); S[k8][1] = MFMA16(af, vb[k2][1], S[k8][1]); }
            }
        }
#pragma unroll
        for (int tt = 0; tt < 4; ++tt) { f32x4 pp;
#pragma unroll
            for (int rg = 0; rg < 4; ++rg) { float p = o[tt][0][rg] * o[tt][0][rg] + o[tt][1][rg] * o[tt][1][rg];
                p += __shfl_xor(p, 1); p += __shfl_xor(p, 2); p += __shfl_xor(p, 4); p += __shfl_xor(p, 8); pp[rg] = p; }
            if (fr == 0) *(LAS f32x4*)(SS + w * 64 + 16 * tt + 4 * fq) = pp; }
        __syncthreads();
#pragma unroll
        for (int tt = 0; tt < 4; ++tt) { f32x4 ss = *(const LAS f32x4*)(SS + 16 * tt + 4 * fq);
#pragma unroll
            for (int ww = 1; ww < 8; ++ww) ss += *(const LAS f32x4*)(SS + ww * 64 + 16 * tt + 4 * fq);
#pragma unroll
            for (int rg = 0; rg < 4; ++rg) { const float rs = __builtin_amdgcn_rsqf(ss[rg] * (1.0f / 256.0f) + RMS_EPS); const int i = 16 * tt + 4 * fq + rg;
                OST[i * 264 + dv0 + fr] = (bf16_t)(cvt_pk_bf16(o[tt][0][rg] * rs * gn0, 0.f) & 0xffffu); OST[i * 264 + dv0 + 16 + fr] = (bf16_t)(cvt_pk_bf16(o[tt][1][rg] * rs * gn1, 0.f) & 0xffffu); } }
        __syncthreads();
#pragma unroll
        for (int c2 = 0; c2 < 4; ++c2) { const int idx = tid + NTHREADS * c2, r = idx >> 5, ch = idx & 31;
            const u32x4 ov = *(const LAS u32x4*)(OST + r * 264 + ch * 8); const u32x4 sv = *(const u32x4*)(SR + (size_t)(tok0 + r) * 1024 + ch * 8);
            u32x4 rr; rr.x = cvt_pk_bf16(bf_lo(ov.x) * bf_lo(sv.x), bf_hi(ov.x) * bf_hi(sv.x)); rr.y = cvt_pk_bf16(bf_lo(ov.y) * bf_lo(sv.y), bf_hi(ov.y) * bf_hi(sv.y));
            rr.z = cvt_pk_bf16(bf_lo(ov.z) * bf_lo(sv.z), bf_hi(ov.z) * bf_hi(sv.z)); rr.w = cvt_pk_bf16(bf_lo(ov.w) * bf_lo(sv.w), bf_hi(ov.w) * bf_hi(sv.w));
            *(u32x4*)(OG + (size_t)(tok0 + r) * 1024 + ch * 8) = rr; }
    }
    __syncthreads();
}

constexpr int AT_K = 0, AT_V = 36864;
DI void attn_unit(LAS unsigned char* lds, const Ctx& c, int bl, int g, int h, int x) {
    const int tid = ltid(), lane = tid & 63, w = rfl(tid >> 6), fr = lane & 15, fq = lane >> 4;
    const int dl = (g == 0) ? 1 : (g == 1 ? 4 : 16), nb = 32 / dl, r = x / nb, n = x - r * nb;
    const size_t tb = (size_t)bl * SEQ + r; const int colo = g * 512 + h * 64;
    const bf16_t* Q = wsb(c, WS_H + H_QD) + colo; const bf16_t* K = wsb(c, WS_H + H_KD) + colo; const bf16_t* V = wsb(c, WS_H + H_VD) + colo;
    LAS bf16_t* Ks = (LAS bf16_t*)(lds + AT_K); LAS bf16_t* Vs = (LAS bf16_t*)(lds + AT_V);
    const size_t tokq = tb + (size_t)dl * (128 * n + 16 * w + fr);
    bf16x8 qf[2];
#pragma unroll
    for (int d0 = 0; d0 < 2; ++d0) qf[d0] = *(const bf16x8*)(Q + tokq * 1536 + 32 * d0 + 8 * fq);
    __syncthreads();
#pragma unroll
    for (int c2 = 0; c2 < 4; ++c2) { const int idx = tid + NTHREADS * c2, row = idx >> 3, ch = idx & 7; const int j = 128 * (n - 1) + row;
        u32x4 kv = (u32x4){0u, 0u, 0u, 0u}, vv = (u32x4){0u, 0u, 0u, 0u};
        if (j >= 0) { const size_t tok = tb + (size_t)dl * j; kv = *(const u32x4*)(K + tok * 1536 + ch * 8); vv = *(const u32x4*)(V + tok * 1536 + ch * 8); }
        *(LAS u32x4*)(Ks + row * 72 + ch * 8) = kv; *(LAS u32x4*)(Vs + row * 72 + ch * 8) = vv; }
    __syncthreads();
    f32x4 s[9]; float m = -1e30f;
#pragma unroll
    for (int kr = 0; kr < 9; ++kr) { const int kt = w + kr; f32x4 a = (f32x4){0.f, 0.f, 0.f, 0.f};
#pragma unroll
        for (int d0 = 0; d0 < 2; ++d0) { const bf16x8 af = *(const LAS bf16x8*)(Ks + (16 * kt + fr) * 72 + 32 * d0 + 8 * fq); a = MFMA16(af, qf[d0], a); }
#pragma unroll
        for (int rg = 0; rg < 4; ++rg) { const int rel = 16 * kr + 4 * fq + rg - fr; const bool ok = rel >= 0 && rel <= 128 && (n > 0 || 16 * kt + 4 * fq + rg >= 128); a[rg] = ok ? a[rg] : -1e30f; m = fmaxf(m, a[rg]); }
        s[kr] = a; }
    m = fmaxf(m, __shfl_xor(m, 16)); m = fmaxf(m, __shfl_xor(m, 32));
    float lsum = 0.f;
#pragma unroll
    for (int kr = 0; kr < 9; ++kr)
#pragma unroll
        for (int rg = 0; rg < 4; ++rg) { const float p = s[kr][rg] > -1e29f ? __builtin_amdgcn_exp2f(s[kr][rg] - m) : 0.f; s[kr][rg] = p; lsum += p; }
    lsum += __shfl_xor(lsum, 16); lsum += __shfl_xor(lsum, 32);
    f32x4 oT[4];
#pragma unroll
    for (int dt = 0; dt < 4; ++dt) oT[dt] = (f32x4){0.f, 0.f, 0.f, 0.f};
#pragma unroll
    for (int pp = 0; pp < 5; ++pp) { const int ka = 2 * pp, kb = (2 * pp + 1 < 9) ? 2 * pp + 1 : 8;
        u32x4 pk; pk.x = cvt_pk_bf16(s[ka][0], s[ka][1]); pk.y = cvt_pk_bf16(s[ka][2], s[ka][3]);
        if (2 * pp + 1 < 9) { pk.z = cvt_pk_bf16(s[kb][0], s[kb][1]); pk.w = cvt_pk_bf16(s[kb][2], s[kb][3]); } else { pk.z = 0u; pk.w = 0u; }
        const bf16x8 pf = __builtin_bit_cast(bf16x8, pk);
#pragma unroll
        for (int dt = 0; dt < 4; ++dt) { const LAS bf16_t* pa = Vs + (16 * (w + ka) + 4 * fq + (fr >> 2)) * 72 + 16 * dt + (fr & 3) * 4; const LAS bf16_t* pb = Vs + (16 * (w + kb) + 4 * fq + (fr >> 2)) * 72 + 16 * dt + (fr & 3) * 4;
            oT[dt] = MFMA16(cat8(tr16(pa), tr16(pb)), pf, oT[dt]); } }
    const float inv = 1.0f / lsum; const size_t tq = tb + (size_t)dl * (128 * n + 16 * w + fr);
    bf16_t* op = wsb(c, WS_ATTG) + ((size_t)g * TH + tq) * 512 + h * 64 + 4 * fq;
#pragma unroll
    for (int dt = 0; dt < 4; ++dt) { u32x2 o; o.x = cvt_pk_bf16(oT[dt][0] * inv, oT[dt][1] * inv); o.y = cvt_pk_bf16(oT[dt][2] * inv, oT[dt][3] * inv); *(u32x2*)(op + 16 * dt) = o; }
    if (fq == 0) ((float*)(c.ws + WS_LSE))[((size_t)g * TH + tq) * 8 + h] = m + __builtin_amdgcn_logf(lsum);
}
DI void phase_b(LAS unsigned char* lds, const Ctx& c, int l, int G) {
    const int bid = lbid(); constexpr int NGLA = 32, NATT = 8 * 3 * 8 * 32;
    if (G >= 64) {
        if (bid < NGLA) gla_chain(lds, c, l, bid >> 2, bid & 3);
        else { const int k = bid - NGLA, W = G - NGLA; const int u0 = (int)((long)k * NATT / W), u1 = (int)((long)(k + 1) * NATT / W);
            for (int u = u0; u < u1; ++u) attn_unit(lds, c, u / 768, (u / 256) % 3, (u >> 5) & 7, u & 31); }
    } else {
        for (int id = bid; id < NGLA; id += G) gla_chain(lds, c, l, id >> 2, id & 3);
        for (int u = bid; u < NATT; u += G) attn_unit(lds, c, u / 768, (u / 256) % 3, (u >> 5) & 7, u & 31);
    }
}
DI void phase_f(const Ctx& c, int G) {
    const bf16_t* ag = wsb(c, WS_ATTG); const float* lse = (const float*)(c.ws + WS_LSE); bf16_t* att = wsb(c, WS_ATT);
    for (size_t i = (size_t)lbid() * NTHREADS + ltid(); i < (size_t)TH * 64; i += (size_t)G * NTHREADS) {
        const size_t tok = i >> 6; const int ch = (int)(i & 63), h = ch >> 3;
        const float l0 = lse[tok * 8 + h], l1 = lse[((size_t)TH + tok) * 8 + h], l2 = lse[((size_t)2 * TH + tok) * 8 + h];
        const float mx = fmaxf(l0, fmaxf(l1, l2)); float w0 = __builtin_amdgcn_exp2f(l0 - mx), w1 = __builtin_amdgcn_exp2f(l1 - mx), w2 = __builtin_amdgcn_exp2f(l2 - mx);
        const float inv = 1.0f / (w0 + w1 + w2); w0 *= inv; w1 *= inv; w2 *= inv;
        const u32x4 a = *(const u32x4*)(ag + tok * 512 + ch * 8), b = *(const u32x4*)(ag + ((size_t)TH + tok) * 512 + ch * 8), d = *(const u32x4*)(ag + ((size_t)2 * TH + tok) * 512 + ch * 8);
        u32x4 o;
        o.x = cvt_pk_bf16(w0 * bf_lo(a.x) + w1 * bf_lo(b.x) + w2 * bf_lo(d.x), w0 * bf_hi(a.x) + w1 * bf_hi(b.x) + w2 * bf_hi(d.x));
        o.y = cvt_pk_bf16(w0 * bf_lo(a.y) + w1 * bf_lo(b.y) + w2 * bf_lo(d.y), w0 * bf_hi(a.y) + w1 * bf_hi(b.y) + w2 * bf_hi(d.y));
        o.z = cvt_pk_bf16(w0 * bf_lo(a.z) + w1 * bf_lo(b.z) + w2 * bf_lo(d.z), w0 * bf_hi(a.z) + w1 * bf_hi(b.z) + w2 * bf_hi(d.z));
        o.w = cvt_pk_bf16(w0 * bf_lo(a.w) + w1 * bf_lo(b.w) + w2 * bf_lo(d.w), w0 * bf_hi(a.w) + w1 * bf_hi(b.w) + w2 * bf_hi(d.w));
        *(u32x4*)(att + tok * 512 + ch * 8) = o;
    }
}

DI float wave_sum(float v) {
#pragma unroll
    for (int o = 1; o < 64; o <<= 1) v += __shfl_xor(v, o);
    return v;
}
constexpr int R_WR = 0, R_HIST = 65536, R_BASE = 65536 + 64, R_INFO = 65536 + 128;
DI void phase_r(LAS unsigned char* lds, const Ctx& c, int l, int G) {
    const int tid = ltid(), lane = tid & 63, wave = rfl(tid >> 6);
    LAS float* WR = (LAS float*)(lds + R_WR); volatile LAS int* HIST = (volatile LAS int*)(lds + R_HIST); volatile LAS int* BASE = (volatile LAS int*)(lds + R_BASE); volatile LAS int* INFO = (volatile LAS int*)(lds + R_INFO);
    __syncthreads();
    for (int i = tid; i < 16 * 1024; i += NTHREADS) WR[(i & 15) * 1024 + (i >> 4)] = c.w_router[i];
    f32x4 g4[4], b4[4];
#pragma unroll
    for (int j = 0; j < 4; ++j) { g4[j] = *(const f32x4*)(c.ln1_g + l * D + 4 * lane + 256 * j); b4[j] = *(const f32x4*)(c.ln1_b + l * D + 4 * lane + 256 * j); }
    float* xo = c.out; bf16_t* xb = wsb(c, WS_XB); int* histg = (int*)(c.ws + WS_HISTG); float* gate = (float*)(c.ws + WS_GATE);
    for (int chunk = lbid(); chunk < T / 256; chunk += G) {
        __syncthreads();
        for (int rr = 0; rr < 32; ++rr) {
            const int rl = wave * 32 + rr; const size_t row = (size_t)chunk * 256 + rl;
            f32x4 v[4]; float s = 0.f;
#pragma unroll
            for (int j = 0; j < 4; ++j) { v[j] = *(const f32x4*)(xo + row * D + 4 * lane + 256 * j); s += (v[j][0] + v[j][1]) + (v[j][2] + v[j][3]); }
            const float mean = wave_sum(s) * (1.0f / D); float s2 = 0.f;
#pragma unroll
            for (int j = 0; j < 4; ++j) { v[j] = v[j] - mean; s2 += (v[j][0] * v[j][0] + v[j][1] * v[j][1]) + (v[j][2] * v[j][2] + v[j][3] * v[j][3]); }
            const float rstd = __builtin_amdgcn_rsqf(wave_sum(s2) * (1.0f / D) + LN_EPS);
#pragma unroll
            for (int j = 0; j < 4; ++j) { v[j] = v[j] * rstd * g4[j] + b4[j]; *(f32x4*)(xo + row * D + 4 * lane + 256 * j) = v[j];
                u32x2 pk; pk.x = cvt_pk_bf16(v[j][0], v[j][1]); pk.y = cvt_pk_bf16(v[j][2], v[j][3]); *(u32x2*)(xb + row * D + 4 * lane + 256 * j) = pk; }
            float lg[16];
#pragma unroll
            for (int e = 0; e < 16; ++e) { float a = 0.f;
#pragma unroll
                for (int j = 0; j < 4; ++j) { const f32x4 wv = *(const LAS f32x4*)(WR + e * 1024 + 4 * lane + 256 * j); a += v[j][0] * wv[0] + v[j][1] * wv[1] + v[j][2] * wv[2] + v[j][3] * wv[3]; }
                lg[e] = wave_sum(a) + c.b_router[e]; }
            float mx = lg[0];
#pragma unroll
            for (int e = 1; e < 16; ++e) mx = fmaxf(mx, lg[e]);
            float se = 0.f;
#pragma unroll
            for (int e = 0; e < 16; ++e) { lg[e] = __expf(lg[e] - mx); se += lg[e]; }
            const float ise = 1.0f / se;
#pragma unroll
            for (int e = 0; e < 16; ++e) lg[e] *= ise;
            int gsel = 0; float gbest = -1.f;
#pragma unroll
            for (int gi = 0; gi < 4; ++gi) { const float a = lg[4 * gi], b = lg[4 * gi + 1], cc = lg[4 * gi + 2], d = lg[4 * gi + 3];
                const float sc = (a + b + cc + d) - fminf(fminf(a, b), fminf(cc, d)) - fminf(fmaxf(fminf(a, b), fminf(cc, d)), fminf(fmaxf(a, b), fmaxf(cc, d)));
                if (sc > gbest) { gbest = sc; gsel = gi; } }
            float p[4];
#pragma unroll
            for (int k = 0; k < 4; ++k) p[k] = gsel == 0 ? lg[k] : gsel == 1 ? lg[4 + k] : gsel == 2 ? lg[8 + k] : lg[12 + k];
            int i0 = 0; float v0 = p[0];
#pragma unroll
            for (int k = 1; k < 4; ++k) if (p[k] > v0) { v0 = p[k]; i0 = k; }
            int i1 = -1; float v1 = -1.f;
#pragma unroll
            for (int k = 0; k < 4; ++k) if (k != i0 && p[k] > v1) { v1 = p[k]; i1 = k; }
            if (lane == 0) { const int e0 = 4 * gsel + i0, e1 = 4 * gsel + i1; INFO[rl * 4 + 0] = e0; INFO[rl * 4 + 1] = e1;
                const float gs = 1.0f / (v0 + v1); gate[row * 2] = v0 * gs; gate[row * 2 + 1] = v1 * gs; }
        }
        __syncthreads();
        if (tid < 16) { int cnt = 0;
            for (int r = 0; r < 256; ++r) { if (INFO[r * 4] == tid) INFO[r * 4 + 2] = cnt++; else if (INFO[r * 4 + 1] == tid) INFO[r * 4 + 3] = cnt++; }
            histg[chunk * 16 + tid] = cnt; }
        __syncthreads();
        if (tid < 256) { int4 v; v.x = INFO[tid * 4]; v.y = INFO[tid * 4 + 1]; v.z = INFO[tid * 4 + 2]; v.w = INFO[tid * 4 + 3]; ((int4*)(c.ws + WS_INFO))[(size_t)chunk * 256 + tid] = v; }
        __syncthreads();
    }
}
DI void phase_r2(LAS unsigned char* lds, const Ctx& c, int l, int G) {
    const int tid = ltid(); volatile LAS int* BASE = (volatile LAS int*)(lds + R_BASE);
    const int* histg = (const int*)(c.ws + WS_HISTG); int* list = (int*)(c.ws + WS_LIST);
    unsigned* cur = (unsigned*)(c.ws + WS_CTL) + CW_CUR + l * 16 * 64;
    for (int chunk = lbid(); chunk < T / 256; chunk += G) {
        __syncthreads();
        if (tid < 16) BASE[tid] = 0;
        __syncthreads();
        { const int e = tid & 15; int s = 0; for (int cc = tid >> 4; cc < chunk; cc += 32) s += histg[cc * 16 + e]; if (s) atomicAdd((int*)&BASE[e], s); }
        __syncthreads();
        if (tid < 256) { const int4 v = ((const int4*)(c.ws + WS_INFO))[(size_t)chunk * 256 + tid]; const int row = chunk * 256 + tid;
            list[(size_t)v.x * T + BASE[v.x] + v.z] = row * 2; list[(size_t)v.y * T + BASE[v.y] + v.w] = row * 2 + 1; }
        if (chunk == T / 256 - 1 && tid < 16) __hip_atomic_store(cur + tid * 64, (unsigned)(BASE[tid] + histg[chunk * 16 + tid]), __ATOMIC_RELAXED, __HIP_MEMORY_SCOPE_AGENT);
    }
}
DI int moe_setup(LAS unsigned char* lds, const Ctx& c, int l) {
    volatile LAS int* PRE = (volatile LAS int*)(lds + MISC_OFF); volatile LAS int* CNT = PRE + 17;
    unsigned* cur = (unsigned*)(c.ws + WS_CTL) + CW_CUR + l * 16 * 64;
    __syncthreads();
    if (threadIdx.x == 0) { int acc = 0; for (int e = 0; e < 16; ++e) { const int n = (int)__hip_atomic_load(cur + e * 64, __ATOMIC_RELAXED, __HIP_MEMORY_SCOPE_AGENT); PRE[e] = acc; CNT[e] = n; acc += (n + 255) >> 8; } PRE[16] = acc; }
    __syncthreads();
    return rfl(PRE[16]);
}
DI void phase_c(const Ctx& c, int l, int G) {
    const int tid = ltid(), lane = tid & 63, wave = rfl(tid >> 6);
    f32x4 g4[4], b4[4];
#pragma unroll
    for (int j = 0; j < 4; ++j) { g4[j] = *(const f32x4*)(c.ln2_g + l * D + 4 * lane + 256 * j); b4[j] = *(const f32x4*)(c.ln2_b + l * D + 4 * lane + 256 * j); }
    float* xo = c.out; bf16_t* xb = wsb(c, WS_XB); const bf16_t* ys = wsb(c, WS_YS); const float* gate = (const float*)(c.ws + WS_GATE);
    for (size_t row = (size_t)lbid() * NWAVES + wave; row < (size_t)T; row += (size_t)G * NWAVES) {
        const float g0 = gate[row * 2], g1 = gate[row * 2 + 1];
        f32x4 v[4]; float s = 0.f;
#pragma unroll
        for (int j = 0; j < 4; ++j) { const f32x4 xr = *(const f32x4*)(xo + row * D + 4 * lane + 256 * j);
            const u32x2 y0 = *(const u32x2*)(ys + (row * 2) * D + 4 * lane + 256 * j), y1 = *(const u32x2*)(ys + (row * 2 + 1) * D + 4 * lane + 256 * j);
            v[j][0] = xr[0] * DN_ALPHA + g0 * bf_lo(y0.x) + g1 * bf_lo(y1.x); v[j][1] = xr[1] * DN_ALPHA + g0 * bf_hi(y0.x) + g1 * bf_hi(y1.x);
            v[j][2] = xr[2] * DN_ALPHA + g0 * bf_lo(y0.y) + g1 * bf_lo(y1.y); v[j][3] = xr[3] * DN_ALPHA + g0 * bf_hi(y0.y) + g1 * bf_hi(y1.y);
            s += (v[j][0] + v[j][1]) + (v[j][2] + v[j][3]); }
        const float mean = wave_sum(s) * (1.0f / D); float s2 = 0.f;
#pragma unroll
        for (int j = 0; j < 4; ++j) { v[j] = v[j] - mean; s2 += (v[j][0] * v[j][0] + v[j][1] * v[j][1]) + (v[j][2] * v[j][2] + v[j][3] * v[j][3]); }
        const float rstd = __builtin_amdgcn_rsqf(wave_sum(s2) * (1.0f / D) + LN_EPS);
#pragma unroll
        for (int j = 0; j < 4; ++j) { v[j] = v[j] * rstd * g4[j] + b4[j]; *(f32x4*)(xo + row * D + 4 * lane + 256 * j) = v[j];
            u32x2 pk; pk.x = cvt_pk_bf16(v[j][0], v[j][1]); pk.y = cvt_pk_bf16(v[j][2], v[j][3]); *(u32x2*)(xb + row * D + 4 * lane + 256 * j) = pk; }
    }
}

DI Ctx load_ctx() {
    union { Ctx c; unsigned long long q[sizeof(Ctx) / 8]; } u;
#if defined(__HIP_DEVICE_COMPILE__)
    const __attribute__((address_space(4))) unsigned long long* p = (const __attribute__((address_space(4))) unsigned long long*)__builtin_amdgcn_kernarg_segment_ptr();
    asm volatile("" : "+s"(p));
#pragma unroll
    for (int i = 0; i < (int)(sizeof(Ctx) / 8); ++i) u.q[i] = p[i];
#endif
    return u.c;
}
#define CTX const Ctx c = load_ctx(); const int G = lgrid(); LAS unsigned char* lds = LDSBASE
__global__ void __launch_bounds__(NTHREADS, 2) mk_fwd(Ctx c_arg) {
    extern __shared__ __attribute__((aligned(16))) unsigned char lds_raw[];
#define LDSBASE ({ unsigned _b = (unsigned)(uintptr_t)(LAS unsigned char*)lds_raw; asm volatile("" : "+s"(_b)); (LAS unsigned char*)(uintptr_t)_b; })
    LAS unsigned char* lds0 = LDSBASE;
    const int tid = threadIdx.x; const Ctx c = load_ctx();
    volatile LAS unsigned* MISC = (volatile LAS unsigned*)(lds0 + MISC_OFF);
    if (tid < 64) MISC[tid] = 0u;
    __syncthreads();
    XcdBarrier bar; bar.bar = (unsigned*)(c.ws + WS_CTL) + CW_BAR; bar.x = 0; bar.st = MISC + 40;
    if (!MK_MULTI) bar = xcd_barrier_post((unsigned*)(c.ws + WS_CTL) + CW_BAR, MISC + 40);
    const int lo = c.lo, hi = c.hi; int step = 0;
#define RUN (lo <= step && step < hi)
#define END_STEP do { if (RUN && step + 1 < hi) { if (!MK_MULTI) xcd_barrier(bar); } ++step; } while (0)
    for (int l = 0; l < DEPTH; ++l) {
        if (RUN) { CTX; phase_w(lds, c, l, G); }
        END_STEP;
        for (int hf = 0; hf < 2; ++hf) {
            const size_t r0 = (size_t)hf * TH;
            if (RUN) {
                CTX;
                pg8::StaticOrder S; S.init(wsb(c, WS_XB) + r0 * D, wsb(c, WS_WIN), TH, NIN, D, G, lbid());
                EpiIn E{wsb(c, WS_H + H_QG), wsb(c, WS_H + H_KG), wsb(c, WS_H + H_VG), wsb(c, WS_H + H_SR), wsb(c, WS_H + H_QD), wsb(c, WS_H + H_KD), wsb(c, WS_H + H_VD), wsb(c, WS_H + H_GT), (float*)(c.ws + WS_HA), c.pos + r0};
                pg8::gemm_phase(lds, D, S, E);
            }
            END_STEP;
            if (RUN) { CTX; phase_b(lds, c, l, G); }
            END_STEP;
            if (RUN) { CTX; (void)lds; phase_f(c, G); }
            END_STEP;
            if (RUN) {
                CTX;
                pg8::StaticOrder S; S.init(wsb(c, WS_OG), wsb(c, WS_WGO), TH, D, D, G, lbid());
                EpiGate<false> E{wsb(c, WS_MIX), wsb(c, WS_H + H_GT)};
                pg8::gemm_phase(lds, D, S, E);
            }
            END_STEP;
            if (RUN) {
                CTX;
                pg8::StaticOrder S; S.init(wsb(c, WS_ATT), wsb(c, WS_WAO), TH, D, 512, G, lbid());
                EpiGate<true> E{wsb(c, WS_MIX), wsb(c, WS_H + H_GT) + 1024};
                pg8::gemm_phase(lds, 512, S, E);
            }
            END_STEP;
            if (RUN) {
                CTX;
                pg8::StaticOrder S; S.init(wsb(c, WS_MIX), wsb(c, WS_WOUT), TH, D, D, G, lbid());
                EpiRes E{(l == 0 ? c.x : c.out) + r0 * D, c.out + r0 * D};
                pg8::gemm_phase(lds, D, S, E);
            }
            END_STEP;
        }
        if (RUN) { CTX; phase_r(lds, c, l, G); }
        END_STEP;
        if (RUN) { CTX; phase_r2(lds, c, l, G); }
        END_STEP;
        if (RUN) {   CTX;
            const int ntiles = moe_setup(lds, c, l);
            volatile LAS int* PRE = (volatile LAS int*)(lds + MISC_OFF); volatile LAS int* TAB = (volatile LAS int*)(lds + TAB_OFF);
            pg8::MoeOrder S; S.G = G; S.c = lbid(); S.ntot = ntiles * 8; S.NC = 8; S.K = D; S.pre = PRE; S.cnt = PRE + 17; S.A = (const char*)wsb(c, WS_XB); S.Bt = (const char*)wsb(c, WS_WGU);
            S.bstride = (size_t)2048 * 1024 * 2; S.tab = TAB; S.gather = true;
            const int* list = (const int*)(c.ws + WS_LIST);
            { const int lt_tid = ltid(); const int r = lt_tid & 255, half = rfl(lt_tid >> 8);
              for (int i0 = 0; i0 < MAXU; i0 += 2) { Unit u; const int i = i0 + half;
                  if (S.next(i, u)) { const int lt = u.pm - PRE[u.e]; const int pos = 256 * lt + (r < u.nv ? r : 0); TAB[i * 256 + r] = list[(size_t)u.e * T + pos] >> 1; } } }
            __syncthreads();
            EpiM1 E{wsb(c, WS_HM)};
            pg8::gemm_phase(lds, D, S, E);
        }
        END_STEP;
        if (RUN) {   CTX;
            const int ntiles = moe_setup(lds, c, l);
            volatile LAS int* PRE = (volatile LAS int*)(lds + MISC_OFF);
            pg8::MoeOrder S; S.G = G; S.c = lbid(); S.ntot = ntiles * 4; S.NC = 4; S.K = DFF; S.pre = PRE; S.cnt = PRE + 17; S.A = (const char*)wsb(c, WS_HM); S.Bt = (const char*)wsb(c, WS_WD);
            S.bstride = (size_t)1024 * 1024 * 2; S.tab = nullptr; S.gather = false;
            EpiM2 E{wsb(c, WS_YS), (const int*)(c.ws + WS_LIST), PRE};
            pg8::gemm_phase(lds, DFF, S, E);
        }
        END_STEP;
        if (RUN) { CTX; (void)lds; phase_c(c, l, G); }
        END_STEP;
    }
#undef RUN
#undef END_STEP
}
constexpr int NSTEPS = DEPTH * (1 + 2 * 6 + 5);

extern "C" void kernel_launch(void* const* d_in, const int* in_sizes, int n_in, void* d_out, int out_size, void* d_ws, size_t ws_size, hipStream_t stream) {
    static int grid = 0;
    if (grid == 0) {
        if (n_in != 18 || in_sizes[0] != T * D || out_size != T * D || ws_size < WS_END) { fprintf(stderr, "kernel_launch: unexpected shapes / workspace (need %zu, got %zu)\n", (size_t)WS_END, ws_size); grid = -1; return; }
        int dev = 0, cus = 0;
        if (hipGetDevice(&dev) != hipSuccess || hipDeviceGetAttribute(&cus, hipDeviceAttributeMultiprocessorCount, dev) != hipSuccess) { grid = -1; return; }
        if (hipFuncSetAttribute((const void*)mk_fwd, hipFuncAttributeMaxDynamicSharedMemorySize, LDS_BYTES) != hipSuccess) { fprintf(stderr, "kernel_launch: hipFuncSetAttribute failed\n"); grid = -1; return; }
        int per_cu = 0;
        if (hipOccupancyMaxActiveBlocksPerMultiprocessor(&per_cu, (const void*)mk_fwd, NTHREADS, LDS_BYTES) != hipSuccess || per_cu < 1) { fprintf(stderr, "kernel_launch: occupancy query says %d\n", per_cu); }
        (void)hipGetLastError();
        grid = cus;
    }
    if (grid < 0) return;
    (void)hipMemsetAsync((char*)d_ws + WS_CTL, 0, CTL_ZERO_BYTES, stream);
    Ctx c{};
    c.x = (const float*)d_in[0]; c.pos = (const int*)d_in[1]; c.w_in = (const float*)d_in[2]; c.w_alpha_up = (const float*)d_in[3]; c.b_alpha = (const float*)d_in[4]; c.gla_norm = (const float*)d_in[5];
    c.w_gla_o = (const float*)d_in[6]; c.w_att_o = (const float*)d_in[7]; c.w_out = (const float*)d_in[8]; c.ln1_g = (const float*)d_in[9]; c.ln1_b = (const float*)d_in[10]; c.w_router = (const float*)d_in[11];
    c.b_router = (const float*)d_in[12]; c.w_e_gate = (const float*)d_in[13]; c.w_e_up = (const float*)d_in[14]; c.w_e_down = (const float*)d_in[15]; c.ln2_g = (const float*)d_in[16]; c.ln2_b = (const float*)d_in[17];
    c.out = (float*)d_out; c.ws = (unsigned char*)d_ws;
#if MK_MULTI
    for (int s = 0; s < NSTEPS; ++s) { c.lo = s; c.hi = s + 1; hipLaunchKernelGGL(mk_fwd, dim3(grid), dim3(NTHREADS), LDS_BYTES, stream, c); }
#else
    c.lo = 0; c.hi = NSTEPS; hipLaunchKernelGGL(mk_fwd, dim3(grid), dim3(NTHREADS), LDS_BYTES, stream, c);
#endif
}
```

```cpp
#include <hip/hip_runtime.h>
#include <cstdio>
#include <cstdint>

#ifndef MK_MULTI
#define MK_MULTI 0
#endif

#define DI __device__ __forceinline__
#define GAS __attribute__((address_space(1)))
#define LAS __attribute__((address_space(3)))
typedef unsigned short bf16_t;
typedef short bf16x8 __attribute__((ext_vector_type(8)));
typedef short s16x4 __attribute__((ext_vector_type(4)));
typedef float f32x4 __attribute__((ext_vector_type(4)));
typedef float f32x2 __attribute__((ext_vector_type(2)));
typedef unsigned u32x4 __attribute__((ext_vector_type(4)));
typedef unsigned u32x2 __attribute__((ext_vector_type(2)));
#define LDS_WAIT() asm volatile("s_waitcnt lgkmcnt(0)" ::: "memory")
#define VM_WAIT() asm volatile("s_waitcnt vmcnt(0)" ::: "memory")

constexpr int D = 1024, NBATCH = 16, SEQ = 4096, T = NBATCH * SEQ, DEPTH = 4;
constexpr int TH = T / 2;
constexpr int DIN = 9744, NIN = 9984;
constexpr int NEXP = 16, DFF = 1024;
constexpr float LN_EPS = 1e-5f, RMS_EPS = 1e-6f;
constexpr float DN_ALPHA = 1.6817928305074290f;
constexpr float LOG2E = 1.4426950408889634f;
constexpr int NWAVES = 8, NTHREADS = 512;

constexpr size_t MiB = 1u << 20;
constexpr size_t WS_CTL = 0, CTL_ZERO_BYTES = 1 * MiB;
constexpr size_t WS_WIN = 1 * MiB;
constexpr size_t WS_WGO = WS_WIN + (size_t)NIN * D * 2;
constexpr size_t WS_WAO = WS_WGO + 2 * MiB;
constexpr size_t WS_WOUT = WS_WAO + 1 * MiB;
constexpr size_t WS_WGU = WS_WOUT + 2 * MiB;
constexpr size_t WS_WD = WS_WGU + 64 * MiB;
constexpr size_t WS_XB = WS_WD + 32 * MiB;
constexpr size_t WS_LIST = WS_XB + 128 * MiB;
constexpr size_t WS_GATE = WS_LIST + 4 * MiB;
constexpr size_t WS_INFO = WS_GATE + 1 * MiB;
constexpr size_t WS_HISTG = WS_INFO + 1 * MiB;
constexpr size_t WS_OG = WS_HISTG + 1 * MiB;
constexpr size_t WS_ATTG = WS_OG + 64 * MiB;
constexpr size_t WS_LSE = WS_ATTG + 96 * MiB;
constexpr size_t WS_ATT = WS_LSE + 3 * MiB;
constexpr size_t WS_MIX = WS_ATT + 32 * MiB;
constexpr size_t WS_HA = WS_MIX + 64 * MiB;
constexpr size_t WS_H = WS_HA + 2 * MiB;
constexpr size_t H_QG = 0, H_KG = H_QG + (size_t)TH * 512 * 2, H_VG = H_KG + (size_t)TH * 512 * 2, H_SR = H_VG + (size_t)TH * 1024 * 2,
                 H_QD = H_SR + (size_t)TH * 1024 * 2, H_KD = H_QD + (size_t)TH * 1536 * 2, H_VD = H_KD + (size_t)TH * 1536 * 2, H_GT = H_VD + (size_t)TH * 1536 * 2,
                 H_END = H_GT + (size_t)TH * 2048 * 2;
constexpr size_t WS_HM = WS_H;
constexpr size_t WS_YS = WS_HM + (size_t)(2 * T + 4096) * 1024 * 2;
constexpr size_t WS_END = WS_H + H_END;
static_assert(WS_YS + (size_t)2 * T * 1024 * 2 <= WS_END, "MoE overlay fits");
constexpr int CW_BAR = 4096;
constexpr int CW_CUR = 16384;

constexpr int RING_BYTES = 131072;
constexpr int TAB_OFF = RING_BYTES, MAXU = 18, TAB_BYTES = MAXU * 1024;
constexpr int MISC_OFF = TAB_OFF + TAB_BYTES;
constexpr int LDS_BYTES = MISC_OFF + 256;

DI int rfl(int v) { return __builtin_amdgcn_readfirstlane(v); }
DI int lbid() { int t = blockIdx.x; asm volatile("" : "+s"(t)); return t; }
DI int lgrid() { int t = gridDim.x; asm volatile("" : "+s"(t)); return t; }
DI int ltid() { int t = threadIdx.x; asm volatile("" : "+v"(t)); return t; }
DI float bf2f(unsigned b) { return __uint_as_float(b << 16); }
DI unsigned cvt_pk_bf16(float lo, float hi) { unsigned r; asm volatile("v_cvt_pk_bf16_f32 %0, %1, %2" : "=v"(r) : "v"(lo), "v"(hi)); return r; }
DI float bf_lo(unsigned w) { return __uint_as_float(w << 16); }
DI float bf_hi(unsigned w) { return __uint_as_float(w & 0xffff0000u); }
DI float sigmoidf_(float x) { return __builtin_amdgcn_rcpf(1.0f + __builtin_amdgcn_exp2f(-x * LOG2E)); }

#define XB_TMO      128
#define XB_XCNT(j)  (256  + 64 * (j))
#define XB_XSUB(j)  (1280 + 64 * (j))
#define XB_XGEN(j)  (2304 + 64 * (j))
#define XB_TOP      3328
#define XB_TOPGEN   3392
#define XCD_BAR_WORDS 3456
#define XB_SPIN_CAP (1u << 18)
DI unsigned xb_ld(unsigned* p)              { return __hip_atomic_load(p, __ATOMIC_RELAXED, __HIP_MEMORY_SCOPE_AGENT); }
DI unsigned xb_add(unsigned* p, unsigned v) { return __hip_atomic_fetch_add(p, v, __ATOMIC_RELAXED, __HIP_MEMORY_SCOPE_AGENT); }
DI unsigned xb_xcc_id() { return (unsigned)__builtin_amdgcn_s_getreg((3 << 11) | 20) & 0xFu; }
#define XB_SPIN(cond, bar) do { unsigned _sp = 0; while (cond) { __builtin_amdgcn_s_sleep(1); \
    if ((++_sp & 255u) == 0u) { if (xb_ld(&(bar)[XB_TMO])) break; if (_sp > XB_SPIN_CAP) { atomicAdd(&(bar)[XB_TMO], 1u); break; } } } } while (0)
struct XcdBarrier { unsigned* bar; unsigned x; volatile LAS unsigned* st; };
DI XcdBarrier xcd_barrier_post(unsigned* bar, volatile LAS unsigned* st) {
    XcdBarrier b; b.bar = bar; b.x = xb_xcc_id(); b.st = st;
    if (threadIdx.x == 0) (void)xb_add(&bar[XB_XCNT(b.x)], 1u);
    return b;
}
DI void xcd_barrier_complete(unsigned* bar, unsigned x, unsigned& nloc, unsigned& nx) {
    const unsigned G = gridDim.x * gridDim.y * gridDim.z;
    unsigned sum, cnt, mine, sp = 0u;
    for (;;) {
        sum = 0u; cnt = 0u; mine = 0u;
#pragma unroll
        for (unsigned j = 0; j < 16; ++j) { const unsigned c = xb_ld(&bar[XB_XCNT(j)]); sum += c; cnt += (c > 0u) ? 1u : 0u; mine = (j == x) ? c : mine; }
        if (sum == G) break;
        __builtin_amdgcn_s_sleep(1);
        if ((++sp & 255u) == 0u) { if (xb_ld(&bar[XB_TMO])) break; if (sp > XB_SPIN_CAP) { atomicAdd(&bar[XB_TMO], 1u); break; } }
    }
    nloc = mine > 0u ? mine : 1u; nx = cnt > 0u ? cnt : 1u;
}
DI void xcd_barrier(const XcdBarrier& b) {
    asm volatile("s_waitcnt vmcnt(0)" ::: "memory");
    __syncthreads();
    if (threadIdx.x == 0) {
        unsigned* bar = b.bar;
        __builtin_amdgcn_s_waitcnt(0);
        unsigned nloc = b.st[0], nx = b.st[1];
        if (nloc == 0u) { xcd_barrier_complete(bar, b.x, nloc, nx); b.st[0] = nloc; b.st[1] = nx; }
        const unsigned old = xb_add(&bar[XB_XSUB(b.x)], 1u);
        const unsigned gen = old / nloc;
        if (old + 1u == (gen + 1u) * nloc) {
            __builtin_amdgcn_fence(__ATOMIC_RELEASE, "agent");
            asm volatile("s_waitcnt vmcnt(0)" ::: "memory");
            const unsigned og = xb_add(&bar[XB_TOP], 1u);
            const unsigned tg = og / nx;
            if (og + 1u == (tg + 1u) * nx) xb_add(&bar[XB_TOPGEN], 1u);
            else XB_SPIN(xb_ld(&bar[XB_TOPGEN]) == tg, bar);
            __builtin_amdgcn_fence(__ATOMIC_ACQUIRE, "agent");
            xb_add(&bar[XB_XGEN(b.x)], 1u);
            asm volatile("s_waitcnt vmcnt(0)" ::: "memory");
        } else {
            XB_SPIN(xb_ld(&bar[XB_XGEN(b.x)]) == gen, bar);
            __builtin_amdgcn_fence(__ATOMIC_ACQUIRE, "agent");
            asm volatile("s_waitcnt vmcnt(0)" ::: "memory");
        }
    }
    __syncthreads();
}

struct Ctx {
    const float* x; const int* pos; const float* w_in; const float* w_alpha_up; const float* b_alpha; const float* gla_norm;
    const float* w_gla_o; const float* w_att_o; const float* w_out; const float* ln1_g; const float* ln1_b; const float* w_router; const float* b_router;
    const float* w_e_gate; const float* w_e_up; const float* w_e_down; const float* ln2_g; const float* ln2_b;
    float* out; unsigned char* ws;
    int lo, hi;
};
DI bf16_t* wsb(const Ctx& c, size_t off) { return (bf16_t*)(c.ws + off); }

namespace pg8 {
constexpr int BM = 256, BK = 64, HALF = 128, HTB = HALF * BK * 2, STAGE_BYTES = 8 * HTB, NXCD = 8, WGM = 8;
DI int lds_byte(int r, int c) { const int st = (r >> 4) * 2 + (c >> 5), rr = r & 15, cc = c & 31, ob = rr * 64 + cc * 2; return st * 1024 + (ob ^ (((ob >> 9) & 1) << 5)); }
DI void stage_rc(int b, int& R, int& C) { const int st = b / 1024, sb = b % 1024, swz = sb ^ (((sb >> 9) & 1) << 5); R = (st >> 1) * 16 + swz / 64; C = (st & 1) * 32 + (swz % 64) / 2; }
DI int perm32(int rho) { const int n = rho >> 4, i = rho & 15; return 8 * (i >> 2) + 4 * n + (i & 3); }
struct Unit { int pm, pn, e, nv, ui; };

struct StaticOrder {
    int nM, nN, nwg, G, c, K; const char* A; const char* Bt;
    DI void init(const void* A_, const void* Bt_, int M, int N, int K_, int G_, int c_) { A = (const char*)A_; Bt = (const char*)Bt_; nM = M / BM; nN = N / BM; nwg = nM * nN; G = G_; c = c_; K = K_; }
    DI bool next(int i, Unit& u) const {
        const long L = (long)i * G + c; if (L >= nwg) return false;
        int wgid = (int)L; { const int q = nwg / NXCD, r = nwg % NXCD, xcd = wgid % NXCD, off = wgid / NXCD; wgid = (xcd < r ? xcd * (q + 1) : r * (q + 1) + (xcd - r) * q) + off; }
        const int nig = WGM * nN, gid = wgid / nig, fm = gid * WGM, gsz = (nM - fm) < WGM ? (nM - fm) : WGM;
        u.pm = fm + ((wgid % nig) % gsz); u.pn = (wgid % nig) / gsz; u.e = 0; u.nv = 256; u.ui = i; return true;
    }
    DI const char* a_base(const Unit& u) const { return A + (size_t)u.pm * BM * K * 2; }
    DI const char* b_base(const Unit& u) const { return Bt + (size_t)u.pn * BM * K * 2; }
    DI void a_off(const Unit&, int tid, unsigned (&o)[2][2]) const {
#pragma unroll
        for (int i = 0; i < 2; ++i) { int R, C; stage_rc(tid * 16 + i * 8192, R, C);
#pragma unroll
            for (int h = 0; h < 2; ++h) o[h][i] = (unsigned)((h * HALF + R) * K + C) * 2u; }
    }
};
struct MoeOrder {
    int G, c, ntot, NC, K; const volatile LAS int* pre; const volatile LAS int* cnt; const char* A; const char* Bt; size_t bstride; const volatile LAS int* tab; bool gather;
    DI bool next(int i, Unit& u) const {
        const int L = i * G + c; if (L >= ntot) return false;
        const int rt = L / NC; u.pn = L - rt * NC; u.pm = rt;
        int e = 0;
#pragma unroll
        for (int j = 1; j < 16; ++j) e += (rt >= rfl(pre[j])) ? 1 : 0;
        e = rfl(e); u.e = e; const int rem = rfl(cnt[e]) - 256 * (rt - rfl(pre[e])); u.nv = rem < 256 ? rem : 256; u.ui = i; return true;
    }
    DI const char* a_base(const Unit& u) const { return gather ? A : A + (size_t)u.pm * BM * K * 2; }
    DI const char* b_base(const Unit& u) const { return Bt + (size_t)u.e * bstride + (size_t)u.pn * BM * K * 2; }
    DI void a_off(const Unit& u, int tid, unsigned (&o)[2][2]) const {
#pragma unroll
        for (int i = 0; i < 2; ++i) { int R, C; stage_rc(tid * 16 + i * 8192, R, C);
#pragma unroll
            for (int h = 0; h < 2; ++h) { const int row = gather ? tab[u.ui * 256 + h * HALF + R] : (h * HALF + R); o[h][i] = (unsigned)(row * K + C) * 2u; } }
    }
};

template <class Epi, class Sched>
DI void gemm_phase(LAS unsigned char* lds, const int K, const Sched& S, const Epi& E) {
    const int tid = ltid(), wid = rfl(tid >> 6), lane = tid & 63, wr = wid >> 2, wc = wid & 3, fr = lane & 15, fq = lane >> 4;
    const int nt = K / BK;
    unsigned voffB[2];
#pragma unroll
    for (int i = 0; i < 2; ++i) { int R, C; stage_rc(tid * 16 + i * 8192, R, C); const int Rb = Epi::PERM ? ((R & ~31) + perm32(R & 31)) : R; voffB[i] = (unsigned)(Rb * K + C) * 2u; }
    const size_t kstep = (size_t)(BK * 2);
    const size_t hstep = (size_t)HALF * K * 2;
    const unsigned ldsw = (unsigned)wid * 1024u;
    const int aoff = lds_byte(wr * 64 + fr, fq * 8), boff = lds_byte(wc * 32 + fr, fq * 8);
#define PG8_SA(b, h) (((b) * 2 + (h)) * HTB)
#define PG8_SB(b, h) ((4 + (b) * 2 + (h)) * HTB)
#define PG8_STAGE(bufoff, gbase, voff) do { _Pragma("unroll") for (int _i = 0; _i < 2; ++_i) \
        __builtin_amdgcn_global_load_lds((const unsigned*)((const char*)(gbase) + (voff)[_i]), (LAS unsigned*)(lds + (bufoff) + ldsw + _i * 8192), 16, 0, 0); } while (0)
#define PG8_LDA(dst, b, h) do { _Pragma("unroll") for (int m = 0; m < 4; ++m) _Pragma("unroll") for (int k = 0; k < 2; ++k) dst[m][k] = *(const LAS bf16x8*)(lds + PG8_SA(b, h) + aoff + m * 2048 + k * 1024); } while (0)
#define PG8_LDB(dst, b, h) do { _Pragma("unroll") for (int n = 0; n < 2; ++n) _Pragma("unroll") for (int k = 0; k < 2; ++k) dst[n][k] = *(const LAS bf16x8*)(lds + PG8_SB(b, h) + boff + n * 2048 + k * 1024); } while (0)
#define PG8_MMA(ai, bj, At, Bt) do { __builtin_amdgcn_s_setprio(1); _Pragma("unroll") for (int m = 0; m < 4; ++m) _Pragma("unroll") for (int n = 0; n < 2; ++n) _Pragma("unroll") for (int k = 0; k < 2; ++k) \
        acc[ai][bj][m][n] = __builtin_amdgcn_mfma_f32_16x16x32_bf16(Bt[n][k], At[m][k], acc[ai][bj][m][n], 0, 0, 0); __builtin_amdgcn_s_setprio(0); } while (0)
#define PG8_WAIT_V(n) asm volatile("s_waitcnt vmcnt(" #n ")" ::: "memory")
#define PG8_WAIT_L(n) asm volatile("s_waitcnt lgkmcnt(" #n ")" ::: "memory")
#define PG8_BAR __builtin_amdgcn_s_barrier()
#define PG8_SCHED __builtin_amdgcn_sched_barrier(0)
    Unit cur, nxt; int ui = 0;
    if (!S.next(0, cur)) return;
    f32x4 acc[2][2][4][2];
#pragma unroll
    for (int a = 0; a < 2; ++a)
#pragma unroll
        for (int b = 0; b < 2; ++b)
#pragma unroll
            for (int m = 0; m < 4; ++m)
#pragma unroll
                for (int n = 0; n < 2; ++n) acc[a][b][m][n] = (f32x4){0.f, 0.f, 0.f, 0.f};
    bf16x8 At[4][2], B0[2][2], B1[2][2];
    unsigned oA[2][2]; S.a_off(cur, tid, oA);
    const char* cA = S.a_base(cur); const char* cB = S.b_base(cur);
    PG8_STAGE(PG8_SB(0, 0), cB, voffB); PG8_STAGE(PG8_SB(0, 1), cB + hstep, voffB); PG8_STAGE(PG8_SA(0, 0), cA, oA[0]); PG8_STAGE(PG8_SA(0, 1), cA, oA[1]);
    if (wr == 1) PG8_BAR;
    PG8_WAIT_V(2); PG8_BAR;
    PG8_STAGE(PG8_SB(1, 0), cB + kstep, voffB); PG8_STAGE(PG8_SA(1, 0), cA + kstep, oA[0]); PG8_STAGE(PG8_SB(1, 1), cB + hstep + kstep, voffB);
    PG8_WAIT_V(6); PG8_BAR;
    for (;;) {
        const bool has_next = S.next(ui + 1, nxt);
        const char* nA = has_next ? S.a_base(nxt) : cA; const char* nB = has_next ? S.b_base(nxt) : cB;
        for (int t = 0; t < nt; t += 2) {
            const bool last = (t == nt - 2);
            const char* a1 = cA + (size_t)(t + 1) * kstep;
            const char* a2 = last ? nA : cA + (size_t)(t + 2) * kstep; const char* b2 = last ? nB : cB + (size_t)(t + 2) * kstep;
            const char* a3 = a2 + kstep; const char* b3 = b2 + kstep;
            PG8_LDB(B0, 0, 0); PG8_LDB(B1, 0, 1); PG8_SCHED; PG8_LDA(At, 0, 0); PG8_STAGE(PG8_SA(1, 1), a1, oA[1]);
            if (last && has_next) S.a_off(nxt, tid, oA);
            PG8_WAIT_V(8); PG8_WAIT_L(0); PG8_BAR; PG8_MMA(0, 0, At, B0); PG8_MMA(0, 1, At, B1); PG8_BAR; PG8_SCHED;
            PG8_LDA(At, 0, 1); PG8_STAGE(PG8_SB(0, 0), b2, voffB); PG8_STAGE(PG8_SB(0, 1), b2 + hstep, voffB); PG8_STAGE(PG8_SA(0, 0), a2, oA[0]);
            PG8_WAIT_V(8); PG8_WAIT_L(0); PG8_BAR; PG8_MMA(1, 0, At, B0); PG8_MMA(1, 1, At, B1); PG8_BAR; PG8_SCHED;
            PG8_LDB(B0, 1, 0); PG8_LDB(B1, 1, 1); PG8_SCHED; PG8_LDA(At, 1, 0); PG8_STAGE(PG8_SA(0, 1), a2, oA[1]);
            PG8_WAIT_V(8); PG8_WAIT_L(0); PG8_BAR; PG8_MMA(0, 0, At, B0); PG8_MMA(0, 1, At, B1); PG8_BAR; PG8_SCHED;
            PG8_LDA(At, 1, 1); PG8_STAGE(PG8_SB(1, 0), b3, voffB); PG8_STAGE(PG8_SB(1, 1), b3 + hstep, voffB); PG8_STAGE(PG8_SA(1, 0), a3, oA[0]);
            PG8_WAIT_V(8); PG8_WAIT_L(0); PG8_BAR; PG8_MMA(1, 0, At, B0); PG8_MMA(1, 1, At, B1); PG8_BAR; PG8_SCHED;
        }
        if (wr == 0) PG8_BAR;
        E(acc, cur, wr, wc, fr, fq);
        if (!has_next) break;
#pragma unroll
        for (int a = 0; a < 2; ++a)
#pragma unroll
            for (int b = 0; b < 2; ++b)
#pragma unroll
                for (int m = 0; m < 4; ++m)
#pragma unroll
                    for (int n = 0; n < 2; ++n) acc[a][b][m][n] = (f32x4){0.f, 0.f, 0.f, 0.f};
        cur = nxt; cA = nA; cB = nB; ++ui;
        if (wr == 1) PG8_BAR;
    }
    PG8_WAIT_V(0);
    PG8_BAR;
#undef PG8_SA
#undef PG8_SB
#undef PG8_STAGE
#undef PG8_LDA
#undef PG8_LDB
#undef PG8_MMA
#undef PG8_WAIT_V
#undef PG8_WAIT_L
#undef PG8_BAR
#undef PG8_SCHED
}
}
using pg8::Unit;

DI u32x4 pack8(const f32x4& v0, const f32x4& v1) { u32x4 w; w.x = cvt_pk_bf16(v0[0], v0[1]); w.y = cvt_pk_bf16(v0[2], v0[3]); w.z = cvt_pk_bf16(v1[0], v1[1]); w.w = cvt_pk_bf16(v1[2], v1[3]); return w; }

struct EpiIn {
    static constexpr bool PERM = true;
    bf16_t *qg, *kg, *vg, *sr, *qd, *kd, *vd, *gt; float* ha; const int* pos;
    DI void operator()(const f32x4 (&acc)[2][2][4][2], const Unit& u, int wr, int wc, int fr, int fq) const {
        const int row0 = u.pm * 256 + wr * 64 + fr; const int pn = u.pn;
        if (pn >= 12 && pn < 24) {
            bf16_t* base = pn < 18 ? qd : kd; const int tq = pn < 18 ? pn - 12 : pn - 18; const float sc = pn < 18 ? 0.125f * LOG2E : 1.0f;
            float fre[8];
#pragma unroll
            for (int i = 0; i < 8; ++i) fre[i] = __builtin_amdgcn_exp2f(-(float)(8 * fq + i) * (13.287712379549449f / 32.0f)) * 0.15915494309189535f;
#pragma unroll
            for (int ai = 0; ai < 2; ++ai)
#pragma unroll
                for (int m = 0; m < 4; ++m) {
                    const int r = row0 + ai * 128 + m * 16; const float p = (float)pos[r];
                    bf16_t* rowp = base + (size_t)r * 1536 + (4 * tq + wc) * 64 + 8 * fq;
#pragma unroll
                    for (int n = 0; n < 2; ++n) { f32x4 o1, o2;
#pragma unroll
                        for (int j = 0; j < 4; ++j) {
                            float a = p * fre[n * 4 + j]; a = a - __builtin_floorf(a);
                            const float sn = __builtin_amdgcn_sinf(a), cs = __builtin_amdgcn_cosf(a);
                            const float x1 = acc[ai][0][m][n][j], x2 = acc[ai][1][m][n][j];
                            o1[j] = (x1 * cs - x2 * sn) * sc; o2[j] = (x2 * cs + x1 * sn) * sc;
                        }
                        u32x2 w1, w2; w1.x = cvt_pk_bf16(o1[0], o1[1]); w1.y = cvt_pk_bf16(o1[2], o1[3]); w2.x = cvt_pk_bf16(o2[0], o2[1]); w2.y = cvt_pk_bf16(o2[2], o2[3]);
                        *(u32x2*)(rowp + 4 * n) = w1; *(u32x2*)(rowp + 32 + 4 * n) = w2; }
                    asm volatile("" ::: "memory");
                }
        } else if (pn == 38) {
            if (wc == 0 && fq < 2) {
#pragma unroll
                for (int ai = 0; ai < 2; ++ai)
#pragma unroll
                    for (int m = 0; m < 4; ++m) { float* p = ha + (size_t)(row0 + ai * 128 + m * 16) * 16 + 8 * fq; *(f32x4*)p = acc[ai][0][m][0]; *(f32x4*)(p + 4) = acc[ai][0][m][1]; }
            }
        } else {
            bf16_t* base; int ldc, colt, act = 0; float sc = 1.0f;
            if (pn < 2) { base = qg; ldc = 512; colt = pn * 256; sc = 0.08838834764831845f; }
            else if (pn < 4) { base = kg; ldc = 512; colt = (pn - 2) * 256; }
            else if (pn < 8) { base = vg; ldc = 1024; colt = (pn - 4) * 256; }
            else if (pn < 12) { base = sr; ldc = 1024; colt = (pn - 8) * 256; act = 1; }
            else if (pn < 30) { base = vd; ldc = 1536; colt = (pn - 24) * 256; }
            else { base = gt; ldc = 2048; colt = (pn - 30) * 256; act = 2; }
#pragma unroll
            for (int ai = 0; ai < 2; ++ai)
#pragma unroll
                for (int m = 0; m < 4; ++m) { bf16_t* rowp = base + (size_t)(row0 + ai * 128 + m * 16) * ldc + colt + wc * 32 + 8 * fq;
#pragma unroll
                    for (int bj = 0; bj < 2; ++bj) { f32x4 v0 = acc[ai][bj][m][0] * sc, v1 = acc[ai][bj][m][1] * sc;
                        if (act) {
#pragma unroll
                            for (int j = 0; j < 4; ++j) { const float s0 = sigmoidf_(v0[j]), s1 = sigmoidf_(v1[j]); v0[j] = act == 1 ? v0[j] * s0 : s0; v1[j] = act == 1 ? v1[j] * s1 : s1; } }
                        *(u32x4*)(rowp + bj * 128) = pack8(v0, v1); } }
        }
    }
};
template <bool ADD> struct EpiGate {
    static constexpr bool PERM = true;
    bf16_t* mix; const bf16_t* gt;
    DI void operator()(const f32x4 (&acc)[2][2][4][2], const Unit& u, int wr, int wc, int fr, int fq) const {
        const int row0 = u.pm * 256 + wr * 64 + fr, col0 = u.pn * 256 + wc * 32 + 8 * fq;
#pragma unroll
        for (int ai = 0; ai < 2; ++ai)
#pragma unroll
            for (int m = 0; m < 4; ++m) { const size_t r = (size_t)(row0 + ai * 128 + m * 16);
#pragma unroll
                for (int bj = 0; bj < 2; ++bj) {
                    const u32x4 g = *(const u32x4*)(gt + r * 2048 + col0 + bj * 128);
                    f32x4 v0 = acc[ai][bj][m][0], v1 = acc[ai][bj][m][1];
                    v0[0] *= bf_lo(g.x); v0[1] *= bf_hi(g.x); v0[2] *= bf_lo(g.y); v0[3] *= bf_hi(g.y); v1[0] *= bf_lo(g.z); v1[1] *= bf_hi(g.z); v1[2] *= bf_lo(g.w); v1[3] *= bf_hi(g.w);
                    bf16_t* mp = mix + r * 1024 + col0 + bj * 128;
                    if (ADD) { const u32x4 o = *(const u32x4*)mp; v0[0] += bf_lo(o.x); v0[1] += bf_hi(o.x); v0[2] += bf_lo(o.y); v0[3] += bf_hi(o.y); v1[0] += bf_lo(o.z); v1[1] += bf_hi(o.z); v1[2] += bf_lo(o.w); v1[3] += bf_hi(o.w); }
                    *(u32x4*)mp = pack8(v0, v1); } }
    }
};
struct EpiRes {
    static constexpr bool PERM = false;
    const float* xres; float* z;
    DI void operator()(const f32x4 (&acc)[2][2][4][2], const Unit& u, int wr, int wc, int fr, int fq) const {
        const int row0 = u.pm * 256 + wr * 64 + fr, col0 = u.pn * 256 + wc * 32 + 4 * fq;
#pragma unroll
        for (int ai = 0; ai < 2; ++ai)
#pragma unroll
            for (int m = 0; m < 4; ++m) { const size_t off = (size_t)(row0 + ai * 128 + m * 16) * 1024 + col0;
#pragma unroll
                for (int bj = 0; bj < 2; ++bj)
#pragma unroll
                    for (int n = 0; n < 2; ++n) { const f32x4 xr = *(const f32x4*)(xres + off + bj * 128 + n * 16); *(f32x4*)(z + off + bj * 128 + n * 16) = xr * DN_ALPHA + acc[ai][bj][m][n]; }
                asm volatile("" ::: "memory"); }
    }
};
struct EpiM1 {
    static constexpr bool PERM = true;
    bf16_t* hm;
    DI void operator()(const f32x4 (&acc)[2][2][4][2], const Unit& u, int wr, int wc, int fr, int fq) const {
        const int row0 = u.pm * 256 + wr * 64 + fr, col0 = u.pn * 128 + wc * 32 + 8 * fq;
#pragma unroll
        for (int ai = 0; ai < 2; ++ai)
#pragma unroll
            for (int m = 0; m < 4; ++m) { f32x4 v0, v1;
#pragma unroll
                for (int j = 0; j < 4; ++j) { const float g0 = acc[ai][0][m][0][j], g1 = acc[ai][0][m][1][j]; v0[j] = g0 * sigmoidf_(g0) * acc[ai][1][m][0][j]; v1[j] = g1 * sigmoidf_(g1) * acc[ai][1][m][1][j]; }
                *(u32x4*)(hm + (size_t)(row0 + ai * 128 + m * 16) * 1024 + col0) = pack8(v0, v1); }
    }
};
struct EpiM2 {
    static constexpr bool PERM = true;
    bf16_t* ys; const int* list; const volatile LAS int* pre;
    DI void operator()(const f32x4 (&acc)[2][2][4][2], const Unit& u, int wr, int wc, int fr, int fq) const {
        const int lrow0 = wr * 64 + fr, col0 = u.pn * 256 + wc * 32 + 8 * fq; const int lt = u.pm - rfl(pre[u.e]);
        const int* lp = list + (size_t)u.e * T + 256 * lt;
#pragma unroll
        for (int ai = 0; ai < 2; ++ai)
#pragma unroll
            for (int m = 0; m < 4; ++m) { const int r = lrow0 + ai * 128 + m * 16;
                if (r < u.nv) { const int slot = lp[r]; bf16_t* yp = ys + (size_t)slot * 1024 + col0;
#pragma unroll
                    for (int bj = 0; bj < 2; ++bj) *(u32x4*)(yp + bj * 128) = pack8(acc[ai][bj][m][0], acc[ai][bj][m][1]); } }
    }
};

DI void tr_item(const float* W, int N, bf16_t* WT, int K, int drow, int c0, int nvalid, int kb, LAS float* scr, int lane) {
    const int k0 = 64 * kb;
    { const int cc = lane & 31, ccl = cc < nvalid ? cc : 0; const float* wp = W + (size_t)(k0 + (lane >> 5)) * N + c0 + ccl; float v[32];
#pragma unroll
      for (int i = 0; i < 32; ++i) v[i] = wp[(size_t)(2 * i) * N];
#pragma unroll
      for (int i = 0; i < 32; ++i) scr[(2 * i + (lane >> 5)) * 33 + cc] = (cc < nvalid) ? v[i] : 0.f; }
    LDS_WAIT(); asm volatile("" ::: "memory");
    const int c = lane & 7;
#pragma unroll
    for (int j = 0; j < 4; ++j) { const int n = (lane >> 3) + 8 * j; const LAS float* s = scr + (8 * c) * 33 + n;
        u32x4 o; o.x = cvt_pk_bf16(s[0 * 33], s[1 * 33]); o.y = cvt_pk_bf16(s[2 * 33], s[3 * 33]); o.z = cvt_pk_bf16(s[4 * 33], s[5 * 33]); o.w = cvt_pk_bf16(s[6 * 33], s[7 * 33]);
        *(u32x4*)(WT + (size_t)(drow + n) * K + k0 + 8 * c) = o; }
    LDS_WAIT(); asm volatile("" ::: "memory");
}
DI void phase_w(LAS unsigned char* lds, const Ctx& c, int l, int G) {
    const int tid = ltid(), lane = tid & 63, wave = rfl(tid >> 6);
    LAS float* scr = (LAS float*)(lds + wave * 16384);
    const int gw = lbid() * NWAVES + wave, NGW = G * NWAVES;
    constexpr int I_IN = (NIN / 32) * 16, I_GO = 512, I_AO = 256, I_OUT = 512, I_EXP = 16 * 512;
    constexpr int NITEMS = I_IN + I_GO + I_AO + I_OUT + 3 * I_EXP;
    for (int it = gw; it < NITEMS; it += NGW) {
        int r = it;
        if (r < I_IN) {
            const int nbg = r >> 4, kb = r & 15, n0 = 32 * nbg, tile = n0 >> 8, p = n0 & 255; int c0, nv = 32;
            if (tile < 12) c0 = n0;
            else if (tile < 24) { const int base = tile < 18 ? 3088 : 4624, tq = tile < 18 ? tile - 12 : tile - 18; c0 = base + (4 * tq + ((p & 127) >> 5)) * 64 + (p >= 128 ? 32 : 0); }
            else if (tile < 30) c0 = 6160 + (n0 - 24 * 256);
            else if (tile < 38) c0 = 7696 + (n0 - 30 * 256);
            else { c0 = 3072; nv = (p == 0) ? 16 : 0; }
            tr_item(c.w_in + (size_t)l * D * DIN, DIN, wsb(c, WS_WIN), D, n0, c0, nv, kb, scr, lane); continue; }
        r -= I_IN;
        if (r < I_GO) { tr_item(c.w_gla_o + (size_t)l * D * D, D, wsb(c, WS_WGO), D, 32 * (r >> 4), 32 * (r >> 4), 32, r & 15, scr, lane); continue; }
        r -= I_GO;
        if (r < I_AO) { tr_item(c.w_att_o + (size_t)l * 512 * D, D, wsb(c, WS_WAO), 512, 32 * (r >> 3), 32 * (r >> 3), 32, r & 7, scr, lane); continue; }
        r -= I_AO;
        if (r < I_OUT) { tr_item(c.w_out + (size_t)l * D * D, D, wsb(c, WS_WOUT), D, 32 * (r >> 4), 32 * (r >> 4), 32, r & 15, scr, lane); continue; }
        r -= I_OUT;
        const int which = r / I_EXP; r -= which * I_EXP; const int e = r >> 9, q = r & 511, nbg = q >> 4, kb = q & 15;
        const size_t eoff = (size_t)(l * NEXP + e) * D * DFF;
        if (which == 0) tr_item(c.w_e_gate + eoff, DFF, wsb(c, WS_WGU) + (size_t)e * 2048 * 1024, D, 256 * (nbg >> 2) + 32 * (nbg & 3), 32 * nbg, 32, kb, scr, lane);
        else if (which == 1) tr_item(c.w_e_up + eoff, DFF, wsb(c, WS_WGU) + (size_t)e * 2048 * 1024, D, 256 * (nbg >> 2) + 128 + 32 * (nbg & 3), 32 * nbg, 32, kb, scr, lane);
        else tr_item(c.w_e_down + eoff, D, wsb(c, WS_WD) + (size_t)e * 1024 * 1024, DFF, 32 * nbg, 32 * nbg, 32, kb, scr, lane);
    }
    if (l == 0) {
        const size_t n8 = (size_t)T * D / 8; bf16_t* xb = wsb(c, WS_XB);
        for (size_t i = (size_t)lbid() * NTHREADS + tid; i < n8; i += (size_t)G * NTHREADS) { const f32x4 a = *(const f32x4*)(c.x + i * 8), b = *(const f32x4*)(c.x + i * 8 + 4); *(u32x4*)(xb + i * 8) = pack8(a, b); }
    }
}

DI s16x4 tr16(const LAS void* p) { return __builtin_bit_cast(s16x4, __builtin_amdgcn_ds_read_tr16_b64_v4i16((LAS s16x4*)p)); }
DI bf16x8 cat8(s16x4 lo, s16x4 hi) { return __builtin_shufflevector(lo, hi, 0, 1, 2, 3, 4, 5, 6, 7); }
#define MFMA16(a, b, c) __builtin_amdgcn_mfma_f32_16x16x32_bf16((a), (b), (c), 0, 0, 0)

constexpr int GL_QT = 0, GL_KT = 17408, GL_KS = 34816, GL_VS = 52224, GL_ATT = 86016, GL_OST = 95232, GL_DEC = 129024, GL_WUP = 129792, GL_BAL = 137984, GL_SS = 138496;
DI void gla_chain(LAS unsigned char* lds, const Ctx& c, int l, int bl, int h) {
    const int tid = ltid(), lane = tid & 63, w = rfl(tid >> 6), fr = lane & 15, fq = lane >> 4;
    const bf16_t* QG = wsb(c, WS_H + H_QG) + (size_t)bl * SEQ * 512 + h * 128;
    const bf16_t* KG = wsb(c, WS_H + H_KG) + (size_t)bl * SEQ * 512 + h * 128;
    const bf16_t* VG = wsb(c, WS_H + H_VG) + (size_t)bl * SEQ * 1024 + h * 256;
    const bf16_t* SR = wsb(c, WS_H + H_SR) + (size_t)bl * SEQ * 1024 + h * 256;
    const float* HA = (const float*)(c.ws + WS_HA) + (size_t)bl * SEQ * 16;
    bf16_t* OG = wsb(c, WS_OG) + (size_t)bl * SEQ * 1024 + h * 256;
    LAS bf16_t* QT = (LAS bf16_t*)(lds + GL_QT); LAS bf16_t* KT = (LAS bf16_t*)(lds + GL_KT); LAS bf16_t* KS = (LAS bf16_t*)(lds + GL_KS);
    LAS bf16_t* VS = (LAS bf16_t*)(lds + GL_VS); LAS bf16_t* AT = (LAS bf16_t*)(lds + GL_ATT); LAS bf16_t* OST = (LAS bf16_t*)(lds + GL_OST);
    LAS float* DEC = (LAS float*)(lds + GL_DEC); LAS float* SS = (LAS float*)(lds + GL_SS); LAS float* WUP = (LAS float*)(lds + GL_WUP); LAS float* BAL = (LAS float*)(lds + GL_BAL);
    __syncthreads();
    for (int i = tid; i < 16 * 128; i += NTHREADS) WUP[i] = c.w_alpha_up[(size_t)l * 16 * 512 + (i >> 7) * 512 + h * 128 + (i & 127)];
    if (tid < 128) BAL[tid] = c.b_alpha[l * 512 + h * 128 + tid];
    const int dv0 = 32 * w;
    const float gn0 = c.gla_norm[l * 1024 + h * 256 + dv0 + fr], gn1 = c.gla_norm[l * 1024 + h * 256 + dv0 + 16 + fr];
    f32x4 S[8][2];
#pragma unroll
    for (int a = 0; a < 8; ++a) { S[a][0] = (f32x4){0.f, 0.f, 0.f, 0.f}; S[a][1] = (f32x4){0.f, 0.f, 0.f, 0.f}; }
    __syncthreads();
    for (int n = 0; n < 64; ++n) {
        const int tok0 = n * 64;
        {
            const int row = lane; const size_t tk = (size_t)(tok0 + row);
            f32x4 a4[4];
#pragma unroll
            for (int j = 0; j < 4; ++j) a4[j] = *(const f32x4*)(HA + tk * 16 + 4 * j);
            const u32x4 q0 = *(const u32x4*)(QG + tk * 512 + 16 * w), q1 = *(const u32x4*)(QG + tk * 512 + 16 * w + 8);
            const u32x4 k0 = *(const u32x4*)(KG + tk * 512 + 16 * w), k1 = *(const u32x4*)(KG + tk * 512 + 16 * w + 8);
#pragma unroll
            for (int c2 = 0; c2 < 4; ++c2) { const int idx = tid + NTHREADS * c2, r = idx >> 5, ch = idx & 31; *(LAS u32x4*)(VS + r * 264 + ch * 8) = *(const u32x4*)(VG + (size_t)(tok0 + r) * 1024 + ch * 8); }
            float la[16];
#pragma unroll
            for (int cc = 0; cc < 16; ++cc) la[cc] = BAL[16 * w + cc];
#pragma unroll
            for (int j = 0; j < 16; ++j) { const float aj = a4[j >> 2][j & 3];
#pragma unroll
                for (int c4 = 0; c4 < 4; ++c4) { const f32x4 wv = *(const LAS f32x4*)(WUP + j * 128 + 16 * w + 4 * c4); la[4 * c4] += aj * wv[0]; la[4 * c4 + 1] += aj * wv[1]; la[4 * c4 + 2] += aj * wv[2]; la[4 * c4 + 3] += aj * wv[3]; } }
#pragma unroll
            for (int cc = 0; cc < 16; ++cc) { const float z = la[cc]; la[cc] = -(fmaxf(-z, 0.f) + __logf(1.0f + __expf(-fabsf(z)))) * (1.0f / 16.0f); }
#pragma unroll
            for (int dlt = 1; dlt < 64; dlt <<= 1)
#pragma unroll
                for (int cc = 0; cc < 16; ++cc) { const float t = __shfl_up(la[cc], dlt); if (lane >= dlt) la[cc] += t; }
            float qv[16], kv[16];
            qv[0] = bf_lo(q0.x); qv[1] = bf_hi(q0.x); qv[2] = bf_lo(q0.y); qv[3] = bf_hi(q0.y); qv[4] = bf_lo(q0.z); qv[5] = bf_hi(q0.z); qv[6] = bf_lo(q0.w); qv[7] = bf_hi(q0.w);
            qv[8] = bf_lo(q1.x); qv[9] = bf_hi(q1.x); qv[10] = bf_lo(q1.y); qv[11] = bf_hi(q1.y); qv[12] = bf_lo(q1.z); qv[13] = bf_hi(q1.z); qv[14] = bf_lo(q1.w); qv[15] = bf_hi(q1.w);
            kv[0] = bf_lo(k0.x); kv[1] = bf_hi(k0.x); kv[2] = bf_lo(k0.y); kv[3] = bf_hi(k0.y); kv[4] = bf_lo(k0.z); kv[5] = bf_hi(k0.z); kv[6] = bf_lo(k0.w); kv[7] = bf_hi(k0.w);
            kv[8] = bf_lo(k1.x); kv[9] = bf_hi(k1.x); kv[10] = bf_lo(k1.y); kv[11] = bf_hi(k1.y); kv[12] = bf_lo(k1.z); kv[13] = bf_hi(k1.z); kv[14] = bf_lo(k1.w); kv[15] = bf_hi(k1.w);
            float qt[16], kt[16], ks[16];
#pragma unroll
            for (int cc = 0; cc < 16; ++cc) { const float b = la[cc]; const float bend = __shfl(b, 63); const float eb = __expf(b); qt[cc] = qv[cc] * eb; kt[cc] = kv[cc] * __expf(-b); ks[cc] = kv[cc] * __expf(bend - b);
                if (lane == 63) DEC[16 * w + cc] = eb; }
            u32x4 p0, p1;
            p0.x = cvt_pk_bf16(qt[0], qt[1]); p0.y = cvt_pk_bf16(qt[2], qt[3]); p0.z = cvt_pk_bf16(qt[4], qt[5]); p0.w = cvt_pk_bf16(qt[6], qt[7]);
            p1.x = cvt_pk_bf16(qt[8], qt[9]); p1.y = cvt_pk_bf16(qt[10], qt[11]); p1.z = cvt_pk_bf16(qt[12], qt[13]); p1.w = cvt_pk_bf16(qt[14], qt[15]);
            *(LAS u32x4*)(QT + row * 136 + 16 * w) = p0; *(LAS u32x4*)(QT + row * 136 + 16 * w + 8) = p1;
            p0.x = cvt_pk_bf16(kt[0], kt[1]); p0.y = cvt_pk_bf16(kt[2], kt[3]); p0.z = cvt_pk_bf16(kt[4], kt[5]); p0.w = cvt_pk_bf16(kt[6], kt[7]);
            p1.x = cvt_pk_bf16(kt[8], kt[9]); p1.y = cvt_pk_bf16(kt[10], kt[11]); p1.z = cvt_pk_bf16(kt[12], kt[13]); p1.w = cvt_pk_bf16(kt[14], kt[15]);
            *(LAS u32x4*)(KT + row * 136 + 16 * w) = p0; *(LAS u32x4*)(KT + row * 136 + 16 * w + 8) = p1;
            p0.x = cvt_pk_bf16(ks[0], ks[1]); p0.y = cvt_pk_bf16(ks[2], ks[3]); p0.z = cvt_pk_bf16(ks[4], ks[5]); p0.w = cvt_pk_bf16(ks[6], ks[7]);
            p1.x = cvt_pk_bf16(ks[8], ks[9]); p1.y = cvt_pk_bf16(ks[10], ks[11]); p1.z = cvt_pk_bf16(ks[12], ks[13]); p1.w = cvt_pk_bf16(ks[14], ks[15]);
            *(LAS u32x4*)(KS + row * 136 + 16 * w) = p0; *(LAS u32x4*)(KS + row * 136 + 16 * w + 8) = p1;
        }
        __syncthreads();
#pragma unroll
        for (int rep = 0; rep < 2; ++rep) {
            const int tt = w + 8 * rep, jt = tt >> 2, it = tt & 3;
            f32x4 a = (f32x4){0.f, 0.f, 0.f, 0.f};
            if (jt <= it) {
#pragma unroll
                for (int k4 = 0; k4 < 4; ++k4) { const bf16x8 af = *(const LAS bf16x8*)(KT + (16 * jt + fr) * 136 + 32 * k4 + 8 * fq), bfr = *(const LAS bf16x8*)(QT + (16 * it + fr) * 136 + 32 * k4 + 8 * fq); a = MFMA16(af, bfr, a); }
            }
            const int i = 16 * it + fr, j0 = 16 * jt + 4 * fq;
            u32x2 o; o.x = cvt_pk_bf16(j0 <= i ? a[0] : 0.f, j0 + 1 <= i ? a[1] : 0.f); o.y = cvt_pk_bf16(j0 + 2 <= i ? a[2] : 0.f, j0 + 3 <= i ? a[3] : 0.f);
            *(LAS u32x2*)(AT + i * 72 + j0) = o;
        }
        __syncthreads();
        f32x4 o[4][2];
        {
            bf16x8 vb[2][2];
#pragma unroll
            for (int k2 = 0; k2 < 2; ++k2)
#pragma unroll
                for (int dt = 0; dt < 2; ++dt) { const LAS bf16_t* p = VS + (32 * k2 + 8 * fq + (fr >> 2)) * 264 + dv0 + 16 * dt + (fr & 3) * 4; vb[k2][dt] = cat8(tr16(p), tr16(p + 4 * 264)); }
#pragma unroll
            for (int tt = 0; tt < 4; ++tt) {
                const bf16x8 a0 = *(const LAS bf16x8*)(AT + (16 * tt + fr) * 72 + 8 * fq), a1 = *(const LAS bf16x8*)(AT + (16 * tt + fr) * 72 + 32 + 8 * fq);
#pragma unroll
                for (int dt = 0; dt < 2; ++dt) { f32x4 z = (f32x4){0.f, 0.f, 0.f, 0.f}; z = MFMA16(a0, vb[0][dt], z); o[tt][dt] = MFMA16(a1, vb[1][dt], z); }
            }
#pragma unroll
            for (int s = 0; s < 4; ++s) {
                bf16x8 sb[2];
#pragma unroll
                for (int dt = 0; dt < 2; ++dt) { u32x4 pk; pk.x = cvt_pk_bf16(S[2 * s][dt][0], S[2 * s][dt][1]); pk.y = cvt_pk_bf16(S[2 * s][dt][2], S[2 * s][dt][3]); pk.z = cvt_pk_bf16(S[2 * s + 1][dt][0], S[2 * s + 1][dt][1]); pk.w = cvt_pk_bf16(S[2 * s + 1][dt][2], S[2 * s + 1][dt][3]); sb[dt] = __builtin_bit_cast(bf16x8, pk); }
#pragma unroll
                for (int tt = 0; tt < 4; ++tt) {
                    const LAS bf16_t* qp = QT + (16 * tt + fr) * 136 + 32 * s + 4 * fq;
                    const bf16x8 af = cat8(*(const LAS s16x4*)qp, *(const LAS s16x4*)(qp + 16));
                    o[tt][0] = MFMA16(af, sb[0], o[tt][0]); o[tt][1] = MFMA16(af, sb[1], o[tt][1]);
                }
            }
#pragma unroll
            for (int k8 = 0; k8 < 8; ++k8) {
                const f32x4 dc = *(const LAS f32x4*)(DEC + 16 * k8 + 4 * fq);
                S[k8][0] *= dc; S[k8][1] *= dc;
#pragma unroll
                for (int k2 = 0; k2 < 2; ++k2) { const LAS bf16_t* p = KS + (32 * k2 + 8 * fq + (fr >> 2)) * 136 + 16 * k8 + (fr & 3) * 4; const bf16x8 af = cat8(tr16(p), tr16(p + 4 * 136));
                    S[k8][0] = MFMA16(af, vb[k2][0], S[k8][0]); S[k8][1] = MFMA16(af, vb[k2][1], S[k8][1]); }
            }
        }
#pragma unroll
        for (int tt = 0; tt < 4; ++tt) { f32x4 pp;
#pragma unroll
            for (int rg = 0; rg < 4; ++rg) { float p = o[tt][0][rg] * o[tt][0][rg] + o[tt][1][rg] * o[tt][1][rg];
                p += __shfl_xor(p, 1); p += __shfl_xor(p, 2); p += __shfl_xor(p, 4); p += __shfl_xor(p, 8); pp[rg] = p; }
            if (fr == 0) *(LAS f32x4*)(SS + w * 64 + 16 * tt + 4 * fq) = pp; }
        __syncthreads();
#pragma unroll
        for (int tt = 0; tt < 4; ++tt) { f32x4 ss = *(const LAS f32x4*)(SS + 16 * tt + 4 * fq);
#pragma unroll
            for (int ww = 1; ww < 8; ++ww) ss += *(const LAS f32x4*)(SS + ww * 64 + 16 * tt + 4 * fq);
#pragma unroll
            for (int rg = 0; rg < 4; ++rg) { const float rs = __builtin_amdgcn_rsqf(ss[rg] * (1.0f / 256.0f) + RMS_EPS); const int i = 16 * tt + 4 * fq + rg;
                OST[i * 264 + dv0 + fr] = (bf16_t)(cvt_pk_bf16(o[tt][0][rg] * rs * gn0, 0.f) & 0xffffu); OST[i * 264 + dv0 + 16 + fr] = (bf16_t)(cvt_pk_bf16(o[tt][1][rg] * rs * gn1, 0.f) & 0xffffu); } }
        __syncthreads();
#pragma unroll
        for (int c2 = 0; c2 < 4; ++c2) { const int idx = tid + NTHREADS * c2, r = idx >> 5, ch = idx & 31;
            const u32x4 ov = *(const LAS u32x4*)(OST + r * 264 + ch * 8); const u32x4 sv = *(const u32x4*)(SR + (size_t)(tok0 + r) * 1024 + ch * 8);
            u32x4 rr; rr.x = cvt_pk_bf16(bf_lo(ov.x) * bf_lo(sv.x), bf_hi(ov.x) * bf_hi(sv.x)); rr.y = cvt_pk_bf16(bf_lo(ov.y) * bf_lo(sv.y), bf_hi(ov.y) * bf_hi(sv.y));
            rr.z = cvt_pk_bf16(bf_lo(ov.z) * bf_lo(sv.z), bf_hi(ov.z) * bf_hi(sv.z)); rr.w = cvt_pk_bf16(bf_lo(ov.w) * bf_lo(sv.w), bf_hi(ov.w) * bf_hi(sv.w));
            *(u32x4*)(OG + (size_t)(tok0 + r) * 1024 + ch * 8) = rr; }
    }
    __syncthreads();
}

constexpr int AT_K = 0, AT_V = 36864;
DI void attn_unit(LAS unsigned char* lds, const Ctx& c, int bl, int g, int h, int x) {
    const int tid = ltid(), lane = tid & 63, w = rfl(tid >> 6), fr = lane & 15, fq = lane >> 4;
    const int dl = (g == 0) ? 1 : (g == 1 ? 4 : 16), nb = 32 / dl, r = x / nb, n = x - r * nb;
    const size_t tb = (size_t)bl * SEQ + r; const int colo = g * 512 + h * 64;
    const bf16_t* Q = wsb(c, WS_H + H_QD) + colo; const bf16_t* K = wsb(c, WS_H + H_KD) + colo; const bf16_t* V = wsb(c, WS_H + H_VD) + colo;
    LAS bf16_t* Ks = (LAS bf16_t*)(lds + AT_K); LAS bf16_t* Vs = (LAS bf16_t*)(lds + AT_V);
    const size_t tokq = tb + (size_t)dl * (128 * n + 16 * w + fr);
    bf16x8 qf[2];
#pragma unroll
    for (int d0 = 0; d0 < 2; ++d0) qf[d0] = *(const bf16x8*)(Q + tokq * 1536 + 32 * d0 + 8 * fq);
    __syncthreads();
#pragma unroll
    for (int c2 = 0; c2 < 4; ++c2) { const int idx = tid + NTHREADS * c2, row = idx >> 3, ch = idx & 7; const int j = 128 * (n - 1) + row;
        u32x4 kv = (u32x4){0u, 0u, 0u, 0u}, vv = (u32x4){0u, 0u, 0u, 0u};
        if (j >= 0) { const size_t tok = tb + (size_t)dl * j; kv = *(const u32x4*)(K + tok * 1536 + ch * 8); vv = *(const u32x4*)(V + tok * 1536 + ch * 8); }
        *(LAS u32x4*)(Ks + row * 72 + ch * 8) = kv; *(LAS u32x4*)(Vs + row * 72 + ch * 8) = vv; }
    __syncthreads();
    f32x4 s[9]; float m = -1e30f;
#pragma unroll
    for (int kr = 0; kr < 9; ++kr) { const int kt = w + kr; f32x4 a = (f32x4){0.f, 0.f, 0.f, 0.f};
#pragma unroll
        for (int d0 = 0; d0 < 2; ++d0) { const bf16x8 af = *(const LAS bf16x8*)(Ks + (16 * kt + fr) * 72 + 32 * d0 + 8 * fq); a = MFMA16(af, qf[d0], a); }
#pragma unroll
        for (int rg = 0; rg < 4; ++rg) { const int rel = 16 * kr + 4 * fq + rg - fr; const bool ok = rel >= 0 && rel <= 128 && (n > 0 || 16 * kt + 4 * fq + rg >= 128); a[rg] = ok ? a[rg] : -1e30f; m = fmaxf(m, a[rg]); }
        s[kr] = a; }
    m = fmaxf(m, __shfl_xor(m, 16)); m = fmaxf(m, __shfl_xor(m, 32));
    float lsum = 0.f;
#pragma unroll
    for (int kr = 0; kr < 9; ++kr)
#pragma unroll
        for (int rg = 0; rg < 4; ++rg) { const float p = s[kr][rg] > -1e29f ? __builtin_amdgcn_exp2f(s[kr][rg] - m) : 0.f; s[kr][rg] = p; lsum += p; }
    lsum += __shfl_xor(lsum, 16); lsum += __shfl_xor(lsum, 32);
    f32x4 oT[4];
#pragma unroll
    for (int dt = 0; dt < 4; ++dt) oT[dt] = (f32x4){0.f, 0.f, 0.f, 0.f};
#pragma unroll
    for (int pp = 0; pp < 5; ++pp) { const int ka = 2 * pp, kb = (2 * pp + 1 < 9) ? 2 * pp + 1 : 8;
        u32x4 pk; pk.x = cvt_pk_bf16(s[ka][0], s[ka][1]); pk.y = cvt_pk_bf16(s[ka][2], s[ka][3]);
        if (2 * pp + 1 < 9) { pk.z = cvt_pk_bf16(s[kb][0], s[kb][1]); pk.w = cvt_pk_bf16(s[kb][2], s[kb][3]); } else { pk.z = 0u; pk.w = 0u; }
        const bf16x8 pf = __builtin_bit_cast(bf16x8, pk);
#pragma unroll
        for (int dt = 0; dt < 4; ++dt) { const LAS bf16_t* pa = Vs + (16 * (w + ka) + 4 * fq + (fr >> 2)) * 72 + 16 * dt + (fr & 3) * 4; const LAS bf16_t* pb = Vs + (16 * (w + kb) + 4 * fq + (fr >> 2)) * 72 + 16 * dt + (fr & 3) * 4;
            oT[dt] = MFMA16(cat8(tr16(pa), tr16(pb)), pf, oT[dt]); } }
    const float inv = 1.0f / lsum; const size_t tq = tb + (size_t)dl * (128 * n + 16 * w + fr);
    bf16_t* op = wsb(c, WS_ATTG) + ((size_t)g * TH + tq) * 512 + h * 64 + 4 * fq;
#pragma unroll
    for (int dt = 0; dt < 4; ++dt) { u32x2 o; o.x = cvt_pk_bf16(oT[dt][0] * inv, oT[dt][1] * inv); o.y = cvt_pk_bf16(oT[dt][2] * inv, oT[dt][3] * inv); *(u32x2*)(op + 16 * dt) = o; }
    if (fq == 0) ((float*)(c.ws + WS_LSE))[((size_t)g * TH + tq) * 8 + h] = m + __builtin_amdgcn_logf(lsum);
}
DI void phase_b(LAS unsigned char* lds, const Ctx& c, int l, int G) {
    const int bid = lbid(); constexpr int NGLA = 32, NATT = 8 * 3 * 8 * 32;
    if (G >= 64) {
        if (bid < NGLA) gla_chain(lds, c, l, bid >> 2, bid & 3);
        else { const int k = bid - NGLA, W = G - NGLA; const int u0 = (int)((long)k * NATT / W), u1 = (int)((long)(k + 1) * NATT / W);
            for (int u = u0; u < u1; ++u) attn_unit(lds, c, u / 768, (u / 256) % 3, (u >> 5) & 7, u & 31); }
    } else {
        for (int id = bid; id < NGLA; id += G) gla_chain(lds, c, l, id >> 2, id & 3);
        for (int u = bid; u < NATT; u += G) attn_unit(lds, c, u / 768, (u / 256) % 3, (u >> 5) & 7, u & 31);
    }
}
DI void phase_f(const Ctx& c, int G) {
    const bf16_t* ag = wsb(c, WS_ATTG); const float* lse = (const float*)(c.ws + WS_LSE); bf16_t* att = wsb(c, WS_ATT);
    for (size_t i = (size_t)lbid() * NTHREADS + ltid(); i < (size_t)TH * 64; i += (size_t)G * NTHREADS) {
        const size_t tok = i >> 6; const int ch = (int)(i & 63), h = ch >> 3;
        const float l0 = lse[tok * 8 + h], l1 = lse[((size_t)TH + tok) * 8 + h], l2 = lse[((size_t)2 * TH + tok) * 8 + h];
        const float mx = fmaxf(l0, fmaxf(l1, l2)); float w0 = __builtin_amdgcn_exp2f(l0 - mx), w1 = __builtin_amdgcn_exp2f(l1 - mx), w2 = __builtin_amdgcn_exp2f(l2 - mx);
        const float inv = 1.0f / (w0 + w1 + w2); w0 *= inv; w1 *= inv; w2 *= inv;
        const u32x4 a = *(const u32x4*)(ag + tok * 512 + ch * 8), b = *(const u32x4*)(ag + ((size_t)TH + tok) * 512 + ch * 8), d = *(const u32x4*)(ag + ((size_t)2 * TH + tok) * 512 + ch * 8);
        u32x4 o;
        o.x = cvt_pk_bf16(w0 * bf_lo(a.x) + w1 * bf_lo(b.x) + w2 * bf_lo(d.x), w0 * bf_hi(a.x) + w1 * bf_hi(b.x) + w2 * bf_hi(d.x));
        o.y = cvt_pk_bf16(w0 * bf_lo(a.y) + w1 * bf_lo(b.y) + w2 * bf_lo(d.y), w0 * bf_hi(a.y) + w1 * bf_hi(b.y) + w2 * bf_hi(d.y));
        o.z = cvt_pk_bf16(w0 * bf_lo(a.z) + w1 * bf_lo(b.z) + w2 * bf_lo(d.z), w0 * bf_hi(a.z) + w1 * bf_hi(b.z) + w2 * bf_hi(d.z));
        o.w = cvt_pk_bf16(w0 * bf_lo(a.w) + w1 * bf_lo(b.w) + w2 * bf_lo(d.w), w0 * bf_hi(a.w) + w1 * bf_hi(b.w) + w2 * bf_hi(d.w));
        *(u32x4*)(att + tok * 512 + ch * 8) = o;
    }
}

DI float wave_sum(float v) {
#pragma unroll
    for (int o = 1; o < 64; o <<= 1) v += __shfl_xor(v, o);
    return v;
}
constexpr int R_WR = 0, R_HIST = 65536, R_BASE = 65536 + 64, R_INFO = 65536 + 128;
DI void phase_r(LAS unsigned char* lds, const Ctx& c, int l, int G) {
    const int tid = ltid(), lane = tid & 63, wave = rfl(tid >> 6);
    LAS float* WR = (LAS float*)(lds + R_WR); volatile LAS int* HIST = (volatile LAS int*)(lds + R_HIST); volatile LAS int* BASE = (volatile LAS int*)(lds + R_BASE); volatile LAS int* INFO = (volatile LAS int*)(lds + R_INFO);
    __syncthreads();
    for (int i = tid; i < 16 * 1024; i += NTHREADS) WR[(i & 15) * 1024 + (i >> 4)] = c.w_router[i];
    f32x4 g4[4], b4[4];
#pragma unroll
    for (int j = 0; j < 4; ++j) { g4[j] = *(const f32x4*)(c.ln1_g + l * D + 4 * lane + 256 * j); b4[j] = *(const f32x4*)(c.ln1_b + l * D + 4 * lane + 256 * j); }
    float* xo = c.out; bf16_t* xb = wsb(c, WS_XB); int* histg = (int*)(c.ws + WS_HISTG); float* gate = (float*)(c.ws + WS_GATE);
    for (int chunk = lbid(); chunk < T / 256; chunk += G) {
        __syncthreads();
        for (int rr = 0; rr < 32; ++rr) {
            const int rl = wave * 32 + rr; const size_t row = (size_t)chunk * 256 + rl;
            f32x4 v[4]; float s = 0.f;
#pragma unroll
            for (int j = 0; j < 4; ++j) { v[j] = *(const f32x4*)(xo + row * D + 4 * lane + 256 * j); s += (v[j][0] + v[j][1]) + (v[j][2] + v[j][3]); }
            const float mean = wave_sum(s) * (1.0f / D); float s2 = 0.f;
#pragma unroll
            for (int j = 0; j < 4; ++j) { v[j] = v[j] - mean; s2 += (v[j][0] * v[j][0] + v[j][1] * v[j][1]) + (v[j][2] * v[j][2] + v[j][3] * v[j][3]); }
            const float rstd = __builtin_amdgcn_rsqf(wave_sum(s2) * (1.0f / D) + LN_EPS);
#pragma unroll
            for (int j = 0; j < 4; ++j) { v[j] = v[j] * rstd * g4[j] + b4[j]; *(f32x4*)(xo + row * D + 4 * lane + 256 * j) = v[j];
                u32x2 pk; pk.x = cvt_pk_bf16(v[j][0], v[j][1]); pk.y = cvt_pk_bf16(v[j][2], v[j][3]); *(u32x2*)(xb + row * D + 4 * lane + 256 * j) = pk; }
            float lg[16];
#pragma unroll
            for (int e = 0; e < 16; ++e) { float a = 0.f;
#pragma unroll
                for (int j = 0; j < 4; ++j) { const f32x4 wv = *(const LAS f32x4*)(WR + e * 1024 + 4 * lane + 256 * j); a += v[j][0] * wv[0] + v[j][1] * wv[1] + v[j][2] * wv[2] + v[j][3] * wv[3]; }
                lg[e] = wave_sum(a) + c.b_router[e]; }
            float mx = lg[0];
#pragma unroll
            for (int e = 1; e < 16; ++e) mx = fmaxf(mx, lg[e]);
            float se = 0.f;
#pragma unroll
            for (int e = 0; e < 16; ++e) { lg[e] = __expf(lg[e] - mx); se += lg[e]; }
            const float ise = 1.0f / se;
#pragma unroll
            for (int e = 0; e < 16; ++e) lg[e] *= ise;
            int gsel = 0; float gbest = -1.f;
#pragma unroll
            for (int gi = 0; gi < 4; ++gi) { const float a = lg[4 * gi], b = lg[4 * gi + 1], cc = lg[4 * gi + 2], d = lg[4 * gi + 3];
                const float sc = (a + b + cc + d) - fminf(fminf(a, b), fminf(cc, d)) - fminf(fmaxf(fminf(a, b), fminf(cc, d)), fminf(fmaxf(a, b), fmaxf(cc, d)));
                if (sc > gbest) { gbest = sc; gsel = gi; } }
            float p[4];
#pragma unroll
            for (int k = 0; k < 4; ++k) p[k] = gsel == 0 ? lg[k] : gsel == 1 ? lg[4 + k] : gsel == 2 ? lg[8 + k] : lg[12 + k];
            int i0 = 0; float v0 = p[0];
#pragma unroll
            for (int k = 1; k < 4; ++k) if (p[k] > v0) { v0 = p[k]; i0 = k; }
            int i1 = -1; float v1 = -1.f;
#pragma unroll
            for (int k = 0; k < 4; ++k) if (k != i0 && p[k] > v1) { v1 = p[k]; i1 = k; }
            if (lane == 0) { const int e0 = 4 * gsel + i0, e1 = 4 * gsel + i1; INFO[rl * 4 + 0] = e0; INFO[rl * 4 + 1] = e1;
                const float gs = 1.0f / (v0 + v1); gate[row * 2] = v0 * gs; gate[row * 2 + 1] = v1 * gs; }
        }
        __syncthreads();
        if (tid < 16) { int cnt = 0;
            for (int r = 0; r < 256; ++r) { if (INFO[r * 4] == tid) INFO[r * 4 + 2] = cnt++; else if (INFO[r * 4 + 1] == tid) INFO[r * 4 + 3] = cnt++; }
            histg[chunk * 16 + tid] = cnt; }
        __syncthreads();
        if (tid < 256) { int4 v; v.x = INFO[tid * 4]; v.y = INFO[tid * 4 + 1]; v.z = INFO[tid * 4 + 2]; v.w = INFO[tid * 4 + 3]; ((int4*)(c.ws + WS_INFO))[(size_t)chunk * 256 + tid] = v; }
        __syncthreads();
    }
}
DI void phase_r2(LAS unsigned char* lds, const Ctx& c, int l, int G) {
    const int tid = ltid(); volatile LAS int* BASE = (volatile LAS int*)(lds + R_BASE);
    const int* histg = (const int*)(c.ws + WS_HISTG); int* list = (int*)(c.ws + WS_LIST);
    unsigned* cur = (unsigned*)(c.ws + WS_CTL) + CW_CUR + l * 16 * 64;
    for (int chunk = lbid(); chunk < T / 256; chunk += G) {
        __syncthreads();
        if (tid < 16) BASE[tid] = 0;
        __syncthreads();
        { const int e = tid & 15; int s = 0; for (int cc = tid >> 4; cc < chunk; cc += 32) s += histg[cc * 16 + e]; if (s) atomicAdd((int*)&BASE[e], s); }
        __syncthreads();
        if (tid < 256) { const int4 v = ((const int4*)(c.ws + WS_INFO))[(size_t)chunk * 256 + tid]; const int row = chunk * 256 + tid;
            list[(size_t)v.x * T + BASE[v.x] + v.z] = row * 2; list[(size_t)v.y * T + BASE[v.y] + v.w] = row * 2 + 1; }
        if (chunk == T / 256 - 1 && tid < 16) __hip_atomic_store(cur + tid * 64, (unsigned)(BASE[tid] + histg[chunk * 16 + tid]), __ATOMIC_RELAXED, __HIP_MEMORY_SCOPE_AGENT);
    }
}
DI int moe_setup(LAS unsigned char* lds, const Ctx& c, int l) {
    volatile LAS int* PRE = (volatile LAS int*)(lds + MISC_OFF); volatile LAS int* CNT = PRE + 17;
    unsigned* cur = (unsigned*)(c.ws + WS_CTL) + CW_CUR + l * 16 * 64;
    __syncthreads();
    if (threadIdx.x == 0) { int acc = 0; for (int e = 0; e < 16; ++e) { const int n = (int)__hip_atomic_load(cur + e * 64, __ATOMIC_RELAXED, __HIP_MEMORY_SCOPE_AGENT); PRE[e] = acc; CNT[e] = n; acc += (n + 255) >> 8; } PRE[16] = acc; }
    __syncthreads();
    return rfl(PRE[16]);
}
DI void phase_c(const Ctx& c, int l, int G) {
    const int tid = ltid(), lane = tid & 63, wave = rfl(tid >> 6);
    f32x4 g4[4], b4[4];
#pragma unroll
    for (int j = 0; j < 4; ++j) { g4[j] = *(const f32x4*)(c.ln2_g + l * D + 4 * lane + 256 * j); b4[j] = *(const f32x4*)(c.ln2_b + l * D + 4 * lane + 256 * j); }
    float* xo = c.out; bf16_t* xb = wsb(c, WS_XB); const bf16_t* ys = wsb(c, WS_YS); const float* gate = (const float*)(c.ws + WS_GATE);
    for (size_t row = (size_t)lbid() * NWAVES + wave; row < (size_t)T; row += (size_t)G * NWAVES) {
        const float g0 = gate[row * 2], g1 = gate[row * 2 + 1];
        f32x4 v[4]; float s = 0.f;
#pragma unroll
        for (int j = 0; j < 4; ++j) { const f32x4 xr = *(const f32x4*)(xo + row * D + 4 * lane + 256 * j);
            const u32x2 y0 = *(const u32x2*)(ys + (row * 2) * D + 4 * lane + 256 * j), y1 = *(const u32x2*)(ys + (row * 2 + 1) * D + 4 * lane + 256 * j);
            v[j][0] = xr[0] * DN_ALPHA + g0 * bf_lo(y0.x) + g1 * bf_lo(y1.x); v[j][1] = xr[1] * DN_ALPHA + g0 * bf_hi(y0.x) + g1 * bf_hi(y1.x);
            v[j][2] = xr[2] * DN_ALPHA + g0 * bf_lo(y0.y) + g1 * bf_lo(y1.y); v[j][3] = xr[3] * DN_ALPHA + g0 * bf_hi(y0.y) + g1 * bf_hi(y1.y);
            s += (v[j][0] + v[j][1]) + (v[j][2] + v[j][3]); }
        const float mean = wave_sum(s) * (1.0f / D); float s2 = 0.f;
#pragma unroll
        for (int j = 0; j < 4; ++j) { v[j] = v[j] - mean; s2 += (v[j][0] * v[j][0] + v[j][1] * v[j][1]) + (v[j][2] * v[j][2] + v[j][3] * v[j][3]); }
        const float rstd = __builtin_amdgcn_rsqf(wave_sum(s2) * (1.0f / D) + LN_EPS);
#pragma unroll
        for (int j = 0; j < 4; ++j) { v[j] = v[j] * rstd * g4[j] + b4[j]; *(f32x4*)(xo + row * D + 4 * lane + 256 * j) = v[j];
            u32x2 pk; pk.x = cvt_pk_bf16(v[j][0], v[j][1]); pk.y = cvt_pk_bf16(v[j][2], v[j][3]); *(u32x2*)(xb + row * D + 4 * lane + 256 * j) = pk; }
    }
}

DI Ctx load_ctx() {
    union { Ctx c; unsigned long long q[sizeof(Ctx) / 8]; } u;
#if defined(__HIP_DEVICE_COMPILE__)
    const __attribute__((address_space(4))) unsigned long long* p = (const __attribute__((address_space(4))) unsigned long long*)__builtin_amdgcn_kernarg_segment_ptr();
    asm volatile("" : "+s"(p));
#pragma unroll
    for (int i = 0; i < (int)(sizeof(Ctx) / 8); ++i) u.q[i] = p[i];
#endif
    return u.c;
}
#define CTX const Ctx c = load_ctx(); const int G = lgrid(); LAS unsigned char* lds = LDSBASE
__global__ void __launch_bounds__(NTHREADS, 2) mk_fwd(Ctx c_arg) {
    extern __shared__ __attribute__((aligned(16))) unsigned char lds_raw[];
#define LDSBASE ({ unsigned _b = (unsigned)(uintptr_t)(LAS unsigned char*)lds_raw; asm volatile("" : "+s"(_b)); (LAS unsigned char*)(uintptr_t)_b; })
    LAS unsigned char* lds0 = LDSBASE;
    const int tid = threadIdx.x; const Ctx c = load_ctx();
    volatile LAS unsigned* MISC = (volatile LAS unsigned*)(lds0 + MISC_OFF);
    if (tid < 64) MISC[tid] = 0u;
    __syncthreads();
    XcdBarrier bar; bar.bar = (unsigned*)(c.ws + WS_CTL) + CW_BAR; bar.x = 0; bar.st = MISC + 40;
    if (!MK_MULTI) bar = xcd_barrier_post((unsigned*)(c.ws + WS_CTL) + CW_BAR, MISC + 40);
    const int lo = c.lo, hi = c.hi; int step = 0;
#define RUN (lo <= step && step < hi)
#define END_STEP do { if (RUN && step + 1 < hi) { if (!MK_MULTI) xcd_barrier(bar); } ++step; } while (0)
    for (int l = 0; l < DEPTH; ++l) {
        if (RUN) { CTX; phase_w(lds, c, l, G); }
        END_STEP;
        for (int hf = 0; hf < 2; ++hf) {
            const size_t r0 = (size_t)hf * TH;
            if (RUN) {
                CTX;
                pg8::StaticOrder S; S.init(wsb(c, WS_XB) + r0 * D, wsb(c, WS_WIN), TH, NIN, D, G, lbid());
                EpiIn E{wsb(c, WS_H + H_QG), wsb(c, WS_H + H_KG), wsb(c, WS_H + H_VG), wsb(c, WS_H + H_SR), wsb(c, WS_H + H_QD), wsb(c, WS_H + H_KD), wsb(c, WS_H + H_VD), wsb(c, WS_H + H_GT), (float*)(c.ws + WS_HA), c.pos + r0};
                pg8::gemm_phase(lds, D, S, E);
            }
            END_STEP;
            if (RUN) { CTX; phase_b(lds, c, l, G); }
            END_STEP;
            if (RUN) { CTX; (void)lds; phase_f(c, G); }
            END_STEP;
            if (RUN) {
                CTX;
                pg8::StaticOrder S; S.init(wsb(c, WS_OG), wsb(c, WS_WGO), TH, D, D, G, lbid());
                EpiGate<false> E{wsb(c, WS_MIX), wsb(c, WS_H + H_GT)};
                pg8::gemm_phase(lds, D, S, E);
            }
            END_STEP;
            if (RUN) {
                CTX;
                pg8::StaticOrder S; S.init(wsb(c, WS_ATT), wsb(c, WS_WAO), TH, D, 512, G, lbid());
                EpiGate<true> E{wsb(c, WS_MIX), wsb(c, WS_H + H_GT) + 1024};
                pg8::gemm_phase(lds, 512, S, E);
            }
            END_STEP;
            if (RUN) {
                CTX;
                pg8::StaticOrder S; S.init(wsb(c, WS_MIX), wsb(c, WS_WOUT), TH, D, D, G, lbid());
                EpiRes E{(l == 0 ? c.x : c.out) + r0 * D, c.out + r0 * D};
                pg8::gemm_phase(lds, D, S, E);
            }
            END_STEP;
        }
        if (RUN) { CTX; phase_r(lds, c, l, G); }
        END_STEP;
        if (RUN) { CTX; phase_r2(lds, c, l, G); }
        END_STEP;
        if (RUN) {   CTX;
            const int ntiles = moe_setup(lds, c, l);
            volatile LAS int* PRE = (volatile LAS int*)(lds + MISC_OFF); volatile LAS int* TAB = (volatile LAS int*)(lds + TAB_OFF);
            pg8::MoeOrder S; S.G = G; S.c = lbid(); S.ntot = ntiles * 8; S.NC = 8; S.K = D; S.pre = PRE; S.cnt = PRE + 17; S.A = (const char*)wsb(c, WS_XB); S.Bt = (const char*)wsb(c, WS_WGU);
            S.bstride = (size_t)2048 * 1024 * 2; S.tab = TAB; S.gather = true;
            const int* list = (const int*)(c.ws + WS_LIST);
            { const int lt_tid = ltid(); const int r = lt_tid & 255, half = rfl(lt_tid >> 8);
              for (int i0 = 0; i0 < MAXU; i0 += 2) { Unit u; const int i = i0 + half;
                  if (S.next(i, u)) { const int lt = u.pm - PRE[u.e]; const int pos = 256 * lt + (r < u.nv ? r : 0); TAB[i * 256 + r] = list[(size_t)u.e * T + pos] >> 1; } } }
            __syncthreads();
            EpiM1 E{wsb(c, WS_HM)};
            pg8::gemm_phase(lds, D, S, E);
        }
        END_STEP;
        if (RUN) {   CTX;
            const int ntiles = moe_setup(lds, c, l);
            volatile LAS int* PRE = (volatile LAS int*)(lds + MISC_OFF);
            pg8::MoeOrder S; S.G = G; S.c = lbid(); S.ntot = ntiles * 4; S.NC = 4; S.K = DFF; S.pre = PRE; S.cnt = PRE + 17; S.A = (const char*)wsb(c, WS_HM); S.Bt = (const char*)wsb(c, WS_WD);
            S.bstride = (size_t)1024 * 1024 * 2; S.tab = nullptr; S.gather = false;
            EpiM2 E{wsb(c, WS_YS), (const int*)(c.ws + WS_LIST), PRE};
            pg8::gemm_phase(lds, DFF, S, E);
        }
        END_STEP;
        if (RUN) { CTX; (void)lds; phase_c(c, l, G); }
        END_STEP;
    }
#undef RUN
#undef END_STEP
}
constexpr int NSTEPS = DEPTH * (1 + 2 * 6 + 5);

extern "C" void kernel_launch(void* const* d_in, const int* in_sizes, int n_in, void* d_out, int out_size, void* d_ws, size_t ws_size, hipStream_t stream) {
    static int grid = 0;
    if (grid == 0) {
        if (n_in != 18 || in_sizes[0] != T * D || out_size != T * D || ws_size < WS_END) { fprintf(stderr, "kernel_launch: unexpected shapes / workspace (need %zu, got %zu)\n", (size_t)WS_END, ws_size); grid = -1; return; }
        int dev = 0, cus = 0;
        if (hipGetDevice(&dev) != hipSuccess || hipDeviceGetAttribute(&cus, hipDeviceAttributeMultiprocessorCount, dev) != hipSuccess) { grid = -1; return; }
        if (hipFuncSetAttribute((const void*)mk_fwd, hipFuncAttributeMaxDynamicSharedMemorySize, LDS_BYTES) != hipSuccess) { fprintf(stderr, "kernel_launch: hipFuncSetAttribute failed\n"); grid = -1; return; }
        int per_cu = 0;
        if (hipOccupancyMaxActiveBlocksPerMultiprocessor(&per_cu, (const void*)mk_fwd, NTHREADS, LDS_BYTES) != hipSuccess || per_cu < 1) { fprintf(stderr, "kernel_launch: occupancy query says %d\n", per_cu); }
        (void)hipGetLastError();
        grid = cus;
    }
    if (grid < 0) return;
    (void)hipMemsetAsync((char*)d_ws + WS_CTL, 0, CTL_ZERO_BYTES, stream);
    Ctx c{};
    c.x = (const float*)d_in[0]; c.pos = (const int*)d_in[1]; c.w_in = (const float*)d_in[2]; c.w_alpha_up = (const float*)d_in[3]; c.b_alpha = (const float*)d_in[4]; c.gla_norm = (const float*)d_in[5];
    c.w_gla_o = (const float*)d_in[6]; c.w_att_o = (const float*)d_in[7]; c.w_out = (const float*)d_in[8]; c.ln1_g = (const float*)d_in[9]; c.ln1_b = (const float*)d_in[10]; c.w_router = (const float*)d_in[11];
    c.b_router = (const float*)d_in[12]; c.w_e_gate = (const float*)d_in[13]; c.w_e_up = (const float*)d_in[14]; c.w_e_down = (const float*)d_in[15]; c.ln2_g = (const float*)d_in[16]; c.ln2_b = (const float*)d_in[17];
    c.out = (float*)d_out; c.ws = (unsigned char*)d_ws;
#if MK_MULTI
    for (int s = 0; s < NSTEPS; ++s) { c.lo = s; c.hi = s + 1; hipLaunchKernelGGL(mk_fwd, dim3(grid), dim3(NTHREADS), LDS_BYTES, stream, c); }
#else
    c.lo = 0; c.hi = NSTEPS; hipLaunchKernelGGL(mk_fwd, dim3(grid), dim3(NTHREADS), LDS_BYTES, stream, c);
#endif
}
```

```cpp
#include <hip/hip_runtime.h>
#include <cstdio>
#include <cstdint>

#ifndef MK_MULTI
#define MK_MULTI 0
#endif

#define DI __device__ __forceinline__
#define GAS __attribute__((address_space(1)))
#define LAS __attribute__((address_space(3)))
typedef unsigned short bf16_t;
typedef short bf16x8 __attribute__((ext_vector_type(8)));
typedef short s16x4 __attribute__((ext_vector_type(4)));
typedef float f32x4 __attribute__((ext_vector_type(4)));
typedef float f32x2 __attribute__((ext_vector_type(2)));
typedef unsigned u32x4 __attribute__((ext_vector_type(4)));
typedef unsigned u32x2 __attribute__((ext_vector_type(2)));
#define LDS_WAIT() asm volatile("s_waitcnt lgkmcnt(0)" ::: "memory")
#define VM_WAIT() asm volatile("s_waitcnt vmcnt(0)" ::: "memory")

constexpr int D = 1024, NBATCH = 16, SEQ = 4096, T = NBATCH * SEQ, DEPTH = 4;
constexpr int TH = T / 2;
constexpr int DIN = 9744, NIN = 9984;
constexpr int NEXP = 16, DFF = 1024;
constexpr float LN_EPS = 1e-5f, RMS_EPS = 1e-6f;
constexpr float DN_ALPHA = 1.6817928305074290f;
constexpr float LOG2E = 1.4426950408889634f;
constexpr int NWAVES = 8, NTHREADS = 512;

constexpr size_t MiB = 1u << 20;
constexpr size_t WS_CTL = 0, CTL_ZERO_BYTES = 1 * MiB;
constexpr size_t WS_WIN = 1 * MiB;
constexpr size_t WS_WGO = WS_WIN + (size_t)NIN * D * 2;
constexpr size_t WS_WAO = WS_WGO + 2 * MiB;
constexpr size_t WS_WOUT = WS_WAO + 1 * MiB;
constexpr size_t WS_WGU = WS_WOUT + 2 * MiB;
constexpr size_t WS_WD = WS_WGU + 64 * MiB;
constexpr size_t WS_XB = WS_WD + 32 * MiB;
constexpr size_t WS_LIST = WS_XB + 128 * MiB;
constexpr size_t WS_GATE = WS_LIST + 4 * MiB;
constexpr size_t WS_INFO = WS_GATE + 1 * MiB;
constexpr size_t WS_HISTG = WS_INFO + 1 * MiB;
constexpr size_t WS_OG = WS_HISTG + 1 * MiB;
constexpr size_t WS_ATTG = WS_OG + 64 * MiB;
constexpr size_t WS_LSE = WS_ATTG + 96 * MiB;
constexpr size_t WS_ATT = WS_LSE + 3 * MiB;
constexpr size_t WS_MIX = WS_ATT + 32 * MiB;
constexpr size_t WS_HA = WS_MIX + 64 * MiB;
constexpr size_t WS_H = WS_HA + 2 * MiB;
constexpr size_t H_QG = 0, H_KG = H_QG + (size_t)TH * 512 * 2, H_VG = H_KG + (size_t)TH * 512 * 2, H_SR = H_VG + (size_t)TH * 1024 * 2,
                 H_QD = H_SR + (size_t)TH * 1024 * 2, H_KD = H_QD + (size_t)TH * 1536 * 2, H_VD = H_KD + (size_t)TH * 1536 * 2, H_GT = H_VD + (size_t)TH * 1536 * 2,
                 H_END = H_GT + (size_t)TH * 2048 * 2;
constexpr size_t WS_HM = WS_H;
constexpr size_t WS_YS = WS_HM + (size_t)(2 * T + 4096) * 1024 * 2;
constexpr size_t WS_REC = WS_H + H_END;
constexpr size_t WS_END = WS_REC + (size_t)2048 * 33792;
static_assert(WS_YS + (size_t)2 * T * 1024 * 2 <= WS_END, "MoE overlay fits");
constexpr int CW_BAR = 4096;
constexpr int CW_CUR = 16384;

constexpr int RING_BYTES = 131072;
constexpr int TAB_OFF = RING_BYTES, MAXU = 18, TAB_BYTES = MAXU * 1024;
constexpr int MISC_OFF = TAB_OFF + TAB_BYTES;
constexpr int LDS_BYTES = MISC_OFF + 256;

DI int rfl(int v) { return __builtin_amdgcn_readfirstlane(v); }
DI int lbid() { int t = blockIdx.x; asm volatile("" : "+s"(t)); return t; }
DI int lgrid() { int t = gridDim.x; asm volatile("" : "+s"(t)); return t; }
DI int ltid() { int t = threadIdx.x; asm volatile("" : "+v"(t)); return t; }
DI float bf2f(unsigned b) { return __uint_as_float(b << 16); }
typedef __bf16 bf16x2_t __attribute__((ext_vector_type(2)));
DI unsigned cvt_pk_bf16(float lo, float hi) { f32x2 v = {lo, hi}; bf16x2_t b = __builtin_convertvector(v, bf16x2_t); return __builtin_bit_cast(unsigned, b); }
DI float bf_lo(unsigned w) { return __uint_as_float(w << 16); }
DI float bf_hi(unsigned w) { return __uint_as_float(w & 0xffff0000u); }
DI float sigmoidf_(float x) { return __builtin_amdgcn_rcpf(1.0f + __builtin_amdgcn_exp2f(-x * LOG2E)); }

#define XB_TMO      128
#define XB_XCNT(j)  (256  + 64 * (j))
#define XB_XSUB(j)  (1280 + 64 * (j))
#define XB_XGEN(j)  (2304 + 64 * (j))
#define XB_TOP      3328
#define XB_TOPGEN   3392
#define XCD_BAR_WORDS 3456
#define XB_SPIN_CAP (1u << 18)
DI unsigned xb_ld(unsigned* p)              { return __hip_atomic_load(p, __ATOMIC_RELAXED, __HIP_MEMORY_SCOPE_AGENT); }
DI unsigned xb_add(unsigned* p, unsigned v) { return __hip_atomic_fetch_add(p, v, __ATOMIC_RELAXED, __HIP_MEMORY_SCOPE_AGENT); }
DI unsigned xb_xcc_id() { return (unsigned)__builtin_amdgcn_s_getreg((3 << 11) | 20) & 0xFu; }
#define XB_SPIN(cond, bar) do { unsigned _sp = 0; while (cond) { __builtin_amdgcn_s_sleep(1); \
    if ((++_sp & 255u) == 0u) { if (xb_ld(&(bar)[XB_TMO])) break; if (_sp > XB_SPIN_CAP) { atomicAdd(&(bar)[XB_TMO], 1u); break; } } } } while (0)
struct XcdBarrier { unsigned* bar; unsigned x; volatile LAS unsigned* st; };
DI XcdBarrier xcd_barrier_post(unsigned* bar, volatile LAS unsigned* st) {
    XcdBarrier b; b.bar = bar; b.x = xb_xcc_id(); b.st = st;
    if (threadIdx.x == 0) (void)xb_add(&bar[XB_XCNT(b.x)], 1u);
    return b;
}
DI void xcd_barrier_complete(unsigned* bar, unsigned x, unsigned& nloc, unsigned& nx) {
    const unsigned G = gridDim.x * gridDim.y * gridDim.z;
    unsigned sum, cnt, mine, sp = 0u;
    for (;;) {
        sum = 0u; cnt = 0u; mine = 0u;
#pragma unroll
        for (unsigned j = 0; j < 16; ++j) { const unsigned c = xb_ld(&bar[XB_XCNT(j)]); sum += c; cnt += (c > 0u) ? 1u : 0u; mine = (j == x) ? c : mine; }
        if (sum == G) break;
        __builtin_amdgcn_s_sleep(1);
        if ((++sp & 255u) == 0u) { if (xb_ld(&bar[XB_TMO])) break; if (sp > XB_SPIN_CAP) { atomicAdd(&bar[XB_TMO], 1u); break; } }
    }
    nloc = mine > 0u ? mine : 1u; nx = cnt > 0u ? cnt : 1u;
}
DI void xcd_barrier(const XcdBarrier& b) {
    asm volatile("s_waitcnt vmcnt(0)" ::: "memory");
    __syncthreads();
    if (threadIdx.x == 0) {
        unsigned* bar = b.bar;
        __builtin_amdgcn_s_waitcnt(0);
        unsigned nloc = b.st[0], nx = b.st[1];
        if (nloc == 0u) { xcd_barrier_complete(bar, b.x, nloc, nx); b.st[0] = nloc; b.st[1] = nx; }
        const unsigned old = xb_add(&bar[XB_XSUB(b.x)], 1u);
        const unsigned gen = old / nloc;
        if (old + 1u == (gen + 1u) * nloc) {
            __builtin_amdgcn_fence(__ATOMIC_RELEASE, "agent");
            asm volatile("s_waitcnt vmcnt(0)" ::: "memory");
            const unsigned og = xb_add(&bar[XB_TOP], 1u);
            const unsigned tg = og / nx;
            if (og + 1u == (tg + 1u) * nx) xb_add(&bar[XB_TOPGEN], 1u);
            else XB_SPIN(xb_ld(&bar[XB_TOPGEN]) == tg, bar);
            __builtin_amdgcn_fence(__ATOMIC_ACQUIRE, "agent");
            xb_add(&bar[XB_XGEN(b.x)], 1u);
            asm volatile("s_waitcnt vmcnt(0)" ::: "memory");
        } else {
            XB_SPIN(xb_ld(&bar[XB_XGEN(b.x)]) == gen, bar);
            __builtin_amdgcn_fence(__ATOMIC_ACQUIRE, "agent");
            asm volatile("s_waitcnt vmcnt(0)" ::: "memory");
        }
    }
    __syncthreads();
}

struct Ctx {
    const float* x; const int* pos; const float* w_in; const float* w_alpha_up; const float* b_alpha; const float* gla_norm;
    const float* w_gla_o; const float* w_att_o; const float* w_out; const float* ln1_g; const float* ln1_b; const float* w_router; const float* b_router;
    const float* w_e_gate; const float* w_e_up; const float* w_e_down; const float* ln2_g; const float* ln2_b;
    float* out; unsigned char* ws;
    int lo, hi;
};
DI bf16_t* wsb(const Ctx& c, size_t off) { return (bf16_t*)(c.ws + off); }

namespace pg8 {
constexpr int BM = 256, BK = 64, HALF = 128, HTB = HALF * BK * 2, STAGE_BYTES = 8 * HTB, NXCD = 8, WGM = 8;
DI int lds_byte(int r, int c) { const int st = (r >> 4) * 2 + (c >> 5), rr = r & 15, cc = c & 31, ob = rr * 64 + cc * 2; return st * 1024 + (ob ^ (((ob >> 9) & 1) << 5)); }
DI void stage_rc(int b, int& R, int& C) { const int st = b / 1024, sb = b % 1024, swz = sb ^ (((sb >> 9) & 1) << 5); R = (st >> 1) * 16 + swz / 64; C = (st & 1) * 32 + (swz % 64) / 2; }
DI int perm32(int rho) { const int n = rho >> 4, i = rho & 15; return 8 * (i >> 2) + 4 * n + (i & 3); }
struct Unit { int pm, pn, e, nv, ui; };

struct StaticOrder {
    int nM, nN, nwg, G, c, K; const char* A; const char* Bt;
    DI void init(const void* A_, const void* Bt_, int M, int N, int K_, int G_, int c_) { A = (const char*)A_; Bt = (const char*)Bt_; nM = M / BM; nN = N / BM; nwg = nM * nN; G = G_; c = c_; K = K_; }
    DI bool next(int i, Unit& u) const {
        const long L = (long)i * G + c; if (L >= nwg) return false;
        int wgid = (int)L; { const int q = nwg / NXCD, r = nwg % NXCD, xcd = wgid % NXCD, off = wgid / NXCD; wgid = (xcd < r ? xcd * (q + 1) : r * (q + 1) + (xcd - r) * q) + off; }
        const int nig = WGM * nN, gid = wgid / nig, fm = gid * WGM, gsz = (nM - fm) < WGM ? (nM - fm) : WGM;
        u.pm = fm + ((wgid % nig) % gsz); u.pn = (wgid % nig) / gsz; u.e = 0; u.nv = 256; u.ui = i; return true;
    }
    DI const char* a_base(const Unit& u) const { return A + (size_t)u.pm * BM * K * 2; }
    DI const char* b_base(const Unit& u) const { return Bt + (size_t)u.pn * BM * K * 2; }
    DI void a_off(const Unit&, int tid, unsigned (&o)[2][2]) const {
#pragma unroll
        for (int i = 0; i < 2; ++i) { int R, C; stage_rc(tid * 16 + i * 8192, R, C);
#pragma unroll
            for (int h = 0; h < 2; ++h) o[h][i] = (unsigned)((h * HALF + R) * K + C) * 2u; }
    }
};
struct MoeOrder {
    int G, c, ntot, NC, K; const volatile LAS int* pre; const volatile LAS int* cnt; const char* A; const char* Bt; size_t bstride; const volatile LAS int* tab; bool gather;
    DI bool next(int i, Unit& u) const {
        const int L = i * G + c; if (L >= ntot) return false;
        const int rt = L / NC; u.pn = L - rt * NC; u.pm = rt;
        int e = 0;
#pragma unroll
        for (int j = 1; j < 16; ++j) e += (rt >= rfl(pre[j])) ? 1 : 0;
        e = rfl(e); u.e = e; const int rem = rfl(cnt[e]) - 256 * (rt - rfl(pre[e])); u.nv = rem < 256 ? rem : 256; u.ui = i; return true;
    }
    DI const char* a_base(const Unit& u) const { return gather ? A : A + (size_t)u.pm * BM * K * 2; }
    DI const char* b_base(const Unit& u) const { return Bt + (size_t)u.e * bstride + (size_t)u.pn * BM * K * 2; }
    DI void a_off(const Unit& u, int tid, unsigned (&o)[2][2]) const {
#pragma unroll
        for (int i = 0; i < 2; ++i) { int R, C; stage_rc(tid * 16 + i * 8192, R, C);
#pragma unroll
            for (int h = 0; h < 2; ++h) { const int row = gather ? tab[u.ui * 256 + h * HALF + R] : (h * HALF + R); o[h][i] = (unsigned)(row * K + C) * 2u; } }
    }
};

template <class Epi, class Sched>
DI void gemm_phase(LAS unsigned char* lds, const int K, const Sched& S, const Epi& E) {
    const int tid = ltid(), wid = rfl(tid >> 6), lane = tid & 63, wr = wid >> 2, wc = wid & 3, fr = lane & 15, fq = lane >> 4;
    const int nt = K / BK;
    unsigned voffB[2];
#pragma unroll
    for (int i = 0; i < 2; ++i) { int R, C; stage_rc(tid * 16 + i * 8192, R, C); const int Rb = Epi::PERM ? ((R & ~31) + perm32(R & 31)) : R; voffB[i] = (unsigned)(Rb * K + C) * 2u; }
    const size_t kstep = (size_t)(BK * 2);
    const size_t hstep = (size_t)HALF * K * 2;
    const unsigned ldsw = (unsigned)wid * 1024u;
    const int aoff = lds_byte(wr * 64 + fr, fq * 8), boff = lds_byte(wc * 32 + fr, fq * 8);
#define PG8_SA(b, h) (((b) * 2 + (h)) * HTB)
#define PG8_SB(b, h) ((4 + (b) * 2 + (h)) * HTB)
#define PG8_STAGE(bufoff, gbase, voff) do { _Pragma("unroll") for (int _i = 0; _i < 2; ++_i) \
        __builtin_amdgcn_global_load_lds((const unsigned*)((const char*)(gbase) + (voff)[_i]), (LAS unsigned*)(lds + (bufoff) + ldsw + _i * 8192), 16, 0, 0); } while (0)
#define PG8_LDA(dst, b, h) do { _Pragma("unroll") for (int m = 0; m < 4; ++m) _Pragma("unroll") for (int k = 0; k < 2; ++k) dst[m][k] = *(const LAS bf16x8*)(lds + PG8_SA(b, h) + aoff + m * 2048 + k * 1024); } while (0)
#define PG8_LDB(dst, b, h) do { _Pragma("unroll") for (int n = 0; n < 2; ++n) _Pragma("unroll") for (int k = 0; k < 2; ++k) dst[n][k] = *(const LAS bf16x8*)(lds + PG8_SB(b, h) + boff + n * 2048 + k * 1024); } while (0)
#define PG8_MMA(ai, bj, At, Bt) do { __builtin_amdgcn_s_setprio(1); _Pragma("unroll") for (int m = 0; m < 4; ++m) _Pragma("unroll") for (int n = 0; n < 2; ++n) _Pragma("unroll") for (int k = 0; k < 2; ++k) \
        acc[ai][bj][m][n] = __builtin_amdgcn_mfma_f32_16x16x32_bf16(Bt[n][k], At[m][k], acc[ai][bj][m][n], 0, 0, 0); __builtin_amdgcn_s_setprio(0); } while (0)
#define PG8_WAIT_V(n) asm volatile("s_waitcnt vmcnt(" #n ")" ::: "memory")
#define PG8_WAIT_L(n) asm volatile("s_waitcnt lgkmcnt(" #n ")" ::: "memory")
#define PG8_BAR __builtin_amdgcn_s_barrier()
#define PG8_SCHED __builtin_amdgcn_sched_barrier(0)
    Unit cur, nxt; int ui = 0;
    if (!S.next(0, cur)) return;
    f32x4 acc[2][2][4][2];
#pragma unroll
    for (int a = 0; a < 2; ++a)
#pragma unroll
        for (int b = 0; b < 2; ++b)
#pragma unroll
            for (int m = 0; m < 4; ++m)
#pragma unroll
                for (int n = 0; n < 2; ++n) acc[a][b][m][n] = (f32x4){0.f, 0.f, 0.f, 0.f};
    bf16x8 At[4][2], B0[2][2], B1[2][2];
    unsigned oA[2][2]; S.a_off(cur, tid, oA);
    const char* cA = S.a_base(cur); const char* cB = S.b_base(cur);
    PG8_STAGE(PG8_SB(0, 0), cB, voffB); PG8_STAGE(PG8_SB(0, 1), cB + hstep, voffB); PG8_STAGE(PG8_SA(0, 0), cA, oA[0]); PG8_STAGE(PG8_SA(0, 1), cA, oA[1]);
    if (wr == 1) PG8_BAR;
    PG8_WAIT_V(2); PG8_BAR;
    PG8_STAGE(PG8_SB(1, 0), cB + kstep, voffB); PG8_STAGE(PG8_SA(1, 0), cA + kstep, oA[0]); PG8_STAGE(PG8_SB(1, 1), cB + hstep + kstep, voffB);
    PG8_WAIT_V(6); PG8_BAR;
    for (;;) {
        const bool has_next = S.next(ui + 1, nxt);
        const char* nA = has_next ? S.a_base(nxt) : cA; const char* nB = has_next ? S.b_base(nxt) : cB;
        for (int t = 0; t < nt; t += 2) {
            const bool last = (t == nt - 2);
            const char* a1 = cA + (size_t)(t + 1) * kstep;
            const char* a2 = last ? nA : cA + (size_t)(t + 2) * kstep; const char* b2 = last ? nB : cB + (size_t)(t + 2) * kstep;
            const char* a3 = a2 + kstep; const char* b3 = b2 + kstep;
            PG8_LDB(B0, 0, 0); PG8_LDB(B1, 0, 1); PG8_SCHED; PG8_LDA(At, 0, 0); PG8_STAGE(PG8_SA(1, 1), a1, oA[1]);
            if (last && has_next) S.a_off(nxt, tid, oA);
            PG8_WAIT_V(8); PG8_WAIT_L(0); PG8_BAR; PG8_MMA(0, 0, At, B0); PG8_MMA(0, 1, At, B1); PG8_BAR; PG8_SCHED;
            PG8_LDA(At, 0, 1); PG8_STAGE(PG8_SB(0, 0), b2, voffB); PG8_STAGE(PG8_SB(0, 1), b2 + hstep, voffB); PG8_STAGE(PG8_SA(0, 0), a2, oA[0]);
            PG8_WAIT_V(8); PG8_WAIT_L(0); PG8_BAR; PG8_MMA(1, 0, At, B0); PG8_MMA(1, 1, At, B1); PG8_BAR; PG8_SCHED;
            PG8_LDB(B0, 1, 0); PG8_LDB(B1, 1, 1); PG8_SCHED; PG8_LDA(At, 1, 0); PG8_STAGE(PG8_SA(0, 1), a2, oA[1]);
            PG8_WAIT_V(8); PG8_WAIT_L(0); PG8_BAR; PG8_MMA(0, 0, At, B0); PG8_MMA(0, 1, At, B1); PG8_BAR; PG8_SCHED;
            PG8_LDA(At, 1, 1); PG8_STAGE(PG8_SB(1, 0), b3, voffB); PG8_STAGE(PG8_SB(1, 1), b3 + hstep, voffB); PG8_STAGE(PG8_SA(1, 0), a3, oA[0]);
            PG8_WAIT_V(8); PG8_WAIT_L(0); PG8_BAR; PG8_MMA(1, 0, At, B0); PG8_MMA(1, 1, At, B1); PG8_BAR; PG8_SCHED;
        }
        if (wr == 0) PG8_BAR;
        E(acc, cur, wr, wc, fr, fq);
        if (!has_next) break;
#pragma unroll
        for (int a = 0; a < 2; ++a)
#pragma unroll
            for (int b = 0; b < 2; ++b)
#pragma unroll
                for (int m = 0; m < 4; ++m)
#pragma unroll
                    for (int n = 0; n < 2; ++n) acc[a][b][m][n] = (f32x4){0.f, 0.f, 0.f, 0.f};
        cur = nxt; cA = nA; cB = nB; ++ui;
        if (wr == 1) PG8_BAR;
    }
    PG8_WAIT_V(0);
    PG8_BAR;
#undef PG8_SA
#undef PG8_SB
#undef PG8_STAGE
#undef PG8_LDA
#undef PG8_LDB
#undef PG8_MMA
#undef PG8_WAIT_V
#undef PG8_WAIT_L
#undef PG8_BAR
#undef PG8_SCHED
}
}
using pg8::Unit;

DI u32x4 pack8(const f32x4& v0, const f32x4& v1) { u32x4 w; w.x = cvt_pk_bf16(v0[0], v0[1]); w.y = cvt_pk_bf16(v0[2], v0[3]); w.z = cvt_pk_bf16(v1[0], v1[1]); w.w = cvt_pk_bf16(v1[2], v1[3]); return w; }

struct EpiIn {
    static constexpr bool PERM = true;
    bf16_t *qg, *kg, *vg, *sr, *qd, *kd, *vd, *gt; float* ha; const int* pos;
    DI void operator()(const f32x4 (&acc)[2][2][4][2], const Unit& u, int wr, int wc, int fr, int fq) const {
        const int row0 = u.pm * 256 + wr * 64 + fr; const int pn = u.pn;
        if (pn >= 12 && pn < 24) {
            bf16_t* base = pn < 18 ? qd : kd; const int tq = pn < 18 ? pn - 12 : pn - 18; const float sc = pn < 18 ? 0.125f * LOG2E : 1.0f;
            float fre[8];
#pragma unroll
            for (int i = 0; i < 8; ++i) fre[i] = __builtin_amdgcn_exp2f(-(float)(8 * fq + i) * (13.287712379549449f / 32.0f)) * 0.15915494309189535f;
#pragma unroll
            for (int ai = 0; ai < 2; ++ai)
#pragma unroll
                for (int m = 0; m < 4; ++m) {
                    const int r = row0 + ai * 128 + m * 16; const float p = (float)pos[r];
                    bf16_t* rowp = base + (size_t)r * 1536 + (4 * tq + wc) * 64 + 8 * fq;
#pragma unroll
                    for (int n = 0; n < 2; ++n) { f32x4 o1, o2;
#pragma unroll
                        for (int j = 0; j < 4; ++j) {
                            float a = p * fre[n * 4 + j]; a = a - __builtin_floorf(a);
                            const float sn = __builtin_amdgcn_sinf(a), cs = __builtin_amdgcn_cosf(a);
                            const float x1 = acc[ai][0][m][n][j], x2 = acc[ai][1][m][n][j];
                            o1[j] = (x1 * cs - x2 * sn) * sc; o2[j] = (x2 * cs + x1 * sn) * sc;
                        }
                        u32x2 w1, w2; w1.x = cvt_pk_bf16(o1[0], o1[1]); w1.y = cvt_pk_bf16(o1[2], o1[3]); w2.x = cvt_pk_bf16(o2[0], o2[1]); w2.y = cvt_pk_bf16(o2[2], o2[3]);
                        *(u32x2*)(rowp + 4 * n) = w1; *(u32x2*)(rowp + 32 + 4 * n) = w2; }
                    asm volatile("" ::: "memory");
                }
        } else if (pn == 38) {
            if (wc == 0 && fq < 2) {
#pragma unroll
                for (int ai = 0; ai < 2; ++ai)
#pragma unroll
                    for (int m = 0; m < 4; ++m) { float* p = ha + (size_t)(row0 + ai * 128 + m * 16) * 16 + 8 * fq; *(f32x4*)p = acc[ai][0][m][0]; *(f32x4*)(p + 4) = acc[ai][0][m][1]; }
            }
        } else {
            bf16_t* base; int ldc, colt, act = 0; float sc = 1.0f;
            if (pn < 2) { base = qg; ldc = 512; colt = pn * 256; sc = 0.08838834764831845f; }
            else if (pn < 4) { base = kg; ldc = 512; colt = (pn - 2) * 256; }
            else if (pn < 8) { base = vg; ldc = 1024; colt = (pn - 4) * 256; }
            else if (pn < 12) { base = sr; ldc = 1024; colt = (pn - 8) * 256; act = 1; }
            else if (pn < 30) { base = vd; ldc = 1536; colt = (pn - 24) * 256; }
            else { base = gt; ldc = 2048; colt = (pn - 30) * 256; act = 2; }
#pragma unroll
            for (int ai = 0; ai < 2; ++ai)
#pragma unroll
                for (int m = 0; m < 4; ++m) { bf16_t* rowp = base + (size_t)(row0 + ai * 128 + m * 16) * ldc + colt + wc * 32 + 8 * fq;
#pragma unroll
                    for (int bj = 0; bj < 2; ++bj) { f32x4 v0 = acc[ai][bj][m][0] * sc, v1 = acc[ai][bj][m][1] * sc;
                        if (act) {
#pragma unroll
                            for (int j = 0; j < 4; ++j) { const float s0 = sigmoidf_(v0[j]), s1 = sigmoidf_(v1[j]); v0[j] = act == 1 ? v0[j] * s0 : s0; v1[j] = act == 1 ? v1[j] * s1 : s1; } }
                        *(u32x4*)(rowp + bj * 128) = pack8(v0, v1); } }
        }
    }
};
template <bool ADD> struct EpiGate {
    static constexpr bool PERM = true;
    bf16_t* mix; const bf16_t* gt;
    DI void operator()(const f32x4 (&acc)[2][2][4][2], const Unit& u, int wr, int wc, int fr, int fq) const {
        const int row0 = u.pm * 256 + wr * 64 + fr, col0 = u.pn * 256 + wc * 32 + 8 * fq;
#pragma unroll
        for (int ai = 0; ai < 2; ++ai)
#pragma unroll
            for (int m = 0; m < 4; ++m) { const size_t r = (size_t)(row0 + ai * 128 + m * 16);
#pragma unroll
                for (int bj = 0; bj < 2; ++bj) {
                    const u32x4 g = *(const u32x4*)(gt + r * 2048 + col0 + bj * 128);
                    f32x4 v0 = acc[ai][bj][m][0], v1 = acc[ai][bj][m][1];
                    v0[0] *= bf_lo(g.x); v0[1] *= bf_hi(g.x); v0[2] *= bf_lo(g.y); v0[3] *= bf_hi(g.y); v1[0] *= bf_lo(g.z); v1[1] *= bf_hi(g.z); v1[2] *= bf_lo(g.w); v1[3] *= bf_hi(g.w);
                    bf16_t* mp = mix + r * 1024 + col0 + bj * 128;
                    if (ADD) { const u32x4 o = *(const u32x4*)mp; v0[0] += bf_lo(o.x); v0[1] += bf_hi(o.x); v0[2] += bf_lo(o.y); v0[3] += bf_hi(o.y); v1[0] += bf_lo(o.z); v1[1] += bf_hi(o.z); v1[2] += bf_lo(o.w); v1[3] += bf_hi(o.w); }
                    *(u32x4*)mp = pack8(v0, v1); } }
    }
};
struct EpiRes {
    static constexpr bool PERM = false;
    const float* xres; float* z;
    DI void operator()(const f32x4 (&acc)[2][2][4][2], const Unit& u, int wr, int wc, int fr, int fq) const {
        const int row0 = u.pm * 256 + wr * 64 + fr, col0 = u.pn * 256 + wc * 32 + 4 * fq;
#pragma unroll
        for (int ai = 0; ai < 2; ++ai)
#pragma unroll
            for (int m = 0; m < 4; ++m) { const size_t off = (size_t)(row0 + ai * 128 + m * 16) * 1024 + col0;
#pragma unroll
                for (int bj = 0; bj < 2; ++bj)
#pragma unroll
                    for (int n = 0; n < 2; ++n) { const f32x4 xr = *(const f32x4*)(xres + off + bj * 128 + n * 16); *(f32x4*)(z + off + bj * 128 + n * 16) = xr * DN_ALPHA + acc[ai][bj][m][n]; }
                asm volatile("" ::: "memory"); }
    }
};
struct EpiM1 {
    static constexpr bool PERM = true;
    bf16_t* hm;
    DI void operator()(const f32x4 (&acc)[2][2][4][2], const Unit& u, int wr, int wc, int fr, int fq) const {
        const int row0 = u.pm * 256 + wr * 64 + fr, col0 = u.pn * 128 + wc * 32 + 8 * fq;
#pragma unroll
        for (int ai = 0; ai < 2; ++ai)
#pragma unroll
            for (int m = 0; m < 4; ++m) { f32x4 v0, v1;
#pragma unroll
                for (int j = 0; j < 4; ++j) { const float g0 = acc[ai][0][m][0][j], g1 = acc[ai][0][m][1][j]; v0[j] = g0 * sigmoidf_(g0) * acc[ai][1][m][0][j]; v1[j] = g1 * sigmoidf_(g1) * acc[ai][1][m][1][j]; }
                *(u32x4*)(hm + (size_t)(row0 + ai * 128 + m * 16) * 1024 + col0) = pack8(v0, v1); }
    }
};
struct EpiM2 {
    static constexpr bool PERM = true;
    bf16_t* ys; const int* list; const volatile LAS int* pre;
    DI void operator()(const f32x4 (&acc)[2][2][4][2], const Unit& u, int wr, int wc, int fr, int fq) const {
        const int lrow0 = wr * 64 + fr, col0 = u.pn * 256 + wc * 32 + 8 * fq; const int lt = u.pm - rfl(pre[u.e]);
        const int* lp = list + (size_t)u.e * T + 256 * lt;
#pragma unroll
        for (int ai = 0; ai < 2; ++ai)
#pragma unroll
            for (int m = 0; m < 4; ++m) { const int r = lrow0 + ai * 128 + m * 16;
                if (r < u.nv) { const int slot = lp[r]; bf16_t* yp = ys + (size_t)slot * 1024 + col0;
#pragma unroll
                    for (int bj = 0; bj < 2; ++bj) *(u32x4*)(yp + bj * 128) = pack8(acc[ai][bj][m][0], acc[ai][bj][m][1]); } }
    }
};

DI void tr_item(const float* W, int N, bf16_t* WT, int K, int drow, int c0, int nvalid, int kb, LAS float* scr, int lane) {
    const int k0 = 64 * kb;
    { const int cc = lane & 31, ccl = cc < nvalid ? cc : 0; const float* wp = W + (size_t)(k0 + (lane >> 5)) * N + c0 + ccl; float v[32];
#pragma unroll
      for (int i = 0; i < 32; ++i) v[i] = wp[(size_t)(2 * i) * N];
#pragma unroll
      for (int i = 0; i < 32; ++i) scr[(2 * i + (lane >> 5)) * 33 + cc] = (cc < nvalid) ? v[i] : 0.f; }
    LDS_WAIT(); asm volatile("" ::: "memory");
    const int c = lane & 7;
#pragma unroll
    for (int j = 0; j < 4; ++j) { const int n = (lane >> 3) + 8 * j; const LAS float* s = scr + (8 * c) * 33 + n;
        u32x4 o; o.x = cvt_pk_bf16(s[0 * 33], s[1 * 33]); o.y = cvt_pk_bf16(s[2 * 33], s[3 * 33]); o.z = cvt_pk_bf16(s[4 * 33], s[5 * 33]); o.w = cvt_pk_bf16(s[6 * 33], s[7 * 33]);
        *(u32x4*)(WT + (size_t)(drow + n) * K + k0 + 8 * c) = o; }
    LDS_WAIT(); asm volatile("" ::: "memory");
}
DI void phase_w(LAS unsigned char* lds, const Ctx& c, int l, int G) {
    const int tid = ltid(), lane = tid & 63, wave = rfl(tid >> 6);
    LAS float* scr = (LAS float*)(lds + wave * 16384);
    const int gw = lbid() * NWAVES + wave, NGW = G * NWAVES;
    constexpr int I_IN = (NIN / 32) * 16, I_GO = 512, I_AO = 256, I_OUT = 512, I_EXP = 16 * 512;
    constexpr int NITEMS = I_IN + I_GO + I_AO + I_OUT + 3 * I_EXP;
    for (int it = gw; it < NITEMS; it += NGW) {
        int r = it;
        if (r < I_IN) {
            const int nbg = r >> 4, kb = r & 15, n0 = 32 * nbg, tile = n0 >> 8, p = n0 & 255; int c0, nv = 32;
            if (tile < 12) c0 = n0;
            else if (tile < 24) { const int base = tile < 18 ? 3088 : 4624, tq = tile < 18 ? tile - 12 : tile - 18; c0 = base + (4 * tq + ((p & 127) >> 5)) * 64 + (p >= 128 ? 32 : 0); }
            else if (tile < 30) c0 = 6160 + (n0 - 24 * 256);
            else if (tile < 38) c0 = 7696 + (n0 - 30 * 256);
            else { c0 = 3072; nv = (p == 0) ? 16 : 0; }
            tr_item(c.w_in + (size_t)l * D * DIN, DIN, wsb(c, WS_WIN), D, n0, c0, nv, kb, scr, lane); continue; }
        r -= I_IN;
        if (r < I_GO) { tr_item(c.w_gla_o + (size_t)l * D * D, D, wsb(c, WS_WGO), D, 32 * (r >> 4), 32 * (r >> 4), 32, r & 15, scr, lane); continue; }
        r -= I_GO;
        if (r < I_AO) { tr_item(c.w_att_o + (size_t)l * 512 * D, D, wsb(c, WS_WAO), 512, 32 * (r >> 3), 32 * (r >> 3), 32, r & 7, scr, lane); continue; }
        r -= I_AO;
        if (r < I_OUT) { tr_item(c.w_out + (size_t)l * D * D, D, wsb(c, WS_WOUT), D, 32 * (r >> 4), 32 * (r >> 4), 32, r & 15, scr, lane); continue; }
        r -= I_OUT;
        const int which = r / I_EXP; r -= which * I_EXP; const int e = r >> 9, q = r & 511, nbg = q >> 4, kb = q & 15;
        const size_t eoff = (size_t)(l * NEXP + e) * D * DFF;
        if (which == 0) tr_item(c.w_e_gate + eoff, DFF, wsb(c, WS_WGU) + (size_t)e * 2048 * 1024, D, 256 * (nbg >> 2) + 32 * (nbg & 3), 32 * nbg, 32, kb, scr, lane);
        else if (which == 1) tr_item(c.w_e_up + eoff, DFF, wsb(c, WS_WGU) + (size_t)e * 2048 * 1024, D, 256 * (nbg >> 2) + 128 + 32 * (nbg & 3), 32 * nbg, 32, kb, scr, lane);
        else tr_item(c.w_e_down + eoff, D, wsb(c, WS_WD) + (size_t)e * 1024 * 1024, DFF, 32 * nbg, 32 * nbg, 32, kb, scr, lane);
    }
    if (l == 0) {
        const size_t n8 = (size_t)T * D / 8; bf16_t* xb = wsb(c, WS_XB);
        for (size_t i = (size_t)lbid() * NTHREADS + tid; i < n8; i += (size_t)G * NTHREADS) { const f32x4 a = *(const f32x4*)(c.x + i * 8), b = *(const f32x4*)(c.x + i * 8 + 4); *(u32x4*)(xb + i * 8) = pack8(a, b); }
    }
}

DI s16x4 tr16(const LAS void* p) { return __builtin_bit_cast(s16x4, __builtin_amdgcn_ds_read_tr16_b64_v4i16((LAS s16x4*)p)); }
DI bf16x8 cat8(s16x4 lo, s16x4 hi) { return __builtin_shufflevector(lo, hi, 0, 1, 2, 3, 4, 5, 6, 7); }
#define MFMA16(a, b, c) __builtin_amdgcn_mfma_f32_16x16x32_bf16((a), (b), (c), 0, 0, 0)

constexpr int REC_BYTES = 33792, REC_KS = 16384, REC_DEC = 32768, OI_BYTES = 32768;
constexpr int GP_QT = 0, GP_KT = 17408, GP_VS = 34816, GP_ATT = 68608, GP_WUP = 77824, GP_BAL = 86016;
DI float exp_(float x) { return __builtin_amdgcn_exp2f(x * LOG2E); }
DI void unpack8(const u32x4& q, float (&v)[16], int o) { v[o] = bf_lo(q.x); v[o + 1] = bf_hi(q.x); v[o + 2] = bf_lo(q.y); v[o + 3] = bf_hi(q.y); v[o + 4] = bf_lo(q.z); v[o + 5] = bf_hi(q.z); v[o + 6] = bf_lo(q.w); v[o + 7] = bf_hi(q.w); }
DI u32x4 packf8(const float (&v)[16], int o) { u32x4 p; p.x = cvt_pk_bf16(v[o], v[o + 1]); p.y = cvt_pk_bf16(v[o + 2], v[o + 3]); p.z = cvt_pk_bf16(v[o + 4], v[o + 5]); p.w = cvt_pk_bf16(v[o + 6], v[o + 7]); return p; }
DI void gla_p_unit(LAS unsigned char* lds, const Ctx& c, int l, int bl, int h, int n, int& h_loaded) {
    const int tid = ltid(), lane = tid & 63, w = rfl(tid >> 6), fr = lane & 15, fq = lane >> 4;
    const size_t tok0 = (size_t)bl * SEQ + n * 64;
    const bf16_t* QG = wsb(c, WS_H + H_QG) + tok0 * 512 + h * 128;
    const bf16_t* KG = wsb(c, WS_H + H_KG) + tok0 * 512 + h * 128;
    const bf16_t* VG = wsb(c, WS_H + H_VG) + tok0 * 1024 + h * 256;
    const float* HA = (const float*)(c.ws + WS_HA) + tok0 * 16;
    const int unit = (bl * 4 + h) * 64 + n;
    unsigned char* rec = c.ws + WS_REC + (size_t)unit * REC_BYTES;
    unsigned char* oi = c.ws + WS_MIX + (size_t)unit * OI_BYTES;
    LAS bf16_t* QT = (LAS bf16_t*)(lds + GP_QT); LAS bf16_t* KT = (LAS bf16_t*)(lds + GP_KT); LAS bf16_t* VS = (LAS bf16_t*)(lds + GP_VS); LAS bf16_t* AT = (LAS bf16_t*)(lds + GP_ATT);
    LAS float* WUP = (LAS float*)(lds + GP_WUP); LAS float* BAL = (LAS float*)(lds + GP_BAL);
    __syncthreads();
    if (h_loaded != h) { for (int i = tid; i < 16 * 128; i += NTHREADS) WUP[i] = c.w_alpha_up[(size_t)l * 16 * 512 + (i >> 7) * 512 + h * 128 + (i & 127)];
        if (tid < 128) BAL[tid] = c.b_alpha[l * 512 + h * 128 + tid]; h_loaded = h; __syncthreads(); }
    {
        const int row = lane;
        f32x4 a4[4];
#pragma unroll
        for (int j = 0; j < 4; ++j) a4[j] = *(const f32x4*)(HA + (size_t)row * 16 + 4 * j);
        const u32x4 q0 = *(const u32x4*)(QG + (size_t)row * 512 + 16 * w), q1 = *(const u32x4*)(QG + (size_t)row * 512 + 16 * w + 8);
        const u32x4 k0 = *(const u32x4*)(KG + (size_t)row * 512 + 16 * w), k1 = *(const u32x4*)(KG + (size_t)row * 512 + 16 * w + 8);
#pragma unroll
        for (int c2 = 0; c2 < 4; ++c2) { const int idx = tid + NTHREADS * c2, r = idx >> 5, ch = idx & 31; *(LAS u32x4*)(VS + r * 264 + ch * 8) = *(const u32x4*)(VG + (size_t)r * 1024 + ch * 8); }
        float la[16];
#pragma unroll
        for (int cc = 0; cc < 16; ++cc) la[cc] = BAL[16 * w + cc];
#pragma unroll
        for (int j = 0; j < 16; ++j) { const float aj = a4[j >> 2][j & 3];
#pragma unroll
            for (int c4 = 0; c4 < 4; ++c4) { const f32x4 wv = *(const LAS f32x4*)(WUP + j * 128 + 16 * w + 4 * c4); la[4 * c4] += aj * wv[0]; la[4 * c4 + 1] += aj * wv[1]; la[4 * c4 + 2] += aj * wv[2]; la[4 * c4 + 3] += aj * wv[3]; } }
#pragma unroll
        for (int cc = 0; cc < 16; ++cc) { const float z = la[cc]; la[cc] = -(fmaxf(-z, 0.f) + __builtin_amdgcn_logf(1.0f + exp_(-fabsf(z))) * 0.6931471805599453f) * (1.0f / 16.0f); }
#pragma unroll
        for (int dlt = 1; dlt < 64; dlt <<= 1)
#pragma unroll
            for (int cc = 0; cc < 16; ++cc) { const float t = __shfl_up(la[cc], dlt); if (lane >= dlt) la[cc] += t; }
        float qv[16], kv[16];
        unpack8(q0, qv, 0); unpack8(q1, qv, 8); unpack8(k0, kv, 0); unpack8(k1, kv, 8);
        float dc[16];
#pragma unroll
        for (int cc = 0; cc < 16; ++cc) { const float b = la[cc]; const float bend = __shfl(b, 63); const float eb = exp_(b); dc[cc] = eb; qv[cc] *= eb; la[cc] = kv[cc] * exp_(bend - b); kv[cc] *= exp_(-b); }
        if (lane == 63) {
#pragma unroll
            for (int c4 = 0; c4 < 4; ++c4) *(f32x4*)(rec + REC_DEC + (16 * w + 4 * c4) * 4) = (f32x4){dc[4 * c4], dc[4 * c4 + 1], dc[4 * c4 + 2], dc[4 * c4 + 3]}; }
        const u32x4 qa = packf8(qv, 0), qb = packf8(qv, 8), ka = packf8(kv, 0), kb = packf8(kv, 8), sa = packf8(la, 0), sb = packf8(la, 8);
        *(LAS u32x4*)(QT + row * 136 + 16 * w) = qa; *(LAS u32x4*)(QT + row * 136 + 16 * w + 8) = qb;
        *(LAS u32x4*)(KT + row * 136 + 16 * w) = ka; *(LAS u32x4*)(KT + row * 136 + 16 * w + 8) = kb;
        *(u32x4*)(rec + row * 256 + (((2 * w) ^ (row & 15)) << 4)) = qa; *(u32x4*)(rec + row * 256 + (((2 * w + 1) ^ (row & 15)) << 4)) = qb;
        *(u32x4*)(rec + REC_KS + row * 256 + (((2 * w) ^ (2 * (row & 7))) << 4)) = sa; *(u32x4*)(rec + REC_KS + row * 256 + (((2 * w + 1) ^ (2 * (row & 7))) << 4)) = sb;
    }
    __syncthreads();
#pragma unroll
    for (int rep = 0; rep < 2; ++rep) {
        const int tt = w + 8 * rep, jt = tt >> 2, it = tt & 3;
        f32x4 a = (f32x4){0.f, 0.f, 0.f, 0.f};
        if (jt <= it) {
#pragma unroll
            for (int k4 = 0; k4 < 4; ++k4) { const bf16x8 af = *(const LAS bf16x8*)(KT + (16 * jt + fr) * 136 + 32 * k4 + 8 * fq), bfr = *(const LAS bf16x8*)(QT + (16 * it + fr) * 136 + 32 * k4 + 8 * fq); a = MFMA16(af, bfr, a); }
        }
        const int i = 16 * it + fr, j0 = 16 * jt + 4 * fq;
        u32x2 o; o.x = cvt_pk_bf16(j0 <= i ? a[0] : 0.f, j0 + 1 <= i ? a[1] : 0.f); o.y = cvt_pk_bf16(j0 + 2 <= i ? a[2] : 0.f, j0 + 3 <= i ? a[3] : 0.f);
        *(LAS u32x2*)(AT + i * 72 + j0) = o;
    }
    __syncthreads();
    {
        const int dv0 = 32 * w;
        bf16x8 vb[2][2];
#pragma unroll
        for (int k2 = 0; k2 < 2; ++k2)
#pragma unroll
            for (int dt = 0; dt < 2; ++dt) { const LAS bf16_t* p = VS + (32 * k2 + 8 * fq + (fr >> 2)) * 264 + dv0 + 16 * dt + (fr & 3) * 4; vb[k2][dt] = cat8(tr16(p), tr16(p + 4 * 264)); }
#pragma unroll
        for (int tt = 0; tt < 4; ++tt) {
            const bf16x8 a0 = *(const LAS bf16x8*)(AT + (16 * tt + fr) * 72 + 8 * fq), a1 = *(const LAS bf16x8*)(AT + (16 * tt + fr) * 72 + 32 + 8 * fq);
#pragma unroll
            for (int dt = 0; dt < 2; ++dt) { f32x4 z = (f32x4){0.f, 0.f, 0.f, 0.f}; z = MFMA16(a0, vb[0][dt], z); z = MFMA16(a1, vb[1][dt], z);
                u32x2 pk; pk.x = cvt_pk_bf16(z[0], z[1]); pk.y = cvt_pk_bf16(z[2], z[3]); *(u32x2*)(oi + ((w * 8 + tt * 2 + dt) * 64 + lane) * 8) = pk; }
        }
    }
}
constexpr int GS_STAGE = 66560, GS_KS = 16384, GS_DEC = 32768, GS_VS = 33792, GS_SS = 2 * GS_STAGE;
DI void gla_s_chain(LAS unsigned char* lds, const Ctx& c, int l, int bl, int h) {
    const int tid = ltid(), lane = tid & 63, w = rfl(tid >> 6), fr = lane & 15, fq = lane >> 4;
    const bf16_t* VG = wsb(c, WS_H + H_VG) + (size_t)bl * SEQ * 1024 + h * 256;
    const bf16_t* SR = wsb(c, WS_H + H_SR) + (size_t)bl * SEQ * 1024 + h * 256;
    bf16_t* OG = wsb(c, WS_OG) + (size_t)bl * SEQ * 1024 + h * 256;
    const unsigned char* rec0 = c.ws + WS_REC + (size_t)((bl * 4 + h) * 64) * REC_BYTES;
    const unsigned char* oi0 = c.ws + WS_MIX + (size_t)((bl * 4 + h) * 64) * OI_BYTES;
    LAS float* SS = (LAS float*)(lds + GS_SS);
    const int dv0 = 32 * w;
    const float gn0 = c.gla_norm[l * 1024 + h * 256 + dv0 + fr], gn1 = c.gla_norm[l * 1024 + h * 256 + dv0 + 16 + fr];
    f32x4 S[8][2];
#pragma unroll
    for (int a = 0; a < 8; ++a) { S[a][0] = (f32x4){0.f, 0.f, 0.f, 0.f}; S[a][1] = (f32x4){0.f, 0.f, 0.f, 0.f}; }
#define GS_PREFETCH(nn, st) do { const unsigned char* _r = rec0 + (size_t)(nn) * REC_BYTES; LAS unsigned char* _s = lds + (st) * GS_STAGE; \
        _Pragma("unroll") for (int _p = 0; _p < 4; ++_p) __builtin_amdgcn_global_load_lds((const unsigned*)(_r + (w * 4 + _p) * 1024 + lane * 16), (LAS unsigned*)(_s + (w * 4 + _p) * 1024), 16, 0, 0); \
        if (w == 0) __builtin_amdgcn_global_load_lds((const unsigned*)(_r + 32768 + lane * 16), (LAS unsigned*)(_s + 32768), 16, 0, 0); \
        _Pragma("unroll") for (int _p = 0; _p < 4; ++_p) { const int _row = 2 * (w * 4 + _p) + (lane >> 5); \
            __builtin_amdgcn_global_load_lds((const unsigned*)(VG + (size_t)((nn) * 64 + _row) * 1024 + (((lane & 31) ^ (2 * (_row & 3))) << 3)), (LAS unsigned*)(_s + GS_VS + (w * 4 + _p) * 1024), 16, 0, 0); } } while (0)
    __syncthreads();
    GS_PREFETCH(0, 0);
    for (int n = 0; n < 64; ++n) {
        const int st = n & 1; LAS unsigned char* sb_ = lds + st * GS_STAGE;
        LAS bf16_t* QT = (LAS bf16_t*)sb_; LAS bf16_t* KS = (LAS bf16_t*)(sb_ + GS_KS); LAS float* DEC = (LAS float*)(sb_ + GS_DEC); LAS bf16_t* VS = (LAS bf16_t*)(sb_ + GS_VS); LAS bf16_t* OST = (LAS bf16_t*)(sb_ + GS_KS);
        VM_WAIT(); __syncthreads();
        u32x2 oiv[8];
#pragma unroll
        for (int q = 0; q < 8; ++q) oiv[q] = *(const u32x2*)(oi0 + (size_t)n * OI_BYTES + ((w * 8 + q) * 64 + lane) * 8);
        u32x4 srv[4];
#pragma unroll
        for (int c2 = 0; c2 < 4; ++c2) { const int idx = tid + NTHREADS * c2, r = idx >> 5, ch = idx & 31; srv[c2] = *(const u32x4*)(SR + (size_t)(n * 64 + r) * 1024 + ch * 8); }
        asm volatile("" ::: "memory");
        if (n + 1 < 64) GS_PREFETCH(n + 1, st ^ 1);
        f32x4 o[4][2];
        {
            bf16x8 vb[2][2];
#pragma unroll
            for (int k2 = 0; k2 < 2; ++k2)
#pragma unroll
                for (int dt = 0; dt < 2; ++dt) { const int r0 = 32 * k2 + 8 * fq + (fr >> 2);
                    const LAS bf16_t* p = VS + r0 * 256 + ((((dv0 + 16 * dt) >> 3) ^ (2 * (r0 & 3))) << 3) + (fr & 3) * 4; vb[k2][dt] = cat8(tr16(p), tr16(p + 4 * 256)); }
#pragma unroll
            for (int tt = 0; tt < 4; ++tt) { o[tt][0] = (f32x4){0.f, 0.f, 0.f, 0.f}; o[tt][1] = (f32x4){0.f, 0.f, 0.f, 0.f}; }
#pragma unroll
            for (int s = 0; s < 4; ++s) {
                bf16x8 sb[2];
#pragma unroll
                for (int dt = 0; dt < 2; ++dt) { u32x4 pk; pk.x = cvt_pk_bf16(S[2 * s][dt][0], S[2 * s][dt][1]); pk.y = cvt_pk_bf16(S[2 * s][dt][2], S[2 * s][dt][3]); pk.z = cvt_pk_bf16(S[2 * s + 1][dt][0], S[2 * s + 1][dt][1]); pk.w = cvt_pk_bf16(S[2 * s + 1][dt][2], S[2 * s + 1][dt][3]); sb[dt] = __builtin_bit_cast(bf16x8, pk); }
#pragma unroll
                for (int tt = 0; tt < 4; ++tt) { const int i = 16 * tt + fr;
                    const LAS bf16_t* qp = QT + i * 128 + (fq & 1) * 4;
                    const bf16x8 af = cat8(*(const LAS s16x4*)(qp + (((4 * s + (fq >> 1)) ^ (i & 15)) << 3)), *(const LAS s16x4*)(qp + (((4 * s + 2 + (fq >> 1)) ^ (i & 15)) << 3)));
                    o[tt][0] = MFMA16(af, sb[0], o[tt][0]); o[tt][1] = MFMA16(af, sb[1], o[tt][1]); }
            }
#pragma unroll
            for (int k8 = 0; k8 < 8; ++k8) {
                const f32x4 dc = *(const LAS f32x4*)(DEC + 16 * k8 + 4 * fq);
                S[k8][0] *= dc; S[k8][1] *= dc;
#pragma unroll
                for (int k2 = 0; k2 < 2; ++k2) { const int r0 = 32 * k2 + 8 * fq + (fr >> 2);
                    const LAS bf16_t* p0 = KS + r0 * 128 + (((2 * k8) ^ (2 * (r0 & 7))) << 3) + (fr & 3) * 4; const LAS bf16_t* p1 = KS + (r0 + 4) * 128 + (((2 * k8) ^ (2 * ((r0 + 4) & 7))) << 3) + (fr & 3) * 4;
                    const bf16x8 af = cat8(tr16(p0), tr16(p1));
                    S[k8][0] = MFMA16(af, vb[k2][0], S[k8][0]); S[k8][1] = MFMA16(af, vb[k2][1], S[k8][1]); }
            }
        }
#pragma unroll
        for (int tt = 0; tt < 4; ++tt)
#pragma unroll
            for (int dt = 0; dt < 2; ++dt) { const u32x2 v = oiv[tt * 2 + dt]; o[tt][dt][0] += bf_lo(v.x); o[tt][dt][1] += bf_hi(v.x); o[tt][dt][2] += bf_lo(v.y); o[tt][dt][3] += bf_hi(v.y); }
#pragma unroll
        for (int tt = 0; tt < 4; ++tt) { f32x4 pp;
#pragma unroll
            for (int rg = 0; rg < 4; ++rg) { float p = o[tt][0][rg] * o[tt][0][rg] + o[tt][1][rg] * o[tt][1][rg];
                p += __shfl_xor(p, 1); p += __shfl_xor(p, 2); p += __shfl_xor(p, 4); p += __shfl_xor(p, 8); pp[rg] = p; }
            if (fr == 0) *(LAS f32x4*)(SS + w * 64 + 16 * tt + 4 * fq) = pp; }
        __syncthreads();
#pragma unroll
        for (int tt = 0; tt < 4; ++tt) { f32x4 ss = *(const LAS f32x4*)(SS + 16 * tt + 4 * fq);
#pragma unroll
            for (int ww = 1; ww < 8; ++ww) ss += *(const LAS f32x4*)(SS + ww * 64 + 16 * tt + 4 * fq);
#pragma unroll
            for (int rg = 0; rg < 4; ++rg) { const float rs = __builtin_amdgcn_rsqf(ss[rg] * (1.0f / 256.0f) + RMS_EPS); const int i = 16 * tt + 4 * fq + rg;
                OST[i * 264 + dv0 + fr] = (bf16_t)(cvt_pk_bf16(o[tt][0][rg] * rs * gn0, 0.f) & 0xffffu); OST[i * 264 + dv0 + 16 + fr] = (bf16_t)(cvt_pk_bf16(o[tt][1][rg] * rs * gn1, 0.f) & 0xffffu); } }
        __syncthreads();
#pragma unroll
        for (int c2 = 0; c2 < 4; ++c2) { const int idx = tid + NTHREADS * c2, r = idx >> 5, ch = idx & 31;
            const u32x4 ov = *(const LAS u32x4*)(OST + r * 264 + ch * 8); const u32x4 sv = srv[c2];
            u32x4 rr; rr.x = cvt_pk_bf16(bf_lo(ov.x) * bf_lo(sv.x), bf_hi(ov.x) * bf_hi(sv.x)); rr.y = cvt_pk_bf16(bf_lo(ov.y) * bf_lo(sv.y), bf_hi(ov.y) * bf_hi(sv.y));
            rr.z = cvt_pk_bf16(bf_lo(ov.z) * bf_lo(sv.z), bf_hi(ov.z) * bf_hi(sv.z)); rr.w = cvt_pk_bf16(bf_lo(ov.w) * bf_lo(sv.w), bf_hi(ov.w) * bf_hi(sv.w));
            *(u32x4*)(OG + (size_t)(n * 64 + r) * 1024 + ch * 8) = rr; }
    }
#undef GS_PREFETCH
    VM_WAIT(); __syncthreads();
}

constexpr int AT_K = 0, AT_V = 36864;
DI void attn_unit(LAS unsigned char* lds, const Ctx& c, int bl, int g, int h, int x) {
    const int tid = ltid(), lane = tid & 63, w = rfl(tid >> 6), fr = lane & 15, fq = lane >> 4;
    const int dl = (g == 0) ? 1 : (g == 1 ? 4 : 16), nb = 32 / dl, r = x / nb, n = x - r * nb;
    const size_t tb = (size_t)bl * SEQ + r; const int colo = g * 512 + h * 64;
    const bf16_t* Q = wsb(c, WS_H + H_QD) + colo; const bf16_t* K = wsb(c, WS_H + H_KD) + colo; const bf16_t* V = wsb(c, WS_H + H_VD) + colo;
    LAS bf16_t* Ks = (LAS bf16_t*)(lds + AT_K); LAS bf16_t* Vs = (LAS bf16_t*)(lds + AT_V);
    const size_t tokq = tb + (size_t)dl * (128 * n + 16 * w + fr);
    bf16x8 qf[2];
#pragma unroll
    for (int d0 = 0; d0 < 2; ++d0) qf[d0] = *(const bf16x8*)(Q + tokq * 1536 + 32 * d0 + 8 * fq);
    __syncthreads();
#pragma unroll
    for (int c2 = 0; c2 < 4; ++c2) { const int idx = tid + NTHREADS * c2, row = idx >> 3, ch = idx & 7; const int j = 128 * (n - 1) + row;
        u32x4 kv = (u32x4){0u, 0u, 0u, 0u}, vv = (u32x4){0u, 0u, 0u, 0u};
        if (j >= 0) { const size_t tok = tb + (size_t)dl * j; kv = *(const u32x4*)(K + tok * 1536 + ch * 8); vv = *(const u32x4*)(V + tok * 1536 + ch * 8); }
        *(LAS u32x4*)(Ks + row * 72 + ch * 8) = kv; *(LAS u32x4*)(Vs + row * 72 + ch * 8) = vv; }
    __syncthreads();
    f32x4 s[9]; float m = -1e30f;
#pragma unroll
    for (int kr = 0; kr < 9; ++kr) { const int kt = w + kr; f32x4 a = (f32x4){0.f, 0.f, 0.f, 0.f};
#pragma unroll
        for (int d0 = 0; d0 < 2; ++d0) { const bf16x8 af = *(const LAS bf16x8*)(Ks + (16 * kt + fr) * 72 + 32 * d0 + 8 * fq); a = MFMA16(af, qf[d0], a); }
#pragma unroll
        for (int rg = 0; rg < 4; ++rg) { const int rel = 16 * kr + 4 * fq + rg - fr; const bool ok = rel >= 0 && rel <= 128 && (n > 0 || 16 * kt + 4 * fq + rg >= 128); a[rg] = ok ? a[rg] : -1e30f; m = fmaxf(m, a[rg]); }
        s[kr] = a; }
    m = fmaxf(m, __shfl_xor(m, 16)); m = fmaxf(m, __shfl_xor(m, 32));
    float lsum = 0.f;
#pragma unroll
    for (int kr = 0; kr < 9; ++kr)
#pragma unroll
        for (int rg = 0; rg < 4; ++rg) { const float p = s[kr][rg] > -1e29f ? __builtin_amdgcn_exp2f(s[kr][rg] - m) : 0.f; s[kr][rg] = p; lsum += p; }
    lsum += __shfl_xor(lsum, 16); lsum += __shfl_xor(lsum, 32);
    f32x4 oT[4];
#pragma unroll
    for (int dt = 0; dt < 4; ++dt) oT[dt] = (f32x4){0.f, 0.f, 0.f, 0.f};
#pragma unroll
    for (int pp = 0; pp < 5; ++pp) { const int ka = 2 * pp, kb = (2 * pp + 1 < 9) ? 2 * pp + 1 : 8;
        u32x4 pk; pk.x = cvt_pk_bf16(s[ka][0], s[ka][1]); pk.y = cvt_pk_bf16(s[ka][2], s[ka][3]);
        if (2 * pp + 1 < 9) { pk.z = cvt_pk_bf16(s[kb][0], s[kb][1]); pk.w = cvt_pk_bf16(s[kb][2], s[kb][3]); } else { pk.z = 0u; pk.w = 0u; }
        const bf16x8 pf = __builtin_bit_cast(bf16x8, pk);
#pragma unroll
        for (int dt = 0; dt < 4; ++dt) { const LAS bf16_t* pa = Vs + (16 * (w + ka) + 4 * fq + (fr >> 2)) * 72 + 16 * dt + (fr & 3) * 4; const LAS bf16_t* pb = Vs + (16 * (w + kb) + 4 * fq + (fr >> 2)) * 72 + 16 * dt + (fr & 3) * 4;
            oT[dt] = MFMA16(cat8(tr16(pa), tr16(pb)), pf, oT[dt]); } }
    const float inv = 1.0f / lsum; const size_t tq = tb + (size_t)dl * (128 * n + 16 * w + fr);
    bf16_t* op = wsb(c, WS_ATTG) + ((size_t)g * TH + tq) * 512 + h * 64 + 4 * fq;
#pragma unroll
    for (int dt = 0; dt < 4; ++dt) { u32x2 o; o.x = cvt_pk_bf16(oT[dt][0] * inv, oT[dt][1] * inv); o.y = cvt_pk_bf16(oT[dt][2] * inv, oT[dt][3] * inv); *(u32x2*)(op + 16 * dt) = o; }
    if (fq == 0) ((float*)(c.ws + WS_LSE))[((size_t)g * TH + tq) * 8 + h] = m + __builtin_amdgcn_logf(lsum);
}
DI void phase_p(LAS unsigned char* lds, const Ctx& c, int l, int G) {
    int h_loaded = -1;
    for (int u = lbid(); u < 8 * 4 * 64; u += G) gla_p_unit(lds, c, l, u >> 8, (u >> 6) & 3, u & 63, h_loaded);
}
DI void phase_b(LAS unsigned char* lds, const Ctx& c, int l, int G) {
    const int bid = lbid(); constexpr int NGLA = 32, NATT = 8 * 3 * 8 * 32;
    if (G >= 64) {
        if (bid < NGLA) gla_s_chain(lds, c, l, bid >> 2, bid & 3);
        else { const int k = bid - NGLA, W = G - NGLA; const int u0 = (int)((long)k * NATT / W), u1 = (int)((long)(k + 1) * NATT / W);
            for (int u = u0; u < u1; ++u) attn_unit(lds, c, u / 768, (u / 256) % 3, (u >> 5) & 7, u & 31); }
    } else {
        for (int id = bid; id < NGLA; id += G) gla_s_chain(lds, c, l, id >> 2, id & 3);
        for (int u = bid; u < NATT; u += G) attn_unit(lds, c, u / 768, (u / 256) % 3, (u >> 5) & 7, u & 31);
    }
}
DI void phase_f(const Ctx& c, int G) {
    const bf16_t* ag = wsb(c, WS_ATTG); const float* lse = (const float*)(c.ws + WS_LSE); bf16_t* att = wsb(c, WS_ATT);
    for (size_t i = (size_t)lbid() * NTHREADS + ltid(); i < (size_t)TH * 64; i += (size_t)G * NTHREADS) {
        const size_t tok = i >> 6; const int ch = (int)(i & 63), h = ch >> 3;
        const float l0 = lse[tok * 8 + h], l1 = lse[((size_t)TH + tok) * 8 + h], l2 = lse[((size_t)2 * TH + tok) * 8 + h];
        const float mx = fmaxf(l0, fmaxf(l1, l2)); float w0 = __builtin_amdgcn_exp2f(l0 - mx), w1 = __builtin_amdgcn_exp2f(l1 - mx), w2 = __builtin_amdgcn_exp2f(l2 - mx);
        const float inv = 1.0f / (w0 + w1 + w2); w0 *= inv; w1 *= inv; w2 *= inv;
        const u32x4 a = *(const u32x4*)(ag + tok * 512 + ch * 8), b = *(const u32x4*)(ag + ((size_t)TH + tok) * 512 + ch * 8), d = *(const u32x4*)(ag + ((size_t)2 * TH + tok) * 512 + ch * 8);
        u32x4 o;
        o.x = cvt_pk_bf16(w0 * bf_lo(a.x) + w1 * bf_lo(b.x) + w2 * bf_lo(d.x), w0 * bf_hi(a.x) + w1 * bf_hi(b.x) + w2 * bf_hi(d.x));
        o.y = cvt_pk_bf16(w0 * bf_lo(a.y) + w1 * bf_lo(b.y) + w2 * bf_lo(d.y), w0 * bf_hi(a.y) + w1 * bf_hi(b.y) + w2 * bf_hi(d.y));
        o.z = cvt_pk_bf16(w0 * bf_lo(a.z) + w1 * bf_lo(b.z) + w2 * bf_lo(d.z), w0 * bf_hi(a.z) + w1 * bf_hi(b.z) + w2 * bf_hi(d.z));
        o.w = cvt_pk_bf16(w0 * bf_lo(a.w) + w1 * bf_lo(b.w) + w2 * bf_lo(d.w), w0 * bf_hi(a.w) + w1 * bf_hi(b.w) + w2 * bf_hi(d.w));
        *(u32x4*)(att + tok * 512 + ch * 8) = o;
    }
}

DI float wave_sum(float v) {
#pragma unroll
    for (int o = 1; o < 64; o <<= 1) v += __shfl_xor(v, o);
    return v;
}
constexpr int R_WR = 0, R_HIST = 65536, R_BASE = 65536 + 64, R_INFO = 65536 + 128;
DI void phase_r(LAS unsigned char* lds, const Ctx& c, int l, int G) {
    const int tid = ltid(), lane = tid & 63, wave = rfl(tid >> 6);
    LAS float* WR = (LAS float*)(lds + R_WR); volatile LAS int* HIST = (volatile LAS int*)(lds + R_HIST); volatile LAS int* BASE = (volatile LAS int*)(lds + R_BASE); volatile LAS int* INFO = (volatile LAS int*)(lds + R_INFO);
    __syncthreads();
    for (int i = tid; i < 16 * 1024; i += NTHREADS) WR[(i & 15) * 1024 + (i >> 4)] = c.w_router[i];
    f32x4 g4[4], b4[4];
#pragma unroll
    for (int j = 0; j < 4; ++j) { g4[j] = *(const f32x4*)(c.ln1_g + l * D + 4 * lane + 256 * j); b4[j] = *(const f32x4*)(c.ln1_b + l * D + 4 * lane + 256 * j); }
    float* xo = c.out; bf16_t* xb = wsb(c, WS_XB); int* histg = (int*)(c.ws + WS_HISTG); float* gate = (float*)(c.ws + WS_GATE);
    for (int chunk = lbid(); chunk < T / 256; chunk += G) {
        __syncthreads();
        for (int rr = 0; rr < 32; ++rr) {
            const int rl = wave * 32 + rr; const size_t row = (size_t)chunk * 256 + rl;
            f32x4 v[4]; float s = 0.f;
#pragma unroll
            for (int j = 0; j < 4; ++j) { v[j] = *(const f32x4*)(xo + row * D + 4 * lane + 256 * j); s += (v[j][0] + v[j][1]) + (v[j][2] + v[j][3]); }
            const float mean = wave_sum(s) * (1.0f / D); float s2 = 0.f;
#pragma unroll
            for (int j = 0; j < 4; ++j) { v[j] = v[j] - mean; s2 += (v[j][0] * v[j][0] + v[j][1] * v[j][1]) + (v[j][2] * v[j][2] + v[j][3] * v[j][3]); }
            const float rstd = __builtin_amdgcn_rsqf(wave_sum(s2) * (1.0f / D) + LN_EPS);
#pragma unroll
            for (int j = 0; j < 4; ++j) { v[j] = v[j] * rstd * g4[j] + b4[j]; *(f32x4*)(xo + row * D + 4 * lane + 256 * j) = v[j];
                u32x2 pk; pk.x = cvt_pk_bf16(v[j][0], v[j][1]); pk.y = cvt_pk_bf16(v[j][2], v[j][3]); *(u32x2*)(xb + row * D + 4 * lane + 256 * j) = pk; }
            float lg[16];
#pragma unroll
            for (int e = 0; e < 16; ++e) { float a = 0.f;
#pragma unroll
                for (int j = 0; j < 4; ++j) { const f32x4 wv = *(const LAS f32x4*)(WR + e * 1024 + 4 * lane + 256 * j); a += v[j][0] * wv[0] + v[j][1] * wv[1] + v[j][2] * wv[2] + v[j][3] * wv[3]; }
                lg[e] = wave_sum(a) + c.b_router[e]; }
            float mx = lg[0];
#pragma unroll
            for (int e = 1; e < 16; ++e) mx = fmaxf(mx, lg[e]);
            float se = 0.f;
#pragma unroll
            for (int e = 0; e < 16; ++e) { lg[e] = __expf(lg[e] - mx); se += lg[e]; }
            const float ise = 1.0f / se;
#pragma unroll
            for (int e = 0; e < 16; ++e) lg[e] *= ise;
            int gsel = 0; float gbest = -1.f;
#pragma unroll
            for (int gi = 0; gi < 4; ++gi) { const float a = lg[4 * gi], b = lg[4 * gi + 1], cc = lg[4 * gi + 2], d = lg[4 * gi + 3];
                const float sc = (a + b + cc + d) - fminf(fminf(a, b), fminf(cc, d)) - fminf(fmaxf(fminf(a, b), fminf(cc, d)), fminf(fmaxf(a, b), fmaxf(cc, d)));
                if (sc > gbest) { gbest = sc; gsel = gi; } }
            float p[4];
#pragma unroll
            for (int k = 0; k < 4; ++k) p[k] = gsel == 0 ? lg[k] : gsel == 1 ? lg[4 + k] : gsel == 2 ? lg[8 + k] : lg[12 + k];
            int i0 = 0; float v0 = p[0];
#pragma unroll
            for (int k = 1; k < 4; ++k) if (p[k] > v0) { v0 = p[k]; i0 = k; }
            int i1 = -1; float v1 = -1.f;
#pragma unroll
            for (int k = 0; k < 4; ++k) if (k != i0 && p[k] > v1) { v1 = p[k]; i1 = k; }
            if (lane == 0) { const int e0 = 4 * gsel + i0, e1 = 4 * gsel + i1; INFO[rl * 4 + 0] = e0; INFO[rl * 4 + 1] = e1;
                const float gs = 1.0f / (v0 + v1); gate[row * 2] = v0 * gs; gate[row * 2 + 1] = v1 * gs; }
        }
        __syncthreads();
        if (tid < 16) { int cnt = 0;
            for (int r = 0; r < 256; ++r) { if (INFO[r * 4] == tid) INFO[r * 4 + 2] = cnt++; else if (INFO[r * 4 + 1] == tid) INFO[r * 4 + 3] = cnt++; }
            histg[chunk * 16 + tid] = cnt; }
        __syncthreads();
        if (tid < 256) { int4 v; v.x = INFO[tid * 4]; v.y = INFO[tid * 4 + 1]; v.z = INFO[tid * 4 + 2]; v.w = INFO[tid * 4 + 3]; ((int4*)(c.ws + WS_INFO))[(size_t)chunk * 256 + tid] = v; }
        __syncthreads();
    }
}
DI void phase_r2(LAS unsigned char* lds, const Ctx& c, int l, int G) {
    const int tid = ltid(); volatile LAS int* BASE = (volatile LAS int*)(lds + R_BASE);
    const int* histg = (const int*)(c.ws + WS_HISTG); int* list = (int*)(c.ws + WS_LIST);
    unsigned* cur = (unsigned*)(c.ws + WS_CTL) + CW_CUR + l * 16 * 64;
    for (int chunk = lbid(); chunk < T / 256; chunk += G) {
        __syncthreads();
        if (tid < 16) BASE[tid] = 0;
        __syncthreads();
        { const int e = tid & 15; int s = 0; for (int cc = tid >> 4; cc < chunk; cc += 32) s += histg[cc * 16 + e]; if (s) atomicAdd((int*)&BASE[e], s); }
        __syncthreads();
        if (tid < 256) { const int4 v = ((const int4*)(c.ws + WS_INFO))[(size_t)chunk * 256 + tid]; const int row = chunk * 256 + tid;
            list[(size_t)v.x * T + BASE[v.x] + v.z] = row * 2; list[(size_t)v.y * T + BASE[v.y] + v.w] = row * 2 + 1; }
        if (chunk == T / 256 - 1 && tid < 16) __hip_atomic_store(cur + tid * 64, (unsigned)(BASE[tid] + histg[chunk * 16 + tid]), __ATOMIC_RELAXED, __HIP_MEMORY_SCOPE_AGENT);
    }
}
DI int moe_setup(LAS unsigned char* lds, const Ctx& c, int l) {
    volatile LAS int* PRE = (volatile LAS int*)(lds + MISC_OFF); volatile LAS int* CNT = PRE + 17;
    unsigned* cur = (unsigned*)(c.ws + WS_CTL) + CW_CUR + l * 16 * 64;
    __syncthreads();
    if (threadIdx.x == 0) { int acc = 0; for (int e = 0; e < 16; ++e) { const int n = (int)__hip_atomic_load(cur + e * 64, __ATOMIC_RELAXED, __HIP_MEMORY_SCOPE_AGENT); PRE[e] = acc; CNT[e] = n; acc += (n + 255) >> 8; } PRE[16] = acc; }
    __syncthreads();
    return rfl(PRE[16]);
}
DI void phase_c(const Ctx& c, int l, int G) {
    const int tid = ltid(), lane = tid & 63, wave = rfl(tid >> 6);
    f32x4 g4[4], b4[4];
#pragma unroll
    for (int j = 0; j < 4; ++j) { g4[j] = *(const f32x4*)(c.ln2_g + l * D + 4 * lane + 256 * j); b4[j] = *(const f32x4*)(c.ln2_b + l * D + 4 * lane + 256 * j); }
    float* xo = c.out; bf16_t* xb = wsb(c, WS_XB); const bf16_t* ys = wsb(c, WS_YS); const float* gate = (const float*)(c.ws + WS_GATE);
    for (size_t row = (size_t)lbid() * NWAVES + wave; row < (size_t)T; row += (size_t)G * NWAVES) {
        const float g0 = gate[row * 2], g1 = gate[row * 2 + 1];
        f32x4 v[4]; float s = 0.f;
#pragma unroll
        for (int j = 0; j < 4; ++j) { const f32x4 xr = *(const f32x4*)(xo + row * D + 4 * lane + 256 * j);
            const u32x2 y0 = *(const u32x2*)(ys + (row * 2) * D + 4 * lane + 256 * j), y1 = *(const u32x2*)(ys + (row * 2 + 1) * D + 4 * lane + 256 * j);
            v[j][0] = xr[0] * DN_ALPHA + g0 * bf_lo(y0.x) + g1 * bf_lo(y1.x); v[j][1] = xr[1] * DN_ALPHA + g0 * bf_hi(y0.x) + g1 * bf_hi(y1.x);
            v[j][2] = xr[2] * DN_ALPHA + g0 * bf_lo(y0.y) + g1 * bf_lo(y1.y); v[j][3] = xr[3] * DN_ALPHA + g0 * bf_hi(y0.y) + g1 * bf_hi(y1.y);
            s += (v[j][0] + v[j][1]) + (v[j][2] + v[j][3]); }
        const float mean = wave_sum(s) * (1.0f / D); float s2 = 0.f;
#pragma unroll
        for (int j = 0; j < 4; ++j) { v[j] = v[j] - mean; s2 += (v[j][0] * v[j][0] + v[j][1] * v[j][1]) + (v[j][2] * v[j][2] + v[j][3] * v[j][3]); }
        const float rstd = __builtin_amdgcn_rsqf(wave_sum(s2) * (1.0f / D) + LN_EPS);
#pragma unroll
        for (int j = 0; j < 4; ++j) { v[j] = v[j] * rstd * g4[j] + b4[j]; *(f32x4*)(xo + row * D + 4 * lane + 256 * j) = v[j];
            u32x2 pk; pk.x = cvt_pk_bf16(v[j][0], v[j][1]); pk.y = cvt_pk_bf16(v[j][2], v[j][3]); *(u32x2*)(xb + row * D + 4 * lane + 256 * j) = pk; }
    }
}

DI Ctx load_ctx() {
    union { Ctx c; unsigned long long q[sizeof(Ctx) / 8]; } u;
#if defined(__HIP_DEVICE_COMPILE__)
    const __attribute__((address_space(4))) unsigned long long* p = (const __attribute__((address_space(4))) unsigned long long*)__builtin_amdgcn_kernarg_segment_ptr();
    asm volatile("" : "+s"(p));
#pragma unroll
    for (int i = 0; i < (int)(sizeof(Ctx) / 8); ++i) u.q[i] = p[i];
#endif
    return u.c;
}
#define CTX const Ctx c = load_ctx(); const int G = lgrid(); LAS unsigned char* lds = LDSBASE
__global__ void __launch_bounds__(NTHREADS, 2) mk_fwd(Ctx c_arg) {
    extern __shared__ __attribute__((aligned(16))) unsigned char lds_raw[];
#define LDSBASE ({ unsigned _b = (unsigned)(uintptr_t)(LAS unsigned char*)lds_raw; asm volatile("" : "+s"(_b)); (LAS unsigned char*)(uintptr_t)_b; })
    LAS unsigned char* lds0 = LDSBASE;
    const int tid = threadIdx.x; const Ctx c = load_ctx();
    volatile LAS unsigned* MISC = (volatile LAS unsigned*)(lds0 + MISC_OFF);
    if (tid < 64) MISC[tid] = 0u;
    __syncthreads();
    XcdBarrier bar; bar.bar = (unsigned*)(c.ws + WS_CTL) + CW_BAR; bar.x = 0; bar.st = MISC + 40;
    if (!MK_MULTI) bar = xcd_barrier_post((unsigned*)(c.ws + WS_CTL) + CW_BAR, MISC + 40);
    const int lo = c.lo, hi = c.hi; int step = 0;
#define RUN (lo <= step && step < hi)
#define END_STEP do { if (RUN && step + 1 < hi) { if (!MK_MULTI) xcd_barrier(bar); } ++step; } while (0)
    for (int l = 0; l < DEPTH; ++l) {
        if (RUN) { CTX; phase_w(lds, c, l, G); }
        END_STEP;
        for (int hf = 0; hf < 2; ++hf) {
            const size_t r0 = (size_t)hf * TH;
            if (RUN) {
                CTX;
                pg8::StaticOrder S; S.init(wsb(c, WS_XB) + r0 * D, wsb(c, WS_WIN), TH, NIN, D, G, lbid());
                EpiIn E{wsb(c, WS_H + H_QG), wsb(c, WS_H + H_KG), wsb(c, WS_H + H_VG), wsb(c, WS_H + H_SR), wsb(c, WS_H + H_QD), wsb(c, WS_H + H_KD), wsb(c, WS_H + H_VD), wsb(c, WS_H + H_GT), (float*)(c.ws + WS_HA), c.pos + r0};
                pg8::gemm_phase(lds, D, S, E);
            }
            END_STEP;
            if (RUN) { CTX; phase_p(lds, c, l, G); }
            END_STEP;
            if (RUN) { CTX; phase_b(lds, c, l, G); }
            END_STEP;
            if (RUN) { CTX; (void)lds; phase_f(c, G); }
            END_STEP;
            if (RUN) {
                CTX;
                pg8::StaticOrder S; S.init(wsb(c, WS_OG), wsb(c, WS_WGO), TH, D, D, G, lbid());
                EpiGate<false> E{wsb(c, WS_MIX), wsb(c, WS_H + H_GT)};
                pg8::gemm_phase(lds, D, S, E);
            }
            END_STEP;
            if (RUN) {
                CTX;
                pg8::StaticOrder S; S.init(wsb(c, WS_ATT), wsb(c, WS_WAO), TH, D, 512, G, lbid());
                EpiGate<true> E{wsb(c, WS_MIX), wsb(c, WS_H + H_GT) + 1024};
                pg8::gemm_phase(lds, 512, S, E);
            }
            END_STEP;
            if (RUN) {
                CTX;
                pg8::StaticOrder S; S.init(wsb(c, WS_MIX), wsb(c, WS_WOUT), TH, D, D, G, lbid());
                EpiRes E{(l == 0 ? c.x : c.out) + r0 * D, c.out + r0 * D};
                pg8::gemm_phase(lds, D, S, E);
            }
            END_STEP;
        }
        if (RUN) { CTX; phase_r(lds, c, l, G); }
        END_STEP;
        if (RUN) { CTX; phase_r2(lds, c, l, G); }
        END_STEP;
        if (RUN) {   CTX;
            const int ntiles = moe_setup(lds, c, l);
            volatile LAS int* PRE = (volatile LAS int*)(lds + MISC_OFF); volatile LAS int* TAB = (volatile LAS int*)(lds + TAB_OFF);
            pg8::MoeOrder S; S.G = G; S.c = lbid(); S.ntot = ntiles * 8; S.NC = 8; S.K = D; S.pre = PRE; S.cnt = PRE + 17; S.A = (const char*)wsb(c, WS_XB); S.Bt = (const char*)wsb(c, WS_WGU);
            S.bstride = (size_t)2048 * 1024 * 2; S.tab = TAB; S.gather = true;
            const int* list = (const int*)(c.ws + WS_LIST);
            { const int lt_tid = ltid(); const int r = lt_tid & 255, half = rfl(lt_tid >> 8);
              for (int i0 = 0; i0 < MAXU; i0 += 2) { Unit u; const int i = i0 + half;
                  if (S.next(i, u)) { const int lt = u.pm - PRE[u.e]; const int pos = 256 * lt + (r < u.nv ? r : 0); TAB[i * 256 + r] = list[(size_t)u.e * T + pos] >> 1; } } }
            __syncthreads();
            EpiM1 E{wsb(c, WS_HM)};
            pg8::gemm_phase(lds, D, S, E);
        }
        END_STEP;
        if (RUN) {   CTX;
            const int ntiles = moe_setup(lds, c, l);
            volatile LAS int* PRE = (volatile LAS int*)(lds + MISC_OFF);
            pg8::MoeOrder S; S.G = G; S.c = lbid(); S.ntot = ntiles * 4; S.NC = 4; S.K = DFF; S.pre = PRE; S.cnt = PRE + 17; S.A = (const char*)wsb(c, WS_HM); S.Bt = (const char*)wsb(c, WS_WD);
            S.bstride = (size_t)1024 * 1024 * 2; S.tab = nullptr; S.gather = false;
            EpiM2 E{wsb(c, WS_YS), (const int*)(c.ws + WS_LIST), PRE};
            pg8::gemm_phase(lds, DFF, S, E);
        }
        END_STEP;
        if (RUN) { CTX; (void)lds; phase_c(c, l, G); }
        END_STEP;
    }
#undef RUN
#undef END_STEP
}
constexpr int NSTEPS = DEPTH * (1 + 2 * 7 + 5);

extern "C" void kernel_launch(void* const* d_in, const int* in_sizes, int n_in, void* d_out, int out_size, void* d_ws, size_t ws_size, hipStream_t stream) {
    static int grid = 0;
    if (grid == 0) {
        if (n_in != 18 || in_sizes[0] != T * D || out_size != T * D || ws_size < WS_END) { fprintf(stderr, "kernel_launch: unexpected shapes / workspace (need %zu, got %zu)\n", (size_t)WS_END, ws_size); grid = -1; return; }
        int dev = 0, cus = 0;
        if (hipGetDevice(&dev) != hipSuccess || hipDeviceGetAttribute(&cus, hipDeviceAttributeMultiprocessorCount, dev) != hipSuccess) { grid = -1; return; }
        if (hipFuncSetAttribute((const void*)mk_fwd, hipFuncAttributeMaxDynamicSharedMemorySize, LDS_BYTES) != hipSuccess) { fprintf(stderr, "kernel_launch: hipFuncSetAttribute failed\n"); grid = -1; return; }
        int per_cu = 0;
        if (hipOccupancyMaxActiveBlocksPerMultiprocessor(&per_cu, (const void*)mk_fwd, NTHREADS, LDS_BYTES) != hipSuccess || per_cu < 1) { fprintf(stderr, "kernel_launch: occupancy query says %d\n", per_cu); }
        (void)hipGetLastError();
        grid = cus;
    }
    if (grid < 0) return;
    (void)hipMemsetAsync((char*)d_ws + WS_CTL, 0, CTL_ZERO_BYTES, stream);
    Ctx c{};
    c.x = (const float*)d_in[0]; c.pos = (const int*)d_in[1]; c.w_in = (const float*)d_in[2]; c.w_alpha_up = (const float*)d_in[3]; c.b_alpha = (const float*)d_in[4]; c.gla_norm = (const float*)d_in[5];
    c.w_gla_o = (const float*)d_in[6]; c.w_att_o = (const float*)d_in[7]; c.w_out = (const float*)d_in[8]; c.ln1_g = (const float*)d_in[9]; c.ln1_b = (const float*)d_in[10]; c.w_router = (const float*)d_in[11];
    c.b_router = (const float*)d_in[12]; c.w_e_gate = (const float*)d_in[13]; c.w_e_up = (const float*)d_in[14]; c.w_e_down = (const float*)d_in[15]; c.ln2_g = (const float*)d_in[16]; c.ln2_b = (const float*)d_in[17];
    c.out = (float*)d_out; c.ws = (unsigned char*)d_ws;
#if MK_MULTI
    for (int s = 0; s < NSTEPS; ++s) { c.lo = s; c.hi = s + 1; hipLaunchKernelGGL(mk_fwd, dim3(grid), dim3(NTHREADS), LDS_BYTES, stream, c); }
#else
    c.lo = 0; c.hi = NSTEPS; hipLaunchKernelGGL(mk_fwd, dim3(grid), dim3(NTHREADS), LDS_BYTES, stream, c);
#endif
}
```

```cpp
#include <hip/hip_runtime.h>
#include <cstdio>
#include <cstdint>

#ifndef MK_MULTI
#define MK_MULTI 0
#endif

#define DI __device__ __forceinline__
#define GAS __attribute__((address_space(1)))
#define LAS __attribute__((address_space(3)))
typedef unsigned short bf16_t;
typedef short bf16x8 __attribute__((ext_vector_type(8)));
typedef short s16x4 __attribute__((ext_vector_type(4)));
typedef float f32x4 __attribute__((ext_vector_type(4)));
typedef float f32x2 __attribute__((ext_vector_type(2)));
typedef unsigned u32x4 __attribute__((ext_vector_type(4)));
typedef unsigned u32x2 __attribute__((ext_vector_type(2)));
typedef int i32x4 __attribute__((ext_vector_type(4)));
#define LDS_WAIT() asm volatile("s_waitcnt lgkmcnt(0)" ::: "memory")
#define VM_WAIT() asm volatile("s_waitcnt vmcnt(0)" ::: "memory")

constexpr int D = 1024, NBATCH = 16, SEQ = 4096, T = NBATCH * SEQ, DEPTH = 4;
constexpr int TH = T / 2;
constexpr int DIN = 9744, NIN = 9984;
constexpr int NEXP = 16, DFF = 1024;
constexpr float LN_EPS = 1e-5f, RMS_EPS = 1e-6f;
constexpr float DN_ALPHA = 1.6817928305074290f;
constexpr float LOG2E = 1.4426950408889634f;
constexpr int NWAVES = 8, NTHREADS = 512;

constexpr size_t MiB = 1u << 20;
constexpr size_t WS_CTL = 0, CTL_ZERO_BYTES = 1 * MiB;
constexpr size_t WS_WIN = 1 * MiB;
constexpr size_t WS_WGO = WS_WIN + (size_t)NIN * D * 2;
constexpr size_t WS_WAO = WS_WGO + 2 * MiB;
constexpr size_t WS_WOUT = WS_WAO + 1 * MiB;
constexpr size_t WS_WGU = WS_WOUT + 2 * MiB;
constexpr size_t WS_WD = WS_WGU + 64 * MiB;
constexpr size_t WS_XB = WS_WD + 32 * MiB;
constexpr size_t WS_LIST = WS_XB + 128 * MiB;
constexpr size_t WS_GATE = WS_LIST + 4 * MiB;
constexpr size_t WS_INFO = WS_GATE + 1 * MiB;
constexpr size_t WS_HISTG = WS_INFO + 1 * MiB;
constexpr size_t WS_OG = WS_HISTG + 1 * MiB;
constexpr size_t WS_ATTG = WS_OG + 64 * MiB;
constexpr size_t WS_LSE = WS_ATTG + 96 * MiB;
constexpr size_t WS_ATT = WS_LSE + 3 * MiB;
constexpr size_t WS_MIX = WS_ATT + 32 * MiB;
constexpr size_t WS_HA = WS_MIX + 64 * MiB;
constexpr size_t WS_H = WS_HA + 2 * MiB;
constexpr size_t H_QG = 0, H_KG = H_QG + (size_t)TH * 512 * 2, H_VG = H_KG + (size_t)TH * 512 * 2, H_SR = H_VG + (size_t)TH * 1024 * 2,
                 H_QD = H_SR + (size_t)TH * 1024 * 2, H_KD = H_QD + (size_t)TH * 1536 * 2, H_VD = H_KD + (size_t)TH * 1536 * 2, H_GT = H_VD + (size_t)TH * 1536 * 2,
                 H_END = H_GT + (size_t)TH * 2048 * 2;
constexpr size_t WS_HM = WS_H;
constexpr size_t WS_YS = WS_HM + (size_t)(2 * T + 4096) * 1024 * 2;
constexpr size_t WS_REC = WS_H + H_END;
constexpr size_t WS_END = WS_REC + (size_t)2048 * 33792;
static_assert(WS_YS + (size_t)2 * T * 1024 * 2 <= WS_END, "MoE overlay fits");
constexpr int CW_BAR = 4096;
constexpr int CW_CUR = 16384;

constexpr int RING_BYTES = 131072;
constexpr int TAB_OFF = RING_BYTES, MAXU = 18, TAB_BYTES = MAXU * 1024;
constexpr int MISC_OFF = TAB_OFF + TAB_BYTES;
constexpr int LDS_BYTES = MISC_OFF + 256;

DI int rfl(int v) { return __builtin_amdgcn_readfirstlane(v); }
DI int lbid() { int t = blockIdx.x; asm volatile("" : "+s"(t)); return t; }
DI int lgrid() { int t = gridDim.x; asm volatile("" : "+s"(t)); return t; }
DI int ltid() { int t = threadIdx.x; asm volatile("" : "+v"(t)); return t; }
DI float bf2f(unsigned b) { return __uint_as_float(b << 16); }
typedef __bf16 bf16x2_t __attribute__((ext_vector_type(2)));
DI unsigned cvt_pk_bf16(float lo, float hi) { f32x2 v = {lo, hi}; bf16x2_t b = __builtin_convertvector(v, bf16x2_t); return __builtin_bit_cast(unsigned, b); }
DI float bf_lo(unsigned w) { return __uint_as_float(w << 16); }
DI float bf_hi(unsigned w) { return __uint_as_float(w & 0xffff0000u); }
DI float sigmoidf_(float x) { return __builtin_amdgcn_rcpf(1.0f + __builtin_amdgcn_exp2f(-x * LOG2E)); }

#define XB_TMO      128
#define XB_XCNT(j)  (256  + 64 * (j))
#define XB_XSUB(j)  (1280 + 64 * (j))
#define XB_XGEN(j)  (2304 + 64 * (j))
#define XB_TOP      3328
#define XB_TOPGEN   3392
#define XCD_BAR_WORDS 3456
#define XB_SPIN_CAP (1u << 18)
DI unsigned xb_ld(unsigned* p)              { return __hip_atomic_load(p, __ATOMIC_RELAXED, __HIP_MEMORY_SCOPE_AGENT); }
DI unsigned xb_add(unsigned* p, unsigned v) { return __hip_atomic_fetch_add(p, v, __ATOMIC_RELAXED, __HIP_MEMORY_SCOPE_AGENT); }
DI unsigned xb_xcc_id() { return (unsigned)__builtin_amdgcn_s_getreg((3 << 11) | 20) & 0xFu; }
#define XB_SPIN(cond, bar) do { unsigned _sp = 0; while (cond) { __builtin_amdgcn_s_sleep(1); \
    if ((++_sp & 255u) == 0u) { if (xb_ld(&(bar)[XB_TMO])) break; if (_sp > XB_SPIN_CAP) { atomicAdd(&(bar)[XB_TMO], 1u); break; } } } } while (0)
struct XcdBarrier { unsigned* bar; unsigned x; volatile LAS unsigned* st; };
DI XcdBarrier xcd_barrier_post(unsigned* bar, volatile LAS unsigned* st) {
    XcdBarrier b; b.bar = bar; b.x = xb_xcc_id(); b.st = st;
    if (threadIdx.x == 0) (void)xb_add(&bar[XB_XCNT(b.x)], 1u);
    return b;
}
DI void xcd_barrier_complete(unsigned* bar, unsigned x, unsigned& nloc, unsigned& nx) {
    const unsigned G = gridDim.x * gridDim.y * gridDim.z;
    unsigned sum, cnt, mine, sp = 0u;
    for (;;) {
        sum = 0u; cnt = 0u; mine = 0u;
#pragma unroll
        for (unsigned j = 0; j < 16; ++j) { const unsigned c = xb_ld(&bar[XB_XCNT(j)]); sum += c; cnt += (c > 0u) ? 1u : 0u; mine = (j == x) ? c : mine; }
        if (sum == G) break;
        __builtin_amdgcn_s_sleep(1);
        if ((++sp & 255u) == 0u) { if (xb_ld(&bar[XB_TMO])) break; if (sp > XB_SPIN_CAP) { atomicAdd(&bar[XB_TMO], 1u); break; } }
    }
    nloc = mine > 0u ? mine : 1u; nx = cnt > 0u ? cnt : 1u;
}
DI void xcd_barrier(const XcdBarrier& b) {
    asm volatile("s_waitcnt vmcnt(0)" ::: "memory");
    __syncthreads();
    if (threadIdx.x == 0) {
        unsigned* bar = b.bar;
        __builtin_amdgcn_s_waitcnt(0);
        unsigned nloc = b.st[0], nx = b.st[1];
        if (nloc == 0u) { xcd_barrier_complete(bar, b.x, nloc, nx); b.st[0] = nloc; b.st[1] = nx; }
        const unsigned old = xb_add(&bar[XB_XSUB(b.x)], 1u);
        const unsigned gen = old / nloc;
        if (old + 1u == (gen + 1u) * nloc) {
            __builtin_amdgcn_fence(__ATOMIC_RELEASE, "agent");
            asm volatile("s_waitcnt vmcnt(0)" ::: "memory");
            const unsigned og = xb_add(&bar[XB_TOP], 1u);
            const unsigned tg = og / nx;
            if (og + 1u == (tg + 1u) * nx) xb_add(&bar[XB_TOPGEN], 1u);
            else XB_SPIN(xb_ld(&bar[XB_TOPGEN]) == tg, bar);
            __builtin_amdgcn_fence(__ATOMIC_ACQUIRE, "agent");
            xb_add(&bar[XB_XGEN(b.x)], 1u);
            asm volatile("s_waitcnt vmcnt(0)" ::: "memory");
        } else {
            XB_SPIN(xb_ld(&bar[XB_XGEN(b.x)]) == gen, bar);
            __builtin_amdgcn_fence(__ATOMIC_ACQUIRE, "agent");
            asm volatile("s_waitcnt vmcnt(0)" ::: "memory");
        }
    }
    __syncthreads();
}

struct Ctx {
    const float* x; const int* pos; const float* w_in; const float* w_alpha_up; const float* b_alpha; const float* gla_norm;
    const float* w_gla_o; const float* w_att_o; const float* w_out; const float* ln1_g; const float* ln1_b; const float* w_router; const float* b_router;
    const float* w_e_gate; const float* w_e_up; const float* w_e_down; const float* ln2_g; const float* ln2_b;
    float* out; unsigned char* ws;
    int lo, hi;
};
DI bf16_t* wsb(const Ctx& c, size_t off) { return (bf16_t*)(c.ws + off); }

namespace pg8 {
constexpr int BM = 256, BK = 64, HALF = 128, HTB = HALF * BK * 2, STAGE_BYTES = 8 * HTB, NXCD = 8, WGM = 8;
DI int lds_byte(int r, int c) { const int st = (r >> 4) * 2 + (c >> 5), rr = r & 15, cc = c & 31, ob = rr * 64 + cc * 2; return st * 1024 + (ob ^ (((ob >> 9) & 1) << 5)); }
DI void stage_rc(int b, int& R, int& C) { const int st = b / 1024, sb = b % 1024, swz = sb ^ (((sb >> 9) & 1) << 5); R = (st >> 1) * 16 + swz / 64; C = (st & 1) * 32 + (swz % 64) / 2; }
DI int perm32(int rho) { const int n = rho >> 4, i = rho & 15; return 8 * (i >> 2) + 4 * n + (i & 3); }
struct Unit { int pm, pn, e, nv, ui; };

struct StaticOrder {
    int nM, nN, nwg, G, c, K; const char* A; const char* Bt;
    DI void init(const void* A_, const void* Bt_, int M, int N, int K_, int G_, int c_) { A = (const char*)A_; Bt = (const char*)Bt_; nM = M / BM; nN = N / BM; nwg = nM * nN; G = G_; c = c_; K = K_; }
    DI bool next(int i, Unit& u) const {
        const long L = (long)i * G + c; if (L >= nwg) return false;
        int wgid = (int)L; { const int q = nwg / NXCD, r = nwg % NXCD, xcd = wgid % NXCD, off = wgid / NXCD; wgid = (xcd < r ? xcd * (q + 1) : r * (q + 1) + (xcd - r) * q) + off; }
        const int nig = WGM * nN, gid = wgid / nig, fm = gid * WGM, gsz = (nM - fm) < WGM ? (nM - fm) : WGM;
        u.pm = fm + ((wgid % nig) % gsz); u.pn = (wgid % nig) / gsz; u.e = 0; u.nv = 256; u.ui = i; return true;
    }
    DI const char* a_base(const Unit& u) const { return A + (size_t)u.pm * BM * K * 2; }
    DI const char* b_base(const Unit& u) const { return Bt + (size_t)u.pn * BM * K * 2; }
    DI void a_off(const Unit&, int tid, unsigned (&o)[2][2]) const {
#pragma unroll
        for (int i = 0; i < 2; ++i) { int R, C; stage_rc(tid * 16 + i * 8192, R, C);
#pragma unroll
            for (int h = 0; h < 2; ++h) o[h][i] = (unsigned)((h * HALF + R) * K + C) * 2u; }
    }
};
struct MoeOrder {
    int G, c, ntot, NC, K; const volatile LAS int* pre; const volatile LAS int* cnt; const char* A; const char* Bt; size_t bstride; const volatile LAS int* tab; bool gather;
    DI bool next(int i, Unit& u) const {
        const int L = i * G + c; if (L >= ntot) return false;
        const int rt = L / NC; u.pn = L - rt * NC; u.pm = rt;
        int e = 0;
#pragma unroll
        for (int j = 1; j < 16; ++j) e += (rt >= rfl(pre[j])) ? 1 : 0;
        e = rfl(e); u.e = e; const int rem = rfl(cnt[e]) - 256 * (rt - rfl(pre[e])); u.nv = rem < 256 ? rem : 256; u.ui = i; return true;
    }
    DI const char* a_base(const Unit& u) const { return gather ? A : A + (size_t)u.pm * BM * K * 2; }
    DI const char* b_base(const Unit& u) const { return Bt + (size_t)u.e * bstride + (size_t)u.pn * BM * K * 2; }
    DI void a_off(const Unit& u, int tid, unsigned (&o)[2][2]) const {
#pragma unroll
        for (int i = 0; i < 2; ++i) { int R, C; stage_rc(tid * 16 + i * 8192, R, C);
#pragma unroll
            for (int h = 0; h < 2; ++h) { const int row = gather ? tab[u.ui * 256 + h * HALF + R] : (h * HALF + R); o[h][i] = (unsigned)(row * K + C) * 2u; } }
    }
};

template <class Epi, class Sched>
DI void gemm_phase(LAS unsigned char* lds, const int K, const Sched& S, const Epi& E) {
    const int tid = ltid(), wid = rfl(tid >> 6), lane = tid & 63, wr = wid >> 2, wc = wid & 3, fr = lane & 15, fq = lane >> 4;
    const int nt = K / BK;
    unsigned voffB[2];
#pragma unroll
    for (int i = 0; i < 2; ++i) { int R, C; stage_rc(tid * 16 + i * 8192, R, C); const int Rb = Epi::PERM ? ((R & ~31) + perm32(R & 31)) : R; voffB[i] = (unsigned)(Rb * K + C) * 2u; }
    const size_t kstep = (size_t)(BK * 2);
    const size_t hstep = (size_t)HALF * K * 2;
    const unsigned ldsw = (unsigned)wid * 1024u;
    const int aoff = lds_byte(wr * 64 + fr, fq * 8), boff = lds_byte(wc * 32 + fr, fq * 8);
#define PG8_SA(b, h) (((b) * 2 + (h)) * HTB)
#define PG8_SB(b, h) ((4 + (b) * 2 + (h)) * HTB)
#define PG8_STAGE(bufoff, gbase, voff) do { _Pragma("unroll") for (int _i = 0; _i < 2; ++_i) \
        __builtin_amdgcn_global_load_lds((const unsigned*)((const char*)(gbase) + (voff)[_i]), (LAS unsigned*)(lds + (bufoff) + ldsw + _i * 8192), 16, 0, 0); } while (0)
#define PG8_LDA(dst, b, h) do { _Pragma("unroll") for (int m = 0; m < 4; ++m) _Pragma("unroll") for (int k = 0; k < 2; ++k) dst[m][k] = *(const LAS bf16x8*)(lds + PG8_SA(b, h) + aoff + m * 2048 + k * 1024); } while (0)
#define PG8_LDB(dst, b, h) do { _Pragma("unroll") for (int n = 0; n < 2; ++n) _Pragma("unroll") for (int k = 0; k < 2; ++k) dst[n][k] = *(const LAS bf16x8*)(lds + PG8_SB(b, h) + boff + n * 2048 + k * 1024); } while (0)
#define PG8_MMA(ai, bj, At, Bt) do { __builtin_amdgcn_s_setprio(1); _Pragma("unroll") for (int m = 0; m < 4; ++m) _Pragma("unroll") for (int n = 0; n < 2; ++n) _Pragma("unroll") for (int k = 0; k < 2; ++k) \
        acc[ai][bj][m][n] = __builtin_amdgcn_mfma_f32_16x16x32_bf16(Bt[n][k], At[m][k], acc[ai][bj][m][n], 0, 0, 0); __builtin_amdgcn_s_setprio(0); } while (0)
#define PG8_WAIT_V(n) asm volatile("s_waitcnt vmcnt(" #n ")" ::: "memory")
#define PG8_WAIT_L(n) asm volatile("s_waitcnt lgkmcnt(" #n ")" ::: "memory")
#define PG8_BAR __builtin_amdgcn_s_barrier()
#define PG8_SCHED __builtin_amdgcn_sched_barrier(0)
    Unit cur, nxt; int ui = 0;
    if (!S.next(0, cur)) return;
    f32x4 acc[2][2][4][2];
#pragma unroll
    for (int a = 0; a < 2; ++a)
#pragma unroll
        for (int b = 0; b < 2; ++b)
#pragma unroll
            for (int m = 0; m < 4; ++m)
#pragma unroll
                for (int n = 0; n < 2; ++n) acc[a][b][m][n] = (f32x4){0.f, 0.f, 0.f, 0.f};
    bf16x8 At[4][2], B0[2][2], B1[2][2];
    unsigned oA[2][2]; S.a_off(cur, tid, oA);
    const char* cA = S.a_base(cur); const char* cB = S.b_base(cur);
    PG8_STAGE(PG8_SB(0, 0), cB, voffB); PG8_STAGE(PG8_SB(0, 1), cB + hstep, voffB); PG8_STAGE(PG8_SA(0, 0), cA, oA[0]); PG8_STAGE(PG8_SA(0, 1), cA, oA[1]);
    if (wr == 1) PG8_BAR;
    PG8_WAIT_V(2); PG8_BAR;
    PG8_STAGE(PG8_SB(1, 0), cB + kstep, voffB); PG8_STAGE(PG8_SA(1, 0), cA + kstep, oA[0]); PG8_STAGE(PG8_SB(1, 1), cB + hstep + kstep, voffB);
    PG8_WAIT_V(6); PG8_BAR;
    for (;;) {
        const bool has_next = S.next(ui + 1, nxt);
        const char* nA = has_next ? S.a_base(nxt) : cA; const char* nB = has_next ? S.b_base(nxt) : cB;
        for (int t = 0; t < nt; t += 2) {
            const bool last = (t == nt - 2);
            const char* a1 = cA + (size_t)(t + 1) * kstep;
            const char* a2 = last ? nA : cA + (size_t)(t + 2) * kstep; const char* b2 = last ? nB : cB + (size_t)(t + 2) * kstep;
            const char* a3 = a2 + kstep; const char* b3 = b2 + kstep;
            PG8_LDB(B0, 0, 0); PG8_LDB(B1, 0, 1); PG8_SCHED; PG8_LDA(At, 0, 0); PG8_STAGE(PG8_SA(1, 1), a1, oA[1]);
            if (last && has_next) S.a_off(nxt, tid, oA);
            PG8_WAIT_V(8); PG8_WAIT_L(0); PG8_BAR; PG8_MMA(0, 0, At, B0); PG8_MMA(0, 1, At, B1); PG8_BAR; PG8_SCHED;
            PG8_LDA(At, 0, 1); PG8_STAGE(PG8_SB(0, 0), b2, voffB); PG8_STAGE(PG8_SB(0, 1), b2 + hstep, voffB); PG8_STAGE(PG8_SA(0, 0), a2, oA[0]);
            PG8_WAIT_V(8); PG8_WAIT_L(0); PG8_BAR; PG8_MMA(1, 0, At, B0); PG8_MMA(1, 1, At, B1); PG8_BAR; PG8_SCHED;
            PG8_LDB(B0, 1, 0); PG8_LDB(B1, 1, 1); PG8_SCHED; PG8_LDA(At, 1, 0); PG8_STAGE(PG8_SA(0, 1), a2, oA[1]);
            PG8_WAIT_V(8); PG8_WAIT_L(0); PG8_BAR; PG8_MMA(0, 0, At, B0); PG8_MMA(0, 1, At, B1); PG8_BAR; PG8_SCHED;
            PG8_LDA(At, 1, 1); PG8_STAGE(PG8_SB(1, 0), b3, voffB); PG8_STAGE(PG8_SB(1, 1), b3 + hstep, voffB); PG8_STAGE(PG8_SA(1, 0), a3, oA[0]);
            PG8_WAIT_V(8); PG8_WAIT_L(0); PG8_BAR; PG8_MMA(1, 0, At, B0); PG8_MMA(1, 1, At, B1); PG8_BAR; PG8_SCHED;
        }
        if (wr == 0) PG8_BAR;
        E(acc, cur, wr, wc, fr, fq);
        if (!has_next) break;
#pragma unroll
        for (int a = 0; a < 2; ++a)
#pragma unroll
            for (int b = 0; b < 2; ++b)
#pragma unroll
                for (int m = 0; m < 4; ++m)
#pragma unroll
                    for (int n = 0; n < 2; ++n) acc[a][b][m][n] = (f32x4){0.f, 0.f, 0.f, 0.f};
        cur = nxt; cA = nA; cB = nB; ++ui;
        if (wr == 1) PG8_BAR;
    }
    PG8_WAIT_V(0);
    PG8_BAR;
#undef PG8_SA
#undef PG8_SB
#undef PG8_STAGE
#undef PG8_LDA
#undef PG8_LDB
#undef PG8_MMA
#undef PG8_WAIT_V
#undef PG8_WAIT_L
#undef PG8_BAR
#undef PG8_SCHED
}
}
using pg8::Unit;

DI u32x4 pack8(const f32x4& v0, const f32x4& v1) { u32x4 w; w.x = cvt_pk_bf16(v0[0], v0[1]); w.y = cvt_pk_bf16(v0[2], v0[3]); w.z = cvt_pk_bf16(v1[0], v1[1]); w.w = cvt_pk_bf16(v1[2], v1[3]); return w; }

struct EpiIn {
    static constexpr bool PERM = true;
    bf16_t *qg, *kg, *vg, *sr, *qd, *kd, *vd, *gt; float* ha; const int* pos;
    DI void operator()(const f32x4 (&acc)[2][2][4][2], const Unit& u, int wr, int wc, int fr, int fq) const {
        const int row0 = u.pm * 256 + wr * 64 + fr; const int pn = u.pn;
        if (pn >= 12 && pn < 24) {
            bf16_t* base = pn < 18 ? qd : kd; const int tq = pn < 18 ? pn - 12 : pn - 18; const float sc = pn < 18 ? 0.125f * LOG2E : 1.0f;
            float fre[8];
#pragma unroll
            for (int i = 0; i < 8; ++i) fre[i] = __builtin_amdgcn_exp2f(-(float)(8 * fq + i) * (13.287712379549449f / 32.0f)) * 0.15915494309189535f;
#pragma unroll
            for (int ai = 0; ai < 2; ++ai)
#pragma unroll
                for (int m = 0; m < 4; ++m) {
                    const int r = row0 + ai * 128 + m * 16; const float p = (float)pos[r];
                    bf16_t* rowp = base + (size_t)r * 1536 + (4 * tq + wc) * 64 + 8 * fq;
#pragma unroll
                    for (int n = 0; n < 2; ++n) { f32x4 o1, o2;
#pragma unroll
                        for (int j = 0; j < 4; ++j) {
                            float a = p * fre[n * 4 + j]; a = a - __builtin_floorf(a);
                            const float sn = __builtin_amdgcn_sinf(a), cs = __builtin_amdgcn_cosf(a);
                            const float x1 = acc[ai][0][m][n][j], x2 = acc[ai][1][m][n][j];
                            o1[j] = (x1 * cs - x2 * sn) * sc; o2[j] = (x2 * cs + x1 * sn) * sc;
                        }
                        u32x2 w1, w2; w1.x = cvt_pk_bf16(o1[0], o1[1]); w1.y = cvt_pk_bf16(o1[2], o1[3]); w2.x = cvt_pk_bf16(o2[0], o2[1]); w2.y = cvt_pk_bf16(o2[2], o2[3]);
                        *(GAS u32x2*)(rowp + 4 * n) = w1; *(GAS u32x2*)(rowp + 32 + 4 * n) = w2; }
                    asm volatile("" ::: "memory");
                }
        } else if (pn == 38) {
            if (wc == 0 && fq < 2) {
#pragma unroll
                for (int ai = 0; ai < 2; ++ai)
#pragma unroll
                    for (int m = 0; m < 4; ++m) { float* p = ha + (size_t)(row0 + ai * 128 + m * 16) * 16 + 8 * fq; *(GAS f32x4*)p = acc[ai][0][m][0]; *(GAS f32x4*)(p + 4) = acc[ai][0][m][1]; }
            }
        } else {
            bf16_t* base; int ldc, colt, act = 0; float sc = 1.0f;
            if (pn < 2) { base = qg; ldc = 512; colt = pn * 256; sc = 0.08838834764831845f; }
            else if (pn < 4) { base = kg; ldc = 512; colt = (pn - 2) * 256; }
            else if (pn < 8) { base = vg; ldc = 1024; colt = (pn - 4) * 256; }
            else if (pn < 12) { base = sr; ldc = 1024; colt = (pn - 8) * 256; act = 1; }
            else if (pn < 30) { base = vd; ldc = 1536; colt = (pn - 24) * 256; }
            else { base = gt; ldc = 2048; colt = (pn - 30) * 256; act = 2; }
#pragma unroll
            for (int ai = 0; ai < 2; ++ai)
#pragma unroll
                for (int m = 0; m < 4; ++m) { bf16_t* rowp = base + (size_t)(row0 + ai * 128 + m * 16) * ldc + colt + wc * 32 + 8 * fq;
#pragma unroll
                    for (int bj = 0; bj < 2; ++bj) { f32x4 v0 = acc[ai][bj][m][0] * sc, v1 = acc[ai][bj][m][1] * sc;
                        if (act) {
#pragma unroll
                            for (int j = 0; j < 4; ++j) { const float s0 = sigmoidf_(v0[j]), s1 = sigmoidf_(v1[j]); v0[j] = act == 1 ? v0[j] * s0 : s0; v1[j] = act == 1 ? v1[j] * s1 : s1; } }
                        *(GAS u32x4*)(rowp + bj * 128) = pack8(v0, v1); } }
        }
    }
};
template <bool ADD> struct EpiGate {
    static constexpr bool PERM = true;
    bf16_t* mix; const bf16_t* gt;
    DI void operator()(const f32x4 (&acc)[2][2][4][2], const Unit& u, int wr, int wc, int fr, int fq) const {
        const int row0 = u.pm * 256 + wr * 64 + fr, col0 = u.pn * 256 + wc * 32 + 8 * fq;
#pragma unroll
        for (int ai = 0; ai < 2; ++ai)
#pragma unroll
            for (int m = 0; m < 4; ++m) { const size_t r = (size_t)(row0 + ai * 128 + m * 16);
#pragma unroll
                for (int bj = 0; bj < 2; ++bj) {
                    const u32x4 g = *(const GAS u32x4*)(gt + r * 2048 + col0 + bj * 128);
                    f32x4 v0 = acc[ai][bj][m][0], v1 = acc[ai][bj][m][1];
                    v0[0] *= bf_lo(g.x); v0[1] *= bf_hi(g.x); v0[2] *= bf_lo(g.y); v0[3] *= bf_hi(g.y); v1[0] *= bf_lo(g.z); v1[1] *= bf_hi(g.z); v1[2] *= bf_lo(g.w); v1[3] *= bf_hi(g.w);
                    bf16_t* mp = mix + r * 1024 + col0 + bj * 128;
                    if (ADD) { const u32x4 o = *(const GAS u32x4*)mp; v0[0] += bf_lo(o.x); v0[1] += bf_hi(o.x); v0[2] += bf_lo(o.y); v0[3] += bf_hi(o.y); v1[0] += bf_lo(o.z); v1[1] += bf_hi(o.z); v1[2] += bf_lo(o.w); v1[3] += bf_hi(o.w); }
                    *(GAS u32x4*)mp = pack8(v0, v1); } }
    }
};
struct EpiRes {
    static constexpr bool PERM = false;
    const float* xres; float* z;
    DI void operator()(const f32x4 (&acc)[2][2][4][2], const Unit& u, int wr, int wc, int fr, int fq) const {
        const int row0 = u.pm * 256 + wr * 64 + fr, col0 = u.pn * 256 + wc * 32 + 4 * fq;
#pragma unroll
        for (int ai = 0; ai < 2; ++ai)
#pragma unroll
            for (int m = 0; m < 4; ++m) { const size_t off = (size_t)(row0 + ai * 128 + m * 16) * 1024 + col0;
#pragma unroll
                for (int bj = 0; bj < 2; ++bj)
#pragma unroll
                    for (int n = 0; n < 2; ++n) { const f32x4 xr = *(const GAS f32x4*)(xres + off + bj * 128 + n * 16); *(GAS f32x4*)(z + off + bj * 128 + n * 16) = xr * DN_ALPHA + acc[ai][bj][m][n]; }
                asm volatile("" ::: "memory"); }
    }
};
struct EpiM1 {
    static constexpr bool PERM = true;
    bf16_t* hm;
    DI void operator()(const f32x4 (&acc)[2][2][4][2], const Unit& u, int wr, int wc, int fr, int fq) const {
        const int row0 = u.pm * 256 + wr * 64 + fr, col0 = u.pn * 128 + wc * 32 + 8 * fq;
#pragma unroll
        for (int ai = 0; ai < 2; ++ai)
#pragma unroll
            for (int m = 0; m < 4; ++m) { f32x4 v0, v1;
#pragma unroll
                for (int j = 0; j < 4; ++j) { const float g0 = acc[ai][0][m][0][j], g1 = acc[ai][0][m][1][j]; v0[j] = g0 * sigmoidf_(g0) * acc[ai][1][m][0][j]; v1[j] = g1 * sigmoidf_(g1) * acc[ai][1][m][1][j]; }
                *(GAS u32x4*)(hm + (size_t)(row0 + ai * 128 + m * 16) * 1024 + col0) = pack8(v0, v1); }
    }
};
struct EpiM2 {
    static constexpr bool PERM = true;
    bf16_t* ys; const int* list; const volatile LAS int* pre;
    DI void operator()(const f32x4 (&acc)[2][2][4][2], const Unit& u, int wr, int wc, int fr, int fq) const {
        const int lrow0 = wr * 64 + fr, col0 = u.pn * 256 + wc * 32 + 8 * fq; const int lt = u.pm - rfl(pre[u.e]);
        const int* lp = list + (size_t)u.e * T + 256 * lt;
#pragma unroll
        for (int ai = 0; ai < 2; ++ai)
#pragma unroll
            for (int m = 0; m < 4; ++m) { const int r = lrow0 + ai * 128 + m * 16;
                if (r < u.nv) { const int slot = lp[r]; bf16_t* yp = ys + (size_t)slot * 1024 + col0;
#pragma unroll
                    for (int bj = 0; bj < 2; ++bj) *(GAS u32x4*)(yp + bj * 128) = pack8(acc[ai][bj][m][0], acc[ai][bj][m][1]); } }
    }
};

DI void tr_item(const float* W, int N, bf16_t* WT, int K, int drow, int c0, int nvalid, int kb, LAS float* scr, int lane) {
    const int k0 = 64 * kb;
    { const int cc = lane & 31, ccl = cc < nvalid ? cc : 0; const float* wp = W + (size_t)(k0 + (lane >> 5)) * N + c0 + ccl; float v[32];
#pragma unroll
      for (int i = 0; i < 32; ++i) v[i] = wp[(size_t)(2 * i) * N];
#pragma unroll
      for (int i = 0; i < 32; ++i) scr[(2 * i + (lane >> 5)) * 33 + cc] = (cc < nvalid) ? v[i] : 0.f; }
    LDS_WAIT(); asm volatile("" ::: "memory");
    const int c = lane & 7;
#pragma unroll
    for (int j = 0; j < 4; ++j) { const int n = (lane >> 3) + 8 * j; const LAS float* s = scr + (8 * c) * 33 + n;
        u32x4 o; o.x = cvt_pk_bf16(s[0 * 33], s[1 * 33]); o.y = cvt_pk_bf16(s[2 * 33], s[3 * 33]); o.z = cvt_pk_bf16(s[4 * 33], s[5 * 33]); o.w = cvt_pk_bf16(s[6 * 33], s[7 * 33]);
        *(GAS u32x4*)(WT + (size_t)(drow + n) * K + k0 + 8 * c) = o; }
    LDS_WAIT(); asm volatile("" ::: "memory");
}
DI void phase_w(LAS unsigned char* lds, const Ctx& c, int l, int G) {
    const int tid = ltid(), lane = tid & 63, wave = rfl(tid >> 6);
    LAS float* scr = (LAS float*)(lds + wave * 16384);
    const int gw = lbid() * NWAVES + wave, NGW = G * NWAVES;
    constexpr int I_IN = (NIN / 32) * 16, I_GO = 512, I_AO = 256, I_OUT = 512, I_EXP = 16 * 512;
    constexpr int NITEMS = I_IN + I_GO + I_AO + I_OUT + 3 * I_EXP;
    for (int it = gw; it < NITEMS; it += NGW) {
        int r = it;
        if (r < I_IN) {
            const int nbg = r >> 4, kb = r & 15, n0 = 32 * nbg, tile = n0 >> 8, p = n0 & 255; int c0, nv = 32;
            if (tile < 12) c0 = n0;
            else if (tile < 24) { const int base = tile < 18 ? 3088 : 4624, tq = tile < 18 ? tile - 12 : tile - 18; c0 = base + (4 * tq + ((p & 127) >> 5)) * 64 + (p >= 128 ? 32 : 0); }
            else if (tile < 30) c0 = 6160 + (n0 - 24 * 256);
            else if (tile < 38) c0 = 7696 + (n0 - 30 * 256);
            else { c0 = 3072; nv = (p == 0) ? 16 : 0; }
            tr_item(c.w_in + (size_t)l * D * DIN, DIN, wsb(c, WS_WIN), D, n0, c0, nv, kb, scr, lane); continue; }
        r -= I_IN;
        if (r < I_GO) { tr_item(c.w_gla_o + (size_t)l * D * D, D, wsb(c, WS_WGO), D, 32 * (r >> 4), 32 * (r >> 4), 32, r & 15, scr, lane); continue; }
        r -= I_GO;
        if (r < I_AO) { tr_item(c.w_att_o + (size_t)l * 512 * D, D, wsb(c, WS_WAO), 512, 32 * (r >> 3), 32 * (r >> 3), 32, r & 7, scr, lane); continue; }
        r -= I_AO;
        if (r < I_OUT) { tr_item(c.w_out + (size_t)l * D * D, D, wsb(c, WS_WOUT), D, 32 * (r >> 4), 32 * (r >> 4), 32, r & 15, scr, lane); continue; }
        r -= I_OUT;
        const int which = r / I_EXP; r -= which * I_EXP; const int e = r >> 9, q = r & 511, nbg = q >> 4, kb = q & 15;
        const size_t eoff = (size_t)(l * NEXP + e) * D * DFF;
        if (which == 0) tr_item(c.w_e_gate + eoff, DFF, wsb(c, WS_WGU) + (size_t)e * 2048 * 1024, D, 256 * (nbg >> 2) + 32 * (nbg & 3), 32 * nbg, 32, kb, scr, lane);
        else if (which == 1) tr_item(c.w_e_up + eoff, DFF, wsb(c, WS_WGU) + (size_t)e * 2048 * 1024, D, 256 * (nbg >> 2) + 128 + 32 * (nbg & 3), 32 * nbg, 32, kb, scr, lane);
        else tr_item(c.w_e_down + eoff, D, wsb(c, WS_WD) + (size_t)e * 1024 * 1024, DFF, 32 * nbg, 32 * nbg, 32, kb, scr, lane);
    }
    if (l == 0) {
        const size_t n8 = (size_t)T * D / 8; bf16_t* xb = wsb(c, WS_XB);
        for (size_t i = (size_t)lbid() * NTHREADS + tid; i < n8; i += (size_t)G * NTHREADS) { const f32x4 a = *(const GAS f32x4*)(c.x + i * 8), b = *(const GAS f32x4*)(c.x + i * 8 + 4); *(GAS u32x4*)(xb + i * 8) = pack8(a, b); }
    }
}

DI s16x4 tr16(const LAS void* p) { return __builtin_bit_cast(s16x4, __builtin_amdgcn_ds_read_tr16_b64_v4i16((LAS s16x4*)p)); }
DI bf16x8 cat8(s16x4 lo, s16x4 hi) { return __builtin_shufflevector(lo, hi, 0, 1, 2, 3, 4, 5, 6, 7); }
#define MFMA16(a, b, c) __builtin_amdgcn_mfma_f32_16x16x32_bf16((a), (b), (c), 0, 0, 0)

constexpr int REC_BYTES = 33792, REC_KS = 16384, REC_DEC = 32768, OI_BYTES = 32768;
constexpr int GP_QT = 0, GP_KT = 17408, GP_VS = 34816, GP_ATT = 68608, GP_WUP = 77824, GP_BAL = 86016;
DI float exp_(float x) { return __builtin_amdgcn_exp2f(x * LOG2E); }
DI void unpack8(const u32x4& q, float (&v)[16], int o) { v[o] = bf_lo(q.x); v[o + 1] = bf_hi(q.x); v[o + 2] = bf_lo(q.y); v[o + 3] = bf_hi(q.y); v[o + 4] = bf_lo(q.z); v[o + 5] = bf_hi(q.z); v[o + 6] = bf_lo(q.w); v[o + 7] = bf_hi(q.w); }
DI u32x4 packf8(const float (&v)[16], int o) { u32x4 p; p.x = cvt_pk_bf16(v[o], v[o + 1]); p.y = cvt_pk_bf16(v[o + 2], v[o + 3]); p.z = cvt_pk_bf16(v[o + 4], v[o + 5]); p.w = cvt_pk_bf16(v[o + 6], v[o + 7]); return p; }
DI void gla_p_unit(LAS unsigned char* lds, const Ctx& c, int l, int bl, int h, int n, int& h_loaded) {
    const int tid = ltid(), lane = tid & 63, w = rfl(tid >> 6), fr = lane & 15, fq = lane >> 4;
    const size_t tok0 = (size_t)bl * SEQ + n * 64;
    const bf16_t* QG = wsb(c, WS_H + H_QG) + tok0 * 512 + h * 128;
    const bf16_t* KG = wsb(c, WS_H + H_KG) + tok0 * 512 + h * 128;
    const bf16_t* VG = wsb(c, WS_H + H_VG) + tok0 * 1024 + h * 256;
    const float* HA = (const float*)(c.ws + WS_HA) + tok0 * 16;
    const int unit = (bl * 4 + h) * 64 + n;
    unsigned char* rec = c.ws + WS_REC + (size_t)unit * REC_BYTES;
    unsigned char* oi = c.ws + WS_MIX + (size_t)unit * OI_BYTES;
    LAS bf16_t* QT = (LAS bf16_t*)(lds + GP_QT); LAS bf16_t* KT = (LAS bf16_t*)(lds + GP_KT); LAS bf16_t* VS = (LAS bf16_t*)(lds + GP_VS); LAS bf16_t* AT = (LAS bf16_t*)(lds + GP_ATT);
    LAS float* WUP = (LAS float*)(lds + GP_WUP); LAS float* BAL = (LAS float*)(lds + GP_BAL);
    __syncthreads();
    if (h_loaded != h) { for (int i = tid; i < 16 * 128; i += NTHREADS) WUP[i] = c.w_alpha_up[(size_t)l * 16 * 512 + (i >> 7) * 512 + h * 128 + (i & 127)];
        if (tid < 128) BAL[tid] = c.b_alpha[l * 512 + h * 128 + tid]; h_loaded = h; __syncthreads(); }
    {
        const int row = lane;
        f32x4 a4[4];
#pragma unroll
        for (int j = 0; j < 4; ++j) a4[j] = *(const GAS f32x4*)(HA + (size_t)row * 16 + 4 * j);
        const u32x4 q0 = *(const GAS u32x4*)(QG + (size_t)row * 512 + 16 * w), q1 = *(const GAS u32x4*)(QG + (size_t)row * 512 + 16 * w + 8);
        const u32x4 k0 = *(const GAS u32x4*)(KG + (size_t)row * 512 + 16 * w), k1 = *(const GAS u32x4*)(KG + (size_t)row * 512 + 16 * w + 8);
#pragma unroll
        for (int c2 = 0; c2 < 4; ++c2) { const int idx = tid + NTHREADS * c2, r = idx >> 5, ch = idx & 31; *(LAS u32x4*)(VS + r * 264 + ch * 8) = *(const GAS u32x4*)(VG + (size_t)r * 1024 + ch * 8); }
        float la[16];
#pragma unroll
        for (int cc = 0; cc < 16; ++cc) la[cc] = BAL[16 * w + cc];
#pragma unroll
        for (int j = 0; j < 16; ++j) { const float aj = a4[j >> 2][j & 3];
#pragma unroll
            for (int c4 = 0; c4 < 4; ++c4) { const f32x4 wv = *(const LAS f32x4*)(WUP + j * 128 + 16 * w + 4 * c4); la[4 * c4] += aj * wv[0]; la[4 * c4 + 1] += aj * wv[1]; la[4 * c4 + 2] += aj * wv[2]; la[4 * c4 + 3] += aj * wv[3]; } }
#pragma unroll
        for (int cc = 0; cc < 16; ++cc) { const float z = la[cc]; la[cc] = -(fmaxf(-z, 0.f) + __builtin_amdgcn_logf(1.0f + exp_(-fabsf(z))) * 0.6931471805599453f) * (1.0f / 16.0f); }
#pragma unroll
        for (int dlt = 1; dlt < 64; dlt <<= 1)
#pragma unroll
            for (int cc = 0; cc < 16; ++cc) { const float t = __shfl_up(la[cc], dlt); if (lane >= dlt) la[cc] += t; }
        float qv[16], kv[16];
        unpack8(q0, qv, 0); unpack8(q1, qv, 8); unpack8(k0, kv, 0); unpack8(k1, kv, 8);
        float dc[16];
#pragma unroll
        for (int cc = 0; cc < 16; ++cc) { const float b = la[cc]; const float bend = __shfl(b, 63); const float eb = exp_(b); dc[cc] = eb; qv[cc] *= eb; la[cc] = kv[cc] * exp_(bend - b); kv[cc] *= exp_(-b); }
        if (lane == 63) {
#pragma unroll
            for (int c4 = 0; c4 < 4; ++c4) *(GAS f32x4*)(rec + REC_DEC + (16 * w + 4 * c4) * 4) = (f32x4){dc[4 * c4], dc[4 * c4 + 1], dc[4 * c4 + 2], dc[4 * c4 + 3]}; }
        const u32x4 qa = packf8(qv, 0), qb = packf8(qv, 8), ka = packf8(kv, 0), kb = packf8(kv, 8), sa = packf8(la, 0), sb = packf8(la, 8);
        *(LAS u32x4*)(QT + row * 136 + 16 * w) = qa; *(LAS u32x4*)(QT + row * 136 + 16 * w + 8) = qb;
        *(LAS u32x4*)(KT + row * 136 + 16 * w) = ka; *(LAS u32x4*)(KT + row * 136 + 16 * w + 8) = kb;
        *(GAS u32x4*)(rec + row * 256 + (((2 * w) ^ (row & 15)) << 4)) = qa; *(GAS u32x4*)(rec + row * 256 + (((2 * w + 1) ^ (row & 15)) << 4)) = qb;
        *(GAS u32x4*)(rec + REC_KS + row * 256 + (((2 * w) ^ (2 * (row & 7))) << 4)) = sa; *(GAS u32x4*)(rec + REC_KS + row * 256 + (((2 * w + 1) ^ (2 * (row & 7))) << 4)) = sb;
    }
    __syncthreads();
#pragma unroll
    for (int rep = 0; rep < 2; ++rep) {
        const int tt = w + 8 * rep, jt = tt >> 2, it = tt & 3;
        f32x4 a = (f32x4){0.f, 0.f, 0.f, 0.f};
        if (jt <= it) {
#pragma unroll
            for (int k4 = 0; k4 < 4; ++k4) { const bf16x8 af = *(const LAS bf16x8*)(KT + (16 * jt + fr) * 136 + 32 * k4 + 8 * fq), bfr = *(const LAS bf16x8*)(QT + (16 * it + fr) * 136 + 32 * k4 + 8 * fq); a = MFMA16(af, bfr, a); }
        }
        const int i = 16 * it + fr, j0 = 16 * jt + 4 * fq;
        u32x2 o; o.x = cvt_pk_bf16(j0 <= i ? a[0] : 0.f, j0 + 1 <= i ? a[1] : 0.f); o.y = cvt_pk_bf16(j0 + 2 <= i ? a[2] : 0.f, j0 + 3 <= i ? a[3] : 0.f);
        *(LAS u32x2*)(AT + i * 72 + j0) = o;
    }
    __syncthreads();
    {
        const int dv0 = 32 * w;
        bf16x8 vb[2][2];
#pragma unroll
        for (int k2 = 0; k2 < 2; ++k2)
#pragma unroll
            for (int dt = 0; dt < 2; ++dt) { const LAS bf16_t* p = VS + (32 * k2 + 8 * fq + (fr >> 2)) * 264 + dv0 + 16 * dt + (fr & 3) * 4; vb[k2][dt] = cat8(tr16(p), tr16(p + 4 * 264)); }
#pragma unroll
        for (int tt = 0; tt < 4; ++tt) {
            const bf16x8 a0 = *(const LAS bf16x8*)(AT + (16 * tt + fr) * 72 + 8 * fq), a1 = *(const LAS bf16x8*)(AT + (16 * tt + fr) * 72 + 32 + 8 * fq);
#pragma unroll
            for (int dt = 0; dt < 2; ++dt) { f32x4 z = (f32x4){0.f, 0.f, 0.f, 0.f}; z = MFMA16(a0, vb[0][dt], z); z = MFMA16(a1, vb[1][dt], z);
                u32x2 pk; pk.x = cvt_pk_bf16(z[0], z[1]); pk.y = cvt_pk_bf16(z[2], z[3]); *(GAS u32x2*)(oi + ((w * 8 + tt * 2 + dt) * 64 + lane) * 8) = pk; }
        }
    }
}
constexpr int GS_STAGE = 66560, GS_KS = 16384, GS_DEC = 32768, GS_VS = 33792, GS_SS = 2 * GS_STAGE;
DI void gla_s_chain(LAS unsigned char* lds, const Ctx& c, int l, int bl, int h) {
    const int tid = ltid(), lane = tid & 63, w = rfl(tid >> 6), fr = lane & 15, fq = lane >> 4;
    const bf16_t* VG = wsb(c, WS_H + H_VG) + (size_t)bl * SEQ * 1024 + h * 256;
    const bf16_t* SR = wsb(c, WS_H + H_SR) + (size_t)bl * SEQ * 1024 + h * 256;
    bf16_t* OG = wsb(c, WS_OG) + (size_t)bl * SEQ * 1024 + h * 256;
    const unsigned char* rec0 = c.ws + WS_REC + (size_t)((bl * 4 + h) * 64) * REC_BYTES;
    const unsigned char* oi0 = c.ws + WS_MIX + (size_t)((bl * 4 + h) * 64) * OI_BYTES;
    LAS float* SS = (LAS float*)(lds + GS_SS);
    const int dv0 = 32 * w;
    const float gn0 = c.gla_norm[l * 1024 + h * 256 + dv0 + fr], gn1 = c.gla_norm[l * 1024 + h * 256 + dv0 + 16 + fr];
    f32x4 S[8][2];
#pragma unroll
    for (int a = 0; a < 8; ++a) { S[a][0] = (f32x4){0.f, 0.f, 0.f, 0.f}; S[a][1] = (f32x4){0.f, 0.f, 0.f, 0.f}; }
#define GS_DMA(gp, ldsoff) do { unsigned _sv; const unsigned _m = (unsigned)__builtin_amdgcn_readfirstlane((int)(ldsoff)); \
        asm volatile("s_mov_b32 %0, m0\n\ts_mov_b32 m0, %2\n\ts_nop 0\n\tglobal_load_lds_dwordx4 %1, off\n\ts_mov_b32 m0, %0" : "=&s"(_sv) : "v"(gp), "s"(_m) : "memory"); } while (0)
#define GS_PREFETCH(nn, st) do { const unsigned char* _r = rec0 + (size_t)(nn) * REC_BYTES; const unsigned _s = lds_u + (unsigned)(st) * GS_STAGE; \
        _Pragma("unroll") for (int _p = 0; _p < 4; ++_p) GS_DMA((const GAS unsigned char*)(_r + (w * 4 + _p) * 1024 + lane * 16), _s + (w * 4 + _p) * 1024); \
        if (w == 0) GS_DMA((const GAS unsigned char*)(_r + 32768 + lane * 16), _s + 32768); \
        _Pragma("unroll") for (int _p = 0; _p < 4; ++_p) { const int _row = 2 * (w * 4 + _p) + (lane >> 5); \
            GS_DMA((const GAS bf16_t*)(VG + (size_t)((nn) * 64 + _row) * 1024 + (((lane & 31) ^ (2 * (_row & 3))) << 3)), _s + GS_VS + (w * 4 + _p) * 1024); } } while (0)
    const unsigned lds_u = (unsigned)(uintptr_t)lds;
#define GS_BAR() do { asm volatile("s_waitcnt lgkmcnt(0)" ::: "memory"); __builtin_amdgcn_s_barrier(); asm volatile("" ::: "memory"); } while (0)
    __syncthreads();
    GS_PREFETCH(0, 0);
    for (int n = 0; n < 64; ++n) {
        const int st = n & 1; LAS unsigned char* sb_ = lds + st * GS_STAGE;
        LAS bf16_t* QT = (LAS bf16_t*)sb_; LAS bf16_t* KS = (LAS bf16_t*)(sb_ + GS_KS); LAS float* DEC = (LAS float*)(sb_ + GS_DEC); LAS bf16_t* VS = (LAS bf16_t*)(sb_ + GS_VS); LAS bf16_t* OST = (LAS bf16_t*)(sb_ + GS_KS);
        VM_WAIT(); GS_BAR();
        u32x2 oiv[8];
#pragma unroll
        for (int q = 0; q < 8; ++q) oiv[q] = *(const GAS u32x2*)(oi0 + (size_t)n * OI_BYTES + ((w * 8 + q) * 64 + lane) * 8);
        u32x4 srv[4];
#pragma unroll
        for (int c2 = 0; c2 < 4; ++c2) { const int idx = tid + NTHREADS * c2, r = idx >> 5, ch = idx & 31; srv[c2] = *(const GAS u32x4*)(SR + (size_t)(n * 64 + r) * 1024 + ch * 8); }
        asm volatile("" ::: "memory");
        if (n + 1 < 64) GS_PREFETCH(n + 1, st ^ 1);
        f32x4 o[4][2];
        {
            bf16x8 vb[2][2];
#pragma unroll
            for (int k2 = 0; k2 < 2; ++k2)
#pragma unroll
                for (int dt = 0; dt < 2; ++dt) { const int r0 = 32 * k2 + 8 * fq + (fr >> 2);
                    const LAS bf16_t* p = VS + r0 * 256 + ((((dv0 + 16 * dt) >> 3) ^ (2 * (r0 & 3))) << 3) + (fr & 3) * 4; vb[k2][dt] = cat8(tr16(p), tr16(p + 4 * 256)); }
#pragma unroll
            for (int tt = 0; tt < 4; ++tt) { o[tt][0] = (f32x4){0.f, 0.f, 0.f, 0.f}; o[tt][1] = (f32x4){0.f, 0.f, 0.f, 0.f}; }
#pragma unroll
            for (int s = 0; s < 4; ++s) {
                bf16x8 sb[2];
#pragma unroll
                for (int dt = 0; dt < 2; ++dt) { u32x4 pk; pk.x = cvt_pk_bf16(S[2 * s][dt][0], S[2 * s][dt][1]); pk.y = cvt_pk_bf16(S[2 * s][dt][2], S[2 * s][dt][3]); pk.z = cvt_pk_bf16(S[2 * s + 1][dt][0], S[2 * s + 1][dt][1]); pk.w = cvt_pk_bf16(S[2 * s + 1][dt][2], S[2 * s + 1][dt][3]); sb[dt] = __builtin_bit_cast(bf16x8, pk); }
#pragma unroll
                for (int tt = 0; tt < 4; ++tt) { const int i = 16 * tt + fr;
                    const LAS bf16_t* qp = QT + i * 128 + (fq & 1) * 4;
                    const bf16x8 af = cat8(*(const LAS s16x4*)(qp + (((4 * s + (fq >> 1)) ^ (i & 15)) << 3)), *(const LAS s16x4*)(qp + (((4 * s + 2 + (fq >> 1)) ^ (i & 15)) << 3)));
                    o[tt][0] = MFMA16(af, sb[0], o[tt][0]); o[tt][1] = MFMA16(af, sb[1], o[tt][1]); }
            }
#pragma unroll
            for (int k8 = 0; k8 < 8; ++k8) {
                const f32x4 dc = *(const LAS f32x4*)(DEC + 16 * k8 + 4 * fq);
                S[k8][0] *= dc; S[k8][1] *= dc;
#pragma unroll
                for (int k2 = 0; k2 < 2; ++k2) { const int r0 = 32 * k2 + 8 * fq + (fr >> 2);
                    const LAS bf16_t* p0 = KS + r0 * 128 + (((2 * k8) ^ (2 * (r0 & 7))) << 3) + (fr & 3) * 4; const LAS bf16_t* p1 = KS + (r0 + 4) * 128 + (((2 * k8) ^ (2 * ((r0 + 4) & 7))) << 3) + (fr & 3) * 4;
                    const bf16x8 af = cat8(tr16(p0), tr16(p1));
                    S[k8][0] = MFMA16(af, vb[k2][0], S[k8][0]); S[k8][1] = MFMA16(af, vb[k2][1], S[k8][1]); }
            }
        }
#pragma unroll
        for (int tt = 0; tt < 4; ++tt)
#pragma unroll
            for (int dt = 0; dt < 2; ++dt) { const u32x2 v = oiv[tt * 2 + dt]; o[tt][dt][0] += bf_lo(v.x); o[tt][dt][1] += bf_hi(v.x); o[tt][dt][2] += bf_lo(v.y); o[tt][dt][3] += bf_hi(v.y); }
#pragma unroll
        for (int tt = 0; tt < 4; ++tt) { f32x4 pp;
#pragma unroll
            for (int rg = 0; rg < 4; ++rg) { float p = o[tt][0][rg] * o[tt][0][rg] + o[tt][1][rg] * o[tt][1][rg];
                p += __shfl_xor(p, 1); p += __shfl_xor(p, 2); p += __shfl_xor(p, 4); p += __shfl_xor(p, 8); pp[rg] = p; }
            if (fr == 0) *(LAS f32x4*)(SS + w * 64 + 16 * tt + 4 * fq) = pp; }
        GS_BAR();
#pragma unroll
        for (int tt = 0; tt < 4; ++tt) { f32x4 ss = *(const LAS f32x4*)(SS + 16 * tt + 4 * fq);
#pragma unroll
            for (int ww = 1; ww < 8; ++ww) ss += *(const LAS f32x4*)(SS + ww * 64 + 16 * tt + 4 * fq);
#pragma unroll
            for (int rg = 0; rg < 4; ++rg) { const float rs = __builtin_amdgcn_rsqf(ss[rg] * (1.0f / 256.0f) + RMS_EPS); const int i = 16 * tt + 4 * fq + rg;
                OST[i * 264 + dv0 + fr] = (bf16_t)(cvt_pk_bf16(o[tt][0][rg] * rs * gn0, 0.f) & 0xffffu); OST[i * 264 + dv0 + 16 + fr] = (bf16_t)(cvt_pk_bf16(o[tt][1][rg] * rs * gn1, 0.f) & 0xffffu); } }
        GS_BAR();
#pragma unroll
        for (int c2 = 0; c2 < 4; ++c2) { const int idx = tid + NTHREADS * c2, r = idx >> 5, ch = idx & 31;
            const u32x4 ov = *(const LAS u32x4*)(OST + r * 264 + ch * 8); const u32x4 sv = srv[c2];
            u32x4 rr; rr.x = cvt_pk_bf16(bf_lo(ov.x) * bf_lo(sv.x), bf_hi(ov.x) * bf_hi(sv.x)); rr.y = cvt_pk_bf16(bf_lo(ov.y) * bf_lo(sv.y), bf_hi(ov.y) * bf_hi(sv.y));
            rr.z = cvt_pk_bf16(bf_lo(ov.z) * bf_lo(sv.z), bf_hi(ov.z) * bf_hi(sv.z)); rr.w = cvt_pk_bf16(bf_lo(ov.w) * bf_lo(sv.w), bf_hi(ov.w) * bf_hi(sv.w));
            *(GAS u32x4*)(OG + (size_t)(n * 64 + r) * 1024 + ch * 8) = rr; }
    }
#undef GS_PREFETCH
#undef GS_DMA
#undef GS_BAR
    VM_WAIT(); __syncthreads();
}

constexpr int AT_K = 0, AT_V = 36864;
DI void attn_unit(LAS unsigned char* lds, const Ctx& c, int bl, int g, int h, int x) {
    const int tid = ltid(), lane = tid & 63, w = rfl(tid >> 6), fr = lane & 15, fq = lane >> 4;
    const int dl = (g == 0) ? 1 : (g == 1 ? 4 : 16), nb = 32 / dl, r = x / nb, n = x - r * nb;
    const size_t tb = (size_t)bl * SEQ + r; const int colo = g * 512 + h * 64;
    const bf16_t* Q = wsb(c, WS_H + H_QD) + colo; const bf16_t* K = wsb(c, WS_H + H_KD) + colo; const bf16_t* V = wsb(c, WS_H + H_VD) + colo;
    LAS bf16_t* Ks = (LAS bf16_t*)(lds + AT_K); LAS bf16_t* Vs = (LAS bf16_t*)(lds + AT_V);
    const size_t tokq = tb + (size_t)dl * (128 * n + 16 * w + fr);
    bf16x8 qf[2];
#pragma unroll
    for (int d0 = 0; d0 < 2; ++d0) qf[d0] = *(const GAS bf16x8*)(Q + tokq * 1536 + 32 * d0 + 8 * fq);
    __syncthreads();
#pragma unroll
    for (int c2 = 0; c2 < 4; ++c2) { const int idx = tid + NTHREADS * c2, row = idx >> 3, ch = idx & 7; const int j = 128 * (n - 1) + row;
        u32x4 kv = (u32x4){0u, 0u, 0u, 0u}, vv = (u32x4){0u, 0u, 0u, 0u};
        if (j >= 0) { const size_t tok = tb + (size_t)dl * j; kv = *(const GAS u32x4*)(K + tok * 1536 + ch * 8); vv = *(const GAS u32x4*)(V + tok * 1536 + ch * 8); }
        *(LAS u32x4*)(Ks + row * 72 + ch * 8) = kv; *(LAS u32x4*)(Vs + row * 72 + ch * 8) = vv; }
    __syncthreads();
    f32x4 s[9]; float m = -1e30f;
#pragma unroll
    for (int kr = 0; kr < 9; ++kr) { const int kt = w + kr; f32x4 a = (f32x4){0.f, 0.f, 0.f, 0.f};
#pragma unroll
        for (int d0 = 0; d0 < 2; ++d0) { const bf16x8 af = *(const LAS bf16x8*)(Ks + (16 * kt + fr) * 72 + 32 * d0 + 8 * fq); a = MFMA16(af, qf[d0], a); }
#pragma unroll
        for (int rg = 0; rg < 4; ++rg) { const int rel = 16 * kr + 4 * fq + rg - fr; const bool ok = rel >= 0 && rel <= 128 && (n > 0 || 16 * kt + 4 * fq + rg >= 128); a[rg] = ok ? a[rg] : -1e30f; m = fmaxf(m, a[rg]); }
        s[kr] = a; }
    m = fmaxf(m, __shfl_xor(m, 16)); m = fmaxf(m, __shfl_xor(m, 32));
    float lsum = 0.f;
#pragma unroll
    for (int kr = 0; kr < 9; ++kr)
#pragma unroll
        for (int rg = 0; rg < 4; ++rg) { const float p = s[kr][rg] > -1e29f ? __builtin_amdgcn_exp2f(s[kr][rg] - m) : 0.f; s[kr][rg] = p; lsum += p; }
    lsum += __shfl_xor(lsum, 16); lsum += __shfl_xor(lsum, 32);
    f32x4 oT[4];
#pragma unroll
    for (int dt = 0; dt < 4; ++dt) oT[dt] = (f32x4){0.f, 0.f, 0.f, 0.f};
#pragma unroll
    for (int pp = 0; pp < 5; ++pp) { const int ka = 2 * pp, kb = (2 * pp + 1 < 9) ? 2 * pp + 1 : 8;
        u32x4 pk; pk.x = cvt_pk_bf16(s[ka][0], s[ka][1]); pk.y = cvt_pk_bf16(s[ka][2], s[ka][3]);
        if (2 * pp + 1 < 9) { pk.z = cvt_pk_bf16(s[kb][0], s[kb][1]); pk.w = cvt_pk_bf16(s[kb][2], s[kb][3]); } else { pk.z = 0u; pk.w = 0u; }
        const bf16x8 pf = __builtin_bit_cast(bf16x8, pk);
#pragma unroll
        for (int dt = 0; dt < 4; ++dt) { const LAS bf16_t* pa = Vs + (16 * (w + ka) + 4 * fq + (fr >> 2)) * 72 + 16 * dt + (fr & 3) * 4; const LAS bf16_t* pb = Vs + (16 * (w + kb) + 4 * fq + (fr >> 2)) * 72 + 16 * dt + (fr & 3) * 4;
            oT[dt] = MFMA16(cat8(tr16(pa), tr16(pb)), pf, oT[dt]); } }
    const float inv = 1.0f / lsum; const size_t tq = tb + (size_t)dl * (128 * n + 16 * w + fr);
    bf16_t* op = wsb(c, WS_ATTG) + ((size_t)g * TH + tq) * 512 + h * 64 + 4 * fq;
#pragma unroll
    for (int dt = 0; dt < 4; ++dt) { u32x2 o; o.x = cvt_pk_bf16(oT[dt][0] * inv, oT[dt][1] * inv); o.y = cvt_pk_bf16(oT[dt][2] * inv, oT[dt][3] * inv); *(GAS u32x2*)(op + 16 * dt) = o; }
    if (fq == 0) ((float*)(c.ws + WS_LSE))[((size_t)g * TH + tq) * 8 + h] = m + __builtin_amdgcn_logf(lsum);
}
DI void phase_p(LAS unsigned char* lds, const Ctx& c, int l, int G) {
    int h_loaded = -1;
    for (int u = lbid(); u < 8 * 4 * 64; u += G) gla_p_unit(lds, c, l, u >> 8, (u >> 6) & 3, u & 63, h_loaded);
}
DI void phase_b(LAS unsigned char* lds, const Ctx& c, int l, int G) {
    const int bid = lbid(); constexpr int NGLA = 32, NATT = 8 * 3 * 8 * 32;
    if (G >= 64) {
        if (bid < NGLA) gla_s_chain(lds, c, l, bid >> 2, bid & 3);
        else { const int k = bid - NGLA, W = G - NGLA; const int u0 = (int)((long)k * NATT / W), u1 = (int)((long)(k + 1) * NATT / W);
            for (int u = u0; u < u1; ++u) attn_unit(lds, c, u / 768, (u / 256) % 3, (u >> 5) & 7, u & 31); }
    } else {
        for (int id = bid; id < NGLA; id += G) gla_s_chain(lds, c, l, id >> 2, id & 3);
        for (int u = bid; u < NATT; u += G) attn_unit(lds, c, u / 768, (u / 256) % 3, (u >> 5) & 7, u & 31);
    }
}
DI void phase_f(const Ctx& c, int G) {
    const bf16_t* ag = wsb(c, WS_ATTG); const float* lse = (const float*)(c.ws + WS_LSE); bf16_t* att = wsb(c, WS_ATT);
    for (size_t i = (size_t)lbid() * NTHREADS + ltid(); i < (size_t)TH * 64; i += (size_t)G * NTHREADS) {
        const size_t tok = i >> 6; const int ch = (int)(i & 63), h = ch >> 3;
        const float l0 = lse[tok * 8 + h], l1 = lse[((size_t)TH + tok) * 8 + h], l2 = lse[((size_t)2 * TH + tok) * 8 + h];
        const float mx = fmaxf(l0, fmaxf(l1, l2)); float w0 = __builtin_amdgcn_exp2f(l0 - mx), w1 = __builtin_amdgcn_exp2f(l1 - mx), w2 = __builtin_amdgcn_exp2f(l2 - mx);
        const float inv = 1.0f / (w0 + w1 + w2); w0 *= inv; w1 *= inv; w2 *= inv;
        const u32x4 a = *(const GAS u32x4*)(ag + tok * 512 + ch * 8), b = *(const GAS u32x4*)(ag + ((size_t)TH + tok) * 512 + ch * 8), d = *(const GAS u32x4*)(ag + ((size_t)2 * TH + tok) * 512 + ch * 8);
        u32x4 o;
        o.x = cvt_pk_bf16(w0 * bf_lo(a.x) + w1 * bf_lo(b.x) + w2 * bf_lo(d.x), w0 * bf_hi(a.x) + w1 * bf_hi(b.x) + w2 * bf_hi(d.x));
        o.y = cvt_pk_bf16(w0 * bf_lo(a.y) + w1 * bf_lo(b.y) + w2 * bf_lo(d.y), w0 * bf_hi(a.y) + w1 * bf_hi(b.y) + w2 * bf_hi(d.y));
        o.z = cvt_pk_bf16(w0 * bf_lo(a.z) + w1 * bf_lo(b.z) + w2 * bf_lo(d.z), w0 * bf_hi(a.z) + w1 * bf_hi(b.z) + w2 * bf_hi(d.z));
        o.w = cvt_pk_bf16(w0 * bf_lo(a.w) + w1 * bf_lo(b.w) + w2 * bf_lo(d.w), w0 * bf_hi(a.w) + w1 * bf_hi(b.w) + w2 * bf_hi(d.w));
        *(GAS u32x4*)(att + tok * 512 + ch * 8) = o;
    }
}

DI float wave_sum(float v) {
#pragma unroll
    for (int o = 1; o < 64; o <<= 1) v += __shfl_xor(v, o);
    return v;
}
constexpr int R_WR = 0, R_HIST = 65536, R_BASE = 65536 + 64, R_INFO = 65536 + 128;
DI void phase_r(LAS unsigned char* lds, const Ctx& c, int l, int G) {
    const int tid = ltid(), lane = tid & 63, wave = rfl(tid >> 6);
    LAS float* WR = (LAS float*)(lds + R_WR); volatile LAS int* HIST = (volatile LAS int*)(lds + R_HIST); volatile LAS int* BASE = (volatile LAS int*)(lds + R_BASE); volatile LAS int* INFO = (volatile LAS int*)(lds + R_INFO);
    __syncthreads();
    for (int i = tid; i < 16 * 1024; i += NTHREADS) WR[(i & 15) * 1024 + (i >> 4)] = c.w_router[i];
    f32x4 g4[4], b4[4];
#pragma unroll
    for (int j = 0; j < 4; ++j) { g4[j] = *(const GAS f32x4*)(c.ln1_g + l * D + 4 * lane + 256 * j); b4[j] = *(const GAS f32x4*)(c.ln1_b + l * D + 4 * lane + 256 * j); }
    float* xo = c.out; bf16_t* xb = wsb(c, WS_XB); int* histg = (int*)(c.ws + WS_HISTG); float* gate = (float*)(c.ws + WS_GATE);
    for (int chunk = lbid(); chunk < T / 256; chunk += G) {
        __syncthreads();
        for (int rr = 0; rr < 32; ++rr) {
            const int rl = wave * 32 + rr; const size_t row = (size_t)chunk * 256 + rl;
            f32x4 v[4]; float s = 0.f;
#pragma unroll
            for (int j = 0; j < 4; ++j) { v[j] = *(const GAS f32x4*)(xo + row * D + 4 * lane + 256 * j); s += (v[j][0] + v[j][1]) + (v[j][2] + v[j][3]); }
            const float mean = wave_sum(s) * (1.0f / D); float s2 = 0.f;
#pragma unroll
            for (int j = 0; j < 4; ++j) { v[j] = v[j] - mean; s2 += (v[j][0] * v[j][0] + v[j][1] * v[j][1]) + (v[j][2] * v[j][2] + v[j][3] * v[j][3]); }
            const float rstd = __builtin_amdgcn_rsqf(wave_sum(s2) * (1.0f / D) + LN_EPS);
#pragma unroll
            for (int j = 0; j < 4; ++j) { v[j] = v[j] * rstd * g4[j] + b4[j]; *(GAS f32x4*)(xo + row * D + 4 * lane + 256 * j) = v[j];
                u32x2 pk; pk.x = cvt_pk_bf16(v[j][0], v[j][1]); pk.y = cvt_pk_bf16(v[j][2], v[j][3]); *(GAS u32x2*)(xb + row * D + 4 * lane + 256 * j) = pk; }
            float lg[16];
#pragma unroll
            for (int e = 0; e < 16; ++e) { float a = 0.f;
#pragma unroll
                for (int j = 0; j < 4; ++j) { const f32x4 wv = *(const LAS f32x4*)(WR + e * 1024 + 4 * lane + 256 * j); a += v[j][0] * wv[0] + v[j][1] * wv[1] + v[j][2] * wv[2] + v[j][3] * wv[3]; }
                lg[e] = wave_sum(a) + c.b_router[e]; }
            float mx = lg[0];
#pragma unroll
            for (int e = 1; e < 16; ++e) mx = fmaxf(mx, lg[e]);
            float se = 0.f;
#pragma unroll
            for (int e = 0; e < 16; ++e) { lg[e] = __expf(lg[e] - mx); se += lg[e]; }
            const float ise = 1.0f / se;
#pragma unroll
            for (int e = 0; e < 16; ++e) lg[e] *= ise;
            int gsel = 0; float gbest = -1.f;
#pragma unroll
            for (int gi = 0; gi < 4; ++gi) { const float a = lg[4 * gi], b = lg[4 * gi + 1], cc = lg[4 * gi + 2], d = lg[4 * gi + 3];
                const float sc = (a + b + cc + d) - fminf(fminf(a, b), fminf(cc, d)) - fminf(fmaxf(fminf(a, b), fminf(cc, d)), fminf(fmaxf(a, b), fmaxf(cc, d)));
                if (sc > gbest) { gbest = sc; gsel = gi; } }
            float p[4];
#pragma unroll
            for (int k = 0; k < 4; ++k) p[k] = gsel == 0 ? lg[k] : gsel == 1 ? lg[4 + k] : gsel == 2 ? lg[8 + k] : lg[12 + k];
            int i0 = 0; float v0 = p[0];
#pragma unroll
            for (int k = 1; k < 4; ++k) if (p[k] > v0) { v0 = p[k]; i0 = k; }
            int i1 = -1; float v1 = -1.f;
#pragma unroll
            for (int k = 0; k < 4; ++k) if (k != i0 && p[k] > v1) { v1 = p[k]; i1 = k; }
            if (lane == 0) { const int e0 = 4 * gsel + i0, e1 = 4 * gsel + i1; INFO[rl * 4 + 0] = e0; INFO[rl * 4 + 1] = e1;
                const float gs = 1.0f / (v0 + v1); gate[row * 2] = v0 * gs; gate[row * 2 + 1] = v1 * gs; }
        }
        __syncthreads();
        if (tid < 16) { int cnt = 0;
            for (int r = 0; r < 256; ++r) { if (INFO[r * 4] == tid) INFO[r * 4 + 2] = cnt++; else if (INFO[r * 4 + 1] == tid) INFO[r * 4 + 3] = cnt++; }
            histg[chunk * 16 + tid] = cnt; }
        __syncthreads();
        if (tid < 256) { i32x4 v; v.x = INFO[tid * 4]; v.y = INFO[tid * 4 + 1]; v.z = INFO[tid * 4 + 2]; v.w = INFO[tid * 4 + 3]; ((GAS i32x4*)(c.ws + WS_INFO))[(size_t)chunk * 256 + tid] = v; }
        __syncthreads();
    }
}
DI void phase_r2(LAS unsigned char* lds, const Ctx& c, int l, int G) {
    const int tid = ltid(); volatile LAS int* BASE = (volatile LAS int*)(lds + R_BASE);
    const int* histg = (const int*)(c.ws + WS_HISTG); int* list = (int*)(c.ws + WS_LIST);
    unsigned* cur = (unsigned*)(c.ws + WS_CTL) + CW_CUR + l * 16 * 64;
    for (int chunk = lbid(); chunk < T / 256; chunk += G) {
        __syncthreads();
        if (tid < 16) BASE[tid] = 0;
        __syncthreads();
        { const int e = tid & 15; int s = 0; for (int cc = tid >> 4; cc < chunk; cc += 32) s += histg[cc * 16 + e]; if (s) atomicAdd((int*)&BASE[e], s); }
        __syncthreads();
        if (tid < 256) { const i32x4 v = ((const GAS i32x4*)(c.ws + WS_INFO))[(size_t)chunk * 256 + tid]; const int row = chunk * 256 + tid;
            list[(size_t)v.x * T + BASE[v.x] + v.z] = row * 2; list[(size_t)v.y * T + BASE[v.y] + v.w] = row * 2 + 1; }
        if (chunk == T / 256 - 1 && tid < 16) __hip_atomic_store(cur + tid * 64, (unsigned)(BASE[tid] + histg[chunk * 16 + tid]), __ATOMIC_RELAXED, __HIP_MEMORY_SCOPE_AGENT);
    }
}
DI int moe_setup(LAS unsigned char* lds, const Ctx& c, int l) {
    volatile LAS int* PRE = (volatile LAS int*)(lds + MISC_OFF); volatile LAS int* CNT = PRE + 17;
    unsigned* cur = (unsigned*)(c.ws + WS_CTL) + CW_CUR + l * 16 * 64;
    __syncthreads();
    if (threadIdx.x == 0) { int acc = 0; for (int e = 0; e < 16; ++e) { const int n = (int)__hip_atomic_load(cur + e * 64, __ATOMIC_RELAXED, __HIP_MEMORY_SCOPE_AGENT); PRE[e] = acc; CNT[e] = n; acc += (n + 255) >> 8; } PRE[16] = acc; }
    __syncthreads();
    return rfl(PRE[16]);
}
DI void phase_c(const Ctx& c, int l, int G) {
    const int tid = ltid(), lane = tid & 63, wave = rfl(tid >> 6);
    f32x4 g4[4], b4[4];
#pragma unroll
    for (int j = 0; j < 4; ++j) { g4[j] = *(const GAS f32x4*)(c.ln2_g + l * D + 4 * lane + 256 * j); b4[j] = *(const GAS f32x4*)(c.ln2_b + l * D + 4 * lane + 256 * j); }
    float* xo = c.out; bf16_t* xb = wsb(c, WS_XB); const bf16_t* ys = wsb(c, WS_YS); const float* gate = (const float*)(c.ws + WS_GATE);
    for (size_t row = (size_t)lbid() * NWAVES + wave; row < (size_t)T; row += (size_t)G * NWAVES) {
        const float g0 = gate[row * 2], g1 = gate[row * 2 + 1];
        f32x4 v[4]; float s = 0.f;
#pragma unroll
        for (int j = 0; j < 4; ++j) { const f32x4 xr = *(const GAS f32x4*)(xo + row * D + 4 * lane + 256 * j);
            const u32x2 y0 = *(const GAS u32x2*)(ys + (row * 2) * D + 4 * lane + 256 * j), y1 = *(const GAS u32x2*)(ys + (row * 2 + 1) * D + 4 * lane + 256 * j);
            v[j][0] = xr[0] * DN_ALPHA + g0 * bf_lo(y0.x) + g1 * bf_lo(y1.x); v[j][1] = xr[1] * DN_ALPHA + g0 * bf_hi(y0.x) + g1 * bf_hi(y1.x);
            v[j][2] = xr[2] * DN_ALPHA + g0 * bf_lo(y0.y) + g1 * bf_lo(y1.y); v[j][3] = xr[3] * DN_ALPHA + g0 * bf_hi(y0.y) + g1 * bf_hi(y1.y);
            s += (v[j][0] + v[j][1]) + (v[j][2] + v[j][3]); }
        const float mean = wave_sum(s) * (1.0f / D); float s2 = 0.f;
#pragma unroll
        for (int j = 0; j < 4; ++j) { v[j] = v[j] - mean; s2 += (v[j][0] * v[j][0] + v[j][1] * v[j][1]) + (v[j][2] * v[j][2] + v[j][3] * v[j][3]); }
        const float rstd = __builtin_amdgcn_rsqf(wave_sum(s2) * (1.0f / D) + LN_EPS);
#pragma unroll
        for (int j = 0; j < 4; ++j) { v[j] = v[j] * rstd * g4[j] + b4[j]; *(GAS f32x4*)(xo + row * D + 4 * lane + 256 * j) = v[j];
            u32x2 pk; pk.x = cvt_pk_bf16(v[j][0], v[j][1]); pk.y = cvt_pk_bf16(v[j][2], v[j][3]); *(GAS u32x2*)(xb + row * D + 4 * lane + 256 * j) = pk; }
    }
}

DI Ctx load_ctx() {
    union { Ctx c; unsigned long long q[sizeof(Ctx) / 8]; } u;
#if defined(__HIP_DEVICE_COMPILE__)
    const __attribute__((address_space(4))) unsigned long long* p = (const __attribute__((address_space(4))) unsigned long long*)__builtin_amdgcn_kernarg_segment_ptr();
    asm volatile("" : "+s"(p));
#pragma unroll
    for (int i = 0; i < (int)(sizeof(Ctx) / 8); ++i) u.q[i] = p[i];
#endif
    return u.c;
}
#define CTX const Ctx c = load_ctx(); const int G = lgrid(); LAS unsigned char* lds = LDSBASE
__global__ void __launch_bounds__(NTHREADS, 2) mk_fwd(Ctx c_arg) {
    extern __shared__ __attribute__((aligned(16))) unsigned char lds_raw[];
#define LDSBASE ({ unsigned _b = (unsigned)(uintptr_t)(LAS unsigned char*)lds_raw; asm volatile("" : "+s"(_b)); (LAS unsigned char*)(uintptr_t)_b; })
    LAS unsigned char* lds0 = LDSBASE;
    const int tid = threadIdx.x; const Ctx c = load_ctx();
    volatile LAS unsigned* MISC = (volatile LAS unsigned*)(lds0 + MISC_OFF);
    if (tid < 64) MISC[tid] = 0u;
    __syncthreads();
    XcdBarrier bar; bar.bar = (unsigned*)(c.ws + WS_CTL) + CW_BAR; bar.x = 0; bar.st = MISC + 40;
    if (!MK_MULTI) bar = xcd_barrier_post((unsigned*)(c.ws + WS_CTL) + CW_BAR, MISC + 40);
    const int lo = c.lo, hi = c.hi; int step = 0;
#define RUN (lo <= step && step < hi)
#define END_STEP do { if (RUN && step + 1 < hi) { if (!MK_MULTI) xcd_barrier(bar); } ++step; } while (0)
    for (int l = 0; l < DEPTH; ++l) {
        if (RUN) { CTX; phase_w(lds, c, l, G); }
        END_STEP;
        for (int hf = 0; hf < 2; ++hf) {
            const size_t r0 = (size_t)hf * TH;
            if (RUN) {
                CTX;
                pg8::StaticOrder S; S.init(wsb(c, WS_XB) + r0 * D, wsb(c, WS_WIN), TH, NIN, D, G, lbid());
                EpiIn E{wsb(c, WS_H + H_QG), wsb(c, WS_H + H_KG), wsb(c, WS_H + H_VG), wsb(c, WS_H + H_SR), wsb(c, WS_H + H_QD), wsb(c, WS_H + H_KD), wsb(c, WS_H + H_VD), wsb(c, WS_H + H_GT), (float*)(c.ws + WS_HA), c.pos + r0};
                pg8::gemm_phase(lds, D, S, E);
            }
            END_STEP;
            if (RUN) { CTX; phase_p(lds, c, l, G); }
            END_STEP;
            if (RUN) { CTX; phase_b(lds, c, l, G); }
            END_STEP;
            if (RUN) { CTX; (void)lds; phase_f(c, G); }
            END_STEP;
            if (RUN) {
                CTX;
                pg8::StaticOrder S; S.init(wsb(c, WS_OG), wsb(c, WS_WGO), TH, D, D, G, lbid());
                EpiGate<false> E{wsb(c, WS_MIX), wsb(c, WS_H + H_GT)};
                pg8::gemm_phase(lds, D, S, E);
            }
            END_STEP;
            if (RUN) {
                CTX;
                pg8::StaticOrder S; S.init(wsb(c, WS_ATT), wsb(c, WS_WAO), TH, D, 512, G, lbid());
                EpiGate<true> E{wsb(c, WS_MIX), wsb(c, WS_H + H_GT) + 1024};
                pg8::gemm_phase(lds, 512, S, E);
            }
            END_STEP;
            if (RUN) {
                CTX;
                pg8::StaticOrder S; S.init(wsb(c, WS_MIX), wsb(c, WS_WOUT), TH, D, D, G, lbid());
                EpiRes E{(l == 0 ? c.x : c.out) + r0 * D, c.out + r0 * D};
                pg8::gemm_phase(lds, D, S, E);
            }
            END_STEP;
        }
        if (RUN) { CTX; phase_r(lds, c, l, G); }
        END_STEP;
        if (RUN) { CTX; phase_r2(lds, c, l, G); }
        END_STEP;
        if (RUN) {   CTX;
            const int ntiles = moe_setup(lds, c, l);
            volatile LAS int* PRE = (volatile LAS int*)(lds + MISC_OFF); volatile LAS int* TAB = (volatile LAS int*)(lds + TAB_OFF);
            pg8::MoeOrder S; S.G = G; S.c = lbid(); S.ntot = ntiles * 8; S.NC = 8; S.K = D; S.pre = PRE; S.cnt = PRE + 17; S.A = (const char*)wsb(c, WS_XB); S.Bt = (const char*)wsb(c, WS_WGU);
            S.bstride = (size_t)2048 * 1024 * 2; S.tab = TAB; S.gather = true;
            const int* list = (const int*)(c.ws + WS_LIST);
            { const int lt_tid = ltid(); const int r = lt_tid & 255, half = rfl(lt_tid >> 8);
              for (int i0 = 0; i0 < MAXU; i0 += 2) { Unit u; const int i = i0 + half;
                  if (S.next(i, u)) { const int lt = u.pm - PRE[u.e]; const int pos = 256 * lt + (r < u.nv ? r : 0); TAB[i * 256 + r] = list[(size_t)u.e * T + pos] >> 1; } } }
            __syncthreads();
            EpiM1 E{wsb(c, WS_HM)};
            pg8::gemm_phase(lds, D, S, E);
        }
        END_STEP;
        if (RUN) {   CTX;
            const int ntiles = moe_setup(lds, c, l);
            volatile LAS int* PRE = (volatile LAS int*)(lds + MISC_OFF);
            pg8::MoeOrder S; S.G = G; S.c = lbid(); S.ntot = ntiles * 4; S.NC = 4; S.K = DFF; S.pre = PRE; S.cnt = PRE + 17; S.A = (const char*)wsb(c, WS_HM); S.Bt = (const char*)wsb(c, WS_WD);
            S.bstride = (size_t)1024 * 1024 * 2; S.tab = nullptr; S.gather = false;
            EpiM2 E{wsb(c, WS_YS), (const int*)(c.ws + WS_LIST), PRE};
            pg8::gemm_phase(lds, DFF, S, E);
        }
        END_STEP;
        if (RUN) { CTX; (void)lds; phase_c(c, l, G); }
        END_STEP;
    }
#undef RUN
#undef END_STEP
}
constexpr int NSTEPS = DEPTH * (1 + 2 * 7 + 5);

extern "C" void kernel_launch(void* const* d_in, const int* in_sizes, int n_in, void* d_out, int out_size, void* d_ws, size_t ws_size, hipStream_t stream) {
    static int grid = 0;
    if (grid == 0) {
        if (n_in != 18 || in_sizes[0] != T * D || out_size != T * D || ws_size < WS_END) { fprintf(stderr, "kernel_launch: unexpected shapes / workspace (need %zu, got %zu)\n", (size_t)WS_END, ws_size); grid = -1; return; }
        int dev = 0, cus = 0;
        if (hipGetDevice(&dev) != hipSuccess || hipDeviceGetAttribute(&cus, hipDeviceAttributeMultiprocessorCount, dev) != hipSuccess) { grid = -1; return; }
        if (hipFuncSetAttribute((const void*)mk_fwd, hipFuncAttributeMaxDynamicSharedMemorySize, LDS_BYTES) != hipSuccess) { fprintf(stderr, "kernel_launch: hipFuncSetAttribute failed\n"); grid = -1; return; }
        int per_cu = 0;
        if (hipOccupancyMaxActiveBlocksPerMultiprocessor(&per_cu, (const void*)mk_fwd, NTHREADS, LDS_BYTES) != hipSuccess || per_cu < 1) { fprintf(stderr, "kernel_launch: occupancy query says %d\n", per_cu); }
        (void)hipGetLastError();
        grid = cus;
    }
    if (grid < 0) return;
    (void)hipMemsetAsync((char*)d_ws + WS_CTL, 0, CTL_ZERO_BYTES, stream);
    Ctx c{};
    c.x = (const float*)d_in[0]; c.pos = (const int*)d_in[1]; c.w_in = (const float*)d_in[2]; c.w_alpha_up = (const float*)d_in[3]; c.b_alpha = (const float*)d_in[4]; c.gla_norm = (const float*)d_in[5];
    c.w_gla_o = (const float*)d_in[6]; c.w_att_o = (const float*)d_in[7]; c.w_out = (const float*)d_in[8]; c.ln1_g = (const float*)d_in[9]; c.ln1_b = (const float*)d_in[10]; c.w_router = (const float*)d_in[11];
    c.b_router = (const float*)d_in[12]; c.w_e_gate = (const float*)d_in[13]; c.w_e_up = (const float*)d_in[14]; c.w_e_down = (const float*)d_in[15]; c.ln2_g = (const float*)d_in[16]; c.ln2_b = (const float*)d_in[17];
    c.out = (float*)d_out; c.ws = (unsigned char*)d_ws;
#if MK_MULTI
    for (int s = 0; s < NSTEPS; ++s) { c.lo = s; c.hi = s + 1; hipLaunchKernelGGL(mk_fwd, dim3(grid), dim3(NTHREADS), LDS_BYTES, stream, c); }
#else
    c.lo = 0; c.hi = NSTEPS; hipLaunchKernelGGL(mk_fwd, dim3(grid), dim3(NTHREADS), LDS_BYTES, stream, c);
#endif
}
```

```cpp
#include <hip/hip_runtime.h>
#include <cstdio>
#include <cstdint>

#ifndef MK_MULTI
#define MK_MULTI 0
#endif

#define DI __device__ __forceinline__
#define GAS __attribute__((address_space(1)))
#define LAS __attribute__((address_space(3)))
typedef unsigned short bf16_t;
typedef short bf16x8 __attribute__((ext_vector_type(8)));
typedef short s16x4 __attribute__((ext_vector_type(4)));
typedef float f32x4 __attribute__((ext_vector_type(4)));
typedef float f32x2 __attribute__((ext_vector_type(2)));
typedef unsigned u32x4 __attribute__((ext_vector_type(4)));
typedef unsigned u32x2 __attribute__((ext_vector_type(2)));
typedef int i32x4 __attribute__((ext_vector_type(4)));
#define LDS_WAIT() asm volatile("s_waitcnt lgkmcnt(0)" ::: "memory")
#define VM_WAIT() asm volatile("s_waitcnt vmcnt(0)" ::: "memory")

constexpr int D = 1024, NBATCH = 16, SEQ = 4096, T = NBATCH * SEQ, DEPTH = 4;
constexpr int TH = T / 2;
constexpr int DIN = 9744, NIN = 9984;
constexpr int NEXP = 16, DFF = 1024;
constexpr float LN_EPS = 1e-5f, RMS_EPS = 1e-6f;
constexpr float DN_ALPHA = 1.6817928305074290f;
constexpr float LOG2E = 1.4426950408889634f;
constexpr int NWAVES = 8, NTHREADS = 512;

constexpr size_t MiB = 1u << 20;
constexpr size_t WS_CTL = 0, CTL_ZERO_BYTES = 1 * MiB;
constexpr size_t WS_WIN = 1 * MiB;
constexpr size_t WS_WGO = WS_WIN + (size_t)NIN * D * 2;
constexpr size_t WS_WAO = WS_WGO + 2 * MiB;
constexpr size_t WS_WOUT = WS_WAO + 1 * MiB;
constexpr size_t WS_WGU = WS_WOUT + 2 * MiB;
constexpr size_t WS_WD = WS_WGU + 64 * MiB;
constexpr size_t WS_XB = WS_WD + 32 * MiB;
constexpr size_t WS_LIST = WS_XB + 128 * MiB;
constexpr size_t WS_GATE = WS_LIST + 4 * MiB;
constexpr size_t WS_INFO = WS_GATE + 1 * MiB;
constexpr size_t WS_HISTG = WS_INFO + 1 * MiB;
constexpr size_t WS_OG = WS_HISTG + 1 * MiB;
constexpr size_t WS_ATTG = WS_OG + 64 * MiB;
constexpr size_t WS_LSE = WS_ATTG + 96 * MiB;
constexpr size_t WS_ATT = WS_LSE + 3 * MiB;
constexpr size_t WS_MIX = WS_ATT + 32 * MiB;
constexpr size_t WS_HA = WS_MIX + 64 * MiB;
constexpr size_t WS_H = WS_HA + 2 * MiB;
constexpr size_t H_QG = 0, H_KG = H_QG + (size_t)TH * 512 * 2, H_VG = H_KG + (size_t)TH * 512 * 2, H_SR = H_VG + (size_t)TH * 1024 * 2,
                 H_QD = H_SR + (size_t)TH * 1024 * 2, H_KD = H_QD + (size_t)TH * 1536 * 2, H_VD = H_KD + (size_t)TH * 1536 * 2, H_GT = H_VD + (size_t)TH * 1536 * 2,
                 H_END = H_GT + (size_t)TH * 2048 * 2;
constexpr size_t WS_HM = WS_H;
constexpr size_t WS_YS = WS_HM + (size_t)(2 * T + 4096) * 1024 * 2;
constexpr size_t WS_REC = WS_H + H_END;
constexpr size_t WS_SLOC = WS_REC + (size_t)2048 * 33792;
constexpr size_t WS_DCUM = WS_SLOC + 16 * MiB;
constexpr size_t WS_END = WS_DCUM + 1 * MiB;
static_assert(WS_YS + (size_t)2 * T * 1024 * 2 <= WS_END, "MoE overlay fits");
constexpr int CW_BAR = 4096;
constexpr int CW_TKT = 24576;
constexpr int CW_CUR = 16384;

constexpr int RING_BYTES = 131072;
constexpr int TAB_OFF = RING_BYTES, MAXU = 18, TAB_BYTES = MAXU * 1024;
constexpr int MISC_OFF = TAB_OFF + TAB_BYTES;
constexpr int LDS_BYTES = MISC_OFF + 256;

DI int rfl(int v) { return __builtin_amdgcn_readfirstlane(v); }
DI int lbid() { int t = blockIdx.x; asm volatile("" : "+s"(t)); return t; }
DI int lgrid() { int t = gridDim.x; asm volatile("" : "+s"(t)); return t; }
DI int ltid() { int t = threadIdx.x; asm volatile("" : "+v"(t)); return t; }
DI float bf2f(unsigned b) { return __uint_as_float(b << 16); }
typedef __bf16 bf16x2_t __attribute__((ext_vector_type(2)));
DI unsigned cvt_pk_bf16(float lo, float hi) { f32x2 v = {lo, hi}; bf16x2_t b = __builtin_convertvector(v, bf16x2_t); return __builtin_bit_cast(unsigned, b); }
DI float bf_lo(unsigned w) { return __uint_as_float(w << 16); }
DI float bf_hi(unsigned w) { return __uint_as_float(w & 0xffff0000u); }
DI float sigmoidf_(float x) { return __builtin_amdgcn_rcpf(1.0f + __builtin_amdgcn_exp2f(-x * LOG2E)); }

#define XB_TMO      128
#define XB_XCNT(j)  (256  + 64 * (j))
#define XB_XSUB(j)  (1280 + 64 * (j))
#define XB_XGEN(j)  (2304 + 64 * (j))
#define XB_TOP      3328
#define XB_TOPGEN   3392
#define XCD_BAR_WORDS 3456
#define XB_SPIN_CAP (1u << 18)
DI unsigned xb_ld(unsigned* p)              { return __hip_atomic_load(p, __ATOMIC_RELAXED, __HIP_MEMORY_SCOPE_AGENT); }
DI unsigned xb_add(unsigned* p, unsigned v) { return __hip_atomic_fetch_add(p, v, __ATOMIC_RELAXED, __HIP_MEMORY_SCOPE_AGENT); }
DI unsigned xb_xcc_id() { return (unsigned)__builtin_amdgcn_s_getreg((3 << 11) | 20) & 0xFu; }
#define XB_SPIN(cond, bar) do { unsigned _sp = 0; while (cond) { __builtin_amdgcn_s_sleep(1); \
    if ((++_sp & 255u) == 0u) { if (xb_ld(&(bar)[XB_TMO])) break; if (_sp > XB_SPIN_CAP) { atomicAdd(&(bar)[XB_TMO], 1u); break; } } } } while (0)
struct XcdBarrier { unsigned* bar; unsigned x; volatile LAS unsigned* st; };
DI XcdBarrier xcd_barrier_post(unsigned* bar, volatile LAS unsigned* st) {
    XcdBarrier b; b.bar = bar; b.x = xb_xcc_id(); b.st = st;
    if (threadIdx.x == 0) (void)xb_add(&bar[XB_XCNT(b.x)], 1u);
    return b;
}
DI void xcd_barrier_complete(unsigned* bar, unsigned x, unsigned& nloc, unsigned& nx) {
    const unsigned G = gridDim.x * gridDim.y * gridDim.z;
    unsigned sum, cnt, mine, sp = 0u;
    for (;;) {
        sum = 0u; cnt = 0u; mine = 0u;
#pragma unroll
        for (unsigned j = 0; j < 16; ++j) { const unsigned c = xb_ld(&bar[XB_XCNT(j)]); sum += c; cnt += (c > 0u) ? 1u : 0u; mine = (j == x) ? c : mine; }
        if (sum == G) break;
        __builtin_amdgcn_s_sleep(1);
        if ((++sp & 255u) == 0u) { if (xb_ld(&bar[XB_TMO])) break; if (sp > XB_SPIN_CAP) { atomicAdd(&bar[XB_TMO], 1u); break; } }
    }
    nloc = mine > 0u ? mine : 1u; nx = cnt > 0u ? cnt : 1u;
}
DI void xcd_barrier(const XcdBarrier& b) {
    asm volatile("s_waitcnt vmcnt(0)" ::: "memory");
    __syncthreads();
    if (threadIdx.x == 0) {
        unsigned* bar = b.bar;
        __builtin_amdgcn_s_waitcnt(0);
        unsigned nloc = b.st[0], nx = b.st[1];
        if (nloc == 0u) { xcd_barrier_complete(bar, b.x, nloc, nx); b.st[0] = nloc; b.st[1] = nx; }
        const unsigned old = xb_add(&bar[XB_XSUB(b.x)], 1u);
        const unsigned gen = old / nloc;
        if (old + 1u == (gen + 1u) * nloc) {
            __builtin_amdgcn_fence(__ATOMIC_RELEASE, "agent");
            asm volatile("s_waitcnt vmcnt(0)" ::: "memory");
            const unsigned og = xb_add(&bar[XB_TOP], 1u);
            const unsigned tg = og / nx;
            if (og + 1u == (tg + 1u) * nx) xb_add(&bar[XB_TOPGEN], 1u);
            else XB_SPIN(xb_ld(&bar[XB_TOPGEN]) == tg, bar);
            __builtin_amdgcn_fence(__ATOMIC_ACQUIRE, "agent");
            xb_add(&bar[XB_XGEN(b.x)], 1u);
            asm volatile("s_waitcnt vmcnt(0)" ::: "memory");
        } else {
            XB_SPIN(xb_ld(&bar[XB_XGEN(b.x)]) == gen, bar);
            __builtin_amdgcn_fence(__ATOMIC_ACQUIRE, "agent");
            asm volatile("s_waitcnt vmcnt(0)" ::: "memory");
        }
    }
    __syncthreads();
}

struct Ctx {
    const float* x; const int* pos; const float* w_in; const float* w_alpha_up; const float* b_alpha; const float* gla_norm;
    const float* w_gla_o; const float* w_att_o; const float* w_out; const float* ln1_g; const float* ln1_b; const float* w_router; const float* b_router;
    const float* w_e_gate; const float* w_e_up; const float* w_e_down; const float* ln2_g; const float* ln2_b;
    float* out; unsigned char* ws;
    int lo, hi;
};
DI bf16_t* wsb(const Ctx& c, size_t off) { return (bf16_t*)(c.ws + off); }

namespace pg8 {
constexpr int BM = 256, BK = 64, HALF = 128, HTB = HALF * BK * 2, STAGE_BYTES = 8 * HTB, NXCD = 8, WGM = 8;
DI int lds_byte(int r, int c) { const int st = (r >> 4) * 2 + (c >> 5), rr = r & 15, cc = c & 31, ob = rr * 64 + cc * 2; return st * 1024 + (ob ^ (((ob >> 9) & 1) << 5)); }
DI void stage_rc(int b, int& R, int& C) { const int st = b / 1024, sb = b % 1024, swz = sb ^ (((sb >> 9) & 1) << 5); R = (st >> 1) * 16 + swz / 64; C = (st & 1) * 32 + (swz % 64) / 2; }
DI int perm32(int rho) { const int n = rho >> 4, i = rho & 15; return 8 * (i >> 2) + 4 * n + (i & 3); }
struct Unit { int pm, pn, e, nv, ui; };

struct StaticOrder {
    int nM, nN, nwg, G, c, K; const char* A; const char* Bt;
    DI void init(const void* A_, const void* Bt_, int M, int N, int K_, int G_, int c_) { A = (const char*)A_; Bt = (const char*)Bt_; nM = M / BM; nN = N / BM; nwg = nM * nN; G = G_; c = c_; K = K_; }
    DI bool next(int i, Unit& u) const {
        const long L = (long)i * G + c; if (L >= nwg) return false;
        int wgid = (int)L; { const int q = nwg / NXCD, r = nwg % NXCD, xcd = wgid % NXCD, off = wgid / NXCD; wgid = (xcd < r ? xcd * (q + 1) : r * (q + 1) + (xcd - r) * q) + off; }
        const int nig = WGM * nN, gid = wgid / nig, fm = gid * WGM, gsz = (nM - fm) < WGM ? (nM - fm) : WGM;
        u.pm = fm + ((wgid % nig) % gsz); u.pn = (wgid % nig) / gsz; u.e = 0; u.nv = 256; u.ui = i; return true;
    }
    DI const char* a_base(const Unit& u) const { return A + (size_t)u.pm * BM * K * 2; }
    DI const char* b_base(const Unit& u) const { return Bt + (size_t)u.pn * BM * K * 2; }
    DI void a_off(const Unit&, int tid, unsigned (&o)[2][2]) const {
#pragma unroll
        for (int i = 0; i < 2; ++i) { int R, C; stage_rc(tid * 16 + i * 8192, R, C);
#pragma unroll
            for (int h = 0; h < 2; ++h) o[h][i] = (unsigned)((h * HALF + R) * K + C) * 2u; }
    }
};
struct MoeOrder {
    int G, c, ntot, NC, K; const volatile LAS int* pre; const volatile LAS int* cnt; const char* A; const char* Bt; size_t bstride; const volatile LAS int* tab; bool gather;
    DI bool next(int i, Unit& u) const {
        const int L = i * G + c; if (L >= ntot) return false;
        const int rt = L / NC; u.pn = L - rt * NC; u.pm = rt;
        int e = 0;
#pragma unroll
        for (int j = 1; j < 16; ++j) e += (rt >= rfl(pre[j])) ? 1 : 0;
        e = rfl(e); u.e = e; const int rem = rfl(cnt[e]) - 256 * (rt - rfl(pre[e])); u.nv = rem < 256 ? rem : 256; u.ui = i; return true;
    }
    DI const char* a_base(const Unit& u) const { return gather ? A : A + (size_t)u.pm * BM * K * 2; }
    DI const char* b_base(const Unit& u) const { return Bt + (size_t)u.e * bstride + (size_t)u.pn * BM * K * 2; }
    DI void a_off(const Unit& u, int tid, unsigned (&o)[2][2]) const {
#pragma unroll
        for (int i = 0; i < 2; ++i) { int R, C; stage_rc(tid * 16 + i * 8192, R, C);
#pragma unroll
            for (int h = 0; h < 2; ++h) { const int row = gather ? tab[u.ui * 256 + h * HALF + R] : (h * HALF + R); o[h][i] = (unsigned)(row * K + C) * 2u; } }
    }
};

template <class Epi, class Sched>
DI void gemm_phase(LAS unsigned char* lds, const int K, const Sched& S, const Epi& E) {
    const int tid = ltid(), wid = rfl(tid >> 6), lane = tid & 63, wr = wid >> 2, wc = wid & 3, fr = lane & 15, fq = lane >> 4;
    const int nt = K / BK;
    unsigned voffB[2];
#pragma unroll
    for (int i = 0; i < 2; ++i) { int R, C; stage_rc(tid * 16 + i * 8192, R, C); const int Rb = Epi::PERM ? ((R & ~31) + perm32(R & 31)) : R; voffB[i] = (unsigned)(Rb * K + C) * 2u; }
    const size_t kstep = (size_t)(BK * 2);
    const size_t hstep = (size_t)HALF * K * 2;
    const unsigned ldsw = (unsigned)wid * 1024u;
    const int aoff = lds_byte(wr * 64 + fr, fq * 8), boff = lds_byte(wc * 32 + fr, fq * 8);
#define PG8_SA(b, h) (((b) * 2 + (h)) * HTB)
#define PG8_SB(b, h) ((4 + (b) * 2 + (h)) * HTB)
#define PG8_STAGE(bufoff, gbase, voff) do { _Pragma("unroll") for (int _i = 0; _i < 2; ++_i) \
        __builtin_amdgcn_global_load_lds((const unsigned*)((const char*)(gbase) + (voff)[_i]), (LAS unsigned*)(lds + (bufoff) + ldsw + _i * 8192), 16, 0, 0); } while (0)
#define PG8_LDA(dst, b, h) do { _Pragma("unroll") for (int m = 0; m < 4; ++m) _Pragma("unroll") for (int k = 0; k < 2; ++k) dst[m][k] = *(const LAS bf16x8*)(lds + PG8_SA(b, h) + aoff + m * 2048 + k * 1024); } while (0)
#define PG8_LDB(dst, b, h) do { _Pragma("unroll") for (int n = 0; n < 2; ++n) _Pragma("unroll") for (int k = 0; k < 2; ++k) dst[n][k] = *(const LAS bf16x8*)(lds + PG8_SB(b, h) + boff + n * 2048 + k * 1024); } while (0)
#define PG8_MMA(ai, bj, At, Bt) do { __builtin_amdgcn_s_setprio(1); _Pragma("unroll") for (int m = 0; m < 4; ++m) _Pragma("unroll") for (int n = 0; n < 2; ++n) _Pragma("unroll") for (int k = 0; k < 2; ++k) \
        acc[ai][bj][m][n] = __builtin_amdgcn_mfma_f32_16x16x32_bf16(Bt[n][k], At[m][k], acc[ai][bj][m][n], 0, 0, 0); __builtin_amdgcn_s_setprio(0); } while (0)
#define PG8_WAIT_V(n) asm volatile("s_waitcnt vmcnt(" #n ")" ::: "memory")
#define PG8_WAIT_L(n) asm volatile("s_waitcnt lgkmcnt(" #n ")" ::: "memory")
#define PG8_BAR __builtin_amdgcn_s_barrier()
#define PG8_SCHED __builtin_amdgcn_sched_barrier(0)
    Unit cur, nxt; int ui = 0;
    if (!S.next(0, cur)) return;
    f32x4 acc[2][2][4][2];
#pragma unroll
    for (int a = 0; a < 2; ++a)
#pragma unroll
        for (int b = 0; b < 2; ++b)
#pragma unroll
            for (int m = 0; m < 4; ++m)
#pragma unroll
                for (int n = 0; n < 2; ++n) acc[a][b][m][n] = (f32x4){0.f, 0.f, 0.f, 0.f};
    bf16x8 At[4][2], B0[2][2], B1[2][2];
    unsigned oA[2][2]; S.a_off(cur, tid, oA);
    const char* cA = S.a_base(cur); const char* cB = S.b_base(cur);
    PG8_STAGE(PG8_SB(0, 0), cB, voffB); PG8_STAGE(PG8_SB(0, 1), cB + hstep, voffB); PG8_STAGE(PG8_SA(0, 0), cA, oA[0]); PG8_STAGE(PG8_SA(0, 1), cA, oA[1]);
    if (wr == 1) PG8_BAR;
    PG8_WAIT_V(2); PG8_BAR;
    PG8_STAGE(PG8_SB(1, 0), cB + kstep, voffB); PG8_STAGE(PG8_SA(1, 0), cA + kstep, oA[0]); PG8_STAGE(PG8_SB(1, 1), cB + hstep + kstep, voffB);
    PG8_WAIT_V(6); PG8_BAR;
    for (;;) {
        const bool has_next = S.next(ui + 1, nxt);
        const char* nA = has_next ? S.a_base(nxt) : cA; const char* nB = has_next ? S.b_base(nxt) : cB;
        for (int t = 0; t < nt; t += 2) {
            const bool last = (t == nt - 2);
            const char* a1 = cA + (size_t)(t + 1) * kstep;
            const char* a2 = last ? nA : cA + (size_t)(t + 2) * kstep; const char* b2 = last ? nB : cB + (size_t)(t + 2) * kstep;
            const char* a3 = a2 + kstep; const char* b3 = b2 + kstep;
            PG8_LDB(B0, 0, 0); PG8_LDB(B1, 0, 1); PG8_SCHED; PG8_LDA(At, 0, 0); PG8_STAGE(PG8_SA(1, 1), a1, oA[1]);
            if (last && has_next) S.a_off(nxt, tid, oA);
            PG8_WAIT_V(8); PG8_WAIT_L(0); PG8_BAR; PG8_MMA(0, 0, At, B0); PG8_MMA(0, 1, At, B1); PG8_BAR; PG8_SCHED;
            PG8_LDA(At, 0, 1); PG8_STAGE(PG8_SB(0, 0), b2, voffB); PG8_STAGE(PG8_SB(0, 1), b2 + hstep, voffB); PG8_STAGE(PG8_SA(0, 0), a2, oA[0]);
            PG8_WAIT_V(8); PG8_WAIT_L(0); PG8_BAR; PG8_MMA(1, 0, At, B0); PG8_MMA(1, 1, At, B1); PG8_BAR; PG8_SCHED;
            PG8_LDB(B0, 1, 0); PG8_LDB(B1, 1, 1); PG8_SCHED; PG8_LDA(At, 1, 0); PG8_STAGE(PG8_SA(0, 1), a2, oA[1]);
            PG8_WAIT_V(8); PG8_WAIT_L(0); PG8_BAR; PG8_MMA(0, 0, At, B0); PG8_MMA(0, 1, At, B1); PG8_BAR; PG8_SCHED;
            PG8_LDA(At, 1, 1); PG8_STAGE(PG8_SB(1, 0), b3, voffB); PG8_STAGE(PG8_SB(1, 1), b3 + hstep, voffB); PG8_STAGE(PG8_SA(1, 0), a3, oA[0]);
            PG8_WAIT_V(8); PG8_WAIT_L(0); PG8_BAR; PG8_MMA(1, 0, At, B0); PG8_MMA(1, 1, At, B1); PG8_BAR; PG8_SCHED;
        }
        if (wr == 0) PG8_BAR;
        E(acc, cur, wr, wc, fr, fq);
        if (!has_next) break;
#pragma unroll
        for (int a = 0; a < 2; ++a)
#pragma unroll
            for (int b = 0; b < 2; ++b)
#pragma unroll
                for (int m = 0; m < 4; ++m)
#pragma unroll
                    for (int n = 0; n < 2; ++n) acc[a][b][m][n] = (f32x4){0.f, 0.f, 0.f, 0.f};
        cur = nxt; cA = nA; cB = nB; ++ui;
        if (wr == 1) PG8_BAR;
    }
    PG8_WAIT_V(0);
    PG8_BAR;
#undef PG8_SA
#undef PG8_SB
#undef PG8_STAGE
#undef PG8_LDA
#undef PG8_LDB
#undef PG8_MMA
#undef PG8_WAIT_V
#undef PG8_WAIT_L
#undef PG8_BAR
#undef PG8_SCHED
}
}
using pg8::Unit;

DI u32x4 pack8(const f32x4& v0, const f32x4& v1) { u32x4 w; w.x = cvt_pk_bf16(v0[0], v0[1]); w.y = cvt_pk_bf16(v0[2], v0[3]); w.z = cvt_pk_bf16(v1[0], v1[1]); w.w = cvt_pk_bf16(v1[2], v1[3]); return w; }

struct EpiIn {
    static constexpr bool PERM = true;
    bf16_t *qg, *kg, *vg, *sr, *qd, *kd, *vd, *gt; float* ha; const int* pos;
    DI void operator()(const f32x4 (&acc)[2][2][4][2], const Unit& u, int wr, int wc, int fr, int fq) const {
        const int row0 = u.pm * 256 + wr * 64 + fr; const int pn = u.pn;
        if (pn >= 12 && pn < 24) {
            bf16_t* base = pn < 18 ? qd : kd; const int tq = pn < 18 ? pn - 12 : pn - 18; const float sc = pn < 18 ? 0.125f * LOG2E : 1.0f;
            float fre[8];
#pragma unroll
            for (int i = 0; i < 8; ++i) fre[i] = __builtin_amdgcn_exp2f(-(float)(8 * fq + i) * (13.287712379549449f / 32.0f)) * 0.15915494309189535f;
#pragma unroll
            for (int ai = 0; ai < 2; ++ai)
#pragma unroll
                for (int m = 0; m < 4; ++m) {
                    const int r = row0 + ai * 128 + m * 16; const float p = (float)pos[r];
                    bf16_t* rowp = base + (size_t)r * 1536 + (4 * tq + wc) * 64 + 8 * fq;
#pragma unroll
                    for (int n = 0; n < 2; ++n) { f32x4 o1, o2;
#pragma unroll
                        for (int j = 0; j < 4; ++j) {
                            float a = p * fre[n * 4 + j]; a = a - __builtin_floorf(a);
                            const float sn = __builtin_amdgcn_sinf(a), cs = __builtin_amdgcn_cosf(a);
                            const float x1 = acc[ai][0][m][n][j], x2 = acc[ai][1][m][n][j];
                            o1[j] = (x1 * cs - x2 * sn) * sc; o2[j] = (x2 * cs + x1 * sn) * sc;
                        }
                        u32x2 w1, w2; w1.x = cvt_pk_bf16(o1[0], o1[1]); w1.y = cvt_pk_bf16(o1[2], o1[3]); w2.x = cvt_pk_bf16(o2[0], o2[1]); w2.y = cvt_pk_bf16(o2[2], o2[3]);
                        *(GAS u32x2*)(rowp + 4 * n) = w1; *(GAS u32x2*)(rowp + 32 + 4 * n) = w2; }
                    asm volatile("" ::: "memory");
                }
        } else if (pn == 38) {
            if (wc == 0 && fq < 2) {
#pragma unroll
                for (int ai = 0; ai < 2; ++ai)
#pragma unroll
                    for (int m = 0; m < 4; ++m) { float* p = ha + (size_t)(row0 + ai * 128 + m * 16) * 16 + 8 * fq; *(GAS f32x4*)p = acc[ai][0][m][0]; *(GAS f32x4*)(p + 4) = acc[ai][0][m][1]; }
            }
        } else {
            bf16_t* base; int ldc, colt, act = 0; float sc = 1.0f;
            if (pn < 2) { base = qg; ldc = 512; colt = pn * 256; sc = 0.08838834764831845f; }
            else if (pn < 4) { base = kg; ldc = 512; colt = (pn - 2) * 256; }
            else if (pn < 8) { base = vg; ldc = 1024; colt = (pn - 4) * 256; }
            else if (pn < 12) { base = sr; ldc = 1024; colt = (pn - 8) * 256; act = 1; }
            else if (pn < 30) { base = vd; ldc = 1536; colt = (pn - 24) * 256; }
            else { base = gt; ldc = 2048; colt = (pn - 30) * 256; act = 2; }
#pragma unroll
            for (int ai = 0; ai < 2; ++ai)
#pragma unroll
                for (int m = 0; m < 4; ++m) { bf16_t* rowp = base + (size_t)(row0 + ai * 128 + m * 16) * ldc + colt + wc * 32 + 8 * fq;
#pragma unroll
                    for (int bj = 0; bj < 2; ++bj) { f32x4 v0 = acc[ai][bj][m][0] * sc, v1 = acc[ai][bj][m][1] * sc;
                        if (act) {
#pragma unroll
                            for (int j = 0; j < 4; ++j) { const float s0 = sigmoidf_(v0[j]), s1 = sigmoidf_(v1[j]); v0[j] = act == 1 ? v0[j] * s0 : s0; v1[j] = act == 1 ? v1[j] * s1 : s1; } }
                        *(GAS u32x4*)(rowp + bj * 128) = pack8(v0, v1); } }
        }
    }
};
template <bool ADD> struct EpiGate {
    static constexpr bool PERM = true;
    bf16_t* mix; const bf16_t* gt;
    DI void operator()(const f32x4 (&acc)[2][2][4][2], const Unit& u, int wr, int wc, int fr, int fq) const {
        const int row0 = u.pm * 256 + wr * 64 + fr, col0 = u.pn * 256 + wc * 32 + 8 * fq;
#pragma unroll
        for (int ai = 0; ai < 2; ++ai)
#pragma unroll
            for (int m = 0; m < 4; ++m) { const size_t r = (size_t)(row0 + ai * 128 + m * 16);
#pragma unroll
                for (int bj = 0; bj < 2; ++bj) {
                    const u32x4 g = *(const GAS u32x4*)(gt + r * 2048 + col0 + bj * 128);
                    f32x4 v0 = acc[ai][bj][m][0], v1 = acc[ai][bj][m][1];
                    v0[0] *= bf_lo(g.x); v0[1] *= bf_hi(g.x); v0[2] *= bf_lo(g.y); v0[3] *= bf_hi(g.y); v1[0] *= bf_lo(g.z); v1[1] *= bf_hi(g.z); v1[2] *= bf_lo(g.w); v1[3] *= bf_hi(g.w);
                    bf16_t* mp = mix + r * 1024 + col0 + bj * 128;
                    if (ADD) { const u32x4 o = *(const GAS u32x4*)mp; v0[0] += bf_lo(o.x); v0[1] += bf_hi(o.x); v0[2] += bf_lo(o.y); v0[3] += bf_hi(o.y); v1[0] += bf_lo(o.z); v1[1] += bf_hi(o.z); v1[2] += bf_lo(o.w); v1[3] += bf_hi(o.w); }
                    *(GAS u32x4*)mp = pack8(v0, v1); } }
    }
};
struct EpiRes {
    static constexpr bool PERM = false;
    const float* xres; float* z;
    DI void operator()(const f32x4 (&acc)[2][2][4][2], const Unit& u, int wr, int wc, int fr, int fq) const {
        const int row0 = u.pm * 256 + wr * 64 + fr, col0 = u.pn * 256 + wc * 32 + 4 * fq;
#pragma unroll
        for (int ai = 0; ai < 2; ++ai)
#pragma unroll
            for (int m = 0; m < 4; ++m) { const size_t off = (size_t)(row0 + ai * 128 + m * 16) * 1024 + col0;
#pragma unroll
                for (int bj = 0; bj < 2; ++bj)
#pragma unroll
                    for (int n = 0; n < 2; ++n) { const f32x4 xr = *(const GAS f32x4*)(xres + off + bj * 128 + n * 16); *(GAS f32x4*)(z + off + bj * 128 + n * 16) = xr * DN_ALPHA + acc[ai][bj][m][n]; }
                asm volatile("" ::: "memory"); }
    }
};
struct EpiM1 {
    static constexpr bool PERM = true;
    bf16_t* hm;
    DI void operator()(const f32x4 (&acc)[2][2][4][2], const Unit& u, int wr, int wc, int fr, int fq) const {
        const int row0 = u.pm * 256 + wr * 64 + fr, col0 = u.pn * 128 + wc * 32 + 8 * fq;
#pragma unroll
        for (int ai = 0; ai < 2; ++ai)
#pragma unroll
            for (int m = 0; m < 4; ++m) { f32x4 v0, v1;
#pragma unroll
                for (int j = 0; j < 4; ++j) { const float g0 = acc[ai][0][m][0][j], g1 = acc[ai][0][m][1][j]; v0[j] = g0 * sigmoidf_(g0) * acc[ai][1][m][0][j]; v1[j] = g1 * sigmoidf_(g1) * acc[ai][1][m][1][j]; }
                *(GAS u32x4*)(hm + (size_t)(row0 + ai * 128 + m * 16) * 1024 + col0) = pack8(v0, v1); }
    }
};
struct EpiM2 {
    static constexpr bool PERM = true;
    bf16_t* ys; const int* list; const volatile LAS int* pre;
    DI void operator()(const f32x4 (&acc)[2][2][4][2], const Unit& u, int wr, int wc, int fr, int fq) const {
        const int lrow0 = wr * 64 + fr, col0 = u.pn * 256 + wc * 32 + 8 * fq; const int lt = u.pm - rfl(pre[u.e]);
        const int* lp = list + (size_t)u.e * T + 256 * lt;
#pragma unroll
        for (int ai = 0; ai < 2; ++ai)
#pragma unroll
            for (int m = 0; m < 4; ++m) { const int r = lrow0 + ai * 128 + m * 16;
                if (r < u.nv) { const int slot = lp[r]; bf16_t* yp = ys + (size_t)slot * 1024 + col0;
#pragma unroll
                    for (int bj = 0; bj < 2; ++bj) *(GAS u32x4*)(yp + bj * 128) = pack8(acc[ai][bj][m][0], acc[ai][bj][m][1]); } }
    }
};

DI void tr_item(const float* W, int N, bf16_t* WT, int K, int drow, int c0, int nvalid, int kb, LAS float* scr, int lane) {
    const int k0 = 64 * kb;
    { const int cc = lane & 31, ccl = cc < nvalid ? cc : 0; const float* wp = W + (size_t)(k0 + (lane >> 5)) * N + c0 + ccl; float v[32];
#pragma unroll
      for (int i = 0; i < 32; ++i) v[i] = wp[(size_t)(2 * i) * N];
#pragma unroll
      for (int i = 0; i < 32; ++i) scr[(2 * i + (lane >> 5)) * 33 + cc] = (cc < nvalid) ? v[i] : 0.f; }
    LDS_WAIT(); asm volatile("" ::: "memory");
    const int c = lane & 7;
#pragma unroll
    for (int j = 0; j < 4; ++j) { const int n = (lane >> 3) + 8 * j; const LAS float* s = scr + (8 * c) * 33 + n;
        u32x4 o; o.x = cvt_pk_bf16(s[0 * 33], s[1 * 33]); o.y = cvt_pk_bf16(s[2 * 33], s[3 * 33]); o.z = cvt_pk_bf16(s[4 * 33], s[5 * 33]); o.w = cvt_pk_bf16(s[6 * 33], s[7 * 33]);
        *(GAS u32x4*)(WT + (size_t)(drow + n) * K + k0 + 8 * c) = o; }
    LDS_WAIT(); asm volatile("" ::: "memory");
}
DI void phase_w(LAS unsigned char* lds, const Ctx& c, int l, int G) {
    const int tid = ltid(), lane = tid & 63, wave = rfl(tid >> 6);
    LAS float* scr = (LAS float*)(lds + wave * 16384);
    const int gw = lbid() * NWAVES + wave, NGW = G * NWAVES;
    constexpr int I_IN = (NIN / 32) * 16, I_GO = 512, I_AO = 256, I_OUT = 512, I_EXP = 16 * 512;
    constexpr int NITEMS = I_IN + I_GO + I_AO + I_OUT + 3 * I_EXP;
    for (int it = gw; it < NITEMS; it += NGW) {
        int r = it;
        if (r < I_IN) {
            const int nbg = r >> 4, kb = r & 15, n0 = 32 * nbg, tile = n0 >> 8, p = n0 & 255; int c0, nv = 32;
            if (tile < 12) c0 = n0;
            else if (tile < 24) { const int base = tile < 18 ? 3088 : 4624, tq = tile < 18 ? tile - 12 : tile - 18; c0 = base + (4 * tq + ((p & 127) >> 5)) * 64 + (p >= 128 ? 32 : 0); }
            else if (tile < 30) c0 = 6160 + (n0 - 24 * 256);
            else if (tile < 38) c0 = 7696 + (n0 - 30 * 256);
            else { c0 = 3072; nv = (p == 0) ? 16 : 0; }
            tr_item(c.w_in + (size_t)l * D * DIN, DIN, wsb(c, WS_WIN), D, n0, c0, nv, kb, scr, lane); continue; }
        r -= I_IN;
        if (r < I_GO) { tr_item(c.w_gla_o + (size_t)l * D * D, D, wsb(c, WS_WGO), D, 32 * (r >> 4), 32 * (r >> 4), 32, r & 15, scr, lane); continue; }
        r -= I_GO;
        if (r < I_AO) { tr_item(c.w_att_o + (size_t)l * 512 * D, D, wsb(c, WS_WAO), 512, 32 * (r >> 3), 32 * (r >> 3), 32, r & 7, scr, lane); continue; }
        r -= I_AO;
        if (r < I_OUT) { tr_item(c.w_out + (size_t)l * D * D, D, wsb(c, WS_WOUT), D, 32 * (r >> 4), 32 * (r >> 4), 32, r & 15, scr, lane); continue; }
        r -= I_OUT;
        const int which = r / I_EXP; r -= which * I_EXP; const int e = r >> 9, q = r & 511, nbg = q >> 4, kb = q & 15;
        const size_t eoff = (size_t)(l * NEXP + e) * D * DFF;
        if (which == 0) tr_item(c.w_e_gate + eoff, DFF, wsb(c, WS_WGU) + (size_t)e * 2048 * 1024, D, 256 * (nbg >> 2) + 32 * (nbg & 3), 32 * nbg, 32, kb, scr, lane);
        else if (which == 1) tr_item(c.w_e_up + eoff, DFF, wsb(c, WS_WGU) + (size_t)e * 2048 * 1024, D, 256 * (nbg >> 2) + 128 + 32 * (nbg & 3), 32 * nbg, 32, kb, scr, lane);
        else tr_item(c.w_e_down + eoff, D, wsb(c, WS_WD) + (size_t)e * 1024 * 1024, DFF, 32 * nbg, 32 * nbg, 32, kb, scr, lane);
    }
    if (l == 0) {
        const size_t n8 = (size_t)T * D / 8; bf16_t* xb = wsb(c, WS_XB);
        for (size_t i = (size_t)lbid() * NTHREADS + tid; i < n8; i += (size_t)G * NTHREADS) { const f32x4 a = *(const GAS f32x4*)(c.x + i * 8), b = *(const GAS f32x4*)(c.x + i * 8 + 4); *(GAS u32x4*)(xb + i * 8) = pack8(a, b); }
    }
}

DI s16x4 tr16(const LAS void* p) { return __builtin_bit_cast(s16x4, __builtin_amdgcn_ds_read_tr16_b64_v4i16((LAS s16x4*)p)); }
DI bf16x8 cat8(s16x4 lo, s16x4 hi) { return __builtin_shufflevector(lo, hi, 0, 1, 2, 3, 4, 5, 6, 7); }
#define MFMA16(a, b, c) __builtin_amdgcn_mfma_f32_16x16x32_bf16((a), (b), (c), 0, 0, 0)

constexpr int REC_BYTES = 33792, REC_KS = 16384, REC_DEC = 32768, OI_BYTES = 32768;
constexpr int GP_QT = 0, GP_KT = 17408, GP_VS = 34816, GP_ATT = 68608, GP_WUP = 77824, GP_BAL = 86016;
DI float exp_(float x) { return __builtin_amdgcn_exp2f(x * LOG2E); }
DI void unpack8(const u32x4& q, float (&v)[16], int o) { v[o] = bf_lo(q.x); v[o + 1] = bf_hi(q.x); v[o + 2] = bf_lo(q.y); v[o + 3] = bf_hi(q.y); v[o + 4] = bf_lo(q.z); v[o + 5] = bf_hi(q.z); v[o + 6] = bf_lo(q.w); v[o + 7] = bf_hi(q.w); }
DI u32x4 packf8(const float (&v)[16], int o) { u32x4 p; p.x = cvt_pk_bf16(v[o], v[o + 1]); p.y = cvt_pk_bf16(v[o + 2], v[o + 3]); p.z = cvt_pk_bf16(v[o + 4], v[o + 5]); p.w = cvt_pk_bf16(v[o + 6], v[o + 7]); return p; }
DI void gla_p_unit(LAS unsigned char* lds, const Ctx& c, int l, int bl, int h, int n, int& h_loaded) {
    const int tid = ltid(), lane = tid & 63, w = rfl(tid >> 6), fr = lane & 15, fq = lane >> 4;
    const size_t tok0 = (size_t)bl * SEQ + n * 64;
    const bf16_t* QG = wsb(c, WS_H + H_QG) + tok0 * 512 + h * 128;
    const bf16_t* KG = wsb(c, WS_H + H_KG) + tok0 * 512 + h * 128;
    const bf16_t* VG = wsb(c, WS_H + H_VG) + tok0 * 1024 + h * 256;
    const float* HA = (const float*)(c.ws + WS_HA) + tok0 * 16;
    const int unit = (bl * 4 + h) * 64 + n;
    unsigned char* rec = c.ws + WS_REC + (size_t)unit * REC_BYTES;
    unsigned char* oi = c.ws + WS_MIX + (size_t)unit * OI_BYTES;
    LAS bf16_t* QT = (LAS bf16_t*)(lds + GP_QT); LAS bf16_t* KT = (LAS bf16_t*)(lds + GP_KT); LAS bf16_t* VS = (LAS bf16_t*)(lds + GP_VS); LAS bf16_t* AT = (LAS bf16_t*)(lds + GP_ATT);
    LAS float* WUP = (LAS float*)(lds + GP_WUP); LAS float* BAL = (LAS float*)(lds + GP_BAL);
    __syncthreads();
    if (h_loaded != h) { for (int i = tid; i < 16 * 128; i += NTHREADS) WUP[i] = c.w_alpha_up[(size_t)l * 16 * 512 + (i >> 7) * 512 + h * 128 + (i & 127)];
        if (tid < 128) BAL[tid] = c.b_alpha[l * 512 + h * 128 + tid]; h_loaded = h; __syncthreads(); }
    {
        const int row = lane;
        f32x4 a4[4];
#pragma unroll
        for (int j = 0; j < 4; ++j) a4[j] = *(const GAS f32x4*)(HA + (size_t)row * 16 + 4 * j);
        const u32x4 q0 = *(const GAS u32x4*)(QG + (size_t)row * 512 + 16 * w), q1 = *(const GAS u32x4*)(QG + (size_t)row * 512 + 16 * w + 8);
        const u32x4 k0 = *(const GAS u32x4*)(KG + (size_t)row * 512 + 16 * w), k1 = *(const GAS u32x4*)(KG + (size_t)row * 512 + 16 * w + 8);
#pragma unroll
        for (int c2 = 0; c2 < 4; ++c2) { const int idx = tid + NTHREADS * c2, r = idx >> 5, ch = idx & 31; *(LAS u32x4*)(VS + r * 264 + ch * 8) = *(const GAS u32x4*)(VG + (size_t)r * 1024 + ch * 8); }
        float la[16];
#pragma unroll
        for (int cc = 0; cc < 16; ++cc) la[cc] = BAL[16 * w + cc];
#pragma unroll
        for (int j = 0; j < 16; ++j) { const float aj = a4[j >> 2][j & 3];
#pragma unroll
            for (int c4 = 0; c4 < 4; ++c4) { const f32x4 wv = *(const LAS f32x4*)(WUP + j * 128 + 16 * w + 4 * c4); la[4 * c4] += aj * wv[0]; la[4 * c4 + 1] += aj * wv[1]; la[4 * c4 + 2] += aj * wv[2]; la[4 * c4 + 3] += aj * wv[3]; } }
#pragma unroll
        for (int cc = 0; cc < 16; ++cc) { const float z = la[cc]; la[cc] = -(fmaxf(-z, 0.f) + __builtin_amdgcn_logf(1.0f + exp_(-fabsf(z))) * 0.6931471805599453f) * (1.0f / 16.0f); }
#pragma unroll
        for (int dlt = 1; dlt < 64; dlt <<= 1)
#pragma unroll
            for (int cc = 0; cc < 16; ++cc) { const float t = __shfl_up(la[cc], dlt); if (lane >= dlt) la[cc] += t; }
        float qv[16], kv[16];
        unpack8(q0, qv, 0); unpack8(q1, qv, 8); unpack8(k0, kv, 0); unpack8(k1, kv, 8);
        float dc[16];
#pragma unroll
        for (int cc = 0; cc < 16; ++cc) { const float b = la[cc]; const float bend = __shfl(b, 63); const float eb = exp_(b); dc[cc] = eb; qv[cc] *= eb; la[cc] = kv[cc] * exp_(bend - b); kv[cc] *= exp_(-b); }
        if (lane == 63) {
#pragma unroll
            for (int c4 = 0; c4 < 4; ++c4) *(GAS f32x4*)(rec + REC_DEC + (16 * w + 4 * c4) * 4) = (f32x4){dc[4 * c4], dc[4 * c4 + 1], dc[4 * c4 + 2], dc[4 * c4 + 3]}; }
        const u32x4 qa = packf8(qv, 0), qb = packf8(qv, 8), ka = packf8(kv, 0), kb = packf8(kv, 8), sa = packf8(la, 0), sb = packf8(la, 8);
        *(LAS u32x4*)(QT + row * 136 + 16 * w) = qa; *(LAS u32x4*)(QT + row * 136 + 16 * w + 8) = qb;
        *(LAS u32x4*)(KT + row * 136 + 16 * w) = ka; *(LAS u32x4*)(KT + row * 136 + 16 * w + 8) = kb;
        *(GAS u32x4*)(rec + row * 256 + (((2 * w) ^ (row & 15)) << 4)) = qa; *(GAS u32x4*)(rec + row * 256 + (((2 * w + 1) ^ (row & 15)) << 4)) = qb;
        *(GAS u32x4*)(rec + REC_KS + row * 256 + (((2 * w) ^ (2 * (row & 7))) << 4)) = sa; *(GAS u32x4*)(rec + REC_KS + row * 256 + (((2 * w + 1) ^ (2 * (row & 7))) << 4)) = sb;
    }
    __syncthreads();
#pragma unroll
    for (int rep = 0; rep < 2; ++rep) {
        const int tt = w + 8 * rep, jt = tt >> 2, it = tt & 3;
        f32x4 a = (f32x4){0.f, 0.f, 0.f, 0.f};
        if (jt <= it) {
#pragma unroll
            for (int k4 = 0; k4 < 4; ++k4) { const bf16x8 af = *(const LAS bf16x8*)(KT + (16 * jt + fr) * 136 + 32 * k4 + 8 * fq), bfr = *(const LAS bf16x8*)(QT + (16 * it + fr) * 136 + 32 * k4 + 8 * fq); a = MFMA16(af, bfr, a); }
        }
        const int i = 16 * it + fr, j0 = 16 * jt + 4 * fq;
        u32x2 o; o.x = cvt_pk_bf16(j0 <= i ? a[0] : 0.f, j0 + 1 <= i ? a[1] : 0.f); o.y = cvt_pk_bf16(j0 + 2 <= i ? a[2] : 0.f, j0 + 3 <= i ? a[3] : 0.f);
        *(LAS u32x2*)(AT + i * 72 + j0) = o;
    }
    __syncthreads();
    {
        const int dv0 = 32 * w;
        bf16x8 vb[2][2];
#pragma unroll
        for (int k2 = 0; k2 < 2; ++k2)
#pragma unroll
            for (int dt = 0; dt < 2; ++dt) { const LAS bf16_t* p = VS + (32 * k2 + 8 * fq + (fr >> 2)) * 264 + dv0 + 16 * dt + (fr & 3) * 4; vb[k2][dt] = cat8(tr16(p), tr16(p + 4 * 264)); }
#pragma unroll
        for (int tt = 0; tt < 4; ++tt) {
            const bf16x8 a0 = *(const LAS bf16x8*)(AT + (16 * tt + fr) * 72 + 8 * fq), a1 = *(const LAS bf16x8*)(AT + (16 * tt + fr) * 72 + 32 + 8 * fq);
#pragma unroll
            for (int dt = 0; dt < 2; ++dt) { f32x4 z = (f32x4){0.f, 0.f, 0.f, 0.f}; z = MFMA16(a0, vb[0][dt], z); z = MFMA16(a1, vb[1][dt], z);
                u32x2 pk; pk.x = cvt_pk_bf16(z[0], z[1]); pk.y = cvt_pk_bf16(z[2], z[3]); *(GAS u32x2*)(oi + ((w * 8 + tt * 2 + dt) * 64 + lane) * 8) = pk; }
        }
    }
}
constexpr int GSEG = 16, NSEG = 64 / GSEG;
constexpr int GL_STAGE = 50176, GL_DEC = 16384, GL_VS = 17408;
DI void gla_l_chain(LAS unsigned char* lds, const Ctx& c, int bl, int h, int seg) {
    const int tid = ltid(), lane = tid & 63, w = rfl(tid >> 6), fr = lane & 15, fq = lane >> 4;
    const size_t t0 = (size_t)bl * SEQ + (size_t)seg * (GSEG * 64);
    const bf16_t* VG = wsb(c, WS_H + H_VG) + t0 * 1024 + h * 256;
    const unsigned char* rec0 = c.ws + WS_REC + (size_t)((bl * 4 + h) * 64 + seg * GSEG) * REC_BYTES;
    const int dv0 = 32 * w; const unsigned lds_u = (unsigned)(uintptr_t)lds;
    f32x4 S[8][2], Dc[8];
#pragma unroll
    for (int a = 0; a < 8; ++a) { S[a][0] = (f32x4){0.f, 0.f, 0.f, 0.f}; S[a][1] = (f32x4){0.f, 0.f, 0.f, 0.f}; Dc[a] = (f32x4){1.f, 1.f, 1.f, 1.f}; }
#define GL_DMA(gp, ldsoff) do { unsigned _sv; const unsigned _m = (unsigned)__builtin_amdgcn_readfirstlane((int)(ldsoff)); \
        asm volatile("s_mov_b32 %0, m0\n\ts_mov_b32 m0, %2\n\ts_nop 0\n\tglobal_load_lds_dwordx4 %1, off\n\ts_mov_b32 m0, %0" : "=&s"(_sv) : "v"(gp), "s"(_m) : "memory"); } while (0)
#define GL_PREFETCH(nn, st) do { const unsigned char* _r = rec0 + (size_t)(nn) * REC_BYTES + REC_KS; const unsigned _s = lds_u + (unsigned)(st) * GL_STAGE; \
        _Pragma("unroll") for (int _p = 0; _p < 2; ++_p) GL_DMA((const GAS unsigned char*)(_r + (w * 2 + _p) * 1024 + lane * 16), _s + (w * 2 + _p) * 1024); \
        if (w == 0) GL_DMA((const GAS unsigned char*)(_r + 16384 + lane * 16), _s + GL_DEC); \
        _Pragma("unroll") for (int _p = 0; _p < 4; ++_p) { const int _row = 2 * (w * 4 + _p) + (lane >> 5); \
            GL_DMA((const GAS bf16_t*)(VG + (size_t)((nn) * 64 + _row) * 1024 + (((lane & 31) ^ (2 * (_row & 3))) << 3)), _s + GL_VS + (w * 4 + _p) * 1024); } } while (0)
    __syncthreads();
    GL_PREFETCH(0, 0);
    for (int n = 0; n < GSEG; ++n) {
        const int st = n & 1; LAS unsigned char* sb_ = lds + st * GL_STAGE;
        LAS bf16_t* KS = (LAS bf16_t*)sb_; LAS float* DEC = (LAS float*)(sb_ + GL_DEC); LAS bf16_t* VS = (LAS bf16_t*)(sb_ + GL_VS);
        VM_WAIT(); asm volatile("s_waitcnt lgkmcnt(0)" ::: "memory"); __builtin_amdgcn_s_barrier(); asm volatile("" ::: "memory");
        if (n + 1 < GSEG) GL_PREFETCH(n + 1, st ^ 1);
        bf16x8 vb[2][2];
#pragma unroll
        for (int k2 = 0; k2 < 2; ++k2)
#pragma unroll
            for (int dt = 0; dt < 2; ++dt) { const int r0 = 32 * k2 + 8 * fq + (fr >> 2);
                const LAS bf16_t* p = VS + r0 * 256 + ((((dv0 + 16 * dt) >> 3) ^ (2 * (r0 & 3))) << 3) + (fr & 3) * 4; vb[k2][dt] = cat8(tr16(p), tr16(p + 4 * 256)); }
#pragma unroll
        for (int k8 = 0; k8 < 8; ++k8) {
            const f32x4 dc = *(const LAS f32x4*)(DEC + 16 * k8 + 4 * fq);
            S[k8][0] *= dc; S[k8][1] *= dc; Dc[k8] *= dc;
#pragma unroll
            for (int k2 = 0; k2 < 2; ++k2) { const int r0 = 32 * k2 + 8 * fq + (fr >> 2);
                const LAS bf16_t* p0 = KS + r0 * 128 + (((2 * k8) ^ (2 * (r0 & 7))) << 3) + (fr & 3) * 4; const LAS bf16_t* p1 = KS + (r0 + 4) * 128 + (((2 * k8) ^ (2 * ((r0 + 4) & 7))) << 3) + (fr & 3) * 4;
                const bf16x8 af = cat8(tr16(p0), tr16(p1));
                S[k8][0] = MFMA16(af, vb[k2][0], S[k8][0]); S[k8][1] = MFMA16(af, vb[k2][1], S[k8][1]); }
        }
    }
#undef GL_PREFETCH
#undef GL_DMA
    const int cj = (bl * 4 + h) * NSEG + seg;
    GAS f32x4* sl = (GAS f32x4*)(c.ws + WS_SLOC) + ((size_t)(cj * 8 + w) * 16) * 64 + lane;
#pragma unroll
    for (int a = 0; a < 8; ++a) { sl[(a * 2) * 64] = S[a][0]; sl[(a * 2 + 1) * 64] = S[a][1]; }
    if (w == 0) { GAS f32x4* dq = (GAS f32x4*)(c.ws + WS_DCUM) + (size_t)cj * 8 * 64 + lane;
#pragma unroll
        for (int a = 0; a < 8; ++a) dq[a * 64] = Dc[a]; }
    VM_WAIT(); __syncthreads();
}
constexpr int GS_STAGE = 66560, GS_KS = 16384, GS_DEC = 32768, GS_VS = 33792, GS_SS = 2 * GS_STAGE;
DI void gla_s_chain(LAS unsigned char* lds, const Ctx& c, int l, int bl, int h, int seg) {
    const int tid = ltid(), lane = tid & 63, w = rfl(tid >> 6), fr = lane & 15, fq = lane >> 4;
    const size_t t0 = (size_t)bl * SEQ + (size_t)seg * (GSEG * 64);
    const bf16_t* VG = wsb(c, WS_H + H_VG) + t0 * 1024 + h * 256;
    const bf16_t* SR = wsb(c, WS_H + H_SR) + t0 * 1024 + h * 256;
    bf16_t* OG = wsb(c, WS_OG) + t0 * 1024 + h * 256;
    const unsigned char* rec0 = c.ws + WS_REC + (size_t)((bl * 4 + h) * 64 + seg * GSEG) * REC_BYTES;
    const unsigned char* oi0 = c.ws + WS_MIX + (size_t)((bl * 4 + h) * 64 + seg * GSEG) * OI_BYTES;
    LAS float* SS = (LAS float*)(lds + GS_SS);
    const int dv0 = 32 * w;
    const float gn0 = c.gla_norm[l * 1024 + h * 256 + dv0 + fr], gn1 = c.gla_norm[l * 1024 + h * 256 + dv0 + 16 + fr];
    f32x4 S[8][2];
#pragma unroll
    for (int a = 0; a < 8; ++a) { S[a][0] = (f32x4){0.f, 0.f, 0.f, 0.f}; S[a][1] = (f32x4){0.f, 0.f, 0.f, 0.f}; }
    for (int j = 0; j < seg; ++j) {
        const int cj = (bl * 4 + h) * NSEG + j;
        const GAS f32x4* sl = (const GAS f32x4*)(c.ws + WS_SLOC) + ((size_t)(cj * 8 + w) * 16) * 64 + lane; const GAS f32x4* dq = (const GAS f32x4*)(c.ws + WS_DCUM) + (size_t)cj * 8 * 64 + lane;
#pragma unroll
        for (int a = 0; a < 8; ++a) { const f32x4 dcv = dq[a * 64]; S[a][0] = S[a][0] * dcv + sl[(a * 2) * 64]; S[a][1] = S[a][1] * dcv + sl[(a * 2 + 1) * 64]; }
    }
#define GS_DMA(gp, ldsoff) do { unsigned _sv; const unsigned _m = (unsigned)__builtin_amdgcn_readfirstlane((int)(ldsoff)); \
        asm volatile("s_mov_b32 %0, m0\n\ts_mov_b32 m0, %2\n\ts_nop 0\n\tglobal_load_lds_dwordx4 %1, off\n\ts_mov_b32 m0, %0" : "=&s"(_sv) : "v"(gp), "s"(_m) : "memory"); } while (0)
#define GS_PREFETCH(nn, st) do { const unsigned char* _r = rec0 + (size_t)(nn) * REC_BYTES; const unsigned _s = lds_u + (unsigned)(st) * GS_STAGE; \
        _Pragma("unroll") for (int _p = 0; _p < 4; ++_p) GS_DMA((const GAS unsigned char*)(_r + (w * 4 + _p) * 1024 + lane * 16), _s + (w * 4 + _p) * 1024); \
        if (w == 0) GS_DMA((const GAS unsigned char*)(_r + 32768 + lane * 16), _s + 32768); \
        _Pragma("unroll") for (int _p = 0; _p < 4; ++_p) { const int _row = 2 * (w * 4 + _p) + (lane >> 5); \
            GS_DMA((const GAS bf16_t*)(VG + (size_t)((nn) * 64 + _row) * 1024 + (((lane & 31) ^ (2 * (_row & 3))) << 3)), _s + GS_VS + (w * 4 + _p) * 1024); } } while (0)
    const unsigned lds_u = (unsigned)(uintptr_t)lds;
#define GS_BAR() do { asm volatile("s_waitcnt lgkmcnt(0)" ::: "memory"); __builtin_amdgcn_s_barrier(); asm volatile("" ::: "memory"); } while (0)
    __syncthreads();
    GS_PREFETCH(0, 0);
    for (int n = 0; n < GSEG; ++n) {
        const int st = n & 1; LAS unsigned char* sb_ = lds + st * GS_STAGE;
        LAS bf16_t* QT = (LAS bf16_t*)sb_; LAS bf16_t* KS = (LAS bf16_t*)(sb_ + GS_KS); LAS float* DEC = (LAS float*)(sb_ + GS_DEC); LAS bf16_t* VS = (LAS bf16_t*)(sb_ + GS_VS); LAS bf16_t* OST = (LAS bf16_t*)(sb_ + GS_KS);
        VM_WAIT(); GS_BAR();
        u32x2 oiv[8];
#pragma unroll
        for (int q = 0; q < 8; ++q) oiv[q] = *(const GAS u32x2*)(oi0 + (size_t)n * OI_BYTES + ((w * 8 + q) * 64 + lane) * 8);
        u32x4 srv[4];
#pragma unroll
        for (int c2 = 0; c2 < 4; ++c2) { const int idx = tid + NTHREADS * c2, r = idx >> 5, ch = idx & 31; srv[c2] = *(const GAS u32x4*)(SR + (size_t)(n * 64 + r) * 1024 + ch * 8); }
        asm volatile("" ::: "memory");
        if (n + 1 < GSEG) GS_PREFETCH(n + 1, st ^ 1);
        f32x4 o[4][2];
        {
            bf16x8 vb[2][2];
#pragma unroll
            for (int k2 = 0; k2 < 2; ++k2)
#pragma unroll
                for (int dt = 0; dt < 2; ++dt) { const int r0 = 32 * k2 + 8 * fq + (fr >> 2);
                    const LAS bf16_t* p = VS + r0 * 256 + ((((dv0 + 16 * dt) >> 3) ^ (2 * (r0 & 3))) << 3) + (fr & 3) * 4; vb[k2][dt] = cat8(tr16(p), tr16(p + 4 * 256)); }
#pragma unroll
            for (int tt = 0; tt < 4; ++tt) { o[tt][0] = (f32x4){0.f, 0.f, 0.f, 0.f}; o[tt][1] = (f32x4){0.f, 0.f, 0.f, 0.f}; }
#pragma unroll
            for (int s = 0; s < 4; ++s) {
                bf16x8 sb[2];
#pragma unroll
                for (int dt = 0; dt < 2; ++dt) { u32x4 pk; pk.x = cvt_pk_bf16(S[2 * s][dt][0], S[2 * s][dt][1]); pk.y = cvt_pk_bf16(S[2 * s][dt][2], S[2 * s][dt][3]); pk.z = cvt_pk_bf16(S[2 * s + 1][dt][0], S[2 * s + 1][dt][1]); pk.w = cvt_pk_bf16(S[2 * s + 1][dt][2], S[2 * s + 1][dt][3]); sb[dt] = __builtin_bit_cast(bf16x8, pk); }
#pragma unroll
                for (int tt = 0; tt < 4; ++tt) { const int i = 16 * tt + fr;
                    const LAS bf16_t* qp = QT + i * 128 + (fq & 1) * 4;
                    const bf16x8 af = cat8(*(const LAS s16x4*)(qp + (((4 * s + (fq >> 1)) ^ (i & 15)) << 3)), *(const LAS s16x4*)(qp + (((4 * s + 2 + (fq >> 1)) ^ (i & 15)) << 3)));
                    o[tt][0] = MFMA16(af, sb[0], o[tt][0]); o[tt][1] = MFMA16(af, sb[1], o[tt][1]); }
            }
#pragma unroll
            for (int k8 = 0; k8 < 8; ++k8) {
                const f32x4 dc = *(const LAS f32x4*)(DEC + 16 * k8 + 4 * fq);
                S[k8][0] *= dc; S[k8][1] *= dc;
#pragma unroll
                for (int k2 = 0; k2 < 2; ++k2) { const int r0 = 32 * k2 + 8 * fq + (fr >> 2);
                    const LAS bf16_t* p0 = KS + r0 * 128 + (((2 * k8) ^ (2 * (r0 & 7))) << 3) + (fr & 3) * 4; const LAS bf16_t* p1 = KS + (r0 + 4) * 128 + (((2 * k8) ^ (2 * ((r0 + 4) & 7))) << 3) + (fr & 3) * 4;
                    const bf16x8 af = cat8(tr16(p0), tr16(p1));
                    S[k8][0] = MFMA16(af, vb[k2][0], S[k8][0]); S[k8][1] = MFMA16(af, vb[k2][1], S[k8][1]); }
            }
        }
#pragma unroll
        for (int tt = 0; tt < 4; ++tt)
#pragma unroll
            for (int dt = 0; dt < 2; ++dt) { const u32x2 v = oiv[tt * 2 + dt]; o[tt][dt][0] += bf_lo(v.x); o[tt][dt][1] += bf_hi(v.x); o[tt][dt][2] += bf_lo(v.y); o[tt][dt][3] += bf_hi(v.y); }
#pragma unroll
        for (int tt = 0; tt < 4; ++tt) { f32x4 pp;
#pragma unroll
            for (int rg = 0; rg < 4; ++rg) { float p = o[tt][0][rg] * o[tt][0][rg] + o[tt][1][rg] * o[tt][1][rg];
                p += __shfl_xor(p, 1); p += __shfl_xor(p, 2); p += __shfl_xor(p, 4); p += __shfl_xor(p, 8); pp[rg] = p; }
            if (fr == 0) *(LAS f32x4*)(SS + w * 64 + 16 * tt + 4 * fq) = pp; }
        GS_BAR();
#pragma unroll
        for (int tt = 0; tt < 4; ++tt) { f32x4 ss = *(const LAS f32x4*)(SS + 16 * tt + 4 * fq);
#pragma unroll
            for (int ww = 1; ww < 8; ++ww) ss += *(const LAS f32x4*)(SS + ww * 64 + 16 * tt + 4 * fq);
#pragma unroll
            for (int rg = 0; rg < 4; ++rg) { const float rs = __builtin_amdgcn_rsqf(ss[rg] * (1.0f / 256.0f) + RMS_EPS); const int i = 16 * tt + 4 * fq + rg;
                OST[i * 264 + dv0 + fr] = (bf16_t)(cvt_pk_bf16(o[tt][0][rg] * rs * gn0, 0.f) & 0xffffu); OST[i * 264 + dv0 + 16 + fr] = (bf16_t)(cvt_pk_bf16(o[tt][1][rg] * rs * gn1, 0.f) & 0xffffu); } }
        GS_BAR();
#pragma unroll
        for (int c2 = 0; c2 < 4; ++c2) { const int idx = tid + NTHREADS * c2, r = idx >> 5, ch = idx & 31;
            const u32x4 ov = *(const LAS u32x4*)(OST + r * 264 + ch * 8); const u32x4 sv = srv[c2];
            u32x4 rr; rr.x = cvt_pk_bf16(bf_lo(ov.x) * bf_lo(sv.x), bf_hi(ov.x) * bf_hi(sv.x)); rr.y = cvt_pk_bf16(bf_lo(ov.y) * bf_lo(sv.y), bf_hi(ov.y) * bf_hi(sv.y));
            rr.z = cvt_pk_bf16(bf_lo(ov.z) * bf_lo(sv.z), bf_hi(ov.z) * bf_hi(sv.z)); rr.w = cvt_pk_bf16(bf_lo(ov.w) * bf_lo(sv.w), bf_hi(ov.w) * bf_hi(sv.w));
            *(GAS u32x4*)(OG + (size_t)(n * 64 + r) * 1024 + ch * 8) = rr; }
    }
#undef GS_PREFETCH
#undef GS_DMA
#undef GS_BAR
    VM_WAIT(); __syncthreads();
}

constexpr int AT_K = 0, AT_V = 36864;
DI void attn_unit(LAS unsigned char* lds, const Ctx& c, int bl, int g, int h, int x) {
    const int tid = ltid(), lane = tid & 63, w = rfl(tid >> 6), fr = lane & 15, fq = lane >> 4;
    const int dl = (g == 0) ? 1 : (g == 1 ? 4 : 16), nb = 32 / dl, r = x / nb, n = x - r * nb;
    const size_t tb = (size_t)bl * SEQ + r; const int colo = g * 512 + h * 64;
    const bf16_t* Q = wsb(c, WS_H + H_QD) + colo; const bf16_t* K = wsb(c, WS_H + H_KD) + colo; const bf16_t* V = wsb(c, WS_H + H_VD) + colo;
    LAS bf16_t* Ks = (LAS bf16_t*)(lds + AT_K); LAS bf16_t* Vs = (LAS bf16_t*)(lds + AT_V);
    const size_t tokq = tb + (size_t)dl * (128 * n + 16 * w + fr);
    bf16x8 qf[2];
#pragma unroll
    for (int d0 = 0; d0 < 2; ++d0) qf[d0] = *(const GAS bf16x8*)(Q + tokq * 1536 + 32 * d0 + 8 * fq);
    __syncthreads();
#pragma unroll
    for (int c2 = 0; c2 < 4; ++c2) { const int idx = tid + NTHREADS * c2, row = idx >> 3, ch = idx & 7; const int j = 128 * (n - 1) + row;
        u32x4 kv = (u32x4){0u, 0u, 0u, 0u}, vv = (u32x4){0u, 0u, 0u, 0u};
        if (j >= 0) { const size_t tok = tb + (size_t)dl * j; kv = *(const GAS u32x4*)(K + tok * 1536 + ch * 8); vv = *(const GAS u32x4*)(V + tok * 1536 + ch * 8); }
        *(LAS u32x4*)(Ks + row * 72 + ch * 8) = kv; *(LAS u32x4*)(Vs + row * 72 + ch * 8) = vv; }
    __syncthreads();
    f32x4 s[9]; float m = -1e30f;
#pragma unroll
    for (int kr = 0; kr < 9; ++kr) { const int kt = w + kr; f32x4 a = (f32x4){0.f, 0.f, 0.f, 0.f};
#pragma unroll
        for (int d0 = 0; d0 < 2; ++d0) { const bf16x8 af = *(const LAS bf16x8*)(Ks + (16 * kt + fr) * 72 + 32 * d0 + 8 * fq); a = MFMA16(af, qf[d0], a); }
#pragma unroll
        for (int rg = 0; rg < 4; ++rg) { const int rel = 16 * kr + 4 * fq + rg - fr; const bool ok = rel >= 0 && rel <= 128 && (n > 0 || 16 * kt + 4 * fq + rg >= 128); a[rg] = ok ? a[rg] : -1e30f; m = fmaxf(m, a[rg]); }
        s[kr] = a; }
    m = fmaxf(m, __shfl_xor(m, 16)); m = fmaxf(m, __shfl_xor(m, 32));
    float lsum = 0.f;
#pragma unroll
    for (int kr = 0; kr < 9; ++kr)
#pragma unroll
        for (int rg = 0; rg < 4; ++rg) { const float p = s[kr][rg] > -1e29f ? __builtin_amdgcn_exp2f(s[kr][rg] - m) : 0.f; s[kr][rg] = p; lsum += p; }
    lsum += __shfl_xor(lsum, 16); lsum += __shfl_xor(lsum, 32);
    f32x4 oT[4];
#pragma unroll
    for (int dt = 0; dt < 4; ++dt) oT[dt] = (f32x4){0.f, 0.f, 0.f, 0.f};
#pragma unroll
    for (int pp = 0; pp < 5; ++pp) { const int ka = 2 * pp, kb = (2 * pp + 1 < 9) ? 2 * pp + 1 : 8;
        u32x4 pk; pk.x = cvt_pk_bf16(s[ka][0], s[ka][1]); pk.y = cvt_pk_bf16(s[ka][2], s[ka][3]);
        if (2 * pp + 1 < 9) { pk.z = cvt_pk_bf16(s[kb][0], s[kb][1]); pk.w = cvt_pk_bf16(s[kb][2], s[kb][3]); } else { pk.z = 0u; pk.w = 0u; }
        const bf16x8 pf = __builtin_bit_cast(bf16x8, pk);
#pragma unroll
        for (int dt = 0; dt < 4; ++dt) { const LAS bf16_t* pa = Vs + (16 * (w + ka) + 4 * fq + (fr >> 2)) * 72 + 16 * dt + (fr & 3) * 4; const LAS bf16_t* pb = Vs + (16 * (w + kb) + 4 * fq + (fr >> 2)) * 72 + 16 * dt + (fr & 3) * 4;
            oT[dt] = MFMA16(cat8(tr16(pa), tr16(pb)), pf, oT[dt]); } }
    const float inv = 1.0f / lsum; const size_t tq = tb + (size_t)dl * (128 * n + 16 * w + fr);
    bf16_t* op = wsb(c, WS_ATTG) + ((size_t)g * TH + tq) * 512 + h * 64 + 4 * fq;
#pragma unroll
    for (int dt = 0; dt < 4; ++dt) { u32x2 o; o.x = cvt_pk_bf16(oT[dt][0] * inv, oT[dt][1] * inv); o.y = cvt_pk_bf16(oT[dt][2] * inv, oT[dt][3] * inv); *(GAS u32x2*)(op + 16 * dt) = o; }
    if (fq == 0) ((float*)(c.ws + WS_LSE))[((size_t)g * TH + tq) * 8 + h] = m + __builtin_amdgcn_logf(lsum);
}
DI void phase_p(LAS unsigned char* lds, const Ctx& c, int l, int G) {
    int h_loaded = -1;
    for (int u = lbid(); u < 8 * 4 * 64; u += G) gla_p_unit(lds, c, l, u >> 8, (u >> 6) & 3, u & 63, h_loaded);
}
constexpr int NATT = 8 * 3 * 8 * 32, NATT1 = 2304, NCHAIN = 8 * 4 * NSEG;
DI void attn_pull(LAS unsigned char* lds, const Ctx& c, unsigned* ctr, int base, int limit) {
    volatile LAS int* TK = (volatile LAS int*)(lds + MISC_OFF + 192);
    const int tid = ltid();
    __syncthreads();
    if (tid == 0) TK[0] = base + (int)__hip_atomic_fetch_add(ctr, 1u, __ATOMIC_RELAXED, __HIP_MEMORY_SCOPE_AGENT);
    __syncthreads();
    int u = rfl(TK[0]);
    while (u < limit) {
        int nxt = 0; if (tid == 0) nxt = base + (int)__hip_atomic_fetch_add(ctr, 1u, __ATOMIC_RELAXED, __HIP_MEMORY_SCOPE_AGENT);
        attn_unit(lds, c, u / 768, (u / 256) % 3, (u >> 5) & 7, u & 31);
        __syncthreads();
        if (tid == 0) TK[0] = nxt;
        __syncthreads();
        u = rfl(TK[0]);
    }
}
DI void phase_b1(LAS unsigned char* lds, const Ctx& c, int l, int hf, int G) {
    const int bid = lbid(); unsigned* ctr = (unsigned*)(c.ws + WS_CTL) + CW_TKT + ((l * 2 + hf) * 2) * 64;
    for (int id = bid; id < NCHAIN; id += G) gla_l_chain(lds, c, id >> 4, (id >> 2) & 3, id & 3);
    attn_pull(lds, c, ctr, 0, NATT1);
}
DI void phase_b(LAS unsigned char* lds, const Ctx& c, int l, int hf, int G) {
    const int bid = lbid(); unsigned* ctr = (unsigned*)(c.ws + WS_CTL) + CW_TKT + ((l * 2 + hf) * 2 + 1) * 64;
    for (int id = bid; id < NCHAIN; id += G) gla_s_chain(lds, c, l, id >> 4, (id >> 2) & 3, id & 3);
    attn_pull(lds, c, ctr, NATT1, NATT);
}
DI void phase_f(const Ctx& c, int G) {
    const bf16_t* ag = wsb(c, WS_ATTG); const float* lse = (const float*)(c.ws + WS_LSE); bf16_t* att = wsb(c, WS_ATT);
    for (size_t i = (size_t)lbid() * NTHREADS + ltid(); i < (size_t)TH * 64; i += (size_t)G * NTHREADS) {
        const size_t tok = i >> 6; const int ch = (int)(i & 63), h = ch >> 3;
        const float l0 = lse[tok * 8 + h], l1 = lse[((size_t)TH + tok) * 8 + h], l2 = lse[((size_t)2 * TH + tok) * 8 + h];
        const float mx = fmaxf(l0, fmaxf(l1, l2)); float w0 = __builtin_amdgcn_exp2f(l0 - mx), w1 = __builtin_amdgcn_exp2f(l1 - mx), w2 = __builtin_amdgcn_exp2f(l2 - mx);
        const float inv = 1.0f / (w0 + w1 + w2); w0 *= inv; w1 *= inv; w2 *= inv;
        const u32x4 a = *(const GAS u32x4*)(ag + tok * 512 + ch * 8), b = *(const GAS u32x4*)(ag + ((size_t)TH + tok) * 512 + ch * 8), d = *(const GAS u32x4*)(ag + ((size_t)2 * TH + tok) * 512 + ch * 8);
        u32x4 o;
        o.x = cvt_pk_bf16(w0 * bf_lo(a.x) + w1 * bf_lo(b.x) + w2 * bf_lo(d.x), w0 * bf_hi(a.x) + w1 * bf_hi(b.x) + w2 * bf_hi(d.x));
        o.y = cvt_pk_bf16(w0 * bf_lo(a.y) + w1 * bf_lo(b.y) + w2 * bf_lo(d.y), w0 * bf_hi(a.y) + w1 * bf_hi(b.y) + w2 * bf_hi(d.y));
        o.z = cvt_pk_bf16(w0 * bf_lo(a.z) + w1 * bf_lo(b.z) + w2 * bf_lo(d.z), w0 * bf_hi(a.z) + w1 * bf_hi(b.z) + w2 * bf_hi(d.z));
        o.w = cvt_pk_bf16(w0 * bf_lo(a.w) + w1 * bf_lo(b.w) + w2 * bf_lo(d.w), w0 * bf_hi(a.w) + w1 * bf_hi(b.w) + w2 * bf_hi(d.w));
        *(GAS u32x4*)(att + tok * 512 + ch * 8) = o;
    }
}

DI float wave_sum(float v) {
#pragma unroll
    for (int o = 1; o < 64; o <<= 1) v += __shfl_xor(v, o);
    return v;
}
constexpr int R_WR = 0, R_HIST = 65536, R_BASE = 65536 + 64, R_INFO = 65536 + 128;
DI void phase_r(LAS unsigned char* lds, const Ctx& c, int l, int G) {
    const int tid = ltid(), lane = tid & 63, wave = rfl(tid >> 6);
    LAS float* WR = (LAS float*)(lds + R_WR); volatile LAS int* HIST = (volatile LAS int*)(lds + R_HIST); volatile LAS int* BASE = (volatile LAS int*)(lds + R_BASE); volatile LAS int* INFO = (volatile LAS int*)(lds + R_INFO);
    __syncthreads();
    for (int i = tid; i < 16 * 1024; i += NTHREADS) WR[(i & 15) * 1024 + (i >> 4)] = c.w_router[i];
    f32x4 g4[4], b4[4];
#pragma unroll
    for (int j = 0; j < 4; ++j) { g4[j] = *(const GAS f32x4*)(c.ln1_g + l * D + 4 * lane + 256 * j); b4[j] = *(const GAS f32x4*)(c.ln1_b + l * D + 4 * lane + 256 * j); }
    float* xo = c.out; bf16_t* xb = wsb(c, WS_XB); int* histg = (int*)(c.ws + WS_HISTG); float* gate = (float*)(c.ws + WS_GATE);
    for (int chunk = lbid(); chunk < T / 256; chunk += G) {
        __syncthreads();
        for (int rr = 0; rr < 32; ++rr) {
            const int rl = wave * 32 + rr; const size_t row = (size_t)chunk * 256 + rl;
            f32x4 v[4]; float s = 0.f;
#pragma unroll
            for (int j = 0; j < 4; ++j) { v[j] = *(const GAS f32x4*)(xo + row * D + 4 * lane + 256 * j); s += (v[j][0] + v[j][1]) + (v[j][2] + v[j][3]); }
            const float mean = wave_sum(s) * (1.0f / D); float s2 = 0.f;
#pragma unroll
            for (int j = 0; j < 4; ++j) { v[j] = v[j] - mean; s2 += (v[j][0] * v[j][0] + v[j][1] * v[j][1]) + (v[j][2] * v[j][2] + v[j][3] * v[j][3]); }
            const float rstd = __builtin_amdgcn_rsqf(wave_sum(s2) * (1.0f / D) + LN_EPS);
#pragma unroll
            for (int j = 0; j < 4; ++j) { v[j] = v[j] * rstd * g4[j] + b4[j]; *(GAS f32x4*)(xo + row * D + 4 * lane + 256 * j) = v[j];
                u32x2 pk; pk.x = cvt_pk_bf16(v[j][0], v[j][1]); pk.y = cvt_pk_bf16(v[j][2], v[j][3]); *(GAS u32x2*)(xb + row * D + 4 * lane + 256 * j) = pk; }
            float lg[16];
#pragma unroll
            for (int e = 0; e < 16; ++e) { float a = 0.f;
#pragma unroll
                for (int j = 0; j < 4; ++j) { const f32x4 wv = *(const LAS f32x4*)(WR + e * 1024 + 4 * lane + 256 * j); a += v[j][0] * wv[0] + v[j][1] * wv[1] + v[j][2] * wv[2] + v[j][3] * wv[3]; }
                lg[e] = wave_sum(a) + c.b_router[e]; }
            float mx = lg[0];
#pragma unroll
            for (int e = 1; e < 16; ++e) mx = fmaxf(mx, lg[e]);
            float se = 0.f;
#pragma unroll
            for (int e = 0; e < 16; ++e) { lg[e] = __expf(lg[e] - mx); se += lg[e]; }
            const float ise = 1.0f / se;
#pragma unroll
            for (int e = 0; e < 16; ++e) lg[e] *= ise;
            int gsel = 0; float gbest = -1.f;
#pragma unroll
            for (int gi = 0; gi < 4; ++gi) { const float a = lg[4 * gi], b = lg[4 * gi + 1], cc = lg[4 * gi + 2], d = lg[4 * gi + 3];
                const float sc = (a + b + cc + d) - fminf(fminf(a, b), fminf(cc, d)) - fminf(fmaxf(fminf(a, b), fminf(cc, d)), fminf(fmaxf(a, b), fmaxf(cc, d)));
                if (sc > gbest) { gbest = sc; gsel = gi; } }
            float p[4];
#pragma unroll
            for (int k = 0; k < 4; ++k) p[k] = gsel == 0 ? lg[k] : gsel == 1 ? lg[4 + k] : gsel == 2 ? lg[8 + k] : lg[12 + k];
            int i0 = 0; float v0 = p[0];
#pragma unroll
            for (int k = 1; k < 4; ++k) if (p[k] > v0) { v0 = p[k]; i0 = k; }
            int i1 = -1; float v1 = -1.f;
#pragma unroll
            for (int k = 0; k < 4; ++k) if (k != i0 && p[k] > v1) { v1 = p[k]; i1 = k; }
            if (lane == 0) { const int e0 = 4 * gsel + i0, e1 = 4 * gsel + i1; INFO[rl * 4 + 0] = e0; INFO[rl * 4 + 1] = e1;
                const float gs = 1.0f / (v0 + v1); gate[row * 2] = v0 * gs; gate[row * 2 + 1] = v1 * gs; }
        }
        __syncthreads();
        if (tid < 16) { int cnt = 0;
            for (int r = 0; r < 256; ++r) { if (INFO[r * 4] == tid) INFO[r * 4 + 2] = cnt++; else if (INFO[r * 4 + 1] == tid) INFO[r * 4 + 3] = cnt++; }
            histg[chunk * 16 + tid] = cnt; }
        __syncthreads();
        if (tid < 256) { i32x4 v; v.x = INFO[tid * 4]; v.y = INFO[tid * 4 + 1]; v.z = INFO[tid * 4 + 2]; v.w = INFO[tid * 4 + 3]; ((GAS i32x4*)(c.ws + WS_INFO))[(size_t)chunk * 256 + tid] = v; }
        __syncthreads();
    }
}
DI void phase_r2(LAS unsigned char* lds, const Ctx& c, int l, int G) {
    const int tid = ltid(); volatile LAS int* BASE = (volatile LAS int*)(lds + R_BASE);
    const int* histg = (const int*)(c.ws + WS_HISTG); int* list = (int*)(c.ws + WS_LIST);
    unsigned* cur = (unsigned*)(c.ws + WS_CTL) + CW_CUR + l * 16 * 64;
    for (int chunk = lbid(); chunk < T / 256; chunk += G) {
        __syncthreads();
        if (tid < 16) BASE[tid] = 0;
        __syncthreads();
        { const int e = tid & 15; int s = 0; for (int cc = tid >> 4; cc < chunk; cc += 32) s += histg[cc * 16 + e]; if (s) atomicAdd((int*)&BASE[e], s); }
        __syncthreads();
        if (tid < 256) { const i32x4 v = ((const GAS i32x4*)(c.ws + WS_INFO))[(size_t)chunk * 256 + tid]; const int row = chunk * 256 + tid;
            list[(size_t)v.x * T + BASE[v.x] + v.z] = row * 2; list[(size_t)v.y * T + BASE[v.y] + v.w] = row * 2 + 1; }
        if (chunk == T / 256 - 1 && tid < 16) __hip_atomic_store(cur + tid * 64, (unsigned)(BASE[tid] + histg[chunk * 16 + tid]), __ATOMIC_RELAXED, __HIP_MEMORY_SCOPE_AGENT);
    }
}
DI int moe_setup(LAS unsigned char* lds, const Ctx& c, int l) {
    volatile LAS int* PRE = (volatile LAS int*)(lds + MISC_OFF); volatile LAS int* CNT = PRE + 17;
    unsigned* cur = (unsigned*)(c.ws + WS_CTL) + CW_CUR + l * 16 * 64;
    __syncthreads();
    if (threadIdx.x == 0) { int acc = 0; for (int e = 0; e < 16; ++e) { const int n = (int)__hip_atomic_load(cur + e * 64, __ATOMIC_RELAXED, __HIP_MEMORY_SCOPE_AGENT); PRE[e] = acc; CNT[e] = n; acc += (n + 255) >> 8; } PRE[16] = acc; }
    __syncthreads();
    return rfl(PRE[16]);
}
DI void phase_c(const Ctx& c, int l, int G) {
    const int tid = ltid(), lane = tid & 63, wave = rfl(tid >> 6);
    f32x4 g4[4], b4[4];
#pragma unroll
    for (int j = 0; j < 4; ++j) { g4[j] = *(const GAS f32x4*)(c.ln2_g + l * D + 4 * lane + 256 * j); b4[j] = *(const GAS f32x4*)(c.ln2_b + l * D + 4 * lane + 256 * j); }
    float* xo = c.out; bf16_t* xb = wsb(c, WS_XB); const bf16_t* ys = wsb(c, WS_YS); const float* gate = (const float*)(c.ws + WS_GATE);
    for (size_t row = (size_t)lbid() * NWAVES + wave; row < (size_t)T; row += (size_t)G * NWAVES) {
        const float g0 = gate[row * 2], g1 = gate[row * 2 + 1];
        f32x4 v[4]; float s = 0.f;
#pragma unroll
        for (int j = 0; j < 4; ++j) { const f32x4 xr = *(const GAS f32x4*)(xo + row * D + 4 * lane + 256 * j);
            const u32x2 y0 = *(const GAS u32x2*)(ys + (row * 2) * D + 4 * lane + 256 * j), y1 = *(const GAS u32x2*)(ys + (row * 2 + 1) * D + 4 * lane + 256 * j);
            v[j][0] = xr[0] * DN_ALPHA + g0 * bf_lo(y0.x) + g1 * bf_lo(y1.x); v[j][1] = xr[1] * DN_ALPHA + g0 * bf_hi(y0.x) + g1 * bf_hi(y1.x);
            v[j][2] = xr[2] * DN_ALPHA + g0 * bf_lo(y0.y) + g1 * bf_lo(y1.y); v[j][3] = xr[3] * DN_ALPHA + g0 * bf_hi(y0.y) + g1 * bf_hi(y1.y);
            s += (v[j][0] + v[j][1]) + (v[j][2] + v[j][3]); }
        const float mean = wave_sum(s) * (1.0f / D); float s2 = 0.f;
#pragma unroll
        for (int j = 0; j < 4; ++j) { v[j] = v[j] - mean; s2 += (v[j][0] * v[j][0] + v[j][1] * v[j][1]) + (v[j][2] * v[j][2] + v[j][3] * v[j][3]); }
        const float rstd = __builtin_amdgcn_rsqf(wave_sum(s2) * (1.0f / D) + LN_EPS);
#pragma unroll
        for (int j = 0; j < 4; ++j) { v[j] = v[j] * rstd * g4[j] + b4[j]; *(GAS f32x4*)(xo + row * D + 4 * lane + 256 * j) = v[j];
            u32x2 pk; pk.x = cvt_pk_bf16(v[j][0], v[j][1]); pk.y = cvt_pk_bf16(v[j][2], v[j][3]); *(GAS u32x2*)(xb + row * D + 4 * lane + 256 * j) = pk; }
    }
}

DI Ctx load_ctx() {
    union { Ctx c; unsigned long long q[sizeof(Ctx) / 8]; } u;
#if defined(__HIP_DEVICE_COMPILE__)
    const __attribute__((address_space(4))) unsigned long long* p = (const __attribute__((address_space(4))) unsigned long long*)__builtin_amdgcn_kernarg_segment_ptr();
    asm volatile("" : "+s"(p));
#pragma unroll
    for (int i = 0; i < (int)(sizeof(Ctx) / 8); ++i) u.q[i] = p[i];
#endif
    return u.c;
}
#define CTX const Ctx c = load_ctx(); const int G = lgrid(); LAS unsigned char* lds = LDSBASE
__global__ void __launch_bounds__(NTHREADS, 2) mk_fwd(Ctx c_arg) {
    extern __shared__ __attribute__((aligned(16))) unsigned char lds_raw[];
#define LDSBASE ({ unsigned _b = (unsigned)(uintptr_t)(LAS unsigned char*)lds_raw; asm volatile("" : "+s"(_b)); (LAS unsigned char*)(uintptr_t)_b; })
    LAS unsigned char* lds0 = LDSBASE;
    const int tid = threadIdx.x; const Ctx c = load_ctx();
    volatile LAS unsigned* MISC = (volatile LAS unsigned*)(lds0 + MISC_OFF);
    if (tid < 64) MISC[tid] = 0u;
    __syncthreads();
    XcdBarrier bar; bar.bar = (unsigned*)(c.ws + WS_CTL) + CW_BAR; bar.x = 0; bar.st = MISC + 40;
    if (!MK_MULTI) bar = xcd_barrier_post((unsigned*)(c.ws + WS_CTL) + CW_BAR, MISC + 40);
    const int lo = c.lo, hi = c.hi; int step = 0;
#define RUN (lo <= step && step < hi)
#define END_STEP do { if (RUN && step + 1 < hi) { if (!MK_MULTI) xcd_barrier(bar); } ++step; } while (0)
    for (int l = 0; l < DEPTH; ++l) {
        if (RUN) { CTX; phase_w(lds, c, l, G); }
        END_STEP;
        for (int hf = 0; hf < 2; ++hf) {
            const size_t r0 = (size_t)hf * TH;
            if (RUN) {
                CTX;
                pg8::StaticOrder S; S.init(wsb(c, WS_XB) + r0 * D, wsb(c, WS_WIN), TH, NIN, D, G, lbid());
                EpiIn E{wsb(c, WS_H + H_QG), wsb(c, WS_H + H_KG), wsb(c, WS_H + H_VG), wsb(c, WS_H + H_SR), wsb(c, WS_H + H_QD), wsb(c, WS_H + H_KD), wsb(c, WS_H + H_VD), wsb(c, WS_H + H_GT), (float*)(c.ws + WS_HA), c.pos + r0};
                pg8::gemm_phase(lds, D, S, E);
            }
            END_STEP;
            if (RUN) { CTX; phase_p(lds, c, l, G); }
            END_STEP;
            if (RUN) { CTX; phase_b1(lds, c, l, hf, G); }
            END_STEP;
            if (RUN) { CTX; phase_b(lds, c, l, hf, G); }
            END_STEP;
            if (RUN) { CTX; (void)lds; phase_f(c, G); }
            END_STEP;
            if (RUN) {
                CTX;
                pg8::StaticOrder S; S.init(wsb(c, WS_OG), wsb(c, WS_WGO), TH, D, D, G, lbid());
                EpiGate<false> E{wsb(c, WS_MIX), wsb(c, WS_H + H_GT)};
                pg8::gemm_phase(lds, D, S, E);
            }
            END_STEP;
            if (RUN) {
                CTX;
                pg8::StaticOrder S; S.init(wsb(c, WS_ATT), wsb(c, WS_WAO), TH, D, 512, G, lbid());
                EpiGate<true> E{wsb(c, WS_MIX), wsb(c, WS_H + H_GT) + 1024};
                pg8::gemm_phase(lds, 512, S, E);
            }
            END_STEP;
            if (RUN) {
                CTX;
                pg8::StaticOrder S; S.init(wsb(c, WS_MIX), wsb(c, WS_WOUT), TH, D, D, G, lbid());
                EpiRes E{(l == 0 ? c.x : c.out) + r0 * D, c.out + r0 * D};
                pg8::gemm_phase(lds, D, S, E);
            }
            END_STEP;
        }
        if (RUN) { CTX; phase_r(lds, c, l, G); }
        END_STEP;
        if (RUN) { CTX; phase_r2(lds, c, l, G); }
        END_STEP;
        if (RUN) {   CTX;
            const int ntiles = moe_setup(lds, c, l);
            volatile LAS int* PRE = (volatile LAS int*)(lds + MISC_OFF); volatile LAS int* TAB = (volatile LAS int*)(lds + TAB_OFF);
            pg8::MoeOrder S; S.G = G; S.c = lbid(); S.ntot = ntiles * 8; S.NC = 8; S.K = D; S.pre = PRE; S.cnt = PRE + 17; S.A = (const char*)wsb(c, WS_XB); S.Bt = (const char*)wsb(c, WS_WGU);
            S.bstride = (size_t)2048 * 1024 * 2; S.tab = TAB; S.gather = true;
            const int* list = (const int*)(c.ws + WS_LIST);
            { const int lt_tid = ltid(); const int r = lt_tid & 255, half = rfl(lt_tid >> 8);
              for (int i0 = 0; i0 < MAXU; i0 += 2) { Unit u; const int i = i0 + half;
                  if (S.next(i, u)) { const int lt = u.pm - PRE[u.e]; const int pos = 256 * lt + (r < u.nv ? r : 0); TAB[i * 256 + r] = list[(size_t)u.e * T + pos] >> 1; } } }
            __syncthreads();
            EpiM1 E{wsb(c, WS_HM)};
            pg8::gemm_phase(lds, D, S, E);
        }
        END_STEP;
        if (RUN) {   CTX;
            const int ntiles = moe_setup(lds, c, l);
            volatile LAS int* PRE = (volatile LAS int*)(lds + MISC_OFF);
            pg8::MoeOrder S; S.G = G; S.c = lbid(); S.ntot = ntiles * 4; S.NC = 4; S.K = DFF; S.pre = PRE; S.cnt = PRE + 17; S.A = (const char*)wsb(c, WS_HM); S.Bt = (const char*)wsb(c, WS_WD);
            S.bstride = (size_t)1024 * 1024 * 2; S.tab = nullptr; S.gather = false;
            EpiM2 E{wsb(c, WS_YS), (const int*)(c.ws + WS_LIST), PRE};
            pg8::gemm_phase(lds, DFF, S, E);
        }
        END_STEP;
        if (RUN) { CTX; (void)lds; phase_c(c, l, G); }
        END_STEP;
    }
#undef RUN
#undef END_STEP
}
constexpr int NSTEPS = DEPTH * (1 + 2 * 8 + 5);

extern "C" void kernel_launch(void* const* d_in, const int* in_sizes, int n_in, void* d_out, int out_size, void* d_ws, size_t ws_size, hipStream_t stream) {
    static int grid = 0;
    if (grid == 0) {
        if (n_in != 18 || in_sizes[0] != T * D || out_size != T * D || ws_size < WS_END) { fprintf(stderr, "kernel_launch: unexpected shapes / workspace (need %zu, got %zu)\n", (size_t)WS_END, ws_size); grid = -1; return; }
        int dev = 0, cus = 0;
        if (hipGetDevice(&dev) != hipSuccess || hipDeviceGetAttribute(&cus, hipDeviceAttributeMultiprocessorCount, dev) != hipSuccess) { grid = -1; return; }
        if (hipFuncSetAttribute((const void*)mk_fwd, hipFuncAttributeMaxDynamicSharedMemorySize, LDS_BYTES) != hipSuccess) { fprintf(stderr, "kernel_launch: hipFuncSetAttribute failed\n"); grid = -1; return; }
        int per_cu = 0;
        if (hipOccupancyMaxActiveBlocksPerMultiprocessor(&per_cu, (const void*)mk_fwd, NTHREADS, LDS_BYTES) != hipSuccess || per_cu < 1) { fprintf(stderr, "kernel_launch: occupancy query says %d\n", per_cu); }
        (void)hipGetLastError();
        grid = cus;
    }
    if (grid < 0) return;
    (void)hipMemsetAsync((char*)d_ws + WS_CTL, 0, CTL_ZERO_BYTES, stream);
    Ctx c{};
    c.x = (const float*)d_in[0]; c.pos = (const int*)d_in[1]; c.w_in = (const float*)d_in[2]; c.w_alpha_up = (const float*)d_in[3]; c.b_alpha = (const float*)d_in[4]; c.gla_norm = (const float*)d_in[5];
    c.w_gla_o = (const float*)d_in[6]; c.w_att_o = (const float*)d_in[7]; c.w_out = (const float*)d_in[8]; c.ln1_g = (const float*)d_in[9]; c.ln1_b = (const float*)d_in[10]; c.w_router = (const float*)d_in[11];
    c.b_router = (const float*)d_in[12]; c.w_e_gate = (const float*)d_in[13]; c.w_e_up = (const float*)d_in[14]; c.w_e_down = (const float*)d_in[15]; c.ln2_g = (const float*)d_in[16]; c.ln2_b = (const float*)d_in[17];
    c.out = (float*)d_out; c.ws = (unsigned char*)d_ws;
#if MK_MULTI
    for (int s = 0; s < NSTEPS; ++s) { c.lo = s; c.hi = s + 1; hipLaunchKernelGGL(mk_fwd, dim3(grid), dim3(NTHREADS), LDS_BYTES, stream, c); }
#else
    c.lo = 0; c.hi = NSTEPS; hipLaunchKernelGGL(mk_fwd, dim3(grid), dim3(NTHREADS), LDS_BYTES, stream, c);
#endif
}
```

```cpp
#include <hip/hip_runtime.h>
#include <cstdio>
#include <cstdint>

#ifndef MK_MULTI
#define MK_MULTI 0
#endif

#define DI __device__ __forceinline__
#define GAS __attribute__((address_space(1)))
#define LAS __attribute__((address_space(3)))
typedef unsigned short bf16_t;
typedef short bf16x8 __attribute__((ext_vector_type(8)));
typedef short s16x4 __attribute__((ext_vector_type(4)));
typedef float f32x4 __attribute__((ext_vector_type(4)));
typedef float f32x2 __attribute__((ext_vector_type(2)));
typedef unsigned u32x4 __attribute__((ext_vector_type(4)));
typedef unsigned u32x2 __attribute__((ext_vector_type(2)));
typedef int i32x4 __attribute__((ext_vector_type(4)));
typedef int i32x8 __attribute__((ext_vector_type(8)));
#define LDS_WAIT() asm volatile("s_waitcnt lgkmcnt(0)" ::: "memory")
#define VM_WAIT() asm volatile("s_waitcnt vmcnt(0)" ::: "memory")

constexpr int D = 1024, NBATCH = 16, SEQ = 4096, T = NBATCH * SEQ, DEPTH = 4;
constexpr int TH = T / 2;
constexpr int DIN = 9744, NIN = 9984;
constexpr int NEXP = 16, DFF = 1024;
constexpr float LN_EPS = 1e-5f, RMS_EPS = 1e-6f;
constexpr float DN_ALPHA = 1.6817928305074290f;
constexpr float LOG2E = 1.4426950408889634f;
constexpr int NWAVES = 8, NTHREADS = 512;

constexpr size_t MiB = 1u << 20;
constexpr size_t WS_CTL = 0, CTL_ZERO_BYTES = 1 * MiB;
constexpr size_t WS_WIN = 1 * MiB;
constexpr size_t WS_WGO = WS_WIN + (size_t)NIN * D * 2;
constexpr size_t WS_WAO = WS_WGO + 2 * MiB;
constexpr size_t WS_WOUT = WS_WAO + 1 * MiB;
constexpr size_t WS_WGU = WS_WOUT + 2 * MiB;
constexpr size_t WS_WD = WS_WGU + 64 * MiB;
constexpr size_t WS_XB = WS_WD + 32 * MiB;
constexpr size_t WS_LIST = WS_XB + 128 * MiB;
constexpr size_t WS_GATE = WS_LIST + 4 * MiB;
constexpr size_t WS_INFO = WS_GATE + 1 * MiB;
constexpr size_t WS_HISTG = WS_INFO + 1 * MiB;
constexpr size_t WS_OG = WS_HISTG + 1 * MiB;
constexpr size_t WS_ATTG = WS_OG + 64 * MiB;
constexpr size_t WS_LSE = WS_ATTG + 96 * MiB;
constexpr size_t WS_ATT = WS_LSE + 3 * MiB;
constexpr size_t WS_MIX = WS_ATT + 32 * MiB;
constexpr size_t WS_HA = WS_MIX + 64 * MiB;
constexpr size_t WS_H = WS_HA + 2 * MiB;
constexpr size_t H_QG = 0, H_KG = H_QG + (size_t)TH * 512 * 2, H_VG = H_KG + (size_t)TH * 512 * 2, H_SR = H_VG + (size_t)TH * 1024 * 2,
                 H_QD = H_SR + (size_t)TH * 1024 * 2, H_KD = H_QD + (size_t)TH * 1536 * 2, H_VD = H_KD + (size_t)TH * 1536 * 2, H_GT = H_VD + (size_t)TH * 1536 * 2,
                 H_END = H_GT + (size_t)TH * 2048 * 2;
constexpr size_t WS_HM = WS_H;
constexpr size_t WS_YS = WS_HM + (size_t)(2 * T + 4096) * 1024 * 2;
constexpr size_t WS_REC = WS_H + H_END;
constexpr size_t WS_SLOC = WS_REC + (size_t)2048 * 33792;
constexpr size_t WS_DCUM = WS_SLOC + 16 * MiB;
constexpr size_t WS_END = WS_DCUM + 1 * MiB;
static_assert(WS_YS + (size_t)2 * T * 1024 * 2 <= WS_END, "MoE overlay fits");
constexpr int CW_BAR = 4096;
constexpr int CW_TKT = 24576;
constexpr int CW_CUR = 16384;

constexpr int RING_BYTES = 131072;
constexpr int TAB_OFF = RING_BYTES, MAXU = 18, TAB_BYTES = MAXU * 1024;
constexpr int MISC_OFF = TAB_OFF + TAB_BYTES;
constexpr int LDS_BYTES = MISC_OFF + 256;

DI int rfl(int v) { return __builtin_amdgcn_readfirstlane(v); }
DI int lbid() { int t = blockIdx.x; asm volatile("" : "+s"(t)); return t; }
DI int lgrid() { int t = gridDim.x; asm volatile("" : "+s"(t)); return t; }
DI int ltid() { int t = threadIdx.x; asm volatile("" : "+v"(t)); return t; }
DI float bf2f(unsigned b) { return __uint_as_float(b << 16); }
typedef __bf16 bf16x2_t __attribute__((ext_vector_type(2)));
DI unsigned cvt_pk_bf16(float lo, float hi) { f32x2 v = {lo, hi}; bf16x2_t b = __builtin_convertvector(v, bf16x2_t); return __builtin_bit_cast(unsigned, b); }
DI float clamp8(float v) { return fminf(fmaxf(v, -448.f), 448.f); }
DI unsigned pk4_fp8(float a, float b, float c_, float d) { int w = 0; w = __builtin_amdgcn_cvt_pk_fp8_f32(clamp8(a), clamp8(b), w, false); w = __builtin_amdgcn_cvt_pk_fp8_f32(clamp8(c_), clamp8(d), w, true); return (unsigned)w; }
constexpr float W8_SCALE = 64.0f;
DI float bf_lo(unsigned w) { return __uint_as_float(w << 16); }
DI float bf_hi(unsigned w) { return __uint_as_float(w & 0xffff0000u); }
DI float sigmoidf_(float x) { return __builtin_amdgcn_rcpf(1.0f + __builtin_amdgcn_exp2f(-x * LOG2E)); }

#define XB_TMO      128
#define XB_XCNT(j)  (256  + 64 * (j))
#define XB_XSUB(j)  (1280 + 64 * (j))
#define XB_XGEN(j)  (2304 + 64 * (j))
#define XB_TOP      3328
#define XB_TOPGEN   3392
#define XCD_BAR_WORDS 3456
#define XB_SPIN_CAP (1u << 18)
DI unsigned xb_ld(unsigned* p)              { return __hip_atomic_load(p, __ATOMIC_RELAXED, __HIP_MEMORY_SCOPE_AGENT); }
DI unsigned xb_add(unsigned* p, unsigned v) { return __hip_atomic_fetch_add(p, v, __ATOMIC_RELAXED, __HIP_MEMORY_SCOPE_AGENT); }
DI unsigned xb_xcc_id() { return (unsigned)__builtin_amdgcn_s_getreg((3 << 11) | 20) & 0xFu; }
#define XB_SPIN(cond, bar) do { unsigned _sp = 0; while (cond) { __builtin_amdgcn_s_sleep(1); \
    if ((++_sp & 255u) == 0u) { if (xb_ld(&(bar)[XB_TMO])) break; if (_sp > XB_SPIN_CAP) { atomicAdd(&(bar)[XB_TMO], 1u); break; } } } } while (0)
struct XcdBarrier { unsigned* bar; unsigned x; volatile LAS unsigned* st; };
DI XcdBarrier xcd_barrier_post(unsigned* bar, volatile LAS unsigned* st) {
    XcdBarrier b; b.bar = bar; b.x = xb_xcc_id(); b.st = st;
    if (threadIdx.x == 0) (void)xb_add(&bar[XB_XCNT(b.x)], 1u);
    return b;
}
DI void xcd_barrier_complete(unsigned* bar, unsigned x, unsigned& nloc, unsigned& nx) {
    const unsigned G = gridDim.x * gridDim.y * gridDim.z;
    unsigned sum, cnt, mine, sp = 0u;
    for (;;) {
        sum = 0u; cnt = 0u; mine = 0u;
#pragma unroll
        for (unsigned j = 0; j < 16; ++j) { const unsigned c = xb_ld(&bar[XB_XCNT(j)]); sum += c; cnt += (c > 0u) ? 1u : 0u; mine = (j == x) ? c : mine; }
        if (sum == G) break;
        __builtin_amdgcn_s_sleep(1);
        if ((++sp & 255u) == 0u) { if (xb_ld(&bar[XB_TMO])) break; if (sp > XB_SPIN_CAP) { atomicAdd(&bar[XB_TMO], 1u); break; } }
    }
    nloc = mine > 0u ? mine : 1u; nx = cnt > 0u ? cnt : 1u;
}
DI void xcd_barrier(const XcdBarrier& b) {
    asm volatile("s_waitcnt vmcnt(0)" ::: "memory");
    __syncthreads();
    if (threadIdx.x == 0) {
        unsigned* bar = b.bar;
        __builtin_amdgcn_s_waitcnt(0);
        unsigned nloc = b.st[0], nx = b.st[1];
        if (nloc == 0u) { xcd_barrier_complete(bar, b.x, nloc, nx); b.st[0] = nloc; b.st[1] = nx; }
        const unsigned old = xb_add(&bar[XB_XSUB(b.x)], 1u);
        const unsigned gen = old / nloc;
        if (old + 1u == (gen + 1u) * nloc) {
            __builtin_amdgcn_fence(__ATOMIC_RELEASE, "agent");
            asm volatile("s_waitcnt vmcnt(0)" ::: "memory");
            const unsigned og = xb_add(&bar[XB_TOP], 1u);
            const unsigned tg = og / nx;
            if (og + 1u == (tg + 1u) * nx) xb_add(&bar[XB_TOPGEN], 1u);
            else XB_SPIN(xb_ld(&bar[XB_TOPGEN]) == tg, bar);
            __builtin_amdgcn_fence(__ATOMIC_ACQUIRE, "agent");
            xb_add(&bar[XB_XGEN(b.x)], 1u);
            asm volatile("s_waitcnt vmcnt(0)" ::: "memory");
        } else {
            XB_SPIN(xb_ld(&bar[XB_XGEN(b.x)]) == gen, bar);
            __builtin_amdgcn_fence(__ATOMIC_ACQUIRE, "agent");
            asm volatile("s_waitcnt vmcnt(0)" ::: "memory");
        }
    }
    __syncthreads();
}

struct Ctx {
    const float* x; const int* pos; const float* w_in; const float* w_alpha_up; const float* b_alpha; const float* gla_norm;
    const float* w_gla_o; const float* w_att_o; const float* w_out; const float* ln1_g; const float* ln1_b; const float* w_router; const float* b_router;
    const float* w_e_gate; const float* w_e_up; const float* w_e_down; const float* ln2_g; const float* ln2_b;
    float* out; unsigned char* ws;
    int lo, hi;
};
DI bf16_t* wsb(const Ctx& c, size_t off) { return (bf16_t*)(c.ws + off); }

namespace pg8 {
constexpr int BM = 256, BK = 64, HALF = 128, HTB = HALF * BK * 2, STAGE_BYTES = 8 * HTB, NXCD = 8, WGM = 8;
DI int lds_byte(int r, int c) { const int st = (r >> 4) * 2 + (c >> 5), rr = r & 15, cc = c & 31, ob = rr * 64 + cc * 2; return st * 1024 + (ob ^ (((ob >> 9) & 1) << 5)); }
DI void stage_rc(int b, int& R, int& C) { const int st = b / 1024, sb = b % 1024, swz = sb ^ (((sb >> 9) & 1) << 5); R = (st >> 1) * 16 + swz / 64; C = (st & 1) * 32 + (swz % 64) / 2; }
DI int perm32(int rho) { const int n = rho >> 4, i = rho & 15; return 8 * (i >> 2) + 4 * n + (i & 3); }
struct Unit { int pm, pn, e, nv, ui; };

struct StaticOrder {
    int nM, nN, nwg, G, c, K; const char* A; const char* Bt;
    DI void init(const void* A_, const void* Bt_, int M, int N, int K_, int G_, int c_) { A = (const char*)A_; Bt = (const char*)Bt_; nM = M / BM; nN = N / BM; nwg = nM * nN; G = G_; c = c_; K = K_; }
    DI bool next(int i, Unit& u) const {
        const long L = (long)i * G + c; if (L >= nwg) return false;
        int wgid = (int)L; { const int q = nwg / NXCD, r = nwg % NXCD, xcd = wgid % NXCD, off = wgid / NXCD; wgid = (xcd < r ? xcd * (q + 1) : r * (q + 1) + (xcd - r) * q) + off; }
        const int nig = WGM * nN, gid = wgid / nig, fm = gid * WGM, gsz = (nM - fm) < WGM ? (nM - fm) : WGM;
        u.pm = fm + ((wgid % nig) % gsz); u.pn = (wgid % nig) / gsz; u.e = 0; u.nv = 256; u.ui = i; return true;
    }
    DI const char* a_base(const Unit& u) const { return A + (size_t)u.pm * BM * K * 2; }
    DI const char* b_base(const Unit& u) const { return Bt + (size_t)u.pn * BM * K * 2; }
    DI void a_off(const Unit&, int tid, unsigned (&o)[2][2]) const {
#pragma unroll
        for (int i = 0; i < 2; ++i) { int R, C; stage_rc(tid * 16 + i * 8192, R, C);
#pragma unroll
            for (int h = 0; h < 2; ++h) o[h][i] = (unsigned)((h * HALF + R) * K + C) * 2u; }
    }
};
struct MoeOrder {
    int G, c, ntot, NC, K; const volatile LAS int* pre; const volatile LAS int* cnt; const char* A; const char* Bt; size_t bstride; const volatile LAS int* tab; bool gather;
    DI bool next(int i, Unit& u) const {
        const int L = i * G + c; if (L >= ntot) return false;
        const int rt = L / NC; u.pn = L - rt * NC; u.pm = rt;
        int e = 0;
#pragma unroll
        for (int j = 1; j < 16; ++j) e += (rt >= rfl(pre[j])) ? 1 : 0;
        e = rfl(e); u.e = e; const int rem = rfl(cnt[e]) - 256 * (rt - rfl(pre[e])); u.nv = rem < 256 ? rem : 256; u.ui = i; return true;
    }
    DI const char* a_base(const Unit& u) const { return gather ? A : A + (size_t)u.pm * BM * K * 2; }
    DI const char* b_base(const Unit& u) const { return Bt + (size_t)u.e * bstride + (size_t)u.pn * BM * K * 2; }
    DI void a_off(const Unit& u, int tid, unsigned (&o)[2][2]) const {
#pragma unroll
        for (int i = 0; i < 2; ++i) { int R, C; stage_rc(tid * 16 + i * 8192, R, C);
#pragma unroll
            for (int h = 0; h < 2; ++h) { const int row = gather ? tab[u.ui * 256 + h * HALF + R] : (h * HALF + R); o[h][i] = (unsigned)(row * K + C) * 2u; } }
    }
};

template <class Epi, class Sched, bool F8 = false>
DI void gemm_phase(LAS unsigned char* lds, const int K, const Sched& S, const Epi& E) {
    const int tid = ltid(), wid = rfl(tid >> 6), lane = tid & 63, wr = wid >> 2, wc = wid & 3, fr = lane & 15, fq = lane >> 4;
    const int nt = K / BK;
    unsigned voffB[2];
#pragma unroll
    for (int i = 0; i < 2; ++i) { int R, C; stage_rc(tid * 16 + i * 8192, R, C); const int Rb = Epi::PERM ? ((R & ~31) + perm32(R & 31)) : R; voffB[i] = (unsigned)(Rb * K + C) * 2u; }
    const size_t kstep = (size_t)(BK * 2);
    const size_t hstep = (size_t)HALF * K * 2;
    const unsigned ldsw = (unsigned)wid * 1024u;
    const int aoff = lds_byte(wr * 64 + fr, fq * 8), boff = lds_byte(wc * 32 + fr, fq * 8);
#define PG8_SA(b, h) (((b) * 2 + (h)) * HTB)
#define PG8_SB(b, h) ((4 + (b) * 2 + (h)) * HTB)
#define PG8_STAGE(bufoff, gbase, voff) do { _Pragma("unroll") for (int _i = 0; _i < 2; ++_i) \
        __builtin_amdgcn_global_load_lds((const unsigned*)((const char*)(gbase) + (voff)[_i]), (LAS unsigned*)(lds + (bufoff) + ldsw + _i * 8192), 16, 0, 0); } while (0)
#define PG8_LD8(p) __builtin_shufflevector(*(const LAS i32x4*)(p), *(const LAS i32x4*)((p) + 1024), 0, 1, 2, 3, 4, 5, 6, 7)
#define PG8_LDA(dst, b, h) do { if constexpr (F8) { _Pragma("unroll") for (int m = 0; m < 4; ++m) dst##8[m] = PG8_LD8(lds + PG8_SA(b, h) + aoff + m * 2048); } else { \
        _Pragma("unroll") for (int m = 0; m < 4; ++m) _Pragma("unroll") for (int k = 0; k < 2; ++k) dst[m][k] = *(const LAS bf16x8*)(lds + PG8_SA(b, h) + aoff + m * 2048 + k * 1024); } } while (0)
#define PG8_LDB(dst, b, h) do { if constexpr (F8) { _Pragma("unroll") for (int n = 0; n < 2; ++n) dst##8[n] = PG8_LD8(lds + PG8_SB(b, h) + boff + n * 2048); } else { \
        _Pragma("unroll") for (int n = 0; n < 2; ++n) _Pragma("unroll") for (int k = 0; k < 2; ++k) dst[n][k] = *(const LAS bf16x8*)(lds + PG8_SB(b, h) + boff + n * 2048 + k * 1024); } } while (0)
#define PG8_MMA(ai, bj, At, Bt) do { __builtin_amdgcn_s_setprio(1); if constexpr (F8) { _Pragma("unroll") for (int m = 0; m < 4; ++m) _Pragma("unroll") for (int n = 0; n < 2; ++n) \
        asm volatile("v_mfma_scale_f32_16x16x128_f8f6f4 %0, %1, %2, %0, %3, %4 op_sel_hi:[0,0,0]" : "+v"(acc[ai][bj][m][n]) : "v"(Bt##8[n]), "v"(At##8[m]), "v"(sc_w), "v"(sc_a)); } else { \
        _Pragma("unroll") for (int m = 0; m < 4; ++m) _Pragma("unroll") for (int n = 0; n < 2; ++n) _Pragma("unroll") for (int k = 0; k < 2; ++k) \
        acc[ai][bj][m][n] = __builtin_amdgcn_mfma_f32_16x16x32_bf16(Bt[n][k], At[m][k], acc[ai][bj][m][n], 0, 0, 0); } __builtin_amdgcn_s_setprio(0); } while (0)
#define PG8_WAIT_V(n) asm volatile("s_waitcnt vmcnt(" #n ")" ::: "memory")
#define PG8_WAIT_L(n) asm volatile("s_waitcnt lgkmcnt(" #n ")" ::: "memory")
#define PG8_BAR __builtin_amdgcn_s_barrier()
#define PG8_SCHED __builtin_amdgcn_sched_barrier(0)
    Unit cur, nxt; int ui = 0;
    if (!S.next(0, cur)) return;
    f32x4 acc[2][2][4][2];
#pragma unroll
    for (int a = 0; a < 2; ++a)
#pragma unroll
        for (int b = 0; b < 2; ++b)
#pragma unroll
            for (int m = 0; m < 4; ++m)
#pragma unroll
                for (int n = 0; n < 2; ++n) acc[a][b][m][n] = (f32x4){0.f, 0.f, 0.f, 0.f};
    int sc_w = 0x79797979, sc_a = 0x7f7f7f7f; asm volatile("" : "+v"(sc_w), "+v"(sc_a));
    bf16x8 At[4][2], B0[2][2], B1[2][2]; i32x8 At8[4], B08[2], B18[2];
    unsigned oA[2][2]; S.a_off(cur, tid, oA);
    const char* cA = S.a_base(cur); const char* cB = S.b_base(cur);
    PG8_STAGE(PG8_SB(0, 0), cB, voffB); PG8_STAGE(PG8_SB(0, 1), cB + hstep, voffB); PG8_STAGE(PG8_SA(0, 0), cA, oA[0]); PG8_STAGE(PG8_SA(0, 1), cA, oA[1]);
    if (wr == 1) PG8_BAR;
    PG8_WAIT_V(2); PG8_BAR;
    PG8_STAGE(PG8_SB(1, 0), cB + kstep, voffB); PG8_STAGE(PG8_SA(1, 0), cA + kstep, oA[0]); PG8_STAGE(PG8_SB(1, 1), cB + hstep + kstep, voffB);
    PG8_WAIT_V(6); PG8_BAR;
    for (;;) {
        const bool has_next = S.next(ui + 1, nxt);
        const char* nA = has_next ? S.a_base(nxt) : cA; const char* nB = has_next ? S.b_base(nxt) : cB;
        for (int t = 0; t < nt; t += 2) {
            const bool last = (t == nt - 2);
            const char* a1 = cA + (size_t)(t + 1) * kstep;
            const char* a2 = last ? nA : cA + (size_t)(t + 2) * kstep; const char* b2 = last ? nB : cB + (size_t)(t + 2) * kstep;
            const char* a3 = a2 + kstep; const char* b3 = b2 + kstep;
            PG8_LDB(B0, 0, 0); PG8_LDB(B1, 0, 1); PG8_SCHED; PG8_LDA(At, 0, 0); PG8_STAGE(PG8_SA(1, 1), a1, oA[1]);
            if (last && has_next) S.a_off(nxt, tid, oA);
            PG8_WAIT_V(8); PG8_WAIT_L(0); PG8_BAR; PG8_MMA(0, 0, At, B0); PG8_MMA(0, 1, At, B1); PG8_BAR; PG8_SCHED;
            PG8_LDA(At, 0, 1); PG8_STAGE(PG8_SB(0, 0), b2, voffB); PG8_STAGE(PG8_SB(0, 1), b2 + hstep, voffB); PG8_STAGE(PG8_SA(0, 0), a2, oA[0]);
            PG8_WAIT_V(8); PG8_WAIT_L(0); PG8_BAR; PG8_MMA(1, 0, At, B0); PG8_MMA(1, 1, At, B1); PG8_BAR; PG8_SCHED;
            PG8_LDB(B0, 1, 0); PG8_LDB(B1, 1, 1); PG8_SCHED; PG8_LDA(At, 1, 0); PG8_STAGE(PG8_SA(0, 1), a2, oA[1]);
            PG8_WAIT_V(8); PG8_WAIT_L(0); PG8_BAR; PG8_MMA(0, 0, At, B0); PG8_MMA(0, 1, At, B1); PG8_BAR; PG8_SCHED;
            PG8_LDA(At, 1, 1); PG8_STAGE(PG8_SB(1, 0), b3, voffB); PG8_STAGE(PG8_SB(1, 1), b3 + hstep, voffB); PG8_STAGE(PG8_SA(1, 0), a3, oA[0]);
            PG8_WAIT_V(8); PG8_WAIT_L(0); PG8_BAR; PG8_MMA(1, 0, At, B0); PG8_MMA(1, 1, At, B1); PG8_BAR; PG8_SCHED;
        }
        if (wr == 0) PG8_BAR;
        if constexpr (F8) asm volatile("s_nop 15\n\ts_nop 15" ::: "memory");
        E(acc, cur, wr, wc, fr, fq);
        if (!has_next) break;
#pragma unroll
        for (int a = 0; a < 2; ++a)
#pragma unroll
            for (int b = 0; b < 2; ++b)
#pragma unroll
                for (int m = 0; m < 4; ++m)
#pragma unroll
                    for (int n = 0; n < 2; ++n) acc[a][b][m][n] = (f32x4){0.f, 0.f, 0.f, 0.f};
        cur = nxt; cA = nA; cB = nB; ++ui;
        if (wr == 1) PG8_BAR;
    }
    PG8_WAIT_V(0);
    PG8_BAR;
#undef PG8_SA
#undef PG8_SB
#undef PG8_STAGE
#undef PG8_LDA
#undef PG8_LDB
#undef PG8_MMA
#undef PG8_LD8
#undef PG8_WAIT_V
#undef PG8_WAIT_L
#undef PG8_BAR
#undef PG8_SCHED
}
}
using pg8::Unit;

DI u32x4 pack8(const f32x4& v0, const f32x4& v1) { u32x4 w; w.x = cvt_pk_bf16(v0[0], v0[1]); w.y = cvt_pk_bf16(v0[2], v0[3]); w.z = cvt_pk_bf16(v1[0], v1[1]); w.w = cvt_pk_bf16(v1[2], v1[3]); return w; }

struct EpiIn {
    static constexpr bool PERM = true;
    bf16_t *qg, *kg, *vg, *sr, *qd, *kd, *vd, *gt; float* ha; const int* pos;
    DI void operator()(const f32x4 (&acc)[2][2][4][2], const Unit& u, int wr, int wc, int fr, int fq) const {
        const int row0 = u.pm * 256 + wr * 64 + fr; const int pn = u.pn;
        if (pn >= 12 && pn < 24) {
            bf16_t* base = pn < 18 ? qd : kd; const int tq = pn < 18 ? pn - 12 : pn - 18; const float sc = pn < 18 ? 0.125f * LOG2E : 1.0f;
            float fre[8];
#pragma unroll
            for (int i = 0; i < 8; ++i) fre[i] = __builtin_amdgcn_exp2f(-(float)(8 * fq + i) * (13.287712379549449f / 32.0f)) * 0.15915494309189535f;
#pragma unroll
            for (int ai = 0; ai < 2; ++ai)
#pragma unroll
                for (int m = 0; m < 4; ++m) {
                    const int r = row0 + ai * 128 + m * 16; const float p = (float)pos[r];
                    bf16_t* rowp = base + (size_t)r * 1536 + (4 * tq + wc) * 64 + 8 * fq;
#pragma unroll
                    for (int n = 0; n < 2; ++n) { f32x4 o1, o2;
#pragma unroll
                        for (int j = 0; j < 4; ++j) {
                            float a = p * fre[n * 4 + j]; a = a - __builtin_floorf(a);
                            const float sn = __builtin_amdgcn_sinf(a), cs = __builtin_amdgcn_cosf(a);
                            const float x1 = acc[ai][0][m][n][j], x2 = acc[ai][1][m][n][j];
                            o1[j] = (x1 * cs - x2 * sn) * sc; o2[j] = (x2 * cs + x1 * sn) * sc;
                        }
                        u32x2 w1, w2; w1.x = cvt_pk_bf16(o1[0], o1[1]); w1.y = cvt_pk_bf16(o1[2], o1[3]); w2.x = cvt_pk_bf16(o2[0], o2[1]); w2.y = cvt_pk_bf16(o2[2], o2[3]);
                        *(GAS u32x2*)(rowp + 4 * n) = w1; *(GAS u32x2*)(rowp + 32 + 4 * n) = w2; }
                    asm volatile("" ::: "memory");
                }
        } else if (pn == 38) {
            if (wc == 0 && fq < 2) {
#pragma unroll
                for (int ai = 0; ai < 2; ++ai)
#pragma unroll
                    for (int m = 0; m < 4; ++m) { float* p = ha + (size_t)(row0 + ai * 128 + m * 16) * 16 + 8 * fq; *(GAS f32x4*)p = acc[ai][0][m][0]; *(GAS f32x4*)(p + 4) = acc[ai][0][m][1]; }
            }
        } else {
            bf16_t* base; int ldc, colt, act = 0; float sc = 1.0f;
            if (pn < 2) { base = qg; ldc = 512; colt = pn * 256; sc = 0.08838834764831845f; }
            else if (pn < 4) { base = kg; ldc = 512; colt = (pn - 2) * 256; }
            else if (pn < 8) { base = vg; ldc = 1024; colt = (pn - 4) * 256; }
            else if (pn < 12) { base = sr; ldc = 1024; colt = (pn - 8) * 256; act = 1; }
            else if (pn < 30) { base = vd; ldc = 1536; colt = (pn - 24) * 256; }
            else { base = gt; ldc = 2048; colt = (pn - 30) * 256; act = 2; }
#pragma unroll
            for (int ai = 0; ai < 2; ++ai)
#pragma unroll
                for (int m = 0; m < 4; ++m) { bf16_t* rowp = base + (size_t)(row0 + ai * 128 + m * 16) * ldc + colt + wc * 32 + 8 * fq;
#pragma unroll
                    for (int bj = 0; bj < 2; ++bj) { f32x4 v0 = acc[ai][bj][m][0] * sc, v1 = acc[ai][bj][m][1] * sc;
                        if (act) {
#pragma unroll
                            for (int j = 0; j < 4; ++j) { const float s0 = sigmoidf_(v0[j]), s1 = sigmoidf_(v1[j]); v0[j] = act == 1 ? v0[j] * s0 : s0; v1[j] = act == 1 ? v1[j] * s1 : s1; } }
                        *(GAS u32x4*)(rowp + bj * 128) = pack8(v0, v1); } }
        }
    }
};
template <bool ADD> struct EpiGate {
    static constexpr bool PERM = true;
    bf16_t* mix; const bf16_t* gt;
    DI void operator()(const f32x4 (&acc)[2][2][4][2], const Unit& u, int wr, int wc, int fr, int fq) const {
        const int row0 = u.pm * 256 + wr * 64 + fr, col0 = u.pn * 256 + wc * 32 + 8 * fq;
#pragma unroll
        for (int ai = 0; ai < 2; ++ai)
#pragma unroll
            for (int m = 0; m < 4; ++m) { const size_t r = (size_t)(row0 + ai * 128 + m * 16);
#pragma unroll
                for (int bj = 0; bj < 2; ++bj) {
                    const u32x4 g = *(const GAS u32x4*)(gt + r * 2048 + col0 + bj * 128);
                    f32x4 v0 = acc[ai][bj][m][0], v1 = acc[ai][bj][m][1];
                    v0[0] *= bf_lo(g.x); v0[1] *= bf_hi(g.x); v0[2] *= bf_lo(g.y); v0[3] *= bf_hi(g.y); v1[0] *= bf_lo(g.z); v1[1] *= bf_hi(g.z); v1[2] *= bf_lo(g.w); v1[3] *= bf_hi(g.w);
                    bf16_t* mp = mix + r * 1024 + col0 + bj * 128;
                    if (ADD) { const u32x4 o = *(const GAS u32x4*)mp; v0[0] += bf_lo(o.x); v0[1] += bf_hi(o.x); v0[2] += bf_lo(o.y); v0[3] += bf_hi(o.y); v1[0] += bf_lo(o.z); v1[1] += bf_hi(o.z); v1[2] += bf_lo(o.w); v1[3] += bf_hi(o.w); }
                    *(GAS u32x4*)mp = pack8(v0, v1); } }
    }
};
struct EpiRes {
    static constexpr bool PERM = false;
    const float* xres; float* z;
    DI void operator()(const f32x4 (&acc)[2][2][4][2], const Unit& u, int wr, int wc, int fr, int fq) const {
        const int row0 = u.pm * 256 + wr * 64 + fr, col0 = u.pn * 256 + wc * 32 + 4 * fq;
#pragma unroll
        for (int ai = 0; ai < 2; ++ai)
#pragma unroll
            for (int m = 0; m < 4; ++m) { const size_t off = (size_t)(row0 + ai * 128 + m * 16) * 1024 + col0;
#pragma unroll
                for (int bj = 0; bj < 2; ++bj)
#pragma unroll
                    for (int n = 0; n < 2; ++n) { const f32x4 xr = *(const GAS f32x4*)(xres + off + bj * 128 + n * 16); *(GAS f32x4*)(z + off + bj * 128 + n * 16) = xr * DN_ALPHA + acc[ai][bj][m][n]; }
                asm volatile("" ::: "memory"); }
    }
};
struct EpiM1 {
    static constexpr bool PERM = true;
    unsigned char* hm;
    DI void operator()(const f32x4 (&acc)[2][2][4][2], const Unit& u, int wr, int wc, int fr, int fq) const {
        const int row0 = u.pm * 256 + wr * 64 + fr, col0 = u.pn * 128 + wc * 32 + 8 * fq;
#pragma unroll
        for (int ai = 0; ai < 2; ++ai)
#pragma unroll
            for (int m = 0; m < 4; ++m) { f32x4 v0, v1;
#pragma unroll
                for (int j = 0; j < 4; ++j) { const float g0 = acc[ai][0][m][0][j], g1 = acc[ai][0][m][1][j]; v0[j] = g0 * sigmoidf_(g0) * acc[ai][1][m][0][j]; v1[j] = g1 * sigmoidf_(g1) * acc[ai][1][m][1][j]; }
                u32x2 o; o.x = pk4_fp8(v0[0], v0[1], v0[2], v0[3]); o.y = pk4_fp8(v1[0], v1[1], v1[2], v1[3]);
                *(GAS u32x2*)(hm + (size_t)(row0 + ai * 128 + m * 16) * 1024 + col0) = o; }
    }
};
struct EpiM2 {
    static constexpr bool PERM = true;
    bf16_t* ys; const int* list; const volatile LAS int* pre;
    DI void operator()(const f32x4 (&acc)[2][2][4][2], const Unit& u, int wr, int wc, int fr, int fq) const {
        const int lrow0 = wr * 64 + fr, col0 = u.pn * 256 + wc * 32 + 8 * fq; const int lt = u.pm - rfl(pre[u.e]);
        const int* lp = list + (size_t)u.e * T + 256 * lt;
#pragma unroll
        for (int ai = 0; ai < 2; ++ai)
#pragma unroll
            for (int m = 0; m < 4; ++m) { const int r = lrow0 + ai * 128 + m * 16;
                if (r < u.nv) { const int slot = lp[r]; bf16_t* yp = ys + (size_t)slot * 1024 + col0;
#pragma unroll
                    for (int bj = 0; bj < 2; ++bj) *(GAS u32x4*)(yp + bj * 128) = pack8(acc[ai][bj][m][0], acc[ai][bj][m][1]); } }
    }
};

template <bool F8>
DI void tr_item(const float* W, int N, void* WTv, int K, int drow, int c0, int nvalid, int kb, LAS float* scr, int lane) {
    const int k0 = 64 * kb;
    { const int cc = lane & 31, ccl = cc < nvalid ? cc : 0; const float* wp = W + (size_t)(k0 + (lane >> 5)) * N + c0 + ccl; float v[32];
#pragma unroll
      for (int i = 0; i < 32; ++i) v[i] = wp[(size_t)(2 * i) * N];
#pragma unroll
      for (int i = 0; i < 32; ++i) scr[(2 * i + (lane >> 5)) * 33 + cc] = (cc < nvalid) ? v[i] : 0.f; }
    LDS_WAIT(); asm volatile("" ::: "memory");
    const int c = lane & 7;
#pragma unroll
    for (int j = 0; j < 4; ++j) { const int n = (lane >> 3) + 8 * j; const LAS float* s = scr + (8 * c) * 33 + n;
        if constexpr (F8) { u32x2 o; o.x = pk4_fp8(s[0 * 33] * W8_SCALE, s[1 * 33] * W8_SCALE, s[2 * 33] * W8_SCALE, s[3 * 33] * W8_SCALE); o.y = pk4_fp8(s[4 * 33] * W8_SCALE, s[5 * 33] * W8_SCALE, s[6 * 33] * W8_SCALE, s[7 * 33] * W8_SCALE);
            *(GAS u32x2*)((unsigned char*)WTv + (size_t)(drow + n) * K + k0 + 8 * c) = o; }
        else { u32x4 o; o.x = cvt_pk_bf16(s[0 * 33], s[1 * 33]); o.y = cvt_pk_bf16(s[2 * 33], s[3 * 33]); o.z = cvt_pk_bf16(s[4 * 33], s[5 * 33]); o.w = cvt_pk_bf16(s[6 * 33], s[7 * 33]);
            *(GAS u32x4*)((bf16_t*)WTv + (size_t)(drow + n) * K + k0 + 8 * c) = o; } }
    LDS_WAIT(); asm volatile("" ::: "memory");
}
DI void phase_w(LAS unsigned char* lds, const Ctx& c, int l, int G) {
    const int tid = ltid(), lane = tid & 63, wave = rfl(tid >> 6);
    LAS float* scr = (LAS float*)(lds + wave * 16384);
    const int gw = lbid() * NWAVES + wave, NGW = G * NWAVES;
    constexpr int I_IN = (NIN / 32) * 16, I_GO = 512, I_AO = 256, I_OUT = 512, I_EXP = 16 * 512;
    constexpr int NITEMS = I_IN + I_GO + I_AO + I_OUT + 3 * I_EXP;
    for (int it = gw; it < NITEMS; it += NGW) {
        int r = it;
        if (r < I_IN) {
            const int nbg = r >> 4, kb = r & 15, n0 = 32 * nbg, tile = n0 >> 8, p = n0 & 255; int c0, nv = 32;
            if (tile < 12) c0 = n0;
            else if (tile < 24) { const int base = tile < 18 ? 3088 : 4624, tq = tile < 18 ? tile - 12 : tile - 18; c0 = base + (4 * tq + ((p & 127) >> 5)) * 64 + (p >= 128 ? 32 : 0); }
            else if (tile < 30) c0 = 6160 + (n0 - 24 * 256);
            else if (tile < 38) c0 = 7696 + (n0 - 30 * 256);
            else { c0 = 3072; nv = (p == 0) ? 16 : 0; }
            tr_item<true>(c.w_in + (size_t)l * D * DIN, DIN, c.ws + WS_WIN, D, n0, c0, nv, kb, scr, lane); continue; }
        r -= I_IN;
        if (r < I_GO) { tr_item<false>(c.w_gla_o + (size_t)l * D * D, D, wsb(c, WS_WGO), D, 32 * (r >> 4), 32 * (r >> 4), 32, r & 15, scr, lane); continue; }
        r -= I_GO;
        if (r < I_AO) { tr_item<false>(c.w_att_o + (size_t)l * 512 * D, D, wsb(c, WS_WAO), 512, 32 * (r >> 3), 32 * (r >> 3), 32, r & 7, scr, lane); continue; }
        r -= I_AO;
        if (r < I_OUT) { tr_item<false>(c.w_out + (size_t)l * D * D, D, wsb(c, WS_WOUT), D, 32 * (r >> 4), 32 * (r >> 4), 32, r & 15, scr, lane); continue; }
        r -= I_OUT;
        const int which = r / I_EXP; r -= which * I_EXP; const int e = r >> 9, q = r & 511, nbg = q >> 4, kb = q & 15;
        const size_t eoff = (size_t)(l * NEXP + e) * D * DFF;
        if (which == 0) tr_item<true>(c.w_e_gate + eoff, DFF, c.ws + WS_WGU + (size_t)e * 2048 * 1024, D, 256 * (nbg >> 2) + 32 * (nbg & 3), 32 * nbg, 32, kb, scr, lane);
        else if (which == 1) tr_item<true>(c.w_e_up + eoff, DFF, c.ws + WS_WGU + (size_t)e * 2048 * 1024, D, 256 * (nbg >> 2) + 128 + 32 * (nbg & 3), 32 * nbg, 32, kb, scr, lane);
        else tr_item<true>(c.w_e_down + eoff, D, c.ws + WS_WD + (size_t)e * 1024 * 1024, DFF, 32 * nbg, 32 * nbg, 32, kb, scr, lane);
    }
    if (l == 0) {
        const size_t n8 = (size_t)T * D / 8; unsigned char* xb = c.ws + WS_XB;
        for (size_t i = (size_t)lbid() * NTHREADS + tid; i < n8; i += (size_t)G * NTHREADS) { const f32x4 a = *(const GAS f32x4*)(c.x + i * 8), b = *(const GAS f32x4*)(c.x + i * 8 + 4);
            u32x2 o; o.x = pk4_fp8(a[0], a[1], a[2], a[3]); o.y = pk4_fp8(b[0], b[1], b[2], b[3]); *(GAS u32x2*)(xb + i * 8) = o; }
    }
}

DI s16x4 tr16(const LAS void* p) { return __builtin_bit_cast(s16x4, __builtin_amdgcn_ds_read_tr16_b64_v4i16((LAS s16x4*)p)); }
DI bf16x8 cat8(s16x4 lo, s16x4 hi) { return __builtin_shufflevector(lo, hi, 0, 1, 2, 3, 4, 5, 6, 7); }
#define MFMA16(a, b, c) __builtin_amdgcn_mfma_f32_16x16x32_bf16((a), (b), (c), 0, 0, 0)

constexpr int REC_BYTES = 33792, REC_KS = 16384, REC_DEC = 32768, OI_BYTES = 32768;
constexpr int GP_QT = 0, GP_KT = 17408, GP_VS = 34816, GP_ATT = 68608, GP_WUP = 77824, GP_BAL = 86016;
DI float exp_(float x) { return __builtin_amdgcn_exp2f(x * LOG2E); }
DI void unpack8(const u32x4& q, float (&v)[16], int o) { v[o] = bf_lo(q.x); v[o + 1] = bf_hi(q.x); v[o + 2] = bf_lo(q.y); v[o + 3] = bf_hi(q.y); v[o + 4] = bf_lo(q.z); v[o + 5] = bf_hi(q.z); v[o + 6] = bf_lo(q.w); v[o + 7] = bf_hi(q.w); }
DI u32x4 packf8(const float (&v)[16], int o) { u32x4 p; p.x = cvt_pk_bf16(v[o], v[o + 1]); p.y = cvt_pk_bf16(v[o + 2], v[o + 3]); p.z = cvt_pk_bf16(v[o + 4], v[o + 5]); p.w = cvt_pk_bf16(v[o + 6], v[o + 7]); return p; }
DI void gla_p_unit(LAS unsigned char* lds, const Ctx& c, int l, int bl, int h, int n, int& h_loaded) {
    const int tid = ltid(), lane = tid & 63, w = rfl(tid >> 6), fr = lane & 15, fq = lane >> 4;
    const size_t tok0 = (size_t)bl * SEQ + n * 64;
    const bf16_t* QG = wsb(c, WS_H + H_QG) + tok0 * 512 + h * 128;
    const bf16_t* KG = wsb(c, WS_H + H_KG) + tok0 * 512 + h * 128;
    const bf16_t* VG = wsb(c, WS_H + H_VG) + tok0 * 1024 + h * 256;
    const float* HA = (const float*)(c.ws + WS_HA) + tok0 * 16;
    const int unit = (bl * 4 + h) * 64 + n;
    unsigned char* rec = c.ws + WS_REC + (size_t)unit * REC_BYTES;
    unsigned char* oi = c.ws + WS_MIX + (size_t)unit * OI_BYTES;
    LAS bf16_t* QT = (LAS bf16_t*)(lds + GP_QT); LAS bf16_t* KT = (LAS bf16_t*)(lds + GP_KT); LAS bf16_t* VS = (LAS bf16_t*)(lds + GP_VS); LAS bf16_t* AT = (LAS bf16_t*)(lds + GP_ATT);
    LAS float* WUP = (LAS float*)(lds + GP_WUP); LAS float* BAL = (LAS float*)(lds + GP_BAL);
    __syncthreads();
    if (h_loaded != h) { for (int i = tid; i < 16 * 128; i += NTHREADS) WUP[i] = c.w_alpha_up[(size_t)l * 16 * 512 + (i >> 7) * 512 + h * 128 + (i & 127)];
        if (tid < 128) BAL[tid] = c.b_alpha[l * 512 + h * 128 + tid]; h_loaded = h; __syncthreads(); }
    {
        const int row = lane;
        f32x4 a4[4];
#pragma unroll
        for (int j = 0; j < 4; ++j) a4[j] = *(const GAS f32x4*)(HA + (size_t)row * 16 + 4 * j);
        const u32x4 q0 = *(const GAS u32x4*)(QG + (size_t)row * 512 + 16 * w), q1 = *(const GAS u32x4*)(QG + (size_t)row * 512 + 16 * w + 8);
        const u32x4 k0 = *(const GAS u32x4*)(KG + (size_t)row * 512 + 16 * w), k1 = *(const GAS u32x4*)(KG + (size_t)row * 512 + 16 * w + 8);
#pragma unroll
        for (int c2 = 0; c2 < 4; ++c2) { const int idx = tid + NTHREADS * c2, r = idx >> 5, ch = idx & 31; *(LAS u32x4*)(VS + r * 264 + ch * 8) = *(const GAS u32x4*)(VG + (size_t)r * 1024 + ch * 8); }
        float la[16];
#pragma unroll
        for (int cc = 0; cc < 16; ++cc) la[cc] = BAL[16 * w + cc];
#pragma unroll
        for (int j = 0; j < 16; ++j) { const float aj = a4[j >> 2][j & 3];
#pragma unroll
            for (int c4 = 0; c4 < 4; ++c4) { const f32x4 wv = *(const LAS f32x4*)(WUP + j * 128 + 16 * w + 4 * c4); la[4 * c4] += aj * wv[0]; la[4 * c4 + 1] += aj * wv[1]; la[4 * c4 + 2] += aj * wv[2]; la[4 * c4 + 3] += aj * wv[3]; } }
#pragma unroll
        for (int cc = 0; cc < 16; ++cc) { const float z = la[cc]; la[cc] = -(fmaxf(-z, 0.f) + __builtin_amdgcn_logf(1.0f + exp_(-fabsf(z))) * 0.6931471805599453f) * (1.0f / 16.0f); }
#pragma unroll
        for (int dlt = 1; dlt < 64; dlt <<= 1)
#pragma unroll
            for (int cc = 0; cc < 16; ++cc) { const float t = __shfl_up(la[cc], dlt); if (lane >= dlt) la[cc] += t; }
        float qv[16], kv[16];
        unpack8(q0, qv, 0); unpack8(q1, qv, 8); unpack8(k0, kv, 0); unpack8(k1, kv, 8);
        float dc[16];
#pragma unroll
        for (int cc = 0; cc < 16; ++cc) { const float b = la[cc]; const float bend = __shfl(b, 63); const float eb = exp_(b); dc[cc] = eb; qv[cc] *= eb; la[cc] = kv[cc] * exp_(bend - b); kv[cc] *= exp_(-b); }
        if (lane == 63) {
#pragma unroll
            for (int c4 = 0; c4 < 4; ++c4) *(GAS f32x4*)(rec + REC_DEC + (16 * w + 4 * c4) * 4) = (f32x4){dc[4 * c4], dc[4 * c4 + 1], dc[4 * c4 + 2], dc[4 * c4 + 3]}; }
        const u32x4 qa = packf8(qv, 0), qb = packf8(qv, 8), ka = packf8(kv, 0), kb = packf8(kv, 8), sa = packf8(la, 0), sb = packf8(la, 8);
        *(LAS u32x4*)(QT + row * 136 + 16 * w) = qa; *(LAS u32x4*)(QT + row * 136 + 16 * w + 8) = qb;
        *(LAS u32x4*)(KT + row * 136 + 16 * w) = ka; *(LAS u32x4*)(KT + row * 136 + 16 * w + 8) = kb;
        *(GAS u32x4*)(rec + row * 256 + (((2 * w) ^ (row & 15)) << 4)) = qa; *(GAS u32x4*)(rec + row * 256 + (((2 * w + 1) ^ (row & 15)) << 4)) = qb;
        *(GAS u32x4*)(rec + REC_KS + row * 256 + (((2 * w) ^ (2 * (row & 7))) << 4)) = sa; *(GAS u32x4*)(rec + REC_KS + row * 256 + (((2 * w + 1) ^ (2 * (row & 7))) << 4)) = sb;
    }
    __syncthreads();
#pragma unroll
    for (int rep = 0; rep < 2; ++rep) {
        const int tt = w + 8 * rep, jt = tt >> 2, it = tt & 3;
        f32x4 a = (f32x4){0.f, 0.f, 0.f, 0.f};
        if (jt <= it) {
#pragma unroll
            for (int k4 = 0; k4 < 4; ++k4) { const bf16x8 af = *(const LAS bf16x8*)(KT + (16 * jt + fr) * 136 + 32 * k4 + 8 * fq), bfr = *(const LAS bf16x8*)(QT + (16 * it + fr) * 136 + 32 * k4 + 8 * fq); a = MFMA16(af, bfr, a); }
        }
        const int i = 16 * it + fr, j0 = 16 * jt + 4 * fq;
        u32x2 o; o.x = cvt_pk_bf16(j0 <= i ? a[0] : 0.f, j0 + 1 <= i ? a[1] : 0.f); o.y = cvt_pk_bf16(j0 + 2 <= i ? a[2] : 0.f, j0 + 3 <= i ? a[3] : 0.f);
        *(LAS u32x2*)(AT + i * 72 + j0) = o;
    }
    __syncthreads();
    {
        const int dv0 = 32 * w;
        bf16x8 vb[2][2];
#pragma unroll
        for (int k2 = 0; k2 < 2; ++k2)
#pragma unroll
            for (int dt = 0; dt < 2; ++dt) { const LAS bf16_t* p = VS + (32 * k2 + 8 * fq + (fr >> 2)) * 264 + dv0 + 16 * dt + (fr & 3) * 4; vb[k2][dt] = cat8(tr16(p), tr16(p + 4 * 264)); }
#pragma unroll
        for (int tt = 0; tt < 4; ++tt) {
            const bf16x8 a0 = *(const LAS bf16x8*)(AT + (16 * tt + fr) * 72 + 8 * fq), a1 = *(const LAS bf16x8*)(AT + (16 * tt + fr) * 72 + 32 + 8 * fq);
#pragma unroll
            for (int dt = 0; dt < 2; ++dt) { f32x4 z = (f32x4){0.f, 0.f, 0.f, 0.f}; z = MFMA16(a0, vb[0][dt], z); z = MFMA16(a1, vb[1][dt], z);
                u32x2 pk; pk.x = cvt_pk_bf16(z[0], z[1]); pk.y = cvt_pk_bf16(z[2], z[3]); *(GAS u32x2*)(oi + ((w * 8 + tt * 2 + dt) * 64 + lane) * 8) = pk; }
        }
    }
}
constexpr int GSEG = 16, NSEG = 64 / GSEG;
constexpr int GL_STAGE = 50176, GL_DEC = 16384, GL_VS = 17408;
DI void gla_l_chain(LAS unsigned char* lds, const Ctx& c, int bl, int h, int seg) {
    const int tid = ltid(), lane = tid & 63, w = rfl(tid >> 6), fr = lane & 15, fq = lane >> 4;
    const size_t t0 = (size_t)bl * SEQ + (size_t)seg * (GSEG * 64);
    const bf16_t* VG = wsb(c, WS_H + H_VG) + t0 * 1024 + h * 256;
    const unsigned char* rec0 = c.ws + WS_REC + (size_t)((bl * 4 + h) * 64 + seg * GSEG) * REC_BYTES;
    const int dv0 = 32 * w; const unsigned lds_u = (unsigned)(uintptr_t)lds;
    f32x4 S[8][2], Dc[8];
#pragma unroll
    for (int a = 0; a < 8; ++a) { S[a][0] = (f32x4){0.f, 0.f, 0.f, 0.f}; S[a][1] = (f32x4){0.f, 0.f, 0.f, 0.f}; Dc[a] = (f32x4){1.f, 1.f, 1.f, 1.f}; }
#define GL_DMA(gp, ldsoff) do { unsigned _sv; const unsigned _m = (unsigned)__builtin_amdgcn_readfirstlane((int)(ldsoff)); \
        asm volatile("s_mov_b32 %0, m0\n\ts_mov_b32 m0, %2\n\ts_nop 0\n\tglobal_load_lds_dwordx4 %1, off\n\ts_mov_b32 m0, %0" : "=&s"(_sv) : "v"(gp), "s"(_m) : "memory"); } while (0)
#define GL_PREFETCH(nn, st) do { const unsigned char* _r = rec0 + (size_t)(nn) * REC_BYTES + REC_KS; const unsigned _s = lds_u + (unsigned)(st) * GL_STAGE; \
        _Pragma("unroll") for (int _p = 0; _p < 2; ++_p) GL_DMA((const GAS unsigned char*)(_r + (w * 2 + _p) * 1024 + lane * 16), _s + (w * 2 + _p) * 1024); \
        if (w == 0) GL_DMA((const GAS unsigned char*)(_r + 16384 + lane * 16), _s + GL_DEC); \
        _Pragma("unroll") for (int _p = 0; _p < 4; ++_p) { const int _row = 2 * (w * 4 + _p) + (lane >> 5); \
            GL_DMA((const GAS bf16_t*)(VG + (size_t)((nn) * 64 + _row) * 1024 + (((lane & 31) ^ (2 * (_row & 3))) << 3)), _s + GL_VS + (w * 4 + _p) * 1024); } } while (0)
    __syncthreads();
    GL_PREFETCH(0, 0);
    for (int n = 0; n < GSEG; ++n) {
        const int st = n & 1; LAS unsigned char* sb_ = lds + st * GL_STAGE;
        LAS bf16_t* KS = (LAS bf16_t*)sb_; LAS float* DEC = (LAS float*)(sb_ + GL_DEC); LAS bf16_t* VS = (LAS bf16_t*)(sb_ + GL_VS);
        VM_WAIT(); asm volatile("s_waitcnt lgkmcnt(0)" ::: "memory"); __builtin_amdgcn_s_barrier(); asm volatile("" ::: "memory");
        if (n + 1 < GSEG) GL_PREFETCH(n + 1, st ^ 1);
        bf16x8 vb[2][2];
#pragma unroll
        for (int k2 = 0; k2 < 2; ++k2)
#pragma unroll
            for (int dt = 0; dt < 2; ++dt) { const int r0 = 32 * k2 + 8 * fq + (fr >> 2);
                const LAS bf16_t* p = VS + r0 * 256 + ((((dv0 + 16 * dt) >> 3) ^ (2 * (r0 & 3))) << 3) + (fr & 3) * 4; vb[k2][dt] = cat8(tr16(p), tr16(p + 4 * 256)); }
#pragma unroll
        for (int k8 = 0; k8 < 8; ++k8) {
            const f32x4 dc = *(const LAS f32x4*)(DEC + 16 * k8 + 4 * fq);
            S[k8][0] *= dc; S[k8][1] *= dc; Dc[k8] *= dc;
#pragma unroll
            for (int k2 = 0; k2 < 2; ++k2) { const int r0 = 32 * k2 + 8 * fq + (fr >> 2);
                const LAS bf16_t* p0 = KS + r0 * 128 + (((2 * k8) ^ (2 * (r0 & 7))) << 3) + (fr & 3) * 4; const LAS bf16_t* p1 = KS + (r0 + 4) * 128 + (((2 * k8) ^ (2 * ((r0 + 4) & 7))) << 3) + (fr & 3) * 4;
                const bf16x8 af = cat8(tr16(p0), tr16(p1));
                S[k8][0] = MFMA16(af, vb[k2][0], S[k8][0]); S[k8][1] = MFMA16(af, vb[k2][1], S[k8][1]); }
        }
    }
#undef GL_PREFETCH
#undef GL_DMA
    const int cj = (bl * 4 + h) * NSEG + seg;
    GAS f32x4* sl = (GAS f32x4*)(c.ws + WS_SLOC) + ((size_t)(cj * 8 + w) * 16) * 64 + lane;
#pragma unroll
    for (int a = 0; a < 8; ++a) { sl[(a * 2) * 64] = S[a][0]; sl[(a * 2 + 1) * 64] = S[a][1]; }
    if (w == 0) { GAS f32x4* dq = (GAS f32x4*)(c.ws + WS_DCUM) + (size_t)cj * 8 * 64 + lane;
#pragma unroll
        for (int a = 0; a < 8; ++a) dq[a * 64] = Dc[a]; }
    VM_WAIT(); __syncthreads();
}
constexpr int GS_STAGE = 66560, GS_KS = 16384, GS_DEC = 32768, GS_VS = 33792, GS_SS = 2 * GS_STAGE;
DI void gla_s_chain(LAS unsigned char* lds, const Ctx& c, int l, int bl, int h, int seg) {
    const int tid = ltid(), lane = tid & 63, w = rfl(tid >> 6), fr = lane & 15, fq = lane >> 4;
    const size_t t0 = (size_t)bl * SEQ + (size_t)seg * (GSEG * 64);
    const bf16_t* VG = wsb(c, WS_H + H_VG) + t0 * 1024 + h * 256;
    const bf16_t* SR = wsb(c, WS_H + H_SR) + t0 * 1024 + h * 256;
    bf16_t* OG = wsb(c, WS_OG) + t0 * 1024 + h * 256;
    const unsigned char* rec0 = c.ws + WS_REC + (size_t)((bl * 4 + h) * 64 + seg * GSEG) * REC_BYTES;
    const unsigned char* oi0 = c.ws + WS_MIX + (size_t)((bl * 4 + h) * 64 + seg * GSEG) * OI_BYTES;
    LAS float* SS = (LAS float*)(lds + GS_SS);
    const int dv0 = 32 * w;
    const float gn0 = c.gla_norm[l * 1024 + h * 256 + dv0 + fr], gn1 = c.gla_norm[l * 1024 + h * 256 + dv0 + 16 + fr];
    f32x4 S[8][2];
#pragma unroll
    for (int a = 0; a < 8; ++a) { S[a][0] = (f32x4){0.f, 0.f, 0.f, 0.f}; S[a][1] = (f32x4){0.f, 0.f, 0.f, 0.f}; }
    for (int j = 0; j < seg; ++j) {
        const int cj = (bl * 4 + h) * NSEG + j;
        const GAS f32x4* sl = (const GAS f32x4*)(c.ws + WS_SLOC) + ((size_t)(cj * 8 + w) * 16) * 64 + lane; const GAS f32x4* dq = (const GAS f32x4*)(c.ws + WS_DCUM) + (size_t)cj * 8 * 64 + lane;
#pragma unroll
        for (int a = 0; a < 8; ++a) { const f32x4 dcv = dq[a * 64]; S[a][0] = S[a][0] * dcv + sl[(a * 2) * 64]; S[a][1] = S[a][1] * dcv + sl[(a * 2 + 1) * 64]; }
    }
#define GS_DMA(gp, ldsoff) do { unsigned _sv; const unsigned _m = (unsigned)__builtin_amdgcn_readfirstlane((int)(ldsoff)); \
        asm volatile("s_mov_b32 %0, m0\n\ts_mov_b32 m0, %2\n\ts_nop 0\n\tglobal_load_lds_dwordx4 %1, off\n\ts_mov_b32 m0, %0" : "=&s"(_sv) : "v"(gp), "s"(_m) : "memory"); } while (0)
#define GS_PREFETCH(nn, st) do { const unsigned char* _r = rec0 + (size_t)(nn) * REC_BYTES; const unsigned _s = lds_u + (unsigned)(st) * GS_STAGE; \
        _Pragma("unroll") for (int _p = 0; _p < 4; ++_p) GS_DMA((const GAS unsigned char*)(_r + (w * 4 + _p) * 1024 + lane * 16), _s + (w * 4 + _p) * 1024); \
        if (w == 0) GS_DMA((const GAS unsigned char*)(_r + 32768 + lane * 16), _s + 32768); \
        _Pragma("unroll") for (int _p = 0; _p < 4; ++_p) { const int _row = 2 * (w * 4 + _p) + (lane >> 5); \
            GS_DMA((const GAS bf16_t*)(VG + (size_t)((nn) * 64 + _row) * 1024 + (((lane & 31) ^ (2 * (_row & 3))) << 3)), _s + GS_VS + (w * 4 + _p) * 1024); } } while (0)
    const unsigned lds_u = (unsigned)(uintptr_t)lds;
#define GS_BAR() do { asm volatile("s_waitcnt lgkmcnt(0)" ::: "memory"); __builtin_amdgcn_s_barrier(); asm volatile("" ::: "memory"); } while (0)
    __syncthreads();
    GS_PREFETCH(0, 0);
    for (int n = 0; n < GSEG; ++n) {
        const int st = n & 1; LAS unsigned char* sb_ = lds + st * GS_STAGE;
        LAS bf16_t* QT = (LAS bf16_t*)sb_; LAS bf16_t* KS = (LAS bf16_t*)(sb_ + GS_KS); LAS float* DEC = (LAS float*)(sb_ + GS_DEC); LAS bf16_t* VS = (LAS bf16_t*)(sb_ + GS_VS); LAS bf16_t* OST = (LAS bf16_t*)(sb_ + GS_KS);
        VM_WAIT(); GS_BAR();
        u32x2 oiv[8];
#pragma unroll
        for (int q = 0; q < 8; ++q) oiv[q] = *(const GAS u32x2*)(oi0 + (size_t)n * OI_BYTES + ((w * 8 + q) * 64 + lane) * 8);
        u32x4 srv[4];
#pragma unroll
        for (int c2 = 0; c2 < 4; ++c2) { const int idx = tid + NTHREADS * c2, r = idx >> 5, ch = idx & 31; srv[c2] = *(const GAS u32x4*)(SR + (size_t)(n * 64 + r) * 1024 + ch * 8); }
        asm volatile("" ::: "memory");
        if (n + 1 < GSEG) GS_PREFETCH(n + 1, st ^ 1);
        f32x4 o[4][2];
        {
            bf16x8 vb[2][2];
#pragma unroll
            for (int k2 = 0; k2 < 2; ++k2)
#pragma unroll
                for (int dt = 0; dt < 2; ++dt) { const int r0 = 32 * k2 + 8 * fq + (fr >> 2);
                    const LAS bf16_t* p = VS + r0 * 256 + ((((dv0 + 16 * dt) >> 3) ^ (2 * (r0 & 3))) << 3) + (fr & 3) * 4; vb[k2][dt] = cat8(tr16(p), tr16(p + 4 * 256)); }
#pragma unroll
            for (int tt = 0; tt < 4; ++tt) { o[tt][0] = (f32x4){0.f, 0.f, 0.f, 0.f}; o[tt][1] = (f32x4){0.f, 0.f, 0.f, 0.f}; }
#pragma unroll
            for (int s = 0; s < 4; ++s) {
                bf16x8 sb[2];
#pragma unroll
                for (int dt = 0; dt < 2; ++dt) { u32x4 pk; pk.x = cvt_pk_bf16(S[2 * s][dt][0], S[2 * s][dt][1]); pk.y = cvt_pk_bf16(S[2 * s][dt][2], S[2 * s][dt][3]); pk.z = cvt_pk_bf16(S[2 * s + 1][dt][0], S[2 * s + 1][dt][1]); pk.w = cvt_pk_bf16(S[2 * s + 1][dt][2], S[2 * s + 1][dt][3]); sb[dt] = __builtin_bit_cast(bf16x8, pk); }
#pragma unroll
                for (int tt = 0; tt < 4; ++tt) { const int i = 16 * tt + fr;
                    const LAS bf16_t* qp = QT + i * 128 + (fq & 1) * 4;
                    const bf16x8 af = cat8(*(const LAS s16x4*)(qp + (((4 * s + (fq >> 1)) ^ (i & 15)) << 3)), *(const LAS s16x4*)(qp + (((4 * s + 2 + (fq >> 1)) ^ (i & 15)) << 3)));
                    o[tt][0] = MFMA16(af, sb[0], o[tt][0]); o[tt][1] = MFMA16(af, sb[1], o[tt][1]); }
            }
#pragma unroll
            for (int k8 = 0; k8 < 8; ++k8) {
                const f32x4 dc = *(const LAS f32x4*)(DEC + 16 * k8 + 4 * fq);
                S[k8][0] *= dc; S[k8][1] *= dc;
#pragma unroll
                for (int k2 = 0; k2 < 2; ++k2) { const int r0 = 32 * k2 + 8 * fq + (fr >> 2);
                    const LAS bf16_t* p0 = KS + r0 * 128 + (((2 * k8) ^ (2 * (r0 & 7))) << 3) + (fr & 3) * 4; const LAS bf16_t* p1 = KS + (r0 + 4) * 128 + (((2 * k8) ^ (2 * ((r0 + 4) & 7))) << 3) + (fr & 3) * 4;
                    const bf16x8 af = cat8(tr16(p0), tr16(p1));
                    S[k8][0] = MFMA16(af, vb[k2][0], S[k8][0]); S[k8][1] = MFMA16(af, vb[k2][1], S[k8][1]); }
            }
        }
#pragma unroll
        for (int tt = 0; tt < 4; ++tt)
#pragma unroll
            for (int dt = 0; dt < 2; ++dt) { const u32x2 v = oiv[tt * 2 + dt]; o[tt][dt][0] += bf_lo(v.x); o[tt][dt][1] += bf_hi(v.x); o[tt][dt][2] += bf_lo(v.y); o[tt][dt][3] += bf_hi(v.y); }
#pragma unroll
        for (int tt = 0; tt < 4; ++tt) { f32x4 pp;
#pragma unroll
            for (int rg = 0; rg < 4; ++rg) { float p = o[tt][0][rg] * o[tt][0][rg] + o[tt][1][rg] * o[tt][1][rg];
                p += __shfl_xor(p, 1); p += __shfl_xor(p, 2); p += __shfl_xor(p, 4); p += __shfl_xor(p, 8); pp[rg] = p; }
            if (fr == 0) *(LAS f32x4*)(SS + w * 64 + 16 * tt + 4 * fq) = pp; }
        GS_BAR();
#pragma unroll
        for (int tt = 0; tt < 4; ++tt) { f32x4 ss = *(const LAS f32x4*)(SS + 16 * tt + 4 * fq);
#pragma unroll
            for (int ww = 1; ww < 8; ++ww) ss += *(const LAS f32x4*)(SS + ww * 64 + 16 * tt + 4 * fq);
#pragma unroll
            for (int rg = 0; rg < 4; ++rg) { const float rs = __builtin_amdgcn_rsqf(ss[rg] * (1.0f / 256.0f) + RMS_EPS); const int i = 16 * tt + 4 * fq + rg;
                OST[i * 264 + dv0 + fr] = (bf16_t)(cvt_pk_bf16(o[tt][0][rg] * rs * gn0, 0.f) & 0xffffu); OST[i * 264 + dv0 + 16 + fr] = (bf16_t)(cvt_pk_bf16(o[tt][1][rg] * rs * gn1, 0.f) & 0xffffu); } }
        GS_BAR();
#pragma unroll
        for (int c2 = 0; c2 < 4; ++c2) { const int idx = tid + NTHREADS * c2, r = idx >> 5, ch = idx & 31;
            const u32x4 ov = *(const LAS u32x4*)(OST + r * 264 + ch * 8); const u32x4 sv = srv[c2];
            u32x4 rr; rr.x = cvt_pk_bf16(bf_lo(ov.x) * bf_lo(sv.x), bf_hi(ov.x) * bf_hi(sv.x)); rr.y = cvt_pk_bf16(bf_lo(ov.y) * bf_lo(sv.y), bf_hi(ov.y) * bf_hi(sv.y));
            rr.z = cvt_pk_bf16(bf_lo(ov.z) * bf_lo(sv.z), bf_hi(ov.z) * bf_hi(sv.z)); rr.w = cvt_pk_bf16(bf_lo(ov.w) * bf_lo(sv.w), bf_hi(ov.w) * bf_hi(sv.w));
            *(GAS u32x4*)(OG + (size_t)(n * 64 + r) * 1024 + ch * 8) = rr; }
    }
#undef GS_PREFETCH
#undef GS_DMA
#undef GS_BAR
    VM_WAIT(); __syncthreads();
}

constexpr int AT_K = 0, AT_V = 36864;
DI void attn_unit(LAS unsigned char* lds, const Ctx& c, int bl, int g, int h, int x) {
    const int tid = ltid(), lane = tid & 63, w = rfl(tid >> 6), fr = lane & 15, fq = lane >> 4;
    const int dl = (g == 0) ? 1 : (g == 1 ? 4 : 16), nb = 32 / dl, r = x / nb, n = x - r * nb;
    const size_t tb = (size_t)bl * SEQ + r; const int colo = g * 512 + h * 64;
    const bf16_t* Q = wsb(c, WS_H + H_QD) + colo; const bf16_t* K = wsb(c, WS_H + H_KD) + colo; const bf16_t* V = wsb(c, WS_H + H_VD) + colo;
    LAS bf16_t* Ks = (LAS bf16_t*)(lds + AT_K); LAS bf16_t* Vs = (LAS bf16_t*)(lds + AT_V);
    const size_t tokq = tb + (size_t)dl * (128 * n + 16 * w + fr);
    bf16x8 qf[2];
#pragma unroll
    for (int d0 = 0; d0 < 2; ++d0) qf[d0] = *(const GAS bf16x8*)(Q + tokq * 1536 + 32 * d0 + 8 * fq);
    __syncthreads();
#pragma unroll
    for (int c2 = 0; c2 < 4; ++c2) { const int idx = tid + NTHREADS * c2, row = idx >> 3, ch = idx & 7; const int j = 128 * (n - 1) + row;
        u32x4 kv = (u32x4){0u, 0u, 0u, 0u}, vv = (u32x4){0u, 0u, 0u, 0u};
        if (j >= 0) { const size_t tok = tb + (size_t)dl * j; kv = *(const GAS u32x4*)(K + tok * 1536 + ch * 8); vv = *(const GAS u32x4*)(V + tok * 1536 + ch * 8); }
        *(LAS u32x4*)(Ks + row * 72 + ch * 8) = kv; *(LAS u32x4*)(Vs + row * 72 + ch * 8) = vv; }
    __syncthreads();
    f32x4 s[9]; float m = -1e30f;
#pragma unroll
    for (int kr = 0; kr < 9; ++kr) { const int kt = w + kr; f32x4 a = (f32x4){0.f, 0.f, 0.f, 0.f};
#pragma unroll
        for (int d0 = 0; d0 < 2; ++d0) { const bf16x8 af = *(const LAS bf16x8*)(Ks + (16 * kt + fr) * 72 + 32 * d0 + 8 * fq); a = MFMA16(af, qf[d0], a); }
#pragma unroll
        for (int rg = 0; rg < 4; ++rg) { const int rel = 16 * kr + 4 * fq + rg - fr; const bool ok = rel >= 0 && rel <= 128 && (n > 0 || 16 * kt + 4 * fq + rg >= 128); a[rg] = ok ? a[rg] : -1e30f; m = fmaxf(m, a[rg]); }
        s[kr] = a; }
    m = fmaxf(m, __shfl_xor(m, 16)); m = fmaxf(m, __shfl_xor(m, 32));
    float lsum = 0.f;
#pragma unroll
    for (int kr = 0; kr < 9; ++kr)
#pragma unroll
        for (int rg = 0; rg < 4; ++rg) { const float p = s[kr][rg] > -1e29f ? __builtin_amdgcn_exp2f(s[kr][rg] - m) : 0.f; s[kr][rg] = p; lsum += p; }
    lsum += __shfl_xor(lsum, 16); lsum += __shfl_xor(lsum, 32);
    f32x4 oT[4];
#pragma unroll
    for (int dt = 0; dt < 4; ++dt) oT[dt] = (f32x4){0.f, 0.f, 0.f, 0.f};
#pragma unroll
    for (int pp = 0; pp < 5; ++pp) { const int ka = 2 * pp, kb = (2 * pp + 1 < 9) ? 2 * pp + 1 : 8;
        u32x4 pk; pk.x = cvt_pk_bf16(s[ka][0], s[ka][1]); pk.y = cvt_pk_bf16(s[ka][2], s[ka][3]);
        if (2 * pp + 1 < 9) { pk.z = cvt_pk_bf16(s[kb][0], s[kb][1]); pk.w = cvt_pk_bf16(s[kb][2], s[kb][3]); } else { pk.z = 0u; pk.w = 0u; }
        const bf16x8 pf = __builtin_bit_cast(bf16x8, pk);
#pragma unroll
        for (int dt = 0; dt < 4; ++dt) { const LAS bf16_t* pa = Vs + (16 * (w + ka) + 4 * fq + (fr >> 2)) * 72 + 16 * dt + (fr & 3) * 4; const LAS bf16_t* pb = Vs + (16 * (w + kb) + 4 * fq + (fr >> 2)) * 72 + 16 * dt + (fr & 3) * 4;
            oT[dt] = MFMA16(cat8(tr16(pa), tr16(pb)), pf, oT[dt]); } }
    const float inv = 1.0f / lsum; const size_t tq = tb + (size_t)dl * (128 * n + 16 * w + fr);
    bf16_t* op = wsb(c, WS_ATTG) + ((size_t)g * TH + tq) * 512 + h * 64 + 4 * fq;
#pragma unroll
    for (int dt = 0; dt < 4; ++dt) { u32x2 o; o.x = cvt_pk_bf16(oT[dt][0] * inv, oT[dt][1] * inv); o.y = cvt_pk_bf16(oT[dt][2] * inv, oT[dt][3] * inv); *(GAS u32x2*)(op + 16 * dt) = o; }
    if (fq == 0) ((float*)(c.ws + WS_LSE))[((size_t)g * TH + tq) * 8 + h] = m + __builtin_amdgcn_logf(lsum);
}
DI void phase_p(LAS unsigned char* lds, const Ctx& c, int l, int G) {
    int h_loaded = -1;
    for (int u = lbid(); u < 8 * 4 * 64; u += G) gla_p_unit(lds, c, l, u >> 8, (u >> 6) & 3, u & 63, h_loaded);
}
constexpr int NATT = 8 * 3 * 8 * 32, NATT1 = 2304, NCHAIN = 8 * 4 * NSEG;
DI void attn_pull(LAS unsigned char* lds, const Ctx& c, unsigned* ctr, int base, int limit) {
    volatile LAS int* TK = (volatile LAS int*)(lds + MISC_OFF + 192);
    const int tid = ltid();
    __syncthreads();
    if (tid == 0) TK[0] = base + (int)__hip_atomic_fetch_add(ctr, 1u, __ATOMIC_RELAXED, __HIP_MEMORY_SCOPE_AGENT);
    __syncthreads();
    int u = rfl(TK[0]);
    while (u < limit) {
        int nxt = 0; if (tid == 0) nxt = base + (int)__hip_atomic_fetch_add(ctr, 1u, __ATOMIC_RELAXED, __HIP_MEMORY_SCOPE_AGENT);
        attn_unit(lds, c, u / 768, (u / 256) % 3, (u >> 5) & 7, u & 31);
        __syncthreads();
        if (tid == 0) TK[0] = nxt;
        __syncthreads();
        u = rfl(TK[0]);
    }
}
DI void phase_b1(LAS unsigned char* lds, const Ctx& c, int l, int hf, int G) {
    const int bid = lbid(); unsigned* ctr = (unsigned*)(c.ws + WS_CTL) + CW_TKT + ((l * 2 + hf) * 2) * 64;
    for (int id = bid; id < NCHAIN; id += G) gla_l_chain(lds, c, id >> 4, (id >> 2) & 3, id & 3);
    attn_pull(lds, c, ctr, 0, NATT1);
}
DI void phase_b(LAS unsigned char* lds, const Ctx& c, int l, int hf, int G) {
    const int bid = lbid(); unsigned* ctr = (unsigned*)(c.ws + WS_CTL) + CW_TKT + ((l * 2 + hf) * 2 + 1) * 64;
    for (int id = bid; id < NCHAIN; id += G) gla_s_chain(lds, c, l, id >> 4, (id >> 2) & 3, id & 3);
    attn_pull(lds, c, ctr, NATT1, NATT);
}
DI void phase_f(const Ctx& c, int G) {
    const bf16_t* ag = wsb(c, WS_ATTG); const float* lse = (const float*)(c.ws + WS_LSE); bf16_t* att = wsb(c, WS_ATT);
    for (size_t i = (size_t)lbid() * NTHREADS + ltid(); i < (size_t)TH * 64; i += (size_t)G * NTHREADS) {
        const size_t tok = i >> 6; const int ch = (int)(i & 63), h = ch >> 3;
        const float l0 = lse[tok * 8 + h], l1 = lse[((size_t)TH + tok) * 8 + h], l2 = lse[((size_t)2 * TH + tok) * 8 + h];
        const float mx = fmaxf(l0, fmaxf(l1, l2)); float w0 = __builtin_amdgcn_exp2f(l0 - mx), w1 = __builtin_amdgcn_exp2f(l1 - mx), w2 = __builtin_amdgcn_exp2f(l2 - mx);
        const float inv = 1.0f / (w0 + w1 + w2); w0 *= inv; w1 *= inv; w2 *= inv;
        const u32x4 a = *(const GAS u32x4*)(ag + tok * 512 + ch * 8), b = *(const GAS u32x4*)(ag + ((size_t)TH + tok) * 512 + ch * 8), d = *(const GAS u32x4*)(ag + ((size_t)2 * TH + tok) * 512 + ch * 8);
        u32x4 o;
        o.x = cvt_pk_bf16(w0 * bf_lo(a.x) + w1 * bf_lo(b.x) + w2 * bf_lo(d.x), w0 * bf_hi(a.x) + w1 * bf_hi(b.x) + w2 * bf_hi(d.x));
        o.y = cvt_pk_bf16(w0 * bf_lo(a.y) + w1 * bf_lo(b.y) + w2 * bf_lo(d.y), w0 * bf_hi(a.y) + w1 * bf_hi(b.y) + w2 * bf_hi(d.y));
        o.z = cvt_pk_bf16(w0 * bf_lo(a.z) + w1 * bf_lo(b.z) + w2 * bf_lo(d.z), w0 * bf_hi(a.z) + w1 * bf_hi(b.z) + w2 * bf_hi(d.z));
        o.w = cvt_pk_bf16(w0 * bf_lo(a.w) + w1 * bf_lo(b.w) + w2 * bf_lo(d.w), w0 * bf_hi(a.w) + w1 * bf_hi(b.w) + w2 * bf_hi(d.w));
        *(GAS u32x4*)(att + tok * 512 + ch * 8) = o;
    }
}

DI float wave_sum(float v) {
#pragma unroll
    for (int o = 1; o < 64; o <<= 1) v += __shfl_xor(v, o);
    return v;
}
constexpr int R_WR = 0, R_HIST = 65536, R_BASE = 65536 + 64, R_INFO = 65536 + 128;
DI void phase_r(LAS unsigned char* lds, const Ctx& c, int l, int G) {
    const int tid = ltid(), lane = tid & 63, wave = rfl(tid >> 6);
    LAS float* WR = (LAS float*)(lds + R_WR); volatile LAS int* HIST = (volatile LAS int*)(lds + R_HIST); volatile LAS int* BASE = (volatile LAS int*)(lds + R_BASE); volatile LAS int* INFO = (volatile LAS int*)(lds + R_INFO);
    __syncthreads();
    for (int i = tid; i < 16 * 1024; i += NTHREADS) WR[(i & 15) * 1024 + (i >> 4)] = c.w_router[i];
    f32x4 g4[4], b4[4];
#pragma unroll
    for (int j = 0; j < 4; ++j) { g4[j] = *(const GAS f32x4*)(c.ln1_g + l * D + 4 * lane + 256 * j); b4[j] = *(const GAS f32x4*)(c.ln1_b + l * D + 4 * lane + 256 * j); }
    float* xo = c.out; unsigned char* xb = c.ws + WS_XB; int* histg = (int*)(c.ws + WS_HISTG); float* gate = (float*)(c.ws + WS_GATE);
    for (int chunk = lbid(); chunk < T / 256; chunk += G) {
        __syncthreads();
        for (int rr = 0; rr < 32; ++rr) {
            const int rl = wave * 32 + rr; const size_t row = (size_t)chunk * 256 + rl;
            f32x4 v[4]; float s = 0.f;
#pragma unroll
            for (int j = 0; j < 4; ++j) { v[j] = *(const GAS f32x4*)(xo + row * D + 4 * lane + 256 * j); s += (v[j][0] + v[j][1]) + (v[j][2] + v[j][3]); }
            const float mean = wave_sum(s) * (1.0f / D); float s2 = 0.f;
#pragma unroll
            for (int j = 0; j < 4; ++j) { v[j] = v[j] - mean; s2 += (v[j][0] * v[j][0] + v[j][1] * v[j][1]) + (v[j][2] * v[j][2] + v[j][3] * v[j][3]); }
            const float rstd = __builtin_amdgcn_rsqf(wave_sum(s2) * (1.0f / D) + LN_EPS);
#pragma unroll
            for (int j = 0; j < 4; ++j) { v[j] = v[j] * rstd * g4[j] + b4[j]; *(GAS f32x4*)(xo + row * D + 4 * lane + 256 * j) = v[j];
                *(GAS unsigned*)(xb + row * D + 4 * lane + 256 * j) = pk4_fp8(v[j][0], v[j][1], v[j][2], v[j][3]); }
            float lg[16];
#pragma unroll
            for (int e = 0; e < 16; ++e) { float a = 0.f;
#pragma unroll
                for (int j = 0; j < 4; ++j) { const f32x4 wv = *(const LAS f32x4*)(WR + e * 1024 + 4 * lane + 256 * j); a += v[j][0] * wv[0] + v[j][1] * wv[1] + v[j][2] * wv[2] + v[j][3] * wv[3]; }
                lg[e] = wave_sum(a) + c.b_router[e]; }
            float mx = lg[0];
#pragma unroll
            for (int e = 1; e < 16; ++e) mx = fmaxf(mx, lg[e]);
            float se = 0.f;
#pragma unroll
            for (int e = 0; e < 16; ++e) { lg[e] = __expf(lg[e] - mx); se += lg[e]; }
            const float ise = 1.0f / se;
#pragma unroll
            for (int e = 0; e < 16; ++e) lg[e] *= ise;
            int gsel = 0; float gbest = -1.f;
#pragma unroll
            for (int gi = 0; gi < 4; ++gi) { const float a = lg[4 * gi], b = lg[4 * gi + 1], cc = lg[4 * gi + 2], d = lg[4 * gi + 3];
                const float sc = (a + b + cc + d) - fminf(fminf(a, b), fminf(cc, d)) - fminf(fmaxf(fminf(a, b), fminf(cc, d)), fminf(fmaxf(a, b), fmaxf(cc, d)));
                if (sc > gbest) { gbest = sc; gsel = gi; } }
            float p[4];
#pragma unroll
            for (int k = 0; k < 4; ++k) p[k] = gsel == 0 ? lg[k] : gsel == 1 ? lg[4 + k] : gsel == 2 ? lg[8 + k] : lg[12 + k];
            int i0 = 0; float v0 = p[0];
#pragma unroll
            for (int k = 1; k < 4; ++k) if (p[k] > v0) { v0 = p[k]; i0 = k; }
            int i1 = -1; float v1 = -1.f;
#pragma unroll
            for (int k = 0; k < 4; ++k) if (k != i0 && p[k] > v1) { v1 = p[k]; i1 = k; }
            if (lane == 0) { const int e0 = 4 * gsel + i0, e1 = 4 * gsel + i1; INFO[rl * 4 + 0] = e0; INFO[rl * 4 + 1] = e1;
                const float gs = 1.0f / (v0 + v1); gate[row * 2] = v0 * gs; gate[row * 2 + 1] = v1 * gs; }
        }
        __syncthreads();
        if (tid < 16) { int cnt = 0;
            for (int r = 0; r < 256; ++r) { if (INFO[r * 4] == tid) INFO[r * 4 + 2] = cnt++; else if (INFO[r * 4 + 1] == tid) INFO[r * 4 + 3] = cnt++; }
            histg[chunk * 16 + tid] = cnt; }
        __syncthreads();
        if (tid < 256) { i32x4 v; v.x = INFO[tid * 4]; v.y = INFO[tid * 4 + 1]; v.z = INFO[tid * 4 + 2]; v.w = INFO[tid * 4 + 3]; ((GAS i32x4*)(c.ws + WS_INFO))[(size_t)chunk * 256 + tid] = v; }
        __syncthreads();
    }
}
DI void phase_r2(LAS unsigned char* lds, const Ctx& c, int l, int G) {
    const int tid = ltid(); volatile LAS int* BASE = (volatile LAS int*)(lds + R_BASE);
    const int* histg = (const int*)(c.ws + WS_HISTG); int* list = (int*)(c.ws + WS_LIST);
    unsigned* cur = (unsigned*)(c.ws + WS_CTL) + CW_CUR + l * 16 * 64;
    for (int chunk = lbid(); chunk < T / 256; chunk += G) {
        __syncthreads();
        if (tid < 16) BASE[tid] = 0;
        __syncthreads();
        { const int e = tid & 15; int s = 0; for (int cc = tid >> 4; cc < chunk; cc += 32) s += histg[cc * 16 + e]; if (s) atomicAdd((int*)&BASE[e], s); }
        __syncthreads();
        if (tid < 256) { const i32x4 v = ((const GAS i32x4*)(c.ws + WS_INFO))[(size_t)chunk * 256 + tid]; const int row = chunk * 256 + tid;
            list[(size_t)v.x * T + BASE[v.x] + v.z] = row * 2; list[(size_t)v.y * T + BASE[v.y] + v.w] = row * 2 + 1; }
        if (chunk == T / 256 - 1 && tid < 16) __hip_atomic_store(cur + tid * 64, (unsigned)(BASE[tid] + histg[chunk * 16 + tid]), __ATOMIC_RELAXED, __HIP_MEMORY_SCOPE_AGENT);
    }
}
DI int moe_setup(LAS unsigned char* lds, const Ctx& c, int l) {
    volatile LAS int* PRE = (volatile LAS int*)(lds + MISC_OFF); volatile LAS int* CNT = PRE + 17;
    unsigned* cur = (unsigned*)(c.ws + WS_CTL) + CW_CUR + l * 16 * 64;
    __syncthreads();
    if (threadIdx.x == 0) { int acc = 0; for (int e = 0; e < 16; ++e) { const int n = (int)__hip_atomic_load(cur + e * 64, __ATOMIC_RELAXED, __HIP_MEMORY_SCOPE_AGENT); PRE[e] = acc; CNT[e] = n; acc += (n + 255) >> 8; } PRE[16] = acc; }
    __syncthreads();
    return rfl(PRE[16]);
}
DI void phase_c(const Ctx& c, int l, int G) {
    const int tid = ltid(), lane = tid & 63, wave = rfl(tid >> 6);
    f32x4 g4[4], b4[4];
#pragma unroll
    for (int j = 0; j < 4; ++j) { g4[j] = *(const GAS f32x4*)(c.ln2_g + l * D + 4 * lane + 256 * j); b4[j] = *(const GAS f32x4*)(c.ln2_b + l * D + 4 * lane + 256 * j); }
    float* xo = c.out; unsigned char* xb = c.ws + WS_XB; const bf16_t* ys = wsb(c, WS_YS); const float* gate = (const float*)(c.ws + WS_GATE);
    for (size_t row = (size_t)lbid() * NWAVES + wave; row < (size_t)T; row += (size_t)G * NWAVES) {
        const float g0 = gate[row * 2], g1 = gate[row * 2 + 1];
        f32x4 v[4]; float s = 0.f;
#pragma unroll
        for (int j = 0; j < 4; ++j) { const f32x4 xr = *(const GAS f32x4*)(xo + row * D + 4 * lane + 256 * j);
            const u32x2 y0 = *(const GAS u32x2*)(ys + (row * 2) * D + 4 * lane + 256 * j), y1 = *(const GAS u32x2*)(ys + (row * 2 + 1) * D + 4 * lane + 256 * j);
            v[j][0] = xr[0] * DN_ALPHA + g0 * bf_lo(y0.x) + g1 * bf_lo(y1.x); v[j][1] = xr[1] * DN_ALPHA + g0 * bf_hi(y0.x) + g1 * bf_hi(y1.x);
            v[j][2] = xr[2] * DN_ALPHA + g0 * bf_lo(y0.y) + g1 * bf_lo(y1.y); v[j][3] = xr[3] * DN_ALPHA + g0 * bf_hi(y0.y) + g1 * bf_hi(y1.y);
            s += (v[j][0] + v[j][1]) + (v[j][2] + v[j][3]); }
        const float mean = wave_sum(s) * (1.0f / D); float s2 = 0.f;
#pragma unroll
        for (int j = 0; j < 4; ++j) { v[j] = v[j] - mean; s2 += (v[j][0] * v[j][0] + v[j][1] * v[j][1]) + (v[j][2] * v[j][2] + v[j][3] * v[j][3]); }
        const float rstd = __builtin_amdgcn_rsqf(wave_sum(s2) * (1.0f / D) + LN_EPS);
#pragma unroll
        for (int j = 0; j < 4; ++j) { v[j] = v[j] * rstd * g4[j] + b4[j]; *(GAS f32x4*)(xo + row * D + 4 * lane + 256 * j) = v[j];
            *(GAS unsigned*)(xb + row * D + 4 * lane + 256 * j) = pk4_fp8(v[j][0], v[j][1], v[j][2], v[j][3]); }
    }
}

DI Ctx load_ctx() {
    union { Ctx c; unsigned long long q[sizeof(Ctx) / 8]; } u;
#if defined(__HIP_DEVICE_COMPILE__)
    const __attribute__((address_space(4))) unsigned long long* p = (const __attribute__((address_space(4))) unsigned long long*)__builtin_amdgcn_kernarg_segment_ptr();
    asm volatile("" : "+s"(p));
#pragma unroll
    for (int i = 0; i < (int)(sizeof(Ctx) / 8); ++i) u.q[i] = p[i];
#endif
    return u.c;
}
#define CTX const Ctx c = load_ctx(); const int G = lgrid(); LAS unsigned char* lds = LDSBASE
__global__ void __launch_bounds__(NTHREADS, 2) mk_fwd(Ctx c_arg) {
    extern __shared__ __attribute__((aligned(16))) unsigned char lds_raw[];
#define LDSBASE ({ unsigned _b = (unsigned)(uintptr_t)(LAS unsigned char*)lds_raw; asm volatile("" : "+s"(_b)); (LAS unsigned char*)(uintptr_t)_b; })
    LAS unsigned char* lds0 = LDSBASE;
    const int tid = threadIdx.x; const Ctx c = load_ctx();
    volatile LAS unsigned* MISC = (volatile LAS unsigned*)(lds0 + MISC_OFF);
    if (tid < 64) MISC[tid] = 0u;
    __syncthreads();
    XcdBarrier bar; bar.bar = (unsigned*)(c.ws + WS_CTL) + CW_BAR; bar.x = 0; bar.st = MISC + 40;
    if (!MK_MULTI) bar = xcd_barrier_post((unsigned*)(c.ws + WS_CTL) + CW_BAR, MISC + 40);
    const int lo = c.lo, hi = c.hi; int step = 0;
#define RUN (lo <= step && step < hi)
#define END_STEP do { if (RUN && step + 1 < hi) { if (!MK_MULTI) xcd_barrier(bar); } ++step; } while (0)
    for (int l = 0; l < DEPTH; ++l) {
        if (RUN) { CTX; phase_w(lds, c, l, G); }
        END_STEP;
        for (int hf = 0; hf < 2; ++hf) {
            const size_t r0 = (size_t)hf * TH;
            if (RUN) {
                CTX;
                pg8::StaticOrder S; S.init(c.ws + WS_XB + r0 * D, c.ws + WS_WIN, TH, NIN, D / 2, G, lbid());
                EpiIn E{wsb(c, WS_H + H_QG), wsb(c, WS_H + H_KG), wsb(c, WS_H + H_VG), wsb(c, WS_H + H_SR), wsb(c, WS_H + H_QD), wsb(c, WS_H + H_KD), wsb(c, WS_H + H_VD), wsb(c, WS_H + H_GT), (float*)(c.ws + WS_HA), c.pos + r0};
                pg8::gemm_phase<EpiIn, pg8::StaticOrder, true>(lds, D / 2, S, E);
            }
            END_STEP;
            if (RUN) { CTX; phase_p(lds, c, l, G); }
            END_STEP;
            if (RUN) { CTX; phase_b1(lds, c, l, hf, G); }
            END_STEP;
            if (RUN) { CTX; phase_b(lds, c, l, hf, G); }
            END_STEP;
            if (RUN) { CTX; (void)lds; phase_f(c, G); }
            END_STEP;
            if (RUN) {
                CTX;
                pg8::StaticOrder S; S.init(wsb(c, WS_OG), wsb(c, WS_WGO), TH, D, D, G, lbid());
                EpiGate<false> E{wsb(c, WS_MIX), wsb(c, WS_H + H_GT)};
                pg8::gemm_phase(lds, D, S, E);
            }
            END_STEP;
            if (RUN) {
                CTX;
                pg8::StaticOrder S; S.init(wsb(c, WS_ATT), wsb(c, WS_WAO), TH, D, 512, G, lbid());
                EpiGate<true> E{wsb(c, WS_MIX), wsb(c, WS_H + H_GT) + 1024};
                pg8::gemm_phase(lds, 512, S, E);
            }
            END_STEP;
            if (RUN) {
                CTX;
                pg8::StaticOrder S; S.init(wsb(c, WS_MIX), wsb(c, WS_WOUT), TH, D, D, G, lbid());
                EpiRes E{(l == 0 ? c.x : c.out) + r0 * D, c.out + r0 * D};
                pg8::gemm_phase(lds, D, S, E);
            }
            END_STEP;
        }
        if (RUN) { CTX; phase_r(lds, c, l, G); }
        END_STEP;
        if (RUN) { CTX; phase_r2(lds, c, l, G); }
        END_STEP;
        if (RUN) {   CTX;
            const int ntiles = moe_setup(lds, c, l);
            volatile LAS int* PRE = (volatile LAS int*)(lds + MISC_OFF); volatile LAS int* TAB = (volatile LAS int*)(lds + TAB_OFF);
            pg8::MoeOrder S; S.G = G; S.c = lbid(); S.ntot = ntiles * 8; S.NC = 8; S.K = D / 2; S.pre = PRE; S.cnt = PRE + 17; S.A = (const char*)(c.ws + WS_XB); S.Bt = (const char*)(c.ws + WS_WGU);
            S.bstride = (size_t)2048 * 1024; S.tab = TAB; S.gather = true;
            const int* list = (const int*)(c.ws + WS_LIST);
            { const int lt_tid = ltid(); const int r = lt_tid & 255, half = rfl(lt_tid >> 8);
              for (int i0 = 0; i0 < MAXU; i0 += 2) { Unit u; const int i = i0 + half;
                  if (S.next(i, u)) { const int lt = u.pm - PRE[u.e]; const int pos = 256 * lt + (r < u.nv ? r : 0); TAB[i * 256 + r] = list[(size_t)u.e * T + pos] >> 1; } } }
            __syncthreads();
            EpiM1 E{c.ws + WS_HM};
            pg8::gemm_phase<EpiM1, pg8::MoeOrder, true>(lds, D / 2, S, E);
        }
        END_STEP;
        if (RUN) {   CTX;
            const int ntiles = moe_setup(lds, c, l);
            volatile LAS int* PRE = (volatile LAS int*)(lds + MISC_OFF);
            pg8::MoeOrder S; S.G = G; S.c = lbid(); S.ntot = ntiles * 4; S.NC = 4; S.K = DFF / 2; S.pre = PRE; S.cnt = PRE + 17; S.A = (const char*)(c.ws + WS_HM); S.Bt = (const char*)(c.ws + WS_WD);
            S.bstride = (size_t)1024 * 1024; S.tab = nullptr; S.gather = false;
            EpiM2 E{wsb(c, WS_YS), (const int*)(c.ws + WS_LIST), PRE};
            pg8::gemm_phase<EpiM2, pg8::MoeOrder, true>(lds, DFF / 2, S, E);
        }
        END_STEP;
        if (RUN) { CTX; (void)lds; phase_c(c, l, G); }
        END_STEP;
    }
#undef RUN
#undef END_STEP
}
constexpr int NSTEPS = DEPTH * (1 + 2 * 8 + 5);

extern "C" void kernel_launch(void* const* d_in, const int* in_sizes, int n_in, void* d_out, int out_size, void* d_ws, size_t ws_size, hipStream_t stream) {
    static int grid = 0;
    if (grid == 0) {
        if (n_in != 18 || in_sizes[0] != T * D || out_size != T * D || ws_size < WS_END) { fprintf(stderr, "kernel_launch: unexpected shapes / workspace (need %zu, got %zu)\n", (size_t)WS_END, ws_size); grid = -1; return; }
        int dev = 0, cus = 0;
        if (hipGetDevice(&dev) != hipSuccess || hipDeviceGetAttribute(&cus, hipDeviceAttributeMultiprocessorCount, dev) != hipSuccess) { grid = -1; return; }
        if (hipFuncSetAttribute((const void*)mk_fwd, hipFuncAttributeMaxDynamicSharedMemorySize, LDS_BYTES) != hipSuccess) { fprintf(stderr, "kernel_launch: hipFuncSetAttribute failed\n"); grid = -1; return; }
        int per_cu = 0;
        if (hipOccupancyMaxActiveBlocksPerMultiprocessor(&per_cu, (const void*)mk_fwd, NTHREADS, LDS_BYTES) != hipSuccess || per_cu < 1) { fprintf(stderr, "kernel_launch: occupancy query says %d\n", per_cu); }
        (void)hipGetLastError();
        grid = cus;
    }
    if (grid < 0) return;
    (void)hipMemsetAsync((char*)d_ws + WS_CTL, 0, CTL_ZERO_BYTES, stream);
    Ctx c{};
    c.x = (const float*)d_in[0]; c.pos = (const int*)d_in[1]; c.w_in = (const float*)d_in[2]; c.w_alpha_up = (const float*)d_in[3]; c.b_alpha = (const float*)d_in[4]; c.gla_norm = (const float*)d_in[5];
    c.w_gla_o = (const float*)d_in[6]; c.w_att_o = (const float*)d_in[7]; c.w_out = (const float*)d_in[8]; c.ln1_g = (const float*)d_in[9]; c.ln1_b = (const float*)d_in[10]; c.w_router = (const float*)d_in[11];
    c.b_router = (const float*)d_in[12]; c.w_e_gate = (const float*)d_in[13]; c.w_e_up = (const float*)d_in[14]; c.w_e_down = (const float*)d_in[15]; c.ln2_g = (const float*)d_in[16]; c.ln2_b = (const float*)d_in[17];
    c.out = (float*)d_out; c.ws = (unsigned char*)d_ws;
#if MK_MULTI
    for (int s = 0; s < NSTEPS; ++s) { c.lo = s; c.hi = s + 1; hipLaunchKernelGGL(mk_fwd, dim3(grid), dim3(NTHREADS), LDS_BYTES, stream, c); }
#else
    c.lo = 0; c.hi = NSTEPS; hipLaunchKernelGGL(mk_fwd, dim3(grid), dim3(NTHREADS), LDS_BYTES, stream, c);
#endif
}
```

```cpp
#include <hip/hip_runtime.h>
#include <cstdio>
#include <cstdint>

#ifndef MK_MULTI
#define MK_MULTI 0
#endif

#define DI __device__ __forceinline__
#define GAS __attribute__((address_space(1)))
#define LAS __attribute__((address_space(3)))
typedef unsigned short bf16_t;
typedef short bf16x8 __attribute__((ext_vector_type(8)));
typedef short s16x4 __attribute__((ext_vector_type(4)));
typedef float f32x4 __attribute__((ext_vector_type(4)));
typedef float f32x2 __attribute__((ext_vector_type(2)));
typedef unsigned u32x4 __attribute__((ext_vector_type(4)));
typedef unsigned u32x2 __attribute__((ext_vector_type(2)));
typedef int i32x4 __attribute__((ext_vector_type(4)));
typedef int i32x8 __attribute__((ext_vector_type(8)));
#define LDS_WAIT() asm volatile("s_waitcnt lgkmcnt(0)" ::: "memory")
#define VM_WAIT() asm volatile("s_waitcnt vmcnt(0)" ::: "memory")

constexpr int D = 1024, NBATCH = 16, SEQ = 4096, T = NBATCH * SEQ, DEPTH = 4;
constexpr int TH = T / 2;
constexpr int DIN = 9744, NIN = 9984;
constexpr int NEXP = 16, DFF = 1024;
constexpr float LN_EPS = 1e-5f, RMS_EPS = 1e-6f;
constexpr float DN_ALPHA = 1.6817928305074290f;
constexpr float LOG2E = 1.4426950408889634f;
constexpr int NWAVES = 8, NTHREADS = 512;

constexpr size_t MiB = 1u << 20;
constexpr size_t WS_CTL = 0, CTL_ZERO_BYTES = 1 * MiB;
constexpr size_t WS_WIN = 1 * MiB;
constexpr size_t WS_WGO = WS_WIN + (size_t)NIN * D;
constexpr size_t WS_WAO = WS_WGO + 2 * MiB;
constexpr size_t WS_WOUT = WS_WAO + 1 * MiB;
constexpr size_t WS_WGU = WS_WOUT + 2 * MiB;
constexpr size_t WS_WD = WS_WGU + 32 * MiB;
constexpr size_t WS_XB = WS_WD + 16 * MiB;
constexpr size_t WS_XR = WS_XB + 64 * MiB;
constexpr size_t WS_LIST = WS_XR + 128 * MiB;
constexpr size_t WS_GATE = WS_LIST + 4 * MiB;
constexpr size_t WS_INFO = WS_GATE + 1 * MiB;
constexpr size_t WS_HISTG = WS_INFO + 1 * MiB;
constexpr size_t WS_OG = WS_HISTG + 1 * MiB;
constexpr size_t WS_ATTG = WS_OG + 64 * MiB;
constexpr size_t WS_LSE = WS_ATTG + 96 * MiB;
constexpr size_t WS_ATT = WS_LSE + 3 * MiB;
constexpr size_t WS_MIX = WS_ATT + 32 * MiB;
constexpr size_t WS_HA = WS_MIX + 64 * MiB;
constexpr size_t WS_H = WS_HA + 2 * MiB;
constexpr size_t H_QG = 0, H_KG = H_QG + (size_t)TH * 512 * 2, H_VG = H_KG + (size_t)TH * 512 * 2, H_SR = H_VG + (size_t)TH * 1024 * 2,
                 H_QD = H_SR + (size_t)TH * 1024 * 2, H_KD = H_QD + (size_t)TH * 1536 * 2, H_VD = H_KD + (size_t)TH * 1536 * 2, H_GT = H_VD + (size_t)TH * 1536 * 2,
                 H_END = H_GT + (size_t)TH * 2048 * 2;
constexpr size_t WS_HM = WS_H;
constexpr size_t WS_YS = WS_HM + (size_t)(2 * T + 4096) * 1024 * 2;
constexpr size_t WS_REC = WS_H + H_END;
constexpr size_t WS_SLOC = WS_REC + (size_t)2048 * 33792;
constexpr size_t WS_DCUM = WS_SLOC + 16 * MiB;
constexpr size_t WS_END = WS_DCUM + 1 * MiB;
static_assert(WS_YS + (size_t)2 * T * 1024 * 2 <= WS_END, "MoE overlay fits");
constexpr int CW_BAR = 4096;
constexpr int CW_TKT = 24576;
constexpr int CW_CUR = 16384;

constexpr int RING_BYTES = 131072;
constexpr int TAB_OFF = RING_BYTES, MAXU = 18, TAB_BYTES = MAXU * 1024;
constexpr int MISC_OFF = TAB_OFF + TAB_BYTES;
constexpr int LDS_BYTES = MISC_OFF + 256;

DI int rfl(int v) { return __builtin_amdgcn_readfirstlane(v); }
DI int lbid() { int t = blockIdx.x; asm volatile("" : "+s"(t)); return t; }
DI int lgrid() { int t = gridDim.x; asm volatile("" : "+s"(t)); return t; }
DI int ltid() { int t = threadIdx.x; asm volatile("" : "+v"(t)); return t; }
DI float bf2f(unsigned b) { return __uint_as_float(b << 16); }
typedef __bf16 bf16x2_t __attribute__((ext_vector_type(2)));
DI unsigned cvt_pk_bf16(float lo, float hi) { f32x2 v = {lo, hi}; bf16x2_t b = __builtin_convertvector(v, bf16x2_t); return __builtin_bit_cast(unsigned, b); }
DI float clamp8(float v) { return fminf(fmaxf(v, -448.f), 448.f); }
DI unsigned pk4_fp8(float a, float b, float c_, float d) { int w = 0; w = __builtin_amdgcn_cvt_pk_fp8_f32(clamp8(a), clamp8(b), w, false); w = __builtin_amdgcn_cvt_pk_fp8_f32(clamp8(c_), clamp8(d), w, true); return (unsigned)w; }
constexpr float W8_SCALE = 64.0f;
DI float bf_lo(unsigned w) { return __uint_as_float(w << 16); }
DI float bf_hi(unsigned w) { return __uint_as_float(w & 0xffff0000u); }
DI float sigmoidf_(float x) { return __builtin_amdgcn_rcpf(1.0f + __builtin_amdgcn_exp2f(-x * LOG2E)); }

#define XB_TMO      128
#define XB_XCNT(j)  (256  + 64 * (j))
#define XB_XSUB(j)  (1280 + 64 * (j))
#define XB_XGEN(j)  (2304 + 64 * (j))
#define XB_TOP      3328
#define XB_TOPGEN   3392
#define XCD_BAR_WORDS 3456
#define XB_SPIN_CAP (1u << 18)
DI unsigned xb_ld(unsigned* p)              { return __hip_atomic_load(p, __ATOMIC_RELAXED, __HIP_MEMORY_SCOPE_AGENT); }
DI unsigned xb_add(unsigned* p, unsigned v) { return __hip_atomic_fetch_add(p, v, __ATOMIC_RELAXED, __HIP_MEMORY_SCOPE_AGENT); }
DI unsigned xb_xcc_id() { return (unsigned)__builtin_amdgcn_s_getreg((3 << 11) | 20) & 0xFu; }
#define XB_SPIN(cond, bar) do { unsigned _sp = 0; while (cond) { __builtin_amdgcn_s_sleep(1); \
    if ((++_sp & 255u) == 0u) { if (xb_ld(&(bar)[XB_TMO])) break; if (_sp > XB_SPIN_CAP) { atomicAdd(&(bar)[XB_TMO], 1u); break; } } } } while (0)
struct XcdBarrier { unsigned* bar; unsigned x; volatile LAS unsigned* st; };
DI XcdBarrier xcd_barrier_post(unsigned* bar, volatile LAS unsigned* st) {
    XcdBarrier b; b.bar = bar; b.x = xb_xcc_id(); b.st = st;
    if (threadIdx.x == 0) (void)xb_add(&bar[XB_XCNT(b.x)], 1u);
    return b;
}
DI void xcd_barrier_complete(unsigned* bar, unsigned x, unsigned& nloc, unsigned& nx) {
    const unsigned G = gridDim.x * gridDim.y * gridDim.z;
    unsigned sum, cnt, mine, sp = 0u;
    for (;;) {
        sum = 0u; cnt = 0u; mine = 0u;
#pragma unroll
        for (unsigned j = 0; j < 16; ++j) { const unsigned c = xb_ld(&bar[XB_XCNT(j)]); sum += c; cnt += (c > 0u) ? 1u : 0u; mine = (j == x) ? c : mine; }
        if (sum == G) break;
        __builtin_amdgcn_s_sleep(1);
        if ((++sp & 255u) == 0u) { if (xb_ld(&bar[XB_TMO])) break; if (sp > XB_SPIN_CAP) { atomicAdd(&bar[XB_TMO], 1u); break; } }
    }
    nloc = mine > 0u ? mine : 1u; nx = cnt > 0u ? cnt : 1u;
}
DI void xcd_barrier(const XcdBarrier& b) {
    asm volatile("s_waitcnt vmcnt(0)" ::: "memory");
    __syncthreads();
    if (threadIdx.x == 0) {
        unsigned* bar = b.bar;
        __builtin_amdgcn_s_waitcnt(0);
        unsigned nloc = b.st[0], nx = b.st[1];
        if (nloc == 0u) { xcd_barrier_complete(bar, b.x, nloc, nx); b.st[0] = nloc; b.st[1] = nx; }
        const unsigned old = xb_add(&bar[XB_XSUB(b.x)], 1u);
        const unsigned gen = old / nloc;
        if (old + 1u == (gen + 1u) * nloc) {
            __builtin_amdgcn_fence(__ATOMIC_RELEASE, "agent");
            asm volatile("s_waitcnt vmcnt(0)" ::: "memory");
            const unsigned og = xb_add(&bar[XB_TOP], 1u);
            const unsigned tg = og / nx;
            if (og + 1u == (tg + 1u) * nx) xb_add(&bar[XB_TOPGEN], 1u);
            else XB_SPIN(xb_ld(&bar[XB_TOPGEN]) == tg, bar);
            __builtin_amdgcn_fence(__ATOMIC_ACQUIRE, "agent");
            xb_add(&bar[XB_XGEN(b.x)], 1u);
            asm volatile("s_waitcnt vmcnt(0)" ::: "memory");
        } else {
            XB_SPIN(xb_ld(&bar[XB_XGEN(b.x)]) == gen, bar);
            __builtin_amdgcn_fence(__ATOMIC_ACQUIRE, "agent");
            asm volatile("s_waitcnt vmcnt(0)" ::: "memory");
        }
    }
    __syncthreads();
}

struct Ctx {
    const float* x; const int* pos; const float* w_in; const float* w_alpha_up; const float* b_alpha; const float* gla_norm;
    const float* w_gla_o; const float* w_att_o; const float* w_out; const float* ln1_g; const float* ln1_b; const float* w_router; const float* b_router;
    const float* w_e_gate; const float* w_e_up; const float* w_e_down; const float* ln2_g; const float* ln2_b;
    float* out; unsigned char* ws;
    int lo, hi;
};
DI bf16_t* wsb(const Ctx& c, size_t off) { return (bf16_t*)(c.ws + off); }

namespace pg8 {
constexpr int BM = 256, BK = 64, HALF = 128, HTB = HALF * BK * 2, STAGE_BYTES = 8 * HTB, NXCD = 8, WGM = 8;
DI int lds_byte(int r, int c) { const int st = (r >> 4) * 2 + (c >> 5), rr = r & 15, cc = c & 31, ob = rr * 64 + cc * 2; return st * 1024 + (ob ^ (((ob >> 9) & 1) << 5)); }
DI void stage_rc(int b, int& R, int& C) { const int st = b / 1024, sb = b % 1024, swz = sb ^ (((sb >> 9) & 1) << 5); R = (st >> 1) * 16 + swz / 64; C = (st & 1) * 32 + (swz % 64) / 2; }
DI int perm32(int rho) { const int n = rho >> 4, i = rho & 15; return 8 * (i >> 2) + 4 * n + (i & 3); }
struct Unit { int pm, pn, e, nv, ui; };

struct StaticOrder {
    int nM, nN, nwg, G, c, K; const char* A; const char* Bt;
    DI void init(const void* A_, const void* Bt_, int M, int N, int K_, int G_, int c_) { A = (const char*)A_; Bt = (const char*)Bt_; nM = M / BM; nN = N / BM; nwg = nM * nN; G = G_; c = c_; K = K_; }
    DI bool next(int i, Unit& u) const {
        const long L = (long)i * G + c; if (L >= nwg) return false;
        int wgid = (int)L; { const int q = nwg / NXCD, r = nwg % NXCD, xcd = wgid % NXCD, off = wgid / NXCD; wgid = (xcd < r ? xcd * (q + 1) : r * (q + 1) + (xcd - r) * q) + off; }
        const int nig = WGM * nN, gid = wgid / nig, fm = gid * WGM, gsz = (nM - fm) < WGM ? (nM - fm) : WGM;
        u.pm = fm + ((wgid % nig) % gsz); u.pn = (wgid % nig) / gsz; u.e = 0; u.nv = 256; u.ui = i; return true;
    }
    DI const char* a_base(const Unit& u) const { return A + (size_t)u.pm * BM * K * 2; }
    DI const char* b_base(const Unit& u) const { return Bt + (size_t)u.pn * BM * K * 2; }
    DI void a_off(const Unit&, int tid, unsigned (&o)[2][2]) const {
#pragma unroll
        for (int i = 0; i < 2; ++i) { int R, C; stage_rc(tid * 16 + i * 8192, R, C);
#pragma unroll
            for (int h = 0; h < 2; ++h) o[h][i] = (unsigned)((h * HALF + R) * K + C) * 2u; }
    }
};
struct MoeOrder {
    int G, c, ntot, NC, K; const volatile LAS int* pre; const volatile LAS int* cnt; const char* A; const char* Bt; size_t bstride; const volatile LAS int* tab; bool gather;
    DI bool next(int i, Unit& u) const {
        const int L = i * G + c; if (L >= ntot) return false;
        const int rt = L / NC; u.pn = L - rt * NC; u.pm = rt;
        int e = 0;
#pragma unroll
        for (int j = 1; j < 16; ++j) e += (rt >= rfl(pre[j])) ? 1 : 0;
        e = rfl(e); u.e = e; const int rem = rfl(cnt[e]) - 256 * (rt - rfl(pre[e])); u.nv = rem < 256 ? rem : 256; u.ui = i; return true;
    }
    DI const char* a_base(const Unit& u) const { return gather ? A : A + (size_t)u.pm * BM * K * 2; }
    DI const char* b_base(const Unit& u) const { return Bt + (size_t)u.e * bstride + (size_t)u.pn * BM * K * 2; }
    DI void a_off(const Unit& u, int tid, unsigned (&o)[2][2]) const {
#pragma unroll
        for (int i = 0; i < 2; ++i) { int R, C; stage_rc(tid * 16 + i * 8192, R, C);
#pragma unroll
            for (int h = 0; h < 2; ++h) { const int row = gather ? tab[u.ui * 256 + h * HALF + R] : (h * HALF + R); o[h][i] = (unsigned)(row * K + C) * 2u; } }
    }
};

template <class Epi, class Sched, bool F8 = false>
DI void gemm_phase(LAS unsigned char* lds, const int K, const Sched& S, const Epi& E) {
    const int tid = ltid(), wid = rfl(tid >> 6), lane = tid & 63, wr = wid >> 2, wc = wid & 3, fr = lane & 15, fq = lane >> 4;
    const int nt = K / BK;
    unsigned voffB[2];
#pragma unroll
    for (int i = 0; i < 2; ++i) { int R, C; stage_rc(tid * 16 + i * 8192, R, C); const int Rb = Epi::PERM ? ((R & ~31) + perm32(R & 31)) : R; voffB[i] = (unsigned)(Rb * K + C) * 2u; }
    const size_t kstep = (size_t)(BK * 2);
    const size_t hstep = (size_t)HALF * K * 2;
    const unsigned ldsw = (unsigned)wid * 1024u;
    const int aoff = lds_byte(wr * 64 + fr, fq * 8), boff = lds_byte(wc * 32 + fr, fq * 8);
#define PG8_SA(b, h) (((b) * 2 + (h)) * HTB)
#define PG8_SB(b, h) ((4 + (b) * 2 + (h)) * HTB)
#define PG8_STAGE(bufoff, gbase, voff) do { _Pragma("unroll") for (int _i = 0; _i < 2; ++_i) \
        __builtin_amdgcn_global_load_lds((const unsigned*)((const char*)(gbase) + (voff)[_i]), (LAS unsigned*)(lds + (bufoff) + ldsw + _i * 8192), 16, 0, 0); } while (0)
#define PG8_LD8(p) __builtin_shufflevector(*(const LAS i32x4*)(p), *(const LAS i32x4*)((p) + 1024), 0, 1, 2, 3, 4, 5, 6, 7)
#define PG8_LDA(dst, b, h) do { if constexpr (F8) { _Pragma("unroll") for (int m = 0; m < 4; ++m) dst##8[m] = PG8_LD8(lds + PG8_SA(b, h) + aoff + m * 2048); } else { \
        _Pragma("unroll") for (int m = 0; m < 4; ++m) _Pragma("unroll") for (int k = 0; k < 2; ++k) dst[m][k] = *(const LAS bf16x8*)(lds + PG8_SA(b, h) + aoff + m * 2048 + k * 1024); } } while (0)
#define PG8_LDB(dst, b, h) do { if constexpr (F8) { _Pragma("unroll") for (int n = 0; n < 2; ++n) dst##8[n] = PG8_LD8(lds + PG8_SB(b, h) + boff + n * 2048); } else { \
        _Pragma("unroll") for (int n = 0; n < 2; ++n) _Pragma("unroll") for (int k = 0; k < 2; ++k) dst[n][k] = *(const LAS bf16x8*)(lds + PG8_SB(b, h) + boff + n * 2048 + k * 1024); } } while (0)
#define PG8_MMA(ai, bj, At, Bt) do { __builtin_amdgcn_s_setprio(1); if constexpr (F8) { _Pragma("unroll") for (int m = 0; m < 4; ++m) _Pragma("unroll") for (int n = 0; n < 2; ++n) \
        asm volatile("v_mfma_scale_f32_16x16x128_f8f6f4 %0, %1, %2, %0, %3, %4 op_sel_hi:[0,0,0]" : "+v"(acc[ai][bj][m][n]) : "v"(Bt##8[n]), "v"(At##8[m]), "v"(sc_w), "v"(sc_a)); } else { \
        _Pragma("unroll") for (int m = 0; m < 4; ++m) _Pragma("unroll") for (int n = 0; n < 2; ++n) _Pragma("unroll") for (int k = 0; k < 2; ++k) \
        acc[ai][bj][m][n] = __builtin_amdgcn_mfma_f32_16x16x32_bf16(Bt[n][k], At[m][k], acc[ai][bj][m][n], 0, 0, 0); } __builtin_amdgcn_s_setprio(0); } while (0)
#define PG8_WAIT_V(n) asm volatile("s_waitcnt vmcnt(" #n ")" ::: "memory")
#define PG8_WAIT_L(n) asm volatile("s_waitcnt lgkmcnt(" #n ")" ::: "memory")
#define PG8_BAR __builtin_amdgcn_s_barrier()
#define PG8_SCHED __builtin_amdgcn_sched_barrier(0)
    Unit cur, nxt; int ui = 0;
    if (!S.next(0, cur)) return;
    f32x4 acc[2][2][4][2];
#pragma unroll
    for (int a = 0; a < 2; ++a)
#pragma unroll
        for (int b = 0; b < 2; ++b)
#pragma unroll
            for (int m = 0; m < 4; ++m)
#pragma unroll
                for (int n = 0; n < 2; ++n) acc[a][b][m][n] = (f32x4){0.f, 0.f, 0.f, 0.f};
    int sc_w = 0x79797979, sc_a = 0x7f7f7f7f; asm volatile("" : "+v"(sc_w), "+v"(sc_a));
    bf16x8 At[4][2], B0[2][2], B1[2][2]; i32x8 At8[4], B08[2], B18[2];
    unsigned oA[2][2]; S.a_off(cur, tid, oA);
    const char* cA = S.a_base(cur); const char* cB = S.b_base(cur);
    PG8_STAGE(PG8_SB(0, 0), cB, voffB); PG8_STAGE(PG8_SB(0, 1), cB + hstep, voffB); PG8_STAGE(PG8_SA(0, 0), cA, oA[0]); PG8_STAGE(PG8_SA(0, 1), cA, oA[1]);
    if (wr == 1) PG8_BAR;
    PG8_WAIT_V(2); PG8_BAR;
    PG8_STAGE(PG8_SB(1, 0), cB + kstep, voffB); PG8_STAGE(PG8_SA(1, 0), cA + kstep, oA[0]); PG8_STAGE(PG8_SB(1, 1), cB + hstep + kstep, voffB);
    PG8_WAIT_V(6); PG8_BAR;
    for (;;) {
        const bool has_next = S.next(ui + 1, nxt);
        const char* nA = has_next ? S.a_base(nxt) : cA; const char* nB = has_next ? S.b_base(nxt) : cB;
        for (int t = 0; t < nt; t += 2) {
            const bool last = (t == nt - 2);
            const char* a1 = cA + (size_t)(t + 1) * kstep;
            const char* a2 = last ? nA : cA + (size_t)(t + 2) * kstep; const char* b2 = last ? nB : cB + (size_t)(t + 2) * kstep;
            const char* a3 = a2 + kstep; const char* b3 = b2 + kstep;
            PG8_LDB(B0, 0, 0); PG8_LDB(B1, 0, 1); PG8_SCHED; PG8_LDA(At, 0, 0); PG8_STAGE(PG8_SA(1, 1), a1, oA[1]);
            if (last && has_next) S.a_off(nxt, tid, oA);
            PG8_WAIT_V(8); PG8_WAIT_L(0); PG8_BAR; PG8_MMA(0, 0, At, B0); PG8_MMA(0, 1, At, B1); PG8_BAR; PG8_SCHED;
            PG8_LDA(At, 0, 1); PG8_STAGE(PG8_SB(0, 0), b2, voffB); PG8_STAGE(PG8_SB(0, 1), b2 + hstep, voffB); PG8_STAGE(PG8_SA(0, 0), a2, oA[0]);
            PG8_WAIT_V(8); PG8_WAIT_L(0); PG8_BAR; PG8_MMA(1, 0, At, B0); PG8_MMA(1, 1, At, B1); PG8_BAR; PG8_SCHED;
            PG8_LDB(B0, 1, 0); PG8_LDB(B1, 1, 1); PG8_SCHED; PG8_LDA(At, 1, 0); PG8_STAGE(PG8_SA(0, 1), a2, oA[1]);
            PG8_WAIT_V(8); PG8_WAIT_L(0); PG8_BAR; PG8_MMA(0, 0, At, B0); PG8_MMA(0, 1, At, B1); PG8_BAR; PG8_SCHED;
            PG8_LDA(At, 1, 1); PG8_STAGE(PG8_SB(1, 0), b3, voffB); PG8_STAGE(PG8_SB(1, 1), b3 + hstep, voffB); PG8_STAGE(PG8_SA(1, 0), a3, oA[0]);
            PG8_WAIT_V(8); PG8_WAIT_L(0); PG8_BAR; PG8_MMA(1, 0, At, B0); PG8_MMA(1, 1, At, B1); PG8_BAR; PG8_SCHED;
        }
        if (wr == 0) PG8_BAR;
        if constexpr (F8) asm volatile("s_nop 15\n\ts_nop 15" ::: "memory");
        E(acc, cur, wr, wc, fr, fq);
        if (!has_next) break;
#pragma unroll
        for (int a = 0; a < 2; ++a)
#pragma unroll
            for (int b = 0; b < 2; ++b)
#pragma unroll
                for (int m = 0; m < 4; ++m)
#pragma unroll
                    for (int n = 0; n < 2; ++n) acc[a][b][m][n] = (f32x4){0.f, 0.f, 0.f, 0.f};
        cur = nxt; cA = nA; cB = nB; ++ui;
        if (wr == 1) PG8_BAR;
    }
    PG8_WAIT_V(0);
    PG8_BAR;
#undef PG8_SA
#undef PG8_SB
#undef PG8_STAGE
#undef PG8_LDA
#undef PG8_LDB
#undef PG8_MMA
#undef PG8_LD8
#undef PG8_WAIT_V
#undef PG8_WAIT_L
#undef PG8_BAR
#undef PG8_SCHED
}
}
using pg8::Unit;

DI u32x4 pack8(const f32x4& v0, const f32x4& v1) { u32x4 w; w.x = cvt_pk_bf16(v0[0], v0[1]); w.y = cvt_pk_bf16(v0[2], v0[3]); w.z = cvt_pk_bf16(v1[0], v1[1]); w.w = cvt_pk_bf16(v1[2], v1[3]); return w; }

struct EpiIn {
    static constexpr bool PERM = true;
    bf16_t *qg, *kg, *vg, *sr, *qd, *kd, *vd, *gt; float* ha; const int* pos;
    DI void operator()(const f32x4 (&acc)[2][2][4][2], const Unit& u, int wr, int wc, int fr, int fq) const {
        const int row0 = u.pm * 256 + wr * 64 + fr; const int pn = u.pn;
        if (pn >= 12 && pn < 24) {
            bf16_t* base = pn < 18 ? qd : kd; const int tq = pn < 18 ? pn - 12 : pn - 18; const float sc = pn < 18 ? 0.125f * LOG2E : 1.0f;
            float fre[8];
#pragma unroll
            for (int i = 0; i < 8; ++i) fre[i] = __builtin_amdgcn_exp2f(-(float)(8 * fq + i) * (13.287712379549449f / 32.0f)) * 0.15915494309189535f;
#pragma unroll
            for (int ai = 0; ai < 2; ++ai)
#pragma unroll
                for (int m = 0; m < 4; ++m) {
                    const int r = row0 + ai * 128 + m * 16; const float p = (float)pos[r];
                    bf16_t* rowp = base + (size_t)r * 1536 + (4 * tq + wc) * 64 + 8 * fq;
#pragma unroll
                    for (int n = 0; n < 2; ++n) { f32x4 o1, o2;
#pragma unroll
                        for (int j = 0; j < 4; ++j) {
                            float a = p * fre[n * 4 + j]; a = a - __builtin_floorf(a);
                            const float sn = __builtin_amdgcn_sinf(a), cs = __builtin_amdgcn_cosf(a);
                            const float x1 = acc[ai][0][m][n][j], x2 = acc[ai][1][m][n][j];
                            o1[j] = (x1 * cs - x2 * sn) * sc; o2[j] = (x2 * cs + x1 * sn) * sc;
                        }
                        u32x2 w1, w2; w1.x = cvt_pk_bf16(o1[0], o1[1]); w1.y = cvt_pk_bf16(o1[2], o1[3]); w2.x = cvt_pk_bf16(o2[0], o2[1]); w2.y = cvt_pk_bf16(o2[2], o2[3]);
                        *(GAS u32x2*)(rowp + 4 * n) = w1; *(GAS u32x2*)(rowp + 32 + 4 * n) = w2; }
                    asm volatile("" ::: "memory");
                }
        } else if (pn == 38) {
            if (wc == 0 && fq < 2) {
#pragma unroll
                for (int ai = 0; ai < 2; ++ai)
#pragma unroll
                    for (int m = 0; m < 4; ++m) { float* p = ha + (size_t)(row0 + ai * 128 + m * 16) * 16 + 8 * fq; *(GAS f32x4*)p = acc[ai][0][m][0]; *(GAS f32x4*)(p + 4) = acc[ai][0][m][1]; }
            }
        } else {
            bf16_t* base; int ldc, colt, act = 0; float sc = 1.0f;
            if (pn < 2) { base = qg; ldc = 512; colt = pn * 256; sc = 0.08838834764831845f; }
            else if (pn < 4) { base = kg; ldc = 512; colt = (pn - 2) * 256; }
            else if (pn < 8) { base = vg; ldc = 1024; colt = (pn - 4) * 256; }
            else if (pn < 12) { base = sr; ldc = 1024; colt = (pn - 8) * 256; act = 1; }
            else if (pn < 30) { base = vd; ldc = 1536; colt = (pn - 24) * 256; }
            else { base = gt; ldc = 2048; colt = (pn - 30) * 256; act = 2; }
#pragma unroll
            for (int ai = 0; ai < 2; ++ai)
#pragma unroll
                for (int m = 0; m < 4; ++m) { bf16_t* rowp = base + (size_t)(row0 + ai * 128 + m * 16) * ldc + colt + wc * 32 + 8 * fq;
#pragma unroll
                    for (int bj = 0; bj < 2; ++bj) { f32x4 v0 = acc[ai][bj][m][0] * sc, v1 = acc[ai][bj][m][1] * sc;
                        if (act) {
#pragma unroll
                            for (int j = 0; j < 4; ++j) { const float s0 = sigmoidf_(v0[j]), s1 = sigmoidf_(v1[j]); v0[j] = act == 1 ? v0[j] * s0 : s0; v1[j] = act == 1 ? v1[j] * s1 : s1; } }
                        *(GAS u32x4*)(rowp + bj * 128) = pack8(v0, v1); } }
        }
    }
};
template <bool ADD> struct EpiGate {
    static constexpr bool PERM = true;
    bf16_t* mix; const bf16_t* gt;
    DI void operator()(const f32x4 (&acc)[2][2][4][2], const Unit& u, int wr, int wc, int fr, int fq) const {
        const int row0 = u.pm * 256 + wr * 64 + fr, col0 = u.pn * 256 + wc * 32 + 8 * fq;
#pragma unroll
        for (int ai = 0; ai < 2; ++ai)
#pragma unroll
            for (int m = 0; m < 4; ++m) { const size_t r = (size_t)(row0 + ai * 128 + m * 16);
#pragma unroll
                for (int bj = 0; bj < 2; ++bj) {
                    const u32x4 g = *(const GAS u32x4*)(gt + r * 2048 + col0 + bj * 128);
                    f32x4 v0 = acc[ai][bj][m][0], v1 = acc[ai][bj][m][1];
                    v0[0] *= bf_lo(g.x); v0[1] *= bf_hi(g.x); v0[2] *= bf_lo(g.y); v0[3] *= bf_hi(g.y); v1[0] *= bf_lo(g.z); v1[1] *= bf_hi(g.z); v1[2] *= bf_lo(g.w); v1[3] *= bf_hi(g.w);
                    bf16_t* mp = mix + r * 1024 + col0 + bj * 128;
                    if (ADD) { const u32x4 o = *(const GAS u32x4*)mp; v0[0] += bf_lo(o.x); v0[1] += bf_hi(o.x); v0[2] += bf_lo(o.y); v0[3] += bf_hi(o.y); v1[0] += bf_lo(o.z); v1[1] += bf_hi(o.z); v1[2] += bf_lo(o.w); v1[3] += bf_hi(o.w); }
                    *(GAS u32x4*)mp = pack8(v0, v1); } }
    }
};
struct EpiRes {
    static constexpr bool PERM = true;
    const float* x32; bf16_t* xr;
    DI void operator()(const f32x4 (&acc)[2][2][4][2], const Unit& u, int wr, int wc, int fr, int fq) const {
        const int row0 = u.pm * 256 + wr * 64 + fr, col0 = u.pn * 256 + wc * 32 + 8 * fq;
#pragma unroll
        for (int ai = 0; ai < 2; ++ai)
#pragma unroll
            for (int m = 0; m < 4; ++m) { const size_t off = (size_t)(row0 + ai * 128 + m * 16) * 1024 + col0;
#pragma unroll
                for (int bj = 0; bj < 2; ++bj) { f32x4 a0, a1;
                    if (x32) { a0 = *(const GAS f32x4*)(x32 + off + bj * 128); a1 = *(const GAS f32x4*)(x32 + off + bj * 128 + 4); }
                    else { const u32x4 o = *(const GAS u32x4*)(xr + off + bj * 128); a0 = (f32x4){bf_lo(o.x), bf_hi(o.x), bf_lo(o.y), bf_hi(o.y)}; a1 = (f32x4){bf_lo(o.z), bf_hi(o.z), bf_lo(o.w), bf_hi(o.w)}; }
                    *(GAS u32x4*)(xr + off + bj * 128) = pack8(a0 * DN_ALPHA + acc[ai][bj][m][0], a1 * DN_ALPHA + acc[ai][bj][m][1]); }
                asm volatile("" ::: "memory"); }
    }
};
struct EpiM1 {
    static constexpr bool PERM = true;
    unsigned char* hm;
    DI void operator()(const f32x4 (&acc)[2][2][4][2], const Unit& u, int wr, int wc, int fr, int fq) const {
        const int row0 = u.pm * 256 + wr * 64 + fr, col0 = u.pn * 128 + wc * 32 + 8 * fq;
#pragma unroll
        for (int ai = 0; ai < 2; ++ai)
#pragma unroll
            for (int m = 0; m < 4; ++m) { f32x4 v0, v1;
#pragma unroll
                for (int j = 0; j < 4; ++j) { const float g0 = acc[ai][0][m][0][j], g1 = acc[ai][0][m][1][j]; v0[j] = g0 * sigmoidf_(g0) * acc[ai][1][m][0][j]; v1[j] = g1 * sigmoidf_(g1) * acc[ai][1][m][1][j]; }
                u32x2 o; o.x = pk4_fp8(v0[0], v0[1], v0[2], v0[3]); o.y = pk4_fp8(v1[0], v1[1], v1[2], v1[3]);
                *(GAS u32x2*)(hm + (size_t)(row0 + ai * 128 + m * 16) * 1024 + col0) = o; }
    }
};
struct EpiM2 {
    static constexpr bool PERM = true;
    unsigned char* ys; const int* list; const volatile LAS int* pre;
    DI void operator()(const f32x4 (&acc)[2][2][4][2], const Unit& u, int wr, int wc, int fr, int fq) const {
        const int lrow0 = wr * 64 + fr, col0 = u.pn * 256 + wc * 32 + 8 * fq; const int lt = u.pm - rfl(pre[u.e]);
        const int* lp = list + (size_t)u.e * T + 256 * lt;
#pragma unroll
        for (int ai = 0; ai < 2; ++ai)
#pragma unroll
            for (int m = 0; m < 4; ++m) { const int r = lrow0 + ai * 128 + m * 16;
                if (r < u.nv) { const int slot = lp[r]; unsigned char* yp = ys + (size_t)slot * 1024 + col0;
#pragma unroll
                    for (int bj = 0; bj < 2; ++bj) { const f32x4 v0 = acc[ai][bj][m][0], v1 = acc[ai][bj][m][1]; u32x2 o; o.x = pk4_fp8(v0[0], v0[1], v0[2], v0[3]); o.y = pk4_fp8(v1[0], v1[1], v1[2], v1[3]); *(GAS u32x2*)(yp + bj * 128) = o; } } }
    }
};

template <bool F8>
DI void tr_item(const float* W, int N, void* WTv, int K, int drow, int c0, int nvalid, int kb, LAS float* scr, int lane) {
    const int k0 = 64 * kb;
    { const int cc = lane & 31, ccl = cc < nvalid ? cc : 0; const float* wp = W + (size_t)(k0 + (lane >> 5)) * N + c0 + ccl; float v[32];
#pragma unroll
      for (int i = 0; i < 32; ++i) v[i] = wp[(size_t)(2 * i) * N];
#pragma unroll
      for (int i = 0; i < 32; ++i) scr[(2 * i + (lane >> 5)) * 33 + cc] = (cc < nvalid) ? v[i] : 0.f; }
    LDS_WAIT(); asm volatile("" ::: "memory");
    const int c = lane & 7;
#pragma unroll
    for (int j = 0; j < 4; ++j) { const int n = (lane >> 3) + 8 * j; const LAS float* s = scr + (8 * c) * 33 + n;
        if constexpr (F8) { u32x2 o; o.x = pk4_fp8(s[0 * 33] * W8_SCALE, s[1 * 33] * W8_SCALE, s[2 * 33] * W8_SCALE, s[3 * 33] * W8_SCALE); o.y = pk4_fp8(s[4 * 33] * W8_SCALE, s[5 * 33] * W8_SCALE, s[6 * 33] * W8_SCALE, s[7 * 33] * W8_SCALE);
            *(GAS u32x2*)((unsigned char*)WTv + (size_t)(drow + n) * K + k0 + 8 * c) = o; }
        else { u32x4 o; o.x = cvt_pk_bf16(s[0 * 33], s[1 * 33]); o.y = cvt_pk_bf16(s[2 * 33], s[3 * 33]); o.z = cvt_pk_bf16(s[4 * 33], s[5 * 33]); o.w = cvt_pk_bf16(s[6 * 33], s[7 * 33]);
            *(GAS u32x4*)((bf16_t*)WTv + (size_t)(drow + n) * K + k0 + 8 * c) = o; } }
    LDS_WAIT(); asm volatile("" ::: "memory");
}
DI void phase_w(LAS unsigned char* lds, const Ctx& c, int l, int G) {
    const int tid = ltid(), lane = tid & 63, wave = rfl(tid >> 6);
    LAS float* scr = (LAS float*)(lds + wave * 16384);
    const int gw = lbid() * NWAVES + wave, NGW = G * NWAVES;
    constexpr int I_IN = (NIN / 32) * 16, I_GO = 512, I_AO = 256, I_OUT = 512, I_EXP = 16 * 512;
    constexpr int NITEMS = I_IN + I_GO + I_AO + I_OUT + 3 * I_EXP;
    for (int it = gw; it < NITEMS; it += NGW) {
        int r = it;
        if (r < I_IN) {
            const int nbg = r >> 4, kb = r & 15, n0 = 32 * nbg, tile = n0 >> 8, p = n0 & 255; int c0, nv = 32;
            if (tile < 12) c0 = n0;
            else if (tile < 24) { const int base = tile < 18 ? 3088 : 4624, tq = tile < 18 ? tile - 12 : tile - 18; c0 = base + (4 * tq + ((p & 127) >> 5)) * 64 + (p >= 128 ? 32 : 0); }
            else if (tile < 30) c0 = 6160 + (n0 - 24 * 256);
            else if (tile < 38) c0 = 7696 + (n0 - 30 * 256);
            else { c0 = 3072; nv = (p == 0) ? 16 : 0; }
            tr_item<true>(c.w_in + (size_t)l * D * DIN, DIN, c.ws + WS_WIN, D, n0, c0, nv, kb, scr, lane); continue; }
        r -= I_IN;
        if (r < I_GO) { tr_item<false>(c.w_gla_o + (size_t)l * D * D, D, wsb(c, WS_WGO), D, 32 * (r >> 4), 32 * (r >> 4), 32, r & 15, scr, lane); continue; }
        r -= I_GO;
        if (r < I_AO) { tr_item<false>(c.w_att_o + (size_t)l * 512 * D, D, wsb(c, WS_WAO), 512, 32 * (r >> 3), 32 * (r >> 3), 32, r & 7, scr, lane); continue; }
        r -= I_AO;
        if (r < I_OUT) { tr_item<false>(c.w_out + (size_t)l * D * D, D, wsb(c, WS_WOUT), D, 32 * (r >> 4), 32 * (r >> 4), 32, r & 15, scr, lane); continue; }
        r -= I_OUT;
        const int which = r / I_EXP; r -= which * I_EXP; const int e = r >> 9, q = r & 511, nbg = q >> 4, kb = q & 15;
        const size_t eoff = (size_t)(l * NEXP + e) * D * DFF;
        if (which == 0) tr_item<true>(c.w_e_gate + eoff, DFF, c.ws + WS_WGU + (size_t)e * 2048 * 1024, D, 256 * (nbg >> 2) + 32 * (nbg & 3), 32 * nbg, 32, kb, scr, lane);
        else if (which == 1) tr_item<true>(c.w_e_up + eoff, DFF, c.ws + WS_WGU + (size_t)e * 2048 * 1024, D, 256 * (nbg >> 2) + 128 + 32 * (nbg & 3), 32 * nbg, 32, kb, scr, lane);
        else tr_item<true>(c.w_e_down + eoff, D, c.ws + WS_WD + (size_t)e * 1024 * 1024, DFF, 32 * nbg, 32 * nbg, 32, kb, scr, lane);
    }
    if (l == 0) {
        const size_t n8 = (size_t)T * D / 8; unsigned char* xb = c.ws + WS_XB;
        for (size_t i = (size_t)lbid() * NTHREADS + tid; i < n8; i += (size_t)G * NTHREADS) { const f32x4 a = *(const GAS f32x4*)(c.x + i * 8), b = *(const GAS f32x4*)(c.x + i * 8 + 4);
            u32x2 o; o.x = pk4_fp8(a[0], a[1], a[2], a[3]); o.y = pk4_fp8(b[0], b[1], b[2], b[3]); *(GAS u32x2*)(xb + i * 8) = o; }
    }
}

DI s16x4 tr16(const LAS void* p) { return __builtin_bit_cast(s16x4, __builtin_amdgcn_ds_read_tr16_b64_v4i16((LAS s16x4*)p)); }
DI bf16x8 cat8(s16x4 lo, s16x4 hi) { return __builtin_shufflevector(lo, hi, 0, 1, 2, 3, 4, 5, 6, 7); }
#define MFMA16(a, b, c) __builtin_amdgcn_mfma_f32_16x16x32_bf16((a), (b), (c), 0, 0, 0)

constexpr int REC_BYTES = 33792, REC_KS = 16384, REC_DEC = 32768, OI_BYTES = 32768;
constexpr int GP_QT = 0, GP_KT = 17408, GP_VS = 34816, GP_ATT = 68608, GP_WUP = 77824, GP_BAL = 86016;
DI float exp_(float x) { return __builtin_amdgcn_exp2f(x * LOG2E); }
DI void unpack8(const u32x4& q, float (&v)[16], int o) { v[o] = bf_lo(q.x); v[o + 1] = bf_hi(q.x); v[o + 2] = bf_lo(q.y); v[o + 3] = bf_hi(q.y); v[o + 4] = bf_lo(q.z); v[o + 5] = bf_hi(q.z); v[o + 6] = bf_lo(q.w); v[o + 7] = bf_hi(q.w); }
DI u32x4 packf8(const float (&v)[16], int o) { u32x4 p; p.x = cvt_pk_bf16(v[o], v[o + 1]); p.y = cvt_pk_bf16(v[o + 2], v[o + 3]); p.z = cvt_pk_bf16(v[o + 4], v[o + 5]); p.w = cvt_pk_bf16(v[o + 6], v[o + 7]); return p; }
DI void gla_p_unit(LAS unsigned char* lds, const Ctx& c, int l, int bl, int h, int n, int& h_loaded) {
    const int tid = ltid(), lane = tid & 63, w = rfl(tid >> 6), fr = lane & 15, fq = lane >> 4;
    const size_t tok0 = (size_t)bl * SEQ + n * 64;
    const bf16_t* QG = wsb(c, WS_H + H_QG) + tok0 * 512 + h * 128;
    const bf16_t* KG = wsb(c, WS_H + H_KG) + tok0 * 512 + h * 128;
    const bf16_t* VG = wsb(c, WS_H + H_VG) + tok0 * 1024 + h * 256;
    const float* HA = (const float*)(c.ws + WS_HA) + tok0 * 16;
    const int unit = (bl * 4 + h) * 64 + n;
    unsigned char* rec = c.ws + WS_REC + (size_t)unit * REC_BYTES;
    unsigned char* oi = c.ws + WS_MIX + (size_t)unit * OI_BYTES;
    LAS bf16_t* QT = (LAS bf16_t*)(lds + GP_QT); LAS bf16_t* KT = (LAS bf16_t*)(lds + GP_KT); LAS bf16_t* VS = (LAS bf16_t*)(lds + GP_VS); LAS bf16_t* AT = (LAS bf16_t*)(lds + GP_ATT);
    LAS float* WUP = (LAS float*)(lds + GP_WUP); LAS float* BAL = (LAS float*)(lds + GP_BAL);
    __syncthreads();
    if (h_loaded != h) { for (int i = tid; i < 16 * 128; i += NTHREADS) WUP[i] = c.w_alpha_up[(size_t)l * 16 * 512 + (i >> 7) * 512 + h * 128 + (i & 127)];
        if (tid < 128) BAL[tid] = c.b_alpha[l * 512 + h * 128 + tid]; h_loaded = h; __syncthreads(); }
    {
        const int row = lane;
        f32x4 a4[4];
#pragma unroll
        for (int j = 0; j < 4; ++j) a4[j] = *(const GAS f32x4*)(HA + (size_t)row * 16 + 4 * j);
        const u32x4 q0 = *(const GAS u32x4*)(QG + (size_t)row * 512 + 16 * w), q1 = *(const GAS u32x4*)(QG + (size_t)row * 512 + 16 * w + 8);
        const u32x4 k0 = *(const GAS u32x4*)(KG + (size_t)row * 512 + 16 * w), k1 = *(const GAS u32x4*)(KG + (size_t)row * 512 + 16 * w + 8);
#pragma unroll
        for (int c2 = 0; c2 < 4; ++c2) { const int idx = tid + NTHREADS * c2, r = idx >> 5, ch = idx & 31; *(LAS u32x4*)(VS + r * 264 + ch * 8) = *(const GAS u32x4*)(VG + (size_t)r * 1024 + ch * 8); }
        float la[16];
#pragma unroll
        for (int cc = 0; cc < 16; ++cc) la[cc] = BAL[16 * w + cc];
#pragma unroll
        for (int j = 0; j < 16; ++j) { const float aj = a4[j >> 2][j & 3];
#pragma unroll
            for (int c4 = 0; c4 < 4; ++c4) { const f32x4 wv = *(const LAS f32x4*)(WUP + j * 128 + 16 * w + 4 * c4); la[4 * c4] += aj * wv[0]; la[4 * c4 + 1] += aj * wv[1]; la[4 * c4 + 2] += aj * wv[2]; la[4 * c4 + 3] += aj * wv[3]; } }
#pragma unroll
        for (int cc = 0; cc < 16; ++cc) { const float z = la[cc]; la[cc] = -(fmaxf(-z, 0.f) + __builtin_amdgcn_logf(1.0f + exp_(-fabsf(z))) * 0.6931471805599453f) * (1.0f / 16.0f); }
#pragma unroll
        for (int dlt = 1; dlt < 64; dlt <<= 1)
#pragma unroll
            for (int cc = 0; cc < 16; ++cc) { const float t = __shfl_up(la[cc], dlt); if (lane >= dlt) la[cc] += t; }
        float qv[16], kv[16];
        unpack8(q0, qv, 0); unpack8(q1, qv, 8); unpack8(k0, kv, 0); unpack8(k1, kv, 8);
        float dc[16];
#pragma unroll
        for (int cc = 0; cc < 16; ++cc) { const float b = la[cc]; const float bend = __shfl(b, 63); const float eb = exp_(b); dc[cc] = eb; qv[cc] *= eb; la[cc] = kv[cc] * exp_(bend - b); kv[cc] *= exp_(-b); }
        if (lane == 63) {
#pragma unroll
            for (int c4 = 0; c4 < 4; ++c4) *(GAS f32x4*)(rec + REC_DEC + (16 * w + 4 * c4) * 4) = (f32x4){dc[4 * c4], dc[4 * c4 + 1], dc[4 * c4 + 2], dc[4 * c4 + 3]}; }
        const u32x4 qa = packf8(qv, 0), qb = packf8(qv, 8), ka = packf8(kv, 0), kb = packf8(kv, 8), sa = packf8(la, 0), sb = packf8(la, 8);
        *(LAS u32x4*)(QT + row * 136 + 16 * w) = qa; *(LAS u32x4*)(QT + row * 136 + 16 * w + 8) = qb;
        *(LAS u32x4*)(KT + row * 136 + 16 * w) = ka; *(LAS u32x4*)(KT + row * 136 + 16 * w + 8) = kb;
        *(GAS u32x4*)(rec + row * 256 + (((2 * w) ^ (row & 15)) << 4)) = qa; *(GAS u32x4*)(rec + row * 256 + (((2 * w + 1) ^ (row & 15)) << 4)) = qb;
        *(GAS u32x4*)(rec + REC_KS + row * 256 + (((2 * w) ^ (2 * (row & 7))) << 4)) = sa; *(GAS u32x4*)(rec + REC_KS + row * 256 + (((2 * w + 1) ^ (2 * (row & 7))) << 4)) = sb;
    }
    __syncthreads();
#pragma unroll
    for (int rep = 0; rep < 2; ++rep) {
        const int tt = w + 8 * rep, jt = tt >> 2, it = tt & 3;
        f32x4 a = (f32x4){0.f, 0.f, 0.f, 0.f};
        if (jt <= it) {
#pragma unroll
            for (int k4 = 0; k4 < 4; ++k4) { const bf16x8 af = *(const LAS bf16x8*)(KT + (16 * jt + fr) * 136 + 32 * k4 + 8 * fq), bfr = *(const LAS bf16x8*)(QT + (16 * it + fr) * 136 + 32 * k4 + 8 * fq); a = MFMA16(af, bfr, a); }
        }
        const int i = 16 * it + fr, j0 = 16 * jt + 4 * fq;
        u32x2 o; o.x = cvt_pk_bf16(j0 <= i ? a[0] : 0.f, j0 + 1 <= i ? a[1] : 0.f); o.y = cvt_pk_bf16(j0 + 2 <= i ? a[2] : 0.f, j0 + 3 <= i ? a[3] : 0.f);
        *(LAS u32x2*)(AT + i * 72 + j0) = o;
    }
    __syncthreads();
    {
        const int dv0 = 32 * w;
        bf16x8 vb[2][2];
#pragma unroll
        for (int k2 = 0; k2 < 2; ++k2)
#pragma unroll
            for (int dt = 0; dt < 2; ++dt) { const LAS bf16_t* p = VS + (32 * k2 + 8 * fq + (fr >> 2)) * 264 + dv0 + 16 * dt + (fr & 3) * 4; vb[k2][dt] = cat8(tr16(p), tr16(p + 4 * 264)); }
#pragma unroll
        for (int tt = 0; tt < 4; ++tt) {
            const bf16x8 a0 = *(const LAS bf16x8*)(AT + (16 * tt + fr) * 72 + 8 * fq), a1 = *(const LAS bf16x8*)(AT + (16 * tt + fr) * 72 + 32 + 8 * fq);
#pragma unroll
            for (int dt = 0; dt < 2; ++dt) { f32x4 z = (f32x4){0.f, 0.f, 0.f, 0.f}; z = MFMA16(a0, vb[0][dt], z); z = MFMA16(a1, vb[1][dt], z);
                u32x2 pk; pk.x = cvt_pk_bf16(z[0], z[1]); pk.y = cvt_pk_bf16(z[2], z[3]); *(GAS u32x2*)(oi + ((w * 8 + tt * 2 + dt) * 64 + lane) * 8) = pk; }
        }
    }
}
constexpr int GSEG = 16, NSEG = 64 / GSEG;
constexpr int GL_STAGE = 50176, GL_DEC = 16384, GL_VS = 17408;
DI void gla_l_chain(LAS unsigned char* lds, const Ctx& c, int bl, int h, int seg) {
    const int tid = ltid(), lane = tid & 63, w = rfl(tid >> 6), fr = lane & 15, fq = lane >> 4;
    const size_t t0 = (size_t)bl * SEQ + (size_t)seg * (GSEG * 64);
    const bf16_t* VG = wsb(c, WS_H + H_VG) + t0 * 1024 + h * 256;
    const unsigned char* rec0 = c.ws + WS_REC + (size_t)((bl * 4 + h) * 64 + seg * GSEG) * REC_BYTES;
    const int dv0 = 32 * w; const unsigned lds_u = (unsigned)(uintptr_t)lds;
    f32x4 S[8][2], Dc[8];
#pragma unroll
    for (int a = 0; a < 8; ++a) { S[a][0] = (f32x4){0.f, 0.f, 0.f, 0.f}; S[a][1] = (f32x4){0.f, 0.f, 0.f, 0.f}; Dc[a] = (f32x4){1.f, 1.f, 1.f, 1.f}; }
#define GL_DMA(gp, ldsoff) do { unsigned _sv; const unsigned _m = (unsigned)__builtin_amdgcn_readfirstlane((int)(ldsoff)); \
        asm volatile("s_mov_b32 %0, m0\n\ts_mov_b32 m0, %2\n\ts_nop 0\n\tglobal_load_lds_dwordx4 %1, off\n\ts_mov_b32 m0, %0" : "=&s"(_sv) : "v"(gp), "s"(_m) : "memory"); } while (0)
#define GL_PREFETCH(nn, st) do { const unsigned char* _r = rec0 + (size_t)(nn) * REC_BYTES + REC_KS; const unsigned _s = lds_u + (unsigned)(st) * GL_STAGE; \
        _Pragma("unroll") for (int _p = 0; _p < 2; ++_p) GL_DMA((const GAS unsigned char*)(_r + (w * 2 + _p) * 1024 + lane * 16), _s + (w * 2 + _p) * 1024); \
        if (w == 0) GL_DMA((const GAS unsigned char*)(_r + 16384 + lane * 16), _s + GL_DEC); \
        _Pragma("unroll") for (int _p = 0; _p < 4; ++_p) { const int _row = 2 * (w * 4 + _p) + (lane >> 5); \
            GL_DMA((const GAS bf16_t*)(VG + (size_t)((nn) * 64 + _row) * 1024 + (((lane & 31) ^ (2 * (_row & 3))) << 3)), _s + GL_VS + (w * 4 + _p) * 1024); } } while (0)
    __syncthreads();
    GL_PREFETCH(0, 0);
    for (int n = 0; n < GSEG; ++n) {
        const int st = n & 1; LAS unsigned char* sb_ = lds + st * GL_STAGE;
        LAS bf16_t* KS = (LAS bf16_t*)sb_; LAS float* DEC = (LAS float*)(sb_ + GL_DEC); LAS bf16_t* VS = (LAS bf16_t*)(sb_ + GL_VS);
        VM_WAIT(); asm volatile("s_waitcnt lgkmcnt(0)" ::: "memory"); __builtin_amdgcn_s_barrier(); asm volatile("" ::: "memory");
        if (n + 1 < GSEG) GL_PREFETCH(n + 1, st ^ 1);
        bf16x8 vb[2][2];
#pragma unroll
        for (int k2 = 0; k2 < 2; ++k2)
#pragma unroll
            for (int dt = 0; dt < 2; ++dt) { const int r0 = 32 * k2 + 8 * fq + (fr >> 2);
                const LAS bf16_t* p = VS + r0 * 256 + ((((dv0 + 16 * dt) >> 3) ^ (2 * (r0 & 3))) << 3) + (fr & 3) * 4; vb[k2][dt] = cat8(tr16(p), tr16(p + 4 * 256)); }
#pragma unroll
        for (int k8 = 0; k8 < 8; ++k8) {
            const f32x4 dc = *(const LAS f32x4*)(DEC + 16 * k8 + 4 * fq);
            S[k8][0] *= dc; S[k8][1] *= dc; Dc[k8] *= dc;
#pragma unroll
            for (int k2 = 0; k2 < 2; ++k2) { const int r0 = 32 * k2 + 8 * fq + (fr >> 2);
                const LAS bf16_t* p0 = KS + r0 * 128 + (((2 * k8) ^ (2 * (r0 & 7))) << 3) + (fr & 3) * 4; const LAS bf16_t* p1 = KS + (r0 + 4) * 128 + (((2 * k8) ^ (2 * ((r0 + 4) & 7))) << 3) + (fr & 3) * 4;
                const bf16x8 af = cat8(tr16(p0), tr16(p1));
                S[k8][0] = MFMA16(af, vb[k2][0], S[k8][0]); S[k8][1] = MFMA16(af, vb[k2][1], S[k8][1]); }
        }
    }
#undef GL_PREFETCH
#undef GL_DMA
    const int cj = (bl * 4 + h) * NSEG + seg;
    GAS f32x4* sl = (GAS f32x4*)(c.ws + WS_SLOC) + ((size_t)(cj * 8 + w) * 16) * 64 + lane;
#pragma unroll
    for (int a = 0; a < 8; ++a) { sl[(a * 2) * 64] = S[a][0]; sl[(a * 2 + 1) * 64] = S[a][1]; }
    if (w == 0) { GAS f32x4* dq = (GAS f32x4*)(c.ws + WS_DCUM) + (size_t)cj * 8 * 64 + lane;
#pragma unroll
        for (int a = 0; a < 8; ++a) dq[a * 64] = Dc[a]; }
    VM_WAIT(); __syncthreads();
}
constexpr int GS_STAGE = 66560, GS_KS = 16384, GS_DEC = 32768, GS_VS = 33792, GS_SS = 2 * GS_STAGE;
DI void gla_s_chain(LAS unsigned char* lds, const Ctx& c, int l, int bl, int h, int seg) {
    const int tid = ltid(), lane = tid & 63, w = rfl(tid >> 6), fr = lane & 15, fq = lane >> 4;
    const size_t t0 = (size_t)bl * SEQ + (size_t)seg * (GSEG * 64);
    const bf16_t* VG = wsb(c, WS_H + H_VG) + t0 * 1024 + h * 256;
    const bf16_t* SR = wsb(c, WS_H + H_SR) + t0 * 1024 + h * 256;
    bf16_t* OG = wsb(c, WS_OG) + t0 * 1024 + h * 256;
    const unsigned char* rec0 = c.ws + WS_REC + (size_t)((bl * 4 + h) * 64 + seg * GSEG) * REC_BYTES;
    const unsigned char* oi0 = c.ws + WS_MIX + (size_t)((bl * 4 + h) * 64 + seg * GSEG) * OI_BYTES;
    LAS float* SS = (LAS float*)(lds + GS_SS);
    const int dv0 = 32 * w;
    const float gn0 = c.gla_norm[l * 1024 + h * 256 + dv0 + fr], gn1 = c.gla_norm[l * 1024 + h * 256 + dv0 + 16 + fr];
    f32x4 S[8][2];
#pragma unroll
    for (int a = 0; a < 8; ++a) { S[a][0] = (f32x4){0.f, 0.f, 0.f, 0.f}; S[a][1] = (f32x4){0.f, 0.f, 0.f, 0.f}; }
    for (int j = 0; j < seg; ++j) {
        const int cj = (bl * 4 + h) * NSEG + j;
        const GAS f32x4* sl = (const GAS f32x4*)(c.ws + WS_SLOC) + ((size_t)(cj * 8 + w) * 16) * 64 + lane; const GAS f32x4* dq = (const GAS f32x4*)(c.ws + WS_DCUM) + (size_t)cj * 8 * 64 + lane;
#pragma unroll
        for (int a = 0; a < 8; ++a) { const f32x4 dcv = dq[a * 64]; S[a][0] = S[a][0] * dcv + sl[(a * 2) * 64]; S[a][1] = S[a][1] * dcv + sl[(a * 2 + 1) * 64]; }
    }
#define GS_DMA(gp, ldsoff) do { unsigned _sv; const unsigned _m = (unsigned)__builtin_amdgcn_readfirstlane((int)(ldsoff)); \
        asm volatile("s_mov_b32 %0, m0\n\ts_mov_b32 m0, %2\n\ts_nop 0\n\tglobal_load_lds_dwordx4 %1, off\n\ts_mov_b32 m0, %0" : "=&s"(_sv) : "v"(gp), "s"(_m) : "memory"); } while (0)
#define GS_PREFETCH(nn, st) do { const unsigned char* _r = rec0 + (size_t)(nn) * REC_BYTES; const unsigned _s = lds_u + (unsigned)(st) * GS_STAGE; \
        _Pragma("unroll") for (int _p = 0; _p < 4; ++_p) GS_DMA((const GAS unsigned char*)(_r + (w * 4 + _p) * 1024 + lane * 16), _s + (w * 4 + _p) * 1024); \
        if (w == 0) GS_DMA((const GAS unsigned char*)(_r + 32768 + lane * 16), _s + 32768); \
        _Pragma("unroll") for (int _p = 0; _p < 4; ++_p) { const int _row = 2 * (w * 4 + _p) + (lane >> 5); \
            GS_DMA((const GAS bf16_t*)(VG + (size_t)((nn) * 64 + _row) * 1024 + (((lane & 31) ^ (2 * (_row & 3))) << 3)), _s + GS_VS + (w * 4 + _p) * 1024); } } while (0)
    const unsigned lds_u = (unsigned)(uintptr_t)lds;
#define GS_BAR() do { asm volatile("s_waitcnt lgkmcnt(0)" ::: "memory"); __builtin_amdgcn_s_barrier(); asm volatile("" ::: "memory"); } while (0)
    __syncthreads();
    GS_PREFETCH(0, 0);
    for (int n = 0; n < GSEG; ++n) {
        const int st = n & 1; LAS unsigned char* sb_ = lds + st * GS_STAGE;
        LAS bf16_t* QT = (LAS bf16_t*)sb_; LAS bf16_t* KS = (LAS bf16_t*)(sb_ + GS_KS); LAS float* DEC = (LAS float*)(sb_ + GS_DEC); LAS bf16_t* VS = (LAS bf16_t*)(sb_ + GS_VS); LAS bf16_t* OST = (LAS bf16_t*)(sb_ + GS_KS);
        VM_WAIT(); GS_BAR();
        u32x2 oiv[8];
#pragma unroll
        for (int q = 0; q < 8; ++q) oiv[q] = *(const GAS u32x2*)(oi0 + (size_t)n * OI_BYTES + ((w * 8 + q) * 64 + lane) * 8);
        u32x4 srv[4];
#pragma unroll
        for (int c2 = 0; c2 < 4; ++c2) { const int idx = tid + NTHREADS * c2, r = idx >> 5, ch = idx & 31; srv[c2] = *(const GAS u32x4*)(SR + (size_t)(n * 64 + r) * 1024 + ch * 8); }
        asm volatile("" ::: "memory");
        if (n + 1 < GSEG) GS_PREFETCH(n + 1, st ^ 1);
        f32x4 o[4][2];
        {
            bf16x8 vb[2][2];
#pragma unroll
            for (int k2 = 0; k2 < 2; ++k2)
#pragma unroll
                for (int dt = 0; dt < 2; ++dt) { const int r0 = 32 * k2 + 8 * fq + (fr >> 2);
                    const LAS bf16_t* p = VS + r0 * 256 + ((((dv0 + 16 * dt) >> 3) ^ (2 * (r0 & 3))) << 3) + (fr & 3) * 4; vb[k2][dt] = cat8(tr16(p), tr16(p + 4 * 256)); }
#pragma unroll
            for (int tt = 0; tt < 4; ++tt) { o[tt][0] = (f32x4){0.f, 0.f, 0.f, 0.f}; o[tt][1] = (f32x4){0.f, 0.f, 0.f, 0.f}; }
#pragma unroll
            for (int s = 0; s < 4; ++s) {
                bf16x8 sb[2];
#pragma unroll
                for (int dt = 0; dt < 2; ++dt) { u32x4 pk; pk.x = cvt_pk_bf16(S[2 * s][dt][0], S[2 * s][dt][1]); pk.y = cvt_pk_bf16(S[2 * s][dt][2], S[2 * s][dt][3]); pk.z = cvt_pk_bf16(S[2 * s + 1][dt][0], S[2 * s + 1][dt][1]); pk.w = cvt_pk_bf16(S[2 * s + 1][dt][2], S[2 * s + 1][dt][3]); sb[dt] = __builtin_bit_cast(bf16x8, pk); }
#pragma unroll
                for (int tt = 0; tt < 4; ++tt) { const int i = 16 * tt + fr;
                    const LAS bf16_t* qp = QT + i * 128 + (fq & 1) * 4;
                    const bf16x8 af = cat8(*(const LAS s16x4*)(qp + (((4 * s + (fq >> 1)) ^ (i & 15)) << 3)), *(const LAS s16x4*)(qp + (((4 * s + 2 + (fq >> 1)) ^ (i & 15)) << 3)));
                    o[tt][0] = MFMA16(af, sb[0], o[tt][0]); o[tt][1] = MFMA16(af, sb[1], o[tt][1]); }
            }
#pragma unroll
            for (int k8 = 0; k8 < 8; ++k8) {
                const f32x4 dc = *(const LAS f32x4*)(DEC + 16 * k8 + 4 * fq);
                S[k8][0] *= dc; S[k8][1] *= dc;
#pragma unroll
                for (int k2 = 0; k2 < 2; ++k2) { const int r0 = 32 * k2 + 8 * fq + (fr >> 2);
                    const LAS bf16_t* p0 = KS + r0 * 128 + (((2 * k8) ^ (2 * (r0 & 7))) << 3) + (fr & 3) * 4; const LAS bf16_t* p1 = KS + (r0 + 4) * 128 + (((2 * k8) ^ (2 * ((r0 + 4) & 7))) << 3) + (fr & 3) * 4;
                    const bf16x8 af = cat8(tr16(p0), tr16(p1));
                    S[k8][0] = MFMA16(af, vb[k2][0], S[k8][0]); S[k8][1] = MFMA16(af, vb[k2][1], S[k8][1]); }
            }
        }
#pragma unroll
        for (int tt = 0; tt < 4; ++tt)
#pragma unroll
            for (int dt = 0; dt < 2; ++dt) { const u32x2 v = oiv[tt * 2 + dt]; o[tt][dt][0] += bf_lo(v.x); o[tt][dt][1] += bf_hi(v.x); o[tt][dt][2] += bf_lo(v.y); o[tt][dt][3] += bf_hi(v.y); }
#pragma unroll
        for (int tt = 0; tt < 4; ++tt) { f32x4 pp;
#pragma unroll
            for (int rg = 0; rg < 4; ++rg) { float p = o[tt][0][rg] * o[tt][0][rg] + o[tt][1][rg] * o[tt][1][rg];
                p += __shfl_xor(p, 1); p += __shfl_xor(p, 2); p += __shfl_xor(p, 4); p += __shfl_xor(p, 8); pp[rg] = p; }
            if (fr == 0) *(LAS f32x4*)(SS + w * 64 + 16 * tt + 4 * fq) = pp; }
        GS_BAR();
#pragma unroll
        for (int tt = 0; tt < 4; ++tt) { f32x4 ss = *(const LAS f32x4*)(SS + 16 * tt + 4 * fq);
#pragma unroll
            for (int ww = 1; ww < 8; ++ww) ss += *(const LAS f32x4*)(SS + ww * 64 + 16 * tt + 4 * fq);
#pragma unroll
            for (int rg = 0; rg < 4; ++rg) { const float rs = __builtin_amdgcn_rsqf(ss[rg] * (1.0f / 256.0f) + RMS_EPS); const int i = 16 * tt + 4 * fq + rg;
                OST[i * 264 + dv0 + fr] = (bf16_t)(cvt_pk_bf16(o[tt][0][rg] * rs * gn0, 0.f) & 0xffffu); OST[i * 264 + dv0 + 16 + fr] = (bf16_t)(cvt_pk_bf16(o[tt][1][rg] * rs * gn1, 0.f) & 0xffffu); } }
        GS_BAR();
#pragma unroll
        for (int c2 = 0; c2 < 4; ++c2) { const int idx = tid + NTHREADS * c2, r = idx >> 5, ch = idx & 31;
            const u32x4 ov = *(const LAS u32x4*)(OST + r * 264 + ch * 8); const u32x4 sv = srv[c2];
            u32x4 rr; rr.x = cvt_pk_bf16(bf_lo(ov.x) * bf_lo(sv.x), bf_hi(ov.x) * bf_hi(sv.x)); rr.y = cvt_pk_bf16(bf_lo(ov.y) * bf_lo(sv.y), bf_hi(ov.y) * bf_hi(sv.y));
            rr.z = cvt_pk_bf16(bf_lo(ov.z) * bf_lo(sv.z), bf_hi(ov.z) * bf_hi(sv.z)); rr.w = cvt_pk_bf16(bf_lo(ov.w) * bf_lo(sv.w), bf_hi(ov.w) * bf_hi(sv.w));
            *(GAS u32x4*)(OG + (size_t)(n * 64 + r) * 1024 + ch * 8) = rr; }
    }
#undef GS_PREFETCH
#undef GS_DMA
#undef GS_BAR
    VM_WAIT(); __syncthreads();
}

constexpr int AT_K = 0, AT_V = 36864;
DI void attn_unit(LAS unsigned char* lds, const Ctx& c, int bl, int g, int h, int x) {
    const int tid = ltid(), lane = tid & 63, w = rfl(tid >> 6), fr = lane & 15, fq = lane >> 4;
    const int dl = (g == 0) ? 1 : (g == 1 ? 4 : 16), nb = 32 / dl, r = x / nb, n = x - r * nb;
    const size_t tb = (size_t)bl * SEQ + r; const int colo = g * 512 + h * 64;
    const bf16_t* Q = wsb(c, WS_H + H_QD) + colo; const bf16_t* K = wsb(c, WS_H + H_KD) + colo; const bf16_t* V = wsb(c, WS_H + H_VD) + colo;
    LAS bf16_t* Ks = (LAS bf16_t*)(lds + AT_K); LAS bf16_t* Vs = (LAS bf16_t*)(lds + AT_V);
    const size_t tokq = tb + (size_t)dl * (128 * n + 16 * w + fr);
    bf16x8 qf[2];
#pragma unroll
    for (int d0 = 0; d0 < 2; ++d0) qf[d0] = *(const GAS bf16x8*)(Q + tokq * 1536 + 32 * d0 + 8 * fq);
    __syncthreads();
#pragma unroll
    for (int c2 = 0; c2 < 4; ++c2) { const int idx = tid + NTHREADS * c2, row = idx >> 3, ch = idx & 7; const int j = 128 * (n - 1) + row;
        u32x4 kv = (u32x4){0u, 0u, 0u, 0u}, vv = (u32x4){0u, 0u, 0u, 0u};
        if (j >= 0) { const size_t tok = tb + (size_t)dl * j; kv = *(const GAS u32x4*)(K + tok * 1536 + ch * 8); vv = *(const GAS u32x4*)(V + tok * 1536 + ch * 8); }
        *(LAS u32x4*)(Ks + row * 72 + ch * 8) = kv; *(LAS u32x4*)(Vs + row * 72 + ch * 8) = vv; }
    __syncthreads();
    f32x4 s[9]; float m = -1e30f;
#pragma unroll
    for (int kr = 0; kr < 9; ++kr) { const int kt = w + kr; f32x4 a = (f32x4){0.f, 0.f, 0.f, 0.f};
#pragma unroll
        for (int d0 = 0; d0 < 2; ++d0) { const bf16x8 af = *(const LAS bf16x8*)(Ks + (16 * kt + fr) * 72 + 32 * d0 + 8 * fq); a = MFMA16(af, qf[d0], a); }
#pragma unroll
        for (int rg = 0; rg < 4; ++rg) { const int rel = 16 * kr + 4 * fq + rg - fr; const bool ok = rel >= 0 && rel <= 128 && (n > 0 || 16 * kt + 4 * fq + rg >= 128); a[rg] = ok ? a[rg] : -1e30f; m = fmaxf(m, a[rg]); }
        s[kr] = a; }
    m = fmaxf(m, __shfl_xor(m, 16)); m = fmaxf(m, __shfl_xor(m, 32));
    float lsum = 0.f;
#pragma unroll
    for (int kr = 0; kr < 9; ++kr)
#pragma unroll
        for (int rg = 0; rg < 4; ++rg) { const float p = s[kr][rg] > -1e29f ? __builtin_amdgcn_exp2f(s[kr][rg] - m) : 0.f; s[kr][rg] = p; lsum += p; }
    lsum += __shfl_xor(lsum, 16); lsum += __shfl_xor(lsum, 32);
    f32x4 oT[4];
#pragma unroll
    for (int dt = 0; dt < 4; ++dt) oT[dt] = (f32x4){0.f, 0.f, 0.f, 0.f};
#pragma unroll
    for (int pp = 0; pp < 5; ++pp) { const int ka = 2 * pp, kb = (2 * pp + 1 < 9) ? 2 * pp + 1 : 8;
        u32x4 pk; pk.x = cvt_pk_bf16(s[ka][0], s[ka][1]); pk.y = cvt_pk_bf16(s[ka][2], s[ka][3]);
        if (2 * pp + 1 < 9) { pk.z = cvt_pk_bf16(s[kb][0], s[kb][1]); pk.w = cvt_pk_bf16(s[kb][2], s[kb][3]); } else { pk.z = 0u; pk.w = 0u; }
        const bf16x8 pf = __builtin_bit_cast(bf16x8, pk);
#pragma unroll
        for (int dt = 0; dt < 4; ++dt) { const LAS bf16_t* pa = Vs + (16 * (w + ka) + 4 * fq + (fr >> 2)) * 72 + 16 * dt + (fr & 3) * 4; const LAS bf16_t* pb = Vs + (16 * (w + kb) + 4 * fq + (fr >> 2)) * 72 + 16 * dt + (fr & 3) * 4;
            oT[dt] = MFMA16(cat8(tr16(pa), tr16(pb)), pf, oT[dt]); } }
    const float inv = 1.0f / lsum; const size_t tq = tb + (size_t)dl * (128 * n + 16 * w + fr);
    bf16_t* op = wsb(c, WS_ATTG) + ((size_t)g * TH + tq) * 512 + h * 64 + 4 * fq;
#pragma unroll
    for (int dt = 0; dt < 4; ++dt) { u32x2 o; o.x = cvt_pk_bf16(oT[dt][0] * inv, oT[dt][1] * inv); o.y = cvt_pk_bf16(oT[dt][2] * inv, oT[dt][3] * inv); *(GAS u32x2*)(op + 16 * dt) = o; }
    if (fq == 0) ((float*)(c.ws + WS_LSE))[((size_t)g * TH + tq) * 8 + h] = m + __builtin_amdgcn_logf(lsum);
}
DI void phase_p(LAS unsigned char* lds, const Ctx& c, int l, int G) {
    int h_loaded = -1;
    for (int u = lbid(); u < 8 * 4 * 64; u += G) gla_p_unit(lds, c, l, u >> 8, (u >> 6) & 3, u & 63, h_loaded);
}
constexpr int NATT = 8 * 3 * 8 * 32, NATT1 = 2304, NCHAIN = 8 * 4 * NSEG;
DI void attn_pull(LAS unsigned char* lds, const Ctx& c, unsigned* ctr, int base, int limit) {
    volatile LAS int* TK = (volatile LAS int*)(lds + MISC_OFF + 192);
    const int tid = ltid();
    __syncthreads();
    if (tid == 0) TK[0] = base + (int)__hip_atomic_fetch_add(ctr, 1u, __ATOMIC_RELAXED, __HIP_MEMORY_SCOPE_AGENT);
    __syncthreads();
    int u = rfl(TK[0]);
    while (u < limit) {
        int nxt = 0; if (tid == 0) nxt = base + (int)__hip_atomic_fetch_add(ctr, 1u, __ATOMIC_RELAXED, __HIP_MEMORY_SCOPE_AGENT);
        attn_unit(lds, c, u / 768, (u / 256) % 3, (u >> 5) & 7, u & 31);
        __syncthreads();
        if (tid == 0) TK[0] = nxt;
        __syncthreads();
        u = rfl(TK[0]);
    }
}
DI void phase_b1(LAS unsigned char* lds, const Ctx& c, int l, int hf, int G) {
    const int bid = lbid(); unsigned* ctr = (unsigned*)(c.ws + WS_CTL) + CW_TKT + ((l * 2 + hf) * 2) * 64;
    for (int id = bid; id < NCHAIN; id += G) gla_l_chain(lds, c, id >> 4, (id >> 2) & 3, id & 3);
    attn_pull(lds, c, ctr, 0, NATT1);
}
DI void phase_b(LAS unsigned char* lds, const Ctx& c, int l, int hf, int G) {
    const int bid = lbid(); unsigned* ctr = (unsigned*)(c.ws + WS_CTL) + CW_TKT + ((l * 2 + hf) * 2 + 1) * 64;
    for (int id = bid; id < NCHAIN; id += G) gla_s_chain(lds, c, l, id >> 4, (id >> 2) & 3, id & 3);
    attn_pull(lds, c, ctr, NATT1, NATT);
}
DI void phase_f(const Ctx& c, int G) {
    const bf16_t* ag = wsb(c, WS_ATTG); const float* lse = (const float*)(c.ws + WS_LSE); bf16_t* att = wsb(c, WS_ATT);
    for (size_t i = (size_t)lbid() * NTHREADS + ltid(); i < (size_t)TH * 64; i += (size_t)G * NTHREADS) {
        const size_t tok = i >> 6; const int ch = (int)(i & 63), h = ch >> 3;
        const float l0 = lse[tok * 8 + h], l1 = lse[((size_t)TH + tok) * 8 + h], l2 = lse[((size_t)2 * TH + tok) * 8 + h];
        const float mx = fmaxf(l0, fmaxf(l1, l2)); float w0 = __builtin_amdgcn_exp2f(l0 - mx), w1 = __builtin_amdgcn_exp2f(l1 - mx), w2 = __builtin_amdgcn_exp2f(l2 - mx);
        const float inv = 1.0f / (w0 + w1 + w2); w0 *= inv; w1 *= inv; w2 *= inv;
        const u32x4 a = *(const GAS u32x4*)(ag + tok * 512 + ch * 8), b = *(const GAS u32x4*)(ag + ((size_t)TH + tok) * 512 + ch * 8), d = *(const GAS u32x4*)(ag + ((size_t)2 * TH + tok) * 512 + ch * 8);
        u32x4 o;
        o.x = cvt_pk_bf16(w0 * bf_lo(a.x) + w1 * bf_lo(b.x) + w2 * bf_lo(d.x), w0 * bf_hi(a.x) + w1 * bf_hi(b.x) + w2 * bf_hi(d.x));
        o.y = cvt_pk_bf16(w0 * bf_lo(a.y) + w1 * bf_lo(b.y) + w2 * bf_lo(d.y), w0 * bf_hi(a.y) + w1 * bf_hi(b.y) + w2 * bf_hi(d.y));
        o.z = cvt_pk_bf16(w0 * bf_lo(a.z) + w1 * bf_lo(b.z) + w2 * bf_lo(d.z), w0 * bf_hi(a.z) + w1 * bf_hi(b.z) + w2 * bf_hi(d.z));
        o.w = cvt_pk_bf16(w0 * bf_lo(a.w) + w1 * bf_lo(b.w) + w2 * bf_lo(d.w), w0 * bf_hi(a.w) + w1 * bf_hi(b.w) + w2 * bf_hi(d.w));
        *(GAS u32x4*)(att + tok * 512 + ch * 8) = o;
    }
}

DI float wave_sum(float v) {
#pragma unroll
    for (int o = 1; o < 64; o <<= 1) v += __shfl_xor(v, o);
    return v;
}
constexpr int R_WR = 0, R_HIST = 65536, R_BASE = 65536 + 64, R_INFO = 65536 + 128;
DI void phase_r(LAS unsigned char* lds, const Ctx& c, int l, int G) {
    const int tid = ltid(), lane = tid & 63, wave = rfl(tid >> 6);
    LAS float* WR = (LAS float*)(lds + R_WR); volatile LAS int* HIST = (volatile LAS int*)(lds + R_HIST); volatile LAS int* BASE = (volatile LAS int*)(lds + R_BASE); volatile LAS int* INFO = (volatile LAS int*)(lds + R_INFO);
    __syncthreads();
    for (int i = tid; i < 16 * 1024; i += NTHREADS) WR[(i & 15) * 1024 + (i >> 4)] = c.w_router[i];
    f32x4 g4[4], b4[4];
#pragma unroll
    for (int j = 0; j < 4; ++j) { g4[j] = *(const GAS f32x4*)(c.ln1_g + l * D + 4 * lane + 256 * j); b4[j] = *(const GAS f32x4*)(c.ln1_b + l * D + 4 * lane + 256 * j); }
    bf16_t* xr = wsb(c, WS_XR); unsigned char* xb = c.ws + WS_XB; int* histg = (int*)(c.ws + WS_HISTG); float* gate = (float*)(c.ws + WS_GATE);
    for (int chunk = lbid(); chunk < T / 256; chunk += G) {
        __syncthreads();
        for (int rr = 0; rr < 32; ++rr) {
            const int rl = wave * 32 + rr; const size_t row = (size_t)chunk * 256 + rl;
            f32x4 v[4]; float s = 0.f;
#pragma unroll
            for (int j = 0; j < 4; ++j) { const u32x2 zq = *(const GAS u32x2*)(xr + row * D + 4 * lane + 256 * j); v[j] = (f32x4){bf_lo(zq.x), bf_hi(zq.x), bf_lo(zq.y), bf_hi(zq.y)}; s += (v[j][0] + v[j][1]) + (v[j][2] + v[j][3]); }
            const float mean = wave_sum(s) * (1.0f / D); float s2 = 0.f;
#pragma unroll
            for (int j = 0; j < 4; ++j) { v[j] = v[j] - mean; s2 += (v[j][0] * v[j][0] + v[j][1] * v[j][1]) + (v[j][2] * v[j][2] + v[j][3] * v[j][3]); }
            const float rstd = __builtin_amdgcn_rsqf(wave_sum(s2) * (1.0f / D) + LN_EPS);
#pragma unroll
            for (int j = 0; j < 4; ++j) { v[j] = v[j] * rstd * g4[j] + b4[j]; u32x2 xq; xq.x = cvt_pk_bf16(v[j][0], v[j][1]); xq.y = cvt_pk_bf16(v[j][2], v[j][3]); *(GAS u32x2*)(xr + row * D + 4 * lane + 256 * j) = xq;
                *(GAS unsigned*)(xb + row * D + 4 * lane + 256 * j) = pk4_fp8(v[j][0], v[j][1], v[j][2], v[j][3]); }
            float lg[16];
#pragma unroll
            for (int e = 0; e < 16; ++e) { float a = 0.f;
#pragma unroll
                for (int j = 0; j < 4; ++j) { const f32x4 wv = *(const LAS f32x4*)(WR + e * 1024 + 4 * lane + 256 * j); a += v[j][0] * wv[0] + v[j][1] * wv[1] + v[j][2] * wv[2] + v[j][3] * wv[3]; }
                lg[e] = wave_sum(a) + c.b_router[e]; }
            float mx = lg[0];
#pragma unroll
            for (int e = 1; e < 16; ++e) mx = fmaxf(mx, lg[e]);
            float se = 0.f;
#pragma unroll
            for (int e = 0; e < 16; ++e) { lg[e] = __expf(lg[e] - mx); se += lg[e]; }
            const float ise = 1.0f / se;
#pragma unroll
            for (int e = 0; e < 16; ++e) lg[e] *= ise;
            int gsel = 0; float gbest = -1.f;
#pragma unroll
            for (int gi = 0; gi < 4; ++gi) { const float a = lg[4 * gi], b = lg[4 * gi + 1], cc = lg[4 * gi + 2], d = lg[4 * gi + 3];
                const float sc = (a + b + cc + d) - fminf(fminf(a, b), fminf(cc, d)) - fminf(fmaxf(fminf(a, b), fminf(cc, d)), fminf(fmaxf(a, b), fmaxf(cc, d)));
                if (sc > gbest) { gbest = sc; gsel = gi; } }
            float p[4];
#pragma unroll
            for (int k = 0; k < 4; ++k) p[k] = gsel == 0 ? lg[k] : gsel == 1 ? lg[4 + k] : gsel == 2 ? lg[8 + k] : lg[12 + k];
            int i0 = 0; float v0 = p[0];
#pragma unroll
            for (int k = 1; k < 4; ++k) if (p[k] > v0) { v0 = p[k]; i0 = k; }
            int i1 = -1; float v1 = -1.f;
#pragma unroll
            for (int k = 0; k < 4; ++k) if (k != i0 && p[k] > v1) { v1 = p[k]; i1 = k; }
            if (lane == 0) { const int e0 = 4 * gsel + i0, e1 = 4 * gsel + i1; INFO[rl * 4 + 0] = e0; INFO[rl * 4 + 1] = e1;
                const float gs = 1.0f / (v0 + v1); gate[row * 2] = v0 * gs; gate[row * 2 + 1] = v1 * gs; }
        }
        __syncthreads();
        {
            int cnt0 = 0, cnt1 = 0; const unsigned long long lt = (1ull << lane) - 1ull;
#pragma unroll
            for (int b = 0; b < 4; ++b) { const int r = 64 * b + lane; const int e0 = INFO[r * 4], e1 = INFO[r * 4 + 1];
                const bool a0 = (e0 == 2 * wave) || (e1 == 2 * wave), a1 = (e0 == 2 * wave + 1) || (e1 == 2 * wave + 1);
                const unsigned long long m0 = __ballot(a0), m1 = __ballot(a1);
                if (a0) INFO[r * 4 + (e0 == 2 * wave ? 2 : 3)] = cnt0 + __popcll(m0 & lt);
                if (a1) INFO[r * 4 + (e0 == 2 * wave + 1 ? 2 : 3)] = cnt1 + __popcll(m1 & lt);
                cnt0 += __popcll(m0); cnt1 += __popcll(m1); }
            if (lane == 0) { histg[chunk * 16 + 2 * wave] = cnt0; histg[chunk * 16 + 2 * wave + 1] = cnt1; }
        }
        __syncthreads();
        if (tid < 256) { i32x4 v; v.x = INFO[tid * 4]; v.y = INFO[tid * 4 + 1]; v.z = INFO[tid * 4 + 2]; v.w = INFO[tid * 4 + 3]; ((GAS i32x4*)(c.ws + WS_INFO))[(size_t)chunk * 256 + tid] = v; }
        __syncthreads();
    }
}
DI void phase_r2(LAS unsigned char* lds, const Ctx& c, int l, int G) {
    const int tid = ltid(); volatile LAS int* BASE = (volatile LAS int*)(lds + R_BASE);
    const int* histg = (const int*)(c.ws + WS_HISTG); int* list = (int*)(c.ws + WS_LIST);
    unsigned* cur = (unsigned*)(c.ws + WS_CTL) + CW_CUR + l * 16 * 64;
    for (int chunk = lbid(); chunk < T / 256; chunk += G) {
        __syncthreads();
        if (tid < 16) BASE[tid] = 0;
        __syncthreads();
        { const int e = tid & 15; int s = 0; for (int cc = tid >> 4; cc < chunk; cc += 32) s += histg[cc * 16 + e]; if (s) atomicAdd((int*)&BASE[e], s); }
        __syncthreads();
        if (tid < 256) { const i32x4 v = ((const GAS i32x4*)(c.ws + WS_INFO))[(size_t)chunk * 256 + tid]; const int row = chunk * 256 + tid;
            list[(size_t)v.x * T + BASE[v.x] + v.z] = row * 2; list[(size_t)v.y * T + BASE[v.y] + v.w] = row * 2 + 1; }
        if (chunk == T / 256 - 1 && tid < 16) __hip_atomic_store(cur + tid * 64, (unsigned)(BASE[tid] + histg[chunk * 16 + tid]), __ATOMIC_RELAXED, __HIP_MEMORY_SCOPE_AGENT);
    }
}
DI int moe_setup(LAS unsigned char* lds, const Ctx& c, int l) {
    volatile LAS int* PRE = (volatile LAS int*)(lds + MISC_OFF); volatile LAS int* CNT = PRE + 17;
    unsigned* cur = (unsigned*)(c.ws + WS_CTL) + CW_CUR + l * 16 * 64;
    __syncthreads();
    if (threadIdx.x == 0) { int acc = 0; for (int e = 0; e < 16; ++e) { const int n = (int)__hip_atomic_load(cur + e * 64, __ATOMIC_RELAXED, __HIP_MEMORY_SCOPE_AGENT); PRE[e] = acc; CNT[e] = n; acc += (n + 255) >> 8; } PRE[16] = acc; }
    __syncthreads();
    return rfl(PRE[16]);
}
DI void phase_c(const Ctx& c, int l, int G) {
    const int tid = ltid(), lane = tid & 63, wave = rfl(tid >> 6);
    f32x4 g4[4], b4[4];
#pragma unroll
    for (int j = 0; j < 4; ++j) { g4[j] = *(const GAS f32x4*)(c.ln2_g + l * D + 4 * lane + 256 * j); b4[j] = *(const GAS f32x4*)(c.ln2_b + l * D + 4 * lane + 256 * j); }
    float* xo = c.out; bf16_t* xr = wsb(c, WS_XR); unsigned char* xb = c.ws + WS_XB; const unsigned char* ys = c.ws + WS_YS; const float* gate = (const float*)(c.ws + WS_GATE);
    for (size_t row = (size_t)lbid() * NWAVES + wave; row < (size_t)T; row += (size_t)G * NWAVES) {
        const float g0 = gate[row * 2], g1 = gate[row * 2 + 1];
        f32x4 v[4]; float s = 0.f;
#pragma unroll
        for (int j = 0; j < 4; ++j) { const u32x2 xq = *(const GAS u32x2*)(xr + row * D + 4 * lane + 256 * j);
            const unsigned y0 = *(const GAS unsigned*)(ys + (row * 2) * D + 4 * lane + 256 * j), y1 = *(const GAS unsigned*)(ys + (row * 2 + 1) * D + 4 * lane + 256 * j);
            const f32x2 y0a = __builtin_amdgcn_cvt_pk_f32_fp8((int)y0, false), y0b = __builtin_amdgcn_cvt_pk_f32_fp8((int)y0, true), y1a = __builtin_amdgcn_cvt_pk_f32_fp8((int)y1, false), y1b = __builtin_amdgcn_cvt_pk_f32_fp8((int)y1, true);
            v[j][0] = bf_lo(xq.x) * DN_ALPHA + g0 * y0a[0] + g1 * y1a[0]; v[j][1] = bf_hi(xq.x) * DN_ALPHA + g0 * y0a[1] + g1 * y1a[1];
            v[j][2] = bf_lo(xq.y) * DN_ALPHA + g0 * y0b[0] + g1 * y1b[0]; v[j][3] = bf_hi(xq.y) * DN_ALPHA + g0 * y0b[1] + g1 * y1b[1];
            s += (v[j][0] + v[j][1]) + (v[j][2] + v[j][3]); }
        const float mean = wave_sum(s) * (1.0f / D); float s2 = 0.f;
#pragma unroll
        for (int j = 0; j < 4; ++j) { v[j] = v[j] - mean; s2 += (v[j][0] * v[j][0] + v[j][1] * v[j][1]) + (v[j][2] * v[j][2] + v[j][3] * v[j][3]); }
        const float rstd = __builtin_amdgcn_rsqf(wave_sum(s2) * (1.0f / D) + LN_EPS);
#pragma unroll
        for (int j = 0; j < 4; ++j) { v[j] = v[j] * rstd * g4[j] + b4[j];
            if (l == DEPTH - 1) *(GAS f32x4*)(xo + row * D + 4 * lane + 256 * j) = v[j];
            else { u32x2 xq; xq.x = cvt_pk_bf16(v[j][0], v[j][1]); xq.y = cvt_pk_bf16(v[j][2], v[j][3]); *(GAS u32x2*)(xr + row * D + 4 * lane + 256 * j) = xq;
                *(GAS unsigned*)(xb + row * D + 4 * lane + 256 * j) = pk4_fp8(v[j][0], v[j][1], v[j][2], v[j][3]); } }
    }
}

DI Ctx load_ctx() {
    union { Ctx c; unsigned long long q[sizeof(Ctx) / 8]; } u;
#if defined(__HIP_DEVICE_COMPILE__)
    const __attribute__((address_space(4))) unsigned long long* p = (const __attribute__((address_space(4))) unsigned long long*)__builtin_amdgcn_kernarg_segment_ptr();
    asm volatile("" : "+s"(p));
#pragma unroll
    for (int i = 0; i < (int)(sizeof(Ctx) / 8); ++i) u.q[i] = p[i];
#endif
    return u.c;
}
#define CTX const Ctx c = load_ctx(); const int G = lgrid(); LAS unsigned char* lds = LDSBASE
__global__ void __launch_bounds__(NTHREADS, 2) mk_fwd(Ctx c_arg) {
    extern __shared__ __attribute__((aligned(16))) unsigned char lds_raw[];
#define LDSBASE ({ unsigned _b = (unsigned)(uintptr_t)(LAS unsigned char*)lds_raw; asm volatile("" : "+s"(_b)); (LAS unsigned char*)(uintptr_t)_b; })
    LAS unsigned char* lds0 = LDSBASE;
    const int tid = threadIdx.x; const Ctx c = load_ctx();
    volatile LAS unsigned* MISC = (volatile LAS unsigned*)(lds0 + MISC_OFF);
    if (tid < 64) MISC[tid] = 0u;
    __syncthreads();
    XcdBarrier bar; bar.bar = (unsigned*)(c.ws + WS_CTL) + CW_BAR; bar.x = 0; bar.st = MISC + 40;
    if (!MK_MULTI) bar = xcd_barrier_post((unsigned*)(c.ws + WS_CTL) + CW_BAR, MISC + 40);
    const int lo = c.lo, hi = c.hi; int step = 0;
#define RUN (lo <= step && step < hi)
#define END_STEP do { if (RUN && step + 1 < hi) { if (!MK_MULTI) xcd_barrier(bar); } ++step; } while (0)
#define END_STEP_NB do { ++step; } while (0)
    for (int l = 0; l < DEPTH; ++l) {
        if (RUN) { CTX; phase_w(lds, c, l, G); }
        END_STEP;
        for (int hf = 0; hf < 2; ++hf) {
            const size_t r0 = (size_t)hf * TH;
            if (RUN) {
                CTX;
                pg8::StaticOrder S; S.init(c.ws + WS_XB + r0 * D, c.ws + WS_WIN, TH, NIN, D / 2, G, lbid());
                EpiIn E{wsb(c, WS_H + H_QG), wsb(c, WS_H + H_KG), wsb(c, WS_H + H_VG), wsb(c, WS_H + H_SR), wsb(c, WS_H + H_QD), wsb(c, WS_H + H_KD), wsb(c, WS_H + H_VD), wsb(c, WS_H + H_GT), (float*)(c.ws + WS_HA), c.pos + r0};
                pg8::gemm_phase<EpiIn, pg8::StaticOrder, true>(lds, D / 2, S, E);
            }
            END_STEP;
            if (RUN) { CTX; phase_p(lds, c, l, G); }
            END_STEP;
            if (RUN) { CTX; phase_b1(lds, c, l, hf, G); }
            END_STEP;
            if (RUN) { CTX; phase_b(lds, c, l, hf, G); }
            END_STEP;
            if (RUN) { CTX; (void)lds; phase_f(c, G); }
            END_STEP_NB;
            if (RUN) {
                CTX;
                pg8::StaticOrder S; S.init(wsb(c, WS_OG), wsb(c, WS_WGO), TH, D, D, G, lbid());
                EpiGate<false> E{wsb(c, WS_MIX), wsb(c, WS_H + H_GT)};
                pg8::gemm_phase(lds, D, S, E);
            }
            END_STEP;
            if (RUN) {
                CTX;
                pg8::StaticOrder S; S.init(wsb(c, WS_ATT), wsb(c, WS_WAO), TH, D, 512, G, lbid());
                EpiGate<true> E{wsb(c, WS_MIX), wsb(c, WS_H + H_GT) + 1024};
                pg8::gemm_phase(lds, 512, S, E);
            }
            END_STEP;
            if (RUN) {
                CTX;
                pg8::StaticOrder S; S.init(wsb(c, WS_MIX), wsb(c, WS_WOUT), TH, D, D, G, lbid());
                EpiRes E{l == 0 ? c.x + r0 * D : nullptr, wsb(c, WS_XR) + r0 * D};
                pg8::gemm_phase(lds, D, S, E);
            }
            if (hf == 1) END_STEP; else END_STEP_NB;
        }
        if (RUN) { CTX; phase_r(lds, c, l, G); }
        END_STEP;
        if (RUN) { CTX; phase_r2(lds, c, l, G); }
        END_STEP;
        if (RUN) {   CTX;
            const int ntiles = moe_setup(lds, c, l);
            volatile LAS int* PRE = (volatile LAS int*)(lds + MISC_OFF); volatile LAS int* TAB = (volatile LAS int*)(lds + TAB_OFF);
            pg8::MoeOrder S; S.G = G; S.c = lbid(); S.ntot = ntiles * 8; S.NC = 8; S.K = D / 2; S.pre = PRE; S.cnt = PRE + 17; S.A = (const char*)(c.ws + WS_XB); S.Bt = (const char*)(c.ws + WS_WGU);
            S.bstride = (size_t)2048 * 1024; S.tab = TAB; S.gather = true;
            const int* list = (const int*)(c.ws + WS_LIST);
            { const int lt_tid = ltid(); const int r = lt_tid & 255, half = rfl(lt_tid >> 8);
              for (int i0 = 0; i0 < MAXU; i0 += 2) { Unit u; const int i = i0 + half;
                  if (S.next(i, u)) { const int lt = u.pm - PRE[u.e]; const int pos = 256 * lt + (r < u.nv ? r : 0); TAB[i * 256 + r] = list[(size_t)u.e * T + pos] >> 1; } } }
            __syncthreads();
            EpiM1 E{c.ws + WS_HM};
            pg8::gemm_phase<EpiM1, pg8::MoeOrder, true>(lds, D / 2, S, E);
        }
        END_STEP;
        if (RUN) {   CTX;
            const int ntiles = moe_setup(lds, c, l);
            volatile LAS int* PRE = (volatile LAS int*)(lds + MISC_OFF);
            pg8::MoeOrder S; S.G = G; S.c = lbid(); S.ntot = ntiles * 4; S.NC = 4; S.K = DFF / 2; S.pre = PRE; S.cnt = PRE + 17; S.A = (const char*)(c.ws + WS_HM); S.Bt = (const char*)(c.ws + WS_WD);
            S.bstride = (size_t)1024 * 1024; S.tab = nullptr; S.gather = false;
            EpiM2 E{c.ws + WS_YS, (const int*)(c.ws + WS_LIST), PRE};
            pg8::gemm_phase<EpiM2, pg8::MoeOrder, true>(lds, DFF / 2, S, E);
        }
        END_STEP;
        if (RUN) { CTX; (void)lds; phase_c(c, l, G); }
        END_STEP_NB;
    }
#undef RUN
#undef END_STEP
#undef END_STEP_NB
}
constexpr int NSTEPS = DEPTH * (1 + 2 * 8 + 5);

extern "C" void kernel_launch(void* const* d_in, const int* in_sizes, int n_in, void* d_out, int out_size, void* d_ws, size_t ws_size, hipStream_t stream) {
    static int grid = 0;
    if (grid == 0) {
        if (n_in != 18 || in_sizes[0] != T * D || out_size != T * D || ws_size < WS_END) { fprintf(stderr, "kernel_launch: unexpected shapes / workspace (need %zu, got %zu)\n", (size_t)WS_END, ws_size); grid = -1; return; }
        int dev = 0, cus = 0;
        if (hipGetDevice(&dev) != hipSuccess || hipDeviceGetAttribute(&cus, hipDeviceAttributeMultiprocessorCount, dev) != hipSuccess) { grid = -1; return; }
        if (hipFuncSetAttribute((const void*)mk_fwd, hipFuncAttributeMaxDynamicSharedMemorySize, LDS_BYTES) != hipSuccess) { fprintf(stderr, "kernel_launch: hipFuncSetAttribute failed\n"); grid = -1; return; }
        int per_cu = 0;
        if (hipOccupancyMaxActiveBlocksPerMultiprocessor(&per_cu, (const void*)mk_fwd, NTHREADS, LDS_BYTES) != hipSuccess || per_cu < 1) { fprintf(stderr, "kernel_launch: occupancy query says %d\n", per_cu); }
        (void)hipGetLastError();
        grid = cus;
    }
    if (grid < 0) return;
    (void)hipMemsetAsync((char*)d_ws + WS_CTL, 0, CTL_ZERO_BYTES, stream);
    Ctx c{};
    c.x = (const float*)d_in[0]; c.pos = (const int*)d_in[1]; c.w_in = (const float*)d_in[2]; c.w_alpha_up = (const float*)d_in[3]; c.b_alpha = (const float*)d_in[4]; c.gla_norm = (const float*)d_in[5];
    c.w_gla_o = (const float*)d_in[6]; c.w_att_o = (const float*)d_in[7]; c.w_out = (const float*)d_in[8]; c.ln1_g = (const float*)d_in[9]; c.ln1_b = (const float*)d_in[10]; c.w_router = (const float*)d_in[11];
    c.b_router = (const float*)d_in[12]; c.w_e_gate = (const float*)d_in[13]; c.w_e_up = (const float*)d_in[14]; c.w_e_down = (const float*)d_in[15]; c.ln2_g = (const float*)d_in[16]; c.ln2_b = (const float*)d_in[17];
    c.out = (float*)d_out; c.ws = (unsigned char*)d_ws;
#if MK_MULTI
    for (int s = 0; s < NSTEPS; ++s) { c.lo = s; c.hi = s + 1; hipLaunchKernelGGL(mk_fwd, dim3(grid), dim3(NTHREADS), LDS_BYTES, stream, c); }
#else
    c.lo = 0; c.hi = NSTEPS; hipLaunchKernelGGL(mk_fwd, dim3(grid), dim3(NTHREADS), LDS_BYTES, stream, c);
#endif
}
```

```cpp
#include <hip/hip_runtime.h>
#include <cstdio>
#include <cstdint>

#ifndef MK_MULTI
#define MK_MULTI 0
#endif

#define DI __device__ __forceinline__
#define GAS __attribute__((address_space(1)))
#define LAS __attribute__((address_space(3)))
typedef unsigned short bf16_t;
typedef short bf16x8 __attribute__((ext_vector_type(8)));
typedef short s16x4 __attribute__((ext_vector_type(4)));
typedef float f32x4 __attribute__((ext_vector_type(4)));
typedef float f32x2 __attribute__((ext_vector_type(2)));
typedef unsigned u32x4 __attribute__((ext_vector_type(4)));
typedef unsigned u32x2 __attribute__((ext_vector_type(2)));
typedef int i32x4 __attribute__((ext_vector_type(4)));
typedef int i32x8 __attribute__((ext_vector_type(8)));
#define LDS_WAIT() asm volatile("s_waitcnt lgkmcnt(0)" ::: "memory")
#define VM_WAIT() asm volatile("s_waitcnt vmcnt(0)" ::: "memory")

constexpr int D = 1024, NBATCH = 16, SEQ = 4096, T = NBATCH * SEQ, DEPTH = 4;
constexpr int TH = T / 2;
constexpr int DIN = 9744, NIN = 9984;
constexpr int NEXP = 16, DFF = 1024;
constexpr float LN_EPS = 1e-5f, RMS_EPS = 1e-6f;
constexpr float DN_ALPHA = 1.6817928305074290f;
constexpr float LOG2E = 1.4426950408889634f;
constexpr int NWAVES = 8, NTHREADS = 512;

constexpr size_t MiB = 1u << 20;
constexpr size_t WS_CTL = 0, CTL_ZERO_BYTES = 1 * MiB;
constexpr size_t WS_WIN = 1 * MiB;
constexpr size_t WS_WGO = WS_WIN + (size_t)NIN * D;
constexpr size_t WS_WAO = WS_WGO + 2 * MiB;
constexpr size_t WS_WOUT = WS_WAO + 1 * MiB;
constexpr size_t WS_WGU = WS_WOUT + 2 * MiB;
constexpr size_t WS_WD = WS_WGU + 32 * MiB;
constexpr size_t WS_XB = WS_WD + 16 * MiB;
constexpr size_t WS_XR = WS_XB + 64 * MiB;
constexpr size_t WS_LIST = WS_XR + 128 * MiB;
constexpr size_t WS_GATE = WS_LIST + 4 * MiB;
constexpr size_t WS_INFO = WS_GATE + 1 * MiB;
constexpr size_t WS_HISTG = WS_INFO + 1 * MiB;
constexpr size_t WS_OG = WS_HISTG + 1 * MiB;
constexpr size_t WS_ATTG = WS_OG + 64 * MiB;
constexpr size_t WS_LSE = WS_ATTG + 96 * MiB;
constexpr size_t WS_ATT = WS_LSE + 3 * MiB;
constexpr size_t WS_MIX = WS_ATT + 32 * MiB;
constexpr size_t WS_HA = WS_MIX + 64 * MiB;
constexpr size_t WS_H = WS_HA + 2 * MiB;
constexpr size_t H_QG = 0, H_KG = H_QG + (size_t)TH * 512 * 2, H_VG = H_KG + (size_t)TH * 512 * 2, H_SR = H_VG + (size_t)TH * 1024 * 2,
                 H_QD = H_SR + (size_t)TH * 1024 * 2, H_KD = H_QD + (size_t)TH * 1536 * 2, H_VD = H_KD + (size_t)TH * 1536 * 2, H_GT = H_VD + (size_t)TH * 1536 * 2,
                 H_END = H_GT + (size_t)TH * 2048 * 2;
constexpr size_t WS_HM = WS_H;
constexpr size_t WS_YS = WS_HM + (size_t)(2 * T + 4096) * 1024 * 2;
constexpr size_t WS_REC = WS_H + H_END;
constexpr size_t WS_SLOC = WS_REC + (size_t)2048 * 33792;
constexpr size_t WS_DCUM = WS_SLOC + 16 * MiB;
constexpr size_t WS_END = WS_DCUM + 1 * MiB;
static_assert(WS_YS + (size_t)2 * T * 1024 * 2 <= WS_END, "MoE overlay fits");
constexpr int CW_BAR = 4096;
constexpr int CW_TKT = 24576;
constexpr int CW_CUR = 16384;

constexpr int RING_BYTES = 131072;
constexpr int TAB_OFF = RING_BYTES, MAXU = 18, TAB_BYTES = MAXU * 1024;
constexpr int MISC_OFF = TAB_OFF + TAB_BYTES;
constexpr int LDS_BYTES = MISC_OFF + 256;

DI int rfl(int v) { return __builtin_amdgcn_readfirstlane(v); }
DI int lbid() { int t = blockIdx.x; asm volatile("" : "+s"(t)); return t; }
DI int lgrid() { int t = gridDim.x; asm volatile("" : "+s"(t)); return t; }
DI int vcu_of(int bid, int G) { return (G % 8 == 0) ? (bid % 8) * (G / 8) + bid / 8 : bid; }
DI int ltid() { int t = threadIdx.x; asm volatile("" : "+v"(t)); return t; }
DI float bf2f(unsigned b) { return __uint_as_float(b << 16); }
typedef __bf16 bf16x2_t __attribute__((ext_vector_type(2)));
DI unsigned cvt_pk_bf16(float lo, float hi) { f32x2 v = {lo, hi}; bf16x2_t b = __builtin_convertvector(v, bf16x2_t); return __builtin_bit_cast(unsigned, b); }
DI float clamp8(float v) { return fminf(fmaxf(v, -448.f), 448.f); }
DI unsigned pk4_fp8(float a, float b, float c_, float d) { int w = 0; w = __builtin_amdgcn_cvt_pk_fp8_f32(clamp8(a), clamp8(b), w, false); w = __builtin_amdgcn_cvt_pk_fp8_f32(clamp8(c_), clamp8(d), w, true); return (unsigned)w; }
constexpr float W8_SCALE = 64.0f;
DI float bf_lo(unsigned w) { return __uint_as_float(w << 16); }
DI float bf_hi(unsigned w) { return __uint_as_float(w & 0xffff0000u); }
DI float sigmoidf_(float x) { return __builtin_amdgcn_rcpf(1.0f + __builtin_amdgcn_exp2f(-x * LOG2E)); }

#define XB_TMO      128
#define XB_XCNT(j)  (256  + 64 * (j))
#define XB_XSUB(j)  (1280 + 64 * (j))
#define XB_XGEN(j)  (2304 + 64 * (j))
#define XB_TOP      3328
#define XB_TOPGEN   3392
#define XCD_BAR_WORDS 3456
#define XB_SPIN_CAP (1u << 18)
DI unsigned xb_ld(unsigned* p)              { return __hip_atomic_load(p, __ATOMIC_RELAXED, __HIP_MEMORY_SCOPE_AGENT); }
DI unsigned xb_add(unsigned* p, unsigned v) { return __hip_atomic_fetch_add(p, v, __ATOMIC_RELAXED, __HIP_MEMORY_SCOPE_AGENT); }
DI unsigned xb_xcc_id() { return (unsigned)__builtin_amdgcn_s_getreg((3 << 11) | 20) & 0xFu; }
#define XB_SPIN(cond, bar) do { unsigned _sp = 0; while (cond) { __builtin_amdgcn_s_sleep(1); \
    if ((++_sp & 255u) == 0u) { if (xb_ld(&(bar)[XB_TMO])) break; if (_sp > XB_SPIN_CAP) { atomicAdd(&(bar)[XB_TMO], 1u); break; } } } } while (0)
struct XcdBarrier { unsigned* bar; unsigned x; volatile LAS unsigned* st; };
DI XcdBarrier xcd_barrier_post(unsigned* bar, volatile LAS unsigned* st) {
    XcdBarrier b; b.bar = bar; b.x = xb_xcc_id(); b.st = st;
    if (threadIdx.x == 0) (void)xb_add(&bar[XB_XCNT(b.x)], 1u);
    return b;
}
DI void xcd_barrier_complete(unsigned* bar, unsigned x, unsigned& nloc, unsigned& nx) {
    const unsigned G = gridDim.x * gridDim.y * gridDim.z;
    unsigned sum, cnt, mine, sp = 0u;
    for (;;) {
        sum = 0u; cnt = 0u; mine = 0u;
#pragma unroll
        for (unsigned j = 0; j < 16; ++j) { const unsigned c = xb_ld(&bar[XB_XCNT(j)]); sum += c; cnt += (c > 0u) ? 1u : 0u; mine = (j == x) ? c : mine; }
        if (sum == G) break;
        __builtin_amdgcn_s_sleep(1);
        if ((++sp & 255u) == 0u) { if (xb_ld(&bar[XB_TMO])) break; if (sp > XB_SPIN_CAP) { atomicAdd(&bar[XB_TMO], 1u); break; } }
    }
    nloc = mine > 0u ? mine : 1u; nx = cnt > 0u ? cnt : 1u;
}
DI void xcd_barrier(const XcdBarrier& b) {
    asm volatile("s_waitcnt vmcnt(0)" ::: "memory");
    __syncthreads();
    if (threadIdx.x == 0) {
        unsigned* bar = b.bar;
        __builtin_amdgcn_s_waitcnt(0);
        unsigned nloc = b.st[0], nx = b.st[1];
        if (nloc == 0u) { xcd_barrier_complete(bar, b.x, nloc, nx); b.st[0] = nloc; b.st[1] = nx; }
        const unsigned old = xb_add(&bar[XB_XSUB(b.x)], 1u);
        const unsigned gen = old / nloc;
        if (old + 1u == (gen + 1u) * nloc) {
            __builtin_amdgcn_fence(__ATOMIC_RELEASE, "agent");
            asm volatile("s_waitcnt vmcnt(0)" ::: "memory");
            const unsigned og = xb_add(&bar[XB_TOP], 1u);
            const unsigned tg = og / nx;
            if (og + 1u == (tg + 1u) * nx) xb_add(&bar[XB_TOPGEN], 1u);
            else XB_SPIN(xb_ld(&bar[XB_TOPGEN]) == tg, bar);
            __builtin_amdgcn_fence(__ATOMIC_ACQUIRE, "agent");
            xb_add(&bar[XB_XGEN(b.x)], 1u);
            asm volatile("s_waitcnt vmcnt(0)" ::: "memory");
        } else {
            XB_SPIN(xb_ld(&bar[XB_XGEN(b.x)]) == gen, bar);
            __builtin_amdgcn_fence(__ATOMIC_ACQUIRE, "agent");
            asm volatile("s_waitcnt vmcnt(0)" ::: "memory");
        }
    }
    __syncthreads();
}

struct Ctx {
    const float* x; const int* pos; const float* w_in; const float* w_alpha_up; const float* b_alpha; const float* gla_norm;
    const float* w_gla_o; const float* w_att_o; const float* w_out; const float* ln1_g; const float* ln1_b; const float* w_router; const float* b_router;
    const float* w_e_gate; const float* w_e_up; const float* w_e_down; const float* ln2_g; const float* ln2_b;
    float* out; unsigned char* ws;
    int lo, hi;
};
DI bf16_t* wsb(const Ctx& c, size_t off) { return (bf16_t*)(c.ws + off); }

namespace pg8 {
constexpr int BM = 256, BK = 64, HALF = 128, HTB = HALF * BK * 2, STAGE_BYTES = 8 * HTB, NXCD = 8, WGM = 8;
DI int lds_byte(int r, int c) { const int st = (r >> 4) * 2 + (c >> 5), rr = r & 15, cc = c & 31, ob = rr * 64 + cc * 2; return st * 1024 + (ob ^ (((ob >> 9) & 1) << 5)); }
DI void stage_rc(int b, int& R, int& C) { const int st = b / 1024, sb = b % 1024, swz = sb ^ (((sb >> 9) & 1) << 5); R = (st >> 1) * 16 + swz / 64; C = (st & 1) * 32 + (swz % 64) / 2; }
DI int perm32(int rho) { const int n = rho >> 4, i = rho & 15; return 8 * (i >> 2) + 4 * n + (i & 3); }
struct Unit { int pm, pn, e, nv, ui; };

struct StaticOrder {
    int nM, nN, nwg, G, c, K; const char* A; const char* Bt;
    DI void init(const void* A_, const void* Bt_, int M, int N, int K_, int G_, int c_) { A = (const char*)A_; Bt = (const char*)Bt_; nM = M / BM; nN = N / BM; nwg = nM * nN; G = G_; c = c_; K = K_; }
    DI bool next(int i, Unit& u) const {
        const long L = (long)i * G + c; if (L >= nwg) return false;
        int wgid = (int)L; { const int q = nwg / NXCD, r = nwg % NXCD, xcd = wgid % NXCD, off = wgid / NXCD; wgid = (xcd < r ? xcd * (q + 1) : r * (q + 1) + (xcd - r) * q) + off; }
        const int nig = WGM * nN, gid = wgid / nig, fm = gid * WGM, gsz = (nM - fm) < WGM ? (nM - fm) : WGM;
        u.pm = fm + ((wgid % nig) % gsz); u.pn = (wgid % nig) / gsz; u.e = 0; u.nv = 256; u.ui = i; return true;
    }
    DI const char* a_base(const Unit& u) const { return A + (size_t)u.pm * BM * K * 2; }
    DI const char* b_base(const Unit& u) const { return Bt + (size_t)u.pn * BM * K * 2; }
    DI void a_off(const Unit&, int tid, unsigned (&o)[2][2]) const {
#pragma unroll
        for (int i = 0; i < 2; ++i) { int R, C; stage_rc(tid * 16 + i * 8192, R, C);
#pragma unroll
            for (int h = 0; h < 2; ++h) o[h][i] = (unsigned)((h * HALF + R) * K + C) * 2u; }
    }
};
struct MoeOrder {
    int G, c, ntot, NC, K; const volatile LAS int* pre; const volatile LAS int* cnt; const char* A; const char* Bt; size_t bstride; const volatile LAS int* tab; bool gather;
    DI bool next(int i, Unit& u) const {
        const int L = i * G + c; if (L >= ntot) return false;
        const int rt = L / NC; u.pn = L - rt * NC; u.pm = rt;
        int e = 0;
#pragma unroll
        for (int j = 1; j < 16; ++j) e += (rt >= rfl(pre[j])) ? 1 : 0;
        e = rfl(e); u.e = e; const int rem = rfl(cnt[e]) - 256 * (rt - rfl(pre[e])); u.nv = rem < 256 ? rem : 256; u.ui = i; return true;
    }
    DI const char* a_base(const Unit& u) const { return gather ? A : A + (size_t)u.pm * BM * K * 2; }
    DI const char* b_base(const Unit& u) const { return Bt + (size_t)u.e * bstride + (size_t)u.pn * BM * K * 2; }
    DI void a_off(const Unit& u, int tid, unsigned (&o)[2][2]) const {
#pragma unroll
        for (int i = 0; i < 2; ++i) { int R, C; stage_rc(tid * 16 + i * 8192, R, C);
#pragma unroll
            for (int h = 0; h < 2; ++h) { const int row = gather ? tab[u.ui * 256 + h * HALF + R] : (h * HALF + R); o[h][i] = (unsigned)(row * K + C) * 2u; } }
    }
};

template <class Epi, class Sched, bool F8 = false>
DI void gemm_phase(LAS unsigned char* lds, const int K, const Sched& S, const Epi& E) {
    const int tid = ltid(), wid = rfl(tid >> 6), lane = tid & 63, wr = wid >> 2, wc = wid & 3, fr = lane & 15, fq = lane >> 4;
    const int nt = K / BK;
    unsigned voffB[2];
#pragma unroll
    for (int i = 0; i < 2; ++i) { int R, C; stage_rc(tid * 16 + i * 8192, R, C); const int Rb = Epi::PERM ? ((R & ~31) + perm32(R & 31)) : R; voffB[i] = (unsigned)(Rb * K + C) * 2u; }
    const size_t kstep = (size_t)(BK * 2);
    const size_t hstep = (size_t)HALF * K * 2;
    const unsigned ldsw = (unsigned)wid * 1024u;
    const int aoff = lds_byte(wr * 64 + fr, fq * 8), boff = lds_byte(wc * 32 + fr, fq * 8);
#define PG8_SA(b, h) (((b) * 2 + (h)) * HTB)
#define PG8_SB(b, h) ((4 + (b) * 2 + (h)) * HTB)
#define PG8_STAGE(bufoff, gbase, voff) do { _Pragma("unroll") for (int _i = 0; _i < 2; ++_i) \
        __builtin_amdgcn_global_load_lds((const unsigned*)((const char*)(gbase) + (voff)[_i]), (LAS unsigned*)(lds + (bufoff) + ldsw + _i * 8192), 16, 0, 0); } while (0)
#define PG8_LD8(p) __builtin_shufflevector(*(const LAS i32x4*)(p), *(const LAS i32x4*)((p) + 1024), 0, 1, 2, 3, 4, 5, 6, 7)
#define PG8_LDA(dst, b, h) do { if constexpr (F8) { _Pragma("unroll") for (int m = 0; m < 4; ++m) dst##8[m] = PG8_LD8(lds + PG8_SA(b, h) + aoff + m * 2048); } else { \
        _Pragma("unroll") for (int m = 0; m < 4; ++m) _Pragma("unroll") for (int k = 0; k < 2; ++k) dst[m][k] = *(const LAS bf16x8*)(lds + PG8_SA(b, h) + aoff + m * 2048 + k * 1024); } } while (0)
#define PG8_LDB(dst, b, h) do { if constexpr (F8) { _Pragma("unroll") for (int n = 0; n < 2; ++n) dst##8[n] = PG8_LD8(lds + PG8_SB(b, h) + boff + n * 2048); } else { \
        _Pragma("unroll") for (int n = 0; n < 2; ++n) _Pragma("unroll") for (int k = 0; k < 2; ++k) dst[n][k] = *(const LAS bf16x8*)(lds + PG8_SB(b, h) + boff + n * 2048 + k * 1024); } } while (0)
#define PG8_MMA(ai, bj, At, Bt) do { __builtin_amdgcn_s_setprio(1); if constexpr (F8) { _Pragma("unroll") for (int m = 0; m < 4; ++m) _Pragma("unroll") for (int n = 0; n < 2; ++n) \
        asm volatile("v_mfma_scale_f32_16x16x128_f8f6f4 %0, %1, %2, %0, %3, %4 op_sel_hi:[0,0,0]" : "+v"(acc[ai][bj][m][n]) : "v"(Bt##8[n]), "v"(At##8[m]), "v"(sc_w), "v"(sc_a)); } else { \
        _Pragma("unroll") for (int m = 0; m < 4; ++m) _Pragma("unroll") for (int n = 0; n < 2; ++n) _Pragma("unroll") for (int k = 0; k < 2; ++k) \
        acc[ai][bj][m][n] = __builtin_amdgcn_mfma_f32_16x16x32_bf16(Bt[n][k], At[m][k], acc[ai][bj][m][n], 0, 0, 0); } __builtin_amdgcn_s_setprio(0); } while (0)
#define PG8_WAIT_V(n) asm volatile("s_waitcnt vmcnt(" #n ")" ::: "memory")
#define PG8_WAIT_L(n) asm volatile("s_waitcnt lgkmcnt(" #n ")" ::: "memory")
#define PG8_BAR __builtin_amdgcn_s_barrier()
#define PG8_SCHED __builtin_amdgcn_sched_barrier(0)
    Unit cur, nxt; int ui = 0;
    if (!S.next(0, cur)) return;
    f32x4 acc[2][2][4][2];
#pragma unroll
    for (int a = 0; a < 2; ++a)
#pragma unroll
        for (int b = 0; b < 2; ++b)
#pragma unroll
            for (int m = 0; m < 4; ++m)
#pragma unroll
                for (int n = 0; n < 2; ++n) acc[a][b][m][n] = (f32x4){0.f, 0.f, 0.f, 0.f};
    int sc_w = 0x79797979, sc_a = 0x7f7f7f7f; asm volatile("" : "+v"(sc_w), "+v"(sc_a));
    bf16x8 At[4][2], B0[2][2], B1[2][2]; i32x8 At8[4], B08[2], B18[2];
    unsigned oA[2][2]; S.a_off(cur, tid, oA);
    const char* cA = S.a_base(cur); const char* cB = S.b_base(cur);
    PG8_STAGE(PG8_SB(0, 0), cB, voffB); PG8_STAGE(PG8_SB(0, 1), cB + hstep, voffB); PG8_STAGE(PG8_SA(0, 0), cA, oA[0]); PG8_STAGE(PG8_SA(0, 1), cA, oA[1]);
    if (wr == 1) PG8_BAR;
    PG8_WAIT_V(2); PG8_BAR;
    PG8_STAGE(PG8_SB(1, 0), cB + kstep, voffB); PG8_STAGE(PG8_SA(1, 0), cA + kstep, oA[0]); PG8_STAGE(PG8_SB(1, 1), cB + hstep + kstep, voffB);
    PG8_WAIT_V(6); PG8_BAR;
    for (;;) {
        const bool has_next = S.next(ui + 1, nxt);
        const char* nA = has_next ? S.a_base(nxt) : cA; const char* nB = has_next ? S.b_base(nxt) : cB;
        for (int t = 0; t < nt; t += 2) {
            const bool last = (t == nt - 2);
            const char* a1 = cA + (size_t)(t + 1) * kstep;
            const char* a2 = last ? nA : cA + (size_t)(t + 2) * kstep; const char* b2 = last ? nB : cB + (size_t)(t + 2) * kstep;
            const char* a3 = a2 + kstep; const char* b3 = b2 + kstep;
            PG8_LDB(B0, 0, 0); PG8_LDB(B1, 0, 1); PG8_SCHED; PG8_LDA(At, 0, 0); PG8_STAGE(PG8_SA(1, 1), a1, oA[1]);
            if (last && has_next) S.a_off(nxt, tid, oA);
            PG8_WAIT_V(8); PG8_WAIT_L(0); PG8_BAR; PG8_MMA(0, 0, At, B0); PG8_MMA(0, 1, At, B1); PG8_BAR; PG8_SCHED;
            PG8_LDA(At, 0, 1); PG8_STAGE(PG8_SB(0, 0), b2, voffB); PG8_STAGE(PG8_SB(0, 1), b2 + hstep, voffB); PG8_STAGE(PG8_SA(0, 0), a2, oA[0]);
            PG8_WAIT_V(8); PG8_WAIT_L(0); PG8_BAR; PG8_MMA(1, 0, At, B0); PG8_MMA(1, 1, At, B1); PG8_BAR; PG8_SCHED;
            PG8_LDB(B0, 1, 0); PG8_LDB(B1, 1, 1); PG8_SCHED; PG8_LDA(At, 1, 0); PG8_STAGE(PG8_SA(0, 1), a2, oA[1]);
            PG8_WAIT_V(8); PG8_WAIT_L(0); PG8_BAR; PG8_MMA(0, 0, At, B0); PG8_MMA(0, 1, At, B1); PG8_BAR; PG8_SCHED;
            PG8_LDA(At, 1, 1); PG8_STAGE(PG8_SB(1, 0), b3, voffB); PG8_STAGE(PG8_SB(1, 1), b3 + hstep, voffB); PG8_STAGE(PG8_SA(1, 0), a3, oA[0]);
            PG8_WAIT_V(8); PG8_WAIT_L(0); PG8_BAR; PG8_MMA(1, 0, At, B0); PG8_MMA(1, 1, At, B1); PG8_BAR; PG8_SCHED;
        }
        if (wr == 0) PG8_BAR;
        if constexpr (F8) asm volatile("s_nop 15\n\ts_nop 15" ::: "memory");
        E(acc, cur, wr, wc, fr, fq);
        if (!has_next) break;
#pragma unroll
        for (int a = 0; a < 2; ++a)
#pragma unroll
            for (int b = 0; b < 2; ++b)
#pragma unroll
                for (int m = 0; m < 4; ++m)
#pragma unroll
                    for (int n = 0; n < 2; ++n) acc[a][b][m][n] = (f32x4){0.f, 0.f, 0.f, 0.f};
        cur = nxt; cA = nA; cB = nB; ++ui;
        if (wr == 1) PG8_BAR;
    }
    PG8_WAIT_V(0);
    PG8_BAR;
#undef PG8_SA
#undef PG8_SB
#undef PG8_STAGE
#undef PG8_LDA
#undef PG8_LDB
#undef PG8_MMA
#undef PG8_LD8
#undef PG8_WAIT_V
#undef PG8_WAIT_L
#undef PG8_BAR
#undef PG8_SCHED
}
}
using pg8::Unit;

DI u32x4 pack8(const f32x4& v0, const f32x4& v1) { u32x4 w; w.x = cvt_pk_bf16(v0[0], v0[1]); w.y = cvt_pk_bf16(v0[2], v0[3]); w.z = cvt_pk_bf16(v1[0], v1[1]); w.w = cvt_pk_bf16(v1[2], v1[3]); return w; }

struct EpiIn {
    static constexpr bool PERM = true;
    bf16_t *qg, *kg, *vg, *sr, *qd, *kd, *vd, *gt; float* ha; const int* pos;
    DI void operator()(const f32x4 (&acc)[2][2][4][2], const Unit& u, int wr, int wc, int fr, int fq) const {
        const int row0 = u.pm * 256 + wr * 64 + fr; const int pn = u.pn;
        if (pn >= 12 && pn < 24) {
            bf16_t* base = pn < 18 ? qd : kd; const int tq = pn < 18 ? pn - 12 : pn - 18; const float sc = pn < 18 ? 0.125f * LOG2E : 1.0f;
            float fre[8];
#pragma unroll
            for (int i = 0; i < 8; ++i) fre[i] = __builtin_amdgcn_exp2f(-(float)(8 * fq + i) * (13.287712379549449f / 32.0f)) * 0.15915494309189535f;
#pragma unroll
            for (int ai = 0; ai < 2; ++ai)
#pragma unroll
                for (int m = 0; m < 4; ++m) {
                    const int r = row0 + ai * 128 + m * 16; const float p = (float)pos[r];
                    bf16_t* rowp = base + (size_t)r * 1536 + (4 * tq + wc) * 64 + 8 * fq;
#pragma unroll
                    for (int n = 0; n < 2; ++n) { f32x4 o1, o2;
#pragma unroll
                        for (int j = 0; j < 4; ++j) {
                            float a = p * fre[n * 4 + j]; a = a - __builtin_floorf(a);
                            const float sn = __builtin_amdgcn_sinf(a), cs = __builtin_amdgcn_cosf(a);
                            const float x1 = acc[ai][0][m][n][j], x2 = acc[ai][1][m][n][j];
                            o1[j] = (x1 * cs - x2 * sn) * sc; o2[j] = (x2 * cs + x1 * sn) * sc;
                        }
                        u32x2 w1, w2; w1.x = cvt_pk_bf16(o1[0], o1[1]); w1.y = cvt_pk_bf16(o1[2], o1[3]); w2.x = cvt_pk_bf16(o2[0], o2[1]); w2.y = cvt_pk_bf16(o2[2], o2[3]);
                        *(GAS u32x2*)(rowp + 4 * n) = w1; *(GAS u32x2*)(rowp + 32 + 4 * n) = w2; }
                    asm volatile("" ::: "memory");
                }
        } else if (pn == 38) {
            if (wc == 0 && fq < 2) {
#pragma unroll
                for (int ai = 0; ai < 2; ++ai)
#pragma unroll
                    for (int m = 0; m < 4; ++m) { float* p = ha + (size_t)(row0 + ai * 128 + m * 16) * 16 + 8 * fq; *(GAS f32x4*)p = acc[ai][0][m][0]; *(GAS f32x4*)(p + 4) = acc[ai][0][m][1]; }
            }
        } else {
            bf16_t* base; int ldc, colt, act = 0; float sc = 1.0f;
            if (pn < 2) { base = qg; ldc = 512; colt = pn * 256; sc = 0.08838834764831845f; }
            else if (pn < 4) { base = kg; ldc = 512; colt = (pn - 2) * 256; }
            else if (pn < 8) { base = vg; ldc = 1024; colt = (pn - 4) * 256; }
            else if (pn < 12) { base = sr; ldc = 1024; colt = (pn - 8) * 256; act = 1; }
            else if (pn < 30) { base = vd; ldc = 1536; colt = (pn - 24) * 256; }
            else {
#pragma unroll
                for (int ai = 0; ai < 2; ++ai)
#pragma unroll
                    for (int m = 0; m < 4; ++m) { unsigned char* rowp = (unsigned char*)gt + (size_t)(row0 + ai * 128 + m * 16) * 2048 + (pn - 30) * 256 + wc * 32 + 8 * fq;
#pragma unroll
                        for (int bj = 0; bj < 2; ++bj) { unsigned w[2];
#pragma unroll
                            for (int n = 0; n < 2; ++n) { const f32x4 v = acc[ai][bj][m][n];
                                w[n] = (unsigned)(sigmoidf_(v[0]) * 255.0f + 0.5f) | ((unsigned)(sigmoidf_(v[1]) * 255.0f + 0.5f) << 8) | ((unsigned)(sigmoidf_(v[2]) * 255.0f + 0.5f) << 16) | ((unsigned)(sigmoidf_(v[3]) * 255.0f + 0.5f) << 24); }
                            *(GAS u32x2*)(rowp + bj * 128) = (u32x2){w[0], w[1]}; } }
                return; }
#pragma unroll
            for (int ai = 0; ai < 2; ++ai)
#pragma unroll
                for (int m = 0; m < 4; ++m) { bf16_t* rowp = base + (size_t)(row0 + ai * 128 + m * 16) * ldc + colt + wc * 32 + 8 * fq;
#pragma unroll
                    for (int bj = 0; bj < 2; ++bj) { f32x4 v0 = acc[ai][bj][m][0] * sc, v1 = acc[ai][bj][m][1] * sc;
                        if (act) {
#pragma unroll
                            for (int j = 0; j < 4; ++j) { const float s0 = sigmoidf_(v0[j]), s1 = sigmoidf_(v1[j]); v0[j] = act == 1 ? v0[j] * s0 : s0; v1[j] = act == 1 ? v1[j] * s1 : s1; } }
                        *(GAS u32x4*)(rowp + bj * 128) = pack8(v0, v1); } }
        }
    }
};
template <bool ADD> struct EpiGate {
    static constexpr bool PERM = true;
    bf16_t* mix; const unsigned char* gt;
    DI void operator()(const f32x4 (&acc)[2][2][4][2], const Unit& u, int wr, int wc, int fr, int fq) const {
        const int row0 = u.pm * 256 + wr * 64 + fr, col0 = u.pn * 256 + wc * 32 + 8 * fq; constexpr float k = 1.0f / 255.0f;
#pragma unroll
        for (int ai = 0; ai < 2; ++ai)
#pragma unroll
            for (int m = 0; m < 4; ++m) { const size_t r = (size_t)(row0 + ai * 128 + m * 16);
#pragma unroll
                for (int bj = 0; bj < 2; ++bj) {
                    const u32x2 g = *(const GAS u32x2*)(gt + r * 2048 + col0 + bj * 128);
                    f32x4 v0 = acc[ai][bj][m][0], v1 = acc[ai][bj][m][1];
                    v0[0] *= (float)((g.x >> 0) & 0xffu) * k; v0[1] *= (float)((g.x >> 8) & 0xffu) * k; v0[2] *= (float)((g.x >> 16) & 0xffu) * k; v0[3] *= (float)((g.x >> 24) & 0xffu) * k;
                    v1[0] *= (float)((g.y >> 0) & 0xffu) * k; v1[1] *= (float)((g.y >> 8) & 0xffu) * k; v1[2] *= (float)((g.y >> 16) & 0xffu) * k; v1[3] *= (float)((g.y >> 24) & 0xffu) * k;
                    bf16_t* mp = mix + r * 1024 + col0 + bj * 128;
                    if (ADD) { const u32x4 o = *(const GAS u32x4*)mp; v0[0] += bf_lo(o.x); v0[1] += bf_hi(o.x); v0[2] += bf_lo(o.y); v0[3] += bf_hi(o.y); v1[0] += bf_lo(o.z); v1[1] += bf_hi(o.z); v1[2] += bf_lo(o.w); v1[3] += bf_hi(o.w); }
                    *(GAS u32x4*)mp = pack8(v0, v1); } }
    }
};
struct EpiRes {
    static constexpr bool PERM = true;
    const float* x32; bf16_t* xr;
    DI void operator()(const f32x4 (&acc)[2][2][4][2], const Unit& u, int wr, int wc, int fr, int fq) const {
        const int row0 = u.pm * 256 + wr * 64 + fr, col0 = u.pn * 256 + wc * 32 + 8 * fq;
#pragma unroll
        for (int ai = 0; ai < 2; ++ai)
#pragma unroll
            for (int m = 0; m < 4; ++m) { const size_t off = (size_t)(row0 + ai * 128 + m * 16) * 1024 + col0;
#pragma unroll
                for (int bj = 0; bj < 2; ++bj) { f32x4 a0, a1;
                    if (x32) { a0 = *(const GAS f32x4*)(x32 + off + bj * 128); a1 = *(const GAS f32x4*)(x32 + off + bj * 128 + 4); }
                    else { const u32x4 o = *(const GAS u32x4*)(xr + off + bj * 128); a0 = (f32x4){bf_lo(o.x), bf_hi(o.x), bf_lo(o.y), bf_hi(o.y)}; a1 = (f32x4){bf_lo(o.z), bf_hi(o.z), bf_lo(o.w), bf_hi(o.w)}; }
                    *(GAS u32x4*)(xr + off + bj * 128) = pack8(a0 * DN_ALPHA + acc[ai][bj][m][0], a1 * DN_ALPHA + acc[ai][bj][m][1]); }
                asm volatile("" ::: "memory"); }
    }
};
struct EpiM1 {
    static constexpr bool PERM = true;
    unsigned char* hm;
    DI void operator()(const f32x4 (&acc)[2][2][4][2], const Unit& u, int wr, int wc, int fr, int fq) const {
        const int row0 = u.pm * 256 + wr * 64 + fr, col0 = u.pn * 128 + wc * 32 + 8 * fq;
#pragma unroll
        for (int ai = 0; ai < 2; ++ai)
#pragma unroll
            for (int m = 0; m < 4; ++m) { f32x4 v0, v1;
#pragma unroll
                for (int j = 0; j < 4; ++j) { const float g0 = acc[ai][0][m][0][j], g1 = acc[ai][0][m][1][j]; v0[j] = g0 * sigmoidf_(g0) * acc[ai][1][m][0][j]; v1[j] = g1 * sigmoidf_(g1) * acc[ai][1][m][1][j]; }
                u32x2 o; o.x = pk4_fp8(v0[0], v0[1], v0[2], v0[3]); o.y = pk4_fp8(v1[0], v1[1], v1[2], v1[3]);
                *(GAS u32x2*)(hm + (size_t)(row0 + ai * 128 + m * 16) * 1024 + col0) = o; }
    }
};
struct EpiM2 {
    static constexpr bool PERM = true;
    unsigned char* ys; const int* list; const volatile LAS int* pre;
    DI void operator()(const f32x4 (&acc)[2][2][4][2], const Unit& u, int wr, int wc, int fr, int fq) const {
        const int lrow0 = wr * 64 + fr, col0 = u.pn * 256 + wc * 32 + 8 * fq; const int lt = u.pm - rfl(pre[u.e]);
        const int* lp = list + (size_t)u.e * T + 256 * lt;
#pragma unroll
        for (int ai = 0; ai < 2; ++ai)
#pragma unroll
            for (int m = 0; m < 4; ++m) { const int r = lrow0 + ai * 128 + m * 16;
                if (r < u.nv) { const int slot = lp[r]; unsigned char* yp = ys + (size_t)slot * 1024 + col0;
#pragma unroll
                    for (int bj = 0; bj < 2; ++bj) { const f32x4 v0 = acc[ai][bj][m][0], v1 = acc[ai][bj][m][1]; u32x2 o; o.x = pk4_fp8(v0[0], v0[1], v0[2], v0[3]); o.y = pk4_fp8(v1[0], v1[1], v1[2], v1[3]); *(GAS u32x2*)(yp + bj * 128) = o; } } }
    }
};

template <bool F8>
DI void tr_item(const float* W, int N, void* WTv, int K, int drow, int c0, int nvalid, int kb, LAS float* scr, int lane) {
    const int k0 = 64 * kb;
    { const int cc = lane & 31, ccl = cc < nvalid ? cc : 0; const float* wp = W + (size_t)(k0 + (lane >> 5)) * N + c0 + ccl; float v[32];
#pragma unroll
      for (int i = 0; i < 32; ++i) v[i] = wp[(size_t)(2 * i) * N];
#pragma unroll
      for (int i = 0; i < 32; ++i) scr[(2 * i + (lane >> 5)) * 33 + cc] = (cc < nvalid) ? v[i] : 0.f; }
    LDS_WAIT(); asm volatile("" ::: "memory");
    const int c = lane & 7;
#pragma unroll
    for (int j = 0; j < 4; ++j) { const int n = (lane >> 3) + 8 * j; const LAS float* s = scr + (8 * c) * 33 + n;
        if constexpr (F8) { u32x2 o; o.x = pk4_fp8(s[0 * 33] * W8_SCALE, s[1 * 33] * W8_SCALE, s[2 * 33] * W8_SCALE, s[3 * 33] * W8_SCALE); o.y = pk4_fp8(s[4 * 33] * W8_SCALE, s[5 * 33] * W8_SCALE, s[6 * 33] * W8_SCALE, s[7 * 33] * W8_SCALE);
            *(GAS u32x2*)((unsigned char*)WTv + (size_t)(drow + n) * K + k0 + 8 * c) = o; }
        else { u32x4 o; o.x = cvt_pk_bf16(s[0 * 33], s[1 * 33]); o.y = cvt_pk_bf16(s[2 * 33], s[3 * 33]); o.z = cvt_pk_bf16(s[4 * 33], s[5 * 33]); o.w = cvt_pk_bf16(s[6 * 33], s[7 * 33]);
            *(GAS u32x4*)((bf16_t*)WTv + (size_t)(drow + n) * K + k0 + 8 * c) = o; } }
    LDS_WAIT(); asm volatile("" ::: "memory");
}
DI void phase_w(LAS unsigned char* lds, const Ctx& c, int l, int G) {
    const int tid = ltid(), lane = tid & 63, wave = rfl(tid >> 6);
    LAS float* scr = (LAS float*)(lds + wave * 16384);
    const int gw = lbid() * NWAVES + wave, NGW = G * NWAVES;
    constexpr int I_IN = (NIN / 32) * 16, I_GO = 512, I_AO = 256, I_OUT = 512, I_EXP = 16 * 512;
    constexpr int NITEMS = I_IN + I_GO + I_AO + I_OUT + 3 * I_EXP;
    for (int it = gw; it < NITEMS; it += NGW) {
        int r = it;
        if (r < I_IN) {
            const int nbg = r >> 4, kb = r & 15, n0 = 32 * nbg, tile = n0 >> 8, p = n0 & 255; int c0, nv = 32;
            if (tile < 12) c0 = n0;
            else if (tile < 24) { const int base = tile < 18 ? 3088 : 4624, tq = tile < 18 ? tile - 12 : tile - 18; c0 = base + (4 * tq + ((p & 127) >> 5)) * 64 + (p >= 128 ? 32 : 0); }
            else if (tile < 30) c0 = 6160 + (n0 - 24 * 256);
            else if (tile < 38) c0 = 7696 + (n0 - 30 * 256);
            else { c0 = 3072; nv = (p == 0) ? 16 : 0; }
            tr_item<true>(c.w_in + (size_t)l * D * DIN, DIN, c.ws + WS_WIN, D, n0, c0, nv, kb, scr, lane); continue; }
        r -= I_IN;
        if (r < I_GO) { tr_item<false>(c.w_gla_o + (size_t)l * D * D, D, wsb(c, WS_WGO), D, 32 * (r >> 4), 32 * (r >> 4), 32, r & 15, scr, lane); continue; }
        r -= I_GO;
        if (r < I_AO) { tr_item<false>(c.w_att_o + (size_t)l * 512 * D, D, wsb(c, WS_WAO), 512, 32 * (r >> 3), 32 * (r >> 3), 32, r & 7, scr, lane); continue; }
        r -= I_AO;
        if (r < I_OUT) { tr_item<false>(c.w_out + (size_t)l * D * D, D, wsb(c, WS_WOUT), D, 32 * (r >> 4), 32 * (r >> 4), 32, r & 15, scr, lane); continue; }
        r -= I_OUT;
        const int which = r / I_EXP; r -= which * I_EXP; const int e = r >> 9, q = r & 511, nbg = q >> 4, kb = q & 15;
        const size_t eoff = (size_t)(l * NEXP + e) * D * DFF;
        if (which == 0) tr_item<true>(c.w_e_gate + eoff, DFF, c.ws + WS_WGU + (size_t)e * 2048 * 1024, D, 256 * (nbg >> 2) + 32 * (nbg & 3), 32 * nbg, 32, kb, scr, lane);
        else if (which == 1) tr_item<true>(c.w_e_up + eoff, DFF, c.ws + WS_WGU + (size_t)e * 2048 * 1024, D, 256 * (nbg >> 2) + 128 + 32 * (nbg & 3), 32 * nbg, 32, kb, scr, lane);
        else tr_item<true>(c.w_e_down + eoff, D, c.ws + WS_WD + (size_t)e * 1024 * 1024, DFF, 32 * nbg, 32 * nbg, 32, kb, scr, lane);
    }
    if (l == 0) {
        const size_t n8 = (size_t)T * D / 8; unsigned char* xb = c.ws + WS_XB;
        for (size_t i = (size_t)lbid() * NTHREADS + tid; i < n8; i += (size_t)G * NTHREADS) { const f32x4 a = *(const GAS f32x4*)(c.x + i * 8), b = *(const GAS f32x4*)(c.x + i * 8 + 4);
            u32x2 o; o.x = pk4_fp8(a[0], a[1], a[2], a[3]); o.y = pk4_fp8(b[0], b[1], b[2], b[3]); *(GAS u32x2*)(xb + i * 8) = o; }
    }
}

DI s16x4 tr16(const LAS void* p) { return __builtin_bit_cast(s16x4, __builtin_amdgcn_ds_read_tr16_b64_v4i16((LAS s16x4*)p)); }
DI bf16x8 cat8(s16x4 lo, s16x4 hi) { return __builtin_shufflevector(lo, hi, 0, 1, 2, 3, 4, 5, 6, 7); }
#define MFMA16(a, b, c) __builtin_amdgcn_mfma_f32_16x16x32_bf16((a), (b), (c), 0, 0, 0)

constexpr int REC_BYTES = 33792, REC_KS = 16384, REC_DEC = 32768, OI_BYTES = 32768;
constexpr int GP_QT = 0, GP_KT = 17408, GP_VS = 34816, GP_ATT = 68608, GP_WUP = 77824, GP_BAL = 86016;
DI float exp_(float x) { return __builtin_amdgcn_exp2f(x * LOG2E); }
DI void unpack8(const u32x4& q, float (&v)[16], int o) { v[o] = bf_lo(q.x); v[o + 1] = bf_hi(q.x); v[o + 2] = bf_lo(q.y); v[o + 3] = bf_hi(q.y); v[o + 4] = bf_lo(q.z); v[o + 5] = bf_hi(q.z); v[o + 6] = bf_lo(q.w); v[o + 7] = bf_hi(q.w); }
DI u32x4 packf8(const float (&v)[16], int o) { u32x4 p; p.x = cvt_pk_bf16(v[o], v[o + 1]); p.y = cvt_pk_bf16(v[o + 2], v[o + 3]); p.z = cvt_pk_bf16(v[o + 4], v[o + 5]); p.w = cvt_pk_bf16(v[o + 6], v[o + 7]); return p; }
DI void gla_p_unit(LAS unsigned char* lds, const Ctx& c, int l, int bl, int h, int n, int& h_loaded) {
    const int tid = ltid(), lane = tid & 63, w = rfl(tid >> 6), fr = lane & 15, fq = lane >> 4;
    const size_t tok0 = (size_t)bl * SEQ + n * 64;
    const bf16_t* QG = wsb(c, WS_H + H_QG) + tok0 * 512 + h * 128;
    const bf16_t* KG = wsb(c, WS_H + H_KG) + tok0 * 512 + h * 128;
    const bf16_t* VG = wsb(c, WS_H + H_VG) + tok0 * 1024 + h * 256;
    const float* HA = (const float*)(c.ws + WS_HA) + tok0 * 16;
    const int unit = (bl * 4 + h) * 64 + n;
    unsigned char* rec = c.ws + WS_REC + (size_t)unit * REC_BYTES;
    unsigned char* oi = c.ws + WS_MIX + (size_t)unit * OI_BYTES;
    LAS bf16_t* QT = (LAS bf16_t*)(lds + GP_QT); LAS bf16_t* KT = (LAS bf16_t*)(lds + GP_KT); LAS bf16_t* VS = (LAS bf16_t*)(lds + GP_VS); LAS bf16_t* AT = (LAS bf16_t*)(lds + GP_ATT);
    LAS float* WUP = (LAS float*)(lds + GP_WUP); LAS float* BAL = (LAS float*)(lds + GP_BAL);
    __syncthreads();
    if (h_loaded != h) { for (int i = tid; i < 16 * 128; i += NTHREADS) WUP[i] = c.w_alpha_up[(size_t)l * 16 * 512 + (i >> 7) * 512 + h * 128 + (i & 127)];
        if (tid < 128) BAL[tid] = c.b_alpha[l * 512 + h * 128 + tid]; h_loaded = h; __syncthreads(); }
    {
        const int row = lane;
        f32x4 a4[4];
#pragma unroll
        for (int j = 0; j < 4; ++j) a4[j] = *(const GAS f32x4*)(HA + (size_t)row * 16 + 4 * j);
        const u32x4 q0 = *(const GAS u32x4*)(QG + (size_t)row * 512 + 16 * w), q1 = *(const GAS u32x4*)(QG + (size_t)row * 512 + 16 * w + 8);
        const u32x4 k0 = *(const GAS u32x4*)(KG + (size_t)row * 512 + 16 * w), k1 = *(const GAS u32x4*)(KG + (size_t)row * 512 + 16 * w + 8);
#pragma unroll
        for (int c2 = 0; c2 < 4; ++c2) { const int idx = tid + NTHREADS * c2, r = idx >> 5, ch = idx & 31; *(LAS u32x4*)(VS + r * 264 + ch * 8) = *(const GAS u32x4*)(VG + (size_t)r * 1024 + ch * 8); }
        float la[16];
#pragma unroll
        for (int cc = 0; cc < 16; ++cc) la[cc] = BAL[16 * w + cc];
#pragma unroll
        for (int j = 0; j < 16; ++j) { const float aj = a4[j >> 2][j & 3];
#pragma unroll
            for (int c4 = 0; c4 < 4; ++c4) { const f32x4 wv = *(const LAS f32x4*)(WUP + j * 128 + 16 * w + 4 * c4); la[4 * c4] += aj * wv[0]; la[4 * c4 + 1] += aj * wv[1]; la[4 * c4 + 2] += aj * wv[2]; la[4 * c4 + 3] += aj * wv[3]; } }
#pragma unroll
        for (int cc = 0; cc < 16; ++cc) { const float z = la[cc]; la[cc] = -(fmaxf(-z, 0.f) + __builtin_amdgcn_logf(1.0f + exp_(-fabsf(z))) * 0.6931471805599453f) * (1.0f / 16.0f); }
#pragma unroll
        for (int dlt = 1; dlt < 64; dlt <<= 1)
#pragma unroll
            for (int cc = 0; cc < 16; ++cc) { const float t = __shfl_up(la[cc], dlt); if (lane >= dlt) la[cc] += t; }
        float qv[16], kv[16];
        unpack8(q0, qv, 0); unpack8(q1, qv, 8); unpack8(k0, kv, 0); unpack8(k1, kv, 8);
        float dc[16];
#pragma unroll
        for (int cc = 0; cc < 16; ++cc) { const float b = la[cc]; const float bend = __shfl(b, 63); const float eb = exp_(b); dc[cc] = eb; qv[cc] *= eb; la[cc] = kv[cc] * exp_(bend - b); kv[cc] *= exp_(-b); }
        if (lane == 63) {
#pragma unroll
            for (int c4 = 0; c4 < 4; ++c4) *(GAS f32x4*)(rec + REC_DEC + (16 * w + 4 * c4) * 4) = (f32x4){dc[4 * c4], dc[4 * c4 + 1], dc[4 * c4 + 2], dc[4 * c4 + 3]}; }
        const u32x4 qa = packf8(qv, 0), qb = packf8(qv, 8), ka = packf8(kv, 0), kb = packf8(kv, 8), sa = packf8(la, 0), sb = packf8(la, 8);
        *(LAS u32x4*)(QT + row * 136 + 16 * w) = qa; *(LAS u32x4*)(QT + row * 136 + 16 * w + 8) = qb;
        *(LAS u32x4*)(KT + row * 136 + 16 * w) = ka; *(LAS u32x4*)(KT + row * 136 + 16 * w + 8) = kb;
        *(GAS u32x4*)(rec + row * 256 + (((2 * w) ^ (row & 15)) << 4)) = qa; *(GAS u32x4*)(rec + row * 256 + (((2 * w + 1) ^ (row & 15)) << 4)) = qb;
        *(GAS u32x4*)(rec + REC_KS + row * 256 + (((2 * w) ^ (2 * (row & 7))) << 4)) = sa; *(GAS u32x4*)(rec + REC_KS + row * 256 + (((2 * w + 1) ^ (2 * (row & 7))) << 4)) = sb;
    }
    __syncthreads();
#pragma unroll
    for (int rep = 0; rep < 2; ++rep) {
        const int tt = w + 8 * rep, jt = tt >> 2, it = tt & 3;
        f32x4 a = (f32x4){0.f, 0.f, 0.f, 0.f};
        if (jt <= it) {
#pragma unroll
            for (int k4 = 0; k4 < 4; ++k4) { const bf16x8 af = *(const LAS bf16x8*)(KT + (16 * jt + fr) * 136 + 32 * k4 + 8 * fq), bfr = *(const LAS bf16x8*)(QT + (16 * it + fr) * 136 + 32 * k4 + 8 * fq); a = MFMA16(af, bfr, a); }
        }
        const int i = 16 * it + fr, j0 = 16 * jt + 4 * fq;
        u32x2 o; o.x = cvt_pk_bf16(j0 <= i ? a[0] : 0.f, j0 + 1 <= i ? a[1] : 0.f); o.y = cvt_pk_bf16(j0 + 2 <= i ? a[2] : 0.f, j0 + 3 <= i ? a[3] : 0.f);
        *(LAS u32x2*)(AT + i * 72 + j0) = o;
    }
    __syncthreads();
    {
        const int dv0 = 32 * w;
        bf16x8 vb[2][2];
#pragma unroll
        for (int k2 = 0; k2 < 2; ++k2)
#pragma unroll
            for (int dt = 0; dt < 2; ++dt) { const LAS bf16_t* p = VS + (32 * k2 + 8 * fq + (fr >> 2)) * 264 + dv0 + 16 * dt + (fr & 3) * 4; vb[k2][dt] = cat8(tr16(p), tr16(p + 4 * 264)); }
#pragma unroll
        for (int tt = 0; tt < 4; ++tt) {
            const bf16x8 a0 = *(const LAS bf16x8*)(AT + (16 * tt + fr) * 72 + 8 * fq), a1 = *(const LAS bf16x8*)(AT + (16 * tt + fr) * 72 + 32 + 8 * fq);
#pragma unroll
            for (int dt = 0; dt < 2; ++dt) { f32x4 z = (f32x4){0.f, 0.f, 0.f, 0.f}; z = MFMA16(vb[0][dt], a0, z); z = MFMA16(vb[1][dt], a1, z);
                u32x2 pk; pk.x = cvt_pk_bf16(z[0], z[1]); pk.y = cvt_pk_bf16(z[2], z[3]); *(GAS u32x2*)(oi + ((w * 8 + tt * 2 + dt) * 64 + lane) * 8) = pk; }
        }
    }
}
constexpr int GSEG = 16, NSEG = 64 / GSEG;
constexpr int GL_STAGE = 50176, GL_DEC = 16384, GL_VS = 17408;
DI void gla_l_chain(LAS unsigned char* lds, const Ctx& c, int bl, int h, int seg) {
    const int tid = ltid(), lane = tid & 63, w = rfl(tid >> 6), fr = lane & 15, fq = lane >> 4;
    const size_t t0 = (size_t)bl * SEQ + (size_t)seg * (GSEG * 64);
    const bf16_t* VG = wsb(c, WS_H + H_VG) + t0 * 1024 + h * 256;
    const unsigned char* rec0 = c.ws + WS_REC + (size_t)((bl * 4 + h) * 64 + seg * GSEG) * REC_BYTES;
    const int dv0 = 32 * w; const unsigned lds_u = (unsigned)(uintptr_t)lds;
    f32x4 S[8][2], Dc[8];
#pragma unroll
    for (int a = 0; a < 8; ++a) { S[a][0] = (f32x4){0.f, 0.f, 0.f, 0.f}; S[a][1] = (f32x4){0.f, 0.f, 0.f, 0.f}; Dc[a] = (f32x4){1.f, 1.f, 1.f, 1.f}; }
#define GL_DMA(gp, ldsoff) do { unsigned _sv; const unsigned _m = (unsigned)__builtin_amdgcn_readfirstlane((int)(ldsoff)); \
        asm volatile("s_mov_b32 %0, m0\n\ts_mov_b32 m0, %2\n\ts_nop 0\n\tglobal_load_lds_dwordx4 %1, off\n\ts_mov_b32 m0, %0" : "=&s"(_sv) : "v"(gp), "s"(_m) : "memory"); } while (0)
#define GL_PREFETCH(nn, st) do { const unsigned char* _r = rec0 + (size_t)(nn) * REC_BYTES + REC_KS; const unsigned _s = lds_u + (unsigned)(st) * GL_STAGE; \
        _Pragma("unroll") for (int _p = 0; _p < 2; ++_p) GL_DMA((const GAS unsigned char*)(_r + (w * 2 + _p) * 1024 + lane * 16), _s + (w * 2 + _p) * 1024); \
        if (w == 0) GL_DMA((const GAS unsigned char*)(_r + 16384 + lane * 16), _s + GL_DEC); \
        _Pragma("unroll") for (int _p = 0; _p < 4; ++_p) { const int _row = 2 * (w * 4 + _p) + (lane >> 5); \
            GL_DMA((const GAS bf16_t*)(VG + (size_t)((nn) * 64 + _row) * 1024 + (((lane & 31) ^ (2 * (_row & 3))) << 3)), _s + GL_VS + (w * 4 + _p) * 1024); } } while (0)
    __syncthreads();
    GL_PREFETCH(0, 0);
    for (int n = 0; n < GSEG; ++n) {
        const int st = n & 1; LAS unsigned char* sb_ = lds + st * GL_STAGE;
        LAS bf16_t* KS = (LAS bf16_t*)sb_; LAS float* DEC = (LAS float*)(sb_ + GL_DEC); LAS bf16_t* VS = (LAS bf16_t*)(sb_ + GL_VS);
        VM_WAIT(); asm volatile("s_waitcnt lgkmcnt(0)" ::: "memory"); __builtin_amdgcn_s_barrier(); asm volatile("" ::: "memory");
        if (n + 1 < GSEG) GL_PREFETCH(n + 1, st ^ 1);
        bf16x8 vb[2][2];
#pragma unroll
        for (int k2 = 0; k2 < 2; ++k2)
#pragma unroll
            for (int dt = 0; dt < 2; ++dt) { const int r0 = 32 * k2 + 8 * fq + (fr >> 2);
                const LAS bf16_t* p = VS + r0 * 256 + ((((dv0 + 16 * dt) >> 3) ^ (2 * (r0 & 3))) << 3) + (fr & 3) * 4; vb[k2][dt] = cat8(tr16(p), tr16(p + 4 * 256)); }
#pragma unroll
        for (int k8 = 0; k8 < 8; ++k8) {
            const f32x4 dc = *(const LAS f32x4*)(DEC + 16 * k8 + 4 * fq);
            S[k8][0] *= dc; S[k8][1] *= dc; Dc[k8] *= dc;
#pragma unroll
            for (int k2 = 0; k2 < 2; ++k2) { const int r0 = 32 * k2 + 8 * fq + (fr >> 2);
                const LAS bf16_t* p0 = KS + r0 * 128 + (((2 * k8) ^ (2 * (r0 & 7))) << 3) + (fr & 3) * 4; const LAS bf16_t* p1 = KS + (r0 + 4) * 128 + (((2 * k8) ^ (2 * ((r0 + 4) & 7))) << 3) + (fr & 3) * 4;
                const bf16x8 af = cat8(tr16(p0), tr16(p1));
                S[k8][0] = MFMA16(af, vb[k2][0], S[k8][0]); S[k8][1] = MFMA16(af, vb[k2][1], S[k8][1]); }
        }
    }
#undef GL_PREFETCH
#undef GL_DMA
    const int cj = (bl * 4 + h) * NSEG + seg;
    GAS f32x4* sl = (GAS f32x4*)(c.ws + WS_SLOC) + ((size_t)(cj * 8 + w) * 16) * 64 + lane;
#pragma unroll
    for (int a = 0; a < 8; ++a) { sl[(a * 2) * 64] = S[a][0]; sl[(a * 2 + 1) * 64] = S[a][1]; }
    if (w == 0) { GAS f32x4* dq = (GAS f32x4*)(c.ws + WS_DCUM) + (size_t)cj * 8 * 64 + lane;
#pragma unroll
        for (int a = 0; a < 8; ++a) dq[a * 64] = Dc[a]; }
    VM_WAIT(); __syncthreads();
}
constexpr int GS_STAGE = 66560, GS_KS = 16384, GS_DEC = 32768, GS_VS = 33792, GS_SS = 2 * GS_STAGE;
DI void gla_s_chain(LAS unsigned char* lds, const Ctx& c, int l, int bl, int h, int seg) {
    const int tid = ltid(), lane = tid & 63, w = rfl(tid >> 6), fr = lane & 15, fq = lane >> 4;
    const size_t t0 = (size_t)bl * SEQ + (size_t)seg * (GSEG * 64);
    const bf16_t* VG = wsb(c, WS_H + H_VG) + t0 * 1024 + h * 256;
    const bf16_t* SR = wsb(c, WS_H + H_SR) + t0 * 1024 + h * 256;
    bf16_t* OG = wsb(c, WS_OG) + t0 * 1024 + h * 256;
    const unsigned char* rec0 = c.ws + WS_REC + (size_t)((bl * 4 + h) * 64 + seg * GSEG) * REC_BYTES;
    const unsigned char* oi0 = c.ws + WS_MIX + (size_t)((bl * 4 + h) * 64 + seg * GSEG) * OI_BYTES;
    LAS float* SS = (LAS float*)(lds + GS_SS);
    const int dv0 = 32 * w;
    f32x4 gnv[2]; gnv[0] = *(const GAS f32x4*)(c.gla_norm + l * 1024 + h * 256 + dv0 + 4 * fq); gnv[1] = *(const GAS f32x4*)(c.gla_norm + l * 1024 + h * 256 + dv0 + 16 + 4 * fq);
    f32x4 S[8][2];
#pragma unroll
    for (int a = 0; a < 8; ++a) { S[a][0] = (f32x4){0.f, 0.f, 0.f, 0.f}; S[a][1] = (f32x4){0.f, 0.f, 0.f, 0.f}; }
    for (int j = 0; j < seg; ++j) {
        const int cj = (bl * 4 + h) * NSEG + j;
        const GAS f32x4* sl = (const GAS f32x4*)(c.ws + WS_SLOC) + ((size_t)(cj * 8 + w) * 16) * 64 + lane; const GAS f32x4* dq = (const GAS f32x4*)(c.ws + WS_DCUM) + (size_t)cj * 8 * 64 + lane;
#pragma unroll
        for (int a = 0; a < 8; ++a) { const f32x4 dcv = dq[a * 64]; S[a][0] = S[a][0] * dcv + sl[(a * 2) * 64]; S[a][1] = S[a][1] * dcv + sl[(a * 2 + 1) * 64]; }
    }
#define GS_DMA(gp, ldsoff) do { unsigned _sv; const unsigned _m = (unsigned)__builtin_amdgcn_readfirstlane((int)(ldsoff)); \
        asm volatile("s_mov_b32 %0, m0\n\ts_mov_b32 m0, %2\n\ts_nop 0\n\tglobal_load_lds_dwordx4 %1, off\n\ts_mov_b32 m0, %0" : "=&s"(_sv) : "v"(gp), "s"(_m) : "memory"); } while (0)
#define GS_PREFETCH(nn, st) do { const unsigned char* _r = rec0 + (size_t)(nn) * REC_BYTES; const unsigned _s = lds_u + (unsigned)(st) * GS_STAGE; \
        _Pragma("unroll") for (int _p = 0; _p < 4; ++_p) GS_DMA((const GAS unsigned char*)(_r + (w * 4 + _p) * 1024 + lane * 16), _s + (w * 4 + _p) * 1024); \
        if (w == 0) GS_DMA((const GAS unsigned char*)(_r + 32768 + lane * 16), _s + 32768); \
        _Pragma("unroll") for (int _p = 0; _p < 4; ++_p) { const int _row = 2 * (w * 4 + _p) + (lane >> 5); \
            GS_DMA((const GAS bf16_t*)(VG + (size_t)((nn) * 64 + _row) * 1024 + (((lane & 31) ^ (2 * (_row & 3))) << 3)), _s + GS_VS + (w * 4 + _p) * 1024); } } while (0)
    const unsigned lds_u = (unsigned)(uintptr_t)lds;
#define GS_BAR() do { asm volatile("s_waitcnt lgkmcnt(0)" ::: "memory"); __builtin_amdgcn_s_barrier(); asm volatile("" ::: "memory"); } while (0)
    __syncthreads();
    GS_PREFETCH(0, 0);
    for (int n = 0; n < GSEG; ++n) {
        const int st = n & 1; LAS unsigned char* sb_ = lds + st * GS_STAGE;
        LAS bf16_t* QT = (LAS bf16_t*)sb_; LAS bf16_t* KS = (LAS bf16_t*)(sb_ + GS_KS); LAS float* DEC = (LAS float*)(sb_ + GS_DEC); LAS bf16_t* VS = (LAS bf16_t*)(sb_ + GS_VS); LAS bf16_t* OST = (LAS bf16_t*)(sb_ + GS_KS);
        VM_WAIT(); GS_BAR();
        u32x2 oiv[8];
#pragma unroll
        for (int q = 0; q < 8; ++q) oiv[q] = *(const GAS u32x2*)(oi0 + (size_t)n * OI_BYTES + ((w * 8 + q) * 64 + lane) * 8);
        u32x2 srv[8];
#pragma unroll
        for (int q = 0; q < 8; ++q) srv[q] = *(const GAS u32x2*)(SR + (size_t)(n * 64 + 16 * (q >> 1) + fr) * 1024 + dv0 + 16 * (q & 1) + 4 * fq);
        asm volatile("" ::: "memory");
        if (n + 1 < GSEG) GS_PREFETCH(n + 1, st ^ 1);
        f32x4 o[4][2];
        {
            bf16x8 vb[2][2];
#pragma unroll
            for (int k2 = 0; k2 < 2; ++k2)
#pragma unroll
                for (int dt = 0; dt < 2; ++dt) { const int r0 = 32 * k2 + 8 * fq + (fr >> 2);
                    const LAS bf16_t* p = VS + r0 * 256 + ((((dv0 + 16 * dt) >> 3) ^ (2 * (r0 & 3))) << 3) + (fr & 3) * 4; vb[k2][dt] = cat8(tr16(p), tr16(p + 4 * 256)); }
#pragma unroll
            for (int tt = 0; tt < 4; ++tt) { o[tt][0] = (f32x4){0.f, 0.f, 0.f, 0.f}; o[tt][1] = (f32x4){0.f, 0.f, 0.f, 0.f}; }
#pragma unroll
            for (int s = 0; s < 4; ++s) {
                bf16x8 sb[2];
#pragma unroll
                for (int dt = 0; dt < 2; ++dt) { u32x4 pk; pk.x = cvt_pk_bf16(S[2 * s][dt][0], S[2 * s][dt][1]); pk.y = cvt_pk_bf16(S[2 * s][dt][2], S[2 * s][dt][3]); pk.z = cvt_pk_bf16(S[2 * s + 1][dt][0], S[2 * s + 1][dt][1]); pk.w = cvt_pk_bf16(S[2 * s + 1][dt][2], S[2 * s + 1][dt][3]); sb[dt] = __builtin_bit_cast(bf16x8, pk); }
#pragma unroll
                for (int tt = 0; tt < 4; ++tt) { const int i = 16 * tt + fr;
                    const LAS bf16_t* qp = QT + i * 128 + (fq & 1) * 4;
                    const bf16x8 af = cat8(*(const LAS s16x4*)(qp + (((4 * s + (fq >> 1)) ^ (i & 15)) << 3)), *(const LAS s16x4*)(qp + (((4 * s + 2 + (fq >> 1)) ^ (i & 15)) << 3)));
                    o[tt][0] = MFMA16(sb[0], af, o[tt][0]); o[tt][1] = MFMA16(sb[1], af, o[tt][1]); }
            }
#pragma unroll
            for (int k8 = 0; k8 < 8; ++k8) {
                const f32x4 dc = *(const LAS f32x4*)(DEC + 16 * k8 + 4 * fq);
                S[k8][0] *= dc; S[k8][1] *= dc;
#pragma unroll
                for (int k2 = 0; k2 < 2; ++k2) { const int r0 = 32 * k2 + 8 * fq + (fr >> 2);
                    const LAS bf16_t* p0 = KS + r0 * 128 + (((2 * k8) ^ (2 * (r0 & 7))) << 3) + (fr & 3) * 4; const LAS bf16_t* p1 = KS + (r0 + 4) * 128 + (((2 * k8) ^ (2 * ((r0 + 4) & 7))) << 3) + (fr & 3) * 4;
                    const bf16x8 af = cat8(tr16(p0), tr16(p1));
                    S[k8][0] = MFMA16(af, vb[k2][0], S[k8][0]); S[k8][1] = MFMA16(af, vb[k2][1], S[k8][1]); }
            }
        }
#pragma unroll
        for (int tt = 0; tt < 4; ++tt)
#pragma unroll
            for (int dt = 0; dt < 2; ++dt) { const u32x2 v = oiv[tt * 2 + dt]; o[tt][dt][0] += bf_lo(v.x); o[tt][dt][1] += bf_hi(v.x); o[tt][dt][2] += bf_lo(v.y); o[tt][dt][3] += bf_hi(v.y); }
        {
            f32x4 pp;
#pragma unroll
            for (int tt = 0; tt < 4; ++tt) { const f32x4 a = o[tt][0] * o[tt][0] + o[tt][1] * o[tt][1]; float p = (a[0] + a[1]) + (a[2] + a[3]); p += __shfl_xor(p, 16); p += __shfl_xor(p, 32); pp[tt] = p; }
            if (fq == 0) { SS[(0 * 16 + fr) * 8 + w] = pp[0]; SS[(1 * 16 + fr) * 8 + w] = pp[1]; SS[(2 * 16 + fr) * 8 + w] = pp[2]; SS[(3 * 16 + fr) * 8 + w] = pp[3]; }
        }
        GS_BAR();
#pragma unroll
        for (int tt = 0; tt < 4; ++tt) { const f32x4 s0 = *(const LAS f32x4*)(SS + (16 * tt + fr) * 8), s1 = *(const LAS f32x4*)(SS + (16 * tt + fr) * 8 + 4);
            const float ss = ((s0[0] + s0[1]) + (s0[2] + s0[3])) + ((s1[0] + s1[1]) + (s1[2] + s1[3])); const float rs = __builtin_amdgcn_rsqf(ss * (1.0f / 256.0f) + RMS_EPS);
#pragma unroll
            for (int dt = 0; dt < 2; ++dt) { const u32x2 sv = srv[tt * 2 + dt]; const f32x4 g = gnv[dt]; const f32x4 v = o[tt][dt] * rs;
                u32x2 rr; rr.x = cvt_pk_bf16(v[0] * g[0] * bf_lo(sv.x), v[1] * g[1] * bf_hi(sv.x)); rr.y = cvt_pk_bf16(v[2] * g[2] * bf_lo(sv.y), v[3] * g[3] * bf_hi(sv.y));
                *(GAS u32x2*)(OG + (size_t)(n * 64 + 16 * tt + fr) * 1024 + dv0 + 16 * dt + 4 * fq) = rr; } }
    }
#undef GS_PREFETCH
#undef GS_DMA
#undef GS_BAR
    VM_WAIT(); __syncthreads();
}

constexpr int AT_K = 0, AT_V = 55296;
DI void attn_unit2(LAS unsigned char* lds, const Ctx& c, int bl, int g, int h, int x) {
    const int tid = ltid(), lane = tid & 63, w = rfl(tid >> 6), fr = lane & 15, fq = lane >> 4;
    const int dl = (g == 0) ? 1 : (g == 1 ? 4 : 16), nb = 32 / dl, r = x / nb, n = x - r * nb;
    const size_t tb = (size_t)bl * SEQ + r; const int colo = g * 512 + h * 64;
    const bf16_t* Q = wsb(c, WS_H + H_QD) + colo; const bf16_t* K = wsb(c, WS_H + H_KD) + colo; const bf16_t* V = wsb(c, WS_H + H_VD) + colo;
    LAS bf16_t* Ks = (LAS bf16_t*)(lds + AT_K); LAS bf16_t* Vs = (LAS bf16_t*)(lds + AT_V);
    bf16x8 qf[2][2];
#pragma unroll
    for (int b = 0; b < 2; ++b) { const size_t tokq = tb + (size_t)dl * (128 * (n + b) + 16 * w + fr);
#pragma unroll
        for (int d0 = 0; d0 < 2; ++d0) qf[b][d0] = *(const GAS bf16x8*)(Q + tokq * 1536 + 32 * d0 + 8 * fq); }
    __syncthreads();
#pragma unroll
    for (int c2 = 0; c2 < 6; ++c2) { const int idx = tid + NTHREADS * c2, row = idx >> 3, ch = idx & 7; const int j = 128 * (n - 1) + row;
        u32x4 kv = (u32x4){0u, 0u, 0u, 0u}, vv = (u32x4){0u, 0u, 0u, 0u};
        if (j >= 0) { const size_t tok = tb + (size_t)dl * j; kv = *(const GAS u32x4*)(K + tok * 1536 + ch * 8); vv = *(const GAS u32x4*)(V + tok * 1536 + ch * 8); }
        *(LAS u32x4*)(Ks + row * 72 + ch * 8) = kv; *(LAS u32x4*)(Vs + row * 72 + ch * 8) = vv; }
    __syncthreads();
#pragma unroll
    for (int b = 0; b < 2; ++b) {
        const int kt0 = 8 * b + w;
        f32x4 s[9]; float m = -1e30f;
#pragma unroll
        for (int kr = 0; kr < 9; ++kr) { const int kt = kt0 + kr; f32x4 a = (f32x4){0.f, 0.f, 0.f, 0.f};
#pragma unroll
            for (int d0 = 0; d0 < 2; ++d0) { const bf16x8 af = *(const LAS bf16x8*)(Ks + (16 * kt + fr) * 72 + 32 * d0 + 8 * fq); a = MFMA16(af, qf[b][d0], a); }
#pragma unroll
            for (int rg = 0; rg < 4; ++rg) { const int rel = 16 * kr + 4 * fq + rg - fr; const bool ok = rel >= 0 && rel <= 128 && (b > 0 || n > 0 || 16 * kt + 4 * fq + rg >= 128); a[rg] = ok ? a[rg] : -1e30f; m = fmaxf(m, a[rg]); }
            s[kr] = a; }
        m = fmaxf(m, __shfl_xor(m, 16)); m = fmaxf(m, __shfl_xor(m, 32));
        float lsum = 0.f;
#pragma unroll
        for (int kr = 0; kr < 9; ++kr)
#pragma unroll
            for (int rg = 0; rg < 4; ++rg) { const float p = s[kr][rg] > -1e29f ? __builtin_amdgcn_exp2f(s[kr][rg] - m) : 0.f; s[kr][rg] = p; lsum += p; }
        lsum += __shfl_xor(lsum, 16); lsum += __shfl_xor(lsum, 32);
        f32x4 oT[4];
#pragma unroll
        for (int dt = 0; dt < 4; ++dt) oT[dt] = (f32x4){0.f, 0.f, 0.f, 0.f};
#pragma unroll
        for (int pp = 0; pp < 5; ++pp) { const int ka = 2 * pp, kb = (2 * pp + 1 < 9) ? 2 * pp + 1 : 8;
            u32x4 pk; pk.x = cvt_pk_bf16(s[ka][0], s[ka][1]); pk.y = cvt_pk_bf16(s[ka][2], s[ka][3]);
            if (2 * pp + 1 < 9) { pk.z = cvt_pk_bf16(s[kb][0], s[kb][1]); pk.w = cvt_pk_bf16(s[kb][2], s[kb][3]); } else { pk.z = 0u; pk.w = 0u; }
            const bf16x8 pf = __builtin_bit_cast(bf16x8, pk);
#pragma unroll
            for (int dt = 0; dt < 4; ++dt) { const LAS bf16_t* pa = Vs + (16 * (kt0 + ka) + 4 * fq + (fr >> 2)) * 72 + 16 * dt + (fr & 3) * 4; const LAS bf16_t* pb = Vs + (16 * (kt0 + kb) + 4 * fq + (fr >> 2)) * 72 + 16 * dt + (fr & 3) * 4;
                oT[dt] = MFMA16(cat8(tr16(pa), tr16(pb)), pf, oT[dt]); } }
        const float inv = 1.0f / lsum; const size_t tq = tb + (size_t)dl * (128 * (n + b) + 16 * w + fr);
        bf16_t* op = wsb(c, WS_ATTG) + ((size_t)g * TH + tq) * 512 + h * 64 + 4 * fq;
#pragma unroll
        for (int dt = 0; dt < 4; ++dt) { u32x2 o; o.x = cvt_pk_bf16(oT[dt][0] * inv, oT[dt][1] * inv); o.y = cvt_pk_bf16(oT[dt][2] * inv, oT[dt][3] * inv); *(GAS u32x2*)(op + 16 * dt) = o; }
        if (fq == 0) ((float*)(c.ws + WS_LSE))[((size_t)g * TH + tq) * 8 + h] = m + __builtin_amdgcn_logf(lsum);
    }
}
DI void phase_p(LAS unsigned char* lds, const Ctx& c, int l, int G) {
    int h_loaded = -1;
    for (int u = lbid(); u < 8 * 4 * 64; u += G) gla_p_unit(lds, c, l, u >> 8, (u >> 6) & 3, u & 63, h_loaded);
}
constexpr int NATT = 8 * 3 * 8 * 32, NATT1 = 2304, NCHAIN = 8 * 4 * NSEG;
DI void attn_pull(LAS unsigned char* lds, const Ctx& c, unsigned* ctr, int base, int limit) {
    volatile LAS int* TK = (volatile LAS int*)(lds + MISC_OFF + 192);
    const int tid = ltid();
    __syncthreads();
    if (tid == 0) TK[0] = base + 2 * (int)__hip_atomic_fetch_add(ctr, 1u, __ATOMIC_RELAXED, __HIP_MEMORY_SCOPE_AGENT);
    __syncthreads();
    int u = rfl(TK[0]);
    while (u < limit) {
        int nxt = 0; if (tid == 0) nxt = base + 2 * (int)__hip_atomic_fetch_add(ctr, 1u, __ATOMIC_RELAXED, __HIP_MEMORY_SCOPE_AGENT);
        attn_unit2(lds, c, u / 768, (u / 256) % 3, (u >> 5) & 7, u & 31);
        __syncthreads();
        if (tid == 0) TK[0] = nxt;
        __syncthreads();
        u = rfl(TK[0]);
    }
}
DI void phase_b1(LAS unsigned char* lds, const Ctx& c, int l, int hf, int G) {
    const int bid = lbid(); unsigned* ctr = (unsigned*)(c.ws + WS_CTL) + CW_TKT + ((l * 2 + hf) * 2) * 64;
    for (int id = bid; id < NCHAIN; id += G) gla_l_chain(lds, c, id >> 4, (id >> 2) & 3, id & 3);
    attn_pull(lds, c, ctr, 0, NATT1);
}
DI void phase_b(LAS unsigned char* lds, const Ctx& c, int l, int hf, int G) {
    const int bid = lbid(); unsigned* ctr = (unsigned*)(c.ws + WS_CTL) + CW_TKT + ((l * 2 + hf) * 2 + 1) * 64;
    for (int id = bid; id < NCHAIN; id += G) gla_s_chain(lds, c, l, id >> 4, (id >> 2) & 3, id & 3);
    attn_pull(lds, c, ctr, NATT1, NATT);
}
DI void phase_f(const Ctx& c, int G) {
    const bf16_t* ag = wsb(c, WS_ATTG); const float* lse = (const float*)(c.ws + WS_LSE); bf16_t* att = wsb(c, WS_ATT);
    for (size_t i = (size_t)lbid() * NTHREADS + ltid(); i < (size_t)TH * 64; i += (size_t)G * NTHREADS) {
        const size_t tok = i >> 6; const int ch = (int)(i & 63), h = ch >> 3;
        const float l0 = lse[tok * 8 + h], l1 = lse[((size_t)TH + tok) * 8 + h], l2 = lse[((size_t)2 * TH + tok) * 8 + h];
        const float mx = fmaxf(l0, fmaxf(l1, l2)); float w0 = __builtin_amdgcn_exp2f(l0 - mx), w1 = __builtin_amdgcn_exp2f(l1 - mx), w2 = __builtin_amdgcn_exp2f(l2 - mx);
        const float inv = 1.0f / (w0 + w1 + w2); w0 *= inv; w1 *= inv; w2 *= inv;
        const u32x4 a = *(const GAS u32x4*)(ag + tok * 512 + ch * 8), b = *(const GAS u32x4*)(ag + ((size_t)TH + tok) * 512 + ch * 8), d = *(const GAS u32x4*)(ag + ((size_t)2 * TH + tok) * 512 + ch * 8);
        u32x4 o;
        o.x = cvt_pk_bf16(w0 * bf_lo(a.x) + w1 * bf_lo(b.x) + w2 * bf_lo(d.x), w0 * bf_hi(a.x) + w1 * bf_hi(b.x) + w2 * bf_hi(d.x));
        o.y = cvt_pk_bf16(w0 * bf_lo(a.y) + w1 * bf_lo(b.y) + w2 * bf_lo(d.y), w0 * bf_hi(a.y) + w1 * bf_hi(b.y) + w2 * bf_hi(d.y));
        o.z = cvt_pk_bf16(w0 * bf_lo(a.z) + w1 * bf_lo(b.z) + w2 * bf_lo(d.z), w0 * bf_hi(a.z) + w1 * bf_hi(b.z) + w2 * bf_hi(d.z));
        o.w = cvt_pk_bf16(w0 * bf_lo(a.w) + w1 * bf_lo(b.w) + w2 * bf_lo(d.w), w0 * bf_hi(a.w) + w1 * bf_hi(b.w) + w2 * bf_hi(d.w));
        *(GAS u32x4*)(att + tok * 512 + ch * 8) = o;
    }
}

DI float wave_sum(float v) {
#pragma unroll
    for (int o = 1; o < 64; o <<= 1) v += __shfl_xor(v, o);
    return v;
}
constexpr int R_WR = 0, R_HIST = 65536, R_BASE = 65536 + 64, R_INFO = 65536 + 128;
DI void phase_r(LAS unsigned char* lds, const Ctx& c, int l, int G) {
    const int tid = ltid(), lane = tid & 63, wave = rfl(tid >> 6);
    LAS float* WR = (LAS float*)(lds + R_WR); volatile LAS int* HIST = (volatile LAS int*)(lds + R_HIST); volatile LAS int* BASE = (volatile LAS int*)(lds + R_BASE); volatile LAS int* INFO = (volatile LAS int*)(lds + R_INFO);
    __syncthreads();
    for (int i = tid; i < 16 * 1024; i += NTHREADS) WR[(i & 15) * 1024 + (i >> 4)] = c.w_router[i];
    f32x4 g4[4], b4[4];
#pragma unroll
    for (int j = 0; j < 4; ++j) { g4[j] = *(const GAS f32x4*)(c.ln1_g + l * D + 4 * lane + 256 * j); b4[j] = *(const GAS f32x4*)(c.ln1_b + l * D + 4 * lane + 256 * j); }
    bf16_t* xr = wsb(c, WS_XR); unsigned char* xb = c.ws + WS_XB; int* histg = (int*)(c.ws + WS_HISTG); float* gate = (float*)(c.ws + WS_GATE);
    for (int chunk = lbid(); chunk < T / 256; chunk += G) {
        __syncthreads();
        for (int rr = 0; rr < 32; ++rr) {
            const int rl = wave * 32 + rr; const size_t row = (size_t)chunk * 256 + rl;
            f32x4 v[4]; float s = 0.f;
#pragma unroll
            for (int j = 0; j < 4; ++j) { const u32x2 zq = *(const GAS u32x2*)(xr + row * D + 4 * lane + 256 * j); v[j] = (f32x4){bf_lo(zq.x), bf_hi(zq.x), bf_lo(zq.y), bf_hi(zq.y)}; s += (v[j][0] + v[j][1]) + (v[j][2] + v[j][3]); }
            const float mean = wave_sum(s) * (1.0f / D); float s2 = 0.f;
#pragma unroll
            for (int j = 0; j < 4; ++j) { v[j] = v[j] - mean; s2 += (v[j][0] * v[j][0] + v[j][1] * v[j][1]) + (v[j][2] * v[j][2] + v[j][3] * v[j][3]); }
            const float rstd = __builtin_amdgcn_rsqf(wave_sum(s2) * (1.0f / D) + LN_EPS);
#pragma unroll
            for (int j = 0; j < 4; ++j) { v[j] = v[j] * rstd * g4[j] + b4[j]; u32x2 xq; xq.x = cvt_pk_bf16(v[j][0], v[j][1]); xq.y = cvt_pk_bf16(v[j][2], v[j][3]); *(GAS u32x2*)(xr + row * D + 4 * lane + 256 * j) = xq;
                *(GAS unsigned*)(xb + row * D + 4 * lane + 256 * j) = pk4_fp8(v[j][0], v[j][1], v[j][2], v[j][3]); }
            float lg[16];
#pragma unroll
            for (int e = 0; e < 16; ++e) { float a = 0.f;
#pragma unroll
                for (int j = 0; j < 4; ++j) { const f32x4 wv = *(const LAS f32x4*)(WR + e * 1024 + 4 * lane + 256 * j); a += v[j][0] * wv[0] + v[j][1] * wv[1] + v[j][2] * wv[2] + v[j][3] * wv[3]; }
                lg[e] = wave_sum(a) + c.b_router[e]; }
            float mx = lg[0];
#pragma unroll
            for (int e = 1; e < 16; ++e) mx = fmaxf(mx, lg[e]);
            float se = 0.f;
#pragma unroll
            for (int e = 0; e < 16; ++e) { lg[e] = __expf(lg[e] - mx); se += lg[e]; }
            const float ise = 1.0f / se;
#pragma unroll
            for (int e = 0; e < 16; ++e) lg[e] *= ise;
            int gsel = 0; float gbest = -1.f;
#pragma unroll
            for (int gi = 0; gi < 4; ++gi) { const float a = lg[4 * gi], b = lg[4 * gi + 1], cc = lg[4 * gi + 2], d = lg[4 * gi + 3];
                const float sc = (a + b + cc + d) - fminf(fminf(a, b), fminf(cc, d)) - fminf(fmaxf(fminf(a, b), fminf(cc, d)), fminf(fmaxf(a, b), fmaxf(cc, d)));
                if (sc > gbest) { gbest = sc; gsel = gi; } }
            float p[4];
#pragma unroll
            for (int k = 0; k < 4; ++k) p[k] = gsel == 0 ? lg[k] : gsel == 1 ? lg[4 + k] : gsel == 2 ? lg[8 + k] : lg[12 + k];
            int i0 = 0; float v0 = p[0];
#pragma unroll
            for (int k = 1; k < 4; ++k) if (p[k] > v0) { v0 = p[k]; i0 = k; }
            int i1 = -1; float v1 = -1.f;
#pragma unroll
            for (int k = 0; k < 4; ++k) if (k != i0 && p[k] > v1) { v1 = p[k]; i1 = k; }
            if (lane == 0) { const int e0 = 4 * gsel + i0, e1 = 4 * gsel + i1; INFO[rl * 4 + 0] = e0; INFO[rl * 4 + 1] = e1;
                const float gs = 1.0f / (v0 + v1); gate[row * 2] = v0 * gs; gate[row * 2 + 1] = v1 * gs; }
        }
        __syncthreads();
        {
            int cnt0 = 0, cnt1 = 0; const unsigned long long lt = (1ull << lane) - 1ull;
#pragma unroll
            for (int b = 0; b < 4; ++b) { const int r = 64 * b + lane; const int e0 = INFO[r * 4], e1 = INFO[r * 4 + 1];
                const bool a0 = (e0 == 2 * wave) || (e1 == 2 * wave), a1 = (e0 == 2 * wave + 1) || (e1 == 2 * wave + 1);
                const unsigned long long m0 = __ballot(a0), m1 = __ballot(a1);
                if (a0) INFO[r * 4 + (e0 == 2 * wave ? 2 : 3)] = cnt0 + __popcll(m0 & lt);
                if (a1) INFO[r * 4 + (e0 == 2 * wave + 1 ? 2 : 3)] = cnt1 + __popcll(m1 & lt);
                cnt0 += __popcll(m0); cnt1 += __popcll(m1); }
            if (lane == 0) { histg[chunk * 16 + 2 * wave] = cnt0; histg[chunk * 16 + 2 * wave + 1] = cnt1; }
        }
        __syncthreads();
        if (tid < 256) { i32x4 v; v.x = INFO[tid * 4]; v.y = INFO[tid * 4 + 1]; v.z = INFO[tid * 4 + 2]; v.w = INFO[tid * 4 + 3]; ((GAS i32x4*)(c.ws + WS_INFO))[(size_t)chunk * 256 + tid] = v; }
        __syncthreads();
    }
}
DI void phase_r2(LAS unsigned char* lds, const Ctx& c, int l, int G) {
    const int tid = ltid(); volatile LAS int* BASE = (volatile LAS int*)(lds + R_BASE);
    const int* histg = (const int*)(c.ws + WS_HISTG); int* list = (int*)(c.ws + WS_LIST);
    unsigned* cur = (unsigned*)(c.ws + WS_CTL) + CW_CUR + l * 16 * 64;
    for (int chunk = lbid(); chunk < T / 256; chunk += G) {
        __syncthreads();
        if (tid < 16) BASE[tid] = 0;
        __syncthreads();
        { const int e = tid & 15; int s = 0; for (int cc = tid >> 4; cc < chunk; cc += 32) s += histg[cc * 16 + e]; if (s) atomicAdd((int*)&BASE[e], s); }
        __syncthreads();
        if (tid < 256) { const i32x4 v = ((const GAS i32x4*)(c.ws + WS_INFO))[(size_t)chunk * 256 + tid]; const int row = chunk * 256 + tid;
            list[(size_t)v.x * T + BASE[v.x] + v.z] = row * 2; list[(size_t)v.y * T + BASE[v.y] + v.w] = row * 2 + 1; }
        if (chunk == T / 256 - 1 && tid < 16) __hip_atomic_store(cur + tid * 64, (unsigned)(BASE[tid] + histg[chunk * 16 + tid]), __ATOMIC_RELAXED, __HIP_MEMORY_SCOPE_AGENT);
    }
}
DI int moe_setup(LAS unsigned char* lds, const Ctx& c, int l) {
    volatile LAS int* PRE = (volatile LAS int*)(lds + MISC_OFF); volatile LAS int* CNT = PRE + 17;
    unsigned* cur = (unsigned*)(c.ws + WS_CTL) + CW_CUR + l * 16 * 64;
    __syncthreads();
    if (threadIdx.x == 0) { int acc = 0; for (int e = 0; e < 16; ++e) { const int n = (int)__hip_atomic_load(cur + e * 64, __ATOMIC_RELAXED, __HIP_MEMORY_SCOPE_AGENT); PRE[e] = acc; CNT[e] = n; acc += (n + 255) >> 8; } PRE[16] = acc; }
    __syncthreads();
    return rfl(PRE[16]);
}
DI void phase_c(const Ctx& c, int l, int G) {
    const int tid = ltid(), lane = tid & 63, wave = rfl(tid >> 6);
    f32x4 g4[4], b4[4];
#pragma unroll
    for (int j = 0; j < 4; ++j) { g4[j] = *(const GAS f32x4*)(c.ln2_g + l * D + 4 * lane + 256 * j); b4[j] = *(const GAS f32x4*)(c.ln2_b + l * D + 4 * lane + 256 * j); }
    float* xo = c.out; bf16_t* xr = wsb(c, WS_XR); unsigned char* xb = c.ws + WS_XB; const unsigned char* ys = c.ws + WS_YS; const float* gate = (const float*)(c.ws + WS_GATE);
    for (size_t row = (size_t)lbid() * NWAVES + wave; row < (size_t)T; row += (size_t)G * NWAVES) {
        const float g0 = gate[row * 2], g1 = gate[row * 2 + 1];
        f32x4 v[4]; float s = 0.f;
#pragma unroll
        for (int j = 0; j < 4; ++j) { const u32x2 xq = *(const GAS u32x2*)(xr + row * D + 4 * lane + 256 * j);
            const unsigned y0 = *(const GAS unsigned*)(ys + (row * 2) * D + 4 * lane + 256 * j), y1 = *(const GAS unsigned*)(ys + (row * 2 + 1) * D + 4 * lane + 256 * j);
            const f32x2 y0a = __builtin_amdgcn_cvt_pk_f32_fp8((int)y0, false), y0b = __builtin_amdgcn_cvt_pk_f32_fp8((int)y0, true), y1a = __builtin_amdgcn_cvt_pk_f32_fp8((int)y1, false), y1b = __builtin_amdgcn_cvt_pk_f32_fp8((int)y1, true);
            v[j][0] = bf_lo(xq.x) * DN_ALPHA + g0 * y0a[0] + g1 * y1a[0]; v[j][1] = bf_hi(xq.x) * DN_ALPHA + g0 * y0a[1] + g1 * y1a[1];
            v[j][2] = bf_lo(xq.y) * DN_ALPHA + g0 * y0b[0] + g1 * y1b[0]; v[j][3] = bf_hi(xq.y) * DN_ALPHA + g0 * y0b[1] + g1 * y1b[1];
            s += (v[j][0] + v[j][1]) + (v[j][2] + v[j][3]); }
        const float mean = wave_sum(s) * (1.0f / D); float s2 = 0.f;
#pragma unroll
        for (int j = 0; j < 4; ++j) { v[j] = v[j] - mean; s2 += (v[j][0] * v[j][0] + v[j][1] * v[j][1]) + (v[j][2] * v[j][2] + v[j][3] * v[j][3]); }
        const float rstd = __builtin_amdgcn_rsqf(wave_sum(s2) * (1.0f / D) + LN_EPS);
#pragma unroll
        for (int j = 0; j < 4; ++j) { v[j] = v[j] * rstd * g4[j] + b4[j];
            if (l == DEPTH - 1) *(GAS f32x4*)(xo + row * D + 4 * lane + 256 * j) = v[j];
            else { u32x2 xq; xq.x = cvt_pk_bf16(v[j][0], v[j][1]); xq.y = cvt_pk_bf16(v[j][2], v[j][3]); *(GAS u32x2*)(xr + row * D + 4 * lane + 256 * j) = xq;
                *(GAS unsigned*)(xb + row * D + 4 * lane + 256 * j) = pk4_fp8(v[j][0], v[j][1], v[j][2], v[j][3]); } }
    }
}

DI Ctx load_ctx() {
    union { Ctx c; unsigned long long q[sizeof(Ctx) / 8]; } u;
#if defined(__HIP_DEVICE_COMPILE__)
    const __attribute__((address_space(4))) unsigned long long* p = (const __attribute__((address_space(4))) unsigned long long*)__builtin_amdgcn_kernarg_segment_ptr();
    asm volatile("" : "+s"(p));
#pragma unroll
    for (int i = 0; i < (int)(sizeof(Ctx) / 8); ++i) u.q[i] = p[i];
#endif
    return u.c;
}
#define CTX const Ctx c = load_ctx(); const int G = lgrid(); LAS unsigned char* lds = LDSBASE
__global__ void __launch_bounds__(NTHREADS, 2) mk_fwd(Ctx c_arg) {
    extern __shared__ __attribute__((aligned(16))) unsigned char lds_raw[];
#define LDSBASE ({ unsigned _b = (unsigned)(uintptr_t)(LAS unsigned char*)lds_raw; asm volatile("" : "+s"(_b)); (LAS unsigned char*)(uintptr_t)_b; })
    LAS unsigned char* lds0 = LDSBASE;
    const int tid = threadIdx.x; const Ctx c = load_ctx();
    volatile LAS unsigned* MISC = (volatile LAS unsigned*)(lds0 + MISC_OFF);
    if (tid < 64) MISC[tid] = 0u;
    __syncthreads();
    XcdBarrier bar; bar.bar = (unsigned*)(c.ws + WS_CTL) + CW_BAR; bar.x = 0; bar.st = MISC + 40;
    if (!MK_MULTI) bar = xcd_barrier_post((unsigned*)(c.ws + WS_CTL) + CW_BAR, MISC + 40);
    const int lo = c.lo, hi = c.hi; int step = 0;
#define RUN (lo <= step && step < hi)
#define END_STEP do { if (RUN && step + 1 < hi) { if (!MK_MULTI) xcd_barrier(bar); } ++step; } while (0)
#define END_STEP_NB do { ++step; } while (0)
    for (int l = 0; l < DEPTH; ++l) {
        if (RUN) { CTX; phase_w(lds, c, l, G); }
        END_STEP;
        for (int hf = 0; hf < 2; ++hf) {
            const size_t r0 = (size_t)hf * TH;
            if (RUN) {
                CTX;
                pg8::StaticOrder S; S.init(c.ws + WS_XB + r0 * D, c.ws + WS_WIN, TH, NIN, D / 2, G, lbid());
                EpiIn E{wsb(c, WS_H + H_QG), wsb(c, WS_H + H_KG), wsb(c, WS_H + H_VG), wsb(c, WS_H + H_SR), wsb(c, WS_H + H_QD), wsb(c, WS_H + H_KD), wsb(c, WS_H + H_VD), wsb(c, WS_H + H_GT), (float*)(c.ws + WS_HA), c.pos + r0};
                pg8::gemm_phase<EpiIn, pg8::StaticOrder, true>(lds, D / 2, S, E);
            }
            END_STEP;
            if (RUN) { CTX; phase_p(lds, c, l, G); }
            END_STEP;
            if (RUN) { CTX; phase_b1(lds, c, l, hf, G); }
            END_STEP;
            if (RUN) { CTX; phase_b(lds, c, l, hf, G); }
            END_STEP;
            if (RUN) { CTX; (void)lds; phase_f(c, G); }
            END_STEP_NB;
            if (RUN) {
                CTX;
                pg8::StaticOrder S; S.init(wsb(c, WS_OG), wsb(c, WS_WGO), TH, D, D, G, lbid());
                EpiGate<false> E{wsb(c, WS_MIX), c.ws + WS_H + H_GT};
                pg8::gemm_phase(lds, D, S, E);
            }
            END_STEP;
            if (RUN) {
                CTX;
                pg8::StaticOrder S; S.init(wsb(c, WS_ATT), wsb(c, WS_WAO), TH, D, 512, G, lbid());
                EpiGate<true> E{wsb(c, WS_MIX), c.ws + WS_H + H_GT + 1024};
                pg8::gemm_phase(lds, 512, S, E);
            }
            END_STEP;
            if (RUN) {
                CTX;
                pg8::StaticOrder S; S.init(wsb(c, WS_MIX), wsb(c, WS_WOUT), TH, D, D, G, lbid());
                EpiRes E{l == 0 ? c.x + r0 * D : nullptr, wsb(c, WS_XR) + r0 * D};
                pg8::gemm_phase(lds, D, S, E);
            }
            if (hf == 1) END_STEP; else END_STEP_NB;
        }
        if (RUN) { CTX; phase_r(lds, c, l, G); }
        END_STEP;
        if (RUN) { CTX; phase_r2(lds, c, l, G); }
        END_STEP;
        if (RUN) {   CTX;
            const int ntiles = moe_setup(lds, c, l);
            volatile LAS int* PRE = (volatile LAS int*)(lds + MISC_OFF); volatile LAS int* TAB = (volatile LAS int*)(lds + TAB_OFF);
            pg8::MoeOrder S; S.G = G; S.c = vcu_of(lbid(), G); S.ntot = ntiles * 8; S.NC = 8; S.K = D / 2; S.pre = PRE; S.cnt = PRE + 17; S.A = (const char*)(c.ws + WS_XB); S.Bt = (const char*)(c.ws + WS_WGU);
            S.bstride = (size_t)2048 * 1024; S.tab = TAB; S.gather = true;
            const int* list = (const int*)(c.ws + WS_LIST);
            { const int lt_tid = ltid(); const int r = lt_tid & 255, half = rfl(lt_tid >> 8);
              for (int i0 = 0; i0 < MAXU; i0 += 2) { Unit u; const int i = i0 + half;
                  if (S.next(i, u)) { const int lt = u.pm - PRE[u.e]; const int pos = 256 * lt + (r < u.nv ? r : 0); TAB[i * 256 + r] = list[(size_t)u.e * T + pos] >> 1; } } }
            __syncthreads();
            EpiM1 E{c.ws + WS_HM};
            pg8::gemm_phase<EpiM1, pg8::MoeOrder, true>(lds, D / 2, S, E);
        }
        END_STEP;
        if (RUN) {   CTX;
            const int ntiles = moe_setup(lds, c, l);
            volatile LAS int* PRE = (volatile LAS int*)(lds + MISC_OFF);
            pg8::MoeOrder S; S.G = G; S.c = vcu_of(lbid(), G); S.ntot = ntiles * 4; S.NC = 4; S.K = DFF / 2; S.pre = PRE; S.cnt = PRE + 17; S.A = (const char*)(c.ws + WS_HM); S.Bt = (const char*)(c.ws + WS_WD);
            S.bstride = (size_t)1024 * 1024; S.tab = nullptr; S.gather = false;
            EpiM2 E{c.ws + WS_YS, (const int*)(c.ws + WS_LIST), PRE};
            pg8::gemm_phase<EpiM2, pg8::MoeOrder, true>(lds, DFF / 2, S, E);
        }
        END_STEP;
        if (RUN) { CTX; (void)lds; phase_c(c, l, G); }
        END_STEP_NB;
    }
#undef RUN
#undef END_STEP
#undef END_STEP_NB
}
constexpr int NSTEPS = DEPTH * (1 + 2 * 8 + 5);

extern "C" void kernel_launch(void* const* d_in, const int* in_sizes, int n_in, void* d_out, int out_size, void* d_ws, size_t ws_size, hipStream_t stream) {
    static int grid = 0;
    if (grid == 0) {
        if (n_in != 18 || in_sizes[0] != T * D || out_size != T * D || ws_size < WS_END) { fprintf(stderr, "kernel_launch: unexpected shapes / workspace (need %zu, got %zu)\n", (size_t)WS_END, ws_size); grid = -1; return; }
        int dev = 0, cus = 0;
        if (hipGetDevice(&dev) != hipSuccess || hipDeviceGetAttribute(&cus, hipDeviceAttributeMultiprocessorCount, dev) != hipSuccess) { grid = -1; return; }
        if (hipFuncSetAttribute((const void*)mk_fwd, hipFuncAttributeMaxDynamicSharedMemorySize, LDS_BYTES) != hipSuccess) { fprintf(stderr, "kernel_launch: hipFuncSetAttribute failed\n"); grid = -1; return; }
        int per_cu = 0;
        if (hipOccupancyMaxActiveBlocksPerMultiprocessor(&per_cu, (const void*)mk_fwd, NTHREADS, LDS_BYTES) != hipSuccess || per_cu < 1) { fprintf(stderr, "kernel_launch: occupancy query says %d\n", per_cu); }
        (void)hipGetLastError();
        grid = cus;
    }
    if (grid < 0) return;
    (void)hipMemsetAsync((char*)d_ws + WS_CTL, 0, CTL_ZERO_BYTES, stream);
    Ctx c{};
    c.x = (const float*)d_in[0]; c.pos = (const int*)d_in[1]; c.w_in = (const float*)d_in[2]; c.w_alpha_up = (const float*)d_in[3]; c.b_alpha = (const float*)d_in[4]; c.gla_norm = (const float*)d_in[5];
    c.w_gla_o = (const float*)d_in[6]; c.w_att_o = (const float*)d_in[7]; c.w_out = (const float*)d_in[8]; c.ln1_g = (const float*)d_in[9]; c.ln1_b = (const float*)d_in[10]; c.w_router = (const float*)d_in[11];
    c.b_router = (const float*)d_in[12]; c.w_e_gate = (const float*)d_in[13]; c.w_e_up = (const float*)d_in[14]; c.w_e_down = (const float*)d_in[15]; c.ln2_g = (const float*)d_in[16]; c.ln2_b = (const float*)d_in[17];
    c.out = (float*)d_out; c.ws = (unsigned char*)d_ws;
#if MK_MULTI
    for (int s = 0; s < NSTEPS; ++s) { c.lo = s; c.hi = s + 1; hipLaunchKernelGGL(mk_fwd, dim3(grid), dim3(NTHREADS), LDS_BYTES, stream, c); }
#else
    c.lo = 0; c.hi = NSTEPS; hipLaunchKernelGGL(mk_fwd, dim3(grid), dim3(NTHREADS), LDS_BYTES, stream, c);
#endif
}
```

```cpp
#include <hip/hip_runtime.h>
#include <cstdio>
#include <cstdint>

#ifndef MK_MULTI
#define MK_MULTI 0
#endif

#define DI __device__ __forceinline__
#define GAS __attribute__((address_space(1)))
#define LAS __attribute__((address_space(3)))
typedef unsigned short bf16_t;
typedef short bf16x8 __attribute__((ext_vector_type(8)));
typedef short s16x4 __attribute__((ext_vector_type(4)));
typedef float f32x4 __attribute__((ext_vector_type(4)));
typedef float f32x2 __attribute__((ext_vector_type(2)));
typedef unsigned u32x4 __attribute__((ext_vector_type(4)));
typedef unsigned u32x2 __attribute__((ext_vector_type(2)));
typedef int i32x4 __attribute__((ext_vector_type(4)));
typedef int i32x8 __attribute__((ext_vector_type(8)));
#define LDS_WAIT() asm volatile("s_waitcnt lgkmcnt(0)" ::: "memory")
#define VM_WAIT() asm volatile("s_waitcnt vmcnt(0)" ::: "memory")

constexpr int D = 1024, NBATCH = 16, SEQ = 4096, T = NBATCH * SEQ, DEPTH = 4;
constexpr int TH = T / 2;
constexpr int DIN = 9744, NIN = 9984;
constexpr int NEXP = 16, DFF = 1024;
constexpr float LN_EPS = 1e-5f, RMS_EPS = 1e-6f;
constexpr float DN_ALPHA = 1.6817928305074290f;
constexpr float LOG2E = 1.4426950408889634f;
constexpr int NWAVES = 8, NTHREADS = 512;

constexpr size_t MiB = 1u << 20;
constexpr size_t WS_CTL = 0, CTL_ZERO_BYTES = 1 * MiB;
constexpr size_t WS_WIN = 1 * MiB;
constexpr size_t WS_WGO = WS_WIN + (size_t)NIN * D;
constexpr size_t WS_WAO = WS_WGO + 2 * MiB;
constexpr size_t WS_WOUT = WS_WAO + 1 * MiB;
constexpr size_t WS_WGU = WS_WOUT + 2 * MiB;
constexpr size_t WS_WD = WS_WGU + 32 * MiB;
constexpr size_t WS_XB = WS_WD + 16 * MiB;
constexpr size_t WS_XR = WS_XB + 64 * MiB;
constexpr size_t WS_LIST = WS_XR + 128 * MiB;
constexpr size_t WS_GATE = WS_LIST + 4 * MiB;
constexpr size_t WS_INFO = WS_GATE + 1 * MiB;
constexpr size_t WS_HISTG = WS_INFO + 1 * MiB;
constexpr size_t WS_OG = WS_HISTG + 1 * MiB;
constexpr size_t WS_ATTG = WS_OG + 64 * MiB;
constexpr size_t WS_LSE = WS_ATTG + 96 * MiB;
constexpr size_t WS_ATT = WS_LSE + 3 * MiB;
constexpr size_t WS_MIX = WS_ATT + 32 * MiB;
constexpr size_t WS_HA = WS_MIX + 64 * MiB;
constexpr size_t WS_H = WS_HA + 2 * MiB;
constexpr size_t H_QG = 0, H_KG = H_QG + (size_t)TH * 512 * 2, H_VG = H_KG + (size_t)TH * 512 * 2, H_SR = H_VG + (size_t)TH * 1024 * 2,
                 H_QD = H_SR + (size_t)TH * 1024 * 2, H_KD = H_QD + (size_t)TH * 1536 * 2, H_VD = H_KD + (size_t)TH * 1536 * 2, H_GT = H_VD + (size_t)TH * 1536 * 2,
                 H_END = H_GT + (size_t)TH * 2048 * 2;
constexpr size_t WS_HM = WS_H;
constexpr size_t WS_YS = WS_HM + (size_t)(2 * T + 4096) * 1024 * 2;
constexpr size_t WS_REC = WS_H + H_END;
constexpr size_t WS_SLOC = WS_REC + (size_t)2048 * 33792;
constexpr size_t WS_DCUM = WS_SLOC + 16 * MiB;
constexpr size_t WS_END = WS_DCUM + 1 * MiB;
static_assert(WS_YS + (size_t)2 * T * 1024 * 2 <= WS_END, "MoE overlay fits");
constexpr int CW_BAR = 4096;
constexpr int CW_TKT = 24576;
constexpr int CW_CUR = 16384;

constexpr int RING_BYTES = 131072;
constexpr int TAB_OFF = RING_BYTES, MAXU = 18, TAB_BYTES = MAXU * 1024;
constexpr int MISC_OFF = TAB_OFF + TAB_BYTES;
constexpr int LDS_BYTES = MISC_OFF + 256;

DI int rfl(int v) { return __builtin_amdgcn_readfirstlane(v); }
DI int lbid() { int t = blockIdx.x; asm volatile("" : "+s"(t)); return t; }
DI int lgrid() { int t = gridDim.x; asm volatile("" : "+s"(t)); return t; }
DI int vcu_of(int bid, int G) { return (G % 8 == 0) ? (bid % 8) * (G / 8) + bid / 8 : bid; }
DI int ltid() { int t = threadIdx.x; asm volatile("" : "+v"(t)); return t; }
DI float bf2f(unsigned b) { return __uint_as_float(b << 16); }
typedef __bf16 bf16x2_t __attribute__((ext_vector_type(2)));
DI unsigned cvt_pk_bf16(float lo, float hi) { f32x2 v = {lo, hi}; bf16x2_t b = __builtin_convertvector(v, bf16x2_t); return __builtin_bit_cast(unsigned, b); }
DI float clamp8(float v) { return fminf(fmaxf(v, -448.f), 448.f); }
DI unsigned pk4_fp8(float a, float b, float c_, float d) { int w = 0; w = __builtin_amdgcn_cvt_pk_fp8_f32(clamp8(a), clamp8(b), w, false); w = __builtin_amdgcn_cvt_pk_fp8_f32(clamp8(c_), clamp8(d), w, true); return (unsigned)w; }
constexpr float W8_SCALE = 64.0f;
DI float bf_lo(unsigned w) { return __uint_as_float(w << 16); }
DI float bf_hi(unsigned w) { return __uint_as_float(w & 0xffff0000u); }
DI float sigmoidf_(float x) { return __builtin_amdgcn_rcpf(1.0f + __builtin_amdgcn_exp2f(-x * LOG2E)); }

#define XB_TMO      128
#define XB_XCNT(j)  (256  + 64 * (j))
#define XB_XSUB(j)  (1280 + 64 * (j))
#define XB_XGEN(j)  (2304 + 64 * (j))
#define XB_TOP      3328
#define XB_TOPGEN   3392
#define XCD_BAR_WORDS 3456
#define XB_SPIN_CAP (1u << 18)
DI unsigned xb_ld(unsigned* p)              { return __hip_atomic_load(p, __ATOMIC_RELAXED, __HIP_MEMORY_SCOPE_AGENT); }
DI unsigned xb_add(unsigned* p, unsigned v) { return __hip_atomic_fetch_add(p, v, __ATOMIC_RELAXED, __HIP_MEMORY_SCOPE_AGENT); }
DI unsigned xb_xcc_id() { return (unsigned)__builtin_amdgcn_s_getreg((3 << 11) | 20) & 0xFu; }
#define XB_SPIN(cond, bar) do { unsigned _sp = 0; while (cond) { __builtin_amdgcn_s_sleep(1); \
    if ((++_sp & 255u) == 0u) { if (xb_ld(&(bar)[XB_TMO])) break; if (_sp > XB_SPIN_CAP) { atomicAdd(&(bar)[XB_TMO], 1u); break; } } } } while (0)
struct XcdBarrier { unsigned* bar; unsigned x; volatile LAS unsigned* st; };
DI XcdBarrier xcd_barrier_post(unsigned* bar, volatile LAS unsigned* st) {
    XcdBarrier b; b.bar = bar; b.x = xb_xcc_id(); b.st = st;
    if (threadIdx.x == 0) (void)xb_add(&bar[XB_XCNT(b.x)], 1u);
    return b;
}
DI void xcd_barrier_complete(unsigned* bar, unsigned x, unsigned& nloc, unsigned& nx) {
    const unsigned G = gridDim.x * gridDim.y * gridDim.z;
    unsigned sum, cnt, mine, sp = 0u;
    for (;;) {
        sum = 0u; cnt = 0u; mine = 0u;
#pragma unroll
        for (unsigned j = 0; j < 16; ++j) { const unsigned c = xb_ld(&bar[XB_XCNT(j)]); sum += c; cnt += (c > 0u) ? 1u : 0u; mine = (j == x) ? c : mine; }
        if (sum == G) break;
        __builtin_amdgcn_s_sleep(1);
        if ((++sp & 255u) == 0u) { if (xb_ld(&bar[XB_TMO])) break; if (sp > XB_SPIN_CAP) { atomicAdd(&bar[XB_TMO], 1u); break; } }
    }
    nloc = mine > 0u ? mine : 1u; nx = cnt > 0u ? cnt : 1u;
}
DI void xcd_barrier(const XcdBarrier& b) {
    asm volatile("s_waitcnt vmcnt(0)" ::: "memory");
    __syncthreads();
    if (threadIdx.x == 0) {
        unsigned* bar = b.bar;
        __builtin_amdgcn_s_waitcnt(0);
        unsigned nloc = b.st[0], nx = b.st[1];
        if (nloc == 0u) { xcd_barrier_complete(bar, b.x, nloc, nx); b.st[0] = nloc; b.st[1] = nx; }
        const unsigned old = xb_add(&bar[XB_XSUB(b.x)], 1u);
        const unsigned gen = old / nloc;
        if (old + 1u == (gen + 1u) * nloc) {
            __builtin_amdgcn_fence(__ATOMIC_RELEASE, "agent");
            asm volatile("s_waitcnt vmcnt(0)" ::: "memory");
            const unsigned og = xb_add(&bar[XB_TOP], 1u);
            const unsigned tg = og / nx;
            if (og + 1u == (tg + 1u) * nx) xb_add(&bar[XB_TOPGEN], 1u);
            else XB_SPIN(xb_ld(&bar[XB_TOPGEN]) == tg, bar);
            __builtin_amdgcn_fence(__ATOMIC_ACQUIRE, "agent");
            xb_add(&bar[XB_XGEN(b.x)], 1u);
            asm volatile("s_waitcnt vmcnt(0)" ::: "memory");
        } else {
            XB_SPIN(xb_ld(&bar[XB_XGEN(b.x)]) == gen, bar);
            __builtin_amdgcn_fence(__ATOMIC_ACQUIRE, "agent");
            asm volatile("s_waitcnt vmcnt(0)" ::: "memory");
        }
    }
    __syncthreads();
}

struct Ctx {
    const float* x; const int* pos; const float* w_in; const float* w_alpha_up; const float* b_alpha; const float* gla_norm;
    const float* w_gla_o; const float* w_att_o; const float* w_out; const float* ln1_g; const float* ln1_b; const float* w_router; const float* b_router;
    const float* w_e_gate; const float* w_e_up; const float* w_e_down; const float* ln2_g; const float* ln2_b;
    float* out; unsigned char* ws;
    int lo, hi;
};
DI bf16_t* wsb(const Ctx& c, size_t off) { return (bf16_t*)(c.ws + off); }

namespace pg8 {
constexpr int BM = 256, BK = 64, HALF = 128, HTB = HALF * BK * 2, STAGE_BYTES = 8 * HTB, NXCD = 8, WGM = 8;
DI int lds_byte(int r, int c) { const int st = (r >> 4) * 2 + (c >> 5), rr = r & 15, cc = c & 31, ob = rr * 64 + cc * 2; return st * 1024 + (ob ^ (((ob >> 9) & 1) << 5)); }
DI void stage_rc(int b, int& R, int& C) { const int st = b / 1024, sb = b % 1024, swz = sb ^ (((sb >> 9) & 1) << 5); R = (st >> 1) * 16 + swz / 64; C = (st & 1) * 32 + (swz % 64) / 2; }
DI int perm32(int rho) { const int n = rho >> 4, i = rho & 15; return 8 * (i >> 2) + 4 * n + (i & 3); }
struct Unit { int pm, pn, e, nv, ui; };

struct StaticOrder {
    int nM, nN, nwg, G, c, K; const char* A; const char* Bt;
    DI void init(const void* A_, const void* Bt_, int M, int N, int K_, int G_, int c_) { A = (const char*)A_; Bt = (const char*)Bt_; nM = M / BM; nN = N / BM; nwg = nM * nN; G = G_; c = c_; K = K_; }
    DI bool next(int i, Unit& u) const {
        const long L = (long)i * G + c; if (L >= nwg) return false;
        int wgid = (int)L; { const int q = nwg / NXCD, r = nwg % NXCD, xcd = wgid % NXCD, off = wgid / NXCD; wgid = (xcd < r ? xcd * (q + 1) : r * (q + 1) + (xcd - r) * q) + off; }
        const int nig = WGM * nN, gid = wgid / nig, fm = gid * WGM, gsz = (nM - fm) < WGM ? (nM - fm) : WGM;
        u.pm = fm + ((wgid % nig) % gsz); u.pn = (wgid % nig) / gsz; u.e = 0; u.nv = 256; u.ui = i; return true;
    }
    DI const char* a_base(const Unit& u) const { return A + (size_t)u.pm * BM * K * 2; }
    DI const char* b_base(const Unit& u) const { return Bt + (size_t)u.pn * BM * K * 2; }
    DI void a_off(const Unit&, int tid, unsigned (&o)[2][2]) const {
#pragma unroll
        for (int i = 0; i < 2; ++i) { int R, C; stage_rc(tid * 16 + i * 8192, R, C);
#pragma unroll
            for (int h = 0; h < 2; ++h) o[h][i] = (unsigned)((h * HALF + R) * K + C) * 2u; }
    }
};
struct MoeOrder {
    int G, c, ntot, NC, K; const volatile LAS int* pre; const volatile LAS int* cnt; const char* A; const char* Bt; size_t bstride; const volatile LAS int* tab; bool gather;
    DI bool next(int i, Unit& u) const {
        const int L = i * G + c; if (L >= ntot) return false;
        const int rt = L / NC; u.pn = L - rt * NC; u.pm = rt;
        int e = 0;
#pragma unroll
        for (int j = 1; j < 16; ++j) e += (rt >= rfl(pre[j])) ? 1 : 0;
        e = rfl(e); u.e = e; const int rem = rfl(cnt[e]) - 256 * (rt - rfl(pre[e])); u.nv = rem < 256 ? rem : 256; u.ui = i; return true;
    }
    DI const char* a_base(const Unit& u) const { return gather ? A : A + (size_t)u.pm * BM * K * 2; }
    DI const char* b_base(const Unit& u) const { return Bt + (size_t)u.e * bstride + (size_t)u.pn * BM * K * 2; }
    DI void a_off(const Unit& u, int tid, unsigned (&o)[2][2]) const {
#pragma unroll
        for (int i = 0; i < 2; ++i) { int R, C; stage_rc(tid * 16 + i * 8192, R, C);
#pragma unroll
            for (int h = 0; h < 2; ++h) { const int row = gather ? tab[u.ui * 256 + h * HALF + R] : (h * HALF + R); o[h][i] = (unsigned)(row * K + C) * 2u; } }
    }
};

template <class Epi, class Sched, bool F8 = false>
DI void gemm_phase(LAS unsigned char* lds, const int K, const Sched& S, const Epi& E) {
    const int tid = ltid(), wid = rfl(tid >> 6), lane = tid & 63, wr = wid >> 2, wc = wid & 3, fr = lane & 15, fq = lane >> 4;
    const int nt = K / BK;
    unsigned voffB[2];
#pragma unroll
    for (int i = 0; i < 2; ++i) { int R, C; stage_rc(tid * 16 + i * 8192, R, C); const int Rb = Epi::PERM ? ((R & ~31) + perm32(R & 31)) : R; voffB[i] = (unsigned)(Rb * K + C) * 2u; }
    const size_t kstep = (size_t)(BK * 2);
    const size_t hstep = (size_t)HALF * K * 2;
    const unsigned ldsw = (unsigned)wid * 1024u;
    const int aoff = lds_byte(wr * 64 + fr, fq * 8), boff = lds_byte(wc * 32 + fr, fq * 8);
#define PG8_SA(b, h) (((b) * 2 + (h)) * HTB)
#define PG8_SB(b, h) ((4 + (b) * 2 + (h)) * HTB)
#define PG8_STAGE(bufoff, gbase, voff) do { _Pragma("unroll") for (int _i = 0; _i < 2; ++_i) \
        __builtin_amdgcn_global_load_lds((const unsigned*)((const char*)(gbase) + (voff)[_i]), (LAS unsigned*)(lds + (bufoff) + ldsw + _i * 8192), 16, 0, 0); } while (0)
#define PG8_LD8(p) __builtin_shufflevector(*(const LAS i32x4*)(p), *(const LAS i32x4*)((p) + 1024), 0, 1, 2, 3, 4, 5, 6, 7)
#define PG8_LDA(dst, b, h) do { if constexpr (F8) { _Pragma("unroll") for (int m = 0; m < 4; ++m) dst##8[m] = PG8_LD8(lds + PG8_SA(b, h) + aoff + m * 2048); } else { \
        _Pragma("unroll") for (int m = 0; m < 4; ++m) _Pragma("unroll") for (int k = 0; k < 2; ++k) dst[m][k] = *(const LAS bf16x8*)(lds + PG8_SA(b, h) + aoff + m * 2048 + k * 1024); } } while (0)
#define PG8_LDB(dst, b, h) do { if constexpr (F8) { _Pragma("unroll") for (int n = 0; n < 2; ++n) dst##8[n] = PG8_LD8(lds + PG8_SB(b, h) + boff + n * 2048); } else { \
        _Pragma("unroll") for (int n = 0; n < 2; ++n) _Pragma("unroll") for (int k = 0; k < 2; ++k) dst[n][k] = *(const LAS bf16x8*)(lds + PG8_SB(b, h) + boff + n * 2048 + k * 1024); } } while (0)
#define PG8_MMA(ai, bj, At, Bt) do { __builtin_amdgcn_s_setprio(1); if constexpr (F8) { _Pragma("unroll") for (int m = 0; m < 4; ++m) _Pragma("unroll") for (int n = 0; n < 2; ++n) \
        asm volatile("v_mfma_scale_f32_16x16x128_f8f6f4 %0, %1, %2, %0, %3, %4 op_sel_hi:[0,0,0]" : "+v"(acc[ai][bj][m][n]) : "v"(Bt##8[n]), "v"(At##8[m]), "v"(sc_w), "v"(sc_a)); } else { \
        _Pragma("unroll") for (int m = 0; m < 4; ++m) _Pragma("unroll") for (int n = 0; n < 2; ++n) _Pragma("unroll") for (int k = 0; k < 2; ++k) \
        acc[ai][bj][m][n] = __builtin_amdgcn_mfma_f32_16x16x32_bf16(Bt[n][k], At[m][k], acc[ai][bj][m][n], 0, 0, 0); } __builtin_amdgcn_s_setprio(0); } while (0)
#define PG8_WAIT_V(n) asm volatile("s_waitcnt vmcnt(" #n ")" ::: "memory")
#define PG8_WAIT_L(n) asm volatile("s_waitcnt lgkmcnt(" #n ")" ::: "memory")
#define PG8_BAR __builtin_amdgcn_s_barrier()
#define PG8_SCHED __builtin_amdgcn_sched_barrier(0)
    Unit cur, nxt; int ui = 0;
    if (!S.next(0, cur)) return;
    f32x4 acc[2][2][4][2];
#pragma unroll
    for (int a = 0; a < 2; ++a)
#pragma unroll
        for (int b = 0; b < 2; ++b)
#pragma unroll
            for (int m = 0; m < 4; ++m)
#pragma unroll
                for (int n = 0; n < 2; ++n) acc[a][b][m][n] = (f32x4){0.f, 0.f, 0.f, 0.f};
    int sc_w = 0x79797979, sc_a = 0x7f7f7f7f; asm volatile("" : "+v"(sc_w), "+v"(sc_a));
    bf16x8 At[4][2], B0[2][2], B1[2][2]; i32x8 At8[4], B08[2], B18[2];
    unsigned oA[2][2]; S.a_off(cur, tid, oA);
    const char* cA = S.a_base(cur); const char* cB = S.b_base(cur);
    PG8_STAGE(PG8_SB(0, 0), cB, voffB); PG8_STAGE(PG8_SB(0, 1), cB + hstep, voffB); PG8_STAGE(PG8_SA(0, 0), cA, oA[0]); PG8_STAGE(PG8_SA(0, 1), cA, oA[1]);
    if (wr == 1) PG8_BAR;
    PG8_WAIT_V(2); PG8_BAR;
    PG8_STAGE(PG8_SB(1, 0), cB + kstep, voffB); PG8_STAGE(PG8_SA(1, 0), cA + kstep, oA[0]); PG8_STAGE(PG8_SB(1, 1), cB + hstep + kstep, voffB);
    PG8_WAIT_V(6); PG8_BAR;
    for (;;) {
        const bool has_next = S.next(ui + 1, nxt);
        const char* nA = has_next ? S.a_base(nxt) : cA; const char* nB = has_next ? S.b_base(nxt) : cB;
        for (int t = 0; t < nt; t += 2) {
            const bool last = (t == nt - 2);
            const char* a1 = cA + (size_t)(t + 1) * kstep;
            const char* a2 = last ? nA : cA + (size_t)(t + 2) * kstep; const char* b2 = last ? nB : cB + (size_t)(t + 2) * kstep;
            const char* a3 = a2 + kstep; const char* b3 = b2 + kstep;
            PG8_LDB(B0, 0, 0); PG8_LDB(B1, 0, 1); PG8_SCHED; PG8_LDA(At, 0, 0); PG8_STAGE(PG8_SA(1, 1), a1, oA[1]);
            if (last && has_next) S.a_off(nxt, tid, oA);
            PG8_WAIT_V(8); PG8_WAIT_L(0); PG8_BAR; PG8_MMA(0, 0, At, B0); PG8_MMA(0, 1, At, B1); PG8_BAR; PG8_SCHED;
            PG8_LDA(At, 0, 1); PG8_STAGE(PG8_SB(0, 0), b2, voffB); PG8_STAGE(PG8_SB(0, 1), b2 + hstep, voffB); PG8_STAGE(PG8_SA(0, 0), a2, oA[0]);
            PG8_WAIT_V(8); PG8_WAIT_L(0); PG8_BAR; PG8_MMA(1, 0, At, B0); PG8_MMA(1, 1, At, B1); PG8_BAR; PG8_SCHED;
            PG8_LDB(B0, 1, 0); PG8_LDB(B1, 1, 1); PG8_SCHED; PG8_LDA(At, 1, 0); PG8_STAGE(PG8_SA(0, 1), a2, oA[1]);
            PG8_WAIT_V(8); PG8_WAIT_L(0); PG8_BAR; PG8_MMA(0, 0, At, B0); PG8_MMA(0, 1, At, B1); PG8_BAR; PG8_SCHED;
            PG8_LDA(At, 1, 1); PG8_STAGE(PG8_SB(1, 0), b3, voffB); PG8_STAGE(PG8_SB(1, 1), b3 + hstep, voffB); PG8_STAGE(PG8_SA(1, 0), a3, oA[0]);
            PG8_WAIT_V(8); PG8_WAIT_L(0); PG8_BAR; PG8_MMA(1, 0, At, B0); PG8_MMA(1, 1, At, B1); PG8_BAR; PG8_SCHED;
        }
        if (wr == 0) PG8_BAR;
        if constexpr (F8) asm volatile("s_nop 15\n\ts_nop 15" ::: "memory");
        E(acc, cur, wr, wc, fr, fq);
        if (!has_next) break;
#pragma unroll
        for (int a = 0; a < 2; ++a)
#pragma unroll
            for (int b = 0; b < 2; ++b)
#pragma unroll
                for (int m = 0; m < 4; ++m)
#pragma unroll
                    for (int n = 0; n < 2; ++n) acc[a][b][m][n] = (f32x4){0.f, 0.f, 0.f, 0.f};
        cur = nxt; cA = nA; cB = nB; ++ui;
        if (wr == 1) PG8_BAR;
    }
    PG8_WAIT_V(0);
    PG8_BAR;
#undef PG8_SA
#undef PG8_SB
#undef PG8_STAGE
#undef PG8_LDA
#undef PG8_LDB
#undef PG8_MMA
#undef PG8_LD8
#undef PG8_WAIT_V
#undef PG8_WAIT_L
#undef PG8_BAR
#undef PG8_SCHED
}
}
using pg8::Unit;

DI u32x4 pack8(const f32x4& v0, const f32x4& v1) { u32x4 w; w.x = cvt_pk_bf16(v0[0], v0[1]); w.y = cvt_pk_bf16(v0[2], v0[3]); w.z = cvt_pk_bf16(v1[0], v1[1]); w.w = cvt_pk_bf16(v1[2], v1[3]); return w; }

struct EpiIn {
    static constexpr bool PERM = true;
    bf16_t *qg, *kg, *vg, *sr, *qd, *kd, *vd, *gt; float* ha; const int* pos;
    DI void operator()(const f32x4 (&acc)[2][2][4][2], const Unit& u, int wr, int wc, int fr, int fq) const {
        const int row0 = u.pm * 256 + wr * 64 + fr; const int pn = u.pn;
        if (pn >= 12 && pn < 24) {
            bf16_t* base = pn < 18 ? qd : kd; const int tq = pn < 18 ? pn - 12 : pn - 18; const float sc = pn < 18 ? 0.125f * LOG2E : 1.0f;
            float fre[8];
#pragma unroll
            for (int i = 0; i < 8; ++i) fre[i] = __builtin_amdgcn_exp2f(-(float)(8 * fq + i) * (13.287712379549449f / 32.0f)) * 0.15915494309189535f;
#pragma unroll
            for (int ai = 0; ai < 2; ++ai)
#pragma unroll
                for (int m = 0; m < 4; ++m) {
                    const int r = row0 + ai * 128 + m * 16; const float p = (float)pos[r];
                    bf16_t* rowp = base + (size_t)r * 1536 + (4 * tq + wc) * 64 + 8 * fq;
#pragma unroll
                    for (int n = 0; n < 2; ++n) { f32x4 o1, o2;
#pragma unroll
                        for (int j = 0; j < 4; ++j) {
                            float a = p * fre[n * 4 + j]; a = a - __builtin_floorf(a);
                            const float sn = __builtin_amdgcn_sinf(a), cs = __builtin_amdgcn_cosf(a);
                            const float x1 = acc[ai][0][m][n][j], x2 = acc[ai][1][m][n][j];
                            o1[j] = (x1 * cs - x2 * sn) * sc; o2[j] = (x2 * cs + x1 * sn) * sc;
                        }
                        u32x2 w1, w2; w1.x = cvt_pk_bf16(o1[0], o1[1]); w1.y = cvt_pk_bf16(o1[2], o1[3]); w2.x = cvt_pk_bf16(o2[0], o2[1]); w2.y = cvt_pk_bf16(o2[2], o2[3]);
                        *(GAS u32x2*)(rowp + 4 * n) = w1; *(GAS u32x2*)(rowp + 32 + 4 * n) = w2; }
                    asm volatile("" ::: "memory");
                }
        } else if (pn == 38) {
            if (wc == 0 && fq < 2) {
#pragma unroll
                for (int ai = 0; ai < 2; ++ai)
#pragma unroll
                    for (int m = 0; m < 4; ++m) { float* p = ha + (size_t)(row0 + ai * 128 + m * 16) * 16 + 8 * fq; *(GAS f32x4*)p = acc[ai][0][m][0]; *(GAS f32x4*)(p + 4) = acc[ai][0][m][1]; }
            }
        } else {
            bf16_t* base; int ldc, colt, act = 0; float sc = 1.0f;
            if (pn < 2) { base = qg; ldc = 512; colt = pn * 256; sc = 0.08838834764831845f; }
            else if (pn < 4) { base = kg; ldc = 512; colt = (pn - 2) * 256; }
            else if (pn < 8) { base = vg; ldc = 1024; colt = (pn - 4) * 256; }
            else if (pn < 12) { base = sr; ldc = 1024; colt = (pn - 8) * 256; act = 1; }
            else if (pn < 30) { base = vd; ldc = 1536; colt = (pn - 24) * 256; }
            else {
#pragma unroll
                for (int ai = 0; ai < 2; ++ai)
#pragma unroll
                    for (int m = 0; m < 4; ++m) { unsigned char* rowp = (unsigned char*)gt + (size_t)(row0 + ai * 128 + m * 16) * 2048 + (pn - 30) * 256 + wc * 32 + 8 * fq;
#pragma unroll
                        for (int bj = 0; bj < 2; ++bj) { unsigned w[2];
#pragma unroll
                            for (int n = 0; n < 2; ++n) { const f32x4 v = acc[ai][bj][m][n];
                                w[n] = (unsigned)(sigmoidf_(v[0]) * 255.0f + 0.5f) | ((unsigned)(sigmoidf_(v[1]) * 255.0f + 0.5f) << 8) | ((unsigned)(sigmoidf_(v[2]) * 255.0f + 0.5f) << 16) | ((unsigned)(sigmoidf_(v[3]) * 255.0f + 0.5f) << 24); }
                            *(GAS u32x2*)(rowp + bj * 128) = (u32x2){w[0], w[1]}; } }
                return; }
#pragma unroll
            for (int ai = 0; ai < 2; ++ai)
#pragma unroll
                for (int m = 0; m < 4; ++m) { bf16_t* rowp = base + (size_t)(row0 + ai * 128 + m * 16) * ldc + colt + wc * 32 + 8 * fq;
#pragma unroll
                    for (int bj = 0; bj < 2; ++bj) { f32x4 v0 = acc[ai][bj][m][0] * sc, v1 = acc[ai][bj][m][1] * sc;
                        if (act) {
#pragma unroll
                            for (int j = 0; j < 4; ++j) { const float s0 = sigmoidf_(v0[j]), s1 = sigmoidf_(v1[j]); v0[j] = act == 1 ? v0[j] * s0 : s0; v1[j] = act == 1 ? v1[j] * s1 : s1; } }
                        *(GAS u32x4*)(rowp + bj * 128) = pack8(v0, v1); } }
        }
    }
};
template <bool ADD> struct EpiGate {
    static constexpr bool PERM = true;
    bf16_t* mix; const unsigned char* gt; unsigned char* mix8;
    DI void operator()(const f32x4 (&acc)[2][2][4][2], const Unit& u, int wr, int wc, int fr, int fq) const {
        const int row0 = u.pm * 256 + wr * 64 + fr, col0 = u.pn * 256 + wc * 32 + 8 * fq; constexpr float k = 1.0f / 255.0f;
#pragma unroll
        for (int ai = 0; ai < 2; ++ai)
#pragma unroll
            for (int m = 0; m < 4; ++m) { const size_t r = (size_t)(row0 + ai * 128 + m * 16);
#pragma unroll
                for (int bj = 0; bj < 2; ++bj) {
                    const u32x2 g = *(const GAS u32x2*)(gt + r * 2048 + col0 + bj * 128);
                    f32x4 v0 = acc[ai][bj][m][0], v1 = acc[ai][bj][m][1];
                    v0[0] *= (float)((g.x >> 0) & 0xffu) * k; v0[1] *= (float)((g.x >> 8) & 0xffu) * k; v0[2] *= (float)((g.x >> 16) & 0xffu) * k; v0[3] *= (float)((g.x >> 24) & 0xffu) * k;
                    v1[0] *= (float)((g.y >> 0) & 0xffu) * k; v1[1] *= (float)((g.y >> 8) & 0xffu) * k; v1[2] *= (float)((g.y >> 16) & 0xffu) * k; v1[3] *= (float)((g.y >> 24) & 0xffu) * k;
                    bf16_t* mp = mix + r * 1024 + col0 + bj * 128;
                    if (ADD) { const u32x4 o = *(const GAS u32x4*)mp; v0[0] += bf_lo(o.x); v0[1] += bf_hi(o.x); v0[2] += bf_lo(o.y); v0[3] += bf_hi(o.y); v1[0] += bf_lo(o.z); v1[1] += bf_hi(o.z); v1[2] += bf_lo(o.w); v1[3] += bf_hi(o.w);
                        u32x2 o8; o8.x = pk4_fp8(v0[0], v0[1], v0[2], v0[3]); o8.y = pk4_fp8(v1[0], v1[1], v1[2], v1[3]); *(GAS u32x2*)(mix8 + r * 1024 + col0 + bj * 128) = o8; }
                    else *(GAS u32x4*)mp = pack8(v0, v1); } }
    }
};
struct EpiRes {
    static constexpr bool PERM = true;
    const float* x32; bf16_t* xr;
    DI void operator()(const f32x4 (&acc)[2][2][4][2], const Unit& u, int wr, int wc, int fr, int fq) const {
        const int row0 = u.pm * 256 + wr * 64 + fr, col0 = u.pn * 256 + wc * 32 + 8 * fq;
#pragma unroll
        for (int ai = 0; ai < 2; ++ai)
#pragma unroll
            for (int m = 0; m < 4; ++m) { const size_t off = (size_t)(row0 + ai * 128 + m * 16) * 1024 + col0;
#pragma unroll
                for (int bj = 0; bj < 2; ++bj) { f32x4 a0, a1;
                    if (x32) { a0 = *(const GAS f32x4*)(x32 + off + bj * 128); a1 = *(const GAS f32x4*)(x32 + off + bj * 128 + 4); }
                    else { const u32x4 o = *(const GAS u32x4*)(xr + off + bj * 128); a0 = (f32x4){bf_lo(o.x), bf_hi(o.x), bf_lo(o.y), bf_hi(o.y)}; a1 = (f32x4){bf_lo(o.z), bf_hi(o.z), bf_lo(o.w), bf_hi(o.w)}; }
                    *(GAS u32x4*)(xr + off + bj * 128) = pack8(a0 * DN_ALPHA + acc[ai][bj][m][0], a1 * DN_ALPHA + acc[ai][bj][m][1]); }
                asm volatile("" ::: "memory"); }
    }
};
struct EpiM1 {
    static constexpr bool PERM = true;
    unsigned char* hm;
    DI void operator()(const f32x4 (&acc)[2][2][4][2], const Unit& u, int wr, int wc, int fr, int fq) const {
        const int row0 = u.pm * 256 + wr * 64 + fr, col0 = u.pn * 128 + wc * 32 + 8 * fq;
#pragma unroll
        for (int ai = 0; ai < 2; ++ai)
#pragma unroll
            for (int m = 0; m < 4; ++m) { f32x4 v0, v1;
#pragma unroll
                for (int j = 0; j < 4; ++j) { const float g0 = acc[ai][0][m][0][j], g1 = acc[ai][0][m][1][j]; v0[j] = g0 * sigmoidf_(g0) * acc[ai][1][m][0][j]; v1[j] = g1 * sigmoidf_(g1) * acc[ai][1][m][1][j]; }
                u32x2 o; o.x = pk4_fp8(v0[0], v0[1], v0[2], v0[3]); o.y = pk4_fp8(v1[0], v1[1], v1[2], v1[3]);
                *(GAS u32x2*)(hm + (size_t)(row0 + ai * 128 + m * 16) * 1024 + col0) = o; }
    }
};
struct EpiM2 {
    static constexpr bool PERM = true;
    unsigned char* ys; const int* list; const volatile LAS int* pre;
    DI void operator()(const f32x4 (&acc)[2][2][4][2], const Unit& u, int wr, int wc, int fr, int fq) const {
        const int lrow0 = wr * 64 + fr, col0 = u.pn * 256 + wc * 32 + 8 * fq; const int lt = u.pm - rfl(pre[u.e]);
        const int* lp = list + (size_t)u.e * T + 256 * lt;
#pragma unroll
        for (int ai = 0; ai < 2; ++ai)
#pragma unroll
            for (int m = 0; m < 4; ++m) { const int r = lrow0 + ai * 128 + m * 16;
                if (r < u.nv) { const int slot = lp[r]; unsigned char* yp = ys + (size_t)slot * 1024 + col0;
#pragma unroll
                    for (int bj = 0; bj < 2; ++bj) { const f32x4 v0 = acc[ai][bj][m][0], v1 = acc[ai][bj][m][1]; u32x2 o; o.x = pk4_fp8(v0[0], v0[1], v0[2], v0[3]); o.y = pk4_fp8(v1[0], v1[1], v1[2], v1[3]); *(GAS u32x2*)(yp + bj * 128) = o; } } }
    }
};

template <bool F8>
DI void tr_item(const float* W, int N, void* WTv, int K, int drow, int c0, int nvalid, int kb, LAS float* scr, int lane) {
    const int k0 = 64 * kb;
    { const int cc = lane & 31, ccl = cc < nvalid ? cc : 0; const float* wp = W + (size_t)(k0 + (lane >> 5)) * N + c0 + ccl; float v[32];
#pragma unroll
      for (int i = 0; i < 32; ++i) v[i] = wp[(size_t)(2 * i) * N];
#pragma unroll
      for (int i = 0; i < 32; ++i) scr[(2 * i + (lane >> 5)) * 33 + cc] = (cc < nvalid) ? v[i] : 0.f; }
    LDS_WAIT(); asm volatile("" ::: "memory");
    const int c = lane & 7;
#pragma unroll
    for (int j = 0; j < 4; ++j) { const int n = (lane >> 3) + 8 * j; const LAS float* s = scr + (8 * c) * 33 + n;
        if constexpr (F8) { u32x2 o; o.x = pk4_fp8(s[0 * 33] * W8_SCALE, s[1 * 33] * W8_SCALE, s[2 * 33] * W8_SCALE, s[3 * 33] * W8_SCALE); o.y = pk4_fp8(s[4 * 33] * W8_SCALE, s[5 * 33] * W8_SCALE, s[6 * 33] * W8_SCALE, s[7 * 33] * W8_SCALE);
            *(GAS u32x2*)((unsigned char*)WTv + (size_t)(drow + n) * K + k0 + 8 * c) = o; }
        else { u32x4 o; o.x = cvt_pk_bf16(s[0 * 33], s[1 * 33]); o.y = cvt_pk_bf16(s[2 * 33], s[3 * 33]); o.z = cvt_pk_bf16(s[4 * 33], s[5 * 33]); o.w = cvt_pk_bf16(s[6 * 33], s[7 * 33]);
            *(GAS u32x4*)((bf16_t*)WTv + (size_t)(drow + n) * K + k0 + 8 * c) = o; } }
    LDS_WAIT(); asm volatile("" ::: "memory");
}
DI void phase_w(LAS unsigned char* lds, const Ctx& c, int l, int G) {
    const int tid = ltid(), lane = tid & 63, wave = rfl(tid >> 6);
    LAS float* scr = (LAS float*)(lds + wave * 16384);
    const int gw = lbid() * NWAVES + wave, NGW = G * NWAVES;
    constexpr int I_IN = (NIN / 32) * 16, I_GO = 512, I_AO = 256, I_OUT = 512, I_EXP = 16 * 512;
    constexpr int NITEMS = I_IN + I_GO + I_AO + I_OUT + 3 * I_EXP;
    for (int it = gw; it < NITEMS; it += NGW) {
        int r = it;
        if (r < I_IN) {
            const int nbg = r >> 4, kb = r & 15, n0 = 32 * nbg, tile = n0 >> 8, p = n0 & 255; int c0, nv = 32;
            if (tile < 12) c0 = n0;
            else if (tile < 24) { const int base = tile < 18 ? 3088 : 4624, tq = tile < 18 ? tile - 12 : tile - 18; c0 = base + (4 * tq + ((p & 127) >> 5)) * 64 + (p >= 128 ? 32 : 0); }
            else if (tile < 30) c0 = 6160 + (n0 - 24 * 256);
            else if (tile < 38) c0 = 7696 + (n0 - 30 * 256);
            else { c0 = 3072; nv = (p == 0) ? 16 : 0; }
            tr_item<true>(c.w_in + (size_t)l * D * DIN, DIN, c.ws + WS_WIN, D, n0, c0, nv, kb, scr, lane); continue; }
        r -= I_IN;
        if (r < I_GO) { tr_item<true>(c.w_gla_o + (size_t)l * D * D, D, c.ws + WS_WGO, D, 32 * (r >> 4), 32 * (r >> 4), 32, r & 15, scr, lane); continue; }
        r -= I_GO;
        if (r < I_AO) { tr_item<true>(c.w_att_o + (size_t)l * 512 * D, D, c.ws + WS_WAO, 512, 32 * (r >> 3), 32 * (r >> 3), 32, r & 7, scr, lane); continue; }
        r -= I_AO;
        if (r < I_OUT) { tr_item<true>(c.w_out + (size_t)l * D * D, D, c.ws + WS_WOUT, D, 32 * (r >> 4), 32 * (r >> 4), 32, r & 15, scr, lane); continue; }
        r -= I_OUT;
        const int which = r / I_EXP; r -= which * I_EXP; const int e = r >> 9, q = r & 511, nbg = q >> 4, kb = q & 15;
        const size_t eoff = (size_t)(l * NEXP + e) * D * DFF;
        if (which == 0) tr_item<true>(c.w_e_gate + eoff, DFF, c.ws + WS_WGU + (size_t)e * 2048 * 1024, D, 256 * (nbg >> 2) + 32 * (nbg & 3), 32 * nbg, 32, kb, scr, lane);
        else if (which == 1) tr_item<true>(c.w_e_up + eoff, DFF, c.ws + WS_WGU + (size_t)e * 2048 * 1024, D, 256 * (nbg >> 2) + 128 + 32 * (nbg & 3), 32 * nbg, 32, kb, scr, lane);
        else tr_item<true>(c.w_e_down + eoff, D, c.ws + WS_WD + (size_t)e * 1024 * 1024, DFF, 32 * nbg, 32 * nbg, 32, kb, scr, lane);
    }
    if (l == 0) {
        const size_t n8 = (size_t)T * D / 8; unsigned char* xb = c.ws + WS_XB;
        for (size_t i = (size_t)lbid() * NTHREADS + tid; i < n8; i += (size_t)G * NTHREADS) { const f32x4 a = *(const GAS f32x4*)(c.x + i * 8), b = *(const GAS f32x4*)(c.x + i * 8 + 4);
            u32x2 o; o.x = pk4_fp8(a[0], a[1], a[2], a[3]); o.y = pk4_fp8(b[0], b[1], b[2], b[3]); *(GAS u32x2*)(xb + i * 8) = o; }
    }
}

DI s16x4 tr16(const LAS void* p) { return __builtin_bit_cast(s16x4, __builtin_amdgcn_ds_read_tr16_b64_v4i16((LAS s16x4*)p)); }
DI bf16x8 cat8(s16x4 lo, s16x4 hi) { return __builtin_shufflevector(lo, hi, 0, 1, 2, 3, 4, 5, 6, 7); }
#define MFMA16(a, b, c) __builtin_amdgcn_mfma_f32_16x16x32_bf16((a), (b), (c), 0, 0, 0)

constexpr int REC_BYTES = 33792, REC_KS = 16384, REC_DEC = 32768, OI_BYTES = 32768;
constexpr int GP_QT = 0, GP_KT = 17408, GP_VS = 34816, GP_ATT = 68608, GP_WUP = 77824, GP_BAL = 86016;
DI float exp_(float x) { return __builtin_amdgcn_exp2f(x * LOG2E); }
DI void unpack8(const u32x4& q, float (&v)[16], int o) { v[o] = bf_lo(q.x); v[o + 1] = bf_hi(q.x); v[o + 2] = bf_lo(q.y); v[o + 3] = bf_hi(q.y); v[o + 4] = bf_lo(q.z); v[o + 5] = bf_hi(q.z); v[o + 6] = bf_lo(q.w); v[o + 7] = bf_hi(q.w); }
DI u32x4 packf8(const float (&v)[16], int o) { u32x4 p; p.x = cvt_pk_bf16(v[o], v[o + 1]); p.y = cvt_pk_bf16(v[o + 2], v[o + 3]); p.z = cvt_pk_bf16(v[o + 4], v[o + 5]); p.w = cvt_pk_bf16(v[o + 6], v[o + 7]); return p; }
DI void gla_p_unit(LAS unsigned char* lds, const Ctx& c, int l, int bl, int h, int n, int& h_loaded) {
    const int tid = ltid(), lane = tid & 63, w = rfl(tid >> 6), fr = lane & 15, fq = lane >> 4;
    const size_t tok0 = (size_t)bl * SEQ + n * 64;
    const bf16_t* QG = wsb(c, WS_H + H_QG) + tok0 * 512 + h * 128;
    const bf16_t* KG = wsb(c, WS_H + H_KG) + tok0 * 512 + h * 128;
    const bf16_t* VG = wsb(c, WS_H + H_VG) + tok0 * 1024 + h * 256;
    const float* HA = (const float*)(c.ws + WS_HA) + tok0 * 16;
    const int unit = (bl * 4 + h) * 64 + n;
    unsigned char* rec = c.ws + WS_REC + (size_t)unit * REC_BYTES;
    unsigned char* oi = c.ws + WS_MIX + (size_t)unit * OI_BYTES;
    LAS bf16_t* QT = (LAS bf16_t*)(lds + GP_QT); LAS bf16_t* KT = (LAS bf16_t*)(lds + GP_KT); LAS bf16_t* VS = (LAS bf16_t*)(lds + GP_VS); LAS bf16_t* AT = (LAS bf16_t*)(lds + GP_ATT);
    LAS float* WUP = (LAS float*)(lds + GP_WUP); LAS float* BAL = (LAS float*)(lds + GP_BAL);
    __syncthreads();
    if (h_loaded != h) { for (int i = tid; i < 16 * 128; i += NTHREADS) WUP[i] = c.w_alpha_up[(size_t)l * 16 * 512 + (i >> 7) * 512 + h * 128 + (i & 127)];
        if (tid < 128) BAL[tid] = c.b_alpha[l * 512 + h * 128 + tid]; h_loaded = h; __syncthreads(); }
    {
        const int row = lane;
        f32x4 a4[4];
#pragma unroll
        for (int j = 0; j < 4; ++j) a4[j] = *(const GAS f32x4*)(HA + (size_t)row * 16 + 4 * j);
        const u32x4 q0 = *(const GAS u32x4*)(QG + (size_t)row * 512 + 16 * w), q1 = *(const GAS u32x4*)(QG + (size_t)row * 512 + 16 * w + 8);
        const u32x4 k0 = *(const GAS u32x4*)(KG + (size_t)row * 512 + 16 * w), k1 = *(const GAS u32x4*)(KG + (size_t)row * 512 + 16 * w + 8);
#pragma unroll
        for (int c2 = 0; c2 < 4; ++c2) { const int idx = tid + NTHREADS * c2, r = idx >> 5, ch = idx & 31; *(LAS u32x4*)(VS + r * 264 + ch * 8) = *(const GAS u32x4*)(VG + (size_t)r * 1024 + ch * 8); }
        float la[16];
#pragma unroll
        for (int cc = 0; cc < 16; ++cc) la[cc] = BAL[16 * w + cc];
#pragma unroll
        for (int j = 0; j < 16; ++j) { const float aj = a4[j >> 2][j & 3];
#pragma unroll
            for (int c4 = 0; c4 < 4; ++c4) { const f32x4 wv = *(const LAS f32x4*)(WUP + j * 128 + 16 * w + 4 * c4); la[4 * c4] += aj * wv[0]; la[4 * c4 + 1] += aj * wv[1]; la[4 * c4 + 2] += aj * wv[2]; la[4 * c4 + 3] += aj * wv[3]; } }
#pragma unroll
        for (int cc = 0; cc < 16; ++cc) { const float z = la[cc]; la[cc] = -(fmaxf(-z, 0.f) + __builtin_amdgcn_logf(1.0f + exp_(-fabsf(z))) * 0.6931471805599453f) * (1.0f / 16.0f); }
#pragma unroll
        for (int dlt = 1; dlt < 64; dlt <<= 1)
#pragma unroll
            for (int cc = 0; cc < 16; ++cc) { const float t = __shfl_up(la[cc], dlt); if (lane >= dlt) la[cc] += t; }
        float qv[16], kv[16];
        unpack8(q0, qv, 0); unpack8(q1, qv, 8); unpack8(k0, kv, 0); unpack8(k1, kv, 8);
        float dc[16];
#pragma unroll
        for (int cc = 0; cc < 16; ++cc) { const float b = la[cc]; const float bend = __shfl(b, 63); const float eb = exp_(b); dc[cc] = eb; qv[cc] *= eb; la[cc] = kv[cc] * exp_(bend - b); kv[cc] *= exp_(-b); }
        if (lane == 63) {
#pragma unroll
            for (int c4 = 0; c4 < 4; ++c4) *(GAS f32x4*)(rec + REC_DEC + (16 * w + 4 * c4) * 4) = (f32x4){dc[4 * c4], dc[4 * c4 + 1], dc[4 * c4 + 2], dc[4 * c4 + 3]}; }
        const u32x4 qa = packf8(qv, 0), qb = packf8(qv, 8), ka = packf8(kv, 0), kb = packf8(kv, 8), sa = packf8(la, 0), sb = packf8(la, 8);
        *(LAS u32x4*)(QT + row * 136 + 16 * w) = qa; *(LAS u32x4*)(QT + row * 136 + 16 * w + 8) = qb;
        *(LAS u32x4*)(KT + row * 136 + 16 * w) = ka; *(LAS u32x4*)(KT + row * 136 + 16 * w + 8) = kb;
        *(GAS u32x4*)(rec + row * 256 + (((2 * w) ^ (row & 15)) << 4)) = qa; *(GAS u32x4*)(rec + row * 256 + (((2 * w + 1) ^ (row & 15)) << 4)) = qb;
        *(GAS u32x4*)(rec + REC_KS + row * 256 + (((2 * w) ^ (2 * (row & 7))) << 4)) = sa; *(GAS u32x4*)(rec + REC_KS + row * 256 + (((2 * w + 1) ^ (2 * (row & 7))) << 4)) = sb;
    }
    __syncthreads();
#pragma unroll
    for (int rep = 0; rep < 2; ++rep) {
        const int tt = w + 8 * rep, jt = tt >> 2, it = tt & 3;
        f32x4 a = (f32x4){0.f, 0.f, 0.f, 0.f};
        if (jt <= it) {
#pragma unroll
            for (int k4 = 0; k4 < 4; ++k4) { const bf16x8 af = *(const LAS bf16x8*)(KT + (16 * jt + fr) * 136 + 32 * k4 + 8 * fq), bfr = *(const LAS bf16x8*)(QT + (16 * it + fr) * 136 + 32 * k4 + 8 * fq); a = MFMA16(af, bfr, a); }
        }
        const int i = 16 * it + fr, j0 = 16 * jt + 4 * fq;
        u32x2 o; o.x = cvt_pk_bf16(j0 <= i ? a[0] : 0.f, j0 + 1 <= i ? a[1] : 0.f); o.y = cvt_pk_bf16(j0 + 2 <= i ? a[2] : 0.f, j0 + 3 <= i ? a[3] : 0.f);
        *(LAS u32x2*)(AT + i * 72 + j0) = o;
    }
    __syncthreads();
    {
        const int dv0 = 32 * w;
        bf16x8 vb[2][2];
#pragma unroll
        for (int k2 = 0; k2 < 2; ++k2)
#pragma unroll
            for (int dt = 0; dt < 2; ++dt) { const LAS bf16_t* p = VS + (32 * k2 + 8 * fq + (fr >> 2)) * 264 + dv0 + 16 * dt + (fr & 3) * 4; vb[k2][dt] = cat8(tr16(p), tr16(p + 4 * 264)); }
#pragma unroll
        for (int tt = 0; tt < 4; ++tt) {
            const bf16x8 a0 = *(const LAS bf16x8*)(AT + (16 * tt + fr) * 72 + 8 * fq), a1 = *(const LAS bf16x8*)(AT + (16 * tt + fr) * 72 + 32 + 8 * fq);
#pragma unroll
            for (int dt = 0; dt < 2; ++dt) { f32x4 z = (f32x4){0.f, 0.f, 0.f, 0.f}; z = MFMA16(vb[0][dt], a0, z); z = MFMA16(vb[1][dt], a1, z);
                u32x2 pk; pk.x = cvt_pk_bf16(z[0], z[1]); pk.y = cvt_pk_bf16(z[2], z[3]); *(GAS u32x2*)(oi + ((w * 8 + tt * 2 + dt) * 64 + lane) * 8) = pk; }
        }
    }
}
constexpr int GSEG = 16, NSEG = 64 / GSEG;
constexpr int GL_STAGE = 50176, GL_DEC = 16384, GL_VS = 17408;
DI void gla_l_chain(LAS unsigned char* lds, const Ctx& c, int bl, int h, int seg) {
    const int tid = ltid(), lane = tid & 63, w = rfl(tid >> 6), fr = lane & 15, fq = lane >> 4;
    const size_t t0 = (size_t)bl * SEQ + (size_t)seg * (GSEG * 64);
    const bf16_t* VG = wsb(c, WS_H + H_VG) + t0 * 1024 + h * 256;
    const unsigned char* rec0 = c.ws + WS_REC + (size_t)((bl * 4 + h) * 64 + seg * GSEG) * REC_BYTES;
    const int dv0 = 32 * w; const unsigned lds_u = (unsigned)(uintptr_t)lds;
    f32x4 S[8][2], Dc[8];
#pragma unroll
    for (int a = 0; a < 8; ++a) { S[a][0] = (f32x4){0.f, 0.f, 0.f, 0.f}; S[a][1] = (f32x4){0.f, 0.f, 0.f, 0.f}; Dc[a] = (f32x4){1.f, 1.f, 1.f, 1.f}; }
#define GL_DMA(gp, ldsoff) do { unsigned _sv; const unsigned _m = (unsigned)__builtin_amdgcn_readfirstlane((int)(ldsoff)); \
        asm volatile("s_mov_b32 %0, m0\n\ts_mov_b32 m0, %2\n\ts_nop 0\n\tglobal_load_lds_dwordx4 %1, off\n\ts_mov_b32 m0, %0" : "=&s"(_sv) : "v"(gp), "s"(_m) : "memory"); } while (0)
#define GL_PREFETCH(nn, st) do { const unsigned char* _r = rec0 + (size_t)(nn) * REC_BYTES + REC_KS; const unsigned _s = lds_u + (unsigned)(st) * GL_STAGE; \
        _Pragma("unroll") for (int _p = 0; _p < 2; ++_p) GL_DMA((const GAS unsigned char*)(_r + (w * 2 + _p) * 1024 + lane * 16), _s + (w * 2 + _p) * 1024); \
        if (w == 0) GL_DMA((const GAS unsigned char*)(_r + 16384 + lane * 16), _s + GL_DEC); \
        _Pragma("unroll") for (int _p = 0; _p < 4; ++_p) { const int _row = 2 * (w * 4 + _p) + (lane >> 5); \
            GL_DMA((const GAS bf16_t*)(VG + (size_t)((nn) * 64 + _row) * 1024 + (((lane & 31) ^ (2 * (_row & 3))) << 3)), _s + GL_VS + (w * 4 + _p) * 1024); } } while (0)
    __syncthreads();
    GL_PREFETCH(0, 0);
    for (int n = 0; n < GSEG; ++n) {
        const int st = n & 1; LAS unsigned char* sb_ = lds + st * GL_STAGE;
        LAS bf16_t* KS = (LAS bf16_t*)sb_; LAS float* DEC = (LAS float*)(sb_ + GL_DEC); LAS bf16_t* VS = (LAS bf16_t*)(sb_ + GL_VS);
        VM_WAIT(); asm volatile("s_waitcnt lgkmcnt(0)" ::: "memory"); __builtin_amdgcn_s_barrier(); asm volatile("" ::: "memory");
        if (n + 1 < GSEG) GL_PREFETCH(n + 1, st ^ 1);
        bf16x8 vb[2][2];
#pragma unroll
        for (int k2 = 0; k2 < 2; ++k2)
#pragma unroll
            for (int dt = 0; dt < 2; ++dt) { const int r0 = 32 * k2 + 8 * fq + (fr >> 2);
                const LAS bf16_t* p = VS + r0 * 256 + ((((dv0 + 16 * dt) >> 3) ^ (2 * (r0 & 3))) << 3) + (fr & 3) * 4; vb[k2][dt] = cat8(tr16(p), tr16(p + 4 * 256)); }
#pragma unroll
        for (int k8 = 0; k8 < 8; ++k8) {
            const f32x4 dc = *(const LAS f32x4*)(DEC + 16 * k8 + 4 * fq);
            S[k8][0] *= dc; S[k8][1] *= dc; Dc[k8] *= dc;
#pragma unroll
            for (int k2 = 0; k2 < 2; ++k2) { const int r0 = 32 * k2 + 8 * fq + (fr >> 2);
                const LAS bf16_t* p0 = KS + r0 * 128 + (((2 * k8) ^ (2 * (r0 & 7))) << 3) + (fr & 3) * 4; const LAS bf16_t* p1 = KS + (r0 + 4) * 128 + (((2 * k8) ^ (2 * ((r0 + 4) & 7))) << 3) + (fr & 3) * 4;
                const bf16x8 af = cat8(tr16(p0), tr16(p1));
                S[k8][0] = MFMA16(af, vb[k2][0], S[k8][0]); S[k8][1] = MFMA16(af, vb[k2][1], S[k8][1]); }
        }
    }
#undef GL_PREFETCH
#undef GL_DMA
    const int cj = (bl * 4 + h) * NSEG + seg;
    GAS f32x4* sl = (GAS f32x4*)(c.ws + WS_SLOC) + ((size_t)(cj * 8 + w) * 16) * 64 + lane;
#pragma unroll
    for (int a = 0; a < 8; ++a) { sl[(a * 2) * 64] = S[a][0]; sl[(a * 2 + 1) * 64] = S[a][1]; }
    if (w == 0) { GAS f32x4* dq = (GAS f32x4*)(c.ws + WS_DCUM) + (size_t)cj * 8 * 64 + lane;
#pragma unroll
        for (int a = 0; a < 8; ++a) dq[a * 64] = Dc[a]; }
    VM_WAIT(); __syncthreads();
}
constexpr int GS_STAGE = 66560, GS_KS = 16384, GS_DEC = 32768, GS_VS = 33792, GS_SS = 2 * GS_STAGE;
DI void gla_s_chain(LAS unsigned char* lds, const Ctx& c, int l, int bl, int h, int seg) {
    const int tid = ltid(), lane = tid & 63, w = rfl(tid >> 6), fr = lane & 15, fq = lane >> 4;
    const size_t t0 = (size_t)bl * SEQ + (size_t)seg * (GSEG * 64);
    const bf16_t* VG = wsb(c, WS_H + H_VG) + t0 * 1024 + h * 256;
    const bf16_t* SR = wsb(c, WS_H + H_SR) + t0 * 1024 + h * 256;
    unsigned char* OG = c.ws + WS_OG + t0 * 1024 + h * 256;
    const unsigned char* rec0 = c.ws + WS_REC + (size_t)((bl * 4 + h) * 64 + seg * GSEG) * REC_BYTES;
    const unsigned char* oi0 = c.ws + WS_MIX + (size_t)((bl * 4 + h) * 64 + seg * GSEG) * OI_BYTES;
    LAS float* SS = (LAS float*)(lds + GS_SS);
    const int dv0 = 32 * w;
    f32x4 gnv[2]; gnv[0] = *(const GAS f32x4*)(c.gla_norm + l * 1024 + h * 256 + dv0 + 4 * fq); gnv[1] = *(const GAS f32x4*)(c.gla_norm + l * 1024 + h * 256 + dv0 + 16 + 4 * fq);
    f32x4 S[8][2];
#pragma unroll
    for (int a = 0; a < 8; ++a) { S[a][0] = (f32x4){0.f, 0.f, 0.f, 0.f}; S[a][1] = (f32x4){0.f, 0.f, 0.f, 0.f}; }
    for (int j = 0; j < seg; ++j) {
        const int cj = (bl * 4 + h) * NSEG + j;
        const GAS f32x4* sl = (const GAS f32x4*)(c.ws + WS_SLOC) + ((size_t)(cj * 8 + w) * 16) * 64 + lane; const GAS f32x4* dq = (const GAS f32x4*)(c.ws + WS_DCUM) + (size_t)cj * 8 * 64 + lane;
#pragma unroll
        for (int a = 0; a < 8; ++a) { const f32x4 dcv = dq[a * 64]; S[a][0] = S[a][0] * dcv + sl[(a * 2) * 64]; S[a][1] = S[a][1] * dcv + sl[(a * 2 + 1) * 64]; }
    }
#define GS_DMA(gp, ldsoff) do { unsigned _sv; const unsigned _m = (unsigned)__builtin_amdgcn_readfirstlane((int)(ldsoff)); \
        asm volatile("s_mov_b32 %0, m0\n\ts_mov_b32 m0, %2\n\ts_nop 0\n\tglobal_load_lds_dwordx4 %1, off\n\ts_mov_b32 m0, %0" : "=&s"(_sv) : "v"(gp), "s"(_m) : "memory"); } while (0)
#define GS_PREFETCH(nn, st) do { const unsigned char* _r = rec0 + (size_t)(nn) * REC_BYTES; const unsigned _s = lds_u + (unsigned)(st) * GS_STAGE; \
        _Pragma("unroll") for (int _p = 0; _p < 4; ++_p) GS_DMA((const GAS unsigned char*)(_r + (w * 4 + _p) * 1024 + lane * 16), _s + (w * 4 + _p) * 1024); \
        if (w == 0) GS_DMA((const GAS unsigned char*)(_r + 32768 + lane * 16), _s + 32768); \
        _Pragma("unroll") for (int _p = 0; _p < 4; ++_p) { const int _row = 2 * (w * 4 + _p) + (lane >> 5); \
            GS_DMA((const GAS bf16_t*)(VG + (size_t)((nn) * 64 + _row) * 1024 + (((lane & 31) ^ (2 * (_row & 3))) << 3)), _s + GS_VS + (w * 4 + _p) * 1024); } } while (0)
    const unsigned lds_u = (unsigned)(uintptr_t)lds;
#define GS_BAR() do { asm volatile("s_waitcnt lgkmcnt(0)" ::: "memory"); __builtin_amdgcn_s_barrier(); asm volatile("" ::: "memory"); } while (0)
    __syncthreads();
    GS_PREFETCH(0, 0);
    for (int n = 0; n < GSEG; ++n) {
        const int st = n & 1; LAS unsigned char* sb_ = lds + st * GS_STAGE;
        LAS bf16_t* QT = (LAS bf16_t*)sb_; LAS bf16_t* KS = (LAS bf16_t*)(sb_ + GS_KS); LAS float* DEC = (LAS float*)(sb_ + GS_DEC); LAS bf16_t* VS = (LAS bf16_t*)(sb_ + GS_VS); LAS bf16_t* OST = (LAS bf16_t*)(sb_ + GS_KS);
        VM_WAIT(); GS_BAR();
        u32x2 oiv[8];
#pragma unroll
        for (int q = 0; q < 8; ++q) oiv[q] = *(const GAS u32x2*)(oi0 + (size_t)n * OI_BYTES + ((w * 8 + q) * 64 + lane) * 8);
        u32x2 srv[8];
#pragma unroll
        for (int q = 0; q < 8; ++q) srv[q] = *(const GAS u32x2*)(SR + (size_t)(n * 64 + 16 * (q >> 1) + fr) * 1024 + dv0 + 16 * (q & 1) + 4 * fq);
        asm volatile("" ::: "memory");
        if (n + 1 < GSEG) GS_PREFETCH(n + 1, st ^ 1);
        f32x4 o[4][2];
        {
            bf16x8 vb[2][2];
#pragma unroll
            for (int k2 = 0; k2 < 2; ++k2)
#pragma unroll
                for (int dt = 0; dt < 2; ++dt) { const int r0 = 32 * k2 + 8 * fq + (fr >> 2);
                    const LAS bf16_t* p = VS + r0 * 256 + ((((dv0 + 16 * dt) >> 3) ^ (2 * (r0 & 3))) << 3) + (fr & 3) * 4; vb[k2][dt] = cat8(tr16(p), tr16(p + 4 * 256)); }
#pragma unroll
            for (int tt = 0; tt < 4; ++tt) { o[tt][0] = (f32x4){0.f, 0.f, 0.f, 0.f}; o[tt][1] = (f32x4){0.f, 0.f, 0.f, 0.f}; }
#pragma unroll
            for (int s = 0; s < 4; ++s) {
                bf16x8 sb[2];
#pragma unroll
                for (int dt = 0; dt < 2; ++dt) { u32x4 pk; pk.x = cvt_pk_bf16(S[2 * s][dt][0], S[2 * s][dt][1]); pk.y = cvt_pk_bf16(S[2 * s][dt][2], S[2 * s][dt][3]); pk.z = cvt_pk_bf16(S[2 * s + 1][dt][0], S[2 * s + 1][dt][1]); pk.w = cvt_pk_bf16(S[2 * s + 1][dt][2], S[2 * s + 1][dt][3]); sb[dt] = __builtin_bit_cast(bf16x8, pk); }
#pragma unroll
                for (int tt = 0; tt < 4; ++tt) { const int i = 16 * tt + fr;
                    const LAS bf16_t* qp = QT + i * 128 + (fq & 1) * 4;
                    const bf16x8 af = cat8(*(const LAS s16x4*)(qp + (((4 * s + (fq >> 1)) ^ (i & 15)) << 3)), *(const LAS s16x4*)(qp + (((4 * s + 2 + (fq >> 1)) ^ (i & 15)) << 3)));
                    o[tt][0] = MFMA16(sb[0], af, o[tt][0]); o[tt][1] = MFMA16(sb[1], af, o[tt][1]); }
            }
#pragma unroll
            for (int k8 = 0; k8 < 8; ++k8) {
                const f32x4 dc = *(const LAS f32x4*)(DEC + 16 * k8 + 4 * fq);
                S[k8][0] *= dc; S[k8][1] *= dc;
#pragma unroll
                for (int k2 = 0; k2 < 2; ++k2) { const int r0 = 32 * k2 + 8 * fq + (fr >> 2);
                    const LAS bf16_t* p0 = KS + r0 * 128 + (((2 * k8) ^ (2 * (r0 & 7))) << 3) + (fr & 3) * 4; const LAS bf16_t* p1 = KS + (r0 + 4) * 128 + (((2 * k8) ^ (2 * ((r0 + 4) & 7))) << 3) + (fr & 3) * 4;
                    const bf16x8 af = cat8(tr16(p0), tr16(p1));
                    S[k8][0] = MFMA16(af, vb[k2][0], S[k8][0]); S[k8][1] = MFMA16(af, vb[k2][1], S[k8][1]); }
            }
        }
#pragma unroll
        for (int tt = 0; tt < 4; ++tt)
#pragma unroll
            for (int dt = 0; dt < 2; ++dt) { const u32x2 v = oiv[tt * 2 + dt]; o[tt][dt][0] += bf_lo(v.x); o[tt][dt][1] += bf_hi(v.x); o[tt][dt][2] += bf_lo(v.y); o[tt][dt][3] += bf_hi(v.y); }
        {
            f32x4 pp;
#pragma unroll
            for (int tt = 0; tt < 4; ++tt) { const f32x4 a = o[tt][0] * o[tt][0] + o[tt][1] * o[tt][1]; float p = (a[0] + a[1]) + (a[2] + a[3]); p += __shfl_xor(p, 16); p += __shfl_xor(p, 32); pp[tt] = p; }
            if (fq == 0) { SS[(0 * 16 + fr) * 8 + w] = pp[0]; SS[(1 * 16 + fr) * 8 + w] = pp[1]; SS[(2 * 16 + fr) * 8 + w] = pp[2]; SS[(3 * 16 + fr) * 8 + w] = pp[3]; }
        }
        GS_BAR();
#pragma unroll
        for (int tt = 0; tt < 4; ++tt) { const f32x4 s0 = *(const LAS f32x4*)(SS + (16 * tt + fr) * 8), s1 = *(const LAS f32x4*)(SS + (16 * tt + fr) * 8 + 4);
            const float ss = ((s0[0] + s0[1]) + (s0[2] + s0[3])) + ((s1[0] + s1[1]) + (s1[2] + s1[3])); const float rs = __builtin_amdgcn_rsqf(ss * (1.0f / 256.0f) + RMS_EPS);
#pragma unroll
            for (int dt = 0; dt < 2; ++dt) { const u32x2 sv = srv[tt * 2 + dt]; const f32x4 g = gnv[dt]; const f32x4 v = o[tt][dt] * rs;
                *(GAS unsigned*)(OG + (size_t)(n * 64 + 16 * tt + fr) * 1024 + dv0 + 16 * dt + 4 * fq) = pk4_fp8(v[0] * g[0] * bf_lo(sv.x), v[1] * g[1] * bf_hi(sv.x), v[2] * g[2] * bf_lo(sv.y), v[3] * g[3] * bf_hi(sv.y)); } }
    }
#undef GS_PREFETCH
#undef GS_DMA
#undef GS_BAR
    VM_WAIT(); __syncthreads();
}

constexpr int AT_K = 0, AT_V = 55296;
DI void attn_unit2(LAS unsigned char* lds, const Ctx& c, int bl, int g, int h, int x) {
    const int tid = ltid(), lane = tid & 63, w = rfl(tid >> 6), fr = lane & 15, fq = lane >> 4;
    const int dl = (g == 0) ? 1 : (g == 1 ? 4 : 16), nb = 32 / dl, r = x / nb, n = x - r * nb;
    const size_t tb = (size_t)bl * SEQ + r; const int colo = g * 512 + h * 64;
    const bf16_t* Q = wsb(c, WS_H + H_QD) + colo; const bf16_t* K = wsb(c, WS_H + H_KD) + colo; const bf16_t* V = wsb(c, WS_H + H_VD) + colo;
    LAS bf16_t* Ks = (LAS bf16_t*)(lds + AT_K); LAS bf16_t* Vs = (LAS bf16_t*)(lds + AT_V);
    bf16x8 qf[2][2];
#pragma unroll
    for (int b = 0; b < 2; ++b) { const size_t tokq = tb + (size_t)dl * (128 * (n + b) + 16 * w + fr);
#pragma unroll
        for (int d0 = 0; d0 < 2; ++d0) qf[b][d0] = *(const GAS bf16x8*)(Q + tokq * 1536 + 32 * d0 + 8 * fq); }
    __syncthreads();
#pragma unroll
    for (int c2 = 0; c2 < 6; ++c2) { const int idx = tid + NTHREADS * c2, row = idx >> 3, ch = idx & 7; const int j = 128 * (n - 1) + row;
        u32x4 kv = (u32x4){0u, 0u, 0u, 0u}, vv = (u32x4){0u, 0u, 0u, 0u};
        if (j >= 0) { const size_t tok = tb + (size_t)dl * j; kv = *(const GAS u32x4*)(K + tok * 1536 + ch * 8); vv = *(const GAS u32x4*)(V + tok * 1536 + ch * 8); }
        *(LAS u32x4*)(Ks + row * 72 + ch * 8) = kv; *(LAS u32x4*)(Vs + row * 72 + ch * 8) = vv; }
    __syncthreads();
#pragma unroll
    for (int b = 0; b < 2; ++b) {
        const int kt0 = 8 * b + w;
        f32x4 s[9]; float m = -1e30f;
#pragma unroll
        for (int kr = 0; kr < 9; ++kr) { const int kt = kt0 + kr; f32x4 a = (f32x4){0.f, 0.f, 0.f, 0.f};
#pragma unroll
            for (int d0 = 0; d0 < 2; ++d0) { const bf16x8 af = *(const LAS bf16x8*)(Ks + (16 * kt + fr) * 72 + 32 * d0 + 8 * fq); a = MFMA16(af, qf[b][d0], a); }
#pragma unroll
            for (int rg = 0; rg < 4; ++rg) { const int rel = 16 * kr + 4 * fq + rg - fr; const bool ok = rel >= 0 && rel <= 128 && (b > 0 || n > 0 || 16 * kt + 4 * fq + rg >= 128); a[rg] = ok ? a[rg] : -1e30f; m = fmaxf(m, a[rg]); }
            s[kr] = a; }
        m = fmaxf(m, __shfl_xor(m, 16)); m = fmaxf(m, __shfl_xor(m, 32));
        float lsum = 0.f;
#pragma unroll
        for (int kr = 0; kr < 9; ++kr)
#pragma unroll
            for (int rg = 0; rg < 4; ++rg) { const float p = s[kr][rg] > -1e29f ? __builtin_amdgcn_exp2f(s[kr][rg] - m) : 0.f; s[kr][rg] = p; lsum += p; }
        lsum += __shfl_xor(lsum, 16); lsum += __shfl_xor(lsum, 32);
        f32x4 oT[4];
#pragma unroll
        for (int dt = 0; dt < 4; ++dt) oT[dt] = (f32x4){0.f, 0.f, 0.f, 0.f};
#pragma unroll
        for (int pp = 0; pp < 5; ++pp) { const int ka = 2 * pp, kb = (2 * pp + 1 < 9) ? 2 * pp + 1 : 8;
            u32x4 pk; pk.x = cvt_pk_bf16(s[ka][0], s[ka][1]); pk.y = cvt_pk_bf16(s[ka][2], s[ka][3]);
            if (2 * pp + 1 < 9) { pk.z = cvt_pk_bf16(s[kb][0], s[kb][1]); pk.w = cvt_pk_bf16(s[kb][2], s[kb][3]); } else { pk.z = 0u; pk.w = 0u; }
            const bf16x8 pf = __builtin_bit_cast(bf16x8, pk);
#pragma unroll
            for (int dt = 0; dt < 4; ++dt) { const LAS bf16_t* pa = Vs + (16 * (kt0 + ka) + 4 * fq + (fr >> 2)) * 72 + 16 * dt + (fr & 3) * 4; const LAS bf16_t* pb = Vs + (16 * (kt0 + kb) + 4 * fq + (fr >> 2)) * 72 + 16 * dt + (fr & 3) * 4;
                oT[dt] = MFMA16(cat8(tr16(pa), tr16(pb)), pf, oT[dt]); } }
        const float inv = 1.0f / lsum; const size_t tq = tb + (size_t)dl * (128 * (n + b) + 16 * w + fr);
        bf16_t* op = wsb(c, WS_ATTG) + ((size_t)g * TH + tq) * 512 + h * 64 + 4 * fq;
#pragma unroll
        for (int dt = 0; dt < 4; ++dt) { u32x2 o; o.x = cvt_pk_bf16(oT[dt][0] * inv, oT[dt][1] * inv); o.y = cvt_pk_bf16(oT[dt][2] * inv, oT[dt][3] * inv); *(GAS u32x2*)(op + 16 * dt) = o; }
        if (fq == 0) ((float*)(c.ws + WS_LSE))[((size_t)g * TH + tq) * 8 + h] = m + __builtin_amdgcn_logf(lsum);
    }
}
DI void phase_p(LAS unsigned char* lds, const Ctx& c, int l, int G) {
    int h_loaded = -1;
    for (int u = lbid(); u < 8 * 4 * 64; u += G) gla_p_unit(lds, c, l, u >> 8, (u >> 6) & 3, u & 63, h_loaded);
}
constexpr int NATT = 8 * 3 * 8 * 32, NATT1 = 2304, NCHAIN = 8 * 4 * NSEG;
DI void attn_pull(LAS unsigned char* lds, const Ctx& c, unsigned* ctr, int base, int limit) {
    volatile LAS int* TK = (volatile LAS int*)(lds + MISC_OFF + 192);
    const int tid = ltid();
    __syncthreads();
    if (tid == 0) TK[0] = base + 2 * (int)__hip_atomic_fetch_add(ctr, 1u, __ATOMIC_RELAXED, __HIP_MEMORY_SCOPE_AGENT);
    __syncthreads();
    int u = rfl(TK[0]);
    while (u < limit) {
        int nxt = 0; if (tid == 0) nxt = base + 2 * (int)__hip_atomic_fetch_add(ctr, 1u, __ATOMIC_RELAXED, __HIP_MEMORY_SCOPE_AGENT);
        attn_unit2(lds, c, u / 768, (u / 256) % 3, (u >> 5) & 7, u & 31);
        __syncthreads();
        if (tid == 0) TK[0] = nxt;
        __syncthreads();
        u = rfl(TK[0]);
    }
}
DI void phase_b1(LAS unsigned char* lds, const Ctx& c, int l, int hf, int G) {
    const int bid = lbid(); unsigned* ctr = (unsigned*)(c.ws + WS_CTL) + CW_TKT + ((l * 2 + hf) * 2) * 64;
    for (int id = bid; id < NCHAIN; id += G) gla_l_chain(lds, c, id >> 4, (id >> 2) & 3, id & 3);
    attn_pull(lds, c, ctr, 0, NATT1);
}
DI void phase_b(LAS unsigned char* lds, const Ctx& c, int l, int hf, int G) {
    const int bid = lbid(); unsigned* ctr = (unsigned*)(c.ws + WS_CTL) + CW_TKT + ((l * 2 + hf) * 2 + 1) * 64;
    for (int id = bid; id < NCHAIN; id += G) gla_s_chain(lds, c, l, id >> 4, (id >> 2) & 3, id & 3);
    attn_pull(lds, c, ctr, NATT1, NATT);
}
DI void phase_f(const Ctx& c, int G) {
    const bf16_t* ag = wsb(c, WS_ATTG); const float* lse = (const float*)(c.ws + WS_LSE); unsigned char* att = c.ws + WS_ATT;
    const size_t stride = (size_t)G * NTHREADS, N = (size_t)TH * 64;
    for (size_t i0 = (size_t)lbid() * NTHREADS + ltid(); i0 < N; i0 += 4 * stride) {
        float l0[4], l1[4], l2[4]; u32x4 a[4], b[4], d[4];
#pragma unroll
        for (int q = 0; q < 4; ++q) { const size_t i = i0 + q * stride; const bool ok = i < N; const size_t tok = ok ? (i >> 6) : 0; const int ch = (int)(i & 63), h = ch >> 3;
            l0[q] = lse[tok * 8 + h]; l1[q] = lse[((size_t)TH + tok) * 8 + h]; l2[q] = lse[((size_t)2 * TH + tok) * 8 + h];
            a[q] = *(const GAS u32x4*)(ag + tok * 512 + ch * 8); b[q] = *(const GAS u32x4*)(ag + ((size_t)TH + tok) * 512 + ch * 8); d[q] = *(const GAS u32x4*)(ag + ((size_t)2 * TH + tok) * 512 + ch * 8); }
#pragma unroll
        for (int q = 0; q < 4; ++q) { const size_t i = i0 + q * stride; if (i >= N) continue; const size_t tok = i >> 6; const int ch = (int)(i & 63);
            const float mx = fmaxf(l0[q], fmaxf(l1[q], l2[q])); float w0 = __builtin_amdgcn_exp2f(l0[q] - mx), w1 = __builtin_amdgcn_exp2f(l1[q] - mx), w2 = __builtin_amdgcn_exp2f(l2[q] - mx);
            const float inv = 1.0f / (w0 + w1 + w2); w0 *= inv; w1 *= inv; w2 *= inv;
            u32x2 o;
            o.x = pk4_fp8(w0 * bf_lo(a[q].x) + w1 * bf_lo(b[q].x) + w2 * bf_lo(d[q].x), w0 * bf_hi(a[q].x) + w1 * bf_hi(b[q].x) + w2 * bf_hi(d[q].x), w0 * bf_lo(a[q].y) + w1 * bf_lo(b[q].y) + w2 * bf_lo(d[q].y), w0 * bf_hi(a[q].y) + w1 * bf_hi(b[q].y) + w2 * bf_hi(d[q].y));
            o.y = pk4_fp8(w0 * bf_lo(a[q].z) + w1 * bf_lo(b[q].z) + w2 * bf_lo(d[q].z), w0 * bf_hi(a[q].z) + w1 * bf_hi(b[q].z) + w2 * bf_hi(d[q].z), w0 * bf_lo(a[q].w) + w1 * bf_lo(b[q].w) + w2 * bf_lo(d[q].w), w0 * bf_hi(a[q].w) + w1 * bf_hi(b[q].w) + w2 * bf_hi(d[q].w));
            *(GAS u32x2*)(att + tok * 512 + ch * 8) = o; }
    }
}

DI float wave_sum(float v) {
#pragma unroll
    for (int o = 1; o < 64; o <<= 1) v += __shfl_xor(v, o);
    return v;
}
constexpr int R_WR = 0, R_HIST = 65536, R_BASE = 65536 + 64, R_INFO = 65536 + 128;
DI void phase_r(LAS unsigned char* lds, const Ctx& c, int l, int G) {
    const int tid = ltid(), lane = tid & 63, wave = rfl(tid >> 6);
    LAS float* WR = (LAS float*)(lds + R_WR); volatile LAS int* HIST = (volatile LAS int*)(lds + R_HIST); volatile LAS int* BASE = (volatile LAS int*)(lds + R_BASE); volatile LAS int* INFO = (volatile LAS int*)(lds + R_INFO);
    __syncthreads();
    for (int i = tid; i < 16 * 1024; i += NTHREADS) WR[(i & 15) * 1024 + (i >> 4)] = c.w_router[i];
    f32x4 g4[4], b4[4];
#pragma unroll
    for (int j = 0; j < 4; ++j) { g4[j] = *(const GAS f32x4*)(c.ln1_g + l * D + 4 * lane + 256 * j); b4[j] = *(const GAS f32x4*)(c.ln1_b + l * D + 4 * lane + 256 * j); }
    bf16_t* xr = wsb(c, WS_XR); unsigned char* xb = c.ws + WS_XB; int* histg = (int*)(c.ws + WS_HISTG); float* gate = (float*)(c.ws + WS_GATE);
    const float brt = c.b_router[((lane >> 5) & 1) * 8 + ((lane >> 4) & 1) * 4 + ((lane >> 3) & 1) * 2 + ((lane >> 2) & 1)];
    for (int chunk = lbid(); chunk < T / 256; chunk += G) {
        __syncthreads();
        u32x2 zn[4];
#pragma unroll
        for (int j = 0; j < 4; ++j) zn[j] = *(const GAS u32x2*)(xr + ((size_t)chunk * 256 + wave * 32) * D + 4 * lane + 256 * j);
        for (int rr = 0; rr < 32; ++rr) {
            const int rl = wave * 32 + rr; const size_t row = (size_t)chunk * 256 + rl;
            f32x4 v[4]; float s = 0.f;
#pragma unroll
            for (int j = 0; j < 4; ++j) { const u32x2 zq = zn[j]; v[j] = (f32x4){bf_lo(zq.x), bf_hi(zq.x), bf_lo(zq.y), bf_hi(zq.y)}; s += (v[j][0] + v[j][1]) + (v[j][2] + v[j][3]); }
            { const size_t rn = row + (rr + 1 < 32 ? 1 : 0);
#pragma unroll
              for (int j = 0; j < 4; ++j) zn[j] = *(const GAS u32x2*)(xr + rn * D + 4 * lane + 256 * j); }
            const float mean = wave_sum(s) * (1.0f / D); float s2 = 0.f;
#pragma unroll
            for (int j = 0; j < 4; ++j) { v[j] = v[j] - mean; s2 += (v[j][0] * v[j][0] + v[j][1] * v[j][1]) + (v[j][2] * v[j][2] + v[j][3] * v[j][3]); }
            const float rstd = __builtin_amdgcn_rsqf(wave_sum(s2) * (1.0f / D) + LN_EPS);
#pragma unroll
            for (int j = 0; j < 4; ++j) { v[j] = v[j] * rstd * g4[j] + b4[j]; u32x2 xq; xq.x = cvt_pk_bf16(v[j][0], v[j][1]); xq.y = cvt_pk_bf16(v[j][2], v[j][3]); *(GAS u32x2*)(xr + row * D + 4 * lane + 256 * j) = xq;
                *(GAS unsigned*)(xb + row * D + 4 * lane + 256 * j) = pk4_fp8(v[j][0], v[j][1], v[j][2], v[j][3]); }
            float lg[16];
#pragma unroll
            for (int e = 0; e < 16; ++e) { float a = 0.f;
#pragma unroll
                for (int j = 0; j < 4; ++j) { const f32x4 wv = *(const LAS f32x4*)(WR + e * 1024 + 4 * lane + 256 * j); a += v[j][0] * wv[0] + v[j][1] * wv[1] + v[j][2] * wv[2] + v[j][3] * wv[3]; }
                lg[e] = a; }
            {
                float b8[8], b4[4], b2[2];
                const bool h5 = lane & 32, h4 = lane & 16, h3 = lane & 8, h2 = lane & 4;
#pragma unroll
                for (int i = 0; i < 8; ++i) { const float mine = h5 ? lg[8 + i] : lg[i], send = h5 ? lg[i] : lg[8 + i]; b8[i] = mine + __shfl_xor(send, 32); }
#pragma unroll
                for (int i = 0; i < 4; ++i) { const float mine = h4 ? b8[4 + i] : b8[i], send = h4 ? b8[i] : b8[4 + i]; b4[i] = mine + __shfl_xor(send, 16); }
#pragma unroll
                for (int i = 0; i < 2; ++i) { const float mine = h3 ? b4[2 + i] : b4[i], send = h3 ? b4[i] : b4[2 + i]; b2[i] = mine + __shfl_xor(send, 8); }
                float b1 = (h2 ? b2[1] : b2[0]) + __shfl_xor(h2 ? b2[0] : b2[1], 4);
                b1 += __shfl_xor(b1, 2); b1 += __shfl_xor(b1, 1);
                b1 += brt;
#pragma unroll
                for (int e = 0; e < 16; ++e) lg[e] = __shfl(b1, ((e >> 3) & 1) * 32 + ((e >> 2) & 1) * 16 + ((e >> 1) & 1) * 8 + (e & 1) * 4);
            }
            float mx = lg[0];
#pragma unroll
            for (int e = 1; e < 16; ++e) mx = fmaxf(mx, lg[e]);
            float se = 0.f;
#pragma unroll
            for (int e = 0; e < 16; ++e) { lg[e] = __expf(lg[e] - mx); se += lg[e]; }
            const float ise = 1.0f / se;
#pragma unroll
            for (int e = 0; e < 16; ++e) lg[e] *= ise;
            int gsel = 0; float gbest = -1.f;
#pragma unroll
            for (int gi = 0; gi < 4; ++gi) { const float a = lg[4 * gi], b = lg[4 * gi + 1], cc = lg[4 * gi + 2], d = lg[4 * gi + 3];
                const float sc = (a + b + cc + d) - fminf(fminf(a, b), fminf(cc, d)) - fminf(fmaxf(fminf(a, b), fminf(cc, d)), fminf(fmaxf(a, b), fmaxf(cc, d)));
                if (sc > gbest) { gbest = sc; gsel = gi; } }
            float p[4];
#pragma unroll
            for (int k = 0; k < 4; ++k) p[k] = gsel == 0 ? lg[k] : gsel == 1 ? lg[4 + k] : gsel == 2 ? lg[8 + k] : lg[12 + k];
            int i0 = 0; float v0 = p[0];
#pragma unroll
            for (int k = 1; k < 4; ++k) if (p[k] > v0) { v0 = p[k]; i0 = k; }
            int i1 = -1; float v1 = -1.f;
#pragma unroll
            for (int k = 0; k < 4; ++k) if (k != i0 && p[k] > v1) { v1 = p[k]; i1 = k; }
            if (lane == 0) { const int e0 = 4 * gsel + i0, e1 = 4 * gsel + i1; INFO[rl * 4 + 0] = e0; INFO[rl * 4 + 1] = e1;
                const float gs = 1.0f / (v0 + v1); gate[row * 2] = v0 * gs; gate[row * 2 + 1] = v1 * gs; }
        }
        __syncthreads();
        {
            int cnt0 = 0, cnt1 = 0; const unsigned long long lt = (1ull << lane) - 1ull;
#pragma unroll
            for (int b = 0; b < 4; ++b) { const int r = 64 * b + lane; const int e0 = INFO[r * 4], e1 = INFO[r * 4 + 1];
                const bool a0 = (e0 == 2 * wave) || (e1 == 2 * wave), a1 = (e0 == 2 * wave + 1) || (e1 == 2 * wave + 1);
                const unsigned long long m0 = __ballot(a0), m1 = __ballot(a1);
                if (a0) INFO[r * 4 + (e0 == 2 * wave ? 2 : 3)] = cnt0 + __popcll(m0 & lt);
                if (a1) INFO[r * 4 + (e0 == 2 * wave + 1 ? 2 : 3)] = cnt1 + __popcll(m1 & lt);
                cnt0 += __popcll(m0); cnt1 += __popcll(m1); }
            if (lane == 0) { histg[chunk * 16 + 2 * wave] = cnt0; histg[chunk * 16 + 2 * wave + 1] = cnt1; }
        }
        __syncthreads();
        if (tid < 256) { i32x4 v; v.x = INFO[tid * 4]; v.y = INFO[tid * 4 + 1]; v.z = INFO[tid * 4 + 2]; v.w = INFO[tid * 4 + 3]; ((GAS i32x4*)(c.ws + WS_INFO))[(size_t)chunk * 256 + tid] = v; }
        __syncthreads();
    }
}
DI void phase_r2(LAS unsigned char* lds, const Ctx& c, int l, int G) {
    const int tid = ltid(); volatile LAS int* BASE = (volatile LAS int*)(lds + R_BASE);
    const int* histg = (const int*)(c.ws + WS_HISTG); int* list = (int*)(c.ws + WS_LIST);
    unsigned* cur = (unsigned*)(c.ws + WS_CTL) + CW_CUR + l * 16 * 64;
    for (int chunk = lbid(); chunk < T / 256; chunk += G) {
        __syncthreads();
        if (tid < 16) BASE[tid] = 0;
        __syncthreads();
        { const int e = tid & 15; int s = 0; for (int cc = tid >> 4; cc < chunk; cc += 32) s += histg[cc * 16 + e]; if (s) atomicAdd((int*)&BASE[e], s); }
        __syncthreads();
        if (tid < 256) { const i32x4 v = ((const GAS i32x4*)(c.ws + WS_INFO))[(size_t)chunk * 256 + tid]; const int row = chunk * 256 + tid;
            list[(size_t)v.x * T + BASE[v.x] + v.z] = row * 2; list[(size_t)v.y * T + BASE[v.y] + v.w] = row * 2 + 1; }
        if (chunk == T / 256 - 1 && tid < 16) __hip_atomic_store(cur + tid * 64, (unsigned)(BASE[tid] + histg[chunk * 16 + tid]), __ATOMIC_RELAXED, __HIP_MEMORY_SCOPE_AGENT);
    }
}
DI int moe_setup(LAS unsigned char* lds, const Ctx& c, int l) {
    volatile LAS int* PRE = (volatile LAS int*)(lds + MISC_OFF); volatile LAS int* CNT = PRE + 17;
    unsigned* cur = (unsigned*)(c.ws + WS_CTL) + CW_CUR + l * 16 * 64;
    __syncthreads();
    if (threadIdx.x == 0) { int acc = 0; for (int e = 0; e < 16; ++e) { const int n = (int)__hip_atomic_load(cur + e * 64, __ATOMIC_RELAXED, __HIP_MEMORY_SCOPE_AGENT); PRE[e] = acc; CNT[e] = n; acc += (n + 255) >> 8; } PRE[16] = acc; }
    __syncthreads();
    return rfl(PRE[16]);
}
DI void phase_c(const Ctx& c, int l, int G) {
    const int tid = ltid(), lane = tid & 63, wave = rfl(tid >> 6);
    f32x4 g4[4], b4[4];
#pragma unroll
    for (int j = 0; j < 4; ++j) { g4[j] = *(const GAS f32x4*)(c.ln2_g + l * D + 4 * lane + 256 * j); b4[j] = *(const GAS f32x4*)(c.ln2_b + l * D + 4 * lane + 256 * j); }
    float* xo = c.out; bf16_t* xr = wsb(c, WS_XR); unsigned char* xb = c.ws + WS_XB; const unsigned char* ys = c.ws + WS_YS; const float* gate = (const float*)(c.ws + WS_GATE);
    const size_t rstep = (size_t)G * NWAVES; size_t row = (size_t)lbid() * NWAVES + wave;
    u32x2 xn[4]; unsigned y0n[4], y1n[4]; float g0n = 0.f, g1n = 0.f;
    if (row < (size_t)T) { g0n = gate[row * 2]; g1n = gate[row * 2 + 1];
#pragma unroll
        for (int j = 0; j < 4; ++j) { xn[j] = *(const GAS u32x2*)(xr + row * D + 4 * lane + 256 * j); y0n[j] = *(const GAS unsigned*)(ys + (row * 2) * D + 4 * lane + 256 * j); y1n[j] = *(const GAS unsigned*)(ys + (row * 2 + 1) * D + 4 * lane + 256 * j); } }
    for (; row < (size_t)T; row += rstep) {
        const float g0 = g0n, g1 = g1n;
        f32x4 v[4]; float s = 0.f;
#pragma unroll
        for (int j = 0; j < 4; ++j) { const u32x2 xq = xn[j]; const unsigned y0 = y0n[j], y1 = y1n[j];
            const f32x2 y0a = __builtin_amdgcn_cvt_pk_f32_fp8((int)y0, false), y0b = __builtin_amdgcn_cvt_pk_f32_fp8((int)y0, true), y1a = __builtin_amdgcn_cvt_pk_f32_fp8((int)y1, false), y1b = __builtin_amdgcn_cvt_pk_f32_fp8((int)y1, true);
            v[j][0] = bf_lo(xq.x) * DN_ALPHA + g0 * y0a[0] + g1 * y1a[0]; v[j][1] = bf_hi(xq.x) * DN_ALPHA + g0 * y0a[1] + g1 * y1a[1];
            v[j][2] = bf_lo(xq.y) * DN_ALPHA + g0 * y0b[0] + g1 * y1b[0]; v[j][3] = bf_hi(xq.y) * DN_ALPHA + g0 * y0b[1] + g1 * y1b[1];
            s += (v[j][0] + v[j][1]) + (v[j][2] + v[j][3]); }
        { const size_t rn = row + rstep < (size_t)T ? row + rstep : row; g0n = gate[rn * 2]; g1n = gate[rn * 2 + 1];
#pragma unroll
          for (int j = 0; j < 4; ++j) { xn[j] = *(const GAS u32x2*)(xr + rn * D + 4 * lane + 256 * j); y0n[j] = *(const GAS unsigned*)(ys + (rn * 2) * D + 4 * lane + 256 * j); y1n[j] = *(const GAS unsigned*)(ys + (rn * 2 + 1) * D + 4 * lane + 256 * j); } }
        const float mean = wave_sum(s) * (1.0f / D); float s2 = 0.f;
#pragma unroll
        for (int j = 0; j < 4; ++j) { v[j] = v[j] - mean; s2 += (v[j][0] * v[j][0] + v[j][1] * v[j][1]) + (v[j][2] * v[j][2] + v[j][3] * v[j][3]); }
        const float rstd = __builtin_amdgcn_rsqf(wave_sum(s2) * (1.0f / D) + LN_EPS);
#pragma unroll
        for (int j = 0; j < 4; ++j) { v[j] = v[j] * rstd * g4[j] + b4[j];
            if (l == DEPTH - 1) *(GAS f32x4*)(xo + row * D + 4 * lane + 256 * j) = v[j];
            else { u32x2 xq; xq.x = cvt_pk_bf16(v[j][0], v[j][1]); xq.y = cvt_pk_bf16(v[j][2], v[j][3]); *(GAS u32x2*)(xr + row * D + 4 * lane + 256 * j) = xq;
                *(GAS unsigned*)(xb + row * D + 4 * lane + 256 * j) = pk4_fp8(v[j][0], v[j][1], v[j][2], v[j][3]); } }
    }
}

DI Ctx load_ctx() {
    union { Ctx c; unsigned long long q[sizeof(Ctx) / 8]; } u;
#if defined(__HIP_DEVICE_COMPILE__)
    const __attribute__((address_space(4))) unsigned long long* p = (const __attribute__((address_space(4))) unsigned long long*)__builtin_amdgcn_kernarg_segment_ptr();
    asm volatile("" : "+s"(p));
#pragma unroll
    for (int i = 0; i < (int)(sizeof(Ctx) / 8); ++i) u.q[i] = p[i];
#endif
    return u.c;
}
#define CTX const Ctx c = load_ctx(); const int G = lgrid(); LAS unsigned char* lds = LDSBASE
__global__ void __launch_bounds__(NTHREADS, 2) mk_fwd(Ctx c_arg) {
    extern __shared__ __attribute__((aligned(16))) unsigned char lds_raw[];
#define LDSBASE ({ unsigned _b = (unsigned)(uintptr_t)(LAS unsigned char*)lds_raw; asm volatile("" : "+s"(_b)); (LAS unsigned char*)(uintptr_t)_b; })
    LAS unsigned char* lds0 = LDSBASE;
    const int tid = threadIdx.x; const Ctx c = load_ctx();
    volatile LAS unsigned* MISC = (volatile LAS unsigned*)(lds0 + MISC_OFF);
    if (tid < 64) MISC[tid] = 0u;
    __syncthreads();
    XcdBarrier bar; bar.bar = (unsigned*)(c.ws + WS_CTL) + CW_BAR; bar.x = 0; bar.st = MISC + 40;
    if (!MK_MULTI) bar = xcd_barrier_post((unsigned*)(c.ws + WS_CTL) + CW_BAR, MISC + 40);
    const int lo = c.lo, hi = c.hi; int step = 0;
#define RUN (lo <= step && step < hi)
#define END_STEP do { if (RUN && step + 1 < hi) { if (!MK_MULTI) xcd_barrier(bar); } ++step; } while (0)
#define END_STEP_NB do { ++step; } while (0)
    for (int l = 0; l < DEPTH; ++l) {
        if (RUN) { CTX; phase_w(lds, c, l, G); }
        END_STEP;
        for (int hf = 0; hf < 2; ++hf) {
            const size_t r0 = (size_t)hf * TH;
            if (RUN) {
                CTX;
                pg8::StaticOrder S; S.init(c.ws + WS_XB + r0 * D, c.ws + WS_WIN, TH, NIN, D / 2, G, lbid());
                EpiIn E{wsb(c, WS_H + H_QG), wsb(c, WS_H + H_KG), wsb(c, WS_H + H_VG), wsb(c, WS_H + H_SR), wsb(c, WS_H + H_QD), wsb(c, WS_H + H_KD), wsb(c, WS_H + H_VD), wsb(c, WS_H + H_GT), (float*)(c.ws + WS_HA), c.pos + r0};
                pg8::gemm_phase<EpiIn, pg8::StaticOrder, true>(lds, D / 2, S, E);
            }
            END_STEP;
            if (RUN) { CTX; phase_p(lds, c, l, G); }
            END_STEP;
            if (RUN) { CTX; phase_b1(lds, c, l, hf, G); }
            END_STEP;
            if (RUN) { CTX; phase_b(lds, c, l, hf, G); }
            END_STEP;
            if (RUN) { CTX; (void)lds; phase_f(c, G); }
            END_STEP_NB;
            if (RUN) {
                CTX;
                pg8::StaticOrder S; S.init(c.ws + WS_OG, c.ws + WS_WGO, TH, D, D / 2, G, lbid());
                EpiGate<false> E{wsb(c, WS_MIX), c.ws + WS_H + H_GT, nullptr};
                pg8::gemm_phase<EpiGate<false>, pg8::StaticOrder, true>(lds, D / 2, S, E);
            }
            END_STEP;
            if (RUN) {
                CTX;
                pg8::StaticOrder S; S.init(c.ws + WS_ATT, c.ws + WS_WAO, TH, D, 256, G, lbid());
                EpiGate<true> E{wsb(c, WS_MIX), c.ws + WS_H + H_GT + 1024, c.ws + WS_OG + 32 * MiB};
                pg8::gemm_phase<EpiGate<true>, pg8::StaticOrder, true>(lds, 256, S, E);
            }
            END_STEP;
            if (RUN) {
                CTX;
                pg8::StaticOrder S; S.init(c.ws + WS_OG + 32 * MiB, c.ws + WS_WOUT, TH, D, D / 2, G, lbid());
                EpiRes E{l == 0 ? c.x + r0 * D : nullptr, wsb(c, WS_XR) + r0 * D};
                pg8::gemm_phase<EpiRes, pg8::StaticOrder, true>(lds, D / 2, S, E);
            }
            if (hf == 1) END_STEP; else END_STEP_NB;
        }
        if (RUN) { CTX; phase_r(lds, c, l, G); }
        END_STEP;
        if (RUN) { CTX; phase_r2(lds, c, l, G); }
        END_STEP;
        if (RUN) {   CTX;
            const int ntiles = moe_setup(lds, c, l);
            volatile LAS int* PRE = (volatile LAS int*)(lds + MISC_OFF); volatile LAS int* TAB = (volatile LAS int*)(lds + TAB_OFF);
            pg8::MoeOrder S; S.G = G; S.c = vcu_of(lbid(), G); S.ntot = ntiles * 8; S.NC = 8; S.K = D / 2; S.pre = PRE; S.cnt = PRE + 17; S.A = (const char*)(c.ws + WS_XB); S.Bt = (const char*)(c.ws + WS_WGU);
            S.bstride = (size_t)2048 * 1024; S.tab = TAB; S.gather = true;
            const int* list = (const int*)(c.ws + WS_LIST);
            { const int lt_tid = ltid(); const int r = lt_tid & 255, half = rfl(lt_tid >> 8);
              for (int i0 = 0; i0 < MAXU; i0 += 2) { Unit u; const int i = i0 + half;
                  if (S.next(i, u)) { const int lt = u.pm - PRE[u.e]; const int pos = 256 * lt + (r < u.nv ? r : 0); TAB[i * 256 + r] = list[(size_t)u.e * T + pos] >> 1; } } }
            __syncthreads();
            EpiM1 E{c.ws + WS_HM};
            pg8::gemm_phase<EpiM1, pg8::MoeOrder, true>(lds, D / 2, S, E);
        }
        END_STEP;
        if (RUN) {   CTX;
            const int ntiles = moe_setup(lds, c, l);
            volatile LAS int* PRE = (volatile LAS int*)(lds + MISC_OFF);
            pg8::MoeOrder S; S.G = G; S.c = vcu_of(lbid(), G); S.ntot = ntiles * 4; S.NC = 4; S.K = DFF / 2; S.pre = PRE; S.cnt = PRE + 17; S.A = (const char*)(c.ws + WS_HM); S.Bt = (const char*)(c.ws + WS_WD);
            S.bstride = (size_t)1024 * 1024; S.tab = nullptr; S.gather = false;
            EpiM2 E{c.ws + WS_YS, (const int*)(c.ws + WS_LIST), PRE};
            pg8::gemm_phase<EpiM2, pg8::MoeOrder, true>(lds, DFF / 2, S, E);
        }
        END_STEP;
        if (RUN) { CTX; (void)lds; phase_c(c, l, G); }
        END_STEP_NB;
    }
#undef RUN
#undef END_STEP
#undef END_STEP_NB
}
constexpr int NSTEPS = DEPTH * (1 + 2 * 8 + 5);

extern "C" void kernel_launch(void* const* d_in, const int* in_sizes, int n_in, void* d_out, int out_size, void* d_ws, size_t ws_size, hipStream_t stream) {
    static int grid = 0;
    if (grid == 0) {
        if (n_in != 18 || in_sizes[0] != T * D || out_size != T * D || ws_size < WS_END) { fprintf(stderr, "kernel_launch: unexpected shapes / workspace (need %zu, got %zu)\n", (size_t)WS_END, ws_size); grid = -1; return; }
        int dev = 0, cus = 0;
        if (hipGetDevice(&dev) != hipSuccess || hipDeviceGetAttribute(&cus, hipDeviceAttributeMultiprocessorCount, dev) != hipSuccess) { grid = -1; return; }
        if (hipFuncSetAttribute((const void*)mk_fwd, hipFuncAttributeMaxDynamicSharedMemorySize, LDS_BYTES) != hipSuccess) { fprintf(stderr, "kernel_launch: hipFuncSetAttribute failed\n"); grid = -1; return; }
        int per_cu = 0;
        if (hipOccupancyMaxActiveBlocksPerMultiprocessor(&per_cu, (const void*)mk_fwd, NTHREADS, LDS_BYTES) != hipSuccess || per_cu < 1) { fprintf(stderr, "kernel_launch: occupancy query says %d\n", per_cu); }
        (void)hipGetLastError();
        grid = cus;
    }
    if (grid < 0) return;
    (void)hipMemsetAsync((char*)d_ws + WS_CTL, 0, CTL_ZERO_BYTES, stream);
    Ctx c{};
    c.x = (const float*)d_in[0]; c.pos = (const int*)d_in[1]; c.w_in = (const float*)d_in[2]; c.w_alpha_up = (const float*)d_in[3]; c.b_alpha = (const float*)d_in[4]; c.gla_norm = (const float*)d_in[5];
    c.w_gla_o = (const float*)d_in[6]; c.w_att_o = (const float*)d_in[7]; c.w_out = (const float*)d_in[8]; c.ln1_g = (const float*)d_in[9]; c.ln1_b = (const float*)d_in[10]; c.w_router = (const float*)d_in[11];
    c.b_router = (const float*)d_in[12]; c.w_e_gate = (const float*)d_in[13]; c.w_e_up = (const float*)d_in[14]; c.w_e_down = (const float*)d_in[15]; c.ln2_g = (const float*)d_in[16]; c.ln2_b = (const float*)d_in[17];
    c.out = (float*)d_out; c.ws = (unsigned char*)d_ws;
#if MK_MULTI
    for (int s = 0; s < NSTEPS; ++s) { c.lo = s; c.hi = s + 1; hipLaunchKernelGGL(mk_fwd, dim3(grid), dim3(NTHREADS), LDS_BYTES, stream, c); }
#else
    c.lo = 0; c.hi = NSTEPS; hipLaunchKernelGGL(mk_fwd, dim3(grid), dim3(NTHREADS), LDS_BYTES, stream, c);
#endif
}
```

```cpp
#include <hip/hip_runtime.h>
#include <cstdio>
#include <cstdint>

#ifndef MK_MULTI
#define MK_MULTI 0
#endif

#define DI __device__ __forceinline__
#define GAS __attribute__((address_space(1)))
#define LAS __attribute__((address_space(3)))
typedef unsigned short bf16_t;
typedef short bf16x8 __attribute__((ext_vector_type(8)));
typedef short s16x4 __attribute__((ext_vector_type(4)));
typedef float f32x4 __attribute__((ext_vector_type(4)));
typedef float f32x2 __attribute__((ext_vector_type(2)));
typedef unsigned u32x4 __attribute__((ext_vector_type(4)));
typedef unsigned u32x2 __attribute__((ext_vector_type(2)));
typedef int i32x4 __attribute__((ext_vector_type(4)));
typedef int i32x8 __attribute__((ext_vector_type(8)));
#define LDS_WAIT() asm volatile("s_waitcnt lgkmcnt(0)" ::: "memory")
#define VM_WAIT() asm volatile("s_waitcnt vmcnt(0)" ::: "memory")

constexpr int D = 1024, NBATCH = 16, SEQ = 4096, T = NBATCH * SEQ, DEPTH = 4;
constexpr int TH = T / 2;
constexpr int DIN = 9744, NIN = 9984;
constexpr int NEXP = 16, DFF = 1024;
constexpr float LN_EPS = 1e-5f, RMS_EPS = 1e-6f;
constexpr float DN_ALPHA = 1.6817928305074290f;
constexpr float LOG2E = 1.4426950408889634f;
constexpr int NWAVES = 8, NTHREADS = 512;

constexpr size_t MiB = 1u << 20;
constexpr size_t WS_CTL = 0, CTL_ZERO_BYTES = 1 * MiB;
constexpr size_t WS_WIN = 1 * MiB;
constexpr size_t WS_WGO = WS_WIN + (size_t)NIN * D;
constexpr size_t WS_WAO = WS_WGO + 2 * MiB;
constexpr size_t WS_WOUT = WS_WAO + 1 * MiB;
constexpr size_t WS_WGU = WS_WOUT + 2 * MiB;
constexpr size_t WS_WD = WS_WGU + 32 * MiB;
constexpr size_t WS_XB = WS_WD + 16 * MiB;
constexpr size_t WS_XR = WS_XB + 64 * MiB;
constexpr size_t WS_LIST = WS_XR + 128 * MiB;
constexpr size_t WS_GATE = WS_LIST + 4 * MiB;
constexpr size_t WS_INFO = WS_GATE + 1 * MiB;
constexpr size_t WS_HISTG = WS_INFO + 1 * MiB;
constexpr size_t WS_OG = WS_HISTG + 1 * MiB;
constexpr size_t WS_ATTG = WS_OG + 64 * MiB;
constexpr size_t WS_LSE = WS_ATTG + 96 * MiB;
constexpr size_t WS_ATT = WS_LSE + 3 * MiB;
constexpr size_t WS_MIX = WS_ATT + 32 * MiB;
constexpr size_t WS_HA = WS_MIX + 64 * MiB;
constexpr size_t WS_H = WS_HA + 2 * MiB;
constexpr size_t H_QG = 0, H_KG = H_QG + (size_t)TH * 512 * 2, H_VG = H_KG + (size_t)TH * 512 * 2, H_SR = H_VG + (size_t)TH * 1024 * 2,
                 H_QD = H_SR + (size_t)TH * 1024 * 2, H_KD = H_QD + (size_t)TH * 1536 * 2, H_VD = H_KD + (size_t)TH * 1536 * 2, H_GT = H_VD + (size_t)TH * 1536 * 2,
                 H_END = H_GT + (size_t)TH * 2048 * 2;
constexpr size_t WS_HM = WS_H;
constexpr size_t WS_YS = WS_HM + (size_t)(2 * T + 4096) * 1024 * 2;
constexpr size_t WS_REC = WS_H + H_END;
constexpr size_t WS_SLOC = WS_REC + (size_t)2048 * 33792;
constexpr size_t WS_DCUM = WS_SLOC + 16 * MiB;
constexpr size_t WS_END = WS_DCUM + 1 * MiB;
static_assert(WS_YS + (size_t)2 * T * 1024 * 2 <= WS_END, "MoE overlay fits");
constexpr int CW_BAR = 4096;
constexpr int CW_TKT = 24576;
constexpr int CW_CUR = 16384;

constexpr int RING_BYTES = 131072;
constexpr int TAB_OFF = RING_BYTES, MAXU = 18, TAB_BYTES = MAXU * 1024;
constexpr int MISC_OFF = TAB_OFF + TAB_BYTES;
constexpr int LDS_BYTES = MISC_OFF + 256;

DI int rfl(int v) { return __builtin_amdgcn_readfirstlane(v); }
DI int lbid() { int t = blockIdx.x; asm volatile("" : "+s"(t)); return t; }
DI int lgrid() { int t = gridDim.x; asm volatile("" : "+s"(t)); return t; }
DI int vcu_of(int bid, int G) { return (G % 8 == 0) ? (bid % 8) * (G / 8) + bid / 8 : bid; }
DI int ltid() { int t = threadIdx.x; asm volatile("" : "+v"(t)); return t; }
DI float bf2f(unsigned b) { return __uint_as_float(b << 16); }
typedef __bf16 bf16x2_t __attribute__((ext_vector_type(2)));
DI unsigned cvt_pk_bf16(float lo, float hi) { f32x2 v = {lo, hi}; bf16x2_t b = __builtin_convertvector(v, bf16x2_t); return __builtin_bit_cast(unsigned, b); }
DI float clamp8(float v) { return fminf(fmaxf(v, -448.f), 448.f); }
DI unsigned pk4_fp8(float a, float b, float c_, float d) { int w = 0; w = __builtin_amdgcn_cvt_pk_fp8_f32(clamp8(a), clamp8(b), w, false); w = __builtin_amdgcn_cvt_pk_fp8_f32(clamp8(c_), clamp8(d), w, true); return (unsigned)w; }
constexpr float W8_SCALE = 64.0f;
DI float bf_lo(unsigned w) { return __uint_as_float(w << 16); }
DI float bf_hi(unsigned w) { return __uint_as_float(w & 0xffff0000u); }
DI float sigmoidf_(float x) { return __builtin_amdgcn_rcpf(1.0f + __builtin_amdgcn_exp2f(-x * LOG2E)); }

#define XB_TMO      128
#define XB_XCNT(j)  (256  + 64 * (j))
#define XB_XSUB(j)  (1280 + 64 * (j))
#define XB_XGEN(j)  (2304 + 64 * (j))
#define XB_TOP      3328
#define XB_TOPGEN   3392
#define XCD_BAR_WORDS 3456
#define XB_SPIN_CAP (1u << 18)
DI unsigned xb_ld(unsigned* p)              { return __hip_atomic_load(p, __ATOMIC_RELAXED, __HIP_MEMORY_SCOPE_AGENT); }
DI unsigned xb_add(unsigned* p, unsigned v) { return __hip_atomic_fetch_add(p, v, __ATOMIC_RELAXED, __HIP_MEMORY_SCOPE_AGENT); }
DI unsigned xb_xcc_id() { return (unsigned)__builtin_amdgcn_s_getreg((3 << 11) | 20) & 0xFu; }
#define XB_SPIN(cond, bar) do { unsigned _sp = 0; while (cond) { __builtin_amdgcn_s_sleep(1); \
    if ((++_sp & 255u) == 0u) { if (xb_ld(&(bar)[XB_TMO])) break; if (_sp > XB_SPIN_CAP) { atomicAdd(&(bar)[XB_TMO], 1u); break; } } } } while (0)
struct XcdBarrier { unsigned* bar; unsigned x; volatile LAS unsigned* st; };
DI XcdBarrier xcd_barrier_post(unsigned* bar, volatile LAS unsigned* st) {
    XcdBarrier b; b.bar = bar; b.x = xb_xcc_id(); b.st = st;
    if (threadIdx.x == 0) (void)xb_add(&bar[XB_XCNT(b.x)], 1u);
    return b;
}
DI void xcd_barrier_complete(unsigned* bar, unsigned x, unsigned& nloc, unsigned& nx) {
    const unsigned G = gridDim.x * gridDim.y * gridDim.z;
    unsigned sum, cnt, mine, sp = 0u;
    for (;;) {
        sum = 0u; cnt = 0u; mine = 0u;
#pragma unroll
        for (unsigned j = 0; j < 16; ++j) { const unsigned c = xb_ld(&bar[XB_XCNT(j)]); sum += c; cnt += (c > 0u) ? 1u : 0u; mine = (j == x) ? c : mine; }
        if (sum == G) break;
        __builtin_amdgcn_s_sleep(1);
        if ((++sp & 255u) == 0u) { if (xb_ld(&bar[XB_TMO])) break; if (sp > XB_SPIN_CAP) { atomicAdd(&bar[XB_TMO], 1u); break; } }
    }
    nloc = mine > 0u ? mine : 1u; nx = cnt > 0u ? cnt : 1u;
}
DI void xcd_barrier(const XcdBarrier& b) {
    asm volatile("s_waitcnt vmcnt(0)" ::: "memory");
    __syncthreads();
    if (threadIdx.x == 0) {
        unsigned* bar = b.bar;
        __builtin_amdgcn_s_waitcnt(0);
        unsigned nloc = b.st[0], nx = b.st[1];
        if (nloc == 0u) { xcd_barrier_complete(bar, b.x, nloc, nx); b.st[0] = nloc; b.st[1] = nx; }
        const unsigned old = xb_add(&bar[XB_XSUB(b.x)], 1u);
        const unsigned gen = old / nloc;
        if (old + 1u == (gen + 1u) * nloc) {
            __builtin_amdgcn_fence(__ATOMIC_RELEASE, "agent");
            asm volatile("s_waitcnt vmcnt(0)" ::: "memory");
            const unsigned og = xb_add(&bar[XB_TOP], 1u);
            const unsigned tg = og / nx;
            if (og + 1u == (tg + 1u) * nx) xb_add(&bar[XB_TOPGEN], 1u);
            else XB_SPIN(xb_ld(&bar[XB_TOPGEN]) == tg, bar);
            __builtin_amdgcn_fence(__ATOMIC_ACQUIRE, "agent");
            xb_add(&bar[XB_XGEN(b.x)], 1u);
            asm volatile("s_waitcnt vmcnt(0)" ::: "memory");
        } else {
            XB_SPIN(xb_ld(&bar[XB_XGEN(b.x)]) == gen, bar);
            __builtin_amdgcn_fence(__ATOMIC_ACQUIRE, "agent");
            asm volatile("s_waitcnt vmcnt(0)" ::: "memory");
        }
    }
    __syncthreads();
}

struct Ctx {
    const float* x; const int* pos; const float* w_in; const float* w_alpha_up; const float* b_alpha; const float* gla_norm;
    const float* w_gla_o; const float* w_att_o; const float* w_out; const float* ln1_g; const float* ln1_b; const float* w_router; const float* b_router;
    const float* w_e_gate; const float* w_e_up; const float* w_e_down; const float* ln2_g; const float* ln2_b;
    float* out; unsigned char* ws;
    int lo, hi;
};
DI bf16_t* wsb(const Ctx& c, size_t off) { return (bf16_t*)(c.ws + off); }

namespace pg8 {
constexpr int BM = 256, BK = 64, HALF = 128, HTB = HALF * BK * 2, STAGE_BYTES = 8 * HTB, NXCD = 8, WGM = 8;
DI int lds_byte(int r, int c) { const int st = (r >> 4) * 2 + (c >> 5), rr = r & 15, cc = c & 31, ob = rr * 64 + cc * 2; return st * 1024 + (ob ^ (((ob >> 9) & 1) << 5)); }
DI void stage_rc(int b, int& R, int& C) { const int st = b / 1024, sb = b % 1024, swz = sb ^ (((sb >> 9) & 1) << 5); R = (st >> 1) * 16 + swz / 64; C = (st & 1) * 32 + (swz % 64) / 2; }
DI int perm32(int rho) { const int n = rho >> 4, i = rho & 15; return 8 * (i >> 2) + 4 * n + (i & 3); }
struct Unit { int pm, pn, e, nv, ui; };

struct StaticOrder {
    int nM, nN, nwg, G, c, K; const char* A; const char* Bt;
    DI void init(const void* A_, const void* Bt_, int M, int N, int K_, int G_, int c_) { A = (const char*)A_; Bt = (const char*)Bt_; nM = M / BM; nN = N / BM; nwg = nM * nN; G = G_; c = c_; K = K_; }
    DI bool next(int i, Unit& u) const {
        const long L = (long)i * G + c; if (L >= nwg) return false;
        int wgid = (int)L; { const int q = nwg / NXCD, r = nwg % NXCD, xcd = wgid % NXCD, off = wgid / NXCD; wgid = (xcd < r ? xcd * (q + 1) : r * (q + 1) + (xcd - r) * q) + off; }
        const int nig = WGM * nN, gid = wgid / nig, fm = gid * WGM, gsz = (nM - fm) < WGM ? (nM - fm) : WGM;
        u.pm = fm + ((wgid % nig) % gsz); u.pn = (wgid % nig) / gsz; u.e = 0; u.nv = 256; u.ui = i; return true;
    }
    DI const char* a_base(const Unit& u) const { return A + (size_t)u.pm * BM * K * 2; }
    DI const char* b_base(const Unit& u) const { return Bt + (size_t)u.pn * BM * K * 2; }
    DI void a_off(const Unit&, int tid, unsigned (&o)[2][2]) const {
#pragma unroll
        for (int i = 0; i < 2; ++i) { int R, C; stage_rc(tid * 16 + i * 8192, R, C);
#pragma unroll
            for (int h = 0; h < 2; ++h) o[h][i] = (unsigned)((h * HALF + R) * K + C) * 2u; }
    }
};
struct MoeOrder {
    int G, c, ntot, NC, K; const volatile LAS int* pre; const volatile LAS int* cnt; const char* A; const char* Bt; size_t bstride; const volatile LAS int* tab; bool gather;
    DI bool next(int i, Unit& u) const {
        const int L = i * G + c; if (L >= ntot) return false;
        const int rt = L / NC; u.pn = L - rt * NC; u.pm = rt;
        int e = 0;
#pragma unroll
        for (int j = 1; j < 16; ++j) e += (rt >= rfl(pre[j])) ? 1 : 0;
        e = rfl(e); u.e = e; const int rem = rfl(cnt[e]) - 256 * (rt - rfl(pre[e])); u.nv = rem < 256 ? rem : 256; u.ui = i; return true;
    }
    DI const char* a_base(const Unit& u) const { return gather ? A : A + (size_t)u.pm * BM * K * 2; }
    DI const char* b_base(const Unit& u) const { return Bt + (size_t)u.e * bstride + (size_t)u.pn * BM * K * 2; }
    DI void a_off(const Unit& u, int tid, unsigned (&o)[2][2]) const {
#pragma unroll
        for (int i = 0; i < 2; ++i) { int R, C; stage_rc(tid * 16 + i * 8192, R, C);
#pragma unroll
            for (int h = 0; h < 2; ++h) { const int row = gather ? tab[u.ui * 256 + h * HALF + R] : (h * HALF + R); o[h][i] = (unsigned)(row * K + C) * 2u; } }
    }
};

template <class Epi, class Sched, bool F8 = false>
DI void gemm_phase(LAS unsigned char* lds, const int K, const Sched& S, const Epi& E) {
    const int tid = ltid(), wid = rfl(tid >> 6), lane = tid & 63, wr = wid >> 2, wc = wid & 3, fr = lane & 15, fq = lane >> 4;
    const int nt = K / BK;
    unsigned voffB[2];
#pragma unroll
    for (int i = 0; i < 2; ++i) { int R, C; stage_rc(tid * 16 + i * 8192, R, C); const int Rb = Epi::PERM ? ((R & ~31) + perm32(R & 31)) : R; voffB[i] = (unsigned)(Rb * K + C) * 2u; }
    const size_t kstep = (size_t)(BK * 2);
    const size_t hstep = (size_t)HALF * K * 2;
    const unsigned ldsw = (unsigned)wid * 1024u;
    const int aoff = lds_byte(wr * 64 + fr, fq * 8), boff = lds_byte(wc * 32 + fr, fq * 8);
#define PG8_SA(b, h) (((b) * 2 + (h)) * HTB)
#define PG8_SB(b, h) ((4 + (b) * 2 + (h)) * HTB)
#define PG8_STAGE(bufoff, gbase, voff) do { _Pragma("unroll") for (int _i = 0; _i < 2; ++_i) \
        __builtin_amdgcn_global_load_lds((const unsigned*)((const char*)(gbase) + (voff)[_i]), (LAS unsigned*)(lds + (bufoff) + ldsw + _i * 8192), 16, 0, 0); } while (0)
#define PG8_LD8(p) __builtin_shufflevector(*(const LAS i32x4*)(p), *(const LAS i32x4*)((p) + 1024), 0, 1, 2, 3, 4, 5, 6, 7)
#define PG8_LDA(dst, b, h) do { if constexpr (F8) { _Pragma("unroll") for (int m = 0; m < 4; ++m) dst##8[m] = PG8_LD8(lds + PG8_SA(b, h) + aoff + m * 2048); } else { \
        _Pragma("unroll") for (int m = 0; m < 4; ++m) _Pragma("unroll") for (int k = 0; k < 2; ++k) dst[m][k] = *(const LAS bf16x8*)(lds + PG8_SA(b, h) + aoff + m * 2048 + k * 1024); } } while (0)
#define PG8_LDB(dst, b, h) do { if constexpr (F8) { _Pragma("unroll") for (int n = 0; n < 2; ++n) dst##8[n] = PG8_LD8(lds + PG8_SB(b, h) + boff + n * 2048); } else { \
        _Pragma("unroll") for (int n = 0; n < 2; ++n) _Pragma("unroll") for (int k = 0; k < 2; ++k) dst[n][k] = *(const LAS bf16x8*)(lds + PG8_SB(b, h) + boff + n * 2048 + k * 1024); } } while (0)
#define PG8_MMA(ai, bj, At, Bt) do { __builtin_amdgcn_s_setprio(1); if constexpr (F8) { _Pragma("unroll") for (int m = 0; m < 4; ++m) _Pragma("unroll") for (int n = 0; n < 2; ++n) \
        asm volatile("v_mfma_scale_f32_16x16x128_f8f6f4 %0, %1, %2, %0, %3, %4 op_sel_hi:[0,0,0]" : "+v"(acc[ai][bj][m][n]) : "v"(Bt##8[n]), "v"(At##8[m]), "v"(sc_w), "v"(sc_a)); } else { \
        _Pragma("unroll") for (int m = 0; m < 4; ++m) _Pragma("unroll") for (int n = 0; n < 2; ++n) _Pragma("unroll") for (int k = 0; k < 2; ++k) \
        acc[ai][bj][m][n] = __builtin_amdgcn_mfma_f32_16x16x32_bf16(Bt[n][k], At[m][k], acc[ai][bj][m][n], 0, 0, 0); } __builtin_amdgcn_s_setprio(0); } while (0)
#define PG8_WAIT_V(n) asm volatile("s_waitcnt vmcnt(" #n ")" ::: "memory")
#define PG8_WAIT_L(n) asm volatile("s_waitcnt lgkmcnt(" #n ")" ::: "memory")
#define PG8_BAR __builtin_amdgcn_s_barrier()
#define PG8_SCHED __builtin_amdgcn_sched_barrier(0)
    Unit cur, nxt; int ui = 0;
    if (!S.next(0, cur)) return;
    f32x4 acc[2][2][4][2];
#pragma unroll
    for (int a = 0; a < 2; ++a)
#pragma unroll
        for (int b = 0; b < 2; ++b)
#pragma unroll
            for (int m = 0; m < 4; ++m)
#pragma unroll
                for (int n = 0; n < 2; ++n) acc[a][b][m][n] = (f32x4){0.f, 0.f, 0.f, 0.f};
    int sc_w = 0x79797979, sc_a = 0x7f7f7f7f; asm volatile("" : "+v"(sc_w), "+v"(sc_a));
    bf16x8 At[4][2], B0[2][2], B1[2][2]; i32x8 At8[4], B08[2], B18[2];
    unsigned oA[2][2]; S.a_off(cur, tid, oA);
    const char* cA = S.a_base(cur); const char* cB = S.b_base(cur);
    PG8_STAGE(PG8_SB(0, 0), cB, voffB); PG8_STAGE(PG8_SB(0, 1), cB + hstep, voffB); PG8_STAGE(PG8_SA(0, 0), cA, oA[0]); PG8_STAGE(PG8_SA(0, 1), cA, oA[1]);
    if (wr == 1) PG8_BAR;
    PG8_WAIT_V(2); PG8_BAR;
    PG8_STAGE(PG8_SB(1, 0), cB + kstep, voffB); PG8_STAGE(PG8_SA(1, 0), cA + kstep, oA[0]); PG8_STAGE(PG8_SB(1, 1), cB + hstep + kstep, voffB);
    PG8_WAIT_V(6); PG8_BAR;
    for (;;) {
        const bool has_next = S.next(ui + 1, nxt);
        const char* nA = has_next ? S.a_base(nxt) : cA; const char* nB = has_next ? S.b_base(nxt) : cB;
        for (int t = 0; t < nt; t += 2) {
            const bool last = (t == nt - 2);
            const char* a1 = cA + (size_t)(t + 1) * kstep;
            const char* a2 = last ? nA : cA + (size_t)(t + 2) * kstep; const char* b2 = last ? nB : cB + (size_t)(t + 2) * kstep;
            const char* a3 = a2 + kstep; const char* b3 = b2 + kstep;
            PG8_LDB(B0, 0, 0); PG8_LDB(B1, 0, 1); PG8_SCHED; PG8_LDA(At, 0, 0); PG8_STAGE(PG8_SA(1, 1), a1, oA[1]);
            if (last && has_next) S.a_off(nxt, tid, oA);
            PG8_WAIT_V(8); PG8_WAIT_L(0); PG8_BAR; PG8_MMA(0, 0, At, B0); PG8_MMA(0, 1, At, B1); PG8_BAR; PG8_SCHED;
            PG8_LDA(At, 0, 1); PG8_STAGE(PG8_SB(0, 0), b2, voffB); PG8_STAGE(PG8_SB(0, 1), b2 + hstep, voffB); PG8_STAGE(PG8_SA(0, 0), a2, oA[0]);
            PG8_WAIT_V(8); PG8_WAIT_L(0); PG8_BAR; PG8_MMA(1, 0, At, B0); PG8_MMA(1, 1, At, B1); PG8_BAR; PG8_SCHED;
            PG8_LDB(B0, 1, 0); PG8_LDB(B1, 1, 1); PG8_SCHED; PG8_LDA(At, 1, 0); PG8_STAGE(PG8_SA(0, 1), a2, oA[1]);
            PG8_WAIT_V(8); PG8_WAIT_L(0); PG8_BAR; PG8_MMA(0, 0, At, B0); PG8_MMA(0, 1, At, B1); PG8_BAR; PG8_SCHED;
            PG8_LDA(At, 1, 1); PG8_STAGE(PG8_SB(1, 0), b3, voffB); PG8_STAGE(PG8_SB(1, 1), b3 + hstep, voffB); PG8_STAGE(PG8_SA(1, 0), a3, oA[0]);
            PG8_WAIT_V(8); PG8_WAIT_L(0); PG8_BAR; PG8_MMA(1, 0, At, B0); PG8_MMA(1, 1, At, B1); PG8_BAR; PG8_SCHED;
        }
        if (wr == 0) PG8_BAR;
        if constexpr (F8) asm volatile("s_nop 15\n\ts_nop 15" ::: "memory");
        E(acc, cur, wr, wc, fr, fq);
        if (!has_next) break;
#pragma unroll
        for (int a = 0; a < 2; ++a)
#pragma unroll
            for (int b = 0; b < 2; ++b)
#pragma unroll
                for (int m = 0; m < 4; ++m)
#pragma unroll
                    for (int n = 0; n < 2; ++n) acc[a][b][m][n] = (f32x4){0.f, 0.f, 0.f, 0.f};
        cur = nxt; cA = nA; cB = nB; ++ui;
        if (wr == 1) PG8_BAR;
    }
    PG8_WAIT_V(0);
    PG8_BAR;
#undef PG8_SA
#undef PG8_SB
#undef PG8_STAGE
#undef PG8_LDA
#undef PG8_LDB
#undef PG8_MMA
#undef PG8_LD8
#undef PG8_WAIT_V
#undef PG8_WAIT_L
#undef PG8_BAR
#undef PG8_SCHED
}
}
using pg8::Unit;

DI u32x4 pack8(const f32x4& v0, const f32x4& v1) { u32x4 w; w.x = cvt_pk_bf16(v0[0], v0[1]); w.y = cvt_pk_bf16(v0[2], v0[3]); w.z = cvt_pk_bf16(v1[0], v1[1]); w.w = cvt_pk_bf16(v1[2], v1[3]); return w; }

struct EpiIn {
    static constexpr bool PERM = true;
    bf16_t *qg, *kg, *vg, *sr, *qd, *kd, *vd, *gt; float* ha; const int* pos;
    DI void operator()(const f32x4 (&acc)[2][2][4][2], const Unit& u, int wr, int wc, int fr, int fq) const {
        const int row0 = u.pm * 256 + wr * 64 + fr; const int pn = u.pn;
        if (pn >= 12 && pn < 24) {
            bf16_t* base = pn < 18 ? qd : kd; const int tq = pn < 18 ? pn - 12 : pn - 18; const float sc = pn < 18 ? 0.125f * LOG2E : 1.0f;
            float fre[8];
#pragma unroll
            for (int i = 0; i < 8; ++i) fre[i] = __builtin_amdgcn_exp2f(-(float)(8 * fq + i) * (13.287712379549449f / 32.0f)) * 0.15915494309189535f;
#pragma unroll
            for (int ai = 0; ai < 2; ++ai)
#pragma unroll
                for (int m = 0; m < 4; ++m) {
                    const int r = row0 + ai * 128 + m * 16; const float p = (float)pos[r];
                    bf16_t* rowp = base + (size_t)r * 1536 + (4 * tq + wc) * 64 + 8 * fq;
#pragma unroll
                    for (int n = 0; n < 2; ++n) { f32x4 o1, o2;
#pragma unroll
                        for (int j = 0; j < 4; ++j) {
                            float a = p * fre[n * 4 + j]; a = a - __builtin_floorf(a);
                            const float sn = __builtin_amdgcn_sinf(a), cs = __builtin_amdgcn_cosf(a);
                            const float x1 = acc[ai][0][m][n][j], x2 = acc[ai][1][m][n][j];
                            o1[j] = (x1 * cs - x2 * sn) * sc; o2[j] = (x2 * cs + x1 * sn) * sc;
                        }
                        u32x2 w1, w2; w1.x = cvt_pk_bf16(o1[0], o1[1]); w1.y = cvt_pk_bf16(o1[2], o1[3]); w2.x = cvt_pk_bf16(o2[0], o2[1]); w2.y = cvt_pk_bf16(o2[2], o2[3]);
                        *(GAS u32x2*)(rowp + 4 * n) = w1; *(GAS u32x2*)(rowp + 32 + 4 * n) = w2; }
                    asm volatile("" ::: "memory");
                }
        } else if (pn == 38) {
            if (wc == 0 && fq < 2) {
#pragma unroll
                for (int ai = 0; ai < 2; ++ai)
#pragma unroll
                    for (int m = 0; m < 4; ++m) { float* p = ha + (size_t)(row0 + ai * 128 + m * 16) * 16 + 8 * fq; *(GAS f32x4*)p = acc[ai][0][m][0]; *(GAS f32x4*)(p + 4) = acc[ai][0][m][1]; }
            }
        } else {
            bf16_t* base; int ldc, colt, act = 0; float sc = 1.0f;
            if (pn < 2) { base = qg; ldc = 512; colt = pn * 256; sc = 0.08838834764831845f; }
            else if (pn < 4) { base = kg; ldc = 512; colt = (pn - 2) * 256; }
            else if (pn < 8) { base = vg; ldc = 1024; colt = (pn - 4) * 256; }
            else if (pn < 12) {
#pragma unroll
                for (int ai = 0; ai < 2; ++ai)
#pragma unroll
                    for (int m = 0; m < 4; ++m) { unsigned char* rowp = (unsigned char*)sr + (size_t)(row0 + ai * 128 + m * 16) * 1024 + (pn - 8) * 256 + wc * 32 + 8 * fq;
#pragma unroll
                        for (int bj = 0; bj < 2; ++bj) { const f32x4 v0 = acc[ai][bj][m][0], v1 = acc[ai][bj][m][1]; u32x2 o;
                            o.x = pk4_fp8(v0[0] * sigmoidf_(v0[0]), v0[1] * sigmoidf_(v0[1]), v0[2] * sigmoidf_(v0[2]), v0[3] * sigmoidf_(v0[3]));
                            o.y = pk4_fp8(v1[0] * sigmoidf_(v1[0]), v1[1] * sigmoidf_(v1[1]), v1[2] * sigmoidf_(v1[2]), v1[3] * sigmoidf_(v1[3]));
                            *(GAS u32x2*)(rowp + bj * 128) = o; } }
                return; }
            else if (pn < 30) { base = vd; ldc = 1536; colt = (pn - 24) * 256; }
            else {
#pragma unroll
                for (int ai = 0; ai < 2; ++ai)
#pragma unroll
                    for (int m = 0; m < 4; ++m) { unsigned char* rowp = (unsigned char*)gt + (size_t)(row0 + ai * 128 + m * 16) * 2048 + (pn - 30) * 256 + wc * 32 + 8 * fq;
#pragma unroll
                        for (int bj = 0; bj < 2; ++bj) { unsigned w[2];
#pragma unroll
                            for (int n = 0; n < 2; ++n) { const f32x4 v = acc[ai][bj][m][n];
                                w[n] = (unsigned)(sigmoidf_(v[0]) * 255.0f + 0.5f) | ((unsigned)(sigmoidf_(v[1]) * 255.0f + 0.5f) << 8) | ((unsigned)(sigmoidf_(v[2]) * 255.0f + 0.5f) << 16) | ((unsigned)(sigmoidf_(v[3]) * 255.0f + 0.5f) << 24); }
                            *(GAS u32x2*)(rowp + bj * 128) = (u32x2){w[0], w[1]}; } }
                return; }
#pragma unroll
            for (int ai = 0; ai < 2; ++ai)
#pragma unroll
                for (int m = 0; m < 4; ++m) { bf16_t* rowp = base + (size_t)(row0 + ai * 128 + m * 16) * ldc + colt + wc * 32 + 8 * fq;
#pragma unroll
                    for (int bj = 0; bj < 2; ++bj) { f32x4 v0 = acc[ai][bj][m][0] * sc, v1 = acc[ai][bj][m][1] * sc;
                        if (act) {
#pragma unroll
                            for (int j = 0; j < 4; ++j) { const float s0 = sigmoidf_(v0[j]), s1 = sigmoidf_(v1[j]); v0[j] = act == 1 ? v0[j] * s0 : s0; v1[j] = act == 1 ? v1[j] * s1 : s1; } }
                        *(GAS u32x4*)(rowp + bj * 128) = pack8(v0, v1); } }
        }
    }
};
template <bool ADD> struct EpiGate {
    static constexpr bool PERM = true;
    bf16_t* mix; const unsigned char* gt; unsigned char* mix8;
    DI void operator()(const f32x4 (&acc)[2][2][4][2], const Unit& u, int wr, int wc, int fr, int fq) const {
        const int row0 = u.pm * 256 + wr * 64 + fr, col0 = u.pn * 256 + wc * 32 + 8 * fq; constexpr float k = 1.0f / 255.0f;
#pragma unroll
        for (int ai = 0; ai < 2; ++ai)
#pragma unroll
            for (int m = 0; m < 4; ++m) { const size_t r = (size_t)(row0 + ai * 128 + m * 16);
#pragma unroll
                for (int bj = 0; bj < 2; ++bj) {
                    const u32x2 g = *(const GAS u32x2*)(gt + r * 2048 + col0 + bj * 128);
                    f32x4 v0 = acc[ai][bj][m][0], v1 = acc[ai][bj][m][1];
                    v0[0] *= (float)((g.x >> 0) & 0xffu) * k; v0[1] *= (float)((g.x >> 8) & 0xffu) * k; v0[2] *= (float)((g.x >> 16) & 0xffu) * k; v0[3] *= (float)((g.x >> 24) & 0xffu) * k;
                    v1[0] *= (float)((g.y >> 0) & 0xffu) * k; v1[1] *= (float)((g.y >> 8) & 0xffu) * k; v1[2] *= (float)((g.y >> 16) & 0xffu) * k; v1[3] *= (float)((g.y >> 24) & 0xffu) * k;
                    bf16_t* mp = mix + r * 1024 + col0 + bj * 128;
                    if (ADD) { const u32x4 o = *(const GAS u32x4*)mp; v0[0] += bf_lo(o.x); v0[1] += bf_hi(o.x); v0[2] += bf_lo(o.y); v0[3] += bf_hi(o.y); v1[0] += bf_lo(o.z); v1[1] += bf_hi(o.z); v1[2] += bf_lo(o.w); v1[3] += bf_hi(o.w);
                        u32x2 o8; o8.x = pk4_fp8(v0[0], v0[1], v0[2], v0[3]); o8.y = pk4_fp8(v1[0], v1[1], v1[2], v1[3]); *(GAS u32x2*)(mix8 + r * 1024 + col0 + bj * 128) = o8; }
                    else *(GAS u32x4*)mp = pack8(v0, v1); } }
    }
};
struct EpiRes {
    static constexpr bool PERM = true;
    const float* x32; bf16_t* xr;
    DI void operator()(const f32x4 (&acc)[2][2][4][2], const Unit& u, int wr, int wc, int fr, int fq) const {
        const int row0 = u.pm * 256 + wr * 64 + fr, col0 = u.pn * 256 + wc * 32 + 8 * fq;
#pragma unroll
        for (int ai = 0; ai < 2; ++ai)
#pragma unroll
            for (int m = 0; m < 4; ++m) { const size_t off = (size_t)(row0 + ai * 128 + m * 16) * 1024 + col0;
#pragma unroll
                for (int bj = 0; bj < 2; ++bj) { f32x4 a0, a1;
                    if (x32) { a0 = *(const GAS f32x4*)(x32 + off + bj * 128); a1 = *(const GAS f32x4*)(x32 + off + bj * 128 + 4); }
                    else { const u32x4 o = *(const GAS u32x4*)(xr + off + bj * 128); a0 = (f32x4){bf_lo(o.x), bf_hi(o.x), bf_lo(o.y), bf_hi(o.y)}; a1 = (f32x4){bf_lo(o.z), bf_hi(o.z), bf_lo(o.w), bf_hi(o.w)}; }
                    *(GAS u32x4*)(xr + off + bj * 128) = pack8(a0 * DN_ALPHA + acc[ai][bj][m][0], a1 * DN_ALPHA + acc[ai][bj][m][1]); }
                asm volatile("" ::: "memory"); }
    }
};
struct EpiM1 {
    static constexpr bool PERM = true;
    unsigned char* hm;
    DI void operator()(const f32x4 (&acc)[2][2][4][2], const Unit& u, int wr, int wc, int fr, int fq) const {
        const int row0 = u.pm * 256 + wr * 64 + fr, col0 = u.pn * 128 + wc * 32 + 8 * fq;
#pragma unroll
        for (int ai = 0; ai < 2; ++ai)
#pragma unroll
            for (int m = 0; m < 4; ++m) { f32x4 v0, v1;
#pragma unroll
                for (int j = 0; j < 4; ++j) { const float g0 = acc[ai][0][m][0][j], g1 = acc[ai][0][m][1][j]; v0[j] = g0 * sigmoidf_(g0) * acc[ai][1][m][0][j]; v1[j] = g1 * sigmoidf_(g1) * acc[ai][1][m][1][j]; }
                u32x2 o; o.x = pk4_fp8(v0[0], v0[1], v0[2], v0[3]); o.y = pk4_fp8(v1[0], v1[1], v1[2], v1[3]);
                *(GAS u32x2*)(hm + (size_t)(row0 + ai * 128 + m * 16) * 1024 + col0) = o; }
    }
};
struct EpiM2 {
    static constexpr bool PERM = true;
    unsigned char* ys; const int* list; const volatile LAS int* pre;
    DI void operator()(const f32x4 (&acc)[2][2][4][2], const Unit& u, int wr, int wc, int fr, int fq) const {
        const int lrow0 = wr * 64 + fr, col0 = u.pn * 256 + wc * 32 + 8 * fq; const int lt = u.pm - rfl(pre[u.e]);
        const int* lp = list + (size_t)u.e * T + 256 * lt;
#pragma unroll
        for (int ai = 0; ai < 2; ++ai)
#pragma unroll
            for (int m = 0; m < 4; ++m) { const int r = lrow0 + ai * 128 + m * 16;
                if (r < u.nv) { const int slot = lp[r]; unsigned char* yp = ys + (size_t)slot * 1024 + col0;
#pragma unroll
                    for (int bj = 0; bj < 2; ++bj) { const f32x4 v0 = acc[ai][bj][m][0], v1 = acc[ai][bj][m][1]; u32x2 o; o.x = pk4_fp8(v0[0], v0[1], v0[2], v0[3]); o.y = pk4_fp8(v1[0], v1[1], v1[2], v1[3]); *(GAS u32x2*)(yp + bj * 128) = o; } } }
    }
};

struct WItem { const float* W; unsigned char* WT; int N, K, drow, c0, nv, kb; };
DI WItem w_decode(const Ctx& c, int l, int it) {
    constexpr int I_IN = (NIN / 32) * 16, I_GO = 512, I_AO = 256, I_OUT = 512, I_EXP = 16 * 512;
    WItem w; int r = it;
    if (r < I_IN) {
        const int nbg = r >> 4, kb = r & 15, n0 = 32 * nbg, tile = n0 >> 8, p = n0 & 255; int c0, nv = 32;
        if (tile < 12) c0 = n0;
        else if (tile < 24) { const int base = tile < 18 ? 3088 : 4624, tq = tile < 18 ? tile - 12 : tile - 18; c0 = base + (4 * tq + ((p & 127) >> 5)) * 64 + (p >= 128 ? 32 : 0); }
        else if (tile < 30) c0 = 6160 + (n0 - 24 * 256);
        else if (tile < 38) c0 = 7696 + (n0 - 30 * 256);
        else { c0 = 3072; nv = (p == 0) ? 16 : 0; }
        w.W = c.w_in + (size_t)l * D * DIN; w.N = DIN; w.WT = c.ws + WS_WIN; w.K = D; w.drow = n0; w.c0 = c0; w.nv = nv; w.kb = kb; return w; }
    r -= I_IN;
    if (r < I_GO) { w.W = c.w_gla_o + (size_t)l * D * D; w.N = D; w.WT = c.ws + WS_WGO; w.K = D; w.drow = 32 * (r >> 4); w.c0 = w.drow; w.nv = 32; w.kb = r & 15; return w; }
    r -= I_GO;
    if (r < I_AO) { w.W = c.w_att_o + (size_t)l * 512 * D; w.N = D; w.WT = c.ws + WS_WAO; w.K = 512; w.drow = 32 * (r >> 3); w.c0 = w.drow; w.nv = 32; w.kb = r & 7; return w; }
    r -= I_AO;
    if (r < I_OUT) { w.W = c.w_out + (size_t)l * D * D; w.N = D; w.WT = c.ws + WS_WOUT; w.K = D; w.drow = 32 * (r >> 4); w.c0 = w.drow; w.nv = 32; w.kb = r & 15; return w; }
    r -= I_OUT;
    const int which = r / I_EXP; r -= which * I_EXP; const int e = r >> 9, q = r & 511, nbg = q >> 4; const size_t eoff = (size_t)(l * NEXP + e) * D * DFF;
    w.N = DFF; w.K = D; w.c0 = 32 * nbg; w.nv = 32; w.kb = q & 15;
    if (which == 0) { w.W = c.w_e_gate + eoff; w.WT = c.ws + WS_WGU + (size_t)e * 2048 * 1024; w.drow = 256 * (nbg >> 2) + 32 * (nbg & 3); }
    else if (which == 1) { w.W = c.w_e_up + eoff; w.WT = c.ws + WS_WGU + (size_t)e * 2048 * 1024; w.drow = 256 * (nbg >> 2) + 128 + 32 * (nbg & 3); }
    else { w.W = c.w_e_down + eoff; w.N = D; w.K = DFF; w.WT = c.ws + WS_WD + (size_t)e * 1024 * 1024; w.drow = 32 * nbg; }
    return w;
}
DI void w_load(const WItem& w, int lane, float (&v)[32]) {
    const int cc = lane & 31, ccl = cc < w.nv ? cc : 0; const GAS float* wp = (const GAS float*)w.W + (size_t)(64 * w.kb + (lane >> 5)) * w.N + w.c0 + ccl;
#pragma unroll
    for (int i = 0; i < 32; ++i) v[i] = wp[(size_t)(2 * i) * w.N];
}
DI void w_store(const WItem& w, int lane, const float (&v)[32], LAS float* scr) {
    const int cc = lane & 31, k0 = 64 * w.kb;
#pragma unroll
    for (int i = 0; i < 32; ++i) scr[(2 * i + (lane >> 5)) * 33 + cc] = (cc < w.nv) ? v[i] : 0.f;
    LDS_WAIT(); asm volatile("" ::: "memory");
    const int c = lane & 7;
#pragma unroll
    for (int j = 0; j < 4; ++j) { const int n = (lane >> 3) + 8 * j; const LAS float* s = scr + (8 * c) * 33 + n;
        u32x2 o; o.x = pk4_fp8(s[0 * 33] * W8_SCALE, s[1 * 33] * W8_SCALE, s[2 * 33] * W8_SCALE, s[3 * 33] * W8_SCALE); o.y = pk4_fp8(s[4 * 33] * W8_SCALE, s[5 * 33] * W8_SCALE, s[6 * 33] * W8_SCALE, s[7 * 33] * W8_SCALE);
        *(GAS u32x2*)(w.WT + (size_t)(w.drow + n) * w.K + k0 + 8 * c) = o; }
    LDS_WAIT(); asm volatile("" ::: "memory");
}
DI void phase_w(LAS unsigned char* lds, const Ctx& c, int l, int G) {
    const int tid = ltid(), lane = tid & 63, wave = rfl(tid >> 6);
    LAS float* scr = (LAS float*)(lds + wave * 16384);
    const int gw = lbid() * NWAVES + wave, NGW = G * NWAVES;
    constexpr int NITEMS = (NIN / 32) * 16 + 512 + 256 + 512 + 3 * 16 * 512;
    float va[32], vb[32]; WItem wa, wb;
    int it = gw;
    if (it < NITEMS) { wa = w_decode(c, l, it); w_load(wa, lane, va); }
    while (it < NITEMS) {
        const bool hb = it + NGW < NITEMS; if (hb) { wb = w_decode(c, l, it + NGW); w_load(wb, lane, vb); }
        w_store(wa, lane, va, scr);
        it += NGW; if (it >= NITEMS) break;
        const bool ha = it + NGW < NITEMS; if (ha) { wa = w_decode(c, l, it + NGW); w_load(wa, lane, va); }
        w_store(wb, lane, vb, scr);
        it += NGW;
    }
    if (l == 0) {
        const size_t n8 = (size_t)T * D / 8; unsigned char* xb = c.ws + WS_XB;
        for (size_t i = (size_t)lbid() * NTHREADS + tid; i < n8; i += (size_t)G * NTHREADS) { const f32x4 a = *(const GAS f32x4*)(c.x + i * 8), b = *(const GAS f32x4*)(c.x + i * 8 + 4);
            u32x2 o; o.x = pk4_fp8(a[0], a[1], a[2], a[3]); o.y = pk4_fp8(b[0], b[1], b[2], b[3]); *(GAS u32x2*)(xb + i * 8) = o; }
    }
}

DI s16x4 tr16(const LAS void* p) { return __builtin_bit_cast(s16x4, __builtin_amdgcn_ds_read_tr16_b64_v4i16((LAS s16x4*)p)); }
DI bf16x8 cat8(s16x4 lo, s16x4 hi) { return __builtin_shufflevector(lo, hi, 0, 1, 2, 3, 4, 5, 6, 7); }
#define MFMA16(a, b, c) __builtin_amdgcn_mfma_f32_16x16x32_bf16((a), (b), (c), 0, 0, 0)

constexpr int REC_BYTES = 33792, REC_KS = 16384, REC_DEC = 32768, OI_BYTES = 16384;
constexpr int GP_QT = 0, GP_KT = 17408, GP_VS = 34816, GP_ATT = 68608, GP_WUP = 77824, GP_BAL = 86016;
DI float exp_(float x) { return __builtin_amdgcn_exp2f(x * LOG2E); }
DI void unpack8(const u32x4& q, float (&v)[16], int o) { v[o] = bf_lo(q.x); v[o + 1] = bf_hi(q.x); v[o + 2] = bf_lo(q.y); v[o + 3] = bf_hi(q.y); v[o + 4] = bf_lo(q.z); v[o + 5] = bf_hi(q.z); v[o + 6] = bf_lo(q.w); v[o + 7] = bf_hi(q.w); }
DI u32x4 packf8(const float (&v)[16], int o) { u32x4 p; p.x = cvt_pk_bf16(v[o], v[o + 1]); p.y = cvt_pk_bf16(v[o + 2], v[o + 3]); p.z = cvt_pk_bf16(v[o + 4], v[o + 5]); p.w = cvt_pk_bf16(v[o + 6], v[o + 7]); return p; }
DI void gla_p_unit(LAS unsigned char* lds, const Ctx& c, int l, int bl, int h, int n, int& h_loaded) {
    const int tid = ltid(), lane = tid & 63, w = rfl(tid >> 6), fr = lane & 15, fq = lane >> 4;
    const size_t tok0 = (size_t)bl * SEQ + n * 64;
    const bf16_t* QG = wsb(c, WS_H + H_QG) + tok0 * 512 + h * 128;
    const bf16_t* KG = wsb(c, WS_H + H_KG) + tok0 * 512 + h * 128;
    const bf16_t* VG = wsb(c, WS_H + H_VG) + tok0 * 1024 + h * 256;
    const float* HA = (const float*)(c.ws + WS_HA) + tok0 * 16;
    const int unit = (bl * 4 + h) * 64 + n;
    unsigned char* rec = c.ws + WS_REC + (size_t)unit * REC_BYTES;
    unsigned char* oi = c.ws + WS_MIX + (size_t)unit * OI_BYTES;
    LAS bf16_t* QT = (LAS bf16_t*)(lds + GP_QT); LAS bf16_t* KT = (LAS bf16_t*)(lds + GP_KT); LAS bf16_t* VS = (LAS bf16_t*)(lds + GP_VS); LAS bf16_t* AT = (LAS bf16_t*)(lds + GP_ATT);
    LAS float* WUP = (LAS float*)(lds + GP_WUP); LAS float* BAL = (LAS float*)(lds + GP_BAL);
    __syncthreads();
    if (h_loaded != h) { for (int i = tid; i < 16 * 128; i += NTHREADS) WUP[i] = c.w_alpha_up[(size_t)l * 16 * 512 + (i >> 7) * 512 + h * 128 + (i & 127)];
        if (tid < 128) BAL[tid] = c.b_alpha[l * 512 + h * 128 + tid]; h_loaded = h; __syncthreads(); }
    {
        const int row = lane;
        f32x4 a4[4];
#pragma unroll
        for (int j = 0; j < 4; ++j) a4[j] = *(const GAS f32x4*)(HA + (size_t)row * 16 + 4 * j);
        const u32x4 q0 = *(const GAS u32x4*)(QG + (size_t)row * 512 + 16 * w), q1 = *(const GAS u32x4*)(QG + (size_t)row * 512 + 16 * w + 8);
        const u32x4 k0 = *(const GAS u32x4*)(KG + (size_t)row * 512 + 16 * w), k1 = *(const GAS u32x4*)(KG + (size_t)row * 512 + 16 * w + 8);
#pragma unroll
        for (int c2 = 0; c2 < 4; ++c2) { const int idx = tid + NTHREADS * c2, r = idx >> 5, ch = idx & 31; *(LAS u32x4*)(VS + r * 264 + ch * 8) = *(const GAS u32x4*)(VG + (size_t)r * 1024 + ch * 8); }
        float la[16];
#pragma unroll
        for (int cc = 0; cc < 16; ++cc) la[cc] = BAL[16 * w + cc];
#pragma unroll
        for (int j = 0; j < 16; ++j) { const float aj = a4[j >> 2][j & 3];
#pragma unroll
            for (int c4 = 0; c4 < 4; ++c4) { const f32x4 wv = *(const LAS f32x4*)(WUP + j * 128 + 16 * w + 4 * c4); la[4 * c4] += aj * wv[0]; la[4 * c4 + 1] += aj * wv[1]; la[4 * c4 + 2] += aj * wv[2]; la[4 * c4 + 3] += aj * wv[3]; } }
#pragma unroll
        for (int cc = 0; cc < 16; ++cc) { const float z = la[cc]; la[cc] = -(fmaxf(-z, 0.f) + __builtin_amdgcn_logf(1.0f + exp_(-fabsf(z))) * 0.6931471805599453f) * (1.0f / 16.0f); }
#pragma unroll
        for (int dlt = 1; dlt < 64; dlt <<= 1)
#pragma unroll
            for (int cc = 0; cc < 16; ++cc) { const float t = __shfl_up(la[cc], dlt); if (lane >= dlt) la[cc] += t; }
        float qv[16], kv[16];
        unpack8(q0, qv, 0); unpack8(q1, qv, 8); unpack8(k0, kv, 0); unpack8(k1, kv, 8);
        float dc[16];
#pragma unroll
        for (int cc = 0; cc < 16; ++cc) { const float b = la[cc]; const float bend = __shfl(b, 63); const float eb = exp_(b); dc[cc] = eb; qv[cc] *= eb; la[cc] = kv[cc] * exp_(bend - b); kv[cc] *= exp_(-b); }
        if (lane == 63) {
#pragma unroll
            for (int c4 = 0; c4 < 4; ++c4) *(GAS f32x4*)(rec + REC_DEC + (16 * w + 4 * c4) * 4) = (f32x4){dc[4 * c4], dc[4 * c4 + 1], dc[4 * c4 + 2], dc[4 * c4 + 3]}; }
        const u32x4 qa = packf8(qv, 0), qb = packf8(qv, 8), ka = packf8(kv, 0), kb = packf8(kv, 8), sa = packf8(la, 0), sb = packf8(la, 8);
        *(LAS u32x4*)(QT + row * 136 + 16 * w) = qa; *(LAS u32x4*)(QT + row * 136 + 16 * w + 8) = qb;
        *(LAS u32x4*)(KT + row * 136 + 16 * w) = ka; *(LAS u32x4*)(KT + row * 136 + 16 * w + 8) = kb;
        *(GAS u32x4*)(rec + row * 256 + (((2 * w) ^ (row & 15)) << 4)) = qa; *(GAS u32x4*)(rec + row * 256 + (((2 * w + 1) ^ (row & 15)) << 4)) = qb;
        *(GAS u32x4*)(rec + REC_KS + row * 256 + (((2 * w) ^ (2 * (row & 7))) << 4)) = sa; *(GAS u32x4*)(rec + REC_KS + row * 256 + (((2 * w + 1) ^ (2 * (row & 7))) << 4)) = sb;
    }
    __syncthreads();
#pragma unroll
    for (int rep = 0; rep < 2; ++rep) {
        const int tt = w + 8 * rep, jt = tt >> 2, it = tt & 3;
        f32x4 a = (f32x4){0.f, 0.f, 0.f, 0.f};
        if (jt <= it) {
#pragma unroll
            for (int k4 = 0; k4 < 4; ++k4) { const bf16x8 af = *(const LAS bf16x8*)(KT + (16 * jt + fr) * 136 + 32 * k4 + 8 * fq), bfr = *(const LAS bf16x8*)(QT + (16 * it + fr) * 136 + 32 * k4 + 8 * fq); a = MFMA16(af, bfr, a); }
        }
        const int i = 16 * it + fr, j0 = 16 * jt + 4 * fq;
        u32x2 o; o.x = cvt_pk_bf16(j0 <= i ? a[0] : 0.f, j0 + 1 <= i ? a[1] : 0.f); o.y = cvt_pk_bf16(j0 + 2 <= i ? a[2] : 0.f, j0 + 3 <= i ? a[3] : 0.f);
        *(LAS u32x2*)(AT + i * 72 + j0) = o;
    }
    __syncthreads();
    {
        const int dv0 = 32 * w;
        bf16x8 vb[2][2];
#pragma unroll
        for (int k2 = 0; k2 < 2; ++k2)
#pragma unroll
            for (int dt = 0; dt < 2; ++dt) { const LAS bf16_t* p = VS + (32 * k2 + 8 * fq + (fr >> 2)) * 264 + dv0 + 16 * dt + (fr & 3) * 4; vb[k2][dt] = cat8(tr16(p), tr16(p + 4 * 264)); }
#pragma unroll
        for (int tt = 0; tt < 4; ++tt) {
            const bf16x8 a0 = *(const LAS bf16x8*)(AT + (16 * tt + fr) * 72 + 8 * fq), a1 = *(const LAS bf16x8*)(AT + (16 * tt + fr) * 72 + 32 + 8 * fq);
#pragma unroll
            for (int dt = 0; dt < 2; ++dt) { f32x4 z = (f32x4){0.f, 0.f, 0.f, 0.f}; z = MFMA16(vb[0][dt], a0, z); z = MFMA16(vb[1][dt], a1, z);
                *(GAS unsigned*)(oi + ((w * 8 + tt * 2 + dt) * 64 + lane) * 4) = pk4_fp8(z[0], z[1], z[2], z[3]); }
        }
    }
}
constexpr int GSEG = 16, NSEG = 64 / GSEG;
constexpr int GL_STAGE = 50176, GL_DEC = 16384, GL_VS = 17408;
DI void gla_l_chain(LAS unsigned char* lds, const Ctx& c, int bl, int h, int seg) {
    const int tid = ltid(), lane = tid & 63, w = rfl(tid >> 6), fr = lane & 15, fq = lane >> 4;
    const size_t t0 = (size_t)bl * SEQ + (size_t)seg * (GSEG * 64);
    const bf16_t* VG = wsb(c, WS_H + H_VG) + t0 * 1024 + h * 256;
    const unsigned char* rec0 = c.ws + WS_REC + (size_t)((bl * 4 + h) * 64 + seg * GSEG) * REC_BYTES;
    const int dv0 = 32 * w; const unsigned lds_u = (unsigned)(uintptr_t)lds;
    f32x4 S[8][2], Dc[8];
#pragma unroll
    for (int a = 0; a < 8; ++a) { S[a][0] = (f32x4){0.f, 0.f, 0.f, 0.f}; S[a][1] = (f32x4){0.f, 0.f, 0.f, 0.f}; Dc[a] = (f32x4){1.f, 1.f, 1.f, 1.f}; }
#define GL_DMA(gp, ldsoff) do { unsigned _sv; const unsigned _m = (unsigned)__builtin_amdgcn_readfirstlane((int)(ldsoff)); \
        asm volatile("s_mov_b32 %0, m0\n\ts_mov_b32 m0, %2\n\ts_nop 0\n\tglobal_load_lds_dwordx4 %1, off\n\ts_mov_b32 m0, %0" : "=&s"(_sv) : "v"(gp), "s"(_m) : "memory"); } while (0)
#define GL_PREFETCH(nn, st) do { const unsigned char* _r = rec0 + (size_t)(nn) * REC_BYTES + REC_KS; const unsigned _s = lds_u + (unsigned)(st) * GL_STAGE; \
        _Pragma("unroll") for (int _p = 0; _p < 2; ++_p) GL_DMA((const GAS unsigned char*)(_r + (w * 2 + _p) * 1024 + lane * 16), _s + (w * 2 + _p) * 1024); \
        if (w == 0) GL_DMA((const GAS unsigned char*)(_r + 16384 + lane * 16), _s + GL_DEC); \
        _Pragma("unroll") for (int _p = 0; _p < 4; ++_p) { const int _row = 2 * (w * 4 + _p) + (lane >> 5); \
            GL_DMA((const GAS bf16_t*)(VG + (size_t)((nn) * 64 + _row) * 1024 + (((lane & 31) ^ (2 * (_row & 3))) << 3)), _s + GL_VS + (w * 4 + _p) * 1024); } } while (0)
    __syncthreads();
    GL_PREFETCH(0, 0);
    for (int n = 0; n < GSEG; ++n) {
        const int st = n & 1; LAS unsigned char* sb_ = lds + st * GL_STAGE;
        LAS bf16_t* KS = (LAS bf16_t*)sb_; LAS float* DEC = (LAS float*)(sb_ + GL_DEC); LAS bf16_t* VS = (LAS bf16_t*)(sb_ + GL_VS);
        VM_WAIT(); asm volatile("s_waitcnt lgkmcnt(0)" ::: "memory"); __builtin_amdgcn_s_barrier(); asm volatile("" ::: "memory");
        if (n + 1 < GSEG) GL_PREFETCH(n + 1, st ^ 1);
        bf16x8 vb[2][2];
#pragma unroll
        for (int k2 = 0; k2 < 2; ++k2)
#pragma unroll
            for (int dt = 0; dt < 2; ++dt) { const int r0 = 32 * k2 + 8 * fq + (fr >> 2);
                const LAS bf16_t* p = VS + r0 * 256 + ((((dv0 + 16 * dt) >> 3) ^ (2 * (r0 & 3))) << 3) + (fr & 3) * 4; vb[k2][dt] = cat8(tr16(p), tr16(p + 4 * 256)); }
#pragma unroll
        for (int k8 = 0; k8 < 8; ++k8) {
            const f32x4 dc = *(const LAS f32x4*)(DEC + 16 * k8 + 4 * fq);
            S[k8][0] *= dc; S[k8][1] *= dc; Dc[k8] *= dc;
#pragma unroll
            for (int k2 = 0; k2 < 2; ++k2) { const int r0 = 32 * k2 + 8 * fq + (fr >> 2);
                const LAS bf16_t* p0 = KS + r0 * 128 + (((2 * k8) ^ (2 * (r0 & 7))) << 3) + (fr & 3) * 4; const LAS bf16_t* p1 = KS + (r0 + 4) * 128 + (((2 * k8) ^ (2 * ((r0 + 4) & 7))) << 3) + (fr & 3) * 4;
                const bf16x8 af = cat8(tr16(p0), tr16(p1));
                S[k8][0] = MFMA16(af, vb[k2][0], S[k8][0]); S[k8][1] = MFMA16(af, vb[k2][1], S[k8][1]); }
        }
    }
#undef GL_PREFETCH
#undef GL_DMA
    const int cj = (bl * 4 + h) * NSEG + seg;
    GAS f32x4* sl = (GAS f32x4*)(c.ws + WS_SLOC) + ((size_t)(cj * 8 + w) * 16) * 64 + lane;
#pragma unroll
    for (int a = 0; a < 8; ++a) { sl[(a * 2) * 64] = S[a][0]; sl[(a * 2 + 1) * 64] = S[a][1]; }
    if (w == 0) { GAS f32x4* dq = (GAS f32x4*)(c.ws + WS_DCUM) + (size_t)cj * 8 * 64 + lane;
#pragma unroll
        for (int a = 0; a < 8; ++a) dq[a * 64] = Dc[a]; }
    VM_WAIT(); __syncthreads();
}
constexpr int GS_STAGE = 66560, GS_KS = 16384, GS_DEC = 32768, GS_VS = 33792, GS_SS = 2 * GS_STAGE;
DI void gla_s_chain(LAS unsigned char* lds, const Ctx& c, int l, int bl, int h, int seg) {
    const int tid = ltid(), lane = tid & 63, w = rfl(tid >> 6), fr = lane & 15, fq = lane >> 4;
    const size_t t0 = (size_t)bl * SEQ + (size_t)seg * (GSEG * 64);
    const bf16_t* VG = wsb(c, WS_H + H_VG) + t0 * 1024 + h * 256;
    const unsigned char* SR = c.ws + WS_H + H_SR + t0 * 1024 + h * 256;
    unsigned char* OG = c.ws + WS_OG + t0 * 1024 + h * 256;
    const unsigned char* rec0 = c.ws + WS_REC + (size_t)((bl * 4 + h) * 64 + seg * GSEG) * REC_BYTES;
    const unsigned char* oi0 = c.ws + WS_MIX + (size_t)((bl * 4 + h) * 64 + seg * GSEG) * OI_BYTES;
    LAS float* SS = (LAS float*)(lds + GS_SS);
    const int dv0 = 32 * w;
    f32x4 gnv[2]; gnv[0] = *(const GAS f32x4*)(c.gla_norm + l * 1024 + h * 256 + dv0 + 4 * fq); gnv[1] = *(const GAS f32x4*)(c.gla_norm + l * 1024 + h * 256 + dv0 + 16 + 4 * fq);
    f32x4 S[8][2];
#pragma unroll
    for (int a = 0; a < 8; ++a) { S[a][0] = (f32x4){0.f, 0.f, 0.f, 0.f}; S[a][1] = (f32x4){0.f, 0.f, 0.f, 0.f}; }
    for (int j = 0; j < seg; ++j) {
        const int cj = (bl * 4 + h) * NSEG + j;
        const GAS f32x4* sl = (const GAS f32x4*)(c.ws + WS_SLOC) + ((size_t)(cj * 8 + w) * 16) * 64 + lane; const GAS f32x4* dq = (const GAS f32x4*)(c.ws + WS_DCUM) + (size_t)cj * 8 * 64 + lane;
#pragma unroll
        for (int a = 0; a < 8; ++a) { const f32x4 dcv = dq[a * 64]; S[a][0] = S[a][0] * dcv + sl[(a * 2) * 64]; S[a][1] = S[a][1] * dcv + sl[(a * 2 + 1) * 64]; }
    }
#define GS_DMA(gp, ldsoff) do { unsigned _sv; const unsigned _m = (unsigned)__builtin_amdgcn_readfirstlane((int)(ldsoff)); \
        asm volatile("s_mov_b32 %0, m0\n\ts_mov_b32 m0, %2\n\ts_nop 0\n\tglobal_load_lds_dwordx4 %1, off\n\ts_mov_b32 m0, %0" : "=&s"(_sv) : "v"(gp), "s"(_m) : "memory"); } while (0)
#define GS_PREFETCH(nn, st) do { const unsigned char* _r = rec0 + (size_t)(nn) * REC_BYTES; const unsigned _s = lds_u + (unsigned)(st) * GS_STAGE; \
        _Pragma("unroll") for (int _p = 0; _p < 4; ++_p) GS_DMA((const GAS unsigned char*)(_r + (w * 4 + _p) * 1024 + lane * 16), _s + (w * 4 + _p) * 1024); \
        if (w == 0) GS_DMA((const GAS unsigned char*)(_r + 32768 + lane * 16), _s + 32768); \
        _Pragma("unroll") for (int _p = 0; _p < 4; ++_p) { const int _row = 2 * (w * 4 + _p) + (lane >> 5); \
            GS_DMA((const GAS bf16_t*)(VG + (size_t)((nn) * 64 + _row) * 1024 + (((lane & 31) ^ (2 * (_row & 3))) << 3)), _s + GS_VS + (w * 4 + _p) * 1024); } } while (0)
    const unsigned lds_u = (unsigned)(uintptr_t)lds;
#define GS_BAR() do { asm volatile("s_waitcnt lgkmcnt(0)" ::: "memory"); __builtin_amdgcn_s_barrier(); asm volatile("" ::: "memory"); } while (0)
    __syncthreads();
    GS_PREFETCH(0, 0);
    for (int n = 0; n < GSEG; ++n) {
        const int st = n & 1; LAS unsigned char* sb_ = lds + st * GS_STAGE;
        LAS bf16_t* QT = (LAS bf16_t*)sb_; LAS bf16_t* KS = (LAS bf16_t*)(sb_ + GS_KS); LAS float* DEC = (LAS float*)(sb_ + GS_DEC); LAS bf16_t* VS = (LAS bf16_t*)(sb_ + GS_VS); LAS bf16_t* OST = (LAS bf16_t*)(sb_ + GS_KS);
        VM_WAIT(); GS_BAR();
        unsigned oiv[8];
#pragma unroll
        for (int q = 0; q < 8; ++q) oiv[q] = *(const GAS unsigned*)(oi0 + (size_t)n * OI_BYTES + ((w * 8 + q) * 64 + lane) * 4);
        unsigned srv[8];
#pragma unroll
        for (int q = 0; q < 8; ++q) srv[q] = *(const GAS unsigned*)(SR + (size_t)(n * 64 + 16 * (q >> 1) + fr) * 1024 + dv0 + 16 * (q & 1) + 4 * fq);
        asm volatile("" ::: "memory");
        if (n + 1 < GSEG) GS_PREFETCH(n + 1, st ^ 1);
        f32x4 o[4][2];
        {
            bf16x8 vb[2][2];
#pragma unroll
            for (int k2 = 0; k2 < 2; ++k2)
#pragma unroll
                for (int dt = 0; dt < 2; ++dt) { const int r0 = 32 * k2 + 8 * fq + (fr >> 2);
                    const LAS bf16_t* p = VS + r0 * 256 + ((((dv0 + 16 * dt) >> 3) ^ (2 * (r0 & 3))) << 3) + (fr & 3) * 4; vb[k2][dt] = cat8(tr16(p), tr16(p + 4 * 256)); }
#pragma unroll
            for (int tt = 0; tt < 4; ++tt) { o[tt][0] = (f32x4){0.f, 0.f, 0.f, 0.f}; o[tt][1] = (f32x4){0.f, 0.f, 0.f, 0.f}; }
#pragma unroll
            for (int s = 0; s < 4; ++s) {
                bf16x8 sb[2];
#pragma unroll
                for (int dt = 0; dt < 2; ++dt) { u32x4 pk; pk.x = cvt_pk_bf16(S[2 * s][dt][0], S[2 * s][dt][1]); pk.y = cvt_pk_bf16(S[2 * s][dt][2], S[2 * s][dt][3]); pk.z = cvt_pk_bf16(S[2 * s + 1][dt][0], S[2 * s + 1][dt][1]); pk.w = cvt_pk_bf16(S[2 * s + 1][dt][2], S[2 * s + 1][dt][3]); sb[dt] = __builtin_bit_cast(bf16x8, pk); }
#pragma unroll
                for (int tt = 0; tt < 4; ++tt) { const int i = 16 * tt + fr;
                    const LAS bf16_t* qp = QT + i * 128 + (fq & 1) * 4;
                    const bf16x8 af = cat8(*(const LAS s16x4*)(qp + (((4 * s + (fq >> 1)) ^ (i & 15)) << 3)), *(const LAS s16x4*)(qp + (((4 * s + 2 + (fq >> 1)) ^ (i & 15)) << 3)));
                    o[tt][0] = MFMA16(sb[0], af, o[tt][0]); o[tt][1] = MFMA16(sb[1], af, o[tt][1]); }
            }
#pragma unroll
            for (int k8 = 0; k8 < 8; ++k8) {
                const f32x4 dc = *(const LAS f32x4*)(DEC + 16 * k8 + 4 * fq);
                S[k8][0] *= dc; S[k8][1] *= dc;
#pragma unroll
                for (int k2 = 0; k2 < 2; ++k2) { const int r0 = 32 * k2 + 8 * fq + (fr >> 2);
                    const LAS bf16_t* p0 = KS + r0 * 128 + (((2 * k8) ^ (2 * (r0 & 7))) << 3) + (fr & 3) * 4; const LAS bf16_t* p1 = KS + (r0 + 4) * 128 + (((2 * k8) ^ (2 * ((r0 + 4) & 7))) << 3) + (fr & 3) * 4;
                    const bf16x8 af = cat8(tr16(p0), tr16(p1));
                    S[k8][0] = MFMA16(af, vb[k2][0], S[k8][0]); S[k8][1] = MFMA16(af, vb[k2][1], S[k8][1]); }
            }
        }
#pragma unroll
        for (int tt = 0; tt < 4; ++tt)
#pragma unroll
            for (int dt = 0; dt < 2; ++dt) { const f32x2 a = __builtin_amdgcn_cvt_pk_f32_fp8((int)oiv[tt * 2 + dt], false), b = __builtin_amdgcn_cvt_pk_f32_fp8((int)oiv[tt * 2 + dt], true); o[tt][dt][0] += a[0]; o[tt][dt][1] += a[1]; o[tt][dt][2] += b[0]; o[tt][dt][3] += b[1]; }
        {
            f32x4 pp;
#pragma unroll
            for (int tt = 0; tt < 4; ++tt) { const f32x4 a = o[tt][0] * o[tt][0] + o[tt][1] * o[tt][1]; float p = (a[0] + a[1]) + (a[2] + a[3]); p += __shfl_xor(p, 16); p += __shfl_xor(p, 32); pp[tt] = p; }
            if (fq == 0) { SS[(0 * 16 + fr) * 8 + w] = pp[0]; SS[(1 * 16 + fr) * 8 + w] = pp[1]; SS[(2 * 16 + fr) * 8 + w] = pp[2]; SS[(3 * 16 + fr) * 8 + w] = pp[3]; }
        }
        GS_BAR();
#pragma unroll
        for (int tt = 0; tt < 4; ++tt) { const f32x4 s0 = *(const LAS f32x4*)(SS + (16 * tt + fr) * 8), s1 = *(const LAS f32x4*)(SS + (16 * tt + fr) * 8 + 4);
            const float ss = ((s0[0] + s0[1]) + (s0[2] + s0[3])) + ((s1[0] + s1[1]) + (s1[2] + s1[3])); const float rs = __builtin_amdgcn_rsqf(ss * (1.0f / 256.0f) + RMS_EPS);
#pragma unroll
            for (int dt = 0; dt < 2; ++dt) { const f32x2 sa = __builtin_amdgcn_cvt_pk_f32_fp8((int)srv[tt * 2 + dt], false), sb2 = __builtin_amdgcn_cvt_pk_f32_fp8((int)srv[tt * 2 + dt], true); const f32x4 g = gnv[dt]; const f32x4 v = o[tt][dt] * rs;
                *(GAS unsigned*)(OG + (size_t)(n * 64 + 16 * tt + fr) * 1024 + dv0 + 16 * dt + 4 * fq) = pk4_fp8(v[0] * g[0] * sa[0], v[1] * g[1] * sa[1], v[2] * g[2] * sb2[0], v[3] * g[3] * sb2[1]); } }
    }
#undef GS_PREFETCH
#undef GS_DMA
#undef GS_BAR
    VM_WAIT(); __syncthreads();
}

constexpr int AT_K = 0, AT_V = 55296;
struct APre { u32x4 k[6], v[6]; bf16x8 q[2][2]; };
struct AUnit { int dl, n, colo; size_t tb; };
DI AUnit attn_decode(int u) { AUnit a; const int bl = u / 768, g = (u / 256) % 3, h = (u >> 5) & 7, x = u & 31; a.dl = (g == 0) ? 1 : (g == 1 ? 4 : 16); const int nb = 32 / a.dl, r = x / nb; a.n = x - r * nb; a.tb = (size_t)bl * SEQ + r; a.colo = g * 512 + h * 64; return a; }
DI void attn_load(const Ctx& c, int u, APre& p) {
    const int tid = ltid(), lane = tid & 63, w = rfl(tid >> 6), fr = lane & 15, fq = lane >> 4; const AUnit a = attn_decode(u);
    const bf16_t* Q = wsb(c, WS_H + H_QD) + a.colo; const bf16_t* K = wsb(c, WS_H + H_KD) + a.colo; const bf16_t* V = wsb(c, WS_H + H_VD) + a.colo;
#pragma unroll
    for (int b = 0; b < 2; ++b) { const size_t tokq = a.tb + (size_t)a.dl * (128 * (a.n + b) + 16 * w + fr);
#pragma unroll
        for (int d0 = 0; d0 < 2; ++d0) p.q[b][d0] = *(const GAS bf16x8*)(Q + tokq * 1536 + 32 * d0 + 8 * fq); }
#pragma unroll
    for (int c2 = 0; c2 < 6; ++c2) { const int idx = tid + NTHREADS * c2, row = idx >> 3, ch = idx & 7; const int j = 128 * (a.n - 1) + row;
        p.k[c2] = (u32x4){0u, 0u, 0u, 0u}; p.v[c2] = (u32x4){0u, 0u, 0u, 0u};
        if (j >= 0) { const size_t tok = a.tb + (size_t)a.dl * j; p.k[c2] = *(const GAS u32x4*)(K + tok * 1536 + ch * 8); p.v[c2] = *(const GAS u32x4*)(V + tok * 1536 + ch * 8); } }
}
DI void attn_stage(LAS unsigned char* lds, const APre& p) {
    const int tid = ltid(); LAS bf16_t* Ks = (LAS bf16_t*)(lds + AT_K); LAS bf16_t* Vs = (LAS bf16_t*)(lds + AT_V);
#pragma unroll
    for (int c2 = 0; c2 < 6; ++c2) { const int idx = tid + NTHREADS * c2, row = idx >> 3, ch = idx & 7; *(LAS u32x4*)(Ks + row * 72 + ch * 8) = p.k[c2]; *(LAS u32x4*)(Vs + row * 72 + ch * 8) = p.v[c2]; }
}
DI void attn_compute(LAS unsigned char* lds, const Ctx& c, int u, const bf16x8 (&qf)[2][2]) {
    const int tid = ltid(), lane = tid & 63, w = rfl(tid >> 6), fr = lane & 15, fq = lane >> 4; const AUnit au = attn_decode(u);
    const int dl = au.dl, n = au.n, g = (u / 256) % 3, h = (u >> 5) & 7; const size_t tb = au.tb;
    LAS bf16_t* Ks = (LAS bf16_t*)(lds + AT_K); LAS bf16_t* Vs = (LAS bf16_t*)(lds + AT_V);
#pragma unroll
    for (int b = 0; b < 2; ++b) {
        const int kt0 = 8 * b + w;
        f32x4 s[9]; float m = -1e30f;
#pragma unroll
        for (int kr = 0; kr < 9; ++kr) { const int kt = kt0 + kr; f32x4 a = (f32x4){0.f, 0.f, 0.f, 0.f};
#pragma unroll
            for (int d0 = 0; d0 < 2; ++d0) { const bf16x8 af = *(const LAS bf16x8*)(Ks + (16 * kt + fr) * 72 + 32 * d0 + 8 * fq); a = MFMA16(af, qf[b][d0], a); }
#pragma unroll
            for (int rg = 0; rg < 4; ++rg) { const bool tile_ok = (b > 0) || (n > 0) || (kt >= 8);
                bool ok = tile_ok; if (kr == 0) ok = ok && (4 * fq + rg >= fr); if (kr == 8) ok = ok && (4 * fq + rg <= fr);
                a[rg] = ok ? a[rg] : -1e30f; m = fmaxf(m, a[rg]); }
            s[kr] = a; }
        m = fmaxf(m, __shfl_xor(m, 16)); m = fmaxf(m, __shfl_xor(m, 32));
        float lsum = 0.f;
#pragma unroll
        for (int kr = 0; kr < 9; ++kr)
#pragma unroll
            for (int rg = 0; rg < 4; ++rg) { const float p = __builtin_amdgcn_exp2f(s[kr][rg] - m); s[kr][rg] = p; lsum += p; }
        lsum += __shfl_xor(lsum, 16); lsum += __shfl_xor(lsum, 32);
        f32x4 oT[4];
#pragma unroll
        for (int dt = 0; dt < 4; ++dt) oT[dt] = (f32x4){0.f, 0.f, 0.f, 0.f};
#pragma unroll
        for (int pp = 0; pp < 5; ++pp) { const int ka = 2 * pp, kb = (2 * pp + 1 < 9) ? 2 * pp + 1 : 8;
            u32x4 pk; pk.x = cvt_pk_bf16(s[ka][0], s[ka][1]); pk.y = cvt_pk_bf16(s[ka][2], s[ka][3]);
            if (2 * pp + 1 < 9) { pk.z = cvt_pk_bf16(s[kb][0], s[kb][1]); pk.w = cvt_pk_bf16(s[kb][2], s[kb][3]); } else { pk.z = 0u; pk.w = 0u; }
            const bf16x8 pf = __builtin_bit_cast(bf16x8, pk);
#pragma unroll
            for (int dt = 0; dt < 4; ++dt) { const LAS bf16_t* pa = Vs + (16 * (kt0 + ka) + 4 * fq + (fr >> 2)) * 72 + 16 * dt + (fr & 3) * 4; const LAS bf16_t* pb = Vs + (16 * (kt0 + kb) + 4 * fq + (fr >> 2)) * 72 + 16 * dt + (fr & 3) * 4;
                oT[dt] = MFMA16(cat8(tr16(pa), tr16(pb)), pf, oT[dt]); } }
        const float inv = 1.0f / lsum; const size_t tq = tb + (size_t)dl * (128 * (n + b) + 16 * w + fr);
        bf16_t* op = wsb(c, WS_ATTG) + ((size_t)g * TH + tq) * 512 + h * 64 + 4 * fq;
#pragma unroll
        for (int dt = 0; dt < 4; ++dt) { u32x2 o; o.x = cvt_pk_bf16(oT[dt][0] * inv, oT[dt][1] * inv); o.y = cvt_pk_bf16(oT[dt][2] * inv, oT[dt][3] * inv); *(GAS u32x2*)(op + 16 * dt) = o; }
        if (fq == 0) ((float*)(c.ws + WS_LSE))[((size_t)g * TH + tq) * 8 + h] = m + __builtin_amdgcn_logf(lsum);
    }
}
DI void phase_p(LAS unsigned char* lds, const Ctx& c, int l, int G) {
    int h_loaded = -1;
    for (int u = lbid(); u < 8 * 4 * 64; u += G) gla_p_unit(lds, c, l, u >> 8, (u >> 6) & 3, u & 63, h_loaded);
}
constexpr int NATT = 8 * 3 * 8 * 32, NATT1 = 2304, NCHAIN = 8 * 4 * NSEG;
DI void attn_pull(LAS unsigned char* lds, const Ctx& c, unsigned* ctr, int base, int limit) {
    volatile LAS int* TK = (volatile LAS int*)(lds + MISC_OFF + 192);
    const int tid = ltid();
    __syncthreads();
    if (tid == 0) { TK[0] = base + 2 * (int)__hip_atomic_fetch_add(ctr, 1u, __ATOMIC_RELAXED, __HIP_MEMORY_SCOPE_AGENT); TK[1] = base + 2 * (int)__hip_atomic_fetch_add(ctr, 1u, __ATOMIC_RELAXED, __HIP_MEMORY_SCOPE_AGENT);
        TK[2] = base + 2 * (int)__hip_atomic_fetch_add(ctr, 1u, __ATOMIC_RELAXED, __HIP_MEMORY_SCOPE_AGENT); }
    __syncthreads();
    int cur = rfl(TK[0]), nxt = rfl(TK[1]);
    APre pre;
    if (cur < limit) attn_load(c, cur, pre);
    while (cur < limit) {
        __syncthreads();
        const int nxt2 = rfl(TK[2]);
        attn_stage(lds, pre);
        bf16x8 qf[2][2];
#pragma unroll
        for (int b = 0; b < 2; ++b)
#pragma unroll
            for (int d0 = 0; d0 < 2; ++d0) qf[b][d0] = pre.q[b][d0];
        __syncthreads();
        if (nxt < limit) attn_load(c, nxt, pre);
        int req = 0; if (tid == 0) req = base + 2 * (int)__hip_atomic_fetch_add(ctr, 1u, __ATOMIC_RELAXED, __HIP_MEMORY_SCOPE_AGENT);
        attn_compute(lds, c, cur, qf);
        if (tid == 0) TK[2] = req;
        cur = nxt; nxt = nxt2;
    }
}
DI void phase_b1(LAS unsigned char* lds, const Ctx& c, int l, int hf, int G) {
    const int bid = lbid(); unsigned* ctr = (unsigned*)(c.ws + WS_CTL) + CW_TKT + ((l * 2 + hf) * 2) * 64;
    for (int id = bid; id < NCHAIN; id += G) gla_l_chain(lds, c, id >> 4, (id >> 2) & 3, id & 3);
    attn_pull(lds, c, ctr, 0, NATT1);
}
DI void phase_b(LAS unsigned char* lds, const Ctx& c, int l, int hf, int G) {
    const int bid = lbid(); unsigned* ctr = (unsigned*)(c.ws + WS_CTL) + CW_TKT + ((l * 2 + hf) * 2 + 1) * 64;
    for (int id = bid; id < NCHAIN; id += G) gla_s_chain(lds, c, l, id >> 4, (id >> 2) & 3, id & 3);
    attn_pull(lds, c, ctr, NATT1, NATT);
}
DI void phase_f(const Ctx& c, int G) {
    const bf16_t* ag = wsb(c, WS_ATTG); const float* lse = (const float*)(c.ws + WS_LSE); unsigned char* att = c.ws + WS_ATT;
    const size_t stride = (size_t)G * NTHREADS, N = (size_t)TH * 64;
    for (size_t i0 = (size_t)lbid() * NTHREADS + ltid(); i0 < N; i0 += 4 * stride) {
        float l0[4], l1[4], l2[4]; u32x4 a[4], b[4], d[4];
#pragma unroll
        for (int q = 0; q < 4; ++q) { const size_t i = i0 + q * stride; const bool ok = i < N; const size_t tok = ok ? (i >> 6) : 0; const int ch = (int)(i & 63), h = ch >> 3;
            l0[q] = lse[tok * 8 + h]; l1[q] = lse[((size_t)TH + tok) * 8 + h]; l2[q] = lse[((size_t)2 * TH + tok) * 8 + h];
            a[q] = *(const GAS u32x4*)(ag + tok * 512 + ch * 8); b[q] = *(const GAS u32x4*)(ag + ((size_t)TH + tok) * 512 + ch * 8); d[q] = *(const GAS u32x4*)(ag + ((size_t)2 * TH + tok) * 512 + ch * 8); }
#pragma unroll
        for (int q = 0; q < 4; ++q) { const size_t i = i0 + q * stride; if (i >= N) continue; const size_t tok = i >> 6; const int ch = (int)(i & 63);
            const float mx = fmaxf(l0[q], fmaxf(l1[q], l2[q])); float w0 = __builtin_amdgcn_exp2f(l0[q] - mx), w1 = __builtin_amdgcn_exp2f(l1[q] - mx), w2 = __builtin_amdgcn_exp2f(l2[q] - mx);
            const float inv = 1.0f / (w0 + w1 + w2); w0 *= inv; w1 *= inv; w2 *= inv;
            u32x2 o;
            o.x = pk4_fp8(w0 * bf_lo(a[q].x) + w1 * bf_lo(b[q].x) + w2 * bf_lo(d[q].x), w0 * bf_hi(a[q].x) + w1 * bf_hi(b[q].x) + w2 * bf_hi(d[q].x), w0 * bf_lo(a[q].y) + w1 * bf_lo(b[q].y) + w2 * bf_lo(d[q].y), w0 * bf_hi(a[q].y) + w1 * bf_hi(b[q].y) + w2 * bf_hi(d[q].y));
            o.y = pk4_fp8(w0 * bf_lo(a[q].z) + w1 * bf_lo(b[q].z) + w2 * bf_lo(d[q].z), w0 * bf_hi(a[q].z) + w1 * bf_hi(b[q].z) + w2 * bf_hi(d[q].z), w0 * bf_lo(a[q].w) + w1 * bf_lo(b[q].w) + w2 * bf_lo(d[q].w), w0 * bf_hi(a[q].w) + w1 * bf_hi(b[q].w) + w2 * bf_hi(d[q].w));
            *(GAS u32x2*)(att + tok * 512 + ch * 8) = o; }
    }
}

DI float wave_sum(float v) {
#pragma unroll
    for (int o = 1; o < 64; o <<= 1) v += __shfl_xor(v, o);
    return v;
}
constexpr int R_WR = 0, R_HIST = 65536, R_BASE = 65536 + 64, R_INFO = 65536 + 128;
DI void phase_r(LAS unsigned char* lds, const Ctx& c, int l, int G) {
    const int tid = ltid(), lane = tid & 63, wave = rfl(tid >> 6);
    LAS float* WR = (LAS float*)(lds + R_WR); volatile LAS int* HIST = (volatile LAS int*)(lds + R_HIST); volatile LAS int* BASE = (volatile LAS int*)(lds + R_BASE); volatile LAS int* INFO = (volatile LAS int*)(lds + R_INFO);
    __syncthreads();
    for (int i = tid; i < 16 * 1024; i += NTHREADS) WR[(i & 15) * 1024 + (i >> 4)] = c.w_router[i];
    f32x4 g4[4], b4[4];
#pragma unroll
    for (int j = 0; j < 4; ++j) { g4[j] = *(const GAS f32x4*)(c.ln1_g + l * D + 4 * lane + 256 * j); b4[j] = *(const GAS f32x4*)(c.ln1_b + l * D + 4 * lane + 256 * j); }
    bf16_t* xr = wsb(c, WS_XR); unsigned char* xb = c.ws + WS_XB; int* histg = (int*)(c.ws + WS_HISTG); float* gate = (float*)(c.ws + WS_GATE);
    const float brt = c.b_router[((lane >> 5) & 1) * 8 + ((lane >> 4) & 1) * 4 + ((lane >> 3) & 1) * 2 + ((lane >> 2) & 1)];
    for (int chunk = lbid(); chunk < T / 256; chunk += G) {
        __syncthreads();
        u32x2 zn[4];
#pragma unroll
        for (int j = 0; j < 4; ++j) zn[j] = *(const GAS u32x2*)(xr + ((size_t)chunk * 256 + wave * 32) * D + 4 * lane + 256 * j);
        for (int rr = 0; rr < 32; ++rr) {
            const int rl = wave * 32 + rr; const size_t row = (size_t)chunk * 256 + rl;
            f32x4 v[4]; float s = 0.f;
#pragma unroll
            for (int j = 0; j < 4; ++j) { const u32x2 zq = zn[j]; v[j] = (f32x4){bf_lo(zq.x), bf_hi(zq.x), bf_lo(zq.y), bf_hi(zq.y)}; s += (v[j][0] + v[j][1]) + (v[j][2] + v[j][3]); }
            { const size_t rn = row + (rr + 1 < 32 ? 1 : 0);
#pragma unroll
              for (int j = 0; j < 4; ++j) zn[j] = *(const GAS u32x2*)(xr + rn * D + 4 * lane + 256 * j); }
            const float mean = wave_sum(s) * (1.0f / D); float s2 = 0.f;
#pragma unroll
            for (int j = 0; j < 4; ++j) { v[j] = v[j] - mean; s2 += (v[j][0] * v[j][0] + v[j][1] * v[j][1]) + (v[j][2] * v[j][2] + v[j][3] * v[j][3]); }
            const float rstd = __builtin_amdgcn_rsqf(wave_sum(s2) * (1.0f / D) + LN_EPS);
#pragma unroll
            for (int j = 0; j < 4; ++j) { v[j] = v[j] * rstd * g4[j] + b4[j]; u32x2 xq; xq.x = cvt_pk_bf16(v[j][0], v[j][1]); xq.y = cvt_pk_bf16(v[j][2], v[j][3]); *(GAS u32x2*)(xr + row * D + 4 * lane + 256 * j) = xq;
                *(GAS unsigned*)(xb + row * D + 4 * lane + 256 * j) = pk4_fp8(v[j][0], v[j][1], v[j][2], v[j][3]); }
            float lg[16];
#pragma unroll
            for (int e = 0; e < 16; ++e) { float a = 0.f;
#pragma unroll
                for (int j = 0; j < 4; ++j) { const f32x4 wv = *(const LAS f32x4*)(WR + e * 1024 + 4 * lane + 256 * j); a += v[j][0] * wv[0] + v[j][1] * wv[1] + v[j][2] * wv[2] + v[j][3] * wv[3]; }
                lg[e] = a; }
            {
                float b8[8], b4[4], b2[2];
                const bool h5 = lane & 32, h4 = lane & 16, h3 = lane & 8, h2 = lane & 4;
#pragma unroll
                for (int i = 0; i < 8; ++i) { const float mine = h5 ? lg[8 + i] : lg[i], send = h5 ? lg[i] : lg[8 + i]; b8[i] = mine + __shfl_xor(send, 32); }
#pragma unroll
                for (int i = 0; i < 4; ++i) { const float mine = h4 ? b8[4 + i] : b8[i], send = h4 ? b8[i] : b8[4 + i]; b4[i] = mine + __shfl_xor(send, 16); }
#pragma unroll
                for (int i = 0; i < 2; ++i) { const float mine = h3 ? b4[2 + i] : b4[i], send = h3 ? b4[i] : b4[2 + i]; b2[i] = mine + __shfl_xor(send, 8); }
                float b1 = (h2 ? b2[1] : b2[0]) + __shfl_xor(h2 ? b2[0] : b2[1], 4);
                b1 += __shfl_xor(b1, 2); b1 += __shfl_xor(b1, 1);
                b1 += brt;
#pragma unroll
                for (int e = 0; e < 16; ++e) lg[e] = __shfl(b1, ((e >> 3) & 1) * 32 + ((e >> 2) & 1) * 16 + ((e >> 1) & 1) * 8 + (e & 1) * 4);
            }
            float mx = lg[0];
#pragma unroll
            for (int e = 1; e < 16; ++e) mx = fmaxf(mx, lg[e]);
            float se = 0.f;
#pragma unroll
            for (int e = 0; e < 16; ++e) { lg[e] = __expf(lg[e] - mx); se += lg[e]; }
            const float ise = 1.0f / se;
#pragma unroll
            for (int e = 0; e < 16; ++e) lg[e] *= ise;
            int gsel = 0; float gbest = -1.f;
#pragma unroll
            for (int gi = 0; gi < 4; ++gi) { const float a = lg[4 * gi], b = lg[4 * gi + 1], cc = lg[4 * gi + 2], d = lg[4 * gi + 3];
                const float sc = (a + b + cc + d) - fminf(fminf(a, b), fminf(cc, d)) - fminf(fmaxf(fminf(a, b), fminf(cc, d)), fminf(fmaxf(a, b), fmaxf(cc, d)));
                if (sc > gbest) { gbest = sc; gsel = gi; } }
            float p[4];
#pragma unroll
            for (int k = 0; k < 4; ++k) p[k] = gsel == 0 ? lg[k] : gsel == 1 ? lg[4 + k] : gsel == 2 ? lg[8 + k] : lg[12 + k];
            int i0 = 0; float v0 = p[0];
#pragma unroll
            for (int k = 1; k < 4; ++k) if (p[k] > v0) { v0 = p[k]; i0 = k; }
            int i1 = -1; float v1 = -1.f;
#pragma unroll
            for (int k = 0; k < 4; ++k) if (k != i0 && p[k] > v1) { v1 = p[k]; i1 = k; }
            if (lane == 0) { const int e0 = 4 * gsel + i0, e1 = 4 * gsel + i1; INFO[rl * 4 + 0] = e0; INFO[rl * 4 + 1] = e1;
                const float gs = 1.0f / (v0 + v1); gate[row * 2] = v0 * gs; gate[row * 2 + 1] = v1 * gs; }
        }
        __syncthreads();
        {
            int cnt0 = 0, cnt1 = 0; const unsigned long long lt = (1ull << lane) - 1ull;
#pragma unroll
            for (int b = 0; b < 4; ++b) { const int r = 64 * b + lane; const int e0 = INFO[r * 4], e1 = INFO[r * 4 + 1];
                const bool a0 = (e0 == 2 * wave) || (e1 == 2 * wave), a1 = (e0 == 2 * wave + 1) || (e1 == 2 * wave + 1);
                const unsigned long long m0 = __ballot(a0), m1 = __ballot(a1);
                if (a0) INFO[r * 4 + (e0 == 2 * wave ? 2 : 3)] = cnt0 + __popcll(m0 & lt);
                if (a1) INFO[r * 4 + (e0 == 2 * wave + 1 ? 2 : 3)] = cnt1 + __popcll(m1 & lt);
                cnt0 += __popcll(m0); cnt1 += __popcll(m1); }
            if (lane == 0) { histg[chunk * 16 + 2 * wave] = cnt0; histg[chunk * 16 + 2 * wave + 1] = cnt1; }
        }
        __syncthreads();
        if (tid < 256) { i32x4 v; v.x = INFO[tid * 4]; v.y = INFO[tid * 4 + 1]; v.z = INFO[tid * 4 + 2]; v.w = INFO[tid * 4 + 3]; ((GAS i32x4*)(c.ws + WS_INFO))[(size_t)chunk * 256 + tid] = v; }
        __syncthreads();
    }
}
DI void phase_r2(LAS unsigned char* lds, const Ctx& c, int l, int G) {
    const int tid = ltid(); volatile LAS int* BASE = (volatile LAS int*)(lds + R_BASE);
    const int* histg = (const int*)(c.ws + WS_HISTG); int* list = (int*)(c.ws + WS_LIST);
    unsigned* cur = (unsigned*)(c.ws + WS_CTL) + CW_CUR + l * 16 * 64;
    for (int chunk = lbid(); chunk < T / 256; chunk += G) {
        __syncthreads();
        if (tid < 16) BASE[tid] = 0;
        __syncthreads();
        { const int e = tid & 15; int s = 0; for (int cc = tid >> 4; cc < chunk; cc += 32) s += histg[cc * 16 + e]; if (s) atomicAdd((int*)&BASE[e], s); }
        __syncthreads();
        if (tid < 256) { const i32x4 v = ((const GAS i32x4*)(c.ws + WS_INFO))[(size_t)chunk * 256 + tid]; const int row = chunk * 256 + tid;
            list[(size_t)v.x * T + BASE[v.x] + v.z] = row * 2; list[(size_t)v.y * T + BASE[v.y] + v.w] = row * 2 + 1; }
        if (chunk == T / 256 - 1 && tid < 16) __hip_atomic_store(cur + tid * 64, (unsigned)(BASE[tid] + histg[chunk * 16 + tid]), __ATOMIC_RELAXED, __HIP_MEMORY_SCOPE_AGENT);
    }
}
DI int moe_setup(LAS unsigned char* lds, const Ctx& c, int l) {
    volatile LAS int* PRE = (volatile LAS int*)(lds + MISC_OFF); volatile LAS int* CNT = PRE + 17;
    unsigned* cur = (unsigned*)(c.ws + WS_CTL) + CW_CUR + l * 16 * 64;
    __syncthreads();
    if (threadIdx.x == 0) { int acc = 0; for (int e = 0; e < 16; ++e) { const int n = (int)__hip_atomic_load(cur + e * 64, __ATOMIC_RELAXED, __HIP_MEMORY_SCOPE_AGENT); PRE[e] = acc; CNT[e] = n; acc += (n + 255) >> 8; } PRE[16] = acc; }
    __syncthreads();
    return rfl(PRE[16]);
}
DI void phase_c(const Ctx& c, int l, int G) {
    const int tid = ltid(), lane = tid & 63, wave = rfl(tid >> 6);
    f32x4 g4[4], b4[4];
#pragma unroll
    for (int j = 0; j < 4; ++j) { g4[j] = *(const GAS f32x4*)(c.ln2_g + l * D + 4 * lane + 256 * j); b4[j] = *(const GAS f32x4*)(c.ln2_b + l * D + 4 * lane + 256 * j); }
    float* xo = c.out; bf16_t* xr = wsb(c, WS_XR); unsigned char* xb = c.ws + WS_XB; const unsigned char* ys = c.ws + WS_YS; const float* gate = (const float*)(c.ws + WS_GATE);
    const size_t rstep = (size_t)G * NWAVES; size_t row = (size_t)lbid() * NWAVES + wave;
    u32x2 xn[4]; unsigned y0n[4], y1n[4]; float g0n = 0.f, g1n = 0.f;
    if (row < (size_t)T) { g0n = gate[row * 2]; g1n = gate[row * 2 + 1];
#pragma unroll
        for (int j = 0; j < 4; ++j) { xn[j] = *(const GAS u32x2*)(xr + row * D + 4 * lane + 256 * j); y0n[j] = *(const GAS unsigned*)(ys + (row * 2) * D + 4 * lane + 256 * j); y1n[j] = *(const GAS unsigned*)(ys + (row * 2 + 1) * D + 4 * lane + 256 * j); } }
    for (; row < (size_t)T; row += rstep) {
        const float g0 = g0n, g1 = g1n;
        f32x4 v[4]; float s = 0.f;
#pragma unroll
        for (int j = 0; j < 4; ++j) { const u32x2 xq = xn[j]; const unsigned y0 = y0n[j], y1 = y1n[j];
            const f32x2 y0a = __builtin_amdgcn_cvt_pk_f32_fp8((int)y0, false), y0b = __builtin_amdgcn_cvt_pk_f32_fp8((int)y0, true), y1a = __builtin_amdgcn_cvt_pk_f32_fp8((int)y1, false), y1b = __builtin_amdgcn_cvt_pk_f32_fp8((int)y1, true);
            v[j][0] = bf_lo(xq.x) * DN_ALPHA + g0 * y0a[0] + g1 * y1a[0]; v[j][1] = bf_hi(xq.x) * DN_ALPHA + g0 * y0a[1] + g1 * y1a[1];
            v[j][2] = bf_lo(xq.y) * DN_ALPHA + g0 * y0b[0] + g1 * y1b[0]; v[j][3] = bf_hi(xq.y) * DN_ALPHA + g0 * y0b[1] + g1 * y1b[1];
            s += (v[j][0] + v[j][1]) + (v[j][2] + v[j][3]); }
        { const size_t rn = row + rstep < (size_t)T ? row + rstep : row; g0n = gate[rn * 2]; g1n = gate[rn * 2 + 1];
#pragma unroll
          for (int j = 0; j < 4; ++j) { xn[j] = *(const GAS u32x2*)(xr + rn * D + 4 * lane + 256 * j); y0n[j] = *(const GAS unsigned*)(ys + (rn * 2) * D + 4 * lane + 256 * j); y1n[j] = *(const GAS unsigned*)(ys + (rn * 2 + 1) * D + 4 * lane + 256 * j); } }
        const float mean = wave_sum(s) * (1.0f / D); float s2 = 0.f;
#pragma unroll
        for (int j = 0; j < 4; ++j) { v[j] = v[j] - mean; s2 += (v[j][0] * v[j][0] + v[j][1] * v[j][1]) + (v[j][2] * v[j][2] + v[j][3] * v[j][3]); }
        const float rstd = __builtin_amdgcn_rsqf(wave_sum(s2) * (1.0f / D) + LN_EPS);
#pragma unroll
        for (int j = 0; j < 4; ++j) { v[j] = v[j] * rstd * g4[j] + b4[j];
            if (l == DEPTH - 1) *(GAS f32x4*)(xo + row * D + 4 * lane + 256 * j) = v[j];
            else { u32x2 xq; xq.x = cvt_pk_bf16(v[j][0], v[j][1]); xq.y = cvt_pk_bf16(v[j][2], v[j][3]); *(GAS u32x2*)(xr + row * D + 4 * lane + 256 * j) = xq;
                *(GAS unsigned*)(xb + row * D + 4 * lane + 256 * j) = pk4_fp8(v[j][0], v[j][1], v[j][2], v[j][3]); } }
    }
}

DI Ctx load_ctx() {
    union { Ctx c; unsigned long long q[sizeof(Ctx) / 8]; } u;
#if defined(__HIP_DEVICE_COMPILE__)
    const __attribute__((address_space(4))) unsigned long long* p = (const __attribute__((address_space(4))) unsigned long long*)__builtin_amdgcn_kernarg_segment_ptr();
    asm volatile("" : "+s"(p));
#pragma unroll
    for (int i = 0; i < (int)(sizeof(Ctx) / 8); ++i) u.q[i] = p[i];
#endif
    return u.c;
}
#define CTX const Ctx c = load_ctx(); const int G = lgrid(); LAS unsigned char* lds = LDSBASE
__global__ void __launch_bounds__(NTHREADS, 2) mk_fwd(Ctx c_arg) {
    extern __shared__ __attribute__((aligned(16))) unsigned char lds_raw[];
#define LDSBASE ({ unsigned _b = (unsigned)(uintptr_t)(LAS unsigned char*)lds_raw; asm volatile("" : "+s"(_b)); (LAS unsigned char*)(uintptr_t)_b; })
    LAS unsigned char* lds0 = LDSBASE;
    const int tid = threadIdx.x; const Ctx c = load_ctx();
    volatile LAS unsigned* MISC = (volatile LAS unsigned*)(lds0 + MISC_OFF);
    if (tid < 64) MISC[tid] = 0u;
    __syncthreads();
    XcdBarrier bar; bar.bar = (unsigned*)(c.ws + WS_CTL) + CW_BAR; bar.x = 0; bar.st = MISC + 40;
    if (!MK_MULTI) bar = xcd_barrier_post((unsigned*)(c.ws + WS_CTL) + CW_BAR, MISC + 40);
    const int lo = c.lo, hi = c.hi; int step = 0;
#define RUN (lo <= step && step < hi)
#define END_STEP do { if (RUN && step + 1 < hi) { if (!MK_MULTI) xcd_barrier(bar); } ++step; } while (0)
#define END_STEP_NB do { ++step; } while (0)
    for (int l = 0; l < DEPTH; ++l) {
        if (RUN) { CTX; phase_w(lds, c, l, G); }
        END_STEP;
        for (int hf = 0; hf < 2; ++hf) {
            const size_t r0 = (size_t)hf * TH;
            if (RUN) {
                CTX;
                pg8::StaticOrder S; S.init(c.ws + WS_XB + r0 * D, c.ws + WS_WIN, TH, NIN, D / 2, G, lbid());
                EpiIn E{wsb(c, WS_H + H_QG), wsb(c, WS_H + H_KG), wsb(c, WS_H + H_VG), wsb(c, WS_H + H_SR), wsb(c, WS_H + H_QD), wsb(c, WS_H + H_KD), wsb(c, WS_H + H_VD), wsb(c, WS_H + H_GT), (float*)(c.ws + WS_HA), c.pos + r0};
                pg8::gemm_phase<EpiIn, pg8::StaticOrder, true>(lds, D / 2, S, E);
            }
            END_STEP;
            if (RUN) { CTX; phase_p(lds, c, l, G); }
            END_STEP;
            if (RUN) { CTX; phase_b1(lds, c, l, hf, G); }
            END_STEP;
            if (RUN) { CTX; phase_b(lds, c, l, hf, G); }
            END_STEP;
            if (RUN) { CTX; (void)lds; phase_f(c, G); }
            END_STEP_NB;
            if (RUN) {
                CTX;
                pg8::StaticOrder S; S.init(c.ws + WS_OG, c.ws + WS_WGO, TH, D, D / 2, G, lbid());
                EpiGate<false> E{wsb(c, WS_MIX), c.ws + WS_H + H_GT, nullptr};
                pg8::gemm_phase<EpiGate<false>, pg8::StaticOrder, true>(lds, D / 2, S, E);
            }
            END_STEP;
            if (RUN) {
                CTX;
                pg8::StaticOrder S; S.init(c.ws + WS_ATT, c.ws + WS_WAO, TH, D, 256, G, lbid());
                EpiGate<true> E{wsb(c, WS_MIX), c.ws + WS_H + H_GT + 1024, c.ws + WS_OG + 32 * MiB};
                pg8::gemm_phase<EpiGate<true>, pg8::StaticOrder, true>(lds, 256, S, E);
            }
            END_STEP;
            if (RUN) {
                CTX;
                pg8::StaticOrder S; S.init(c.ws + WS_OG + 32 * MiB, c.ws + WS_WOUT, TH, D, D / 2, G, lbid());
                EpiRes E{l == 0 ? c.x + r0 * D : nullptr, wsb(c, WS_XR) + r0 * D};
                pg8::gemm_phase<EpiRes, pg8::StaticOrder, true>(lds, D / 2, S, E);
            }
            if (hf == 1) END_STEP; else END_STEP_NB;
        }
        if (RUN) { CTX; phase_r(lds, c, l, G); }
        END_STEP;
        if (RUN) { CTX; phase_r2(lds, c, l, G); }
        END_STEP;
        if (RUN) {   CTX;
            const int ntiles = moe_setup(lds, c, l);
            volatile LAS int* PRE = (volatile LAS int*)(lds + MISC_OFF); volatile LAS int* TAB = (volatile LAS int*)(lds + TAB_OFF);
            pg8::MoeOrder S; S.G = G; S.c = vcu_of(lbid(), G); S.ntot = ntiles * 8; S.NC = 8; S.K = D / 2; S.pre = PRE; S.cnt = PRE + 17; S.A = (const char*)(c.ws + WS_XB); S.Bt = (const char*)(c.ws + WS_WGU);
            S.bstride = (size_t)2048 * 1024; S.tab = TAB; S.gather = true;
            const int* list = (const int*)(c.ws + WS_LIST);
            { const int lt_tid = ltid(); const int r = lt_tid & 255, half = rfl(lt_tid >> 8);
              for (int i0 = 0; i0 < MAXU; i0 += 2) { Unit u; const int i = i0 + half;
                  if (S.next(i, u)) { const int lt = u.pm - PRE[u.e]; const int pos = 256 * lt + (r < u.nv ? r : 0); TAB[i * 256 + r] = list[(size_t)u.e * T + pos] >> 1; } } }
            __syncthreads();
            EpiM1 E{c.ws + WS_HM};
            pg8::gemm_phase<EpiM1, pg8::MoeOrder, true>(lds, D / 2, S, E);
        }
        END_STEP;
        if (RUN) {   CTX;
            const int ntiles = moe_setup(lds, c, l);
            volatile LAS int* PRE = (volatile LAS int*)(lds + MISC_OFF);
            pg8::MoeOrder S; S.G = G; S.c = vcu_of(lbid(), G); S.ntot = ntiles * 4; S.NC = 4; S.K = DFF / 2; S.pre = PRE; S.cnt = PRE + 17; S.A = (const char*)(c.ws + WS_HM); S.Bt = (const char*)(c.ws + WS_WD);
            S.bstride = (size_t)1024 * 1024; S.tab = nullptr; S.gather = false;
            EpiM2 E{c.ws + WS_YS, (const int*)(c.ws + WS_LIST), PRE};
            pg8::gemm_phase<EpiM2, pg8::MoeOrder, true>(lds, DFF / 2, S, E);
        }
        END_STEP;
        if (RUN) { CTX; (void)lds; phase_c(c, l, G); }
        END_STEP_NB;
    }
#undef RUN
#undef END_STEP
#undef END_STEP_NB
}
constexpr int NSTEPS = DEPTH * (1 + 2 * 8 + 5);

extern "C" void kernel_launch(void* const* d_in, const int* in_sizes, int n_in, void* d_out, int out_size, void* d_ws, size_t ws_size, hipStream_t stream) {
    static int grid = 0;
    if (grid == 0) {
        if (n_in != 18 || in_sizes[0] != T * D || out_size != T * D || ws_size < WS_END) { fprintf(stderr, "kernel_launch: unexpected shapes / workspace (need %zu, got %zu)\n", (size_t)WS_END, ws_size); grid = -1; return; }
        int dev = 0, cus = 0;
        if (hipGetDevice(&dev) != hipSuccess || hipDeviceGetAttribute(&cus, hipDeviceAttributeMultiprocessorCount, dev) != hipSuccess) { grid = -1; return; }
        if (hipFuncSetAttribute((const void*)mk_fwd, hipFuncAttributeMaxDynamicSharedMemorySize, LDS_BYTES) != hipSuccess) { fprintf(stderr, "kernel_launch: hipFuncSetAttribute failed\n"); grid = -1; return; }
        int per_cu = 0;
        if (hipOccupancyMaxActiveBlocksPerMultiprocessor(&per_cu, (const void*)mk_fwd, NTHREADS, LDS_BYTES) != hipSuccess || per_cu < 1) { fprintf(stderr, "kernel_launch: occupancy query says %d\n", per_cu); }
        (void)hipGetLastError();
        grid = cus;
    }
    if (grid < 0) return;
    (void)hipMemsetAsync((char*)d_ws + WS_CTL, 0, CTL_ZERO_BYTES, stream);
    Ctx c{};
    c.x = (const float*)d_in[0]; c.pos = (const int*)d_in[1]; c.w_in = (const float*)d_in[2]; c.w_alpha_up = (const float*)d_in[3]; c.b_alpha = (const float*)d_in[4]; c.gla_norm = (const float*)d_in[5];
    c.w_gla_o = (const float*)d_in[6]; c.w_att_o = (const float*)d_in[7]; c.w_out = (const float*)d_in[8]; c.ln1_g = (const float*)d_in[9]; c.ln1_b = (const float*)d_in[10]; c.w_router = (const float*)d_in[11];
    c.b_router = (const float*)d_in[12]; c.w_e_gate = (const float*)d_in[13]; c.w_e_up = (const float*)d_in[14]; c.w_e_down = (const float*)d_in[15]; c.ln2_g = (const float*)d_in[16]; c.ln2_b = (const float*)d_in[17];
    c.out = (float*)d_out; c.ws = (unsigned char*)d_ws;
#if MK_MULTI
    for (int s = 0; s < NSTEPS; ++s) { c.lo = s; c.hi = s + 1; hipLaunchKernelGGL(mk_fwd, dim3(grid), dim3(NTHREADS), LDS_BYTES, stream, c); }
#else
    c.lo = 0; c.hi = NSTEPS; hipLaunchKernelGGL(mk_fwd, dim3(grid), dim3(NTHREADS), LDS_BYTES, stream, c);
#endif
}
```

```cpp
#include <hip/hip_runtime.h>
#include <cstdio>
#include <cstdint>

#ifndef MK_MULTI
#define MK_MULTI 0
#endif

#define DI __device__ __forceinline__
#define GAS __attribute__((address_space(1)))
#define LAS __attribute__((address_space(3)))
typedef unsigned short bf16_t;
typedef short bf16x8 __attribute__((ext_vector_type(8)));
typedef short s16x4 __attribute__((ext_vector_type(4)));
typedef float f32x4 __attribute__((ext_vector_type(4)));
typedef float f32x2 __attribute__((ext_vector_type(2)));
typedef unsigned u32x4 __attribute__((ext_vector_type(4)));
typedef unsigned u32x2 __attribute__((ext_vector_type(2)));
typedef int i32x4 __attribute__((ext_vector_type(4)));
typedef int i32x8 __attribute__((ext_vector_type(8)));
#define LDS_WAIT() asm volatile("s_waitcnt lgkmcnt(0)" ::: "memory")
#define VM_WAIT() asm volatile("s_waitcnt vmcnt(0)" ::: "memory")

constexpr int D = 1024, NBATCH = 16, SEQ = 4096, T = NBATCH * SEQ, DEPTH = 4;
constexpr int TH = T / 2;
constexpr int DIN = 9744, NIN = 9984;
constexpr int NEXP = 16, DFF = 1024;
constexpr float LN_EPS = 1e-5f, RMS_EPS = 1e-6f;
constexpr float DN_ALPHA = 1.6817928305074290f;
constexpr float LOG2E = 1.4426950408889634f;
constexpr int NWAVES = 8, NTHREADS = 512;

constexpr size_t MiB = 1u << 20;
constexpr size_t WS_CTL = 0, CTL_ZERO_BYTES = 1 * MiB;
constexpr size_t WS_WIN = 1 * MiB;
constexpr size_t WS_WGO = WS_WIN + (size_t)NIN * D;
constexpr size_t WS_WAO = WS_WGO + 2 * MiB;
constexpr size_t WS_WOUT = WS_WAO + 1 * MiB;
constexpr size_t WS_WGU = WS_WOUT + 2 * MiB;
constexpr size_t WS_WD = WS_WGU + 32 * MiB;
constexpr size_t WS_XB = WS_WD + 16 * MiB;
constexpr size_t WS_XR = WS_XB + 64 * MiB;
constexpr size_t WS_LIST = WS_XR + 128 * MiB;
constexpr size_t WS_GATE = WS_LIST + 4 * MiB;
constexpr size_t WS_INFO = WS_GATE + 1 * MiB;
constexpr size_t WS_HISTG = WS_INFO + 1 * MiB;
constexpr size_t WS_OG = WS_HISTG + 1 * MiB;
constexpr size_t WS_ATTG = WS_OG + 64 * MiB;
constexpr size_t WS_LSE = WS_ATTG + 96 * MiB;
constexpr size_t WS_ATT = WS_LSE + 3 * MiB;
constexpr size_t WS_MIX = WS_ATT + 32 * MiB;
constexpr size_t WS_HA = WS_MIX + 64 * MiB;
constexpr size_t WS_H = WS_HA + 2 * MiB;
constexpr size_t H_QG = 0, H_KG = H_QG + (size_t)TH * 512 * 2, H_VG = H_KG + (size_t)TH * 512 * 2, H_SR = H_VG + (size_t)TH * 1024 * 2,
                 H_QD = H_SR + (size_t)TH * 1024 * 2, H_KD = H_QD + (size_t)TH * 1536 * 2, H_VD = H_KD + (size_t)TH * 1536 * 2, H_GT = H_VD + (size_t)TH * 1536 * 2,
                 H_END = H_GT + (size_t)TH * 2048 * 2;
constexpr size_t WS_HM = WS_H;
constexpr size_t WS_YS = WS_HM + (size_t)(2 * T + 4096) * 1024 * 2;
constexpr size_t WS_REC = WS_H + H_END;
constexpr size_t WS_SLOC = WS_REC + (size_t)2048 * 33792;
constexpr size_t WS_DCUM = WS_SLOC + 16 * MiB;
constexpr size_t WS_END = WS_DCUM + 1 * MiB;
static_assert(WS_YS + (size_t)2 * T * 1024 * 2 <= WS_END, "MoE overlay fits");
constexpr int CW_BAR = 4096;
constexpr int CW_TKT = 24576;
constexpr int CW_CUR = 16384;

constexpr int RING_BYTES = 131072;
constexpr int TAB_OFF = RING_BYTES, MAXU = 18, TAB_BYTES = MAXU * 1024;
constexpr int MISC_OFF = TAB_OFF + TAB_BYTES;
constexpr int LDS_BYTES = MISC_OFF + 256;

DI int rfl(int v) { return __builtin_amdgcn_readfirstlane(v); }
DI int lbid() { int t = blockIdx.x; asm volatile("" : "+s"(t)); return t; }
DI int lgrid() { int t = gridDim.x; asm volatile("" : "+s"(t)); return t; }
DI int vcu_of(int bid, int G) { return (G % 8 == 0) ? (bid % 8) * (G / 8) + bid / 8 : bid; }
DI int ltid() { int t = threadIdx.x; asm volatile("" : "+v"(t)); return t; }
DI float bf2f(unsigned b) { return __uint_as_float(b << 16); }
typedef __bf16 bf16x2_t __attribute__((ext_vector_type(2)));
DI unsigned cvt_pk_bf16(float lo, float hi) { f32x2 v = {lo, hi}; bf16x2_t b = __builtin_convertvector(v, bf16x2_t); return __builtin_bit_cast(unsigned, b); }
DI float clamp8(float v) { return fminf(fmaxf(v, -448.f), 448.f); }
DI unsigned pk4_fp8(float a, float b, float c_, float d) { int w = 0; w = __builtin_amdgcn_cvt_pk_fp8_f32(clamp8(a), clamp8(b), w, false); w = __builtin_amdgcn_cvt_pk_fp8_f32(clamp8(c_), clamp8(d), w, true); return (unsigned)w; }
constexpr float W8_SCALE = 64.0f;
DI float bf_lo(unsigned w) { return __uint_as_float(w << 16); }
DI float bf_hi(unsigned w) { return __uint_as_float(w & 0xffff0000u); }
DI float sigmoidf_(float x) { return __builtin_amdgcn_rcpf(1.0f + __builtin_amdgcn_exp2f(-x * LOG2E)); }

#define XB_TMO      128
#define XB_XCNT(j)  (256  + 64 * (j))
#define XB_XSUB(j)  (1280 + 64 * (j))
#define XB_XGEN(j)  (2304 + 64 * (j))
#define XB_TOP      3328
#define XB_TOPGEN   3392
#define XCD_BAR_WORDS 3456
#define XB_SPIN_CAP (1u << 18)
DI unsigned xb_ld(unsigned* p)              { return __hip_atomic_load(p, __ATOMIC_RELAXED, __HIP_MEMORY_SCOPE_AGENT); }
DI unsigned xb_add(unsigned* p, unsigned v) { return __hip_atomic_fetch_add(p, v, __ATOMIC_RELAXED, __HIP_MEMORY_SCOPE_AGENT); }
DI unsigned xb_xcc_id() { return (unsigned)__builtin_amdgcn_s_getreg((3 << 11) | 20) & 0xFu; }
#define XB_SPIN(cond, bar) do { unsigned _sp = 0; while (cond) { __builtin_amdgcn_s_sleep(1); \
    if ((++_sp & 255u) == 0u) { if (xb_ld(&(bar)[XB_TMO])) break; if (_sp > XB_SPIN_CAP) { atomicAdd(&(bar)[XB_TMO], 1u); break; } } } } while (0)
struct XcdBarrier { unsigned* bar; unsigned x; volatile LAS unsigned* st; };
DI XcdBarrier xcd_barrier_post(unsigned* bar, volatile LAS unsigned* st) {
    XcdBarrier b; b.bar = bar; b.x = xb_xcc_id(); b.st = st;
    if (threadIdx.x == 0) (void)xb_add(&bar[XB_XCNT(b.x)], 1u);
    return b;
}
DI void xcd_barrier_complete(unsigned* bar, unsigned x, unsigned& nloc, unsigned& nx) {
    const unsigned G = gridDim.x * gridDim.y * gridDim.z;
    unsigned sum, cnt, mine, sp = 0u;
    for (;;) {
        sum = 0u; cnt = 0u; mine = 0u;
#pragma unroll
        for (unsigned j = 0; j < 16; ++j) { const unsigned c = xb_ld(&bar[XB_XCNT(j)]); sum += c; cnt += (c > 0u) ? 1u : 0u; mine = (j == x) ? c : mine; }
        if (sum == G) break;
        __builtin_amdgcn_s_sleep(1);
        if ((++sp & 255u) == 0u) { if (xb_ld(&bar[XB_TMO])) break; if (sp > XB_SPIN_CAP) { atomicAdd(&bar[XB_TMO], 1u); break; } }
    }
    nloc = mine > 0u ? mine : 1u; nx = cnt > 0u ? cnt : 1u;
}
DI void xcd_barrier(const XcdBarrier& b) {
    asm volatile("s_waitcnt vmcnt(0)" ::: "memory");
    __syncthreads();
    if (threadIdx.x == 0) {
        unsigned* bar = b.bar;
        __builtin_amdgcn_s_waitcnt(0);
        unsigned nloc = b.st[0], nx = b.st[1];
        if (nloc == 0u) { xcd_barrier_complete(bar, b.x, nloc, nx); b.st[0] = nloc; b.st[1] = nx; }
        const unsigned old = xb_add(&bar[XB_XSUB(b.x)], 1u);
        const unsigned gen = old / nloc;
        if (old + 1u == (gen + 1u) * nloc) {
            __builtin_amdgcn_fence(__ATOMIC_RELEASE, "agent");
            asm volatile("s_waitcnt vmcnt(0)" ::: "memory");
            const unsigned og = xb_add(&bar[XB_TOP], 1u);
            const unsigned tg = og / nx;
            if (og + 1u == (tg + 1u) * nx) xb_add(&bar[XB_TOPGEN], 1u);
            else XB_SPIN(xb_ld(&bar[XB_TOPGEN]) == tg, bar);
            __builtin_amdgcn_fence(__ATOMIC_ACQUIRE, "agent");
            xb_add(&bar[XB_XGEN(b.x)], 1u);
            asm volatile("s_waitcnt vmcnt(0)" ::: "memory");
        } else {
            XB_SPIN(xb_ld(&bar[XB_XGEN(b.x)]) == gen, bar);
            __builtin_amdgcn_fence(__ATOMIC_ACQUIRE, "agent");
            asm volatile("s_waitcnt vmcnt(0)" ::: "memory");
        }
    }
    __syncthreads();
}

struct Ctx {
    const float* x; const int* pos; const float* w_in; const float* w_alpha_up; const float* b_alpha; const float* gla_norm;
    const float* w_gla_o; const float* w_att_o; const float* w_out; const float* ln1_g; const float* ln1_b; const float* w_router; const float* b_router;
    const float* w_e_gate; const float* w_e_up; const float* w_e_down; const float* ln2_g; const float* ln2_b;
    float* out; unsigned char* ws;
    int lo, hi;
};
DI bf16_t* wsb(const Ctx& c, size_t off) { return (bf16_t*)(c.ws + off); }

namespace pg8 {
constexpr int BM = 256, BK = 64, HALF = 128, HTB = HALF * BK * 2, STAGE_BYTES = 8 * HTB, NXCD = 8, WGM = 8;
DI int lds_byte(int r, int c) { const int st = (r >> 4) * 2 + (c >> 5), rr = r & 15, cc = c & 31, ob = rr * 64 + cc * 2; return st * 1024 + (ob ^ (((ob >> 9) & 1) << 5)); }
DI void stage_rc(int b, int& R, int& C) { const int st = b / 1024, sb = b % 1024, swz = sb ^ (((sb >> 9) & 1) << 5); R = (st >> 1) * 16 + swz / 64; C = (st & 1) * 32 + (swz % 64) / 2; }
DI int perm32(int rho) { const int n = rho >> 4, i = rho & 15; return 8 * (i >> 2) + 4 * n + (i & 3); }
struct Unit { int pm, pn, e, nv, ui; };

struct StaticOrder {
    int nM, nN, nwg, G, c, K; const char* A; const char* Bt;
    DI void init(const void* A_, const void* Bt_, int M, int N, int K_, int G_, int c_) { A = (const char*)A_; Bt = (const char*)Bt_; nM = M / BM; nN = N / BM; nwg = nM * nN; G = G_; c = c_; K = K_; }
    DI bool next(int i, Unit& u) const {
        const long L = (long)i * G + c; if (L >= nwg) return false;
        int wgid = (int)L; { const int q = nwg / NXCD, r = nwg % NXCD, xcd = wgid % NXCD, off = wgid / NXCD; wgid = (xcd < r ? xcd * (q + 1) : r * (q + 1) + (xcd - r) * q) + off; }
        const int nig = WGM * nN, gid = wgid / nig, fm = gid * WGM, gsz = (nM - fm) < WGM ? (nM - fm) : WGM;
        u.pm = fm + ((wgid % nig) % gsz); u.pn = (wgid % nig) / gsz; u.e = 0; u.nv = 256; u.ui = i; return true;
    }
    DI const char* a_base(const Unit& u) const { return A + (size_t)u.pm * BM * K * 2; }
    DI const char* b_base(const Unit& u) const { return Bt + (size_t)u.pn * BM * K * 2; }
    DI void a_off(const Unit&, int tid, unsigned (&o)[2][2]) const {
#pragma unroll
        for (int i = 0; i < 2; ++i) { int R, C; stage_rc(tid * 16 + i * 8192, R, C);
#pragma unroll
            for (int h = 0; h < 2; ++h) o[h][i] = (unsigned)((h * HALF + R) * K + C) * 2u; }
    }
};
struct MoeOrder {
    int G, c, ntot, NC, K; const volatile LAS int* pre; const volatile LAS int* cnt; const char* A; const char* Bt; size_t bstride; const volatile LAS int* tab; bool gather;
    DI bool next(int i, Unit& u) const {
        const int L = i * G + c; if (L >= ntot) return false;
        const int rt = L / NC; u.pn = L - rt * NC; u.pm = rt;
        int e = 0;
#pragma unroll
        for (int j = 1; j < 16; ++j) e += (rt >= rfl(pre[j])) ? 1 : 0;
        e = rfl(e); u.e = e; const int rem = rfl(cnt[e]) - 256 * (rt - rfl(pre[e])); u.nv = rem < 256 ? rem : 256; u.ui = i; return true;
    }
    DI const char* a_base(const Unit& u) const { return gather ? A : A + (size_t)u.pm * BM * K * 2; }
    DI const char* b_base(const Unit& u) const { return Bt + (size_t)u.e * bstride + (size_t)u.pn * BM * K * 2; }
    DI void a_off(const Unit& u, int tid, unsigned (&o)[2][2]) const {
#pragma unroll
        for (int i = 0; i < 2; ++i) { int R, C; stage_rc(tid * 16 + i * 8192, R, C);
#pragma unroll
            for (int h = 0; h < 2; ++h) { const int row = gather ? tab[u.ui * 256 + h * HALF + R] : (h * HALF + R); o[h][i] = (unsigned)(row * K + C) * 2u; } }
    }
};

template <class Epi, class Sched, bool F8 = false>
DI void gemm_phase(LAS unsigned char* lds, const int K, const Sched& S, const Epi& E) {
    const int tid = ltid(), wid = rfl(tid >> 6), lane = tid & 63, wr = wid >> 2, wc = wid & 3, fr = lane & 15, fq = lane >> 4;
    const int nt = K / BK;
    unsigned voffB[2];
#pragma unroll
    for (int i = 0; i < 2; ++i) { int R, C; stage_rc(tid * 16 + i * 8192, R, C); const int Rb = Epi::PERM ? ((R & ~31) + perm32(R & 31)) : R; voffB[i] = (unsigned)(Rb * K + C) * 2u; }
    const size_t kstep = (size_t)(BK * 2);
    const size_t hstep = (size_t)HALF * K * 2;
    const unsigned ldsw = (unsigned)wid * 1024u;
    const int aoff = lds_byte(wr * 64 + fr, fq * 8), boff = lds_byte(wc * 32 + fr, fq * 8);
#define PG8_SA(b, h) (((b) * 2 + (h)) * HTB)
#define PG8_SB(b, h) ((4 + (b) * 2 + (h)) * HTB)
#define PG8_STAGE(bufoff, gbase, voff) do { _Pragma("unroll") for (int _i = 0; _i < 2; ++_i) \
        __builtin_amdgcn_global_load_lds((const unsigned*)((const char*)(gbase) + (voff)[_i]), (LAS unsigned*)(lds + (bufoff) + ldsw + _i * 8192), 16, 0, 0); } while (0)
#define PG8_LD8(p) __builtin_shufflevector(*(const LAS i32x4*)(p), *(const LAS i32x4*)((p) + 1024), 0, 1, 2, 3, 4, 5, 6, 7)
#define PG8_LDA(dst, b, h) do { if constexpr (F8) { _Pragma("unroll") for (int m = 0; m < 4; ++m) dst##8[m] = PG8_LD8(lds + PG8_SA(b, h) + aoff + m * 2048); } else { \
        _Pragma("unroll") for (int m = 0; m < 4; ++m) _Pragma("unroll") for (int k = 0; k < 2; ++k) dst[m][k] = *(const LAS bf16x8*)(lds + PG8_SA(b, h) + aoff + m * 2048 + k * 1024); } } while (0)
#define PG8_LDB(dst, b, h) do { if constexpr (F8) { _Pragma("unroll") for (int n = 0; n < 2; ++n) dst##8[n] = PG8_LD8(lds + PG8_SB(b, h) + boff + n * 2048); } else { \
        _Pragma("unroll") for (int n = 0; n < 2; ++n) _Pragma("unroll") for (int k = 0; k < 2; ++k) dst[n][k] = *(const LAS bf16x8*)(lds + PG8_SB(b, h) + boff + n * 2048 + k * 1024); } } while (0)
#define PG8_MMA(ai, bj, At, Bt) do { __builtin_amdgcn_s_setprio(1); if constexpr (F8) { _Pragma("unroll") for (int m = 0; m < 4; ++m) _Pragma("unroll") for (int n = 0; n < 2; ++n) \
        asm volatile("v_mfma_scale_f32_16x16x128_f8f6f4 %0, %1, %2, %0, %3, %4 op_sel_hi:[0,0,0]" : "+v"(acc[ai][bj][m][n]) : "v"(Bt##8[n]), "v"(At##8[m]), "v"(sc_w), "v"(sc_a)); } else { \
        _Pragma("unroll") for (int m = 0; m < 4; ++m) _Pragma("unroll") for (int n = 0; n < 2; ++n) _Pragma("unroll") for (int k = 0; k < 2; ++k) \
        acc[ai][bj][m][n] = __builtin_amdgcn_mfma_f32_16x16x32_bf16(Bt[n][k], At[m][k], acc[ai][bj][m][n], 0, 0, 0); } __builtin_amdgcn_s_setprio(0); } while (0)
#define PG8_WAIT_V(n) asm volatile("s_waitcnt vmcnt(" #n ")" ::: "memory")
#define PG8_WAIT_L(n) asm volatile("s_waitcnt lgkmcnt(" #n ")" ::: "memory")
#define PG8_BAR __builtin_amdgcn_s_barrier()
#define PG8_SCHED __builtin_amdgcn_sched_barrier(0)
    Unit cur, nxt; int ui = 0;
    if (!S.next(0, cur)) return;
    f32x4 acc[2][2][4][2];
#pragma unroll
    for (int a = 0; a < 2; ++a)
#pragma unroll
        for (int b = 0; b < 2; ++b)
#pragma unroll
            for (int m = 0; m < 4; ++m)
#pragma unroll
                for (int n = 0; n < 2; ++n) acc[a][b][m][n] = (f32x4){0.f, 0.f, 0.f, 0.f};
    int sc_w = 0x79797979, sc_a = 0x7f7f7f7f; asm volatile("" : "+v"(sc_w), "+v"(sc_a));
    bf16x8 At[4][2], B0[2][2], B1[2][2]; i32x8 At8[4], B08[2], B18[2];
    unsigned oA[2][2]; S.a_off(cur, tid, oA);
    const char* cA = S.a_base(cur); const char* cB = S.b_base(cur);
    PG8_STAGE(PG8_SB(0, 0), cB, voffB); PG8_STAGE(PG8_SB(0, 1), cB + hstep, voffB); PG8_STAGE(PG8_SA(0, 0), cA, oA[0]); PG8_STAGE(PG8_SA(0, 1), cA, oA[1]);
    if (wr == 1) PG8_BAR;
    PG8_WAIT_V(2); PG8_BAR;
    PG8_STAGE(PG8_SB(1, 0), cB + kstep, voffB); PG8_STAGE(PG8_SA(1, 0), cA + kstep, oA[0]); PG8_STAGE(PG8_SB(1, 1), cB + hstep + kstep, voffB);
    PG8_WAIT_V(6); PG8_BAR;
    for (;;) {
        const bool has_next = S.next(ui + 1, nxt);
        const char* nA = has_next ? S.a_base(nxt) : cA; const char* nB = has_next ? S.b_base(nxt) : cB;
        for (int t = 0; t < nt; t += 2) {
            const bool last = (t == nt - 2);
            const char* a1 = cA + (size_t)(t + 1) * kstep;
            const char* a2 = last ? nA : cA + (size_t)(t + 2) * kstep; const char* b2 = last ? nB : cB + (size_t)(t + 2) * kstep;
            const char* a3 = a2 + kstep; const char* b3 = b2 + kstep;
            PG8_LDB(B0, 0, 0); PG8_LDB(B1, 0, 1); PG8_SCHED; PG8_LDA(At, 0, 0); PG8_STAGE(PG8_SA(1, 1), a1, oA[1]);
            if (last && has_next) S.a_off(nxt, tid, oA);
            PG8_WAIT_V(8); PG8_WAIT_L(0); PG8_BAR; PG8_MMA(0, 0, At, B0); PG8_MMA(0, 1, At, B1); PG8_BAR; PG8_SCHED;
            PG8_LDA(At, 0, 1); PG8_STAGE(PG8_SB(0, 0), b2, voffB); PG8_STAGE(PG8_SB(0, 1), b2 + hstep, voffB); PG8_STAGE(PG8_SA(0, 0), a2, oA[0]);
            PG8_WAIT_V(8); PG8_WAIT_L(0); PG8_BAR; PG8_MMA(1, 0, At, B0); PG8_MMA(1, 1, At, B1); PG8_BAR; PG8_SCHED;
            PG8_LDB(B0, 1, 0); PG8_LDB(B1, 1, 1); PG8_SCHED; PG8_LDA(At, 1, 0); PG8_STAGE(PG8_SA(0, 1), a2, oA[1]);
            PG8_WAIT_V(8); PG8_WAIT_L(0); PG8_BAR; PG8_MMA(0, 0, At, B0); PG8_MMA(0, 1, At, B1); PG8_BAR; PG8_SCHED;
            PG8_LDA(At, 1, 1); PG8_STAGE(PG8_SB(1, 0), b3, voffB); PG8_STAGE(PG8_SB(1, 1), b3 + hstep, voffB); PG8_STAGE(PG8_SA(1, 0), a3, oA[0]);
            PG8_WAIT_V(8); PG8_WAIT_L(0); PG8_BAR; PG8_MMA(1, 0, At, B0); PG8_MMA(1, 1, At, B1); PG8_BAR; PG8_SCHED;
        }
        if (wr == 0) PG8_BAR;
        if constexpr (F8) asm volatile("s_nop 15\n\ts_nop 15" ::: "memory");
        E(acc, cur, wr, wc, fr, fq);
        if (!has_next) break;
#pragma unroll
        for (int a = 0; a < 2; ++a)
#pragma unroll
            for (int b = 0; b < 2; ++b)
#pragma unroll
                for (int m = 0; m < 4; ++m)
#pragma unroll
                    for (int n = 0; n < 2; ++n) acc[a][b][m][n] = (f32x4){0.f, 0.f, 0.f, 0.f};
        cur = nxt; cA = nA; cB = nB; ++ui;
        if (wr == 1) PG8_BAR;
    }
    PG8_WAIT_V(0);
    PG8_BAR;
#undef PG8_SA
#undef PG8_SB
#undef PG8_STAGE
#undef PG8_LDA
#undef PG8_LDB
#undef PG8_MMA
#undef PG8_LD8
#undef PG8_WAIT_V
#undef PG8_WAIT_L
#undef PG8_BAR
#undef PG8_SCHED
}
}
using pg8::Unit;

DI u32x4 pack8(const f32x4& v0, const f32x4& v1) { u32x4 w; w.x = cvt_pk_bf16(v0[0], v0[1]); w.y = cvt_pk_bf16(v0[2], v0[3]); w.z = cvt_pk_bf16(v1[0], v1[1]); w.w = cvt_pk_bf16(v1[2], v1[3]); return w; }

struct EpiIn {
    static constexpr bool PERM = true;
    bf16_t *qg, *kg, *vg, *sr, *qd, *kd, *vd, *gt; float* ha; const int* pos;
    DI void operator()(const f32x4 (&acc)[2][2][4][2], const Unit& u, int wr, int wc, int fr, int fq) const {
        const int row0 = u.pm * 256 + wr * 64 + fr; const int pn = u.pn;
        if (pn >= 12 && pn < 24) {
            bf16_t* base = pn < 18 ? qd : kd; const int tq = pn < 18 ? pn - 12 : pn - 18; const float sc = pn < 18 ? 0.125f * LOG2E : 1.0f;
            float fre[8];
#pragma unroll
            for (int i = 0; i < 8; ++i) fre[i] = __builtin_amdgcn_exp2f(-(float)(8 * fq + i) * (13.287712379549449f / 32.0f)) * 0.15915494309189535f;
#pragma unroll
            for (int ai = 0; ai < 2; ++ai)
#pragma unroll
                for (int m = 0; m < 4; ++m) {
                    const int r = row0 + ai * 128 + m * 16; const float p = (float)pos[r];
                    bf16_t* rowp = base + (size_t)r * 1536 + (4 * tq + wc) * 64 + 8 * fq;
#pragma unroll
                    for (int n = 0; n < 2; ++n) { f32x4 o1, o2;
#pragma unroll
                        for (int j = 0; j < 4; ++j) {
                            float a = p * fre[n * 4 + j]; a = a - __builtin_floorf(a);
                            const float sn = __builtin_amdgcn_sinf(a), cs = __builtin_amdgcn_cosf(a);
                            const float x1 = acc[ai][0][m][n][j], x2 = acc[ai][1][m][n][j];
                            o1[j] = (x1 * cs - x2 * sn) * sc; o2[j] = (x2 * cs + x1 * sn) * sc;
                        }
                        u32x2 w1, w2; w1.x = cvt_pk_bf16(o1[0], o1[1]); w1.y = cvt_pk_bf16(o1[2], o1[3]); w2.x = cvt_pk_bf16(o2[0], o2[1]); w2.y = cvt_pk_bf16(o2[2], o2[3]);
                        *(GAS u32x2*)(rowp + 4 * n) = w1; *(GAS u32x2*)(rowp + 32 + 4 * n) = w2; }
                    asm volatile("" ::: "memory");
                }
        } else if (pn == 38) {
            if (wc == 0 && fq < 2) {
#pragma unroll
                for (int ai = 0; ai < 2; ++ai)
#pragma unroll
                    for (int m = 0; m < 4; ++m) { float* p = ha + (size_t)(row0 + ai * 128 + m * 16) * 16 + 8 * fq; *(GAS f32x4*)p = acc[ai][0][m][0]; *(GAS f32x4*)(p + 4) = acc[ai][0][m][1]; }
            }
        } else {
            bf16_t* base; int ldc, colt, act = 0; float sc = 1.0f;
            if (pn < 2) { base = qg; ldc = 512; colt = pn * 256; sc = 0.08838834764831845f; }
            else if (pn < 4) { base = kg; ldc = 512; colt = (pn - 2) * 256; }
            else if (pn < 8) { base = vg; ldc = 1024; colt = (pn - 4) * 256; }
            else if (pn < 12) {
#pragma unroll
                for (int ai = 0; ai < 2; ++ai)
#pragma unroll
                    for (int m = 0; m < 4; ++m) { unsigned char* rowp = (unsigned char*)sr + (size_t)(row0 + ai * 128 + m * 16) * 1024 + (pn - 8) * 256 + wc * 32 + 8 * fq;
#pragma unroll
                        for (int bj = 0; bj < 2; ++bj) { const f32x4 v0 = acc[ai][bj][m][0], v1 = acc[ai][bj][m][1]; u32x2 o;
                            o.x = pk4_fp8(v0[0] * sigmoidf_(v0[0]), v0[1] * sigmoidf_(v0[1]), v0[2] * sigmoidf_(v0[2]), v0[3] * sigmoidf_(v0[3]));
                            o.y = pk4_fp8(v1[0] * sigmoidf_(v1[0]), v1[1] * sigmoidf_(v1[1]), v1[2] * sigmoidf_(v1[2]), v1[3] * sigmoidf_(v1[3]));
                            *(GAS u32x2*)(rowp + bj * 128) = o; } }
                return; }
            else if (pn < 30) { base = vd; ldc = 1536; colt = (pn - 24) * 256; }
            else {
#pragma unroll
                for (int ai = 0; ai < 2; ++ai)
#pragma unroll
                    for (int m = 0; m < 4; ++m) { unsigned char* rowp = (unsigned char*)gt + (size_t)(row0 + ai * 128 + m * 16) * 2048 + (pn - 30) * 256 + wc * 32 + 8 * fq;
#pragma unroll
                        for (int bj = 0; bj < 2; ++bj) { unsigned w[2];
#pragma unroll
                            for (int n = 0; n < 2; ++n) { const f32x4 v = acc[ai][bj][m][n];
                                w[n] = (unsigned)(sigmoidf_(v[0]) * 255.0f + 0.5f) | ((unsigned)(sigmoidf_(v[1]) * 255.0f + 0.5f) << 8) | ((unsigned)(sigmoidf_(v[2]) * 255.0f + 0.5f) << 16) | ((unsigned)(sigmoidf_(v[3]) * 255.0f + 0.5f) << 24); }
                            *(GAS u32x2*)(rowp + bj * 128) = (u32x2){w[0], w[1]}; } }
                return; }
#pragma unroll
            for (int ai = 0; ai < 2; ++ai)
#pragma unroll
                for (int m = 0; m < 4; ++m) { bf16_t* rowp = base + (size_t)(row0 + ai * 128 + m * 16) * ldc + colt + wc * 32 + 8 * fq;
#pragma unroll
                    for (int bj = 0; bj < 2; ++bj) { f32x4 v0 = acc[ai][bj][m][0] * sc, v1 = acc[ai][bj][m][1] * sc;
                        if (act) {
#pragma unroll
                            for (int j = 0; j < 4; ++j) { const float s0 = sigmoidf_(v0[j]), s1 = sigmoidf_(v1[j]); v0[j] = act == 1 ? v0[j] * s0 : s0; v1[j] = act == 1 ? v1[j] * s1 : s1; } }
                        *(GAS u32x4*)(rowp + bj * 128) = pack8(v0, v1); } }
        }
    }
};
template <bool ADD> struct EpiGate {
    static constexpr bool PERM = true;
    bf16_t* mix; const unsigned char* gt; unsigned char* mix8;
    DI void operator()(const f32x4 (&acc)[2][2][4][2], const Unit& u, int wr, int wc, int fr, int fq) const {
        const int row0 = u.pm * 256 + wr * 64 + fr, col0 = u.pn * 256 + wc * 32 + 8 * fq; constexpr float k = 1.0f / 255.0f;
#pragma unroll
        for (int ai = 0; ai < 2; ++ai)
#pragma unroll
            for (int m = 0; m < 4; ++m) { const size_t r = (size_t)(row0 + ai * 128 + m * 16);
#pragma unroll
                for (int bj = 0; bj < 2; ++bj) {
                    const u32x2 g = *(const GAS u32x2*)(gt + r * 2048 + col0 + bj * 128);
                    f32x4 v0 = acc[ai][bj][m][0], v1 = acc[ai][bj][m][1];
                    v0[0] *= (float)((g.x >> 0) & 0xffu) * k; v0[1] *= (float)((g.x >> 8) & 0xffu) * k; v0[2] *= (float)((g.x >> 16) & 0xffu) * k; v0[3] *= (float)((g.x >> 24) & 0xffu) * k;
                    v1[0] *= (float)((g.y >> 0) & 0xffu) * k; v1[1] *= (float)((g.y >> 8) & 0xffu) * k; v1[2] *= (float)((g.y >> 16) & 0xffu) * k; v1[3] *= (float)((g.y >> 24) & 0xffu) * k;
                    bf16_t* mp = mix + r * 1024 + col0 + bj * 128;
                    if (ADD) { const u32x4 o = *(const GAS u32x4*)mp; v0[0] += bf_lo(o.x); v0[1] += bf_hi(o.x); v0[2] += bf_lo(o.y); v0[3] += bf_hi(o.y); v1[0] += bf_lo(o.z); v1[1] += bf_hi(o.z); v1[2] += bf_lo(o.w); v1[3] += bf_hi(o.w);
                        u32x2 o8; o8.x = pk4_fp8(v0[0], v0[1], v0[2], v0[3]); o8.y = pk4_fp8(v1[0], v1[1], v1[2], v1[3]); *(GAS u32x2*)(mix8 + r * 1024 + col0 + bj * 128) = o8; }
                    else *(GAS u32x4*)mp = pack8(v0, v1); } }
    }
};
struct EpiRes {
    static constexpr bool PERM = true;
    const float* x32; bf16_t* xr;
    DI void operator()(const f32x4 (&acc)[2][2][4][2], const Unit& u, int wr, int wc, int fr, int fq) const {
        const int row0 = u.pm * 256 + wr * 64 + fr, col0 = u.pn * 256 + wc * 32 + 8 * fq;
#pragma unroll
        for (int ai = 0; ai < 2; ++ai)
#pragma unroll
            for (int m = 0; m < 4; ++m) { const size_t off = (size_t)(row0 + ai * 128 + m * 16) * 1024 + col0;
#pragma unroll
                for (int bj = 0; bj < 2; ++bj) { f32x4 a0, a1;
                    if (x32) { a0 = *(const GAS f32x4*)(x32 + off + bj * 128); a1 = *(const GAS f32x4*)(x32 + off + bj * 128 + 4); }
                    else { const u32x4 o = *(const GAS u32x4*)(xr + off + bj * 128); a0 = (f32x4){bf_lo(o.x), bf_hi(o.x), bf_lo(o.y), bf_hi(o.y)}; a1 = (f32x4){bf_lo(o.z), bf_hi(o.z), bf_lo(o.w), bf_hi(o.w)}; }
                    *(GAS u32x4*)(xr + off + bj * 128) = pack8(a0 * DN_ALPHA + acc[ai][bj][m][0], a1 * DN_ALPHA + acc[ai][bj][m][1]); }
                asm volatile("" ::: "memory"); }
    }
};
struct EpiM1 {
    static constexpr bool PERM = true;
    unsigned char* hm;
    DI void operator()(const f32x4 (&acc)[2][2][4][2], const Unit& u, int wr, int wc, int fr, int fq) const {
        const int row0 = u.pm * 256 + wr * 64 + fr, col0 = u.pn * 128 + wc * 32 + 8 * fq;
#pragma unroll
        for (int ai = 0; ai < 2; ++ai)
#pragma unroll
            for (int m = 0; m < 4; ++m) { f32x4 v0, v1;
#pragma unroll
                for (int j = 0; j < 4; ++j) { const float g0 = acc[ai][0][m][0][j], g1 = acc[ai][0][m][1][j]; v0[j] = g0 * sigmoidf_(g0) * acc[ai][1][m][0][j]; v1[j] = g1 * sigmoidf_(g1) * acc[ai][1][m][1][j]; }
                u32x2 o; o.x = pk4_fp8(v0[0], v0[1], v0[2], v0[3]); o.y = pk4_fp8(v1[0], v1[1], v1[2], v1[3]);
                *(GAS u32x2*)(hm + (size_t)(row0 + ai * 128 + m * 16) * 1024 + col0) = o; }
    }
};
struct EpiM2 {
    static constexpr bool PERM = true;
    unsigned char* ys; const int* list; const volatile LAS int* pre;
    DI void operator()(const f32x4 (&acc)[2][2][4][2], const Unit& u, int wr, int wc, int fr, int fq) const {
        const int lrow0 = wr * 64 + fr, col0 = u.pn * 256 + wc * 32 + 8 * fq; const int lt = u.pm - rfl(pre[u.e]);
        const int* lp = list + (size_t)u.e * T + 256 * lt;
#pragma unroll
        for (int ai = 0; ai < 2; ++ai)
#pragma unroll
            for (int m = 0; m < 4; ++m) { const int r = lrow0 + ai * 128 + m * 16;
                if (r < u.nv) { const int slot = lp[r]; unsigned char* yp = ys + (size_t)slot * 1024 + col0;
#pragma unroll
                    for (int bj = 0; bj < 2; ++bj) { const f32x4 v0 = acc[ai][bj][m][0], v1 = acc[ai][bj][m][1]; u32x2 o; o.x = pk4_fp8(v0[0], v0[1], v0[2], v0[3]); o.y = pk4_fp8(v1[0], v1[1], v1[2], v1[3]); *(GAS u32x2*)(yp + bj * 128) = o; } } }
    }
};

struct WItem { const float* W; unsigned char* WT; int N, K, drow, c0, nv, kb; };
DI WItem w_decode(const Ctx& c, int l, int it) {
    constexpr int I_IN = (NIN / 32) * 16, I_GO = 512, I_AO = 256, I_OUT = 512, I_EXP = 16 * 512;
    WItem w; int r = it;
    if (r < I_IN) {
        const int nbg = r >> 4, kb = r & 15, n0 = 32 * nbg, tile = n0 >> 8, p = n0 & 255; int c0, nv = 32;
        if (tile < 12) c0 = n0;
        else if (tile < 24) { const int base = tile < 18 ? 3088 : 4624, tq = tile < 18 ? tile - 12 : tile - 18; c0 = base + (4 * tq + ((p & 127) >> 5)) * 64 + (p >= 128 ? 32 : 0); }
        else if (tile < 30) c0 = 6160 + (n0 - 24 * 256);
        else if (tile < 38) c0 = 7696 + (n0 - 30 * 256);
        else { c0 = 3072; nv = (p == 0) ? 16 : 0; }
        w.W = c.w_in + (size_t)l * D * DIN; w.N = DIN; w.WT = c.ws + WS_WIN; w.K = D; w.drow = n0; w.c0 = c0; w.nv = nv; w.kb = kb; return w; }
    r -= I_IN;
    if (r < I_GO) { w.W = c.w_gla_o + (size_t)l * D * D; w.N = D; w.WT = c.ws + WS_WGO; w.K = D; w.drow = 32 * (r >> 4); w.c0 = w.drow; w.nv = 32; w.kb = r & 15; return w; }
    r -= I_GO;
    if (r < I_AO) { w.W = c.w_att_o + (size_t)l * 512 * D; w.N = D; w.WT = c.ws + WS_WAO; w.K = 512; w.drow = 32 * (r >> 3); w.c0 = w.drow; w.nv = 32; w.kb = r & 7; return w; }
    r -= I_AO;
    if (r < I_OUT) { w.W = c.w_out + (size_t)l * D * D; w.N = D; w.WT = c.ws + WS_WOUT; w.K = D; w.drow = 32 * (r >> 4); w.c0 = w.drow; w.nv = 32; w.kb = r & 15; return w; }
    r -= I_OUT;
    const int which = r / I_EXP; r -= which * I_EXP; const int e = r >> 9, q = r & 511, nbg = q >> 4; const size_t eoff = (size_t)(l * NEXP + e) * D * DFF;
    w.N = DFF; w.K = D; w.c0 = 32 * nbg; w.nv = 32; w.kb = q & 15;
    if (which == 0) { w.W = c.w_e_gate + eoff; w.WT = c.ws + WS_WGU + (size_t)e * 2048 * 1024; w.drow = 256 * (nbg >> 2) + 32 * (nbg & 3); }
    else if (which == 1) { w.W = c.w_e_up + eoff; w.WT = c.ws + WS_WGU + (size_t)e * 2048 * 1024; w.drow = 256 * (nbg >> 2) + 128 + 32 * (nbg & 3); }
    else { w.W = c.w_e_down + eoff; w.N = D; w.K = DFF; w.WT = c.ws + WS_WD + (size_t)e * 1024 * 1024; w.drow = 32 * nbg; }
    return w;
}
DI void w_load(const WItem& w, int lane, float (&v)[32]) {
    const int cc = lane & 31, ccl = cc < w.nv ? cc : 0; const GAS float* wp = (const GAS float*)w.W + (size_t)(64 * w.kb + (lane >> 5)) * w.N + w.c0 + ccl;
#pragma unroll
    for (int i = 0; i < 32; ++i) v[i] = wp[(size_t)(2 * i) * w.N];
}
DI void w_store(const WItem& w, int lane, const float (&v)[32], LAS float* scr) {
    const int cc = lane & 31, k0 = 64 * w.kb;
#pragma unroll
    for (int i = 0; i < 32; ++i) scr[(2 * i + (lane >> 5)) * 33 + cc] = (cc < w.nv) ? v[i] : 0.f;
    LDS_WAIT(); asm volatile("" ::: "memory");
    const int c = lane & 7;
#pragma unroll
    for (int j = 0; j < 4; ++j) { const int n = (lane >> 3) + 8 * j; const LAS float* s = scr + (8 * c) * 33 + n;
        u32x2 o; o.x = pk4_fp8(s[0 * 33] * W8_SCALE, s[1 * 33] * W8_SCALE, s[2 * 33] * W8_SCALE, s[3 * 33] * W8_SCALE); o.y = pk4_fp8(s[4 * 33] * W8_SCALE, s[5 * 33] * W8_SCALE, s[6 * 33] * W8_SCALE, s[7 * 33] * W8_SCALE);
        *(GAS u32x2*)(w.WT + (size_t)(w.drow + n) * w.K + k0 + 8 * c) = o; }
    LDS_WAIT(); asm volatile("" ::: "memory");
}
DI void phase_w(LAS unsigned char* lds, const Ctx& c, int l, int G) {
    const int tid = ltid(), lane = tid & 63, wave = rfl(tid >> 6);
    LAS float* scr = (LAS float*)(lds + wave * 16384);
    const int gw = lbid() * NWAVES + wave, NGW = G * NWAVES;
    constexpr int NITEMS = (NIN / 32) * 16 + 512 + 256 + 512 + 3 * 16 * 512;
    float va[32], vb[32]; WItem wa, wb;
    int it = gw;
    if (it < NITEMS) { wa = w_decode(c, l, it); w_load(wa, lane, va); }
    while (it < NITEMS) {
        const bool hb = it + NGW < NITEMS; if (hb) { wb = w_decode(c, l, it + NGW); w_load(wb, lane, vb); }
        w_store(wa, lane, va, scr);
        it += NGW; if (it >= NITEMS) break;
        const bool ha = it + NGW < NITEMS; if (ha) { wa = w_decode(c, l, it + NGW); w_load(wa, lane, va); }
        w_store(wb, lane, vb, scr);
        it += NGW;
    }
    if (l == 0) {
        const size_t n8 = (size_t)T * D / 8; unsigned char* xb = c.ws + WS_XB;
        for (size_t i = (size_t)lbid() * NTHREADS + tid; i < n8; i += (size_t)G * NTHREADS) { const f32x4 a = *(const GAS f32x4*)(c.x + i * 8), b = *(const GAS f32x4*)(c.x + i * 8 + 4);
            u32x2 o; o.x = pk4_fp8(a[0], a[1], a[2], a[3]); o.y = pk4_fp8(b[0], b[1], b[2], b[3]); *(GAS u32x2*)(xb + i * 8) = o; }
    }
}

DI s16x4 tr16(const LAS void* p) { return __builtin_bit_cast(s16x4, __builtin_amdgcn_ds_read_tr16_b64_v4i16((LAS s16x4*)p)); }
DI bf16x8 cat8(s16x4 lo, s16x4 hi) { return __builtin_shufflevector(lo, hi, 0, 1, 2, 3, 4, 5, 6, 7); }
#define MFMA16(a, b, c) __builtin_amdgcn_mfma_f32_16x16x32_bf16((a), (b), (c), 0, 0, 0)

constexpr int REC_BYTES = 33792, REC_KS = 16384, REC_DEC = 32768, OI_BYTES = 16384;
constexpr int GP_QT = 0, GP_KT = 17408, GP_VS = 34816, GP_ATT = 68608, GP_WUP = 77824, GP_BAL = 86016;
DI float exp_(float x) { return __builtin_amdgcn_exp2f(x * LOG2E); }
DI void unpack8(const u32x4& q, float (&v)[16], int o) { v[o] = bf_lo(q.x); v[o + 1] = bf_hi(q.x); v[o + 2] = bf_lo(q.y); v[o + 3] = bf_hi(q.y); v[o + 4] = bf_lo(q.z); v[o + 5] = bf_hi(q.z); v[o + 6] = bf_lo(q.w); v[o + 7] = bf_hi(q.w); }
DI u32x4 packf8(const float (&v)[16], int o) { u32x4 p; p.x = cvt_pk_bf16(v[o], v[o + 1]); p.y = cvt_pk_bf16(v[o + 2], v[o + 3]); p.z = cvt_pk_bf16(v[o + 4], v[o + 5]); p.w = cvt_pk_bf16(v[o + 6], v[o + 7]); return p; }
DI void gla_p_unit(LAS unsigned char* lds, const Ctx& c, int l, int bl, int h, int n, int& h_loaded) {
    const int tid = ltid(), lane = tid & 63, w = rfl(tid >> 6), fr = lane & 15, fq = lane >> 4;
    const size_t tok0 = (size_t)bl * SEQ + n * 64;
    const bf16_t* QG = wsb(c, WS_H + H_QG) + tok0 * 512 + h * 128;
    const bf16_t* KG = wsb(c, WS_H + H_KG) + tok0 * 512 + h * 128;
    const bf16_t* VG = wsb(c, WS_H + H_VG) + tok0 * 1024 + h * 256;
    const float* HA = (const float*)(c.ws + WS_HA) + tok0 * 16;
    const int unit = (bl * 4 + h) * 64 + n;
    unsigned char* rec = c.ws + WS_REC + (size_t)unit * REC_BYTES;
    unsigned char* oi = c.ws + WS_MIX + (size_t)unit * OI_BYTES;
    LAS bf16_t* QT = (LAS bf16_t*)(lds + GP_QT); LAS bf16_t* KT = (LAS bf16_t*)(lds + GP_KT); LAS bf16_t* VS = (LAS bf16_t*)(lds + GP_VS); LAS bf16_t* AT = (LAS bf16_t*)(lds + GP_ATT);
    LAS float* WUP = (LAS float*)(lds + GP_WUP); LAS float* BAL = (LAS float*)(lds + GP_BAL);
    __syncthreads();
    if (h_loaded != h) { for (int i = tid; i < 16 * 128; i += NTHREADS) WUP[i] = c.w_alpha_up[(size_t)l * 16 * 512 + (i >> 7) * 512 + h * 128 + (i & 127)];
        if (tid < 128) BAL[tid] = c.b_alpha[l * 512 + h * 128 + tid]; h_loaded = h; __syncthreads(); }
    {
        const int row = lane;
        f32x4 a4[4];
#pragma unroll
        for (int j = 0; j < 4; ++j) a4[j] = *(const GAS f32x4*)(HA + (size_t)row * 16 + 4 * j);
        const u32x4 q0 = *(const GAS u32x4*)(QG + (size_t)row * 512 + 16 * w), q1 = *(const GAS u32x4*)(QG + (size_t)row * 512 + 16 * w + 8);
        const u32x4 k0 = *(const GAS u32x4*)(KG + (size_t)row * 512 + 16 * w), k1 = *(const GAS u32x4*)(KG + (size_t)row * 512 + 16 * w + 8);
#pragma unroll
        for (int c2 = 0; c2 < 4; ++c2) { const int idx = tid + NTHREADS * c2, r = idx >> 5, ch = idx & 31; *(LAS u32x4*)(VS + r * 264 + ch * 8) = *(const GAS u32x4*)(VG + (size_t)r * 1024 + ch * 8); }
        float la[16];
#pragma unroll
        for (int cc = 0; cc < 16; ++cc) la[cc] = BAL[16 * w + cc];
#pragma unroll
        for (int j = 0; j < 16; ++j) { const float aj = a4[j >> 2][j & 3];
#pragma unroll
            for (int c4 = 0; c4 < 4; ++c4) { const f32x4 wv = *(const LAS f32x4*)(WUP + j * 128 + 16 * w + 4 * c4); la[4 * c4] += aj * wv[0]; la[4 * c4 + 1] += aj * wv[1]; la[4 * c4 + 2] += aj * wv[2]; la[4 * c4 + 3] += aj * wv[3]; } }
#pragma unroll
        for (int cc = 0; cc < 16; ++cc) { const float z = la[cc]; la[cc] = -(fmaxf(-z, 0.f) + __builtin_amdgcn_logf(1.0f + exp_(-fabsf(z))) * 0.6931471805599453f) * (1.0f / 16.0f); }
#pragma unroll
        for (int dlt = 1; dlt < 64; dlt <<= 1)
#pragma unroll
            for (int cc = 0; cc < 16; ++cc) { const float t = __shfl_up(la[cc], dlt); if (lane >= dlt) la[cc] += t; }
        float qv[16], kv[16];
        unpack8(q0, qv, 0); unpack8(q1, qv, 8); unpack8(k0, kv, 0); unpack8(k1, kv, 8);
        float dc[16];
#pragma unroll
        for (int cc = 0; cc < 16; ++cc) { const float b = la[cc]; const float bend = __shfl(b, 63); const float eb = exp_(b); dc[cc] = eb; qv[cc] *= eb; la[cc] = kv[cc] * exp_(bend - b); kv[cc] *= exp_(-b); }
        if (lane == 63) {
#pragma unroll
            for (int c4 = 0; c4 < 4; ++c4) *(GAS f32x4*)(rec + REC_DEC + (16 * w + 4 * c4) * 4) = (f32x4){dc[4 * c4], dc[4 * c4 + 1], dc[4 * c4 + 2], dc[4 * c4 + 3]}; }
        const u32x4 qa = packf8(qv, 0), qb = packf8(qv, 8), ka = packf8(kv, 0), kb = packf8(kv, 8), sa = packf8(la, 0), sb = packf8(la, 8);
        *(LAS u32x4*)(QT + row * 136 + 16 * w) = qa; *(LAS u32x4*)(QT + row * 136 + 16 * w + 8) = qb;
        *(LAS u32x4*)(KT + row * 136 + 16 * w) = ka; *(LAS u32x4*)(KT + row * 136 + 16 * w + 8) = kb;
        *(GAS u32x4*)(rec + row * 256 + (((2 * w) ^ (row & 15)) << 4)) = qa; *(GAS u32x4*)(rec + row * 256 + (((2 * w + 1) ^ (row & 15)) << 4)) = qb;
        *(GAS u32x4*)(rec + REC_KS + row * 256 + (((2 * w) ^ (2 * (row & 7))) << 4)) = sa; *(GAS u32x4*)(rec + REC_KS + row * 256 + (((2 * w + 1) ^ (2 * (row & 7))) << 4)) = sb;
    }
    __syncthreads();
#pragma unroll
    for (int rep = 0; rep < 2; ++rep) {
        const int tt = w + 8 * rep, jt = tt >> 2, it = tt & 3;
        f32x4 a = (f32x4){0.f, 0.f, 0.f, 0.f};
        if (jt <= it) {
#pragma unroll
            for (int k4 = 0; k4 < 4; ++k4) { const bf16x8 af = *(const LAS bf16x8*)(KT + (16 * jt + fr) * 136 + 32 * k4 + 8 * fq), bfr = *(const LAS bf16x8*)(QT + (16 * it + fr) * 136 + 32 * k4 + 8 * fq); a = MFMA16(af, bfr, a); }
        }
        const int i = 16 * it + fr, j0 = 16 * jt + 4 * fq;
        u32x2 o; o.x = cvt_pk_bf16(j0 <= i ? a[0] : 0.f, j0 + 1 <= i ? a[1] : 0.f); o.y = cvt_pk_bf16(j0 + 2 <= i ? a[2] : 0.f, j0 + 3 <= i ? a[3] : 0.f);
        *(LAS u32x2*)(AT + i * 72 + j0) = o;
    }
    __syncthreads();
    {
        const int dv0 = 32 * w;
        bf16x8 vb[2][2];
#pragma unroll
        for (int k2 = 0; k2 < 2; ++k2)
#pragma unroll
            for (int dt = 0; dt < 2; ++dt) { const LAS bf16_t* p = VS + (32 * k2 + 8 * fq + (fr >> 2)) * 264 + dv0 + 16 * dt + (fr & 3) * 4; vb[k2][dt] = cat8(tr16(p), tr16(p + 4 * 264)); }
#pragma unroll
        for (int tt = 0; tt < 4; ++tt) {
            const bf16x8 a0 = *(const LAS bf16x8*)(AT + (16 * tt + fr) * 72 + 8 * fq), a1 = *(const LAS bf16x8*)(AT + (16 * tt + fr) * 72 + 32 + 8 * fq);
#pragma unroll
            for (int dt = 0; dt < 2; ++dt) { f32x4 z = (f32x4){0.f, 0.f, 0.f, 0.f}; z = MFMA16(vb[0][dt], a0, z); z = MFMA16(vb[1][dt], a1, z);
                *(GAS unsigned*)(oi + ((w * 8 + tt * 2 + dt) * 64 + lane) * 4) = pk4_fp8(z[0], z[1], z[2], z[3]); }
        }
    }
}
constexpr int GSEG = 16, NSEG = 64 / GSEG;
constexpr int GL_STAGE = 50176, GL_DEC = 16384, GL_VS = 17408;
DI void gla_l_chain(LAS unsigned char* lds, const Ctx& c, int bl, int h, int seg) {
    const int tid = ltid(), lane = tid & 63, w = rfl(tid >> 6), fr = lane & 15, fq = lane >> 4;
    const size_t t0 = (size_t)bl * SEQ + (size_t)seg * (GSEG * 64);
    const bf16_t* VG = wsb(c, WS_H + H_VG) + t0 * 1024 + h * 256;
    const unsigned char* rec0 = c.ws + WS_REC + (size_t)((bl * 4 + h) * 64 + seg * GSEG) * REC_BYTES;
    const int dv0 = 32 * w; const unsigned lds_u = (unsigned)(uintptr_t)lds;
    f32x4 S[8][2], Dc[8];
#pragma unroll
    for (int a = 0; a < 8; ++a) { S[a][0] = (f32x4){0.f, 0.f, 0.f, 0.f}; S[a][1] = (f32x4){0.f, 0.f, 0.f, 0.f}; Dc[a] = (f32x4){1.f, 1.f, 1.f, 1.f}; }
#define GL_DMA(gp, ldsoff) do { unsigned _sv; const unsigned _m = (unsigned)__builtin_amdgcn_readfirstlane((int)(ldsoff)); \
        asm volatile("s_mov_b32 %0, m0\n\ts_mov_b32 m0, %2\n\ts_nop 0\n\tglobal_load_lds_dwordx4 %1, off\n\ts_mov_b32 m0, %0" : "=&s"(_sv) : "v"(gp), "s"(_m) : "memory"); } while (0)
#define GL_PREFETCH(nn, st) do { const unsigned char* _r = rec0 + (size_t)(nn) * REC_BYTES + REC_KS; const unsigned _s = lds_u + (unsigned)(st) * GL_STAGE; \
        _Pragma("unroll") for (int _p = 0; _p < 2; ++_p) GL_DMA((const GAS unsigned char*)(_r + (w * 2 + _p) * 1024 + lane * 16), _s + (w * 2 + _p) * 1024); \
        if (w == 0) GL_DMA((const GAS unsigned char*)(_r + 16384 + lane * 16), _s + GL_DEC); \
        _Pragma("unroll") for (int _p = 0; _p < 4; ++_p) { const int _row = 2 * (w * 4 + _p) + (lane >> 5); \
            GL_DMA((const GAS bf16_t*)(VG + (size_t)((nn) * 64 + _row) * 1024 + (((lane & 31) ^ (2 * (_row & 3))) << 3)), _s + GL_VS + (w * 4 + _p) * 1024); } } while (0)
    __syncthreads();
    GL_PREFETCH(0, 0);
    for (int n = 0; n < GSEG; ++n) {
        const int st = n & 1; LAS unsigned char* sb_ = lds + st * GL_STAGE;
        LAS bf16_t* KS = (LAS bf16_t*)sb_; LAS float* DEC = (LAS float*)(sb_ + GL_DEC); LAS bf16_t* VS = (LAS bf16_t*)(sb_ + GL_VS);
        VM_WAIT(); asm volatile("s_waitcnt lgkmcnt(0)" ::: "memory"); __builtin_amdgcn_s_barrier(); asm volatile("" ::: "memory");
        if (n + 1 < GSEG) GL_PREFETCH(n + 1, st ^ 1);
        bf16x8 vb[2][2];
#pragma unroll
        for (int k2 = 0; k2 < 2; ++k2)
#pragma unroll
            for (int dt = 0; dt < 2; ++dt) { const int r0 = 32 * k2 + 8 * fq + (fr >> 2);
                const LAS bf16_t* p = VS + r0 * 256 + ((((dv0 + 16 * dt) >> 3) ^ (2 * (r0 & 3))) << 3) + (fr & 3) * 4; vb[k2][dt] = cat8(tr16(p), tr16(p + 4 * 256)); }
#pragma unroll
        for (int k8 = 0; k8 < 8; ++k8) {
            const f32x4 dc = *(const LAS f32x4*)(DEC + 16 * k8 + 4 * fq);
            S[k8][0] *= dc; S[k8][1] *= dc; Dc[k8] *= dc;
#pragma unroll
            for (int k2 = 0; k2 < 2; ++k2) { const int r0 = 32 * k2 + 8 * fq + (fr >> 2);
                const LAS bf16_t* p0 = KS + r0 * 128 + (((2 * k8) ^ (2 * (r0 & 7))) << 3) + (fr & 3) * 4; const LAS bf16_t* p1 = KS + (r0 + 4) * 128 + (((2 * k8) ^ (2 * ((r0 + 4) & 7))) << 3) + (fr & 3) * 4;
                const bf16x8 af = cat8(tr16(p0), tr16(p1));
                S[k8][0] = MFMA16(af, vb[k2][0], S[k8][0]); S[k8][1] = MFMA16(af, vb[k2][1], S[k8][1]); }
        }
    }
#undef GL_PREFETCH
#undef GL_DMA
    const int cj = (bl * 4 + h) * NSEG + seg;
    GAS f32x4* sl = (GAS f32x4*)(c.ws + WS_SLOC) + ((size_t)(cj * 8 + w) * 16) * 64 + lane;
#pragma unroll
    for (int a = 0; a < 8; ++a) { sl[(a * 2) * 64] = S[a][0]; sl[(a * 2 + 1) * 64] = S[a][1]; }
    if (w == 0) { GAS f32x4* dq = (GAS f32x4*)(c.ws + WS_DCUM) + (size_t)cj * 8 * 64 + lane;
#pragma unroll
        for (int a = 0; a < 8; ++a) dq[a * 64] = Dc[a]; }
    VM_WAIT(); __syncthreads();
}
constexpr int GS_STAGE = 66560, GS_KS = 16384, GS_DEC = 32768, GS_VS = 33792, GS_SS = 2 * GS_STAGE;
DI void gla_s_chain(LAS unsigned char* lds, const Ctx& c, int l, int bl, int h, int seg) {
    const int tid = ltid(), lane = tid & 63, w = rfl(tid >> 6), fr = lane & 15, fq = lane >> 4;
    const size_t t0 = (size_t)bl * SEQ + (size_t)seg * (GSEG * 64);
    const bf16_t* VG = wsb(c, WS_H + H_VG) + t0 * 1024 + h * 256;
    const unsigned char* SR = c.ws + WS_H + H_SR + t0 * 1024 + h * 256;
    unsigned char* OG = c.ws + WS_OG + t0 * 1024 + h * 256;
    const unsigned char* rec0 = c.ws + WS_REC + (size_t)((bl * 4 + h) * 64 + seg * GSEG) * REC_BYTES;
    const unsigned char* oi0 = c.ws + WS_MIX + (size_t)((bl * 4 + h) * 64 + seg * GSEG) * OI_BYTES;
    LAS float* SS = (LAS float*)(lds + GS_SS);
    const int dv0 = 32 * w;
    f32x4 gnv[2]; gnv[0] = *(const GAS f32x4*)(c.gla_norm + l * 1024 + h * 256 + dv0 + 4 * fq); gnv[1] = *(const GAS f32x4*)(c.gla_norm + l * 1024 + h * 256 + dv0 + 16 + 4 * fq);
    f32x4 S[8][2];
#pragma unroll
    for (int a = 0; a < 8; ++a) { S[a][0] = (f32x4){0.f, 0.f, 0.f, 0.f}; S[a][1] = (f32x4){0.f, 0.f, 0.f, 0.f}; }
    for (int j = 0; j < seg; ++j) {
        const int cj = (bl * 4 + h) * NSEG + j;
        const GAS f32x4* sl = (const GAS f32x4*)(c.ws + WS_SLOC) + ((size_t)(cj * 8 + w) * 16) * 64 + lane; const GAS f32x4* dq = (const GAS f32x4*)(c.ws + WS_DCUM) + (size_t)cj * 8 * 64 + lane;
#pragma unroll
        for (int a = 0; a < 8; ++a) { const f32x4 dcv = dq[a * 64]; S[a][0] = S[a][0] * dcv + sl[(a * 2) * 64]; S[a][1] = S[a][1] * dcv + sl[(a * 2 + 1) * 64]; }
    }
#define GS_DMA(gp, ldsoff) do { unsigned _sv; const unsigned _m = (unsigned)__builtin_amdgcn_readfirstlane((int)(ldsoff)); \
        asm volatile("s_mov_b32 %0, m0\n\ts_mov_b32 m0, %2\n\ts_nop 0\n\tglobal_load_lds_dwordx4 %1, off\n\ts_mov_b32 m0, %0" : "=&s"(_sv) : "v"(gp), "s"(_m) : "memory"); } while (0)
#define GS_PREFETCH(nn, st) do { const unsigned char* _r = rec0 + (size_t)(nn) * REC_BYTES; const unsigned _s = lds_u + (unsigned)(st) * GS_STAGE; \
        _Pragma("unroll") for (int _p = 0; _p < 4; ++_p) GS_DMA((const GAS unsigned char*)(_r + (w * 4 + _p) * 1024 + lane * 16), _s + (w * 4 + _p) * 1024); \
        if (w == 0) GS_DMA((const GAS unsigned char*)(_r + 32768 + lane * 16), _s + 32768); \
        _Pragma("unroll") for (int _p = 0; _p < 4; ++_p) { const int _row = 2 * (w * 4 + _p) + (lane >> 5); \
            GS_DMA((const GAS bf16_t*)(VG + (size_t)((nn) * 64 + _row) * 1024 + (((lane & 31) ^ (2 * (_row & 3))) << 3)), _s + GS_VS + (w * 4 + _p) * 1024); } } while (0)
    const unsigned lds_u = (unsigned)(uintptr_t)lds;
#define GS_BAR() do { asm volatile("s_waitcnt lgkmcnt(0)" ::: "memory"); __builtin_amdgcn_s_barrier(); asm volatile("" ::: "memory"); } while (0)
    __syncthreads();
    GS_PREFETCH(0, 0);
    for (int n = 0; n < GSEG; ++n) {
        const int st = n & 1; LAS unsigned char* sb_ = lds + st * GS_STAGE;
        LAS bf16_t* QT = (LAS bf16_t*)sb_; LAS bf16_t* KS = (LAS bf16_t*)(sb_ + GS_KS); LAS float* DEC = (LAS float*)(sb_ + GS_DEC); LAS bf16_t* VS = (LAS bf16_t*)(sb_ + GS_VS); LAS bf16_t* OST = (LAS bf16_t*)(sb_ + GS_KS);
        VM_WAIT(); GS_BAR();
        unsigned oiv[8];
#pragma unroll
        for (int q = 0; q < 8; ++q) oiv[q] = *(const GAS unsigned*)(oi0 + (size_t)n * OI_BYTES + ((w * 8 + q) * 64 + lane) * 4);
        unsigned srv[8];
#pragma unroll
        for (int q = 0; q < 8; ++q) srv[q] = *(const GAS unsigned*)(SR + (size_t)(n * 64 + 16 * (q >> 1) + fr) * 1024 + dv0 + 16 * (q & 1) + 4 * fq);
        asm volatile("" ::: "memory");
        if (n + 1 < GSEG) GS_PREFETCH(n + 1, st ^ 1);
        f32x4 o[4][2];
        {
            bf16x8 vb[2][2];
#pragma unroll
            for (int k2 = 0; k2 < 2; ++k2)
#pragma unroll
                for (int dt = 0; dt < 2; ++dt) { const int r0 = 32 * k2 + 8 * fq + (fr >> 2);
                    const LAS bf16_t* p = VS + r0 * 256 + ((((dv0 + 16 * dt) >> 3) ^ (2 * (r0 & 3))) << 3) + (fr & 3) * 4; vb[k2][dt] = cat8(tr16(p), tr16(p + 4 * 256)); }
#pragma unroll
            for (int tt = 0; tt < 4; ++tt) { o[tt][0] = (f32x4){0.f, 0.f, 0.f, 0.f}; o[tt][1] = (f32x4){0.f, 0.f, 0.f, 0.f}; }
#pragma unroll
            for (int s = 0; s < 4; ++s) {
                bf16x8 sb[2];
#pragma unroll
                for (int dt = 0; dt < 2; ++dt) { u32x4 pk; pk.x = cvt_pk_bf16(S[2 * s][dt][0], S[2 * s][dt][1]); pk.y = cvt_pk_bf16(S[2 * s][dt][2], S[2 * s][dt][3]); pk.z = cvt_pk_bf16(S[2 * s + 1][dt][0], S[2 * s + 1][dt][1]); pk.w = cvt_pk_bf16(S[2 * s + 1][dt][2], S[2 * s + 1][dt][3]); sb[dt] = __builtin_bit_cast(bf16x8, pk); }
#pragma unroll
                for (int tt = 0; tt < 4; ++tt) { const int i = 16 * tt + fr;
                    const LAS bf16_t* qp = QT + i * 128 + (fq & 1) * 4;
                    const bf16x8 af = cat8(*(const LAS s16x4*)(qp + (((4 * s + (fq >> 1)) ^ (i & 15)) << 3)), *(const LAS s16x4*)(qp + (((4 * s + 2 + (fq >> 1)) ^ (i & 15)) << 3)));
                    o[tt][0] = MFMA16(sb[0], af, o[tt][0]); o[tt][1] = MFMA16(sb[1], af, o[tt][1]); }
            }
#pragma unroll
            for (int k8 = 0; k8 < 8; ++k8) {
                const f32x4 dc = *(const LAS f32x4*)(DEC + 16 * k8 + 4 * fq);
                S[k8][0] *= dc; S[k8][1] *= dc;
#pragma unroll
                for (int k2 = 0; k2 < 2; ++k2) { const int r0 = 32 * k2 + 8 * fq + (fr >> 2);
                    const LAS bf16_t* p0 = KS + r0 * 128 + (((2 * k8) ^ (2 * (r0 & 7))) << 3) + (fr & 3) * 4; const LAS bf16_t* p1 = KS + (r0 + 4) * 128 + (((2 * k8) ^ (2 * ((r0 + 4) & 7))) << 3) + (fr & 3) * 4;
                    const bf16x8 af = cat8(tr16(p0), tr16(p1));
                    S[k8][0] = MFMA16(af, vb[k2][0], S[k8][0]); S[k8][1] = MFMA16(af, vb[k2][1], S[k8][1]); }
            }
        }
#pragma unroll
        for (int tt = 0; tt < 4; ++tt)
#pragma unroll
            for (int dt = 0; dt < 2; ++dt) { const f32x2 a = __builtin_amdgcn_cvt_pk_f32_fp8((int)oiv[tt * 2 + dt], false), b = __builtin_amdgcn_cvt_pk_f32_fp8((int)oiv[tt * 2 + dt], true); o[tt][dt][0] += a[0]; o[tt][dt][1] += a[1]; o[tt][dt][2] += b[0]; o[tt][dt][3] += b[1]; }
        {
            f32x4 pp;
#pragma unroll
            for (int tt = 0; tt < 4; ++tt) { const f32x4 a = o[tt][0] * o[tt][0] + o[tt][1] * o[tt][1]; float p = (a[0] + a[1]) + (a[2] + a[3]); p += __shfl_xor(p, 16); p += __shfl_xor(p, 32); pp[tt] = p; }
            if (fq == 0) { SS[(0 * 16 + fr) * 8 + w] = pp[0]; SS[(1 * 16 + fr) * 8 + w] = pp[1]; SS[(2 * 16 + fr) * 8 + w] = pp[2]; SS[(3 * 16 + fr) * 8 + w] = pp[3]; }
        }
        GS_BAR();
#pragma unroll
        for (int tt = 0; tt < 4; ++tt) { const f32x4 s0 = *(const LAS f32x4*)(SS + (16 * tt + fr) * 8), s1 = *(const LAS f32x4*)(SS + (16 * tt + fr) * 8 + 4);
            const float ss = ((s0[0] + s0[1]) + (s0[2] + s0[3])) + ((s1[0] + s1[1]) + (s1[2] + s1[3])); const float rs = __builtin_amdgcn_rsqf(ss * (1.0f / 256.0f) + RMS_EPS);
#pragma unroll
            for (int dt = 0; dt < 2; ++dt) { const f32x2 sa = __builtin_amdgcn_cvt_pk_f32_fp8((int)srv[tt * 2 + dt], false), sb2 = __builtin_amdgcn_cvt_pk_f32_fp8((int)srv[tt * 2 + dt], true); const f32x4 g = gnv[dt]; const f32x4 v = o[tt][dt] * rs;
                *(GAS unsigned*)(OG + (size_t)(n * 64 + 16 * tt + fr) * 1024 + dv0 + 16 * dt + 4 * fq) = pk4_fp8(v[0] * g[0] * sa[0], v[1] * g[1] * sa[1], v[2] * g[2] * sb2[0], v[3] * g[3] * sb2[1]); } }
    }
#undef GS_PREFETCH
#undef GS_DMA
#undef GS_BAR
    VM_WAIT(); __syncthreads();
}

constexpr int AT_K = 0, AT_V = 55296;
struct APre { u32x4 k[6], v[6]; bf16x8 q[2][2]; };
struct AUnit { int dl, n, colo; size_t tb; };
DI AUnit attn_decode(int u) { AUnit a; const int bl = u / 768, g = (u / 256) % 3, h = (u >> 5) & 7, x = u & 31; a.dl = (g == 0) ? 1 : (g == 1 ? 4 : 16); const int nb = 32 / a.dl, r = x / nb; a.n = x - r * nb; a.tb = (size_t)bl * SEQ + r; a.colo = g * 512 + h * 64; return a; }
DI void attn_load(const Ctx& c, int u, APre& p) {
    const int tid = ltid(), lane = tid & 63, w = rfl(tid >> 6), fr = lane & 15, fq = lane >> 4; const AUnit a = attn_decode(u);
    const bf16_t* Q = wsb(c, WS_H + H_QD) + a.colo; const bf16_t* K = wsb(c, WS_H + H_KD) + a.colo; const bf16_t* V = wsb(c, WS_H + H_VD) + a.colo;
#pragma unroll
    for (int b = 0; b < 2; ++b) { const size_t tokq = a.tb + (size_t)a.dl * (128 * (a.n + b) + 16 * w + fr);
#pragma unroll
        for (int d0 = 0; d0 < 2; ++d0) p.q[b][d0] = *(const GAS bf16x8*)(Q + tokq * 1536 + 32 * d0 + 8 * fq); }
#pragma unroll
    for (int c2 = 0; c2 < 6; ++c2) { const int idx = tid + NTHREADS * c2, row = idx >> 3, ch = idx & 7; const int j = 128 * (a.n - 1) + row;
        p.k[c2] = (u32x4){0u, 0u, 0u, 0u}; p.v[c2] = (u32x4){0u, 0u, 0u, 0u};
        if (j >= 0) { const size_t tok = a.tb + (size_t)a.dl * j; p.k[c2] = *(const GAS u32x4*)(K + tok * 1536 + ch * 8); p.v[c2] = *(const GAS u32x4*)(V + tok * 1536 + ch * 8); } }
}
DI void attn_stage(LAS unsigned char* lds, const APre& p) {
    const int tid = ltid(); LAS bf16_t* Ks = (LAS bf16_t*)(lds + AT_K); LAS bf16_t* Vs = (LAS bf16_t*)(lds + AT_V);
#pragma unroll
    for (int c2 = 0; c2 < 6; ++c2) { const int idx = tid + NTHREADS * c2, row = idx >> 3, ch = idx & 7; *(LAS u32x4*)(Ks + row * 72 + ch * 8) = p.k[c2]; *(LAS u32x4*)(Vs + row * 72 + ch * 8) = p.v[c2]; }
}
DI void attn_compute(LAS unsigned char* lds, const Ctx& c, int u, const bf16x8 (&qf)[2][2]) {
    const int tid = ltid(), lane = tid & 63, w = rfl(tid >> 6), fr = lane & 15, fq = lane >> 4; const AUnit au = attn_decode(u);
    const int dl = au.dl, n = au.n, g = (u / 256) % 3, h = (u >> 5) & 7; const size_t tb = au.tb;
    LAS bf16_t* Ks = (LAS bf16_t*)(lds + AT_K); LAS bf16_t* Vs = (LAS bf16_t*)(lds + AT_V);
#pragma unroll
    for (int b = 0; b < 2; ++b) {
        const int kt0 = 8 * b + w;
        f32x4 s[9]; float m = -1e30f;
#pragma unroll
        for (int kr = 0; kr < 9; ++kr) { const int kt = kt0 + kr; f32x4 a = (f32x4){0.f, 0.f, 0.f, 0.f};
#pragma unroll
            for (int d0 = 0; d0 < 2; ++d0) { const bf16x8 af = *(const LAS bf16x8*)(Ks + (16 * kt + fr) * 72 + 32 * d0 + 8 * fq); a = MFMA16(af, qf[b][d0], a); }
#pragma unroll
            for (int rg = 0; rg < 4; ++rg) { const bool tile_ok = (b > 0) || (n > 0) || (kt >= 8);
                bool ok = tile_ok; if (kr == 0) ok = ok && (4 * fq + rg >= fr); if (kr == 8) ok = ok && (4 * fq + rg <= fr);
                a[rg] = ok ? a[rg] : -1e30f; m = fmaxf(m, a[rg]); }
            s[kr] = a; }
        m = fmaxf(m, __shfl_xor(m, 16)); m = fmaxf(m, __shfl_xor(m, 32));
        float lsum = 0.f;
#pragma unroll
        for (int kr = 0; kr < 9; ++kr)
#pragma unroll
            for (int rg = 0; rg < 4; ++rg) { const float p = __builtin_amdgcn_exp2f(s[kr][rg] - m); s[kr][rg] = p; lsum += p; }
        lsum += __shfl_xor(lsum, 16); lsum += __shfl_xor(lsum, 32);
        f32x4 oT[4];
#pragma unroll
        for (int dt = 0; dt < 4; ++dt) oT[dt] = (f32x4){0.f, 0.f, 0.f, 0.f};
#pragma unroll
        for (int pp = 0; pp < 5; ++pp) { const int ka = 2 * pp, kb = (2 * pp + 1 < 9) ? 2 * pp + 1 : 8;
            u32x4 pk; pk.x = cvt_pk_bf16(s[ka][0], s[ka][1]); pk.y = cvt_pk_bf16(s[ka][2], s[ka][3]);
            if (2 * pp + 1 < 9) { pk.z = cvt_pk_bf16(s[kb][0], s[kb][1]); pk.w = cvt_pk_bf16(s[kb][2], s[kb][3]); } else { pk.z = 0u; pk.w = 0u; }
            const bf16x8 pf = __builtin_bit_cast(bf16x8, pk);
#pragma unroll
            for (int dt = 0; dt < 4; ++dt) { const LAS bf16_t* pa = Vs + (16 * (kt0 + ka) + 4 * fq + (fr >> 2)) * 72 + 16 * dt + (fr & 3) * 4; const LAS bf16_t* pb = Vs + (16 * (kt0 + kb) + 4 * fq + (fr >> 2)) * 72 + 16 * dt + (fr & 3) * 4;
                oT[dt] = MFMA16(cat8(tr16(pa), tr16(pb)), pf, oT[dt]); } }
        const float inv = 1.0f / lsum; const size_t tq = tb + (size_t)dl * (128 * (n + b) + 16 * w + fr);
        bf16_t* op = wsb(c, WS_ATTG) + ((size_t)g * TH + tq) * 512 + h * 64 + 4 * fq;
#pragma unroll
        for (int dt = 0; dt < 4; ++dt) { u32x2 o; o.x = cvt_pk_bf16(oT[dt][0] * inv, oT[dt][1] * inv); o.y = cvt_pk_bf16(oT[dt][2] * inv, oT[dt][3] * inv); *(GAS u32x2*)(op + 16 * dt) = o; }
        if (fq == 0) ((float*)(c.ws + WS_LSE))[((size_t)g * TH + tq) * 8 + h] = m + __builtin_amdgcn_logf(lsum);
    }
}
DI void phase_p(LAS unsigned char* lds, const Ctx& c, int l, int G) {
    int h_loaded = -1;
    for (int u = lbid(); u < 8 * 4 * 64; u += G) gla_p_unit(lds, c, l, u >> 8, (u >> 6) & 3, u & 63, h_loaded);
}
constexpr int NATT = 8 * 3 * 8 * 32, NATT1 = 0, NCHAIN = 8 * 4 * NSEG;
DI void attn_pull(LAS unsigned char* lds, const Ctx& c, unsigned* ctr, int base, int limit) {
    volatile LAS int* TK = (volatile LAS int*)(lds + MISC_OFF + 192);
    const int tid = ltid();
    __syncthreads();
    if (tid == 0) { TK[0] = base + 2 * (int)__hip_atomic_fetch_add(ctr, 1u, __ATOMIC_RELAXED, __HIP_MEMORY_SCOPE_AGENT); TK[1] = base + 2 * (int)__hip_atomic_fetch_add(ctr, 1u, __ATOMIC_RELAXED, __HIP_MEMORY_SCOPE_AGENT);
        TK[2] = base + 2 * (int)__hip_atomic_fetch_add(ctr, 1u, __ATOMIC_RELAXED, __HIP_MEMORY_SCOPE_AGENT); }
    __syncthreads();
    int cur = rfl(TK[0]), nxt = rfl(TK[1]);
    APre pre;
    if (cur < limit) attn_load(c, cur, pre);
    while (cur < limit) {
        __syncthreads();
        const int nxt2 = rfl(TK[2]);
        attn_stage(lds, pre);
        bf16x8 qf[2][2];
#pragma unroll
        for (int b = 0; b < 2; ++b)
#pragma unroll
            for (int d0 = 0; d0 < 2; ++d0) qf[b][d0] = pre.q[b][d0];
        __syncthreads();
        if (nxt < limit) attn_load(c, nxt, pre);
        int req = 0; if (tid == 0) req = base + 2 * (int)__hip_atomic_fetch_add(ctr, 1u, __ATOMIC_RELAXED, __HIP_MEMORY_SCOPE_AGENT);
        attn_compute(lds, c, cur, qf);
        if (tid == 0) TK[2] = req;
        cur = nxt; nxt = nxt2;
    }
}
DI void phase_b1(LAS unsigned char* lds, const Ctx& c, int l, int hf, int G) {
    const int bid = lbid(); unsigned* ctr = (unsigned*)(c.ws + WS_CTL) + CW_TKT + ((l * 2 + hf) * 2) * 64;
    for (int id = bid; id < NCHAIN; id += G) gla_l_chain(lds, c, id >> 4, (id >> 2) & 3, id & 3);
    attn_pull(lds, c, ctr, 0, NATT1);
}
DI void phase_b(LAS unsigned char* lds, const Ctx& c, int l, int hf, int G) {
    const int bid = lbid(); unsigned* ctr = (unsigned*)(c.ws + WS_CTL) + CW_TKT + ((l * 2 + hf) * 2 + 1) * 64;
    for (int id = bid; id < NCHAIN; id += G) gla_s_chain(lds, c, l, id >> 4, (id >> 2) & 3, id & 3);
    attn_pull(lds, c, ctr, NATT1, NATT);
}
DI void phase_f(const Ctx& c, int G) {
    const bf16_t* ag = wsb(c, WS_ATTG); const float* lse = (const float*)(c.ws + WS_LSE); unsigned char* att = c.ws + WS_ATT;
    const size_t stride = (size_t)G * NTHREADS, N = (size_t)TH * 64;
    for (size_t i0 = (size_t)lbid() * NTHREADS + ltid(); i0 < N; i0 += 4 * stride) {
        float l0[4], l1[4], l2[4]; u32x4 a[4], b[4], d[4];
#pragma unroll
        for (int q = 0; q < 4; ++q) { const size_t i = i0 + q * stride; const bool ok = i < N; const size_t tok = ok ? (i >> 6) : 0; const int ch = (int)(i & 63), h = ch >> 3;
            l0[q] = lse[tok * 8 + h]; l1[q] = lse[((size_t)TH + tok) * 8 + h]; l2[q] = lse[((size_t)2 * TH + tok) * 8 + h];
            a[q] = *(const GAS u32x4*)(ag + tok * 512 + ch * 8); b[q] = *(const GAS u32x4*)(ag + ((size_t)TH + tok) * 512 + ch * 8); d[q] = *(const GAS u32x4*)(ag + ((size_t)2 * TH + tok) * 512 + ch * 8); }
#pragma unroll
        for (int q = 0; q < 4; ++q) { const size_t i = i0 + q * stride; if (i >= N) continue; const size_t tok = i >> 6; const int ch = (int)(i & 63);
            const float mx = fmaxf(l0[q], fmaxf(l1[q], l2[q])); float w0 = __builtin_amdgcn_exp2f(l0[q] - mx), w1 = __builtin_amdgcn_exp2f(l1[q] - mx), w2 = __builtin_amdgcn_exp2f(l2[q] - mx);
            const float inv = 1.0f / (w0 + w1 + w2); w0 *= inv; w1 *= inv; w2 *= inv;
            u32x2 o;
            o.x = pk4_fp8(w0 * bf_lo(a[q].x) + w1 * bf_lo(b[q].x) + w2 * bf_lo(d[q].x), w0 * bf_hi(a[q].x) + w1 * bf_hi(b[q].x) + w2 * bf_hi(d[q].x), w0 * bf_lo(a[q].y) + w1 * bf_lo(b[q].y) + w2 * bf_lo(d[q].y), w0 * bf_hi(a[q].y) + w1 * bf_hi(b[q].y) + w2 * bf_hi(d[q].y));
            o.y = pk4_fp8(w0 * bf_lo(a[q].z) + w1 * bf_lo(b[q].z) + w2 * bf_lo(d[q].z), w0 * bf_hi(a[q].z) + w1 * bf_hi(b[q].z) + w2 * bf_hi(d[q].z), w0 * bf_lo(a[q].w) + w1 * bf_lo(b[q].w) + w2 * bf_lo(d[q].w), w0 * bf_hi(a[q].w) + w1 * bf_hi(b[q].w) + w2 * bf_hi(d[q].w));
            *(GAS u32x2*)(att + tok * 512 + ch * 8) = o; }
    }
}

DI float wave_sum(float v) {
#pragma unroll
    for (int o = 1; o < 64; o <<= 1) v += __shfl_xor(v, o);
    return v;
}
constexpr int R_WR = 0, R_HIST = 65536, R_BASE = 65536 + 64, R_INFO = 65536 + 128;
DI void phase_r(LAS unsigned char* lds, const Ctx& c, int l, int G) {
    const int tid = ltid(), lane = tid & 63, wave = rfl(tid >> 6);
    LAS float* WR = (LAS float*)(lds + R_WR); volatile LAS int* HIST = (volatile LAS int*)(lds + R_HIST); volatile LAS int* BASE = (volatile LAS int*)(lds + R_BASE); volatile LAS int* INFO = (volatile LAS int*)(lds + R_INFO);
    __syncthreads();
    for (int i = tid; i < 16 * 1024; i += NTHREADS) WR[(i & 15) * 1024 + (i >> 4)] = c.w_router[i];
    f32x4 g4[4], b4[4];
#pragma unroll
    for (int j = 0; j < 4; ++j) { g4[j] = *(const GAS f32x4*)(c.ln1_g + l * D + 4 * lane + 256 * j); b4[j] = *(const GAS f32x4*)(c.ln1_b + l * D + 4 * lane + 256 * j); }
    bf16_t* xr = wsb(c, WS_XR); unsigned char* xb = c.ws + WS_XB; int* histg = (int*)(c.ws + WS_HISTG); float* gate = (float*)(c.ws + WS_GATE);
    const float brt = c.b_router[((lane >> 5) & 1) * 8 + ((lane >> 4) & 1) * 4 + ((lane >> 3) & 1) * 2 + ((lane >> 2) & 1)];
    for (int chunk = lbid(); chunk < T / 256; chunk += G) {
        __syncthreads();
        u32x2 zn[4];
#pragma unroll
        for (int j = 0; j < 4; ++j) zn[j] = *(const GAS u32x2*)(xr + ((size_t)chunk * 256 + wave * 32) * D + 4 * lane + 256 * j);
        for (int rr = 0; rr < 32; ++rr) {
            const int rl = wave * 32 + rr; const size_t row = (size_t)chunk * 256 + rl;
            f32x4 v[4]; float s = 0.f;
#pragma unroll
            for (int j = 0; j < 4; ++j) { const u32x2 zq = zn[j]; v[j] = (f32x4){bf_lo(zq.x), bf_hi(zq.x), bf_lo(zq.y), bf_hi(zq.y)}; s += (v[j][0] + v[j][1]) + (v[j][2] + v[j][3]); }
            { const size_t rn = row + (rr + 1 < 32 ? 1 : 0);
#pragma unroll
              for (int j = 0; j < 4; ++j) zn[j] = *(const GAS u32x2*)(xr + rn * D + 4 * lane + 256 * j); }
            const float mean = wave_sum(s) * (1.0f / D); float s2 = 0.f;
#pragma unroll
            for (int j = 0; j < 4; ++j) { v[j] = v[j] - mean; s2 += (v[j][0] * v[j][0] + v[j][1] * v[j][1]) + (v[j][2] * v[j][2] + v[j][3] * v[j][3]); }
            const float rstd = __builtin_amdgcn_rsqf(wave_sum(s2) * (1.0f / D) + LN_EPS);
#pragma unroll
            for (int j = 0; j < 4; ++j) { v[j] = v[j] * rstd * g4[j] + b4[j]; u32x2 xq; xq.x = cvt_pk_bf16(v[j][0], v[j][1]); xq.y = cvt_pk_bf16(v[j][2], v[j][3]); *(GAS u32x2*)(xr + row * D + 4 * lane + 256 * j) = xq;
                *(GAS unsigned*)(xb + row * D + 4 * lane + 256 * j) = pk4_fp8(v[j][0], v[j][1], v[j][2], v[j][3]); }
            float lg[16];
#pragma unroll
            for (int e = 0; e < 16; ++e) { float a = 0.f;
#pragma unroll
                for (int j = 0; j < 4; ++j) { const f32x4 wv = *(const LAS f32x4*)(WR + e * 1024 + 4 * lane + 256 * j); a += v[j][0] * wv[0] + v[j][1] * wv[1] + v[j][2] * wv[2] + v[j][3] * wv[3]; }
                lg[e] = a; }
            {
                float b8[8], b4[4], b2[2];
                const bool h5 = lane & 32, h4 = lane & 16, h3 = lane & 8, h2 = lane & 4;
#pragma unroll
                for (int i = 0; i < 8; ++i) { const float mine = h5 ? lg[8 + i] : lg[i], send = h5 ? lg[i] : lg[8 + i]; b8[i] = mine + __shfl_xor(send, 32); }
#pragma unroll
                for (int i = 0; i < 4; ++i) { const float mine = h4 ? b8[4 + i] : b8[i], send = h4 ? b8[i] : b8[4 + i]; b4[i] = mine + __shfl_xor(send, 16); }
#pragma unroll
                for (int i = 0; i < 2; ++i) { const float mine = h3 ? b4[2 + i] : b4[i], send = h3 ? b4[i] : b4[2 + i]; b2[i] = mine + __shfl_xor(send, 8); }
                float b1 = (h2 ? b2[1] : b2[0]) + __shfl_xor(h2 ? b2[0] : b2[1], 4);
                b1 += __shfl_xor(b1, 2); b1 += __shfl_xor(b1, 1);
                b1 += brt;
#pragma unroll
                for (int e = 0; e < 16; ++e) lg[e] = __shfl(b1, ((e >> 3) & 1) * 32 + ((e >> 2) & 1) * 16 + ((e >> 1) & 1) * 8 + (e & 1) * 4);
            }
            float mx = lg[0];
#pragma unroll
            for (int e = 1; e < 16; ++e) mx = fmaxf(mx, lg[e]);
            float se = 0.f;
#pragma unroll
            for (int e = 0; e < 16; ++e) { lg[e] = __expf(lg[e] - mx); se += lg[e]; }
            const float ise = 1.0f / se;
#pragma unroll
            for (int e = 0; e < 16; ++e) lg[e] *= ise;
            int gsel = 0; float gbest = -1.f;
#pragma unroll
            for (int gi = 0; gi < 4; ++gi) { const float a = lg[4 * gi], b = lg[4 * gi + 1], cc = lg[4 * gi + 2], d = lg[4 * gi + 3];
                const float sc = (a + b + cc + d) - fminf(fminf(a, b), fminf(cc, d)) - fminf(fmaxf(fminf(a, b), fminf(cc, d)), fminf(fmaxf(a, b), fmaxf(cc, d)));
                if (sc > gbest) { gbest = sc; gsel = gi; } }
            float p[4];
#pragma unroll
            for (int k = 0; k < 4; ++k) p[k] = gsel == 0 ? lg[k] : gsel == 1 ? lg[4 + k] : gsel == 2 ? lg[8 + k] : lg[12 + k];
            int i0 = 0; float v0 = p[0];
#pragma unroll
            for (int k = 1; k < 4; ++k) if (p[k] > v0) { v0 = p[k]; i0 = k; }
            int i1 = -1; float v1 = -1.f;
#pragma unroll
            for (int k = 0; k < 4; ++k) if (k != i0 && p[k] > v1) { v1 = p[k]; i1 = k; }
            if (lane == 0) { const int e0 = 4 * gsel + i0, e1 = 4 * gsel + i1; INFO[rl * 4 + 0] = e0; INFO[rl * 4 + 1] = e1;
                const float gs = 1.0f / (v0 + v1); gate[row * 2] = v0 * gs; gate[row * 2 + 1] = v1 * gs; }
        }
        __syncthreads();
        {
            int cnt0 = 0, cnt1 = 0; const unsigned long long lt = (1ull << lane) - 1ull;
#pragma unroll
            for (int b = 0; b < 4; ++b) { const int r = 64 * b + lane; const int e0 = INFO[r * 4], e1 = INFO[r * 4 + 1];
                const bool a0 = (e0 == 2 * wave) || (e1 == 2 * wave), a1 = (e0 == 2 * wave + 1) || (e1 == 2 * wave + 1);
                const unsigned long long m0 = __ballot(a0), m1 = __ballot(a1);
                if (a0) INFO[r * 4 + (e0 == 2 * wave ? 2 : 3)] = cnt0 + __popcll(m0 & lt);
                if (a1) INFO[r * 4 + (e0 == 2 * wave + 1 ? 2 : 3)] = cnt1 + __popcll(m1 & lt);
                cnt0 += __popcll(m0); cnt1 += __popcll(m1); }
            if (lane == 0) { histg[chunk * 16 + 2 * wave] = cnt0; histg[chunk * 16 + 2 * wave + 1] = cnt1; }
        }
        __syncthreads();
        if (tid < 256) { i32x4 v; v.x = INFO[tid * 4]; v.y = INFO[tid * 4 + 1]; v.z = INFO[tid * 4 + 2]; v.w = INFO[tid * 4 + 3]; ((GAS i32x4*)(c.ws + WS_INFO))[(size_t)chunk * 256 + tid] = v; }
        __syncthreads();
    }
}
DI void phase_r2(LAS unsigned char* lds, const Ctx& c, int l, int G) {
    const int tid = ltid(); volatile LAS int* BASE = (volatile LAS int*)(lds + R_BASE);
    const int* histg = (const int*)(c.ws + WS_HISTG); int* list = (int*)(c.ws + WS_LIST);
    unsigned* cur = (unsigned*)(c.ws + WS_CTL) + CW_CUR + l * 16 * 64;
    for (int chunk = lbid(); chunk < T / 256; chunk += G) {
        __syncthreads();
        if (tid < 16) BASE[tid] = 0;
        __syncthreads();
        { const int e = tid & 15; int s = 0; for (int cc = tid >> 4; cc < chunk; cc += 32) s += histg[cc * 16 + e]; if (s) atomicAdd((int*)&BASE[e], s); }
        __syncthreads();
        if (tid < 256) { const i32x4 v = ((const GAS i32x4*)(c.ws + WS_INFO))[(size_t)chunk * 256 + tid]; const int row = chunk * 256 + tid;
            list[(size_t)v.x * T + BASE[v.x] + v.z] = row * 2; list[(size_t)v.y * T + BASE[v.y] + v.w] = row * 2 + 1; }
        if (chunk == T / 256 - 1 && tid < 16) __hip_atomic_store(cur + tid * 64, (unsigned)(BASE[tid] + histg[chunk * 16 + tid]), __ATOMIC_RELAXED, __HIP_MEMORY_SCOPE_AGENT);
    }
}
DI int moe_setup(LAS unsigned char* lds, const Ctx& c, int l) {
    volatile LAS int* PRE = (volatile LAS int*)(lds + MISC_OFF); volatile LAS int* CNT = PRE + 17;
    unsigned* cur = (unsigned*)(c.ws + WS_CTL) + CW_CUR + l * 16 * 64;
    __syncthreads();
    if (threadIdx.x == 0) { int acc = 0; for (int e = 0; e < 16; ++e) { const int n = (int)__hip_atomic_load(cur + e * 64, __ATOMIC_RELAXED, __HIP_MEMORY_SCOPE_AGENT); PRE[e] = acc; CNT[e] = n; acc += (n + 255) >> 8; } PRE[16] = acc; }
    __syncthreads();
    return rfl(PRE[16]);
}
DI void phase_c(const Ctx& c, int l, int G) {
    const int tid = ltid(), lane = tid & 63, wave = rfl(tid >> 6);
    f32x4 g4[4], b4[4];
#pragma unroll
    for (int j = 0; j < 4; ++j) { g4[j] = *(const GAS f32x4*)(c.ln2_g + l * D + 4 * lane + 256 * j); b4[j] = *(const GAS f32x4*)(c.ln2_b + l * D + 4 * lane + 256 * j); }
    float* xo = c.out; bf16_t* xr = wsb(c, WS_XR); unsigned char* xb = c.ws + WS_XB; const unsigned char* ys = c.ws + WS_YS; const float* gate = (const float*)(c.ws + WS_GATE);
    const size_t rstep = (size_t)G * NWAVES; size_t row = (size_t)lbid() * NWAVES + wave;
    u32x2 xn[4]; unsigned y0n[4], y1n[4]; float g0n = 0.f, g1n = 0.f;
    if (row < (size_t)T) { g0n = gate[row * 2]; g1n = gate[row * 2 + 1];
#pragma unroll
        for (int j = 0; j < 4; ++j) { xn[j] = *(const GAS u32x2*)(xr + row * D + 4 * lane + 256 * j); y0n[j] = *(const GAS unsigned*)(ys + (row * 2) * D + 4 * lane + 256 * j); y1n[j] = *(const GAS unsigned*)(ys + (row * 2 + 1) * D + 4 * lane + 256 * j); } }
    for (; row < (size_t)T; row += rstep) {
        const float g0 = g0n, g1 = g1n;
        f32x4 v[4]; float s = 0.f;
#pragma unroll
        for (int j = 0; j < 4; ++j) { const u32x2 xq = xn[j]; const unsigned y0 = y0n[j], y1 = y1n[j];
            const f32x2 y0a = __builtin_amdgcn_cvt_pk_f32_fp8((int)y0, false), y0b = __builtin_amdgcn_cvt_pk_f32_fp8((int)y0, true), y1a = __builtin_amdgcn_cvt_pk_f32_fp8((int)y1, false), y1b = __builtin_amdgcn_cvt_pk_f32_fp8((int)y1, true);
            v[j][0] = bf_lo(xq.x) * DN_ALPHA + g0 * y0a[0] + g1 * y1a[0]; v[j][1] = bf_hi(xq.x) * DN_ALPHA + g0 * y0a[1] + g1 * y1a[1];
            v[j][2] = bf_lo(xq.y) * DN_ALPHA + g0 * y0b[0] + g1 * y1b[0]; v[j][3] = bf_hi(xq.y) * DN_ALPHA + g0 * y0b[1] + g1 * y1b[1];
            s += (v[j][0] + v[j][1]) + (v[j][2] + v[j][3]); }
        { const size_t rn = row + rstep < (size_t)T ? row + rstep : row; g0n = gate[rn * 2]; g1n = gate[rn * 2 + 1];
#pragma unroll
          for (int j = 0; j < 4; ++j) { xn[j] = *(const GAS u32x2*)(xr + rn * D + 4 * lane + 256 * j); y0n[j] = *(const GAS unsigned*)(ys + (rn * 2) * D + 4 * lane + 256 * j); y1n[j] = *(const GAS unsigned*)(ys + (rn * 2 + 1) * D + 4 * lane + 256 * j); } }
        const float mean = wave_sum(s) * (1.0f / D); float s2 = 0.f;
#pragma unroll
        for (int j = 0; j < 4; ++j) { v[j] = v[j] - mean; s2 += (v[j][0] * v[j][0] + v[j][1] * v[j][1]) + (v[j][2] * v[j][2] + v[j][3] * v[j][3]); }
        const float rstd = __builtin_amdgcn_rsqf(wave_sum(s2) * (1.0f / D) + LN_EPS);
#pragma unroll
        for (int j = 0; j < 4; ++j) { v[j] = v[j] * rstd * g4[j] + b4[j];
            if (l == DEPTH - 1) *(GAS f32x4*)(xo + row * D + 4 * lane + 256 * j) = v[j];
            else { u32x2 xq; xq.x = cvt_pk_bf16(v[j][0], v[j][1]); xq.y = cvt_pk_bf16(v[j][2], v[j][3]); *(GAS u32x2*)(xr + row * D + 4 * lane + 256 * j) = xq;
                *(GAS unsigned*)(xb + row * D + 4 * lane + 256 * j) = pk4_fp8(v[j][0], v[j][1], v[j][2], v[j][3]); } }
    }
}

DI Ctx load_ctx() {
    union { Ctx c; unsigned long long q[sizeof(Ctx) / 8]; } u;
#if defined(__HIP_DEVICE_COMPILE__)
    const __attribute__((address_space(4))) unsigned long long* p = (const __attribute__((address_space(4))) unsigned long long*)__builtin_amdgcn_kernarg_segment_ptr();
    asm volatile("" : "+s"(p));
#pragma unroll
    for (int i = 0; i < (int)(sizeof(Ctx) / 8); ++i) u.q[i] = p[i];
#endif
    return u.c;
}
#define CTX const Ctx c = load_ctx(); const int G = lgrid(); LAS unsigned char* lds = LDSBASE
__global__ void __launch_bounds__(NTHREADS, 2) mk_fwd(Ctx c_arg) {
    extern __shared__ __attribute__((aligned(16))) unsigned char lds_raw[];
#define LDSBASE ({ unsigned _b = (unsigned)(uintptr_t)(LAS unsigned char*)lds_raw; asm volatile("" : "+s"(_b)); (LAS unsigned char*)(uintptr_t)_b; })
    LAS unsigned char* lds0 = LDSBASE;
    const int tid = threadIdx.x; const Ctx c = load_ctx();
    volatile LAS unsigned* MISC = (volatile LAS unsigned*)(lds0 + MISC_OFF);
    if (tid < 64) MISC[tid] = 0u;
    __syncthreads();
    XcdBarrier bar; bar.bar = (unsigned*)(c.ws + WS_CTL) + CW_BAR; bar.x = 0; bar.st = MISC + 40;
    if (!MK_MULTI) bar = xcd_barrier_post((unsigned*)(c.ws + WS_CTL) + CW_BAR, MISC + 40);
    const int lo = c.lo, hi = c.hi; int step = 0;
#define RUN (lo <= step && step < hi)
#define END_STEP do { if (RUN && step + 1 < hi) { if (!MK_MULTI) xcd_barrier(bar); } ++step; } while (0)
#define END_STEP_NB do { ++step; } while (0)
    for (int l = 0; l < DEPTH; ++l) {
        if (RUN) { CTX; phase_w(lds, c, l, G); }
        END_STEP;
        for (int hf = 0; hf < 2; ++hf) {
            const size_t r0 = (size_t)hf * TH;
            if (RUN) {
                CTX;
                pg8::StaticOrder S; S.init(c.ws + WS_XB + r0 * D, c.ws + WS_WIN, TH, NIN, D / 2, G, lbid());
                EpiIn E{wsb(c, WS_H + H_QG), wsb(c, WS_H + H_KG), wsb(c, WS_H + H_VG), wsb(c, WS_H + H_SR), wsb(c, WS_H + H_QD), wsb(c, WS_H + H_KD), wsb(c, WS_H + H_VD), wsb(c, WS_H + H_GT), (float*)(c.ws + WS_HA), c.pos + r0};
                pg8::gemm_phase<EpiIn, pg8::StaticOrder, true>(lds, D / 2, S, E);
            }
            END_STEP;
            if (RUN) { CTX; phase_p(lds, c, l, G); }
            END_STEP;
            if (RUN) { CTX; phase_b1(lds, c, l, hf, G); }
            END_STEP;
            if (RUN) { CTX; phase_b(lds, c, l, hf, G); }
            END_STEP;
            if (RUN) { CTX; (void)lds; phase_f(c, G); }
            END_STEP_NB;
            if (RUN) {
                CTX;
                pg8::StaticOrder S; S.init(c.ws + WS_OG, c.ws + WS_WGO, TH, D, D / 2, G, lbid());
                EpiGate<false> E{wsb(c, WS_MIX), c.ws + WS_H + H_GT, nullptr};
                pg8::gemm_phase<EpiGate<false>, pg8::StaticOrder, true>(lds, D / 2, S, E);
            }
            END_STEP;
            if (RUN) {
                CTX;
                pg8::StaticOrder S; S.init(c.ws + WS_ATT, c.ws + WS_WAO, TH, D, 256, G, lbid());
                EpiGate<true> E{wsb(c, WS_MIX), c.ws + WS_H + H_GT + 1024, c.ws + WS_OG + 32 * MiB};
                pg8::gemm_phase<EpiGate<true>, pg8::StaticOrder, true>(lds, 256, S, E);
            }
            END_STEP;
            if (RUN) {
                CTX;
                pg8::StaticOrder S; S.init(c.ws + WS_OG + 32 * MiB, c.ws + WS_WOUT, TH, D, D / 2, G, lbid());
                EpiRes E{l == 0 ? c.x + r0 * D : nullptr, wsb(c, WS_XR) + r0 * D};
                pg8::gemm_phase<EpiRes, pg8::StaticOrder, true>(lds, D / 2, S, E);
            }
            if (hf == 1) END_STEP; else END_STEP_NB;
        }
        if (RUN) { CTX; phase_r(lds, c, l, G); }
        END_STEP;
        if (RUN) { CTX; phase_r2(lds, c, l, G); }
        END_STEP;
        if (RUN) {   CTX;
            const int ntiles = moe_setup(lds, c, l);
            volatile LAS int* PRE = (volatile LAS int*)(lds + MISC_OFF); volatile LAS int* TAB = (volatile LAS int*)(lds + TAB_OFF);
            pg8::MoeOrder S; S.G = G; S.c = vcu_of(lbid(), G); S.ntot = ntiles * 8; S.NC = 8; S.K = D / 2; S.pre = PRE; S.cnt = PRE + 17; S.A = (const char*)(c.ws + WS_XB); S.Bt = (const char*)(c.ws + WS_WGU);
            S.bstride = (size_t)2048 * 1024; S.tab = TAB; S.gather = true;
            const int* list = (const int*)(c.ws + WS_LIST);
            { const int lt_tid = ltid(); const int r = lt_tid & 255, half = rfl(lt_tid >> 8);
              for (int i0 = 0; i0 < MAXU; i0 += 2) { Unit u; const int i = i0 + half;
                  if (S.next(i, u)) { const int lt = u.pm - PRE[u.e]; const int pos = 256 * lt + (r < u.nv ? r : 0); TAB[i * 256 + r] = list[(size_t)u.e * T + pos] >> 1; } } }
            __syncthreads();
            EpiM1 E{c.ws + WS_HM};
            pg8::gemm_phase<EpiM1, pg8::MoeOrder, true>(lds, D / 2, S, E);
        }
        END_STEP;
        if (RUN) {   CTX;
            const int ntiles = moe_setup(lds, c, l);
            volatile LAS int* PRE = (volatile LAS int*)(lds + MISC_OFF);
            pg8::MoeOrder S; S.G = G; S.c = vcu_of(lbid(), G); S.ntot = ntiles * 4; S.NC = 4; S.K = DFF / 2; S.pre = PRE; S.cnt = PRE + 17; S.A = (const char*)(c.ws + WS_HM); S.Bt = (const char*)(c.ws + WS_WD);
            S.bstride = (size_t)1024 * 1024; S.tab = nullptr; S.gather = false;
            EpiM2 E{c.ws + WS_YS, (const int*)(c.ws + WS_LIST), PRE};
            pg8::gemm_phase<EpiM2, pg8::MoeOrder, true>(lds, DFF / 2, S, E);
        }
        END_STEP;
        if (RUN) { CTX; (void)lds; phase_c(c, l, G); }
        END_STEP_NB;
    }
#undef RUN
#undef END_STEP
#undef END_STEP_NB
}
constexpr int NSTEPS = DEPTH * (1 + 2 * 8 + 5);

extern "C" void kernel_launch(void* const* d_in, const int* in_sizes, int n_in, void* d_out, int out_size, void* d_ws, size_t ws_size, hipStream_t stream) {
    static int grid = 0;
    if (grid == 0) {
        if (n_in != 18 || in_sizes[0] != T * D || out_size != T * D || ws_size < WS_END) { fprintf(stderr, "kernel_launch: unexpected shapes / workspace (need %zu, got %zu)\n", (size_t)WS_END, ws_size); grid = -1; return; }
        int dev = 0, cus = 0;
        if (hipGetDevice(&dev) != hipSuccess || hipDeviceGetAttribute(&cus, hipDeviceAttributeMultiprocessorCount, dev) != hipSuccess) { grid = -1; return; }
        if (hipFuncSetAttribute((const void*)mk_fwd, hipFuncAttributeMaxDynamicSharedMemorySize, LDS_BYTES) != hipSuccess) { fprintf(stderr, "kernel_launch: hipFuncSetAttribute failed\n"); grid = -1; return; }
        int per_cu = 0;
        if (hipOccupancyMaxActiveBlocksPerMultiprocessor(&per_cu, (const void*)mk_fwd, NTHREADS, LDS_BYTES) != hipSuccess || per_cu < 1) { fprintf(stderr, "kernel_launch: occupancy query says %d\n", per_cu); }
        (void)hipGetLastError();
        grid = cus;
    }
    if (grid < 0) return;
    (void)hipMemsetAsync((char*)d_ws + WS_CTL, 0, CTL_ZERO_BYTES, stream);
    Ctx c{};
    c.x = (const float*)d_in[0]; c.pos = (const int*)d_in[1]; c.w_in = (const float*)d_in[2]; c.w_alpha_up = (const float*)d_in[3]; c.b_alpha = (const float*)d_in[4]; c.gla_norm = (const float*)d_in[5];
    c.w_gla_o = (const float*)d_in[6]; c.w_att_o = (const float*)d_in[7]; c.w_out = (const float*)d_in[8]; c.ln1_g = (const float*)d_in[9]; c.ln1_b = (const float*)d_in[10]; c.w_router = (const float*)d_in[11];
    c.b_router = (const float*)d_in[12]; c.w_e_gate = (const float*)d_in[13]; c.w_e_up = (const float*)d_in[14]; c.w_e_down = (const float*)d_in[15]; c.ln2_g = (const float*)d_in[16]; c.ln2_b = (const float*)d_in[17];
    c.out = (float*)d_out; c.ws = (unsigned char*)d_ws;
#if MK_MULTI
    for (int s = 0; s < NSTEPS; ++s) { c.lo = s; c.hi = s + 1; hipLaunchKernelGGL(mk_fwd, dim3(grid), dim3(NTHREADS), LDS_BYTES, stream, c); }
#else
    c.lo = 0; c.hi = NSTEPS; hipLaunchKernelGGL(mk_fwd, dim3(grid), dim3(NTHREADS), LDS_BYTES, stream, c);
#endif
}
```

```cpp
#include <hip/hip_runtime.h>
#include <cstdio>
#include <cstdint>

#ifndef MK_MULTI
#define MK_MULTI 0
#endif

#define DI __device__ __forceinline__
#define GAS __attribute__((address_space(1)))
#define LAS __attribute__((address_space(3)))
typedef unsigned short bf16_t;
typedef short bf16x8 __attribute__((ext_vector_type(8)));
typedef short s16x4 __attribute__((ext_vector_type(4)));
typedef float f32x4 __attribute__((ext_vector_type(4)));
typedef float f32x2 __attribute__((ext_vector_type(2)));
typedef unsigned u32x4 __attribute__((ext_vector_type(4)));
typedef unsigned u32x2 __attribute__((ext_vector_type(2)));
typedef int i32x4 __attribute__((ext_vector_type(4)));
typedef int i32x8 __attribute__((ext_vector_type(8)));
#define LDS_WAIT() asm volatile("s_waitcnt lgkmcnt(0)" ::: "memory")
#define VM_WAIT() asm volatile("s_waitcnt vmcnt(0)" ::: "memory")

constexpr int D = 1024, NBATCH = 16, SEQ = 4096, T = NBATCH * SEQ, DEPTH = 4;
constexpr int TH = T / 2;
constexpr int DIN = 9744, NIN = 9984;
constexpr int NEXP = 16, DFF = 1024;
constexpr float LN_EPS = 1e-5f, RMS_EPS = 1e-6f;
constexpr float DN_ALPHA = 1.6817928305074290f;
constexpr float LOG2E = 1.4426950408889634f;
constexpr int NWAVES = 8, NTHREADS = 512;

constexpr size_t MiB = 1u << 20;
constexpr size_t WS_CTL = 0, CTL_ZERO_BYTES = 1 * MiB;
constexpr size_t WS_WIN = 1 * MiB;
constexpr size_t WS_WGO = WS_WIN + (size_t)NIN * D;
constexpr size_t WS_WAO = WS_WGO + 2 * MiB;
constexpr size_t WS_WOUT = WS_WAO + 1 * MiB;
constexpr size_t WS_WGU = WS_WOUT + 2 * MiB;
constexpr size_t WS_WD = WS_WGU + 32 * MiB;
constexpr size_t WS_XB = WS_WD + 16 * MiB;
constexpr size_t WS_XR = WS_XB + 64 * MiB;
constexpr size_t WS_LIST = WS_XR + 128 * MiB;
constexpr size_t WS_GATE = WS_LIST + 4 * MiB;
constexpr size_t WS_INFO = WS_GATE + 1 * MiB;
constexpr size_t WS_HISTG = WS_INFO + 1 * MiB;
constexpr size_t WS_OG = WS_HISTG + 1 * MiB;
constexpr size_t WS_ATTG = WS_OG + 64 * MiB;
constexpr size_t WS_LSE = WS_ATTG + 96 * MiB;
constexpr size_t WS_ATT = WS_LSE + 3 * MiB;
constexpr size_t WS_MIX = WS_ATT + 32 * MiB;
constexpr size_t WS_HA = WS_MIX + 64 * MiB;
constexpr size_t WS_H = WS_HA + 2 * MiB;
constexpr size_t H_QG = 0, H_KG = H_QG + (size_t)TH * 512 * 2, H_VG = H_KG + (size_t)TH * 512 * 2, H_SR = H_VG + (size_t)TH * 1024 * 2,
                 H_QD = H_SR + (size_t)TH * 1024 * 2, H_KD = H_QD + (size_t)TH * 1536 * 2, H_VD = H_KD + (size_t)TH * 1536 * 2, H_GT = H_VD + (size_t)TH * 1536 * 2,
                 H_END = H_GT + (size_t)TH * 2048 * 2;
constexpr size_t WS_HM = WS_H;
constexpr size_t WS_YS = WS_HM + (size_t)(2 * T + 4096) * 1024 * 2;
constexpr size_t WS_REC = WS_H + H_END;
constexpr size_t WS_SLOC = WS_REC + (size_t)2048 * 33792;
constexpr size_t WS_DCUM = WS_SLOC + 16 * MiB;
constexpr size_t WS_END = WS_DCUM + 1 * MiB;
static_assert(WS_YS + (size_t)2 * T * 1024 * 2 <= WS_END, "MoE overlay fits");
constexpr int CW_BAR = 4096;
constexpr int CW_TKT = 24576;
constexpr int CW_CUR = 16384;

constexpr int RING_BYTES = 131072;
constexpr int TAB_OFF = RING_BYTES, MAXU = 18, TAB_BYTES = MAXU * 1024;
constexpr int MISC_OFF = TAB_OFF + TAB_BYTES;
constexpr int LDS_BYTES = MISC_OFF + 256;

DI int rfl(int v) { return __builtin_amdgcn_readfirstlane(v); }
DI int lbid() { int t = blockIdx.x; asm volatile("" : "+s"(t)); return t; }
DI int lgrid() { int t = gridDim.x; asm volatile("" : "+s"(t)); return t; }
DI int vcu_of(int bid, int G) { return (G % 8 == 0) ? (bid % 8) * (G / 8) + bid / 8 : bid; }
DI int ltid() { int t = threadIdx.x; asm volatile("" : "+v"(t)); return t; }
DI float bf2f(unsigned b) { return __uint_as_float(b << 16); }
typedef __bf16 bf16x2_t __attribute__((ext_vector_type(2)));
DI unsigned cvt_pk_bf16(float lo, float hi) { f32x2 v = {lo, hi}; bf16x2_t b = __builtin_convertvector(v, bf16x2_t); return __builtin_bit_cast(unsigned, b); }
DI float clamp8(float v) { return fminf(fmaxf(v, -448.f), 448.f); }
DI unsigned pk4_fp8(float a, float b, float c_, float d) { int w = 0; w = __builtin_amdgcn_cvt_pk_fp8_f32(clamp8(a), clamp8(b), w, false); w = __builtin_amdgcn_cvt_pk_fp8_f32(clamp8(c_), clamp8(d), w, true); return (unsigned)w; }
constexpr float W8_SCALE = 64.0f;
DI float bf_lo(unsigned w) { return __uint_as_float(w << 16); }
DI float bf_hi(unsigned w) { return __uint_as_float(w & 0xffff0000u); }
DI float sigmoidf_(float x) { return __builtin_amdgcn_rcpf(1.0f + __builtin_amdgcn_exp2f(-x * LOG2E)); }

#define XB_TMO      128
#define XB_XCNT(j)  (256  + 64 * (j))
#define XB_XSUB(j)  (1280 + 64 * (j))
#define XB_XGEN(j)  (2304 + 64 * (j))
#define XB_TOP      3328
#define XB_TOPGEN   3392
#define XCD_BAR_WORDS 3456
#define XB_SPIN_CAP (1u << 18)
DI unsigned xb_ld(unsigned* p)              { return __hip_atomic_load(p, __ATOMIC_RELAXED, __HIP_MEMORY_SCOPE_AGENT); }
DI unsigned xb_add(unsigned* p, unsigned v) { return __hip_atomic_fetch_add(p, v, __ATOMIC_RELAXED, __HIP_MEMORY_SCOPE_AGENT); }
DI unsigned xb_xcc_id() { return (unsigned)__builtin_amdgcn_s_getreg((3 << 11) | 20) & 0xFu; }
#define XB_SPIN(cond, bar) do { unsigned _sp = 0; while (cond) { __builtin_amdgcn_s_sleep(1); \
    if ((++_sp & 255u) == 0u) { if (xb_ld(&(bar)[XB_TMO])) break; if (_sp > XB_SPIN_CAP) { atomicAdd(&(bar)[XB_TMO], 1u); break; } } } } while (0)
struct XcdBarrier { unsigned* bar; unsigned x; volatile LAS unsigned* st; };
DI XcdBarrier xcd_barrier_post(unsigned* bar, volatile LAS unsigned* st) {
    XcdBarrier b; b.bar = bar; b.x = xb_xcc_id(); b.st = st;
    if (threadIdx.x == 0) (void)xb_add(&bar[XB_XCNT(b.x)], 1u);
    return b;
}
DI void xcd_barrier_complete(unsigned* bar, unsigned x, unsigned& nloc, unsigned& nx) {
    const unsigned G = gridDim.x * gridDim.y * gridDim.z;
    unsigned sum, cnt, mine, sp = 0u;
    for (;;) {
        sum = 0u; cnt = 0u; mine = 0u;
#pragma unroll
        for (unsigned j = 0; j < 16; ++j) { const unsigned c = xb_ld(&bar[XB_XCNT(j)]); sum += c; cnt += (c > 0u) ? 1u : 0u; mine = (j == x) ? c : mine; }
        if (sum == G) break;
        __builtin_amdgcn_s_sleep(1);
        if ((++sp & 255u) == 0u) { if (xb_ld(&bar[XB_TMO])) break; if (sp > XB_SPIN_CAP) { atomicAdd(&bar[XB_TMO], 1u); break; } }
    }
    nloc = mine > 0u ? mine : 1u; nx = cnt > 0u ? cnt : 1u;
}
DI void xcd_barrier(const XcdBarrier& b) {
    asm volatile("s_waitcnt vmcnt(0)" ::: "memory");
    __syncthreads();
    if (threadIdx.x == 0) {
        unsigned* bar = b.bar;
        __builtin_amdgcn_s_waitcnt(0);
        unsigned nloc = b.st[0], nx = b.st[1];
        if (nloc == 0u) { xcd_barrier_complete(bar, b.x, nloc, nx); b.st[0] = nloc; b.st[1] = nx; }
        const unsigned old = xb_add(&bar[XB_XSUB(b.x)], 1u);
        const unsigned gen = old / nloc;
        if (old + 1u == (gen + 1u) * nloc) {
            __builtin_amdgcn_fence(__ATOMIC_RELEASE, "agent");
            asm volatile("s_waitcnt vmcnt(0)" ::: "memory");
            const unsigned og = xb_add(&bar[XB_TOP], 1u);
            const unsigned tg = og / nx;
            if (og + 1u == (tg + 1u) * nx) xb_add(&bar[XB_TOPGEN], 1u);
            else XB_SPIN(xb_ld(&bar[XB_TOPGEN]) == tg, bar);
            __builtin_amdgcn_fence(__ATOMIC_ACQUIRE, "agent");
            xb_add(&bar[XB_XGEN(b.x)], 1u);
            asm volatile("s_waitcnt vmcnt(0)" ::: "memory");
        } else {
            XB_SPIN(xb_ld(&bar[XB_XGEN(b.x)]) == gen, bar);
            __builtin_amdgcn_fence(__ATOMIC_ACQUIRE, "agent");
            asm volatile("s_waitcnt vmcnt(0)" ::: "memory");
        }
    }
    __syncthreads();
}

struct Ctx {
    const float* x; const int* pos; const float* w_in; const float* w_alpha_up; const float* b_alpha; const float* gla_norm;
    const float* w_gla_o; const float* w_att_o; const float* w_out; const float* ln1_g; const float* ln1_b; const float* w_router; const float* b_router;
    const float* w_e_gate; const float* w_e_up; const float* w_e_down; const float* ln2_g; const float* ln2_b;
    float* out; unsigned char* ws;
    int lo, hi;
};
DI bf16_t* wsb(const Ctx& c, size_t off) { return (bf16_t*)(c.ws + off); }

namespace pg8 {
constexpr int BM = 256, BK = 64, HALF = 128, HTB = HALF * BK * 2, STAGE_BYTES = 8 * HTB, NXCD = 8, WGM = 8;
DI int lds_byte(int r, int c) { const int st = (r >> 4) * 2 + (c >> 5), rr = r & 15, cc = c & 31, ob = rr * 64 + cc * 2; return st * 1024 + (ob ^ (((ob >> 9) & 1) << 5)); }
DI void stage_rc(int b, int& R, int& C) { const int st = b / 1024, sb = b % 1024, swz = sb ^ (((sb >> 9) & 1) << 5); R = (st >> 1) * 16 + swz / 64; C = (st & 1) * 32 + (swz % 64) / 2; }
DI int perm32(int rho) { const int n = rho >> 4, i = rho & 15; return 8 * (i >> 2) + 4 * n + (i & 3); }
struct Unit { int pm, pn, e, nv, ui; };

struct StaticOrder {
    int nM, nN, nwg, G, c, K; const char* A; const char* Bt;
    DI void init(const void* A_, const void* Bt_, int M, int N, int K_, int G_, int c_) { A = (const char*)A_; Bt = (const char*)Bt_; nM = M / BM; nN = N / BM; nwg = nM * nN; G = G_; c = c_; K = K_; }
    DI bool next(int i, Unit& u) const {
        const long L = (long)i * G + c; if (L >= nwg) return false;
        int wgid = (int)L; { const int q = nwg / NXCD, r = nwg % NXCD, xcd = wgid % NXCD, off = wgid / NXCD; wgid = (xcd < r ? xcd * (q + 1) : r * (q + 1) + (xcd - r) * q) + off; }
        const int nig = WGM * nN, gid = wgid / nig, fm = gid * WGM, gsz = (nM - fm) < WGM ? (nM - fm) : WGM;
        u.pm = fm + ((wgid % nig) % gsz); u.pn = (wgid % nig) / gsz; u.e = 0; u.nv = 256; u.ui = i; return true;
    }
    DI const char* a_base(const Unit& u) const { return A + (size_t)u.pm * BM * K * 2; }
    DI const char* b_base(const Unit& u) const { return Bt + (size_t)u.pn * BM * K * 2; }
    DI void a_off(const Unit&, int tid, unsigned (&o)[2][2]) const {
#pragma unroll
        for (int i = 0; i < 2; ++i) { int R, C; stage_rc(tid * 16 + i * 8192, R, C);
#pragma unroll
            for (int h = 0; h < 2; ++h) o[h][i] = (unsigned)((h * HALF + R) * K + C) * 2u; }
    }
};
struct MoeOrder {
    int G, c, ntot, NC, K; const volatile LAS int* pre; const volatile LAS int* cnt; const char* A; const char* Bt; size_t bstride; const volatile LAS int* tab; bool gather;
    DI bool next(int i, Unit& u) const {
        const int L = i * G + c; if (L >= ntot) return false;
        const int rt = L / NC; u.pn = L - rt * NC; u.pm = rt;
        int e = 0;
#pragma unroll
        for (int j = 1; j < 16; ++j) e += (rt >= rfl(pre[j])) ? 1 : 0;
        e = rfl(e); u.e = e; const int rem = rfl(cnt[e]) - 256 * (rt - rfl(pre[e])); u.nv = rem < 256 ? rem : 256; u.ui = i; return true;
    }
    DI const char* a_base(const Unit& u) const { return gather ? A : A + (size_t)u.pm * BM * K * 2; }
    DI const char* b_base(const Unit& u) const { return Bt + (size_t)u.e * bstride + (size_t)u.pn * BM * K * 2; }
    DI void a_off(const Unit& u, int tid, unsigned (&o)[2][2]) const {
#pragma unroll
        for (int i = 0; i < 2; ++i) { int R, C; stage_rc(tid * 16 + i * 8192, R, C);
#pragma unroll
            for (int h = 0; h < 2; ++h) { const int row = gather ? tab[u.ui * 256 + h * HALF + R] : (h * HALF + R); o[h][i] = (unsigned)(row * K + C) * 2u; } }
    }
};

template <class Epi, class Sched, bool F8 = false>
DI void gemm_phase(LAS unsigned char* lds, const int K, const Sched& S, const Epi& E) {
    const int tid = ltid(), wid = rfl(tid >> 6), lane = tid & 63, wr = wid >> 2, wc = wid & 3, fr = lane & 15, fq = lane >> 4;
    const int nt = K / BK;
    unsigned voffB[2];
#pragma unroll
    for (int i = 0; i < 2; ++i) { int R, C; stage_rc(tid * 16 + i * 8192, R, C); const int Rb = Epi::PERM ? ((R & ~31) + perm32(R & 31)) : R; voffB[i] = (unsigned)(Rb * K + C) * 2u; }
    const size_t kstep = (size_t)(BK * 2);
    const size_t hstep = (size_t)HALF * K * 2;
    const unsigned ldsw = (unsigned)wid * 1024u;
    const int aoff = lds_byte(wr * 64 + fr, fq * 8), boff = lds_byte(wc * 32 + fr, fq * 8);
#define PG8_SA(b, h) (((b) * 2 + (h)) * HTB)
#define PG8_SB(b, h) ((4 + (b) * 2 + (h)) * HTB)
#define PG8_STAGE(bufoff, gbase, voff) do { _Pragma("unroll") for (int _i = 0; _i < 2; ++_i) \
        __builtin_amdgcn_global_load_lds((const unsigned*)((const char*)(gbase) + (voff)[_i]), (LAS unsigned*)(lds + (bufoff) + ldsw + _i * 8192), 16, 0, 0); } while (0)
#define PG8_LD8(p) __builtin_shufflevector(*(const LAS i32x4*)(p), *(const LAS i32x4*)((p) + 1024), 0, 1, 2, 3, 4, 5, 6, 7)
#define PG8_LDA(dst, b, h) do { if constexpr (F8) { _Pragma("unroll") for (int m = 0; m < 4; ++m) dst##8[m] = PG8_LD8(lds + PG8_SA(b, h) + aoff + m * 2048); } else { \
        _Pragma("unroll") for (int m = 0; m < 4; ++m) _Pragma("unroll") for (int k = 0; k < 2; ++k) dst[m][k] = *(const LAS bf16x8*)(lds + PG8_SA(b, h) + aoff + m * 2048 + k * 1024); } } while (0)
#define PG8_LDB(dst, b, h) do { if constexpr (F8) { _Pragma("unroll") for (int n = 0; n < 2; ++n) dst##8[n] = PG8_LD8(lds + PG8_SB(b, h) + boff + n * 2048); } else { \
        _Pragma("unroll") for (int n = 0; n < 2; ++n) _Pragma("unroll") for (int k = 0; k < 2; ++k) dst[n][k] = *(const LAS bf16x8*)(lds + PG8_SB(b, h) + boff + n * 2048 + k * 1024); } } while (0)
#define PG8_MMA(ai, bj, At, Bt) do { __builtin_amdgcn_s_setprio(1); if constexpr (F8) { _Pragma("unroll") for (int m = 0; m < 4; ++m) _Pragma("unroll") for (int n = 0; n < 2; ++n) \
        asm volatile("v_mfma_scale_f32_16x16x128_f8f6f4 %0, %1, %2, %0, %3, %4 op_sel_hi:[0,0,0]" : "+v"(acc[ai][bj][m][n]) : "v"(Bt##8[n]), "v"(At##8[m]), "v"(sc_w), "v"(sc_a)); } else { \
        _Pragma("unroll") for (int m = 0; m < 4; ++m) _Pragma("unroll") for (int n = 0; n < 2; ++n) _Pragma("unroll") for (int k = 0; k < 2; ++k) \
        acc[ai][bj][m][n] = __builtin_amdgcn_mfma_f32_16x16x32_bf16(Bt[n][k], At[m][k], acc[ai][bj][m][n], 0, 0, 0); } __builtin_amdgcn_s_setprio(0); } while (0)
#define PG8_MMA0(ai, bj, At, Bt) do { __builtin_amdgcn_s_setprio(1); _Pragma("unroll") for (int m = 0; m < 4; ++m) _Pragma("unroll") for (int n = 0; n < 2; ++n) \
        asm volatile("v_mfma_scale_f32_16x16x128_f8f6f4 %0, %1, %2, 0, %3, %4 op_sel_hi:[0,0,0]" : "=&v"(acc[ai][bj][m][n]) : "v"(Bt##8[n]), "v"(At##8[m]), "v"(sc_w), "v"(sc_a)); __builtin_amdgcn_s_setprio(0); } while (0)
#define PG8_WAIT_V(n) asm volatile("s_waitcnt vmcnt(" #n ")" ::: "memory")
#define PG8_WAIT_L(n) asm volatile("s_waitcnt lgkmcnt(" #n ")" ::: "memory")
#define PG8_BAR __builtin_amdgcn_s_barrier()
#define PG8_SCHED __builtin_amdgcn_sched_barrier(0)
    Unit cur, nxt; int ui = 0;
    if (!S.next(0, cur)) return;
    f32x4 acc[2][2][4][2];
    if constexpr (!F8)
#pragma unroll
    for (int a = 0; a < 2; ++a)
#pragma unroll
        for (int b = 0; b < 2; ++b)
#pragma unroll
            for (int m = 0; m < 4; ++m)
#pragma unroll
                for (int n = 0; n < 2; ++n) acc[a][b][m][n] = (f32x4){0.f, 0.f, 0.f, 0.f};
    int sc_w = 0x79797979, sc_a = 0x7f7f7f7f; asm volatile("" : "+v"(sc_w), "+v"(sc_a));
    bf16x8 At[4][2], B0[2][2], B1[2][2]; i32x8 At8[4], B08[2], B18[2];
    unsigned oA[2][2]; S.a_off(cur, tid, oA);
    const char* cA = S.a_base(cur); const char* cB = S.b_base(cur);
    PG8_STAGE(PG8_SB(0, 0), cB, voffB); PG8_STAGE(PG8_SB(0, 1), cB + hstep, voffB); PG8_STAGE(PG8_SA(0, 0), cA, oA[0]); PG8_STAGE(PG8_SA(0, 1), cA, oA[1]);
    if (wr == 1) PG8_BAR;
    PG8_WAIT_V(2); PG8_BAR;
    PG8_STAGE(PG8_SB(1, 0), cB + kstep, voffB); PG8_STAGE(PG8_SA(1, 0), cA + kstep, oA[0]); PG8_STAGE(PG8_SB(1, 1), cB + hstep + kstep, voffB);
    PG8_WAIT_V(6); PG8_BAR;
    for (;;) {
        const bool has_next = S.next(ui + 1, nxt);
        const char* nA = has_next ? S.a_base(nxt) : cA; const char* nB = has_next ? S.b_base(nxt) : cB;
        for (int t = 0; t < nt; t += 2) {
            const bool last = (t == nt - 2);
            const char* a1 = cA + (size_t)(t + 1) * kstep;
            const char* a2 = last ? nA : cA + (size_t)(t + 2) * kstep; const char* b2 = last ? nB : cB + (size_t)(t + 2) * kstep;
            const char* a3 = a2 + kstep; const char* b3 = b2 + kstep;
            PG8_LDB(B0, 0, 0); PG8_LDB(B1, 0, 1); PG8_SCHED; PG8_LDA(At, 0, 0); PG8_STAGE(PG8_SA(1, 1), a1, oA[1]);
            if (last && has_next) S.a_off(nxt, tid, oA);
            PG8_WAIT_V(8); PG8_WAIT_L(0); PG8_BAR; if (F8 && t == 0) { PG8_MMA0(0, 0, At, B0); PG8_MMA0(0, 1, At, B1); } else { PG8_MMA(0, 0, At, B0); PG8_MMA(0, 1, At, B1); } PG8_BAR; PG8_SCHED;
            PG8_LDA(At, 0, 1); PG8_STAGE(PG8_SB(0, 0), b2, voffB); PG8_STAGE(PG8_SB(0, 1), b2 + hstep, voffB); PG8_STAGE(PG8_SA(0, 0), a2, oA[0]);
            PG8_WAIT_V(8); PG8_WAIT_L(0); PG8_BAR; if (F8 && t == 0) { PG8_MMA0(1, 0, At, B0); PG8_MMA0(1, 1, At, B1); } else { PG8_MMA(1, 0, At, B0); PG8_MMA(1, 1, At, B1); } PG8_BAR; PG8_SCHED;
            PG8_LDB(B0, 1, 0); PG8_LDB(B1, 1, 1); PG8_SCHED; PG8_LDA(At, 1, 0); PG8_STAGE(PG8_SA(0, 1), a2, oA[1]);
            PG8_WAIT_V(8); PG8_WAIT_L(0); PG8_BAR; PG8_MMA(0, 0, At, B0); PG8_MMA(0, 1, At, B1); PG8_BAR; PG8_SCHED;
            PG8_LDA(At, 1, 1); PG8_STAGE(PG8_SB(1, 0), b3, voffB); PG8_STAGE(PG8_SB(1, 1), b3 + hstep, voffB); PG8_STAGE(PG8_SA(1, 0), a3, oA[0]);
            PG8_WAIT_V(8); PG8_WAIT_L(0); PG8_BAR; PG8_MMA(1, 0, At, B0); PG8_MMA(1, 1, At, B1); PG8_BAR; PG8_SCHED;
        }
        if (wr == 0) PG8_BAR;
        if constexpr (F8) asm volatile("s_nop 15\n\ts_nop 15" ::: "memory");
        E(acc, cur, wr, wc, fr, fq);
        if (!has_next) break;
        if constexpr (!F8)
#pragma unroll
        for (int a = 0; a < 2; ++a)
#pragma unroll
            for (int b = 0; b < 2; ++b)
#pragma unroll
                for (int m = 0; m < 4; ++m)
#pragma unroll
                    for (int n = 0; n < 2; ++n) acc[a][b][m][n] = (f32x4){0.f, 0.f, 0.f, 0.f};
        cur = nxt; cA = nA; cB = nB; ++ui;
        if (wr == 1) PG8_BAR;
    }
    PG8_WAIT_V(0);
    PG8_BAR;
#undef PG8_SA
#undef PG8_SB
#undef PG8_STAGE
#undef PG8_LDA
#undef PG8_LDB
#undef PG8_MMA
#undef PG8_MMA0
#undef PG8_LD8
#undef PG8_WAIT_V
#undef PG8_WAIT_L
#undef PG8_BAR
#undef PG8_SCHED
}
}
using pg8::Unit;

DI u32x4 pack8(const f32x4& v0, const f32x4& v1) { u32x4 w; w.x = cvt_pk_bf16(v0[0], v0[1]); w.y = cvt_pk_bf16(v0[2], v0[3]); w.z = cvt_pk_bf16(v1[0], v1[1]); w.w = cvt_pk_bf16(v1[2], v1[3]); return w; }

struct EpiIn {
    static constexpr bool PERM = true;
    bf16_t *qg, *kg, *vg, *sr, *qd, *kd, *vd, *gt; float* ha; const int* pos;
    DI void operator()(const f32x4 (&acc)[2][2][4][2], const Unit& u, int wr, int wc, int fr, int fq) const {
        const int row0 = u.pm * 256 + wr * 64 + fr; const int pn = u.pn;
        if (pn >= 12 && pn < 24) {
            bf16_t* base = pn < 18 ? qd : kd; const int tq = pn < 18 ? pn - 12 : pn - 18; const float sc = pn < 18 ? 0.125f * LOG2E : 1.0f;
            float fre[8];
#pragma unroll
            for (int i = 0; i < 8; ++i) fre[i] = __builtin_amdgcn_exp2f(-(float)(8 * fq + i) * (13.287712379549449f / 32.0f)) * 0.15915494309189535f;
#pragma unroll
            for (int ai = 0; ai < 2; ++ai)
#pragma unroll
                for (int m = 0; m < 4; ++m) {
                    const int r = row0 + ai * 128 + m * 16; const float p = (float)pos[r];
                    bf16_t* rowp = base + (size_t)r * 1536 + (4 * tq + wc) * 64 + 8 * fq;
#pragma unroll
                    for (int n = 0; n < 2; ++n) { f32x4 o1, o2;
#pragma unroll
                        for (int j = 0; j < 4; ++j) {
                            float a = p * fre[n * 4 + j]; a = a - __builtin_floorf(a);
                            const float sn = __builtin_amdgcn_sinf(a), cs = __builtin_amdgcn_cosf(a);
                            const float x1 = acc[ai][0][m][n][j], x2 = acc[ai][1][m][n][j];
                            o1[j] = (x1 * cs - x2 * sn) * sc; o2[j] = (x2 * cs + x1 * sn) * sc;
                        }
                        u32x2 w1, w2; w1.x = cvt_pk_bf16(o1[0], o1[1]); w1.y = cvt_pk_bf16(o1[2], o1[3]); w2.x = cvt_pk_bf16(o2[0], o2[1]); w2.y = cvt_pk_bf16(o2[2], o2[3]);
                        *(GAS u32x2*)(rowp + 4 * n) = w1; *(GAS u32x2*)(rowp + 32 + 4 * n) = w2; }
                    asm volatile("" ::: "memory");
                }
        } else if (pn == 38) {
            if (wc == 0 && fq < 2) {
#pragma unroll
                for (int ai = 0; ai < 2; ++ai)
#pragma unroll
                    for (int m = 0; m < 4; ++m) { float* p = ha + (size_t)(row0 + ai * 128 + m * 16) * 16 + 8 * fq; *(GAS f32x4*)p = acc[ai][0][m][0]; *(GAS f32x4*)(p + 4) = acc[ai][0][m][1]; }
            }
        } else {
            bf16_t* base; int ldc, colt, act = 0; float sc = 1.0f;
            if (pn < 2) { base = qg; ldc = 512; colt = pn * 256; sc = 0.08838834764831845f; }
            else if (pn < 4) { base = kg; ldc = 512; colt = (pn - 2) * 256; }
            else if (pn < 8) { base = vg; ldc = 1024; colt = (pn - 4) * 256; }
            else if (pn < 12) {
#pragma unroll
                for (int ai = 0; ai < 2; ++ai)
#pragma unroll
                    for (int m = 0; m < 4; ++m) { unsigned char* rowp = (unsigned char*)sr + (size_t)(row0 + ai * 128 + m * 16) * 1024 + (pn - 8) * 256 + wc * 32 + 8 * fq;
#pragma unroll
                        for (int bj = 0; bj < 2; ++bj) { const f32x4 v0 = acc[ai][bj][m][0], v1 = acc[ai][bj][m][1]; u32x2 o;
                            o.x = pk4_fp8(v0[0] * sigmoidf_(v0[0]), v0[1] * sigmoidf_(v0[1]), v0[2] * sigmoidf_(v0[2]), v0[3] * sigmoidf_(v0[3]));
                            o.y = pk4_fp8(v1[0] * sigmoidf_(v1[0]), v1[1] * sigmoidf_(v1[1]), v1[2] * sigmoidf_(v1[2]), v1[3] * sigmoidf_(v1[3]));
                            *(GAS u32x2*)(rowp + bj * 128) = o; } }
                return; }
            else if (pn < 30) { base = vd; ldc = 1536; colt = (pn - 24) * 256; }
            else {
#pragma unroll
                for (int ai = 0; ai < 2; ++ai)
#pragma unroll
                    for (int m = 0; m < 4; ++m) { unsigned char* rowp = (unsigned char*)gt + (size_t)(row0 + ai * 128 + m * 16) * 2048 + (pn - 30) * 256 + wc * 32 + 8 * fq;
#pragma unroll
                        for (int bj = 0; bj < 2; ++bj) { unsigned w[2];
#pragma unroll
                            for (int n = 0; n < 2; ++n) { const f32x4 v = acc[ai][bj][m][n];
                                w[n] = (unsigned)(sigmoidf_(v[0]) * 255.0f + 0.5f) | ((unsigned)(sigmoidf_(v[1]) * 255.0f + 0.5f) << 8) | ((unsigned)(sigmoidf_(v[2]) * 255.0f + 0.5f) << 16) | ((unsigned)(sigmoidf_(v[3]) * 255.0f + 0.5f) << 24); }
                            *(GAS u32x2*)(rowp + bj * 128) = (u32x2){w[0], w[1]}; } }
                return; }
#pragma unroll
            for (int ai = 0; ai < 2; ++ai)
#pragma unroll
                for (int m = 0; m < 4; ++m) { bf16_t* rowp = base + (size_t)(row0 + ai * 128 + m * 16) * ldc + colt + wc * 32 + 8 * fq;
#pragma unroll
                    for (int bj = 0; bj < 2; ++bj) { f32x4 v0 = acc[ai][bj][m][0] * sc, v1 = acc[ai][bj][m][1] * sc;
                        if (act) {
#pragma unroll
                            for (int j = 0; j < 4; ++j) { const float s0 = sigmoidf_(v0[j]), s1 = sigmoidf_(v1[j]); v0[j] = act == 1 ? v0[j] * s0 : s0; v1[j] = act == 1 ? v1[j] * s1 : s1; } }
                        *(GAS u32x4*)(rowp + bj * 128) = pack8(v0, v1); } }
        }
    }
};
template <bool ADD> struct EpiGate {
    static constexpr bool PERM = true;
    bf16_t* mix; const unsigned char* gt; unsigned char* mix8;
    DI void operator()(const f32x4 (&acc)[2][2][4][2], const Unit& u, int wr, int wc, int fr, int fq) const {
        const int row0 = u.pm * 256 + wr * 64 + fr, col0 = u.pn * 256 + wc * 32 + 8 * fq; constexpr float k = 1.0f / 255.0f;
#pragma unroll
        for (int ai = 0; ai < 2; ++ai)
#pragma unroll
            for (int m = 0; m < 4; ++m) { const size_t r = (size_t)(row0 + ai * 128 + m * 16);
#pragma unroll
                for (int bj = 0; bj < 2; ++bj) {
                    const u32x2 g = *(const GAS u32x2*)(gt + r * 2048 + col0 + bj * 128);
                    f32x4 v0 = acc[ai][bj][m][0], v1 = acc[ai][bj][m][1];
                    v0[0] *= (float)((g.x >> 0) & 0xffu) * k; v0[1] *= (float)((g.x >> 8) & 0xffu) * k; v0[2] *= (float)((g.x >> 16) & 0xffu) * k; v0[3] *= (float)((g.x >> 24) & 0xffu) * k;
                    v1[0] *= (float)((g.y >> 0) & 0xffu) * k; v1[1] *= (float)((g.y >> 8) & 0xffu) * k; v1[2] *= (float)((g.y >> 16) & 0xffu) * k; v1[3] *= (float)((g.y >> 24) & 0xffu) * k;
                    bf16_t* mp = mix + r * 1024 + col0 + bj * 128;
                    if (ADD) { const u32x4 o = *(const GAS u32x4*)mp; v0[0] += bf_lo(o.x); v0[1] += bf_hi(o.x); v0[2] += bf_lo(o.y); v0[3] += bf_hi(o.y); v1[0] += bf_lo(o.z); v1[1] += bf_hi(o.z); v1[2] += bf_lo(o.w); v1[3] += bf_hi(o.w);
                        u32x2 o8; o8.x = pk4_fp8(v0[0], v0[1], v0[2], v0[3]); o8.y = pk4_fp8(v1[0], v1[1], v1[2], v1[3]); *(GAS u32x2*)(mix8 + r * 1024 + col0 + bj * 128) = o8; }
                    else *(GAS u32x4*)mp = pack8(v0, v1); } }
    }
};
struct EpiRes {
    static constexpr bool PERM = true;
    const float* x32; bf16_t* xr;
    DI void operator()(const f32x4 (&acc)[2][2][4][2], const Unit& u, int wr, int wc, int fr, int fq) const {
        const int row0 = u.pm * 256 + wr * 64 + fr, col0 = u.pn * 256 + wc * 32 + 8 * fq;
#pragma unroll
        for (int ai = 0; ai < 2; ++ai)
#pragma unroll
            for (int m = 0; m < 4; ++m) { const size_t off = (size_t)(row0 + ai * 128 + m * 16) * 1024 + col0;
#pragma unroll
                for (int bj = 0; bj < 2; ++bj) { f32x4 a0, a1;
                    if (x32) { a0 = *(const GAS f32x4*)(x32 + off + bj * 128); a1 = *(const GAS f32x4*)(x32 + off + bj * 128 + 4); }
                    else { const u32x4 o = *(const GAS u32x4*)(xr + off + bj * 128); a0 = (f32x4){bf_lo(o.x), bf_hi(o.x), bf_lo(o.y), bf_hi(o.y)}; a1 = (f32x4){bf_lo(o.z), bf_hi(o.z), bf_lo(o.w), bf_hi(o.w)}; }
                    *(GAS u32x4*)(xr + off + bj * 128) = pack8(a0 * DN_ALPHA + acc[ai][bj][m][0], a1 * DN_ALPHA + acc[ai][bj][m][1]); }
                asm volatile("" ::: "memory"); }
    }
};
struct EpiM1 {
    static constexpr bool PERM = true;
    unsigned char* hm;
    DI void operator()(const f32x4 (&acc)[2][2][4][2], const Unit& u, int wr, int wc, int fr, int fq) const {
        const int row0 = u.pm * 256 + wr * 64 + fr, col0 = u.pn * 128 + wc * 32 + 8 * fq;
#pragma unroll
        for (int ai = 0; ai < 2; ++ai)
#pragma unroll
            for (int m = 0; m < 4; ++m) { f32x4 v0, v1;
#pragma unroll
                for (int j = 0; j < 4; ++j) { const float g0 = acc[ai][0][m][0][j], g1 = acc[ai][0][m][1][j]; v0[j] = g0 * sigmoidf_(g0) * acc[ai][1][m][0][j]; v1[j] = g1 * sigmoidf_(g1) * acc[ai][1][m][1][j]; }
                u32x2 o; o.x = pk4_fp8(v0[0], v0[1], v0[2], v0[3]); o.y = pk4_fp8(v1[0], v1[1], v1[2], v1[3]);
                *(GAS u32x2*)(hm + (size_t)(row0 + ai * 128 + m * 16) * 1024 + col0) = o; }
    }
};
struct EpiM2 {
    static constexpr bool PERM = true;
    unsigned char* ys; const int* list; const volatile LAS int* pre;
    DI void operator()(const f32x4 (&acc)[2][2][4][2], const Unit& u, int wr, int wc, int fr, int fq) const {
        const int lrow0 = wr * 64 + fr, col0 = u.pn * 256 + wc * 32 + 8 * fq; const int lt = u.pm - rfl(pre[u.e]);
        const int* lp = list + (size_t)u.e * T + 256 * lt;
#pragma unroll
        for (int ai = 0; ai < 2; ++ai)
#pragma unroll
            for (int m = 0; m < 4; ++m) { const int r = lrow0 + ai * 128 + m * 16;
                if (r < u.nv) { const int slot = lp[r]; unsigned char* yp = ys + (size_t)slot * 1024 + col0;
#pragma unroll
                    for (int bj = 0; bj < 2; ++bj) { const f32x4 v0 = acc[ai][bj][m][0], v1 = acc[ai][bj][m][1]; u32x2 o; o.x = pk4_fp8(v0[0], v0[1], v0[2], v0[3]); o.y = pk4_fp8(v1[0], v1[1], v1[2], v1[3]); *(GAS u32x2*)(yp + bj * 128) = o; } } }
    }
};

struct WItem { const float* W; unsigned char* WT; int N, K, drow, c0, nv, kb; };
DI WItem w_decode(const Ctx& c, int l, int it) {
    constexpr int I_IN = (NIN / 32) * 16, I_GO = 512, I_AO = 256, I_OUT = 512, I_EXP = 16 * 512;
    WItem w; int r = it;
    if (r < I_IN) {
        const int nbg = r >> 4, kb = r & 15, n0 = 32 * nbg, tile = n0 >> 8, p = n0 & 255; int c0, nv = 32;
        if (tile < 12) c0 = n0;
        else if (tile < 24) { const int base = tile < 18 ? 3088 : 4624, tq = tile < 18 ? tile - 12 : tile - 18; c0 = base + (4 * tq + ((p & 127) >> 5)) * 64 + (p >= 128 ? 32 : 0); }
        else if (tile < 30) c0 = 6160 + (n0 - 24 * 256);
        else if (tile < 38) c0 = 7696 + (n0 - 30 * 256);
        else { c0 = 3072; nv = (p == 0) ? 16 : 0; }
        w.W = c.w_in + (size_t)l * D * DIN; w.N = DIN; w.WT = c.ws + WS_WIN; w.K = D; w.drow = n0; w.c0 = c0; w.nv = nv; w.kb = kb; return w; }
    r -= I_IN;
    if (r < I_GO) { w.W = c.w_gla_o + (size_t)l * D * D; w.N = D; w.WT = c.ws + WS_WGO; w.K = D; w.drow = 32 * (r >> 4); w.c0 = w.drow; w.nv = 32; w.kb = r & 15; return w; }
    r -= I_GO;
    if (r < I_AO) { w.W = c.w_att_o + (size_t)l * 512 * D; w.N = D; w.WT = c.ws + WS_WAO; w.K = 512; w.drow = 32 * (r >> 3); w.c0 = w.drow; w.nv = 32; w.kb = r & 7; return w; }
    r -= I_AO;
    if (r < I_OUT) { w.W = c.w_out + (size_t)l * D * D; w.N = D; w.WT = c.ws + WS_WOUT; w.K = D; w.drow = 32 * (r >> 4); w.c0 = w.drow; w.nv = 32; w.kb = r & 15; return w; }
    r -= I_OUT;
    const int which = r / I_EXP; r -= which * I_EXP; const int e = r >> 9, q = r & 511, nbg = q >> 4; const size_t eoff = (size_t)(l * NEXP + e) * D * DFF;
    w.N = DFF; w.K = D; w.c0 = 32 * nbg; w.nv = 32; w.kb = q & 15;
    if (which == 0) { w.W = c.w_e_gate + eoff; w.WT = c.ws + WS_WGU + (size_t)e * 2048 * 1024; w.drow = 256 * (nbg >> 2) + 32 * (nbg & 3); }
    else if (which == 1) { w.W = c.w_e_up + eoff; w.WT = c.ws + WS_WGU + (size_t)e * 2048 * 1024; w.drow = 256 * (nbg >> 2) + 128 + 32 * (nbg & 3); }
    else { w.W = c.w_e_down + eoff; w.N = D; w.K = DFF; w.WT = c.ws + WS_WD + (size_t)e * 1024 * 1024; w.drow = 32 * nbg; }
    return w;
}
DI void w_load(const WItem& w, int lane, float (&v)[32]) {
    const int cc = lane & 31, ccl = cc < w.nv ? cc : 0; const GAS float* wp = (const GAS float*)w.W + (size_t)(64 * w.kb + (lane >> 5)) * w.N + w.c0 + ccl;
#pragma unroll
    for (int i = 0; i < 32; ++i) v[i] = wp[(size_t)(2 * i) * w.N];
}
DI void w_store(const WItem& w, int lane, const float (&v)[32], LAS float* scr) {
    const int cc = lane & 31, k0 = 64 * w.kb;
#pragma unroll
    for (int i = 0; i < 32; ++i) scr[(2 * i + (lane >> 5)) * 33 + cc] = (cc < w.nv) ? v[i] : 0.f;
    LDS_WAIT(); asm volatile("" ::: "memory");
    const int c = lane & 7;
#pragma unroll
    for (int j = 0; j < 4; ++j) { const int n = (lane >> 3) + 8 * j; const LAS float* s = scr + (8 * c) * 33 + n;
        u32x2 o; o.x = pk4_fp8(s[0 * 33] * W8_SCALE, s[1 * 33] * W8_SCALE, s[2 * 33] * W8_SCALE, s[3 * 33] * W8_SCALE); o.y = pk4_fp8(s[4 * 33] * W8_SCALE, s[5 * 33] * W8_SCALE, s[6 * 33] * W8_SCALE, s[7 * 33] * W8_SCALE);
        *(GAS u32x2*)(w.WT + (size_t)(w.drow + n) * w.K + k0 + 8 * c) = o; }
    LDS_WAIT(); asm volatile("" ::: "memory");
}
DI void phase_w(LAS unsigned char* lds, const Ctx& c, int l, int G) {
    const int tid = ltid(), lane = tid & 63, wave = rfl(tid >> 6);
    LAS float* scr = (LAS float*)(lds + wave * 16384);
    const int gw = lbid() * NWAVES + wave, NGW = G * NWAVES;
    constexpr int NITEMS = (NIN / 32) * 16 + 512 + 256 + 512 + 3 * 16 * 512;
    float va[32], vb[32]; WItem wa, wb;
    int it = gw;
    if (it < NITEMS) { wa = w_decode(c, l, it); w_load(wa, lane, va); }
    while (it < NITEMS) {
        const bool hb = it + NGW < NITEMS; if (hb) { wb = w_decode(c, l, it + NGW); w_load(wb, lane, vb); }
        w_store(wa, lane, va, scr);
        it += NGW; if (it >= NITEMS) break;
        const bool ha = it + NGW < NITEMS; if (ha) { wa = w_decode(c, l, it + NGW); w_load(wa, lane, va); }
        w_store(wb, lane, vb, scr);
        it += NGW;
    }
    if (l == 0) {
        const size_t n8 = (size_t)T * D / 8; unsigned char* xb = c.ws + WS_XB;
        for (size_t i = (size_t)lbid() * NTHREADS + tid; i < n8; i += (size_t)G * NTHREADS) { const f32x4 a = *(const GAS f32x4*)(c.x + i * 8), b = *(const GAS f32x4*)(c.x + i * 8 + 4);
            u32x2 o; o.x = pk4_fp8(a[0], a[1], a[2], a[3]); o.y = pk4_fp8(b[0], b[1], b[2], b[3]); *(GAS u32x2*)(xb + i * 8) = o; }
    }
}

DI s16x4 tr16(const LAS void* p) { return __builtin_bit_cast(s16x4, __builtin_amdgcn_ds_read_tr16_b64_v4i16((LAS s16x4*)p)); }
DI bf16x8 cat8(s16x4 lo, s16x4 hi) { return __builtin_shufflevector(lo, hi, 0, 1, 2, 3, 4, 5, 6, 7); }
#define MFMA16(a, b, c) __builtin_amdgcn_mfma_f32_16x16x32_bf16((a), (b), (c), 0, 0, 0)

constexpr int REC_BYTES = 33792, REC_KS = 16384, REC_DEC = 32768, OI_BYTES = 16384;
constexpr int GP_QT = 0, GP_KT = 17408, GP_VS = 34816, GP_ATT = 68608, GP_WUP = 77824, GP_BAL = 86016;
DI float exp_(float x) { return __builtin_amdgcn_exp2f(x * LOG2E); }
DI void unpack8(const u32x4& q, float (&v)[16], int o) { v[o] = bf_lo(q.x); v[o + 1] = bf_hi(q.x); v[o + 2] = bf_lo(q.y); v[o + 3] = bf_hi(q.y); v[o + 4] = bf_lo(q.z); v[o + 5] = bf_hi(q.z); v[o + 6] = bf_lo(q.w); v[o + 7] = bf_hi(q.w); }
DI u32x4 packf8(const float (&v)[16], int o) { u32x4 p; p.x = cvt_pk_bf16(v[o], v[o + 1]); p.y = cvt_pk_bf16(v[o + 2], v[o + 3]); p.z = cvt_pk_bf16(v[o + 4], v[o + 5]); p.w = cvt_pk_bf16(v[o + 6], v[o + 7]); return p; }
DI void gla_p_unit(LAS unsigned char* lds, const Ctx& c, int l, int bl, int h, int n, int& h_loaded) {
    const int tid = ltid(), lane = tid & 63, w = rfl(tid >> 6), fr = lane & 15, fq = lane >> 4;
    const size_t tok0 = (size_t)bl * SEQ + n * 64;
    const bf16_t* QG = wsb(c, WS_H + H_QG) + tok0 * 512 + h * 128;
    const bf16_t* KG = wsb(c, WS_H + H_KG) + tok0 * 512 + h * 128;
    const bf16_t* VG = wsb(c, WS_H + H_VG) + tok0 * 1024 + h * 256;
    const float* HA = (const float*)(c.ws + WS_HA) + tok0 * 16;
    const int unit = (bl * 4 + h) * 64 + n;
    unsigned char* rec = c.ws + WS_REC + (size_t)unit * REC_BYTES;
    unsigned char* oi = c.ws + WS_MIX + (size_t)unit * OI_BYTES;
    LAS bf16_t* QT = (LAS bf16_t*)(lds + GP_QT); LAS bf16_t* KT = (LAS bf16_t*)(lds + GP_KT); LAS bf16_t* VS = (LAS bf16_t*)(lds + GP_VS); LAS bf16_t* AT = (LAS bf16_t*)(lds + GP_ATT);
    LAS float* WUP = (LAS float*)(lds + GP_WUP); LAS float* BAL = (LAS float*)(lds + GP_BAL);
    __syncthreads();
    if (h_loaded != h) { for (int i = tid; i < 16 * 128; i += NTHREADS) WUP[i] = c.w_alpha_up[(size_t)l * 16 * 512 + (i >> 7) * 512 + h * 128 + (i & 127)];
        if (tid < 128) BAL[tid] = c.b_alpha[l * 512 + h * 128 + tid]; h_loaded = h; __syncthreads(); }
    {
        const int row = lane;
        f32x4 a4[4];
#pragma unroll
        for (int j = 0; j < 4; ++j) a4[j] = *(const GAS f32x4*)(HA + (size_t)row * 16 + 4 * j);
        const u32x4 q0 = *(const GAS u32x4*)(QG + (size_t)row * 512 + 16 * w), q1 = *(const GAS u32x4*)(QG + (size_t)row * 512 + 16 * w + 8);
        const u32x4 k0 = *(const GAS u32x4*)(KG + (size_t)row * 512 + 16 * w), k1 = *(const GAS u32x4*)(KG + (size_t)row * 512 + 16 * w + 8);
#pragma unroll
        for (int c2 = 0; c2 < 4; ++c2) { const int idx = tid + NTHREADS * c2, r = idx >> 5, ch = idx & 31; *(LAS u32x4*)(VS + r * 264 + ch * 8) = *(const GAS u32x4*)(VG + (size_t)r * 1024 + ch * 8); }
        float la[16];
#pragma unroll
        for (int cc = 0; cc < 16; ++cc) la[cc] = BAL[16 * w + cc];
#pragma unroll
        for (int j = 0; j < 16; ++j) { const float aj = a4[j >> 2][j & 3];
#pragma unroll
            for (int c4 = 0; c4 < 4; ++c4) { const f32x4 wv = *(const LAS f32x4*)(WUP + j * 128 + 16 * w + 4 * c4); la[4 * c4] += aj * wv[0]; la[4 * c4 + 1] += aj * wv[1]; la[4 * c4 + 2] += aj * wv[2]; la[4 * c4 + 3] += aj * wv[3]; } }
#pragma unroll
        for (int cc = 0; cc < 16; ++cc) { const float z = la[cc]; la[cc] = -(fmaxf(-z, 0.f) + __builtin_amdgcn_logf(1.0f + exp_(-fabsf(z))) * 0.6931471805599453f) * (1.0f / 16.0f); }
#pragma unroll
        for (int dlt = 1; dlt < 64; dlt <<= 1)
#pragma unroll
            for (int cc = 0; cc < 16; ++cc) { const float t = __shfl_up(la[cc], dlt); if (lane >= dlt) la[cc] += t; }
        float qv[16], kv[16];
        unpack8(q0, qv, 0); unpack8(q1, qv, 8); unpack8(k0, kv, 0); unpack8(k1, kv, 8);
        float dc[16];
#pragma unroll
        for (int cc = 0; cc < 16; ++cc) { const float b = la[cc]; const float bend = __shfl(b, 63); const float eb = exp_(b); dc[cc] = eb; qv[cc] *= eb; la[cc] = kv[cc] * exp_(bend - b); kv[cc] *= exp_(-b); }
        if (lane == 63) {
#pragma unroll
            for (int c4 = 0; c4 < 4; ++c4) *(GAS f32x4*)(rec + REC_DEC + (16 * w + 4 * c4) * 4) = (f32x4){dc[4 * c4], dc[4 * c4 + 1], dc[4 * c4 + 2], dc[4 * c4 + 3]}; }
        const u32x4 qa = packf8(qv, 0), qb = packf8(qv, 8), ka = packf8(kv, 0), kb = packf8(kv, 8), sa = packf8(la, 0), sb = packf8(la, 8);
        *(LAS u32x4*)(QT + row * 136 + 16 * w) = qa; *(LAS u32x4*)(QT + row * 136 + 16 * w + 8) = qb;
        *(LAS u32x4*)(KT + row * 136 + 16 * w) = ka; *(LAS u32x4*)(KT + row * 136 + 16 * w + 8) = kb;
        *(GAS u32x4*)(rec + row * 256 + (((2 * w) ^ (row & 15)) << 4)) = qa; *(GAS u32x4*)(rec + row * 256 + (((2 * w + 1) ^ (row & 15)) << 4)) = qb;
        *(GAS u32x4*)(rec + REC_KS + row * 256 + (((2 * w) ^ (2 * (row & 7))) << 4)) = sa; *(GAS u32x4*)(rec + REC_KS + row * 256 + (((2 * w + 1) ^ (2 * (row & 7))) << 4)) = sb;
    }
    __syncthreads();
#pragma unroll
    for (int rep = 0; rep < 2; ++rep) {
        const int tt = w + 8 * rep, jt = tt >> 2, it = tt & 3;
        f32x4 a = (f32x4){0.f, 0.f, 0.f, 0.f};
        if (jt <= it) {
#pragma unroll
            for (int k4 = 0; k4 < 4; ++k4) { const bf16x8 af = *(const LAS bf16x8*)(KT + (16 * jt + fr) * 136 + 32 * k4 + 8 * fq), bfr = *(const LAS bf16x8*)(QT + (16 * it + fr) * 136 + 32 * k4 + 8 * fq); a = MFMA16(af, bfr, a); }
        }
        const int i = 16 * it + fr, j0 = 16 * jt + 4 * fq;
        u32x2 o; o.x = cvt_pk_bf16(j0 <= i ? a[0] : 0.f, j0 + 1 <= i ? a[1] : 0.f); o.y = cvt_pk_bf16(j0 + 2 <= i ? a[2] : 0.f, j0 + 3 <= i ? a[3] : 0.f);
        *(LAS u32x2*)(AT + i * 72 + j0) = o;
    }
    __syncthreads();
    {
        const int dv0 = 32 * w;
        bf16x8 vb[2][2];
#pragma unroll
        for (int k2 = 0; k2 < 2; ++k2)
#pragma unroll
            for (int dt = 0; dt < 2; ++dt) { const LAS bf16_t* p = VS + (32 * k2 + 8 * fq + (fr >> 2)) * 264 + dv0 + 16 * dt + (fr & 3) * 4; vb[k2][dt] = cat8(tr16(p), tr16(p + 4 * 264)); }
#pragma unroll
        for (int tt = 0; tt < 4; ++tt) {
            const bf16x8 a0 = *(const LAS bf16x8*)(AT + (16 * tt + fr) * 72 + 8 * fq), a1 = *(const LAS bf16x8*)(AT + (16 * tt + fr) * 72 + 32 + 8 * fq);
#pragma unroll
            for (int dt = 0; dt < 2; ++dt) { f32x4 z = (f32x4){0.f, 0.f, 0.f, 0.f}; z = MFMA16(vb[0][dt], a0, z); z = MFMA16(vb[1][dt], a1, z);
                *(GAS unsigned*)(oi + ((w * 8 + tt * 2 + dt) * 64 + lane) * 4) = pk4_fp8(z[0], z[1], z[2], z[3]); }
        }
    }
}
constexpr int GSEG = 16, NSEG = 64 / GSEG;
constexpr int GL_STAGE = 50176, GL_DEC = 16384, GL_VS = 17408;
DI void gla_l_chain(LAS unsigned char* lds, const Ctx& c, int bl, int h, int seg) {
    const int tid = ltid(), lane = tid & 63, w = rfl(tid >> 6), fr = lane & 15, fq = lane >> 4;
    const size_t t0 = (size_t)bl * SEQ + (size_t)seg * (GSEG * 64);
    const bf16_t* VG = wsb(c, WS_H + H_VG) + t0 * 1024 + h * 256;
    const unsigned char* rec0 = c.ws + WS_REC + (size_t)((bl * 4 + h) * 64 + seg * GSEG) * REC_BYTES;
    const int dv0 = 32 * w; const unsigned lds_u = (unsigned)(uintptr_t)lds;
    f32x4 S[8][2], Dc[8];
#pragma unroll
    for (int a = 0; a < 8; ++a) { S[a][0] = (f32x4){0.f, 0.f, 0.f, 0.f}; S[a][1] = (f32x4){0.f, 0.f, 0.f, 0.f}; Dc[a] = (f32x4){1.f, 1.f, 1.f, 1.f}; }
#define GL_DMA(gp, ldsoff) do { unsigned _sv; const unsigned _m = (unsigned)__builtin_amdgcn_readfirstlane((int)(ldsoff)); \
        asm volatile("s_mov_b32 %0, m0\n\ts_mov_b32 m0, %2\n\ts_nop 0\n\tglobal_load_lds_dwordx4 %1, off\n\ts_mov_b32 m0, %0" : "=&s"(_sv) : "v"(gp), "s"(_m) : "memory"); } while (0)
#define GL_PREFETCH(nn, st) do { const unsigned char* _r = rec0 + (size_t)(nn) * REC_BYTES + REC_KS; const unsigned _s = lds_u + (unsigned)(st) * GL_STAGE; \
        _Pragma("unroll") for (int _p = 0; _p < 2; ++_p) GL_DMA((const GAS unsigned char*)(_r + (w * 2 + _p) * 1024 + lane * 16), _s + (w * 2 + _p) * 1024); \
        if (w == 0) GL_DMA((const GAS unsigned char*)(_r + 16384 + lane * 16), _s + GL_DEC); \
        _Pragma("unroll") for (int _p = 0; _p < 4; ++_p) { const int _row = 2 * (w * 4 + _p) + (lane >> 5); \
            GL_DMA((const GAS bf16_t*)(VG + (size_t)((nn) * 64 + _row) * 1024 + (((lane & 31) ^ (2 * (_row & 3))) << 3)), _s + GL_VS + (w * 4 + _p) * 1024); } } while (0)
    __syncthreads();
    GL_PREFETCH(0, 0);
    for (int n = 0; n < GSEG; ++n) {
        const int st = n & 1; LAS unsigned char* sb_ = lds + st * GL_STAGE;
        LAS bf16_t* KS = (LAS bf16_t*)sb_; LAS float* DEC = (LAS float*)(sb_ + GL_DEC); LAS bf16_t* VS = (LAS bf16_t*)(sb_ + GL_VS);
        VM_WAIT(); asm volatile("s_waitcnt lgkmcnt(0)" ::: "memory"); __builtin_amdgcn_s_barrier(); asm volatile("" ::: "memory");
        if (n + 1 < GSEG) GL_PREFETCH(n + 1, st ^ 1);
        bf16x8 vb[2][2];
#pragma unroll
        for (int k2 = 0; k2 < 2; ++k2)
#pragma unroll
            for (int dt = 0; dt < 2; ++dt) { const int r0 = 32 * k2 + 8 * fq + (fr >> 2);
                const LAS bf16_t* p = VS + r0 * 256 + ((((dv0 + 16 * dt) >> 3) ^ (2 * (r0 & 3))) << 3) + (fr & 3) * 4; vb[k2][dt] = cat8(tr16(p), tr16(p + 4 * 256)); }
#pragma unroll
        for (int k8 = 0; k8 < 8; ++k8) {
            const f32x4 dc = *(const LAS f32x4*)(DEC + 16 * k8 + 4 * fq);
            S[k8][0] *= dc; S[k8][1] *= dc; Dc[k8] *= dc;
#pragma unroll
            for (int k2 = 0; k2 < 2; ++k2) { const int r0 = 32 * k2 + 8 * fq + (fr >> 2);
                const LAS bf16_t* p0 = KS + r0 * 128 + (((2 * k8) ^ (2 * (r0 & 7))) << 3) + (fr & 3) * 4; const LAS bf16_t* p1 = KS + (r0 + 4) * 128 + (((2 * k8) ^ (2 * ((r0 + 4) & 7))) << 3) + (fr & 3) * 4;
                const bf16x8 af = cat8(tr16(p0), tr16(p1));
                S[k8][0] = MFMA16(af, vb[k2][0], S[k8][0]); S[k8][1] = MFMA16(af, vb[k2][1], S[k8][1]); }
        }
    }
#undef GL_PREFETCH
#undef GL_DMA
    const int cj = (bl * 4 + h) * NSEG + seg;
    GAS f32x4* sl = (GAS f32x4*)(c.ws + WS_SLOC) + ((size_t)(cj * 8 + w) * 16) * 64 + lane;
#pragma unroll
    for (int a = 0; a < 8; ++a) { sl[(a * 2) * 64] = S[a][0]; sl[(a * 2 + 1) * 64] = S[a][1]; }
    if (w == 0) { GAS f32x4* dq = (GAS f32x4*)(c.ws + WS_DCUM) + (size_t)cj * 8 * 64 + lane;
#pragma unroll
        for (int a = 0; a < 8; ++a) dq[a * 64] = Dc[a]; }
    VM_WAIT(); __syncthreads();
}
constexpr int GS_STAGE = 66560, GS_KS = 16384, GS_DEC = 32768, GS_VS = 33792, GS_SS = 2 * GS_STAGE;
DI void gla_s_chain(LAS unsigned char* lds, const Ctx& c, int l, int bl, int h, int seg) {
    const int tid = ltid(), lane = tid & 63, w = rfl(tid >> 6), fr = lane & 15, fq = lane >> 4;
    const size_t t0 = (size_t)bl * SEQ + (size_t)seg * (GSEG * 64);
    const bf16_t* VG = wsb(c, WS_H + H_VG) + t0 * 1024 + h * 256;
    const unsigned char* SR = c.ws + WS_H + H_SR + t0 * 1024 + h * 256;
    unsigned char* OG = c.ws + WS_OG + t0 * 1024 + h * 256;
    const unsigned char* rec0 = c.ws + WS_REC + (size_t)((bl * 4 + h) * 64 + seg * GSEG) * REC_BYTES;
    const unsigned char* oi0 = c.ws + WS_MIX + (size_t)((bl * 4 + h) * 64 + seg * GSEG) * OI_BYTES;
    LAS float* SS = (LAS float*)(lds + GS_SS);
    const int dv0 = 32 * w;
    f32x4 gnv[2]; gnv[0] = *(const GAS f32x4*)(c.gla_norm + l * 1024 + h * 256 + dv0 + 4 * fq); gnv[1] = *(const GAS f32x4*)(c.gla_norm + l * 1024 + h * 256 + dv0 + 16 + 4 * fq);
    f32x4 S[8][2];
#pragma unroll
    for (int a = 0; a < 8; ++a) { S[a][0] = (f32x4){0.f, 0.f, 0.f, 0.f}; S[a][1] = (f32x4){0.f, 0.f, 0.f, 0.f}; }
    for (int j = 0; j < seg; ++j) {
        const int cj = (bl * 4 + h) * NSEG + j;
        const GAS f32x4* sl = (const GAS f32x4*)(c.ws + WS_SLOC) + ((size_t)(cj * 8 + w) * 16) * 64 + lane; const GAS f32x4* dq = (const GAS f32x4*)(c.ws + WS_DCUM) + (size_t)cj * 8 * 64 + lane;
#pragma unroll
        for (int a = 0; a < 8; ++a) { const f32x4 dcv = dq[a * 64]; S[a][0] = S[a][0] * dcv + sl[(a * 2) * 64]; S[a][1] = S[a][1] * dcv + sl[(a * 2 + 1) * 64]; }
    }
#define GS_DMA(gp, ldsoff) do { unsigned _sv; const unsigned _m = (unsigned)__builtin_amdgcn_readfirstlane((int)(ldsoff)); \
        asm volatile("s_mov_b32 %0, m0\n\ts_mov_b32 m0, %2\n\ts_nop 0\n\tglobal_load_lds_dwordx4 %1, off\n\ts_mov_b32 m0, %0" : "=&s"(_sv) : "v"(gp), "s"(_m) : "memory"); } while (0)
#define GS_PREFETCH(nn, st) do { const unsigned char* _r = rec0 + (size_t)(nn) * REC_BYTES; const unsigned _s = lds_u + (unsigned)(st) * GS_STAGE; \
        _Pragma("unroll") for (int _p = 0; _p < 4; ++_p) GS_DMA((const GAS unsigned char*)(_r + (w * 4 + _p) * 1024 + lane * 16), _s + (w * 4 + _p) * 1024); \
        if (w == 0) GS_DMA((const GAS unsigned char*)(_r + 32768 + lane * 16), _s + 32768); \
        _Pragma("unroll") for (int _p = 0; _p < 4; ++_p) { const int _row = 2 * (w * 4 + _p) + (lane >> 5); \
            GS_DMA((const GAS bf16_t*)(VG + (size_t)((nn) * 64 + _row) * 1024 + (((lane & 31) ^ (2 * (_row & 3))) << 3)), _s + GS_VS + (w * 4 + _p) * 1024); } } while (0)
    const unsigned lds_u = (unsigned)(uintptr_t)lds;
#define GS_BAR() do { asm volatile("s_waitcnt lgkmcnt(0)" ::: "memory"); __builtin_amdgcn_s_barrier(); asm volatile("" ::: "memory"); } while (0)
    __syncthreads();
    GS_PREFETCH(0, 0);
    for (int n = 0; n < GSEG; ++n) {
        const int st = n & 1; LAS unsigned char* sb_ = lds + st * GS_STAGE;
        LAS bf16_t* QT = (LAS bf16_t*)sb_; LAS bf16_t* KS = (LAS bf16_t*)(sb_ + GS_KS); LAS float* DEC = (LAS float*)(sb_ + GS_DEC); LAS bf16_t* VS = (LAS bf16_t*)(sb_ + GS_VS); LAS bf16_t* OST = (LAS bf16_t*)(sb_ + GS_KS);
        VM_WAIT(); GS_BAR();
        unsigned oiv[8];
#pragma unroll
        for (int q = 0; q < 8; ++q) oiv[q] = *(const GAS unsigned*)(oi0 + (size_t)n * OI_BYTES + ((w * 8 + q) * 64 + lane) * 4);
        unsigned srv[8];
#pragma unroll
        for (int q = 0; q < 8; ++q) srv[q] = *(const GAS unsigned*)(SR + (size_t)(n * 64 + 16 * (q >> 1) + fr) * 1024 + dv0 + 16 * (q & 1) + 4 * fq);
        asm volatile("" ::: "memory");
        if (n + 1 < GSEG) GS_PREFETCH(n + 1, st ^ 1);
        f32x4 o[4][2];
        {
            bf16x8 vb[2][2];
#pragma unroll
            for (int k2 = 0; k2 < 2; ++k2)
#pragma unroll
                for (int dt = 0; dt < 2; ++dt) { const int r0 = 32 * k2 + 8 * fq + (fr >> 2);
                    const LAS bf16_t* p = VS + r0 * 256 + ((((dv0 + 16 * dt) >> 3) ^ (2 * (r0 & 3))) << 3) + (fr & 3) * 4; vb[k2][dt] = cat8(tr16(p), tr16(p + 4 * 256)); }
#pragma unroll
            for (int tt = 0; tt < 4; ++tt) { o[tt][0] = (f32x4){0.f, 0.f, 0.f, 0.f}; o[tt][1] = (f32x4){0.f, 0.f, 0.f, 0.f}; }
#pragma unroll
            for (int s = 0; s < 4; ++s) {
                bf16x8 sb[2];
#pragma unroll
                for (int dt = 0; dt < 2; ++dt) { u32x4 pk; pk.x = cvt_pk_bf16(S[2 * s][dt][0], S[2 * s][dt][1]); pk.y = cvt_pk_bf16(S[2 * s][dt][2], S[2 * s][dt][3]); pk.z = cvt_pk_bf16(S[2 * s + 1][dt][0], S[2 * s + 1][dt][1]); pk.w = cvt_pk_bf16(S[2 * s + 1][dt][2], S[2 * s + 1][dt][3]); sb[dt] = __builtin_bit_cast(bf16x8, pk); }
#pragma unroll
                for (int tt = 0; tt < 4; ++tt) { const int i = 16 * tt + fr;
                    const LAS bf16_t* qp = QT + i * 128 + (fq & 1) * 4;
                    const bf16x8 af = cat8(*(const LAS s16x4*)(qp + (((4 * s + (fq >> 1)) ^ (i & 15)) << 3)), *(const LAS s16x4*)(qp + (((4 * s + 2 + (fq >> 1)) ^ (i & 15)) << 3)));
                    o[tt][0] = MFMA16(sb[0], af, o[tt][0]); o[tt][1] = MFMA16(sb[1], af, o[tt][1]); }
            }
#pragma unroll
            for (int k8 = 0; k8 < 8; ++k8) {
                const f32x4 dc = *(const LAS f32x4*)(DEC + 16 * k8 + 4 * fq);
                S[k8][0] *= dc; S[k8][1] *= dc;
#pragma unroll
                for (int k2 = 0; k2 < 2; ++k2) { const int r0 = 32 * k2 + 8 * fq + (fr >> 2);
                    const LAS bf16_t* p0 = KS + r0 * 128 + (((2 * k8) ^ (2 * (r0 & 7))) << 3) + (fr & 3) * 4; const LAS bf16_t* p1 = KS + (r0 + 4) * 128 + (((2 * k8) ^ (2 * ((r0 + 4) & 7))) << 3) + (fr & 3) * 4;
                    const bf16x8 af = cat8(tr16(p0), tr16(p1));
                    S[k8][0] = MFMA16(af, vb[k2][0], S[k8][0]); S[k8][1] = MFMA16(af, vb[k2][1], S[k8][1]); }
            }
        }
#pragma unroll
        for (int tt = 0; tt < 4; ++tt)
#pragma unroll
            for (int dt = 0; dt < 2; ++dt) { const f32x2 a = __builtin_amdgcn_cvt_pk_f32_fp8((int)oiv[tt * 2 + dt], false), b = __builtin_amdgcn_cvt_pk_f32_fp8((int)oiv[tt * 2 + dt], true); o[tt][dt][0] += a[0]; o[tt][dt][1] += a[1]; o[tt][dt][2] += b[0]; o[tt][dt][3] += b[1]; }
        {
            f32x4 pp;
#pragma unroll
            for (int tt = 0; tt < 4; ++tt) { const f32x4 a = o[tt][0] * o[tt][0] + o[tt][1] * o[tt][1]; float p = (a[0] + a[1]) + (a[2] + a[3]); p += __shfl_xor(p, 16); p += __shfl_xor(p, 32); pp[tt] = p; }
            if (fq == 0) { SS[(0 * 16 + fr) * 8 + w] = pp[0]; SS[(1 * 16 + fr) * 8 + w] = pp[1]; SS[(2 * 16 + fr) * 8 + w] = pp[2]; SS[(3 * 16 + fr) * 8 + w] = pp[3]; }
        }
        GS_BAR();
#pragma unroll
        for (int tt = 0; tt < 4; ++tt) { const f32x4 s0 = *(const LAS f32x4*)(SS + (16 * tt + fr) * 8), s1 = *(const LAS f32x4*)(SS + (16 * tt + fr) * 8 + 4);
            const float ss = ((s0[0] + s0[1]) + (s0[2] + s0[3])) + ((s1[0] + s1[1]) + (s1[2] + s1[3])); const float rs = __builtin_amdgcn_rsqf(ss * (1.0f / 256.0f) + RMS_EPS);
#pragma unroll
            for (int dt = 0; dt < 2; ++dt) { const f32x2 sa = __builtin_amdgcn_cvt_pk_f32_fp8((int)srv[tt * 2 + dt], false), sb2 = __builtin_amdgcn_cvt_pk_f32_fp8((int)srv[tt * 2 + dt], true); const f32x4 g = gnv[dt]; const f32x4 v = o[tt][dt] * rs;
                *(GAS unsigned*)(OG + (size_t)(n * 64 + 16 * tt + fr) * 1024 + dv0 + 16 * dt + 4 * fq) = pk4_fp8(v[0] * g[0] * sa[0], v[1] * g[1] * sa[1], v[2] * g[2] * sb2[0], v[3] * g[3] * sb2[1]); } }
    }
#undef GS_PREFETCH
#undef GS_DMA
#undef GS_BAR
    VM_WAIT(); __syncthreads();
}

constexpr int AT_K = 0, AT_V = 55296;
struct APre { u32x4 k[6], v[6]; bf16x8 q[2][2]; };
struct AUnit { int dl, n, colo; size_t tb; };
DI AUnit attn_decode(int u) { AUnit a; const int bl = u / 768, g = (u / 256) % 3, h = (u >> 5) & 7, x = u & 31; a.dl = (g == 0) ? 1 : (g == 1 ? 4 : 16); const int nb = 32 / a.dl, r = x / nb; a.n = x - r * nb; a.tb = (size_t)bl * SEQ + r; a.colo = g * 512 + h * 64; return a; }
DI void attn_load(const Ctx& c, int u, APre& p) {
    const int tid = ltid(), lane = tid & 63, w = rfl(tid >> 6), fr = lane & 15, fq = lane >> 4; const AUnit a = attn_decode(u);
    const bf16_t* Q = wsb(c, WS_H + H_QD) + a.colo; const bf16_t* K = wsb(c, WS_H + H_KD) + a.colo; const bf16_t* V = wsb(c, WS_H + H_VD) + a.colo;
#pragma unroll
    for (int b = 0; b < 2; ++b) { const size_t tokq = a.tb + (size_t)a.dl * (128 * (a.n + b) + 16 * w + fr);
#pragma unroll
        for (int d0 = 0; d0 < 2; ++d0) p.q[b][d0] = *(const GAS bf16x8*)(Q + tokq * 1536 + 32 * d0 + 8 * fq); }
#pragma unroll
    for (int c2 = 0; c2 < 6; ++c2) { const int idx = tid + NTHREADS * c2, row = idx >> 3, ch = idx & 7; const int j = 128 * (a.n - 1) + row;
        p.k[c2] = (u32x4){0u, 0u, 0u, 0u}; p.v[c2] = (u32x4){0u, 0u, 0u, 0u};
        if (j >= 0) { const size_t tok = a.tb + (size_t)a.dl * j; p.k[c2] = *(const GAS u32x4*)(K + tok * 1536 + ch * 8); p.v[c2] = *(const GAS u32x4*)(V + tok * 1536 + ch * 8); } }
}
DI void attn_stage(LAS unsigned char* lds, const APre& p) {
    const int tid = ltid(); LAS bf16_t* Ks = (LAS bf16_t*)(lds + AT_K); LAS bf16_t* Vs = (LAS bf16_t*)(lds + AT_V);
#pragma unroll
    for (int c2 = 0; c2 < 6; ++c2) { const int idx = tid + NTHREADS * c2, row = idx >> 3, ch = idx & 7; *(LAS u32x4*)(Ks + row * 72 + ch * 8) = p.k[c2]; *(LAS u32x4*)(Vs + row * 72 + ch * 8) = p.v[c2]; }
}
DI void attn_compute(LAS unsigned char* lds, const Ctx& c, int u, const bf16x8 (&qf)[2][2]) {
    const int tid = ltid(), lane = tid & 63, w = rfl(tid >> 6), fr = lane & 15, fq = lane >> 4; const AUnit au = attn_decode(u);
    const int dl = au.dl, n = au.n, g = (u / 256) % 3, h = (u >> 5) & 7; const size_t tb = au.tb;
    LAS bf16_t* Ks = (LAS bf16_t*)(lds + AT_K); LAS bf16_t* Vs = (LAS bf16_t*)(lds + AT_V);
#pragma unroll
    for (int b = 0; b < 2; ++b) {
        const int kt0 = 8 * b + w;
        f32x4 s[9]; float m = -1e30f;
#pragma unroll
        for (int kr = 0; kr < 9; ++kr) { const int kt = kt0 + kr; f32x4 a = (f32x4){0.f, 0.f, 0.f, 0.f};
#pragma unroll
            for (int d0 = 0; d0 < 2; ++d0) { const bf16x8 af = *(const LAS bf16x8*)(Ks + (16 * kt + fr) * 72 + 32 * d0 + 8 * fq); a = MFMA16(af, qf[b][d0], a); }
#pragma unroll
            for (int rg = 0; rg < 4; ++rg) { const bool tile_ok = (b > 0) || (n > 0) || (kt >= 8);
                bool ok = tile_ok; if (kr == 0) ok = ok && (4 * fq + rg >= fr); if (kr == 8) ok = ok && (4 * fq + rg <= fr);
                a[rg] = ok ? a[rg] : -1e30f; m = fmaxf(m, a[rg]); }
            s[kr] = a; }
        m = fmaxf(m, __shfl_xor(m, 16)); m = fmaxf(m, __shfl_xor(m, 32));
        float lsum = 0.f;
#pragma unroll
        for (int kr = 0; kr < 9; ++kr)
#pragma unroll
            for (int rg = 0; rg < 4; ++rg) { const float p = __builtin_amdgcn_exp2f(s[kr][rg] - m); s[kr][rg] = p; lsum += p; }
        lsum += __shfl_xor(lsum, 16); lsum += __shfl_xor(lsum, 32);
        f32x4 oT[4];
#pragma unroll
        for (int dt = 0; dt < 4; ++dt) oT[dt] = (f32x4){0.f, 0.f, 0.f, 0.f};
#pragma unroll
        for (int pp = 0; pp < 5; ++pp) { const int ka = 2 * pp, kb = (2 * pp + 1 < 9) ? 2 * pp + 1 : 8;
            u32x4 pk; pk.x = cvt_pk_bf16(s[ka][0], s[ka][1]); pk.y = cvt_pk_bf16(s[ka][2], s[ka][3]);
            if (2 * pp + 1 < 9) { pk.z = cvt_pk_bf16(s[kb][0], s[kb][1]); pk.w = cvt_pk_bf16(s[kb][2], s[kb][3]); } else { pk.z = 0u; pk.w = 0u; }
            const bf16x8 pf = __builtin_bit_cast(bf16x8, pk);
#pragma unroll
            for (int dt = 0; dt < 4; ++dt) { const LAS bf16_t* pa = Vs + (16 * (kt0 + ka) + 4 * fq + (fr >> 2)) * 72 + 16 * dt + (fr & 3) * 4; const LAS bf16_t* pb = Vs + (16 * (kt0 + kb) + 4 * fq + (fr >> 2)) * 72 + 16 * dt + (fr & 3) * 4;
                oT[dt] = MFMA16(cat8(tr16(pa), tr16(pb)), pf, oT[dt]); } }
        const float inv = 1.0f / lsum; const size_t tq = tb + (size_t)dl * (128 * (n + b) + 16 * w + fr);
        bf16_t* op = wsb(c, WS_ATTG) + ((size_t)g * TH + tq) * 512 + h * 64 + 4 * fq;
#pragma unroll
        for (int dt = 0; dt < 4; ++dt) { u32x2 o; o.x = cvt_pk_bf16(oT[dt][0] * inv, oT[dt][1] * inv); o.y = cvt_pk_bf16(oT[dt][2] * inv, oT[dt][3] * inv); *(GAS u32x2*)(op + 16 * dt) = o; }
        if (fq == 0) ((float*)(c.ws + WS_LSE))[((size_t)g * TH + tq) * 8 + h] = m + __builtin_amdgcn_logf(lsum);
    }
}
DI void phase_p(LAS unsigned char* lds, const Ctx& c, int l, int G) {
    int h_loaded = -1;
    for (int u = lbid(); u < 8 * 4 * 64; u += G) gla_p_unit(lds, c, l, u >> 8, (u >> 6) & 3, u & 63, h_loaded);
}
constexpr int NATT = 8 * 3 * 8 * 32, NATT1 = 0, NCHAIN = 8 * 4 * NSEG;
DI void attn_pull(LAS unsigned char* lds, const Ctx& c, unsigned* ctr, int base, int limit) {
    volatile LAS int* TK = (volatile LAS int*)(lds + MISC_OFF + 192);
    const int tid = ltid();
    __syncthreads();
    if (tid == 0) { TK[0] = base + 2 * (int)__hip_atomic_fetch_add(ctr, 1u, __ATOMIC_RELAXED, __HIP_MEMORY_SCOPE_AGENT); TK[1] = base + 2 * (int)__hip_atomic_fetch_add(ctr, 1u, __ATOMIC_RELAXED, __HIP_MEMORY_SCOPE_AGENT);
        TK[2] = base + 2 * (int)__hip_atomic_fetch_add(ctr, 1u, __ATOMIC_RELAXED, __HIP_MEMORY_SCOPE_AGENT); }
    __syncthreads();
    int cur = rfl(TK[0]), nxt = rfl(TK[1]);
    APre pre;
    if (cur < limit) attn_load(c, cur, pre);
    while (cur < limit) {
        __syncthreads();
        const int nxt2 = rfl(TK[2]);
        attn_stage(lds, pre);
        bf16x8 qf[2][2];
#pragma unroll
        for (int b = 0; b < 2; ++b)
#pragma unroll
            for (int d0 = 0; d0 < 2; ++d0) qf[b][d0] = pre.q[b][d0];
        __syncthreads();
        if (nxt < limit) attn_load(c, nxt, pre);
        int req = 0; if (tid == 0) req = base + 2 * (int)__hip_atomic_fetch_add(ctr, 1u, __ATOMIC_RELAXED, __HIP_MEMORY_SCOPE_AGENT);
        attn_compute(lds, c, cur, qf);
        if (tid == 0) TK[2] = req;
        cur = nxt; nxt = nxt2;
    }
}
DI void phase_b1(LAS unsigned char* lds, const Ctx& c, int l, int hf, int G) {
    const int bid = lbid(); unsigned* ctr = (unsigned*)(c.ws + WS_CTL) + CW_TKT + ((l * 2 + hf) * 2) * 64;
    for (int id = bid; id < NCHAIN; id += G) gla_l_chain(lds, c, id >> 4, (id >> 2) & 3, id & 3);
    attn_pull(lds, c, ctr, 0, NATT1);
}
DI void phase_b(LAS unsigned char* lds, const Ctx& c, int l, int hf, int G) {
    const int bid = lbid(); unsigned* ctr = (unsigned*)(c.ws + WS_CTL) + CW_TKT + ((l * 2 + hf) * 2 + 1) * 64;
    for (int id = bid; id < NCHAIN; id += G) gla_s_chain(lds, c, l, id >> 4, (id >> 2) & 3, id & 3);
    attn_pull(lds, c, ctr, NATT1, NATT);
}
DI void phase_f(const Ctx& c, int G) {
    const bf16_t* ag = wsb(c, WS_ATTG); const float* lse = (const float*)(c.ws + WS_LSE); unsigned char* att = c.ws + WS_ATT;
    const size_t stride = (size_t)G * NTHREADS, N = (size_t)TH * 64;
    for (size_t i0 = (size_t)lbid() * NTHREADS + ltid(); i0 < N; i0 += 4 * stride) {
        float l0[4], l1[4], l2[4]; u32x4 a[4], b[4], d[4];
#pragma unroll
        for (int q = 0; q < 4; ++q) { const size_t i = i0 + q * stride; const bool ok = i < N; const size_t tok = ok ? (i >> 6) : 0; const int ch = (int)(i & 63), h = ch >> 3;
            l0[q] = lse[tok * 8 + h]; l1[q] = lse[((size_t)TH + tok) * 8 + h]; l2[q] = lse[((size_t)2 * TH + tok) * 8 + h];
            a[q] = *(const GAS u32x4*)(ag + tok * 512 + ch * 8); b[q] = *(const GAS u32x4*)(ag + ((size_t)TH + tok) * 512 + ch * 8); d[q] = *(const GAS u32x4*)(ag + ((size_t)2 * TH + tok) * 512 + ch * 8); }
#pragma unroll
        for (int q = 0; q < 4; ++q) { const size_t i = i0 + q * stride; if (i >= N) continue; const size_t tok = i >> 6; const int ch = (int)(i & 63);
            const float mx = fmaxf(l0[q], fmaxf(l1[q], l2[q])); float w0 = __builtin_amdgcn_exp2f(l0[q] - mx), w1 = __builtin_amdgcn_exp2f(l1[q] - mx), w2 = __builtin_amdgcn_exp2f(l2[q] - mx);
            const float inv = 1.0f / (w0 + w1 + w2); w0 *= inv; w1 *= inv; w2 *= inv;
            u32x2 o;
            o.x = pk4_fp8(w0 * bf_lo(a[q].x) + w1 * bf_lo(b[q].x) + w2 * bf_lo(d[q].x), w0 * bf_hi(a[q].x) + w1 * bf_hi(b[q].x) + w2 * bf_hi(d[q].x), w0 * bf_lo(a[q].y) + w1 * bf_lo(b[q].y) + w2 * bf_lo(d[q].y), w0 * bf_hi(a[q].y) + w1 * bf_hi(b[q].y) + w2 * bf_hi(d[q].y));
            o.y = pk4_fp8(w0 * bf_lo(a[q].z) + w1 * bf_lo(b[q].z) + w2 * bf_lo(d[q].z), w0 * bf_hi(a[q].z) + w1 * bf_hi(b[q].z) + w2 * bf_hi(d[q].z), w0 * bf_lo(a[q].w) + w1 * bf_lo(b[q].w) + w2 * bf_lo(d[q].w), w0 * bf_hi(a[q].w) + w1 * bf_hi(b[q].w) + w2 * bf_hi(d[q].w));
            *(GAS u32x2*)(att + tok * 512 + ch * 8) = o; }
    }
}

DI float wave_sum(float v) {
#pragma unroll
    for (int o = 1; o < 64; o <<= 1) v += __shfl_xor(v, o);
    return v;
}
constexpr int R_WR = 0, R_HIST = 65536, R_BASE = 65536 + 64, R_INFO = 65536 + 128;
DI void phase_r(LAS unsigned char* lds, const Ctx& c, int l, int G) {
    const int tid = ltid(), lane = tid & 63, wave = rfl(tid >> 6);
    LAS float* WR = (LAS float*)(lds + R_WR); volatile LAS int* HIST = (volatile LAS int*)(lds + R_HIST); volatile LAS int* BASE = (volatile LAS int*)(lds + R_BASE); volatile LAS int* INFO = (volatile LAS int*)(lds + R_INFO);
    __syncthreads();
    for (int i = tid; i < 16 * 1024; i += NTHREADS) WR[(i & 15) * 1024 + (i >> 4)] = c.w_router[i];
    f32x4 g4[4], b4[4];
#pragma unroll
    for (int j = 0; j < 4; ++j) { g4[j] = *(const GAS f32x4*)(c.ln1_g + l * D + 4 * lane + 256 * j); b4[j] = *(const GAS f32x4*)(c.ln1_b + l * D + 4 * lane + 256 * j); }
    bf16_t* xr = wsb(c, WS_XR); unsigned char* xb = c.ws + WS_XB; int* histg = (int*)(c.ws + WS_HISTG); float* gate = (float*)(c.ws + WS_GATE);
    const float brt = c.b_router[((lane >> 5) & 1) * 8 + ((lane >> 4) & 1) * 4 + ((lane >> 3) & 1) * 2 + ((lane >> 2) & 1)];
    for (int chunk = lbid(); chunk < T / 256; chunk += G) {
        __syncthreads();
        u32x2 zn[4];
#pragma unroll
        for (int j = 0; j < 4; ++j) zn[j] = *(const GAS u32x2*)(xr + ((size_t)chunk * 256 + wave * 32) * D + 4 * lane + 256 * j);
        for (int rr = 0; rr < 32; ++rr) {
            const int rl = wave * 32 + rr; const size_t row = (size_t)chunk * 256 + rl;
            f32x4 v[4]; float s = 0.f;
#pragma unroll
            for (int j = 0; j < 4; ++j) { const u32x2 zq = zn[j]; v[j] = (f32x4){bf_lo(zq.x), bf_hi(zq.x), bf_lo(zq.y), bf_hi(zq.y)}; s += (v[j][0] + v[j][1]) + (v[j][2] + v[j][3]); }
            { const size_t rn = row + (rr + 1 < 32 ? 1 : 0);
#pragma unroll
              for (int j = 0; j < 4; ++j) zn[j] = *(const GAS u32x2*)(xr + rn * D + 4 * lane + 256 * j); }
            const float mean = wave_sum(s) * (1.0f / D); float s2 = 0.f;
#pragma unroll
            for (int j = 0; j < 4; ++j) { v[j] = v[j] - mean; s2 += (v[j][0] * v[j][0] + v[j][1] * v[j][1]) + (v[j][2] * v[j][2] + v[j][3] * v[j][3]); }
            const float rstd = __builtin_amdgcn_rsqf(wave_sum(s2) * (1.0f / D) + LN_EPS);
#pragma unroll
            for (int j = 0; j < 4; ++j) { v[j] = v[j] * rstd * g4[j] + b4[j]; u32x2 xq; xq.x = cvt_pk_bf16(v[j][0], v[j][1]); xq.y = cvt_pk_bf16(v[j][2], v[j][3]); *(GAS u32x2*)(xr + row * D + 4 * lane + 256 * j) = xq;
                *(GAS unsigned*)(xb + row * D + 4 * lane + 256 * j) = pk4_fp8(v[j][0], v[j][1], v[j][2], v[j][3]); }
            float lg[16];
#pragma unroll
            for (int e = 0; e < 16; ++e) { float a = 0.f;
#pragma unroll
                for (int j = 0; j < 4; ++j) { const f32x4 wv = *(const LAS f32x4*)(WR + e * 1024 + 4 * lane + 256 * j); a += v[j][0] * wv[0] + v[j][1] * wv[1] + v[j][2] * wv[2] + v[j][3] * wv[3]; }
                lg[e] = a; }
            {
                float b8[8], b4[4], b2[2];
                const bool h5 = lane & 32, h4 = lane & 16, h3 = lane & 8, h2 = lane & 4;
#pragma unroll
                for (int i = 0; i < 8; ++i) { const float mine = h5 ? lg[8 + i] : lg[i], send = h5 ? lg[i] : lg[8 + i]; b8[i] = mine + __shfl_xor(send, 32); }
#pragma unroll
                for (int i = 0; i < 4; ++i) { const float mine = h4 ? b8[4 + i] : b8[i], send = h4 ? b8[i] : b8[4 + i]; b4[i] = mine + __shfl_xor(send, 16); }
#pragma unroll
                for (int i = 0; i < 2; ++i) { const float mine = h3 ? b4[2 + i] : b4[i], send = h3 ? b4[i] : b4[2 + i]; b2[i] = mine + __shfl_xor(send, 8); }
                float b1 = (h2 ? b2[1] : b2[0]) + __shfl_xor(h2 ? b2[0] : b2[1], 4);
                b1 += __shfl_xor(b1, 2); b1 += __shfl_xor(b1, 1);
                b1 += brt;
#pragma unroll
                for (int e = 0; e < 16; ++e) lg[e] = __shfl(b1, ((e >> 3) & 1) * 32 + ((e >> 2) & 1) * 16 + ((e >> 1) & 1) * 8 + (e & 1) * 4);
            }
            float mx = lg[0];
#pragma unroll
            for (int e = 1; e < 16; ++e) mx = fmaxf(mx, lg[e]);
            float se = 0.f;
#pragma unroll
            for (int e = 0; e < 16; ++e) { lg[e] = __expf(lg[e] - mx); se += lg[e]; }
            const float ise = 1.0f / se;
#pragma unroll
            for (int e = 0; e < 16; ++e) lg[e] *= ise;
            int gsel = 0; float gbest = -1.f;
#pragma unroll
            for (int gi = 0; gi < 4; ++gi) { const float a = lg[4 * gi], b = lg[4 * gi + 1], cc = lg[4 * gi + 2], d = lg[4 * gi + 3];
                const float sc = (a + b + cc + d) - fminf(fminf(a, b), fminf(cc, d)) - fminf(fmaxf(fminf(a, b), fminf(cc, d)), fminf(fmaxf(a, b), fmaxf(cc, d)));
                if (sc > gbest) { gbest = sc; gsel = gi; } }
            float p[4];
#pragma unroll
            for (int k = 0; k < 4; ++k) p[k] = gsel == 0 ? lg[k] : gsel == 1 ? lg[4 + k] : gsel == 2 ? lg[8 + k] : lg[12 + k];
            int i0 = 0; float v0 = p[0];
#pragma unroll
            for (int k = 1; k < 4; ++k) if (p[k] > v0) { v0 = p[k]; i0 = k; }
            int i1 = -1; float v1 = -1.f;
#pragma unroll
            for (int k = 0; k < 4; ++k) if (k != i0 && p[k] > v1) { v1 = p[k]; i1 = k; }
            if (lane == 0) { const int e0 = 4 * gsel + i0, e1 = 4 * gsel + i1; INFO[rl * 4 + 0] = e0; INFO[rl * 4 + 1] = e1;
                const float gs = 1.0f / (v0 + v1); gate[row * 2] = v0 * gs; gate[row * 2 + 1] = v1 * gs; }
        }
        __syncthreads();
        {
            int cnt0 = 0, cnt1 = 0; const unsigned long long lt = (1ull << lane) - 1ull;
#pragma unroll
            for (int b = 0; b < 4; ++b) { const int r = 64 * b + lane; const int e0 = INFO[r * 4], e1 = INFO[r * 4 + 1];
                const bool a0 = (e0 == 2 * wave) || (e1 == 2 * wave), a1 = (e0 == 2 * wave + 1) || (e1 == 2 * wave + 1);
                const unsigned long long m0 = __ballot(a0), m1 = __ballot(a1);
                if (a0) INFO[r * 4 + (e0 == 2 * wave ? 2 : 3)] = cnt0 + __popcll(m0 & lt);
                if (a1) INFO[r * 4 + (e0 == 2 * wave + 1 ? 2 : 3)] = cnt1 + __popcll(m1 & lt);
                cnt0 += __popcll(m0); cnt1 += __popcll(m1); }
            if (lane == 0) { histg[chunk * 16 + 2 * wave] = cnt0; histg[chunk * 16 + 2 * wave + 1] = cnt1; }
        }
        __syncthreads();
        if (tid < 256) { i32x4 v; v.x = INFO[tid * 4]; v.y = INFO[tid * 4 + 1]; v.z = INFO[tid * 4 + 2]; v.w = INFO[tid * 4 + 3]; ((GAS i32x4*)(c.ws + WS_INFO))[(size_t)chunk * 256 + tid] = v; }
        __syncthreads();
    }
}
DI void phase_r2(LAS unsigned char* lds, const Ctx& c, int l, int G) {
    const int tid = ltid(); volatile LAS int* BASE = (volatile LAS int*)(lds + R_BASE);
    const int* histg = (const int*)(c.ws + WS_HISTG); int* list = (int*)(c.ws + WS_LIST);
    unsigned* cur = (unsigned*)(c.ws + WS_CTL) + CW_CUR + l * 16 * 64;
    for (int chunk = lbid(); chunk < T / 256; chunk += G) {
        __syncthreads();
        if (tid < 16) BASE[tid] = 0;
        __syncthreads();
        { const int e = tid & 15; int s = 0; for (int cc = tid >> 4; cc < chunk; cc += 32) s += histg[cc * 16 + e]; if (s) atomicAdd((int*)&BASE[e], s); }
        __syncthreads();
        if (tid < 256) { const i32x4 v = ((const GAS i32x4*)(c.ws + WS_INFO))[(size_t)chunk * 256 + tid]; const int row = chunk * 256 + tid;
            list[(size_t)v.x * T + BASE[v.x] + v.z] = row * 2; list[(size_t)v.y * T + BASE[v.y] + v.w] = row * 2 + 1; }
        if (chunk == T / 256 - 1 && tid < 16) __hip_atomic_store(cur + tid * 64, (unsigned)(BASE[tid] + histg[chunk * 16 + tid]), __ATOMIC_RELAXED, __HIP_MEMORY_SCOPE_AGENT);
    }
}
DI int moe_setup(LAS unsigned char* lds, const Ctx& c, int l) {
    volatile LAS int* PRE = (volatile LAS int*)(lds + MISC_OFF); volatile LAS int* CNT = PRE + 17;
    unsigned* cur = (unsigned*)(c.ws + WS_CTL) + CW_CUR + l * 16 * 64;
    __syncthreads();
    if (threadIdx.x == 0) { int acc = 0; for (int e = 0; e < 16; ++e) { const int n = (int)__hip_atomic_load(cur + e * 64, __ATOMIC_RELAXED, __HIP_MEMORY_SCOPE_AGENT); PRE[e] = acc; CNT[e] = n; acc += (n + 255) >> 8; } PRE[16] = acc; }
    __syncthreads();
    return rfl(PRE[16]);
}
DI void phase_c(const Ctx& c, int l, int G) {
    const int tid = ltid(), lane = tid & 63, wave = rfl(tid >> 6);
    f32x4 g4[4], b4[4];
#pragma unroll
    for (int j = 0; j < 4; ++j) { g4[j] = *(const GAS f32x4*)(c.ln2_g + l * D + 4 * lane + 256 * j); b4[j] = *(const GAS f32x4*)(c.ln2_b + l * D + 4 * lane + 256 * j); }
    float* xo = c.out; bf16_t* xr = wsb(c, WS_XR); unsigned char* xb = c.ws + WS_XB; const unsigned char* ys = c.ws + WS_YS; const float* gate = (const float*)(c.ws + WS_GATE);
    const size_t rstep = (size_t)G * NWAVES; size_t row = (size_t)lbid() * NWAVES + wave;
    u32x2 xn[4]; unsigned y0n[4], y1n[4]; float g0n = 0.f, g1n = 0.f;
    if (row < (size_t)T) { g0n = gate[row * 2]; g1n = gate[row * 2 + 1];
#pragma unroll
        for (int j = 0; j < 4; ++j) { xn[j] = *(const GAS u32x2*)(xr + row * D + 4 * lane + 256 * j); y0n[j] = *(const GAS unsigned*)(ys + (row * 2) * D + 4 * lane + 256 * j); y1n[j] = *(const GAS unsigned*)(ys + (row * 2 + 1) * D + 4 * lane + 256 * j); } }
    for (; row < (size_t)T; row += rstep) {
        const float g0 = g0n, g1 = g1n;
        f32x4 v[4]; float s = 0.f;
#pragma unroll
        for (int j = 0; j < 4; ++j) { const u32x2 xq = xn[j]; const unsigned y0 = y0n[j], y1 = y1n[j];
            const f32x2 y0a = __builtin_amdgcn_cvt_pk_f32_fp8((int)y0, false), y0b = __builtin_amdgcn_cvt_pk_f32_fp8((int)y0, true), y1a = __builtin_amdgcn_cvt_pk_f32_fp8((int)y1, false), y1b = __builtin_amdgcn_cvt_pk_f32_fp8((int)y1, true);
            v[j][0] = bf_lo(xq.x) * DN_ALPHA + g0 * y0a[0] + g1 * y1a[0]; v[j][1] = bf_hi(xq.x) * DN_ALPHA + g0 * y0a[1] + g1 * y1a[1];
            v[j][2] = bf_lo(xq.y) * DN_ALPHA + g0 * y0b[0] + g1 * y1b[0]; v[j][3] = bf_hi(xq.y) * DN_ALPHA + g0 * y0b[1] + g1 * y1b[1];
            s += (v[j][0] + v[j][1]) + (v[j][2] + v[j][3]); }
        { const size_t rn = row + rstep < (size_t)T ? row + rstep : row; g0n = gate[rn * 2]; g1n = gate[rn * 2 + 1];
#pragma unroll
          for (int j = 0; j < 4; ++j) { xn[j] = *(const GAS u32x2*)(xr + rn * D + 4 * lane + 256 * j); y0n[j] = *(const GAS unsigned*)(ys + (rn * 2) * D + 4 * lane + 256 * j); y1n[j] = *(const GAS unsigned*)(ys + (rn * 2 + 1) * D + 4 * lane + 256 * j); } }
        const float mean = wave_sum(s) * (1.0f / D); float s2 = 0.f;
#pragma unroll
        for (int j = 0; j < 4; ++j) { v[j] = v[j] - mean; s2 += (v[j][0] * v[j][0] + v[j][1] * v[j][1]) + (v[j][2] * v[j][2] + v[j][3] * v[j][3]); }
        const float rstd = __builtin_amdgcn_rsqf(wave_sum(s2) * (1.0f / D) + LN_EPS);
#pragma unroll
        for (int j = 0; j < 4; ++j) { v[j] = v[j] * rstd * g4[j] + b4[j];
            if (l == DEPTH - 1) *(GAS f32x4*)(xo + row * D + 4 * lane + 256 * j) = v[j];
            else { u32x2 xq; xq.x = cvt_pk_bf16(v[j][0], v[j][1]); xq.y = cvt_pk_bf16(v[j][2], v[j][3]); *(GAS u32x2*)(xr + row * D + 4 * lane + 256 * j) = xq;
                *(GAS unsigned*)(xb + row * D + 4 * lane + 256 * j) = pk4_fp8(v[j][0], v[j][1], v[j][2], v[j][3]); } }
    }
}

DI Ctx load_ctx() {
    union { Ctx c; unsigned long long q[sizeof(Ctx) / 8]; } u;
#if defined(__HIP_DEVICE_COMPILE__)
    const __attribute__((address_space(4))) unsigned long long* p = (const __attribute__((address_space(4))) unsigned long long*)__builtin_amdgcn_kernarg_segment_ptr();
    asm volatile("" : "+s"(p));
#pragma unroll
    for (int i = 0; i < (int)(sizeof(Ctx) / 8); ++i) u.q[i] = p[i];
#endif
    return u.c;
}
#define CTX const Ctx c = load_ctx(); const int G = lgrid(); LAS unsigned char* lds = LDSBASE
__global__ void __launch_bounds__(NTHREADS, 2) mk_fwd(Ctx c_arg) {
    extern __shared__ __attribute__((aligned(16))) unsigned char lds_raw[];
#define LDSBASE ({ unsigned _b = (unsigned)(uintptr_t)(LAS unsigned char*)lds_raw; asm volatile("" : "+s"(_b)); (LAS unsigned char*)(uintptr_t)_b; })
    LAS unsigned char* lds0 = LDSBASE;
    const int tid = threadIdx.x; const Ctx c = load_ctx();
    volatile LAS unsigned* MISC = (volatile LAS unsigned*)(lds0 + MISC_OFF);
    if (tid < 64) MISC[tid] = 0u;
    __syncthreads();
    XcdBarrier bar; bar.bar = (unsigned*)(c.ws + WS_CTL) + CW_BAR; bar.x = 0; bar.st = MISC + 40;
    if (!MK_MULTI) bar = xcd_barrier_post((unsigned*)(c.ws + WS_CTL) + CW_BAR, MISC + 40);
    const int lo = c.lo, hi = c.hi; int step = 0;
#define RUN (lo <= step && step < hi)
#define END_STEP do { if (RUN && step + 1 < hi) { if (!MK_MULTI) xcd_barrier(bar); } ++step; } while (0)
#define END_STEP_NB do { ++step; } while (0)
    for (int l = 0; l < DEPTH; ++l) {
        if (RUN) { CTX; phase_w(lds, c, l, G); }
        END_STEP;
        for (int hf = 0; hf < 2; ++hf) {
            const size_t r0 = (size_t)hf * TH;
            if (RUN) {
                CTX;
                pg8::StaticOrder S; S.init(c.ws + WS_XB + r0 * D, c.ws + WS_WIN, TH, NIN, D / 2, G, lbid());
                EpiIn E{wsb(c, WS_H + H_QG), wsb(c, WS_H + H_KG), wsb(c, WS_H + H_VG), wsb(c, WS_H + H_SR), wsb(c, WS_H + H_QD), wsb(c, WS_H + H_KD), wsb(c, WS_H + H_VD), wsb(c, WS_H + H_GT), (float*)(c.ws + WS_HA), c.pos + r0};
                pg8::gemm_phase<EpiIn, pg8::StaticOrder, true>(lds, D / 2, S, E);
            }
            END_STEP;
            if (RUN) { CTX; phase_p(lds, c, l, G); }
            END_STEP;
            if (RUN) { CTX; phase_b1(lds, c, l, hf, G); }
            END_STEP;
            if (RUN) { CTX; phase_b(lds, c, l, hf, G); }
            END_STEP;
            if (RUN) { CTX; (void)lds; phase_f(c, G); }
            END_STEP_NB;
            if (RUN) {
                CTX;
                pg8::StaticOrder S; S.init(c.ws + WS_OG, c.ws + WS_WGO, TH, D, D / 2, G, lbid());
                EpiGate<false> E{wsb(c, WS_MIX), c.ws + WS_H + H_GT, nullptr};
                pg8::gemm_phase<EpiGate<false>, pg8::StaticOrder, true>(lds, D / 2, S, E);
            }
            END_STEP;
            if (RUN) {
                CTX;
                pg8::StaticOrder S; S.init(c.ws + WS_ATT, c.ws + WS_WAO, TH, D, 256, G, lbid());
                EpiGate<true> E{wsb(c, WS_MIX), c.ws + WS_H + H_GT + 1024, c.ws + WS_OG + 32 * MiB};
                pg8::gemm_phase<EpiGate<true>, pg8::StaticOrder, true>(lds, 256, S, E);
            }
            END_STEP;
            if (RUN) {
                CTX;
                pg8::StaticOrder S; S.init(c.ws + WS_OG + 32 * MiB, c.ws + WS_WOUT, TH, D, D / 2, G, lbid());
                EpiRes E{l == 0 ? c.x + r0 * D : nullptr, wsb(c, WS_XR) + r0 * D};
                pg8::gemm_phase<EpiRes, pg8::StaticOrder, true>(lds, D / 2, S, E);
            }
            if (hf == 1) END_STEP; else END_STEP_NB;
        }
        if (RUN) { CTX; phase_r(lds, c, l, G); }
        END_STEP;
        if (RUN) { CTX; phase_r2(lds, c, l, G); }
        END_STEP;
        if (RUN) {   CTX;
            const int ntiles = moe_setup(lds, c, l);
            volatile LAS int* PRE = (volatile LAS int*)(lds + MISC_OFF); volatile LAS int* TAB = (volatile LAS int*)(lds + TAB_OFF);
            pg8::MoeOrder S; S.G = G; S.c = vcu_of(lbid(), G); S.ntot = ntiles * 8; S.NC = 8; S.K = D / 2; S.pre = PRE; S.cnt = PRE + 17; S.A = (const char*)(c.ws + WS_XB); S.Bt = (const char*)(c.ws + WS_WGU);
            S.bstride = (size_t)2048 * 1024; S.tab = TAB; S.gather = true;
            const int* list = (const int*)(c.ws + WS_LIST);
            { const int lt_tid = ltid(); const int r = lt_tid & 255, half = rfl(lt_tid >> 8);
              for (int i0 = 0; i0 < MAXU; i0 += 2) { Unit u; const int i = i0 + half;
                  if (S.next(i, u)) { const int lt = u.pm - PRE[u.e]; const int pos = 256 * lt + (r < u.nv ? r : 0); TAB[i * 256 + r] = list[(size_t)u.e * T + pos] >> 1; } } }
            __syncthreads();
            EpiM1 E{c.ws + WS_HM};
            pg8::gemm_phase<EpiM1, pg8::MoeOrder, true>(lds, D / 2, S, E);
        }
        END_STEP;
        if (RUN) {   CTX;
            const int ntiles = moe_setup(lds, c, l);
            volatile LAS int* PRE = (volatile LAS int*)(lds + MISC_OFF);
            pg8::MoeOrder S; S.G = G; S.c = vcu_of(lbid(), G); S.ntot = ntiles * 4; S.NC = 4; S.K = DFF / 2; S.pre = PRE; S.cnt = PRE + 17; S.A = (const char*)(c.ws + WS_HM); S.Bt = (const char*)(c.ws + WS_WD);
            S.bstride = (size_t)1024 * 1024; S.tab = nullptr; S.gather = false;
            EpiM2 E{c.ws + WS_YS, (const int*)(c.ws + WS_LIST), PRE};
            pg8::gemm_phase<EpiM2, pg8::MoeOrder, true>(lds, DFF / 2, S, E);
        }
        END_STEP;
        if (RUN) { CTX; (void)lds; phase_c(c, l, G); }
        END_STEP_NB;
    }
#undef RUN
#undef END_STEP
#undef END_STEP_NB
}
constexpr int NSTEPS = DEPTH * (1 + 2 * 8 + 5);

extern "C" void kernel_launch(void* const* d_in, const int* in_sizes, int n_in, void* d_out, int out_size, void* d_ws, size_t ws_size, hipStream_t stream) {
    static int grid = 0;
    if (grid == 0) {
        if (n_in != 18 || in_sizes[0] != T * D || out_size != T * D || ws_size < WS_END) { fprintf(stderr, "kernel_launch: unexpected shapes / workspace (need %zu, got %zu)\n", (size_t)WS_END, ws_size); grid = -1; return; }
        int dev = 0, cus = 0;
        if (hipGetDevice(&dev) != hipSuccess || hipDeviceGetAttribute(&cus, hipDeviceAttributeMultiprocessorCount, dev) != hipSuccess) { grid = -1; return; }
        if (hipFuncSetAttribute((const void*)mk_fwd, hipFuncAttributeMaxDynamicSharedMemorySize, LDS_BYTES) != hipSuccess) { fprintf(stderr, "kernel_launch: hipFuncSetAttribute failed\n"); grid = -1; return; }
        int per_cu = 0;
        if (hipOccupancyMaxActiveBlocksPerMultiprocessor(&per_cu, (const void*)mk_fwd, NTHREADS, LDS_BYTES) != hipSuccess || per_cu < 1) { fprintf(stderr, "kernel_launch: occupancy query says %d\n", per_cu); }
        (void)hipGetLastError();
        grid = cus;
    }
    if (grid < 0) return;
    (void)hipMemsetAsync((char*)d_ws + WS_CTL, 0, CTL_ZERO_BYTES, stream);
    Ctx c{};
    c.x = (const float*)d_in[0]; c.pos = (const int*)d_in[1]; c.w_in = (const float*)d_in[2]; c.w_alpha_up = (const float*)d_in[3]; c.b_alpha = (const float*)d_in[4]; c.gla_norm = (const float*)d_in[5];
    c.w_gla_o = (const float*)d_in[6]; c.w_att_o = (const float*)d_in[7]; c.w_out = (const float*)d_in[8]; c.ln1_g = (const float*)d_in[9]; c.ln1_b = (const float*)d_in[10]; c.w_router = (const float*)d_in[11];
    c.b_router = (const float*)d_in[12]; c.w_e_gate = (const float*)d_in[13]; c.w_e_up = (const float*)d_in[14]; c.w_e_down = (const float*)d_in[15]; c.ln2_g = (const float*)d_in[16]; c.ln2_b = (const float*)d_in[17];
    c.out = (float*)d_out; c.ws = (unsigned char*)d_ws;
#if MK_MULTI
    for (int s = 0; s < NSTEPS; ++s) { c.lo = s; c.hi = s + 1; hipLaunchKernelGGL(mk_fwd, dim3(grid), dim3(NTHREADS), LDS_BYTES, stream, c); }
#else
    c.lo = 0; c.hi = NSTEPS; hipLaunchKernelGGL(mk_fwd, dim3(grid), dim3(NTHREADS), LDS_BYTES, stream, c);
#endif
}
```

```cpp
#include <hip/hip_runtime.h>
#include <cstdio>
#include <cstdint>

#ifndef MK_MULTI
#define MK_MULTI 0
#endif

#define DI __device__ __forceinline__
#define GAS __attribute__((address_space(1)))
#define LAS __attribute__((address_space(3)))
typedef unsigned short bf16_t;
typedef short bf16x8 __attribute__((ext_vector_type(8)));
typedef short s16x4 __attribute__((ext_vector_type(4)));
typedef float f32x4 __attribute__((ext_vector_type(4)));
typedef float f32x2 __attribute__((ext_vector_type(2)));
typedef unsigned u32x4 __attribute__((ext_vector_type(4)));
typedef unsigned u32x2 __attribute__((ext_vector_type(2)));
typedef int i32x4 __attribute__((ext_vector_type(4)));
typedef int i32x8 __attribute__((ext_vector_type(8)));
#define LDS_WAIT() asm volatile("s_waitcnt lgkmcnt(0)" ::: "memory")
#define VM_WAIT() asm volatile("s_waitcnt vmcnt(0)" ::: "memory")

constexpr int D = 1024, NBATCH = 16, SEQ = 4096, T = NBATCH * SEQ, DEPTH = 4;
constexpr int TH = T / 2;
constexpr int DIN = 9744, NIN = 9984;
constexpr int NEXP = 16, DFF = 1024;
constexpr float LN_EPS = 1e-5f, RMS_EPS = 1e-6f;
constexpr float DN_ALPHA = 1.6817928305074290f;
constexpr float LOG2E = 1.4426950408889634f;
constexpr int NWAVES = 8, NTHREADS = 512;

constexpr size_t MiB = 1u << 20;
constexpr size_t WS_CTL = 0, CTL_ZERO_BYTES = 1 * MiB;
constexpr size_t WS_WIN = 1 * MiB;
constexpr size_t WS_WGO = WS_WIN + (size_t)NIN * D;
constexpr size_t WS_WAO = WS_WGO + 2 * MiB;
constexpr size_t WS_WOUT = WS_WAO + 1 * MiB;
constexpr size_t WS_WGU = WS_WOUT + 2 * MiB;
constexpr size_t WS_WD = WS_WGU + 32 * MiB;
constexpr size_t WS_XB = WS_WD + 16 * MiB;
constexpr size_t WS_XR = WS_XB + 64 * MiB;
constexpr size_t WS_LIST = WS_XR + 128 * MiB;
constexpr size_t WS_GATE = WS_LIST + 4 * MiB;
constexpr size_t WS_INFO = WS_GATE + 1 * MiB;
constexpr size_t WS_HISTG = WS_INFO + 1 * MiB;
constexpr size_t WS_OG = WS_HISTG + 1 * MiB;
constexpr size_t WS_ATTG = WS_OG + 64 * MiB;
constexpr size_t WS_LSE = WS_ATTG + 96 * MiB;
constexpr size_t WS_ATT = WS_LSE + 3 * MiB;
constexpr size_t WS_MIX = WS_ATT + 32 * MiB;
constexpr size_t WS_HA = WS_MIX + 64 * MiB;
constexpr size_t WS_H = WS_HA + 2 * MiB;
constexpr size_t H_QG = 0, H_KG = H_QG + (size_t)TH * 512 * 2, H_VG = H_KG + (size_t)TH * 512 * 2, H_SR = H_VG + (size_t)TH * 1024 * 2,
                 H_QD = H_SR + (size_t)TH * 1024 * 2, H_KD = H_QD + (size_t)TH * 1536 * 2, H_VD = H_KD + (size_t)TH * 1536 * 2, H_GT = H_VD + (size_t)TH * 1536 * 2,
                 H_END = H_GT + (size_t)TH * 2048 * 2;
constexpr size_t WS_HM = WS_H;
constexpr size_t WS_YS = WS_HM + (size_t)(2 * T + 4096) * 1024 * 2;
constexpr size_t WS_REC = WS_H + H_END;
constexpr size_t WS_SLOC = WS_REC + (size_t)2048 * 33792;
constexpr size_t WS_DCUM = WS_SLOC + 16 * MiB;
constexpr size_t WS_END = WS_DCUM + 1 * MiB;
static_assert(WS_YS + (size_t)2 * T * 1024 * 2 <= WS_END, "MoE overlay fits");
constexpr int CW_BAR = 4096;
constexpr int CW_TKT = 24576;
constexpr int CW_CUR = 16384;

constexpr int RING_BYTES = 131072;
constexpr int TAB_OFF = RING_BYTES, MAXU = 18, TAB_BYTES = MAXU * 1024;
constexpr int MISC_OFF = TAB_OFF + TAB_BYTES;
constexpr int LDS_BYTES = MISC_OFF + 256;

DI int rfl(int v) { return __builtin_amdgcn_readfirstlane(v); }
DI int lbid() { int t = blockIdx.x; asm volatile("" : "+s"(t)); return t; }
DI int lgrid() { int t = gridDim.x; asm volatile("" : "+s"(t)); return t; }
DI int vcu_of(int bid, int G) { return (G % 8 == 0) ? (bid % 8) * (G / 8) + bid / 8 : bid; }
DI int ltid() { int t = threadIdx.x; asm volatile("" : "+v"(t)); return t; }
DI float bf2f(unsigned b) { return __uint_as_float(b << 16); }
typedef __bf16 bf16x2_t __attribute__((ext_vector_type(2)));
DI unsigned cvt_pk_bf16(float lo, float hi) { f32x2 v = {lo, hi}; bf16x2_t b = __builtin_convertvector(v, bf16x2_t); return __builtin_bit_cast(unsigned, b); }
DI float clamp8(float v) { return fminf(fmaxf(v, -448.f), 448.f); }
DI unsigned pk4_fp8(float a, float b, float c_, float d) { int w = 0; w = __builtin_amdgcn_cvt_pk_fp8_f32(clamp8(a), clamp8(b), w, false); w = __builtin_amdgcn_cvt_pk_fp8_f32(clamp8(c_), clamp8(d), w, true); return (unsigned)w; }
constexpr float W8_SCALE = 64.0f;
DI float bf_lo(unsigned w) { return __uint_as_float(w << 16); }
DI float bf_hi(unsigned w) { return __uint_as_float(w & 0xffff0000u); }
DI float sigmoidf_(float x) { return __builtin_amdgcn_rcpf(1.0f + __builtin_amdgcn_exp2f(-x * LOG2E)); }

#define XB_TMO      128
#define XB_XCNT(j)  (256  + 64 * (j))
#define XB_XSUB(j)  (1280 + 64 * (j))
#define XB_XGEN(j)  (2304 + 64 * (j))
#define XB_TOP      3328
#define XB_TOPGEN   3392
#define XCD_BAR_WORDS 3456
#define XB_SPIN_CAP (1u << 18)
DI unsigned xb_ld(unsigned* p)              { return __hip_atomic_load(p, __ATOMIC_RELAXED, __HIP_MEMORY_SCOPE_AGENT); }
DI unsigned xb_add(unsigned* p, unsigned v) { return __hip_atomic_fetch_add(p, v, __ATOMIC_RELAXED, __HIP_MEMORY_SCOPE_AGENT); }
DI unsigned xb_xcc_id() { return (unsigned)__builtin_amdgcn_s_getreg((3 << 11) | 20) & 0xFu; }
#define XB_SPIN(cond, bar) do { unsigned _sp = 0; while (cond) { __builtin_amdgcn_s_sleep(1); \
    if ((++_sp & 255u) == 0u) { if (xb_ld(&(bar)[XB_TMO])) break; if (_sp > XB_SPIN_CAP) { atomicAdd(&(bar)[XB_TMO], 1u); break; } } } } while (0)
struct XcdBarrier { unsigned* bar; unsigned x; volatile LAS unsigned* st; };
DI XcdBarrier xcd_barrier_post(unsigned* bar, volatile LAS unsigned* st) {
    XcdBarrier b; b.bar = bar; b.x = xb_xcc_id(); b.st = st;
    if (threadIdx.x == 0) (void)xb_add(&bar[XB_XCNT(b.x)], 1u);
    return b;
}
DI void xcd_barrier_complete(unsigned* bar, unsigned x, unsigned& nloc, unsigned& nx) {
    const unsigned G = gridDim.x * gridDim.y * gridDim.z;
    unsigned sum, cnt, mine, sp = 0u;
    for (;;) {
        sum = 0u; cnt = 0u; mine = 0u;
#pragma unroll
        for (unsigned j = 0; j < 16; ++j) { const unsigned c = xb_ld(&bar[XB_XCNT(j)]); sum += c; cnt += (c > 0u) ? 1u : 0u; mine = (j == x) ? c : mine; }
        if (sum == G) break;
        __builtin_amdgcn_s_sleep(1);
        if ((++sp & 255u) == 0u) { if (xb_ld(&bar[XB_TMO])) break; if (sp > XB_SPIN_CAP) { atomicAdd(&bar[XB_TMO], 1u); break; } }
    }
    nloc = mine > 0u ? mine : 1u; nx = cnt > 0u ? cnt : 1u;
}
DI void xcd_barrier(const XcdBarrier& b) {
    asm volatile("s_waitcnt vmcnt(0)" ::: "memory");
    __syncthreads();
    if (threadIdx.x == 0) {
        unsigned* bar = b.bar;
        __builtin_amdgcn_s_waitcnt(0);
        unsigned nloc = b.st[0], nx = b.st[1];
        if (nloc == 0u) { xcd_barrier_complete(bar, b.x, nloc, nx); b.st[0] = nloc; b.st[1] = nx; }
        const unsigned old = xb_add(&bar[XB_XSUB(b.x)], 1u);
        const unsigned gen = old / nloc;
        if (old + 1u == (gen + 1u) * nloc) {
            __builtin_amdgcn_fence(__ATOMIC_RELEASE, "agent");
            asm volatile("s_waitcnt vmcnt(0)" ::: "memory");
            const unsigned og = xb_add(&bar[XB_TOP], 1u);
            const unsigned tg = og / nx;
            if (og + 1u == (tg + 1u) * nx) xb_add(&bar[XB_TOPGEN], 1u);
            else XB_SPIN(xb_ld(&bar[XB_TOPGEN]) == tg, bar);
            __builtin_amdgcn_fence(__ATOMIC_ACQUIRE, "agent");
            xb_add(&bar[XB_XGEN(b.x)], 1u);
            asm volatile("s_waitcnt vmcnt(0)" ::: "memory");
        } else {
            XB_SPIN(xb_ld(&bar[XB_XGEN(b.x)]) == gen, bar);
            __builtin_amdgcn_fence(__ATOMIC_ACQUIRE, "agent");
            asm volatile("s_waitcnt vmcnt(0)" ::: "memory");
        }
    }
    __syncthreads();
}

struct Ctx {
    const float* x; const int* pos; const float* w_in; const float* w_alpha_up; const float* b_alpha; const float* gla_norm;
    const float* w_gla_o; const float* w_att_o; const float* w_out; const float* ln1_g; const float* ln1_b; const float* w_router; const float* b_router;
    const float* w_e_gate; const float* w_e_up; const float* w_e_down; const float* ln2_g; const float* ln2_b;
    float* out; unsigned char* ws;
    int lo, hi;
};
DI bf16_t* wsb(const Ctx& c, size_t off) { return (bf16_t*)(c.ws + off); }

namespace pg8 {
constexpr int BM = 256, BK = 64, HALF = 128, HTB = HALF * BK * 2, STAGE_BYTES = 8 * HTB, NXCD = 8, WGM = 8;
DI int lds_byte(int r, int c) { const int st = (r >> 4) * 2 + (c >> 5), rr = r & 15, cc = c & 31, ob = rr * 64 + cc * 2; return st * 1024 + (ob ^ (((ob >> 9) & 1) << 5)); }
DI void stage_rc(int b, int& R, int& C) { const int st = b / 1024, sb = b % 1024, swz = sb ^ (((sb >> 9) & 1) << 5); R = (st >> 1) * 16 + swz / 64; C = (st & 1) * 32 + (swz % 64) / 2; }
DI int perm32(int rho) { const int n = rho >> 4, i = rho & 15; return 8 * (i >> 2) + 4 * n + (i & 3); }
struct Unit { int pm, pn, e, nv, ui; };

struct StaticOrder {
    int nM, nN, nwg, G, c, K; const char* A; const char* Bt;
    DI void init(const void* A_, const void* Bt_, int M, int N, int K_, int G_, int c_) { A = (const char*)A_; Bt = (const char*)Bt_; nM = M / BM; nN = N / BM; nwg = nM * nN; G = G_; c = c_; K = K_; }
    DI bool next(int i, Unit& u) const {
        const long L = (long)i * G + c; if (L >= nwg) return false;
        int wgid = (int)L; { const int q = nwg / NXCD, r = nwg % NXCD, xcd = wgid % NXCD, off = wgid / NXCD; wgid = (xcd < r ? xcd * (q + 1) : r * (q + 1) + (xcd - r) * q) + off; }
        const int nig = WGM * nN, gid = wgid / nig, fm = gid * WGM, gsz = (nM - fm) < WGM ? (nM - fm) : WGM;
        u.pm = fm + ((wgid % nig) % gsz); u.pn = (wgid % nig) / gsz; u.e = 0; u.nv = 256; u.ui = i; return true;
    }
    DI const char* a_base(const Unit& u) const { return A + (size_t)u.pm * BM * K * 2; }
    DI const char* b_base(const Unit& u) const { return Bt + (size_t)u.pn * BM * K * 2; }
    DI void a_off(const Unit&, int tid, unsigned (&o)[2][2]) const {
#pragma unroll
        for (int i = 0; i < 2; ++i) { int R, C; stage_rc(tid * 16 + i * 8192, R, C);
#pragma unroll
            for (int h = 0; h < 2; ++h) o[h][i] = (unsigned)((h * HALF + R) * K + C) * 2u; }
    }
};
struct MoeOrder {
    int G, c, ntot, NC, K; const volatile LAS int* pre; const volatile LAS int* cnt; const char* A; const char* Bt; size_t bstride; const volatile LAS int* tab; bool gather;
    DI bool next(int i, Unit& u) const {
        const int L = i * G + c; if (L >= ntot) return false;
        const int rt = L / NC; u.pn = L - rt * NC; u.pm = rt;
        int e = 0;
#pragma unroll
        for (int j = 1; j < 16; ++j) e += (rt >= rfl(pre[j])) ? 1 : 0;
        e = rfl(e); u.e = e; const int rem = rfl(cnt[e]) - 256 * (rt - rfl(pre[e])); u.nv = rem < 256 ? rem : 256; u.ui = i; return true;
    }
    DI const char* a_base(const Unit& u) const { return gather ? A : A + (size_t)u.pm * BM * K * 2; }
    DI const char* b_base(const Unit& u) const { return Bt + (size_t)u.e * bstride + (size_t)u.pn * BM * K * 2; }
    DI void a_off(const Unit& u, int tid, unsigned (&o)[2][2]) const {
#pragma unroll
        for (int i = 0; i < 2; ++i) { int R, C; stage_rc(tid * 16 + i * 8192, R, C);
#pragma unroll
            for (int h = 0; h < 2; ++h) { const int row = gather ? tab[u.ui * 256 + h * HALF + R] : (h * HALF + R); o[h][i] = (unsigned)(row * K + C) * 2u; } }
    }
};

template <class Epi, class Sched, bool F8 = false>
DI void gemm_phase(LAS unsigned char* lds, const int K, const Sched& S, const Epi& E) {
    const int tid = ltid(), wid = rfl(tid >> 6), lane = tid & 63, wr = wid >> 2, wc = wid & 3, fr = lane & 15, fq = lane >> 4;
    const int nt = K / BK;
    unsigned voffB[2];
#pragma unroll
    for (int i = 0; i < 2; ++i) { int R, C; stage_rc(tid * 16 + i * 8192, R, C); const int Rb = Epi::PERM ? ((R & ~31) + perm32(R & 31)) : R; voffB[i] = (unsigned)(Rb * K + C) * 2u; }
    const size_t kstep = (size_t)(BK * 2);
    const size_t hstep = (size_t)HALF * K * 2;
    const unsigned ldsw = (unsigned)wid * 1024u;
    const int aoff = lds_byte(wr * 64 + fr, fq * 8), boff = lds_byte(wc * 32 + fr, fq * 8);
#define PG8_SA(b, h) (((b) * 2 + (h)) * HTB)
#define PG8_SB(b, h) ((4 + (b) * 2 + (h)) * HTB)
#define PG8_STAGE(bufoff, gbase, voff) do { _Pragma("unroll") for (int _i = 0; _i < 2; ++_i) \
        __builtin_amdgcn_global_load_lds((const unsigned*)((const char*)(gbase) + (voff)[_i]), (LAS unsigned*)(lds + (bufoff) + ldsw + _i * 8192), 16, 0, 0); } while (0)
#define PG8_LD8(p) __builtin_shufflevector(*(const LAS i32x4*)(p), *(const LAS i32x4*)((p) + 1024), 0, 1, 2, 3, 4, 5, 6, 7)
#define PG8_LDA(dst, b, h) do { if constexpr (F8) { _Pragma("unroll") for (int m = 0; m < 4; ++m) dst##8[m] = PG8_LD8(lds + PG8_SA(b, h) + aoff + m * 2048); } else { \
        _Pragma("unroll") for (int m = 0; m < 4; ++m) _Pragma("unroll") for (int k = 0; k < 2; ++k) dst[m][k] = *(const LAS bf16x8*)(lds + PG8_SA(b, h) + aoff + m * 2048 + k * 1024); } } while (0)
#define PG8_LDB(dst, b, h) do { if constexpr (F8) { _Pragma("unroll") for (int n = 0; n < 2; ++n) dst##8[n] = PG8_LD8(lds + PG8_SB(b, h) + boff + n * 2048); } else { \
        _Pragma("unroll") for (int n = 0; n < 2; ++n) _Pragma("unroll") for (int k = 0; k < 2; ++k) dst[n][k] = *(const LAS bf16x8*)(lds + PG8_SB(b, h) + boff + n * 2048 + k * 1024); } } while (0)
#define PG8_MMA(ai, bj, At, Bt) do { __builtin_amdgcn_s_setprio(1); if constexpr (F8) { _Pragma("unroll") for (int m = 0; m < 4; ++m) _Pragma("unroll") for (int n = 0; n < 2; ++n) \
        asm volatile("v_mfma_scale_f32_16x16x128_f8f6f4 %0, %1, %2, %0, %3, %4 op_sel_hi:[0,0,0]" : "+v"(acc[ai][bj][m][n]) : "v"(Bt##8[n]), "v"(At##8[m]), "v"(sc_w), "v"(sc_a)); } else { \
        _Pragma("unroll") for (int m = 0; m < 4; ++m) _Pragma("unroll") for (int n = 0; n < 2; ++n) _Pragma("unroll") for (int k = 0; k < 2; ++k) \
        acc[ai][bj][m][n] = __builtin_amdgcn_mfma_f32_16x16x32_bf16(Bt[n][k], At[m][k], acc[ai][bj][m][n], 0, 0, 0); } __builtin_amdgcn_s_setprio(0); } while (0)
#define PG8_MMA0(ai, bj, At, Bt) do { __builtin_amdgcn_s_setprio(1); _Pragma("unroll") for (int m = 0; m < 4; ++m) _Pragma("unroll") for (int n = 0; n < 2; ++n) \
        asm volatile("v_mfma_scale_f32_16x16x128_f8f6f4 %0, %1, %2, 0, %3, %4 op_sel_hi:[0,0,0]" : "=&v"(acc[ai][bj][m][n]) : "v"(Bt##8[n]), "v"(At##8[m]), "v"(sc_w), "v"(sc_a)); __builtin_amdgcn_s_setprio(0); } while (0)
#define PG8_WAIT_V(n) asm volatile("s_waitcnt vmcnt(" #n ")" ::: "memory")
#define PG8_WAIT_L(n) asm volatile("s_waitcnt lgkmcnt(" #n ")" ::: "memory")
#define PG8_BAR __builtin_amdgcn_s_barrier()
#define PG8_SCHED __builtin_amdgcn_sched_barrier(0)
    Unit cur, nxt; int ui = 0;
    if (!S.next(0, cur)) return;
    f32x4 acc[2][2][4][2];
    if constexpr (!F8)
#pragma unroll
    for (int a = 0; a < 2; ++a)
#pragma unroll
        for (int b = 0; b < 2; ++b)
#pragma unroll
            for (int m = 0; m < 4; ++m)
#pragma unroll
                for (int n = 0; n < 2; ++n) acc[a][b][m][n] = (f32x4){0.f, 0.f, 0.f, 0.f};
    int sc_w = 0x79797979, sc_a = 0x7f7f7f7f; asm volatile("" : "+v"(sc_w), "+v"(sc_a));
    bf16x8 At[4][2], B0[2][2], B1[2][2]; i32x8 At8[4], B08[2], B18[2];
    unsigned oA[2][2]; S.a_off(cur, tid, oA);
    const char* cA = S.a_base(cur); const char* cB = S.b_base(cur);
    PG8_STAGE(PG8_SB(0, 0), cB, voffB); PG8_STAGE(PG8_SB(0, 1), cB + hstep, voffB); PG8_STAGE(PG8_SA(0, 0), cA, oA[0]); PG8_STAGE(PG8_SA(0, 1), cA, oA[1]);
    if (wr == 1) PG8_BAR;
    PG8_WAIT_V(2); PG8_BAR;
    PG8_STAGE(PG8_SB(1, 0), cB + kstep, voffB); PG8_STAGE(PG8_SA(1, 0), cA + kstep, oA[0]); PG8_STAGE(PG8_SB(1, 1), cB + hstep + kstep, voffB);
    PG8_WAIT_V(6); PG8_BAR;
    for (;;) {
        const bool has_next = S.next(ui + 1, nxt);
        const char* nA = has_next ? S.a_base(nxt) : cA; const char* nB = has_next ? S.b_base(nxt) : cB;
        for (int t = 0; t < nt; t += 2) {
            const bool last = (t == nt - 2);
            const char* a1 = cA + (size_t)(t + 1) * kstep;
            const char* a2 = last ? nA : cA + (size_t)(t + 2) * kstep; const char* b2 = last ? nB : cB + (size_t)(t + 2) * kstep;
            const char* a3 = a2 + kstep; const char* b3 = b2 + kstep;
            PG8_LDB(B0, 0, 0); PG8_LDB(B1, 0, 1); PG8_SCHED; PG8_LDA(At, 0, 0); PG8_STAGE(PG8_SA(1, 1), a1, oA[1]);
            if (last && has_next) S.a_off(nxt, tid, oA);
            PG8_WAIT_V(8); PG8_WAIT_L(0); PG8_BAR; if (F8 && t == 0) { PG8_MMA0(0, 0, At, B0); PG8_MMA0(0, 1, At, B1); } else { PG8_MMA(0, 0, At, B0); PG8_MMA(0, 1, At, B1); } PG8_BAR; PG8_SCHED;
            PG8_LDA(At, 0, 1); PG8_STAGE(PG8_SB(0, 0), b2, voffB); PG8_STAGE(PG8_SB(0, 1), b2 + hstep, voffB); PG8_STAGE(PG8_SA(0, 0), a2, oA[0]);
            PG8_WAIT_V(8); PG8_WAIT_L(0); PG8_BAR; if (F8 && t == 0) { PG8_MMA0(1, 0, At, B0); PG8_MMA0(1, 1, At, B1); } else { PG8_MMA(1, 0, At, B0); PG8_MMA(1, 1, At, B1); } PG8_BAR; PG8_SCHED;
            PG8_LDB(B0, 1, 0); PG8_LDB(B1, 1, 1); PG8_SCHED; PG8_LDA(At, 1, 0); PG8_STAGE(PG8_SA(0, 1), a2, oA[1]);
            PG8_WAIT_V(8); PG8_WAIT_L(0); PG8_BAR; PG8_MMA(0, 0, At, B0); PG8_MMA(0, 1, At, B1); PG8_BAR; PG8_SCHED;
            PG8_LDA(At, 1, 1); PG8_STAGE(PG8_SB(1, 0), b3, voffB); PG8_STAGE(PG8_SB(1, 1), b3 + hstep, voffB); PG8_STAGE(PG8_SA(1, 0), a3, oA[0]);
            PG8_WAIT_V(8); PG8_WAIT_L(0); PG8_BAR; PG8_MMA(1, 0, At, B0); PG8_MMA(1, 1, At, B1); PG8_BAR; PG8_SCHED;
        }
        if (wr == 0) PG8_BAR;
        if constexpr (F8) asm volatile("s_nop 15\n\ts_nop 15" ::: "memory");
        E(acc, cur, wr, wc, fr, fq);
        if (!has_next) break;
        if constexpr (!F8)
#pragma unroll
        for (int a = 0; a < 2; ++a)
#pragma unroll
            for (int b = 0; b < 2; ++b)
#pragma unroll
                for (int m = 0; m < 4; ++m)
#pragma unroll
                    for (int n = 0; n < 2; ++n) acc[a][b][m][n] = (f32x4){0.f, 0.f, 0.f, 0.f};
        cur = nxt; cA = nA; cB = nB; ++ui;
        if (wr == 1) PG8_BAR;
    }
    PG8_WAIT_V(0);
    PG8_BAR;
#undef PG8_SA
#undef PG8_SB
#undef PG8_STAGE
#undef PG8_LDA
#undef PG8_LDB
#undef PG8_MMA
#undef PG8_MMA0
#undef PG8_LD8
#undef PG8_WAIT_V
#undef PG8_WAIT_L
#undef PG8_BAR
#undef PG8_SCHED
}
}
using pg8::Unit;

DI u32x4 pack8(const f32x4& v0, const f32x4& v1) { u32x4 w; w.x = cvt_pk_bf16(v0[0], v0[1]); w.y = cvt_pk_bf16(v0[2], v0[3]); w.z = cvt_pk_bf16(v1[0], v1[1]); w.w = cvt_pk_bf16(v1[2], v1[3]); return w; }

struct EpiIn {
    static constexpr bool PERM = true;
    bf16_t *qg, *kg, *vg, *sr, *qd, *kd, *vd, *gt; float* ha; const int* pos;
    DI void operator()(const f32x4 (&acc)[2][2][4][2], const Unit& u, int wr, int wc, int fr, int fq) const {
        asm volatile("" : "+v"(fr), "+v"(fq));
        const int row0 = u.pm * 256 + wr * 64 + fr; const int pn = u.pn;
        if (pn >= 12 && pn < 24) {
            bf16_t* base = pn < 18 ? qd : kd; const int tq = pn < 18 ? pn - 12 : pn - 18; const float sc = pn < 18 ? 0.125f * LOG2E : 1.0f;
            float fre[8];
#pragma unroll
            for (int i = 0; i < 8; ++i) fre[i] = __builtin_amdgcn_exp2f(-(float)(8 * fq + i) * (13.287712379549449f / 32.0f)) * 0.15915494309189535f;
#pragma unroll
            for (int ai = 0; ai < 2; ++ai) {
                int posv[4];
#pragma unroll
                for (int q = 0; q < 4; ++q) posv[q] = pos[row0 + ai * 128 + q * 16];
#pragma unroll
                for (int m = 0; m < 4; ++m) {
                    const int r = row0 + ai * 128 + m * 16; const float p = (float)posv[m];
                    bf16_t* rowp = base + (size_t)r * 1536 + (4 * tq + wc) * 64 + 8 * fq;
#pragma unroll
                    for (int n = 0; n < 2; ++n) { f32x4 o1, o2;
#pragma unroll
                        for (int j = 0; j < 4; ++j) {
                            float a = p * fre[n * 4 + j]; a = a - __builtin_floorf(a);
                            const float sn = __builtin_amdgcn_sinf(a), cs = __builtin_amdgcn_cosf(a);
                            const float x1 = acc[ai][0][m][n][j], x2 = acc[ai][1][m][n][j];
                            o1[j] = (x1 * cs - x2 * sn) * sc; o2[j] = (x2 * cs + x1 * sn) * sc;
                        }
                        u32x2 w1, w2; w1.x = cvt_pk_bf16(o1[0], o1[1]); w1.y = cvt_pk_bf16(o1[2], o1[3]); w2.x = cvt_pk_bf16(o2[0], o2[1]); w2.y = cvt_pk_bf16(o2[2], o2[3]);
                        *(GAS u32x2*)(rowp + 4 * n) = w1; *(GAS u32x2*)(rowp + 32 + 4 * n) = w2; }
                    asm volatile("" ::: "memory");
                } }
        } else if (pn == 38) {
            if (wc == 0 && fq < 2) {
#pragma unroll
                for (int ai = 0; ai < 2; ++ai)
#pragma unroll
                    for (int m = 0; m < 4; ++m) { float* p = ha + (size_t)(row0 + ai * 128 + m * 16) * 16 + 8 * fq; *(GAS f32x4*)p = acc[ai][0][m][0]; *(GAS f32x4*)(p + 4) = acc[ai][0][m][1]; }
            }
        } else {
            bf16_t* base; int ldc, colt, act = 0; float sc = 1.0f;
            if (pn < 2) { base = qg; ldc = 512; colt = pn * 256; sc = 0.08838834764831845f; }
            else if (pn < 4) { base = kg; ldc = 512; colt = (pn - 2) * 256; }
            else if (pn < 8) { base = vg; ldc = 1024; colt = (pn - 4) * 256; }
            else if (pn < 12) {
#pragma unroll
                for (int ai = 0; ai < 2; ++ai)
#pragma unroll
                    for (int m = 0; m < 4; ++m) { unsigned char* rowp = (unsigned char*)sr + (size_t)(row0 + ai * 128 + m * 16) * 1024 + (pn - 8) * 256 + wc * 32 + 8 * fq;
#pragma unroll
                        for (int bj = 0; bj < 2; ++bj) { const f32x4 v0 = acc[ai][bj][m][0], v1 = acc[ai][bj][m][1]; u32x2 o;
                            o.x = pk4_fp8(v0[0] * sigmoidf_(v0[0]), v0[1] * sigmoidf_(v0[1]), v0[2] * sigmoidf_(v0[2]), v0[3] * sigmoidf_(v0[3]));
                            o.y = pk4_fp8(v1[0] * sigmoidf_(v1[0]), v1[1] * sigmoidf_(v1[1]), v1[2] * sigmoidf_(v1[2]), v1[3] * sigmoidf_(v1[3]));
                            *(GAS u32x2*)(rowp + bj * 128) = o; } }
                return; }
            else if (pn < 30) { base = vd; ldc = 1536; colt = (pn - 24) * 256; }
            else {
#pragma unroll
                for (int ai = 0; ai < 2; ++ai)
#pragma unroll
                    for (int m = 0; m < 4; ++m) { unsigned char* rowp = (unsigned char*)gt + (size_t)(row0 + ai * 128 + m * 16) * 2048 + (pn - 30) * 256 + wc * 32 + 8 * fq;
#pragma unroll
                        for (int bj = 0; bj < 2; ++bj) { unsigned w[2];
#pragma unroll
                            for (int n = 0; n < 2; ++n) { const f32x4 v = acc[ai][bj][m][n];
                                w[n] = (unsigned)(sigmoidf_(v[0]) * 255.0f + 0.5f) | ((unsigned)(sigmoidf_(v[1]) * 255.0f + 0.5f) << 8) | ((unsigned)(sigmoidf_(v[2]) * 255.0f + 0.5f) << 16) | ((unsigned)(sigmoidf_(v[3]) * 255.0f + 0.5f) << 24); }
                            *(GAS u32x2*)(rowp + bj * 128) = (u32x2){w[0], w[1]}; } }
                return; }
#pragma unroll
            for (int ai = 0; ai < 2; ++ai)
#pragma unroll
                for (int m = 0; m < 4; ++m) { bf16_t* rowp = base + (size_t)(row0 + ai * 128 + m * 16) * ldc + colt + wc * 32 + 8 * fq;
#pragma unroll
                    for (int bj = 0; bj < 2; ++bj) { f32x4 v0 = acc[ai][bj][m][0] * sc, v1 = acc[ai][bj][m][1] * sc;
                        if (act) {
#pragma unroll
                            for (int j = 0; j < 4; ++j) { const float s0 = sigmoidf_(v0[j]), s1 = sigmoidf_(v1[j]); v0[j] = act == 1 ? v0[j] * s0 : s0; v1[j] = act == 1 ? v1[j] * s1 : s1; } }
                        *(GAS u32x4*)(rowp + bj * 128) = pack8(v0, v1); } }
        }
    }
};
template <bool ADD> struct EpiGate {
    static constexpr bool PERM = true;
    bf16_t* mix; const unsigned char* gt; unsigned char* mix8;
    DI void operator()(const f32x4 (&acc)[2][2][4][2], const Unit& u, int wr, int wc, int fr, int fq) const {
        asm volatile("" : "+v"(fr), "+v"(fq));
        const int row0 = u.pm * 256 + wr * 64 + fr, col0 = u.pn * 256 + wc * 32 + 8 * fq; constexpr float k = 1.0f / 255.0f;
#pragma unroll
        for (int ai = 0; ai < 2; ++ai)
#pragma unroll
            for (int m = 0; m < 4; ++m) { const size_t r = (size_t)(row0 + ai * 128 + m * 16);
#pragma unroll
                for (int bj = 0; bj < 2; ++bj) {
                    const u32x2 g = *(const GAS u32x2*)(gt + r * 2048 + col0 + bj * 128);
                    f32x4 v0 = acc[ai][bj][m][0], v1 = acc[ai][bj][m][1];
                    v0[0] *= (float)((g.x >> 0) & 0xffu) * k; v0[1] *= (float)((g.x >> 8) & 0xffu) * k; v0[2] *= (float)((g.x >> 16) & 0xffu) * k; v0[3] *= (float)((g.x >> 24) & 0xffu) * k;
                    v1[0] *= (float)((g.y >> 0) & 0xffu) * k; v1[1] *= (float)((g.y >> 8) & 0xffu) * k; v1[2] *= (float)((g.y >> 16) & 0xffu) * k; v1[3] *= (float)((g.y >> 24) & 0xffu) * k;
                    bf16_t* mp = mix + r * 1024 + col0 + bj * 128;
                    if (ADD) { const u32x4 o = *(const GAS u32x4*)mp; v0[0] += bf_lo(o.x); v0[1] += bf_hi(o.x); v0[2] += bf_lo(o.y); v0[3] += bf_hi(o.y); v1[0] += bf_lo(o.z); v1[1] += bf_hi(o.z); v1[2] += bf_lo(o.w); v1[3] += bf_hi(o.w);
                        u32x2 o8; o8.x = pk4_fp8(v0[0], v0[1], v0[2], v0[3]); o8.y = pk4_fp8(v1[0], v1[1], v1[2], v1[3]); *(GAS u32x2*)(mix8 + r * 1024 + col0 + bj * 128) = o8; }
                    else *(GAS u32x4*)mp = pack8(v0, v1); } }
    }
};
struct EpiRes {
    static constexpr bool PERM = true;
    const float* x32; bf16_t* xr;
    DI void operator()(const f32x4 (&acc)[2][2][4][2], const Unit& u, int wr, int wc, int fr, int fq) const {
        asm volatile("" : "+v"(fr), "+v"(fq));
        const int row0 = u.pm * 256 + wr * 64 + fr, col0 = u.pn * 256 + wc * 32 + 8 * fq;
#pragma unroll
        for (int ai = 0; ai < 2; ++ai)
#pragma unroll
            for (int m = 0; m < 4; ++m) { const size_t off = (size_t)(row0 + ai * 128 + m * 16) * 1024 + col0;
#pragma unroll
                for (int bj = 0; bj < 2; ++bj) { f32x4 a0, a1;
                    if (x32) { a0 = *(const GAS f32x4*)(x32 + off + bj * 128); a1 = *(const GAS f32x4*)(x32 + off + bj * 128 + 4); }
                    else { const u32x4 o = *(const GAS u32x4*)(xr + off + bj * 128); a0 = (f32x4){bf_lo(o.x), bf_hi(o.x), bf_lo(o.y), bf_hi(o.y)}; a1 = (f32x4){bf_lo(o.z), bf_hi(o.z), bf_lo(o.w), bf_hi(o.w)}; }
                    *(GAS u32x4*)(xr + off + bj * 128) = pack8(a0 * DN_ALPHA + acc[ai][bj][m][0], a1 * DN_ALPHA + acc[ai][bj][m][1]); }
                if (m & 1) asm volatile("" ::: "memory"); }
    }
};
struct EpiM1 {
    static constexpr bool PERM = true;
    unsigned char* hm;
    DI void operator()(const f32x4 (&acc)[2][2][4][2], const Unit& u, int wr, int wc, int fr, int fq) const {
        asm volatile("" : "+v"(fr), "+v"(fq));
        const int row0 = u.pm * 256 + wr * 64 + fr, col0 = u.pn * 128 + wc * 32 + 8 * fq;
#pragma unroll
        for (int ai = 0; ai < 2; ++ai)
#pragma unroll
            for (int m = 0; m < 4; ++m) { f32x4 v0, v1;
#pragma unroll
                for (int j = 0; j < 4; ++j) { const float g0 = acc[ai][0][m][0][j], g1 = acc[ai][0][m][1][j]; v0[j] = g0 * sigmoidf_(g0) * acc[ai][1][m][0][j]; v1[j] = g1 * sigmoidf_(g1) * acc[ai][1][m][1][j]; }
                u32x2 o; o.x = pk4_fp8(v0[0], v0[1], v0[2], v0[3]); o.y = pk4_fp8(v1[0], v1[1], v1[2], v1[3]);
                *(GAS u32x2*)(hm + (size_t)(row0 + ai * 128 + m * 16) * 1024 + col0) = o; }
    }
};
struct EpiM2 {
    static constexpr bool PERM = true;
    unsigned char* ys; const int* list; const volatile LAS int* pre;
    DI void operator()(const f32x4 (&acc)[2][2][4][2], const Unit& u, int wr, int wc, int fr, int fq) const {
        asm volatile("" : "+v"(fr), "+v"(fq));
        const int lrow0 = wr * 64 + fr, col0 = u.pn * 256 + wc * 32 + 8 * fq; const int lt = u.pm - rfl(pre[u.e]);
        const int* lp = list + (size_t)u.e * T + 256 * lt;
        int slotv[8];
#pragma unroll
        for (int q = 0; q < 8; ++q) { const int r = lrow0 + (q >> 2) * 128 + (q & 3) * 16; slotv[q] = lp[r < u.nv ? r : 0]; }
#pragma unroll
        for (int ai = 0; ai < 2; ++ai)
#pragma unroll
            for (int m = 0; m < 4; ++m) { const int r = lrow0 + ai * 128 + m * 16;
                if (r < u.nv) { const int slot = slotv[ai * 4 + m]; unsigned char* yp = ys + (size_t)slot * 1024 + col0;
#pragma unroll
                    for (int bj = 0; bj < 2; ++bj) { const f32x4 v0 = acc[ai][bj][m][0], v1 = acc[ai][bj][m][1]; u32x2 o; o.x = pk4_fp8(v0[0], v0[1], v0[2], v0[3]); o.y = pk4_fp8(v1[0], v1[1], v1[2], v1[3]); *(GAS u32x2*)(yp + bj * 128) = o; } } }
    }
};

struct WItem { const float* W; unsigned char* WT; int N, K, drow, c0, nv, kb; };
DI WItem w_decode(const Ctx& c, int l, int it) {
    constexpr int I_IN = (NIN / 32) * 16, I_GO = 512, I_AO = 256, I_OUT = 512, I_EXP = 16 * 512;
    WItem w; int r = it;
    if (r < I_IN) {
        const int nbg = r >> 4, kb = r & 15, n0 = 32 * nbg, tile = n0 >> 8, p = n0 & 255; int c0, nv = 32;
        if (tile < 12) c0 = n0;
        else if (tile < 24) { const int base = tile < 18 ? 3088 : 4624, tq = tile < 18 ? tile - 12 : tile - 18; c0 = base + (4 * tq + ((p & 127) >> 5)) * 64 + (p >= 128 ? 32 : 0); }
        else if (tile < 30) c0 = 6160 + (n0 - 24 * 256);
        else if (tile < 38) c0 = 7696 + (n0 - 30 * 256);
        else { c0 = 3072; nv = (p == 0) ? 16 : 0; }
        w.W = c.w_in + (size_t)l * D * DIN; w.N = DIN; w.WT = c.ws + WS_WIN; w.K = D; w.drow = n0; w.c0 = c0; w.nv = nv; w.kb = kb; return w; }
    r -= I_IN;
    if (r < I_GO) { w.W = c.w_gla_o + (size_t)l * D * D; w.N = D; w.WT = c.ws + WS_WGO; w.K = D; w.drow = 32 * (r >> 4); w.c0 = w.drow; w.nv = 32; w.kb = r & 15; return w; }
    r -= I_GO;
    if (r < I_AO) { w.W = c.w_att_o + (size_t)l * 512 * D; w.N = D; w.WT = c.ws + WS_WAO; w.K = 512; w.drow = 32 * (r >> 3); w.c0 = w.drow; w.nv = 32; w.kb = r & 7; return w; }
    r -= I_AO;
    if (r < I_OUT) { w.W = c.w_out + (size_t)l * D * D; w.N = D; w.WT = c.ws + WS_WOUT; w.K = D; w.drow = 32 * (r >> 4); w.c0 = w.drow; w.nv = 32; w.kb = r & 15; return w; }
    r -= I_OUT;
    const int which = r / I_EXP; r -= which * I_EXP; const int e = r >> 9, q = r & 511, nbg = q >> 4; const size_t eoff = (size_t)(l * NEXP + e) * D * DFF;
    w.N = DFF; w.K = D; w.c0 = 32 * nbg; w.nv = 32; w.kb = q & 15;
    if (which == 0) { w.W = c.w_e_gate + eoff; w.WT = c.ws + WS_WGU + (size_t)e * 2048 * 1024; w.drow = 256 * (nbg >> 2) + 32 * (nbg & 3); }
    else if (which == 1) { w.W = c.w_e_up + eoff; w.WT = c.ws + WS_WGU + (size_t)e * 2048 * 1024; w.drow = 256 * (nbg >> 2) + 128 + 32 * (nbg & 3); }
    else { w.W = c.w_e_down + eoff; w.N = D; w.K = DFF; w.WT = c.ws + WS_WD + (size_t)e * 1024 * 1024; w.drow = 32 * nbg; }
    return w;
}
DI void w_load(const WItem& w, int lane, float (&v)[32]) {
    const int cc = lane & 31, ccl = cc < w.nv ? cc : 0; const GAS float* wp = (const GAS float*)w.W + (size_t)(64 * w.kb + (lane >> 5)) * w.N + w.c0 + ccl;
#pragma unroll
    for (int i = 0; i < 32; ++i) v[i] = wp[(size_t)(2 * i) * w.N];
}
DI void w_store(const WItem& w, int lane, const float (&v)[32], LAS float* scr) {
    const int cc = lane & 31, k0 = 64 * w.kb;
#pragma unroll
    for (int i = 0; i < 32; ++i) scr[(2 * i + (lane >> 5)) * 33 + cc] = (cc < w.nv) ? v[i] : 0.f;
    LDS_WAIT(); asm volatile("" ::: "memory");
    const int c = lane & 7;
#pragma unroll
    for (int j = 0; j < 4; ++j) { const int n = (lane >> 3) + 8 * j; const LAS float* s = scr + (8 * c) * 33 + n;
        u32x2 o; o.x = pk4_fp8(s[0 * 33] * W8_SCALE, s[1 * 33] * W8_SCALE, s[2 * 33] * W8_SCALE, s[3 * 33] * W8_SCALE); o.y = pk4_fp8(s[4 * 33] * W8_SCALE, s[5 * 33] * W8_SCALE, s[6 * 33] * W8_SCALE, s[7 * 33] * W8_SCALE);
        *(GAS u32x2*)(w.WT + (size_t)(w.drow + n) * w.K + k0 + 8 * c) = o; }
    LDS_WAIT(); asm volatile("" ::: "memory");
}
DI void phase_w(LAS unsigned char* lds, const Ctx& c, int l, int G) {
    const int tid = ltid(), lane = tid & 63, wave = rfl(tid >> 6);
    LAS float* scr = (LAS float*)(lds + wave * 16384);
    const int gw = lbid() * NWAVES + wave, NGW = G * NWAVES;
    constexpr int NITEMS = (NIN / 32) * 16 + 512 + 256 + 512 + 3 * 16 * 512;
    float va[32], vb[32]; WItem wa, wb;
    int it = gw;
    if (it < NITEMS) { wa = w_decode(c, l, it); w_load(wa, lane, va); }
    while (it < NITEMS) {
        const bool hb = it + NGW < NITEMS; if (hb) { wb = w_decode(c, l, it + NGW); w_load(wb, lane, vb); }
        w_store(wa, lane, va, scr);
        it += NGW; if (it >= NITEMS) break;
        const bool ha = it + NGW < NITEMS; if (ha) { wa = w_decode(c, l, it + NGW); w_load(wa, lane, va); }
        w_store(wb, lane, vb, scr);
        it += NGW;
    }
    if (l == 0) {
        const size_t n8 = (size_t)T * D / 8; unsigned char* xb = c.ws + WS_XB;
        for (size_t i = (size_t)lbid() * NTHREADS + tid; i < n8; i += (size_t)G * NTHREADS) { const f32x4 a = *(const GAS f32x4*)(c.x + i * 8), b = *(const GAS f32x4*)(c.x + i * 8 + 4);
            u32x2 o; o.x = pk4_fp8(a[0], a[1], a[2], a[3]); o.y = pk4_fp8(b[0], b[1], b[2], b[3]); *(GAS u32x2*)(xb + i * 8) = o; }
    }
}

DI s16x4 tr16(const LAS void* p) { return __builtin_bit_cast(s16x4, __builtin_amdgcn_ds_read_tr16_b64_v4i16((LAS s16x4*)p)); }
DI bf16x8 cat8(s16x4 lo, s16x4 hi) { return __builtin_shufflevector(lo, hi, 0, 1, 2, 3, 4, 5, 6, 7); }
#define MFMA16(a, b, c) __builtin_amdgcn_mfma_f32_16x16x32_bf16((a), (b), (c), 0, 0, 0)

constexpr int REC_BYTES = 33792, REC_KS = 16384, REC_DEC = 32768, OI_BYTES = 16384;
constexpr int GP_QT = 0, GP_KT = 17408, GP_VS = 34816, GP_ATT = 68608, GP_WUP = 77824, GP_BAL = 86016;
DI float exp_(float x) { return __builtin_amdgcn_exp2f(x * LOG2E); }
DI void unpack8(const u32x4& q, float (&v)[16], int o) { v[o] = bf_lo(q.x); v[o + 1] = bf_hi(q.x); v[o + 2] = bf_lo(q.y); v[o + 3] = bf_hi(q.y); v[o + 4] = bf_lo(q.z); v[o + 5] = bf_hi(q.z); v[o + 6] = bf_lo(q.w); v[o + 7] = bf_hi(q.w); }
DI u32x4 packf8(const float (&v)[16], int o) { u32x4 p; p.x = cvt_pk_bf16(v[o], v[o + 1]); p.y = cvt_pk_bf16(v[o + 2], v[o + 3]); p.z = cvt_pk_bf16(v[o + 4], v[o + 5]); p.w = cvt_pk_bf16(v[o + 6], v[o + 7]); return p; }
DI void gla_p_unit(LAS unsigned char* lds, const Ctx& c, int l, int bl, int h, int n, int& h_loaded) {
    const int tid = ltid(), lane = tid & 63, w = rfl(tid >> 6), fr = lane & 15, fq = lane >> 4;
    const size_t tok0 = (size_t)bl * SEQ + n * 64;
    const bf16_t* QG = wsb(c, WS_H + H_QG) + tok0 * 512 + h * 128;
    const bf16_t* KG = wsb(c, WS_H + H_KG) + tok0 * 512 + h * 128;
    const bf16_t* VG = wsb(c, WS_H + H_VG) + tok0 * 1024 + h * 256;
    const float* HA = (const float*)(c.ws + WS_HA) + tok0 * 16;
    const int unit = (bl * 4 + h) * 64 + n;
    unsigned char* rec = c.ws + WS_REC + (size_t)unit * REC_BYTES;
    unsigned char* oi = c.ws + WS_MIX + (size_t)unit * OI_BYTES;
    LAS bf16_t* QT = (LAS bf16_t*)(lds + GP_QT); LAS bf16_t* KT = (LAS bf16_t*)(lds + GP_KT); LAS bf16_t* VS = (LAS bf16_t*)(lds + GP_VS); LAS bf16_t* AT = (LAS bf16_t*)(lds + GP_ATT);
    LAS float* WUP = (LAS float*)(lds + GP_WUP); LAS float* BAL = (LAS float*)(lds + GP_BAL);
    __syncthreads();
    if (h_loaded != h) { for (int i = tid; i < 16 * 128; i += NTHREADS) WUP[i] = c.w_alpha_up[(size_t)l * 16 * 512 + (i >> 7) * 512 + h * 128 + (i & 127)];
        if (tid < 128) BAL[tid] = c.b_alpha[l * 512 + h * 128 + tid]; h_loaded = h; __syncthreads(); }
    {
        const int row = lane;
        f32x4 a4[4];
#pragma unroll
        for (int j = 0; j < 4; ++j) a4[j] = *(const GAS f32x4*)(HA + (size_t)row * 16 + 4 * j);
        const u32x4 q0 = *(const GAS u32x4*)(QG + (size_t)row * 512 + 16 * w), q1 = *(const GAS u32x4*)(QG + (size_t)row * 512 + 16 * w + 8);
        const u32x4 k0 = *(const GAS u32x4*)(KG + (size_t)row * 512 + 16 * w), k1 = *(const GAS u32x4*)(KG + (size_t)row * 512 + 16 * w + 8);
#pragma unroll
        for (int c2 = 0; c2 < 4; ++c2) { const int idx = tid + NTHREADS * c2, r = idx >> 5, ch = idx & 31; *(LAS u32x4*)(VS + r * 264 + ch * 8) = *(const GAS u32x4*)(VG + (size_t)r * 1024 + ch * 8); }
        float la[16];
#pragma unroll
        for (int cc = 0; cc < 16; ++cc) la[cc] = BAL[16 * w + cc];
#pragma unroll
        for (int j = 0; j < 16; ++j) { const float aj = a4[j >> 2][j & 3];
#pragma unroll
            for (int c4 = 0; c4 < 4; ++c4) { const f32x4 wv = *(const LAS f32x4*)(WUP + j * 128 + 16 * w + 4 * c4); la[4 * c4] += aj * wv[0]; la[4 * c4 + 1] += aj * wv[1]; la[4 * c4 + 2] += aj * wv[2]; la[4 * c4 + 3] += aj * wv[3]; } }
#pragma unroll
        for (int cc = 0; cc < 16; ++cc) { const float z = la[cc]; la[cc] = -(fmaxf(-z, 0.f) + __builtin_amdgcn_logf(1.0f + exp_(-fabsf(z))) * 0.6931471805599453f) * (1.0f / 16.0f); }
#pragma unroll
        for (int dlt = 1; dlt < 64; dlt <<= 1)
#pragma unroll
            for (int cc = 0; cc < 16; ++cc) { const float t = __shfl_up(la[cc], dlt); if (lane >= dlt) la[cc] += t; }
        float qv[16], kv[16];
        unpack8(q0, qv, 0); unpack8(q1, qv, 8); unpack8(k0, kv, 0); unpack8(k1, kv, 8);
        float dc[16];
#pragma unroll
        for (int cc = 0; cc < 16; ++cc) { const float b = la[cc]; const float bend = __shfl(b, 63); const float eb = exp_(b); dc[cc] = eb; qv[cc] *= eb; la[cc] = kv[cc] * exp_(bend - b); kv[cc] *= exp_(-b); }
        if (lane == 63) {
#pragma unroll
            for (int c4 = 0; c4 < 4; ++c4) *(GAS f32x4*)(rec + REC_DEC + (16 * w + 4 * c4) * 4) = (f32x4){dc[4 * c4], dc[4 * c4 + 1], dc[4 * c4 + 2], dc[4 * c4 + 3]}; }
        const u32x4 qa = packf8(qv, 0), qb = packf8(qv, 8), ka = packf8(kv, 0), kb = packf8(kv, 8), sa = packf8(la, 0), sb = packf8(la, 8);
        *(LAS u32x4*)(QT + row * 136 + 16 * w) = qa; *(LAS u32x4*)(QT + row * 136 + 16 * w + 8) = qb;
        *(LAS u32x4*)(KT + row * 136 + 16 * w) = ka; *(LAS u32x4*)(KT + row * 136 + 16 * w + 8) = kb;
        *(GAS u32x4*)(rec + row * 256 + (((2 * w) ^ (row & 15)) << 4)) = qa; *(GAS u32x4*)(rec + row * 256 + (((2 * w + 1) ^ (row & 15)) << 4)) = qb;
        *(GAS u32x4*)(rec + REC_KS + row * 256 + (((2 * w) ^ (2 * (row & 7))) << 4)) = sa; *(GAS u32x4*)(rec + REC_KS + row * 256 + (((2 * w + 1) ^ (2 * (row & 7))) << 4)) = sb;
    }
    __syncthreads();
#pragma unroll
    for (int rep = 0; rep < 2; ++rep) {
        const int tt = w + 8 * rep, jt = tt >> 2, it = tt & 3;
        f32x4 a = (f32x4){0.f, 0.f, 0.f, 0.f};
        if (jt <= it) {
#pragma unroll
            for (int k4 = 0; k4 < 4; ++k4) { const bf16x8 af = *(const LAS bf16x8*)(KT + (16 * jt + fr) * 136 + 32 * k4 + 8 * fq), bfr = *(const LAS bf16x8*)(QT + (16 * it + fr) * 136 + 32 * k4 + 8 * fq); a = MFMA16(af, bfr, a); }
        }
        const int i = 16 * it + fr, j0 = 16 * jt + 4 * fq;
        u32x2 o; o.x = cvt_pk_bf16(j0 <= i ? a[0] : 0.f, j0 + 1 <= i ? a[1] : 0.f); o.y = cvt_pk_bf16(j0 + 2 <= i ? a[2] : 0.f, j0 + 3 <= i ? a[3] : 0.f);
        *(LAS u32x2*)(AT + i * 72 + j0) = o;
    }
    __syncthreads();
    {
        const int dv0 = 32 * w;
        bf16x8 vb[2][2];
#pragma unroll
        for (int k2 = 0; k2 < 2; ++k2)
#pragma unroll
            for (int dt = 0; dt < 2; ++dt) { const LAS bf16_t* p = VS + (32 * k2 + 8 * fq + (fr >> 2)) * 264 + dv0 + 16 * dt + (fr & 3) * 4; vb[k2][dt] = cat8(tr16(p), tr16(p + 4 * 264)); }
#pragma unroll
        for (int tt = 0; tt < 4; ++tt) {
            const bf16x8 a0 = *(const LAS bf16x8*)(AT + (16 * tt + fr) * 72 + 8 * fq), a1 = *(const LAS bf16x8*)(AT + (16 * tt + fr) * 72 + 32 + 8 * fq);
#pragma unroll
            for (int dt = 0; dt < 2; ++dt) { f32x4 z = (f32x4){0.f, 0.f, 0.f, 0.f}; z = MFMA16(vb[0][dt], a0, z); z = MFMA16(vb[1][dt], a1, z);
                *(GAS unsigned*)(oi + ((w * 8 + tt * 2 + dt) * 64 + lane) * 4) = pk4_fp8(z[0], z[1], z[2], z[3]); }
        }
    }
}
constexpr int GSEG = 16, NSEG = 64 / GSEG;
constexpr int GL_STAGE = 50176, GL_DEC = 16384, GL_VS = 17408;
DI void gla_l_chain(LAS unsigned char* lds, const Ctx& c, int bl, int h, int seg) {
    const int tid = ltid(), lane = tid & 63, w = rfl(tid >> 6), fr = lane & 15, fq = lane >> 4;
    const size_t t0 = (size_t)bl * SEQ + (size_t)seg * (GSEG * 64);
    const bf16_t* VG = wsb(c, WS_H + H_VG) + t0 * 1024 + h * 256;
    const unsigned char* rec0 = c.ws + WS_REC + (size_t)((bl * 4 + h) * 64 + seg * GSEG) * REC_BYTES;
    const int dv0 = 32 * w; const unsigned lds_u = (unsigned)(uintptr_t)lds;
    f32x4 S[8][2], Dc[8];
#pragma unroll
    for (int a = 0; a < 8; ++a) { S[a][0] = (f32x4){0.f, 0.f, 0.f, 0.f}; S[a][1] = (f32x4){0.f, 0.f, 0.f, 0.f}; Dc[a] = (f32x4){1.f, 1.f, 1.f, 1.f}; }
#define GL_DMA(gp, ldsoff) do { unsigned _sv; const unsigned _m = (unsigned)__builtin_amdgcn_readfirstlane((int)(ldsoff)); \
        asm volatile("s_mov_b32 %0, m0\n\ts_mov_b32 m0, %2\n\ts_nop 0\n\tglobal_load_lds_dwordx4 %1, off\n\ts_mov_b32 m0, %0" : "=&s"(_sv) : "v"(gp), "s"(_m) : "memory"); } while (0)
#define GL_PREFETCH(nn, st) do { const unsigned char* _r = rec0 + (size_t)(nn) * REC_BYTES + REC_KS; const unsigned _s = lds_u + (unsigned)(st) * GL_STAGE; \
        _Pragma("unroll") for (int _p = 0; _p < 2; ++_p) GL_DMA((const GAS unsigned char*)(_r + (w * 2 + _p) * 1024 + lane * 16), _s + (w * 2 + _p) * 1024); \
        if (w == 0) GL_DMA((const GAS unsigned char*)(_r + 16384 + lane * 16), _s + GL_DEC); \
        _Pragma("unroll") for (int _p = 0; _p < 4; ++_p) { const int _row = 2 * (w * 4 + _p) + (lane >> 5); \
            GL_DMA((const GAS bf16_t*)(VG + (size_t)((nn) * 64 + _row) * 1024 + (((lane & 31) ^ (2 * (_row & 3))) << 3)), _s + GL_VS + (w * 4 + _p) * 1024); } } while (0)
    __syncthreads();
    GL_PREFETCH(0, 0);
    for (int n = 0; n < GSEG; ++n) {
        const int st = n & 1; LAS unsigned char* sb_ = lds + st * GL_STAGE;
        LAS bf16_t* KS = (LAS bf16_t*)sb_; LAS float* DEC = (LAS float*)(sb_ + GL_DEC); LAS bf16_t* VS = (LAS bf16_t*)(sb_ + GL_VS);
        VM_WAIT(); asm volatile("s_waitcnt lgkmcnt(0)" ::: "memory"); __builtin_amdgcn_s_barrier(); asm volatile("" ::: "memory");
        if (n + 1 < GSEG) GL_PREFETCH(n + 1, st ^ 1);
        bf16x8 vb[2][2];
#pragma unroll
        for (int k2 = 0; k2 < 2; ++k2)
#pragma unroll
            for (int dt = 0; dt < 2; ++dt) { const int r0 = 32 * k2 + 8 * fq + (fr >> 2);
                const LAS bf16_t* p = VS + r0 * 256 + ((((dv0 + 16 * dt) >> 3) ^ (2 * (r0 & 3))) << 3) + (fr & 3) * 4; vb[k2][dt] = cat8(tr16(p), tr16(p + 4 * 256)); }
#pragma unroll
        for (int k8 = 0; k8 < 8; ++k8) {
            const f32x4 dc = *(const LAS f32x4*)(DEC + 16 * k8 + 4 * fq);
            S[k8][0] *= dc; S[k8][1] *= dc; Dc[k8] *= dc;
#pragma unroll
            for (int k2 = 0; k2 < 2; ++k2) { const int r0 = 32 * k2 + 8 * fq + (fr >> 2);
                const LAS bf16_t* p0 = KS + r0 * 128 + (((2 * k8) ^ (2 * (r0 & 7))) << 3) + (fr & 3) * 4; const LAS bf16_t* p1 = KS + (r0 + 4) * 128 + (((2 * k8) ^ (2 * ((r0 + 4) & 7))) << 3) + (fr & 3) * 4;
                const bf16x8 af = cat8(tr16(p0), tr16(p1));
                S[k8][0] = MFMA16(af, vb[k2][0], S[k8][0]); S[k8][1] = MFMA16(af, vb[k2][1], S[k8][1]); }
        }
    }
#undef GL_PREFETCH
#undef GL_DMA
    const int cj = (bl * 4 + h) * NSEG + seg;
    GAS f32x4* sl = (GAS f32x4*)(c.ws + WS_SLOC) + ((size_t)(cj * 8 + w) * 16) * 64 + lane;
#pragma unroll
    for (int a = 0; a < 8; ++a) { sl[(a * 2) * 64] = S[a][0]; sl[(a * 2 + 1) * 64] = S[a][1]; }
    if (w == 0) { GAS f32x4* dq = (GAS f32x4*)(c.ws + WS_DCUM) + (size_t)cj * 8 * 64 + lane;
#pragma unroll
        for (int a = 0; a < 8; ++a) dq[a * 64] = Dc[a]; }
    VM_WAIT(); __syncthreads();
}
constexpr int GS_STAGE = 66560, GS_KS = 16384, GS_DEC = 32768, GS_VS = 33792, GS_SS = 2 * GS_STAGE;
DI void gla_s_chain(LAS unsigned char* lds, const Ctx& c, int l, int bl, int h, int seg) {
    const int tid = ltid(), lane = tid & 63, w = rfl(tid >> 6), fr = lane & 15, fq = lane >> 4;
    const size_t t0 = (size_t)bl * SEQ + (size_t)seg * (GSEG * 64);
    const bf16_t* VG = wsb(c, WS_H + H_VG) + t0 * 1024 + h * 256;
    const unsigned char* SR = c.ws + WS_H + H_SR + t0 * 1024 + h * 256;
    unsigned char* OG = c.ws + WS_OG + t0 * 1024 + h * 256;
    const unsigned char* rec0 = c.ws + WS_REC + (size_t)((bl * 4 + h) * 64 + seg * GSEG) * REC_BYTES;
    const unsigned char* oi0 = c.ws + WS_MIX + (size_t)((bl * 4 + h) * 64 + seg * GSEG) * OI_BYTES;
    LAS float* SS = (LAS float*)(lds + GS_SS);
    const int dv0 = 32 * w;
    f32x4 gnv[2]; gnv[0] = *(const GAS f32x4*)(c.gla_norm + l * 1024 + h * 256 + dv0 + 4 * fq); gnv[1] = *(const GAS f32x4*)(c.gla_norm + l * 1024 + h * 256 + dv0 + 16 + 4 * fq);
    f32x4 S[8][2];
#pragma unroll
    for (int a = 0; a < 8; ++a) { S[a][0] = (f32x4){0.f, 0.f, 0.f, 0.f}; S[a][1] = (f32x4){0.f, 0.f, 0.f, 0.f}; }
    for (int j = 0; j < seg; ++j) {
        const int cj = (bl * 4 + h) * NSEG + j;
        const GAS f32x4* sl = (const GAS f32x4*)(c.ws + WS_SLOC) + ((size_t)(cj * 8 + w) * 16) * 64 + lane; const GAS f32x4* dq = (const GAS f32x4*)(c.ws + WS_DCUM) + (size_t)cj * 8 * 64 + lane;
#pragma unroll
        for (int a = 0; a < 8; ++a) { const f32x4 dcv = dq[a * 64]; S[a][0] = S[a][0] * dcv + sl[(a * 2) * 64]; S[a][1] = S[a][1] * dcv + sl[(a * 2 + 1) * 64]; }
    }
#define GS_DMA(gp, ldsoff) do { unsigned _sv; const unsigned _m = (unsigned)__builtin_amdgcn_readfirstlane((int)(ldsoff)); \
        asm volatile("s_mov_b32 %0, m0\n\ts_mov_b32 m0, %2\n\ts_nop 0\n\tglobal_load_lds_dwordx4 %1, off\n\ts_mov_b32 m0, %0" : "=&s"(_sv) : "v"(gp), "s"(_m) : "memory"); } while (0)
#define GS_PREFETCH(nn, st) do { const unsigned char* _r = rec0 + (size_t)(nn) * REC_BYTES; const unsigned _s = lds_u + (unsigned)(st) * GS_STAGE; \
        _Pragma("unroll") for (int _p = 0; _p < 4; ++_p) GS_DMA((const GAS unsigned char*)(_r + (w * 4 + _p) * 1024 + lane * 16), _s + (w * 4 + _p) * 1024); \
        if (w == 0) GS_DMA((const GAS unsigned char*)(_r + 32768 + lane * 16), _s + 32768); \
        _Pragma("unroll") for (int _p = 0; _p < 4; ++_p) { const int _row = 2 * (w * 4 + _p) + (lane >> 5); \
            GS_DMA((const GAS bf16_t*)(VG + (size_t)((nn) * 64 + _row) * 1024 + (((lane & 31) ^ (2 * (_row & 3))) << 3)), _s + GS_VS + (w * 4 + _p) * 1024); } } while (0)
    const unsigned lds_u = (unsigned)(uintptr_t)lds;
#define GS_BAR() do { asm volatile("s_waitcnt lgkmcnt(0)" ::: "memory"); __builtin_amdgcn_s_barrier(); asm volatile("" ::: "memory"); } while (0)
    __syncthreads();
    GS_PREFETCH(0, 0);
    for (int n = 0; n < GSEG; ++n) {
        const int st = n & 1; LAS unsigned char* sb_ = lds + st * GS_STAGE;
        LAS bf16_t* QT = (LAS bf16_t*)sb_; LAS bf16_t* KS = (LAS bf16_t*)(sb_ + GS_KS); LAS float* DEC = (LAS float*)(sb_ + GS_DEC); LAS bf16_t* VS = (LAS bf16_t*)(sb_ + GS_VS); LAS bf16_t* OST = (LAS bf16_t*)(sb_ + GS_KS);
        VM_WAIT(); GS_BAR();
        unsigned oiv[8];
#pragma unroll
        for (int q = 0; q < 8; ++q) oiv[q] = *(const GAS unsigned*)(oi0 + (size_t)n * OI_BYTES + ((w * 8 + q) * 64 + lane) * 4);
        unsigned srv[8];
#pragma unroll
        for (int q = 0; q < 8; ++q) srv[q] = *(const GAS unsigned*)(SR + (size_t)(n * 64 + 16 * (q >> 1) + fr) * 1024 + dv0 + 16 * (q & 1) + 4 * fq);
        asm volatile("" ::: "memory");
        if (n + 1 < GSEG) GS_PREFETCH(n + 1, st ^ 1);
        f32x4 o[4][2];
        {
            bf16x8 vb[2][2];
#pragma unroll
            for (int k2 = 0; k2 < 2; ++k2)
#pragma unroll
                for (int dt = 0; dt < 2; ++dt) { const int r0 = 32 * k2 + 8 * fq + (fr >> 2);
                    const LAS bf16_t* p = VS + r0 * 256 + ((((dv0 + 16 * dt) >> 3) ^ (2 * (r0 & 3))) << 3) + (fr & 3) * 4; vb[k2][dt] = cat8(tr16(p), tr16(p + 4 * 256)); }
#pragma unroll
            for (int tt = 0; tt < 4; ++tt) { o[tt][0] = (f32x4){0.f, 0.f, 0.f, 0.f}; o[tt][1] = (f32x4){0.f, 0.f, 0.f, 0.f}; }
#pragma unroll
            for (int s = 0; s < 4; ++s) {
                bf16x8 sb[2];
#pragma unroll
                for (int dt = 0; dt < 2; ++dt) { u32x4 pk; pk.x = cvt_pk_bf16(S[2 * s][dt][0], S[2 * s][dt][1]); pk.y = cvt_pk_bf16(S[2 * s][dt][2], S[2 * s][dt][3]); pk.z = cvt_pk_bf16(S[2 * s + 1][dt][0], S[2 * s + 1][dt][1]); pk.w = cvt_pk_bf16(S[2 * s + 1][dt][2], S[2 * s + 1][dt][3]); sb[dt] = __builtin_bit_cast(bf16x8, pk); }
#pragma unroll
                for (int tt = 0; tt < 4; ++tt) { const int i = 16 * tt + fr;
                    const LAS bf16_t* qp = QT + i * 128 + (fq & 1) * 4;
                    const bf16x8 af = cat8(*(const LAS s16x4*)(qp + (((4 * s + (fq >> 1)) ^ (i & 15)) << 3)), *(const LAS s16x4*)(qp + (((4 * s + 2 + (fq >> 1)) ^ (i & 15)) << 3)));
                    o[tt][0] = MFMA16(sb[0], af, o[tt][0]); o[tt][1] = MFMA16(sb[1], af, o[tt][1]); }
            }
#pragma unroll
            for (int k8 = 0; k8 < 8; ++k8) {
                const f32x4 dc = *(const LAS f32x4*)(DEC + 16 * k8 + 4 * fq);
                S[k8][0] *= dc; S[k8][1] *= dc;
#pragma unroll
                for (int k2 = 0; k2 < 2; ++k2) { const int r0 = 32 * k2 + 8 * fq + (fr >> 2);
                    const LAS bf16_t* p0 = KS + r0 * 128 + (((2 * k8) ^ (2 * (r0 & 7))) << 3) + (fr & 3) * 4; const LAS bf16_t* p1 = KS + (r0 + 4) * 128 + (((2 * k8) ^ (2 * ((r0 + 4) & 7))) << 3) + (fr & 3) * 4;
                    const bf16x8 af = cat8(tr16(p0), tr16(p1));
                    S[k8][0] = MFMA16(af, vb[k2][0], S[k8][0]); S[k8][1] = MFMA16(af, vb[k2][1], S[k8][1]); }
            }
        }
#pragma unroll
        for (int tt = 0; tt < 4; ++tt)
#pragma unroll
            for (int dt = 0; dt < 2; ++dt) { const f32x2 a = __builtin_amdgcn_cvt_pk_f32_fp8((int)oiv[tt * 2 + dt], false), b = __builtin_amdgcn_cvt_pk_f32_fp8((int)oiv[tt * 2 + dt], true); o[tt][dt][0] += a[0]; o[tt][dt][1] += a[1]; o[tt][dt][2] += b[0]; o[tt][dt][3] += b[1]; }
        {
            f32x4 pp;
#pragma unroll
            for (int tt = 0; tt < 4; ++tt) { const f32x4 a = o[tt][0] * o[tt][0] + o[tt][1] * o[tt][1]; float p = (a[0] + a[1]) + (a[2] + a[3]); p += __shfl_xor(p, 16); p += __shfl_xor(p, 32); pp[tt] = p; }
            if (fq == 0) { SS[(0 * 16 + fr) * 8 + w] = pp[0]; SS[(1 * 16 + fr) * 8 + w] = pp[1]; SS[(2 * 16 + fr) * 8 + w] = pp[2]; SS[(3 * 16 + fr) * 8 + w] = pp[3]; }
        }
        GS_BAR();
#pragma unroll
        for (int tt = 0; tt < 4; ++tt) { const f32x4 s0 = *(const LAS f32x4*)(SS + (16 * tt + fr) * 8), s1 = *(const LAS f32x4*)(SS + (16 * tt + fr) * 8 + 4);
            const float ss = ((s0[0] + s0[1]) + (s0[2] + s0[3])) + ((s1[0] + s1[1]) + (s1[2] + s1[3])); const float rs = __builtin_amdgcn_rsqf(ss * (1.0f / 256.0f) + RMS_EPS);
#pragma unroll
            for (int dt = 0; dt < 2; ++dt) { const f32x2 sa = __builtin_amdgcn_cvt_pk_f32_fp8((int)srv[tt * 2 + dt], false), sb2 = __builtin_amdgcn_cvt_pk_f32_fp8((int)srv[tt * 2 + dt], true); const f32x4 g = gnv[dt]; const f32x4 v = o[tt][dt] * rs;
                *(GAS unsigned*)(OG + (size_t)(n * 64 + 16 * tt + fr) * 1024 + dv0 + 16 * dt + 4 * fq) = pk4_fp8(v[0] * g[0] * sa[0], v[1] * g[1] * sa[1], v[2] * g[2] * sb2[0], v[3] * g[3] * sb2[1]); } }
    }
#undef GS_PREFETCH
#undef GS_DMA
#undef GS_BAR
    VM_WAIT(); __syncthreads();
}

constexpr int AT_K = 0, AT_V = 55296;
struct APre { u32x4 k[6], v[6]; bf16x8 q[2][2]; };
struct AUnit { int dl, n, colo; size_t tb; };
DI AUnit attn_decode(int u) { AUnit a; const int bl = u / 768, g = (u / 256) % 3, h = (u >> 5) & 7, x = u & 31; a.dl = (g == 0) ? 1 : (g == 1 ? 4 : 16); const int nb = 32 / a.dl, r = x / nb; a.n = x - r * nb; a.tb = (size_t)bl * SEQ + r; a.colo = g * 512 + h * 64; return a; }
DI void attn_load(const Ctx& c, int u, APre& p) {
    const int tid = ltid(), lane = tid & 63, w = rfl(tid >> 6), fr = lane & 15, fq = lane >> 4; const AUnit a = attn_decode(u);
    const bf16_t* Q = wsb(c, WS_H + H_QD) + a.colo; const bf16_t* K = wsb(c, WS_H + H_KD) + a.colo; const bf16_t* V = wsb(c, WS_H + H_VD) + a.colo;
#pragma unroll
    for (int b = 0; b < 2; ++b) { const size_t tokq = a.tb + (size_t)a.dl * (128 * (a.n + b) + 16 * w + fr);
#pragma unroll
        for (int d0 = 0; d0 < 2; ++d0) p.q[b][d0] = *(const GAS bf16x8*)(Q + tokq * 1536 + 32 * d0 + 8 * fq); }
#pragma unroll
    for (int c2 = 0; c2 < 6; ++c2) { const int idx = tid + NTHREADS * c2, row = idx >> 3, ch = idx & 7; const int j = 128 * (a.n - 1) + row;
        p.k[c2] = (u32x4){0u, 0u, 0u, 0u}; p.v[c2] = (u32x4){0u, 0u, 0u, 0u};
        if (j >= 0) { const size_t tok = a.tb + (size_t)a.dl * j; p.k[c2] = *(const GAS u32x4*)(K + tok * 1536 + ch * 8); p.v[c2] = *(const GAS u32x4*)(V + tok * 1536 + ch * 8); } }
}
DI void attn_stage(LAS unsigned char* lds, const APre& p) {
    const int tid = ltid(); LAS bf16_t* Ks = (LAS bf16_t*)(lds + AT_K); LAS bf16_t* Vs = (LAS bf16_t*)(lds + AT_V);
#pragma unroll
    for (int c2 = 0; c2 < 6; ++c2) { const int idx = tid + NTHREADS * c2, row = idx >> 3, ch = idx & 7; *(LAS u32x4*)(Ks + row * 72 + ch * 8) = p.k[c2]; *(LAS u32x4*)(Vs + row * 72 + ch * 8) = p.v[c2]; }
}
DI void attn_compute(LAS unsigned char* lds, const Ctx& c, int u, const bf16x8 (&qf)[2][2]) {
    const int tid = ltid(), lane = tid & 63, w = rfl(tid >> 6), fr = lane & 15, fq = lane >> 4; const AUnit au = attn_decode(u);
    const int dl = au.dl, n = au.n, g = (u / 256) % 3, h = (u >> 5) & 7; const size_t tb = au.tb;
    LAS bf16_t* Ks = (LAS bf16_t*)(lds + AT_K); LAS bf16_t* Vs = (LAS bf16_t*)(lds + AT_V);
#pragma unroll
    for (int b = 0; b < 2; ++b) {
        const int kt0 = 8 * b + w;
        f32x4 s[9]; float m = -1e30f;
#pragma unroll
        for (int kr = 0; kr < 9; ++kr) { const int kt = kt0 + kr; f32x4 a = (f32x4){0.f, 0.f, 0.f, 0.f};
#pragma unroll
            for (int d0 = 0; d0 < 2; ++d0) { const bf16x8 af = *(const LAS bf16x8*)(Ks + (16 * kt + fr) * 72 + 32 * d0 + 8 * fq); a = MFMA16(af, qf[b][d0], a); }
#pragma unroll
            for (int rg = 0; rg < 4; ++rg) { const bool tile_ok = (b > 0) || (n > 0) || (kt >= 8);
                bool ok = tile_ok; if (kr == 0) ok = ok && (4 * fq + rg >= fr); if (kr == 8) ok = ok && (4 * fq + rg <= fr);
                a[rg] = ok ? a[rg] : -1e30f; m = fmaxf(m, a[rg]); }
            s[kr] = a; }
        m = fmaxf(m, __shfl_xor(m, 16)); m = fmaxf(m, __shfl_xor(m, 32));
        float lsum = 0.f;
#pragma unroll
        for (int kr = 0; kr < 9; ++kr)
#pragma unroll
            for (int rg = 0; rg < 4; ++rg) { const float p = __builtin_amdgcn_exp2f(s[kr][rg] - m); s[kr][rg] = p; lsum += p; }
        lsum += __shfl_xor(lsum, 16); lsum += __shfl_xor(lsum, 32);
        f32x4 oT[4];
#pragma unroll
        for (int dt = 0; dt < 4; ++dt) oT[dt] = (f32x4){0.f, 0.f, 0.f, 0.f};
#pragma unroll
        for (int pp = 0; pp < 5; ++pp) { const int ka = 2 * pp, kb = (2 * pp + 1 < 9) ? 2 * pp + 1 : 8;
            u32x4 pk; pk.x = cvt_pk_bf16(s[ka][0], s[ka][1]); pk.y = cvt_pk_bf16(s[ka][2], s[ka][3]);
            if (2 * pp + 1 < 9) { pk.z = cvt_pk_bf16(s[kb][0], s[kb][1]); pk.w = cvt_pk_bf16(s[kb][2], s[kb][3]); } else { pk.z = 0u; pk.w = 0u; }
            const bf16x8 pf = __builtin_bit_cast(bf16x8, pk);
#pragma unroll
            for (int dt = 0; dt < 4; ++dt) { const LAS bf16_t* pa = Vs + (16 * (kt0 + ka) + 4 * fq + (fr >> 2)) * 72 + 16 * dt + (fr & 3) * 4; const LAS bf16_t* pb = Vs + (16 * (kt0 + kb) + 4 * fq + (fr >> 2)) * 72 + 16 * dt + (fr & 3) * 4;
                oT[dt] = MFMA16(cat8(tr16(pa), tr16(pb)), pf, oT[dt]); } }
        const float inv = 1.0f / lsum; const size_t tq = tb + (size_t)dl * (128 * (n + b) + 16 * w + fr);
        bf16_t* op = wsb(c, WS_ATTG) + ((size_t)g * TH + tq) * 512 + h * 64 + 4 * fq;
#pragma unroll
        for (int dt = 0; dt < 4; ++dt) { u32x2 o; o.x = cvt_pk_bf16(oT[dt][0] * inv, oT[dt][1] * inv); o.y = cvt_pk_bf16(oT[dt][2] * inv, oT[dt][3] * inv); *(GAS u32x2*)(op + 16 * dt) = o; }
        if (fq == 0) ((float*)(c.ws + WS_LSE))[((size_t)g * TH + tq) * 8 + h] = m + __builtin_amdgcn_logf(lsum);
    }
}
DI void phase_p(LAS unsigned char* lds, const Ctx& c, int l, int G) {
    int h_loaded = -1;
    for (int u = lbid(); u < 8 * 4 * 64; u += G) gla_p_unit(lds, c, l, u >> 8, (u >> 6) & 3, u & 63, h_loaded);
}
constexpr int NATT = 8 * 3 * 8 * 32, NATT1 = 0, NCHAIN = 8 * 4 * NSEG;
DI void attn_pull(LAS unsigned char* lds, const Ctx& c, unsigned* ctr, int base, int limit) {
    volatile LAS int* TK = (volatile LAS int*)(lds + MISC_OFF + 192);
    const int tid = ltid();
    __syncthreads();
    if (tid == 0) { TK[0] = base + 2 * (int)__hip_atomic_fetch_add(ctr, 1u, __ATOMIC_RELAXED, __HIP_MEMORY_SCOPE_AGENT); TK[1] = base + 2 * (int)__hip_atomic_fetch_add(ctr, 1u, __ATOMIC_RELAXED, __HIP_MEMORY_SCOPE_AGENT);
        TK[2] = base + 2 * (int)__hip_atomic_fetch_add(ctr, 1u, __ATOMIC_RELAXED, __HIP_MEMORY_SCOPE_AGENT); }
    __syncthreads();
    int cur = rfl(TK[0]), nxt = rfl(TK[1]);
    APre pre;
    if (cur < limit) attn_load(c, cur, pre);
    while (cur < limit) {
        __syncthreads();
        const int nxt2 = rfl(TK[2]);
        attn_stage(lds, pre);
        bf16x8 qf[2][2];
#pragma unroll
        for (int b = 0; b < 2; ++b)
#pragma unroll
            for (int d0 = 0; d0 < 2; ++d0) qf[b][d0] = pre.q[b][d0];
        __syncthreads();
        if (nxt < limit) attn_load(c, nxt, pre);
        int req = 0; if (tid == 0) req = base + 2 * (int)__hip_atomic_fetch_add(ctr, 1u, __ATOMIC_RELAXED, __HIP_MEMORY_SCOPE_AGENT);
        attn_compute(lds, c, cur, qf);
        if (tid == 0) TK[2] = req;
        cur = nxt; nxt = nxt2;
    }
}
DI void phase_b1(LAS unsigned char* lds, const Ctx& c, int l, int hf, int G) {
    const int bid = lbid(); unsigned* ctr = (unsigned*)(c.ws + WS_CTL) + CW_TKT + ((l * 2 + hf) * 2) * 64;
    for (int id = bid; id < NCHAIN; id += G) gla_l_chain(lds, c, id >> 4, (id >> 2) & 3, id & 3);
    attn_pull(lds, c, ctr, 0, NATT1);
}
DI void phase_b(LAS unsigned char* lds, const Ctx& c, int l, int hf, int G) {
    const int bid = lbid(); unsigned* ctr = (unsigned*)(c.ws + WS_CTL) + CW_TKT + ((l * 2 + hf) * 2 + 1) * 64;
    for (int id = bid; id < NCHAIN; id += G) gla_s_chain(lds, c, l, id >> 4, (id >> 2) & 3, id & 3);
    attn_pull(lds, c, ctr, NATT1, NATT);
}
DI void phase_f(const Ctx& c, int G) {
    const bf16_t* ag = wsb(c, WS_ATTG); const float* lse = (const float*)(c.ws + WS_LSE); unsigned char* att = c.ws + WS_ATT;
    const size_t stride = (size_t)G * NTHREADS, N = (size_t)TH * 64;
    for (size_t i0 = (size_t)lbid() * NTHREADS + ltid(); i0 < N; i0 += 4 * stride) {
        float l0[4], l1[4], l2[4]; u32x4 a[4], b[4], d[4];
#pragma unroll
        for (int q = 0; q < 4; ++q) { const size_t i = i0 + q * stride; const bool ok = i < N; const size_t tok = ok ? (i >> 6) : 0; const int ch = (int)(i & 63), h = ch >> 3;
            l0[q] = lse[tok * 8 + h]; l1[q] = lse[((size_t)TH + tok) * 8 + h]; l2[q] = lse[((size_t)2 * TH + tok) * 8 + h];
            a[q] = *(const GAS u32x4*)(ag + tok * 512 + ch * 8); b[q] = *(const GAS u32x4*)(ag + ((size_t)TH + tok) * 512 + ch * 8); d[q] = *(const GAS u32x4*)(ag + ((size_t)2 * TH + tok) * 512 + ch * 8); }
#pragma unroll
        for (int q = 0; q < 4; ++q) { const size_t i = i0 + q * stride; if (i >= N) continue; const size_t tok = i >> 6; const int ch = (int)(i & 63);
            const float mx = fmaxf(l0[q], fmaxf(l1[q], l2[q])); float w0 = __builtin_amdgcn_exp2f(l0[q] - mx), w1 = __builtin_amdgcn_exp2f(l1[q] - mx), w2 = __builtin_amdgcn_exp2f(l2[q] - mx);
            const float inv = 1.0f / (w0 + w1 + w2); w0 *= inv; w1 *= inv; w2 *= inv;
            u32x2 o;
            o.x = pk4_fp8(w0 * bf_lo(a[q].x) + w1 * bf_lo(b[q].x) + w2 * bf_lo(d[q].x), w0 * bf_hi(a[q].x) + w1 * bf_hi(b[q].x) + w2 * bf_hi(d[q].x), w0 * bf_lo(a[q].y) + w1 * bf_lo(b[q].y) + w2 * bf_lo(d[q].y), w0 * bf_hi(a[q].y) + w1 * bf_hi(b[q].y) + w2 * bf_hi(d[q].y));
            o.y = pk4_fp8(w0 * bf_lo(a[q].z) + w1 * bf_lo(b[q].z) + w2 * bf_lo(d[q].z), w0 * bf_hi(a[q].z) + w1 * bf_hi(b[q].z) + w2 * bf_hi(d[q].z), w0 * bf_lo(a[q].w) + w1 * bf_lo(b[q].w) + w2 * bf_lo(d[q].w), w0 * bf_hi(a[q].w) + w1 * bf_hi(b[q].w) + w2 * bf_hi(d[q].w));
            *(GAS u32x2*)(att + tok * 512 + ch * 8) = o; }
    }
}

DI float wave_sum(float v) {
#pragma unroll
    for (int o = 1; o < 64; o <<= 1) v += __shfl_xor(v, o);
    return v;
}
constexpr int R_WR = 0, R_HIST = 65536, R_BASE = 65536 + 64, R_INFO = 65536 + 128;
DI void phase_r(LAS unsigned char* lds, const Ctx& c, int l, int G) {
    const int tid = ltid(), lane = tid & 63, wave = rfl(tid >> 6);
    LAS float* WR = (LAS float*)(lds + R_WR); volatile LAS int* HIST = (volatile LAS int*)(lds + R_HIST); volatile LAS int* BASE = (volatile LAS int*)(lds + R_BASE); volatile LAS int* INFO = (volatile LAS int*)(lds + R_INFO);
    __syncthreads();
    for (int i = tid; i < 16 * 1024; i += NTHREADS) WR[(i & 15) * 1024 + (i >> 4)] = c.w_router[i];
    f32x4 g4[4], b4[4];
#pragma unroll
    for (int j = 0; j < 4; ++j) { g4[j] = *(const GAS f32x4*)(c.ln1_g + l * D + 4 * lane + 256 * j); b4[j] = *(const GAS f32x4*)(c.ln1_b + l * D + 4 * lane + 256 * j); }
    bf16_t* xr = wsb(c, WS_XR); unsigned char* xb = c.ws + WS_XB; int* histg = (int*)(c.ws + WS_HISTG); float* gate = (float*)(c.ws + WS_GATE);
    const float brt = c.b_router[((lane >> 5) & 1) * 8 + ((lane >> 4) & 1) * 4 + ((lane >> 3) & 1) * 2 + ((lane >> 2) & 1)];
    for (int chunk = lbid(); chunk < T / 256; chunk += G) {
        __syncthreads();
        u32x2 zn[4];
#pragma unroll
        for (int j = 0; j < 4; ++j) zn[j] = *(const GAS u32x2*)(xr + ((size_t)chunk * 256 + wave * 32) * D + 4 * lane + 256 * j);
        for (int rr = 0; rr < 32; ++rr) {
            const int rl = wave * 32 + rr; const size_t row = (size_t)chunk * 256 + rl;
            f32x4 v[4]; float s = 0.f;
#pragma unroll
            for (int j = 0; j < 4; ++j) { const u32x2 zq = zn[j]; v[j] = (f32x4){bf_lo(zq.x), bf_hi(zq.x), bf_lo(zq.y), bf_hi(zq.y)}; s += (v[j][0] + v[j][1]) + (v[j][2] + v[j][3]); }
            { const size_t rn = row + (rr + 1 < 32 ? 1 : 0);
#pragma unroll
              for (int j = 0; j < 4; ++j) zn[j] = *(const GAS u32x2*)(xr + rn * D + 4 * lane + 256 * j); }
            const float mean = wave_sum(s) * (1.0f / D); float s2 = 0.f;
#pragma unroll
            for (int j = 0; j < 4; ++j) { v[j] = v[j] - mean; s2 += (v[j][0] * v[j][0] + v[j][1] * v[j][1]) + (v[j][2] * v[j][2] + v[j][3] * v[j][3]); }
            const float rstd = __builtin_amdgcn_rsqf(wave_sum(s2) * (1.0f / D) + LN_EPS);
#pragma unroll
            for (int j = 0; j < 4; ++j) { v[j] = v[j] * rstd * g4[j] + b4[j]; u32x2 xq; xq.x = cvt_pk_bf16(v[j][0], v[j][1]); xq.y = cvt_pk_bf16(v[j][2], v[j][3]); *(GAS u32x2*)(xr + row * D + 4 * lane + 256 * j) = xq;
                *(GAS unsigned*)(xb + row * D + 4 * lane + 256 * j) = pk4_fp8(v[j][0], v[j][1], v[j][2], v[j][3]); }
            float lg[16];
#pragma unroll
            for (int e = 0; e < 16; ++e) { float a = 0.f;
#pragma unroll
                for (int j = 0; j < 4; ++j) { const f32x4 wv = *(const LAS f32x4*)(WR + e * 1024 + 4 * lane + 256 * j); a += v[j][0] * wv[0] + v[j][1] * wv[1] + v[j][2] * wv[2] + v[j][3] * wv[3]; }
                lg[e] = a; }
            {
                float b8[8], b4[4], b2[2];
                const bool h5 = lane & 32, h4 = lane & 16, h3 = lane & 8, h2 = lane & 4;
#pragma unroll
                for (int i = 0; i < 8; ++i) { const float mine = h5 ? lg[8 + i] : lg[i], send = h5 ? lg[i] : lg[8 + i]; b8[i] = mine + __shfl_xor(send, 32); }
#pragma unroll
                for (int i = 0; i < 4; ++i) { const float mine = h4 ? b8[4 + i] : b8[i], send = h4 ? b8[i] : b8[4 + i]; b4[i] = mine + __shfl_xor(send, 16); }
#pragma unroll
                for (int i = 0; i < 2; ++i) { const float mine = h3 ? b4[2 + i] : b4[i], send = h3 ? b4[i] : b4[2 + i]; b2[i] = mine + __shfl_xor(send, 8); }
                float b1 = (h2 ? b2[1] : b2[0]) + __shfl_xor(h2 ? b2[0] : b2[1], 4);
                b1 += __shfl_xor(b1, 2); b1 += __shfl_xor(b1, 1);
                b1 += brt;
#pragma unroll
                for (int e = 0; e < 16; ++e) lg[e] = __shfl(b1, ((e >> 3) & 1) * 32 + ((e >> 2) & 1) * 16 + ((e >> 1) & 1) * 8 + (e & 1) * 4);
            }
            float mx = lg[0];
#pragma unroll
            for (int e = 1; e < 16; ++e) mx = fmaxf(mx, lg[e]);
            float se = 0.f;
#pragma unroll
            for (int e = 0; e < 16; ++e) { lg[e] = __expf(lg[e] - mx); se += lg[e]; }
            const float ise = 1.0f / se;
#pragma unroll
            for (int e = 0; e < 16; ++e) lg[e] *= ise;
            int gsel = 0; float gbest = -1.f;
#pragma unroll
            for (int gi = 0; gi < 4; ++gi) { const float a = lg[4 * gi], b = lg[4 * gi + 1], cc = lg[4 * gi + 2], d = lg[4 * gi + 3];
                const float sc = (a + b + cc + d) - fminf(fminf(a, b), fminf(cc, d)) - fminf(fmaxf(fminf(a, b), fminf(cc, d)), fminf(fmaxf(a, b), fmaxf(cc, d)));
                if (sc > gbest) { gbest = sc; gsel = gi; } }
            float p[4];
#pragma unroll
            for (int k = 0; k < 4; ++k) p[k] = gsel == 0 ? lg[k] : gsel == 1 ? lg[4 + k] : gsel == 2 ? lg[8 + k] : lg[12 + k];
            int i0 = 0; float v0 = p[0];
#pragma unroll
            for (int k = 1; k < 4; ++k) if (p[k] > v0) { v0 = p[k]; i0 = k; }
            int i1 = -1; float v1 = -1.f;
#pragma unroll
            for (int k = 0; k < 4; ++k) if (k != i0 && p[k] > v1) { v1 = p[k]; i1 = k; }
            if (lane == 0) { const int e0 = 4 * gsel + i0, e1 = 4 * gsel + i1; INFO[rl * 4 + 0] = e0; INFO[rl * 4 + 1] = e1;
                const float gs = 1.0f / (v0 + v1); gate[row * 2] = v0 * gs; gate[row * 2 + 1] = v1 * gs; }
        }
        __syncthreads();
        {
            int cnt0 = 0, cnt1 = 0; const unsigned long long lt = (1ull << lane) - 1ull;
#pragma unroll
            for (int b = 0; b < 4; ++b) { const int r = 64 * b + lane; const int e0 = INFO[r * 4], e1 = INFO[r * 4 + 1];
                const bool a0 = (e0 == 2 * wave) || (e1 == 2 * wave), a1 = (e0 == 2 * wave + 1) || (e1 == 2 * wave + 1);
                const unsigned long long m0 = __ballot(a0), m1 = __ballot(a1);
                if (a0) INFO[r * 4 + (e0 == 2 * wave ? 2 : 3)] = cnt0 + __popcll(m0 & lt);
                if (a1) INFO[r * 4 + (e0 == 2 * wave + 1 ? 2 : 3)] = cnt1 + __popcll(m1 & lt);
                cnt0 += __popcll(m0); cnt1 += __popcll(m1); }
            if (lane == 0) { histg[chunk * 16 + 2 * wave] = cnt0; histg[chunk * 16 + 2 * wave + 1] = cnt1; }
        }
        __syncthreads();
        if (tid < 256) { i32x4 v; v.x = INFO[tid * 4]; v.y = INFO[tid * 4 + 1]; v.z = INFO[tid * 4 + 2]; v.w = INFO[tid * 4 + 3]; ((GAS i32x4*)(c.ws + WS_INFO))[(size_t)chunk * 256 + tid] = v; }
        __syncthreads();
    }
}
DI void phase_r2(LAS unsigned char* lds, const Ctx& c, int l, int G) {
    const int tid = ltid(); volatile LAS int* BASE = (volatile LAS int*)(lds + R_BASE);
    const int* histg = (const int*)(c.ws + WS_HISTG); int* list = (int*)(c.ws + WS_LIST);
    unsigned* cur = (unsigned*)(c.ws + WS_CTL) + CW_CUR + l * 16 * 64;
    for (int chunk = lbid(); chunk < T / 256; chunk += G) {
        __syncthreads();
        if (tid < 16) BASE[tid] = 0;
        __syncthreads();
        { const int e = tid & 15; int s = 0; for (int cc = tid >> 4; cc < chunk; cc += 32) s += histg[cc * 16 + e]; if (s) atomicAdd((int*)&BASE[e], s); }
        __syncthreads();
        if (tid < 256) { const i32x4 v = ((const GAS i32x4*)(c.ws + WS_INFO))[(size_t)chunk * 256 + tid]; const int row = chunk * 256 + tid;
            list[(size_t)v.x * T + BASE[v.x] + v.z] = row * 2; list[(size_t)v.y * T + BASE[v.y] + v.w] = row * 2 + 1; }
        if (chunk == T / 256 - 1 && tid < 16) __hip_atomic_store(cur + tid * 64, (unsigned)(BASE[tid] + histg[chunk * 16 + tid]), __ATOMIC_RELAXED, __HIP_MEMORY_SCOPE_AGENT);
    }
}
DI int moe_setup(LAS unsigned char* lds, const Ctx& c, int l) {
    volatile LAS int* PRE = (volatile LAS int*)(lds + MISC_OFF); volatile LAS int* CNT = PRE + 17;
    unsigned* cur = (unsigned*)(c.ws + WS_CTL) + CW_CUR + l * 16 * 64;
    __syncthreads();
    if (threadIdx.x == 0) { int acc = 0; for (int e = 0; e < 16; ++e) { const int n = (int)__hip_atomic_load(cur + e * 64, __ATOMIC_RELAXED, __HIP_MEMORY_SCOPE_AGENT); PRE[e] = acc; CNT[e] = n; acc += (n + 255) >> 8; } PRE[16] = acc; }
    __syncthreads();
    return rfl(PRE[16]);
}
DI void phase_c(const Ctx& c, int l, int G) {
    const int tid = ltid(), lane = tid & 63, wave = rfl(tid >> 6);
    f32x4 g4[4], b4[4];
#pragma unroll
    for (int j = 0; j < 4; ++j) { g4[j] = *(const GAS f32x4*)(c.ln2_g + l * D + 4 * lane + 256 * j); b4[j] = *(const GAS f32x4*)(c.ln2_b + l * D + 4 * lane + 256 * j); }
    float* xo = c.out; bf16_t* xr = wsb(c, WS_XR); unsigned char* xb = c.ws + WS_XB; const unsigned char* ys = c.ws + WS_YS; const float* gate = (const float*)(c.ws + WS_GATE);
    const size_t rstep = (size_t)G * NWAVES; size_t row = (size_t)lbid() * NWAVES + wave;
    u32x2 xn[4]; unsigned y0n[4], y1n[4]; float g0n = 0.f, g1n = 0.f;
    if (row < (size_t)T) { g0n = gate[row * 2]; g1n = gate[row * 2 + 1];
#pragma unroll
        for (int j = 0; j < 4; ++j) { xn[j] = *(const GAS u32x2*)(xr + row * D + 4 * lane + 256 * j); y0n[j] = *(const GAS unsigned*)(ys + (row * 2) * D + 4 * lane + 256 * j); y1n[j] = *(const GAS unsigned*)(ys + (row * 2 + 1) * D + 4 * lane + 256 * j); } }
    for (; row < (size_t)T; row += rstep) {
        const float g0 = g0n, g1 = g1n;
        f32x4 v[4]; float s = 0.f;
#pragma unroll
        for (int j = 0; j < 4; ++j) { const u32x2 xq = xn[j]; const unsigned y0 = y0n[j], y1 = y1n[j];
            const f32x2 y0a = __builtin_amdgcn_cvt_pk_f32_fp8((int)y0, false), y0b = __builtin_amdgcn_cvt_pk_f32_fp8((int)y0, true), y1a = __builtin_amdgcn_cvt_pk_f32_fp8((int)y1, false), y1b = __builtin_amdgcn_cvt_pk_f32_fp8((int)y1, true);
            v[j][0] = bf_lo(xq.x) * DN_ALPHA + g0 * y0a[0] + g1 * y1a[0]; v[j][1] = bf_hi(xq.x) * DN_ALPHA + g0 * y0a[1] + g1 * y1a[1];
            v[j][2] = bf_lo(xq.y) * DN_ALPHA + g0 * y0b[0] + g1 * y1b[0]; v[j][3] = bf_hi(xq.y) * DN_ALPHA + g0 * y0b[1] + g1 * y1b[1];
            s += (v[j][0] + v[j][1]) + (v[j][2] + v[j][3]); }
        { const size_t rn = row + rstep < (size_t)T ? row + rstep : row; g0n = gate[rn * 2]; g1n = gate[rn * 2 + 1];
#pragma unroll
          for (int j = 0; j < 4; ++j) { xn[j] = *(const GAS u32x2*)(xr + rn * D + 4 * lane + 256 * j); y0n[j] = *(const GAS unsigned*)(ys + (rn * 2) * D + 4 * lane + 256 * j); y1n[j] = *(const GAS unsigned*)(ys + (rn * 2 + 1) * D + 4 * lane + 256 * j); } }
        const float mean = wave_sum(s) * (1.0f / D); float s2 = 0.f;
#pragma unroll
        for (int j = 0; j < 4; ++j) { v[j] = v[j] - mean; s2 += (v[j][0] * v[j][0] + v[j][1] * v[j][1]) + (v[j][2] * v[j][2] + v[j][3] * v[j][3]); }
        const float rstd = __builtin_amdgcn_rsqf(wave_sum(s2) * (1.0f / D) + LN_EPS);
#pragma unroll
        for (int j = 0; j < 4; ++j) { v[j] = v[j] * rstd * g4[j] + b4[j];
            if (l == DEPTH - 1) *(GAS f32x4*)(xo + row * D + 4 * lane + 256 * j) = v[j];
            else { u32x2 xq; xq.x = cvt_pk_bf16(v[j][0], v[j][1]); xq.y = cvt_pk_bf16(v[j][2], v[j][3]); *(GAS u32x2*)(xr + row * D + 4 * lane + 256 * j) = xq;
                *(GAS unsigned*)(xb + row * D + 4 * lane + 256 * j) = pk4_fp8(v[j][0], v[j][1], v[j][2], v[j][3]); } }
    }
}

DI Ctx load_ctx() {
    union { Ctx c; unsigned long long q[sizeof(Ctx) / 8]; } u;
#if defined(__HIP_DEVICE_COMPILE__)
    const __attribute__((address_space(4))) unsigned long long* p = (const __attribute__((address_space(4))) unsigned long long*)__builtin_amdgcn_kernarg_segment_ptr();
    asm volatile("" : "+s"(p));
#pragma unroll
    for (int i = 0; i < (int)(sizeof(Ctx) / 8); ++i) u.q[i] = p[i];
#endif
    return u.c;
}
#define CTX const Ctx c = load_ctx(); const int G = lgrid(); LAS unsigned char* lds = LDSBASE
__global__ void __launch_bounds__(NTHREADS, 2) mk_fwd(Ctx c_arg) {
    extern __shared__ __attribute__((aligned(16))) unsigned char lds_raw[];
#define LDSBASE ({ unsigned _b = (unsigned)(uintptr_t)(LAS unsigned char*)lds_raw; asm volatile("" : "+s"(_b)); (LAS unsigned char*)(uintptr_t)_b; })
    LAS unsigned char* lds0 = LDSBASE;
    const int tid = threadIdx.x; const Ctx c = load_ctx();
    volatile LAS unsigned* MISC = (volatile LAS unsigned*)(lds0 + MISC_OFF);
    if (tid < 64) MISC[tid] = 0u;
    __syncthreads();
    XcdBarrier bar; bar.bar = (unsigned*)(c.ws + WS_CTL) + CW_BAR; bar.x = 0; bar.st = MISC + 40;
    if (!MK_MULTI) bar = xcd_barrier_post((unsigned*)(c.ws + WS_CTL) + CW_BAR, MISC + 40);
    const int lo = c.lo, hi = c.hi; int step = 0;
#define RUN (lo <= step && step < hi)
#define END_STEP do { if (RUN && step + 1 < hi) { if (!MK_MULTI) xcd_barrier(bar); } ++step; } while (0)
#define END_STEP_NB do { ++step; } while (0)
    for (int l = 0; l < DEPTH; ++l) {
        if (RUN) { CTX; phase_w(lds, c, l, G); }
        END_STEP;
        for (int hf = 0; hf < 2; ++hf) {
            const size_t r0 = (size_t)hf * TH;
            if (RUN) {
                CTX;
                pg8::StaticOrder S; S.init(c.ws + WS_XB + r0 * D, c.ws + WS_WIN, TH, NIN, D / 2, G, lbid());
                EpiIn E{wsb(c, WS_H + H_QG), wsb(c, WS_H + H_KG), wsb(c, WS_H + H_VG), wsb(c, WS_H + H_SR), wsb(c, WS_H + H_QD), wsb(c, WS_H + H_KD), wsb(c, WS_H + H_VD), wsb(c, WS_H + H_GT), (float*)(c.ws + WS_HA), c.pos + r0};
                pg8::gemm_phase<EpiIn, pg8::StaticOrder, true>(lds, D / 2, S, E);
            }
            END_STEP;
            if (RUN) { CTX; phase_p(lds, c, l, G); }
            END_STEP;
            if (RUN) { CTX; phase_b1(lds, c, l, hf, G); }
            END_STEP;
            if (RUN) { CTX; phase_b(lds, c, l, hf, G); }
            END_STEP;
            if (RUN) { CTX; (void)lds; phase_f(c, G); }
            END_STEP_NB;
            if (RUN) {
                CTX;
                pg8::StaticOrder S; S.init(c.ws + WS_OG, c.ws + WS_WGO, TH, D, D / 2, G, lbid());
                EpiGate<false> E{wsb(c, WS_MIX), c.ws + WS_H + H_GT, nullptr};
                pg8::gemm_phase<EpiGate<false>, pg8::StaticOrder, true>(lds, D / 2, S, E);
            }
            END_STEP;
            if (RUN) {
                CTX;
                pg8::StaticOrder S; S.init(c.ws + WS_ATT, c.ws + WS_WAO, TH, D, 256, G, lbid());
                EpiGate<true> E{wsb(c, WS_MIX), c.ws + WS_H + H_GT + 1024, c.ws + WS_OG + 32 * MiB};
                pg8::gemm_phase<EpiGate<true>, pg8::StaticOrder, true>(lds, 256, S, E);
            }
            END_STEP;
            if (RUN) {
                CTX;
                pg8::StaticOrder S; S.init(c.ws + WS_OG + 32 * MiB, c.ws + WS_WOUT, TH, D, D / 2, G, lbid());
                EpiRes E{l == 0 ? c.x + r0 * D : nullptr, wsb(c, WS_XR) + r0 * D};
                pg8::gemm_phase<EpiRes, pg8::StaticOrder, true>(lds, D / 2, S, E);
            }
            if (hf == 1) END_STEP; else END_STEP_NB;
        }
        if (RUN) { CTX; phase_r(lds, c, l, G); }
        END_STEP;
        if (RUN) { CTX; phase_r2(lds, c, l, G); }
        END_STEP;
        if (RUN) {   CTX;
            const int ntiles = moe_setup(lds, c, l);
            volatile LAS int* PRE = (volatile LAS int*)(lds + MISC_OFF); volatile LAS int* TAB = (volatile LAS int*)(lds + TAB_OFF);
            pg8::MoeOrder S; S.G = G; S.c = vcu_of(lbid(), G); S.ntot = ntiles * 8; S.NC = 8; S.K = D / 2; S.pre = PRE; S.cnt = PRE + 17; S.A = (const char*)(c.ws + WS_XB); S.Bt = (const char*)(c.ws + WS_WGU);
            S.bstride = (size_t)2048 * 1024; S.tab = TAB; S.gather = true;
            const int* list = (const int*)(c.ws + WS_LIST);
            { const int lt_tid = ltid(); const int r = lt_tid & 255, half = rfl(lt_tid >> 8);
              for (int i0 = 0; i0 < MAXU; i0 += 2) { Unit u; const int i = i0 + half;
                  if (S.next(i, u)) { const int lt = u.pm - PRE[u.e]; const int pos = 256 * lt + (r < u.nv ? r : 0); TAB[i * 256 + r] = list[(size_t)u.e * T + pos] >> 1; } } }
            __syncthreads();
            EpiM1 E{c.ws + WS_HM};
            pg8::gemm_phase<EpiM1, pg8::MoeOrder, true>(lds, D / 2, S, E);
        }
        END_STEP;
        if (RUN) {   CTX;
            const int ntiles = moe_setup(lds, c, l);
            volatile LAS int* PRE = (volatile LAS int*)(lds + MISC_OFF);
            pg8::MoeOrder S; S.G = G; S.c = vcu_of(lbid(), G); S.ntot = ntiles * 4; S.NC = 4; S.K = DFF / 2; S.pre = PRE; S.cnt = PRE + 17; S.A = (const char*)(c.ws + WS_HM); S.Bt = (const char*)(c.ws + WS_WD);
            S.bstride = (size_t)1024 * 1024; S.tab = nullptr; S.gather = false;
            EpiM2 E{c.ws + WS_YS, (const int*)(c.ws + WS_LIST), PRE};
            pg8::gemm_phase<EpiM2, pg8::MoeOrder, true>(lds, DFF / 2, S, E);
        }
        END_STEP;
        if (RUN) { CTX; (void)lds; phase_c(c, l, G); }
        END_STEP_NB;
    }
#undef RUN
#undef END_STEP
#undef END_STEP_NB
}
constexpr int NSTEPS = DEPTH * (1 + 2 * 8 + 5);

extern "C" void kernel_launch(void* const* d_in, const int* in_sizes, int n_in, void* d_out, int out_size, void* d_ws, size_t ws_size, hipStream_t stream) {
    static int grid = 0;
    if (grid == 0) {
        if (n_in != 18 || in_sizes[0] != T * D || out_size != T * D || ws_size < WS_END) { fprintf(stderr, "kernel_launch: unexpected shapes / workspace (need %zu, got %zu)\n", (size_t)WS_END, ws_size); grid = -1; return; }
        int dev = 0, cus = 0;
        if (hipGetDevice(&dev) != hipSuccess || hipDeviceGetAttribute(&cus, hipDeviceAttributeMultiprocessorCount, dev) != hipSuccess) { grid = -1; return; }
        if (hipFuncSetAttribute((const void*)mk_fwd, hipFuncAttributeMaxDynamicSharedMemorySize, LDS_BYTES) != hipSuccess) { fprintf(stderr, "kernel_launch: hipFuncSetAttribute failed\n"); grid = -1; return; }
        int per_cu = 0;
        if (hipOccupancyMaxActiveBlocksPerMultiprocessor(&per_cu, (const void*)mk_fwd, NTHREADS, LDS_BYTES) != hipSuccess || per_cu < 1) { fprintf(stderr, "kernel_launch: occupancy query says %d\n", per_cu); }
        (void)hipGetLastError();
        grid = cus;
    }
    if (grid < 0) return;
    (void)hipMemsetAsync((char*)d_ws + WS_CTL, 0, CTL_ZERO_BYTES, stream);
    Ctx c{};
    c.x = (const float*)d_in[0]; c.pos = (const int*)d_in[1]; c.w_in = (const float*)d_in[2]; c.w_alpha_up = (const float*)d_in[3]; c.b_alpha = (const float*)d_in[4]; c.gla_norm = (const float*)d_in[5];
    c.w_gla_o = (const float*)d_in[6]; c.w_att_o = (const float*)d_in[7]; c.w_out = (const float*)d_in[8]; c.ln1_g = (const float*)d_in[9]; c.ln1_b = (const float*)d_in[10]; c.w_router = (const float*)d_in[11];
    c.b_router = (const float*)d_in[12]; c.w_e_gate = (const float*)d_in[13]; c.w_e_up = (const float*)d_in[14]; c.w_e_down = (const float*)d_in[15]; c.ln2_g = (const float*)d_in[16]; c.ln2_b = (const float*)d_in[17];
    c.out = (float*)d_out; c.ws = (unsigned char*)d_ws;
#if MK_MULTI
    for (int s = 0; s < NSTEPS; ++s) { c.lo = s; c.hi = s + 1; hipLaunchKernelGGL(mk_fwd, dim3(grid), dim3(NTHREADS), LDS_BYTES, stream, c); }
#else
    c.lo = 0; c.hi = NSTEPS; hipLaunchKernelGGL(mk_fwd, dim3(grid), dim3(NTHREADS), LDS_BYTES, stream, c);
#endif
}
```

```cpp
#include <hip/hip_runtime.h>
#include <cstdio>
#include <cstdint>

#ifndef MK_MULTI
#define MK_MULTI 0
#endif

#define DI __device__ __forceinline__
#define GAS __attribute__((address_space(1)))
#define LAS __attribute__((address_space(3)))
typedef unsigned short bf16_t;
typedef short bf16x8 __attribute__((ext_vector_type(8)));
typedef short s16x4 __attribute__((ext_vector_type(4)));
typedef float f32x4 __attribute__((ext_vector_type(4)));
typedef float f32x2 __attribute__((ext_vector_type(2)));
typedef unsigned u32x4 __attribute__((ext_vector_type(4)));
typedef unsigned u32x2 __attribute__((ext_vector_type(2)));
typedef int i32x4 __attribute__((ext_vector_type(4)));
typedef int i32x8 __attribute__((ext_vector_type(8)));
#define LDS_WAIT() asm volatile("s_waitcnt lgkmcnt(0)" ::: "memory")
#define VM_WAIT() asm volatile("s_waitcnt vmcnt(0)" ::: "memory")

constexpr int D = 1024, NBATCH = 16, SEQ = 4096, T = NBATCH * SEQ, DEPTH = 4;
constexpr int TH = T / 2;
constexpr int DIN = 9744, NIN = 9984;
constexpr int NEXP = 16, DFF = 1024;
constexpr float LN_EPS = 1e-5f, RMS_EPS = 1e-6f;
constexpr float DN_ALPHA = 1.6817928305074290f;
constexpr float LOG2E = 1.4426950408889634f;
constexpr int NWAVES = 8, NTHREADS = 512;

constexpr size_t MiB = 1u << 20;
constexpr size_t WS_CTL = 0, CTL_ZERO_BYTES = 1 * MiB;
constexpr size_t WS_WIN = 1 * MiB;
constexpr size_t WS_WGO = WS_WIN + (size_t)NIN * D;
constexpr size_t WS_WAO = WS_WGO + 2 * MiB;
constexpr size_t WS_WOUT = WS_WAO + 1 * MiB;
constexpr size_t WS_WGU = WS_WOUT + 2 * MiB;
constexpr size_t WS_WD = WS_WGU + 32 * MiB;
constexpr size_t WS_XB = WS_WD + 16 * MiB;
constexpr size_t WS_XR = WS_XB + 64 * MiB;
constexpr size_t WS_LIST = WS_XR + 128 * MiB;
constexpr size_t WS_GATE = WS_LIST + 4 * MiB;
constexpr size_t WS_INFO = WS_GATE + 1 * MiB;
constexpr size_t WS_HISTG = WS_INFO + 1 * MiB;
constexpr size_t WS_OG = WS_HISTG + 1 * MiB;
constexpr size_t WS_ATTG = WS_OG + 64 * MiB;
constexpr size_t WS_LSE = WS_ATTG + 96 * MiB;
constexpr size_t WS_ATT = WS_LSE + 3 * MiB;
constexpr size_t WS_MIX = WS_ATT + 32 * MiB;
constexpr size_t WS_HA = WS_MIX + 64 * MiB;
constexpr size_t WS_H = WS_HA + 2 * MiB;
constexpr size_t H_QG = 0, H_KG = H_QG + (size_t)TH * 512 * 2, H_VG = H_KG + (size_t)TH * 512 * 2, H_SR = H_VG + (size_t)TH * 1024 * 2,
                 H_QD = H_SR + (size_t)TH * 1024 * 2, H_KD = H_QD + (size_t)TH * 1536 * 2, H_VD = H_KD + (size_t)TH * 1536 * 2, H_GT = H_VD + (size_t)TH * 1536 * 2,
                 H_END = H_GT + (size_t)TH * 2048 * 2;
constexpr size_t WS_HM = WS_H;
constexpr size_t WS_YS = WS_HM + (size_t)(2 * T + 4096) * 1024 * 2;
constexpr size_t WS_STAT = WS_CTL + 512 * 1024;
constexpr size_t WS_W2 = WS_H + 544 * MiB, WSET_BYTES = WS_XB - WS_WIN;
static_assert(WS_W2 + WSET_BYTES <= WS_H + H_END, "second weight set fits");
constexpr size_t WS_REC = WS_H + H_END;
constexpr size_t WS_SLOC = WS_REC + (size_t)2048 * 33792;
constexpr size_t WS_DCUM = WS_SLOC + 16 * MiB;
constexpr size_t WS_END = WS_DCUM + 1 * MiB;
static_assert(WS_YS + (size_t)2 * T * 1024 * 2 <= WS_END, "MoE overlay fits");
constexpr int CW_BAR = 4096;
constexpr int CW_TKT = 24576;
constexpr int CW_CUR = 16384;
constexpr int CW_WTK = 40960;

constexpr int RING_BYTES = 131072;
constexpr int TAB_OFF = RING_BYTES, MAXU = 18, TAB_BYTES = MAXU * 1024;
constexpr int LDS_BYTES = 163840;
constexpr int MISC_OFF = LDS_BYTES - 256;
static_assert(TAB_OFF + TAB_BYTES <= MISC_OFF, "LDS map");

DI int rfl(int v) { return __builtin_amdgcn_readfirstlane(v); }
DI int lbid() { int t = blockIdx.x; asm volatile("" : "+s"(t)); return t; }
DI int lgrid() { int t = gridDim.x; asm volatile("" : "+s"(t)); return t; }
DI int vcu_of(int bid, int G) { return (G % 8 == 0) ? (bid % 8) * (G / 8) + bid / 8 : bid; }
DI int ltid() { int t = threadIdx.x; asm volatile("" : "+v"(t)); return t; }
DI float bf2f(unsigned b) { return __uint_as_float(b << 16); }
typedef __bf16 bf16x2_t __attribute__((ext_vector_type(2)));
DI unsigned cvt_pk_bf16(float lo, float hi) { f32x2 v = {lo, hi}; bf16x2_t b = __builtin_convertvector(v, bf16x2_t); return __builtin_bit_cast(unsigned, b); }
DI float clamp8(float v) { return fminf(fmaxf(v, -448.f), 448.f); }
DI unsigned pk4_fp8(float a, float b, float c_, float d) { int w = 0; w = __builtin_amdgcn_cvt_pk_fp8_f32(clamp8(a), clamp8(b), w, false); w = __builtin_amdgcn_cvt_pk_fp8_f32(clamp8(c_), clamp8(d), w, true); return (unsigned)w; }
constexpr float W8_SCALE = 64.0f, W8_INV = 1.0f / 64.0f;
DI float bf_lo(unsigned w) { return __uint_as_float(w << 16); }
DI float bf_hi(unsigned w) { return __uint_as_float(w & 0xffff0000u); }
DI float sigmoidf_(float x) { return __builtin_amdgcn_rcpf(1.0f + __builtin_amdgcn_exp2f(-x * LOG2E)); }
DI float sigmoid64_(float x64) { return __builtin_amdgcn_rcpf(1.0f + __builtin_amdgcn_exp2f(x64 * (-LOG2E * W8_INV))); }

#define XB_TMO      128
#define XB_XCNT(j)  (256  + 64 * (j))
#define XB_XSUB(j)  (1280 + 64 * (j))
#define XB_XGEN(j)  (2304 + 64 * (j))
#define XB_TOP      3328
#define XB_TOPGEN   3392
#define XCD_BAR_WORDS 3456
#define XB_SPIN_CAP (1u << 18)
DI unsigned xb_ld(unsigned* p)              { return __hip_atomic_load(p, __ATOMIC_RELAXED, __HIP_MEMORY_SCOPE_AGENT); }
DI unsigned xb_add(unsigned* p, unsigned v) { return __hip_atomic_fetch_add(p, v, __ATOMIC_RELAXED, __HIP_MEMORY_SCOPE_AGENT); }
DI unsigned xb_xcc_id() { return (unsigned)__builtin_amdgcn_s_getreg((3 << 11) | 20) & 0xFu; }
#define XB_SPIN(cond, bar) do { unsigned _sp = 0; while (cond) { __builtin_amdgcn_s_sleep(1); \
    if ((++_sp & 255u) == 0u) { if (xb_ld(&(bar)[XB_TMO])) break; if (_sp > XB_SPIN_CAP) { atomicAdd(&(bar)[XB_TMO], 1u); break; } } } } while (0)
struct XcdBarrier { unsigned* bar; unsigned x; volatile LAS unsigned* st; };
DI XcdBarrier xcd_barrier_post(unsigned* bar, volatile LAS unsigned* st) {
    XcdBarrier b; b.bar = bar; b.x = xb_xcc_id(); b.st = st;
    if (threadIdx.x == 0) (void)xb_add(&bar[XB_XCNT(b.x)], 1u);
    return b;
}
DI void xcd_barrier_complete(unsigned* bar, unsigned x, unsigned& nloc, unsigned& nx) {
    const unsigned G = gridDim.x * gridDim.y * gridDim.z;
    unsigned sum, cnt, mine, sp = 0u;
    for (;;) {
        sum = 0u; cnt = 0u; mine = 0u;
#pragma unroll
        for (unsigned j = 0; j < 16; ++j) { const unsigned c = xb_ld(&bar[XB_XCNT(j)]); sum += c; cnt += (c > 0u) ? 1u : 0u; mine = (j == x) ? c : mine; }
        if (sum == G) break;
        __builtin_amdgcn_s_sleep(1);
        if ((++sp & 255u) == 0u) { if (xb_ld(&bar[XB_TMO])) break; if (sp > XB_SPIN_CAP) { atomicAdd(&bar[XB_TMO], 1u); break; } }
    }
    nloc = mine > 0u ? mine : 1u; nx = cnt > 0u ? cnt : 1u;
}
DI void xcd_barrier(const XcdBarrier& b) {
    asm volatile("s_waitcnt vmcnt(0)" ::: "memory");
    __syncthreads();
    if (threadIdx.x == 0) {
        unsigned* bar = b.bar;
        __builtin_amdgcn_s_waitcnt(0);
        unsigned nloc = b.st[0], nx = b.st[1];
        if (nloc == 0u) { xcd_barrier_complete(bar, b.x, nloc, nx); b.st[0] = nloc; b.st[1] = nx; }
        const unsigned old = xb_add(&bar[XB_XSUB(b.x)], 1u);
        const unsigned gen = old / nloc;
        if (old + 1u == (gen + 1u) * nloc) {
            __builtin_amdgcn_fence(__ATOMIC_RELEASE, "agent");
            asm volatile("s_waitcnt vmcnt(0)" ::: "memory");
            const unsigned og = xb_add(&bar[XB_TOP], 1u);
            const unsigned tg = og / nx;
            if (og + 1u == (tg + 1u) * nx) xb_add(&bar[XB_TOPGEN], 1u);
            else XB_SPIN(xb_ld(&bar[XB_TOPGEN]) == tg, bar);
            __builtin_amdgcn_fence(__ATOMIC_ACQUIRE, "agent");
            xb_add(&bar[XB_XGEN(b.x)], 1u);
            asm volatile("s_waitcnt vmcnt(0)" ::: "memory");
        } else {
            XB_SPIN(xb_ld(&bar[XB_XGEN(b.x)]) == gen, bar);
            __builtin_amdgcn_fence(__ATOMIC_ACQUIRE, "agent");
            asm volatile("s_waitcnt vmcnt(0)" ::: "memory");
        }
    }
    __syncthreads();
}

struct Ctx {
    const float* x; const int* pos; const float* w_in; const float* w_alpha_up; const float* b_alpha; const float* gla_norm;
    const float* w_gla_o; const float* w_att_o; const float* w_out; const float* ln1_g; const float* ln1_b; const float* w_router; const float* b_router;
    const float* w_e_gate; const float* w_e_up; const float* w_e_down; const float* ln2_g; const float* ln2_b;
    float* out; unsigned char* ws;
    int lo, hi;
};
DI bf16_t* wsb(const Ctx& c, size_t off) { return (bf16_t*)(c.ws + off); }
DI size_t wset(int l) { return (l & 1) ? (WS_W2 - WS_WIN) : (size_t)0; }

namespace pg8 {
constexpr int BM = 256, BK = 64, HALF = 128, HTB = HALF * BK * 2, STAGE_BYTES = 8 * HTB, NXCD = 8, WGM = 8;
DI int lds_byte(int r, int c) { const int st = (r >> 4) * 2 + (c >> 5), rr = r & 15, cc = c & 31, ob = rr * 64 + cc * 2; return st * 1024 + (ob ^ (((ob >> 9) & 1) << 5)); }
DI void stage_rc(int b, int& R, int& C) { const int st = b / 1024, sb = b % 1024, swz = sb ^ (((sb >> 9) & 1) << 5); R = (st >> 1) * 16 + swz / 64; C = (st & 1) * 32 + (swz % 64) / 2; }
DI int perm32(int rho) { const int n = rho >> 4, i = rho & 15; return 8 * (i >> 2) + 4 * n + (i & 3); }
struct Unit { int pm, pn, e, nv, ui; };

struct StaticOrder {
    int nM, nN, nwg, G, c, K; const char* A; const char* Bt;
    DI void init(const void* A_, const void* Bt_, int M, int N, int K_, int G_, int c_) { A = (const char*)A_; Bt = (const char*)Bt_; nM = M / BM; nN = N / BM; nwg = nM * nN; G = G_; c = c_; K = K_; }
    DI bool next(int i, Unit& u) const {
        const long L = (long)i * G + c; if (L >= nwg) return false;
        int wgid = (int)L; { const int q = nwg / NXCD, r = nwg % NXCD, xcd = wgid % NXCD, off = wgid / NXCD; wgid = (xcd < r ? xcd * (q + 1) : r * (q + 1) + (xcd - r) * q) + off; }
        const int nig = WGM * nN, gid = wgid / nig, fm = gid * WGM, gsz = (nM - fm) < WGM ? (nM - fm) : WGM;
        u.pm = fm + ((wgid % nig) % gsz); u.pn = (wgid % nig) / gsz; u.e = 0; u.nv = 256; u.ui = i; return true;
    }
    DI const char* a_base(const Unit& u) const { return A + (size_t)u.pm * BM * K * 2; }
    DI const char* b_base(const Unit& u) const { return Bt + (size_t)u.pn * BM * K * 2; }
    DI void a_off(const Unit&, int tid, unsigned (&o)[2][2]) const {
#pragma unroll
        for (int i = 0; i < 2; ++i) { int R, C; stage_rc(tid * 16 + i * 8192, R, C);
#pragma unroll
            for (int h = 0; h < 2; ++h) o[h][i] = (unsigned)((h * HALF + R) * K + C) * 2u; }
    }
};
struct MoeOrder {
    int G, c, ntot, NC, K; const volatile LAS int* pre; const volatile LAS int* cnt; const char* A; const char* Bt; size_t bstride; const volatile LAS int* tab; bool gather;
    DI bool next(int i, Unit& u) const {
        const int L = i * G + c; if (L >= ntot) return false;
        const int rt = L / NC; u.pn = L - rt * NC; u.pm = rt;
        int e = 0;
#pragma unroll
        for (int j = 1; j < 16; ++j) e += (rt >= rfl(pre[j])) ? 1 : 0;
        e = rfl(e); u.e = e; const int rem = rfl(cnt[e]) - 256 * (rt - rfl(pre[e])); u.nv = rem < 256 ? rem : 256; u.ui = i; return true;
    }
    DI const char* a_base(const Unit& u) const { return gather ? A : A + (size_t)u.pm * BM * K * 2; }
    DI const char* b_base(const Unit& u) const { return Bt + (size_t)u.e * bstride + (size_t)u.pn * BM * K * 2; }
    DI void a_off(const Unit& u, int tid, unsigned (&o)[2][2]) const {
#pragma unroll
        for (int i = 0; i < 2; ++i) { int R, C; stage_rc(tid * 16 + i * 8192, R, C);
#pragma unroll
            for (int h = 0; h < 2; ++h) { const int row = gather ? tab[u.ui * 256 + h * HALF + R] : (h * HALF + R); o[h][i] = (unsigned)(row * K + C) * 2u; } }
    }
};

template <class Epi, class Sched, bool F8 = false>
DI void gemm_phase(LAS unsigned char* lds, const int K, const Sched& S, const Epi& E) {
    const int tid = ltid(), wid = rfl(tid >> 6), lane = tid & 63, wr = wid >> 2, wc = wid & 3, fr = lane & 15, fq = lane >> 4;
    const int nt = K / BK;
    unsigned voffB[2];
#pragma unroll
    for (int i = 0; i < 2; ++i) { int R, C; stage_rc(tid * 16 + i * 8192, R, C); const int Rb = Epi::PERM ? ((R & ~31) + perm32(R & 31)) : R; voffB[i] = (unsigned)(Rb * K + C) * 2u; }
    const size_t kstep = (size_t)(BK * 2);
    const size_t hstep = (size_t)HALF * K * 2;
    const unsigned ldsw = (unsigned)wid * 1024u;
    const int aoff = lds_byte(wr * 64 + fr, fq * 8), boff = lds_byte(wc * 32 + fr, fq * 8);
#define PG8_SA(b, h) (((b) * 2 + (h)) * HTB)
#define PG8_SB(b, h) ((4 + (b) * 2 + (h)) * HTB)
#define PG8_STAGE(bufoff, gbase, voff) do { _Pragma("unroll") for (int _i = 0; _i < 2; ++_i) \
        __builtin_amdgcn_global_load_lds((const unsigned*)((const char*)(gbase) + (voff)[_i]), (LAS unsigned*)(lds + (bufoff) + ldsw + _i * 8192), 16, 0, 0); } while (0)
#define PG8_LD8(p) __builtin_shufflevector(*(const LAS i32x4*)(p), *(const LAS i32x4*)((p) + 1024), 0, 1, 2, 3, 4, 5, 6, 7)
#define PG8_LDA(dst, b, h) do { if constexpr (F8) { _Pragma("unroll") for (int m = 0; m < 4; ++m) dst##8[m] = PG8_LD8(lds + PG8_SA(b, h) + aoff + m * 2048); } else { \
        _Pragma("unroll") for (int m = 0; m < 4; ++m) _Pragma("unroll") for (int k = 0; k < 2; ++k) dst[m][k] = *(const LAS bf16x8*)(lds + PG8_SA(b, h) + aoff + m * 2048 + k * 1024); } } while (0)
#define PG8_LDB(dst, b, h) do { if constexpr (F8) { _Pragma("unroll") for (int n = 0; n < 2; ++n) dst##8[n] = PG8_LD8(lds + PG8_SB(b, h) + boff + n * 2048); } else { \
        _Pragma("unroll") for (int n = 0; n < 2; ++n) _Pragma("unroll") for (int k = 0; k < 2; ++k) dst[n][k] = *(const LAS bf16x8*)(lds + PG8_SB(b, h) + boff + n * 2048 + k * 1024); } } while (0)
#define PG8_MMA(ai, bj, At, Bt) do { __builtin_amdgcn_s_setprio(1); if constexpr (F8) { _Pragma("unroll") for (int m = 0; m < 4; ++m) _Pragma("unroll") for (int n = 0; n < 2; ++n) \
        asm volatile("v_mfma_f32_16x16x128_f8f6f4 %0, %1, %2, %0" : "+v"(acc[ai][bj][m][n]) : "v"(Bt##8[n]), "v"(At##8[m])); } else { \
        _Pragma("unroll") for (int m = 0; m < 4; ++m) _Pragma("unroll") for (int n = 0; n < 2; ++n) _Pragma("unroll") for (int k = 0; k < 2; ++k) \
        acc[ai][bj][m][n] = __builtin_amdgcn_mfma_f32_16x16x32_bf16(Bt[n][k], At[m][k], acc[ai][bj][m][n], 0, 0, 0); } __builtin_amdgcn_s_setprio(0); } while (0)
#define PG8_MMA0(ai, bj, At, Bt) do { __builtin_amdgcn_s_setprio(1); _Pragma("unroll") for (int m = 0; m < 4; ++m) _Pragma("unroll") for (int n = 0; n < 2; ++n) \
        asm volatile("v_mfma_f32_16x16x128_f8f6f4 %0, %1, %2, 0" : "=&v"(acc[ai][bj][m][n]) : "v"(Bt##8[n]), "v"(At##8[m])); __builtin_amdgcn_s_setprio(0); } while (0)
#define PG8_WAIT_V(n) asm volatile("s_waitcnt vmcnt(" #n ")" ::: "memory")
#define PG8_WAIT_L(n) asm volatile("s_waitcnt lgkmcnt(" #n ")" ::: "memory")
#define PG8_WAIT_VX(sx) do { if ((sx) >= 48) PG8_WAIT_V(56); else if ((sx) >= 32) PG8_WAIT_V(40); else if ((sx) >= 24) PG8_WAIT_V(32); else if ((sx) >= 16) PG8_WAIT_V(24); else if ((sx) >= 8) PG8_WAIT_V(16); else PG8_WAIT_V(8); } while (0)
#define PG8_BAR __builtin_amdgcn_s_barrier()
#define PG8_SCHED __builtin_amdgcn_sched_barrier(0)
    Unit cur, nxt; int ui = 0, sx = 0;
    if (!S.next(0, cur)) return;
    f32x4 acc[2][2][4][2];
    if constexpr (!F8)
#pragma unroll
    for (int a = 0; a < 2; ++a)
#pragma unroll
        for (int b = 0; b < 2; ++b)
#pragma unroll
            for (int m = 0; m < 4; ++m)
#pragma unroll
                for (int n = 0; n < 2; ++n) acc[a][b][m][n] = (f32x4){0.f, 0.f, 0.f, 0.f};
    bf16x8 At[4][2], B0[2][2], B1[2][2]; i32x8 At8[4], B08[2], B18[2];
    unsigned oA[2][2]; S.a_off(cur, tid, oA);
    const char* cA = S.a_base(cur); const char* cB = S.b_base(cur);
    PG8_STAGE(PG8_SB(0, 0), cB, voffB); PG8_STAGE(PG8_SB(0, 1), cB + hstep, voffB); PG8_STAGE(PG8_SA(0, 0), cA, oA[0]); PG8_STAGE(PG8_SA(0, 1), cA, oA[1]);
    if (wr == 1) PG8_BAR;
    PG8_WAIT_V(2); PG8_BAR;
    PG8_STAGE(PG8_SB(1, 0), cB + kstep, voffB); PG8_STAGE(PG8_SA(1, 0), cA + kstep, oA[0]); PG8_STAGE(PG8_SB(1, 1), cB + hstep + kstep, voffB);
    PG8_WAIT_V(6); PG8_BAR;
    for (;;) {
        const bool has_next = S.next(ui + 1, nxt);
        const char* nA = has_next ? S.a_base(nxt) : cA; const char* nB = has_next ? S.b_base(nxt) : cB;
        for (int t = 0; t < nt; t += 2) {
            const bool last = (t == nt - 2); const int sxe = (t == 0) ? sx : 0;
            const char* a1 = cA + (size_t)(t + 1) * kstep;
            const char* a2 = last ? nA : cA + (size_t)(t + 2) * kstep; const char* b2 = last ? nB : cB + (size_t)(t + 2) * kstep;
            const char* a3 = a2 + kstep; const char* b3 = b2 + kstep;
            PG8_LDB(B0, 0, 0); PG8_LDB(B1, 0, 1); PG8_SCHED; PG8_LDA(At, 0, 0); PG8_STAGE(PG8_SA(1, 1), a1, oA[1]);
            if (last && has_next) S.a_off(nxt, tid, oA);
            PG8_WAIT_VX(sxe); PG8_WAIT_L(0); PG8_BAR; if (F8 && t == 0) { PG8_MMA0(0, 0, At, B0); PG8_MMA0(0, 1, At, B1); } else { PG8_MMA(0, 0, At, B0); PG8_MMA(0, 1, At, B1); } PG8_BAR; PG8_SCHED;
            PG8_LDA(At, 0, 1); PG8_STAGE(PG8_SB(0, 0), b2, voffB); PG8_STAGE(PG8_SB(0, 1), b2 + hstep, voffB); PG8_STAGE(PG8_SA(0, 0), a2, oA[0]);
            PG8_WAIT_VX(sxe); PG8_WAIT_L(0); PG8_BAR; if (F8 && t == 0) { PG8_MMA0(1, 0, At, B0); PG8_MMA0(1, 1, At, B1); } else { PG8_MMA(1, 0, At, B0); PG8_MMA(1, 1, At, B1); } PG8_BAR; PG8_SCHED;
            PG8_LDB(B0, 1, 0); PG8_LDB(B1, 1, 1); PG8_SCHED; PG8_LDA(At, 1, 0); PG8_STAGE(PG8_SA(0, 1), a2, oA[1]);
            PG8_WAIT_V(8); PG8_WAIT_L(0); PG8_BAR; PG8_MMA(0, 0, At, B0); PG8_MMA(0, 1, At, B1); PG8_BAR; PG8_SCHED;
            PG8_LDA(At, 1, 1); PG8_STAGE(PG8_SB(1, 0), b3, voffB); PG8_STAGE(PG8_SB(1, 1), b3 + hstep, voffB); PG8_STAGE(PG8_SA(1, 0), a3, oA[0]);
            PG8_WAIT_V(8); PG8_WAIT_L(0); PG8_BAR; PG8_MMA(1, 0, At, B0); PG8_MMA(1, 1, At, B1); PG8_BAR; PG8_SCHED;
        }
        if (wr == 0) PG8_BAR;
        if constexpr (F8) asm volatile("s_nop 15\n\ts_nop 15" ::: "memory");
        E(acc, cur, wr, wc, fr, fq);
        if (!has_next) break;
        if constexpr (!F8)
#pragma unroll
        for (int a = 0; a < 2; ++a)
#pragma unroll
            for (int b = 0; b < 2; ++b)
#pragma unroll
                for (int m = 0; m < 4; ++m)
#pragma unroll
                    for (int n = 0; n < 2; ++n) acc[a][b][m][n] = (f32x4){0.f, 0.f, 0.f, 0.f};
        cur = nxt; cA = nA; cB = nB; ++ui;
        if (wr == 1) PG8_BAR;
    }
    PG8_WAIT_V(0);
    PG8_BAR;
#undef PG8_SA
#undef PG8_SB
#undef PG8_STAGE
#undef PG8_LDA
#undef PG8_LDB
#undef PG8_MMA
#undef PG8_MMA0
#undef PG8_LD8
#undef PG8_WAIT_V
#undef PG8_WAIT_VX
#undef PG8_WAIT_L
#undef PG8_BAR
#undef PG8_SCHED
}
}
using pg8::Unit;

DI u32x4 pack8(const f32x4& v0, const f32x4& v1) { u32x4 w; w.x = cvt_pk_bf16(v0[0], v0[1]); w.y = cvt_pk_bf16(v0[2], v0[3]); w.z = cvt_pk_bf16(v1[0], v1[1]); w.w = cvt_pk_bf16(v1[2], v1[3]); return w; }

DI void st_pair16(unsigned char* px, int gap, u32x2 x, u32x2 y, int fq) {
    const auto r0 = __builtin_amdgcn_permlane16_swap(x.x, y.x, false, false), r1 = __builtin_amdgcn_permlane16_swap(x.y, y.y, false, false);
    *(GAS u32x4*)(px + ((fq & 1) ? gap - 8 : 0)) = (u32x4){r0[0], r1[0], r0[1], r1[1]};
}
#define SWAP16(a_, b_, x_, y_) do { const auto _r = __builtin_amdgcn_permlane16_swap((a_), (b_), false, false); x_ = _r[0]; y_ = _r[1]; asm volatile("" : "+v"(x_), "+v"(y_)); } while (0)
#define SWAP32(a_, b_, x_, y_) do { const auto _r = __builtin_amdgcn_permlane32_swap((a_), (b_), false, false); x_ = _r[0]; y_ = _r[1]; asm volatile("" : "+v"(x_), "+v"(y_)); } while (0)
DI float xrow_sum(float p) { unsigned x, y; SWAP16(__builtin_bit_cast(unsigned, p), __builtin_bit_cast(unsigned, p), x, y);
    const float t = __builtin_bit_cast(float, x) + __builtin_bit_cast(float, y);
    SWAP32(__builtin_bit_cast(unsigned, t), __builtin_bit_cast(unsigned, t), x, y); return __builtin_bit_cast(float, x) + __builtin_bit_cast(float, y); }
DI float xrow_max(float p) { unsigned x, y; SWAP16(__builtin_bit_cast(unsigned, p), __builtin_bit_cast(unsigned, p), x, y);
    const float t = fmaxf(__builtin_bit_cast(float, x), __builtin_bit_cast(float, y));
    SWAP32(__builtin_bit_cast(unsigned, t), __builtin_bit_cast(unsigned, t), x, y); return fmaxf(__builtin_bit_cast(float, x), __builtin_bit_cast(float, y)); }
DI float rs_swap32(float lo, float hi) { unsigned x, y; SWAP32(__builtin_bit_cast(unsigned, lo), __builtin_bit_cast(unsigned, hi), x, y); return __builtin_bit_cast(float, x) + __builtin_bit_cast(float, y); }
DI float rs_swap16(float lo, float hi) { unsigned x, y; SWAP16(__builtin_bit_cast(unsigned, lo), __builtin_bit_cast(unsigned, hi), x, y); return __builtin_bit_cast(float, x) + __builtin_bit_cast(float, y); }
DI size_t dil_row(int gh, int R) { const int s = 2 * (gh >> 3), bl = R >> 12, t = R & (SEQ - 1);
    return ((size_t)((gh * 8 + bl) * SEQ) + (size_t)((t & ((1 << s) - 1)) * (SEQ >> s) + (t >> s))) * 64; }
struct EpiIn {
    static constexpr bool PERM = true;
    bf16_t *qg, *kg, *vg, *sr, *qd, *kd, *vd, *gt; float* ha; const int* pos;
    DI int nvm(const Unit& u, int) const { return u.pn == 38 ? 0 : 16; }
    DI void operator()(const f32x4 (&acc)[2][2][4][2], const Unit& u, int wr, int wc, int fr, int fq) const {
        asm volatile("" : "+v"(fr), "+v"(fq));
        const int row0 = u.pm * 256 + wr * 64 + fr; const int pn = u.pn;
        if (pn >= 12 && pn < 24) {
            bf16_t* base = pn < 18 ? qd : kd; const int tq = pn < 18 ? pn - 12 : pn - 18; const float sc = pn < 18 ? 0.125f * LOG2E * W8_INV : W8_INV;
            float fre[8];
#pragma unroll
            for (int i = 0; i < 8; ++i) fre[i] = __builtin_amdgcn_exp2f(-(float)(8 * fq + i) * (13.287712379549449f / 32.0f)) * 0.15915494309189535f;
            int posv[8];
#pragma unroll
            for (int q = 0; q < 8; ++q) posv[q] = ((const GAS int*)pos)[row0 + (q >> 2) * 128 + (q & 3) * 16];
#pragma unroll
            for (int ai = 0; ai < 2; ++ai) {
#pragma unroll
                for (int m = 0; m < 4; ++m) {
                    const int r = row0 + ai * 128 + m * 16; const float p = (float)posv[ai * 4 + m];
                    unsigned char* rowp = (unsigned char*)base + dil_row(4 * tq + wc, r) + 8 * fq;
                    u32x2 w1, w2;
#pragma unroll
                    for (int n = 0; n < 2; ++n) { f32x4 o1, o2;
#pragma unroll
                        for (int j = 0; j < 4; ++j) {
                            float a = p * fre[n * 4 + j]; a = a - __builtin_floorf(a);
                            const float sn = __builtin_amdgcn_sinf(a), cs = __builtin_amdgcn_cosf(a);
                            const float x1 = acc[ai][0][m][n][j], x2 = acc[ai][1][m][n][j];
                            o1[j] = (x1 * cs - x2 * sn) * sc; o2[j] = (x2 * cs + x1 * sn) * sc;
                        }
                        w1[n] = pk4_fp8(o1[0], o1[1], o1[2], o1[3]); w2[n] = pk4_fp8(o2[0], o2[1], o2[2], o2[3]); }
                    st_pair16(rowp, 32, w1, w2, fq);
                    asm volatile("" ::: "memory");
                } }
        } else if (pn == 38) {
            if (wc == 0 && fq < 2) {
#pragma unroll
                for (int ai = 0; ai < 2; ++ai)
#pragma unroll
                    for (int m = 0; m < 4; ++m) { float* p = ha + (size_t)(row0 + ai * 128 + m * 16) * 16 + 8 * fq; *(GAS f32x4*)p = acc[ai][0][m][0] * W8_INV; *(GAS f32x4*)(p + 4) = acc[ai][0][m][1] * W8_INV; }
            }
        } else {
            bf16_t* base; int ldc, colt, act = 0; float sc = W8_INV;
            if (pn < 2) { base = qg; ldc = 512; colt = pn * 256; sc = 0.08838834764831845f * W8_INV; }
            else if (pn < 4) { base = kg; ldc = 512; colt = (pn - 2) * 256; }
            else if (pn < 8) { base = vg; ldc = 1024; colt = (pn - 4) * 256; }
            else if (pn < 12) {
#pragma unroll
                for (int ai = 0; ai < 2; ++ai)
#pragma unroll
                    for (int m = 0; m < 4; ++m) { unsigned char* rowp = (unsigned char*)sr + (size_t)(row0 + ai * 128 + m * 16) * 1024 + (pn - 8) * 256 + wc * 32 + 8 * fq;
                        u32x2 o[2];
#pragma unroll
                        for (int bj = 0; bj < 2; ++bj) { const f32x4 v0 = acc[ai][bj][m][0] * W8_INV, v1 = acc[ai][bj][m][1] * W8_INV;
                            o[bj].x = pk4_fp8(v0[0] * sigmoidf_(v0[0]), v0[1] * sigmoidf_(v0[1]), v0[2] * sigmoidf_(v0[2]), v0[3] * sigmoidf_(v0[3]));
                            o[bj].y = pk4_fp8(v1[0] * sigmoidf_(v1[0]), v1[1] * sigmoidf_(v1[1]), v1[2] * sigmoidf_(v1[2]), v1[3] * sigmoidf_(v1[3])); }
                        st_pair16(rowp, 128, o[0], o[1], fq); }
                return; }
            else if (pn < 30) {
#pragma unroll
                for (int ai = 0; ai < 2; ++ai)
#pragma unroll
                    for (int m = 0; m < 4; ++m) { unsigned char* rowp = (unsigned char*)vd + dil_row(4 * (pn - 24) + (wc >> 1), row0 + ai * 128 + m * 16) + (wc & 1) * 32 + 8 * fq;
                        u32x2 o[2];
#pragma unroll
                        for (int bj = 0; bj < 2; ++bj) { const f32x4 v0 = acc[ai][bj][m][0] * W8_INV, v1 = acc[ai][bj][m][1] * W8_INV; o[bj].x = pk4_fp8(v0[0], v0[1], v0[2], v0[3]); o[bj].y = pk4_fp8(v1[0], v1[1], v1[2], v1[3]); }
                        st_pair16(rowp, 2 * 8 * SEQ * 64, o[0], o[1], fq); }
                return; }
            else {
#pragma unroll
                for (int ai = 0; ai < 2; ++ai)
#pragma unroll
                    for (int m = 0; m < 4; ++m) { unsigned char* rowp = (unsigned char*)gt + (size_t)(row0 + ai * 128 + m * 16) * 2048 + (pn - 30) * 256 + wc * 32 + 8 * fq;
                        u32x2 o[2];
#pragma unroll
                        for (int bj = 0; bj < 2; ++bj) {
#pragma unroll
                            for (int n = 0; n < 2; ++n) { const f32x4 v = acc[ai][bj][m][n];
                                o[bj][n] = (unsigned)(sigmoid64_(v[0]) * 255.0f + 0.5f) | ((unsigned)(sigmoid64_(v[1]) * 255.0f + 0.5f) << 8) | ((unsigned)(sigmoid64_(v[2]) * 255.0f + 0.5f) << 16) | ((unsigned)(sigmoid64_(v[3]) * 255.0f + 0.5f) << 24); } }
                        st_pair16(rowp, 128, o[0], o[1], fq); }
                return; }
#pragma unroll
            for (int ai = 0; ai < 2; ++ai)
#pragma unroll
                for (int m = 0; m < 4; ++m) { bf16_t* rowp = base + (size_t)(row0 + ai * 128 + m * 16) * ldc + colt + wc * 32 + 8 * fq;
#pragma unroll
                    for (int bj = 0; bj < 2; ++bj) { f32x4 v0 = acc[ai][bj][m][0] * sc, v1 = acc[ai][bj][m][1] * sc;
                        if (act) {
#pragma unroll
                            for (int j = 0; j < 4; ++j) { const float s0 = sigmoidf_(v0[j]), s1 = sigmoidf_(v1[j]); v0[j] = act == 1 ? v0[j] * s0 : s0; v1[j] = act == 1 ? v1[j] * s1 : s1; } }
                        *(GAS u32x4*)(rowp + bj * 128) = pack8(v0, v1); } }
        }
    }
};
template <bool ADD> struct EpiGate {
    static constexpr bool PERM = true;
    bf16_t* mix; const unsigned char* gt; unsigned char* mix8;
    DI int nvm(const Unit&, int) const { return ADD ? 48 : 32; }
    DI void operator()(const f32x4 (&acc)[2][2][4][2], const Unit& u, int wr, int wc, int fr, int fq) const {
        asm volatile("" : "+v"(fr), "+v"(fq));
        const int row0 = u.pm * 256 + wr * 64 + fr, col0 = u.pn * 256 + wc * 32 + 8 * fq; constexpr float k = W8_INV / 255.0f;
        u32x2 g[2][4][2];
#pragma unroll
        for (int ai = 0; ai < 2; ++ai)
#pragma unroll
            for (int m = 0; m < 4; ++m)
#pragma unroll
                for (int bj = 0; bj < 2; ++bj) g[ai][m][bj] = *(const GAS u32x2*)(gt + (size_t)(row0 + ai * 128 + m * 16) * 2048 + col0 + bj * 128);
#pragma unroll
        for (int ai = 0; ai < 2; ++ai) {
            u32x2 ov[4][2];
            if (ADD) {
#pragma unroll
                for (int m = 0; m < 4; ++m)
#pragma unroll
                    for (int bj = 0; bj < 2; ++bj) ov[m][bj] = *(const GAS u32x2*)((const GAS unsigned char*)mix + (size_t)(row0 + ai * 128 + m * 16) * 1024 + col0 + bj * 128);
            }
            asm volatile("" ::: "memory");
#pragma unroll
            for (int m = 0; m < 4; ++m) { const size_t r = (size_t)(row0 + ai * 128 + m * 16); u32x2 o8v[2];
#pragma unroll
                for (int bj = 0; bj < 2; ++bj) {
                    const u32x2 gg = g[ai][m][bj];
                    f32x4 v0 = acc[ai][bj][m][0], v1 = acc[ai][bj][m][1];
                    v0[0] *= (float)((gg.x >> 0) & 0xffu) * k; v0[1] *= (float)((gg.x >> 8) & 0xffu) * k; v0[2] *= (float)((gg.x >> 16) & 0xffu) * k; v0[3] *= (float)((gg.x >> 24) & 0xffu) * k;
                    v1[0] *= (float)((gg.y >> 0) & 0xffu) * k; v1[1] *= (float)((gg.y >> 8) & 0xffu) * k; v1[2] *= (float)((gg.y >> 16) & 0xffu) * k; v1[3] *= (float)((gg.y >> 24) & 0xffu) * k;
                    if (ADD) { const u32x2 o = ov[m][bj]; const f32x2 oa = __builtin_amdgcn_cvt_pk_f32_fp8((int)o.x, false), ob = __builtin_amdgcn_cvt_pk_f32_fp8((int)o.x, true), oc = __builtin_amdgcn_cvt_pk_f32_fp8((int)o.y, false), od = __builtin_amdgcn_cvt_pk_f32_fp8((int)o.y, true);
                        v0[0] += oa[0]; v0[1] += oa[1]; v0[2] += ob[0]; v0[3] += ob[1]; v1[0] += oc[0]; v1[1] += oc[1]; v1[2] += od[0]; v1[3] += od[1];
                    }
                    o8v[bj].x = pk4_fp8(v0[0], v0[1], v0[2], v0[3]); o8v[bj].y = pk4_fp8(v1[0], v1[1], v1[2], v1[3]); }
                st_pair16((ADD ? mix8 : (unsigned char*)mix) + r * 1024 + col0, 128, o8v[0], o8v[1], fq); }
        }
    }
};
struct EpiRes {
    static constexpr bool PERM = true;
    const float* x32; bf16_t* xr;
    DI int nvm(const Unit&, int) const { return 32; }
    DI void operator()(const f32x4 (&acc)[2][2][4][2], const Unit& u, int wr, int wc, int fr, int fq) const {
        asm volatile("" : "+v"(fr), "+v"(fq));
        const int row0 = u.pm * 256 + wr * 64 + fr, col0 = u.pn * 256 + wc * 32 + 8 * fq;
        if (x32) {
#pragma unroll
            for (int ai = 0; ai < 2; ++ai)
#pragma unroll
                for (int m2 = 0; m2 < 4; m2 += 2) { f32x4 a[2][2][2];
#pragma unroll
                    for (int mm = 0; mm < 2; ++mm)
#pragma unroll
                        for (int bj = 0; bj < 2; ++bj) { const size_t off = (size_t)(row0 + ai * 128 + (m2 + mm) * 16) * 1024 + col0 + bj * 128; a[mm][bj][0] = *(const GAS f32x4*)(x32 + off); a[mm][bj][1] = *(const GAS f32x4*)(x32 + off + 4); }
                    asm volatile("" ::: "memory");
#pragma unroll
                    for (int mm = 0; mm < 2; ++mm)
#pragma unroll
                        for (int bj = 0; bj < 2; ++bj) { const size_t off = (size_t)(row0 + ai * 128 + (m2 + mm) * 16) * 1024 + col0 + bj * 128;
                            *(GAS u32x4*)(xr + off) = pack8(a[mm][bj][0] * DN_ALPHA + acc[ai][bj][m2 + mm][0] * W8_INV, a[mm][bj][1] * DN_ALPHA + acc[ai][bj][m2 + mm][1] * W8_INV); }
                    asm volatile("" ::: "memory"); }
        } else {
#pragma unroll
            for (int ai = 0; ai < 2; ++ai) { u32x4 o[4][2];
#pragma unroll
                for (int m = 0; m < 4; ++m)
#pragma unroll
                    for (int bj = 0; bj < 2; ++bj) o[m][bj] = *(const GAS u32x4*)(xr + (size_t)(row0 + ai * 128 + m * 16) * 1024 + col0 + bj * 128);
                asm volatile("" ::: "memory");
#pragma unroll
                for (int m = 0; m < 4; ++m)
#pragma unroll
                    for (int bj = 0; bj < 2; ++bj) { const u32x4 q = o[m][bj]; const f32x4 a0 = (f32x4){bf_lo(q.x), bf_hi(q.x), bf_lo(q.y), bf_hi(q.y)}, a1 = (f32x4){bf_lo(q.z), bf_hi(q.z), bf_lo(q.w), bf_hi(q.w)};
                        *(GAS u32x4*)(xr + (size_t)(row0 + ai * 128 + m * 16) * 1024 + col0 + bj * 128) = pack8(a0 * DN_ALPHA + acc[ai][bj][m][0] * W8_INV, a1 * DN_ALPHA + acc[ai][bj][m][1] * W8_INV); }
                asm volatile("" ::: "memory"); }
        }
    }
};
struct EpiM1 {
    static constexpr bool PERM = true;
    unsigned char* hm;
    DI int nvm(const Unit&, int) const { return 8; }
    DI void operator()(const f32x4 (&acc)[2][2][4][2], const Unit& u, int wr, int wc, int fr, int fq) const {
        asm volatile("" : "+v"(fr), "+v"(fq));
        const int row0 = u.pm * 256 + wr * 64 + fr, col0 = u.pn * 128 + wc * 32 + 8 * fq;
#pragma unroll
        for (int ai = 0; ai < 2; ++ai)
#pragma unroll
            for (int m2 = 0; m2 < 4; m2 += 2) { u32x2 o[2];
#pragma unroll
                for (int mm = 0; mm < 2; ++mm) { const int m = m2 + mm; f32x4 v0, v1;
#pragma unroll
                    for (int j = 0; j < 4; ++j) { const float g0 = acc[ai][0][m][0][j], g1 = acc[ai][0][m][1][j]; v0[j] = g0 * sigmoid64_(g0) * (acc[ai][1][m][0][j] * (W8_INV * W8_INV)); v1[j] = g1 * sigmoid64_(g1) * (acc[ai][1][m][1][j] * (W8_INV * W8_INV)); }
                    o[mm].x = pk4_fp8(v0[0], v0[1], v0[2], v0[3]); o[mm].y = pk4_fp8(v1[0], v1[1], v1[2], v1[3]); }
                st_pair16(hm + (size_t)(row0 + ai * 128 + m2 * 16) * 1024 + col0, 16 * 1024, o[0], o[1], fq); }
    }
};
struct EpiM2 {
    static constexpr bool PERM = true;
    unsigned char* ys; const int* list; const volatile LAS int* pre;
    DI int nvm(const Unit& u, int) const { return u.nv == 256 ? 24 : 8; }
    DI void operator()(const f32x4 (&acc)[2][2][4][2], const Unit& u, int wr, int wc, int fr, int fq) const {
        asm volatile("" : "+v"(fr), "+v"(fq));
        const int lrow0 = wr * 64 + fr, col0 = u.pn * 256 + wc * 32 + 8 * fq; const int lt = u.pm - rfl(pre[u.e]);
        const int* lp = list + (size_t)u.e * T + 256 * lt;
        int slotv[8];
#pragma unroll
        for (int q = 0; q < 8; ++q) { const int r = lrow0 + (q >> 2) * 128 + (q & 3) * 16; slotv[q] = ((const GAS int*)lp)[r < u.nv ? r : 0]; }
#pragma unroll
        for (int ai = 0; ai < 2; ++ai)
#pragma unroll
            for (int m = 0; m < 4; ++m) { const int r = lrow0 + ai * 128 + m * 16;
                if (r < u.nv) { const int slot = slotv[ai * 4 + m]; unsigned char* yp = ys + (size_t)slot * 1024 + col0;
                    u32x2 o[2];
#pragma unroll
                    for (int bj = 0; bj < 2; ++bj) { const f32x4 v0 = acc[ai][bj][m][0] * W8_INV, v1 = acc[ai][bj][m][1] * W8_INV; o[bj].x = pk4_fp8(v0[0], v0[1], v0[2], v0[3]); o[bj].y = pk4_fp8(v1[0], v1[1], v1[2], v1[3]); }
                    st_pair16(yp, 128, o[0], o[1], fq); } }
    }
};

struct WItem { const float* W; unsigned char* WT; int N, K, drow, c0, nv, kb; };
DI WItem w_decode(const Ctx& c, int l, int it) {
    constexpr int I_IN = (NIN / 32) * 16, I_GO = 512, I_AO = 256, I_OUT = 512, I_EXP = 16 * 512;
    WItem w; int r = it;
    if (r < I_IN) {
        const int nbg = r >> 4, kb = r & 15, n0 = 32 * nbg, tile = n0 >> 8, p = n0 & 255; int c0, nv = 32;
        if (tile < 12) c0 = n0;
        else if (tile < 24) { const int base = tile < 18 ? 3088 : 4624, tq = tile < 18 ? tile - 12 : tile - 18; c0 = base + (4 * tq + ((p & 127) >> 5)) * 64 + (p >= 128 ? 32 : 0); }
        else if (tile < 30) c0 = 6160 + (n0 - 24 * 256);
        else if (tile < 38) c0 = 7696 + (n0 - 30 * 256);
        else { c0 = 3072; nv = (p == 0) ? 16 : 0; }
        w.W = c.w_in + (size_t)l * D * DIN; w.N = DIN; w.WT = c.ws + wset(l) + WS_WIN; w.K = D; w.drow = n0; w.c0 = c0; w.nv = nv; w.kb = kb; return w; }
    r -= I_IN;
    if (r < I_GO) { w.W = c.w_gla_o + (size_t)l * D * D; w.N = D; w.WT = c.ws + wset(l) + WS_WGO; w.K = D; w.drow = 32 * (r >> 4); w.c0 = w.drow; w.nv = 32; w.kb = r & 15; return w; }
    r -= I_GO;
    if (r < I_AO) { w.W = c.w_att_o + (size_t)l * 512 * D; w.N = D; w.WT = c.ws + wset(l) + WS_WAO; w.K = 512; w.drow = 32 * (r >> 3); w.c0 = w.drow; w.nv = 32; w.kb = r & 7; return w; }
    r -= I_AO;
    if (r < I_OUT) { w.W = c.w_out + (size_t)l * D * D; w.N = D; w.WT = c.ws + wset(l) + WS_WOUT; w.K = D; w.drow = 32 * (r >> 4); w.c0 = w.drow; w.nv = 32; w.kb = r & 15; return w; }
    r -= I_OUT;
    const int which = r / I_EXP; r -= which * I_EXP; const int e = r >> 9, q = r & 511, nbg = q >> 4; const size_t eoff = (size_t)(l * NEXP + e) * D * DFF;
    w.N = DFF; w.K = D; w.c0 = 32 * nbg; w.nv = 32; w.kb = q & 15;
    if (which == 0) { w.W = c.w_e_gate + eoff; w.WT = c.ws + wset(l) + WS_WGU + (size_t)e * 2048 * 1024; w.drow = 256 * (nbg >> 2) + 32 * (nbg & 3); }
    else if (which == 1) { w.W = c.w_e_up + eoff; w.WT = c.ws + wset(l) + WS_WGU + (size_t)e * 2048 * 1024; w.drow = 256 * (nbg >> 2) + 128 + 32 * (nbg & 3); }
    else { w.W = c.w_e_down + eoff; w.N = D; w.K = DFF; w.WT = c.ws + wset(l) + WS_WD + (size_t)e * 1024 * 1024; w.drow = 32 * nbg; }
    return w;
}
DI void w_load(const WItem& w, int lane, float (&v)[32]) {
    const int cc = lane & 31, ccl = cc < w.nv ? cc : 0; const GAS float* wp = (const GAS float*)w.W + (size_t)(64 * w.kb + (lane >> 5)) * w.N + w.c0 + ccl;
#pragma unroll
    for (int i = 0; i < 32; ++i) v[i] = wp[(size_t)(2 * i) * w.N];
}
DI void w_store(const WItem& w, int lane, const float (&v)[32], LAS float* scr) {
    const int cc = lane & 31, k0 = 64 * w.kb;
#pragma unroll
    for (int i = 0; i < 32; ++i) scr[(2 * i + (lane >> 5)) * 33 + cc] = (cc < w.nv) ? v[i] : 0.f;
    LDS_WAIT(); asm volatile("" ::: "memory");
    const int c = lane & 7;
#pragma unroll
    for (int j = 0; j < 4; ++j) { const int n = (lane >> 3) + 8 * j; const LAS float* s = scr + (8 * c) * 33 + n;
        u32x2 o; o.x = pk4_fp8(s[0 * 33] * W8_SCALE, s[1 * 33] * W8_SCALE, s[2 * 33] * W8_SCALE, s[3 * 33] * W8_SCALE); o.y = pk4_fp8(s[4 * 33] * W8_SCALE, s[5 * 33] * W8_SCALE, s[6 * 33] * W8_SCALE, s[7 * 33] * W8_SCALE);
        *(GAS u32x2*)(w.WT + (size_t)(w.drow + n) * w.K + k0 + 8 * c) = o; }
    LDS_WAIT(); asm volatile("" ::: "memory");
}
constexpr int W_NITEMS = (NIN / 32) * 16 + 512 + 256 + 512 + 3 * 16 * 512, W_NTK = (W_NITEMS + 31) / 32;
DI void w_tickets(LAS unsigned char* lds, const Ctx& c, int l, int budget) {
    const int tid = ltid(), lane = tid & 63, wave = rfl(tid >> 6);
    LAS float* scr = (LAS float*)(lds + wave * 16384);
    volatile LAS int* TK = (volatile LAS int*)(lds + MISC_OFF + 208);
    GAS unsigned* ctr = (GAS unsigned*)((unsigned*)(c.ws + WS_CTL) + CW_WTK + l * 64);
    float va[32], vb[32]; WItem wa, wb;
    for (int k = 0; k < budget; ++k) {
        __syncthreads();
        if (tid == 0) TK[0] = (int)__hip_atomic_fetch_add(ctr, 1u, __ATOMIC_RELAXED, __HIP_MEMORY_SCOPE_AGENT);
        __syncthreads();
        const int t = rfl(TK[0]); if (t >= W_NTK) break;
        const int i0 = 32 * t + wave, i1 = i0 + 8, i2 = i0 + 16, i3 = i0 + 24;
        if (i0 < W_NITEMS) { wa = w_decode(c, l, i0); w_load(wa, lane, va); }
        if (i1 < W_NITEMS) { wb = w_decode(c, l, i1); w_load(wb, lane, vb); }
        if (i0 < W_NITEMS) w_store(wa, lane, va, scr);
        if (i2 < W_NITEMS) { wa = w_decode(c, l, i2); w_load(wa, lane, va); }
        if (i1 < W_NITEMS) w_store(wb, lane, vb, scr);
        if (i3 < W_NITEMS) { wb = w_decode(c, l, i3); w_load(wb, lane, vb); }
        if (i2 < W_NITEMS) w_store(wa, lane, va, scr);
        if (i3 < W_NITEMS) w_store(wb, lane, vb, scr);
    }
}
DI void phase_w(LAS unsigned char* lds, const Ctx& c, int l, int G) {
    const int tid = ltid();
    w_tickets(lds, c, l, 1 << 30);
    if (l == 0) {
        const size_t n8 = (size_t)T * D / 8; unsigned char* xb = c.ws + WS_XB;
        const size_t st = (size_t)G * NTHREADS;
        for (size_t i0 = (size_t)lbid() * NTHREADS + tid; i0 < n8; i0 += 4 * st) {
            f32x4 a[4], b[4];
#pragma unroll
            for (int q = 0; q < 4; ++q) { const size_t i = i0 + q * st < n8 ? i0 + q * st : i0; a[q] = *(const GAS f32x4*)(c.x + i * 8); b[q] = *(const GAS f32x4*)(c.x + i * 8 + 4); }
#pragma unroll
            for (int q = 0; q < 4; ++q) { const size_t i = i0 + q * st; if (i < n8) { u32x2 o; o.x = pk4_fp8(a[q][0], a[q][1], a[q][2], a[q][3]); o.y = pk4_fp8(b[q][0], b[q][1], b[q][2], b[q][3]); *(GAS u32x2*)(xb + i * 8) = o; } }
        }
    }
}

DI s16x4 tr16(const LAS void* p) { return __builtin_bit_cast(s16x4, __builtin_amdgcn_ds_read_tr16_b64_v4i16((LAS s16x4*)p)); }
DI bf16x8 cat8(s16x4 lo, s16x4 hi) { return __builtin_shufflevector(lo, hi, 0, 1, 2, 3, 4, 5, 6, 7); }
#define MFMA16(a, b, c) __builtin_amdgcn_mfma_f32_16x16x32_bf16((a), (b), (c), 0, 0, 0)

constexpr int REC_BYTES = 33792, REC_KS = 16384, REC_DEC = 32768, OI_BYTES = 16384;
constexpr int GP_QT = 0, GP_KT = 17408, GP_VS = 34816, GP_ATT = 68608, GP_WUP = 77824, GP_BAL = 86016;
DI float exp_(float x) { return __builtin_amdgcn_exp2f(x * LOG2E); }
DI void unpack8(const u32x4& q, float (&v)[16], int o) { v[o] = bf_lo(q.x); v[o + 1] = bf_hi(q.x); v[o + 2] = bf_lo(q.y); v[o + 3] = bf_hi(q.y); v[o + 4] = bf_lo(q.z); v[o + 5] = bf_hi(q.z); v[o + 6] = bf_lo(q.w); v[o + 7] = bf_hi(q.w); }
DI u32x4 packf8(const float (&v)[16], int o) { u32x4 p; p.x = cvt_pk_bf16(v[o], v[o + 1]); p.y = cvt_pk_bf16(v[o + 2], v[o + 3]); p.z = cvt_pk_bf16(v[o + 4], v[o + 5]); p.w = cvt_pk_bf16(v[o + 6], v[o + 7]); return p; }
#define DPP0(x, ctrl, row_mask) __builtin_bit_cast(float, __builtin_amdgcn_update_dpp(0, __builtin_bit_cast(int, (x)), (ctrl), (row_mask), 0xf, false))
DI float scan64(float x) {
    x += DPP0(x, 0x111, 0xf); x += DPP0(x, 0x112, 0xf); x += DPP0(x, 0x114, 0xf); x += DPP0(x, 0x118, 0xf);
    x += DPP0(x, 0x142, 0xa); x += DPP0(x, 0x143, 0xc);
    return x;
}
DI void gla_p_unit(LAS unsigned char* lds, const Ctx& c, int l, int bl, int h, int n, int& h_loaded) {
    const int tid = ltid(), lane = tid & 63, w = rfl(tid >> 6), fr = lane & 15, fq = lane >> 4;
    const size_t tok0 = (size_t)bl * SEQ + n * 64;
    const bf16_t* QG = wsb(c, WS_H + H_QG) + tok0 * 512 + h * 128;
    const bf16_t* KG = wsb(c, WS_H + H_KG) + tok0 * 512 + h * 128;
    const bf16_t* VG = wsb(c, WS_H + H_VG) + tok0 * 1024 + h * 256;
    const float* HA = (const float*)(c.ws + WS_HA) + tok0 * 16;
    const int unit = (bl * 4 + h) * 64 + n;
    unsigned char* rec = c.ws + WS_REC + (size_t)unit * REC_BYTES;
    unsigned char* oi = c.ws + WS_MIX + (size_t)unit * OI_BYTES;
    LAS bf16_t* QT = (LAS bf16_t*)(lds + GP_QT); LAS bf16_t* KT = (LAS bf16_t*)(lds + GP_KT); LAS bf16_t* VS = (LAS bf16_t*)(lds + GP_VS); LAS bf16_t* AT = (LAS bf16_t*)(lds + GP_ATT);
    LAS float* WUP = (LAS float*)(lds + GP_WUP); LAS float* BAL = (LAS float*)(lds + GP_BAL);
    __syncthreads();
    if (h_loaded != h) { for (int i = tid; i < 16 * 128; i += NTHREADS) WUP[i] = ((const GAS float*)c.w_alpha_up)[(size_t)l * 16 * 512 + (i >> 7) * 512 + h * 128 + (i & 127)];
        if (tid < 128) BAL[tid] = ((const GAS float*)c.b_alpha)[l * 512 + h * 128 + tid]; h_loaded = h; __syncthreads(); }
    {
        const int row = lane;
        f32x4 a4[4];
#pragma unroll
        for (int j = 0; j < 4; ++j) a4[j] = *(const GAS f32x4*)(HA + (size_t)row * 16 + 4 * j);
        const u32x4 q0 = *(const GAS u32x4*)(QG + (size_t)row * 512 + 16 * w), q1 = *(const GAS u32x4*)(QG + (size_t)row * 512 + 16 * w + 8);
        const u32x4 k0 = *(const GAS u32x4*)(KG + (size_t)row * 512 + 16 * w), k1 = *(const GAS u32x4*)(KG + (size_t)row * 512 + 16 * w + 8);
#pragma unroll
        for (int c2 = 0; c2 < 4; ++c2) { const int idx = tid + NTHREADS * c2, r = idx >> 5, ch = idx & 31; *(LAS u32x4*)(VS + r * 264 + ch * 8) = *(const GAS u32x4*)(VG + (size_t)r * 1024 + ch * 8); }
        float la[16];
        {
            f32x2 la2[8];
#pragma unroll
            for (int c2 = 0; c2 < 8; ++c2) la2[c2] = *(const LAS f32x2*)(BAL + 16 * w + 2 * c2);
#pragma unroll
            for (int j = 0; j < 16; ++j) { const float aj = a4[j >> 2][j & 3]; const f32x2 aj2 = (f32x2){aj, aj};
#pragma unroll
                for (int c4 = 0; c4 < 4; ++c4) { const f32x4 wv = *(const LAS f32x4*)(WUP + j * 128 + 16 * w + 4 * c4); la2[2 * c4] = aj2 * __builtin_shufflevector(wv, wv, 0, 1) + la2[2 * c4]; la2[2 * c4 + 1] = aj2 * __builtin_shufflevector(wv, wv, 2, 3) + la2[2 * c4 + 1]; } }
#pragma unroll
            for (int c2 = 0; c2 < 8; ++c2) { la[2 * c2] = la2[c2][0]; la[2 * c2 + 1] = la2[c2][1]; }
        }
#pragma unroll
        for (int cc = 0; cc < 16; ++cc) { const float z = la[cc]; la[cc] = -(fmaxf(-z, 0.f) + __builtin_amdgcn_logf(1.0f + exp_(-fabsf(z))) * 0.6931471805599453f) * (1.0f / 16.0f); }
#pragma unroll
        for (int cc = 0; cc < 16; ++cc) la[cc] = scan64(la[cc]);
        float qv[16], kv[16];
        unpack8(q0, qv, 0); unpack8(q1, qv, 8); unpack8(k0, kv, 0); unpack8(k1, kv, 8);
        float dc[16];
#pragma unroll
        for (int cc = 0; cc < 16; ++cc) { const float b = la[cc]; const float bend = __shfl(b, 63); const float eb = exp_(b); dc[cc] = eb; qv[cc] *= eb; la[cc] = kv[cc] * exp_(bend - b); kv[cc] *= exp_(-b); }
        if (lane == 63) {
#pragma unroll
            for (int c4 = 0; c4 < 4; ++c4) *(GAS f32x4*)(rec + REC_DEC + (16 * w + 4 * c4) * 4) = (f32x4){dc[4 * c4], dc[4 * c4 + 1], dc[4 * c4 + 2], dc[4 * c4 + 3]}; }
        const u32x4 qa = packf8(qv, 0), qb = packf8(qv, 8), ka = packf8(kv, 0), kb = packf8(kv, 8), sa = packf8(la, 0), sb = packf8(la, 8);
        *(LAS u32x4*)(QT + row * 136 + 16 * w) = qa; *(LAS u32x4*)(QT + row * 136 + 16 * w + 8) = qb;
        *(LAS u32x4*)(KT + row * 136 + 16 * w) = ka; *(LAS u32x4*)(KT + row * 136 + 16 * w + 8) = kb;
        *(GAS u32x4*)(rec + row * 256 + (((2 * w) ^ (row & 15)) << 4)) = qa; *(GAS u32x4*)(rec + row * 256 + (((2 * w + 1) ^ (row & 15)) << 4)) = qb;
        *(GAS u32x4*)(rec + REC_KS + row * 256 + (((2 * w) ^ (2 * (row & 7))) << 4)) = sa; *(GAS u32x4*)(rec + REC_KS + row * 256 + (((2 * w + 1) ^ (2 * (row & 7))) << 4)) = sb;
    }
    __syncthreads();
#pragma unroll
    for (int rep = 0; rep < 2; ++rep) {
        const int tt = w + 8 * rep, jt = tt >> 2, it = tt & 3;
        f32x4 a = (f32x4){0.f, 0.f, 0.f, 0.f};
        if (jt <= it) {
#pragma unroll
            for (int k4 = 0; k4 < 4; ++k4) { const bf16x8 af = *(const LAS bf16x8*)(KT + (16 * jt + fr) * 136 + 32 * k4 + 8 * fq), bfr = *(const LAS bf16x8*)(QT + (16 * it + fr) * 136 + 32 * k4 + 8 * fq); a = MFMA16(af, bfr, a); }
        }
        const int i = 16 * it + fr, j0 = 16 * jt + 4 * fq;
        u32x2 o; o.x = cvt_pk_bf16(j0 <= i ? a[0] : 0.f, j0 + 1 <= i ? a[1] : 0.f); o.y = cvt_pk_bf16(j0 + 2 <= i ? a[2] : 0.f, j0 + 3 <= i ? a[3] : 0.f);
        *(LAS u32x2*)(AT + i * 72 + j0) = o;
    }
    __syncthreads();
    {
        const int dv0 = 32 * w;
        bf16x8 vb[2][2];
#pragma unroll
        for (int k2 = 0; k2 < 2; ++k2)
#pragma unroll
            for (int dt = 0; dt < 2; ++dt) { const LAS bf16_t* p = VS + (32 * k2 + 8 * fq + (fr >> 2)) * 264 + dv0 + 16 * dt + (fr & 3) * 4; vb[k2][dt] = cat8(tr16(p), tr16(p + 4 * 264)); }
#pragma unroll
        for (int tt = 0; tt < 4; ++tt) {
            const bf16x8 a0 = *(const LAS bf16x8*)(AT + (16 * tt + fr) * 72 + 8 * fq), a1 = *(const LAS bf16x8*)(AT + (16 * tt + fr) * 72 + 32 + 8 * fq);
#pragma unroll
            for (int dt = 0; dt < 2; ++dt) { f32x4 z = (f32x4){0.f, 0.f, 0.f, 0.f}; z = MFMA16(vb[0][dt], a0, z); z = MFMA16(vb[1][dt], a1, z);
                *(GAS unsigned*)(oi + ((w * 8 + tt * 2 + dt) * 64 + lane) * 4) = pk4_fp8(z[0], z[1], z[2], z[3]); }
        }
    }
}
constexpr int GSEG = 16, NSEG = 64 / GSEG;
constexpr int GL_STAGE = 50176, GL_DEC = 16384, GL_VS = 17408;
static_assert(3 * GL_STAGE <= MISC_OFF, "light-chain stages");
DI void gla_l_chain(LAS unsigned char* lds, const Ctx& c, int bl, int h, int seg) {
    const int tid = ltid(), lane = tid & 63, w = rfl(tid >> 6), fr = lane & 15, fq = lane >> 4;
    const size_t t0 = (size_t)bl * SEQ + (size_t)seg * (GSEG * 64);
    const bf16_t* VG = wsb(c, WS_H + H_VG) + t0 * 1024 + h * 256;
    const unsigned char* rec0 = c.ws + WS_REC + (size_t)((bl * 4 + h) * 64 + seg * GSEG) * REC_BYTES;
    const int dv0 = 32 * w; const unsigned lds_u = (unsigned)(uintptr_t)lds;
    f32x4 S[8][2], Dc[8];
#pragma unroll
    for (int a = 0; a < 8; ++a) { S[a][0] = (f32x4){0.f, 0.f, 0.f, 0.f}; S[a][1] = (f32x4){0.f, 0.f, 0.f, 0.f}; Dc[a] = (f32x4){1.f, 1.f, 1.f, 1.f}; }
#define GL_DMA(gp, ldsoff) do { unsigned _sv; const unsigned _m = (unsigned)__builtin_amdgcn_readfirstlane((int)(ldsoff)); \
        asm volatile("s_mov_b32 %0, m0\n\ts_mov_b32 m0, %2\n\ts_nop 0\n\tglobal_load_lds_dwordx4 %1, off\n\ts_mov_b32 m0, %0" : "=&s"(_sv) : "v"(gp), "s"(_m) : "memory"); } while (0)
#define GL_PREFETCH(nn, st) do { const unsigned char* _r = rec0 + (size_t)(nn) * REC_BYTES + REC_KS; const unsigned _s = lds_u + (unsigned)(st) * GL_STAGE; \
        _Pragma("unroll") for (int _p = 0; _p < 2; ++_p) GL_DMA((const GAS unsigned char*)(_r + (w * 2 + _p) * 1024 + lane * 16), _s + (w * 2 + _p) * 1024); \
        if (w == 0) GL_DMA((const GAS unsigned char*)(_r + 16384 + lane * 16), _s + GL_DEC); \
        _Pragma("unroll") for (int _p = 0; _p < 4; ++_p) { const int _row = 2 * (w * 4 + _p) + (lane >> 5); \
            GL_DMA((const GAS bf16_t*)(VG + (size_t)((nn) * 64 + _row) * 1024 + (((lane & 31) ^ (2 * (_row & 3))) << 3)), _s + GL_VS + (w * 4 + _p) * 1024); } } while (0)
    __syncthreads();
    GL_PREFETCH(0, 0); GL_PREFETCH(1, 1);
    int st = 0;
    for (int n = 0; n < GSEG; ++n) {
        LAS unsigned char* sb_ = lds + st * GL_STAGE;
        LAS bf16_t* KS = (LAS bf16_t*)sb_; LAS float* DEC = (LAS float*)(sb_ + GL_DEC); LAS bf16_t* VS = (LAS bf16_t*)(sb_ + GL_VS);
        if (n + 1 < GSEG) { if (w == 0) asm volatile("s_waitcnt vmcnt(7)" ::: "memory"); else asm volatile("s_waitcnt vmcnt(6)" ::: "memory"); } else VM_WAIT();
        asm volatile("s_waitcnt lgkmcnt(0)" ::: "memory"); __builtin_amdgcn_s_barrier(); asm volatile("" ::: "memory");
        if (n + 2 < GSEG) GL_PREFETCH(n + 2, st == 0 ? 2 : st - 1);
        bf16x8 vb[2][2];
#pragma unroll
        for (int k2 = 0; k2 < 2; ++k2)
#pragma unroll
            for (int dt = 0; dt < 2; ++dt) { const int r0 = 32 * k2 + 8 * fq + (fr >> 2);
                const LAS bf16_t* p = VS + r0 * 256 + ((((dv0 + 16 * dt) >> 3) ^ (2 * (r0 & 3))) << 3) + (fr & 3) * 4; vb[k2][dt] = cat8(tr16(p), tr16(p + 4 * 256)); }
#pragma unroll
        for (int k8 = 0; k8 < 8; ++k8) {
            const f32x4 dc = *(const LAS f32x4*)(DEC + 16 * k8 + 4 * fq);
            S[k8][0] *= dc; S[k8][1] *= dc; Dc[k8] *= dc;
#pragma unroll
            for (int k2 = 0; k2 < 2; ++k2) { const int r0 = 32 * k2 + 8 * fq + (fr >> 2);
                const LAS bf16_t* p0 = KS + r0 * 128 + (((2 * k8) ^ (2 * (r0 & 7))) << 3) + (fr & 3) * 4; const LAS bf16_t* p1 = KS + (r0 + 4) * 128 + (((2 * k8) ^ (2 * ((r0 + 4) & 7))) << 3) + (fr & 3) * 4;
                const bf16x8 af = cat8(tr16(p0), tr16(p1));
                S[k8][0] = MFMA16(af, vb[k2][0], S[k8][0]); S[k8][1] = MFMA16(af, vb[k2][1], S[k8][1]); }
        }
        st = st == 2 ? 0 : st + 1;
    }
#undef GL_PREFETCH
#undef GL_DMA
    const int cj = (bl * 4 + h) * NSEG + seg;
    GAS f32x4* sl = (GAS f32x4*)(c.ws + WS_SLOC) + ((size_t)(cj * 8 + w) * 16) * 64 + lane;
#pragma unroll
    for (int a = 0; a < 8; ++a) { sl[(a * 2) * 64] = S[a][0]; sl[(a * 2 + 1) * 64] = S[a][1]; }
    if (w == 0) { GAS f32x4* dq = (GAS f32x4*)(c.ws + WS_DCUM) + (size_t)cj * 8 * 64 + lane;
#pragma unroll
        for (int a = 0; a < 8; ++a) dq[a * 64] = Dc[a]; }
    VM_WAIT(); __syncthreads();
}
constexpr int GS_STAGE = 66560, GS_KS = 16384, GS_DEC = 32768, GS_VS = 33792, GS_SS = 2 * GS_STAGE;
DI void gla_s_chain(LAS unsigned char* lds, const Ctx& c, int l, int bl, int h, int seg) {
    const int tid = ltid(), lane = tid & 63, w = rfl(tid >> 6), fr = lane & 15, fq = lane >> 4;
    const size_t t0 = (size_t)bl * SEQ + (size_t)seg * (GSEG * 64);
    const bf16_t* VG = wsb(c, WS_H + H_VG) + t0 * 1024 + h * 256;
    const unsigned char* SR = c.ws + WS_H + H_SR + t0 * 1024 + h * 256;
    unsigned char* OG = c.ws + WS_OG + t0 * 1024 + h * 256;
    const unsigned char* rec0 = c.ws + WS_REC + (size_t)((bl * 4 + h) * 64 + seg * GSEG) * REC_BYTES;
    const unsigned char* oi0 = c.ws + WS_MIX + (size_t)((bl * 4 + h) * 64 + seg * GSEG) * OI_BYTES;
    LAS float* SS = (LAS float*)(lds + GS_SS);
    const int dv0 = 32 * w;
    f32x4 gnv[2]; gnv[0] = *(const GAS f32x4*)(c.gla_norm + l * 1024 + h * 256 + dv0 + 4 * fq); gnv[1] = *(const GAS f32x4*)(c.gla_norm + l * 1024 + h * 256 + dv0 + 16 + 4 * fq);
    f32x4 S[8][2];
#pragma unroll
    for (int a = 0; a < 8; ++a) { S[a][0] = (f32x4){0.f, 0.f, 0.f, 0.f}; S[a][1] = (f32x4){0.f, 0.f, 0.f, 0.f}; }
    for (int j = 0; j < seg; ++j) {
        const int cj = (bl * 4 + h) * NSEG + j;
        const GAS f32x4* sl = (const GAS f32x4*)(c.ws + WS_SLOC) + ((size_t)(cj * 8 + w) * 16) * 64 + lane; const GAS f32x4* dq = (const GAS f32x4*)(c.ws + WS_DCUM) + (size_t)cj * 8 * 64 + lane;
#pragma unroll
        for (int a = 0; a < 8; ++a) { const f32x4 dcv = dq[a * 64]; S[a][0] = S[a][0] * dcv + sl[(a * 2) * 64]; S[a][1] = S[a][1] * dcv + sl[(a * 2 + 1) * 64]; }
    }
#define GS_DMA(gp, ldsoff) do { unsigned _sv; const unsigned _m = (unsigned)__builtin_amdgcn_readfirstlane((int)(ldsoff)); \
        asm volatile("s_mov_b32 %0, m0\n\ts_mov_b32 m0, %2\n\ts_nop 0\n\tglobal_load_lds_dwordx4 %1, off\n\ts_mov_b32 m0, %0" : "=&s"(_sv) : "v"(gp), "s"(_m) : "memory"); } while (0)
#define GS_PREFETCH(nn, st) do { const unsigned char* _r = rec0 + (size_t)(nn) * REC_BYTES; const unsigned _s = lds_u + (unsigned)(st) * GS_STAGE; \
        _Pragma("unroll") for (int _p = 0; _p < 4; ++_p) GS_DMA((const GAS unsigned char*)(_r + (w * 4 + _p) * 1024 + lane * 16), _s + (w * 4 + _p) * 1024); \
        if (w == 0) GS_DMA((const GAS unsigned char*)(_r + 32768 + lane * 16), _s + 32768); \
        _Pragma("unroll") for (int _p = 0; _p < 4; ++_p) { const int _row = 2 * (w * 4 + _p) + (lane >> 5); \
            GS_DMA((const GAS bf16_t*)(VG + (size_t)((nn) * 64 + _row) * 1024 + (((lane & 31) ^ (2 * (_row & 3))) << 3)), _s + GS_VS + (w * 4 + _p) * 1024); } } while (0)
    const unsigned lds_u = (unsigned)(uintptr_t)lds;
#define GS_BAR() do { asm volatile("s_waitcnt lgkmcnt(0)" ::: "memory"); __builtin_amdgcn_s_barrier(); asm volatile("" ::: "memory"); } while (0)
#define GS_HEAD(n_) do { \
        _Pragma("unroll") for (int q = 0; q < 8; ++q) oiv[q] = *(const GAS unsigned*)(oi0 + (size_t)(n_) * OI_BYTES + ((w * 8 + q) * 64 + lane) * 4); \
        if ((n_) > 0) { _Pragma("unroll") for (int q = 0; q < 8; ++q) srv[q] = *(const GAS unsigned*)(SR + (size_t)(((n_) - 1) * 64 + 16 * (q >> 1) + fr) * 1024 + dv0 + 16 * (q & 1) + 4 * fq); }     \
        asm volatile("" ::: "memory"); \
        if ((n_) + 1 < GSEG) GS_PREFETCH((n_) + 1, (((n_) & 1) ^ 1)); } while (0)
#define GS_MAIN(n_) do { \
        LAS unsigned char* sb_ = lds + ((n_) & 1) * GS_STAGE; LAS float* SSn = SS + ((n_) & 1) * 512; \
        LAS bf16_t* QT = (LAS bf16_t*)sb_; LAS bf16_t* KS = (LAS bf16_t*)(sb_ + GS_KS); LAS float* DEC = (LAS float*)(sb_ + GS_DEC); LAS bf16_t* VS = (LAS bf16_t*)(sb_ + GS_VS); \
        bf16x8 vb[2][2]; \
        _Pragma("unroll") for (int k2 = 0; k2 < 2; ++k2) _Pragma("unroll") for (int dt = 0; dt < 2; ++dt) { const int r0 = 32 * k2 + 8 * fq + (fr >> 2); \
            const LAS bf16_t* p = VS + r0 * 256 + ((((dv0 + 16 * dt) >> 3) ^ (2 * (r0 & 3))) << 3) + (fr & 3) * 4; vb[k2][dt] = cat8(tr16(p), tr16(p + 4 * 256)); } \
        _Pragma("unroll") for (int tt = 0; tt < 4; ++tt) { o[tt][0] = (f32x4){0.f, 0.f, 0.f, 0.f}; o[tt][1] = (f32x4){0.f, 0.f, 0.f, 0.f}; } \
        _Pragma("unroll") for (int s = 0; s < 4; ++s) { \
            bf16x8 sb[2]; \
            _Pragma("unroll") for (int dt = 0; dt < 2; ++dt) { u32x4 pk; pk.x = cvt_pk_bf16(S[2 * s][dt][0], S[2 * s][dt][1]); pk.y = cvt_pk_bf16(S[2 * s][dt][2], S[2 * s][dt][3]); pk.z = cvt_pk_bf16(S[2 * s + 1][dt][0], S[2 * s + 1][dt][1]); pk.w = cvt_pk_bf16(S[2 * s + 1][dt][2], S[2 * s + 1][dt][3]); sb[dt] = __builtin_bit_cast(bf16x8, pk); } \
            _Pragma("unroll") for (int tt = 0; tt < 4; ++tt) { const int i = 16 * tt + fr; \
                const LAS bf16_t* qp = QT + i * 128 + (fq & 1) * 4; \
                const bf16x8 af = cat8(*(const LAS s16x4*)(qp + (((4 * s + (fq >> 1)) ^ (i & 15)) << 3)), *(const LAS s16x4*)(qp + (((4 * s + 2 + (fq >> 1)) ^ (i & 15)) << 3))); \
                o[tt][0] = MFMA16(sb[0], af, o[tt][0]); o[tt][1] = MFMA16(sb[1], af, o[tt][1]); } \
        } \
        _Pragma("unroll") for (int k8 = 0; k8 < 8; ++k8) { \
            const f32x4 dc = *(const LAS f32x4*)(DEC + 16 * k8 + 4 * fq); \
            S[k8][0] *= dc; S[k8][1] *= dc; \
            _Pragma("unroll") for (int k2 = 0; k2 < 2; ++k2) { const int r0 = 32 * k2 + 8 * fq + (fr >> 2); \
                const LAS bf16_t* p0 = KS + r0 * 128 + (((2 * k8) ^ (2 * (r0 & 7))) << 3) + (fr & 3) * 4; const LAS bf16_t* p1 = KS + (r0 + 4) * 128 + (((2 * k8) ^ (2 * ((r0 + 4) & 7))) << 3) + (fr & 3) * 4; \
                const bf16x8 af = cat8(tr16(p0), tr16(p1)); \
                S[k8][0] = MFMA16(af, vb[k2][0], S[k8][0]); S[k8][1] = MFMA16(af, vb[k2][1], S[k8][1]); } \
        } \
        _Pragma("unroll") for (int tt = 0; tt < 4; ++tt) _Pragma("unroll") for (int dt = 0; dt < 2; ++dt) { const f32x2 a = __builtin_amdgcn_cvt_pk_f32_fp8((int)oiv[tt * 2 + dt], false), b = __builtin_amdgcn_cvt_pk_f32_fp8((int)oiv[tt * 2 + dt], true); o[tt][dt][0] += a[0]; o[tt][dt][1] += a[1]; o[tt][dt][2] += b[0]; o[tt][dt][3] += b[1]; } \
        {     \
            f32x4 pp; \
            _Pragma("unroll") for (int tt = 0; tt < 4; ++tt) { const f32x4 a = o[tt][0] * o[tt][0] + o[tt][1] * o[tt][1]; float p = (a[0] + a[1]) + (a[2] + a[3]); pp[tt] = xrow_sum(p); } \
            if (fq == 0) { SSn[(0 * 16 + fr) * 8 + w] = pp[0]; SSn[(1 * 16 + fr) * 8 + w] = pp[1]; SSn[(2 * 16 + fr) * 8 + w] = pp[2]; SSn[(3 * 16 + fr) * 8 + w] = pp[3]; }     \
        } } while (0)
#define GS_TAIL(m_) do { const LAS float* SSm = SS + ((m_) & 1) * 512; \
        _Pragma("unroll") for (int tt = 0; tt < 4; ++tt) { const f32x4 s0 = *(const LAS f32x4*)(SSm + (16 * tt + fr) * 8), s1 = *(const LAS f32x4*)(SSm + (16 * tt + fr) * 8 + 4); \
            const float ss = ((s0[0] + s0[1]) + (s0[2] + s0[3])) + ((s1[0] + s1[1]) + (s1[2] + s1[3])); const float rs = __builtin_amdgcn_rsqf(ss * (1.0f / 256.0f) + RMS_EPS); \
            _Pragma("unroll") for (int dt = 0; dt < 2; ++dt) { const f32x2 sa = __builtin_amdgcn_cvt_pk_f32_fp8((int)srv[tt * 2 + dt], false), sb2 = __builtin_amdgcn_cvt_pk_f32_fp8((int)srv[tt * 2 + dt], true); const f32x4 g = gnv[dt]; const u32x2 ok = opk[tt][dt]; const f32x4 v = (f32x4){bf_lo(ok.x), bf_hi(ok.x), bf_lo(ok.y), bf_hi(ok.y)} * rs; \
                *(GAS unsigned*)(OG + (size_t)((m_) * 64 + 16 * tt + fr) * 1024 + dv0 + 16 * dt + 4 * fq) = pk4_fp8(v[0] * g[0] * sa[0], v[1] * g[1] * sa[1], v[2] * g[2] * sb2[0], v[3] * g[3] * sb2[1]); } } } while (0)
#define GS_KEEP() do { _Pragma("unroll") for (int tt = 0; tt < 4; ++tt) _Pragma("unroll") for (int dt = 0; dt < 2; ++dt) { opk[tt][dt].x = cvt_pk_bf16(o[tt][dt][0], o[tt][dt][1]); opk[tt][dt].y = cvt_pk_bf16(o[tt][dt][2], o[tt][dt][3]); } } while (0)
    f32x4 o[4][2]; u32x2 opk[4][2]; unsigned oiv[8], srv[8];
    __syncthreads();
    GS_PREFETCH(0, 0);
    VM_WAIT(); GS_BAR();
    GS_HEAD(0); GS_MAIN(0); GS_KEEP();
    for (int n = 1; n < GSEG; ++n) {
        if (n == 1) VM_WAIT(); else asm volatile("s_waitcnt vmcnt(8)" ::: "memory");
        GS_BAR();
        GS_HEAD(n);
        GS_MAIN(n);
        GS_TAIL(n - 1);
        GS_KEEP();
    }
#pragma unroll
    for (int q = 0; q < 8; ++q) srv[q] = *(const GAS unsigned*)(SR + (size_t)((GSEG - 1) * 64 + 16 * (q >> 1) + fr) * 1024 + dv0 + 16 * (q & 1) + 4 * fq);
    GS_BAR();
    GS_TAIL(GSEG - 1);
#undef GS_HEAD
#undef GS_MAIN
#undef GS_TAIL
#undef GS_KEEP
#undef GS_PREFETCH
#undef GS_DMA
#undef GS_BAR
    VM_WAIT(); __syncthreads();
}

constexpr int AT_K = 0, AT_V = 55296;
struct APre { u32x2 k[6], v[6], q[2][2]; };
DI u32x4 fp8x8_to_bf16(const u32x2 w) { const f32x2 a = __builtin_amdgcn_cvt_pk_f32_fp8((int)w.x, false), b = __builtin_amdgcn_cvt_pk_f32_fp8((int)w.x, true), c_ = __builtin_amdgcn_cvt_pk_f32_fp8((int)w.y, false), d = __builtin_amdgcn_cvt_pk_f32_fp8((int)w.y, true);
    u32x4 o; o.x = cvt_pk_bf16(a[0], a[1]); o.y = cvt_pk_bf16(b[0], b[1]); o.z = cvt_pk_bf16(c_[0], c_[1]); o.w = cvt_pk_bf16(d[0], d[1]); return o; }
struct AUnit { int dl, n, colo; unsigned tb, slab; };
DI AUnit attn_decode(int u) { AUnit a; const int bl = u / 768, g = (u / 256) % 3, h = (u >> 5) & 7, x = u & 31; a.dl = (g == 0) ? 1 : (g == 1 ? 4 : 16); const int nb = 32 / a.dl, r = x / nb; a.n = x - r * nb; a.tb = (unsigned)(bl * SEQ + r); a.colo = g * 512 + h * 64; a.slab = (unsigned)(((g * 8 + h) * 8 + bl) * SEQ + r * (SEQ / a.dl)) * 64u; return a; }
DI void attn_load(const Ctx& c, int u, APre& p) {
    const int tid = ltid(), lane = tid & 63, w = rfl(tid >> 6), fr = lane & 15, fq = lane >> 4; const AUnit a = attn_decode(u);
    const GAS char* Q = (const GAS char*)(c.ws + WS_H + H_QD) + a.slab; const GAS char* K = (const GAS char*)(c.ws + WS_H + H_KD) + a.slab; const GAS char* V = (const GAS char*)(c.ws + WS_H + H_VD) + a.slab;
#pragma unroll
    for (int b = 0; b < 2; ++b) { const unsigned jq = (unsigned)(128 * (a.n + b) + 16 * w + fr);
#pragma unroll
        for (int d0 = 0; d0 < 2; ++d0) p.q[b][d0] = *(const GAS u32x2*)(Q + (jq * 64u + (unsigned)(32 * d0 + 8 * fq))); }
#pragma unroll
    for (int c2 = 0; c2 < 6; ++c2) { const int idx = tid + NTHREADS * c2, row = idx >> 3, ch = idx & 7; const int j = 128 * (a.n - 1) + row;
        p.k[c2] = (u32x2){0u, 0u}; p.v[c2] = (u32x2){0u, 0u};
        if (j >= 0) { const unsigned off = (unsigned)j * 64u + (unsigned)(ch * 8); p.k[c2] = *(const GAS u32x2*)(K + off); p.v[c2] = *(const GAS u32x2*)(V + off); } }
}
DI void attn_stage(LAS unsigned char* lds, const APre& p) {
    const int tid = ltid(); LAS bf16_t* Ks = (LAS bf16_t*)(lds + AT_K); LAS bf16_t* Vs = (LAS bf16_t*)(lds + AT_V);
#pragma unroll
    for (int c2 = 0; c2 < 6; ++c2) { const int o = (tid >> 3) * 72 + (tid & 7) * 8 + c2 * (64 * 72); *(LAS u32x4*)(Ks + o) = fp8x8_to_bf16(p.k[c2]); *(LAS u32x4*)(Vs + o) = fp8x8_to_bf16(p.v[c2]); }
}
DI void attn_compute(LAS unsigned char* lds, const Ctx& c, int u, const bf16x8 (&qf)[2][2]) {
    const int tid = ltid(), lane = tid & 63, w = rfl(tid >> 6), fr = lane & 15, fq = lane >> 4; const AUnit au = attn_decode(u);
    const int dl = au.dl, n = au.n, g = (u / 256) % 3, h = (u >> 5) & 7; const unsigned tb = au.tb;
    LAS bf16_t* Ks = (LAS bf16_t*)(lds + AT_K); LAS bf16_t* Vs = (LAS bf16_t*)(lds + AT_V);
#pragma unroll
    for (int b = 0; b < 2; ++b) {
        const int kt0 = 8 * b + w;
        const LAS bf16_t* kbase = Ks + (16 * w + fr) * 72 + 8 * fq + b * (128 * 72);
        const LAS bf16_t* vbase = Vs + (16 * w + 4 * fq + (fr >> 2)) * 72 + (fr & 3) * 4 + b * (128 * 72);
        f32x4 s[9]; float m = -1e30f;
#pragma unroll
        for (int kr = 0; kr < 9; ++kr) { const int kt = kt0 + kr; f32x4 a = (f32x4){0.f, 0.f, 0.f, 0.f};
#pragma unroll
            for (int d0 = 0; d0 < 2; ++d0) { const bf16x8 af = *(const LAS bf16x8*)(kbase + kr * (16 * 72) + 32 * d0); a = MFMA16(af, qf[b][d0], a); }
#pragma unroll
            for (int rg = 0; rg < 4; ++rg) { const bool tile_ok = (b > 0) || (n > 0) || (kt >= 8);
                bool ok = tile_ok; if (kr == 0) ok = ok && (4 * fq + rg >= fr); if (kr == 8) ok = ok && (4 * fq + rg <= fr);
                a[rg] = ok ? a[rg] : -1e30f; m = fmaxf(m, a[rg]); }
            s[kr] = a; }
        m = xrow_max(m);
        f32x4 ls4 = (f32x4){0.f, 0.f, 0.f, 0.f}; const f32x4 m4 = (f32x4){m, m, m, m};
#pragma unroll
        for (int kr = 0; kr < 9; ++kr) { const f32x4 d = s[kr] - m4;
            s[kr] = (f32x4){__builtin_amdgcn_exp2f(d[0]), __builtin_amdgcn_exp2f(d[1]), __builtin_amdgcn_exp2f(d[2]), __builtin_amdgcn_exp2f(d[3])}; ls4 += s[kr]; }
        float lsum = (ls4[0] + ls4[1]) + (ls4[2] + ls4[3]);
        lsum = xrow_sum(lsum);
        f32x4 oT[4];
#pragma unroll
        for (int dt = 0; dt < 4; ++dt) oT[dt] = (f32x4){0.f, 0.f, 0.f, 0.f};
#pragma unroll
        for (int pp = 0; pp < 5; ++pp) { const int ka = 2 * pp, kb = (2 * pp + 1 < 9) ? 2 * pp + 1 : 8;
            u32x4 pk; pk.x = cvt_pk_bf16(s[ka][0], s[ka][1]); pk.y = cvt_pk_bf16(s[ka][2], s[ka][3]);
            if (2 * pp + 1 < 9) { pk.z = cvt_pk_bf16(s[kb][0], s[kb][1]); pk.w = cvt_pk_bf16(s[kb][2], s[kb][3]); } else { pk.z = 0u; pk.w = 0u; }
            const bf16x8 pf = __builtin_bit_cast(bf16x8, pk);
#pragma unroll
            for (int dt = 0; dt < 4; ++dt) { const LAS bf16_t* pa = vbase + ka * (16 * 72) + 16 * dt; const LAS bf16_t* pb = vbase + kb * (16 * 72) + 16 * dt;
                oT[dt] = MFMA16(cat8(tr16(pa), tr16(pb)), pf, oT[dt]); } }
        const float inv = 1.0f / lsum; const unsigned tq = tb + (unsigned)dl * (unsigned)(128 * (n + b) + 16 * w + fr), gt = (unsigned)(g * TH) + tq;
        GAS char* op = (GAS char*)(c.ws + WS_ATTG) + (gt * 512u + (unsigned)(h * 64 + 4 * fq));
#pragma unroll
        for (int dt = 0; dt < 4; ++dt) *(GAS unsigned*)(op + 16 * dt) = pk4_fp8(oT[dt][0] * inv, oT[dt][1] * inv, oT[dt][2] * inv, oT[dt][3] * inv);
        if (fq == 0) *(GAS float*)((GAS char*)(c.ws + WS_LSE) + (gt * 32u + (unsigned)(h * 4))) = m + __builtin_amdgcn_logf(lsum);
    }
}
DI void phase_p(LAS unsigned char* lds, const Ctx& c, int l, int G) {
    int h_loaded = -1;
    for (int u = lbid(); u < 8 * 4 * 64; u += G) gla_p_unit(lds, c, l, u >> 8, (u >> 6) & 3, u & 63, h_loaded);
}
constexpr int NATT = 8 * 3 * 8 * 32, NATT1 = 1536, NCHAIN = 8 * 4 * NSEG;
#define AT_BAR() do { asm volatile("s_waitcnt lgkmcnt(0)" ::: "memory"); __builtin_amdgcn_s_barrier(); asm volatile("" ::: "memory"); } while (0)
DI void attn_pull(LAS unsigned char* lds, const Ctx& c, unsigned* ctr, int base, int limit) {
    volatile LAS int* TK = (volatile LAS int*)(lds + MISC_OFF + 192);
    const int tid = ltid();
    __syncthreads();
    if (tid == 0) { TK[0] = base + 2 * (int)__hip_atomic_fetch_add((GAS unsigned*)ctr, 1u, __ATOMIC_RELAXED, __HIP_MEMORY_SCOPE_AGENT); TK[1] = base + 2 * (int)__hip_atomic_fetch_add((GAS unsigned*)ctr, 1u, __ATOMIC_RELAXED, __HIP_MEMORY_SCOPE_AGENT);
        TK[2] = base + 2 * (int)__hip_atomic_fetch_add((GAS unsigned*)ctr, 1u, __ATOMIC_RELAXED, __HIP_MEMORY_SCOPE_AGENT); }
    __syncthreads();
    int cur = rfl(TK[0]), nxt = rfl(TK[1]);
    APre pre;
    if (cur < limit) attn_load(c, cur, pre);
    while (cur < limit) {
        AT_BAR();
        const int nxt2 = rfl(TK[2]);
        attn_stage(lds, pre);
        bf16x8 qf[2][2];
#pragma unroll
        for (int b = 0; b < 2; ++b)
#pragma unroll
            for (int d0 = 0; d0 < 2; ++d0) qf[b][d0] = __builtin_bit_cast(bf16x8, fp8x8_to_bf16(pre.q[b][d0]));
        AT_BAR();
        if (nxt < limit) attn_load(c, nxt, pre);
        int req = 0; if (tid == 0) req = base + 2 * (int)__hip_atomic_fetch_add((GAS unsigned*)ctr, 1u, __ATOMIC_RELAXED, __HIP_MEMORY_SCOPE_AGENT);
        attn_compute(lds, c, cur, qf);
        if (tid == 0) TK[2] = req;
        cur = nxt; nxt = nxt2;
    }
}
DI void phase_b1(LAS unsigned char* lds, const Ctx& c, int l, int hf, int G) {
    const int bid = lbid(); unsigned* ctr = (unsigned*)(c.ws + WS_CTL) + CW_TKT + ((l * 2 + hf) * 2) * 64;
    for (int id = bid; id < NCHAIN; id += G) if ((id & 3) != NSEG - 1) gla_l_chain(lds, c, id >> 4, (id >> 2) & 3, id & 3);
    attn_pull(lds, c, ctr, 0, NATT1);
}
DI void phase_b(LAS unsigned char* lds, const Ctx& c, int l, int hf, int G) {
    const int bid = lbid(); unsigned* ctr = (unsigned*)(c.ws + WS_CTL) + CW_TKT + ((l * 2 + hf) * 2 + 1) * 64;
    for (int id = bid; id < NCHAIN; id += G) gla_s_chain(lds, c, l, id >> 4, (id >> 2) & 3, id & 3);
    attn_pull(lds, c, ctr, NATT1, NATT);
}
DI void phase_f(const Ctx& c, int G) {
    const GAS unsigned char* ag = (const GAS unsigned char*)(c.ws + WS_ATTG); const GAS float* lse = (const GAS float*)(c.ws + WS_LSE); unsigned char* att = c.ws + WS_ATT;
    const size_t stride = (size_t)G * NTHREADS, N = (size_t)TH * 64;
    for (size_t i0 = (size_t)lbid() * NTHREADS + ltid(); i0 < N; i0 += 8 * stride) {
        float l0[8], l1[8], l2[8]; u32x2 a[8], b[8], d[8];
#pragma unroll
        for (int q = 0; q < 8; ++q) { const size_t i = i0 + q * stride; const bool ok = i < N; const size_t tok = ok ? (i >> 6) : 0; const int ch = (int)(i & 63), h = ch >> 3;
            l0[q] = lse[tok * 8 + h]; l1[q] = lse[((size_t)TH + tok) * 8 + h]; l2[q] = lse[((size_t)2 * TH + tok) * 8 + h];
            a[q] = *(const GAS u32x2*)(ag + tok * 512 + ch * 8); b[q] = *(const GAS u32x2*)(ag + ((size_t)TH + tok) * 512 + ch * 8); d[q] = *(const GAS u32x2*)(ag + ((size_t)2 * TH + tok) * 512 + ch * 8); }
#pragma unroll
        for (int q = 0; q < 8; ++q) { const size_t i = i0 + q * stride; if (i >= N) continue; const size_t tok = i >> 6; const int ch = (int)(i & 63);
            const float mx = fmaxf(l0[q], fmaxf(l1[q], l2[q])); float w0 = __builtin_amdgcn_exp2f(l0[q] - mx), w1 = __builtin_amdgcn_exp2f(l1[q] - mx), w2 = __builtin_amdgcn_exp2f(l2[q] - mx);
            const float inv = 1.0f / (w0 + w1 + w2); w0 *= inv; w1 *= inv; w2 *= inv;
            u32x2 o;
#pragma unroll
            for (int hw = 0; hw < 2; ++hw) { const int aw = (int)a[q][hw], bw = (int)b[q][hw], dw = (int)d[q][hw];
                const f32x2 a0 = __builtin_amdgcn_cvt_pk_f32_fp8(aw, false), a1 = __builtin_amdgcn_cvt_pk_f32_fp8(aw, true), b0 = __builtin_amdgcn_cvt_pk_f32_fp8(bw, false), b1 = __builtin_amdgcn_cvt_pk_f32_fp8(bw, true),
                            d0 = __builtin_amdgcn_cvt_pk_f32_fp8(dw, false), d1 = __builtin_amdgcn_cvt_pk_f32_fp8(dw, true);
                o[hw] = pk4_fp8(w0 * a0[0] + w1 * b0[0] + w2 * d0[0], w0 * a0[1] + w1 * b0[1] + w2 * d0[1], w0 * a1[0] + w1 * b1[0] + w2 * d1[0], w0 * a1[1] + w1 * b1[1] + w2 * d1[1]); }
            *(GAS u32x2*)(att + tok * 512 + ch * 8) = o; }
    }
}

DI float wave_sum(float v) {
    return __builtin_bit_cast(float, __builtin_amdgcn_readlane(__builtin_bit_cast(int, scan64(v)), 63));
}
constexpr int R_WR = 0, R_HIST = 65536, R_BASE = 65536 + 64, R_INFO = 65536 + 128, R_LG = 70144;
DI void phase_r(LAS unsigned char* lds, const Ctx& c, int l, int G) {
    const int tid = ltid(), lane = tid & 63, wave = rfl(tid >> 6);
    LAS float* WR = (LAS float*)(lds + R_WR); volatile LAS int* HIST = (volatile LAS int*)(lds + R_HIST); volatile LAS int* BASE = (volatile LAS int*)(lds + R_BASE); volatile LAS int* INFO = (volatile LAS int*)(lds + R_INFO); LAS float* LG = (LAS float*)(lds + R_LG);
    __syncthreads();
#pragma unroll
    for (int i0 = 0; i0 < 16 * 1024; i0 += 8 * NTHREADS) {
        float wv8[8];
#pragma unroll
        for (int q = 0; q < 8; ++q) wv8[q] = ((const GAS float*)c.w_router)[i0 + q * NTHREADS + tid];
#pragma unroll
        for (int q = 0; q < 8; ++q) { const int i = i0 + q * NTHREADS + tid; WR[(i & 15) * 1024 + (i >> 4)] = wv8[q]; }
    }
    f32x4 g4[4], b4[4];
#pragma unroll
    for (int j = 0; j < 4; ++j) { g4[j] = *(const GAS f32x4*)(c.ln1_g + l * D + 4 * lane + 256 * j); b4[j] = *(const GAS f32x4*)(c.ln1_b + l * D + 4 * lane + 256 * j); }
    bf16_t* xr = wsb(c, WS_XR); unsigned char* xb = c.ws + WS_XB; GAS int* histg = (GAS int*)(c.ws + WS_HISTG); GAS float* gate = (GAS float*)(c.ws + WS_GATE); GAS float* stat = (GAS float*)(c.ws + WS_STAT);
    const int elane = ((lane >> 5) & 1) * 8 + ((lane >> 4) & 1) * 4 + ((lane >> 3) & 1) * 2 + ((lane >> 2) & 1);
    const float brt = ((const GAS float*)c.b_router)[((lane >> 5) & 1) * 8 + ((lane >> 4) & 1) * 4 + ((lane >> 3) & 1) * 2 + ((lane >> 2) & 1)];
    for (int chunk = lbid(); chunk < T / 256; chunk += G) {
        __syncthreads();
        u32x2 zn[2][4];
#pragma unroll
        for (int q = 0; q < 2; ++q)
#pragma unroll
            for (int j = 0; j < 4; ++j) zn[q][j] = *(const GAS u32x2*)(xr + ((size_t)chunk * 256 + wave * 32 + q) * D + 4 * lane + 256 * j);
        for (int rr = 0; rr < 32; rr += 2) {
            const int rl = wave * 32 + rr; const size_t row = (size_t)chunk * 256 + rl;
            f32x4 v[2][4];
#pragma unroll
            for (int q = 0; q < 2; ++q) {
                float s = 0.f;
#pragma unroll
                for (int j = 0; j < 4; ++j) { const u32x2 zq = zn[q][j]; v[q][j] = (f32x4){bf_lo(zq.x), bf_hi(zq.x), bf_lo(zq.y), bf_hi(zq.y)}; s += (v[q][j][0] + v[q][j][1]) + (v[q][j][2] + v[q][j][3]); }
                { const size_t rn = row + q + (rr + 2 < 32 ? 2 : 0);
#pragma unroll
                  for (int j = 0; j < 4; ++j) zn[q][j] = *(const GAS u32x2*)(xr + rn * D + 4 * lane + 256 * j); }
                const float mean = wave_sum(s) * (1.0f / D); float s2 = 0.f;
#pragma unroll
                for (int j = 0; j < 4; ++j) { v[q][j] = v[q][j] - mean; s2 += (v[q][j][0] * v[q][j][0] + v[q][j][1] * v[q][j][1]) + (v[q][j][2] * v[q][j][2] + v[q][j][3] * v[q][j][3]); }
                const float rstd = __builtin_amdgcn_rsqf(wave_sum(s2) * (1.0f / D) + LN_EPS);
#pragma unroll
                for (int j = 0; j < 4; ++j) { v[q][j] = v[q][j] * rstd * g4[j] + b4[j];
                    *(GAS unsigned*)(xb + (row + q) * D + 4 * lane + 256 * j) = pk4_fp8(v[q][j][0], v[q][j][1], v[q][j][2], v[q][j][3]); }
                if (lane == 0) *(GAS f32x2*)(stat + (row + q) * 2) = (f32x2){mean, rstd};
                asm volatile("" ::: "memory");
            }
            const bool h5 = lane & 32, h4 = lane & 16, h3 = lane & 8, h2 = lane & 4;
            float b8[2][8];
#pragma unroll
            for (int i = 0; i < 8; ++i) {
                f32x2 a2[2][2];
#pragma unroll
                for (int q = 0; q < 2; ++q) { a2[q][0] = (f32x2){0.f, 0.f}; a2[q][1] = (f32x2){0.f, 0.f}; }
#pragma unroll
                for (int hh = 0; hh < 2; ++hh)
#pragma unroll
                    for (int j = 0; j < 4; ++j) { const f32x4 wv = *(const LAS f32x4*)(WR + (i + 8 * hh) * 1024 + 4 * lane + 256 * j); const f32x2 w01 = __builtin_shufflevector(wv, wv, 0, 1), w23 = __builtin_shufflevector(wv, wv, 2, 3);
#pragma unroll
                        for (int q = 0; q < 2; ++q) { a2[q][hh] = __builtin_shufflevector(v[q][j], v[q][j], 0, 1) * w01 + a2[q][hh]; a2[q][hh] = __builtin_shufflevector(v[q][j], v[q][j], 2, 3) * w23 + a2[q][hh]; } }
#pragma unroll
                for (int q = 0; q < 2; ++q) { const float lo = a2[q][0][0] + a2[q][0][1], hi = a2[q][1][0] + a2[q][1][1]; b8[q][i] = rs_swap32(lo, hi); }
                asm volatile("" ::: "memory");
            }
#pragma unroll
            for (int q = 0; q < 2; ++q) {
                float b4_[4], b2[2];
#pragma unroll
                for (int i = 0; i < 4; ++i) b4_[i] = rs_swap16(b8[q][i], b8[q][4 + i]);
#pragma unroll
                for (int i = 0; i < 2; ++i) { const float mine = h3 ? b4_[2 + i] : b4_[i], send = h3 ? b4_[i] : b4_[2 + i]; b2[i] = mine + __shfl_xor(send, 8); }
                float b1 = (h2 ? b2[1] : b2[0]) + __shfl_xor(h2 ? b2[0] : b2[1], 4);
                b1 += __shfl_xor(b1, 2); b1 += __shfl_xor(b1, 1);
                b1 += brt;
                if ((lane & 3) == 0) LG[(rl + q) * 16 + elane] = b1;
            }
        }
        {
            const int rl = wave * 32 + (lane & 31); const size_t row = (size_t)chunk * 256 + rl;
            float lg[16];
#pragma unroll
            for (int q = 0; q < 4; ++q) { const f32x4 t4 = *(const LAS f32x4*)(LG + rl * 16 + 4 * q); lg[4 * q] = t4[0]; lg[4 * q + 1] = t4[1]; lg[4 * q + 2] = t4[2]; lg[4 * q + 3] = t4[3]; }
            float mx = lg[0];
#pragma unroll
            for (int e = 1; e < 16; ++e) mx = fmaxf(mx, lg[e]);
            float se = 0.f;
#pragma unroll
            for (int e = 0; e < 16; ++e) { lg[e] = __expf(lg[e] - mx); se += lg[e]; }
            const float ise = 1.0f / se;
#pragma unroll
            for (int e = 0; e < 16; ++e) lg[e] *= ise;
            int gsel = 0; float gbest = -1.f;
#pragma unroll
            for (int gi = 0; gi < 4; ++gi) { const float a = lg[4 * gi], b = lg[4 * gi + 1], cc = lg[4 * gi + 2], d = lg[4 * gi + 3];
                const float sc = (a + b + cc + d) - fminf(fminf(a, b), fminf(cc, d)) - fminf(fmaxf(fminf(a, b), fminf(cc, d)), fminf(fmaxf(a, b), fmaxf(cc, d)));
                if (sc > gbest) { gbest = sc; gsel = gi; } }
            float p[4];
#pragma unroll
            for (int k = 0; k < 4; ++k) p[k] = gsel == 0 ? lg[k] : gsel == 1 ? lg[4 + k] : gsel == 2 ? lg[8 + k] : lg[12 + k];
            int i0 = 0; float v0 = p[0];
#pragma unroll
            for (int k = 1; k < 4; ++k) if (p[k] > v0) { v0 = p[k]; i0 = k; }
            int i1 = -1; float v1 = -1.f;
#pragma unroll
            for (int k = 0; k < 4; ++k) if (k != i0 && p[k] > v1) { v1 = p[k]; i1 = k; }
            if (lane < 32) { const int e0 = 4 * gsel + i0, e1 = 4 * gsel + i1; INFO[rl * 4 + 0] = e0; INFO[rl * 4 + 1] = e1;
                const float gs = 1.0f / (v0 + v1); *(GAS f32x2*)(gate + row * 2) = (f32x2){v0 * gs, v1 * gs}; }
        }
        __syncthreads();
        {
            int cnt0 = 0, cnt1 = 0; const unsigned long long lt = (1ull << lane) - 1ull;
#pragma unroll
            for (int b = 0; b < 4; ++b) { const int r = 64 * b + lane; const int e0 = INFO[r * 4], e1 = INFO[r * 4 + 1];
                const bool a0 = (e0 == 2 * wave) || (e1 == 2 * wave), a1 = (e0 == 2 * wave + 1) || (e1 == 2 * wave + 1);
                const unsigned long long m0 = __ballot(a0), m1 = __ballot(a1);
                if (a0) INFO[r * 4 + (e0 == 2 * wave ? 2 : 3)] = cnt0 + __popcll(m0 & lt);
                if (a1) INFO[r * 4 + (e0 == 2 * wave + 1 ? 2 : 3)] = cnt1 + __popcll(m1 & lt);
                cnt0 += __popcll(m0); cnt1 += __popcll(m1); }
            if (lane == 0) { histg[chunk * 16 + 2 * wave] = cnt0; histg[chunk * 16 + 2 * wave + 1] = cnt1; }
        }
        __syncthreads();
        if (tid < 256) { i32x4 v; v.x = INFO[tid * 4]; v.y = INFO[tid * 4 + 1]; v.z = INFO[tid * 4 + 2]; v.w = INFO[tid * 4 + 3]; ((GAS i32x4*)(c.ws + WS_INFO))[(size_t)chunk * 256 + tid] = v; }
        __syncthreads();
    }
}
DI void phase_r2(LAS unsigned char* lds, const Ctx& c, int l, int G) {
    const int tid = ltid(); volatile LAS int* BASE = (volatile LAS int*)(lds + R_BASE);
    const GAS int* histg = (const GAS int*)(c.ws + WS_HISTG); GAS int* list = (GAS int*)(c.ws + WS_LIST);
    unsigned* cur = (unsigned*)(c.ws + WS_CTL) + CW_CUR + l * 16 * 64;
    for (int chunk = lbid(); chunk < T / 256; chunk += G) {
        __syncthreads();
        if (tid < 16) BASE[tid] = 0;
        __syncthreads();
        { const int e = tid & 15; int s = 0;
#pragma unroll
          for (int k = 0; k < T / 256 / 32; ++k) { const int cc = (tid >> 4) + 32 * k; s += cc < chunk ? histg[cc * 16 + e] : 0; }
          if (s) atomicAdd((int*)&BASE[e], s); }
        __syncthreads();
        if (tid < 256) { const i32x4 v = ((const GAS i32x4*)(c.ws + WS_INFO))[(size_t)chunk * 256 + tid]; const int row = chunk * 256 + tid;
            list[(size_t)v.x * T + BASE[v.x] + v.z] = row * 2; list[(size_t)v.y * T + BASE[v.y] + v.w] = row * 2 + 1; }
        if (chunk == T / 256 - 1 && tid < 16) __hip_atomic_store(cur + tid * 64, (unsigned)(BASE[tid] + histg[chunk * 16 + tid]), __ATOMIC_RELAXED, __HIP_MEMORY_SCOPE_AGENT);
    }
}
DI int moe_setup(LAS unsigned char* lds, const Ctx& c, int l) {
    volatile LAS int* PRE = (volatile LAS int*)(lds + MISC_OFF); volatile LAS int* CNT = PRE + 17;
    unsigned* cur = (unsigned*)(c.ws + WS_CTL) + CW_CUR + l * 16 * 64;
    __syncthreads();
    if (threadIdx.x < 16) CNT[threadIdx.x] = (int)__hip_atomic_load((GAS unsigned*)(cur + threadIdx.x * 64), __ATOMIC_RELAXED, __HIP_MEMORY_SCOPE_AGENT);
    __syncthreads();
    if (threadIdx.x == 0) { int acc = 0; for (int e = 0; e < 16; ++e) { PRE[e] = acc; acc += (CNT[e] + 255) >> 8; } PRE[16] = acc; }
    __syncthreads();
    return rfl(PRE[16]);
}
template <bool LAST> DI void phase_c(const Ctx& c, int l, int G) {
    const int tid = ltid(), lane = tid & 63, wave = rfl(tid >> 6);
    f32x4 g4[4], b4[4];
#pragma unroll
    for (int j = 0; j < 4; ++j) { g4[j] = *(const GAS f32x4*)(c.ln2_g + l * D + 4 * lane + 256 * j); b4[j] = *(const GAS f32x4*)(c.ln2_b + l * D + 4 * lane + 256 * j); }
    f32x4 h4[4], c4[4];
#pragma unroll
    for (int j = 0; j < 4; ++j) { h4[j] = *(const GAS f32x4*)(c.ln1_g + l * D + 4 * lane + 256 * j) * DN_ALPHA; c4[j] = *(const GAS f32x4*)(c.ln1_b + l * D + 4 * lane + 256 * j) * DN_ALPHA; }
    const GAS float* stat = (const GAS float*)(c.ws + WS_STAT);
    float* xo = c.out; bf16_t* xr = wsb(c, WS_XR); unsigned char* xb = c.ws + WS_XB; const unsigned char* ys = c.ws + WS_YS; const GAS float* gate = (const GAS float*)(c.ws + WS_GATE);
    const size_t rstep = (size_t)G * NWAVES; size_t row = (size_t)lbid() * NWAVES + wave;
    u32x2 xn[2][4]; unsigned y0n[2][4], y1n[2][4]; float g0n[2], g1n[2], mun[2], rsn[2];
#define C_LOAD(sl, r_) do { const size_t rq_ = (r_); g0n[sl] = gate[rq_ * 2]; g1n[sl] = gate[rq_ * 2 + 1]; mun[sl] = stat[rq_ * 2]; rsn[sl] = stat[rq_ * 2 + 1]; \
        _Pragma("unroll") for (int j = 0; j < 4; ++j) { xn[sl][j] = *(const GAS u32x2*)(xr + rq_ * D + 4 * lane + 256 * j); y0n[sl][j] = *(const GAS unsigned*)(ys + (rq_ * 2) * D + 4 * lane + 256 * j); y1n[sl][j] = *(const GAS unsigned*)(ys + (rq_ * 2 + 1) * D + 4 * lane + 256 * j); } } while (0)
    if (row < (size_t)T) { C_LOAD(0, row); C_LOAD(1, row + rstep < (size_t)T ? row + rstep : row); }
    for (; row < (size_t)T; row += 2 * rstep) {
#pragma unroll
        for (int sl = 0; sl < 2; ++sl) {
            const size_t rw = row + sl * rstep; if (rw >= (size_t)T) break;
            const float g0 = g0n[sl], g1 = g1n[sl], mu = mun[sl], rs = rsn[sl];
            f32x4 v[4]; float s = 0.f;
#pragma unroll
            for (int j = 0; j < 4; ++j) { const u32x2 xq = xn[sl][j]; const unsigned y0 = y0n[sl][j], y1 = y1n[sl][j];
                const f32x2 y0a = __builtin_amdgcn_cvt_pk_f32_fp8((int)y0, false), y0b = __builtin_amdgcn_cvt_pk_f32_fp8((int)y0, true), y1a = __builtin_amdgcn_cvt_pk_f32_fp8((int)y1, false), y1b = __builtin_amdgcn_cvt_pk_f32_fp8((int)y1, true);
                const f32x4 zc = ((f32x4){bf_lo(xq.x), bf_hi(xq.x), bf_lo(xq.y), bf_hi(xq.y)} - mu) * rs;
                const f32x4 ax = zc * h4[j] + c4[j];
                v[j][0] = ax[0] + g0 * y0a[0] + g1 * y1a[0]; v[j][1] = ax[1] + g0 * y0a[1] + g1 * y1a[1];
                v[j][2] = ax[2] + g0 * y0b[0] + g1 * y1b[0]; v[j][3] = ax[3] + g0 * y0b[1] + g1 * y1b[1];
                s += (v[j][0] + v[j][1]) + (v[j][2] + v[j][3]); }
            C_LOAD(sl, rw + 2 * rstep < (size_t)T ? rw + 2 * rstep : rw);
            const float mean = wave_sum(s) * (1.0f / D); float s2 = 0.f;
#pragma unroll
            for (int j = 0; j < 4; ++j) { v[j] = v[j] - mean; s2 += (v[j][0] * v[j][0] + v[j][1] * v[j][1]) + (v[j][2] * v[j][2] + v[j][3] * v[j][3]); }
            const float rstd = __builtin_amdgcn_rsqf(wave_sum(s2) * (1.0f / D) + LN_EPS);
#pragma unroll
            for (int j = 0; j < 4; ++j) { v[j] = v[j] * rstd * g4[j] + b4[j];
                if constexpr (LAST) *(GAS f32x4*)(xo + rw * D + 4 * lane + 256 * j) = v[j];
                else { u32x2 xq; xq.x = cvt_pk_bf16(v[j][0], v[j][1]); xq.y = cvt_pk_bf16(v[j][2], v[j][3]); *(GAS u32x2*)(xr + rw * D + 4 * lane + 256 * j) = xq;
                    *(GAS unsigned*)(xb + rw * D + 4 * lane + 256 * j) = pk4_fp8(v[j][0], v[j][1], v[j][2], v[j][3]); } }
        }
    }
#undef C_LOAD
}

DI Ctx load_ctx() {
    union { Ctx c; unsigned long long q[sizeof(Ctx) / 8]; } u;
#if defined(__HIP_DEVICE_COMPILE__)
    const __attribute__((address_space(4))) unsigned long long* p = (const __attribute__((address_space(4))) unsigned long long*)__builtin_amdgcn_kernarg_segment_ptr();
    asm volatile("" : "+s"(p));
#pragma unroll
    for (int i = 0; i < (int)(sizeof(Ctx) / 8); ++i) u.q[i] = p[i];
#endif
    return u.c;
}
#define CTX const Ctx c = load_ctx(); const int G = lgrid(); LAS unsigned char* lds = LDSBASE
__global__ void __launch_bounds__(NTHREADS, 2) mk_fwd(Ctx c_arg) {
    extern __shared__ __attribute__((aligned(16))) unsigned char lds_raw[];
#define LDSBASE ({ unsigned _b = (unsigned)(uintptr_t)(LAS unsigned char*)lds_raw; asm volatile("" : "+s"(_b)); (LAS unsigned char*)(uintptr_t)_b; })
    LAS unsigned char* lds0 = LDSBASE;
    const int tid = threadIdx.x; const Ctx c = load_ctx();
    volatile LAS unsigned* MISC = (volatile LAS unsigned*)(lds0 + MISC_OFF);
    if (tid < 64) MISC[tid] = 0u;
    __syncthreads();
    XcdBarrier bar; bar.bar = (unsigned*)(c.ws + WS_CTL) + CW_BAR; bar.x = 0; bar.st = MISC + 40;
    if (!MK_MULTI) bar = xcd_barrier_post((unsigned*)(c.ws + WS_CTL) + CW_BAR, MISC + 40);
    const int lo = c.lo, hi = c.hi; int step = 0;
#define RUN (lo <= step && step < hi)
#define END_STEP do { if (RUN && step + 1 < hi) { if (!MK_MULTI) xcd_barrier(bar); } ++step; } while (0)
#define END_STEP_NB do { ++step; } while (0)
    for (int l = 0; l < DEPTH; ++l) {
        if (RUN) { CTX; phase_w(lds, c, l, G); }
        END_STEP;
        for (int hf = 0; hf < 2; ++hf) {
            const size_t r0 = (size_t)hf * TH;
            if (RUN) {
                CTX;
                pg8::StaticOrder S; S.init(c.ws + WS_XB + r0 * D, c.ws + wset(l) + WS_WIN, TH, NIN, D / 2, G, lbid());
                EpiIn E{wsb(c, WS_H + H_QG), wsb(c, WS_H + H_KG), wsb(c, WS_H + H_VG), wsb(c, WS_H + H_SR), wsb(c, WS_H + H_QD), wsb(c, WS_H + H_KD), wsb(c, WS_H + H_VD), wsb(c, WS_H + H_GT), (float*)(c.ws + WS_HA), c.pos + r0};
                pg8::gemm_phase<EpiIn, pg8::StaticOrder, true>(lds, D / 2, S, E);
                if (l + 1 < DEPTH && lbid() >= (TH / 256) * (NIN / 256) % G && (TH / 256) * (NIN / 256) % G != 0) w_tickets(lds, c, l + 1, 1);
            }
            END_STEP;
            if (RUN) { CTX; phase_p(lds, c, l, G); }
            END_STEP;
            if (RUN) { CTX; phase_b1(lds, c, l, hf, G); }
            END_STEP;
            if (RUN) { CTX; phase_b(lds, c, l, hf, G); }
            END_STEP;
            if (RUN) { CTX; (void)lds; phase_f(c, G); }
            END_STEP_NB;
            if (RUN) {
                CTX;
                pg8::StaticOrder S; S.init(c.ws + WS_OG, c.ws + wset(l) + WS_WGO, TH, D, D / 2, G, lbid());
                EpiGate<false> E{wsb(c, WS_MIX), c.ws + WS_H + H_GT, nullptr};
                pg8::gemm_phase<EpiGate<false>, pg8::StaticOrder, true>(lds, D / 2, S, E);
            }
            END_STEP;
            if (RUN) {
                CTX;
                pg8::StaticOrder S; S.init(c.ws + WS_ATT, c.ws + wset(l) + WS_WAO, TH, D, 256, G, lbid());
                EpiGate<true> E{wsb(c, WS_MIX), c.ws + WS_H + H_GT + 1024, c.ws + WS_OG + 32 * MiB};
                pg8::gemm_phase<EpiGate<true>, pg8::StaticOrder, true>(lds, 256, S, E);
            }
            END_STEP;
            if (RUN) {
                CTX;
                pg8::StaticOrder S; S.init(c.ws + WS_OG + 32 * MiB, c.ws + wset(l) + WS_WOUT, TH, D, D / 2, G, lbid());
                EpiRes E{l == 0 ? c.x + r0 * D : nullptr, wsb(c, WS_XR) + r0 * D};
                pg8::gemm_phase<EpiRes, pg8::StaticOrder, true>(lds, D / 2, S, E);
            }
            if (hf == 1) END_STEP; else END_STEP_NB;
        }
        if (RUN) { CTX; phase_r(lds, c, l, G); }
        END_STEP;
        if (RUN) { CTX; phase_r2(lds, c, l, G); }
        END_STEP;
        if (RUN) {   CTX;
            const int ntiles = moe_setup(lds, c, l);
            volatile LAS int* PRE = (volatile LAS int*)(lds + MISC_OFF); volatile LAS int* TAB = (volatile LAS int*)(lds + TAB_OFF);
            pg8::MoeOrder S; S.G = G; S.c = vcu_of(lbid(), G); S.ntot = ntiles * 8; S.NC = 8; S.K = D / 2; S.pre = PRE; S.cnt = PRE + 17; S.A = (const char*)(c.ws + WS_XB); S.Bt = (const char*)(c.ws + wset(l) + WS_WGU);
            S.bstride = (size_t)2048 * 1024; S.tab = TAB; S.gather = true;
            const GAS int* list = (const GAS int*)(c.ws + WS_LIST);
            { const int lt_tid = ltid(); const int r = lt_tid & 255, half = rfl(lt_tid >> 8);
              int tv[MAXU / 2];
#pragma unroll
              for (int k = 0; k < MAXU / 2; ++k) { Unit u; const int i = 2 * k + half; tv[k] = 0;
                  if (S.next(i, u)) { const int lt = u.pm - PRE[u.e]; const int pos = 256 * lt + (r < u.nv ? r : 0); tv[k] = list[(size_t)u.e * T + pos]; } }
#pragma unroll
              for (int k = 0; k < MAXU / 2; ++k) { const int i = 2 * k + half; if (i * S.G + S.c < S.ntot) TAB[i * 256 + r] = tv[k] >> 1; } }
            __syncthreads();
            EpiM1 E{c.ws + WS_HM};
            pg8::gemm_phase<EpiM1, pg8::MoeOrder, true>(lds, D / 2, S, E);
            if (l + 1 < DEPTH && S.ntot % G != 0 && S.c >= S.ntot % G) w_tickets(lds, c, l + 1, 1);
        }
        END_STEP;
        if (RUN) {   CTX;
            const int ntiles = moe_setup(lds, c, l);
            volatile LAS int* PRE = (volatile LAS int*)(lds + MISC_OFF);
            pg8::MoeOrder S; S.G = G; S.c = vcu_of(lbid(), G); S.ntot = ntiles * 4; S.NC = 4; S.K = DFF / 2; S.pre = PRE; S.cnt = PRE + 17; S.A = (const char*)(c.ws + WS_HM); S.Bt = (const char*)(c.ws + wset(l) + WS_WD);
            S.bstride = (size_t)1024 * 1024; S.tab = nullptr; S.gather = false;
            EpiM2 E{c.ws + WS_YS, (const int*)(c.ws + WS_LIST), PRE};
            pg8::gemm_phase<EpiM2, pg8::MoeOrder, true>(lds, DFF / 2, S, E);
            if (l + 1 < DEPTH && S.ntot % G != 0 && S.c >= S.ntot % G) w_tickets(lds, c, l + 1, 1);
        }
        END_STEP;
        if (RUN) { CTX; (void)lds; if (l == DEPTH - 1) phase_c<true>(c, l, G); else phase_c<false>(c, l, G); }
        END_STEP_NB;
    }
#undef RUN
#undef END_STEP
#undef END_STEP_NB
}
constexpr int NSTEPS = DEPTH * (1 + 2 * 8 + 5);

extern "C" void kernel_launch(void* const* d_in, const int* in_sizes, int n_in, void* d_out, int out_size, void* d_ws, size_t ws_size, hipStream_t stream) {
    static int grid = 0;
    if (grid == 0) {
        if (n_in != 18 || in_sizes[0] != T * D || out_size != T * D || ws_size < WS_END) { fprintf(stderr, "kernel_launch: unexpected shapes / workspace (need %zu, got %zu)\n", (size_t)WS_END, ws_size); grid = -1; return; }
        int dev = 0, cus = 0;
        if (hipGetDevice(&dev) != hipSuccess || hipDeviceGetAttribute(&cus, hipDeviceAttributeMultiprocessorCount, dev) != hipSuccess) { grid = -1; return; }
        if (hipFuncSetAttribute((const void*)mk_fwd, hipFuncAttributeMaxDynamicSharedMemorySize, LDS_BYTES) != hipSuccess) { fprintf(stderr, "kernel_launch: hipFuncSetAttribute failed\n"); grid = -1; return; }
        int per_cu = 0;
        if (hipOccupancyMaxActiveBlocksPerMultiprocessor(&per_cu, (const void*)mk_fwd, NTHREADS, LDS_BYTES) != hipSuccess || per_cu < 1) { fprintf(stderr, "kernel_launch: occupancy query says %d\n", per_cu); }
        (void)hipGetLastError();
        grid = cus;
    }
    if (grid < 0) return;
    (void)hipMemsetAsync((char*)d_ws + WS_CTL, 0, CTL_ZERO_BYTES, stream);
    Ctx c{};
    c.x = (const float*)d_in[0]; c.pos = (const int*)d_in[1]; c.w_in = (const float*)d_in[2]; c.w_alpha_up = (const float*)d_in[3]; c.b_alpha = (const float*)d_in[4]; c.gla_norm = (const float*)d_in[5];
    c.w_gla_o = (const float*)d_in[6]; c.w_att_o = (const float*)d_in[7]; c.w_out = (const float*)d_in[8]; c.ln1_g = (const float*)d_in[9]; c.ln1_b = (const float*)d_in[10]; c.w_router = (const float*)d_in[11];
    c.b_router = (const float*)d_in[12]; c.w_e_gate = (const float*)d_in[13]; c.w_e_up = (const float*)d_in[14]; c.w_e_down = (const float*)d_in[15]; c.ln2_g = (const float*)d_in[16]; c.ln2_b = (const float*)d_in[17];
    c.out = (float*)d_out; c.ws = (unsigned char*)d_ws;
#if MK_MULTI
    for (int s = 0; s < NSTEPS; ++s) { c.lo = s; c.hi = s + 1; hipLaunchKernelGGL(mk_fwd, dim3(grid), dim3(NTHREADS), LDS_BYTES, stream, c); }
#else
    c.lo = 0; c.hi = NSTEPS; hipLaunchKernelGGL(mk_fwd, dim3(grid), dim3(NTHREADS), LDS_BYTES, stream, c);
#endif
}
```

```cpp
#include <hip/hip_runtime.h>
#include <cstdio>
#include <cstdint>

#ifndef MK_MULTI
#define MK_MULTI 0
#endif

#define DI __device__ __forceinline__
#define GAS __attribute__((address_space(1)))
#define LAS __attribute__((address_space(3)))
typedef unsigned short bf16_t;
typedef short bf16x8 __attribute__((ext_vector_type(8)));
typedef short s16x4 __attribute__((ext_vector_type(4)));
typedef float f32x4 __attribute__((ext_vector_type(4)));
typedef float f32x2 __attribute__((ext_vector_type(2)));
typedef unsigned u32x4 __attribute__((ext_vector_type(4)));
typedef unsigned u32x2 __attribute__((ext_vector_type(2)));
typedef int i32x4 __attribute__((ext_vector_type(4)));
typedef int i32x8 __attribute__((ext_vector_type(8)));
#define LDS_WAIT() asm volatile("s_waitcnt lgkmcnt(0)" ::: "memory")
#define VM_WAIT() asm volatile("s_waitcnt vmcnt(0)" ::: "memory")

constexpr int D = 1024, NBATCH = 16, SEQ = 4096, T = NBATCH * SEQ, DEPTH = 4;
constexpr int TH = T / 2;
constexpr int DIN = 9744, NIN = 9984;
constexpr int NEXP = 16, DFF = 1024;
constexpr float LN_EPS = 1e-5f, RMS_EPS = 1e-6f;
constexpr float DN_ALPHA = 1.6817928305074290f;
constexpr float LOG2E = 1.4426950408889634f;
constexpr int NWAVES = 8, NTHREADS = 512;

constexpr size_t MiB = 1u << 20;
constexpr size_t WS_CTL = 0, CTL_ZERO_BYTES = 1 * MiB;
constexpr size_t WS_WIN = 1 * MiB;
constexpr size_t WS_WGO = WS_WIN + (size_t)NIN * D;
constexpr size_t WS_WAO = WS_WGO + 2 * MiB;
constexpr size_t WS_WOUT = WS_WAO + 1 * MiB;
constexpr size_t WS_WGU = WS_WOUT + 2 * MiB;
constexpr size_t WS_WD = WS_WGU + 32 * MiB;
constexpr size_t WS_XB = WS_WD + 16 * MiB;
constexpr size_t WS_XR = WS_XB + 64 * MiB;
constexpr size_t WS_LIST = WS_XR + 128 * MiB;
constexpr size_t WS_GATE = WS_LIST + 4 * MiB;
constexpr size_t WS_INFO = WS_GATE + 1 * MiB;
constexpr size_t WS_HISTG = WS_INFO + 1 * MiB;
constexpr size_t WS_OG = WS_HISTG + 1 * MiB;
constexpr size_t WS_ATTG = WS_OG + 64 * MiB;
constexpr size_t WS_LSE = WS_ATTG + 96 * MiB;
constexpr size_t WS_ATT = WS_LSE + 3 * MiB;
constexpr size_t WS_MIX = WS_ATT + 32 * MiB;
constexpr size_t WS_HA = WS_MIX + 64 * MiB;
constexpr size_t WS_H = WS_HA + 2 * MiB;
constexpr size_t H_QG = 0, H_KG = H_QG + (size_t)TH * 512 * 2, H_VG = H_KG + (size_t)TH * 512 * 2, H_SR = H_VG + (size_t)TH * 1024 * 2,
                 H_QD = H_SR + (size_t)TH * 1024 * 2, H_KD = H_QD + (size_t)TH * 1536 * 2, H_VD = H_KD + (size_t)TH * 1536 * 2, H_GT = H_VD + (size_t)TH * 1536 * 2,
                 H_END = H_GT + (size_t)TH * 2048 * 2;
constexpr size_t WS_HM = WS_H;
constexpr size_t WS_YS = WS_HM + (size_t)(2 * T + 4096) * 1024 * 2;
constexpr size_t WS_STAT = WS_CTL + 512 * 1024;
constexpr size_t WS_W2 = WS_H + 544 * MiB, WSET_BYTES = WS_XB - WS_WIN;
static_assert(WS_W2 + WSET_BYTES <= WS_H + H_END, "second weight set fits");
constexpr size_t WS_REC = WS_H + H_END;
constexpr size_t WS_SLOC = WS_REC + (size_t)2048 * 33792;
constexpr size_t WS_DCUM = WS_SLOC + 16 * MiB;
constexpr size_t WS_END = WS_DCUM + 1 * MiB;
static_assert(WS_YS + (size_t)2 * T * 1024 * 2 <= WS_END, "MoE overlay fits");
constexpr int CW_BAR = 4096;
constexpr int CW_TKT = 24576;
constexpr int CW_CUR = 16384;
constexpr int CW_WTK = 40960;

constexpr int RING_BYTES = 131072;
constexpr int TAB_OFF = RING_BYTES, MAXU = 18, TAB_BYTES = MAXU * 1024;
constexpr int LDS_BYTES = 163840;
constexpr int MISC_OFF = LDS_BYTES - 256;
static_assert(TAB_OFF + TAB_BYTES <= MISC_OFF, "LDS map");

DI int rfl(int v) { return __builtin_amdgcn_readfirstlane(v); }
DI int lbid() { int t = blockIdx.x; asm volatile("" : "+s"(t)); return t; }
DI int lgrid() { int t = gridDim.x; asm volatile("" : "+s"(t)); return t; }
DI int vcu_of(int bid, int G) { return (G % 8 == 0) ? (bid % 8) * (G / 8) + bid / 8 : bid; }
DI int ltid() { int t = threadIdx.x; asm volatile("" : "+v"(t)); return t; }
DI float bf2f(unsigned b) { return __uint_as_float(b << 16); }
typedef __bf16 bf16x2_t __attribute__((ext_vector_type(2)));
DI unsigned cvt_pk_bf16(float lo, float hi) { f32x2 v = {lo, hi}; bf16x2_t b = __builtin_convertvector(v, bf16x2_t); return __builtin_bit_cast(unsigned, b); }
DI float clamp8(float v) { return fminf(fmaxf(v, -448.f), 448.f); }
DI unsigned pk4_fp8(float a, float b, float c_, float d) { int w = 0; w = __builtin_amdgcn_cvt_pk_fp8_f32(clamp8(a), clamp8(b), w, false); w = __builtin_amdgcn_cvt_pk_fp8_f32(clamp8(c_), clamp8(d), w, true); return (unsigned)w; }
constexpr float W8_SCALE = 64.0f, W8_INV = 1.0f / 64.0f;
DI float bf_lo(unsigned w) { return __uint_as_float(w << 16); }
DI float bf_hi(unsigned w) { return __uint_as_float(w & 0xffff0000u); }
DI float sigmoidf_(float x) { return __builtin_amdgcn_rcpf(1.0f + __builtin_amdgcn_exp2f(-x * LOG2E)); }
DI float sigmoid64_(float x64) { return __builtin_amdgcn_rcpf(1.0f + __builtin_amdgcn_exp2f(x64 * (-LOG2E * W8_INV))); }

#define XB_TMO      128
#define XB_XCNT(j)  (256  + 64 * (j))
#define XB_XSUB(j)  (1280 + 64 * (j))
#define XB_XGEN(j)  (2304 + 64 * (j))
#define XB_TOP      3328
#define XB_TOPGEN   3392
#define XCD_BAR_WORDS 3456
#define XB_SPIN_CAP (1u << 18)
DI unsigned xb_ld(unsigned* p)              { return __hip_atomic_load(p, __ATOMIC_RELAXED, __HIP_MEMORY_SCOPE_AGENT); }
DI unsigned xb_add(unsigned* p, unsigned v) { return __hip_atomic_fetch_add(p, v, __ATOMIC_RELAXED, __HIP_MEMORY_SCOPE_AGENT); }
DI unsigned xb_xcc_id() { return (unsigned)__builtin_amdgcn_s_getreg((3 << 11) | 20) & 0xFu; }
#define XB_SPIN(cond, bar) do { unsigned _sp = 0; while (cond) { __builtin_amdgcn_s_sleep(1); \
    if ((++_sp & 255u) == 0u) { if (xb_ld(&(bar)[XB_TMO])) break; if (_sp > XB_SPIN_CAP) { atomicAdd(&(bar)[XB_TMO], 1u); break; } } } } while (0)
struct XcdBarrier { unsigned* bar; unsigned x; volatile LAS unsigned* st; };
DI XcdBarrier xcd_barrier_post(unsigned* bar, volatile LAS unsigned* st) {
    XcdBarrier b; b.bar = bar; b.x = xb_xcc_id(); b.st = st;
    if (threadIdx.x == 0) (void)xb_add(&bar[XB_XCNT(b.x)], 1u);
    return b;
}
DI void xcd_barrier_complete(unsigned* bar, unsigned x, unsigned& nloc, unsigned& nx) {
    const unsigned G = gridDim.x * gridDim.y * gridDim.z;
    unsigned sum, cnt, mine, sp = 0u;
    for (;;) {
        sum = 0u; cnt = 0u; mine = 0u;
#pragma unroll
        for (unsigned j = 0; j < 16; ++j) { const unsigned c = xb_ld(&bar[XB_XCNT(j)]); sum += c; cnt += (c > 0u) ? 1u : 0u; mine = (j == x) ? c : mine; }
        if (sum == G) break;
        __builtin_amdgcn_s_sleep(1);
        if ((++sp & 255u) == 0u) { if (xb_ld(&bar[XB_TMO])) break; if (sp > XB_SPIN_CAP) { atomicAdd(&bar[XB_TMO], 1u); break; } }
    }
    nloc = mine > 0u ? mine : 1u; nx = cnt > 0u ? cnt : 1u;
}
DI void xcd_barrier(const XcdBarrier& b) {
    asm volatile("s_waitcnt vmcnt(0)" ::: "memory");
    __syncthreads();
    if (threadIdx.x == 0) {
        unsigned* bar = b.bar;
        __builtin_amdgcn_s_waitcnt(0);
        unsigned nloc = b.st[0], nx = b.st[1];
        if (nloc == 0u) { xcd_barrier_complete(bar, b.x, nloc, nx); b.st[0] = nloc; b.st[1] = nx; }
        const unsigned old = xb_add(&bar[XB_XSUB(b.x)], 1u);
        const unsigned gen = old / nloc;
        if (old + 1u == (gen + 1u) * nloc) {
            __builtin_amdgcn_fence(__ATOMIC_RELEASE, "agent");
            asm volatile("s_waitcnt vmcnt(0)" ::: "memory");
            const unsigned og = xb_add(&bar[XB_TOP], 1u);
            const unsigned tg = og / nx;
            if (og + 1u == (tg + 1u) * nx) xb_add(&bar[XB_TOPGEN], 1u);
            else XB_SPIN(xb_ld(&bar[XB_TOPGEN]) == tg, bar);
            __builtin_amdgcn_fence(__ATOMIC_ACQUIRE, "agent");
            xb_add(&bar[XB_XGEN(b.x)], 1u);
            asm volatile("s_waitcnt vmcnt(0)" ::: "memory");
        } else {
            XB_SPIN(xb_ld(&bar[XB_XGEN(b.x)]) == gen, bar);
            __builtin_amdgcn_fence(__ATOMIC_ACQUIRE, "agent");
            asm volatile("s_waitcnt vmcnt(0)" ::: "memory");
        }
    }
    __syncthreads();
}

struct Ctx {
    const float* x; const int* pos; const float* w_in; const float* w_alpha_up; const float* b_alpha; const float* gla_norm;
    const float* w_gla_o; const float* w_att_o; const float* w_out; const float* ln1_g; const float* ln1_b; const float* w_router; const float* b_router;
    const float* w_e_gate; const float* w_e_up; const float* w_e_down; const float* ln2_g; const float* ln2_b;
    float* out; unsigned char* ws;
    int lo, hi;
};
DI bf16_t* wsb(const Ctx& c, size_t off) { return (bf16_t*)(c.ws + off); }
DI int in_tile(int pt) { return pt == 7 ? 37 : (pt == 37 ? 7 : pt); }
DI size_t wset(int l) { return (l & 1) ? (WS_W2 - WS_WIN) : (size_t)0; }

namespace pg8 {
constexpr int BM = 256, BK = 64, HALF = 128, HTB = HALF * BK * 2, STAGE_BYTES = 8 * HTB, NXCD = 8, WGM = 8;
DI int lds_byte(int r, int c) { const int st = (r >> 4) * 2 + (c >> 5), rr = r & 15, cc = c & 31, ob = rr * 64 + cc * 2; return st * 1024 + (ob ^ (((ob >> 9) & 1) << 5)); }
DI void stage_rc(int b, int& R, int& C) { const int st = b / 1024, sb = b % 1024, swz = sb ^ (((sb >> 9) & 1) << 5); R = (st >> 1) * 16 + swz / 64; C = (st & 1) * 32 + (swz % 64) / 2; }
DI int perm32(int rho) { const int n = rho >> 4, i = rho & 15; return 8 * (i >> 2) + 4 * n + (i & 3); }
struct Unit { int pm, pn, e, nv, ui; };

struct StaticOrder {
    int nM, nN, nwg, G, c, K; const char* A; const char* Bt;
    DI void init(const void* A_, const void* Bt_, int M, int N, int K_, int G_, int c_) { A = (const char*)A_; Bt = (const char*)Bt_; nM = M / BM; nN = N / BM; nwg = nM * nN; G = G_; c = c_; K = K_; }
    DI bool next(int i, Unit& u) const {
        const long L = (long)i * G + c; if (L >= nwg) return false;
        int wgid = (int)L; { const int q = nwg / NXCD, r = nwg % NXCD, xcd = wgid % NXCD, off = wgid / NXCD; wgid = (xcd < r ? xcd * (q + 1) : r * (q + 1) + (xcd - r) * q) + off; }
        const int nig = WGM * nN, gid = wgid / nig, fm = gid * WGM, gsz = (nM - fm) < WGM ? (nM - fm) : WGM;
        u.pm = fm + ((wgid % nig) % gsz); u.pn = (wgid % nig) / gsz; u.e = 0; u.nv = 256; u.ui = i; return true;
    }
    DI const char* a_base(const Unit& u) const { return A + (size_t)u.pm * BM * K * 2; }
    DI const char* b_base(const Unit& u) const { return Bt + (size_t)u.pn * BM * K * 2; }
    DI void a_off(const Unit&, int tid, unsigned (&o)[2][2]) const {
#pragma unroll
        for (int i = 0; i < 2; ++i) { int R, C; stage_rc(tid * 16 + i * 8192, R, C);
#pragma unroll
            for (int h = 0; h < 2; ++h) o[h][i] = (unsigned)((h * HALF + R) * K + C) * 2u; }
    }
};
struct MoeOrder {
    int G, c, ntot, NC, K; const volatile LAS int* pre; const volatile LAS int* cnt; const char* A; const char* Bt; size_t bstride; const volatile LAS int* tab; bool gather;
    DI bool next(int i, Unit& u) const {
        const int L = i * G + c; if (L >= ntot) return false;
        const int rt = L / NC; u.pn = L - rt * NC; u.pm = rt;
        int e = 0;
#pragma unroll
        for (int j = 1; j < 16; ++j) e += (rt >= rfl(pre[j])) ? 1 : 0;
        e = rfl(e); u.e = e; const int rem = rfl(cnt[e]) - 256 * (rt - rfl(pre[e])); u.nv = rem < 256 ? rem : 256; u.ui = i; return true;
    }
    DI const char* a_base(const Unit& u) const { return gather ? A : A + (size_t)u.pm * BM * K * 2; }
    DI const char* b_base(const Unit& u) const { return Bt + (size_t)u.e * bstride + (size_t)u.pn * BM * K * 2; }
    DI void a_off(const Unit& u, int tid, unsigned (&o)[2][2]) const {
#pragma unroll
        for (int i = 0; i < 2; ++i) { int R, C; stage_rc(tid * 16 + i * 8192, R, C);
#pragma unroll
            for (int h = 0; h < 2; ++h) { const int row = gather ? tab[u.ui * 256 + h * HALF + R] : (h * HALF + R); o[h][i] = (unsigned)(row * K + C) * 2u; } }
    }
};

template <class Epi, class Sched, bool F8 = false>
DI void gemm_phase(LAS unsigned char* lds, const int K, const Sched& S, const Epi& E) {
    const int tid = ltid(), wid = rfl(tid >> 6), lane = tid & 63, wr = wid >> 2, wc = wid & 3, fr = lane & 15, fq = lane >> 4;
    const int nt = K / BK;
    unsigned voffB[2];
#pragma unroll
    for (int i = 0; i < 2; ++i) { int R, C; stage_rc(tid * 16 + i * 8192, R, C); const int Rb = Epi::PERM ? ((R & ~31) + perm32(R & 31)) : R; voffB[i] = (unsigned)(Rb * K + C) * 2u; }
    const size_t kstep = (size_t)(BK * 2);
    const size_t hstep = (size_t)HALF * K * 2;
    const unsigned ldsw = (unsigned)wid * 1024u;
    const int aoff = lds_byte(wr * 64 + fr, fq * 8), boff = lds_byte(wc * 32 + fr, fq * 8);
#define PG8_SA(b, h) (((b) * 2 + (h)) * HTB)
#define PG8_SB(b, h) ((4 + (b) * 2 + (h)) * HTB)
#define PG8_STAGE(bufoff, gbase, voff) do { _Pragma("unroll") for (int _i = 0; _i < 2; ++_i) \
        __builtin_amdgcn_global_load_lds((const unsigned*)((const char*)(gbase) + (voff)[_i]), (LAS unsigned*)(lds + (bufoff) + ldsw + _i * 8192), 16, 0, 0); } while (0)
#define PG8_LD8(p) __builtin_shufflevector(*(const LAS i32x4*)(p), *(const LAS i32x4*)((p) + 1024), 0, 1, 2, 3, 4, 5, 6, 7)
#define PG8_LDA(dst, b, h) do { if constexpr (F8) { _Pragma("unroll") for (int m = 0; m < 4; ++m) dst##8[m] = PG8_LD8(lds + PG8_SA(b, h) + aoff + m * 2048); } else { \
        _Pragma("unroll") for (int m = 0; m < 4; ++m) _Pragma("unroll") for (int k = 0; k < 2; ++k) dst[m][k] = *(const LAS bf16x8*)(lds + PG8_SA(b, h) + aoff + m * 2048 + k * 1024); } } while (0)
#define PG8_LDB(dst, b, h) do { if constexpr (F8) { _Pragma("unroll") for (int n = 0; n < 2; ++n) dst##8[n] = PG8_LD8(lds + PG8_SB(b, h) + boff + n * 2048); } else { \
        _Pragma("unroll") for (int n = 0; n < 2; ++n) _Pragma("unroll") for (int k = 0; k < 2; ++k) dst[n][k] = *(const LAS bf16x8*)(lds + PG8_SB(b, h) + boff + n * 2048 + k * 1024); } } while (0)
#define PG8_MMA(ai, bj, At, Bt) do { __builtin_amdgcn_s_setprio(1); if constexpr (F8) { _Pragma("unroll") for (int m = 0; m < 4; ++m) _Pragma("unroll") for (int n = 0; n < 2; ++n) \
        asm volatile("v_mfma_f32_16x16x128_f8f6f4 %0, %1, %2, %0" : "+v"(acc[ai][bj][m][n]) : "v"(Bt##8[n]), "v"(At##8[m])); } else { \
        _Pragma("unroll") for (int m = 0; m < 4; ++m) _Pragma("unroll") for (int n = 0; n < 2; ++n) _Pragma("unroll") for (int k = 0; k < 2; ++k) \
        acc[ai][bj][m][n] = __builtin_amdgcn_mfma_f32_16x16x32_bf16(Bt[n][k], At[m][k], acc[ai][bj][m][n], 0, 0, 0); } __builtin_amdgcn_s_setprio(0); } while (0)
#define PG8_MMA0(ai, bj, At, Bt) do { __builtin_amdgcn_s_setprio(1); _Pragma("unroll") for (int m = 0; m < 4; ++m) _Pragma("unroll") for (int n = 0; n < 2; ++n) \
        asm volatile("v_mfma_f32_16x16x128_f8f6f4 %0, %1, %2, 0" : "=&v"(acc[ai][bj][m][n]) : "v"(Bt##8[n]), "v"(At##8[m])); __builtin_amdgcn_s_setprio(0); } while (0)
#define PG8_WAIT_V(n) asm volatile("s_waitcnt vmcnt(" #n ")" ::: "memory")
#define PG8_WAIT_L(n) asm volatile("s_waitcnt lgkmcnt(" #n ")" ::: "memory")
#define PG8_WAIT_VX(sx) do { if ((sx) >= 48) PG8_WAIT_V(56); else if ((sx) >= 32) PG8_WAIT_V(40); else if ((sx) >= 24) PG8_WAIT_V(32); else if ((sx) >= 16) PG8_WAIT_V(24); else if ((sx) >= 8) PG8_WAIT_V(16); else PG8_WAIT_V(8); } while (0)
#define PG8_BAR __builtin_amdgcn_s_barrier()
#define PG8_SCHED __builtin_amdgcn_sched_barrier(0)
    Unit cur, nxt; int ui = 0, sx = 0;
    if (!S.next(0, cur)) return;
    f32x4 acc[2][2][4][2];
    if constexpr (!F8)
#pragma unroll
    for (int a = 0; a < 2; ++a)
#pragma unroll
        for (int b = 0; b < 2; ++b)
#pragma unroll
            for (int m = 0; m < 4; ++m)
#pragma unroll
                for (int n = 0; n < 2; ++n) acc[a][b][m][n] = (f32x4){0.f, 0.f, 0.f, 0.f};
    bf16x8 At[4][2], B0[2][2], B1[2][2]; i32x8 At8[4], B08[2], B18[2];
    unsigned oA[2][2]; S.a_off(cur, tid, oA);
    const char* cA = S.a_base(cur); const char* cB = S.b_base(cur);
    PG8_STAGE(PG8_SB(0, 0), cB, voffB); PG8_STAGE(PG8_SB(0, 1), cB + hstep, voffB); PG8_STAGE(PG8_SA(0, 0), cA, oA[0]); PG8_STAGE(PG8_SA(0, 1), cA, oA[1]);
    if (wr == 1) PG8_BAR;
    PG8_WAIT_V(2); PG8_BAR;
    PG8_STAGE(PG8_SB(1, 0), cB + kstep, voffB); PG8_STAGE(PG8_SA(1, 0), cA + kstep, oA[0]); PG8_STAGE(PG8_SB(1, 1), cB + hstep + kstep, voffB);
    PG8_WAIT_V(6); PG8_BAR;
    for (;;) {
        const bool has_next = S.next(ui + 1, nxt);
        const char* nA = has_next ? S.a_base(nxt) : cA; const char* nB = has_next ? S.b_base(nxt) : cB;
        for (int t = 0; t < nt; t += 2) {
            const bool last = (t == nt - 2); const int sxe = (t == 0) ? sx : 0;
            const char* a1 = cA + (size_t)(t + 1) * kstep;
            const char* a2 = last ? nA : cA + (size_t)(t + 2) * kstep; const char* b2 = last ? nB : cB + (size_t)(t + 2) * kstep;
            const char* a3 = a2 + kstep; const char* b3 = b2 + kstep;
            PG8_LDB(B0, 0, 0); PG8_LDB(B1, 0, 1); PG8_SCHED; PG8_LDA(At, 0, 0); PG8_STAGE(PG8_SA(1, 1), a1, oA[1]);
            if (last && has_next) S.a_off(nxt, tid, oA);
            PG8_WAIT_VX(sxe); PG8_WAIT_L(0); PG8_BAR; if (F8 && t == 0) { PG8_MMA0(0, 0, At, B0); PG8_MMA0(0, 1, At, B1); } else { PG8_MMA(0, 0, At, B0); PG8_MMA(0, 1, At, B1); } PG8_BAR; PG8_SCHED;
            PG8_LDA(At, 0, 1); PG8_STAGE(PG8_SB(0, 0), b2, voffB); PG8_STAGE(PG8_SB(0, 1), b2 + hstep, voffB); PG8_STAGE(PG8_SA(0, 0), a2, oA[0]);
            PG8_WAIT_VX(sxe); PG8_WAIT_L(0); PG8_BAR; if (F8 && t == 0) { PG8_MMA0(1, 0, At, B0); PG8_MMA0(1, 1, At, B1); } else { PG8_MMA(1, 0, At, B0); PG8_MMA(1, 1, At, B1); } PG8_BAR; PG8_SCHED;
            PG8_LDB(B0, 1, 0); PG8_LDB(B1, 1, 1); PG8_SCHED; PG8_LDA(At, 1, 0); PG8_STAGE(PG8_SA(0, 1), a2, oA[1]);
            PG8_WAIT_V(8); PG8_WAIT_L(0); PG8_BAR; PG8_MMA(0, 0, At, B0); PG8_MMA(0, 1, At, B1); PG8_BAR; PG8_SCHED;
            PG8_LDA(At, 1, 1); PG8_STAGE(PG8_SB(1, 0), b3, voffB); PG8_STAGE(PG8_SB(1, 1), b3 + hstep, voffB); PG8_STAGE(PG8_SA(1, 0), a3, oA[0]);
            PG8_WAIT_V(8); PG8_WAIT_L(0); PG8_BAR; PG8_MMA(1, 0, At, B0); PG8_MMA(1, 1, At, B1); PG8_BAR; PG8_SCHED;
        }
        if (wr == 0) PG8_BAR;
        if constexpr (F8) asm volatile("s_nop 15\n\ts_nop 15" ::: "memory");
        E(acc, cur, wr, wc, fr, fq);
        if (!has_next) break;
        if constexpr (!F8)
#pragma unroll
        for (int a = 0; a < 2; ++a)
#pragma unroll
            for (int b = 0; b < 2; ++b)
#pragma unroll
                for (int m = 0; m < 4; ++m)
#pragma unroll
                    for (int n = 0; n < 2; ++n) acc[a][b][m][n] = (f32x4){0.f, 0.f, 0.f, 0.f};
        cur = nxt; cA = nA; cB = nB; ++ui;
        if (wr == 1) PG8_BAR;
    }
    PG8_WAIT_V(0);
    PG8_BAR;
#undef PG8_SA
#undef PG8_SB
#undef PG8_STAGE
#undef PG8_LDA
#undef PG8_LDB
#undef PG8_MMA
#undef PG8_MMA0
#undef PG8_LD8
#undef PG8_WAIT_V
#undef PG8_WAIT_VX
#undef PG8_WAIT_L
#undef PG8_BAR
#undef PG8_SCHED
}
}
using pg8::Unit;

DI u32x4 pack8(const f32x4& v0, const f32x4& v1) { u32x4 w; w.x = cvt_pk_bf16(v0[0], v0[1]); w.y = cvt_pk_bf16(v0[2], v0[3]); w.z = cvt_pk_bf16(v1[0], v1[1]); w.w = cvt_pk_bf16(v1[2], v1[3]); return w; }

DI void st_pair16(unsigned char* px, int gap, u32x2 x, u32x2 y, int fq) {
    const auto r0 = __builtin_amdgcn_permlane16_swap(x.x, y.x, false, false), r1 = __builtin_amdgcn_permlane16_swap(x.y, y.y, false, false);
    *(GAS u32x4*)(px + ((fq & 1) ? gap - 8 : 0)) = (u32x4){r0[0], r1[0], r0[1], r1[1]};
}
DI size_t dil_row(int gh, int R) { const int s = 2 * (gh >> 3), bl = R >> 12, t = R & (SEQ - 1);
    return ((size_t)((gh * 8 + bl) * SEQ) + (size_t)((t & ((1 << s) - 1)) * (SEQ >> s) + (t >> s))) * 64; }
struct EpiIn {
    static constexpr bool PERM = true;
    bf16_t *qg, *kg, *vg, *sr, *qd, *kd, *vd, *gt; float* ha; const int* pos;
    DI int nvm(const Unit& u, int) const { return u.pn == 38 ? 0 : 16; }
    DI void operator()(const f32x4 (&acc)[2][2][4][2], const Unit& u, int wr, int wc, int fr, int fq) const {
        asm volatile("" : "+v"(fr), "+v"(fq));
        const int row0 = u.pm * 256 + wr * 64 + fr; const int pn = in_tile(u.pn);
        if (pn >= 12 && pn < 24) {
            bf16_t* base = pn < 18 ? qd : kd; const int tq = pn < 18 ? pn - 12 : pn - 18; const float sc = pn < 18 ? 0.125f * LOG2E * W8_INV : W8_INV;
            float fre[8];
#pragma unroll
            for (int i = 0; i < 8; ++i) fre[i] = __builtin_amdgcn_exp2f(-(float)(8 * fq + i) * (13.287712379549449f / 32.0f)) * 0.15915494309189535f;
            int posv[8];
#pragma unroll
            for (int q = 0; q < 8; ++q) posv[q] = ((const GAS int*)pos)[row0 + (q >> 2) * 128 + (q & 3) * 16];
#pragma unroll
            for (int ai = 0; ai < 2; ++ai) {
#pragma unroll
                for (int m = 0; m < 4; ++m) {
                    const int r = row0 + ai * 128 + m * 16; const float p = (float)posv[ai * 4 + m];
                    unsigned char* rowp = (unsigned char*)base + dil_row(4 * tq + wc, r) + 8 * fq;
                    u32x2 w1, w2;
#pragma unroll
                    for (int n = 0; n < 2; ++n) { f32x4 o1, o2;
#pragma unroll
                        for (int j = 0; j < 4; ++j) {
                            float a = p * fre[n * 4 + j]; a = a - __builtin_floorf(a);
                            const float sn = __builtin_amdgcn_sinf(a), cs = __builtin_amdgcn_cosf(a);
                            const float x1 = acc[ai][0][m][n][j], x2 = acc[ai][1][m][n][j];
                            o1[j] = (x1 * cs - x2 * sn) * sc; o2[j] = (x2 * cs + x1 * sn) * sc;
                        }
                        w1[n] = pk4_fp8(o1[0], o1[1], o1[2], o1[3]); w2[n] = pk4_fp8(o2[0], o2[1], o2[2], o2[3]); }
                    st_pair16(rowp, 32, w1, w2, fq);
                    asm volatile("" ::: "memory");
                } }
        } else if (pn == 38) {
            if (wc == 0 && fq < 2) {
#pragma unroll
                for (int ai = 0; ai < 2; ++ai)
#pragma unroll
                    for (int m = 0; m < 4; ++m) { float* p = ha + (size_t)(row0 + ai * 128 + m * 16) * 16 + 8 * fq; *(GAS f32x4*)p = acc[ai][0][m][0] * W8_INV; *(GAS f32x4*)(p + 4) = acc[ai][0][m][1] * W8_INV; }
            }
        } else {
            bf16_t* base; int ldc, colt, act = 0; float sc = W8_INV;
            if (pn < 2) { base = qg; ldc = 512; colt = pn * 256; sc = 0.08838834764831845f * W8_INV; }
            else if (pn < 4) { base = kg; ldc = 512; colt = (pn - 2) * 256; }
            else if (pn < 8) { base = vg; ldc = 1024; colt = (pn - 4) * 256; }
            else if (pn < 12) {
#pragma unroll
                for (int ai = 0; ai < 2; ++ai)
#pragma unroll
                    for (int m = 0; m < 4; ++m) { unsigned char* rowp = (unsigned char*)sr + (size_t)(row0 + ai * 128 + m * 16) * 1024 + (pn - 8) * 256 + wc * 32 + 8 * fq;
                        u32x2 o[2];
#pragma unroll
                        for (int bj = 0; bj < 2; ++bj) { const f32x4 v0 = acc[ai][bj][m][0] * W8_INV, v1 = acc[ai][bj][m][1] * W8_INV;
                            o[bj].x = pk4_fp8(v0[0] * sigmoidf_(v0[0]), v0[1] * sigmoidf_(v0[1]), v0[2] * sigmoidf_(v0[2]), v0[3] * sigmoidf_(v0[3]));
                            o[bj].y = pk4_fp8(v1[0] * sigmoidf_(v1[0]), v1[1] * sigmoidf_(v1[1]), v1[2] * sigmoidf_(v1[2]), v1[3] * sigmoidf_(v1[3])); }
                        st_pair16(rowp, 128, o[0], o[1], fq); }
                return; }
            else if (pn < 30) {
#pragma unroll
                for (int ai = 0; ai < 2; ++ai)
#pragma unroll
                    for (int m = 0; m < 4; ++m) { unsigned char* rowp = (unsigned char*)vd + dil_row(4 * (pn - 24) + (wc >> 1), row0 + ai * 128 + m * 16) + (wc & 1) * 32 + 8 * fq;
                        u32x2 o[2];
#pragma unroll
                        for (int bj = 0; bj < 2; ++bj) { const f32x4 v0 = acc[ai][bj][m][0] * W8_INV, v1 = acc[ai][bj][m][1] * W8_INV; o[bj].x = pk4_fp8(v0[0], v0[1], v0[2], v0[3]); o[bj].y = pk4_fp8(v1[0], v1[1], v1[2], v1[3]); }
                        st_pair16(rowp, 2 * 8 * SEQ * 64, o[0], o[1], fq); }
                return; }
            else {
#pragma unroll
                for (int ai = 0; ai < 2; ++ai)
#pragma unroll
                    for (int m = 0; m < 4; ++m) { unsigned char* rowp = (unsigned char*)gt + (size_t)(row0 + ai * 128 + m * 16) * 2048 + (pn - 30) * 256 + wc * 32 + 8 * fq;
                        u32x2 o[2];
#pragma unroll
                        for (int bj = 0; bj < 2; ++bj) {
#pragma unroll
                            for (int n = 0; n < 2; ++n) { const f32x4 v = acc[ai][bj][m][n];
                                o[bj][n] = (unsigned)(sigmoid64_(v[0]) * 255.0f + 0.5f) | ((unsigned)(sigmoid64_(v[1]) * 255.0f + 0.5f) << 8) | ((unsigned)(sigmoid64_(v[2]) * 255.0f + 0.5f) << 16) | ((unsigned)(sigmoid64_(v[3]) * 255.0f + 0.5f) << 24); } }
                        st_pair16(rowp, 128, o[0], o[1], fq); }
                return; }
#pragma unroll
            for (int ai = 0; ai < 2; ++ai)
#pragma unroll
                for (int m = 0; m < 4; ++m) { bf16_t* rowp = base + (size_t)(row0 + ai * 128 + m * 16) * ldc + colt + wc * 32 + 8 * fq;
#pragma unroll
                    for (int bj = 0; bj < 2; ++bj) { f32x4 v0 = acc[ai][bj][m][0] * sc, v1 = acc[ai][bj][m][1] * sc;
                        if (act) {
#pragma unroll
                            for (int j = 0; j < 4; ++j) { const float s0 = sigmoidf_(v0[j]), s1 = sigmoidf_(v1[j]); v0[j] = act == 1 ? v0[j] * s0 : s0; v1[j] = act == 1 ? v1[j] * s1 : s1; } }
                        *(GAS u32x4*)(rowp + bj * 128) = pack8(v0, v1); } }
        }
    }
};
template <bool ADD> struct EpiGate {
    static constexpr bool PERM = true;
    bf16_t* mix; const unsigned char* gt; unsigned char* mix8;
    DI int nvm(const Unit&, int) const { return ADD ? 48 : 32; }
    DI void operator()(const f32x4 (&acc)[2][2][4][2], const Unit& u, int wr, int wc, int fr, int fq) const {
        asm volatile("" : "+v"(fr), "+v"(fq));
        const int row0 = u.pm * 256 + wr * 64 + fr, col0 = u.pn * 256 + wc * 32 + 8 * fq; constexpr float k = W8_INV / 255.0f;
        u32x2 g[2][4][2];
#pragma unroll
        for (int ai = 0; ai < 2; ++ai)
#pragma unroll
            for (int m = 0; m < 4; ++m)
#pragma unroll
                for (int bj = 0; bj < 2; ++bj) g[ai][m][bj] = *(const GAS u32x2*)(gt + (size_t)(row0 + ai * 128 + m * 16) * 2048 + col0 + bj * 128);
#pragma unroll
        for (int ai = 0; ai < 2; ++ai) {
            u32x2 ov[4][2];
            if (ADD) {
#pragma unroll
                for (int m = 0; m < 4; ++m)
#pragma unroll
                    for (int bj = 0; bj < 2; ++bj) ov[m][bj] = *(const GAS u32x2*)((const GAS unsigned char*)mix + (size_t)(row0 + ai * 128 + m * 16) * 1024 + col0 + bj * 128);
            }
            asm volatile("" ::: "memory");
#pragma unroll
            for (int m = 0; m < 4; ++m) { const size_t r = (size_t)(row0 + ai * 128 + m * 16); u32x2 o8v[2];
#pragma unroll
                for (int bj = 0; bj < 2; ++bj) {
                    const u32x2 gg = g[ai][m][bj];
                    f32x4 v0 = acc[ai][bj][m][0], v1 = acc[ai][bj][m][1];
                    v0[0] *= (float)((gg.x >> 0) & 0xffu) * k; v0[1] *= (float)((gg.x >> 8) & 0xffu) * k; v0[2] *= (float)((gg.x >> 16) & 0xffu) * k; v0[3] *= (float)((gg.x >> 24) & 0xffu) * k;
                    v1[0] *= (float)((gg.y >> 0) & 0xffu) * k; v1[1] *= (float)((gg.y >> 8) & 0xffu) * k; v1[2] *= (float)((gg.y >> 16) & 0xffu) * k; v1[3] *= (float)((gg.y >> 24) & 0xffu) * k;
                    if (ADD) { const u32x2 o = ov[m][bj]; const f32x2 oa = __builtin_amdgcn_cvt_pk_f32_fp8((int)o.x, false), ob = __builtin_amdgcn_cvt_pk_f32_fp8((int)o.x, true), oc = __builtin_amdgcn_cvt_pk_f32_fp8((int)o.y, false), od = __builtin_amdgcn_cvt_pk_f32_fp8((int)o.y, true);
                        v0[0] += oa[0]; v0[1] += oa[1]; v0[2] += ob[0]; v0[3] += ob[1]; v1[0] += oc[0]; v1[1] += oc[1]; v1[2] += od[0]; v1[3] += od[1];
                    }
                    o8v[bj].x = pk4_fp8(v0[0], v0[1], v0[2], v0[3]); o8v[bj].y = pk4_fp8(v1[0], v1[1], v1[2], v1[3]); }
                st_pair16((ADD ? mix8 : (unsigned char*)mix) + r * 1024 + col0, 128, o8v[0], o8v[1], fq); }
        }
    }
};
struct EpiRes {
    static constexpr bool PERM = true;
    const float* x32; bf16_t* xr;
    DI int nvm(const Unit&, int) const { return 32; }
    DI void operator()(const f32x4 (&acc)[2][2][4][2], const Unit& u, int wr, int wc, int fr, int fq) const {
        asm volatile("" : "+v"(fr), "+v"(fq));
        const int row0 = u.pm * 256 + wr * 64 + fr, col0 = u.pn * 256 + wc * 32 + 8 * fq;
        if (x32) {
#pragma unroll
            for (int ai = 0; ai < 2; ++ai)
#pragma unroll
                for (int m2 = 0; m2 < 4; m2 += 2) { f32x4 a[2][2][2];
#pragma unroll
                    for (int mm = 0; mm < 2; ++mm)
#pragma unroll
                        for (int bj = 0; bj < 2; ++bj) { const size_t off = (size_t)(row0 + ai * 128 + (m2 + mm) * 16) * 1024 + col0 + bj * 128; a[mm][bj][0] = *(const GAS f32x4*)(x32 + off); a[mm][bj][1] = *(const GAS f32x4*)(x32 + off + 4); }
                    asm volatile("" ::: "memory");
#pragma unroll
                    for (int mm = 0; mm < 2; ++mm)
#pragma unroll
                        for (int bj = 0; bj < 2; ++bj) { const size_t off = (size_t)(row0 + ai * 128 + (m2 + mm) * 16) * 1024 + col0 + bj * 128;
                            *(GAS u32x4*)(xr + off) = pack8(a[mm][bj][0] * DN_ALPHA + acc[ai][bj][m2 + mm][0] * W8_INV, a[mm][bj][1] * DN_ALPHA + acc[ai][bj][m2 + mm][1] * W8_INV); }
                    asm volatile("" ::: "memory"); }
        } else {
#pragma unroll
            for (int ai = 0; ai < 2; ++ai) { u32x4 o[4][2];
#pragma unroll
                for (int m = 0; m < 4; ++m)
#pragma unroll
                    for (int bj = 0; bj < 2; ++bj) o[m][bj] = *(const GAS u32x4*)(xr + (size_t)(row0 + ai * 128 + m * 16) * 1024 + col0 + bj * 128);
                asm volatile("" ::: "memory");
#pragma unroll
                for (int m = 0; m < 4; ++m)
#pragma unroll
                    for (int bj = 0; bj < 2; ++bj) { const u32x4 q = o[m][bj]; const f32x4 a0 = (f32x4){bf_lo(q.x), bf_hi(q.x), bf_lo(q.y), bf_hi(q.y)}, a1 = (f32x4){bf_lo(q.z), bf_hi(q.z), bf_lo(q.w), bf_hi(q.w)};
                        *(GAS u32x4*)(xr + (size_t)(row0 + ai * 128 + m * 16) * 1024 + col0 + bj * 128) = pack8(a0 * DN_ALPHA + acc[ai][bj][m][0] * W8_INV, a1 * DN_ALPHA + acc[ai][bj][m][1] * W8_INV); }
                asm volatile("" ::: "memory"); }
        }
    }
};
struct EpiM1 {
    static constexpr bool PERM = true;
    unsigned char* hm;
    DI int nvm(const Unit&, int) const { return 8; }
    DI void operator()(const f32x4 (&acc)[2][2][4][2], const Unit& u, int wr, int wc, int fr, int fq) const {
        asm volatile("" : "+v"(fr), "+v"(fq));
        const int row0 = u.pm * 256 + wr * 64 + fr, col0 = u.pn * 128 + wc * 32 + 8 * fq;
#pragma unroll
        for (int ai = 0; ai < 2; ++ai)
#pragma unroll
            for (int m2 = 0; m2 < 4; m2 += 2) { u32x2 o[2];
#pragma unroll
                for (int mm = 0; mm < 2; ++mm) { const int m = m2 + mm; f32x4 v0, v1;
#pragma unroll
                    for (int j = 0; j < 4; ++j) { const float g0 = acc[ai][0][m][0][j], g1 = acc[ai][0][m][1][j]; v0[j] = g0 * sigmoid64_(g0) * (acc[ai][1][m][0][j] * (W8_INV * W8_INV)); v1[j] = g1 * sigmoid64_(g1) * (acc[ai][1][m][1][j] * (W8_INV * W8_INV)); }
                    o[mm].x = pk4_fp8(v0[0], v0[1], v0[2], v0[3]); o[mm].y = pk4_fp8(v1[0], v1[1], v1[2], v1[3]); }
                st_pair16(hm + (size_t)(row0 + ai * 128 + m2 * 16) * 1024 + col0, 16 * 1024, o[0], o[1], fq); }
    }
};
struct EpiM2 {
    static constexpr bool PERM = true;
    unsigned char* ys; const int* list; const volatile LAS int* pre;
    DI int nvm(const Unit& u, int) const { return u.nv == 256 ? 24 : 8; }
    DI void operator()(const f32x4 (&acc)[2][2][4][2], const Unit& u, int wr, int wc, int fr, int fq) const {
        asm volatile("" : "+v"(fr), "+v"(fq));
        const int lrow0 = wr * 64 + fr, col0 = u.pn * 256 + wc * 32 + 8 * fq; const int lt = u.pm - rfl(pre[u.e]);
        const int* lp = list + (size_t)u.e * T + 256 * lt;
        int slotv[8];
#pragma unroll
        for (int q = 0; q < 8; ++q) { const int r = lrow0 + (q >> 2) * 128 + (q & 3) * 16; slotv[q] = ((const GAS int*)lp)[r < u.nv ? r : 0]; }
#pragma unroll
        for (int ai = 0; ai < 2; ++ai)
#pragma unroll
            for (int m = 0; m < 4; ++m) { const int r = lrow0 + ai * 128 + m * 16;
                if (r < u.nv) { const int slot = slotv[ai * 4 + m]; unsigned char* yp = ys + (size_t)slot * 1024 + col0;
                    u32x2 o[2];
#pragma unroll
                    for (int bj = 0; bj < 2; ++bj) { const f32x4 v0 = acc[ai][bj][m][0] * W8_INV, v1 = acc[ai][bj][m][1] * W8_INV; o[bj].x = pk4_fp8(v0[0], v0[1], v0[2], v0[3]); o[bj].y = pk4_fp8(v1[0], v1[1], v1[2], v1[3]); }
                    st_pair16(yp, 128, o[0], o[1], fq); } }
    }
};

struct WItem { const float* W; unsigned char* WT; int N, K, drow, c0, nv, kb; };
DI WItem w_decode(const Ctx& c, int l, int it) {
    constexpr int I_IN = (NIN / 32) * 16, I_GO = 512, I_AO = 256, I_OUT = 512, I_EXP = 16 * 512;
    WItem w; int r = it;
    if (r < I_IN) {
        const int nbg = r >> 4, kb = r & 15, pn0 = 32 * nbg, tile = in_tile(pn0 >> 8), p = pn0 & 255, n0 = tile * 256 + p; int c0, nv = 32;
        if (tile < 12) c0 = n0;
        else if (tile < 24) { const int base = tile < 18 ? 3088 : 4624, tq = tile < 18 ? tile - 12 : tile - 18; c0 = base + (4 * tq + ((p & 127) >> 5)) * 64 + (p >= 128 ? 32 : 0); }
        else if (tile < 30) c0 = 6160 + (n0 - 24 * 256);
        else if (tile < 38) c0 = 7696 + (n0 - 30 * 256);
        else { c0 = 3072; nv = (p == 0) ? 16 : 0; }
        w.W = c.w_in + (size_t)l * D * DIN; w.N = DIN; w.WT = c.ws + wset(l) + WS_WIN; w.K = D; w.drow = pn0; w.c0 = c0; w.nv = nv; w.kb = kb; return w; }
    r -= I_IN;
    if (r < I_GO) { w.W = c.w_gla_o + (size_t)l * D * D; w.N = D; w.WT = c.ws + wset(l) + WS_WGO; w.K = D; w.drow = 32 * (r >> 4); w.c0 = w.drow; w.nv = 32; w.kb = r & 15; return w; }
    r -= I_GO;
    if (r < I_AO) { w.W = c.w_att_o + (size_t)l * 512 * D; w.N = D; w.WT = c.ws + wset(l) + WS_WAO; w.K = 512; w.drow = 32 * (r >> 3); w.c0 = w.drow; w.nv = 32; w.kb = r & 7; return w; }
    r -= I_AO;
    if (r < I_OUT) { w.W = c.w_out + (size_t)l * D * D; w.N = D; w.WT = c.ws + wset(l) + WS_WOUT; w.K = D; w.drow = 32 * (r >> 4); w.c0 = w.drow; w.nv = 32; w.kb = r & 15; return w; }
    r -= I_OUT;
    const int which = r / I_EXP; r -= which * I_EXP; const int e = r >> 9, q = r & 511, nbg = q >> 4; const size_t eoff = (size_t)(l * NEXP + e) * D * DFF;
    w.N = DFF; w.K = D; w.c0 = 32 * nbg; w.nv = 32; w.kb = q & 15;
    if (which == 0) { w.W = c.w_e_gate + eoff; w.WT = c.ws + wset(l) + WS_WGU + (size_t)e * 2048 * 1024; w.drow = 256 * (nbg >> 2) + 32 * (nbg & 3); }
    else if (which == 1) { w.W = c.w_e_up + eoff; w.WT = c.ws + wset(l) + WS_WGU + (size_t)e * 2048 * 1024; w.drow = 256 * (nbg >> 2) + 128 + 32 * (nbg & 3); }
    else { w.W = c.w_e_down + eoff; w.N = D; w.K = DFF; w.WT = c.ws + wset(l) + WS_WD + (size_t)e * 1024 * 1024; w.drow = 32 * nbg; }
    return w;
}
DI void w_load(const WItem& w, int lane, float (&v)[32]) {
    const int cc = lane & 31, ccl = cc < w.nv ? cc : 0; const GAS float* wp = (const GAS float*)w.W + (size_t)(64 * w.kb + (lane >> 5)) * w.N + w.c0 + ccl;
#pragma unroll
    for (int i = 0; i < 32; ++i) v[i] = wp[(size_t)(2 * i) * w.N];
}
DI void w_store(const WItem& w, int lane, const float (&v)[32], LAS float* scr) {
    const int cc = lane & 31, k0 = 64 * w.kb;
#pragma unroll
    for (int i = 0; i < 32; ++i) scr[(2 * i + (lane >> 5)) * 33 + cc] = (cc < w.nv) ? v[i] : 0.f;
    LDS_WAIT(); asm volatile("" ::: "memory");
    const int c = lane & 7;
#pragma unroll
    for (int j = 0; j < 4; ++j) { const int n = (lane >> 3) + 8 * j; const LAS float* s = scr + (8 * c) * 33 + n;
        u32x2 o; o.x = pk4_fp8(s[0 * 33] * W8_SCALE, s[1 * 33] * W8_SCALE, s[2 * 33] * W8_SCALE, s[3 * 33] * W8_SCALE); o.y = pk4_fp8(s[4 * 33] * W8_SCALE, s[5 * 33] * W8_SCALE, s[6 * 33] * W8_SCALE, s[7 * 33] * W8_SCALE);
        *(GAS u32x2*)(w.WT + (size_t)(w.drow + n) * w.K + k0 + 8 * c) = o; }
    LDS_WAIT(); asm volatile("" ::: "memory");
}
constexpr int W_NITEMS = (NIN / 32) * 16 + 512 + 256 + 512 + 3 * 16 * 512, W_NTK = (W_NITEMS + 31) / 32;
DI void w_tickets(LAS unsigned char* lds, const Ctx& c, int l, int budget) {
    const int tid = ltid(), lane = tid & 63, wave = rfl(tid >> 6);
    LAS float* scr = (LAS float*)(lds + wave * 16384);
    volatile LAS int* TK = (volatile LAS int*)(lds + MISC_OFF + 208);
    GAS unsigned* ctr = (GAS unsigned*)((unsigned*)(c.ws + WS_CTL) + CW_WTK + l * 64);
    float va[32], vb[32]; WItem wa, wb;
    for (int k = 0; k < budget; ++k) {
        __syncthreads();
        if (tid == 0) TK[0] = (int)__hip_atomic_fetch_add(ctr, 1u, __ATOMIC_RELAXED, __HIP_MEMORY_SCOPE_AGENT);
        __syncthreads();
        const int t = rfl(TK[0]); if (t >= W_NTK) break;
        const int i0 = 32 * t + wave, i1 = i0 + 8, i2 = i0 + 16, i3 = i0 + 24;
        if (i0 < W_NITEMS) { wa = w_decode(c, l, i0); w_load(wa, lane, va); }
        if (i1 < W_NITEMS) { wb = w_decode(c, l, i1); w_load(wb, lane, vb); }
        if (i0 < W_NITEMS) w_store(wa, lane, va, scr);
        if (i2 < W_NITEMS) { wa = w_decode(c, l, i2); w_load(wa, lane, va); }
        if (i1 < W_NITEMS) w_store(wb, lane, vb, scr);
        if (i3 < W_NITEMS) { wb = w_decode(c, l, i3); w_load(wb, lane, vb); }
        if (i2 < W_NITEMS) w_store(wa, lane, va, scr);
        if (i3 < W_NITEMS) w_store(wb, lane, vb, scr);
    }
}
DI void phase_w(LAS unsigned char* lds, const Ctx& c, int l, int G) {
    const int tid = ltid();
    w_tickets(lds, c, l, 1 << 30);
    if (l == 0) {
        const size_t n8 = (size_t)T * D / 8; unsigned char* xb = c.ws + WS_XB;
        const size_t st = (size_t)G * NTHREADS;
        for (size_t i0 = (size_t)lbid() * NTHREADS + tid; i0 < n8; i0 += 4 * st) {
            f32x4 a[4], b[4];
#pragma unroll
            for (int q = 0; q < 4; ++q) { const size_t i = i0 + q * st < n8 ? i0 + q * st : i0; a[q] = *(const GAS f32x4*)(c.x + i * 8); b[q] = *(const GAS f32x4*)(c.x + i * 8 + 4); }
#pragma unroll
            for (int q = 0; q < 4; ++q) { const size_t i = i0 + q * st; if (i < n8) { u32x2 o; o.x = pk4_fp8(a[q][0], a[q][1], a[q][2], a[q][3]); o.y = pk4_fp8(b[q][0], b[q][1], b[q][2], b[q][3]); *(GAS u32x2*)(xb + i * 8) = o; } }
        }
    }
}

DI s16x4 tr16(const LAS void* p) { return __builtin_bit_cast(s16x4, __builtin_amdgcn_ds_read_tr16_b64_v4i16((LAS s16x4*)p)); }
DI bf16x8 cat8(s16x4 lo, s16x4 hi) { return __builtin_shufflevector(lo, hi, 0, 1, 2, 3, 4, 5, 6, 7); }
#define MFMA16(a, b, c) __builtin_amdgcn_mfma_f32_16x16x32_bf16((a), (b), (c), 0, 0, 0)

constexpr int REC_BYTES = 33792, REC_KS = 16384, REC_DEC = 32768, OI_BYTES = 16384;
constexpr int GP_QT = 0, GP_KT = 17408, GP_VS = 34816, GP_ATT = 68608, GP_WUP = 77824, GP_BAL = 86016;
DI float exp_(float x) { return __builtin_amdgcn_exp2f(x * LOG2E); }
DI void unpack8(const u32x4& q, float (&v)[16], int o) { v[o] = bf_lo(q.x); v[o + 1] = bf_hi(q.x); v[o + 2] = bf_lo(q.y); v[o + 3] = bf_hi(q.y); v[o + 4] = bf_lo(q.z); v[o + 5] = bf_hi(q.z); v[o + 6] = bf_lo(q.w); v[o + 7] = bf_hi(q.w); }
DI u32x4 packf8(const float (&v)[16], int o) { u32x4 p; p.x = cvt_pk_bf16(v[o], v[o + 1]); p.y = cvt_pk_bf16(v[o + 2], v[o + 3]); p.z = cvt_pk_bf16(v[o + 4], v[o + 5]); p.w = cvt_pk_bf16(v[o + 6], v[o + 7]); return p; }
#define DPP0(x, ctrl, row_mask) __builtin_bit_cast(float, __builtin_amdgcn_update_dpp(0, __builtin_bit_cast(int, (x)), (ctrl), (row_mask), 0xf, false))
DI float scan64(float x) {
    x += DPP0(x, 0x111, 0xf); x += DPP0(x, 0x112, 0xf); x += DPP0(x, 0x114, 0xf); x += DPP0(x, 0x118, 0xf);
    x += DPP0(x, 0x142, 0xa); x += DPP0(x, 0x143, 0xc);
    return x;
}
DI void gla_p_unit(LAS unsigned char* lds, const Ctx& c, int l, int bl, int h, int n, int& h_loaded) {
    const int tid = ltid(), lane = tid & 63, w = rfl(tid >> 6), fr = lane & 15, fq = lane >> 4;
    const size_t tok0 = (size_t)bl * SEQ + n * 64;
    const bf16_t* QG = wsb(c, WS_H + H_QG) + tok0 * 512 + h * 128;
    const bf16_t* KG = wsb(c, WS_H + H_KG) + tok0 * 512 + h * 128;
    const bf16_t* VG = wsb(c, WS_H + H_VG) + tok0 * 1024 + h * 256;
    const float* HA = (const float*)(c.ws + WS_HA) + tok0 * 16;
    const int unit = (bl * 4 + h) * 64 + n;
    unsigned char* rec = c.ws + WS_REC + (size_t)unit * REC_BYTES;
    unsigned char* oi = c.ws + WS_MIX + (size_t)unit * OI_BYTES;
    LAS bf16_t* QT = (LAS bf16_t*)(lds + GP_QT); LAS bf16_t* KT = (LAS bf16_t*)(lds + GP_KT); LAS bf16_t* VS = (LAS bf16_t*)(lds + GP_VS); LAS bf16_t* AT = (LAS bf16_t*)(lds + GP_ATT);
    LAS float* WUP = (LAS float*)(lds + GP_WUP); LAS float* BAL = (LAS float*)(lds + GP_BAL);
    __syncthreads();
    if (h_loaded != h) { for (int i = tid; i < 16 * 128; i += NTHREADS) WUP[i] = ((const GAS float*)c.w_alpha_up)[(size_t)l * 16 * 512 + (i >> 7) * 512 + h * 128 + (i & 127)];
        if (tid < 128) BAL[tid] = ((const GAS float*)c.b_alpha)[l * 512 + h * 128 + tid]; h_loaded = h; __syncthreads(); }
    {
        const int row = lane;
        f32x4 a4[4];
#pragma unroll
        for (int j = 0; j < 4; ++j) a4[j] = *(const GAS f32x4*)(HA + (size_t)row * 16 + 4 * j);
        const u32x4 q0 = *(const GAS u32x4*)(QG + (size_t)row * 512 + 16 * w), q1 = *(const GAS u32x4*)(QG + (size_t)row * 512 + 16 * w + 8);
        const u32x4 k0 = *(const GAS u32x4*)(KG + (size_t)row * 512 + 16 * w), k1 = *(const GAS u32x4*)(KG + (size_t)row * 512 + 16 * w + 8);
#pragma unroll
        for (int c2 = 0; c2 < 4; ++c2) { const int idx = tid + NTHREADS * c2, r = idx >> 5, ch = idx & 31; *(LAS u32x4*)(VS + r * 264 + ch * 8) = *(const GAS u32x4*)(VG + (size_t)r * 1024 + ch * 8); }
        float la[16];
        {
            f32x2 la2[8];
#pragma unroll
            for (int c2 = 0; c2 < 8; ++c2) la2[c2] = *(const LAS f32x2*)(BAL + 16 * w + 2 * c2);
#pragma unroll
            for (int j = 0; j < 16; ++j) { const float aj = a4[j >> 2][j & 3]; const f32x2 aj2 = (f32x2){aj, aj};
#pragma unroll
                for (int c4 = 0; c4 < 4; ++c4) { const f32x4 wv = *(const LAS f32x4*)(WUP + j * 128 + 16 * w + 4 * c4); la2[2 * c4] = aj2 * __builtin_shufflevector(wv, wv, 0, 1) + la2[2 * c4]; la2[2 * c4 + 1] = aj2 * __builtin_shufflevector(wv, wv, 2, 3) + la2[2 * c4 + 1]; } }
#pragma unroll
            for (int c2 = 0; c2 < 8; ++c2) { la[2 * c2] = la2[c2][0]; la[2 * c2 + 1] = la2[c2][1]; }
        }
#pragma unroll
        for (int cc = 0; cc < 16; ++cc) { const float z = la[cc]; la[cc] = -(fmaxf(-z, 0.f) + __builtin_amdgcn_logf(1.0f + exp_(-fabsf(z))) * 0.6931471805599453f) * (1.0f / 16.0f); }
#pragma unroll
        for (int cc = 0; cc < 16; ++cc) la[cc] = scan64(la[cc]);
        float qv[16], kv[16];
        unpack8(q0, qv, 0); unpack8(q1, qv, 8); unpack8(k0, kv, 0); unpack8(k1, kv, 8);
        float dc[16];
#pragma unroll
        for (int cc = 0; cc < 16; ++cc) { const float b = la[cc]; const float bend = __shfl(b, 63); const float eb = exp_(b); dc[cc] = eb; qv[cc] *= eb; la[cc] = kv[cc] * exp_(bend - b); kv[cc] *= exp_(-b); }
        if (lane == 63) {
#pragma unroll
            for (int c4 = 0; c4 < 4; ++c4) *(GAS f32x4*)(rec + REC_DEC + (16 * w + 4 * c4) * 4) = (f32x4){dc[4 * c4], dc[4 * c4 + 1], dc[4 * c4 + 2], dc[4 * c4 + 3]}; }
        const u32x4 qa = packf8(qv, 0), qb = packf8(qv, 8), ka = packf8(kv, 0), kb = packf8(kv, 8), sa = packf8(la, 0), sb = packf8(la, 8);
        *(LAS u32x4*)(QT + row * 136 + 16 * w) = qa; *(LAS u32x4*)(QT + row * 136 + 16 * w + 8) = qb;
        *(LAS u32x4*)(KT + row * 136 + 16 * w) = ka; *(LAS u32x4*)(KT + row * 136 + 16 * w + 8) = kb;
        *(GAS u32x4*)(rec + row * 256 + (((2 * w) ^ (row & 15)) << 4)) = qa; *(GAS u32x4*)(rec + row * 256 + (((2 * w + 1) ^ (row & 15)) << 4)) = qb;
        *(GAS u32x4*)(rec + REC_KS + row * 256 + (((2 * w) ^ (2 * (row & 7))) << 4)) = sa; *(GAS u32x4*)(rec + REC_KS + row * 256 + (((2 * w + 1) ^ (2 * (row & 7))) << 4)) = sb;
    }
    __syncthreads();
#pragma unroll
    for (int rep = 0; rep < 2; ++rep) {
        const int tt = w + 8 * rep, jt = tt >> 2, it = tt & 3;
        f32x4 a = (f32x4){0.f, 0.f, 0.f, 0.f};
        if (jt <= it) {
#pragma unroll
            for (int k4 = 0; k4 < 4; ++k4) { const bf16x8 af = *(const LAS bf16x8*)(KT + (16 * jt + fr) * 136 + 32 * k4 + 8 * fq), bfr = *(const LAS bf16x8*)(QT + (16 * it + fr) * 136 + 32 * k4 + 8 * fq); a = MFMA16(af, bfr, a); }
        }
        const int i = 16 * it + fr, j0 = 16 * jt + 4 * fq;
        u32x2 o; o.x = cvt_pk_bf16(j0 <= i ? a[0] : 0.f, j0 + 1 <= i ? a[1] : 0.f); o.y = cvt_pk_bf16(j0 + 2 <= i ? a[2] : 0.f, j0 + 3 <= i ? a[3] : 0.f);
        *(LAS u32x2*)(AT + i * 72 + j0) = o;
    }
    __syncthreads();
    {
        const int dv0 = 32 * w;
        bf16x8 vb[2][2];
#pragma unroll
        for (int k2 = 0; k2 < 2; ++k2)
#pragma unroll
            for (int dt = 0; dt < 2; ++dt) { const LAS bf16_t* p = VS + (32 * k2 + 8 * fq + (fr >> 2)) * 264 + dv0 + 16 * dt + (fr & 3) * 4; vb[k2][dt] = cat8(tr16(p), tr16(p + 4 * 264)); }
#pragma unroll
        for (int tt = 0; tt < 4; ++tt) {
            const bf16x8 a0 = *(const LAS bf16x8*)(AT + (16 * tt + fr) * 72 + 8 * fq), a1 = *(const LAS bf16x8*)(AT + (16 * tt + fr) * 72 + 32 + 8 * fq);
#pragma unroll
            for (int dt = 0; dt < 2; ++dt) { f32x4 z = (f32x4){0.f, 0.f, 0.f, 0.f}; z = MFMA16(vb[0][dt], a0, z); z = MFMA16(vb[1][dt], a1, z);
                *(GAS unsigned*)(oi + ((w * 8 + tt * 2 + dt) * 64 + lane) * 4) = pk4_fp8(z[0], z[1], z[2], z[3]); }
        }
    }
}
constexpr int GSEG = 16, NSEG = 64 / GSEG;
constexpr int GL_STAGE = 50176, GL_DEC = 16384, GL_VS = 17408;
static_assert(3 * GL_STAGE <= MISC_OFF, "light-chain stages");
DI void gla_l_chain(LAS unsigned char* lds, const Ctx& c, int bl, int h, int seg) {
    const int tid = ltid(), lane = tid & 63, w = rfl(tid >> 6), fr = lane & 15, fq = lane >> 4;
    const size_t t0 = (size_t)bl * SEQ + (size_t)seg * (GSEG * 64);
    const bf16_t* VG = wsb(c, WS_H + H_VG) + t0 * 1024 + h * 256;
    const unsigned char* rec0 = c.ws + WS_REC + (size_t)((bl * 4 + h) * 64 + seg * GSEG) * REC_BYTES;
    const int dv0 = 32 * w; const unsigned lds_u = (unsigned)(uintptr_t)lds;
    f32x4 S[8][2], Dc[8];
#pragma unroll
    for (int a = 0; a < 8; ++a) { S[a][0] = (f32x4){0.f, 0.f, 0.f, 0.f}; S[a][1] = (f32x4){0.f, 0.f, 0.f, 0.f}; Dc[a] = (f32x4){1.f, 1.f, 1.f, 1.f}; }
#define GL_DMA(gp, ldsoff) do { unsigned _sv; const unsigned _m = (unsigned)__builtin_amdgcn_readfirstlane((int)(ldsoff)); \
        asm volatile("s_mov_b32 %0, m0\n\ts_mov_b32 m0, %2\n\ts_nop 0\n\tglobal_load_lds_dwordx4 %1, off\n\ts_mov_b32 m0, %0" : "=&s"(_sv) : "v"(gp), "s"(_m) : "memory"); } while (0)
#define GL_PREFETCH(nn, st) do { const unsigned char* _r = rec0 + (size_t)(nn) * REC_BYTES + REC_KS; const unsigned _s = lds_u + (unsigned)(st) * GL_STAGE; \
        _Pragma("unroll") for (int _p = 0; _p < 2; ++_p) GL_DMA((const GAS unsigned char*)(_r + (w * 2 + _p) * 1024 + lane * 16), _s + (w * 2 + _p) * 1024); \
        if (w == 0) GL_DMA((const GAS unsigned char*)(_r + 16384 + lane * 16), _s + GL_DEC); \
        _Pragma("unroll") for (int _p = 0; _p < 4; ++_p) { const int _row = 2 * (w * 4 + _p) + (lane >> 5); \
            GL_DMA((const GAS bf16_t*)(VG + (size_t)((nn) * 64 + _row) * 1024 + (((lane & 31) ^ (2 * (_row & 3))) << 3)), _s + GL_VS + (w * 4 + _p) * 1024); } } while (0)
    __syncthreads();
    GL_PREFETCH(0, 0); GL_PREFETCH(1, 1);
    int st = 0;
    for (int n = 0; n < GSEG; ++n) {
        LAS unsigned char* sb_ = lds + st * GL_STAGE;
        LAS bf16_t* KS = (LAS bf16_t*)sb_; LAS float* DEC = (LAS float*)(sb_ + GL_DEC); LAS bf16_t* VS = (LAS bf16_t*)(sb_ + GL_VS);
        if (n + 1 < GSEG) { if (w == 0) asm volatile("s_waitcnt vmcnt(7)" ::: "memory"); else asm volatile("s_waitcnt vmcnt(6)" ::: "memory"); } else VM_WAIT();
        asm volatile("s_waitcnt lgkmcnt(0)" ::: "memory"); __builtin_amdgcn_s_barrier(); asm volatile("" ::: "memory");
        if (n + 2 < GSEG) GL_PREFETCH(n + 2, st == 0 ? 2 : st - 1);
        bf16x8 vb[2][2];
#pragma unroll
        for (int k2 = 0; k2 < 2; ++k2)
#pragma unroll
            for (int dt = 0; dt < 2; ++dt) { const int r0 = 32 * k2 + 8 * fq + (fr >> 2);
                const LAS bf16_t* p = VS + r0 * 256 + ((((dv0 + 16 * dt) >> 3) ^ (2 * (r0 & 3))) << 3) + (fr & 3) * 4; vb[k2][dt] = cat8(tr16(p), tr16(p + 4 * 256)); }
#pragma unroll
        for (int k8 = 0; k8 < 8; ++k8) {
            const f32x4 dc = *(const LAS f32x4*)(DEC + 16 * k8 + 4 * fq);
            S[k8][0] *= dc; S[k8][1] *= dc; Dc[k8] *= dc;
#pragma unroll
            for (int k2 = 0; k2 < 2; ++k2) { const int r0 = 32 * k2 + 8 * fq + (fr >> 2);
                const LAS bf16_t* p0 = KS + r0 * 128 + (((2 * k8) ^ (2 * (r0 & 7))) << 3) + (fr & 3) * 4; const LAS bf16_t* p1 = KS + (r0 + 4) * 128 + (((2 * k8) ^ (2 * ((r0 + 4) & 7))) << 3) + (fr & 3) * 4;
                const bf16x8 af = cat8(tr16(p0), tr16(p1));
                S[k8][0] = MFMA16(af, vb[k2][0], S[k8][0]); S[k8][1] = MFMA16(af, vb[k2][1], S[k8][1]); }
        }
        st = st == 2 ? 0 : st + 1;
    }
#undef GL_PREFETCH
#undef GL_DMA
    const int cj = (bl * 4 + h) * NSEG + seg;
    GAS f32x4* sl = (GAS f32x4*)(c.ws + WS_SLOC) + ((size_t)(cj * 8 + w) * 16) * 64 + lane;
#pragma unroll
    for (int a = 0; a < 8; ++a) { sl[(a * 2) * 64] = S[a][0]; sl[(a * 2 + 1) * 64] = S[a][1]; }
    if (w == 0) { GAS f32x4* dq = (GAS f32x4*)(c.ws + WS_DCUM) + (size_t)cj * 8 * 64 + lane;
#pragma unroll
        for (int a = 0; a < 8; ++a) dq[a * 64] = Dc[a]; }
    VM_WAIT(); __syncthreads();
}
constexpr int GS_STAGE = 66560, GS_KS = 16384, GS_DEC = 32768, GS_VS = 33792, GS_SS = 2 * GS_STAGE;
DI void gla_s_chain(LAS unsigned char* lds, const Ctx& c, int l, int bl, int h, int seg) {
    const int tid = ltid(), lane = tid & 63, w = rfl(tid >> 6), fr = lane & 15, fq = lane >> 4;
    const size_t t0 = (size_t)bl * SEQ + (size_t)seg * (GSEG * 64);
    const bf16_t* VG = wsb(c, WS_H + H_VG) + t0 * 1024 + h * 256;
    const unsigned char* SR = c.ws + WS_H + H_SR + t0 * 1024 + h * 256;
    unsigned char* OG = c.ws + WS_OG + t0 * 1024 + h * 256;
    const unsigned char* rec0 = c.ws + WS_REC + (size_t)((bl * 4 + h) * 64 + seg * GSEG) * REC_BYTES;
    const unsigned char* oi0 = c.ws + WS_MIX + (size_t)((bl * 4 + h) * 64 + seg * GSEG) * OI_BYTES;
    LAS float* SS = (LAS float*)(lds + GS_SS);
    const int dv0 = 32 * w;
    f32x4 gnv[2]; gnv[0] = *(const GAS f32x4*)(c.gla_norm + l * 1024 + h * 256 + dv0 + 4 * fq); gnv[1] = *(const GAS f32x4*)(c.gla_norm + l * 1024 + h * 256 + dv0 + 16 + 4 * fq);
    f32x4 S[8][2];
#pragma unroll
    for (int a = 0; a < 8; ++a) { S[a][0] = (f32x4){0.f, 0.f, 0.f, 0.f}; S[a][1] = (f32x4){0.f, 0.f, 0.f, 0.f}; }
    for (int j = 0; j < seg; ++j) {
        const int cj = (bl * 4 + h) * NSEG + j;
        const GAS f32x4* sl = (const GAS f32x4*)(c.ws + WS_SLOC) + ((size_t)(cj * 8 + w) * 16) * 64 + lane; const GAS f32x4* dq = (const GAS f32x4*)(c.ws + WS_DCUM) + (size_t)cj * 8 * 64 + lane;
#pragma unroll
        for (int a = 0; a < 8; ++a) { const f32x4 dcv = dq[a * 64]; S[a][0] = S[a][0] * dcv + sl[(a * 2) * 64]; S[a][1] = S[a][1] * dcv + sl[(a * 2 + 1) * 64]; }
    }
#define GS_DMA(gp, ldsoff) do { unsigned _sv; const unsigned _m = (unsigned)__builtin_amdgcn_readfirstlane((int)(ldsoff)); \
        asm volatile("s_mov_b32 %0, m0\n\ts_mov_b32 m0, %2\n\ts_nop 0\n\tglobal_load_lds_dwordx4 %1, off\n\ts_mov_b32 m0, %0" : "=&s"(_sv) : "v"(gp), "s"(_m) : "memory"); } while (0)
#define GS_PREFETCH(nn, st) do { const unsigned char* _r = rec0 + (size_t)(nn) * REC_BYTES; const unsigned _s = lds_u + (unsigned)(st) * GS_STAGE; \
        _Pragma("unroll") for (int _p = 0; _p < 4; ++_p) GS_DMA((const GAS unsigned char*)(_r + (w * 4 + _p) * 1024 + lane * 16), _s + (w * 4 + _p) * 1024); \
        if (w == 0) GS_DMA((const GAS unsigned char*)(_r + 32768 + lane * 16), _s + 32768); \
        _Pragma("unroll") for (int _p = 0; _p < 4; ++_p) { const int _row = 2 * (w * 4 + _p) + (lane >> 5); \
            GS_DMA((const GAS bf16_t*)(VG + (size_t)((nn) * 64 + _row) * 1024 + (((lane & 31) ^ (2 * (_row & 3))) << 3)), _s + GS_VS + (w * 4 + _p) * 1024); } } while (0)
    const unsigned lds_u = (unsigned)(uintptr_t)lds;
#define GS_BAR() do { asm volatile("s_waitcnt lgkmcnt(0)" ::: "memory"); __builtin_amdgcn_s_barrier(); asm volatile("" ::: "memory"); } while (0)
#define GS_HEAD(n_) do { \
        _Pragma("unroll") for (int q = 0; q < 8; ++q) oiv[q] = *(const GAS unsigned*)(oi0 + (size_t)(n_) * OI_BYTES + ((w * 8 + q) * 64 + lane) * 4); \
        if ((n_) > 0) { _Pragma("unroll") for (int q = 0; q < 8; ++q) srv[q] = *(const GAS unsigned*)(SR + (size_t)(((n_) - 1) * 64 + 16 * (q >> 1) + fr) * 1024 + dv0 + 16 * (q & 1) + 4 * fq); }     \
        asm volatile("" ::: "memory"); \
        if ((n_) + 1 < GSEG) GS_PREFETCH((n_) + 1, (((n_) & 1) ^ 1)); } while (0)
#define GS_MAIN(n_) do { \
        LAS unsigned char* sb_ = lds + ((n_) & 1) * GS_STAGE; LAS float* SSn = SS + ((n_) & 1) * 512; \
        LAS bf16_t* QT = (LAS bf16_t*)sb_; LAS bf16_t* KS = (LAS bf16_t*)(sb_ + GS_KS); LAS float* DEC = (LAS float*)(sb_ + GS_DEC); LAS bf16_t* VS = (LAS bf16_t*)(sb_ + GS_VS); \
        bf16x8 vb[2][2]; \
        _Pragma("unroll") for (int k2 = 0; k2 < 2; ++k2) _Pragma("unroll") for (int dt = 0; dt < 2; ++dt) { const int r0 = 32 * k2 + 8 * fq + (fr >> 2); \
            const LAS bf16_t* p = VS + r0 * 256 + ((((dv0 + 16 * dt) >> 3) ^ (2 * (r0 & 3))) << 3) + (fr & 3) * 4; vb[k2][dt] = cat8(tr16(p), tr16(p + 4 * 256)); } \
        _Pragma("unroll") for (int tt = 0; tt < 4; ++tt) { o[tt][0] = (f32x4){0.f, 0.f, 0.f, 0.f}; o[tt][1] = (f32x4){0.f, 0.f, 0.f, 0.f}; } \
        _Pragma("unroll") for (int s = 0; s < 4; ++s) { \
            bf16x8 sb[2]; \
            _Pragma("unroll") for (int dt = 0; dt < 2; ++dt) { u32x4 pk; pk.x = cvt_pk_bf16(S[2 * s][dt][0], S[2 * s][dt][1]); pk.y = cvt_pk_bf16(S[2 * s][dt][2], S[2 * s][dt][3]); pk.z = cvt_pk_bf16(S[2 * s + 1][dt][0], S[2 * s + 1][dt][1]); pk.w = cvt_pk_bf16(S[2 * s + 1][dt][2], S[2 * s + 1][dt][3]); sb[dt] = __builtin_bit_cast(bf16x8, pk); } \
            _Pragma("unroll") for (int tt = 0; tt < 4; ++tt) { const int i = 16 * tt + fr; \
                const LAS bf16_t* qp = QT + i * 128 + (fq & 1) * 4; \
                const bf16x8 af = cat8(*(const LAS s16x4*)(qp + (((4 * s + (fq >> 1)) ^ (i & 15)) << 3)), *(const LAS s16x4*)(qp + (((4 * s + 2 + (fq >> 1)) ^ (i & 15)) << 3))); \
                o[tt][0] = MFMA16(sb[0], af, o[tt][0]); o[tt][1] = MFMA16(sb[1], af, o[tt][1]); } \
        } \
        _Pragma("unroll") for (int k8 = 0; k8 < 8; ++k8) { \
            const f32x4 dc = *(const LAS f32x4*)(DEC + 16 * k8 + 4 * fq); \
            S[k8][0] *= dc; S[k8][1] *= dc; \
            _Pragma("unroll") for (int k2 = 0; k2 < 2; ++k2) { const int r0 = 32 * k2 + 8 * fq + (fr >> 2); \
                const LAS bf16_t* p0 = KS + r0 * 128 + (((2 * k8) ^ (2 * (r0 & 7))) << 3) + (fr & 3) * 4; const LAS bf16_t* p1 = KS + (r0 + 4) * 128 + (((2 * k8) ^ (2 * ((r0 + 4) & 7))) << 3) + (fr & 3) * 4; \
                const bf16x8 af = cat8(tr16(p0), tr16(p1)); \
                S[k8][0] = MFMA16(af, vb[k2][0], S[k8][0]); S[k8][1] = MFMA16(af, vb[k2][1], S[k8][1]); } \
        } \
        _Pragma("unroll") for (int tt = 0; tt < 4; ++tt) _Pragma("unroll") for (int dt = 0; dt < 2; ++dt) { const f32x2 a = __builtin_amdgcn_cvt_pk_f32_fp8((int)oiv[tt * 2 + dt], false), b = __builtin_amdgcn_cvt_pk_f32_fp8((int)oiv[tt * 2 + dt], true); o[tt][dt][0] += a[0]; o[tt][dt][1] += a[1]; o[tt][dt][2] += b[0]; o[tt][dt][3] += b[1]; } \
        {     \
            f32x4 pp; \
            _Pragma("unroll") for (int tt = 0; tt < 4; ++tt) { const f32x4 a = o[tt][0] * o[tt][0] + o[tt][1] * o[tt][1]; float p = (a[0] + a[1]) + (a[2] + a[3]); p += __shfl_xor(p, 16); p += __shfl_xor(p, 32); pp[tt] = p; } \
            if (fq == 0) { SSn[(0 * 16 + fr) * 8 + w] = pp[0]; SSn[(1 * 16 + fr) * 8 + w] = pp[1]; SSn[(2 * 16 + fr) * 8 + w] = pp[2]; SSn[(3 * 16 + fr) * 8 + w] = pp[3]; }     \
        } } while (0)
#define GS_TAIL(m_) do { const LAS float* SSm = SS + ((m_) & 1) * 512; \
        _Pragma("unroll") for (int tt = 0; tt < 4; ++tt) { const f32x4 s0 = *(const LAS f32x4*)(SSm + (16 * tt + fr) * 8), s1 = *(const LAS f32x4*)(SSm + (16 * tt + fr) * 8 + 4); \
            const float ss = ((s0[0] + s0[1]) + (s0[2] + s0[3])) + ((s1[0] + s1[1]) + (s1[2] + s1[3])); const float rs = __builtin_amdgcn_rsqf(ss * (1.0f / 256.0f) + RMS_EPS); \
            _Pragma("unroll") for (int dt = 0; dt < 2; ++dt) { const f32x2 sa = __builtin_amdgcn_cvt_pk_f32_fp8((int)srv[tt * 2 + dt], false), sb2 = __builtin_amdgcn_cvt_pk_f32_fp8((int)srv[tt * 2 + dt], true); const f32x4 g = gnv[dt]; const u32x2 ok = opk[tt][dt]; const f32x4 v = (f32x4){bf_lo(ok.x), bf_hi(ok.x), bf_lo(ok.y), bf_hi(ok.y)} * rs; \
                *(GAS unsigned*)(OG + (size_t)((m_) * 64 + 16 * tt + fr) * 1024 + dv0 + 16 * dt + 4 * fq) = pk4_fp8(v[0] * g[0] * sa[0], v[1] * g[1] * sa[1], v[2] * g[2] * sb2[0], v[3] * g[3] * sb2[1]); } } } while (0)
#define GS_KEEP() do { _Pragma("unroll") for (int tt = 0; tt < 4; ++tt) _Pragma("unroll") for (int dt = 0; dt < 2; ++dt) { opk[tt][dt].x = cvt_pk_bf16(o[tt][dt][0], o[tt][dt][1]); opk[tt][dt].y = cvt_pk_bf16(o[tt][dt][2], o[tt][dt][3]); } } while (0)
    f32x4 o[4][2]; u32x2 opk[4][2]; unsigned oiv[8], srv[8];
    __syncthreads();
    GS_PREFETCH(0, 0);
    VM_WAIT(); GS_BAR();
    GS_HEAD(0); GS_MAIN(0); GS_KEEP();
    for (int n = 1; n < GSEG; ++n) {
        if (n == 1) VM_WAIT(); else asm volatile("s_waitcnt vmcnt(8)" ::: "memory");
        GS_BAR();
        GS_HEAD(n);
        GS_MAIN(n);
        GS_TAIL(n - 1);
        GS_KEEP();
    }
#pragma unroll
    for (int q = 0; q < 8; ++q) srv[q] = *(const GAS unsigned*)(SR + (size_t)((GSEG - 1) * 64 + 16 * (q >> 1) + fr) * 1024 + dv0 + 16 * (q & 1) + 4 * fq);
    GS_BAR();
    GS_TAIL(GSEG - 1);
#undef GS_HEAD
#undef GS_MAIN
#undef GS_TAIL
#undef GS_KEEP
#undef GS_PREFETCH
#undef GS_DMA
#undef GS_BAR
    VM_WAIT(); __syncthreads();
}

constexpr int AT_K = 0, AT_V = 55296;
struct APre { u32x2 k[6], v[6], q[2][2]; };
DI u32x4 fp8x8_to_bf16(const u32x2 w) { const f32x2 a = __builtin_amdgcn_cvt_pk_f32_fp8((int)w.x, false), b = __builtin_amdgcn_cvt_pk_f32_fp8((int)w.x, true), c_ = __builtin_amdgcn_cvt_pk_f32_fp8((int)w.y, false), d = __builtin_amdgcn_cvt_pk_f32_fp8((int)w.y, true);
    u32x4 o; o.x = cvt_pk_bf16(a[0], a[1]); o.y = cvt_pk_bf16(b[0], b[1]); o.z = cvt_pk_bf16(c_[0], c_[1]); o.w = cvt_pk_bf16(d[0], d[1]); return o; }
struct AUnit { int dl, n, colo; unsigned tb, slab; };
DI AUnit attn_decode(int u) { AUnit a; const int bl = u / 768, g = (u / 256) % 3, h = (u >> 5) & 7, x = u & 31; a.dl = (g == 0) ? 1 : (g == 1 ? 4 : 16); const int nb = 32 / a.dl, r = x / nb; a.n = x - r * nb; a.tb = (unsigned)(bl * SEQ + r); a.colo = g * 512 + h * 64; a.slab = (unsigned)(((g * 8 + h) * 8 + bl) * SEQ + r * (SEQ / a.dl)) * 64u; return a; }
DI void attn_load(const Ctx& c, int u, APre& p) {
    const int tid = ltid(), lane = tid & 63, w = rfl(tid >> 6), fr = lane & 15, fq = lane >> 4; const AUnit a = attn_decode(u);
    const GAS char* Q = (const GAS char*)(c.ws + WS_H + H_QD) + a.slab; const GAS char* K = (const GAS char*)(c.ws + WS_H + H_KD) + a.slab; const GAS char* V = (const GAS char*)(c.ws + WS_H + H_VD) + a.slab;
#pragma unroll
    for (int b = 0; b < 2; ++b) { const unsigned jq = (unsigned)(128 * (a.n + b) + 16 * w + fr);
#pragma unroll
        for (int d0 = 0; d0 < 2; ++d0) p.q[b][d0] = *(const GAS u32x2*)(Q + (jq * 64u + (unsigned)(32 * d0 + 8 * fq))); }
#pragma unroll
    for (int c2 = 0; c2 < 6; ++c2) { const int idx = tid + NTHREADS * c2, row = idx >> 3, ch = idx & 7; const int j = 128 * (a.n - 1) + row;
        p.k[c2] = (u32x2){0u, 0u}; p.v[c2] = (u32x2){0u, 0u};
        if (j >= 0) { const unsigned off = (unsigned)j * 64u + (unsigned)(ch * 8); p.k[c2] = *(const GAS u32x2*)(K + off); p.v[c2] = *(const GAS u32x2*)(V + off); } }
}
DI void attn_stage(LAS unsigned char* lds, const APre& p) {
    const int tid = ltid(); LAS bf16_t* Ks = (LAS bf16_t*)(lds + AT_K); LAS bf16_t* Vs = (LAS bf16_t*)(lds + AT_V);
#pragma unroll
    for (int c2 = 0; c2 < 6; ++c2) { const int o = (tid >> 3) * 72 + (tid & 7) * 8 + c2 * (64 * 72); *(LAS u32x4*)(Ks + o) = fp8x8_to_bf16(p.k[c2]); *(LAS u32x4*)(Vs + o) = fp8x8_to_bf16(p.v[c2]); }
}
DI void attn_compute(LAS unsigned char* lds, const Ctx& c, int u, const bf16x8 (&qf)[2][2]) {
    const int tid = ltid(), lane = tid & 63, w = rfl(tid >> 6), fr = lane & 15, fq = lane >> 4; const AUnit au = attn_decode(u);
    const int dl = au.dl, n = au.n, g = (u / 256) % 3, h = (u >> 5) & 7; const unsigned tb = au.tb;
    LAS bf16_t* Ks = (LAS bf16_t*)(lds + AT_K); LAS bf16_t* Vs = (LAS bf16_t*)(lds + AT_V);
#pragma unroll
    for (int b = 0; b < 2; ++b) {
        const int kt0 = 8 * b + w;
        const LAS bf16_t* kbase = Ks + (16 * w + fr) * 72 + 8 * fq + b * (128 * 72);
        const LAS bf16_t* vbase = Vs + (16 * w + 4 * fq + (fr >> 2)) * 72 + (fr & 3) * 4 + b * (128 * 72);
        f32x4 s[9]; float m = -1e30f;
#pragma unroll
        for (int kr = 0; kr < 9; ++kr) { const int kt = kt0 + kr; f32x4 a = (f32x4){0.f, 0.f, 0.f, 0.f};
#pragma unroll
            for (int d0 = 0; d0 < 2; ++d0) { const bf16x8 af = *(const LAS bf16x8*)(kbase + kr * (16 * 72) + 32 * d0); a = MFMA16(af, qf[b][d0], a); }
#pragma unroll
            for (int rg = 0; rg < 4; ++rg) { const bool tile_ok = (b > 0) || (n > 0) || (kt >= 8);
                bool ok = tile_ok; if (kr == 0) ok = ok && (4 * fq + rg >= fr); if (kr == 8) ok = ok && (4 * fq + rg <= fr);
                a[rg] = ok ? a[rg] : -1e30f; m = fmaxf(m, a[rg]); }
            s[kr] = a; }
        m = fmaxf(m, __shfl_xor(m, 16)); m = fmaxf(m, __shfl_xor(m, 32));
        f32x4 ls4 = (f32x4){0.f, 0.f, 0.f, 0.f}; const f32x4 m4 = (f32x4){m, m, m, m};
#pragma unroll
        for (int kr = 0; kr < 9; ++kr) { const f32x4 d = s[kr] - m4;
            s[kr] = (f32x4){__builtin_amdgcn_exp2f(d[0]), __builtin_amdgcn_exp2f(d[1]), __builtin_amdgcn_exp2f(d[2]), __builtin_amdgcn_exp2f(d[3])}; ls4 += s[kr]; }
        float lsum = (ls4[0] + ls4[1]) + (ls4[2] + ls4[3]);
        lsum += __shfl_xor(lsum, 16); lsum += __shfl_xor(lsum, 32);
        f32x4 oT[4];
#pragma unroll
        for (int dt = 0; dt < 4; ++dt) oT[dt] = (f32x4){0.f, 0.f, 0.f, 0.f};
#pragma unroll
        for (int pp = 0; pp < 5; ++pp) { const int ka = 2 * pp, kb = (2 * pp + 1 < 9) ? 2 * pp + 1 : 8;
            u32x4 pk; pk.x = cvt_pk_bf16(s[ka][0], s[ka][1]); pk.y = cvt_pk_bf16(s[ka][2], s[ka][3]);
            if (2 * pp + 1 < 9) { pk.z = cvt_pk_bf16(s[kb][0], s[kb][1]); pk.w = cvt_pk_bf16(s[kb][2], s[kb][3]); } else { pk.z = 0u; pk.w = 0u; }
            const bf16x8 pf = __builtin_bit_cast(bf16x8, pk);
#pragma unroll
            for (int dt = 0; dt < 4; ++dt) { const LAS bf16_t* pa = vbase + ka * (16 * 72) + 16 * dt; const LAS bf16_t* pb = vbase + kb * (16 * 72) + 16 * dt;
                oT[dt] = MFMA16(cat8(tr16(pa), tr16(pb)), pf, oT[dt]); } }
        const float inv = 1.0f / lsum; const unsigned tq = tb + (unsigned)dl * (unsigned)(128 * (n + b) + 16 * w + fr), gt = (unsigned)(g * TH) + tq;
        GAS char* op = (GAS char*)(c.ws + WS_ATTG) + (gt * 512u + (unsigned)(h * 64 + 4 * fq));
#pragma unroll
        for (int dt = 0; dt < 4; ++dt) *(GAS unsigned*)(op + 16 * dt) = pk4_fp8(oT[dt][0] * inv, oT[dt][1] * inv, oT[dt][2] * inv, oT[dt][3] * inv);
        if (fq == 0) *(GAS float*)((GAS char*)(c.ws + WS_LSE) + (gt * 32u + (unsigned)(h * 4))) = m + __builtin_amdgcn_logf(lsum);
    }
}
DI void phase_p(LAS unsigned char* lds, const Ctx& c, int l, int G) {
    int h_loaded = -1;
    for (int u = lbid(); u < 8 * 4 * 64; u += G) gla_p_unit(lds, c, l, u >> 8, (u >> 6) & 3, u & 63, h_loaded);
}
constexpr int NATT = 8 * 3 * 8 * 32, NATT1 = 1536, NCHAIN = 8 * 4 * NSEG;
#define AT_BAR() do { asm volatile("s_waitcnt lgkmcnt(0)" ::: "memory"); __builtin_amdgcn_s_barrier(); asm volatile("" ::: "memory"); } while (0)
DI void attn_pull(LAS unsigned char* lds, const Ctx& c, unsigned* ctr, int base, int limit) {
    volatile LAS int* TK = (volatile LAS int*)(lds + MISC_OFF + 192);
    const int tid = ltid();
    __syncthreads();
    if (tid == 0) { TK[0] = base + 2 * (int)__hip_atomic_fetch_add((GAS unsigned*)ctr, 1u, __ATOMIC_RELAXED, __HIP_MEMORY_SCOPE_AGENT); TK[1] = base + 2 * (int)__hip_atomic_fetch_add((GAS unsigned*)ctr, 1u, __ATOMIC_RELAXED, __HIP_MEMORY_SCOPE_AGENT);
        TK[2] = base + 2 * (int)__hip_atomic_fetch_add((GAS unsigned*)ctr, 1u, __ATOMIC_RELAXED, __HIP_MEMORY_SCOPE_AGENT); }
    __syncthreads();
    int cur = rfl(TK[0]), nxt = rfl(TK[1]);
    APre pre;
    if (cur < limit) attn_load(c, cur, pre);
    while (cur < limit) {
        AT_BAR();
        const int nxt2 = rfl(TK[2]);
        attn_stage(lds, pre);
        bf16x8 qf[2][2];
#pragma unroll
        for (int b = 0; b < 2; ++b)
#pragma unroll
            for (int d0 = 0; d0 < 2; ++d0) qf[b][d0] = __builtin_bit_cast(bf16x8, fp8x8_to_bf16(pre.q[b][d0]));
        AT_BAR();
        if (nxt < limit) attn_load(c, nxt, pre);
        int req = 0; if (tid == 0) req = base + 2 * (int)__hip_atomic_fetch_add((GAS unsigned*)ctr, 1u, __ATOMIC_RELAXED, __HIP_MEMORY_SCOPE_AGENT);
        attn_compute(lds, c, cur, qf);
        if (tid == 0) TK[2] = req;
        cur = nxt; nxt = nxt2;
    }
}
DI void phase_b1(LAS unsigned char* lds, const Ctx& c, int l, int hf, int G) {
    const int bid = lbid(); unsigned* ctr = (unsigned*)(c.ws + WS_CTL) + CW_TKT + ((l * 2 + hf) * 2) * 64;
    for (int id = bid; id < NCHAIN; id += G) if ((id & 3) != NSEG - 1) gla_l_chain(lds, c, id >> 4, (id >> 2) & 3, id & 3);
    attn_pull(lds, c, ctr, 0, NATT1);
}
DI void phase_b(LAS unsigned char* lds, const Ctx& c, int l, int hf, int G) {
    const int bid = lbid(); unsigned* ctr = (unsigned*)(c.ws + WS_CTL) + CW_TKT + ((l * 2 + hf) * 2 + 1) * 64;
    for (int id = bid; id < NCHAIN; id += G) gla_s_chain(lds, c, l, id >> 4, (id >> 2) & 3, id & 3);
    attn_pull(lds, c, ctr, NATT1, NATT);
}
DI void phase_f(const Ctx& c, int G) {
    const GAS unsigned char* ag = (const GAS unsigned char*)(c.ws + WS_ATTG); const GAS float* lse = (const GAS float*)(c.ws + WS_LSE); unsigned char* att = c.ws + WS_ATT;
    const size_t stride = (size_t)G * NTHREADS, N = (size_t)TH * 64;
    for (size_t i0 = (size_t)lbid() * NTHREADS + ltid(); i0 < N; i0 += 8 * stride) {
        float l0[8], l1[8], l2[8]; u32x2 a[8], b[8], d[8];
#pragma unroll
        for (int q = 0; q < 8; ++q) { const size_t i = i0 + q * stride; const bool ok = i < N; const size_t tok = ok ? (i >> 6) : 0; const int ch = (int)(i & 63), h = ch >> 3;
            l0[q] = lse[tok * 8 + h]; l1[q] = lse[((size_t)TH + tok) * 8 + h]; l2[q] = lse[((size_t)2 * TH + tok) * 8 + h];
            a[q] = *(const GAS u32x2*)(ag + tok * 512 + ch * 8); b[q] = *(const GAS u32x2*)(ag + ((size_t)TH + tok) * 512 + ch * 8); d[q] = *(const GAS u32x2*)(ag + ((size_t)2 * TH + tok) * 512 + ch * 8); }
#pragma unroll
        for (int q = 0; q < 8; ++q) { const size_t i = i0 + q * stride; if (i >= N) continue; const size_t tok = i >> 6; const int ch = (int)(i & 63);
            const float mx = fmaxf(l0[q], fmaxf(l1[q], l2[q])); float w0 = __builtin_amdgcn_exp2f(l0[q] - mx), w1 = __builtin_amdgcn_exp2f(l1[q] - mx), w2 = __builtin_amdgcn_exp2f(l2[q] - mx);
            const float inv = 1.0f / (w0 + w1 + w2); w0 *= inv; w1 *= inv; w2 *= inv;
            u32x2 o;
#pragma unroll
            for (int hw = 0; hw < 2; ++hw) { const int aw = (int)a[q][hw], bw = (int)b[q][hw], dw = (int)d[q][hw];
                const f32x2 a0 = __builtin_amdgcn_cvt_pk_f32_fp8(aw, false), a1 = __builtin_amdgcn_cvt_pk_f32_fp8(aw, true), b0 = __builtin_amdgcn_cvt_pk_f32_fp8(bw, false), b1 = __builtin_amdgcn_cvt_pk_f32_fp8(bw, true),
                            d0 = __builtin_amdgcn_cvt_pk_f32_fp8(dw, false), d1 = __builtin_amdgcn_cvt_pk_f32_fp8(dw, true);
                o[hw] = pk4_fp8(w0 * a0[0] + w1 * b0[0] + w2 * d0[0], w0 * a0[1] + w1 * b0[1] + w2 * d0[1], w0 * a1[0] + w1 * b1[0] + w2 * d1[0], w0 * a1[1] + w1 * b1[1] + w2 * d1[1]); }
            *(GAS u32x2*)(att + tok * 512 + ch * 8) = o; }
    }
}

DI float wave_sum(float v) {
    return __builtin_bit_cast(float, __builtin_amdgcn_readlane(__builtin_bit_cast(int, scan64(v)), 63));
}
constexpr int R_WR = 0, R_HIST = 65536, R_BASE = 65536 + 64, R_INFO = 65536 + 128, R_LG = 70144;
DI void phase_r(LAS unsigned char* lds, const Ctx& c, int l, int G) {
    const int tid = ltid(), lane = tid & 63, wave = rfl(tid >> 6);
    LAS float* WR = (LAS float*)(lds + R_WR); volatile LAS int* HIST = (volatile LAS int*)(lds + R_HIST); volatile LAS int* BASE = (volatile LAS int*)(lds + R_BASE); volatile LAS int* INFO = (volatile LAS int*)(lds + R_INFO); LAS float* LG = (LAS float*)(lds + R_LG);
    __syncthreads();
#pragma unroll
    for (int i0 = 0; i0 < 16 * 1024; i0 += 8 * NTHREADS) {
        float wv8[8];
#pragma unroll
        for (int q = 0; q < 8; ++q) wv8[q] = ((const GAS float*)c.w_router)[i0 + q * NTHREADS + tid];
#pragma unroll
        for (int q = 0; q < 8; ++q) { const int i = i0 + q * NTHREADS + tid; WR[(i & 15) * 1024 + (i >> 4)] = wv8[q]; }
    }
    f32x4 g4[4], b4[4];
#pragma unroll
    for (int j = 0; j < 4; ++j) { g4[j] = *(const GAS f32x4*)(c.ln1_g + l * D + 4 * lane + 256 * j); b4[j] = *(const GAS f32x4*)(c.ln1_b + l * D + 4 * lane + 256 * j); }
    bf16_t* xr = wsb(c, WS_XR); unsigned char* xb = c.ws + WS_XB; GAS int* histg = (GAS int*)(c.ws + WS_HISTG); GAS float* gate = (GAS float*)(c.ws + WS_GATE); GAS float* stat = (GAS float*)(c.ws + WS_STAT);
    const int elane = ((lane >> 5) & 1) * 8 + ((lane >> 4) & 1) * 4 + ((lane >> 3) & 1) * 2 + ((lane >> 2) & 1);
    const float brt = ((const GAS float*)c.b_router)[((lane >> 5) & 1) * 8 + ((lane >> 4) & 1) * 4 + ((lane >> 3) & 1) * 2 + ((lane >> 2) & 1)];
    for (int chunk = lbid(); chunk < T / 256; chunk += G) {
        __syncthreads();
        u32x2 zn[2][4];
#pragma unroll
        for (int q = 0; q < 2; ++q)
#pragma unroll
            for (int j = 0; j < 4; ++j) zn[q][j] = *(const GAS u32x2*)(xr + ((size_t)chunk * 256 + wave * 32 + q) * D + 4 * lane + 256 * j);
        for (int rr = 0; rr < 32; rr += 2) {
            const int rl = wave * 32 + rr; const size_t row = (size_t)chunk * 256 + rl;
            f32x4 v[2][4];
#pragma unroll
            for (int q = 0; q < 2; ++q) {
                float s = 0.f;
#pragma unroll
                for (int j = 0; j < 4; ++j) { const u32x2 zq = zn[q][j]; v[q][j] = (f32x4){bf_lo(zq.x), bf_hi(zq.x), bf_lo(zq.y), bf_hi(zq.y)}; s += (v[q][j][0] + v[q][j][1]) + (v[q][j][2] + v[q][j][3]); }
                { const size_t rn = row + q + (rr + 2 < 32 ? 2 : 0);
#pragma unroll
                  for (int j = 0; j < 4; ++j) zn[q][j] = *(const GAS u32x2*)(xr + rn * D + 4 * lane + 256 * j); }
                const float mean = wave_sum(s) * (1.0f / D); float s2 = 0.f;
#pragma unroll
                for (int j = 0; j < 4; ++j) { v[q][j] = v[q][j] - mean; s2 += (v[q][j][0] * v[q][j][0] + v[q][j][1] * v[q][j][1]) + (v[q][j][2] * v[q][j][2] + v[q][j][3] * v[q][j][3]); }
                const float rstd = __builtin_amdgcn_rsqf(wave_sum(s2) * (1.0f / D) + LN_EPS);
#pragma unroll
                for (int j = 0; j < 4; ++j) { v[q][j] = v[q][j] * rstd * g4[j] + b4[j];
                    *(GAS unsigned*)(xb + (row + q) * D + 4 * lane + 256 * j) = pk4_fp8(v[q][j][0], v[q][j][1], v[q][j][2], v[q][j][3]); }
                if (lane == 0) *(GAS f32x2*)(stat + (row + q) * 2) = (f32x2){mean, rstd};
                asm volatile("" ::: "memory");
            }
            const bool h5 = lane & 32, h4 = lane & 16, h3 = lane & 8, h2 = lane & 4;
            float b8[2][8];
#pragma unroll
            for (int i = 0; i < 8; ++i) {
                f32x2 a2[2][2];
#pragma unroll
                for (int q = 0; q < 2; ++q) { a2[q][0] = (f32x2){0.f, 0.f}; a2[q][1] = (f32x2){0.f, 0.f}; }
#pragma unroll
                for (int hh = 0; hh < 2; ++hh)
#pragma unroll
                    for (int j = 0; j < 4; ++j) { const f32x4 wv = *(const LAS f32x4*)(WR + (i + 8 * hh) * 1024 + 4 * lane + 256 * j); const f32x2 w01 = __builtin_shufflevector(wv, wv, 0, 1), w23 = __builtin_shufflevector(wv, wv, 2, 3);
#pragma unroll
                        for (int q = 0; q < 2; ++q) { a2[q][hh] = __builtin_shufflevector(v[q][j], v[q][j], 0, 1) * w01 + a2[q][hh]; a2[q][hh] = __builtin_shufflevector(v[q][j], v[q][j], 2, 3) * w23 + a2[q][hh]; } }
#pragma unroll
                for (int q = 0; q < 2; ++q) { const float lo = a2[q][0][0] + a2[q][0][1], hi = a2[q][1][0] + a2[q][1][1]; const float mine = h5 ? hi : lo, send = h5 ? lo : hi; b8[q][i] = mine + __shfl_xor(send, 32); }
                asm volatile("" ::: "memory");
            }
#pragma unroll
            for (int q = 0; q < 2; ++q) {
                float b4_[4], b2[2];
#pragma unroll
                for (int i = 0; i < 4; ++i) { const float mine = h4 ? b8[q][4 + i] : b8[q][i], send = h4 ? b8[q][i] : b8[q][4 + i]; b4_[i] = mine + __shfl_xor(send, 16); }
#pragma unroll
                for (int i = 0; i < 2; ++i) { const float mine = h3 ? b4_[2 + i] : b4_[i], send = h3 ? b4_[i] : b4_[2 + i]; b2[i] = mine + __shfl_xor(send, 8); }
                float b1 = (h2 ? b2[1] : b2[0]) + __shfl_xor(h2 ? b2[0] : b2[1], 4);
                b1 += __shfl_xor(b1, 2); b1 += __shfl_xor(b1, 1);
                b1 += brt;
                if ((lane & 3) == 0) LG[(rl + q) * 16 + elane] = b1;
            }
        }
        {
            const int rl = wave * 32 + (lane & 31); const size_t row = (size_t)chunk * 256 + rl;
            float lg[16];
#pragma unroll
            for (int q = 0; q < 4; ++q) { const f32x4 t4 = *(const LAS f32x4*)(LG + rl * 16 + 4 * q); lg[4 * q] = t4[0]; lg[4 * q + 1] = t4[1]; lg[4 * q + 2] = t4[2]; lg[4 * q + 3] = t4[3]; }
            float mx = lg[0];
#pragma unroll
            for (int e = 1; e < 16; ++e) mx = fmaxf(mx, lg[e]);
            float se = 0.f;
#pragma unroll
            for (int e = 0; e < 16; ++e) { lg[e] = __expf(lg[e] - mx); se += lg[e]; }
            const float ise = 1.0f / se;
#pragma unroll
            for (int e = 0; e < 16; ++e) lg[e] *= ise;
            int gsel = 0; float gbest = -1.f;
#pragma unroll
            for (int gi = 0; gi < 4; ++gi) { const float a = lg[4 * gi], b = lg[4 * gi + 1], cc = lg[4 * gi + 2], d = lg[4 * gi + 3];
                const float sc = (a + b + cc + d) - fminf(fminf(a, b), fminf(cc, d)) - fminf(fmaxf(fminf(a, b), fminf(cc, d)), fminf(fmaxf(a, b), fmaxf(cc, d)));
                if (sc > gbest) { gbest = sc; gsel = gi; } }
            float p[4];
#pragma unroll
            for (int k = 0; k < 4; ++k) p[k] = gsel == 0 ? lg[k] : gsel == 1 ? lg[4 + k] : gsel == 2 ? lg[8 + k] : lg[12 + k];
            int i0 = 0; float v0 = p[0];
#pragma unroll
            for (int k = 1; k < 4; ++k) if (p[k] > v0) { v0 = p[k]; i0 = k; }
            int i1 = -1; float v1 = -1.f;
#pragma unroll
            for (int k = 0; k < 4; ++k) if (k != i0 && p[k] > v1) { v1 = p[k]; i1 = k; }
            if (lane < 32) { const int e0 = 4 * gsel + i0, e1 = 4 * gsel + i1; INFO[rl * 4 + 0] = e0; INFO[rl * 4 + 1] = e1;
                const float gs = 1.0f / (v0 + v1); *(GAS f32x2*)(gate + row * 2) = (f32x2){v0 * gs, v1 * gs}; }
        }
        __syncthreads();
        {
            int cnt0 = 0, cnt1 = 0; const unsigned long long lt = (1ull << lane) - 1ull;
#pragma unroll
            for (int b = 0; b < 4; ++b) { const int r = 64 * b + lane; const int e0 = INFO[r * 4], e1 = INFO[r * 4 + 1];
                const bool a0 = (e0 == 2 * wave) || (e1 == 2 * wave), a1 = (e0 == 2 * wave + 1) || (e1 == 2 * wave + 1);
                const unsigned long long m0 = __ballot(a0), m1 = __ballot(a1);
                if (a0) INFO[r * 4 + (e0 == 2 * wave ? 2 : 3)] = cnt0 + __popcll(m0 & lt);
                if (a1) INFO[r * 4 + (e0 == 2 * wave + 1 ? 2 : 3)] = cnt1 + __popcll(m1 & lt);
                cnt0 += __popcll(m0); cnt1 += __popcll(m1); }
            if (lane == 0) { histg[chunk * 16 + 2 * wave] = cnt0; histg[chunk * 16 + 2 * wave + 1] = cnt1; }
        }
        __syncthreads();
        if (tid < 256) { i32x4 v; v.x = INFO[tid * 4]; v.y = INFO[tid * 4 + 1]; v.z = INFO[tid * 4 + 2]; v.w = INFO[tid * 4 + 3]; ((GAS i32x4*)(c.ws + WS_INFO))[(size_t)chunk * 256 + tid] = v; }
        __syncthreads();
    }
}
DI void phase_r2(LAS unsigned char* lds, const Ctx& c, int l, int G) {
    const int tid = ltid(); volatile LAS int* BASE = (volatile LAS int*)(lds + R_BASE);
    const GAS int* histg = (const GAS int*)(c.ws + WS_HISTG); GAS int* list = (GAS int*)(c.ws + WS_LIST);
    unsigned* cur = (unsigned*)(c.ws + WS_CTL) + CW_CUR + l * 16 * 64;
    for (int chunk = lbid(); chunk < T / 256; chunk += G) {
        __syncthreads();
        if (tid < 16) BASE[tid] = 0;
        __syncthreads();
        { const int e = tid & 15; int s = 0;
#pragma unroll
          for (int k = 0; k < T / 256 / 32; ++k) { const int cc = (tid >> 4) + 32 * k; s += cc < chunk ? histg[cc * 16 + e] : 0; }
          if (s) atomicAdd((int*)&BASE[e], s); }
        __syncthreads();
        if (tid < 256) { const i32x4 v = ((const GAS i32x4*)(c.ws + WS_INFO))[(size_t)chunk * 256 + tid]; const int row = chunk * 256 + tid;
            list[(size_t)v.x * T + BASE[v.x] + v.z] = row * 2; list[(size_t)v.y * T + BASE[v.y] + v.w] = row * 2 + 1; }
        if (chunk == T / 256 - 1 && tid < 16) __hip_atomic_store(cur + tid * 64, (unsigned)(BASE[tid] + histg[chunk * 16 + tid]), __ATOMIC_RELAXED, __HIP_MEMORY_SCOPE_AGENT);
    }
}
DI int moe_setup(LAS unsigned char* lds, const Ctx& c, int l) {
    volatile LAS int* PRE = (volatile LAS int*)(lds + MISC_OFF); volatile LAS int* CNT = PRE + 17;
    unsigned* cur = (unsigned*)(c.ws + WS_CTL) + CW_CUR + l * 16 * 64;
    __syncthreads();
    if (threadIdx.x < 16) CNT[threadIdx.x] = (int)__hip_atomic_load((GAS unsigned*)(cur + threadIdx.x * 64), __ATOMIC_RELAXED, __HIP_MEMORY_SCOPE_AGENT);
    __syncthreads();
    if (threadIdx.x == 0) { int acc = 0; for (int e = 0; e < 16; ++e) { PRE[e] = acc; acc += (CNT[e] + 255) >> 8; } PRE[16] = acc; }
    __syncthreads();
    return rfl(PRE[16]);
}
template <bool LAST> DI void phase_c(const Ctx& c, int l, int G) {
    const int tid = ltid(), lane = tid & 63, wave = rfl(tid >> 6);
    f32x4 g4[4], b4[4];
#pragma unroll
    for (int j = 0; j < 4; ++j) { g4[j] = *(const GAS f32x4*)(c.ln2_g + l * D + 4 * lane + 256 * j); b4[j] = *(const GAS f32x4*)(c.ln2_b + l * D + 4 * lane + 256 * j); }
    f32x4 h4[4], c4[4];
#pragma unroll
    for (int j = 0; j < 4; ++j) { h4[j] = *(const GAS f32x4*)(c.ln1_g + l * D + 4 * lane + 256 * j) * DN_ALPHA; c4[j] = *(const GAS f32x4*)(c.ln1_b + l * D + 4 * lane + 256 * j) * DN_ALPHA; }
    const GAS float* stat = (const GAS float*)(c.ws + WS_STAT);
    float* xo = c.out; bf16_t* xr = wsb(c, WS_XR); unsigned char* xb = c.ws + WS_XB; const unsigned char* ys = c.ws + WS_YS; const GAS float* gate = (const GAS float*)(c.ws + WS_GATE);
    const size_t rstep = (size_t)G * NWAVES; size_t row = (size_t)lbid() * NWAVES + wave;
    u32x2 xn[2][4]; unsigned y0n[2][4], y1n[2][4]; float g0n[2], g1n[2], mun[2], rsn[2];
#define C_LOAD(sl, r_) do { const size_t rq_ = (r_); g0n[sl] = gate[rq_ * 2]; g1n[sl] = gate[rq_ * 2 + 1]; mun[sl] = stat[rq_ * 2]; rsn[sl] = stat[rq_ * 2 + 1]; \
        _Pragma("unroll") for (int j = 0; j < 4; ++j) { xn[sl][j] = *(const GAS u32x2*)(xr + rq_ * D + 4 * lane + 256 * j); y0n[sl][j] = *(const GAS unsigned*)(ys + (rq_ * 2) * D + 4 * lane + 256 * j); y1n[sl][j] = *(const GAS unsigned*)(ys + (rq_ * 2 + 1) * D + 4 * lane + 256 * j); } } while (0)
    if (row < (size_t)T) { C_LOAD(0, row); C_LOAD(1, row + rstep < (size_t)T ? row + rstep : row); }
    for (; row < (size_t)T; row += 2 * rstep) {
#pragma unroll
        for (int sl = 0; sl < 2; ++sl) {
            const size_t rw = row + sl * rstep; if (rw >= (size_t)T) break;
            const float g0 = g0n[sl], g1 = g1n[sl], mu = mun[sl], rs = rsn[sl];
            f32x4 v[4]; float s = 0.f;
#pragma unroll
            for (int j = 0; j < 4; ++j) { const u32x2 xq = xn[sl][j]; const unsigned y0 = y0n[sl][j], y1 = y1n[sl][j];
                const f32x2 y0a = __builtin_amdgcn_cvt_pk_f32_fp8((int)y0, false), y0b = __builtin_amdgcn_cvt_pk_f32_fp8((int)y0, true), y1a = __builtin_amdgcn_cvt_pk_f32_fp8((int)y1, false), y1b = __builtin_amdgcn_cvt_pk_f32_fp8((int)y1, true);
                const f32x4 zc = ((f32x4){bf_lo(xq.x), bf_hi(xq.x), bf_lo(xq.y), bf_hi(xq.y)} - mu) * rs;
                const f32x4 ax = zc * h4[j] + c4[j];
                v[j][0] = ax[0] + g0 * y0a[0] + g1 * y1a[0]; v[j][1] = ax[1] + g0 * y0a[1] + g1 * y1a[1];
                v[j][2] = ax[2] + g0 * y0b[0] + g1 * y1b[0]; v[j][3] = ax[3] + g0 * y0b[1] + g1 * y1b[1];
                s += (v[j][0] + v[j][1]) + (v[j][2] + v[j][3]); }
            C_LOAD(sl, rw + 2 * rstep < (size_t)T ? rw + 2 * rstep : rw);
            const float mean = wave_sum(s) * (1.0f / D); float s2 = 0.f;
#pragma unroll
            for (int j = 0; j < 4; ++j) { v[j] = v[j] - mean; s2 += (v[j][0] * v[j][0] + v[j][1] * v[j][1]) + (v[j][2] * v[j][2] + v[j][3] * v[j][3]); }
            const float rstd = __builtin_amdgcn_rsqf(wave_sum(s2) * (1.0f / D) + LN_EPS);
#pragma unroll
            for (int j = 0; j < 4; ++j) { v[j] = v[j] * rstd * g4[j] + b4[j];
                if constexpr (LAST) *(GAS f32x4*)(xo + rw * D + 4 * lane + 256 * j) = v[j];
                else { u32x2 xq; xq.x = cvt_pk_bf16(v[j][0], v[j][1]); xq.y = cvt_pk_bf16(v[j][2], v[j][3]); *(GAS u32x2*)(xr + rw * D + 4 * lane + 256 * j) = xq;
                    *(GAS unsigned*)(xb + rw * D + 4 * lane + 256 * j) = pk4_fp8(v[j][0], v[j][1], v[j][2], v[j][3]); } }
        }
    }
#undef C_LOAD
}

DI Ctx load_ctx() {
    union { Ctx c; unsigned long long q[sizeof(Ctx) / 8]; } u;
#if defined(__HIP_DEVICE_COMPILE__)
    const __attribute__((address_space(4))) unsigned long long* p = (const __attribute__((address_space(4))) unsigned long long*)__builtin_amdgcn_kernarg_segment_ptr();
    asm volatile("" : "+s"(p));
#pragma unroll
    for (int i = 0; i < (int)(sizeof(Ctx) / 8); ++i) u.q[i] = p[i];
#endif
    return u.c;
}
#define CTX const Ctx c = load_ctx(); const int G = lgrid(); LAS unsigned char* lds = LDSBASE
__global__ void __launch_bounds__(NTHREADS, 2) mk_fwd(Ctx c_arg) {
    extern __shared__ __attribute__((aligned(16))) unsigned char lds_raw[];
#define LDSBASE ({ unsigned _b = (unsigned)(uintptr_t)(LAS unsigned char*)lds_raw; asm volatile("" : "+s"(_b)); (LAS unsigned char*)(uintptr_t)_b; })
    LAS unsigned char* lds0 = LDSBASE;
    const int tid = threadIdx.x; const Ctx c = load_ctx();
    volatile LAS unsigned* MISC = (volatile LAS unsigned*)(lds0 + MISC_OFF);
    if (tid < 64) MISC[tid] = 0u;
    __syncthreads();
    XcdBarrier bar; bar.bar = (unsigned*)(c.ws + WS_CTL) + CW_BAR; bar.x = 0; bar.st = MISC + 40;
    if (!MK_MULTI) bar = xcd_barrier_post((unsigned*)(c.ws + WS_CTL) + CW_BAR, MISC + 40);
    const int lo = c.lo, hi = c.hi; int step = 0;
#define RUN (lo <= step && step < hi)
#define END_STEP do { if (RUN && step + 1 < hi) { if (!MK_MULTI) xcd_barrier(bar); } ++step; } while (0)
#define END_STEP_NB do { ++step; } while (0)
    for (int l = 0; l < DEPTH; ++l) {
        if (RUN) { CTX; phase_w(lds, c, l, G); }
        END_STEP;
        for (int hf = 0; hf < 2; ++hf) {
            const size_t r0 = (size_t)hf * TH;
            if (RUN) {
                CTX;
                pg8::StaticOrder S; S.init(c.ws + WS_XB + r0 * D, c.ws + wset(l) + WS_WIN, TH, NIN, D / 2, G, lbid());
                EpiIn E{wsb(c, WS_H + H_QG), wsb(c, WS_H + H_KG), wsb(c, WS_H + H_VG), wsb(c, WS_H + H_SR), wsb(c, WS_H + H_QD), wsb(c, WS_H + H_KD), wsb(c, WS_H + H_VD), wsb(c, WS_H + H_GT), (float*)(c.ws + WS_HA), c.pos + r0};
                pg8::gemm_phase<EpiIn, pg8::StaticOrder, true>(lds, D / 2, S, E);
                if (l + 1 < DEPTH && lbid() >= (TH / 256) * (NIN / 256) % G && (TH / 256) * (NIN / 256) % G != 0) w_tickets(lds, c, l + 1, 1);
            }
            END_STEP;
            if (RUN) { CTX; phase_p(lds, c, l, G); }
            END_STEP;
            if (RUN) { CTX; phase_b1(lds, c, l, hf, G); }
            END_STEP;
            if (RUN) { CTX; phase_b(lds, c, l, hf, G); }
            END_STEP;
            if (RUN) { CTX; (void)lds; phase_f(c, G); }
            END_STEP_NB;
            if (RUN) {
                CTX;
                pg8::StaticOrder S; S.init(c.ws + WS_OG, c.ws + wset(l) + WS_WGO, TH, D, D / 2, G, lbid());
                EpiGate<false> E{wsb(c, WS_MIX), c.ws + WS_H + H_GT, nullptr};
                pg8::gemm_phase<EpiGate<false>, pg8::StaticOrder, true>(lds, D / 2, S, E);
            }
            END_STEP;
            if (RUN) {
                CTX;
                pg8::StaticOrder S; S.init(c.ws + WS_ATT, c.ws + wset(l) + WS_WAO, TH, D, 256, G, lbid());
                EpiGate<true> E{wsb(c, WS_MIX), c.ws + WS_H + H_GT + 1024, c.ws + WS_OG + 32 * MiB};
                pg8::gemm_phase<EpiGate<true>, pg8::StaticOrder, true>(lds, 256, S, E);
            }
            END_STEP;
            if (RUN) {
                CTX;
                pg8::StaticOrder S; S.init(c.ws + WS_OG + 32 * MiB, c.ws + wset(l) + WS_WOUT, TH, D, D / 2, G, lbid());
                EpiRes E{l == 0 ? c.x + r0 * D : nullptr, wsb(c, WS_XR) + r0 * D};
                pg8::gemm_phase<EpiRes, pg8::StaticOrder, true>(lds, D / 2, S, E);
            }
            if (hf == 1) END_STEP; else END_STEP_NB;
        }
        if (RUN) { CTX; phase_r(lds, c, l, G); }
        END_STEP;
        if (RUN) { CTX; phase_r2(lds, c, l, G); }
        END_STEP;
        if (RUN) {   CTX;
            const int ntiles = moe_setup(lds, c, l);
            volatile LAS int* PRE = (volatile LAS int*)(lds + MISC_OFF); volatile LAS int* TAB = (volatile LAS int*)(lds + TAB_OFF);
            pg8::MoeOrder S; S.G = G; S.c = vcu_of(lbid(), G); S.ntot = ntiles * 8; S.NC = 8; S.K = D / 2; S.pre = PRE; S.cnt = PRE + 17; S.A = (const char*)(c.ws + WS_XB); S.Bt = (const char*)(c.ws + wset(l) + WS_WGU);
            S.bstride = (size_t)2048 * 1024; S.tab = TAB; S.gather = true;
            const GAS int* list = (const GAS int*)(c.ws + WS_LIST);
            { const int lt_tid = ltid(); const int r = lt_tid & 255, half = rfl(lt_tid >> 8);
              int tv[MAXU / 2];
#pragma unroll
              for (int k = 0; k < MAXU / 2; ++k) { Unit u; const int i = 2 * k + half; tv[k] = 0;
                  if (S.next(i, u)) { const int lt = u.pm - PRE[u.e]; const int pos = 256 * lt + (r < u.nv ? r : 0); tv[k] = list[(size_t)u.e * T + pos]; } }
#pragma unroll
              for (int k = 0; k < MAXU / 2; ++k) { const int i = 2 * k + half; if (i * S.G + S.c < S.ntot) TAB[i * 256 + r] = tv[k] >> 1; } }
            __syncthreads();
            EpiM1 E{c.ws + WS_HM};
            pg8::gemm_phase<EpiM1, pg8::MoeOrder, true>(lds, D / 2, S, E);
            if (l + 1 < DEPTH && S.ntot % G != 0 && S.c >= S.ntot % G) w_tickets(lds, c, l + 1, 1);
        }
        END_STEP;
        if (RUN) {   CTX;
            const int ntiles = moe_setup(lds, c, l);
            volatile LAS int* PRE = (volatile LAS int*)(lds + MISC_OFF);
            pg8::MoeOrder S; S.G = G; S.c = vcu_of(lbid(), G); S.ntot = ntiles * 4; S.NC = 4; S.K = DFF / 2; S.pre = PRE; S.cnt = PRE + 17; S.A = (const char*)(c.ws + WS_HM); S.Bt = (const char*)(c.ws + wset(l) + WS_WD);
            S.bstride = (size_t)1024 * 1024; S.tab = nullptr; S.gather = false;
            EpiM2 E{c.ws + WS_YS, (const int*)(c.ws + WS_LIST), PRE};
            pg8::gemm_phase<EpiM2, pg8::MoeOrder, true>(lds, DFF / 2, S, E);
            if (l + 1 < DEPTH && S.ntot % G != 0 && S.c >= S.ntot % G) w_tickets(lds, c, l + 1, 1);
        }
        END_STEP;
        if (RUN) { CTX; (void)lds; if (l == DEPTH - 1) phase_c<true>(c, l, G); else phase_c<false>(c, l, G); }
        END_STEP_NB;
    }
#undef RUN
#undef END_STEP
#undef END_STEP_NB
}
constexpr int NSTEPS = DEPTH * (1 + 2 * 8 + 5);

extern "C" void kernel_launch(void* const* d_in, const int* in_sizes, int n_in, void* d_out, int out_size, void* d_ws, size_t ws_size, hipStream_t stream) {
    static int grid = 0;
    if (grid == 0) {
        if (n_in != 18 || in_sizes[0] != T * D || out_size != T * D || ws_size < WS_END) { fprintf(stderr, "kernel_launch: unexpected shapes / workspace (need %zu, got %zu)\n", (size_t)WS_END, ws_size); grid = -1; return; }
        int dev = 0, cus = 0;
        if (hipGetDevice(&dev) != hipSuccess || hipDeviceGetAttribute(&cus, hipDeviceAttributeMultiprocessorCount, dev) != hipSuccess) { grid = -1; return; }
        if (hipFuncSetAttribute((const void*)mk_fwd, hipFuncAttributeMaxDynamicSharedMemorySize, LDS_BYTES) != hipSuccess) { fprintf(stderr, "kernel_launch: hipFuncSetAttribute failed\n"); grid = -1; return; }
        int per_cu = 0;
        if (hipOccupancyMaxActiveBlocksPerMultiprocessor(&per_cu, (const void*)mk_fwd, NTHREADS, LDS_BYTES) != hipSuccess || per_cu < 1) { fprintf(stderr, "kernel_launch: occupancy query says %d\n", per_cu); }
        (void)hipGetLastError();
        grid = cus;
    }
    if (grid < 0) return;
    (void)hipMemsetAsync((char*)d_ws + WS_CTL, 0, CTL_ZERO_BYTES, stream);
    Ctx c{};
    c.x = (const float*)d_in[0]; c.pos = (const int*)d_in[1]; c.w_in = (const float*)d_in[2]; c.w_alpha_up = (const float*)d_in[3]; c.b_alpha = (const float*)d_in[4]; c.gla_norm = (const float*)d_in[5];
    c.w_gla_o = (const float*)d_in[6]; c.w_att_o = (const float*)d_in[7]; c.w_out = (const float*)d_in[8]; c.ln1_g = (const float*)d_in[9]; c.ln1_b = (const float*)d_in[10]; c.w_router = (const float*)d_in[11];
    c.b_router = (const float*)d_in[12]; c.w_e_gate = (const float*)d_in[13]; c.w_e_up = (const float*)d_in[14]; c.w_e_down = (const float*)d_in[15]; c.ln2_g = (const float*)d_in[16]; c.ln2_b = (const float*)d_in[17];
    c.out = (float*)d_out; c.ws = (unsigned char*)d_ws;
#if MK_MULTI
    for (int s = 0; s < NSTEPS; ++s) { c.lo = s; c.hi = s + 1; hipLaunchKernelGGL(mk_fwd, dim3(grid), dim3(NTHREADS), LDS_BYTES, stream, c); }
#else
    c.lo = 0; c.hi = NSTEPS; hipLaunchKernelGGL(mk_fwd, dim3(grid), dim3(NTHREADS), LDS_BYTES, stream, c);
#endif
}
```

```cpp
#include <hip/hip_runtime.h>
#include <cstdio>
#include <cstdint>

#ifndef MK_MULTI
#define MK_MULTI 0
#endif

#define DI __device__ __forceinline__
#define GAS __attribute__((address_space(1)))
#define LAS __attribute__((address_space(3)))
typedef unsigned short bf16_t;
typedef short bf16x8 __attribute__((ext_vector_type(8)));
typedef short s16x4 __attribute__((ext_vector_type(4)));
typedef float f32x4 __attribute__((ext_vector_type(4)));
typedef float f32x2 __attribute__((ext_vector_type(2)));
typedef unsigned u32x4 __attribute__((ext_vector_type(4)));
typedef unsigned u32x2 __attribute__((ext_vector_type(2)));
typedef int i32x4 __attribute__((ext_vector_type(4)));
typedef int i32x8 __attribute__((ext_vector_type(8)));
#define LDS_WAIT() asm volatile("s_waitcnt lgkmcnt(0)" ::: "memory")
#define VM_WAIT() asm volatile("s_waitcnt vmcnt(0)" ::: "memory")

constexpr int D = 1024, NBATCH = 16, SEQ = 4096, T = NBATCH * SEQ, DEPTH = 4;
constexpr int TH = T / 2;
constexpr int DIN = 9744, NIN = 9984;
constexpr int NEXP = 16, DFF = 1024;
constexpr float LN_EPS = 1e-5f, RMS_EPS = 1e-6f;
constexpr float DN_ALPHA = 1.6817928305074290f;
constexpr float LOG2E = 1.4426950408889634f;
constexpr int NWAVES = 8, NTHREADS = 512;

constexpr size_t MiB = 1u << 20;
constexpr size_t WS_CTL = 0, CTL_ZERO_BYTES = 1 * MiB;
constexpr size_t WS_WIN = 1 * MiB;
constexpr size_t WS_WGO = WS_WIN + (size_t)NIN * D;
constexpr size_t WS_WAO = WS_WGO + 2 * MiB;
constexpr size_t WS_WOUT = WS_WAO + 1 * MiB;
constexpr size_t WS_WGU = WS_WOUT + 2 * MiB;
constexpr size_t WS_WD = WS_WGU + 32 * MiB;
constexpr size_t WS_XB = WS_WD + 16 * MiB;
constexpr size_t WS_XR = WS_XB + 64 * MiB;
constexpr size_t WS_LIST = WS_XR + 128 * MiB;
constexpr size_t WS_GATE = WS_LIST + 4 * MiB;
constexpr size_t WS_INFO = WS_GATE + 1 * MiB;
constexpr size_t WS_HISTG = WS_INFO + 1 * MiB;
constexpr size_t WS_OG = WS_HISTG + 1 * MiB;
constexpr size_t WS_ATTG = WS_OG + 64 * MiB;
constexpr size_t WS_LSE = WS_ATTG + 96 * MiB;
constexpr size_t WS_ATT = WS_LSE + 3 * MiB;
constexpr size_t WS_MIX = WS_ATT + 32 * MiB;
constexpr size_t WS_HA = WS_MIX + 64 * MiB;
constexpr size_t WS_H = WS_HA + 2 * MiB;
constexpr size_t H_QG = 0, H_KG = H_QG + (size_t)TH * 512 * 2, H_VG = H_KG + (size_t)TH * 512 * 2, H_SR = H_VG + (size_t)TH * 1024 * 2,
                 H_QD = H_SR + (size_t)TH * 1024 * 2, H_KD = H_QD + (size_t)TH * 1536 * 2, H_VD = H_KD + (size_t)TH * 1536 * 2, H_GT = H_VD + (size_t)TH * 1536 * 2,
                 H_END = H_GT + (size_t)TH * 2048 * 2;
constexpr size_t WS_HM = WS_H;
constexpr size_t WS_YS = WS_HM + (size_t)(2 * T + 4096) * 1024 * 2;
constexpr size_t WS_STAT = WS_CTL + 512 * 1024;
constexpr size_t WS_W2 = WS_H + 544 * MiB, WSET_BYTES = WS_XB - WS_WIN;
static_assert(WS_W2 + WSET_BYTES <= WS_H + H_END, "second weight set fits");
constexpr size_t WS_REC = WS_H + H_END;
constexpr size_t WS_SLOC = WS_REC + (size_t)2048 * 33792;
constexpr size_t WS_DCUM = WS_SLOC + 16 * MiB;
constexpr size_t WS_END = WS_DCUM + 1 * MiB;
static_assert(WS_YS + (size_t)2 * T * 1024 * 2 <= WS_END, "MoE overlay fits");
constexpr int CW_BAR = 4096;
constexpr int CW_TKT = 24576;
constexpr int CW_CUR = 16384;
constexpr int CW_WTK = 40960;

constexpr int RING_BYTES = 131072;
constexpr int TAB_OFF = RING_BYTES, MAXU = 18, TAB_BYTES = MAXU * 1024;
constexpr int LDS_BYTES = 163840;
constexpr int MISC_OFF = LDS_BYTES - 256;
static_assert(TAB_OFF + TAB_BYTES <= MISC_OFF, "LDS map");

DI int rfl(int v) { return __builtin_amdgcn_readfirstlane(v); }
DI int lbid() { int t = blockIdx.x; asm volatile("" : "+s"(t)); return t; }
DI int lgrid() { int t = gridDim.x; asm volatile("" : "+s"(t)); return t; }
DI int vcu_of(int bid, int G) { return (G % 8 == 0) ? (bid % 8) * (G / 8) + bid / 8 : bid; }
DI int ltid() { int t = threadIdx.x; asm volatile("" : "+v"(t)); return t; }
DI float bf2f(unsigned b) { return __uint_as_float(b << 16); }
typedef __bf16 bf16x2_t __attribute__((ext_vector_type(2)));
DI unsigned cvt_pk_bf16(float lo, float hi) { f32x2 v = {lo, hi}; bf16x2_t b = __builtin_convertvector(v, bf16x2_t); return __builtin_bit_cast(unsigned, b); }
DI float clamp8(float v) { return fminf(fmaxf(v, -448.f), 448.f); }
DI unsigned pk4_fp8(float a, float b, float c_, float d) { int w = 0; w = __builtin_amdgcn_cvt_pk_fp8_f32(clamp8(a), clamp8(b), w, false); w = __builtin_amdgcn_cvt_pk_fp8_f32(clamp8(c_), clamp8(d), w, true); return (unsigned)w; }
constexpr float W8_SCALE = 64.0f, W8_INV = 1.0f / 64.0f;
DI float bf_lo(unsigned w) { return __uint_as_float(w << 16); }
DI float bf_hi(unsigned w) { return __uint_as_float(w & 0xffff0000u); }
DI float sigmoidf_(float x) { return __builtin_amdgcn_rcpf(1.0f + __builtin_amdgcn_exp2f(-x * LOG2E)); }
DI float sigmoid64_(float x64) { return __builtin_amdgcn_rcpf(1.0f + __builtin_amdgcn_exp2f(x64 * (-LOG2E * W8_INV))); }

#define XB_TMO      128
#define XB_XCNT(j)  (256  + 64 * (j))
#define XB_XSUB(j)  (1280 + 64 * (j))
#define XB_XGEN(j)  (2304 + 64 * (j))
#define XB_TOP      3328
#define XB_TOPGEN   3392
#define XCD_BAR_WORDS 3456
#define XB_SPIN_CAP (1u << 18)
DI unsigned xb_ld(unsigned* p)              { return __hip_atomic_load(p, __ATOMIC_RELAXED, __HIP_MEMORY_SCOPE_AGENT); }
DI unsigned xb_add(unsigned* p, unsigned v) { return __hip_atomic_fetch_add(p, v, __ATOMIC_RELAXED, __HIP_MEMORY_SCOPE_AGENT); }
DI unsigned xb_xcc_id() { return (unsigned)__builtin_amdgcn_s_getreg((3 << 11) | 20) & 0xFu; }
#define XB_SPIN(cond, bar) do { unsigned _sp = 0; while (cond) { __builtin_amdgcn_s_sleep(1); \
    if ((++_sp & 255u) == 0u) { if (xb_ld(&(bar)[XB_TMO])) break; if (_sp > XB_SPIN_CAP) { atomicAdd(&(bar)[XB_TMO], 1u); break; } } } } while (0)
struct XcdBarrier { unsigned* bar; unsigned x; volatile LAS unsigned* st; };
DI XcdBarrier xcd_barrier_post(unsigned* bar, volatile LAS unsigned* st) {
    XcdBarrier b; b.bar = bar; b.x = xb_xcc_id(); b.st = st;
    if (threadIdx.x == 0) (void)xb_add(&bar[XB_XCNT(b.x)], 1u);
    return b;
}
DI void xcd_barrier_complete(unsigned* bar, unsigned x, unsigned& nloc, unsigned& nx) {
    const unsigned G = gridDim.x * gridDim.y * gridDim.z;
    unsigned sum, cnt, mine, sp = 0u;
    for (;;) {
        sum = 0u; cnt = 0u; mine = 0u;
#pragma unroll
        for (unsigned j = 0; j < 16; ++j) { const unsigned c = xb_ld(&bar[XB_XCNT(j)]); sum += c; cnt += (c > 0u) ? 1u : 0u; mine = (j == x) ? c : mine; }
        if (sum == G) break;
        __builtin_amdgcn_s_sleep(1);
        if ((++sp & 255u) == 0u) { if (xb_ld(&bar[XB_TMO])) break; if (sp > XB_SPIN_CAP) { atomicAdd(&bar[XB_TMO], 1u); break; } }
    }
    nloc = mine > 0u ? mine : 1u; nx = cnt > 0u ? cnt : 1u;
}
DI void xcd_barrier(const XcdBarrier& b) {
    asm volatile("s_waitcnt vmcnt(0)" ::: "memory");
    __syncthreads();
    if (threadIdx.x == 0) {
        unsigned* bar = b.bar;
        __builtin_amdgcn_s_waitcnt(0);
        unsigned nloc = b.st[0], nx = b.st[1];
        if (nloc == 0u) { xcd_barrier_complete(bar, b.x, nloc, nx); b.st[0] = nloc; b.st[1] = nx; }
        const unsigned old = xb_add(&bar[XB_XSUB(b.x)], 1u);
        const unsigned gen = old / nloc;
        if (old + 1u == (gen + 1u) * nloc) {
            __builtin_amdgcn_fence(__ATOMIC_RELEASE, "agent");
            asm volatile("s_waitcnt vmcnt(0)" ::: "memory");
            const unsigned og = xb_add(&bar[XB_TOP], 1u);
            const unsigned tg = og / nx;
            if (og + 1u == (tg + 1u) * nx) xb_add(&bar[XB_TOPGEN], 1u);
            else XB_SPIN(xb_ld(&bar[XB_TOPGEN]) == tg, bar);
            __builtin_amdgcn_fence(__ATOMIC_ACQUIRE, "agent");
            xb_add(&bar[XB_XGEN(b.x)], 1u);
            asm volatile("s_waitcnt vmcnt(0)" ::: "memory");
        } else {
            XB_SPIN(xb_ld(&bar[XB_XGEN(b.x)]) == gen, bar);
            __builtin_amdgcn_fence(__ATOMIC_ACQUIRE, "agent");
            asm volatile("s_waitcnt vmcnt(0)" ::: "memory");
        }
    }
    __syncthreads();
}

struct Ctx {
    const float* x; const int* pos; const float* w_in; const float* w_alpha_up; const float* b_alpha; const float* gla_norm;
    const float* w_gla_o; const float* w_att_o; const float* w_out; const float* ln1_g; const float* ln1_b; const float* w_router; const float* b_router;
    const float* w_e_gate; const float* w_e_up; const float* w_e_down; const float* ln2_g; const float* ln2_b;
    float* out; unsigned char* ws;
    int lo, hi;
};
DI bf16_t* wsb(const Ctx& c, size_t off) { return (bf16_t*)(c.ws + off); }
DI int in_tile(int pt) { return (pt >= 5 && pt <= 7) ? pt + 30 : ((pt >= 35 && pt <= 37) ? pt - 30 : pt); }
DI size_t wset(int l) { return (l & 1) ? (WS_W2 - WS_WIN) : (size_t)0; }

namespace pg8 {
constexpr int BM = 256, BK = 64, HALF = 128, HTB = HALF * BK * 2, STAGE_BYTES = 8 * HTB, NXCD = 8, WGM = 4;
DI int lds_byte(int r, int c) { const int st = (r >> 4) * 2 + (c >> 5), rr = r & 15, cc = c & 31, ob = rr * 64 + cc * 2; return st * 1024 + (ob ^ (((ob >> 9) & 1) << 5)); }
DI void stage_rc(int b, int& R, int& C) { const int st = b / 1024, sb = b % 1024, swz = sb ^ (((sb >> 9) & 1) << 5); R = (st >> 1) * 16 + swz / 64; C = (st & 1) * 32 + (swz % 64) / 2; }
DI int perm32(int rho) { const int n = rho >> 4, i = rho & 15; return 8 * (i >> 2) + 4 * n + (i & 3); }
struct Unit { int pm, pn, e, nv, ui; };

struct StaticOrder {
    int nM, nN, nwg, G, c, K; const char* A; const char* Bt;
    DI void init(const void* A_, const void* Bt_, int M, int N, int K_, int G_, int c_) { A = (const char*)A_; Bt = (const char*)Bt_; nM = M / BM; nN = N / BM; nwg = nM * nN; G = G_; c = c_; K = K_; }
    DI bool next(int i, Unit& u) const {
        const long L = (long)i * G + c; if (L >= nwg) return false;
        int wgid = (int)L; { const int q = nwg / NXCD, r = nwg % NXCD, xcd = wgid % NXCD, off = wgid / NXCD; wgid = (xcd < r ? xcd * (q + 1) : r * (q + 1) + (xcd - r) * q) + off; }
        const int nig = WGM * nN, gid = wgid / nig, fm = gid * WGM, gsz = (nM - fm) < WGM ? (nM - fm) : WGM;
        u.pm = fm + ((wgid % nig) % gsz); u.pn = (wgid % nig) / gsz; u.e = 0; u.nv = 256; u.ui = i; return true;
    }
    DI const char* a_base(const Unit& u) const { return A + (size_t)u.pm * BM * K * 2; }
    DI const char* b_base(const Unit& u) const { return Bt + (size_t)u.pn * BM * K * 2; }
    DI void a_off(const Unit&, int tid, unsigned (&o)[2][2]) const {
#pragma unroll
        for (int i = 0; i < 2; ++i) { int R, C; stage_rc(tid * 16 + i * 8192, R, C);
#pragma unroll
            for (int h = 0; h < 2; ++h) o[h][i] = (unsigned)((h * HALF + R) * K + C) * 2u; }
    }
};
struct MoeOrder {
    int G, c, ntot, NC, K; const volatile LAS int* pre; const volatile LAS int* cnt; const char* A; const char* Bt; size_t bstride; const volatile LAS int* tab; bool gather;
    DI bool next(int i, Unit& u) const {
        const int L = i * G + c; if (L >= ntot) return false;
        const int rt = L / NC; u.pn = L - rt * NC; u.pm = rt;
        int e = 0;
#pragma unroll
        for (int j = 1; j < 16; ++j) e += (rt >= rfl(pre[j])) ? 1 : 0;
        e = rfl(e); u.e = e; const int rem = rfl(cnt[e]) - 256 * (rt - rfl(pre[e])); u.nv = rem < 256 ? rem : 256; u.ui = i; return true;
    }
    DI const char* a_base(const Unit& u) const { return gather ? A : A + (size_t)u.pm * BM * K * 2; }
    DI const char* b_base(const Unit& u) const { return Bt + (size_t)u.e * bstride + (size_t)u.pn * BM * K * 2; }
    DI void a_off(const Unit& u, int tid, unsigned (&o)[2][2]) const {
#pragma unroll
        for (int i = 0; i < 2; ++i) { int R, C; stage_rc(tid * 16 + i * 8192, R, C);
#pragma unroll
            for (int h = 0; h < 2; ++h) { const int row = gather ? tab[u.ui * 256 + h * HALF + R] : (h * HALF + R); o[h][i] = (unsigned)(row * K + C) * 2u; } }
    }
};

template <class Epi, class Sched, bool F8 = false>
DI void gemm_phase(LAS unsigned char* lds, const int K, const Sched& S, const Epi& E) {
    const int tid = ltid(), wid = rfl(tid >> 6), lane = tid & 63, wr = wid >> 2, wc = wid & 3, fr = lane & 15, fq = lane >> 4;
    const int nt = K / BK;
    unsigned voffB[2];
#pragma unroll
    for (int i = 0; i < 2; ++i) { int R, C; stage_rc(tid * 16 + i * 8192, R, C); const int Rb = Epi::PERM ? ((R & ~31) + perm32(R & 31)) : R; voffB[i] = (unsigned)(Rb * K + C) * 2u; }
    const size_t kstep = (size_t)(BK * 2);
    const size_t hstep = (size_t)HALF * K * 2;
    const unsigned ldsw = (unsigned)wid * 1024u;
    const int aoff = lds_byte(wr * 64 + fr, fq * 8), boff = lds_byte(wc * 32 + fr, fq * 8);
#define PG8_SA(b, h) (((b) * 2 + (h)) * HTB)
#define PG8_SB(b, h) ((4 + (b) * 2 + (h)) * HTB)
#define PG8_STAGE(bufoff, gbase, voff) do { _Pragma("unroll") for (int _i = 0; _i < 2; ++_i) \
        __builtin_amdgcn_global_load_lds((const unsigned*)((const char*)(gbase) + (voff)[_i]), (LAS unsigned*)(lds + (bufoff) + ldsw + _i * 8192), 16, 0, 0); } while (0)
#define PG8_LD8(p) __builtin_shufflevector(*(const LAS i32x4*)(p), *(const LAS i32x4*)((p) + 1024), 0, 1, 2, 3, 4, 5, 6, 7)
#define PG8_LDA(dst, b, h) do { if constexpr (F8) { _Pragma("unroll") for (int m = 0; m < 4; ++m) dst##8[m] = PG8_LD8(lds + PG8_SA(b, h) + aoff + m * 2048); } else { \
        _Pragma("unroll") for (int m = 0; m < 4; ++m) _Pragma("unroll") for (int k = 0; k < 2; ++k) dst[m][k] = *(const LAS bf16x8*)(lds + PG8_SA(b, h) + aoff + m * 2048 + k * 1024); } } while (0)
#define PG8_LDB(dst, b, h) do { if constexpr (F8) { _Pragma("unroll") for (int n = 0; n < 2; ++n) dst##8[n] = PG8_LD8(lds + PG8_SB(b, h) + boff + n * 2048); } else { \
        _Pragma("unroll") for (int n = 0; n < 2; ++n) _Pragma("unroll") for (int k = 0; k < 2; ++k) dst[n][k] = *(const LAS bf16x8*)(lds + PG8_SB(b, h) + boff + n * 2048 + k * 1024); } } while (0)
#define PG8_MMA(ai, bj, At, Bt) do { __builtin_amdgcn_s_setprio(1); if constexpr (F8) { _Pragma("unroll") for (int m = 0; m < 4; ++m) _Pragma("unroll") for (int n = 0; n < 2; ++n) \
        asm volatile("v_mfma_f32_16x16x128_f8f6f4 %0, %1, %2, %0" : "+v"(acc[ai][bj][m][n]) : "v"(Bt##8[n]), "v"(At##8[m])); } else { \
        _Pragma("unroll") for (int m = 0; m < 4; ++m) _Pragma("unroll") for (int n = 0; n < 2; ++n) _Pragma("unroll") for (int k = 0; k < 2; ++k) \
        acc[ai][bj][m][n] = __builtin_amdgcn_mfma_f32_16x16x32_bf16(Bt[n][k], At[m][k], acc[ai][bj][m][n], 0, 0, 0); } __builtin_amdgcn_s_setprio(0); } while (0)
#define PG8_MMA0(ai, bj, At, Bt) do { __builtin_amdgcn_s_setprio(1); _Pragma("unroll") for (int m = 0; m < 4; ++m) _Pragma("unroll") for (int n = 0; n < 2; ++n) \
        asm volatile("v_mfma_f32_16x16x128_f8f6f4 %0, %1, %2, 0" : "=&v"(acc[ai][bj][m][n]) : "v"(Bt##8[n]), "v"(At##8[m])); __builtin_amdgcn_s_setprio(0); } while (0)
#define PG8_WAIT_V(n) asm volatile("s_waitcnt vmcnt(" #n ")" ::: "memory")
#define PG8_WAIT_L(n) asm volatile("s_waitcnt lgkmcnt(" #n ")" ::: "memory")
#define PG8_WAIT_VX(sx) do { if ((sx) >= 48) PG8_WAIT_V(56); else if ((sx) >= 32) PG8_WAIT_V(40); else if ((sx) >= 24) PG8_WAIT_V(32); else if ((sx) >= 16) PG8_WAIT_V(24); else if ((sx) >= 8) PG8_WAIT_V(16); else PG8_WAIT_V(8); } while (0)
#define PG8_BAR __builtin_amdgcn_s_barrier()
#define PG8_SCHED __builtin_amdgcn_sched_barrier(0)
    Unit cur, nxt; int ui = 0, sx = 0;
    if (!S.next(0, cur)) return;
    f32x4 acc[2][2][4][2];
    if constexpr (!F8)
#pragma unroll
    for (int a = 0; a < 2; ++a)
#pragma unroll
        for (int b = 0; b < 2; ++b)
#pragma unroll
            for (int m = 0; m < 4; ++m)
#pragma unroll
                for (int n = 0; n < 2; ++n) acc[a][b][m][n] = (f32x4){0.f, 0.f, 0.f, 0.f};
    bf16x8 At[4][2], B0[2][2], B1[2][2]; i32x8 At8[4], B08[2], B18[2];
    unsigned oA[2][2]; S.a_off(cur, tid, oA);
    const char* cA = S.a_base(cur); const char* cB = S.b_base(cur);
    PG8_STAGE(PG8_SB(0, 0), cB, voffB); PG8_STAGE(PG8_SB(0, 1), cB + hstep, voffB); PG8_STAGE(PG8_SA(0, 0), cA, oA[0]); PG8_STAGE(PG8_SA(0, 1), cA, oA[1]);
    if (wr == 1) PG8_BAR;
    PG8_WAIT_V(2); PG8_BAR;
    PG8_STAGE(PG8_SB(1, 0), cB + kstep, voffB); PG8_STAGE(PG8_SA(1, 0), cA + kstep, oA[0]); PG8_STAGE(PG8_SB(1, 1), cB + hstep + kstep, voffB);
    PG8_WAIT_V(6); PG8_BAR;
    for (;;) {
        const bool has_next = S.next(ui + 1, nxt);
        const char* nA = has_next ? S.a_base(nxt) : cA; const char* nB = has_next ? S.b_base(nxt) : cB;
        for (int t = 0; t < nt; t += 2) {
            const bool last = (t == nt - 2); const int sxe = (t == 0) ? sx : 0;
            const char* a1 = cA + (size_t)(t + 1) * kstep;
            const char* a2 = last ? nA : cA + (size_t)(t + 2) * kstep; const char* b2 = last ? nB : cB + (size_t)(t + 2) * kstep;
            const char* a3 = a2 + kstep; const char* b3 = b2 + kstep;
            PG8_LDB(B0, 0, 0); PG8_LDB(B1, 0, 1); PG8_SCHED; PG8_LDA(At, 0, 0); PG8_STAGE(PG8_SA(1, 1), a1, oA[1]);
            if (last && has_next) S.a_off(nxt, tid, oA);
            PG8_WAIT_VX(sxe); PG8_WAIT_L(0); PG8_BAR; if (F8 && t == 0) { PG8_MMA0(0, 0, At, B0); PG8_MMA0(0, 1, At, B1); } else { PG8_MMA(0, 0, At, B0); PG8_MMA(0, 1, At, B1); } PG8_BAR; PG8_SCHED;
            PG8_LDA(At, 0, 1); PG8_STAGE(PG8_SB(0, 0), b2, voffB); PG8_STAGE(PG8_SB(0, 1), b2 + hstep, voffB); PG8_STAGE(PG8_SA(0, 0), a2, oA[0]);
            PG8_WAIT_VX(sxe); PG8_WAIT_L(0); PG8_BAR; if (F8 && t == 0) { PG8_MMA0(1, 0, At, B0); PG8_MMA0(1, 1, At, B1); } else { PG8_MMA(1, 0, At, B0); PG8_MMA(1, 1, At, B1); } PG8_BAR; PG8_SCHED;
            PG8_LDB(B0, 1, 0); PG8_LDB(B1, 1, 1); PG8_SCHED; PG8_LDA(At, 1, 0); PG8_STAGE(PG8_SA(0, 1), a2, oA[1]);
            PG8_WAIT_V(8); PG8_WAIT_L(0); PG8_BAR; PG8_MMA(0, 0, At, B0); PG8_MMA(0, 1, At, B1); PG8_BAR; PG8_SCHED;
            PG8_LDA(At, 1, 1); PG8_STAGE(PG8_SB(1, 0), b3, voffB); PG8_STAGE(PG8_SB(1, 1), b3 + hstep, voffB); PG8_STAGE(PG8_SA(1, 0), a3, oA[0]);
            PG8_WAIT_V(8); PG8_WAIT_L(0); PG8_BAR; PG8_MMA(1, 0, At, B0); PG8_MMA(1, 1, At, B1); PG8_BAR; PG8_SCHED;
        }
        if (wr == 0) PG8_BAR;
        if constexpr (F8) asm volatile("s_nop 15\n\ts_nop 15" ::: "memory");
        E(acc, cur, wr, wc, fr, fq);
        if (!has_next) break;
        if constexpr (!F8)
#pragma unroll
        for (int a = 0; a < 2; ++a)
#pragma unroll
            for (int b = 0; b < 2; ++b)
#pragma unroll
                for (int m = 0; m < 4; ++m)
#pragma unroll
                    for (int n = 0; n < 2; ++n) acc[a][b][m][n] = (f32x4){0.f, 0.f, 0.f, 0.f};
        cur = nxt; cA = nA; cB = nB; ++ui;
        if (wr == 1) PG8_BAR;
    }
    PG8_WAIT_V(0);
    PG8_BAR;
#undef PG8_SA
#undef PG8_SB
#undef PG8_STAGE
#undef PG8_LDA
#undef PG8_LDB
#undef PG8_MMA
#undef PG8_MMA0
#undef PG8_LD8
#undef PG8_WAIT_V
#undef PG8_WAIT_VX
#undef PG8_WAIT_L
#undef PG8_BAR
#undef PG8_SCHED
}
}
using pg8::Unit;

DI u32x4 pack8(const f32x4& v0, const f32x4& v1) { u32x4 w; w.x = cvt_pk_bf16(v0[0], v0[1]); w.y = cvt_pk_bf16(v0[2], v0[3]); w.z = cvt_pk_bf16(v1[0], v1[1]); w.w = cvt_pk_bf16(v1[2], v1[3]); return w; }

DI void st_pair16(unsigned char* px, int gap, u32x2 x, u32x2 y, int fq) {
    const auto r0 = __builtin_amdgcn_permlane16_swap(x.x, y.x, false, false), r1 = __builtin_amdgcn_permlane16_swap(x.y, y.y, false, false);
    *(GAS u32x4*)(px + ((fq & 1) ? gap - 8 : 0)) = (u32x4){r0[0], r1[0], r0[1], r1[1]};
}
DI size_t dil_row(int gh, int R) { const int s = 2 * (gh >> 3), bl = R >> 12, t = R & (SEQ - 1);
    return ((size_t)((gh * 8 + bl) * SEQ) + (size_t)((t & ((1 << s) - 1)) * (SEQ >> s) + (t >> s))) * 64; }
struct EpiIn {
    static constexpr bool PERM = true;
    bf16_t *qg, *kg, *vg, *sr, *qd, *kd, *vd, *gt; float* ha; const int* pos;
    DI int nvm(const Unit& u, int) const { return u.pn == 38 ? 0 : 16; }
    DI void operator()(const f32x4 (&acc)[2][2][4][2], const Unit& u, int wr, int wc, int fr, int fq) const {
        asm volatile("" : "+v"(fr), "+v"(fq));
        const int row0 = u.pm * 256 + wr * 64 + fr; const int pn = in_tile(u.pn);
        if (pn >= 12 && pn < 24) {
            bf16_t* base = pn < 18 ? qd : kd; const int tq = pn < 18 ? pn - 12 : pn - 18; const float sc = pn < 18 ? 0.125f * LOG2E * W8_INV : W8_INV;
            float fre[8];
#pragma unroll
            for (int i = 0; i < 8; ++i) fre[i] = __builtin_amdgcn_exp2f(-(float)(8 * fq + i) * (13.287712379549449f / 32.0f)) * 0.15915494309189535f;
            int posv[8];
#pragma unroll
            for (int q = 0; q < 8; ++q) posv[q] = ((const GAS int*)pos)[row0 + (q >> 2) * 128 + (q & 3) * 16];
#pragma unroll
            for (int ai = 0; ai < 2; ++ai) {
#pragma unroll
                for (int m = 0; m < 4; ++m) {
                    const int r = row0 + ai * 128 + m * 16; const float p = (float)posv[ai * 4 + m];
                    unsigned char* rowp = (unsigned char*)base + dil_row(4 * tq + wc, r) + 8 * fq;
                    u32x2 w1, w2;
#pragma unroll
                    for (int n = 0; n < 2; ++n) { f32x4 o1, o2;
#pragma unroll
                        for (int j = 0; j < 4; ++j) {
                            float a = p * fre[n * 4 + j]; a = a - __builtin_floorf(a);
                            const float sn = __builtin_amdgcn_sinf(a), cs = __builtin_amdgcn_cosf(a);
                            const float x1 = acc[ai][0][m][n][j], x2 = acc[ai][1][m][n][j];
                            o1[j] = (x1 * cs - x2 * sn) * sc; o2[j] = (x2 * cs + x1 * sn) * sc;
                        }
                        w1[n] = pk4_fp8(o1[0], o1[1], o1[2], o1[3]); w2[n] = pk4_fp8(o2[0], o2[1], o2[2], o2[3]); }
                    st_pair16(rowp, 32, w1, w2, fq);
                    asm volatile("" ::: "memory");
                } }
        } else if (pn == 38) {
            if (wc == 0 && fq < 2) {
#pragma unroll
                for (int ai = 0; ai < 2; ++ai)
#pragma unroll
                    for (int m = 0; m < 4; ++m) { float* p = ha + (size_t)(row0 + ai * 128 + m * 16) * 16 + 8 * fq; *(GAS f32x4*)p = acc[ai][0][m][0] * W8_INV; *(GAS f32x4*)(p + 4) = acc[ai][0][m][1] * W8_INV; }
            }
        } else {
            bf16_t* base; int ldc, colt, act = 0; float sc = W8_INV;
            if (pn < 2) { base = qg; ldc = 512; colt = pn * 256; sc = 0.08838834764831845f * W8_INV; }
            else if (pn < 4) { base = kg; ldc = 512; colt = (pn - 2) * 256; }
            else if (pn < 8) { base = vg; ldc = 1024; colt = (pn - 4) * 256; }
            else if (pn < 12) {
#pragma unroll
                for (int ai = 0; ai < 2; ++ai)
#pragma unroll
                    for (int m = 0; m < 4; ++m) { unsigned char* rowp = (unsigned char*)sr + (size_t)(row0 + ai * 128 + m * 16) * 1024 + (pn - 8) * 256 + wc * 32 + 8 * fq;
                        u32x2 o[2];
#pragma unroll
                        for (int bj = 0; bj < 2; ++bj) { const f32x4 v0 = acc[ai][bj][m][0] * W8_INV, v1 = acc[ai][bj][m][1] * W8_INV;
                            o[bj].x = pk4_fp8(v0[0] * sigmoidf_(v0[0]), v0[1] * sigmoidf_(v0[1]), v0[2] * sigmoidf_(v0[2]), v0[3] * sigmoidf_(v0[3]));
                            o[bj].y = pk4_fp8(v1[0] * sigmoidf_(v1[0]), v1[1] * sigmoidf_(v1[1]), v1[2] * sigmoidf_(v1[2]), v1[3] * sigmoidf_(v1[3])); }
                        st_pair16(rowp, 128, o[0], o[1], fq); }
                return; }
            else if (pn < 30) {
#pragma unroll
                for (int ai = 0; ai < 2; ++ai)
#pragma unroll
                    for (int m = 0; m < 4; ++m) { unsigned char* rowp = (unsigned char*)vd + dil_row(4 * (pn - 24) + (wc >> 1), row0 + ai * 128 + m * 16) + (wc & 1) * 32 + 8 * fq;
                        u32x2 o[2];
#pragma unroll
                        for (int bj = 0; bj < 2; ++bj) { const f32x4 v0 = acc[ai][bj][m][0] * W8_INV, v1 = acc[ai][bj][m][1] * W8_INV; o[bj].x = pk4_fp8(v0[0], v0[1], v0[2], v0[3]); o[bj].y = pk4_fp8(v1[0], v1[1], v1[2], v1[3]); }
                        st_pair16(rowp, 2 * 8 * SEQ * 64, o[0], o[1], fq); }
                return; }
            else {
#pragma unroll
                for (int ai = 0; ai < 2; ++ai)
#pragma unroll
                    for (int m = 0; m < 4; ++m) { unsigned char* rowp = (unsigned char*)gt + (size_t)(row0 + ai * 128 + m * 16) * 2048 + (pn - 30) * 256 + wc * 32 + 8 * fq;
                        u32x2 o[2];
#pragma unroll
                        for (int bj = 0; bj < 2; ++bj) {
#pragma unroll
                            for (int n = 0; n < 2; ++n) { const f32x4 v = acc[ai][bj][m][n];
                                o[bj][n] = (unsigned)(sigmoid64_(v[0]) * 255.0f + 0.5f) | ((unsigned)(sigmoid64_(v[1]) * 255.0f + 0.5f) << 8) | ((unsigned)(sigmoid64_(v[2]) * 255.0f + 0.5f) << 16) | ((unsigned)(sigmoid64_(v[3]) * 255.0f + 0.5f) << 24); } }
                        st_pair16(rowp, 128, o[0], o[1], fq); }
                return; }
#pragma unroll
            for (int ai = 0; ai < 2; ++ai)
#pragma unroll
                for (int m = 0; m < 4; ++m) { bf16_t* rowp = base + (size_t)(row0 + ai * 128 + m * 16) * ldc + colt + wc * 32 + 8 * fq;
#pragma unroll
                    for (int bj = 0; bj < 2; ++bj) { f32x4 v0 = acc[ai][bj][m][0] * sc, v1 = acc[ai][bj][m][1] * sc;
                        if (act) {
#pragma unroll
                            for (int j = 0; j < 4; ++j) { const float s0 = sigmoidf_(v0[j]), s1 = sigmoidf_(v1[j]); v0[j] = act == 1 ? v0[j] * s0 : s0; v1[j] = act == 1 ? v1[j] * s1 : s1; } }
                        *(GAS u32x4*)(rowp + bj * 128) = pack8(v0, v1); } }
        }
    }
};
template <bool ADD> struct EpiGate {
    static constexpr bool PERM = true;
    bf16_t* mix; const unsigned char* gt; unsigned char* mix8;
    DI int nvm(const Unit&, int) const { return ADD ? 48 : 32; }
    DI void operator()(const f32x4 (&acc)[2][2][4][2], const Unit& u, int wr, int wc, int fr, int fq) const {
        asm volatile("" : "+v"(fr), "+v"(fq));
        const int row0 = u.pm * 256 + wr * 64 + fr, col0 = u.pn * 256 + wc * 32 + 8 * fq; constexpr float k = W8_INV / 255.0f;
        u32x2 g[2][4][2];
#pragma unroll
        for (int ai = 0; ai < 2; ++ai)
#pragma unroll
            for (int m = 0; m < 4; ++m)
#pragma unroll
                for (int bj = 0; bj < 2; ++bj) g[ai][m][bj] = *(const GAS u32x2*)(gt + (size_t)(row0 + ai * 128 + m * 16) * 2048 + col0 + bj * 128);
#pragma unroll
        for (int ai = 0; ai < 2; ++ai) {
            u32x2 ov[4][2];
            if (ADD) {
#pragma unroll
                for (int m = 0; m < 4; ++m)
#pragma unroll
                    for (int bj = 0; bj < 2; ++bj) ov[m][bj] = *(const GAS u32x2*)((const GAS unsigned char*)mix + (size_t)(row0 + ai * 128 + m * 16) * 1024 + col0 + bj * 128);
            }
            asm volatile("" ::: "memory");
#pragma unroll
            for (int m = 0; m < 4; ++m) { const size_t r = (size_t)(row0 + ai * 128 + m * 16); u32x2 o8v[2];
#pragma unroll
                for (int bj = 0; bj < 2; ++bj) {
                    const u32x2 gg = g[ai][m][bj];
                    f32x4 v0 = acc[ai][bj][m][0], v1 = acc[ai][bj][m][1];
                    v0[0] *= (float)((gg.x >> 0) & 0xffu) * k; v0[1] *= (float)((gg.x >> 8) & 0xffu) * k; v0[2] *= (float)((gg.x >> 16) & 0xffu) * k; v0[3] *= (float)((gg.x >> 24) & 0xffu) * k;
                    v1[0] *= (float)((gg.y >> 0) & 0xffu) * k; v1[1] *= (float)((gg.y >> 8) & 0xffu) * k; v1[2] *= (float)((gg.y >> 16) & 0xffu) * k; v1[3] *= (float)((gg.y >> 24) & 0xffu) * k;
                    if (ADD) { const u32x2 o = ov[m][bj]; const f32x2 oa = __builtin_amdgcn_cvt_pk_f32_fp8((int)o.x, false), ob = __builtin_amdgcn_cvt_pk_f32_fp8((int)o.x, true), oc = __builtin_amdgcn_cvt_pk_f32_fp8((int)o.y, false), od = __builtin_amdgcn_cvt_pk_f32_fp8((int)o.y, true);
                        v0[0] += oa[0]; v0[1] += oa[1]; v0[2] += ob[0]; v0[3] += ob[1]; v1[0] += oc[0]; v1[1] += oc[1]; v1[2] += od[0]; v1[3] += od[1];
                    }
                    o8v[bj].x = pk4_fp8(v0[0], v0[1], v0[2], v0[3]); o8v[bj].y = pk4_fp8(v1[0], v1[1], v1[2], v1[3]); }
                st_pair16((ADD ? mix8 : (unsigned char*)mix) + r * 1024 + col0, 128, o8v[0], o8v[1], fq); }
        }
    }
};
struct EpiRes {
    static constexpr bool PERM = true;
    const float* x32; bf16_t* xr;
    DI int nvm(const Unit&, int) const { return 32; }
    DI void operator()(const f32x4 (&acc)[2][2][4][2], const Unit& u, int wr, int wc, int fr, int fq) const {
        asm volatile("" : "+v"(fr), "+v"(fq));
        const int row0 = u.pm * 256 + wr * 64 + fr, col0 = u.pn * 256 + wc * 32 + 8 * fq;
        if (x32) {
#pragma unroll
            for (int ai = 0; ai < 2; ++ai)
#pragma unroll
                for (int m2 = 0; m2 < 4; m2 += 2) { f32x4 a[2][2][2];
#pragma unroll
                    for (int mm = 0; mm < 2; ++mm)
#pragma unroll
                        for (int bj = 0; bj < 2; ++bj) { const size_t off = (size_t)(row0 + ai * 128 + (m2 + mm) * 16) * 1024 + col0 + bj * 128; a[mm][bj][0] = *(const GAS f32x4*)(x32 + off); a[mm][bj][1] = *(const GAS f32x4*)(x32 + off + 4); }
                    asm volatile("" ::: "memory");
#pragma unroll
                    for (int mm = 0; mm < 2; ++mm)
#pragma unroll
                        for (int bj = 0; bj < 2; ++bj) { const size_t off = (size_t)(row0 + ai * 128 + (m2 + mm) * 16) * 1024 + col0 + bj * 128;
                            *(GAS u32x4*)(xr + off) = pack8(a[mm][bj][0] * DN_ALPHA + acc[ai][bj][m2 + mm][0] * W8_INV, a[mm][bj][1] * DN_ALPHA + acc[ai][bj][m2 + mm][1] * W8_INV); }
                    asm volatile("" ::: "memory"); }
        } else {
#pragma unroll
            for (int ai = 0; ai < 2; ++ai) { u32x4 o[4][2];
#pragma unroll
                for (int m = 0; m < 4; ++m)
#pragma unroll
                    for (int bj = 0; bj < 2; ++bj) o[m][bj] = *(const GAS u32x4*)(xr + (size_t)(row0 + ai * 128 + m * 16) * 1024 + col0 + bj * 128);
                asm volatile("" ::: "memory");
#pragma unroll
                for (int m = 0; m < 4; ++m)
#pragma unroll
                    for (int bj = 0; bj < 2; ++bj) { const u32x4 q = o[m][bj]; const f32x4 a0 = (f32x4){bf_lo(q.x), bf_hi(q.x), bf_lo(q.y), bf_hi(q.y)}, a1 = (f32x4){bf_lo(q.z), bf_hi(q.z), bf_lo(q.w), bf_hi(q.w)};
                        *(GAS u32x4*)(xr + (size_t)(row0 + ai * 128 + m * 16) * 1024 + col0 + bj * 128) = pack8(a0 * DN_ALPHA + acc[ai][bj][m][0] * W8_INV, a1 * DN_ALPHA + acc[ai][bj][m][1] * W8_INV); }
                asm volatile("" ::: "memory"); }
        }
    }
};
struct EpiM1 {
    static constexpr bool PERM = true;
    unsigned char* hm;
    DI int nvm(const Unit&, int) const { return 8; }
    DI void operator()(const f32x4 (&acc)[2][2][4][2], const Unit& u, int wr, int wc, int fr, int fq) const {
        asm volatile("" : "+v"(fr), "+v"(fq));
        const int row0 = u.pm * 256 + wr * 64 + fr, col0 = u.pn * 128 + wc * 32 + 8 * fq;
#pragma unroll
        for (int ai = 0; ai < 2; ++ai)
#pragma unroll
            for (int m2 = 0; m2 < 4; m2 += 2) { u32x2 o[2];
#pragma unroll
                for (int mm = 0; mm < 2; ++mm) { const int m = m2 + mm; f32x4 v0, v1;
#pragma unroll
                    for (int j = 0; j < 4; ++j) { const float g0 = acc[ai][0][m][0][j], g1 = acc[ai][0][m][1][j]; v0[j] = g0 * sigmoid64_(g0) * (acc[ai][1][m][0][j] * (W8_INV * W8_INV)); v1[j] = g1 * sigmoid64_(g1) * (acc[ai][1][m][1][j] * (W8_INV * W8_INV)); }
                    o[mm].x = pk4_fp8(v0[0], v0[1], v0[2], v0[3]); o[mm].y = pk4_fp8(v1[0], v1[1], v1[2], v1[3]); }
                st_pair16(hm + (size_t)(row0 + ai * 128 + m2 * 16) * 1024 + col0, 16 * 1024, o[0], o[1], fq); }
    }
};
struct EpiM2 {
    static constexpr bool PERM = true;
    unsigned char* ys; const int* list; const volatile LAS int* pre;
    DI int nvm(const Unit& u, int) const { return u.nv == 256 ? 24 : 8; }
    DI void operator()(const f32x4 (&acc)[2][2][4][2], const Unit& u, int wr, int wc, int fr, int fq) const {
        asm volatile("" : "+v"(fr), "+v"(fq));
        const int lrow0 = wr * 64 + fr, col0 = u.pn * 256 + wc * 32 + 8 * fq; const int lt = u.pm - rfl(pre[u.e]);
        const int* lp = list + (size_t)u.e * T + 256 * lt;
        int slotv[8];
#pragma unroll
        for (int q = 0; q < 8; ++q) { const int r = lrow0 + (q >> 2) * 128 + (q & 3) * 16; slotv[q] = ((const GAS int*)lp)[r < u.nv ? r : 0]; }
#pragma unroll
        for (int ai = 0; ai < 2; ++ai)
#pragma unroll
            for (int m = 0; m < 4; ++m) { const int r = lrow0 + ai * 128 + m * 16;
                if (r < u.nv) { const int slot = slotv[ai * 4 + m]; unsigned char* yp = ys + (size_t)slot * 1024 + col0;
                    u32x2 o[2];
#pragma unroll
                    for (int bj = 0; bj < 2; ++bj) { const f32x4 v0 = acc[ai][bj][m][0] * W8_INV, v1 = acc[ai][bj][m][1] * W8_INV; o[bj].x = pk4_fp8(v0[0], v0[1], v0[2], v0[3]); o[bj].y = pk4_fp8(v1[0], v1[1], v1[2], v1[3]); }
                    st_pair16(yp, 128, o[0], o[1], fq); } }
    }
};

struct WItem { const float* W; unsigned char* WT; int N, K, drow, c0, nv, kb; };
DI WItem w_decode(const Ctx& c, int l, int it) {
    constexpr int I_IN = (NIN / 32) * 16, I_GO = 512, I_AO = 256, I_OUT = 512, I_EXP = 16 * 512;
    WItem w; int r = it;
    if (r < I_IN) {
        const int nbg = r >> 4, kb = r & 15, pn0 = 32 * nbg, tile = in_tile(pn0 >> 8), p = pn0 & 255, n0 = tile * 256 + p; int c0, nv = 32;
        if (tile < 12) c0 = n0;
        else if (tile < 24) { const int base = tile < 18 ? 3088 : 4624, tq = tile < 18 ? tile - 12 : tile - 18; c0 = base + (4 * tq + ((p & 127) >> 5)) * 64 + (p >= 128 ? 32 : 0); }
        else if (tile < 30) c0 = 6160 + (n0 - 24 * 256);
        else if (tile < 38) c0 = 7696 + (n0 - 30 * 256);
        else { c0 = 3072; nv = (p == 0) ? 16 : 0; }
        w.W = c.w_in + (size_t)l * D * DIN; w.N = DIN; w.WT = c.ws + wset(l) + WS_WIN; w.K = D; w.drow = pn0; w.c0 = c0; w.nv = nv; w.kb = kb; return w; }
    r -= I_IN;
    if (r < I_GO) { w.W = c.w_gla_o + (size_t)l * D * D; w.N = D; w.WT = c.ws + wset(l) + WS_WGO; w.K = D; w.drow = 32 * (r >> 4); w.c0 = w.drow; w.nv = 32; w.kb = r & 15; return w; }
    r -= I_GO;
    if (r < I_AO) { w.W = c.w_att_o + (size_t)l * 512 * D; w.N = D; w.WT = c.ws + wset(l) + WS_WAO; w.K = 512; w.drow = 32 * (r >> 3); w.c0 = w.drow; w.nv = 32; w.kb = r & 7; return w; }
    r -= I_AO;
    if (r < I_OUT) { w.W = c.w_out + (size_t)l * D * D; w.N = D; w.WT = c.ws + wset(l) + WS_WOUT; w.K = D; w.drow = 32 * (r >> 4); w.c0 = w.drow; w.nv = 32; w.kb = r & 15; return w; }
    r -= I_OUT;
    const int which = r / I_EXP; r -= which * I_EXP; const int e = r >> 9, q = r & 511, nbg = q >> 4; const size_t eoff = (size_t)(l * NEXP + e) * D * DFF;
    w.N = DFF; w.K = D; w.c0 = 32 * nbg; w.nv = 32; w.kb = q & 15;
    if (which == 0) { w.W = c.w_e_gate + eoff; w.WT = c.ws + wset(l) + WS_WGU + (size_t)e * 2048 * 1024; w.drow = 256 * (nbg >> 2) + 32 * (nbg & 3); }
    else if (which == 1) { w.W = c.w_e_up + eoff; w.WT = c.ws + wset(l) + WS_WGU + (size_t)e * 2048 * 1024; w.drow = 256 * (nbg >> 2) + 128 + 32 * (nbg & 3); }
    else { w.W = c.w_e_down + eoff; w.N = D; w.K = DFF; w.WT = c.ws + wset(l) + WS_WD + (size_t)e * 1024 * 1024; w.drow = 32 * nbg; }
    return w;
}
DI void w_load(const WItem& w, int lane, float (&v)[32]) {
    const int cc = lane & 31, ccl = cc < w.nv ? cc : 0; const GAS float* wp = (const GAS float*)w.W + (size_t)(64 * w.kb + (lane >> 5)) * w.N + w.c0 + ccl;
#pragma unroll
    for (int i = 0; i < 32; ++i) v[i] = wp[(size_t)(2 * i) * w.N];
}
DI void w_store(const WItem& w, int lane, const float (&v)[32], LAS float* scr) {
    const int cc = lane & 31, k0 = 64 * w.kb;
#pragma unroll
    for (int i = 0; i < 32; ++i) scr[(2 * i + (lane >> 5)) * 33 + cc] = (cc < w.nv) ? v[i] : 0.f;
    LDS_WAIT(); asm volatile("" ::: "memory");
    const int c = lane & 7;
#pragma unroll
    for (int j = 0; j < 4; ++j) { const int n = (lane >> 3) + 8 * j; const LAS float* s = scr + (8 * c) * 33 + n;
        u32x2 o; o.x = pk4_fp8(s[0 * 33] * W8_SCALE, s[1 * 33] * W8_SCALE, s[2 * 33] * W8_SCALE, s[3 * 33] * W8_SCALE); o.y = pk4_fp8(s[4 * 33] * W8_SCALE, s[5 * 33] * W8_SCALE, s[6 * 33] * W8_SCALE, s[7 * 33] * W8_SCALE);
        *(GAS u32x2*)(w.WT + (size_t)(w.drow + n) * w.K + k0 + 8 * c) = o; }
    LDS_WAIT(); asm volatile("" ::: "memory");
}
constexpr int W_NITEMS = (NIN / 32) * 16 + 512 + 256 + 512 + 3 * 16 * 512, W_NTK = (W_NITEMS + 31) / 32;
DI void w_tickets(LAS unsigned char* lds, const Ctx& c, int l, int budget) {
    const int tid = ltid(), lane = tid & 63, wave = rfl(tid >> 6);
    LAS float* scr = (LAS float*)(lds + wave * 16384);
    volatile LAS int* TK = (volatile LAS int*)(lds + MISC_OFF + 208);
    GAS unsigned* ctr = (GAS unsigned*)((unsigned*)(c.ws + WS_CTL) + CW_WTK + l * 64);
    float va[32], vb[32]; WItem wa, wb;
    for (int k = 0; k < budget; ++k) {
        __syncthreads();
        if (tid == 0) TK[0] = (int)__hip_atomic_fetch_add(ctr, 1u, __ATOMIC_RELAXED, __HIP_MEMORY_SCOPE_AGENT);
        __syncthreads();
        const int t = rfl(TK[0]); if (t >= W_NTK) break;
        const int i0 = 32 * t + wave, i1 = i0 + 8, i2 = i0 + 16, i3 = i0 + 24;
        if (i0 < W_NITEMS) { wa = w_decode(c, l, i0); w_load(wa, lane, va); }
        if (i1 < W_NITEMS) { wb = w_decode(c, l, i1); w_load(wb, lane, vb); }
        if (i0 < W_NITEMS) w_store(wa, lane, va, scr);
        if (i2 < W_NITEMS) { wa = w_decode(c, l, i2); w_load(wa, lane, va); }
        if (i1 < W_NITEMS) w_store(wb, lane, vb, scr);
        if (i3 < W_NITEMS) { wb = w_decode(c, l, i3); w_load(wb, lane, vb); }
        if (i2 < W_NITEMS) w_store(wa, lane, va, scr);
        if (i3 < W_NITEMS) w_store(wb, lane, vb, scr);
    }
}
DI void phase_w(LAS unsigned char* lds, const Ctx& c, int l, int G) {
    const int tid = ltid();
    w_tickets(lds, c, l, 1 << 30);
    if (l == 0) {
        const size_t n8 = (size_t)T * D / 8; unsigned char* xb = c.ws + WS_XB;
        const size_t st = (size_t)G * NTHREADS;
        for (size_t i0 = (size_t)lbid() * NTHREADS + tid; i0 < n8; i0 += 4 * st) {
            f32x4 a[4], b[4];
#pragma unroll
            for (int q = 0; q < 4; ++q) { const size_t i = i0 + q * st < n8 ? i0 + q * st : i0; a[q] = *(const GAS f32x4*)(c.x + i * 8); b[q] = *(const GAS f32x4*)(c.x + i * 8 + 4); }
#pragma unroll
            for (int q = 0; q < 4; ++q) { const size_t i = i0 + q * st; if (i < n8) { u32x2 o; o.x = pk4_fp8(a[q][0], a[q][1], a[q][2], a[q][3]); o.y = pk4_fp8(b[q][0], b[q][1], b[q][2], b[q][3]); *(GAS u32x2*)(xb + i * 8) = o; } }
        }
    }
}

DI s16x4 tr16(const LAS void* p) { return __builtin_bit_cast(s16x4, __builtin_amdgcn_ds_read_tr16_b64_v4i16((LAS s16x4*)p)); }
DI bf16x8 cat8(s16x4 lo, s16x4 hi) { return __builtin_shufflevector(lo, hi, 0, 1, 2, 3, 4, 5, 6, 7); }
#define MFMA16(a, b, c) __builtin_amdgcn_mfma_f32_16x16x32_bf16((a), (b), (c), 0, 0, 0)

constexpr int REC_BYTES = 33792, REC_KS = 16384, REC_DEC = 32768, OI_BYTES = 16384;
constexpr int GP_QT = 0, GP_KT = 17408, GP_VS = 34816, GP_ATT = 68608, GP_WUP = 77824, GP_BAL = 86016;
DI float exp_(float x) { return __builtin_amdgcn_exp2f(x * LOG2E); }
DI void unpack8(const u32x4& q, float (&v)[16], int o) { v[o] = bf_lo(q.x); v[o + 1] = bf_hi(q.x); v[o + 2] = bf_lo(q.y); v[o + 3] = bf_hi(q.y); v[o + 4] = bf_lo(q.z); v[o + 5] = bf_hi(q.z); v[o + 6] = bf_lo(q.w); v[o + 7] = bf_hi(q.w); }
DI u32x4 packf8(const float (&v)[16], int o) { u32x4 p; p.x = cvt_pk_bf16(v[o], v[o + 1]); p.y = cvt_pk_bf16(v[o + 2], v[o + 3]); p.z = cvt_pk_bf16(v[o + 4], v[o + 5]); p.w = cvt_pk_bf16(v[o + 6], v[o + 7]); return p; }
#define DPP0(x, ctrl, row_mask) __builtin_bit_cast(float, __builtin_amdgcn_update_dpp(0, __builtin_bit_cast(int, (x)), (ctrl), (row_mask), 0xf, false))
DI float scan64(float x) {
    x += DPP0(x, 0x111, 0xf); x += DPP0(x, 0x112, 0xf); x += DPP0(x, 0x114, 0xf); x += DPP0(x, 0x118, 0xf);
    x += DPP0(x, 0x142, 0xa); x += DPP0(x, 0x143, 0xc);
    return x;
}
DI void gla_p_unit(LAS unsigned char* lds, const Ctx& c, int l, int bl, int h, int n, int& h_loaded) {
    const int tid = ltid(), lane = tid & 63, w = rfl(tid >> 6), fr = lane & 15, fq = lane >> 4;
    const size_t tok0 = (size_t)bl * SEQ + n * 64;
    const bf16_t* QG = wsb(c, WS_H + H_QG) + tok0 * 512 + h * 128;
    const bf16_t* KG = wsb(c, WS_H + H_KG) + tok0 * 512 + h * 128;
    const bf16_t* VG = wsb(c, WS_H + H_VG) + tok0 * 1024 + h * 256;
    const float* HA = (const float*)(c.ws + WS_HA) + tok0 * 16;
    const int unit = (bl * 4 + h) * 64 + n;
    unsigned char* rec = c.ws + WS_REC + (size_t)unit * REC_BYTES;
    unsigned char* oi = c.ws + WS_MIX + (size_t)unit * OI_BYTES;
    LAS bf16_t* QT = (LAS bf16_t*)(lds + GP_QT); LAS bf16_t* KT = (LAS bf16_t*)(lds + GP_KT); LAS bf16_t* VS = (LAS bf16_t*)(lds + GP_VS); LAS bf16_t* AT = (LAS bf16_t*)(lds + GP_ATT);
    LAS float* WUP = (LAS float*)(lds + GP_WUP); LAS float* BAL = (LAS float*)(lds + GP_BAL);
    __syncthreads();
    if (h_loaded != h) { for (int i = tid; i < 16 * 128; i += NTHREADS) WUP[i] = ((const GAS float*)c.w_alpha_up)[(size_t)l * 16 * 512 + (i >> 7) * 512 + h * 128 + (i & 127)];
        if (tid < 128) BAL[tid] = ((const GAS float*)c.b_alpha)[l * 512 + h * 128 + tid]; h_loaded = h; __syncthreads(); }
    {
        const int row = lane;
        f32x4 a4[4];
#pragma unroll
        for (int j = 0; j < 4; ++j) a4[j] = *(const GAS f32x4*)(HA + (size_t)row * 16 + 4 * j);
        const u32x4 q0 = *(const GAS u32x4*)(QG + (size_t)row * 512 + 16 * w), q1 = *(const GAS u32x4*)(QG + (size_t)row * 512 + 16 * w + 8);
        const u32x4 k0 = *(const GAS u32x4*)(KG + (size_t)row * 512 + 16 * w), k1 = *(const GAS u32x4*)(KG + (size_t)row * 512 + 16 * w + 8);
#pragma unroll
        for (int c2 = 0; c2 < 4; ++c2) { const int idx = tid + NTHREADS * c2, r = idx >> 5, ch = idx & 31; *(LAS u32x4*)(VS + r * 264 + ch * 8) = *(const GAS u32x4*)(VG + (size_t)r * 1024 + ch * 8); }
        float la[16];
        {
            f32x2 la2[8];
#pragma unroll
            for (int c2 = 0; c2 < 8; ++c2) la2[c2] = *(const LAS f32x2*)(BAL + 16 * w + 2 * c2);
#pragma unroll
            for (int j = 0; j < 16; ++j) { const float aj = a4[j >> 2][j & 3]; const f32x2 aj2 = (f32x2){aj, aj};
#pragma unroll
                for (int c4 = 0; c4 < 4; ++c4) { const f32x4 wv = *(const LAS f32x4*)(WUP + j * 128 + 16 * w + 4 * c4); la2[2 * c4] = aj2 * __builtin_shufflevector(wv, wv, 0, 1) + la2[2 * c4]; la2[2 * c4 + 1] = aj2 * __builtin_shufflevector(wv, wv, 2, 3) + la2[2 * c4 + 1]; } }
#pragma unroll
            for (int c2 = 0; c2 < 8; ++c2) { la[2 * c2] = la2[c2][0]; la[2 * c2 + 1] = la2[c2][1]; }
        }
#pragma unroll
        for (int cc = 0; cc < 16; ++cc) { const float z = la[cc]; la[cc] = -(fmaxf(-z, 0.f) + __builtin_amdgcn_logf(1.0f + exp_(-fabsf(z))) * 0.6931471805599453f) * (1.0f / 16.0f); }
#pragma unroll
        for (int cc = 0; cc < 16; ++cc) la[cc] = scan64(la[cc]);
        float qv[16], kv[16];
        unpack8(q0, qv, 0); unpack8(q1, qv, 8); unpack8(k0, kv, 0); unpack8(k1, kv, 8);
        float dc[16];
#pragma unroll
        for (int cc = 0; cc < 16; ++cc) { const float b = la[cc]; const float bend = __shfl(b, 63); const float eb = exp_(b); dc[cc] = eb; qv[cc] *= eb; la[cc] = kv[cc] * exp_(bend - b); kv[cc] *= exp_(-b); }
        if (lane == 63) {
#pragma unroll
            for (int c4 = 0; c4 < 4; ++c4) *(GAS f32x4*)(rec + REC_DEC + (16 * w + 4 * c4) * 4) = (f32x4){dc[4 * c4], dc[4 * c4 + 1], dc[4 * c4 + 2], dc[4 * c4 + 3]}; }
        const u32x4 qa = packf8(qv, 0), qb = packf8(qv, 8), ka = packf8(kv, 0), kb = packf8(kv, 8), sa = packf8(la, 0), sb = packf8(la, 8);
        *(LAS u32x4*)(QT + row * 136 + 16 * w) = qa; *(LAS u32x4*)(QT + row * 136 + 16 * w + 8) = qb;
        *(LAS u32x4*)(KT + row * 136 + 16 * w) = ka; *(LAS u32x4*)(KT + row * 136 + 16 * w + 8) = kb;
        *(GAS u32x4*)(rec + row * 256 + (((2 * w) ^ (row & 15)) << 4)) = qa; *(GAS u32x4*)(rec + row * 256 + (((2 * w + 1) ^ (row & 15)) << 4)) = qb;
        *(GAS u32x4*)(rec + REC_KS + row * 256 + (((2 * w) ^ (2 * (row & 7))) << 4)) = sa; *(GAS u32x4*)(rec + REC_KS + row * 256 + (((2 * w + 1) ^ (2 * (row & 7))) << 4)) = sb;
    }
    __syncthreads();
#pragma unroll
    for (int rep = 0; rep < 2; ++rep) {
        const int tt = w + 8 * rep, jt = tt >> 2, it = tt & 3;
        f32x4 a = (f32x4){0.f, 0.f, 0.f, 0.f};
        if (jt <= it) {
#pragma unroll
            for (int k4 = 0; k4 < 4; ++k4) { const bf16x8 af = *(const LAS bf16x8*)(KT + (16 * jt + fr) * 136 + 32 * k4 + 8 * fq), bfr = *(const LAS bf16x8*)(QT + (16 * it + fr) * 136 + 32 * k4 + 8 * fq); a = MFMA16(af, bfr, a); }
        }
        const int i = 16 * it + fr, j0 = 16 * jt + 4 * fq;
        u32x2 o; o.x = cvt_pk_bf16(j0 <= i ? a[0] : 0.f, j0 + 1 <= i ? a[1] : 0.f); o.y = cvt_pk_bf16(j0 + 2 <= i ? a[2] : 0.f, j0 + 3 <= i ? a[3] : 0.f);
        *(LAS u32x2*)(AT + i * 72 + j0) = o;
    }
    __syncthreads();
    {
        const int dv0 = 32 * w;
        bf16x8 vb[2][2];
#pragma unroll
        for (int k2 = 0; k2 < 2; ++k2)
#pragma unroll
            for (int dt = 0; dt < 2; ++dt) { const LAS bf16_t* p = VS + (32 * k2 + 8 * fq + (fr >> 2)) * 264 + dv0 + 16 * dt + (fr & 3) * 4; vb[k2][dt] = cat8(tr16(p), tr16(p + 4 * 264)); }
#pragma unroll
        for (int tt = 0; tt < 4; ++tt) {
            const bf16x8 a0 = *(const LAS bf16x8*)(AT + (16 * tt + fr) * 72 + 8 * fq), a1 = *(const LAS bf16x8*)(AT + (16 * tt + fr) * 72 + 32 + 8 * fq);
#pragma unroll
            for (int dt = 0; dt < 2; ++dt) { f32x4 z = (f32x4){0.f, 0.f, 0.f, 0.f}; z = MFMA16(vb[0][dt], a0, z); z = MFMA16(vb[1][dt], a1, z);
                *(GAS unsigned*)(oi + ((w * 8 + tt * 2 + dt) * 64 + lane) * 4) = pk4_fp8(z[0], z[1], z[2], z[3]); }
        }
    }
}
constexpr int GSEG = 16, NSEG = 64 / GSEG;
constexpr int GL_STAGE = 50176, GL_DEC = 16384, GL_VS = 17408;
static_assert(3 * GL_STAGE <= MISC_OFF, "light-chain stages");
DI void gla_l_chain(LAS unsigned char* lds, const Ctx& c, int bl, int h, int seg) {
    const int tid = ltid(), lane = tid & 63, w = rfl(tid >> 6), fr = lane & 15, fq = lane >> 4;
    const size_t t0 = (size_t)bl * SEQ + (size_t)seg * (GSEG * 64);
    const bf16_t* VG = wsb(c, WS_H + H_VG) + t0 * 1024 + h * 256;
    const unsigned char* rec0 = c.ws + WS_REC + (size_t)((bl * 4 + h) * 64 + seg * GSEG) * REC_BYTES;
    const int dv0 = 32 * w; const unsigned lds_u = (unsigned)(uintptr_t)lds;
    f32x4 S[8][2], Dc[8];
#pragma unroll
    for (int a = 0; a < 8; ++a) { S[a][0] = (f32x4){0.f, 0.f, 0.f, 0.f}; S[a][1] = (f32x4){0.f, 0.f, 0.f, 0.f}; Dc[a] = (f32x4){1.f, 1.f, 1.f, 1.f}; }
#define GL_DMA(gp, ldsoff) do { unsigned _sv; const unsigned _m = (unsigned)__builtin_amdgcn_readfirstlane((int)(ldsoff)); \
        asm volatile("s_mov_b32 %0, m0\n\ts_mov_b32 m0, %2\n\ts_nop 0\n\tglobal_load_lds_dwordx4 %1, off\n\ts_mov_b32 m0, %0" : "=&s"(_sv) : "v"(gp), "s"(_m) : "memory"); } while (0)
#define GL_PREFETCH(nn, st) do { const unsigned char* _r = rec0 + (size_t)(nn) * REC_BYTES + REC_KS; const unsigned _s = lds_u + (unsigned)(st) * GL_STAGE; \
        _Pragma("unroll") for (int _p = 0; _p < 2; ++_p) GL_DMA((const GAS unsigned char*)(_r + (w * 2 + _p) * 1024 + lane * 16), _s + (w * 2 + _p) * 1024); \
        if (w == 0) GL_DMA((const GAS unsigned char*)(_r + 16384 + lane * 16), _s + GL_DEC); \
        _Pragma("unroll") for (int _p = 0; _p < 4; ++_p) { const int _row = 2 * (w * 4 + _p) + (lane >> 5); \
            GL_DMA((const GAS bf16_t*)(VG + (size_t)((nn) * 64 + _row) * 1024 + (((lane & 31) ^ (2 * (_row & 3))) << 3)), _s + GL_VS + (w * 4 + _p) * 1024); } } while (0)
    __syncthreads();
    GL_PREFETCH(0, 0); GL_PREFETCH(1, 1);
    int st = 0;
    for (int n = 0; n < GSEG; ++n) {
        LAS unsigned char* sb_ = lds + st * GL_STAGE;
        LAS bf16_t* KS = (LAS bf16_t*)sb_; LAS float* DEC = (LAS float*)(sb_ + GL_DEC); LAS bf16_t* VS = (LAS bf16_t*)(sb_ + GL_VS);
        if (n + 1 < GSEG) { if (w == 0) asm volatile("s_waitcnt vmcnt(7)" ::: "memory"); else asm volatile("s_waitcnt vmcnt(6)" ::: "memory"); } else VM_WAIT();
        asm volatile("s_waitcnt lgkmcnt(0)" ::: "memory"); __builtin_amdgcn_s_barrier(); asm volatile("" ::: "memory");
        if (n + 2 < GSEG) GL_PREFETCH(n + 2, st == 0 ? 2 : st - 1);
        bf16x8 vb[2][2];
#pragma unroll
        for (int k2 = 0; k2 < 2; ++k2)
#pragma unroll
            for (int dt = 0; dt < 2; ++dt) { const int r0 = 32 * k2 + 8 * fq + (fr >> 2);
                const LAS bf16_t* p = VS + r0 * 256 + ((((dv0 + 16 * dt) >> 3) ^ (2 * (r0 & 3))) << 3) + (fr & 3) * 4; vb[k2][dt] = cat8(tr16(p), tr16(p + 4 * 256)); }
#pragma unroll
        for (int k8 = 0; k8 < 8; ++k8) {
            const f32x4 dc = *(const LAS f32x4*)(DEC + 16 * k8 + 4 * fq);
            S[k8][0] *= dc; S[k8][1] *= dc; Dc[k8] *= dc;
#pragma unroll
            for (int k2 = 0; k2 < 2; ++k2) { const int r0 = 32 * k2 + 8 * fq + (fr >> 2);
                const LAS bf16_t* p0 = KS + r0 * 128 + (((2 * k8) ^ (2 * (r0 & 7))) << 3) + (fr & 3) * 4; const LAS bf16_t* p1 = KS + (r0 + 4) * 128 + (((2 * k8) ^ (2 * ((r0 + 4) & 7))) << 3) + (fr & 3) * 4;
                const bf16x8 af = cat8(tr16(p0), tr16(p1));
                S[k8][0] = MFMA16(af, vb[k2][0], S[k8][0]); S[k8][1] = MFMA16(af, vb[k2][1], S[k8][1]); }
        }
        st = st == 2 ? 0 : st + 1;
    }
#undef GL_PREFETCH
#undef GL_DMA
    const int cj = (bl * 4 + h) * NSEG + seg;
    GAS f32x4* sl = (GAS f32x4*)(c.ws + WS_SLOC) + ((size_t)(cj * 8 + w) * 16) * 64 + lane;
#pragma unroll
    for (int a = 0; a < 8; ++a) { sl[(a * 2) * 64] = S[a][0]; sl[(a * 2 + 1) * 64] = S[a][1]; }
    if (w == 0) { GAS f32x4* dq = (GAS f32x4*)(c.ws + WS_DCUM) + (size_t)cj * 8 * 64 + lane;
#pragma unroll
        for (int a = 0; a < 8; ++a) dq[a * 64] = Dc[a]; }
    VM_WAIT(); __syncthreads();
}
constexpr int GS_STAGE = 66560, GS_KS = 16384, GS_DEC = 32768, GS_VS = 33792, GS_SS = 2 * GS_STAGE;
DI void gla_s_chain(LAS unsigned char* lds, const Ctx& c, int l, int bl, int h, int seg) {
    const int tid = ltid(), lane = tid & 63, w = rfl(tid >> 6), fr = lane & 15, fq = lane >> 4;
    const size_t t0 = (size_t)bl * SEQ + (size_t)seg * (GSEG * 64);
    const bf16_t* VG = wsb(c, WS_H + H_VG) + t0 * 1024 + h * 256;
    const unsigned char* SR = c.ws + WS_H + H_SR + t0 * 1024 + h * 256;
    unsigned char* OG = c.ws + WS_OG + t0 * 1024 + h * 256;
    const unsigned char* rec0 = c.ws + WS_REC + (size_t)((bl * 4 + h) * 64 + seg * GSEG) * REC_BYTES;
    const unsigned char* oi0 = c.ws + WS_MIX + (size_t)((bl * 4 + h) * 64 + seg * GSEG) * OI_BYTES;
    LAS float* SS = (LAS float*)(lds + GS_SS);
    const int dv0 = 32 * w;
    f32x4 gnv[2]; gnv[0] = *(const GAS f32x4*)(c.gla_norm + l * 1024 + h * 256 + dv0 + 4 * fq); gnv[1] = *(const GAS f32x4*)(c.gla_norm + l * 1024 + h * 256 + dv0 + 16 + 4 * fq);
    f32x4 S[8][2];
#pragma unroll
    for (int a = 0; a < 8; ++a) { S[a][0] = (f32x4){0.f, 0.f, 0.f, 0.f}; S[a][1] = (f32x4){0.f, 0.f, 0.f, 0.f}; }
    for (int j = 0; j < seg; ++j) {
        const int cj = (bl * 4 + h) * NSEG + j;
        const GAS f32x4* sl = (const GAS f32x4*)(c.ws + WS_SLOC) + ((size_t)(cj * 8 + w) * 16) * 64 + lane; const GAS f32x4* dq = (const GAS f32x4*)(c.ws + WS_DCUM) + (size_t)cj * 8 * 64 + lane;
#pragma unroll
        for (int a = 0; a < 8; ++a) { const f32x4 dcv = dq[a * 64]; S[a][0] = S[a][0] * dcv + sl[(a * 2) * 64]; S[a][1] = S[a][1] * dcv + sl[(a * 2 + 1) * 64]; }
    }
#define GS_DMA(gp, ldsoff) do { unsigned _sv; const unsigned _m = (unsigned)__builtin_amdgcn_readfirstlane((int)(ldsoff)); \
        asm volatile("s_mov_b32 %0, m0\n\ts_mov_b32 m0, %2\n\ts_nop 0\n\tglobal_load_lds_dwordx4 %1, off\n\ts_mov_b32 m0, %0" : "=&s"(_sv) : "v"(gp), "s"(_m) : "memory"); } while (0)
#define GS_PREFETCH(nn, st) do { const unsigned char* _r = rec0 + (size_t)(nn) * REC_BYTES; const unsigned _s = lds_u + (unsigned)(st) * GS_STAGE; \
        _Pragma("unroll") for (int _p = 0; _p < 4; ++_p) GS_DMA((const GAS unsigned char*)(_r + (w * 4 + _p) * 1024 + lane * 16), _s + (w * 4 + _p) * 1024); \
        if (w == 0) GS_DMA((const GAS unsigned char*)(_r + 32768 + lane * 16), _s + 32768); \
        _Pragma("unroll") for (int _p = 0; _p < 4; ++_p) { const int _row = 2 * (w * 4 + _p) + (lane >> 5); \
            GS_DMA((const GAS bf16_t*)(VG + (size_t)((nn) * 64 + _row) * 1024 + (((lane & 31) ^ (2 * (_row & 3))) << 3)), _s + GS_VS + (w * 4 + _p) * 1024); } } while (0)
    const unsigned lds_u = (unsigned)(uintptr_t)lds;
#define GS_BAR() do { asm volatile("s_waitcnt lgkmcnt(0)" ::: "memory"); __builtin_amdgcn_s_barrier(); asm volatile("" ::: "memory"); } while (0)
#define GS_HEAD(n_) do { \
        _Pragma("unroll") for (int q = 0; q < 8; ++q) oiv[q] = *(const GAS unsigned*)(oi0 + (size_t)(n_) * OI_BYTES + ((w * 8 + q) * 64 + lane) * 4); \
        if ((n_) > 0) { _Pragma("unroll") for (int q = 0; q < 8; ++q) srv[q] = *(const GAS unsigned*)(SR + (size_t)(((n_) - 1) * 64 + 16 * (q >> 1) + fr) * 1024 + dv0 + 16 * (q & 1) + 4 * fq); }     \
        asm volatile("" ::: "memory"); \
        if ((n_) + 1 < GSEG) GS_PREFETCH((n_) + 1, (((n_) & 1) ^ 1)); } while (0)
#define GS_MAIN(n_) do { \
        LAS unsigned char* sb_ = lds + ((n_) & 1) * GS_STAGE; LAS float* SSn = SS + ((n_) & 1) * 512; \
        LAS bf16_t* QT = (LAS bf16_t*)sb_; LAS bf16_t* KS = (LAS bf16_t*)(sb_ + GS_KS); LAS float* DEC = (LAS float*)(sb_ + GS_DEC); LAS bf16_t* VS = (LAS bf16_t*)(sb_ + GS_VS); \
        bf16x8 vb[2][2]; \
        _Pragma("unroll") for (int k2 = 0; k2 < 2; ++k2) _Pragma("unroll") for (int dt = 0; dt < 2; ++dt) { const int r0 = 32 * k2 + 8 * fq + (fr >> 2); \
            const LAS bf16_t* p = VS + r0 * 256 + ((((dv0 + 16 * dt) >> 3) ^ (2 * (r0 & 3))) << 3) + (fr & 3) * 4; vb[k2][dt] = cat8(tr16(p), tr16(p + 4 * 256)); } \
        _Pragma("unroll") for (int tt = 0; tt < 4; ++tt) { o[tt][0] = (f32x4){0.f, 0.f, 0.f, 0.f}; o[tt][1] = (f32x4){0.f, 0.f, 0.f, 0.f}; } \
        _Pragma("unroll") for (int s = 0; s < 4; ++s) { \
            bf16x8 sb[2]; \
            _Pragma("unroll") for (int dt = 0; dt < 2; ++dt) { u32x4 pk; pk.x = cvt_pk_bf16(S[2 * s][dt][0], S[2 * s][dt][1]); pk.y = cvt_pk_bf16(S[2 * s][dt][2], S[2 * s][dt][3]); pk.z = cvt_pk_bf16(S[2 * s + 1][dt][0], S[2 * s + 1][dt][1]); pk.w = cvt_pk_bf16(S[2 * s + 1][dt][2], S[2 * s + 1][dt][3]); sb[dt] = __builtin_bit_cast(bf16x8, pk); } \
            _Pragma("unroll") for (int tt = 0; tt < 4; ++tt) { const int i = 16 * tt + fr; \
                const LAS bf16_t* qp = QT + i * 128 + (fq & 1) * 4; \
                const bf16x8 af = cat8(*(const LAS s16x4*)(qp + (((4 * s + (fq >> 1)) ^ (i & 15)) << 3)), *(const LAS s16x4*)(qp + (((4 * s + 2 + (fq >> 1)) ^ (i & 15)) << 3))); \
                o[tt][0] = MFMA16(sb[0], af, o[tt][0]); o[tt][1] = MFMA16(sb[1], af, o[tt][1]); } \
        } \
        _Pragma("unroll") for (int k8 = 0; k8 < 8; ++k8) { \
            const f32x4 dc = *(const LAS f32x4*)(DEC + 16 * k8 + 4 * fq); \
            S[k8][0] *= dc; S[k8][1] *= dc; \
            _Pragma("unroll") for (int k2 = 0; k2 < 2; ++k2) { const int r0 = 32 * k2 + 8 * fq + (fr >> 2); \
                const LAS bf16_t* p0 = KS + r0 * 128 + (((2 * k8) ^ (2 * (r0 & 7))) << 3) + (fr & 3) * 4; const LAS bf16_t* p1 = KS + (r0 + 4) * 128 + (((2 * k8) ^ (2 * ((r0 + 4) & 7))) << 3) + (fr & 3) * 4; \
                const bf16x8 af = cat8(tr16(p0), tr16(p1)); \
                S[k8][0] = MFMA16(af, vb[k2][0], S[k8][0]); S[k8][1] = MFMA16(af, vb[k2][1], S[k8][1]); } \
        } \
        _Pragma("unroll") for (int tt = 0; tt < 4; ++tt) _Pragma("unroll") for (int dt = 0; dt < 2; ++dt) { const f32x2 a = __builtin_amdgcn_cvt_pk_f32_fp8((int)oiv[tt * 2 + dt], false), b = __builtin_amdgcn_cvt_pk_f32_fp8((int)oiv[tt * 2 + dt], true); o[tt][dt][0] += a[0]; o[tt][dt][1] += a[1]; o[tt][dt][2] += b[0]; o[tt][dt][3] += b[1]; } \
        {     \
            f32x4 pp; \
            _Pragma("unroll") for (int tt = 0; tt < 4; ++tt) { const f32x4 a = o[tt][0] * o[tt][0] + o[tt][1] * o[tt][1]; float p = (a[0] + a[1]) + (a[2] + a[3]); p += __shfl_xor(p, 16); p += __shfl_xor(p, 32); pp[tt] = p; } \
            if (fq == 0) { SSn[(0 * 16 + fr) * 8 + w] = pp[0]; SSn[(1 * 16 + fr) * 8 + w] = pp[1]; SSn[(2 * 16 + fr) * 8 + w] = pp[2]; SSn[(3 * 16 + fr) * 8 + w] = pp[3]; }     \
        } } while (0)
#define GS_TAIL(m_) do { const LAS float* SSm = SS + ((m_) & 1) * 512; \
        _Pragma("unroll") for (int tt = 0; tt < 4; ++tt) { const f32x4 s0 = *(const LAS f32x4*)(SSm + (16 * tt + fr) * 8), s1 = *(const LAS f32x4*)(SSm + (16 * tt + fr) * 8 + 4); \
            const float ss = ((s0[0] + s0[1]) + (s0[2] + s0[3])) + ((s1[0] + s1[1]) + (s1[2] + s1[3])); const float rs = __builtin_amdgcn_rsqf(ss * (1.0f / 256.0f) + RMS_EPS); \
            _Pragma("unroll") for (int dt = 0; dt < 2; ++dt) { const f32x2 sa = __builtin_amdgcn_cvt_pk_f32_fp8((int)srv[tt * 2 + dt], false), sb2 = __builtin_amdgcn_cvt_pk_f32_fp8((int)srv[tt * 2 + dt], true); const f32x4 g = gnv[dt]; const u32x2 ok = opk[tt][dt]; const f32x4 v = (f32x4){bf_lo(ok.x), bf_hi(ok.x), bf_lo(ok.y), bf_hi(ok.y)} * rs; \
                *(GAS unsigned*)(OG + (size_t)((m_) * 64 + 16 * tt + fr) * 1024 + dv0 + 16 * dt + 4 * fq) = pk4_fp8(v[0] * g[0] * sa[0], v[1] * g[1] * sa[1], v[2] * g[2] * sb2[0], v[3] * g[3] * sb2[1]); } } } while (0)
#define GS_KEEP() do { _Pragma("unroll") for (int tt = 0; tt < 4; ++tt) _Pragma("unroll") for (int dt = 0; dt < 2; ++dt) { opk[tt][dt].x = cvt_pk_bf16(o[tt][dt][0], o[tt][dt][1]); opk[tt][dt].y = cvt_pk_bf16(o[tt][dt][2], o[tt][dt][3]); } } while (0)
    f32x4 o[4][2]; u32x2 opk[4][2]; unsigned oiv[8], srv[8];
    __syncthreads();
    GS_PREFETCH(0, 0);
    VM_WAIT(); GS_BAR();
    GS_HEAD(0); GS_MAIN(0); GS_KEEP();
    for (int n = 1; n < GSEG; ++n) {
        if (n == 1) VM_WAIT(); else asm volatile("s_waitcnt vmcnt(8)" ::: "memory");
        GS_BAR();
        GS_HEAD(n);
        GS_MAIN(n);
        GS_TAIL(n - 1);
        GS_KEEP();
    }
#pragma unroll
    for (int q = 0; q < 8; ++q) srv[q] = *(const GAS unsigned*)(SR + (size_t)((GSEG - 1) * 64 + 16 * (q >> 1) + fr) * 1024 + dv0 + 16 * (q & 1) + 4 * fq);
    GS_BAR();
    GS_TAIL(GSEG - 1);
#undef GS_HEAD
#undef GS_MAIN
#undef GS_TAIL
#undef GS_KEEP
#undef GS_PREFETCH
#undef GS_DMA
#undef GS_BAR
    VM_WAIT(); __syncthreads();
}

constexpr int AT_K = 0, AT_V = 55296;
struct APre { u32x2 k[6], v[6], q[2][2]; };
DI u32x4 fp8x8_to_bf16(const u32x2 w) { const f32x2 a = __builtin_amdgcn_cvt_pk_f32_fp8((int)w.x, false), b = __builtin_amdgcn_cvt_pk_f32_fp8((int)w.x, true), c_ = __builtin_amdgcn_cvt_pk_f32_fp8((int)w.y, false), d = __builtin_amdgcn_cvt_pk_f32_fp8((int)w.y, true);
    u32x4 o; o.x = cvt_pk_bf16(a[0], a[1]); o.y = cvt_pk_bf16(b[0], b[1]); o.z = cvt_pk_bf16(c_[0], c_[1]); o.w = cvt_pk_bf16(d[0], d[1]); return o; }
struct AUnit { int dl, n, colo; unsigned tb, slab; };
DI AUnit attn_decode(int u) { AUnit a; const int bl = u / 768, g = (u / 256) % 3, h = (u >> 5) & 7, x = u & 31; a.dl = (g == 0) ? 1 : (g == 1 ? 4 : 16); const int nb = 32 / a.dl, r = x / nb; a.n = x - r * nb; a.tb = (unsigned)(bl * SEQ + r); a.colo = g * 512 + h * 64; a.slab = (unsigned)(((g * 8 + h) * 8 + bl) * SEQ + r * (SEQ / a.dl)) * 64u; return a; }
DI void attn_load(const Ctx& c, int u, APre& p) {
    const int tid = ltid(), lane = tid & 63, w = rfl(tid >> 6), fr = lane & 15, fq = lane >> 4; const AUnit a = attn_decode(u);
    const GAS char* Q = (const GAS char*)(c.ws + WS_H + H_QD) + a.slab; const GAS char* K = (const GAS char*)(c.ws + WS_H + H_KD) + a.slab; const GAS char* V = (const GAS char*)(c.ws + WS_H + H_VD) + a.slab;
#pragma unroll
    for (int b = 0; b < 2; ++b) { const unsigned jq = (unsigned)(128 * (a.n + b) + 16 * w + fr);
#pragma unroll
        for (int d0 = 0; d0 < 2; ++d0) p.q[b][d0] = *(const GAS u32x2*)(Q + (jq * 64u + (unsigned)(32 * d0 + 8 * fq))); }
#pragma unroll
    for (int c2 = 0; c2 < 6; ++c2) { const int idx = tid + NTHREADS * c2, row = idx >> 3, ch = idx & 7; const int j = 128 * (a.n - 1) + row;
        p.k[c2] = (u32x2){0u, 0u}; p.v[c2] = (u32x2){0u, 0u};
        if (j >= 0) { const unsigned off = (unsigned)j * 64u + (unsigned)(ch * 8); p.k[c2] = *(const GAS u32x2*)(K + off); p.v[c2] = *(const GAS u32x2*)(V + off); } }
}
DI void attn_stage(LAS unsigned char* lds, const APre& p) {
    const int tid = ltid(); LAS bf16_t* Ks = (LAS bf16_t*)(lds + AT_K); LAS bf16_t* Vs = (LAS bf16_t*)(lds + AT_V);
#pragma unroll
    for (int c2 = 0; c2 < 6; ++c2) { const int o = (tid >> 3) * 72 + (tid & 7) * 8 + c2 * (64 * 72); *(LAS u32x4*)(Ks + o) = fp8x8_to_bf16(p.k[c2]); *(LAS u32x4*)(Vs + o) = fp8x8_to_bf16(p.v[c2]); }
}
DI void attn_compute(LAS unsigned char* lds, const Ctx& c, int u, const bf16x8 (&qf)[2][2]) {
    const int tid = ltid(), lane = tid & 63, w = rfl(tid >> 6), fr = lane & 15, fq = lane >> 4; const AUnit au = attn_decode(u);
    const int dl = au.dl, n = au.n, g = (u / 256) % 3, h = (u >> 5) & 7; const unsigned tb = au.tb;
    LAS bf16_t* Ks = (LAS bf16_t*)(lds + AT_K); LAS bf16_t* Vs = (LAS bf16_t*)(lds + AT_V);
#pragma unroll
    for (int b = 0; b < 2; ++b) {
        const int kt0 = 8 * b + w;
        const LAS bf16_t* kbase = Ks + (16 * w + fr) * 72 + 8 * fq + b * (128 * 72);
        const LAS bf16_t* vbase = Vs + (16 * w + 4 * fq + (fr >> 2)) * 72 + (fr & 3) * 4 + b * (128 * 72);
        f32x4 s[9]; float m = -1e30f;
#pragma unroll
        for (int kr = 0; kr < 9; ++kr) { const int kt = kt0 + kr; f32x4 a = (f32x4){0.f, 0.f, 0.f, 0.f};
#pragma unroll
            for (int d0 = 0; d0 < 2; ++d0) { const bf16x8 af = *(const LAS bf16x8*)(kbase + kr * (16 * 72) + 32 * d0); a = MFMA16(af, qf[b][d0], a); }
#pragma unroll
            for (int rg = 0; rg < 4; ++rg) { const bool tile_ok = (b > 0) || (n > 0) || (kt >= 8);
                bool ok = tile_ok; if (kr == 0) ok = ok && (4 * fq + rg >= fr); if (kr == 8) ok = ok && (4 * fq + rg <= fr);
                a[rg] = ok ? a[rg] : -1e30f; m = fmaxf(m, a[rg]); }
            s[kr] = a; }
        m = fmaxf(m, __shfl_xor(m, 16)); m = fmaxf(m, __shfl_xor(m, 32));
        f32x4 ls4 = (f32x4){0.f, 0.f, 0.f, 0.f}; const f32x4 m4 = (f32x4){m, m, m, m};
#pragma unroll
        for (int kr = 0; kr < 9; ++kr) { const f32x4 d = s[kr] - m4;
            s[kr] = (f32x4){__builtin_amdgcn_exp2f(d[0]), __builtin_amdgcn_exp2f(d[1]), __builtin_amdgcn_exp2f(d[2]), __builtin_amdgcn_exp2f(d[3])}; ls4 += s[kr]; }
        float lsum = (ls4[0] + ls4[1]) + (ls4[2] + ls4[3]);
        lsum += __shfl_xor(lsum, 16); lsum += __shfl_xor(lsum, 32);
        f32x4 oT[4];
#pragma unroll
        for (int dt = 0; dt < 4; ++dt) oT[dt] = (f32x4){0.f, 0.f, 0.f, 0.f};
#pragma unroll
        for (int pp = 0; pp < 5; ++pp) { const int ka = 2 * pp, kb = (2 * pp + 1 < 9) ? 2 * pp + 1 : 8;
            u32x4 pk; pk.x = cvt_pk_bf16(s[ka][0], s[ka][1]); pk.y = cvt_pk_bf16(s[ka][2], s[ka][3]);
            if (2 * pp + 1 < 9) { pk.z = cvt_pk_bf16(s[kb][0], s[kb][1]); pk.w = cvt_pk_bf16(s[kb][2], s[kb][3]); } else { pk.z = 0u; pk.w = 0u; }
            const bf16x8 pf = __builtin_bit_cast(bf16x8, pk);
#pragma unroll
            for (int dt = 0; dt < 4; ++dt) { const LAS bf16_t* pa = vbase + ka * (16 * 72) + 16 * dt; const LAS bf16_t* pb = vbase + kb * (16 * 72) + 16 * dt;
                oT[dt] = MFMA16(cat8(tr16(pa), tr16(pb)), pf, oT[dt]); } }
        const float inv = 1.0f / lsum; const unsigned tq = tb + (unsigned)dl * (unsigned)(128 * (n + b) + 16 * w + fr), gt = (unsigned)(g * TH) + tq;
        GAS char* op = (GAS char*)(c.ws + WS_ATTG) + (gt * 512u + (unsigned)(h * 64 + 4 * fq));
#pragma unroll
        for (int dt = 0; dt < 4; ++dt) *(GAS unsigned*)(op + 16 * dt) = pk4_fp8(oT[dt][0] * inv, oT[dt][1] * inv, oT[dt][2] * inv, oT[dt][3] * inv);
        if (fq == 0) *(GAS float*)((GAS char*)(c.ws + WS_LSE) + (gt * 32u + (unsigned)(h * 4))) = m + __builtin_amdgcn_logf(lsum);
    }
}
DI void phase_p(LAS unsigned char* lds, const Ctx& c, int l, int G) {
    int h_loaded = -1;
    for (int u = lbid(); u < 8 * 4 * 64; u += G) gla_p_unit(lds, c, l, u >> 8, (u >> 6) & 3, u & 63, h_loaded);
}
constexpr int NATT = 8 * 3 * 8 * 32, NATT1 = 1536, NCHAIN = 8 * 4 * NSEG;
#define AT_BAR() do { asm volatile("s_waitcnt lgkmcnt(0)" ::: "memory"); __builtin_amdgcn_s_barrier(); asm volatile("" ::: "memory"); } while (0)
DI void attn_pull(LAS unsigned char* lds, const Ctx& c, unsigned* ctr, int base, int limit) {
    volatile LAS int* TK = (volatile LAS int*)(lds + MISC_OFF + 192);
    const int tid = ltid();
    __syncthreads();
    if (tid == 0) { TK[0] = base + 2 * (int)__hip_atomic_fetch_add((GAS unsigned*)ctr, 1u, __ATOMIC_RELAXED, __HIP_MEMORY_SCOPE_AGENT); TK[1] = base + 2 * (int)__hip_atomic_fetch_add((GAS unsigned*)ctr, 1u, __ATOMIC_RELAXED, __HIP_MEMORY_SCOPE_AGENT);
        TK[2] = base + 2 * (int)__hip_atomic_fetch_add((GAS unsigned*)ctr, 1u, __ATOMIC_RELAXED, __HIP_MEMORY_SCOPE_AGENT); }
    __syncthreads();
    int cur = rfl(TK[0]), nxt = rfl(TK[1]);
    APre pre;
    if (cur < limit) attn_load(c, cur, pre);
    while (cur < limit) {
        AT_BAR();
        const int nxt2 = rfl(TK[2]);
        attn_stage(lds, pre);
        bf16x8 qf[2][2];
#pragma unroll
        for (int b = 0; b < 2; ++b)
#pragma unroll
            for (int d0 = 0; d0 < 2; ++d0) qf[b][d0] = __builtin_bit_cast(bf16x8, fp8x8_to_bf16(pre.q[b][d0]));
        AT_BAR();
        if (nxt < limit) attn_load(c, nxt, pre);
        int req = 0; if (tid == 0) req = base + 2 * (int)__hip_atomic_fetch_add((GAS unsigned*)ctr, 1u, __ATOMIC_RELAXED, __HIP_MEMORY_SCOPE_AGENT);
        attn_compute(lds, c, cur, qf);
        if (tid == 0) TK[2] = req;
        cur = nxt; nxt = nxt2;
    }
}
DI void phase_b1(LAS unsigned char* lds, const Ctx& c, int l, int hf, int G) {
    const int bid = lbid(); unsigned* ctr = (unsigned*)(c.ws + WS_CTL) + CW_TKT + ((l * 2 + hf) * 2) * 64;
    for (int id = bid; id < NCHAIN; id += G) if ((id & 3) != NSEG - 1) gla_l_chain(lds, c, id >> 4, (id >> 2) & 3, id & 3);
    attn_pull(lds, c, ctr, 0, NATT1);
}
DI void phase_b(LAS unsigned char* lds, const Ctx& c, int l, int hf, int G) {
    const int bid = lbid(); unsigned* ctr = (unsigned*)(c.ws + WS_CTL) + CW_TKT + ((l * 2 + hf) * 2 + 1) * 64;
    for (int id = bid; id < NCHAIN; id += G) gla_s_chain(lds, c, l, id >> 4, (id >> 2) & 3, id & 3);
    attn_pull(lds, c, ctr, NATT1, NATT);
}
DI void phase_f(const Ctx& c, int G) {
    const GAS unsigned char* ag = (const GAS unsigned char*)(c.ws + WS_ATTG); const GAS float* lse = (const GAS float*)(c.ws + WS_LSE); unsigned char* att = c.ws + WS_ATT;
    const size_t stride = (size_t)G * NTHREADS, N = (size_t)TH * 64;
    for (size_t i0 = (size_t)lbid() * NTHREADS + ltid(); i0 < N; i0 += 8 * stride) {
        float l0[8], l1[8], l2[8]; u32x2 a[8], b[8], d[8];
#pragma unroll
        for (int q = 0; q < 8; ++q) { const size_t i = i0 + q * stride; const bool ok = i < N; const size_t tok = ok ? (i >> 6) : 0; const int ch = (int)(i & 63), h = ch >> 3;
            l0[q] = lse[tok * 8 + h]; l1[q] = lse[((size_t)TH + tok) * 8 + h]; l2[q] = lse[((size_t)2 * TH + tok) * 8 + h];
            a[q] = *(const GAS u32x2*)(ag + tok * 512 + ch * 8); b[q] = *(const GAS u32x2*)(ag + ((size_t)TH + tok) * 512 + ch * 8); d[q] = *(const GAS u32x2*)(ag + ((size_t)2 * TH + tok) * 512 + ch * 8); }
#pragma unroll
        for (int q = 0; q < 8; ++q) { const size_t i = i0 + q * stride; if (i >= N) continue; const size_t tok = i >> 6; const int ch = (int)(i & 63);
            const float mx = fmaxf(l0[q], fmaxf(l1[q], l2[q])); float w0 = __builtin_amdgcn_exp2f(l0[q] - mx), w1 = __builtin_amdgcn_exp2f(l1[q] - mx), w2 = __builtin_amdgcn_exp2f(l2[q] - mx);
            const float inv = 1.0f / (w0 + w1 + w2); w0 *= inv; w1 *= inv; w2 *= inv;
            u32x2 o;
#pragma unroll
            for (int hw = 0; hw < 2; ++hw) { const int aw = (int)a[q][hw], bw = (int)b[q][hw], dw = (int)d[q][hw];
                const f32x2 a0 = __builtin_amdgcn_cvt_pk_f32_fp8(aw, false), a1 = __builtin_amdgcn_cvt_pk_f32_fp8(aw, true), b0 = __builtin_amdgcn_cvt_pk_f32_fp8(bw, false), b1 = __builtin_amdgcn_cvt_pk_f32_fp8(bw, true),
                            d0 = __builtin_amdgcn_cvt_pk_f32_fp8(dw, false), d1 = __builtin_amdgcn_cvt_pk_f32_fp8(dw, true);
                o[hw] = pk4_fp8(w0 * a0[0] + w1 * b0[0] + w2 * d0[0], w0 * a0[1] + w1 * b0[1] + w2 * d0[1], w0 * a1[0] + w1 * b1[0] + w2 * d1[0], w0 * a1[1] + w1 * b1[1] + w2 * d1[1]); }
            *(GAS u32x2*)(att + tok * 512 + ch * 8) = o; }
    }
}

DI float wave_sum(float v) {
    return __builtin_bit_cast(float, __builtin_amdgcn_readlane(__builtin_bit_cast(int, scan64(v)), 63));
}
constexpr int R_WR = 0, R_HIST = 65536, R_BASE = 65536 + 64, R_INFO = 65536 + 128, R_LG = 70144;
DI void phase_r(LAS unsigned char* lds, const Ctx& c, int l, int G) {
    const int tid = ltid(), lane = tid & 63, wave = rfl(tid >> 6);
    LAS float* WR = (LAS float*)(lds + R_WR); volatile LAS int* HIST = (volatile LAS int*)(lds + R_HIST); volatile LAS int* BASE = (volatile LAS int*)(lds + R_BASE); volatile LAS int* INFO = (volatile LAS int*)(lds + R_INFO); LAS float* LG = (LAS float*)(lds + R_LG);
    __syncthreads();
#pragma unroll
    for (int i0 = 0; i0 < 16 * 1024; i0 += 8 * NTHREADS) {
        float wv8[8];
#pragma unroll
        for (int q = 0; q < 8; ++q) wv8[q] = ((const GAS float*)c.w_router)[i0 + q * NTHREADS + tid];
#pragma unroll
        for (int q = 0; q < 8; ++q) { const int i = i0 + q * NTHREADS + tid; WR[(i & 15) * 1024 + (i >> 4)] = wv8[q]; }
    }
    f32x4 g4[4], b4[4];
#pragma unroll
    for (int j = 0; j < 4; ++j) { g4[j] = *(const GAS f32x4*)(c.ln1_g + l * D + 4 * lane + 256 * j); b4[j] = *(const GAS f32x4*)(c.ln1_b + l * D + 4 * lane + 256 * j); }
    bf16_t* xr = wsb(c, WS_XR); unsigned char* xb = c.ws + WS_XB; GAS int* histg = (GAS int*)(c.ws + WS_HISTG); GAS float* gate = (GAS float*)(c.ws + WS_GATE); GAS float* stat = (GAS float*)(c.ws + WS_STAT);
    const int elane = ((lane >> 5) & 1) * 8 + ((lane >> 4) & 1) * 4 + ((lane >> 3) & 1) * 2 + ((lane >> 2) & 1);
    const float brt = ((const GAS float*)c.b_router)[((lane >> 5) & 1) * 8 + ((lane >> 4) & 1) * 4 + ((lane >> 3) & 1) * 2 + ((lane >> 2) & 1)];
    for (int chunk = lbid(); chunk < T / 256; chunk += G) {
        __syncthreads();
        u32x2 zn[2][4];
#pragma unroll
        for (int q = 0; q < 2; ++q)
#pragma unroll
            for (int j = 0; j < 4; ++j) zn[q][j] = *(const GAS u32x2*)(xr + ((size_t)chunk * 256 + wave * 32 + q) * D + 4 * lane + 256 * j);
        for (int rr = 0; rr < 32; rr += 2) {
            const int rl = wave * 32 + rr; const size_t row = (size_t)chunk * 256 + rl;
            f32x4 v[2][4];
#pragma unroll
            for (int q = 0; q < 2; ++q) {
                float s = 0.f;
#pragma unroll
                for (int j = 0; j < 4; ++j) { const u32x2 zq = zn[q][j]; v[q][j] = (f32x4){bf_lo(zq.x), bf_hi(zq.x), bf_lo(zq.y), bf_hi(zq.y)}; s += (v[q][j][0] + v[q][j][1]) + (v[q][j][2] + v[q][j][3]); }
                { const size_t rn = row + q + (rr + 2 < 32 ? 2 : 0);
#pragma unroll
                  for (int j = 0; j < 4; ++j) zn[q][j] = *(const GAS u32x2*)(xr + rn * D + 4 * lane + 256 * j); }
                const float mean = wave_sum(s) * (1.0f / D); float s2 = 0.f;
#pragma unroll
                for (int j = 0; j < 4; ++j) { v[q][j] = v[q][j] - mean; s2 += (v[q][j][0] * v[q][j][0] + v[q][j][1] * v[q][j][1]) + (v[q][j][2] * v[q][j][2] + v[q][j][3] * v[q][j][3]); }
                const float rstd = __builtin_amdgcn_rsqf(wave_sum(s2) * (1.0f / D) + LN_EPS);
#pragma unroll
                for (int j = 0; j < 4; ++j) { v[q][j] = v[q][j] * rstd * g4[j] + b4[j];
                    *(GAS unsigned*)(xb + (row + q) * D + 4 * lane + 256 * j) = pk4_fp8(v[q][j][0], v[q][j][1], v[q][j][2], v[q][j][3]); }
                if (lane == 0) *(GAS f32x2*)(stat + (row + q) * 2) = (f32x2){mean, rstd};
                asm volatile("" ::: "memory");
            }
            const bool h5 = lane & 32, h4 = lane & 16, h3 = lane & 8, h2 = lane & 4;
            float b8[2][8];
#pragma unroll
            for (int i = 0; i < 8; ++i) {
                f32x2 a2[2][2];
#pragma unroll
                for (int q = 0; q < 2; ++q) { a2[q][0] = (f32x2){0.f, 0.f}; a2[q][1] = (f32x2){0.f, 0.f}; }
#pragma unroll
                for (int hh = 0; hh < 2; ++hh)
#pragma unroll
                    for (int j = 0; j < 4; ++j) { const f32x4 wv = *(const LAS f32x4*)(WR + (i + 8 * hh) * 1024 + 4 * lane + 256 * j); const f32x2 w01 = __builtin_shufflevector(wv, wv, 0, 1), w23 = __builtin_shufflevector(wv, wv, 2, 3);
#pragma unroll
                        for (int q = 0; q < 2; ++q) { a2[q][hh] = __builtin_shufflevector(v[q][j], v[q][j], 0, 1) * w01 + a2[q][hh]; a2[q][hh] = __builtin_shufflevector(v[q][j], v[q][j], 2, 3) * w23 + a2[q][hh]; } }
#pragma unroll
                for (int q = 0; q < 2; ++q) { const float lo = a2[q][0][0] + a2[q][0][1], hi = a2[q][1][0] + a2[q][1][1]; const float mine = h5 ? hi : lo, send = h5 ? lo : hi; b8[q][i] = mine + __shfl_xor(send, 32); }
                asm volatile("" ::: "memory");
            }
#pragma unroll
            for (int q = 0; q < 2; ++q) {
                float b4_[4], b2[2];
#pragma unroll
                for (int i = 0; i < 4; ++i) { const float mine = h4 ? b8[q][4 + i] : b8[q][i], send = h4 ? b8[q][i] : b8[q][4 + i]; b4_[i] = mine + __shfl_xor(send, 16); }
#pragma unroll
                for (int i = 0; i < 2; ++i) { const float mine = h3 ? b4_[2 + i] : b4_[i], send = h3 ? b4_[i] : b4_[2 + i]; b2[i] = mine + __shfl_xor(send, 8); }
                float b1 = (h2 ? b2[1] : b2[0]) + __shfl_xor(h2 ? b2[0] : b2[1], 4);
                b1 += __shfl_xor(b1, 2); b1 += __shfl_xor(b1, 1);
                b1 += brt;
                if ((lane & 3) == 0) LG[(rl + q) * 16 + elane] = b1;
            }
        }
        {
            const int rl = wave * 32 + (lane & 31); const size_t row = (size_t)chunk * 256 + rl;
            float lg[16];
#pragma unroll
            for (int q = 0; q < 4; ++q) { const f32x4 t4 = *(const LAS f32x4*)(LG + rl * 16 + 4 * q); lg[4 * q] = t4[0]; lg[4 * q + 1] = t4[1]; lg[4 * q + 2] = t4[2]; lg[4 * q + 3] = t4[3]; }
            float mx = lg[0];
#pragma unroll
            for (int e = 1; e < 16; ++e) mx = fmaxf(mx, lg[e]);
            float se = 0.f;
#pragma unroll
            for (int e = 0; e < 16; ++e) { lg[e] = __expf(lg[e] - mx); se += lg[e]; }
            const float ise = 1.0f / se;
#pragma unroll
            for (int e = 0; e < 16; ++e) lg[e] *= ise;
            int gsel = 0; float gbest = -1.f;
#pragma unroll
            for (int gi = 0; gi < 4; ++gi) { const float a = lg[4 * gi], b = lg[4 * gi + 1], cc = lg[4 * gi + 2], d = lg[4 * gi + 3];
                const float sc = (a + b + cc + d) - fminf(fminf(a, b), fminf(cc, d)) - fminf(fmaxf(fminf(a, b), fminf(cc, d)), fminf(fmaxf(a, b), fmaxf(cc, d)));
                if (sc > gbest) { gbest = sc; gsel = gi; } }
            float p[4];
#pragma unroll
            for (int k = 0; k < 4; ++k) p[k] = gsel == 0 ? lg[k] : gsel == 1 ? lg[4 + k] : gsel == 2 ? lg[8 + k] : lg[12 + k];
            int i0 = 0; float v0 = p[0];
#pragma unroll
            for (int k = 1; k < 4; ++k) if (p[k] > v0) { v0 = p[k]; i0 = k; }
            int i1 = -1; float v1 = -1.f;
#pragma unroll
            for (int k = 0; k < 4; ++k) if (k != i0 && p[k] > v1) { v1 = p[k]; i1 = k; }
            if (lane < 32) { const int e0 = 4 * gsel + i0, e1 = 4 * gsel + i1; INFO[rl * 4 + 0] = e0; INFO[rl * 4 + 1] = e1;
                const float gs = 1.0f / (v0 + v1); *(GAS f32x2*)(gate + row * 2) = (f32x2){v0 * gs, v1 * gs}; }
        }
        __syncthreads();
        {
            int cnt0 = 0, cnt1 = 0; const unsigned long long lt = (1ull << lane) - 1ull;
#pragma unroll
            for (int b = 0; b < 4; ++b) { const int r = 64 * b + lane; const int e0 = INFO[r * 4], e1 = INFO[r * 4 + 1];
                const bool a0 = (e0 == 2 * wave) || (e1 == 2 * wave), a1 = (e0 == 2 * wave + 1) || (e1 == 2 * wave + 1);
                const unsigned long long m0 = __ballot(a0), m1 = __ballot(a1);
                if (a0) INFO[r * 4 + (e0 == 2 * wave ? 2 : 3)] = cnt0 + __popcll(m0 & lt);
                if (a1) INFO[r * 4 + (e0 == 2 * wave + 1 ? 2 : 3)] = cnt1 + __popcll(m1 & lt);
                cnt0 += __popcll(m0); cnt1 += __popcll(m1); }
            if (lane == 0) { histg[chunk * 16 + 2 * wave] = cnt0; histg[chunk * 16 + 2 * wave + 1] = cnt1; }
        }
        __syncthreads();
        if (tid < 256) { i32x4 v; v.x = INFO[tid * 4]; v.y = INFO[tid * 4 + 1]; v.z = INFO[tid * 4 + 2]; v.w = INFO[tid * 4 + 3]; ((GAS i32x4*)(c.ws + WS_INFO))[(size_t)chunk * 256 + tid] = v; }
        __syncthreads();
    }
}
DI void phase_r2(LAS unsigned char* lds, const Ctx& c, int l, int G) {
    const int tid = ltid(); volatile LAS int* BASE = (volatile LAS int*)(lds + R_BASE);
    const GAS int* histg = (const GAS int*)(c.ws + WS_HISTG); GAS int* list = (GAS int*)(c.ws + WS_LIST);
    unsigned* cur = (unsigned*)(c.ws + WS_CTL) + CW_CUR + l * 16 * 64;
    for (int chunk = lbid(); chunk < T / 256; chunk += G) {
        __syncthreads();
        if (tid < 16) BASE[tid] = 0;
        __syncthreads();
        { const int e = tid & 15; int s = 0;
#pragma unroll
          for (int k = 0; k < T / 256 / 32; ++k) { const int cc = (tid >> 4) + 32 * k; s += cc < chunk ? histg[cc * 16 + e] : 0; }
          if (s) atomicAdd((int*)&BASE[e], s); }
        __syncthreads();
        if (tid < 256) { const i32x4 v = ((const GAS i32x4*)(c.ws + WS_INFO))[(size_t)chunk * 256 + tid]; const int row = chunk * 256 + tid;
            list[(size_t)v.x * T + BASE[v.x] + v.z] = row * 2; list[(size_t)v.y * T + BASE[v.y] + v.w] = row * 2 + 1; }
        if (chunk == T / 256 - 1 && tid < 16) __hip_atomic_store(cur + tid * 64, (unsigned)(BASE[tid] + histg[chunk * 16 + tid]), __ATOMIC_RELAXED, __HIP_MEMORY_SCOPE_AGENT);
    }
}
DI int moe_setup(LAS unsigned char* lds, const Ctx& c, int l) {
    volatile LAS int* PRE = (volatile LAS int*)(lds + MISC_OFF); volatile LAS int* CNT = PRE + 17;
    unsigned* cur = (unsigned*)(c.ws + WS_CTL) + CW_CUR + l * 16 * 64;
    __syncthreads();
    if (threadIdx.x < 16) CNT[threadIdx.x] = (int)__hip_atomic_load((GAS unsigned*)(cur + threadIdx.x * 64), __ATOMIC_RELAXED, __HIP_MEMORY_SCOPE_AGENT);
    __syncthreads();
    if (threadIdx.x == 0) { int acc = 0; for (int e = 0; e < 16; ++e) { PRE[e] = acc; acc += (CNT[e] + 255) >> 8; } PRE[16] = acc; }
    __syncthreads();
    return rfl(PRE[16]);
}
template <bool LAST> DI void phase_c(const Ctx& c, int l, int G) {
    const int tid = ltid(), lane = tid & 63, wave = rfl(tid >> 6);
    f32x4 g4[4], b4[4];
#pragma unroll
    for (int j = 0; j < 4; ++j) { g4[j] = *(const GAS f32x4*)(c.ln2_g + l * D + 4 * lane + 256 * j); b4[j] = *(const GAS f32x4*)(c.ln2_b + l * D + 4 * lane + 256 * j); }
    f32x4 h4[4], c4[4];
#pragma unroll
    for (int j = 0; j < 4; ++j) { h4[j] = *(const GAS f32x4*)(c.ln1_g + l * D + 4 * lane + 256 * j) * DN_ALPHA; c4[j] = *(const GAS f32x4*)(c.ln1_b + l * D + 4 * lane + 256 * j) * DN_ALPHA; }
    const GAS float* stat = (const GAS float*)(c.ws + WS_STAT);
    float* xo = c.out; bf16_t* xr = wsb(c, WS_XR); unsigned char* xb = c.ws + WS_XB; const unsigned char* ys = c.ws + WS_YS; const GAS float* gate = (const GAS float*)(c.ws + WS_GATE);
    const size_t rstep = (size_t)G * NWAVES; size_t row = (size_t)lbid() * NWAVES + wave;
    u32x2 xn[2][4]; unsigned y0n[2][4], y1n[2][4]; float g0n[2], g1n[2], mun[2], rsn[2];
#define C_LOAD(sl, r_) do { const size_t rq_ = (r_); g0n[sl] = gate[rq_ * 2]; g1n[sl] = gate[rq_ * 2 + 1]; mun[sl] = stat[rq_ * 2]; rsn[sl] = stat[rq_ * 2 + 1]; \
        _Pragma("unroll") for (int j = 0; j < 4; ++j) { xn[sl][j] = *(const GAS u32x2*)(xr + rq_ * D + 4 * lane + 256 * j); y0n[sl][j] = *(const GAS unsigned*)(ys + (rq_ * 2) * D + 4 * lane + 256 * j); y1n[sl][j] = *(const GAS unsigned*)(ys + (rq_ * 2 + 1) * D + 4 * lane + 256 * j); } } while (0)
    if (row < (size_t)T) { C_LOAD(0, row); C_LOAD(1, row + rstep < (size_t)T ? row + rstep : row); }
    for (; row < (size_t)T; row += 2 * rstep) {
#pragma unroll
        for (int sl = 0; sl < 2; ++sl) {
            const size_t rw = row + sl * rstep; if (rw >= (size_t)T) break;
            const float g0 = g0n[sl], g1 = g1n[sl], mu = mun[sl], rs = rsn[sl];
            f32x4 v[4]; float s = 0.f;
#pragma unroll
            for (int j = 0; j < 4; ++j) { const u32x2 xq = xn[sl][j]; const unsigned y0 = y0n[sl][j], y1 = y1n[sl][j];
                const f32x2 y0a = __builtin_amdgcn_cvt_pk_f32_fp8((int)y0, false), y0b = __builtin_amdgcn_cvt_pk_f32_fp8((int)y0, true), y1a = __builtin_amdgcn_cvt_pk_f32_fp8((int)y1, false), y1b = __builtin_amdgcn_cvt_pk_f32_fp8((int)y1, true);
                const f32x4 zc = ((f32x4){bf_lo(xq.x), bf_hi(xq.x), bf_lo(xq.y), bf_hi(xq.y)} - mu) * rs;
                const f32x4 ax = zc * h4[j] + c4[j];
                v[j][0] = ax[0] + g0 * y0a[0] + g1 * y1a[0]; v[j][1] = ax[1] + g0 * y0a[1] + g1 * y1a[1];
                v[j][2] = ax[2] + g0 * y0b[0] + g1 * y1b[0]; v[j][3] = ax[3] + g0 * y0b[1] + g1 * y1b[1];
                s += (v[j][0] + v[j][1]) + (v[j][2] + v[j][3]); }
            C_LOAD(sl, rw + 2 * rstep < (size_t)T ? rw + 2 * rstep : rw);
            const float mean = wave_sum(s) * (1.0f / D); float s2 = 0.f;
#pragma unroll
            for (int j = 0; j < 4; ++j) { v[j] = v[j] - mean; s2 += (v[j][0] * v[j][0] + v[j][1] * v[j][1]) + (v[j][2] * v[j][2] + v[j][3] * v[j][3]); }
            const float rstd = __builtin_amdgcn_rsqf(wave_sum(s2) * (1.0f / D) + LN_EPS);
#pragma unroll
            for (int j = 0; j < 4; ++j) { v[j] = v[j] * rstd * g4[j] + b4[j];
                if constexpr (LAST) *(GAS f32x4*)(xo + rw * D + 4 * lane + 256 * j) = v[j];
                else { u32x2 xq; xq.x = cvt_pk_bf16(v[j][0], v[j][1]); xq.y = cvt_pk_bf16(v[j][2], v[j][3]); *(GAS u32x2*)(xr + rw * D + 4 * lane + 256 * j) = xq;
                    *(GAS unsigned*)(xb + rw * D + 4 * lane + 256 * j) = pk4_fp8(v[j][0], v[j][1], v[j][2], v[j][3]); } }
        }
    }
#undef C_LOAD
}

DI Ctx load_ctx() {
    union { Ctx c; unsigned long long q[sizeof(Ctx) / 8]; } u;
#if defined(__HIP_DEVICE_COMPILE__)
    const __attribute__((address_space(4))) unsigned long long* p = (const __attribute__((address_space(4))) unsigned long long*)__builtin_amdgcn_kernarg_segment_ptr();
    asm volatile("" : "+s"(p));
#pragma unroll
    for (int i = 0; i < (int)(sizeof(Ctx) / 8); ++i) u.q[i] = p[i];
#endif
    return u.c;
}
#define CTX const Ctx c = load_ctx(); const int G = lgrid(); LAS unsigned char* lds = LDSBASE
__global__ void __launch_bounds__(NTHREADS, 2) mk_fwd(Ctx c_arg) {
    extern __shared__ __attribute__((aligned(16))) unsigned char lds_raw[];
#define LDSBASE ({ unsigned _b = (unsigned)(uintptr_t)(LAS unsigned char*)lds_raw; asm volatile("" : "+s"(_b)); (LAS unsigned char*)(uintptr_t)_b; })
    LAS unsigned char* lds0 = LDSBASE;
    const int tid = threadIdx.x; const Ctx c = load_ctx();
    volatile LAS unsigned* MISC = (volatile LAS unsigned*)(lds0 + MISC_OFF);
    if (tid < 64) MISC[tid] = 0u;
    __syncthreads();
    XcdBarrier bar; bar.bar = (unsigned*)(c.ws + WS_CTL) + CW_BAR; bar.x = 0; bar.st = MISC + 40;
    if (!MK_MULTI) bar = xcd_barrier_post((unsigned*)(c.ws + WS_CTL) + CW_BAR, MISC + 40);
    const int lo = c.lo, hi = c.hi; int step = 0;
#define RUN (lo <= step && step < hi)
#define END_STEP do { if (RUN && step + 1 < hi) { if (!MK_MULTI) xcd_barrier(bar); } ++step; } while (0)
#define END_STEP_NB do { ++step; } while (0)
    for (int l = 0; l < DEPTH; ++l) {
        if (RUN) { CTX; phase_w(lds, c, l, G); }
        END_STEP;
        for (int hf = 0; hf < 2; ++hf) {
            const size_t r0 = (size_t)hf * TH;
            if (RUN) {
                CTX;
                pg8::StaticOrder S; S.init(c.ws + WS_XB + r0 * D, c.ws + wset(l) + WS_WIN, TH, NIN, D / 2, G, lbid());
                EpiIn E{wsb(c, WS_H + H_QG), wsb(c, WS_H + H_KG), wsb(c, WS_H + H_VG), wsb(c, WS_H + H_SR), wsb(c, WS_H + H_QD), wsb(c, WS_H + H_KD), wsb(c, WS_H + H_VD), wsb(c, WS_H + H_GT), (float*)(c.ws + WS_HA), c.pos + r0};
                pg8::gemm_phase<EpiIn, pg8::StaticOrder, true>(lds, D / 2, S, E);
                if (l + 1 < DEPTH && lbid() >= (TH / 256) * (NIN / 256) % G && (TH / 256) * (NIN / 256) % G != 0) w_tickets(lds, c, l + 1, 1);
            }
            END_STEP;
            if (RUN) { CTX; phase_p(lds, c, l, G); }
            END_STEP;
            if (RUN) { CTX; phase_b1(lds, c, l, hf, G); }
            END_STEP;
            if (RUN) { CTX; phase_b(lds, c, l, hf, G); }
            END_STEP;
            if (RUN) { CTX; (void)lds; phase_f(c, G); }
            END_STEP_NB;
            if (RUN) {
                CTX;
                pg8::StaticOrder S; S.init(c.ws + WS_OG, c.ws + wset(l) + WS_WGO, TH, D, D / 2, G, lbid());
                EpiGate<false> E{wsb(c, WS_MIX), c.ws + WS_H + H_GT, nullptr};
                pg8::gemm_phase<EpiGate<false>, pg8::StaticOrder, true>(lds, D / 2, S, E);
            }
            END_STEP;
            if (RUN) {
                CTX;
                pg8::StaticOrder S; S.init(c.ws + WS_ATT, c.ws + wset(l) + WS_WAO, TH, D, 256, G, lbid());
                EpiGate<true> E{wsb(c, WS_MIX), c.ws + WS_H + H_GT + 1024, c.ws + WS_OG + 32 * MiB};
                pg8::gemm_phase<EpiGate<true>, pg8::StaticOrder, true>(lds, 256, S, E);
            }
            END_STEP;
            if (RUN) {
                CTX;
                pg8::StaticOrder S; S.init(c.ws + WS_OG + 32 * MiB, c.ws + wset(l) + WS_WOUT, TH, D, D / 2, G, lbid());
                EpiRes E{l == 0 ? c.x + r0 * D : nullptr, wsb(c, WS_XR) + r0 * D};
                pg8::gemm_phase<EpiRes, pg8::StaticOrder, true>(lds, D / 2, S, E);
            }
            if (hf == 1) END_STEP; else END_STEP_NB;
        }
        if (RUN) { CTX; phase_r(lds, c, l, G); }
        END_STEP;
        if (RUN) { CTX; phase_r2(lds, c, l, G); }
        END_STEP;
        if (RUN) {   CTX;
            const int ntiles = moe_setup(lds, c, l);
            volatile LAS int* PRE = (volatile LAS int*)(lds + MISC_OFF); volatile LAS int* TAB = (volatile LAS int*)(lds + TAB_OFF);
            pg8::MoeOrder S; S.G = G; S.c = vcu_of(lbid(), G); S.ntot = ntiles * 8; S.NC = 8; S.K = D / 2; S.pre = PRE; S.cnt = PRE + 17; S.A = (const char*)(c.ws + WS_XB); S.Bt = (const char*)(c.ws + wset(l) + WS_WGU);
            S.bstride = (size_t)2048 * 1024; S.tab = TAB; S.gather = true;
            const GAS int* list = (const GAS int*)(c.ws + WS_LIST);
            { const int lt_tid = ltid(); const int r = lt_tid & 255, half = rfl(lt_tid >> 8);
              int tv[MAXU / 2];
#pragma unroll
              for (int k = 0; k < MAXU / 2; ++k) { Unit u; const int i = 2 * k + half; tv[k] = 0;
                  if (S.next(i, u)) { const int lt = u.pm - PRE[u.e]; const int pos = 256 * lt + (r < u.nv ? r : 0); tv[k] = list[(size_t)u.e * T + pos]; } }
#pragma unroll
              for (int k = 0; k < MAXU / 2; ++k) { const int i = 2 * k + half; if (i * S.G + S.c < S.ntot) TAB[i * 256 + r] = tv[k] >> 1; } }
            __syncthreads();
            EpiM1 E{c.ws + WS_HM};
            pg8::gemm_phase<EpiM1, pg8::MoeOrder, true>(lds, D / 2, S, E);
            if (l + 1 < DEPTH && S.ntot % G != 0 && S.c >= S.ntot % G) w_tickets(lds, c, l + 1, 1);
        }
        END_STEP;
        if (RUN) {   CTX;
            const int ntiles = moe_setup(lds, c, l);
            volatile LAS int* PRE = (volatile LAS int*)(lds + MISC_OFF);
            pg8::MoeOrder S; S.G = G; S.c = vcu_of(lbid(), G); S.ntot = ntiles * 4; S.NC = 4; S.K = DFF / 2; S.pre = PRE; S.cnt = PRE + 17; S.A = (const char*)(c.ws + WS_HM); S.Bt = (const char*)(c.ws + wset(l) + WS_WD);
            S.bstride = (size_t)1024 * 1024; S.tab = nullptr; S.gather = false;
            EpiM2 E{c.ws + WS_YS, (const int*)(c.ws + WS_LIST), PRE};
            pg8::gemm_phase<EpiM2, pg8::MoeOrder, true>(lds, DFF / 2, S, E);
            if (l + 1 < DEPTH && S.ntot % G != 0 && S.c >= S.ntot % G) w_tickets(lds, c, l + 1, 1);
        }
        END_STEP;
        if (RUN) { CTX; (void)lds; if (l == DEPTH - 1) phase_c<true>(c, l, G); else phase_c<false>(c, l, G); }
        END_STEP_NB;
    }
#undef RUN
#undef END_STEP
#undef END_STEP_NB
}
constexpr int NSTEPS = DEPTH * (1 + 2 * 8 + 5);

extern "C" void kernel_launch(void* const* d_in, const int* in_sizes, int n_in, void* d_out, int out_size, void* d_ws, size_t ws_size, hipStream_t stream) {
    static int grid = 0;
    if (grid == 0) {
        if (n_in != 18 || in_sizes[0] != T * D || out_size != T * D || ws_size < WS_END) { fprintf(stderr, "kernel_launch: unexpected shapes / workspace (need %zu, got %zu)\n", (size_t)WS_END, ws_size); grid = -1; return; }
        int dev = 0, cus = 0;
        if (hipGetDevice(&dev) != hipSuccess || hipDeviceGetAttribute(&cus, hipDeviceAttributeMultiprocessorCount, dev) != hipSuccess) { grid = -1; return; }
        if (hipFuncSetAttribute((const void*)mk_fwd, hipFuncAttributeMaxDynamicSharedMemorySize, LDS_BYTES) != hipSuccess) { fprintf(stderr, "kernel_launch: hipFuncSetAttribute failed\n"); grid = -1; return; }
        int per_cu = 0;
        if (hipOccupancyMaxActiveBlocksPerMultiprocessor(&per_cu, (const void*)mk_fwd, NTHREADS, LDS_BYTES) != hipSuccess || per_cu < 1) { fprintf(stderr, "kernel_launch: occupancy query says %d\n", per_cu); }
        (void)hipGetLastError();
        grid = cus;
    }
    if (grid < 0) return;
    (void)hipMemsetAsync((char*)d_ws + WS_CTL, 0, CTL_ZERO_BYTES, stream);
    Ctx c{};
    c.x = (const float*)d_in[0]; c.pos = (const int*)d_in[1]; c.w_in = (const float*)d_in[2]; c.w_alpha_up = (const float*)d_in[3]; c.b_alpha = (const float*)d_in[4]; c.gla_norm = (const float*)d_in[5];
    c.w_gla_o = (const float*)d_in[6]; c.w_att_o = (const float*)d_in[7]; c.w_out = (const float*)d_in[8]; c.ln1_g = (const float*)d_in[9]; c.ln1_b = (const float*)d_in[10]; c.w_router = (const float*)d_in[11];
    c.b_router = (const float*)d_in[12]; c.w_e_gate = (const float*)d_in[13]; c.w_e_up = (const float*)d_in[14]; c.w_e_down = (const float*)d_in[15]; c.ln2_g = (const float*)d_in[16]; c.ln2_b = (const float*)d_in[17];
    c.out = (float*)d_out; c.ws = (unsigned char*)d_ws;
#if MK_MULTI
    for (int s = 0; s < NSTEPS; ++s) { c.lo = s; c.hi = s + 1; hipLaunchKernelGGL(mk_fwd, dim3(grid), dim3(NTHREADS), LDS_BYTES, stream, c); }
#else
    c.lo = 0; c.hi = NSTEPS; hipLaunchKernelGGL(mk_fwd, dim3(grid), dim3(NTHREADS), LDS_BYTES, stream, c);
#endif
}
```

```cpp
#include <hip/hip_runtime.h>
#include <cstdio>
#include <cstdint>

#ifndef MK_MULTI
#define MK_MULTI 0
#endif

#define DI __device__ __forceinline__
#define GAS __attribute__((address_space(1)))
#define LAS __attribute__((address_space(3)))
typedef unsigned short bf16_t;
typedef short bf16x8 __attribute__((ext_vector_type(8)));
typedef short s16x4 __attribute__((ext_vector_type(4)));
typedef float f32x4 __attribute__((ext_vector_type(4)));
typedef float f32x2 __attribute__((ext_vector_type(2)));
typedef unsigned u32x4 __attribute__((ext_vector_type(4)));
typedef unsigned u32x2 __attribute__((ext_vector_type(2)));
typedef int i32x4 __attribute__((ext_vector_type(4)));
typedef int i32x8 __attribute__((ext_vector_type(8)));
#define LDS_WAIT() asm volatile("s_waitcnt lgkmcnt(0)" ::: "memory")
#define VM_WAIT() asm volatile("s_waitcnt vmcnt(0)" ::: "memory")

constexpr int D = 1024, NBATCH = 16, SEQ = 4096, T = NBATCH * SEQ, DEPTH = 4;
constexpr int TH = T / 2;
constexpr int DIN = 9744, NIN = 9984;
constexpr int NEXP = 16, DFF = 1024;
constexpr float LN_EPS = 1e-5f, RMS_EPS = 1e-6f;
constexpr float DN_ALPHA = 1.6817928305074290f;
constexpr float LOG2E = 1.4426950408889634f;
constexpr int NWAVES = 8, NTHREADS = 512;

constexpr size_t MiB = 1u << 20;
constexpr size_t WS_CTL = 0, CTL_ZERO_BYTES = 1 * MiB;
constexpr size_t WS_WIN = 1 * MiB;
constexpr size_t WS_WGO = WS_WIN + (size_t)NIN * D;
constexpr size_t WS_WAO = WS_WGO + 2 * MiB;
constexpr size_t WS_WOUT = WS_WAO + 1 * MiB;
constexpr size_t WS_WGU = WS_WOUT + 2 * MiB;
constexpr size_t WS_WD = WS_WGU + 32 * MiB;
constexpr size_t WS_XB = WS_WD + 16 * MiB;
constexpr size_t WS_XR = WS_XB + 64 * MiB;
constexpr size_t WS_LIST = WS_XR + 128 * MiB;
constexpr size_t WS_GATE = WS_LIST + 4 * MiB;
constexpr size_t WS_INFO = WS_GATE + 1 * MiB;
constexpr size_t WS_HISTG = WS_INFO + 1 * MiB;
constexpr size_t WS_OG = WS_HISTG + 1 * MiB;
constexpr size_t WS_ATTG = WS_OG + 64 * MiB;
constexpr size_t WS_LSE = WS_ATTG + 96 * MiB;
constexpr size_t WS_ATT = WS_LSE + 3 * MiB;
constexpr size_t WS_MIX = WS_ATT + 32 * MiB;
constexpr size_t WS_HA = WS_MIX + 64 * MiB;
constexpr size_t WS_H = WS_HA + 2 * MiB;
constexpr size_t H_QG = 0, H_KG = H_QG + (size_t)TH * 512 * 2, H_VG = H_KG + (size_t)TH * 512 * 2, H_SR = H_VG + (size_t)TH * 1024 * 2,
                 H_QD = H_SR + (size_t)TH * 1024 * 2, H_KD = H_QD + (size_t)TH * 1536 * 2, H_VD = H_KD + (size_t)TH * 1536 * 2, H_GT = H_VD + (size_t)TH * 1536 * 2,
                 H_END = H_GT + (size_t)TH * 2048 * 2;
constexpr size_t WS_HM = WS_H;
constexpr size_t WS_YS = WS_HM + (size_t)(2 * T + 4096) * 1024 * 2;
constexpr size_t WS_STAT = WS_CTL + 512 * 1024;
constexpr size_t WS_W2 = WS_H + 544 * MiB, WSET_BYTES = WS_XB - WS_WIN;
static_assert(WS_W2 + WSET_BYTES <= WS_H + H_END, "second weight set fits");
constexpr size_t WS_REC = WS_H + H_END;
constexpr size_t WS_SLOC = WS_REC + (size_t)2048 * 33792;
constexpr size_t WS_DCUM = WS_SLOC + 16 * MiB;
constexpr size_t WS_END = WS_DCUM + 1 * MiB;
static_assert(WS_YS + (size_t)2 * T * 1024 * 2 <= WS_END, "MoE overlay fits");
constexpr int CW_BAR = 4096;
constexpr int CW_TKT = 24576;
constexpr int CW_CUR = 16384;
constexpr int CW_WTK = 40960;

constexpr int RING_BYTES = 131072;
constexpr int TAB_OFF = RING_BYTES, MAXU = 18, TAB_BYTES = MAXU * 1024;
constexpr int LDS_BYTES = 163840;
constexpr int MISC_OFF = LDS_BYTES - 256;
static_assert(TAB_OFF + TAB_BYTES <= MISC_OFF, "LDS map");

DI int rfl(int v) { return __builtin_amdgcn_readfirstlane(v); }
DI int lbid() { int t = blockIdx.x; asm volatile("" : "+s"(t)); return t; }
DI int lgrid() { int t = gridDim.x; asm volatile("" : "+s"(t)); return t; }
DI int vcu_of(int bid, int G) { return (G % 8 == 0) ? (bid % 8) * (G / 8) + bid / 8 : bid; }
DI int ltid() { int t = threadIdx.x; asm volatile("" : "+v"(t)); return t; }
DI float bf2f(unsigned b) { return __uint_as_float(b << 16); }
typedef __bf16 bf16x2_t __attribute__((ext_vector_type(2)));
DI unsigned cvt_pk_bf16(float lo, float hi) { f32x2 v = {lo, hi}; bf16x2_t b = __builtin_convertvector(v, bf16x2_t); return __builtin_bit_cast(unsigned, b); }
DI float clamp8(float v) { return fminf(fmaxf(v, -448.f), 448.f); }
DI unsigned pk4_fp8(float a, float b, float c_, float d) { int w = 0; w = __builtin_amdgcn_cvt_pk_fp8_f32(clamp8(a), clamp8(b), w, false); w = __builtin_amdgcn_cvt_pk_fp8_f32(clamp8(c_), clamp8(d), w, true); return (unsigned)w; }
constexpr float W8_SCALE = 64.0f, W8_INV = 1.0f / 64.0f;
DI float bf_lo(unsigned w) { return __uint_as_float(w << 16); }
DI float bf_hi(unsigned w) { return __uint_as_float(w & 0xffff0000u); }
DI float sigmoidf_(float x) { return __builtin_amdgcn_rcpf(1.0f + __builtin_amdgcn_exp2f(-x * LOG2E)); }
DI float sigmoid64_(float x64) { return __builtin_amdgcn_rcpf(1.0f + __builtin_amdgcn_exp2f(x64 * (-LOG2E * W8_INV))); }

#define XB_TMO      128
#define XB_XCNT(j)  (256  + 64 * (j))
#define XB_XSUB(j)  (1280 + 64 * (j))
#define XB_XGEN(j)  (2304 + 64 * (j))
#define XB_TOP      3328
#define XB_TOPGEN   3392
#define XCD_BAR_WORDS 3456
#define XB_SPIN_CAP (1u << 18)
DI unsigned xb_ld(unsigned* p)              { return __hip_atomic_load(p, __ATOMIC_RELAXED, __HIP_MEMORY_SCOPE_AGENT); }
DI unsigned xb_add(unsigned* p, unsigned v) { return __hip_atomic_fetch_add(p, v, __ATOMIC_RELAXED, __HIP_MEMORY_SCOPE_AGENT); }
DI unsigned xb_xcc_id() { return (unsigned)__builtin_amdgcn_s_getreg((3 << 11) | 20) & 0xFu; }
#define XB_SPIN(cond, bar) do { unsigned _sp = 0; while (cond) { __builtin_amdgcn_s_sleep(1); \
    if ((++_sp & 255u) == 0u) { if (xb_ld(&(bar)[XB_TMO])) break; if (_sp > XB_SPIN_CAP) { atomicAdd(&(bar)[XB_TMO], 1u); break; } } } } while (0)
struct XcdBarrier { unsigned* bar; unsigned x; volatile LAS unsigned* st; };
DI XcdBarrier xcd_barrier_post(unsigned* bar, volatile LAS unsigned* st) {
    XcdBarrier b; b.bar = bar; b.x = xb_xcc_id(); b.st = st;
    if (threadIdx.x == 0) (void)xb_add(&bar[XB_XCNT(b.x)], 1u);
    return b;
}
DI void xcd_barrier_complete(unsigned* bar, unsigned x, unsigned& nloc, unsigned& nx) {
    const unsigned G = gridDim.x * gridDim.y * gridDim.z;
    unsigned sum, cnt, mine, sp = 0u;
    for (;;) {
        sum = 0u; cnt = 0u; mine = 0u;
#pragma unroll
        for (unsigned j = 0; j < 16; ++j) { const unsigned c = xb_ld(&bar[XB_XCNT(j)]); sum += c; cnt += (c > 0u) ? 1u : 0u; mine = (j == x) ? c : mine; }
        if (sum == G) break;
        __builtin_amdgcn_s_sleep(1);
        if ((++sp & 255u) == 0u) { if (xb_ld(&bar[XB_TMO])) break; if (sp > XB_SPIN_CAP) { atomicAdd(&bar[XB_TMO], 1u); break; } }
    }
    nloc = mine > 0u ? mine : 1u; nx = cnt > 0u ? cnt : 1u;
}
DI void xcd_barrier(const XcdBarrier& b) {
    asm volatile("s_waitcnt vmcnt(0)" ::: "memory");
    __syncthreads();
    if (threadIdx.x == 0) {
        unsigned* bar = b.bar;
        __builtin_amdgcn_s_waitcnt(0);
        unsigned nloc = b.st[0], nx = b.st[1];
        if (nloc == 0u) { xcd_barrier_complete(bar, b.x, nloc, nx); b.st[0] = nloc; b.st[1] = nx; }
        const unsigned old = xb_add(&bar[XB_XSUB(b.x)], 1u);
        const unsigned gen = old / nloc;
        if (old + 1u == (gen + 1u) * nloc) {
            __builtin_amdgcn_fence(__ATOMIC_RELEASE, "agent");
            asm volatile("s_waitcnt vmcnt(0)" ::: "memory");
            const unsigned og = xb_add(&bar[XB_TOP], 1u);
            const unsigned tg = og / nx;
            if (og + 1u == (tg + 1u) * nx) xb_add(&bar[XB_TOPGEN], 1u);
            else XB_SPIN(xb_ld(&bar[XB_TOPGEN]) == tg, bar);
            __builtin_amdgcn_fence(__ATOMIC_ACQUIRE, "agent");
            xb_add(&bar[XB_XGEN(b.x)], 1u);
            asm volatile("s_waitcnt vmcnt(0)" ::: "memory");
        } else {
            XB_SPIN(xb_ld(&bar[XB_XGEN(b.x)]) == gen, bar);
            __builtin_amdgcn_fence(__ATOMIC_ACQUIRE, "agent");
            asm volatile("s_waitcnt vmcnt(0)" ::: "memory");
        }
    }
    __syncthreads();
}

struct Ctx {
    const float* x; const int* pos; const float* w_in; const float* w_alpha_up; const float* b_alpha; const float* gla_norm;
    const float* w_gla_o; const float* w_att_o; const float* w_out; const float* ln1_g; const float* ln1_b; const float* w_router; const float* b_router;
    const float* w_e_gate; const float* w_e_up; const float* w_e_down; const float* ln2_g; const float* ln2_b;
    float* out; unsigned char* ws;
    int lo, hi;
};
DI bf16_t* wsb(const Ctx& c, size_t off) { return (bf16_t*)(c.ws + off); }
DI int in_tile(int pt) { return (pt >= 5 && pt <= 7) ? pt + 30 : ((pt >= 35 && pt <= 37) ? pt - 30 : pt); }
DI size_t wset(int l) { return (l & 1) ? (WS_W2 - WS_WIN) : (size_t)0; }

namespace pg8 {
constexpr int BM = 256, BK = 64, HALF = 128, HTB = HALF * BK * 2, STAGE_BYTES = 8 * HTB, NXCD = 8, WGM = 4;
DI int lds_byte(int r, int c) { const int st = (r >> 4) * 2 + (c >> 5), rr = r & 15, cc = c & 31, ob = rr * 64 + cc * 2; return st * 1024 + (ob ^ (((ob >> 9) & 1) << 5)); }
DI void stage_rc(int b, int& R, int& C) { const int st = b / 1024, sb = b % 1024, swz = sb ^ (((sb >> 9) & 1) << 5); R = (st >> 1) * 16 + swz / 64; C = (st & 1) * 32 + (swz % 64) / 2; }
DI int perm32(int rho) { const int n = rho >> 4, i = rho & 15; return 8 * (i >> 2) + 4 * n + (i & 3); }
struct Unit { int pm, pn, e, nv, ui; };

struct StaticOrder {
    int nM, nN, nwg, G, c, K; const char* A; const char* Bt;
    DI void init(const void* A_, const void* Bt_, int M, int N, int K_, int G_, int c_) { A = (const char*)A_; Bt = (const char*)Bt_; nM = M / BM; nN = N / BM; nwg = nM * nN; G = G_; c = c_; K = K_; }
    DI bool next(int i, Unit& u) const {
        const long L = (long)i * G + c; if (L >= nwg) return false;
        int wgid = (int)L; { const int q = nwg / NXCD, r = nwg % NXCD, xcd = wgid % NXCD, off = wgid / NXCD; wgid = (xcd < r ? xcd * (q + 1) : r * (q + 1) + (xcd - r) * q) + off; }
        const int nig = WGM * nN, gid = wgid / nig, fm = gid * WGM, gsz = (nM - fm) < WGM ? (nM - fm) : WGM;
        u.pm = fm + ((wgid % nig) % gsz); u.pn = (wgid % nig) / gsz; u.e = 0; u.nv = 256; u.ui = i; return true;
    }
    DI const char* a_base(const Unit& u) const { return A + (size_t)u.pm * BM * K * 2; }
    DI const char* b_base(const Unit& u) const { return Bt + (size_t)u.pn * BM * K * 2; }
    DI void a_off(const Unit&, int tid, unsigned (&o)[2][2]) const {
#pragma unroll
        for (int i = 0; i < 2; ++i) { int R, C; stage_rc(tid * 16 + i * 8192, R, C);
#pragma unroll
            for (int h = 0; h < 2; ++h) o[h][i] = (unsigned)((h * HALF + R) * K + C) * 2u; }
    }
};
struct MoeOrder {
    int G, c, ntot, NC, K; const volatile LAS int* pre; const volatile LAS int* cnt; const char* A; const char* Bt; size_t bstride; const volatile LAS int* tab; bool gather;
    DI int lin(int i) const {
        if (G != 256) { const int L = i * G + c; return L < ntot ? L : -1; }
        const int q = ntot >> 3, r = ntot & 7, x = c >> 5, n = q + (x < r ? 1 : 0), s = i * 32 + (c & 31);
        return s < n ? x * q + (x < r ? x : r) + s : -1; }
    DI bool next(int i, Unit& u) const {
        const int L = lin(i); if (L < 0) return false;
        const int rt = L / NC; u.pn = L - rt * NC; u.pm = rt;
        int e = 0;
#pragma unroll
        for (int j = 1; j < 16; ++j) e += (rt >= rfl(pre[j])) ? 1 : 0;
        e = rfl(e); u.e = e; const int rem = rfl(cnt[e]) - 256 * (rt - rfl(pre[e])); u.nv = rem < 256 ? rem : 256; u.ui = i; return true;
    }
    DI const char* a_base(const Unit& u) const { return gather ? A : A + (size_t)u.pm * BM * K * 2; }
    DI const char* b_base(const Unit& u) const { return Bt + (size_t)u.e * bstride + (size_t)u.pn * BM * K * 2; }
    DI void a_off(const Unit& u, int tid, unsigned (&o)[2][2]) const {
#pragma unroll
        for (int i = 0; i < 2; ++i) { int R, C; stage_rc(tid * 16 + i * 8192, R, C);
#pragma unroll
            for (int h = 0; h < 2; ++h) { const int row = gather ? tab[u.ui * 256 + h * HALF + R] : (h * HALF + R); o[h][i] = (unsigned)(row * K + C) * 2u; } }
    }
};

template <class Epi, class Sched, bool F8 = false>
DI void gemm_phase(LAS unsigned char* lds, const int K, const Sched& S, const Epi& E) {
    const int tid = ltid(), wid = rfl(tid >> 6), lane = tid & 63, wr = wid >> 2, wc = wid & 3, fr = lane & 15, fq = lane >> 4;
    const int nt = K / BK;
    unsigned voffB[2];
#pragma unroll
    for (int i = 0; i < 2; ++i) { int R, C; stage_rc(tid * 16 + i * 8192, R, C); const int Rb = Epi::PERM ? ((R & ~31) + perm32(R & 31)) : R; voffB[i] = (unsigned)(Rb * K + C) * 2u; }
    const size_t kstep = (size_t)(BK * 2);
    const size_t hstep = (size_t)HALF * K * 2;
    const unsigned ldsw = (unsigned)wid * 1024u;
    const int aoff = lds_byte(wr * 64 + fr, fq * 8), boff = lds_byte(wc * 32 + fr, fq * 8);
#define PG8_SA(b, h) (((b) * 2 + (h)) * HTB)
#define PG8_SB(b, h) ((4 + (b) * 2 + (h)) * HTB)
#define PG8_STAGE(bufoff, gbase, voff) do { _Pragma("unroll") for (int _i = 0; _i < 2; ++_i) \
        __builtin_amdgcn_global_load_lds((const unsigned*)((const char*)(gbase) + (voff)[_i]), (LAS unsigned*)(lds + (bufoff) + ldsw + _i * 8192), 16, 0, 0); } while (0)
#define PG8_LD8(p) __builtin_shufflevector(*(const LAS i32x4*)(p), *(const LAS i32x4*)((p) + 1024), 0, 1, 2, 3, 4, 5, 6, 7)
#define PG8_LDA(dst, b, h) do { if constexpr (F8) { _Pragma("unroll") for (int m = 0; m < 4; ++m) dst##8[m] = PG8_LD8(lds + PG8_SA(b, h) + aoff + m * 2048); } else { \
        _Pragma("unroll") for (int m = 0; m < 4; ++m) _Pragma("unroll") for (int k = 0; k < 2; ++k) dst[m][k] = *(const LAS bf16x8*)(lds + PG8_SA(b, h) + aoff + m * 2048 + k * 1024); } } while (0)
#define PG8_LDB(dst, b, h) do { if constexpr (F8) { _Pragma("unroll") for (int n = 0; n < 2; ++n) dst##8[n] = PG8_LD8(lds + PG8_SB(b, h) + boff + n * 2048); } else { \
        _Pragma("unroll") for (int n = 0; n < 2; ++n) _Pragma("unroll") for (int k = 0; k < 2; ++k) dst[n][k] = *(const LAS bf16x8*)(lds + PG8_SB(b, h) + boff + n * 2048 + k * 1024); } } while (0)
#define PG8_MMA(ai, bj, At, Bt) do { __builtin_amdgcn_s_setprio(1); if constexpr (F8) { _Pragma("unroll") for (int m = 0; m < 4; ++m) _Pragma("unroll") for (int n = 0; n < 2; ++n) \
        asm volatile("v_mfma_f32_16x16x128_f8f6f4 %0, %1, %2, %0" : "+v"(acc[ai][bj][m][n]) : "v"(Bt##8[n]), "v"(At##8[m])); } else { \
        _Pragma("unroll") for (int m = 0; m < 4; ++m) _Pragma("unroll") for (int n = 0; n < 2; ++n) _Pragma("unroll") for (int k = 0; k < 2; ++k) \
        acc[ai][bj][m][n] = __builtin_amdgcn_mfma_f32_16x16x32_bf16(Bt[n][k], At[m][k], acc[ai][bj][m][n], 0, 0, 0); } __builtin_amdgcn_s_setprio(0); } while (0)
#define PG8_MMA0(ai, bj, At, Bt) do { __builtin_amdgcn_s_setprio(1); _Pragma("unroll") for (int m = 0; m < 4; ++m) _Pragma("unroll") for (int n = 0; n < 2; ++n) \
        asm volatile("v_mfma_f32_16x16x128_f8f6f4 %0, %1, %2, 0" : "=&v"(acc[ai][bj][m][n]) : "v"(Bt##8[n]), "v"(At##8[m])); __builtin_amdgcn_s_setprio(0); } while (0)
#define PG8_WAIT_V(n) asm volatile("s_waitcnt vmcnt(" #n ")" ::: "memory")
#define PG8_WAIT_L(n) asm volatile("s_waitcnt lgkmcnt(" #n ")" ::: "memory")
#define PG8_WAIT_VX(sx) do { if ((sx) >= 48) PG8_WAIT_V(56); else if ((sx) >= 32) PG8_WAIT_V(40); else if ((sx) >= 24) PG8_WAIT_V(32); else if ((sx) >= 16) PG8_WAIT_V(24); else if ((sx) >= 8) PG8_WAIT_V(16); else PG8_WAIT_V(8); } while (0)
#define PG8_BAR __builtin_amdgcn_s_barrier()
#define PG8_SCHED __builtin_amdgcn_sched_barrier(0)
    Unit cur, nxt; int ui = 0, sx = 0;
    if (!S.next(0, cur)) return;
    f32x4 acc[2][2][4][2];
    if constexpr (!F8)
#pragma unroll
    for (int a = 0; a < 2; ++a)
#pragma unroll
        for (int b = 0; b < 2; ++b)
#pragma unroll
            for (int m = 0; m < 4; ++m)
#pragma unroll
                for (int n = 0; n < 2; ++n) acc[a][b][m][n] = (f32x4){0.f, 0.f, 0.f, 0.f};
    bf16x8 At[4][2], B0[2][2], B1[2][2]; i32x8 At8[4], B08[2], B18[2];
    unsigned oA[2][2]; S.a_off(cur, tid, oA);
    const char* cA = S.a_base(cur); const char* cB = S.b_base(cur);
    PG8_STAGE(PG8_SB(0, 0), cB, voffB); PG8_STAGE(PG8_SB(0, 1), cB + hstep, voffB); PG8_STAGE(PG8_SA(0, 0), cA, oA[0]); PG8_STAGE(PG8_SA(0, 1), cA, oA[1]);
    if (wr == 1) PG8_BAR;
    PG8_WAIT_V(2); PG8_BAR;
    PG8_STAGE(PG8_SB(1, 0), cB + kstep, voffB); PG8_STAGE(PG8_SA(1, 0), cA + kstep, oA[0]); PG8_STAGE(PG8_SB(1, 1), cB + hstep + kstep, voffB);
    PG8_WAIT_V(6); PG8_BAR;
    for (;;) {
        const bool has_next = S.next(ui + 1, nxt);
        const char* nA = has_next ? S.a_base(nxt) : cA; const char* nB = has_next ? S.b_base(nxt) : cB;
        for (int t = 0; t < nt; t += 2) {
            const bool last = (t == nt - 2); const int sxe = (t == 0) ? sx : 0;
            const char* a1 = cA + (size_t)(t + 1) * kstep;
            const char* a2 = last ? nA : cA + (size_t)(t + 2) * kstep; const char* b2 = last ? nB : cB + (size_t)(t + 2) * kstep;
            const char* a3 = a2 + kstep; const char* b3 = b2 + kstep;
            PG8_LDB(B0, 0, 0); PG8_LDB(B1, 0, 1); PG8_SCHED; PG8_LDA(At, 0, 0); PG8_STAGE(PG8_SA(1, 1), a1, oA[1]);
            if (last && has_next) S.a_off(nxt, tid, oA);
            PG8_WAIT_VX(sxe); PG8_WAIT_L(0); PG8_BAR; if (F8 && t == 0) { PG8_MMA0(0, 0, At, B0); PG8_MMA0(0, 1, At, B1); } else { PG8_MMA(0, 0, At, B0); PG8_MMA(0, 1, At, B1); } PG8_BAR; PG8_SCHED;
            PG8_LDA(At, 0, 1); PG8_STAGE(PG8_SB(0, 0), b2, voffB); PG8_STAGE(PG8_SB(0, 1), b2 + hstep, voffB); PG8_STAGE(PG8_SA(0, 0), a2, oA[0]);
            PG8_WAIT_VX(sxe); PG8_WAIT_L(0); PG8_BAR; if (F8 && t == 0) { PG8_MMA0(1, 0, At, B0); PG8_MMA0(1, 1, At, B1); } else { PG8_MMA(1, 0, At, B0); PG8_MMA(1, 1, At, B1); } PG8_BAR; PG8_SCHED;
            PG8_LDB(B0, 1, 0); PG8_LDB(B1, 1, 1); PG8_SCHED; PG8_LDA(At, 1, 0); PG8_STAGE(PG8_SA(0, 1), a2, oA[1]);
            PG8_WAIT_V(8); PG8_WAIT_L(0); PG8_BAR; PG8_MMA(0, 0, At, B0); PG8_MMA(0, 1, At, B1); PG8_BAR; PG8_SCHED;
            PG8_LDA(At, 1, 1); PG8_STAGE(PG8_SB(1, 0), b3, voffB); PG8_STAGE(PG8_SB(1, 1), b3 + hstep, voffB); PG8_STAGE(PG8_SA(1, 0), a3, oA[0]);
            PG8_WAIT_V(8); PG8_WAIT_L(0); PG8_BAR; PG8_MMA(1, 0, At, B0); PG8_MMA(1, 1, At, B1); PG8_BAR; PG8_SCHED;
        }
        if (wr == 0) PG8_BAR;
        if constexpr (F8) asm volatile("s_nop 15\n\ts_nop 15" ::: "memory");
        E(acc, cur, wr, wc, fr, fq);
        if (!has_next) break;
        if constexpr (!F8)
#pragma unroll
        for (int a = 0; a < 2; ++a)
#pragma unroll
            for (int b = 0; b < 2; ++b)
#pragma unroll
                for (int m = 0; m < 4; ++m)
#pragma unroll
                    for (int n = 0; n < 2; ++n) acc[a][b][m][n] = (f32x4){0.f, 0.f, 0.f, 0.f};
        cur = nxt; cA = nA; cB = nB; ++ui;
        if (wr == 1) PG8_BAR;
    }
    PG8_WAIT_V(0);
    PG8_BAR;
#undef PG8_SA
#undef PG8_SB
#undef PG8_STAGE
#undef PG8_LDA
#undef PG8_LDB
#undef PG8_MMA
#undef PG8_MMA0
#undef PG8_LD8
#undef PG8_WAIT_V
#undef PG8_WAIT_VX
#undef PG8_WAIT_L
#undef PG8_BAR
#undef PG8_SCHED
}
}
using pg8::Unit;

DI u32x4 pack8(const f32x4& v0, const f32x4& v1) { u32x4 w; w.x = cvt_pk_bf16(v0[0], v0[1]); w.y = cvt_pk_bf16(v0[2], v0[3]); w.z = cvt_pk_bf16(v1[0], v1[1]); w.w = cvt_pk_bf16(v1[2], v1[3]); return w; }

DI void st_pair16(unsigned char* px, int gap, u32x2 x, u32x2 y, int fq) {
    const auto r0 = __builtin_amdgcn_permlane16_swap(x.x, y.x, false, false), r1 = __builtin_amdgcn_permlane16_swap(x.y, y.y, false, false);
    *(GAS u32x4*)(px + ((fq & 1) ? gap - 8 : 0)) = (u32x4){r0[0], r1[0], r0[1], r1[1]};
}
DI size_t dil_row(int gh, int R) { const int s = 2 * (gh >> 3), bl = R >> 12, t = R & (SEQ - 1);
    return ((size_t)((gh * 8 + bl) * SEQ) + (size_t)((t & ((1 << s) - 1)) * (SEQ >> s) + (t >> s))) * 64; }
struct EpiIn {
    static constexpr bool PERM = true;
    bf16_t *qg, *kg, *vg, *sr, *qd, *kd, *vd, *gt; float* ha; const int* pos;
    DI int nvm(const Unit& u, int) const { return u.pn == 38 ? 0 : 16; }
    DI void operator()(const f32x4 (&acc)[2][2][4][2], const Unit& u, int wr, int wc, int fr, int fq) const {
        asm volatile("" : "+v"(fr), "+v"(fq));
        const int row0 = u.pm * 256 + wr * 64 + fr; const int pn = in_tile(u.pn);
        if (pn >= 12 && pn < 24) {
            bf16_t* base = pn < 18 ? qd : kd; const int tq = pn < 18 ? pn - 12 : pn - 18; const float sc = pn < 18 ? 0.125f * LOG2E * W8_INV : W8_INV;
            float fre[8];
#pragma unroll
            for (int i = 0; i < 8; ++i) fre[i] = __builtin_amdgcn_exp2f(-(float)(8 * fq + i) * (13.287712379549449f / 32.0f)) * 0.15915494309189535f;
            int posv[8];
#pragma unroll
            for (int q = 0; q < 8; ++q) posv[q] = ((const GAS int*)pos)[row0 + (q >> 2) * 128 + (q & 3) * 16];
#pragma unroll
            for (int ai = 0; ai < 2; ++ai) {
#pragma unroll
                for (int m = 0; m < 4; ++m) {
                    const int r = row0 + ai * 128 + m * 16; const float p = (float)posv[ai * 4 + m];
                    unsigned char* rowp = (unsigned char*)base + dil_row(4 * tq + wc, r) + 8 * fq;
                    u32x2 w1, w2;
#pragma unroll
                    for (int n = 0; n < 2; ++n) { f32x4 o1, o2;
#pragma unroll
                        for (int j = 0; j < 4; ++j) {
                            float a = p * fre[n * 4 + j]; a = a - __builtin_floorf(a);
                            const float sn = __builtin_amdgcn_sinf(a), cs = __builtin_amdgcn_cosf(a);
                            const float x1 = acc[ai][0][m][n][j], x2 = acc[ai][1][m][n][j];
                            o1[j] = (x1 * cs - x2 * sn) * sc; o2[j] = (x2 * cs + x1 * sn) * sc;
                        }
                        w1[n] = pk4_fp8(o1[0], o1[1], o1[2], o1[3]); w2[n] = pk4_fp8(o2[0], o2[1], o2[2], o2[3]); }
                    st_pair16(rowp, 32, w1, w2, fq);
                    asm volatile("" ::: "memory");
                } }
        } else if (pn == 38) {
            if (wc == 0 && fq < 2) {
#pragma unroll
                for (int ai = 0; ai < 2; ++ai)
#pragma unroll
                    for (int m = 0; m < 4; ++m) { float* p = ha + (size_t)(row0 + ai * 128 + m * 16) * 16 + 8 * fq; *(GAS f32x4*)p = acc[ai][0][m][0] * W8_INV; *(GAS f32x4*)(p + 4) = acc[ai][0][m][1] * W8_INV; }
            }
        } else {
            bf16_t* base; int ldc, colt, act = 0; float sc = W8_INV;
            if (pn < 2) { base = qg; ldc = 512; colt = pn * 256; sc = 0.08838834764831845f * W8_INV; }
            else if (pn < 4) { base = kg; ldc = 512; colt = (pn - 2) * 256; }
            else if (pn < 8) { base = vg; ldc = 1024; colt = (pn - 4) * 256; }
            else if (pn < 12) {
#pragma unroll
                for (int ai = 0; ai < 2; ++ai)
#pragma unroll
                    for (int m = 0; m < 4; ++m) { unsigned char* rowp = (unsigned char*)sr + (size_t)(row0 + ai * 128 + m * 16) * 1024 + (pn - 8) * 256 + wc * 32 + 8 * fq;
                        u32x2 o[2];
#pragma unroll
                        for (int bj = 0; bj < 2; ++bj) { const f32x4 v0 = acc[ai][bj][m][0] * W8_INV, v1 = acc[ai][bj][m][1] * W8_INV;
                            o[bj].x = pk4_fp8(v0[0] * sigmoidf_(v0[0]), v0[1] * sigmoidf_(v0[1]), v0[2] * sigmoidf_(v0[2]), v0[3] * sigmoidf_(v0[3]));
                            o[bj].y = pk4_fp8(v1[0] * sigmoidf_(v1[0]), v1[1] * sigmoidf_(v1[1]), v1[2] * sigmoidf_(v1[2]), v1[3] * sigmoidf_(v1[3])); }
                        st_pair16(rowp, 128, o[0], o[1], fq); }
                return; }
            else if (pn < 30) {
#pragma unroll
                for (int ai = 0; ai < 2; ++ai)
#pragma unroll
                    for (int m = 0; m < 4; ++m) { unsigned char* rowp = (unsigned char*)vd + dil_row(4 * (pn - 24) + (wc >> 1), row0 + ai * 128 + m * 16) + (wc & 1) * 32 + 8 * fq;
                        u32x2 o[2];
#pragma unroll
                        for (int bj = 0; bj < 2; ++bj) { const f32x4 v0 = acc[ai][bj][m][0] * W8_INV, v1 = acc[ai][bj][m][1] * W8_INV; o[bj].x = pk4_fp8(v0[0], v0[1], v0[2], v0[3]); o[bj].y = pk4_fp8(v1[0], v1[1], v1[2], v1[3]); }
                        st_pair16(rowp, 2 * 8 * SEQ * 64, o[0], o[1], fq); }
                return; }
            else {
#pragma unroll
                for (int ai = 0; ai < 2; ++ai)
#pragma unroll
                    for (int m = 0; m < 4; ++m) { unsigned char* rowp = (unsigned char*)gt + (size_t)(row0 + ai * 128 + m * 16) * 2048 + (pn - 30) * 256 + wc * 32 + 8 * fq;
                        u32x2 o[2];
#pragma unroll
                        for (int bj = 0; bj < 2; ++bj) {
#pragma unroll
                            for (int n = 0; n < 2; ++n) { const f32x4 v = acc[ai][bj][m][n];
                                o[bj][n] = (unsigned)(sigmoid64_(v[0]) * 255.0f + 0.5f) | ((unsigned)(sigmoid64_(v[1]) * 255.0f + 0.5f) << 8) | ((unsigned)(sigmoid64_(v[2]) * 255.0f + 0.5f) << 16) | ((unsigned)(sigmoid64_(v[3]) * 255.0f + 0.5f) << 24); } }
                        st_pair16(rowp, 128, o[0], o[1], fq); }
                return; }
#pragma unroll
            for (int ai = 0; ai < 2; ++ai)
#pragma unroll
                for (int m = 0; m < 4; ++m) { bf16_t* rowp = base + (size_t)(row0 + ai * 128 + m * 16) * ldc + colt + wc * 32 + 8 * fq;
#pragma unroll
                    for (int bj = 0; bj < 2; ++bj) { f32x4 v0 = acc[ai][bj][m][0] * sc, v1 = acc[ai][bj][m][1] * sc;
                        if (act) {
#pragma unroll
                            for (int j = 0; j < 4; ++j) { const float s0 = sigmoidf_(v0[j]), s1 = sigmoidf_(v1[j]); v0[j] = act == 1 ? v0[j] * s0 : s0; v1[j] = act == 1 ? v1[j] * s1 : s1; } }
                        *(GAS u32x4*)(rowp + bj * 128) = pack8(v0, v1); } }
        }
    }
};
template <bool ADD> struct EpiGate {
    static constexpr bool PERM = true;
    bf16_t* mix; const unsigned char* gt; unsigned char* mix8;
    DI int nvm(const Unit&, int) const { return ADD ? 48 : 32; }
    DI void operator()(const f32x4 (&acc)[2][2][4][2], const Unit& u, int wr, int wc, int fr, int fq) const {
        asm volatile("" : "+v"(fr), "+v"(fq));
        const int row0 = u.pm * 256 + wr * 64 + fr, col0 = u.pn * 256 + wc * 32 + 8 * fq; constexpr float k = W8_INV / 255.0f;
        u32x2 g[2][4][2];
#pragma unroll
        for (int ai = 0; ai < 2; ++ai)
#pragma unroll
            for (int m = 0; m < 4; ++m)
#pragma unroll
                for (int bj = 0; bj < 2; ++bj) g[ai][m][bj] = *(const GAS u32x2*)(gt + (size_t)(row0 + ai * 128 + m * 16) * 2048 + col0 + bj * 128);
#pragma unroll
        for (int ai = 0; ai < 2; ++ai) {
            u32x2 ov[4][2];
            if (ADD) {
#pragma unroll
                for (int m = 0; m < 4; ++m)
#pragma unroll
                    for (int bj = 0; bj < 2; ++bj) ov[m][bj] = *(const GAS u32x2*)((const GAS unsigned char*)mix + (size_t)(row0 + ai * 128 + m * 16) * 1024 + col0 + bj * 128);
            }
            asm volatile("" ::: "memory");
#pragma unroll
            for (int m = 0; m < 4; ++m) { const size_t r = (size_t)(row0 + ai * 128 + m * 16); u32x2 o8v[2];
#pragma unroll
                for (int bj = 0; bj < 2; ++bj) {
                    const u32x2 gg = g[ai][m][bj];
                    f32x4 v0 = acc[ai][bj][m][0], v1 = acc[ai][bj][m][1];
                    v0[0] *= (float)((gg.x >> 0) & 0xffu) * k; v0[1] *= (float)((gg.x >> 8) & 0xffu) * k; v0[2] *= (float)((gg.x >> 16) & 0xffu) * k; v0[3] *= (float)((gg.x >> 24) & 0xffu) * k;
                    v1[0] *= (float)((gg.y >> 0) & 0xffu) * k; v1[1] *= (float)((gg.y >> 8) & 0xffu) * k; v1[2] *= (float)((gg.y >> 16) & 0xffu) * k; v1[3] *= (float)((gg.y >> 24) & 0xffu) * k;
                    if (ADD) { const u32x2 o = ov[m][bj]; const f32x2 oa = __builtin_amdgcn_cvt_pk_f32_fp8((int)o.x, false), ob = __builtin_amdgcn_cvt_pk_f32_fp8((int)o.x, true), oc = __builtin_amdgcn_cvt_pk_f32_fp8((int)o.y, false), od = __builtin_amdgcn_cvt_pk_f32_fp8((int)o.y, true);
                        v0[0] += oa[0]; v0[1] += oa[1]; v0[2] += ob[0]; v0[3] += ob[1]; v1[0] += oc[0]; v1[1] += oc[1]; v1[2] += od[0]; v1[3] += od[1];
                    }
                    o8v[bj].x = pk4_fp8(v0[0], v0[1], v0[2], v0[3]); o8v[bj].y = pk4_fp8(v1[0], v1[1], v1[2], v1[3]); }
                st_pair16((ADD ? mix8 : (unsigned char*)mix) + r * 1024 + col0, 128, o8v[0], o8v[1], fq); }
        }
    }
};
struct EpiRes {
    static constexpr bool PERM = true;
    const float* x32; bf16_t* xr;
    DI int nvm(const Unit&, int) const { return 32; }
    DI void operator()(const f32x4 (&acc)[2][2][4][2], const Unit& u, int wr, int wc, int fr, int fq) const {
        asm volatile("" : "+v"(fr), "+v"(fq));
        const int row0 = u.pm * 256 + wr * 64 + fr, col0 = u.pn * 256 + wc * 32 + 8 * fq;
        if (x32) {
#pragma unroll
            for (int ai = 0; ai < 2; ++ai)
#pragma unroll
                for (int m2 = 0; m2 < 4; m2 += 2) { f32x4 a[2][2][2];
#pragma unroll
                    for (int mm = 0; mm < 2; ++mm)
#pragma unroll
                        for (int bj = 0; bj < 2; ++bj) { const size_t off = (size_t)(row0 + ai * 128 + (m2 + mm) * 16) * 1024 + col0 + bj * 128; a[mm][bj][0] = *(const GAS f32x4*)(x32 + off); a[mm][bj][1] = *(const GAS f32x4*)(x32 + off + 4); }
                    asm volatile("" ::: "memory");
#pragma unroll
                    for (int mm = 0; mm < 2; ++mm)
#pragma unroll
                        for (int bj = 0; bj < 2; ++bj) { const size_t off = (size_t)(row0 + ai * 128 + (m2 + mm) * 16) * 1024 + col0 + bj * 128;
                            *(GAS u32x4*)(xr + off) = pack8(a[mm][bj][0] * DN_ALPHA + acc[ai][bj][m2 + mm][0] * W8_INV, a[mm][bj][1] * DN_ALPHA + acc[ai][bj][m2 + mm][1] * W8_INV); }
                    asm volatile("" ::: "memory"); }
        } else {
#pragma unroll
            for (int ai = 0; ai < 2; ++ai) { u32x4 o[4][2];
#pragma unroll
                for (int m = 0; m < 4; ++m)
#pragma unroll
                    for (int bj = 0; bj < 2; ++bj) o[m][bj] = *(const GAS u32x4*)(xr + (size_t)(row0 + ai * 128 + m * 16) * 1024 + col0 + bj * 128);
                asm volatile("" ::: "memory");
#pragma unroll
                for (int m = 0; m < 4; ++m)
#pragma unroll
                    for (int bj = 0; bj < 2; ++bj) { const u32x4 q = o[m][bj]; const f32x4 a0 = (f32x4){bf_lo(q.x), bf_hi(q.x), bf_lo(q.y), bf_hi(q.y)}, a1 = (f32x4){bf_lo(q.z), bf_hi(q.z), bf_lo(q.w), bf_hi(q.w)};
                        *(GAS u32x4*)(xr + (size_t)(row0 + ai * 128 + m * 16) * 1024 + col0 + bj * 128) = pack8(a0 * DN_ALPHA + acc[ai][bj][m][0] * W8_INV, a1 * DN_ALPHA + acc[ai][bj][m][1] * W8_INV); }
                asm volatile("" ::: "memory"); }
        }
    }
};
struct EpiM1 {
    static constexpr bool PERM = true;
    unsigned char* hm;
    DI int nvm(const Unit&, int) const { return 8; }
    DI void operator()(const f32x4 (&acc)[2][2][4][2], const Unit& u, int wr, int wc, int fr, int fq) const {
        asm volatile("" : "+v"(fr), "+v"(fq));
        const int row0 = u.pm * 256 + wr * 64 + fr, col0 = u.pn * 128 + wc * 32 + 8 * fq;
#pragma unroll
        for (int ai = 0; ai < 2; ++ai)
#pragma unroll
            for (int m2 = 0; m2 < 4; m2 += 2) { u32x2 o[2];
#pragma unroll
                for (int mm = 0; mm < 2; ++mm) { const int m = m2 + mm; f32x4 v0, v1;
#pragma unroll
                    for (int j = 0; j < 4; ++j) { const float g0 = acc[ai][0][m][0][j], g1 = acc[ai][0][m][1][j]; v0[j] = g0 * sigmoid64_(g0) * (acc[ai][1][m][0][j] * (W8_INV * W8_INV)); v1[j] = g1 * sigmoid64_(g1) * (acc[ai][1][m][1][j] * (W8_INV * W8_INV)); }
                    o[mm].x = pk4_fp8(v0[0], v0[1], v0[2], v0[3]); o[mm].y = pk4_fp8(v1[0], v1[1], v1[2], v1[3]); }
                st_pair16(hm + (size_t)(row0 + ai * 128 + m2 * 16) * 1024 + col0, 16 * 1024, o[0], o[1], fq); }
    }
};
struct EpiM2 {
    static constexpr bool PERM = true;
    unsigned char* ys; const int* list; const volatile LAS int* pre;
    DI int nvm(const Unit& u, int) const { return u.nv == 256 ? 24 : 8; }
    DI void operator()(const f32x4 (&acc)[2][2][4][2], const Unit& u, int wr, int wc, int fr, int fq) const {
        asm volatile("" : "+v"(fr), "+v"(fq));
        const int lrow0 = wr * 64 + fr, col0 = u.pn * 256 + wc * 32 + 8 * fq; const int lt = u.pm - rfl(pre[u.e]);
        const int* lp = list + (size_t)u.e * T + 256 * lt;
        int slotv[8];
#pragma unroll
        for (int q = 0; q < 8; ++q) { const int r = lrow0 + (q >> 2) * 128 + (q & 3) * 16; slotv[q] = ((const GAS int*)lp)[r < u.nv ? r : 0]; }
#pragma unroll
        for (int ai = 0; ai < 2; ++ai)
#pragma unroll
            for (int m = 0; m < 4; ++m) { const int r = lrow0 + ai * 128 + m * 16;
                if (r < u.nv) { const int slot = slotv[ai * 4 + m]; unsigned char* yp = ys + (size_t)slot * 1024 + col0;
                    u32x2 o[2];
#pragma unroll
                    for (int bj = 0; bj < 2; ++bj) { const f32x4 v0 = acc[ai][bj][m][0] * W8_INV, v1 = acc[ai][bj][m][1] * W8_INV; o[bj].x = pk4_fp8(v0[0], v0[1], v0[2], v0[3]); o[bj].y = pk4_fp8(v1[0], v1[1], v1[2], v1[3]); }
                    st_pair16(yp, 128, o[0], o[1], fq); } }
    }
};

struct WItem { const float* W; unsigned char* WT; int N, K, drow, c0, nv, kb; };
DI WItem w_decode(const Ctx& c, int l, int it) {
    constexpr int I_IN = (NIN / 32) * 16, I_GO = 512, I_AO = 256, I_OUT = 512, I_EXP = 16 * 512;
    WItem w; int r = it;
    if (r < I_IN) {
        const int nbg = r >> 4, kb = r & 15, pn0 = 32 * nbg, tile = in_tile(pn0 >> 8), p = pn0 & 255, n0 = tile * 256 + p; int c0, nv = 32;
        if (tile < 12) c0 = n0;
        else if (tile < 24) { const int base = tile < 18 ? 3088 : 4624, tq = tile < 18 ? tile - 12 : tile - 18; c0 = base + (4 * tq + ((p & 127) >> 5)) * 64 + (p >= 128 ? 32 : 0); }
        else if (tile < 30) c0 = 6160 + (n0 - 24 * 256);
        else if (tile < 38) c0 = 7696 + (n0 - 30 * 256);
        else { c0 = 3072; nv = (p == 0) ? 16 : 0; }
        w.W = c.w_in + (size_t)l * D * DIN; w.N = DIN; w.WT = c.ws + wset(l) + WS_WIN; w.K = D; w.drow = pn0; w.c0 = c0; w.nv = nv; w.kb = kb; return w; }
    r -= I_IN;
    if (r < I_GO) { w.W = c.w_gla_o + (size_t)l * D * D; w.N = D; w.WT = c.ws + wset(l) + WS_WGO; w.K = D; w.drow = 32 * (r >> 4); w.c0 = w.drow; w.nv = 32; w.kb = r & 15; return w; }
    r -= I_GO;
    if (r < I_AO) { w.W = c.w_att_o + (size_t)l * 512 * D; w.N = D; w.WT = c.ws + wset(l) + WS_WAO; w.K = 512; w.drow = 32 * (r >> 3); w.c0 = w.drow; w.nv = 32; w.kb = r & 7; return w; }
    r -= I_AO;
    if (r < I_OUT) { w.W = c.w_out + (size_t)l * D * D; w.N = D; w.WT = c.ws + wset(l) + WS_WOUT; w.K = D; w.drow = 32 * (r >> 4); w.c0 = w.drow; w.nv = 32; w.kb = r & 15; return w; }
    r -= I_OUT;
    const int which = r / I_EXP; r -= which * I_EXP; const int e = r >> 9, q = r & 511, nbg = q >> 4; const size_t eoff = (size_t)(l * NEXP + e) * D * DFF;
    w.N = DFF; w.K = D; w.c0 = 32 * nbg; w.nv = 32; w.kb = q & 15;
    if (which == 0) { w.W = c.w_e_gate + eoff; w.WT = c.ws + wset(l) + WS_WGU + (size_t)e * 2048 * 1024; w.drow = 256 * (nbg >> 2) + 32 * (nbg & 3); }
    else if (which == 1) { w.W = c.w_e_up + eoff; w.WT = c.ws + wset(l) + WS_WGU + (size_t)e * 2048 * 1024; w.drow = 256 * (nbg >> 2) + 128 + 32 * (nbg & 3); }
    else { w.W = c.w_e_down + eoff; w.N = D; w.K = DFF; w.WT = c.ws + wset(l) + WS_WD + (size_t)e * 1024 * 1024; w.drow = 32 * nbg; }
    return w;
}
DI void w_load(const WItem& w, int lane, float (&v)[32]) {
    const int cc = lane & 31, ccl = cc < w.nv ? cc : 0; const GAS float* wp = (const GAS float*)w.W + (size_t)(64 * w.kb + (lane >> 5)) * w.N + w.c0 + ccl;
#pragma unroll
    for (int i = 0; i < 32; ++i) v[i] = wp[(size_t)(2 * i) * w.N];
}
DI void w_store(const WItem& w, int lane, const float (&v)[32], LAS float* scr) {
    const int cc = lane & 31, k0 = 64 * w.kb;
#pragma unroll
    for (int i = 0; i < 32; ++i) scr[(2 * i + (lane >> 5)) * 33 + cc] = (cc < w.nv) ? v[i] : 0.f;
    LDS_WAIT(); asm volatile("" ::: "memory");
    const int c = lane & 7;
#pragma unroll
    for (int j = 0; j < 4; ++j) { const int n = (lane >> 3) + 8 * j; const LAS float* s = scr + (8 * c) * 33 + n;
        u32x2 o; o.x = pk4_fp8(s[0 * 33] * W8_SCALE, s[1 * 33] * W8_SCALE, s[2 * 33] * W8_SCALE, s[3 * 33] * W8_SCALE); o.y = pk4_fp8(s[4 * 33] * W8_SCALE, s[5 * 33] * W8_SCALE, s[6 * 33] * W8_SCALE, s[7 * 33] * W8_SCALE);
        *(GAS u32x2*)(w.WT + (size_t)(w.drow + n) * w.K + k0 + 8 * c) = o; }
    LDS_WAIT(); asm volatile("" ::: "memory");
}
constexpr int W_NITEMS = (NIN / 32) * 16 + 512 + 256 + 512 + 3 * 16 * 512, W_NTK = (W_NITEMS + 31) / 32;
DI void w_tickets(LAS unsigned char* lds, const Ctx& c, int l, int budget) {
    const int tid = ltid(), lane = tid & 63, wave = rfl(tid >> 6);
    LAS float* scr = (LAS float*)(lds + wave * 16384);
    volatile LAS int* TK = (volatile LAS int*)(lds + MISC_OFF + 208);
    GAS unsigned* ctr = (GAS unsigned*)((unsigned*)(c.ws + WS_CTL) + CW_WTK + l * 64);
    float va[32], vb[32]; WItem wa, wb;
    for (int k = 0; k < budget; ++k) {
        __syncthreads();
        if (tid == 0) TK[0] = (int)__hip_atomic_fetch_add(ctr, 1u, __ATOMIC_RELAXED, __HIP_MEMORY_SCOPE_AGENT);
        __syncthreads();
        const int t = rfl(TK[0]); if (t >= W_NTK) break;
        const int i0 = 32 * t + wave, i1 = i0 + 8, i2 = i0 + 16, i3 = i0 + 24;
        if (i0 < W_NITEMS) { wa = w_decode(c, l, i0); w_load(wa, lane, va); }
        if (i1 < W_NITEMS) { wb = w_decode(c, l, i1); w_load(wb, lane, vb); }
        if (i0 < W_NITEMS) w_store(wa, lane, va, scr);
        if (i2 < W_NITEMS) { wa = w_decode(c, l, i2); w_load(wa, lane, va); }
        if (i1 < W_NITEMS) w_store(wb, lane, vb, scr);
        if (i3 < W_NITEMS) { wb = w_decode(c, l, i3); w_load(wb, lane, vb); }
        if (i2 < W_NITEMS) w_store(wa, lane, va, scr);
        if (i3 < W_NITEMS) w_store(wb, lane, vb, scr);
    }
}
DI void phase_w(LAS unsigned char* lds, const Ctx& c, int l, int G) {
    const int tid = ltid();
    w_tickets(lds, c, l, 1 << 30);
    if (l == 0) {
        const size_t n8 = (size_t)T * D / 8; unsigned char* xb = c.ws + WS_XB;
        const size_t st = (size_t)G * NTHREADS;
        for (size_t i0 = (size_t)lbid() * NTHREADS + tid; i0 < n8; i0 += 4 * st) {
            f32x4 a[4], b[4];
#pragma unroll
            for (int q = 0; q < 4; ++q) { const size_t i = i0 + q * st < n8 ? i0 + q * st : i0; a[q] = *(const GAS f32x4*)(c.x + i * 8); b[q] = *(const GAS f32x4*)(c.x + i * 8 + 4); }
#pragma unroll
            for (int q = 0; q < 4; ++q) { const size_t i = i0 + q * st; if (i < n8) { u32x2 o; o.x = pk4_fp8(a[q][0], a[q][1], a[q][2], a[q][3]); o.y = pk4_fp8(b[q][0], b[q][1], b[q][2], b[q][3]); *(GAS u32x2*)(xb + i * 8) = o; } }
        }
    }
}

DI s16x4 tr16(const LAS void* p) { return __builtin_bit_cast(s16x4, __builtin_amdgcn_ds_read_tr16_b64_v4i16((LAS s16x4*)p)); }
DI bf16x8 cat8(s16x4 lo, s16x4 hi) { return __builtin_shufflevector(lo, hi, 0, 1, 2, 3, 4, 5, 6, 7); }
#define MFMA16(a, b, c) __builtin_amdgcn_mfma_f32_16x16x32_bf16((a), (b), (c), 0, 0, 0)

constexpr int REC_BYTES = 33792, REC_KS = 16384, REC_DEC = 32768, OI_BYTES = 16384;
constexpr int GP_QT = 0, GP_KT = 17408, GP_VS = 34816, GP_ATT = 68608, GP_WUP = 77824, GP_BAL = 86016;
DI float exp_(float x) { return __builtin_amdgcn_exp2f(x * LOG2E); }
DI void unpack8(const u32x4& q, float (&v)[16], int o) { v[o] = bf_lo(q.x); v[o + 1] = bf_hi(q.x); v[o + 2] = bf_lo(q.y); v[o + 3] = bf_hi(q.y); v[o + 4] = bf_lo(q.z); v[o + 5] = bf_hi(q.z); v[o + 6] = bf_lo(q.w); v[o + 7] = bf_hi(q.w); }
DI u32x4 packf8(const float (&v)[16], int o) { u32x4 p; p.x = cvt_pk_bf16(v[o], v[o + 1]); p.y = cvt_pk_bf16(v[o + 2], v[o + 3]); p.z = cvt_pk_bf16(v[o + 4], v[o + 5]); p.w = cvt_pk_bf16(v[o + 6], v[o + 7]); return p; }
#define DPP0(x, ctrl, row_mask) __builtin_bit_cast(float, __builtin_amdgcn_update_dpp(0, __builtin_bit_cast(int, (x)), (ctrl), (row_mask), 0xf, false))
DI float scan64(float x) {
    x += DPP0(x, 0x111, 0xf); x += DPP0(x, 0x112, 0xf); x += DPP0(x, 0x114, 0xf); x += DPP0(x, 0x118, 0xf);
    x += DPP0(x, 0x142, 0xa); x += DPP0(x, 0x143, 0xc);
    return x;
}
DI void gla_p_unit(LAS unsigned char* lds, const Ctx& c, int l, int bl, int h, int n, int& h_loaded) {
    const int tid = ltid(), lane = tid & 63, w = rfl(tid >> 6), fr = lane & 15, fq = lane >> 4;
    const size_t tok0 = (size_t)bl * SEQ + n * 64;
    const bf16_t* QG = wsb(c, WS_H + H_QG) + tok0 * 512 + h * 128;
    const bf16_t* KG = wsb(c, WS_H + H_KG) + tok0 * 512 + h * 128;
    const bf16_t* VG = wsb(c, WS_H + H_VG) + tok0 * 1024 + h * 256;
    const float* HA = (const float*)(c.ws + WS_HA) + tok0 * 16;
    const int unit = (bl * 4 + h) * 64 + n;
    unsigned char* rec = c.ws + WS_REC + (size_t)unit * REC_BYTES;
    unsigned char* oi = c.ws + WS_MIX + (size_t)unit * OI_BYTES;
    LAS bf16_t* QT = (LAS bf16_t*)(lds + GP_QT); LAS bf16_t* KT = (LAS bf16_t*)(lds + GP_KT); LAS bf16_t* VS = (LAS bf16_t*)(lds + GP_VS); LAS bf16_t* AT = (LAS bf16_t*)(lds + GP_ATT);
    LAS float* WUP = (LAS float*)(lds + GP_WUP); LAS float* BAL = (LAS float*)(lds + GP_BAL);
    __syncthreads();
    if (h_loaded != h) { for (int i = tid; i < 16 * 128; i += NTHREADS) WUP[i] = ((const GAS float*)c.w_alpha_up)[(size_t)l * 16 * 512 + (i >> 7) * 512 + h * 128 + (i & 127)];
        if (tid < 128) BAL[tid] = ((const GAS float*)c.b_alpha)[l * 512 + h * 128 + tid]; h_loaded = h; __syncthreads(); }
    {
        const int row = lane;
        f32x4 a4[4];
#pragma unroll
        for (int j = 0; j < 4; ++j) a4[j] = *(const GAS f32x4*)(HA + (size_t)row * 16 + 4 * j);
        const u32x4 q0 = *(const GAS u32x4*)(QG + (size_t)row * 512 + 16 * w), q1 = *(const GAS u32x4*)(QG + (size_t)row * 512 + 16 * w + 8);
        const u32x4 k0 = *(const GAS u32x4*)(KG + (size_t)row * 512 + 16 * w), k1 = *(const GAS u32x4*)(KG + (size_t)row * 512 + 16 * w + 8);
#pragma unroll
        for (int c2 = 0; c2 < 4; ++c2) { const int idx = tid + NTHREADS * c2, r = idx >> 5, ch = idx & 31; *(LAS u32x4*)(VS + r * 264 + ch * 8) = *(const GAS u32x4*)(VG + (size_t)r * 1024 + ch * 8); }
        float la[16];
        {
            f32x2 la2[8];
#pragma unroll
            for (int c2 = 0; c2 < 8; ++c2) la2[c2] = *(const LAS f32x2*)(BAL + 16 * w + 2 * c2);
#pragma unroll
            for (int j = 0; j < 16; ++j) { const float aj = a4[j >> 2][j & 3]; const f32x2 aj2 = (f32x2){aj, aj};
#pragma unroll
                for (int c4 = 0; c4 < 4; ++c4) { const f32x4 wv = *(const LAS f32x4*)(WUP + j * 128 + 16 * w + 4 * c4); la2[2 * c4] = aj2 * __builtin_shufflevector(wv, wv, 0, 1) + la2[2 * c4]; la2[2 * c4 + 1] = aj2 * __builtin_shufflevector(wv, wv, 2, 3) + la2[2 * c4 + 1]; } }
#pragma unroll
            for (int c2 = 0; c2 < 8; ++c2) { la[2 * c2] = la2[c2][0]; la[2 * c2 + 1] = la2[c2][1]; }
        }
#pragma unroll
        for (int cc = 0; cc < 16; ++cc) { const float z = la[cc]; la[cc] = -(fmaxf(-z, 0.f) + __builtin_amdgcn_logf(1.0f + exp_(-fabsf(z))) * 0.6931471805599453f) * (1.0f / 16.0f); }
#pragma unroll
        for (int cc = 0; cc < 16; ++cc) la[cc] = scan64(la[cc]);
        float qv[16], kv[16];
        unpack8(q0, qv, 0); unpack8(q1, qv, 8); unpack8(k0, kv, 0); unpack8(k1, kv, 8);
        float dc[16];
#pragma unroll
        for (int cc = 0; cc < 16; ++cc) { const float b = la[cc]; const float bend = __shfl(b, 63); const float eb = exp_(b); dc[cc] = eb; qv[cc] *= eb; la[cc] = kv[cc] * exp_(bend - b); kv[cc] *= exp_(-b); }
        if (lane == 63) {
#pragma unroll
            for (int c4 = 0; c4 < 4; ++c4) *(GAS f32x4*)(rec + REC_DEC + (16 * w + 4 * c4) * 4) = (f32x4){dc[4 * c4], dc[4 * c4 + 1], dc[4 * c4 + 2], dc[4 * c4 + 3]}; }
        const u32x4 qa = packf8(qv, 0), qb = packf8(qv, 8), ka = packf8(kv, 0), kb = packf8(kv, 8), sa = packf8(la, 0), sb = packf8(la, 8);
        *(LAS u32x4*)(QT + row * 136 + 16 * w) = qa; *(LAS u32x4*)(QT + row * 136 + 16 * w + 8) = qb;
        *(LAS u32x4*)(KT + row * 136 + 16 * w) = ka; *(LAS u32x4*)(KT + row * 136 + 16 * w + 8) = kb;
        *(GAS u32x4*)(rec + row * 256 + (((2 * w) ^ (row & 15)) << 4)) = qa; *(GAS u32x4*)(rec + row * 256 + (((2 * w + 1) ^ (row & 15)) << 4)) = qb;
        *(GAS u32x4*)(rec + REC_KS + row * 256 + (((2 * w) ^ (2 * (row & 7))) << 4)) = sa; *(GAS u32x4*)(rec + REC_KS + row * 256 + (((2 * w + 1) ^ (2 * (row & 7))) << 4)) = sb;
    }
    __syncthreads();
#pragma unroll
    for (int rep = 0; rep < 2; ++rep) {
        const int tt = w + 8 * rep, jt = tt >> 2, it = tt & 3;
        f32x4 a = (f32x4){0.f, 0.f, 0.f, 0.f};
        if (jt <= it) {
#pragma unroll
            for (int k4 = 0; k4 < 4; ++k4) { const bf16x8 af = *(const LAS bf16x8*)(KT + (16 * jt + fr) * 136 + 32 * k4 + 8 * fq), bfr = *(const LAS bf16x8*)(QT + (16 * it + fr) * 136 + 32 * k4 + 8 * fq); a = MFMA16(af, bfr, a); }
        }
        const int i = 16 * it + fr, j0 = 16 * jt + 4 * fq;
        u32x2 o; o.x = cvt_pk_bf16(j0 <= i ? a[0] : 0.f, j0 + 1 <= i ? a[1] : 0.f); o.y = cvt_pk_bf16(j0 + 2 <= i ? a[2] : 0.f, j0 + 3 <= i ? a[3] : 0.f);
        *(LAS u32x2*)(AT + i * 72 + j0) = o;
    }
    __syncthreads();
    {
        const int dv0 = 32 * w;
        bf16x8 vb[2][2];
#pragma unroll
        for (int k2 = 0; k2 < 2; ++k2)
#pragma unroll
            for (int dt = 0; dt < 2; ++dt) { const LAS bf16_t* p = VS + (32 * k2 + 8 * fq + (fr >> 2)) * 264 + dv0 + 16 * dt + (fr & 3) * 4; vb[k2][dt] = cat8(tr16(p), tr16(p + 4 * 264)); }
#pragma unroll
        for (int tt = 0; tt < 4; ++tt) {
            const bf16x8 a0 = *(const LAS bf16x8*)(AT + (16 * tt + fr) * 72 + 8 * fq), a1 = *(const LAS bf16x8*)(AT + (16 * tt + fr) * 72 + 32 + 8 * fq);
#pragma unroll
            for (int dt = 0; dt < 2; ++dt) { f32x4 z = (f32x4){0.f, 0.f, 0.f, 0.f}; z = MFMA16(vb[0][dt], a0, z); z = MFMA16(vb[1][dt], a1, z);
                *(GAS unsigned*)(oi + ((w * 8 + tt * 2 + dt) * 64 + lane) * 4) = pk4_fp8(z[0], z[1], z[2], z[3]); }
        }
    }
}
constexpr int GSEG = 16, NSEG = 64 / GSEG;
constexpr int GL_STAGE = 50176, GL_DEC = 16384, GL_VS = 17408;
static_assert(3 * GL_STAGE <= MISC_OFF, "light-chain stages");
DI void gla_l_chain(LAS unsigned char* lds, const Ctx& c, int bl, int h, int seg) {
    const int tid = ltid(), lane = tid & 63, w = rfl(tid >> 6), fr = lane & 15, fq = lane >> 4;
    const size_t t0 = (size_t)bl * SEQ + (size_t)seg * (GSEG * 64);
    const bf16_t* VG = wsb(c, WS_H + H_VG) + t0 * 1024 + h * 256;
    const unsigned char* rec0 = c.ws + WS_REC + (size_t)((bl * 4 + h) * 64 + seg * GSEG) * REC_BYTES;
    const int dv0 = 32 * w; const unsigned lds_u = (unsigned)(uintptr_t)lds;
    f32x4 S[8][2], Dc[8];
#pragma unroll
    for (int a = 0; a < 8; ++a) { S[a][0] = (f32x4){0.f, 0.f, 0.f, 0.f}; S[a][1] = (f32x4){0.f, 0.f, 0.f, 0.f}; Dc[a] = (f32x4){1.f, 1.f, 1.f, 1.f}; }
#define GL_DMA(gp, ldsoff) do { unsigned _sv; const unsigned _m = (unsigned)__builtin_amdgcn_readfirstlane((int)(ldsoff)); \
        asm volatile("s_mov_b32 %0, m0\n\ts_mov_b32 m0, %2\n\ts_nop 0\n\tglobal_load_lds_dwordx4 %1, off\n\ts_mov_b32 m0, %0" : "=&s"(_sv) : "v"(gp), "s"(_m) : "memory"); } while (0)
#define GL_PREFETCH(nn, st) do { const unsigned char* _r = rec0 + (size_t)(nn) * REC_BYTES + REC_KS; const unsigned _s = lds_u + (unsigned)(st) * GL_STAGE; \
        _Pragma("unroll") for (int _p = 0; _p < 2; ++_p) GL_DMA((const GAS unsigned char*)(_r + (w * 2 + _p) * 1024 + lane * 16), _s + (w * 2 + _p) * 1024); \
        if (w == 0) GL_DMA((const GAS unsigned char*)(_r + 16384 + lane * 16), _s + GL_DEC); \
        _Pragma("unroll") for (int _p = 0; _p < 4; ++_p) { const int _row = 2 * (w * 4 + _p) + (lane >> 5); \
            GL_DMA((const GAS bf16_t*)(VG + (size_t)((nn) * 64 + _row) * 1024 + (((lane & 31) ^ (2 * (_row & 3))) << 3)), _s + GL_VS + (w * 4 + _p) * 1024); } } while (0)
    __syncthreads();
    GL_PREFETCH(0, 0); GL_PREFETCH(1, 1);
    int st = 0;
    for (int n = 0; n < GSEG; ++n) {
        LAS unsigned char* sb_ = lds + st * GL_STAGE;
        LAS bf16_t* KS = (LAS bf16_t*)sb_; LAS float* DEC = (LAS float*)(sb_ + GL_DEC); LAS bf16_t* VS = (LAS bf16_t*)(sb_ + GL_VS);
        if (n + 1 < GSEG) { if (w == 0) asm volatile("s_waitcnt vmcnt(7)" ::: "memory"); else asm volatile("s_waitcnt vmcnt(6)" ::: "memory"); } else VM_WAIT();
        asm volatile("s_waitcnt lgkmcnt(0)" ::: "memory"); __builtin_amdgcn_s_barrier(); asm volatile("" ::: "memory");
        if (n + 2 < GSEG) GL_PREFETCH(n + 2, st == 0 ? 2 : st - 1);
        bf16x8 vb[2][2];
#pragma unroll
        for (int k2 = 0; k2 < 2; ++k2)
#pragma unroll
            for (int dt = 0; dt < 2; ++dt) { const int r0 = 32 * k2 + 8 * fq + (fr >> 2);
                const LAS bf16_t* p = VS + r0 * 256 + ((((dv0 + 16 * dt) >> 3) ^ (2 * (r0 & 3))) << 3) + (fr & 3) * 4; vb[k2][dt] = cat8(tr16(p), tr16(p + 4 * 256)); }
#pragma unroll
        for (int k8 = 0; k8 < 8; ++k8) {
            const f32x4 dc = *(const LAS f32x4*)(DEC + 16 * k8 + 4 * fq);
            S[k8][0] *= dc; S[k8][1] *= dc; Dc[k8] *= dc;
#pragma unroll
            for (int k2 = 0; k2 < 2; ++k2) { const int r0 = 32 * k2 + 8 * fq + (fr >> 2);
                const LAS bf16_t* p0 = KS + r0 * 128 + (((2 * k8) ^ (2 * (r0 & 7))) << 3) + (fr & 3) * 4; const LAS bf16_t* p1 = KS + (r0 + 4) * 128 + (((2 * k8) ^ (2 * ((r0 + 4) & 7))) << 3) + (fr & 3) * 4;
                const bf16x8 af = cat8(tr16(p0), tr16(p1));
                S[k8][0] = MFMA16(af, vb[k2][0], S[k8][0]); S[k8][1] = MFMA16(af, vb[k2][1], S[k8][1]); }
        }
        st = st == 2 ? 0 : st + 1;
    }
#undef GL_PREFETCH
#undef GL_DMA
    const int cj = (bl * 4 + h) * NSEG + seg;
    GAS f32x4* sl = (GAS f32x4*)(c.ws + WS_SLOC) + ((size_t)(cj * 8 + w) * 16) * 64 + lane;
#pragma unroll
    for (int a = 0; a < 8; ++a) { sl[(a * 2) * 64] = S[a][0]; sl[(a * 2 + 1) * 64] = S[a][1]; }
    if (w == 0) { GAS f32x4* dq = (GAS f32x4*)(c.ws + WS_DCUM) + (size_t)cj * 8 * 64 + lane;
#pragma unroll
        for (int a = 0; a < 8; ++a) dq[a * 64] = Dc[a]; }
    VM_WAIT(); __syncthreads();
}
constexpr int GS_STAGE = 66560, GS_KS = 16384, GS_DEC = 32768, GS_VS = 33792, GS_SS = 2 * GS_STAGE;
DI void gla_s_chain(LAS unsigned char* lds, const Ctx& c, int l, int bl, int h, int seg) {
    const int tid = ltid(), lane = tid & 63, w = rfl(tid >> 6), fr = lane & 15, fq = lane >> 4;
    const size_t t0 = (size_t)bl * SEQ + (size_t)seg * (GSEG * 64);
    const bf16_t* VG = wsb(c, WS_H + H_VG) + t0 * 1024 + h * 256;
    const unsigned char* SR = c.ws + WS_H + H_SR + t0 * 1024 + h * 256;
    unsigned char* OG = c.ws + WS_OG + t0 * 1024 + h * 256;
    const unsigned char* rec0 = c.ws + WS_REC + (size_t)((bl * 4 + h) * 64 + seg * GSEG) * REC_BYTES;
    const unsigned char* oi0 = c.ws + WS_MIX + (size_t)((bl * 4 + h) * 64 + seg * GSEG) * OI_BYTES;
    LAS float* SS = (LAS float*)(lds + GS_SS);
    const int dv0 = 32 * w;
    f32x4 gnv[2]; gnv[0] = *(const GAS f32x4*)(c.gla_norm + l * 1024 + h * 256 + dv0 + 4 * fq); gnv[1] = *(const GAS f32x4*)(c.gla_norm + l * 1024 + h * 256 + dv0 + 16 + 4 * fq);
    f32x4 S[8][2];
#pragma unroll
    for (int a = 0; a < 8; ++a) { S[a][0] = (f32x4){0.f, 0.f, 0.f, 0.f}; S[a][1] = (f32x4){0.f, 0.f, 0.f, 0.f}; }
    for (int j = 0; j < seg; ++j) {
        const int cj = (bl * 4 + h) * NSEG + j;
        const GAS f32x4* sl = (const GAS f32x4*)(c.ws + WS_SLOC) + ((size_t)(cj * 8 + w) * 16) * 64 + lane; const GAS f32x4* dq = (const GAS f32x4*)(c.ws + WS_DCUM) + (size_t)cj * 8 * 64 + lane;
#pragma unroll
        for (int a = 0; a < 8; ++a) { const f32x4 dcv = dq[a * 64]; S[a][0] = S[a][0] * dcv + sl[(a * 2) * 64]; S[a][1] = S[a][1] * dcv + sl[(a * 2 + 1) * 64]; }
    }
#define GS_DMA(gp, ldsoff) do { unsigned _sv; const unsigned _m = (unsigned)__builtin_amdgcn_readfirstlane((int)(ldsoff)); \
        asm volatile("s_mov_b32 %0, m0\n\ts_mov_b32 m0, %2\n\ts_nop 0\n\tglobal_load_lds_dwordx4 %1, off\n\ts_mov_b32 m0, %0" : "=&s"(_sv) : "v"(gp), "s"(_m) : "memory"); } while (0)
#define GS_PREFETCH(nn, st) do { const unsigned char* _r = rec0 + (size_t)(nn) * REC_BYTES; const unsigned _s = lds_u + (unsigned)(st) * GS_STAGE; \
        _Pragma("unroll") for (int _p = 0; _p < 4; ++_p) GS_DMA((const GAS unsigned char*)(_r + (w * 4 + _p) * 1024 + lane * 16), _s + (w * 4 + _p) * 1024); \
        if (w == 0) GS_DMA((const GAS unsigned char*)(_r + 32768 + lane * 16), _s + 32768); \
        _Pragma("unroll") for (int _p = 0; _p < 4; ++_p) { const int _row = 2 * (w * 4 + _p) + (lane >> 5); \
            GS_DMA((const GAS bf16_t*)(VG + (size_t)((nn) * 64 + _row) * 1024 + (((lane & 31) ^ (2 * (_row & 3))) << 3)), _s + GS_VS + (w * 4 + _p) * 1024); } } while (0)
    const unsigned lds_u = (unsigned)(uintptr_t)lds;
#define GS_BAR() do { asm volatile("s_waitcnt lgkmcnt(0)" ::: "memory"); __builtin_amdgcn_s_barrier(); asm volatile("" ::: "memory"); } while (0)
#define GS_HEAD(n_) do { \
        _Pragma("unroll") for (int q = 0; q < 8; ++q) oiv[q] = *(const GAS unsigned*)(oi0 + (size_t)(n_) * OI_BYTES + ((w * 8 + q) * 64 + lane) * 4); \
        if ((n_) > 0) { _Pragma("unroll") for (int q = 0; q < 8; ++q) srv[q] = *(const GAS unsigned*)(SR + (size_t)(((n_) - 1) * 64 + 16 * (q >> 1) + fr) * 1024 + dv0 + 16 * (q & 1) + 4 * fq); }     \
        asm volatile("" ::: "memory"); \
        if ((n_) + 1 < GSEG) GS_PREFETCH((n_) + 1, (((n_) & 1) ^ 1)); } while (0)
#define GS_MAIN(n_) do { \
        LAS unsigned char* sb_ = lds + ((n_) & 1) * GS_STAGE; LAS float* SSn = SS + ((n_) & 1) * 512; \
        LAS bf16_t* QT = (LAS bf16_t*)sb_; LAS bf16_t* KS = (LAS bf16_t*)(sb_ + GS_KS); LAS float* DEC = (LAS float*)(sb_ + GS_DEC); LAS bf16_t* VS = (LAS bf16_t*)(sb_ + GS_VS); \
        bf16x8 vb[2][2]; \
        _Pragma("unroll") for (int k2 = 0; k2 < 2; ++k2) _Pragma("unroll") for (int dt = 0; dt < 2; ++dt) { const int r0 = 32 * k2 + 8 * fq + (fr >> 2); \
            const LAS bf16_t* p = VS + r0 * 256 + ((((dv0 + 16 * dt) >> 3) ^ (2 * (r0 & 3))) << 3) + (fr & 3) * 4; vb[k2][dt] = cat8(tr16(p), tr16(p + 4 * 256)); } \
        _Pragma("unroll") for (int tt = 0; tt < 4; ++tt) { o[tt][0] = (f32x4){0.f, 0.f, 0.f, 0.f}; o[tt][1] = (f32x4){0.f, 0.f, 0.f, 0.f}; } \
        _Pragma("unroll") for (int s = 0; s < 4; ++s) { \
            bf16x8 sb[2]; \
            _Pragma("unroll") for (int dt = 0; dt < 2; ++dt) { u32x4 pk; pk.x = cvt_pk_bf16(S[2 * s][dt][0], S[2 * s][dt][1]); pk.y = cvt_pk_bf16(S[2 * s][dt][2], S[2 * s][dt][3]); pk.z = cvt_pk_bf16(S[2 * s + 1][dt][0], S[2 * s + 1][dt][1]); pk.w = cvt_pk_bf16(S[2 * s + 1][dt][2], S[2 * s + 1][dt][3]); sb[dt] = __builtin_bit_cast(bf16x8, pk); } \
            _Pragma("unroll") for (int tt = 0; tt < 4; ++tt) { const int i = 16 * tt + fr; \
                const LAS bf16_t* qp = QT + i * 128 + (fq & 1) * 4; \
                const bf16x8 af = cat8(*(const LAS s16x4*)(qp + (((4 * s + (fq >> 1)) ^ (i & 15)) << 3)), *(const LAS s16x4*)(qp + (((4 * s + 2 + (fq >> 1)) ^ (i & 15)) << 3))); \
                o[tt][0] = MFMA16(sb[0], af, o[tt][0]); o[tt][1] = MFMA16(sb[1], af, o[tt][1]); } \
        } \
        _Pragma("unroll") for (int k8 = 0; k8 < 8; ++k8) { \
            const f32x4 dc = *(const LAS f32x4*)(DEC + 16 * k8 + 4 * fq); \
            S[k8][0] *= dc; S[k8][1] *= dc; \
            _Pragma("unroll") for (int k2 = 0; k2 < 2; ++k2) { const int r0 = 32 * k2 + 8 * fq + (fr >> 2); \
                const LAS bf16_t* p0 = KS + r0 * 128 + (((2 * k8) ^ (2 * (r0 & 7))) << 3) + (fr & 3) * 4; const LAS bf16_t* p1 = KS + (r0 + 4) * 128 + (((2 * k8) ^ (2 * ((r0 + 4) & 7))) << 3) + (fr & 3) * 4; \
                const bf16x8 af = cat8(tr16(p0), tr16(p1)); \
                S[k8][0] = MFMA16(af, vb[k2][0], S[k8][0]); S[k8][1] = MFMA16(af, vb[k2][1], S[k8][1]); } \
        } \
        _Pragma("unroll") for (int tt = 0; tt < 4; ++tt) _Pragma("unroll") for (int dt = 0; dt < 2; ++dt) { const f32x2 a = __builtin_amdgcn_cvt_pk_f32_fp8((int)oiv[tt * 2 + dt], false), b = __builtin_amdgcn_cvt_pk_f32_fp8((int)oiv[tt * 2 + dt], true); o[tt][dt][0] += a[0]; o[tt][dt][1] += a[1]; o[tt][dt][2] += b[0]; o[tt][dt][3] += b[1]; } \
        {     \
            f32x4 pp; \
            _Pragma("unroll") for (int tt = 0; tt < 4; ++tt) { const f32x4 a = o[tt][0] * o[tt][0] + o[tt][1] * o[tt][1]; float p = (a[0] + a[1]) + (a[2] + a[3]); p += __shfl_xor(p, 16); p += __shfl_xor(p, 32); pp[tt] = p; } \
            if (fq == 0) { SSn[(0 * 16 + fr) * 8 + w] = pp[0]; SSn[(1 * 16 + fr) * 8 + w] = pp[1]; SSn[(2 * 16 + fr) * 8 + w] = pp[2]; SSn[(3 * 16 + fr) * 8 + w] = pp[3]; }     \
        } } while (0)
#define GS_TAIL(m_) do { const LAS float* SSm = SS + ((m_) & 1) * 512; \
        _Pragma("unroll") for (int tt = 0; tt < 4; ++tt) { const f32x4 s0 = *(const LAS f32x4*)(SSm + (16 * tt + fr) * 8), s1 = *(const LAS f32x4*)(SSm + (16 * tt + fr) * 8 + 4); \
            const float ss = ((s0[0] + s0[1]) + (s0[2] + s0[3])) + ((s1[0] + s1[1]) + (s1[2] + s1[3])); const float rs = __builtin_amdgcn_rsqf(ss * (1.0f / 256.0f) + RMS_EPS); \
            _Pragma("unroll") for (int dt = 0; dt < 2; ++dt) { const f32x2 sa = __builtin_amdgcn_cvt_pk_f32_fp8((int)srv[tt * 2 + dt], false), sb2 = __builtin_amdgcn_cvt_pk_f32_fp8((int)srv[tt * 2 + dt], true); const f32x4 g = gnv[dt]; const u32x2 ok = opk[tt][dt]; const f32x4 v = (f32x4){bf_lo(ok.x), bf_hi(ok.x), bf_lo(ok.y), bf_hi(ok.y)} * rs; \
                *(GAS unsigned*)(OG + (size_t)((m_) * 64 + 16 * tt + fr) * 1024 + dv0 + 16 * dt + 4 * fq) = pk4_fp8(v[0] * g[0] * sa[0], v[1] * g[1] * sa[1], v[2] * g[2] * sb2[0], v[3] * g[3] * sb2[1]); } } } while (0)
#define GS_KEEP() do { _Pragma("unroll") for (int tt = 0; tt < 4; ++tt) _Pragma("unroll") for (int dt = 0; dt < 2; ++dt) { opk[tt][dt].x = cvt_pk_bf16(o[tt][dt][0], o[tt][dt][1]); opk[tt][dt].y = cvt_pk_bf16(o[tt][dt][2], o[tt][dt][3]); } } while (0)
    f32x4 o[4][2]; u32x2 opk[4][2]; unsigned oiv[8], srv[8];
    __syncthreads();
    GS_PREFETCH(0, 0);
    VM_WAIT(); GS_BAR();
    GS_HEAD(0); GS_MAIN(0); GS_KEEP();
    for (int n = 1; n < GSEG; ++n) {
        if (n == 1) VM_WAIT(); else asm volatile("s_waitcnt vmcnt(8)" ::: "memory");
        GS_BAR();
        GS_HEAD(n);
        GS_MAIN(n);
        GS_TAIL(n - 1);
        GS_KEEP();
    }
#pragma unroll
    for (int q = 0; q < 8; ++q) srv[q] = *(const GAS unsigned*)(SR + (size_t)((GSEG - 1) * 64 + 16 * (q >> 1) + fr) * 1024 + dv0 + 16 * (q & 1) + 4 * fq);
    GS_BAR();
    GS_TAIL(GSEG - 1);
#undef GS_HEAD
#undef GS_MAIN
#undef GS_TAIL
#undef GS_KEEP
#undef GS_PREFETCH
#undef GS_DMA
#undef GS_BAR
    VM_WAIT(); __syncthreads();
}

constexpr int AT_K = 0, AT_V = 55296;
struct APre { u32x2 k[6], v[6], q[2][2]; };
DI u32x4 fp8x8_to_bf16(const u32x2 w) { const f32x2 a = __builtin_amdgcn_cvt_pk_f32_fp8((int)w.x, false), b = __builtin_amdgcn_cvt_pk_f32_fp8((int)w.x, true), c_ = __builtin_amdgcn_cvt_pk_f32_fp8((int)w.y, false), d = __builtin_amdgcn_cvt_pk_f32_fp8((int)w.y, true);
    u32x4 o; o.x = cvt_pk_bf16(a[0], a[1]); o.y = cvt_pk_bf16(b[0], b[1]); o.z = cvt_pk_bf16(c_[0], c_[1]); o.w = cvt_pk_bf16(d[0], d[1]); return o; }
struct AUnit { int dl, n, colo; unsigned tb, slab; };
DI AUnit attn_decode(int u) { AUnit a; const int bl = u / 768, g = (u / 256) % 3, h = (u >> 5) & 7, x = u & 31; a.dl = (g == 0) ? 1 : (g == 1 ? 4 : 16); const int nb = 32 / a.dl, r = x / nb; a.n = x - r * nb; a.tb = (unsigned)(bl * SEQ + r); a.colo = g * 512 + h * 64; a.slab = (unsigned)(((g * 8 + h) * 8 + bl) * SEQ + r * (SEQ / a.dl)) * 64u; return a; }
DI void attn_load(const Ctx& c, int u, APre& p) {
    const int tid = ltid(), lane = tid & 63, w = rfl(tid >> 6), fr = lane & 15, fq = lane >> 4; const AUnit a = attn_decode(u);
    const GAS char* Q = (const GAS char*)(c.ws + WS_H + H_QD) + a.slab; const GAS char* K = (const GAS char*)(c.ws + WS_H + H_KD) + a.slab; const GAS char* V = (const GAS char*)(c.ws + WS_H + H_VD) + a.slab;
#pragma unroll
    for (int b = 0; b < 2; ++b) { const unsigned jq = (unsigned)(128 * (a.n + b) + 16 * w + fr);
#pragma unroll
        for (int d0 = 0; d0 < 2; ++d0) p.q[b][d0] = *(const GAS u32x2*)(Q + (jq * 64u + (unsigned)(32 * d0 + 8 * fq))); }
#pragma unroll
    for (int c2 = 0; c2 < 6; ++c2) { const int idx = tid + NTHREADS * c2, row = idx >> 3, ch = idx & 7; const int j = 128 * (a.n - 1) + row;
        p.k[c2] = (u32x2){0u, 0u}; p.v[c2] = (u32x2){0u, 0u};
        if (j >= 0) { const unsigned off = (unsigned)j * 64u + (unsigned)(ch * 8); p.k[c2] = *(const GAS u32x2*)(K + off); p.v[c2] = *(const GAS u32x2*)(V + off); } }
}
DI void attn_stage(LAS unsigned char* lds, const APre& p) {
    const int tid = ltid(); LAS bf16_t* Ks = (LAS bf16_t*)(lds + AT_K); LAS bf16_t* Vs = (LAS bf16_t*)(lds + AT_V);
#pragma unroll
    for (int c2 = 0; c2 < 6; ++c2) { const int o = (tid >> 3) * 72 + (tid & 7) * 8 + c2 * (64 * 72); *(LAS u32x4*)(Ks + o) = fp8x8_to_bf16(p.k[c2]); *(LAS u32x4*)(Vs + o) = fp8x8_to_bf16(p.v[c2]); }
}
DI void attn_compute(LAS unsigned char* lds, const Ctx& c, int u, const bf16x8 (&qf)[2][2]) {
    const int tid = ltid(), lane = tid & 63, w = rfl(tid >> 6), fr = lane & 15, fq = lane >> 4; const AUnit au = attn_decode(u);
    const int dl = au.dl, n = au.n, g = (u / 256) % 3, h = (u >> 5) & 7; const unsigned tb = au.tb;
    LAS bf16_t* Ks = (LAS bf16_t*)(lds + AT_K); LAS bf16_t* Vs = (LAS bf16_t*)(lds + AT_V);
#pragma unroll
    for (int b = 0; b < 2; ++b) {
        const int kt0 = 8 * b + w;
        const LAS bf16_t* kbase = Ks + (16 * w + fr) * 72 + 8 * fq + b * (128 * 72);
        const LAS bf16_t* vbase = Vs + (16 * w + 4 * fq + (fr >> 2)) * 72 + (fr & 3) * 4 + b * (128 * 72);
        f32x4 s[9]; float m = -1e30f;
#pragma unroll
        for (int kr = 0; kr < 9; ++kr) { const int kt = kt0 + kr; f32x4 a = (f32x4){0.f, 0.f, 0.f, 0.f};
#pragma unroll
            for (int d0 = 0; d0 < 2; ++d0) { const bf16x8 af = *(const LAS bf16x8*)(kbase + kr * (16 * 72) + 32 * d0); a = MFMA16(af, qf[b][d0], a); }
#pragma unroll
            for (int rg = 0; rg < 4; ++rg) { const bool tile_ok = (b > 0) || (n > 0) || (kt >= 8);
                bool ok = tile_ok; if (kr == 0) ok = ok && (4 * fq + rg >= fr); if (kr == 8) ok = ok && (4 * fq + rg <= fr);
                a[rg] = ok ? a[rg] : -1e30f; m = fmaxf(m, a[rg]); }
            s[kr] = a; }
        m = fmaxf(m, __shfl_xor(m, 16)); m = fmaxf(m, __shfl_xor(m, 32));
        f32x4 ls4 = (f32x4){0.f, 0.f, 0.f, 0.f}; const f32x4 m4 = (f32x4){m, m, m, m};
#pragma unroll
        for (int kr = 0; kr < 9; ++kr) { const f32x4 d = s[kr] - m4;
            s[kr] = (f32x4){__builtin_amdgcn_exp2f(d[0]), __builtin_amdgcn_exp2f(d[1]), __builtin_amdgcn_exp2f(d[2]), __builtin_amdgcn_exp2f(d[3])}; ls4 += s[kr]; }
        float lsum = (ls4[0] + ls4[1]) + (ls4[2] + ls4[3]);
        lsum += __shfl_xor(lsum, 16); lsum += __shfl_xor(lsum, 32);
        f32x4 oT[4];
#pragma unroll
        for (int dt = 0; dt < 4; ++dt) oT[dt] = (f32x4){0.f, 0.f, 0.f, 0.f};
#pragma unroll
        for (int pp = 0; pp < 5; ++pp) { const int ka = 2 * pp, kb = (2 * pp + 1 < 9) ? 2 * pp + 1 : 8;
            u32x4 pk; pk.x = cvt_pk_bf16(s[ka][0], s[ka][1]); pk.y = cvt_pk_bf16(s[ka][2], s[ka][3]);
            if (2 * pp + 1 < 9) { pk.z = cvt_pk_bf16(s[kb][0], s[kb][1]); pk.w = cvt_pk_bf16(s[kb][2], s[kb][3]); } else { pk.z = 0u; pk.w = 0u; }
            const bf16x8 pf = __builtin_bit_cast(bf16x8, pk);
#pragma unroll
            for (int dt = 0; dt < 4; ++dt) { const LAS bf16_t* pa = vbase + ka * (16 * 72) + 16 * dt; const LAS bf16_t* pb = vbase + kb * (16 * 72) + 16 * dt;
                oT[dt] = MFMA16(cat8(tr16(pa), tr16(pb)), pf, oT[dt]); } }
        const float inv = 1.0f / lsum; const unsigned tq = tb + (unsigned)dl * (unsigned)(128 * (n + b) + 16 * w + fr), gt = (unsigned)(g * TH) + tq;
        GAS char* op = (GAS char*)(c.ws + WS_ATTG) + (gt * 512u + (unsigned)(h * 64 + 4 * fq));
#pragma unroll
        for (int dt = 0; dt < 4; ++dt) *(GAS unsigned*)(op + 16 * dt) = pk4_fp8(oT[dt][0] * inv, oT[dt][1] * inv, oT[dt][2] * inv, oT[dt][3] * inv);
        if (fq == 0) *(GAS float*)((GAS char*)(c.ws + WS_LSE) + (gt * 32u + (unsigned)(h * 4))) = m + __builtin_amdgcn_logf(lsum);
    }
}
DI void phase_p(LAS unsigned char* lds, const Ctx& c, int l, int G) {
    int h_loaded = -1;
    for (int u = lbid(); u < 8 * 4 * 64; u += G) gla_p_unit(lds, c, l, u >> 8, (u >> 6) & 3, u & 63, h_loaded);
}
constexpr int NATT = 8 * 3 * 8 * 32, NATT1 = 1536, NCHAIN = 8 * 4 * NSEG;
#define AT_BAR() do { asm volatile("s_waitcnt lgkmcnt(0)" ::: "memory"); __builtin_amdgcn_s_barrier(); asm volatile("" ::: "memory"); } while (0)
DI void attn_pull(LAS unsigned char* lds, const Ctx& c, unsigned* ctr, int base, int limit) {
    volatile LAS int* TK = (volatile LAS int*)(lds + MISC_OFF + 192);
    const int tid = ltid();
    __syncthreads();
    if (tid == 0) { TK[0] = base + 2 * (int)__hip_atomic_fetch_add((GAS unsigned*)ctr, 1u, __ATOMIC_RELAXED, __HIP_MEMORY_SCOPE_AGENT); TK[1] = base + 2 * (int)__hip_atomic_fetch_add((GAS unsigned*)ctr, 1u, __ATOMIC_RELAXED, __HIP_MEMORY_SCOPE_AGENT);
        TK[2] = base + 2 * (int)__hip_atomic_fetch_add((GAS unsigned*)ctr, 1u, __ATOMIC_RELAXED, __HIP_MEMORY_SCOPE_AGENT); }
    __syncthreads();
    int cur = rfl(TK[0]), nxt = rfl(TK[1]);
    APre pre;
    if (cur < limit) attn_load(c, cur, pre);
    while (cur < limit) {
        AT_BAR();
        const int nxt2 = rfl(TK[2]);
        attn_stage(lds, pre);
        bf16x8 qf[2][2];
#pragma unroll
        for (int b = 0; b < 2; ++b)
#pragma unroll
            for (int d0 = 0; d0 < 2; ++d0) qf[b][d0] = __builtin_bit_cast(bf16x8, fp8x8_to_bf16(pre.q[b][d0]));
        AT_BAR();
        if (nxt < limit) attn_load(c, nxt, pre);
        int req = 0; if (tid == 0) req = base + 2 * (int)__hip_atomic_fetch_add((GAS unsigned*)ctr, 1u, __ATOMIC_RELAXED, __HIP_MEMORY_SCOPE_AGENT);
        attn_compute(lds, c, cur, qf);
        if (tid == 0) TK[2] = req;
        cur = nxt; nxt = nxt2;
    }
}
DI void phase_b1(LAS unsigned char* lds, const Ctx& c, int l, int hf, int G) {
    const int bid = lbid(); unsigned* ctr = (unsigned*)(c.ws + WS_CTL) + CW_TKT + ((l * 2 + hf) * 2) * 64;
    for (int id = bid; id < NCHAIN; id += G) if ((id & 3) != NSEG - 1) gla_l_chain(lds, c, id >> 4, (id >> 2) & 3, id & 3);
    attn_pull(lds, c, ctr, 0, NATT1);
}
DI void phase_b(LAS unsigned char* lds, const Ctx& c, int l, int hf, int G) {
    const int bid = lbid(); unsigned* ctr = (unsigned*)(c.ws + WS_CTL) + CW_TKT + ((l * 2 + hf) * 2 + 1) * 64;
    for (int id = bid; id < NCHAIN; id += G) gla_s_chain(lds, c, l, id >> 4, (id >> 2) & 3, id & 3);
    attn_pull(lds, c, ctr, NATT1, NATT);
}
DI void phase_f(const Ctx& c, int G) {
    const GAS unsigned char* ag = (const GAS unsigned char*)(c.ws + WS_ATTG); const GAS float* lse = (const GAS float*)(c.ws + WS_LSE); unsigned char* att = c.ws + WS_ATT;
    const size_t stride = (size_t)G * NTHREADS, N = (size_t)TH * 64;
    for (size_t i0 = (size_t)lbid() * NTHREADS + ltid(); i0 < N; i0 += 8 * stride) {
        float l0[8], l1[8], l2[8]; u32x2 a[8], b[8], d[8];
#pragma unroll
        for (int q = 0; q < 8; ++q) { const size_t i = i0 + q * stride; const bool ok = i < N; const size_t tok = ok ? (i >> 6) : 0; const int ch = (int)(i & 63), h = ch >> 3;
            l0[q] = lse[tok * 8 + h]; l1[q] = lse[((size_t)TH + tok) * 8 + h]; l2[q] = lse[((size_t)2 * TH + tok) * 8 + h];
            a[q] = *(const GAS u32x2*)(ag + tok * 512 + ch * 8); b[q] = *(const GAS u32x2*)(ag + ((size_t)TH + tok) * 512 + ch * 8); d[q] = *(const GAS u32x2*)(ag + ((size_t)2 * TH + tok) * 512 + ch * 8); }
#pragma unroll
        for (int q = 0; q < 8; ++q) { const size_t i = i0 + q * stride; if (i >= N) continue; const size_t tok = i >> 6; const int ch = (int)(i & 63);
            const float mx = fmaxf(l0[q], fmaxf(l1[q], l2[q])); float w0 = __builtin_amdgcn_exp2f(l0[q] - mx), w1 = __builtin_amdgcn_exp2f(l1[q] - mx), w2 = __builtin_amdgcn_exp2f(l2[q] - mx);
            const float inv = 1.0f / (w0 + w1 + w2); w0 *= inv; w1 *= inv; w2 *= inv;
            u32x2 o;
#pragma unroll
            for (int hw = 0; hw < 2; ++hw) { const int aw = (int)a[q][hw], bw = (int)b[q][hw], dw = (int)d[q][hw];
                const f32x2 a0 = __builtin_amdgcn_cvt_pk_f32_fp8(aw, false), a1 = __builtin_amdgcn_cvt_pk_f32_fp8(aw, true), b0 = __builtin_amdgcn_cvt_pk_f32_fp8(bw, false), b1 = __builtin_amdgcn_cvt_pk_f32_fp8(bw, true),
                            d0 = __builtin_amdgcn_cvt_pk_f32_fp8(dw, false), d1 = __builtin_amdgcn_cvt_pk_f32_fp8(dw, true);
                o[hw] = pk4_fp8(w0 * a0[0] + w1 * b0[0] + w2 * d0[0], w0 * a0[1] + w1 * b0[1] + w2 * d0[1], w0 * a1[0] + w1 * b1[0] + w2 * d1[0], w0 * a1[1] + w1 * b1[1] + w2 * d1[1]); }
            *(GAS u32x2*)(att + tok * 512 + ch * 8) = o; }
    }
}

DI float wave_sum(float v) {
    return __builtin_bit_cast(float, __builtin_amdgcn_readlane(__builtin_bit_cast(int, scan64(v)), 63));
}
constexpr int R_WR = 0, R_HIST = 65536, R_BASE = 65536 + 64, R_INFO = 65536 + 128, R_LG = 70144;
DI void phase_r(LAS unsigned char* lds, const Ctx& c, int l, int G) {
    const int tid = ltid(), lane = tid & 63, wave = rfl(tid >> 6);
    LAS float* WR = (LAS float*)(lds + R_WR); volatile LAS int* HIST = (volatile LAS int*)(lds + R_HIST); volatile LAS int* BASE = (volatile LAS int*)(lds + R_BASE); volatile LAS int* INFO = (volatile LAS int*)(lds + R_INFO); LAS float* LG = (LAS float*)(lds + R_LG);
    __syncthreads();
#pragma unroll
    for (int i0 = 0; i0 < 16 * 1024; i0 += 8 * NTHREADS) {
        float wv8[8];
#pragma unroll
        for (int q = 0; q < 8; ++q) wv8[q] = ((const GAS float*)c.w_router)[i0 + q * NTHREADS + tid];
#pragma unroll
        for (int q = 0; q < 8; ++q) { const int i = i0 + q * NTHREADS + tid; WR[(i & 15) * 1024 + (i >> 4)] = wv8[q]; }
    }
    f32x4 g4[4], b4[4];
#pragma unroll
    for (int j = 0; j < 4; ++j) { g4[j] = *(const GAS f32x4*)(c.ln1_g + l * D + 4 * lane + 256 * j); b4[j] = *(const GAS f32x4*)(c.ln1_b + l * D + 4 * lane + 256 * j); }
    bf16_t* xr = wsb(c, WS_XR); unsigned char* xb = c.ws + WS_XB; GAS int* histg = (GAS int*)(c.ws + WS_HISTG); GAS float* gate = (GAS float*)(c.ws + WS_GATE); GAS float* stat = (GAS float*)(c.ws + WS_STAT);
    const int elane = ((lane >> 5) & 1) * 8 + ((lane >> 4) & 1) * 4 + ((lane >> 3) & 1) * 2 + ((lane >> 2) & 1);
    const float brt = ((const GAS float*)c.b_router)[((lane >> 5) & 1) * 8 + ((lane >> 4) & 1) * 4 + ((lane >> 3) & 1) * 2 + ((lane >> 2) & 1)];
    for (int chunk = lbid(); chunk < T / 256; chunk += G) {
        __syncthreads();
        u32x2 zn[2][4];
#pragma unroll
        for (int q = 0; q < 2; ++q)
#pragma unroll
            for (int j = 0; j < 4; ++j) zn[q][j] = *(const GAS u32x2*)(xr + ((size_t)chunk * 256 + wave * 32 + q) * D + 4 * lane + 256 * j);
        for (int rr = 0; rr < 32; rr += 2) {
            const int rl = wave * 32 + rr; const size_t row = (size_t)chunk * 256 + rl;
            f32x4 v[2][4];
#pragma unroll
            for (int q = 0; q < 2; ++q) {
                float s = 0.f;
#pragma unroll
                for (int j = 0; j < 4; ++j) { const u32x2 zq = zn[q][j]; v[q][j] = (f32x4){bf_lo(zq.x), bf_hi(zq.x), bf_lo(zq.y), bf_hi(zq.y)}; s += (v[q][j][0] + v[q][j][1]) + (v[q][j][2] + v[q][j][3]); }
                { const size_t rn = row + q + (rr + 2 < 32 ? 2 : 0);
#pragma unroll
                  for (int j = 0; j < 4; ++j) zn[q][j] = *(const GAS u32x2*)(xr + rn * D + 4 * lane + 256 * j); }
                const float mean = wave_sum(s) * (1.0f / D); float s2 = 0.f;
#pragma unroll
                for (int j = 0; j < 4; ++j) { v[q][j] = v[q][j] - mean; s2 += (v[q][j][0] * v[q][j][0] + v[q][j][1] * v[q][j][1]) + (v[q][j][2] * v[q][j][2] + v[q][j][3] * v[q][j][3]); }
                const float rstd = __builtin_amdgcn_rsqf(wave_sum(s2) * (1.0f / D) + LN_EPS);
#pragma unroll
                for (int j = 0; j < 4; ++j) { v[q][j] = v[q][j] * rstd * g4[j] + b4[j];
                    *(GAS unsigned*)(xb + (row + q) * D + 4 * lane + 256 * j) = pk4_fp8(v[q][j][0], v[q][j][1], v[q][j][2], v[q][j][3]); }
                if (lane == 0) *(GAS f32x2*)(stat + (row + q) * 2) = (f32x2){mean, rstd};
                asm volatile("" ::: "memory");
            }
            const bool h5 = lane & 32, h4 = lane & 16, h3 = lane & 8, h2 = lane & 4;
            float b8[2][8];
#pragma unroll
            for (int i = 0; i < 8; ++i) {
                f32x2 a2[2][2];
#pragma unroll
                for (int q = 0; q < 2; ++q) { a2[q][0] = (f32x2){0.f, 0.f}; a2[q][1] = (f32x2){0.f, 0.f}; }
#pragma unroll
                for (int hh = 0; hh < 2; ++hh)
#pragma unroll
                    for (int j = 0; j < 4; ++j) { const f32x4 wv = *(const LAS f32x4*)(WR + (i + 8 * hh) * 1024 + 4 * lane + 256 * j); const f32x2 w01 = __builtin_shufflevector(wv, wv, 0, 1), w23 = __builtin_shufflevector(wv, wv, 2, 3);
#pragma unroll
                        for (int q = 0; q < 2; ++q) { a2[q][hh] = __builtin_shufflevector(v[q][j], v[q][j], 0, 1) * w01 + a2[q][hh]; a2[q][hh] = __builtin_shufflevector(v[q][j], v[q][j], 2, 3) * w23 + a2[q][hh]; } }
#pragma unroll
                for (int q = 0; q < 2; ++q) { const float lo = a2[q][0][0] + a2[q][0][1], hi = a2[q][1][0] + a2[q][1][1]; const float mine = h5 ? hi : lo, send = h5 ? lo : hi; b8[q][i] = mine + __shfl_xor(send, 32); }
                asm volatile("" ::: "memory");
            }
#pragma unroll
            for (int q = 0; q < 2; ++q) {
                float b4_[4], b2[2];
#pragma unroll
                for (int i = 0; i < 4; ++i) { const float mine = h4 ? b8[q][4 + i] : b8[q][i], send = h4 ? b8[q][i] : b8[q][4 + i]; b4_[i] = mine + __shfl_xor(send, 16); }
#pragma unroll
                for (int i = 0; i < 2; ++i) { const float mine = h3 ? b4_[2 + i] : b4_[i], send = h3 ? b4_[i] : b4_[2 + i]; b2[i] = mine + __shfl_xor(send, 8); }
                float b1 = (h2 ? b2[1] : b2[0]) + __shfl_xor(h2 ? b2[0] : b2[1], 4);
                b1 += __shfl_xor(b1, 2); b1 += __shfl_xor(b1, 1);
                b1 += brt;
                if ((lane & 3) == 0) LG[(rl + q) * 16 + elane] = b1;
            }
        }
        {
            const int rl = wave * 32 + (lane & 31); const size_t row = (size_t)chunk * 256 + rl;
            float lg[16];
#pragma unroll
            for (int q = 0; q < 4; ++q) { const f32x4 t4 = *(const LAS f32x4*)(LG + rl * 16 + 4 * q); lg[4 * q] = t4[0]; lg[4 * q + 1] = t4[1]; lg[4 * q + 2] = t4[2]; lg[4 * q + 3] = t4[3]; }
            float mx = lg[0];
#pragma unroll
            for (int e = 1; e < 16; ++e) mx = fmaxf(mx, lg[e]);
            float se = 0.f;
#pragma unroll
            for (int e = 0; e < 16; ++e) { lg[e] = __expf(lg[e] - mx); se += lg[e]; }
            const float ise = 1.0f / se;
#pragma unroll
            for (int e = 0; e < 16; ++e) lg[e] *= ise;
            int gsel = 0; float gbest = -1.f;
#pragma unroll
            for (int gi = 0; gi < 4; ++gi) { const float a = lg[4 * gi], b = lg[4 * gi + 1], cc = lg[4 * gi + 2], d = lg[4 * gi + 3];
                const float sc = (a + b + cc + d) - fminf(fminf(a, b), fminf(cc, d)) - fminf(fmaxf(fminf(a, b), fminf(cc, d)), fminf(fmaxf(a, b), fmaxf(cc, d)));
                if (sc > gbest) { gbest = sc; gsel = gi; } }
            float p[4];
#pragma unroll
            for (int k = 0; k < 4; ++k) p[k] = gsel == 0 ? lg[k] : gsel == 1 ? lg[4 + k] : gsel == 2 ? lg[8 + k] : lg[12 + k];
            int i0 = 0; float v0 = p[0];
#pragma unroll
            for (int k = 1; k < 4; ++k) if (p[k] > v0) { v0 = p[k]; i0 = k; }
            int i1 = -1; float v1 = -1.f;
#pragma unroll
            for (int k = 0; k < 4; ++k) if (k != i0 && p[k] > v1) { v1 = p[k]; i1 = k; }
            if (lane < 32) { const int e0 = 4 * gsel + i0, e1 = 4 * gsel + i1; INFO[rl * 4 + 0] = e0; INFO[rl * 4 + 1] = e1;
                const float gs = 1.0f / (v0 + v1); *(GAS f32x2*)(gate + row * 2) = (f32x2){v0 * gs, v1 * gs}; }
        }
        __syncthreads();
        {
            int cnt0 = 0, cnt1 = 0; const unsigned long long lt = (1ull << lane) - 1ull;
#pragma unroll
            for (int b = 0; b < 4; ++b) { const int r = 64 * b + lane; const int e0 = INFO[r * 4], e1 = INFO[r * 4 + 1];
                const bool a0 = (e0 == 2 * wave) || (e1 == 2 * wave), a1 = (e0 == 2 * wave + 1) || (e1 == 2 * wave + 1);
                const unsigned long long m0 = __ballot(a0), m1 = __ballot(a1);
                if (a0) INFO[r * 4 + (e0 == 2 * wave ? 2 : 3)] = cnt0 + __popcll(m0 & lt);
                if (a1) INFO[r * 4 + (e0 == 2 * wave + 1 ? 2 : 3)] = cnt1 + __popcll(m1 & lt);
                cnt0 += __popcll(m0); cnt1 += __popcll(m1); }
            if (lane == 0) { histg[chunk * 16 + 2 * wave] = cnt0; histg[chunk * 16 + 2 * wave + 1] = cnt1; }
        }
        __syncthreads();
        if (tid < 256) { i32x4 v; v.x = INFO[tid * 4]; v.y = INFO[tid * 4 + 1]; v.z = INFO[tid * 4 + 2]; v.w = INFO[tid * 4 + 3]; ((GAS i32x4*)(c.ws + WS_INFO))[(size_t)chunk * 256 + tid] = v; }
        __syncthreads();
    }
}
DI void phase_r2(LAS unsigned char* lds, const Ctx& c, int l, int G) {
    const int tid = ltid(); volatile LAS int* BASE = (volatile LAS int*)(lds + R_BASE);
    const GAS int* histg = (const GAS int*)(c.ws + WS_HISTG); GAS int* list = (GAS int*)(c.ws + WS_LIST);
    unsigned* cur = (unsigned*)(c.ws + WS_CTL) + CW_CUR + l * 16 * 64;
    for (int chunk = lbid(); chunk < T / 256; chunk += G) {
        __syncthreads();
        if (tid < 16) BASE[tid] = 0;
        __syncthreads();
        { const int e = tid & 15; int s = 0;
#pragma unroll
          for (int k = 0; k < T / 256 / 32; ++k) { const int cc = (tid >> 4) + 32 * k; s += cc < chunk ? histg[cc * 16 + e] : 0; }
          if (s) atomicAdd((int*)&BASE[e], s); }
        __syncthreads();
        if (tid < 256) { const i32x4 v = ((const GAS i32x4*)(c.ws + WS_INFO))[(size_t)chunk * 256 + tid]; const int row = chunk * 256 + tid;
            list[(size_t)v.x * T + BASE[v.x] + v.z] = row * 2; list[(size_t)v.y * T + BASE[v.y] + v.w] = row * 2 + 1; }
        if (chunk == T / 256 - 1 && tid < 16) __hip_atomic_store(cur + tid * 64, (unsigned)(BASE[tid] + histg[chunk * 16 + tid]), __ATOMIC_RELAXED, __HIP_MEMORY_SCOPE_AGENT);
    }
}
DI int moe_setup(LAS unsigned char* lds, const Ctx& c, int l) {
    volatile LAS int* PRE = (volatile LAS int*)(lds + MISC_OFF); volatile LAS int* CNT = PRE + 17;
    unsigned* cur = (unsigned*)(c.ws + WS_CTL) + CW_CUR + l * 16 * 64;
    __syncthreads();
    if (threadIdx.x < 16) CNT[threadIdx.x] = (int)__hip_atomic_load((GAS unsigned*)(cur + threadIdx.x * 64), __ATOMIC_RELAXED, __HIP_MEMORY_SCOPE_AGENT);
    __syncthreads();
    if (threadIdx.x == 0) { int acc = 0; for (int e = 0; e < 16; ++e) { PRE[e] = acc; acc += (CNT[e] + 255) >> 8; } PRE[16] = acc; }
    __syncthreads();
    return rfl(PRE[16]);
}
template <bool LAST> DI void phase_c(const Ctx& c, int l, int G) {
    const int tid = ltid(), lane = tid & 63, wave = rfl(tid >> 6);
    f32x4 g4[4], b4[4];
#pragma unroll
    for (int j = 0; j < 4; ++j) { g4[j] = *(const GAS f32x4*)(c.ln2_g + l * D + 4 * lane + 256 * j); b4[j] = *(const GAS f32x4*)(c.ln2_b + l * D + 4 * lane + 256 * j); }
    f32x4 h4[4], c4[4];
#pragma unroll
    for (int j = 0; j < 4; ++j) { h4[j] = *(const GAS f32x4*)(c.ln1_g + l * D + 4 * lane + 256 * j) * DN_ALPHA; c4[j] = *(const GAS f32x4*)(c.ln1_b + l * D + 4 * lane + 256 * j) * DN_ALPHA; }
    const GAS float* stat = (const GAS float*)(c.ws + WS_STAT);
    float* xo = c.out; bf16_t* xr = wsb(c, WS_XR); unsigned char* xb = c.ws + WS_XB; const unsigned char* ys = c.ws + WS_YS; const GAS float* gate = (const GAS float*)(c.ws + WS_GATE);
    const size_t rstep = (size_t)G * NWAVES; size_t row = (size_t)lbid() * NWAVES + wave;
    u32x2 xn[2][4]; unsigned y0n[2][4], y1n[2][4]; float g0n[2], g1n[2], mun[2], rsn[2];
#define C_LOAD(sl, r_) do { const size_t rq_ = (r_); g0n[sl] = gate[rq_ * 2]; g1n[sl] = gate[rq_ * 2 + 1]; mun[sl] = stat[rq_ * 2]; rsn[sl] = stat[rq_ * 2 + 1]; \
        _Pragma("unroll") for (int j = 0; j < 4; ++j) { xn[sl][j] = *(const GAS u32x2*)(xr + rq_ * D + 4 * lane + 256 * j); y0n[sl][j] = *(const GAS unsigned*)(ys + (rq_ * 2) * D + 4 * lane + 256 * j); y1n[sl][j] = *(const GAS unsigned*)(ys + (rq_ * 2 + 1) * D + 4 * lane + 256 * j); } } while (0)
    if (row < (size_t)T) { C_LOAD(0, row); C_LOAD(1, row + rstep < (size_t)T ? row + rstep : row); }
    for (; row < (size_t)T; row += 2 * rstep) {
#pragma unroll
        for (int sl = 0; sl < 2; ++sl) {
            const size_t rw = row + sl * rstep; if (rw >= (size_t)T) break;
            const float g0 = g0n[sl], g1 = g1n[sl], mu = mun[sl], rs = rsn[sl];
            f32x4 v[4]; float s = 0.f;
#pragma unroll
            for (int j = 0; j < 4; ++j) { const u32x2 xq = xn[sl][j]; const unsigned y0 = y0n[sl][j], y1 = y1n[sl][j];
                const f32x2 y0a = __builtin_amdgcn_cvt_pk_f32_fp8((int)y0, false), y0b = __builtin_amdgcn_cvt_pk_f32_fp8((int)y0, true), y1a = __builtin_amdgcn_cvt_pk_f32_fp8((int)y1, false), y1b = __builtin_amdgcn_cvt_pk_f32_fp8((int)y1, true);
                const f32x4 zc = ((f32x4){bf_lo(xq.x), bf_hi(xq.x), bf_lo(xq.y), bf_hi(xq.y)} - mu) * rs;
                const f32x4 ax = zc * h4[j] + c4[j];
                v[j][0] = ax[0] + g0 * y0a[0] + g1 * y1a[0]; v[j][1] = ax[1] + g0 * y0a[1] + g1 * y1a[1];
                v[j][2] = ax[2] + g0 * y0b[0] + g1 * y1b[0]; v[j][3] = ax[3] + g0 * y0b[1] + g1 * y1b[1];
                s += (v[j][0] + v[j][1]) + (v[j][2] + v[j][3]); }
            C_LOAD(sl, rw + 2 * rstep < (size_t)T ? rw + 2 * rstep : rw);
            const float mean = wave_sum(s) * (1.0f / D); float s2 = 0.f;
#pragma unroll
            for (int j = 0; j < 4; ++j) { v[j] = v[j] - mean; s2 += (v[j][0] * v[j][0] + v[j][1] * v[j][1]) + (v[j][2] * v[j][2] + v[j][3] * v[j][3]); }
            const float rstd = __builtin_amdgcn_rsqf(wave_sum(s2) * (1.0f / D) + LN_EPS);
#pragma unroll
            for (int j = 0; j < 4; ++j) { v[j] = v[j] * rstd * g4[j] + b4[j];
                if constexpr (LAST) *(GAS f32x4*)(xo + rw * D + 4 * lane + 256 * j) = v[j];
                else { u32x2 xq; xq.x = cvt_pk_bf16(v[j][0], v[j][1]); xq.y = cvt_pk_bf16(v[j][2], v[j][3]); *(GAS u32x2*)(xr + rw * D + 4 * lane + 256 * j) = xq;
                    *(GAS unsigned*)(xb + rw * D + 4 * lane + 256 * j) = pk4_fp8(v[j][0], v[j][1], v[j][2], v[j][3]); } }
        }
    }
#undef C_LOAD
}

DI Ctx load_ctx() {
    union { Ctx c; unsigned long long q[sizeof(Ctx) / 8]; } u;
#if defined(__HIP_DEVICE_COMPILE__)
    const __attribute__((address_space(4))) unsigned long long* p = (const __attribute__((address_space(4))) unsigned long long*)__builtin_amdgcn_kernarg_segment_ptr();
    asm volatile("" : "+s"(p));
#pragma unroll
    for (int i = 0; i < (int)(sizeof(Ctx) / 8); ++i) u.q[i] = p[i];
#endif
    return u.c;
}
#define CTX const Ctx c = load_ctx(); const int G = lgrid(); LAS unsigned char* lds = LDSBASE
__global__ void __launch_bounds__(NTHREADS, 2) mk_fwd(Ctx c_arg) {
    extern __shared__ __attribute__((aligned(16))) unsigned char lds_raw[];
#define LDSBASE ({ unsigned _b = (unsigned)(uintptr_t)(LAS unsigned char*)lds_raw; asm volatile("" : "+s"(_b)); (LAS unsigned char*)(uintptr_t)_b; })
    LAS unsigned char* lds0 = LDSBASE;
    const int tid = threadIdx.x; const Ctx c = load_ctx();
    volatile LAS unsigned* MISC = (volatile LAS unsigned*)(lds0 + MISC_OFF);
    if (tid < 64) MISC[tid] = 0u;
    __syncthreads();
    XcdBarrier bar; bar.bar = (unsigned*)(c.ws + WS_CTL) + CW_BAR; bar.x = 0; bar.st = MISC + 40;
    if (!MK_MULTI) bar = xcd_barrier_post((unsigned*)(c.ws + WS_CTL) + CW_BAR, MISC + 40);
    const int lo = c.lo, hi = c.hi; int step = 0;
#define RUN (lo <= step && step < hi)
#define END_STEP do { if (RUN && step + 1 < hi) { if (!MK_MULTI) xcd_barrier(bar); } ++step; } while (0)
#define END_STEP_NB do { ++step; } while (0)
    for (int l = 0; l < DEPTH; ++l) {
        if (RUN) { CTX; phase_w(lds, c, l, G); }
        END_STEP;
        for (int hf = 0; hf < 2; ++hf) {
            const size_t r0 = (size_t)hf * TH;
            if (RUN) {
                CTX;
                pg8::StaticOrder S; S.init(c.ws + WS_XB + r0 * D, c.ws + wset(l) + WS_WIN, TH, NIN, D / 2, G, lbid());
                EpiIn E{wsb(c, WS_H + H_QG), wsb(c, WS_H + H_KG), wsb(c, WS_H + H_VG), wsb(c, WS_H + H_SR), wsb(c, WS_H + H_QD), wsb(c, WS_H + H_KD), wsb(c, WS_H + H_VD), wsb(c, WS_H + H_GT), (float*)(c.ws + WS_HA), c.pos + r0};
                pg8::gemm_phase<EpiIn, pg8::StaticOrder, true>(lds, D / 2, S, E);
                if (l + 1 < DEPTH && lbid() >= (TH / 256) * (NIN / 256) % G && (TH / 256) * (NIN / 256) % G != 0) w_tickets(lds, c, l + 1, 1);
            }
            END_STEP;
            if (RUN) { CTX; phase_p(lds, c, l, G); }
            END_STEP;
            if (RUN) { CTX; phase_b1(lds, c, l, hf, G); }
            END_STEP;
            if (RUN) { CTX; phase_b(lds, c, l, hf, G); }
            END_STEP;
            if (RUN) { CTX; (void)lds; phase_f(c, G); }
            END_STEP_NB;
            if (RUN) {
                CTX;
                pg8::StaticOrder S; S.init(c.ws + WS_OG, c.ws + wset(l) + WS_WGO, TH, D, D / 2, G, lbid());
                EpiGate<false> E{wsb(c, WS_MIX), c.ws + WS_H + H_GT, nullptr};
                pg8::gemm_phase<EpiGate<false>, pg8::StaticOrder, true>(lds, D / 2, S, E);
            }
            END_STEP;
            if (RUN) {
                CTX;
                pg8::StaticOrder S; S.init(c.ws + WS_ATT, c.ws + wset(l) + WS_WAO, TH, D, 256, G, lbid());
                EpiGate<true> E{wsb(c, WS_MIX), c.ws + WS_H + H_GT + 1024, c.ws + WS_OG + 32 * MiB};
                pg8::gemm_phase<EpiGate<true>, pg8::StaticOrder, true>(lds, 256, S, E);
            }
            END_STEP;
            if (RUN) {
                CTX;
                pg8::StaticOrder S; S.init(c.ws + WS_OG + 32 * MiB, c.ws + wset(l) + WS_WOUT, TH, D, D / 2, G, lbid());
                EpiRes E{l == 0 ? c.x + r0 * D : nullptr, wsb(c, WS_XR) + r0 * D};
                pg8::gemm_phase<EpiRes, pg8::StaticOrder, true>(lds, D / 2, S, E);
            }
            if (hf == 1) END_STEP; else END_STEP_NB;
        }
        if (RUN) { CTX; phase_r(lds, c, l, G); }
        END_STEP;
        if (RUN) { CTX; phase_r2(lds, c, l, G); }
        END_STEP;
        if (RUN) {   CTX;
            const int ntiles = moe_setup(lds, c, l);
            volatile LAS int* PRE = (volatile LAS int*)(lds + MISC_OFF); volatile LAS int* TAB = (volatile LAS int*)(lds + TAB_OFF);
            pg8::MoeOrder S; S.G = G; S.c = vcu_of(lbid(), G); S.ntot = ntiles * 8; S.NC = 8; S.K = D / 2; S.pre = PRE; S.cnt = PRE + 17; S.A = (const char*)(c.ws + WS_XB); S.Bt = (const char*)(c.ws + wset(l) + WS_WGU);
            S.bstride = (size_t)2048 * 1024; S.tab = TAB; S.gather = true;
            const GAS int* list = (const GAS int*)(c.ws + WS_LIST);
            { const int lt_tid = ltid(); const int r = lt_tid & 255, half = rfl(lt_tid >> 8);
              int tv[MAXU / 2];
#pragma unroll
              for (int k = 0; k < MAXU / 2; ++k) { Unit u; const int i = 2 * k + half; tv[k] = 0;
                  if (S.next(i, u)) { const int lt = u.pm - PRE[u.e]; const int pos = 256 * lt + (r < u.nv ? r : 0); tv[k] = list[(size_t)u.e * T + pos]; } }
#pragma unroll
              for (int k = 0; k < MAXU / 2; ++k) { const int i = 2 * k + half; if (S.lin(i) >= 0) TAB[i * 256 + r] = tv[k] >> 1; } }
            __syncthreads();
            EpiM1 E{c.ws + WS_HM};
            pg8::gemm_phase<EpiM1, pg8::MoeOrder, true>(lds, D / 2, S, E);
            if (l + 1 < DEPTH && S.lin((S.ntot + G - 1) / G - 1) < 0) w_tickets(lds, c, l + 1, 1);
        }
        END_STEP;
        if (RUN) {   CTX;
            const int ntiles = moe_setup(lds, c, l);
            volatile LAS int* PRE = (volatile LAS int*)(lds + MISC_OFF);
            pg8::MoeOrder S; S.G = G; S.c = vcu_of(lbid(), G); S.ntot = ntiles * 4; S.NC = 4; S.K = DFF / 2; S.pre = PRE; S.cnt = PRE + 17; S.A = (const char*)(c.ws + WS_HM); S.Bt = (const char*)(c.ws + wset(l) + WS_WD);
            S.bstride = (size_t)1024 * 1024; S.tab = nullptr; S.gather = false;
            EpiM2 E{c.ws + WS_YS, (const int*)(c.ws + WS_LIST), PRE};
            pg8::gemm_phase<EpiM2, pg8::MoeOrder, true>(lds, DFF / 2, S, E);
            if (l + 1 < DEPTH && S.lin((S.ntot + G - 1) / G - 1) < 0) w_tickets(lds, c, l + 1, 1);
        }
        END_STEP;
        if (RUN) { CTX; (void)lds; if (l == DEPTH - 1) phase_c<true>(c, l, G); else phase_c<false>(c, l, G); }
        END_STEP_NB;
    }
#undef RUN
#undef END_STEP
#undef END_STEP_NB
}
constexpr int NSTEPS = DEPTH * (1 + 2 * 8 + 5);

extern "C" void kernel_launch(void* const* d_in, const int* in_sizes, int n_in, void* d_out, int out_size, void* d_ws, size_t ws_size, hipStream_t stream) {
    static int grid = 0;
    if (grid == 0) {
        if (n_in != 18 || in_sizes[0] != T * D || out_size != T * D || ws_size < WS_END) { fprintf(stderr, "kernel_launch: unexpected shapes / workspace (need %zu, got %zu)\n", (size_t)WS_END, ws_size); grid = -1; return; }
        int dev = 0, cus = 0;
        if (hipGetDevice(&dev) != hipSuccess || hipDeviceGetAttribute(&cus, hipDeviceAttributeMultiprocessorCount, dev) != hipSuccess) { grid = -1; return; }
        if (hipFuncSetAttribute((const void*)mk_fwd, hipFuncAttributeMaxDynamicSharedMemorySize, LDS_BYTES) != hipSuccess) { fprintf(stderr, "kernel_launch: hipFuncSetAttribute failed\n"); grid = -1; return; }
        int per_cu = 0;
        if (hipOccupancyMaxActiveBlocksPerMultiprocessor(&per_cu, (const void*)mk_fwd, NTHREADS, LDS_BYTES) != hipSuccess || per_cu < 1) { fprintf(stderr, "kernel_launch: occupancy query says %d\n", per_cu); }
        (void)hipGetLastError();
        grid = cus;
    }
    if (grid < 0) return;
    (void)hipMemsetAsync((char*)d_ws + WS_CTL, 0, CTL_ZERO_BYTES, stream);
    Ctx c{};
    c.x = (const float*)d_in[0]; c.pos = (const int*)d_in[1]; c.w_in = (const float*)d_in[2]; c.w_alpha_up = (const float*)d_in[3]; c.b_alpha = (const float*)d_in[4]; c.gla_norm = (const float*)d_in[5];
    c.w_gla_o = (const float*)d_in[6]; c.w_att_o = (const float*)d_in[7]; c.w_out = (const float*)d_in[8]; c.ln1_g = (const float*)d_in[9]; c.ln1_b = (const float*)d_in[10]; c.w_router = (const float*)d_in[11];
    c.b_router = (const float*)d_in[12]; c.w_e_gate = (const float*)d_in[13]; c.w_e_up = (const float*)d_in[14]; c.w_e_down = (const float*)d_in[15]; c.ln2_g = (const float*)d_in[16]; c.ln2_b = (const float*)d_in[17];
    c.out = (float*)d_out; c.ws = (unsigned char*)d_ws;
#if MK_MULTI
    for (int s = 0; s < NSTEPS; ++s) { c.lo = s; c.hi = s + 1; hipLaunchKernelGGL(mk_fwd, dim3(grid), dim3(NTHREADS), LDS_BYTES, stream, c); }
#else
    c.lo = 0; c.hi = NSTEPS; hipLaunchKernelGGL(mk_fwd, dim3(grid), dim3(NTHREADS), LDS_BYTES, stream, c);
#endif
}
```
